# Optimizing an MI355X kernel written in HIP

```python
import jax
import jax.numpy as jnp
from jax import lax
import numpy as np


D_MODEL = 4096
BATCH = 2
SEQ = 8192
DEPTH = 2

HEAD_DIM = 128
MIX_WIDTH = D_MODEL
A_HEADS = MIX_WIDTH // (2 * HEAD_DIM)
B_HEADS = MIX_WIDTH // (2 * HEAD_DIM)
A_WIDTH = A_HEADS * HEAD_DIM
B_WIDTH = B_HEADS * HEAD_DIM
HGRN_CHUNK = 64
SB_Q_BLOCK = 128
NSA_HEADS = MIX_WIDTH // HEAD_DIM
NSA_KV_HEADS = 4
NSA_GROUP = NSA_HEADS // NSA_KV_HEADS
KV_WIDTH = NSA_KV_HEADS * HEAD_DIM
CMP_LEN = 32
CMP_STRIDE = 16
SLC_LEN = 64
SLC_TOP = 16
WINDOW = 512
NSA_Q_BLOCK = 64
N_MEM = 256
XA_HEADS = 4
XA_WIDTH = XA_HEADS * HEAD_DIM
D_FF = ((8 * D_MODEL // 3 + 255) // 256) * 256
CONV_W = 3
ROPE_THETA = 10000.0
DN_ALPHA = (2 * DEPTH) ** 0.25
DN_BETA = (8 * DEPTH) ** -0.25
N_EVEN = (DEPTH + 1) // 2
N_ODD = DEPTH // 2
LN_EPS = 1e-5
RMS_EPS = 1e-6
NEG_INF = -1e30
FORCE_SCORE = 1e9

kernel_name = 'hybrid_hgrn2_stickbreak_nsa_deepnorm'


def layer_norm(x, g, b):
    xf = x.astype(jnp.float32)
    mu = jnp.mean(xf, axis=-1, keepdims=True)
    var = jnp.mean(jnp.square(xf - mu), axis=-1, keepdims=True)
    y = (xf - mu) * lax.rsqrt(var + LN_EPS) * g.astype(jnp.float32) + b.astype(jnp.float32)
    return y.astype(x.dtype)


def rope(t, pos):
    half = t.shape[-1] // 2
    inv_freq = ROPE_THETA ** (-jnp.arange(half, dtype=jnp.float32) / half)
    ang = pos.astype(jnp.float32)[:, None] * inv_freq[None, :]
    cos = jnp.cos(ang)[None, :, None, :]
    sin = jnp.sin(ang)[None, :, None, :]
    tf = t.astype(jnp.float32)
    t1, t2 = tf[..., :half], tf[..., half:]
    return jnp.concatenate([t1 * cos - t2 * sin, t2 * cos + t1 * sin], axis=-1).astype(t.dtype)


def masked_softmax(s, mask):
    s = jnp.where(mask, s, NEG_INF)
    return jnp.where(mask, jax.nn.softmax(s, axis=-1), 0.0)


def hgrn2_chunked(q, f_logit, i, lb):
    B, S, H, Dk = q.shape
    Dv = i.shape[-1]
    C = HGRN_CHUNK
    NC = S // C
    zf = f_logit.astype(jnp.float32)
    log_f = jnp.log(lb + (1.0 - lb) * jax.nn.sigmoid(zf))
    k = (1.0 - lb) * jax.nn.sigmoid(-zf)

    def chunks(t):
        return t.reshape(B, NC, C, H, t.shape[-1]).transpose(1, 0, 3, 2, 4)

    qc = chunks(q.astype(jnp.float32))
    kc = chunks(k)
    vc = chunks(i.astype(jnp.float32))
    bc = jnp.cumsum(chunks(log_f), axis=3)
    causal = jnp.tril(jnp.ones((C, C), dtype=bool))[:, :, None]

    def step(state, inp):
        q_, k_, v_, b_ = inp
        diff = b_[:, :, :, None, :] - b_[:, :, None, :, :]
        decay = jnp.exp(jnp.where(causal, diff, -jnp.inf))
        scores = jnp.einsum('bhtd,bhtsd->bhts', q_, decay * k_[:, :, None, :, :])
        o = jnp.einsum('bhts,bhsv->bhtv', scores, v_)
        o = o + jnp.einsum('bhtd,bhdv->bhtv', q_ * jnp.exp(b_), state)
        b_last = b_[:, :, -1, :]
        k_dec = k_ * jnp.exp(b_last[:, :, None, :] - b_)
        state = state * jnp.exp(b_last)[..., None] + jnp.einsum('bhsd,bhsv->bhdv', k_dec, v_)
        return state, o

    state0 = jnp.zeros((B, H, Dk, Dv), jnp.float32)
    _, o = lax.scan(step, state0, (qc, kc, vc, bc))
    return o.transpose(1, 0, 3, 2, 4).reshape(B, S, H, Dv)


def stick_breaking_attention(q, k, v):
    B, S, H, Dh = q.shape
    nb = S // SB_Q_BLOCK
    scale = Dh ** -0.5
    key_pos = jnp.arange(S)
    qb = q.reshape(B, nb, SB_Q_BLOCK, H, Dh).transpose(1, 0, 3, 2, 4)

    def block(args):
        q_blk, bi = args
        z = jnp.einsum('bhqd,bshd->bhqs', q_blk, k, preferred_element_type=jnp.float32) * scale
        t = bi * SB_Q_BLOCK + jnp.arange(SB_Q_BLOCK)
        mask = key_pos[None, :] < t[:, None]
        log_1m = jnp.where(mask, jax.nn.log_sigmoid(-z), 0.0)
        rev = lax.cumsum(log_1m, axis=3, reverse=True) - log_1m
        w = jnp.where(mask, jnp.exp(jax.nn.log_sigmoid(z) + rev), 0.0)
        return jnp.einsum('bhqs,bshd->bqhd', w.astype(v.dtype), v)

    out = lax.map(block, (qb, jnp.arange(nb)))
    return out.transpose(1, 0, 2, 3, 4).reshape(B, S, H, Dh)


def hgrn_stickbreak_mixer(h, w_in, lb, norm_w, w_out):
    B, S, _ = h.shape
    proj = h @ w_in
    cuts = [A_WIDTH, 2 * A_WIDTH, 3 * A_WIDTH, 4 * A_WIDTH, 4 * A_WIDTH + B_WIDTH, 4 * A_WIDTH + 2 * B_WIDTH]
    a_q, a_f, a_i, a_g, b_q, b_k, b_v = jnp.split(proj, cuts, axis=-1)

    def heads(t, n):
        return t.reshape(B, S, n, HEAD_DIM)

    o_a = hgrn2_chunked(heads(a_q, A_HEADS), heads(a_f, A_HEADS), heads(a_i, A_HEADS),
                        lb.reshape(A_HEADS, HEAD_DIM))
    gate = jax.nn.silu(heads(a_g, A_HEADS).astype(jnp.float32))
    o_a = o_a * lax.rsqrt(jnp.mean(jnp.square(o_a), axis=-1, keepdims=True) + RMS_EPS) \
        * norm_w.astype(jnp.float32) * gate
    o_b = stick_breaking_attention(heads(b_q, B_HEADS), heads(b_k, B_HEADS), heads(b_v, B_HEADS))
    o = jnp.concatenate([o_a.astype(h.dtype).reshape(B, S, A_WIDTH), o_b.reshape(B, S, B_WIDTH)], axis=-1)
    return o @ w_out


def compress_blocks(t, pos_emb, w1, w2, n_cmp):
    idx = jnp.arange(n_cmp)[:, None] * CMP_STRIDE + jnp.arange(CMP_LEN)[None, :]
    blocks = t[:, idx] + pos_emb[None, None, :, None, :]
    hid = jax.nn.gelu(jnp.einsum('bnlgd,lde->bnge', blocks, w1), approximate=False)
    return jnp.einsum('bnge,ef->bngf', hid, w2)


def nsa_mixer(h, w_in, cmp_pos, cmp_w1, cmp_w2, w_out, pos):
    B, S, _ = h.shape
    G, R, Dh = NSA_KV_HEADS, NSA_GROUP, HEAD_DIM
    scale = Dh ** -0.5
    proj = h @ w_in
    q_w = NSA_HEADS * Dh
    cuts = [q_w + j * KV_WIDTH for j in range(7)]
    q, kc, vc, ks, vs, kw, vw, gl = jnp.split(proj, cuts, axis=-1)
    q = q.reshape(B, S, NSA_HEADS, Dh)
    q_nope = q.reshape(B, S, G, R, Dh)
    q_rot = rope(q, pos).reshape(B, S, G, R, Dh)
    kc, vc, ks, vs, kw, vw = [t.reshape(B, S, G, Dh) for t in (kc, vc, ks, vs, kw, vw)]
    ks = rope(ks, pos)
    kw = rope(kw, pos)
    gates = jax.nn.sigmoid(gl.astype(jnp.float32)).reshape(B, S, G, R, 3)

    n_cmp = (S - CMP_LEN) // CMP_STRIDE + 1
    k_cmp = compress_blocks(kc, cmp_pos[0], cmp_w1[0], cmp_w2[0], n_cmp)
    v_cmp = compress_blocks(vc, cmp_pos[1], cmp_w1[1], cmp_w2[1], n_cmp)
    cmp_start = jnp.arange(n_cmp) * CMP_STRIDE
    cmp_end = cmp_start + CMP_LEN - 1
    n_slc = S // SLC_LEN
    n_top = min(SLC_TOP, n_slc)
    slc_start = jnp.arange(n_slc) * SLC_LEN
    overlap = ((cmp_start[:, None] < slc_start[None, :] + SLC_LEN)
               & (cmp_start[:, None] + CMP_LEN > slc_start[None, :])).astype(jnp.float32)
    k_blocks = ks.reshape(B, n_slc, SLC_LEN, G, Dh).transpose(0, 3, 1, 2, 4)
    v_blocks = vs.reshape(B, n_slc, SLC_LEN, G, Dh).transpose(0, 3, 1, 2, 4)
    b_ix = jnp.arange(B)[:, None, None, None]
    g_ix = jnp.arange(G)[None, :, None, None]
    kw_pad = jnp.pad(kw, ((0, 0), (WINDOW, 0), (0, 0), (0, 0)))
    vw_pad = jnp.pad(vw, ((0, 0), (WINDOW, 0), (0, 0), (0, 0)))
    QB = NSA_Q_BLOCK
    nb = S // QB

    def block(bi):
        q0 = bi * QB
        t = q0 + jnp.arange(QB)
        qr = lax.dynamic_slice_in_dim(q_rot, q0, QB, axis=1)
        qn = lax.dynamic_slice_in_dim(q_nope, q0, QB, axis=1)
        gt = lax.dynamic_slice_in_dim(gates, q0, QB, axis=1)
        s_c = jnp.einsum('bqgrd,bngd->bgrqn', qn, k_cmp, preferred_element_type=jnp.float32) * scale
        p_c = masked_softmax(s_c, cmp_end[None, :] <= t[:, None])
        o_c = jnp.einsum('bgrqn,bngd->bqgrd', p_c.astype(v_cmp.dtype), v_cmp)
        imp = jnp.einsum('bgrqn,nj->bgqj', p_c, overlap)
        cur = t // SLC_LEN
        j = jnp.arange(n_slc)
        forced = (j[None, :] == 0) | (j[None, :] == cur[:, None]) | (j[None, :] == cur[:, None] - 1)
        allowed = j[None, :] * SLC_LEN <= t[:, None]
        score = jnp.where(forced, FORCE_SCORE, jnp.where(allowed, imp, -1.0))
        _, idx = lax.top_k(score, n_top)
        k_sel = k_blocks[b_ix, g_ix, idx]
        v_sel = v_blocks[b_ix, g_ix, idx]
        tok = idx[..., None] * SLC_LEN + jnp.arange(SLC_LEN)
        smask = (tok <= t[None, None, :, None, None]).reshape(B, G, 1, QB, n_top * SLC_LEN)
        s_s = jnp.einsum('bqgrd,bgqkld->bgrqkl', qr, k_sel, preferred_element_type=jnp.float32) * scale
        p_s = masked_softmax(s_s.reshape(B, G, R, QB, n_top * SLC_LEN), smask)
        o_s = jnp.einsum('bgrqkl,bgqkld->bqgrd',
                         p_s.reshape(B, G, R, QB, n_top, SLC_LEN).astype(v_sel.dtype), v_sel)
        kwb = lax.dynamic_slice_in_dim(kw_pad, q0, QB + WINDOW, axis=1)
        vwb = lax.dynamic_slice_in_dim(vw_pad, q0, QB + WINDOW, axis=1)
        kp = q0 - WINDOW + jnp.arange(QB + WINDOW)
        wmask = (kp[None, :] >= 0) & (kp[None, :] <= t[:, None]) & (kp[None, :] > t[:, None] - WINDOW)
        s_w = jnp.einsum('bqgrd,bkgd->bgrqk', qr, kwb, preferred_element_type=jnp.float32) * scale
        p_w = masked_softmax(s_w, wmask)
        o_w = jnp.einsum('bgrqk,bkgd->bqgrd', p_w.astype(vwb.dtype), vwb)
        out = gt[..., 0:1] * o_c + gt[..., 1:2] * o_s + gt[..., 2:3] * o_w
        return out.astype(h.dtype)

    o = lax.map(block, jnp.arange(nb))
    o = o.transpose(1, 0, 2, 3, 4, 5).reshape(B, S, NSA_HEADS * Dh)
    return o @ w_out


def memory_cross_attention(h, mem, w_q, w_kv, w_o):
    B, S, _ = h.shape
    q = (h @ w_q).reshape(B, S, XA_HEADS, HEAD_DIM)
    kv = (mem @ w_kv).reshape(mem.shape[0], mem.shape[1], 2, XA_HEADS, HEAD_DIM)
    k, v = kv[:, :, 0], kv[:, :, 1]
    s = jnp.einsum('bshd,bmhd->bhsm', q, k, preferred_element_type=jnp.float32) * HEAD_DIM ** -0.5
    p = jax.nn.softmax(s, axis=-1)
    o = jnp.einsum('bhsm,bmhd->bshd', p.astype(v.dtype), v).reshape(B, S, XA_WIDTH)
    return o @ w_o


def conv_glu_ffn(h, w_up, conv_w, w_down):
    S = h.shape[1]
    a, u = jnp.split(h @ w_up, 2, axis=-1)
    a_pad = jnp.pad(a, ((0, 0), (CONV_W - 1, 0), (0, 0)))
    c = conv_w[CONV_W - 1] * a
    for tap in range(CONV_W - 1):
        c = c + conv_w[tap] * a_pad[:, tap:tap + S]
    return (jax.nn.gelu(c, approximate=False) * u) @ w_down


def setup_inputs(seed: int = 0) -> dict:
    key = jax.random.key(seed)
    ks = jax.random.split(key, 20)
    D = D_MODEL
    ab_in = 4 * A_WIDTH + 3 * B_WIDTH
    nsa_in = NSA_HEADS * HEAD_DIM + 6 * KV_WIDTH + 3 * NSA_HEADS

    def nrm(k, shape, s):
        return jax.random.normal(k, shape, jnp.float32) * s

    return {
        'x': nrm(ks[0], (BATCH, SEQ, D), 1.0),
        'mem': nrm(ks[1], (BATCH, N_MEM, D), 1.0),
        'ab_w_in': nrm(ks[2], (N_EVEN, D, ab_in), D ** -0.5),
        'hgrn_lb': nrm(ks[3], (N_EVEN + 1, A_WIDTH), 0.1),
        'hgrn_norm_w': 1.0 + nrm(ks[4], (N_EVEN, HEAD_DIM), 0.02),
        'ab_w_out': nrm(ks[5], (N_EVEN, A_WIDTH + B_WIDTH, D), DN_BETA * (A_WIDTH + B_WIDTH) ** -0.5),
        'nsa_w_in': nrm(ks[6], (N_ODD, D, nsa_in), D ** -0.5),
        'nsa_cmp_pos': nrm(ks[7], (N_ODD, 2, CMP_LEN, HEAD_DIM), 0.1),
        'nsa_cmp_w1': nrm(ks[8], (N_ODD, 2, CMP_LEN, HEAD_DIM, HEAD_DIM), (CMP_LEN * HEAD_DIM) ** -0.5),
        'nsa_cmp_w2': nrm(ks[9], (N_ODD, 2, HEAD_DIM, HEAD_DIM), HEAD_DIM ** -0.5),
        'nsa_w_out': nrm(ks[10], (N_ODD, NSA_HEADS * HEAD_DIM, D), DN_BETA * (NSA_HEADS * HEAD_DIM) ** -0.5),
        'xa_w_q': nrm(ks[11], (DEPTH, D, XA_WIDTH), D ** -0.5),
        'xa_w_kv': nrm(ks[12], (DEPTH, D, 2 * XA_WIDTH), D ** -0.5),
        'xa_w_o': nrm(ks[13], (DEPTH, XA_WIDTH, D), DN_BETA * XA_WIDTH ** -0.5),
        'ffn_w_up': nrm(ks[14], (DEPTH, D, 2 * D_FF), D ** -0.5),
        'ffn_conv': nrm(ks[15], (DEPTH, CONV_W, D_FF), CONV_W ** -0.5),
        'ffn_w_down': nrm(ks[16], (DEPTH, D_FF, D), DN_BETA * D_FF ** -0.5),
        'ln_g': 1.0 + nrm(ks[17], (DEPTH, 3, D), 0.02),
        'ln_b': nrm(ks[18], (DEPTH, 3, D), 0.02),
    }


def reference(x, mem, ab_w_in, hgrn_lb, hgrn_norm_w, ab_w_out, nsa_w_in, nsa_cmp_pos, nsa_cmp_w1,
              nsa_cmp_w2, nsa_w_out, xa_w_q, xa_w_kv, xa_w_o, ffn_w_up, ffn_conv, ffn_w_down, ln_g, ln_b):
    S = x.shape[1]
    pos = jnp.arange(S)
    lb_all = jnp.cumsum(jax.nn.softmax(hgrn_lb.astype(jnp.float32), axis=0), axis=0)
    h = x
    for layer in range(DEPTH):
        if layer % 2 == 0:
            e = layer // 2
            mix = hgrn_stickbreak_mixer(h, ab_w_in[e], lb_all[e], hgrn_norm_w[e], ab_w_out[e])
        else:
            o = layer // 2
            mix = nsa_mixer(h, nsa_w_in[o], nsa_cmp_pos[o], nsa_cmp_w1[o], nsa_cmp_w2[o], nsa_w_out[o], pos)
        h = layer_norm(DN_ALPHA * h + mix, ln_g[layer, 0], ln_b[layer, 0])
        h = layer_norm(DN_ALPHA * h + memory_cross_attention(h, mem, xa_w_q[layer], xa_w_kv[layer], xa_w_o[layer]),
                       ln_g[layer, 1], ln_b[layer, 1])
        h = layer_norm(DN_ALPHA * h + conv_glu_ffn(h, ffn_w_up[layer], ffn_conv[layer], ffn_w_down[layer]),
                       ln_g[layer, 2], ln_b[layer, 2])
    return h
```

```cpp
#include <hip/hip_runtime.h>
#include <cstdio>
#include <cstdint>
namespace pg8 {
#define PG8_LAS __attribute__((address_space(3)))
typedef unsigned short bf16_t;
typedef short bf16x8 __attribute__((ext_vector_type(8)));
typedef float f32x4 __attribute__((ext_vector_type(4)));
typedef unsigned u32x4 __attribute__((ext_vector_type(4)));
constexpr int BM = 256, BK = 64, HALF = 128, HTB = HALF * BK * 2  , STAGE_BYTES = 8 * HTB, NXCD = 8, WGM = 8;

__host__ __device__ __forceinline__ int lds_byte(int r, int c) { const int st = (r >> 4) * 2 + (c >> 5), rr = r & 15, cc = c & 31, ob = rr * 64 + cc * 2; return st * 1024 + (ob ^ (((ob >> 9) & 1) << 5)); }
__host__ __device__ __forceinline__ void stage_rc(int b, int& R, int& C) { const int st = b / 1024, sb = b % 1024, swz = sb ^ (((sb >> 9) & 1) << 5); R = (st >> 1) * 16 + swz / 64; C = (st & 1) * 32 + (swz % 64) / 2; }
__host__ __device__ __forceinline__ int perm32(int rho) { const int n = rho >> 4, i = rho & 15; return 8 * (i >> 2) + 4 * n + (i & 3); }

struct Unit { int pm, pn; };
struct Gemm { const bf16_t* A; const bf16_t* Bt; int M, N, K; };

struct StaticOrder {
    int nM, nN, nwg, G, c;
    __host__ __device__ void init(int M, int N, int G_, int c_) { nM = M / BM; nN = N / BM; nwg = nM * nN; G = G_; c = c_; }
    __host__ __device__ bool next(int i, Unit& u) const {
        const long L = (long)i * G + c; if (L >= nwg) return false;
        int wgid = (int)L; { const int q = nwg / NXCD, r = nwg % NXCD, xcd = wgid % NXCD, off = wgid / NXCD; wgid = (xcd < r ? xcd * (q + 1) : r * (q + 1) + (xcd - r) * q) + off; }
        const int nig = WGM * nN, gid = wgid / nig, fm = gid * WGM, gsz = (nM - fm) < WGM ? (nM - fm) : WGM;
        u.pm = fm + ((wgid % nig) % gsz); u.pn = (wgid % nig) / gsz; return true;
    }
    __device__ __forceinline__ void a_ready(const Unit&) const {}
    __device__ __forceinline__ void done(const Unit&) const {}
};

__device__ __forceinline__ unsigned cvt_pk_bf16(float lo, float hi) { unsigned r; asm volatile("v_cvt_pk_bf16_f32 %0, %1, %2" : "=v"(r) : "v"(lo), "v"(hi)); return r; }
typedef float f32x2 __attribute__((ext_vector_type(2)));
__device__ __forceinline__ f32x2 gelu_pk(f32x2 v) {
    const f32x2 av = __builtin_elementwise_abs(v), d = av * 0.2316418882f + 1.0f;
    f32x2 t; t.x = __builtin_amdgcn_rcpf(d.x); t.y = __builtin_amdgcn_rcpf(d.y);
    f32x2 q = t * 0.5307027145f + (-0.7265760135f); q = q * t + 0.7107068705f; q = q * t + (-0.142248368f); q = q * t + 0.127414796f; q = q * t;
    const f32x2 s = (v * v) * (-0.72134752044f);
    f32x2 e; e.x = __builtin_amdgcn_exp2f(s.x); e.y = __builtin_amdgcn_exp2f(s.y);
    const f32x2 m = v * (q * e), r = v - m;
    f32x2 o; o.x = v.x < 0.f ? m.x : r.x; o.y = v.y < 0.f ? m.y : r.y; return o;
}

template <int ACT  > struct EpiBf16 {
    static constexpr bool PERM = true, AFTER_DRAIN = false; static_assert(ACT == 0 || ACT == 1, "EpiBf16: ACT is 0 (none) or 1 (gelu_pk)");
    bf16_t* O; int ldc; const float* bias; int split_cols; size_t split_stride; float scale0;
    __device__ __forceinline__ void operator()(const f32x4 (&acc)[2][2][4][2], const Unit& u, int wr, int wc, int fr, int fq) const {
        const int row0 = u.pm * BM + wr * 64 + fr; int colt = u.pn * BM; bf16_t* base = O;
        float sc = 1.f; if (split_cols) { const int t = colt / split_cols; base += (size_t)t * split_stride; colt -= t * split_cols; if (t == 0) sc = scale0; }
        const int col0 = colt + wc * 32 + 8 * fq, bcol0 = u.pn * BM + wc * 32 + 8 * fq;
        f32x4 bv[2][2];
#pragma unroll
        for (int bj = 0; bj < 2; ++bj)
#pragma unroll
            for (int n = 0; n < 2; ++n) bv[bj][n] = bias ? *(const f32x4*)(bias + bcol0 + bj * HALF + 4 * n) : (f32x4){0.f, 0.f, 0.f, 0.f};
#pragma unroll
        for (int ai = 0; ai < 2; ++ai)
#pragma unroll
            for (int m = 0; m < 4; ++m) { bf16_t* rowp = base + (size_t)(row0 + ai * HALF + m * 16) * ldc + col0;
#pragma unroll
                for (int bj = 0; bj < 2; ++bj) { f32x4 v0 = acc[ai][bj][m][0] + bv[bj][0], v1 = acc[ai][bj][m][1] + bv[bj][1];
                    if (ACT == 1) { f32x2 a = gelu_pk((f32x2){v0[0], v0[1]}), b = gelu_pk((f32x2){v0[2], v0[3]}), c = gelu_pk((f32x2){v1[0], v1[1]}), d = gelu_pk((f32x2){v1[2], v1[3]});
                        v0 = (f32x4){a.x, a.y, b.x, b.y}; v1 = (f32x4){c.x, c.y, d.x, d.y}; }
                    v0 = v0 * sc; v1 = v1 * sc; u32x4 w; w.x = cvt_pk_bf16(v0[0], v0[1]); w.y = cvt_pk_bf16(v0[2], v0[3]); w.z = cvt_pk_bf16(v1[0], v1[1]); w.w = cvt_pk_bf16(v1[2], v1[3]);
                    *(u32x4*)(rowp + bj * HALF) = w; } }
    }
};


struct EpiRes {
    static constexpr bool PERM = false, AFTER_DRAIN = false;
    float* Y; const float* res; int ldc; float alpha;
    __device__ __forceinline__ void operator()(const f32x4 (&acc)[2][2][4][2], const Unit& u, int wr, int wc, int fr, int fq) const {
        const int row0 = u.pm * BM + wr * 64 + fr, col0 = u.pn * BM + wc * 32 + 4 * fq;
#pragma unroll
        for (int ai = 0; ai < 2; ++ai)
#pragma unroll
            for (int m = 0; m < 4; ++m) { const size_t off = (size_t)(row0 + ai * HALF + m * 16) * ldc + col0;
#pragma unroll
                for (int bj = 0; bj < 2; ++bj)
#pragma unroll
                    for (int n = 0; n < 2; ++n) { const f32x4 r = *(const f32x4*)(res + off + bj * HALF + n * 16);
                        *(f32x4*)(Y + off + bj * HALF + n * 16) = r * alpha + acc[ai][bj][m][n]; } }
    }
};
struct RangeOrder {
    int nM, nN, ntot, c0, nw, c;
    __host__ __device__ void init(int M, int N, int c0_, int nw_, int c_) { nM = M / BM; nN = N / BM; ntot = nM * nN; c0 = c0_; nw = nw_; c = c_; }
    __host__ __device__ bool next(int i, Unit& u) const {
        if (c < c0 || c >= c0 + nw) return false;
        const int L = i * nw + (c - c0); if (L >= ntot) return false;
        u.pm = L / nN; u.pn = L % nN; return true;
    }
    __device__ __forceinline__ void a_ready(const Unit&) const {}
    __device__ __forceinline__ void done(const Unit&) const {}
};
template <class Epi, class Sched, bool ALIGN_EPI = false, bool SP2 = false>
__device__ __forceinline__ void gemm_phase(PG8_LAS unsigned char* lds, const Gemm g, const Sched& S, const Epi& E) {
    int tid_l = threadIdx.x; asm volatile("" : "+v"(tid_l)); const int tid = tid_l, wid = __builtin_amdgcn_readfirstlane(tid >> 6), lane = tid & 63, wr = wid >> 2, wc = wid & 3, fr = lane & 15, fq = lane >> 4;
    const int K = g.K, nt = K / BK;
    unsigned voffA[2], voffB[2];
#pragma unroll
    for (int i = 0; i < 2; ++i) { int R, C; stage_rc(tid * 16 + i * 8192, R, C); const int Rb = Epi::PERM ? ((R & ~31) + perm32(R & 31)) : R;
        voffA[i] = (unsigned)(R * K + C) * 2u; voffB[i] = (unsigned)(Rb * K + C) * 2u; }
    const size_t kstep = (size_t)(BK * 2);
    const size_t hstep = (size_t)HALF * K * 2;
    const size_t tstep = 2 * hstep;
    const unsigned ldsw = (unsigned)wid * 1024u;
    const int aoff = lds_byte(wr * 64 + fr, fq * 8), boff = lds_byte(wc * 32 + fr, fq * 8);
#define PG8_SA(b, h) (((b) * 2 + (h)) * HTB)
#define PG8_SB(b, h) ((4 + (b) * 2 + (h)) * HTB)
#define PG8_STAGE(bufoff, gbase, voff) do { _Pragma("unroll") for (int _i = 0; _i < 2; ++_i) \
        __builtin_amdgcn_global_load_lds((const unsigned*)((const char*)(gbase) + (voff)[_i]), (PG8_LAS unsigned*)(lds + (bufoff) + ldsw + _i * 8192), 16, 0, 0); } while (0)
#define PG8_LDA(dst, b, h) do { _Pragma("unroll") for (int m = 0; m < 4; ++m) _Pragma("unroll") for (int k = 0; k < 2; ++k) dst[m][k] = *(const PG8_LAS bf16x8*)(lds + PG8_SA(b, h) + aoff + m * 2048 + k * 1024); } while (0)
#define PG8_LDB(dst, b, h) do { _Pragma("unroll") for (int n = 0; n < 2; ++n) _Pragma("unroll") for (int k = 0; k < 2; ++k) dst[n][k] = *(const PG8_LAS bf16x8*)(lds + PG8_SB(b, h) + boff + n * 2048 + k * 1024); } while (0)
#define PG8_MMA(ai, bj, At, Bt) do { __builtin_amdgcn_s_setprio(1); _Pragma("unroll") for (int m = 0; m < 4; ++m) _Pragma("unroll") for (int n = 0; n < 2; ++n) _Pragma("unroll") for (int k = 0; k < 2; ++k) \
        acc[ai][bj][m][n] = __builtin_amdgcn_mfma_f32_16x16x32_bf16(Bt[n][k], At[m][k], acc[ai][bj][m][n], 0, 0, 0); __builtin_amdgcn_s_setprio(0); } while (0)
#define PG8_WAIT_V(n) asm volatile("s_waitcnt vmcnt(" #n ")" ::: "memory")
#define PG8_WAIT_L(n) asm volatile("s_waitcnt lgkmcnt(" #n ")" ::: "memory")
#define PG8_BAR __builtin_amdgcn_s_barrier()
#define PG8_SCHED __builtin_amdgcn_sched_barrier(0)
    Unit cur, nxt; int ui = 0;
    if (!S.next(0, cur)) return;
    f32x4 acc[2][2][4][2];
#pragma unroll
    for (int a = 0; a < 2; ++a)
#pragma unroll
        for (int b = 0; b < 2; ++b)
#pragma unroll
            for (int m = 0; m < 4; ++m)
#pragma unroll
                for (int n = 0; n < 2; ++n) acc[a][b][m][n] = (f32x4){0.f, 0.f, 0.f, 0.f};
    bf16x8 At[4][2], B0[2][2], B1[2][2];
    const char* cA = (const char*)g.A + (size_t)cur.pm * tstep; const char* cB = (const char*)g.Bt + (size_t)cur.pn * tstep;
    S.a_ready(cur);
    if constexpr (SP2) {
        PG8_STAGE(PG8_SB(0, 0), cB, voffB); PG8_STAGE(PG8_SB(0, 1), cB + hstep, voffB); PG8_STAGE(PG8_SA(0, 0), cA, voffA); PG8_STAGE(PG8_SA(0, 1), cA + hstep, voffA);
        if (wr == 1) PG8_BAR;
        PG8_WAIT_V(2); PG8_BAR;
        PG8_STAGE(PG8_SB(1, 0), cB + kstep, voffB); PG8_STAGE(PG8_SA(1, 0), cA + kstep, voffA); PG8_STAGE(PG8_SB(1, 1), cB + hstep + kstep, voffB);
        PG8_WAIT_V(6); PG8_BAR;
    } else {
        PG8_STAGE(PG8_SB(0, 0), cB, voffB); PG8_STAGE(PG8_SA(0, 0), cA, voffA); PG8_STAGE(PG8_SB(0, 1), cB + hstep, voffB); PG8_STAGE(PG8_SA(0, 1), cA + hstep, voffA);
        if (wr == 1) PG8_BAR;
        PG8_WAIT_V(4); PG8_BAR;
        PG8_STAGE(PG8_SB(1, 0), cB + kstep, voffB); PG8_STAGE(PG8_SA(1, 0), cA + kstep, voffA); PG8_STAGE(PG8_SB(1, 1), cB + hstep + kstep, voffB);
        PG8_WAIT_V(6); PG8_BAR;
    }
    for (;;) {
        const bool has_next = S.next(ui + 1, nxt);
        const char* nA = has_next ? (const char*)g.A + (size_t)nxt.pm * tstep : cA; const char* nB = has_next ? (const char*)g.Bt + (size_t)nxt.pn * tstep : cB;
        for (int t = 0; t < nt; t += 2) {
            const bool last = (t == nt - 2);
            const char* a1 = cA + (size_t)(t + 1) * kstep;
            const char* a2 = last ? nA : cA + (size_t)(t + 2) * kstep; const char* b2 = last ? nB : cB + (size_t)(t + 2) * kstep;
            const char* a3 = a2 + kstep; const char* b3 = b2 + kstep;
            if (last && has_next) S.a_ready(nxt);
            if constexpr (SP2) {
            PG8_LDB(B0, 0, 0); PG8_LDB(B1, 0, 1); PG8_SCHED; PG8_LDA(At, 0, 0); PG8_STAGE(PG8_SA(1, 1), a1 + hstep, voffA);
            PG8_WAIT_V(8); PG8_WAIT_L(0); PG8_BAR; PG8_MMA(0, 0, At, B0); PG8_MMA(0, 1, At, B1); PG8_BAR; PG8_SCHED;
            PG8_LDA(At, 0, 1); PG8_STAGE(PG8_SB(0, 0), b2, voffB); PG8_STAGE(PG8_SB(0, 1), b2 + hstep, voffB); PG8_STAGE(PG8_SA(0, 0), a2, voffA);
            PG8_WAIT_V(8); PG8_WAIT_L(0); PG8_BAR; PG8_MMA(1, 0, At, B0); PG8_MMA(1, 1, At, B1); PG8_BAR; PG8_SCHED;
            PG8_LDB(B0, 1, 0); PG8_LDB(B1, 1, 1); PG8_SCHED; PG8_LDA(At, 1, 0); PG8_STAGE(PG8_SA(0, 1), a2 + hstep, voffA);
            PG8_WAIT_V(8); PG8_WAIT_L(0); PG8_BAR; PG8_MMA(0, 0, At, B0); PG8_MMA(0, 1, At, B1); PG8_BAR; PG8_SCHED;
            PG8_LDA(At, 1, 1); PG8_STAGE(PG8_SB(1, 0), b3, voffB); PG8_STAGE(PG8_SB(1, 1), b3 + hstep, voffB); PG8_STAGE(PG8_SA(1, 0), a3, voffA);
            PG8_WAIT_V(8); PG8_WAIT_L(0); PG8_BAR; PG8_MMA(1, 0, At, B0); PG8_MMA(1, 1, At, B1); PG8_BAR; PG8_SCHED;
            } else {
            PG8_LDB(B0, 0, 0); PG8_SCHED; PG8_LDA(At, 0, 0); PG8_STAGE(PG8_SA(1, 1), a1 + hstep, voffA);
            PG8_WAIT_L(8); PG8_BAR; PG8_WAIT_L(0); PG8_MMA(0, 0, At, B0); PG8_BAR; PG8_SCHED;
            PG8_LDB(B1, 0, 1); PG8_STAGE(PG8_SB(0, 0), b2, voffB);
            PG8_BAR; PG8_WAIT_L(0); PG8_MMA(0, 1, At, B1); PG8_BAR;
            PG8_LDA(At, 0, 1); PG8_STAGE(PG8_SA(0, 0), a2, voffA);
            PG8_BAR; PG8_WAIT_L(0); PG8_MMA(1, 0, At, B0); PG8_BAR; PG8_SCHED;
            PG8_STAGE(PG8_SB(0, 1), b2 + hstep, voffB);
            PG8_WAIT_V(6); PG8_BAR; PG8_MMA(1, 1, At, B1); PG8_BAR;
            PG8_LDB(B0, 1, 0); PG8_SCHED; PG8_LDA(At, 1, 0); PG8_STAGE(PG8_SA(0, 1), a2 + hstep, voffA);
            PG8_WAIT_L(8); PG8_BAR; PG8_WAIT_L(0); PG8_MMA(0, 0, At, B0); PG8_BAR; PG8_SCHED;
            PG8_LDB(B1, 1, 1); PG8_STAGE(PG8_SB(1, 0), b3, voffB);
            PG8_BAR; PG8_WAIT_L(0); PG8_MMA(0, 1, At, B1); PG8_BAR;
            PG8_LDA(At, 1, 1); PG8_STAGE(PG8_SA(1, 0), a3, voffA);
            PG8_BAR; PG8_WAIT_L(0); PG8_MMA(1, 0, At, B0); PG8_BAR; PG8_SCHED;
            PG8_STAGE(PG8_SB(1, 1), b3 + hstep, voffB);
            PG8_WAIT_V(6); PG8_BAR; PG8_MMA(1, 1, At, B1); PG8_BAR;
            }
        }
        if constexpr (ALIGN_EPI) { if (wr == 0) PG8_BAR; }
        if constexpr (!Epi::AFTER_DRAIN) { E(acc, cur, wr, wc, fr, fq); S.done(cur); }
        if (!has_next) break;
#pragma unroll
        for (int a = 0; a < 2; ++a)
#pragma unroll
            for (int b = 0; b < 2; ++b)
#pragma unroll
                for (int m = 0; m < 4; ++m)
#pragma unroll
                    for (int n = 0; n < 2; ++n) acc[a][b][m][n] = (f32x4){0.f, 0.f, 0.f, 0.f};
        cur = nxt; cA = nA; cB = nB; ++ui;
        if constexpr (ALIGN_EPI) { if (wr == 1) PG8_BAR; }
    }
    PG8_WAIT_V(0);
    if constexpr (!ALIGN_EPI) { if (wr == 0) PG8_BAR; }
    PG8_BAR;
    if constexpr (Epi::AFTER_DRAIN) { E.fused(acc, cur, wr, wc, fr, fq, lds, wid, lane); S.done(cur); }
#undef PG8_SA
#undef PG8_SB
#undef PG8_STAGE
#undef PG8_LDA
#undef PG8_LDB
#undef PG8_MMA
#undef PG8_WAIT_V
#undef PG8_WAIT_L
#undef PG8_BAR
#undef PG8_SCHED
}
}

#ifndef PG8_SP2
#define PG8_SP2 true
#endif
#ifndef PG8_ALIGN
#define PG8_ALIGN true
#endif
constexpr int NWAVES = 8, NTHR = 512;
constexpr int BATCH = 2, SEQ = 8192, DM = 4096, MTOK = BATCH * SEQ;
constexpr int HD = 128;
constexpr int A_HEADS = 16, B_HEADS = 16, A_W = 2048, B_W = 2048, AB_IN = 4 * A_W + 3 * B_W;
constexpr int NSA_H = 32, NSA_G = 4, NSA_R = 8, KVW = 512, NSA_IN = 4096 + 6 * KVW + 96, NSA_INP = 7424;
constexpr int NCMP = 511, NCMPP = 512, NSLC = 128, NTOP = 16, WINDOW = 512;
constexpr int NMEM = 256, XH = 4, XW = 512;
constexpr int DFF = 11008, DFF2 = 22016;
constexpr float LN_EPS = 1e-5f, RMS_EPS = 1e-6f;
constexpr float DN_ALPHA = 1.41421356237309515f;
constexpr size_t MiB = (size_t)1 << 20;
constexpr size_t WS_CTL = 0, CTL_ZERO_BYTES = 1 * MiB;
constexpr size_t WS_W_ABIN = 1 * MiB;
constexpr size_t WS_W_ABOUT = WS_W_ABIN + 112 * MiB;
constexpr size_t WS_W_NSAIN = WS_W_ABOUT + 32 * MiB;
constexpr size_t WS_W_NSAOUT = WS_W_NSAIN + 58 * MiB;
constexpr size_t WS_W_XQ = WS_W_NSAOUT + 32 * MiB;
constexpr size_t WS_W_XKV = WS_W_XQ + 8 * MiB;
constexpr size_t WS_W_XO = WS_W_XKV + 16 * MiB;
constexpr size_t WS_W_UP = WS_W_XO + 8 * MiB;
constexpr size_t WS_W_DOWN = WS_W_UP + 344 * MiB;
constexpr size_t WS_W_C1 = WS_W_DOWN + 172 * MiB;
constexpr size_t WS_W_C2 = WS_W_C1 + 2 * MiB;
constexpr size_t WS_MEMB = WS_W_C2 + 1 * MiB;
constexpr size_t WS_HB = WS_MEMB + 4 * MiB;
constexpr size_t WS_Y = WS_HB + 128 * MiB;
constexpr size_t WS_BIG = WS_Y + 256 * MiB;
constexpr size_t WS_G = WS_BIG + 688 * MiB;
constexpr size_t WS_O = WS_G + 344 * MiB;
constexpr size_t WS_MISC = WS_O + 128 * MiB;
constexpr size_t WS_END = WS_MISC + 64 * MiB;
constexpr size_t WS_XQ = WS_MISC;
constexpr size_t WS_XO = WS_MISC + 16 * MiB;
constexpr size_t WS_XKV = WS_MISC + 32 * MiB;
constexpr size_t WS_LB = WS_MISC + 34 * MiB;
constexpr size_t WS_PROJ0 = WS_BIG;
constexpr size_t WS_SPREV = WS_BIG + 448 * MiB;
constexpr size_t WS_QT = WS_G;
constexpr size_t WS_OINTRA = WS_G + 64 * MiB;
constexpr size_t WS_DEC = WS_G + 192 * MiB;
constexpr size_t WS_DS = WS_Y;
constexpr size_t WS_PROJ1 = WS_BIG;
constexpr size_t WS_QROT = WS_BIG + 232 * MiB;
constexpr size_t WS_KSROT = WS_BIG + 360 * MiB;
constexpr size_t WS_KWROT = WS_BIG + 376 * MiB;
constexpr size_t WS_KCMP = WS_BIG + 392 * MiB;
constexpr size_t WS_VCMP = WS_BIG + 393 * MiB;
constexpr size_t WS_OVL = WS_BIG + 394 * MiB;
constexpr size_t WS_SEL = WS_BIG + 395 * MiB;
constexpr size_t WS_IMP = WS_Y;
constexpr size_t WS_O32 = WS_G;
static_assert(WS_SPREV + 128 * MiB <= WS_G && WS_DEC + 2 * MiB <= WS_O && WS_SEL + MiB <= WS_G, "ws map");
constexpr int CW_TMO = 0, CW_CODE = 1;
constexpr int CW_BAR = 4096;
constexpr int RING_OFF = 0, RING_BYTES = 131072;
constexpr int LDSCTL_OFF = RING_BYTES, MISC_OFF = LDSCTL_OFF + 320;
constexpr int LDS_BYTES = 147456;
static_assert(MISC_OFF + 128 <= LDS_BYTES, "LDS map");

#define GAS __attribute__((address_space(1)))
#define LAS __attribute__((address_space(3)))
typedef unsigned short bf16;
typedef unsigned v4u __attribute__((ext_vector_type(4)));
typedef unsigned v2u __attribute__((ext_vector_type(2)));
typedef float f32x4 __attribute__((ext_vector_type(4)));
typedef float f32x2 __attribute__((ext_vector_type(2)));
typedef float f32x16 __attribute__((ext_vector_type(16)));
typedef short bf16x8 __attribute__((ext_vector_type(8)));
typedef short s16x4 __attribute__((ext_vector_type(4)));
typedef GAS unsigned gu32;
#define RLX_AGENT __ATOMIC_RELAXED, __HIP_MEMORY_SCOPE_AGENT
#define LDS_WAIT() asm volatile("s_waitcnt lgkmcnt(0)" ::: "memory")
#define VM_WAIT() asm volatile("s_waitcnt vmcnt(0)" ::: "memory")
#define SBAR() __builtin_amdgcn_sched_barrier(0)
__device__ __forceinline__ unsigned f2bf(float f) { unsigned u = __builtin_bit_cast(unsigned, f); return (u + 0x7fffu + ((u >> 16) & 1u)) >> 16; }
__device__ __forceinline__ unsigned pk2(float lo, float hi) { return f2bf(lo) | (f2bf(hi) << 16); }
__device__ __forceinline__ float bf2f(unsigned short b) { return __builtin_bit_cast(float, (unsigned)b << 16); }
__device__ __forceinline__ float bflo(unsigned w) { return __builtin_bit_cast(float, w << 16); }
__device__ __forceinline__ float bfhi(unsigned w) { return __builtin_bit_cast(float, w & 0xffff0000u); }
__device__ __forceinline__ unsigned cvtpk(float lo, float hi) { unsigned r; asm volatile("v_cvt_pk_bf16_f32 %0, %1, %2" : "=v"(r) : "v"(lo), "v"(hi)); return r; }
__device__ __forceinline__ float wave_sum(float v) {
#pragma unroll
    for (int o = 1; o < 64; o <<= 1) v += __shfl_xor(v, o);
    return v;
}
__device__ __forceinline__ float sigmoidf_(float x) { return __builtin_amdgcn_rcpf(1.f + __builtin_amdgcn_exp2f(-1.4426950408889634f * x)); }
__device__ __forceinline__ float gelu1(float v) { pg8::f32x2 r = pg8::gelu_pk((pg8::f32x2){v, 0.f}); return r.x; }
#define XB_TMO      128
#define XB_XCNT(j)  (256  + 64 * (j))
#define XB_XSUB(j)  (1280 + 64 * (j))
#define XB_XGEN(j)  (2304 + 64 * (j))
#define XB_TOP      3328
#define XB_TOPGEN   3392
#define XCD_BAR_WORDS 3456
#define XB_SPIN_CAP (1u << 18)
#define LAS __attribute__((address_space(3)))

__device__ __forceinline__ unsigned xb_ld(unsigned* p)              { return __hip_atomic_load(p, __ATOMIC_RELAXED, __HIP_MEMORY_SCOPE_AGENT); }
__device__ __forceinline__ unsigned xb_add(unsigned* p, unsigned v) { return __hip_atomic_fetch_add(p, v, __ATOMIC_RELAXED, __HIP_MEMORY_SCOPE_AGENT); }
__device__ __forceinline__ unsigned xb_xcc_id() { return (unsigned)__builtin_amdgcn_s_getreg((3 << 11) | 20) & 0xFu; }
#define XB_SPIN(cond, bar) do { unsigned _sp = 0; while (cond) { __builtin_amdgcn_s_sleep(1); \
    if ((++_sp & 255u) == 0u) { if (xb_ld(&(bar)[XB_TMO])) break; if (_sp > XB_SPIN_CAP) { atomicAdd(&(bar)[XB_TMO], 1u); break; } } } } while (0)

struct XcdBarrier {
    unsigned* bar; unsigned x;
    volatile LAS unsigned* st;
};

__device__ __forceinline__ XcdBarrier xcd_barrier_post(unsigned* bar, volatile LAS unsigned* st) {
    XcdBarrier b; b.bar = bar; b.x = xb_xcc_id(); b.st = st;
    if (threadIdx.x == 0) (void)xb_add(&bar[XB_XCNT(b.x)], 1u);
    return b;
}
__device__ __forceinline__ void xcd_barrier_complete(unsigned* bar, unsigned x, unsigned& nloc, unsigned& nx) {
    const unsigned G = gridDim.x * gridDim.y * gridDim.z;
    unsigned sum, cnt, mine, sp = 0u;
    for (;;) {
        sum = 0u; cnt = 0u; mine = 0u;
#pragma unroll
        for (unsigned j = 0; j < 16; ++j) { const unsigned c = xb_ld(&bar[XB_XCNT(j)]); sum += c; cnt += (c > 0u) ? 1u : 0u; mine = (j == x) ? c : mine; }
        if (sum == G) break;
        __builtin_amdgcn_s_sleep(1);
        if ((++sp & 255u) == 0u) { if (xb_ld(&bar[XB_TMO])) break; if (sp > XB_SPIN_CAP) { atomicAdd(&bar[XB_TMO], 1u); break; } }
    }
    nloc = mine > 0u ? mine : 1u; nx = cnt > 0u ? cnt : 1u;
}

__device__ __forceinline__ void xcd_barrier(const XcdBarrier& b) {
    asm volatile("s_waitcnt vmcnt(0)" ::: "memory");
    __syncthreads();
    if (threadIdx.x == 0) {
        unsigned* bar = b.bar;
        __builtin_amdgcn_s_waitcnt(0);
        unsigned nloc = b.st[0], nx = b.st[1];
        if (nloc == 0u) { xcd_barrier_complete(bar, b.x, nloc, nx); b.st[0] = nloc; b.st[1] = nx; }
        const unsigned old = xb_add(&bar[XB_XSUB(b.x)], 1u);
        const unsigned gen = old / nloc;
        if (old + 1u == (gen + 1u) * nloc) {
            __builtin_amdgcn_fence(__ATOMIC_RELEASE, "agent");
            asm volatile("s_waitcnt vmcnt(0)" ::: "memory");
            const unsigned og = xb_add(&bar[XB_TOP], 1u);
            const unsigned tg = og / nx;
            if (og + 1u == (tg + 1u) * nx) xb_add(&bar[XB_TOPGEN], 1u);
            else XB_SPIN(xb_ld(&bar[XB_TOPGEN]) == tg, bar);
            __builtin_amdgcn_fence(__ATOMIC_ACQUIRE, "agent");
            xb_add(&bar[XB_XGEN(b.x)], 1u);
            asm volatile("s_waitcnt vmcnt(0)" ::: "memory");
        } else {
            XB_SPIN(xb_ld(&bar[XB_XGEN(b.x)]) == gen, bar);
            __builtin_amdgcn_fence(__ATOMIC_ACQUIRE, "agent");
            asm volatile("s_waitcnt vmcnt(0)" ::: "memory");
        }
    }
    __syncthreads();
}


constexpr int ATT_D = 128, KVBLK = 64;
constexpr int SHM_V = KVBLK * ATT_D * 2, SHM_K = KVBLK * ATT_D * 2;
constexpr int ATT_K_OFF = 0, ATT_V_OFF = SHM_K, ATT_WS_OFF = SHM_K + SHM_V;
constexpr int ATT_X_OFF = ATT_WS_OFF + NWAVES * 256;
#define KSWZ(row, colB) ((row) * 256 + ((colB) ^ (((row) & 7) << 4)))
__device__ __forceinline__ int crow(int r, int hi) { return (r & 3) + 8 * (r >> 2) + 4 * hi; }
__device__ __forceinline__ int v_st(int k, int c) { const int kk = (k & ~0xC) | ((k & 4) << 1) | ((k & 8) >> 1); return ((kk >> 3) * 4 + (c >> 5)) * 512 + ((kk & 7) * 32 + (c & 31)) * 2; }
__device__ __forceinline__ int v_rd_base(int lane) { return ((lane & 3) << 3) | (((lane >> 2) & 3) << 6) | (((lane >> 4) & 1) << 5) | (((lane >> 5) & 1) << 8); }
constexpr int v_rd_off(int d0, int ks, int half) { return d0 * 512 + ks * 4096 + half * 2048; }
template <int OFF> __device__ __forceinline__ s16x4 tr_read(int vb) {
  s16x4 r; asm volatile("ds_read_b64_tr_b16 %0, %1 offset:%2" : "=&v"(r) : "v"(vb), "i"(OFF) : "memory"); return r;
}
__device__ __forceinline__ void qkt(f32x16& p0, f32x16& p1, const LAS char* Ks, const bf16x8* qr, int r32, int hi) {
  p0 = f32x16{}; p1 = f32x16{};
#pragma unroll
  for (int d0 = 0; d0 < 8; ++d0) { const int cb = (d0 * 16 + hi * 8) * 2;
    const bf16x8 b0 = *(const LAS bf16x8*)(Ks + KSWZ(r32, cb));
    const bf16x8 b1 = *(const LAS bf16x8*)(Ks + KSWZ(32 + r32, cb));
    p0 = __builtin_amdgcn_mfma_f32_32x32x16_bf16(b0, qr[d0], p0, 0, 0, 0);
    p1 = __builtin_amdgcn_mfma_f32_32x32x16_bf16(b1, qr[d0], p1, 0, 0, 0); }
}
__device__ __forceinline__ void pack_p(const f32x16& p0, const f32x16& p1, bf16x8& pa0, bf16x8& pa1, bf16x8& pa2, bf16x8& pa3) {
#define PK4(P, BASE, OUT) do { unsigned a0 = cvtpk(P[BASE + 0], P[BASE + 1]), a1 = cvtpk(P[BASE + 2], P[BASE + 3]);   \
    unsigned b0 = cvtpk(P[BASE + 4], P[BASE + 5]), b1 = cvtpk(P[BASE + 6], P[BASE + 7]);                              \
    auto r0 = __builtin_amdgcn_permlane32_swap(a0, b0, false, false); auto r1 = __builtin_amdgcn_permlane32_swap(a1, b1, false, false); \
    v4u w = {r0[0], r1[0], r0[1], r1[1]}; OUT = __builtin_bit_cast(bf16x8, w); } while (0)
  PK4(p0, 0, pa0); PK4(p0, 8, pa1); PK4(p1, 0, pa2); PK4(p1, 8, pa3);
#undef PK4
}
template <int D0> __device__ __forceinline__ void pv_one(f32x16& od, int vb, bf16x8 pa0, bf16x8 pa1, bf16x8 pa2, bf16x8 pa3) {
  const s16x4 l0 = tr_read<v_rd_off(D0, 0, 0)>(vb), h0 = tr_read<v_rd_off(D0, 0, 1)>(vb), l1 = tr_read<v_rd_off(D0, 1, 0)>(vb), h1 = tr_read<v_rd_off(D0, 1, 1)>(vb);
  const s16x4 l2 = tr_read<v_rd_off(D0, 2, 0)>(vb), h2 = tr_read<v_rd_off(D0, 2, 1)>(vb), l3 = tr_read<v_rd_off(D0, 3, 0)>(vb), h3 = tr_read<v_rd_off(D0, 3, 1)>(vb);
  asm volatile("s_waitcnt lgkmcnt(0)" ::: "memory"); SBAR();
#define PKV(L, H) (bf16x8){L[0], L[1], L[2], L[3], H[0], H[1], H[2], H[3]}
  od = __builtin_amdgcn_mfma_f32_32x32x16_bf16(pa0, PKV(l0, h0), od, 0, 0, 0);
  od = __builtin_amdgcn_mfma_f32_32x32x16_bf16(pa1, PKV(l1, h1), od, 0, 0, 0);
  od = __builtin_amdgcn_mfma_f32_32x32x16_bf16(pa2, PKV(l2, h2), od, 0, 0, 0);
  od = __builtin_amdgcn_mfma_f32_32x32x16_bf16(pa3, PKV(l3, h3), od, 0, 0, 0);
#undef PKV
}
__device__ __forceinline__ void pv_d0(f32x16* o, int vb, bf16x8 pa0, bf16x8 pa1, bf16x8 pa2, bf16x8 pa3) {
  pv_one<0>(o[0], vb, pa0, pa1, pa2, pa3); pv_one<1>(o[1], vb, pa0, pa1, pa2, pa3); pv_one<2>(o[2], vb, pa0, pa1, pa2, pa3); pv_one<3>(o[3], vb, pa0, pa1, pa2, pa3);
}
struct KVStage { bf16x8 ks0, ks1, vs0, vs1; };
__device__ __forceinline__ void kv_load(KVStage& s, const bf16* Kh, const bf16* Vh, long ldk, long ldv, int k0, int sr, int sc) {
  s.ks0 = *(const bf16x8*)(Kh + (long)(k0 + sr) * ldk + sc); s.ks1 = *(const bf16x8*)(Kh + (long)(k0 + 32 + sr) * ldk + sc);
  s.vs0 = *(const bf16x8*)(Vh + (long)(k0 + sr) * ldv + sc); s.vs1 = *(const bf16x8*)(Vh + (long)(k0 + 32 + sr) * ldv + sc);
}
__device__ __forceinline__ void kv_write(const KVStage& s, LAS char* lds, int sr, int sc) {
  *(LAS bf16x8*)(lds + ATT_V_OFF + v_st(sr, sc)) = s.vs0; *(LAS bf16x8*)(lds + ATT_V_OFF + v_st(32 + sr, sc)) = s.vs1;
  *(LAS bf16x8*)(lds + ATT_K_OFF + KSWZ(sr, sc * 2)) = s.ks0; *(LAS bf16x8*)(lds + ATT_K_OFF + KSWZ(32 + sr, sc * 2)) = s.ks1;
}
__device__ __forceinline__ void rescale_o(f32x16* o, float a, LAS float* al_l, int r32, int hi) {
  if (__any(a < 1.f)) { if (hi == 0) al_l[r32] = a; LDS_WAIT();
#pragma unroll
    for (int r = 0; r < 16; ++r) { const float f = al_l[crow(r, hi)];
#pragma unroll
      for (int d = 0; d < 4; ++d) o[d][r] *= f; }
    LDS_WAIT(); }
}
constexpr float ATT_SCALE = 0.088388347648318440f, ATT_C = ATT_SCALE * 1.4426950408889634f, ATT_THR = 8.f;
template <bool MASKED>
__device__ __forceinline__ void softmax_tile(f32x16& p0, f32x16& p1, unsigned vm0, unsigned vm1, float& m_reg, float& l_reg, float& alpha) {
  if (MASKED) {
#pragma unroll
    for (int r = 0; r < 16; ++r) { p0[r] = ((vm0 >> r) & 1u) ? p0[r] : -1e30f; p1[r] = ((vm1 >> r) & 1u) ? p1[r] : -1e30f; }
  }
  float pmax = p0[0];
#pragma unroll
  for (int r = 1; r < 16; ++r) pmax = fmaxf(pmax, p0[r]);
#pragma unroll
  for (int r = 0; r < 16; ++r) pmax = fmaxf(pmax, p1[r]);
  { auto rr = __builtin_amdgcn_permlane32_swap(__float_as_uint(pmax), __float_as_uint(pmax), false, false);
    pmax = fmaxf(__uint_as_float(rr[0]), __uint_as_float(rr[1])); }
  float mn;
  if (__all(pmax - m_reg <= ATT_THR / ATT_SCALE)) { mn = m_reg; alpha = 1.f; }
  else { mn = fmaxf(m_reg, pmax); alpha = __builtin_amdgcn_exp2f((m_reg - mn) * ATT_C); m_reg = mn; }
  const float mnC = -mn * ATT_C;
#pragma unroll
  for (int r = 0; r < 16; ++r) { p0[r] = __builtin_amdgcn_exp2f(fmaf(p0[r], ATT_C, mnC)); p1[r] = __builtin_amdgcn_exp2f(fmaf(p1[r], ATT_C, mnC)); }
  if (MASKED) {
#pragma unroll
    for (int r = 0; r < 16; ++r) { p0[r] = ((vm0 >> r) & 1u) ? p0[r] : 0.f; p1[r] = ((vm1 >> r) & 1u) ? p1[r] : 0.f; }
  }
  float ps = 0.f;
#pragma unroll
  for (int r = 0; r < 16; ++r) ps += p0[r] + p1[r];
  { auto rr = __builtin_amdgcn_permlane32_swap(__float_as_uint(ps), __float_as_uint(ps), false, false);
    ps = __uint_as_float(rr[0]) + __uint_as_float(rr[1]); }
  l_reg = l_reg * alpha + ps;
}
__device__ __forceinline__ void load_q(bf16x8* qr, const bf16* Qw) {
#pragma unroll
  for (int d0 = 0; d0 < 8; ++d0) qr[d0] = *(const bf16x8*)(Qw + d0 * 16);
}

struct Frame {
    LAS unsigned char* lds;
    unsigned char* ws;
    int tid, lane, wave, G, bid;
    __device__ __forceinline__ void fresh() { int t = threadIdx.x; asm volatile("" : "+v"(t)); tid = t; lane = t & 63; wave = __builtin_amdgcn_readfirstlane(t >> 6);
        int g_ = gridDim.x, b_ = blockIdx.x; asm volatile("" : "+s"(g_), "+s"(b_)); G = g_; bid = b_; }
};
struct Args { const float* in[19]; float* out; unsigned char* ws; int ph_lo, ph_hi; };
enum { IN_X = 0, IN_MEM, IN_AB_W_IN, IN_HGRN_LB, IN_HGRN_NW, IN_AB_W_OUT, IN_NSA_W_IN, IN_NSA_CMP_POS, IN_NSA_CMP_W1, IN_NSA_CMP_W2, IN_NSA_W_OUT,
       IN_XA_WQ, IN_XA_WKV, IN_XA_WO, IN_FFN_UP, IN_FFN_CONV, IN_FFN_DOWN, IN_LN_G, IN_LN_B };

__device__ __forceinline__ void p0_transpose_item(const float* W, int K, int N, bf16* WT, LAS float* scr, int item, int lane) {
    const int nblk = N / 32, kb = item / nblk, nb = item % nblk, k0 = 64 * kb, n0 = 32 * nb;
#pragma unroll 8
    for (int i = 0; i < 32; ++i) { const int kk = 2 * i + (lane >> 5); scr[kk * 33 + (lane & 31)] = W[(size_t)(k0 + kk) * N + n0 + (lane & 31)]; }
    LDS_WAIT(); asm volatile("" ::: "memory");
    const int c = lane & 7;
#pragma unroll
    for (int j = 0; j < 4; ++j) { const int n = (lane >> 3) + 8 * j; const LAS float* s = scr + (8 * c) * 33 + n;
        v4u o; o.x = pk2(s[0 * 33], s[1 * 33]); o.y = pk2(s[2 * 33], s[3 * 33]); o.z = pk2(s[4 * 33], s[5 * 33]); o.w = pk2(s[6 * 33], s[7 * 33]);
        *(GAS v4u*)(WT + (size_t)(n0 + n) * K + k0 + 8 * c) = o; }
    LDS_WAIT(); asm volatile("" ::: "memory");
}
__device__ __forceinline__ void transpose_mat(Frame& F, const float* W, int K, int N, bf16* WT) {
    LAS float* scr = (LAS float*)(F.lds + RING_OFF + F.wave * 16384);
    const int gw = F.bid * NWAVES + F.wave, NGW = F.G * NWAVES;
    const int nitems = (K / 64) * (N / 32);
    for (int it = gw; it < nitems; it += NGW) p0_transpose_item(W, K, N, WT, scr, it, F.lane);
}
__device__ __forceinline__ void cvt_flat(Frame& F, const float* src, bf16* dst, long n8) {
    for (long i = (long)F.bid * NTHR + F.tid; i < n8; i += (long)F.G * NTHR) {
        const f32x4 a = *(const f32x4*)(src + i * 8), b = *(const f32x4*)(src + i * 8 + 4);
        v4u o; o.x = pk2(a.x, a.y); o.y = pk2(a.z, a.w); o.z = pk2(b.x, b.y); o.w = pk2(b.z, b.w);
        *(v4u*)(dst + i * 8) = o; }
}
__device__ __forceinline__ void p0_prologue(Frame& F, const Args& A) {
    unsigned char* ws = F.ws;
    transpose_mat(F, A.in[IN_AB_W_IN], DM, AB_IN, (bf16*)(ws + WS_W_ABIN));
    transpose_mat(F, A.in[IN_AB_W_OUT], DM, DM, (bf16*)(ws + WS_W_ABOUT));
    transpose_mat(F, A.in[IN_NSA_W_IN], DM, NSA_IN, (bf16*)(ws + WS_W_NSAIN));
    transpose_mat(F, A.in[IN_NSA_W_OUT], DM, DM, (bf16*)(ws + WS_W_NSAOUT));
    for (int l = 0; l < 2; ++l) {
        transpose_mat(F, A.in[IN_XA_WQ] + (size_t)l * DM * XW, DM, XW, (bf16*)(ws + WS_W_XQ) + (size_t)l * XW * DM);
        transpose_mat(F, A.in[IN_XA_WKV] + (size_t)l * DM * 2 * XW, DM, 2 * XW, (bf16*)(ws + WS_W_XKV) + (size_t)l * 2 * XW * DM);
        transpose_mat(F, A.in[IN_XA_WO] + (size_t)l * XW * DM, XW, DM, (bf16*)(ws + WS_W_XO) + (size_t)l * DM * XW);
        transpose_mat(F, A.in[IN_FFN_UP] + (size_t)l * DM * DFF2, DM, DFF2, (bf16*)(ws + WS_W_UP) + (size_t)l * DFF2 * DM);
        transpose_mat(F, A.in[IN_FFN_DOWN] + (size_t)l * DFF * DM, DFF, DM, (bf16*)(ws + WS_W_DOWN) + (size_t)l * DM * DFF);
        transpose_mat(F, A.in[IN_NSA_CMP_W1] + (size_t)l * 32 * HD * HD, 32 * HD, HD, (bf16*)(ws + WS_W_C1) + (size_t)l * HD * 32 * HD);
        transpose_mat(F, A.in[IN_NSA_CMP_W2] + (size_t)l * HD * HD, HD, HD, (bf16*)(ws + WS_W_C2) + (size_t)l * HD * HD);
    }
    cvt_flat(F, A.in[IN_X], (bf16*)(ws + WS_HB), (long)MTOK * DM / 8);
    cvt_flat(F, A.in[IN_MEM], (bf16*)(ws + WS_MEMB), (long)BATCH * NMEM * DM / 8);
    { v4u z = {0u, 0u, 0u, 0u}; v4u* p = (v4u*)((bf16*)(ws + WS_W_NSAIN) + (size_t)NSA_IN * DM); const long n = (long)(NSA_INP - NSA_IN) * DM / 8;
      for (long i = (long)F.bid * NTHR + F.tid; i < n; i += (long)F.G * NTHR) p[i] = z; }
    { const float* lbp = A.in[IN_HGRN_LB]; float* lbo = (float*)(ws + WS_LB);
      for (int i = F.bid * NTHR + F.tid; i < A_W; i += F.G * NTHR) { const float a = lbp[i], b = lbp[A_W + i], m = fmaxf(a, b), ea = __expf(a - m), eb = __expf(b - m); lbo[i] = ea / (ea + eb); } }
}

__device__ __forceinline__ void ln_phase(Frame& F, const float* Y, const float* g, const float* b, float* h32, bf16* hb) {
    const int gw = F.bid * NWAVES + F.wave, NGW = F.G * NWAVES;
    for (int m = gw; m < MTOK; m += NGW) {
        const f32x4* yr = (const f32x4*)(Y + (size_t)m * DM) + F.lane;
        f32x4 v[16]; float s = 0.f;
#pragma unroll
        for (int j = 0; j < 16; ++j) { v[j] = yr[64 * j]; s += (v[j].x + v[j].y) + (v[j].z + v[j].w); }
        const float mean = wave_sum(s) * (1.f / DM); float s2 = 0.f;
#pragma unroll
        for (int j = 0; j < 16; ++j) { v[j] = v[j] - mean; s2 += (v[j].x * v[j].x + v[j].y * v[j].y) + (v[j].z * v[j].z + v[j].w * v[j].w); }
        const float rstd = 1.f / sqrtf(wave_sum(s2) * (1.f / DM) + LN_EPS);
        f32x4* o4 = (f32x4*)(h32 + (size_t)m * DM) + F.lane; v2u* o2 = (v2u*)(hb + (size_t)m * DM) + F.lane;
        const f32x4* g4 = (const f32x4*)g + F.lane; const f32x4* b4 = (const f32x4*)b + F.lane;
#pragma unroll
        for (int j = 0; j < 16; ++j) { const f32x4 r = v[j] * rstd * g4[64 * j] + b4[64 * j]; o4[64 * j] = r; v2u w; w.x = pk2(r.x, r.y); w.y = pk2(r.z, r.w); o2[64 * j] = w; }
    }
}

__device__ __forceinline__ void convglu_phase(Frame& F, const bf16* UP, const float* cw, bf16* Gm) {
    constexpr int NCG = DFF / 8, RB = 16, NRB = MTOK / RB;
    const long nitems = (long)NCG * NRB;
    for (long it = (long)F.bid * NTHR + F.tid; it < nitems; it += (long)F.G * NTHR) {
        const int cg = (int)(it % NCG), rb = (int)(it / NCG), c0 = cg * 8, t0 = rb * RB;
        float w0[8], w1[8], w2[8];
#pragma unroll
        for (int j = 0; j < 8; ++j) { w0[j] = cw[c0 + j]; w1[j] = cw[DFF + c0 + j]; w2[j] = cw[2 * DFF + c0 + j]; }
        float am2[8], am1[8];
        if ((t0 & (SEQ - 1)) == 0) {
#pragma unroll
            for (int j = 0; j < 8; ++j) { am2[j] = 0.f; am1[j] = 0.f; }
        } else {
            const v4u x2 = *(const v4u*)(UP + (size_t)(t0 - 2) * DFF2 + c0), x1 = *(const v4u*)(UP + (size_t)(t0 - 1) * DFF2 + c0);
            am2[0] = bflo(x2.x); am2[1] = bfhi(x2.x); am2[2] = bflo(x2.y); am2[3] = bfhi(x2.y); am2[4] = bflo(x2.z); am2[5] = bfhi(x2.z); am2[6] = bflo(x2.w); am2[7] = bfhi(x2.w);
            am1[0] = bflo(x1.x); am1[1] = bfhi(x1.x); am1[2] = bflo(x1.y); am1[3] = bfhi(x1.y); am1[4] = bflo(x1.z); am1[5] = bfhi(x1.z); am1[6] = bflo(x1.w); am1[7] = bfhi(x1.w);
        }
#pragma unroll 4
        for (int r = 0; r < RB; ++r) {
            const size_t row = (size_t)(t0 + r);
            const v4u xa = *(const v4u*)(UP + row * DFF2 + c0), xu = *(const v4u*)(UP + row * DFF2 + DFF + c0);
            float a[8], u[8];
            a[0] = bflo(xa.x); a[1] = bfhi(xa.x); a[2] = bflo(xa.y); a[3] = bfhi(xa.y); a[4] = bflo(xa.z); a[5] = bfhi(xa.z); a[6] = bflo(xa.w); a[7] = bfhi(xa.w);
            u[0] = bflo(xu.x); u[1] = bfhi(xu.x); u[2] = bflo(xu.y); u[3] = bfhi(xu.y); u[4] = bflo(xu.z); u[5] = bfhi(xu.z); u[6] = bflo(xu.w); u[7] = bfhi(xu.w);
            float o[8];
#pragma unroll
            for (int j = 0; j < 8; j += 2) {
                const float c0v = w2[j] * a[j] + w1[j] * am1[j] + w0[j] * am2[j], c1v = w2[j + 1] * a[j + 1] + w1[j + 1] * am1[j + 1] + w0[j + 1] * am2[j + 1];
                const pg8::f32x2 gg = pg8::gelu_pk((pg8::f32x2){c0v, c1v}); o[j] = gg.x * u[j]; o[j + 1] = gg.y * u[j + 1]; }
            v4u w; w.x = pk2(o[0], o[1]); w.y = pk2(o[2], o[3]); w.z = pk2(o[4], o[5]); w.w = pk2(o[6], o[7]);
            *(v4u*)(Gm + row * DFF + c0) = w;
#pragma unroll
            for (int j = 0; j < 8; ++j) { am2[j] = am1[j]; am1[j] = a[j]; }
        }
    }
}

__device__ __forceinline__ void xattn_phase(Frame& F, const bf16* XQ, const bf16* XKV, bf16* XO) {
    const int tid = F.tid, wid = F.wave, lane = F.lane, r32 = lane & 31, hi = lane >> 5;
    LAS char* lds = (LAS char*)F.lds;
    LAS float* wsc = (LAS float*)(lds + ATT_WS_OFF + wid * 256);
    const int sr = tid >> 4, sc = (tid & 15) * 8;
    const int vb0 = (int)(uintptr_t)(lds + ATT_V_OFF) + v_rd_base(lane);
    constexpr int NU = (MTOK / 256) * XH;
    for (int u = F.bid; u < NU; u += F.G) {
        const int head = u % XH, rbk = u / XH, row0 = rbk * 256, b = row0 / SEQ;
        const bf16* Kh = XKV + (size_t)b * NMEM * 2 * XW + head * HD; const bf16* Vh = Kh + XW;
        bf16x8 qr[8]; load_q(qr, XQ + (size_t)(row0 + wid * 32 + r32) * XW + head * HD + hi * 8);
        float m_reg = -1e30f, l_reg = 0.f; f32x16 o[4] = {};
        KVStage st; kv_load(st, Kh, Vh, 2 * XW, 2 * XW, 0, sr, sc);
        for (int j = 0; j < NMEM / KVBLK; ++j) {
            VM_WAIT(); __syncthreads(); kv_write(st, lds, sr, sc); LDS_WAIT(); __syncthreads();
            if (j + 1 < NMEM / KVBLK) kv_load(st, Kh, Vh, 2 * XW, 2 * XW, (j + 1) * KVBLK, sr, sc);
            f32x16 p0, p1; qkt(p0, p1, lds + ATT_K_OFF, qr, r32, hi);
            float alpha; softmax_tile<false>(p0, p1, 0u, 0u, m_reg, l_reg, alpha);
            rescale_o(o, alpha, wsc, r32, hi);
            bf16x8 pa0, pa1, pa2, pa3; pack_p(p0, p1, pa0, pa1, pa2, pa3);
            pv_d0(o, vb0, pa0, pa1, pa2, pa3);
        }
        if (hi == 0) wsc[32 + r32] = l_reg; LDS_WAIT();
        bf16* Ow = XO + (size_t)(row0 + wid * 32) * XW + head * HD;
#pragma unroll
        for (int r = 0; r < 16; ++r) { const int orow = crow(r, hi); const float rl = __builtin_amdgcn_rcpf(wsc[32 + orow]);
#pragma unroll
            for (int d0 = 0; d0 < 4; ++d0) Ow[(size_t)orow * XW + d0 * 32 + r32] = (bf16)f2bf(o[d0][r] * rl); }
        LDS_WAIT();
    }
}

template <int K>
__device__ __forceinline__ f32x4 mma_tile(const LAS char* A, int lda, const LAS char* B, int ldb, int fr, int fq) {
    f32x4 acc = {0.f, 0.f, 0.f, 0.f};
#pragma unroll
    for (int k0 = 0; k0 < K; k0 += 32) {
        const bf16x8 a = *(const LAS bf16x8*)(A + fr * lda + (k0 + 8 * fq) * 2);
        const bf16x8 b = *(const LAS bf16x8*)(B + fr * ldb + (k0 + 8 * fq) * 2);
        acc = __builtin_amdgcn_mfma_f32_16x16x32_bf16(a, b, acc, 0, 0, 0);
    }
    return acc;
}
constexpr int HG_CH = 64, HG_NC = SEQ / HG_CH, HG_ITEMS = BATCH * A_HEADS * HG_NC;
constexpr int HG_QT = 0, HG_KT = 17408, HG_KH = 34816, HG_VT = 53248, HG_PT = 71680, HG_SEG = 80896;
constexpr int HG_SP = 17408, HG_OT = 52224;
__device__ __forceinline__ void hgrn_phase_a(Frame& F, const bf16* P0, const float* lbv, bf16* QTg, float* OINTRA, float* DS, float* DEC) {
    LAS char* lds = (LAS char*)F.lds;
    const int tid = F.tid, wid = F.wave, lane = F.lane, fr = lane & 15, fq = lane >> 4;
    const int d = tid & 127, sq = tid >> 7;
    for (int it = F.bid; it < HG_ITEMS; it += F.G) {
        const int c = it % HG_NC, bh = it / HG_NC, h = bh % A_HEADS, b = bh / A_HEADS;
        const size_t row0 = (size_t)b * SEQ + (size_t)c * HG_CH;
        const float lb = lbv[h * HD + d], omlb = 1.f - lb;
        float cum[16], kk[16];
        { float run = 0.f;
#pragma unroll
          for (int j = 0; j < 16; ++j) { const float z = bf2f(P0[(row0 + 16 * sq + j) * AB_IN + A_W + h * HD + d]); const float sg = sigmoidf_(z);
              run += __logf(lb + omlb * sg); cum[j] = run; kk[j] = omlb * (1.f - sg); }
          ((LAS float*)(lds + HG_SEG))[sq * 128 + d] = run; }
        LDS_WAIT(); __syncthreads();
        float base = 0.f, total = 0.f;
#pragma unroll
        for (int q = 0; q < 4; ++q) { const float sgm = ((LAS float*)(lds + HG_SEG))[q * 128 + d]; total += sgm; if (q < sq) base += sgm; }
        unsigned kh[8], vt[8];
#pragma unroll
        for (int j = 0; j < 16; j += 2) {
            float e[2][3]; unsigned short vr[2];
#pragma unroll
            for (int jj = 0; jj < 2; ++jj) { const int s = 16 * sq + j + jj; const float bb = base + cum[j + jj];
                const float q = bf2f(P0[(row0 + s) * AB_IN + h * HD + d]); vr[jj] = P0[(row0 + s) * AB_IN + 2 * A_W + h * HD + d];
                const float qt = q * __expf(bb), kt = kk[j + jj] * __expf(-bb), kht = kk[j + jj] * __expf(total - bb);
                const unsigned short qb16 = (unsigned short)f2bf(qt);
                *(LAS unsigned short*)(lds + HG_QT + s * 272 + d * 2) = qb16; QTg[(row0 + s) * A_W + h * HD + d] = qb16;
                *(LAS unsigned short*)(lds + HG_KT + s * 272 + d * 2) = (unsigned short)f2bf(kt);
                e[jj][0] = kht; }
            kh[j >> 1] = pk2(e[0][0], e[1][0]); vt[j >> 1] = (unsigned)vr[0] | ((unsigned)vr[1] << 16);
        }
        { LAS v4u* pk = (LAS v4u*)(lds + HG_KH + d * 144 + sq * 32); pk[0] = (v4u){kh[0], kh[1], kh[2], kh[3]}; pk[1] = (v4u){kh[4], kh[5], kh[6], kh[7]};
          LAS v4u* pv = (LAS v4u*)(lds + HG_VT + d * 144 + sq * 32); pv[0] = (v4u){vt[0], vt[1], vt[2], vt[3]}; pv[1] = (v4u){vt[4], vt[5], vt[6], vt[7]}; }
        if (sq == 3) DEC[(size_t)it * HD + d] = __expf(total);
        LDS_WAIT(); __syncthreads();
#pragma unroll
        for (int k = 0; k < 2; ++k) { const int tau = 2 * wid + k, ti = tau >> 2, si = tau & 3;
            f32x4 acc = {0.f, 0.f, 0.f, 0.f};
            if (si <= ti) acc = mma_tile<128>(lds + HG_QT + ti * 16 * 272, 272, lds + HG_KT + si * 16 * 272, 272, fr, fq);
#pragma unroll
            for (int i = 0; i < 4; ++i) { const int t = 16 * ti + 4 * fq + i, s = 16 * si + fr; const float v = (s <= t) ? acc[i] : 0.f;
                *(LAS unsigned short*)(lds + HG_PT + t * 144 + s * 2) = (unsigned short)f2bf(v); } }
        LDS_WAIT(); __syncthreads();
#pragma unroll
        for (int k = 0; k < 4; ++k) { const int tau = wid + 8 * k, ti = tau >> 3, vi = tau & 7;
            const f32x4 acc = mma_tile<64>(lds + HG_PT + ti * 16 * 144, 144, lds + HG_VT + vi * 16 * 144, 144, fr, fq);
#pragma unroll
            for (int i = 0; i < 4; ++i) OINTRA[(row0 + 16 * ti + 4 * fq + i) * A_W + h * HD + 16 * vi + fr] = acc[i]; }
#pragma unroll
        for (int k = 0; k < 8; ++k) { const int tau = wid + 8 * k, vi = tau >> 3, ki = tau & 7;
            const f32x4 acc = mma_tile<64>(lds + HG_VT + vi * 16 * 144, 144, lds + HG_KH + ki * 16 * 144, 144, fr, fq);
#pragma unroll
            for (int i = 0; i < 4; ++i) DS[((size_t)it * HD + 16 * vi + 4 * fq + i) * HD + 16 * ki + fr] = acc[i]; }
        LDS_WAIT(); __syncthreads();
    }
}
__device__ __forceinline__ void hgrn_phase_b(Frame& F, const float* DS, const float* DEC, bf16* SPREV) {
    const int tid = F.tid, dvl = tid >> 5, dk4 = (tid & 31) * 4;
    for (int item = F.bid; item < BATCH * A_HEADS * 8; item += F.G) {
        const int sl = item & 7, bh = item >> 3, dv = sl * 16 + dvl;
        f32x4 S = {0.f, 0.f, 0.f, 0.f};
        for (int c0 = 0; c0 < HG_NC; c0 += 8) {
            f32x4 ds[8], dc[8];
#pragma unroll
            for (int k = 0; k < 8; ++k) { const size_t it = (size_t)bh * HG_NC + c0 + k; ds[k] = *(const f32x4*)(DS + (it * HD + dv) * HD + dk4); dc[k] = *(const f32x4*)(DEC + it * HD + dk4); }
#pragma unroll
            for (int k = 0; k < 8; ++k) { const size_t it = (size_t)bh * HG_NC + c0 + k;
                v2u w; w.x = pk2(S.x, S.y); w.y = pk2(S.z, S.w); *(v2u*)(SPREV + (it * HD + dv) * HD + dk4) = w;
                S = S * dc[k] + ds[k]; }
        }
    }
}
__device__ __forceinline__ void hgrn_phase_c(Frame& F, const bf16* P0, const bf16* QTg, const float* OINTRA, const bf16* SPREV, const float* nw, bf16* Ob) {
    LAS char* lds = (LAS char*)F.lds;
    const int tid = F.tid, wid = F.wave, lane = F.lane, fr = lane & 15, fq = lane >> 4;
    for (int it = F.bid; it < HG_ITEMS; it += F.G) {
        const int c = it % HG_NC, bh = it / HG_NC, h = bh % A_HEADS, b = bh / A_HEADS;
        const size_t row0 = (size_t)b * SEQ + (size_t)c * HG_CH;
        { const int s = tid >> 3, ch = (tid & 7) * 16; const bf16* src = QTg + (row0 + s) * A_W + h * HD + ch;
          const v4u x0 = *(const v4u*)src, x1 = *(const v4u*)(src + 8); LAS v4u* dst = (LAS v4u*)(lds + HG_QT + s * 272 + ch * 2); dst[0] = x0; dst[1] = x1; }
        { const int dv = tid >> 2, ch = (tid & 3) * 32; const bf16* src = SPREV + ((size_t)it * HD + dv) * HD + ch;
          const v4u x0 = *(const v4u*)src, x1 = *(const v4u*)(src + 8), x2 = *(const v4u*)(src + 16), x3 = *(const v4u*)(src + 24);
          LAS v4u* dst = (LAS v4u*)(lds + HG_SP + dv * 272 + ch * 2); dst[0] = x0; dst[1] = x1; dst[2] = x2; dst[3] = x3; }
        LDS_WAIT(); __syncthreads();
#pragma unroll
        for (int k = 0; k < 4; ++k) { const int tau = wid + 8 * k, ti = tau >> 3, vi = tau & 7;
            const f32x4 acc = mma_tile<128>(lds + HG_QT + ti * 16 * 272, 272, lds + HG_SP + vi * 16 * 272, 272, fr, fq);
#pragma unroll
            for (int i = 0; i < 4; ++i) { const int t = 16 * ti + 4 * fq + i, dv = 16 * vi + fr;
                *(LAS float*)(lds + HG_OT + (t * 132 + dv) * 4) = acc[i] + OINTRA[(row0 + t) * A_W + h * HD + dv]; } }
        LDS_WAIT(); __syncthreads();
#pragma unroll
        for (int k = 0; k < 8; ++k) { const int t = wid * 8 + k;
            const float v0 = *(LAS float*)(lds + HG_OT + (t * 132 + lane) * 4), v1 = *(LAS float*)(lds + HG_OT + (t * 132 + 64 + lane) * 4);
            const float ss = wave_sum(v0 * v0 + v1 * v1); const float r = 1.f / sqrtf(ss * (1.f / HD) + RMS_EPS);
            const float g0 = bf2f(P0[(row0 + t) * AB_IN + 3 * A_W + h * HD + lane]), g1 = bf2f(P0[(row0 + t) * AB_IN + 3 * A_W + h * HD + 64 + lane]);
            Ob[(row0 + t) * DM + h * HD + lane] = (bf16)f2bf(v0 * r * nw[lane] * g0 * sigmoidf_(g0));
            Ob[(row0 + t) * DM + h * HD + 64 + lane] = (bf16)f2bf(v1 * r * nw[64 + lane] * g1 * sigmoidf_(g1)); }
        LDS_WAIT(); __syncthreads();
    }
}

__device__ __forceinline__ void sb_phase(Frame& F, const bf16* P0, bf16* Ob) {
    const int tid = F.tid, wid = F.wave, lane = F.lane, r32 = lane & 31, hi = lane >> 5;
    LAS char* lds = (LAS char*)F.lds;
    const int sr = tid >> 4, sc = (tid & 15) * 8;
    const int vb0 = (int)(uintptr_t)(lds + ATT_V_OFF) + v_rd_base(lane);
    constexpr int NQB = SEQ / 256, NU = BATCH * B_HEADS * NQB;
    for (int rd = 0; ; ++rd) {
        const int idx = (rd & 1) ? rd * F.G + (F.G - 1 - F.bid) : rd * F.G + F.bid;
        if (rd * F.G >= NU) break;
        if (idx >= NU) continue;
        const int qb = NQB - 1 - idx / (BATCH * B_HEADS), bh = idx % (BATCH * B_HEADS), head = bh % B_HEADS, b = bh / B_HEADS;
        const size_t rowb = (size_t)b * SEQ; const int q0 = qb * 256;
        const bf16* Kh = P0 + rowb * AB_IN + 4 * A_W + B_W + head * HD; const bf16* Vh = Kh + B_W;
        const int tw0 = q0 + wid * 32, t = tw0 + r32;
        bf16x8 qr[8]; load_q(qr, P0 + (rowb + t) * AB_IN + 4 * A_W + head * HD + hi * 8);
        float R = 0.f; f32x16 o[4] = {};
        const int jtop = (q0 + 254) >> 6;
        KVStage st;
        for (int j = jtop; j >= 0; --j) {
            kv_load(st, Kh, Vh, AB_IN, AB_IN, j * KVBLK, sr, sc); VM_WAIT(); __syncthreads(); kv_write(st, lds, sr, sc); LDS_WAIT(); __syncthreads();
            const int k0 = j * KVBLK;
            if (k0 < tw0 + 31) {
                f32x16 p0, p1; qkt(p0, p1, lds + ATT_K_OFF, qr, r32, hi);
                const bool need_mask = (k0 + 63 >= tw0);
                float L0[16], L1[16];
#pragma unroll
                for (int r = 0; r < 16; ++r) {
                    const float z0 = p0[r] * ATT_C, z1 = p1[r] * ATT_C;
                    float l0 = -(fmaxf(z0, 0.f) + __builtin_amdgcn_logf(1.f + __builtin_amdgcn_exp2f(-fabsf(z0))));
                    float l1 = -(fmaxf(z1, 0.f) + __builtin_amdgcn_logf(1.f + __builtin_amdgcn_exp2f(-fabsf(z1))));
                    if (need_mask) { if (k0 + crow(r, hi) >= t) l0 = 0.f; if (k0 + 32 + crow(r, hi) >= t) l1 = 0.f; }
                    L0[r] = l0; L1[r] = l1; p0[r] = z0 + l0; p1[r] = z1 + l1;
                }
                SBAR();
                float Sg[16];
#pragma unroll
                for (int gi = 0; gi < 4; ++gi) {
                    const float a = (L0[4 * gi] + L0[4 * gi + 1]) + (L0[4 * gi + 2] + L0[4 * gi + 3]), c = (L1[4 * gi] + L1[4 * gi + 1]) + (L1[4 * gi + 2] + L1[4 * gi + 3]);
                    auto ra = __builtin_amdgcn_permlane32_swap(__float_as_uint(a), __float_as_uint(a), false, false);
                    auto rc = __builtin_amdgcn_permlane32_swap(__float_as_uint(c), __float_as_uint(c), false, false);
                    Sg[2 * gi] = __uint_as_float(ra[0]); Sg[2 * gi + 1] = __uint_as_float(ra[1]); Sg[8 + 2 * gi] = __uint_as_float(rc[0]); Sg[8 + 2 * gi + 1] = __uint_as_float(rc[1]);
                }
                float run = R;
#pragma unroll
                for (int s = 15; s >= 0; --s) { const float tt = run; run += Sg[s]; Sg[s] = tt; }
                const float Rn = run;
                SBAR();
#pragma unroll
                for (int gi = 0; gi < 4; ++gi) {
                    float base0 = hi ? Sg[2 * gi + 1] : Sg[2 * gi], base1 = hi ? Sg[8 + 2 * gi + 1] : Sg[8 + 2 * gi];
                    float r3 = base0, r2 = r3 + L0[4 * gi + 3], r1 = r2 + L0[4 * gi + 2], r0 = r1 + L0[4 * gi + 1];
                    p0[4 * gi + 3] = __builtin_amdgcn_exp2f(p0[4 * gi + 3] + r3); p0[4 * gi + 2] = __builtin_amdgcn_exp2f(p0[4 * gi + 2] + r2);
                    p0[4 * gi + 1] = __builtin_amdgcn_exp2f(p0[4 * gi + 1] + r1); p0[4 * gi + 0] = __builtin_amdgcn_exp2f(p0[4 * gi + 0] + r0);
                    r3 = base1; r2 = r3 + L1[4 * gi + 3]; r1 = r2 + L1[4 * gi + 2]; r0 = r1 + L1[4 * gi + 1];
                    p1[4 * gi + 3] = __builtin_amdgcn_exp2f(p1[4 * gi + 3] + r3); p1[4 * gi + 2] = __builtin_amdgcn_exp2f(p1[4 * gi + 2] + r2);
                    p1[4 * gi + 1] = __builtin_amdgcn_exp2f(p1[4 * gi + 1] + r1); p1[4 * gi + 0] = __builtin_amdgcn_exp2f(p1[4 * gi + 0] + r0);
                }
                R = Rn;
                if (need_mask) {
#pragma unroll
                    for (int r = 0; r < 16; ++r) { if (k0 + crow(r, hi) >= t) p0[r] = 0.f; if (k0 + 32 + crow(r, hi) >= t) p1[r] = 0.f; }
                }
                bf16x8 pa0, pa1, pa2, pa3; pack_p(p0, p1, pa0, pa1, pa2, pa3);
                pv_d0(o, vb0, pa0, pa1, pa2, pa3);
            }
        }
        bf16* Ow = Ob + (rowb + tw0) * DM + A_W + head * HD;
#pragma unroll
        for (int r = 0; r < 16; ++r) { const int orow = crow(r, hi);
#pragma unroll
            for (int d0 = 0; d0 < 4; ++d0) Ow[(size_t)orow * DM + d0 * 32 + r32] = (bf16)f2bf(o[d0][r]); }
    }
}

constexpr int P1_KC = 4096, P1_VC = 4608, P1_KS = 5120, P1_VS = 5632, P1_KW = 6144, P1_VW = 6656, P1_GL = 7168;
__device__ __forceinline__ void nsa_rope_phase(Frame& F, const bf16* P1, bf16* QROT, bf16* KSROT, bf16* KWROT, bf16* OVL) {
    const int gw = F.bid * NWAVES + F.wave, NGW = F.G * NWAVES, lane = F.lane;
    const float inv_freq = powf(10000.0f, -(float)lane * (1.0f / 64.0f));
    for (int m = gw; m < MTOK; m += NGW) {
        const int t = m & (SEQ - 1);
        float sn, cs; sincosf((float)t * inv_freq, &sn, &cs);
        const bf16* row = P1 + (size_t)m * NSA_INP;
        for (int hh = 0; hh < 40; ++hh) {
            const bf16* src; bf16* dst;
            if (hh < 32) { src = row + hh * HD; dst = QROT + (size_t)m * DM + hh * HD; }
            else if (hh < 36) { src = row + P1_KS + (hh - 32) * HD; dst = KSROT + (size_t)m * KVW + (hh - 32) * HD; }
            else { src = row + P1_KW + (hh - 36) * HD; dst = KWROT + (size_t)m * KVW + (hh - 36) * HD; }
            const float x1 = bf2f(src[lane]), x2 = bf2f(src[64 + lane]);
            dst[lane] = (bf16)f2bf(x1 * cs - x2 * sn); dst[64 + lane] = (bf16)f2bf(x2 * cs + x1 * sn);
        }
    }
    for (int i = F.bid * NTHR + F.tid; i < NCMPP * NSLC; i += F.G * NTHR) { const int n = i / NSLC, j = i % NSLC;
        OVL[i] = (n < NCMP && n >= 4 * j - 1 && n <= 4 * j + 3) ? (bf16)0x3f80u : (bf16)0u; }
}
constexpr int CM_A = 0, CM_B = 17408, CM_H = 17408 + 34816;
__device__ __forceinline__ void nsa_compress_phase(Frame& F, const bf16* P1, const float* pos, const bf16* W1t, const bf16* W2t, bf16* KCMP, bf16* VCMP) {
    LAS char* lds = (LAS char*)F.lds;
    const int tid = F.tid, wid = F.wave, lane = F.lane, fr = lane & 15, fq = lane >> 4;
    for (int item = F.bid; item < 128; item += F.G) {
        const int nt = item & 7, g = (item >> 3) & 3, b = (item >> 5) & 1, which = item >> 6;
        const bf16* w1 = W1t + (size_t)which * HD * 32 * HD; const bf16* w2 = W2t + (size_t)which * HD * HD;
        const float* posw = pos + (size_t)which * 32 * HD;
        f32x4 acc[4];
#pragma unroll
        for (int k = 0; k < 4; ++k) acc[k] = (f32x4){0.f, 0.f, 0.f, 0.f};
        for (int l = 0; l < 32; ++l) {
            { const int r = tid >> 3, ch = (tid & 7) * 16, n = nt * 64 + r; unsigned w[8];
              if (n < NCMP) { const bf16* src = P1 + ((size_t)b * SEQ + 16 * n + l) * NSA_INP + P1_KC + which * KVW + g * HD + ch;
                  const v4u x0 = *(const v4u*)src, x1 = *(const v4u*)(src + 8); const unsigned xs[8] = {x0.x, x0.y, x0.z, x0.w, x1.x, x1.y, x1.z, x1.w};
#pragma unroll
                  for (int q = 0; q < 8; ++q) w[q] = pk2(bflo(xs[q]) + posw[l * HD + ch + 2 * q], bfhi(xs[q]) + posw[l * HD + ch + 2 * q + 1]);
              } else {
#pragma unroll
                  for (int q = 0; q < 8; ++q) w[q] = 0u; }
              LAS v4u* dst = (LAS v4u*)(lds + CM_A + r * 272 + ch * 2); dst[0] = (v4u){w[0], w[1], w[2], w[3]}; dst[1] = (v4u){w[4], w[5], w[6], w[7]}; }
            { const int e = tid >> 2, ch = (tid & 3) * 32; const bf16* src = w1 + (size_t)e * 32 * HD + l * HD + ch;
              const v4u x0 = *(const v4u*)src, x1 = *(const v4u*)(src + 8), x2 = *(const v4u*)(src + 16), x3 = *(const v4u*)(src + 24);
              LAS v4u* dst = (LAS v4u*)(lds + CM_B + e * 272 + ch * 2); dst[0] = x0; dst[1] = x1; dst[2] = x2; dst[3] = x3; }
            LDS_WAIT(); __syncthreads();
#pragma unroll
            for (int k = 0; k < 4; ++k) { const int tau = wid + 8 * k, ni = tau >> 3, ei = tau & 7;
                acc[k] += mma_tile<128>(lds + CM_A + ni * 16 * 272, 272, lds + CM_B + ei * 16 * 272, 272, fr, fq); }
            LDS_WAIT(); __syncthreads();
        }
#pragma unroll
        for (int k = 0; k < 4; ++k) { const int tau = wid + 8 * k, ni = tau >> 3, ei = tau & 7;
#pragma unroll
            for (int i = 0; i < 4; ++i) *(LAS unsigned short*)(lds + CM_H + (16 * ni + 4 * fq + i) * 272 + (16 * ei + fr) * 2) = (unsigned short)f2bf(gelu1(acc[k][i])); }
        { const int f = tid >> 2, ch = (tid & 3) * 32; const bf16* src = w2 + (size_t)f * HD + ch;
          const v4u x0 = *(const v4u*)src, x1 = *(const v4u*)(src + 8), x2 = *(const v4u*)(src + 16), x3 = *(const v4u*)(src + 24);
          LAS v4u* dst = (LAS v4u*)(lds + CM_B + f * 272 + ch * 2); dst[0] = x0; dst[1] = x1; dst[2] = x2; dst[3] = x3; }
        LDS_WAIT(); __syncthreads();
        bf16* outp = which ? VCMP : KCMP;
#pragma unroll
        for (int k = 0; k < 4; ++k) { const int tau = wid + 8 * k, ni = tau >> 3, fi = tau & 7;
            const f32x4 a2 = mma_tile<128>(lds + CM_H + ni * 16 * 272, 272, lds + CM_B + fi * 16 * 272, 272, fr, fq);
#pragma unroll
            for (int i = 0; i < 4; ++i) { const int n = nt * 64 + 16 * ni + 4 * fq + i;
                outp[(((size_t)b * NCMPP + n) * NSA_G + g) * HD + 16 * fi + fr] = (n < NCMP) ? (bf16)f2bf(a2[i]) : (bf16)0u; } }
        LDS_WAIT(); __syncthreads();
    }
}
__device__ __forceinline__ unsigned pick4(const unsigned (&a)[4], int i) { return i == 0 ? a[0] : (i == 1 ? a[1] : (i == 2 ? a[2] : a[3])); }
template <int MODE>
__device__ __forceinline__ void nsa_attn_phase(Frame& F, const bf16* P1, const bf16* Qsrc, const bf16* Ksrc, const bf16* Vsrc, const unsigned* SEL, float* O32, float* IMP, bf16* Ob) {
    const int tid = F.tid, wid = F.wave, lane = F.lane, r32 = lane & 31, hi = lane >> 5;
    LAS char* lds = (LAS char*)F.lds;
    LAS float* wsc = (LAS float*)(lds + ATT_WS_OFF + wid * 256);
    const int sr = tid >> 4, sc = (tid & 15) * 8;
    const int vb0 = (int)(uintptr_t)(lds + ATT_V_OFF) + v_rd_base(lane);
    constexpr int NTB = SEQ / 32, NU = BATCH * NSA_G * NTB;
    for (int rd = 0; ; ++rd) {
        const int idx = (rd & 1) ? rd * F.G + (F.G - 1 - F.bid) : rd * F.G + F.bid;
        if (rd * F.G >= NU) break;
        if (idx >= NU) continue;
        const int tb = NTB - 1 - idx / (BATCH * NSA_G), bg = idx % (BATCH * NSA_G), g = bg % NSA_G, b = bg / NSA_G;
        const size_t rowb = (size_t)b * SEQ; const int t0 = tb * 32, t = t0 + r32, head = g * NSA_R + wid;
        const bf16* Kh; const bf16* Vh; long ldk, ldv; int jlo, jhi;
        if (MODE <= 1) { Kh = Ksrc + ((size_t)b * NCMPP * NSA_G + g) * HD; ldk = NSA_G * HD; jlo = 0; jhi = (t0 >> 4) >> 6;
            if (MODE == 0) { Vh = Vsrc + ((size_t)b * NCMPP * NSA_G + g) * HD; ldv = NSA_G * HD; } else { Vh = Vsrc; ldv = NSLC; } }
        else { Kh = Ksrc + rowb * KVW + g * HD; ldk = KVW; Vh = P1 + rowb * NSA_INP + (MODE == 2 ? P1_VS : P1_VW) + g * HD; ldv = NSA_INP;
            jhi = (t0 + 31) >> 6; jlo = (MODE == 2) ? 0 : ((t0 - (WINDOW - 1) > 0 ? t0 - (WINDOW - 1) : 0) >> 6); }
        bf16x8 qr[8]; load_q(qr, Qsrc + (rowb + t) * (MODE <= 1 ? NSA_INP : DM) + head * HD + hi * 8);
        unsigned selw[4] = {0u, 0u, 0u, 0u}, uni[4] = {~0u, ~0u, ~0u, ~0u};
        if (MODE == 2) { const v4u sv = *(const v4u*)(SEL + ((rowb + t) * NSA_G + g) * 4); selw[0] = sv.x; selw[1] = sv.y; selw[2] = sv.z; selw[3] = sv.w;
#pragma unroll
            for (int q = 0; q < 4; ++q) { unsigned x = selw[q];
#pragma unroll
                for (int o = 1; o < 32; o <<= 1) x |= __shfl_xor(x, o);
                uni[q] = __builtin_amdgcn_readfirstlane(x); } }
        float m_reg = -1e30f, l_reg = 0.f; f32x16 o[4] = {};
        const int cur = t >> 6;
        for (int j = jlo; j <= jhi; ++j) {
            if (MODE == 2) { if (!((pick4(uni, j >> 5) >> (j & 31)) & 1u)) continue; }
            const int k0 = j * KVBLK;
            KVStage st; kv_load(st, Kh, Vh, ldk, ldv, k0, sr, sc);
            VM_WAIT(); __syncthreads(); kv_write(st, lds, sr, sc); LDS_WAIT(); __syncthreads();
            f32x16 p0, p1; qkt(p0, p1, lds + ATT_K_OFF, qr, r32, hi);
            unsigned vm0 = 0u, vm1 = 0u; bool full;
            if (MODE <= 1) { full = (16 * (k0 + 63) + 31 <= t0);
                if (!full) {
#pragma unroll
                    for (int r = 0; r < 16; ++r) { vm0 |= (16 * (k0 + crow(r, hi)) + 31 <= t) ? (1u << r) : 0u; vm1 |= (16 * (k0 + 32 + crow(r, hi)) + 31 <= t) ? (1u << r) : 0u; } } }
            else if (MODE == 2) { full = false; const bool mine = (pick4(selw, j >> 5) >> (j & 31)) & 1u;
                if (mine) { if (j < cur) { vm0 = 0xffffu; vm1 = 0xffffu; } else {
#pragma unroll
                    for (int r = 0; r < 16; ++r) { vm0 |= (k0 + crow(r, hi) <= t) ? (1u << r) : 0u; vm1 |= (k0 + 32 + crow(r, hi) <= t) ? (1u << r) : 0u; } } } }
            else { full = (k0 > t0 + 31 - WINDOW) && (k0 + 63 <= t0);
                if (!full) {
#pragma unroll
                    for (int r = 0; r < 16; ++r) { const int ka = k0 + crow(r, hi), kb = ka + 32;
                        vm0 |= (ka <= t && ka > t - WINDOW) ? (1u << r) : 0u; vm1 |= (kb <= t && kb > t - WINDOW) ? (1u << r) : 0u; } } }
            float alpha;
            if (full) softmax_tile<false>(p0, p1, 0u, 0u, m_reg, l_reg, alpha); else softmax_tile<true>(p0, p1, vm0, vm1, m_reg, l_reg, alpha);
            rescale_o(o, alpha, wsc, r32, hi);
            bf16x8 pa0, pa1, pa2, pa3; pack_p(p0, p1, pa0, pa1, pa2, pa3);
            pv_d0(o, vb0, pa0, pa1, pa2, pa3);
        }
        { float fac = l_reg > 0.f ? __builtin_amdgcn_rcpf(l_reg) : 0.f;
          if (MODE != 1) { const int br = MODE == 0 ? 0 : (MODE == 2 ? 1 : 2); fac *= sigmoidf_(bf2f(P1[(rowb + t) * NSA_INP + P1_GL + head * 3 + br])); }
          if (hi == 0) wsc[32 + r32] = fac; LDS_WAIT(); }
        if (MODE == 1) {
            float fc[16];
#pragma unroll
            for (int r = 0; r < 16; ++r) fc[r] = wsc[32 + crow(r, hi)];
            LDS_WAIT(); __syncthreads();
#pragma unroll
            for (int r = 0; r < 16; ++r) { const int orow = crow(r, hi);
#pragma unroll
                for (int d0 = 0; d0 < 4; ++d0) *(LAS float*)(lds + ((wid * 32 + orow) * 128 + d0 * 32 + r32) * 4) = o[d0][r] * fc[r]; }
            LDS_WAIT(); __syncthreads();
            { const int tok = tid >> 4, j8 = (tid & 15) * 8; f32x4 s0 = {0.f, 0.f, 0.f, 0.f}, s1 = {0.f, 0.f, 0.f, 0.f};
#pragma unroll
              for (int w = 0; w < 8; ++w) { const LAS f32x4* pp = (const LAS f32x4*)(lds + ((w * 32 + tok) * 128 + j8) * 4); s0 += pp[0]; s1 += pp[1]; }
              f32x4* dst = (f32x4*)(IMP + ((rowb + t0 + tok) * NSA_G + g) * NSLC + j8); dst[0] = s0; dst[1] = s1; }
            LDS_WAIT(); __syncthreads();
        } else {
#pragma unroll
            for (int r = 0; r < 16; ++r) { const int orow = crow(r, hi); const float fc = wsc[32 + orow];
                const size_t off = (rowb + t0 + orow) * DM + head * HD + r32;
#pragma unroll
                for (int d0 = 0; d0 < 4; ++d0) {
                    if (MODE == 0) O32[off + d0 * 32] = o[d0][r] * fc;
                    else if (MODE == 2) O32[off + d0 * 32] += o[d0][r] * fc;
                    else Ob[off + d0 * 32] = (bf16)f2bf(O32[off + d0 * 32] + o[d0][r] * fc); } }
            LDS_WAIT();
        }
    }
}
__device__ __forceinline__ void nsa_topk_phase(Frame& F, const float* IMP, unsigned* SEL) {
    LAS float* sc = (LAS float*)(F.lds + F.wave * 1024);
    const int gw = F.bid * NWAVES + F.wave, NGW = F.G * NWAVES, lane = F.lane;
    for (int it = gw; it < MTOK * NSA_G; it += NGW) {
        const int m = it / NSA_G, t = m & (SEQ - 1), cur = t >> 6;
        const float* ip = IMP + (size_t)it * NSLC;
        const float a0 = ip[lane], a1 = ip[64 + lane];
        sc[lane] = a0; sc[64 + lane] = a1; LDS_WAIT();
        const int j0 = lane, j1 = lane + 64;
        const bool f0 = (j0 == 0) || (j0 == cur) || (j0 == cur - 1), f1 = (j1 == cur) || (j1 == cur - 1);
        const bool c0 = !f0 && j0 <= cur, c1 = !f1 && j1 <= cur;
        const int nforced = cur >= 2 ? 3 : cur + 1, slots = NTOP - nforced;
        int rk0 = 0, rk1 = 0;
        const int ncand_hi = cur < NSLC ? cur : NSLC - 1;
        for (int i = 1; i <= ncand_hi; ++i) {
            const bool fi = (i == cur) || (i == cur - 1); if (fi) continue;
            const float v = sc[i];
            rk0 += (v > a0 || (v == a0 && i < j0)) ? 1 : 0; rk1 += (v > a1 || (v == a1 && i < j1)) ? 1 : 0;
        }
        const bool s0 = (f0 && j0 <= cur) || (c0 && rk0 < slots), s1 = (f1 && j1 <= cur) || (c1 && rk1 < slots);
        const unsigned long long m0 = __ballot(s0), m1 = __ballot(s1);
        if (lane == 0) { v4u w = {(unsigned)m0, (unsigned)(m0 >> 32), (unsigned)m1, (unsigned)(m1 >> 32)}; *(v4u*)(SEL + (size_t)it * 4) = w; }
        LDS_WAIT();
    }
}

#ifndef STAGE
#define STAGE 3
#endif
#define ZERO_OB_PHASE PH_BEGIN { v4u z = {0u, 0u, 0u, 0u}; v4u* p = (v4u*)Ob; const long n = (long)MTOK * DM / 8; \
            for (long i = (long)F.bid * NTHR + F.tid; i < n; i += (long)F.G * NTHR) p[i] = z; } PH_END
#define MIXER0_PHASES \
    PH_BEGIN hgrn_phase_a(F, BIG, (const float*)(ws + WS_LB), (bf16*)(ws + WS_QT), (float*)(ws + WS_OINTRA), (float*)(ws + WS_DS), (float*)(ws + WS_DEC)); \
             sb_phase(F, BIG, Ob); PH_END \
    PH_BEGIN hgrn_phase_b(F, (const float*)(ws + WS_DS), (const float*)(ws + WS_DEC), (bf16*)(ws + WS_SPREV)); PH_END \
    PH_BEGIN hgrn_phase_c(F, BIG, (const bf16*)(ws + WS_QT), (const float*)(ws + WS_OINTRA), (const bf16*)(ws + WS_SPREV), args.in[IN_HGRN_NW], Ob); PH_END
#if STAGE <= 2
#define MIXER1_PHASES ZERO_OB_PHASE
#else
#define MIXER1_PHASES \
    PH_BEGIN nsa_rope_phase(F, BIG, (bf16*)(ws + WS_QROT), (bf16*)(ws + WS_KSROT), (bf16*)(ws + WS_KWROT), (bf16*)(ws + WS_OVL)); \
             nsa_compress_phase(F, BIG, args.in[IN_NSA_CMP_POS], (const bf16*)(ws + WS_W_C1), (const bf16*)(ws + WS_W_C2), (bf16*)(ws + WS_KCMP), (bf16*)(ws + WS_VCMP)); PH_END \
    PH_BEGIN nsa_attn_phase<0>(F, BIG, BIG, (const bf16*)(ws + WS_KCMP), (const bf16*)(ws + WS_VCMP), nullptr, (float*)(ws + WS_O32), nullptr, nullptr); \
             nsa_attn_phase<1>(F, BIG, BIG, (const bf16*)(ws + WS_KCMP), (const bf16*)(ws + WS_OVL), nullptr, nullptr, (float*)(ws + WS_IMP), nullptr); PH_END \
    PH_BEGIN nsa_topk_phase(F, (const float*)(ws + WS_IMP), (unsigned*)(ws + WS_SEL)); PH_END \
    PH_BEGIN nsa_attn_phase<2>(F, BIG, (const bf16*)(ws + WS_QROT), (const bf16*)(ws + WS_KSROT), nullptr, (const unsigned*)(ws + WS_SEL), (float*)(ws + WS_O32), nullptr, nullptr); PH_END \
    PH_BEGIN nsa_attn_phase<3>(F, BIG, (const bf16*)(ws + WS_QROT), (const bf16*)(ws + WS_KWROT), nullptr, nullptr, (float*)(ws + WS_O32), nullptr, Ob); PH_END
#endif
#define PH_BEGIN if (pc >= lo && pc < hi) { F.fresh();
#define PH_END   if (pc + 1 < hi) { XcdBarrier bb_ = bar; asm volatile("" : "+s"(bb_.bar), "+s"(bb_.x)); xcd_barrier(bb_); } } ++pc;
template <int l>
__device__ __forceinline__ void layer_body(Frame& F, const Args& args, const XcdBarrier& bar, int& pc, const int lo, const int hi) {
    unsigned char* ws = args.ws;
    bf16* HB = (bf16*)(ws + WS_HB); float* Y = (float*)(ws + WS_Y); float* H32 = args.out;
    bf16* BIG = (bf16*)(ws + WS_BIG); bf16* Gm = (bf16*)(ws + WS_G); bf16* Ob = (bf16*)(ws + WS_O);
    bf16* XQ = (bf16*)(ws + WS_XQ); bf16* XO = (bf16*)(ws + WS_XO);
        const float* res0 = l == 0 ? args.in[IN_X] : H32;
        PH_BEGIN {
            const int N = l == 0 ? AB_IN : NSA_INP;
            pg8::Gemm g{HB, l == 0 ? (const bf16*)(ws + WS_W_ABIN) : (const bf16*)(ws + WS_W_NSAIN), MTOK, N, DM};
            pg8::StaticOrder S; S.init(MTOK, N, F.G, F.bid);
            pg8::EpiBf16<0> E{BIG, N, nullptr, 0, 0, 1.f};
            pg8::gemm_phase<pg8::EpiBf16<0>, pg8::StaticOrder, PG8_ALIGN, PG8_SP2>(F.lds + RING_OFF, g, S, E);
        } PH_END
#if STAGE <= 1
        ZERO_OB_PHASE
#else
        if (l == 0) {
            MIXER0_PHASES
        } else {
            MIXER1_PHASES
        }
#endif
        PH_BEGIN {
            pg8::Gemm g{Ob, l == 0 ? (const bf16*)(ws + WS_W_ABOUT) : (const bf16*)(ws + WS_W_NSAOUT), MTOK, DM, DM};
            pg8::StaticOrder S; S.init(MTOK, DM, F.G, F.bid);
            pg8::EpiRes E{Y, res0, DM, DN_ALPHA};
            pg8::gemm_phase<pg8::EpiRes, pg8::StaticOrder, PG8_ALIGN, PG8_SP2>(F.lds + RING_OFF, g, S, E);
        } PH_END
        PH_BEGIN ln_phase(F, Y, args.in[IN_LN_G] + (size_t)(l * 3 + 0) * DM, args.in[IN_LN_B] + (size_t)(l * 3 + 0) * DM, H32, HB); PH_END
        PH_BEGIN {
            {   pg8::Gemm g{HB, (const bf16*)(ws + WS_W_XQ) + (size_t)l * XW * DM, MTOK, XW, DM};
                pg8::RangeOrder S; S.init(MTOK, XW, 0, 128, F.bid);
                pg8::EpiBf16<0> E{XQ, XW, nullptr, 0, 0, 1.f};
                pg8::gemm_phase<pg8::EpiBf16<0>, pg8::RangeOrder, PG8_ALIGN, PG8_SP2>(F.lds + RING_OFF, g, S, E); }
            {   pg8::Gemm g{(const bf16*)(ws + WS_MEMB), (const bf16*)(ws + WS_W_XKV) + (size_t)l * 2 * XW * DM, BATCH * NMEM, 2 * XW, DM};
                pg8::RangeOrder S; S.init(BATCH * NMEM, 2 * XW, 128, 8, F.bid);
                pg8::EpiBf16<0> E{(bf16*)(ws + WS_XKV) + (size_t)l * BATCH * NMEM * 2 * XW, 2 * XW, nullptr, 0, 0, 1.f};
                pg8::gemm_phase<pg8::EpiBf16<0>, pg8::RangeOrder, PG8_ALIGN, PG8_SP2>(F.lds + RING_OFF, g, S, E); }
        } PH_END
        PH_BEGIN xattn_phase(F, XQ, (const bf16*)(ws + WS_XKV) + (size_t)l * BATCH * NMEM * 2 * XW, XO); PH_END
        PH_BEGIN {
            pg8::Gemm g{XO, (const bf16*)(ws + WS_W_XO) + (size_t)l * DM * XW, MTOK, DM, XW};
            pg8::StaticOrder S; S.init(MTOK, DM, F.G, F.bid);
            pg8::EpiRes E{Y, H32, DM, DN_ALPHA};
            pg8::gemm_phase<pg8::EpiRes, pg8::StaticOrder, PG8_ALIGN, PG8_SP2>(F.lds + RING_OFF, g, S, E);
        } PH_END
        PH_BEGIN ln_phase(F, Y, args.in[IN_LN_G] + (size_t)(l * 3 + 1) * DM, args.in[IN_LN_B] + (size_t)(l * 3 + 1) * DM, H32, HB); PH_END
        PH_BEGIN {
            pg8::Gemm g{HB, (const bf16*)(ws + WS_W_UP) + (size_t)l * DFF2 * DM, MTOK, DFF2, DM};
            pg8::StaticOrder S; S.init(MTOK, DFF2, F.G, F.bid);
            pg8::EpiBf16<0> E{BIG, DFF2, nullptr, 0, 0, 1.f};
            pg8::gemm_phase<pg8::EpiBf16<0>, pg8::StaticOrder, PG8_ALIGN, PG8_SP2>(F.lds + RING_OFF, g, S, E);
        } PH_END
        PH_BEGIN convglu_phase(F, BIG, args.in[IN_FFN_CONV] + (size_t)l * 3 * DFF, Gm); PH_END
        PH_BEGIN {
            pg8::Gemm g{Gm, (const bf16*)(ws + WS_W_DOWN) + (size_t)l * DM * DFF, MTOK, DM, DFF};
            pg8::StaticOrder S; S.init(MTOK, DM, F.G, F.bid);
            pg8::EpiRes E{Y, H32, DM, DN_ALPHA};
            pg8::gemm_phase<pg8::EpiRes, pg8::StaticOrder, PG8_ALIGN, PG8_SP2>(F.lds + RING_OFF, g, S, E);
        } PH_END
        PH_BEGIN ln_phase(F, Y, args.in[IN_LN_G] + (size_t)(l * 3 + 2) * DM, args.in[IN_LN_B] + (size_t)(l * 3 + 2) * DM, H32, HB); PH_END
}
__global__ void __launch_bounds__(NTHR, 2) mega_fwd(Args args) {
    extern __shared__ __attribute__((aligned(16))) unsigned char lds_raw[];
    Frame F;
    F.lds = (LAS unsigned char*)lds_raw; F.ws = args.ws;
    F.tid = threadIdx.x; F.lane = F.tid & 63; F.wave = __builtin_amdgcn_readfirstlane(F.tid >> 6); F.G = gridDim.x;
    unsigned char* ws = args.ws;
    gu32* ctl = (gu32*)(ws + WS_CTL);
    for (int u = F.tid; u < (LDS_BYTES - LDSCTL_OFF) / 4; u += NTHR) ((LAS unsigned*)(F.lds + LDSCTL_OFF))[u] = 0u;
    __syncthreads();
    volatile LAS unsigned* MISC = (volatile LAS unsigned*)(F.lds + MISC_OFF);
    XcdBarrier bar = xcd_barrier_post((unsigned*)(ctl + CW_BAR), MISC + 8);
    const int lo = args.ph_lo, hi = args.ph_hi; int pc = 0;
    bf16* HB = (bf16*)(ws + WS_HB); float* Y = (float*)(ws + WS_Y); float* H32 = args.out;
    bf16* BIG = (bf16*)(ws + WS_BIG); bf16* Gm = (bf16*)(ws + WS_G); bf16* Ob = (bf16*)(ws + WS_O);
    bf16* XQ = (bf16*)(ws + WS_XQ); bf16* XO = (bf16*)(ws + WS_XO);

    PH_BEGIN p0_prologue(F, args); PH_END

    layer_body<0>(F, args, bar, pc, lo, hi);
    layer_body<1>(F, args, bar, pc, lo, hi);
}

extern "C" void kernel_launch(void* const* d_in, const int* in_sizes, int n_in, void* d_out, int out_size, void* d_ws, size_t ws_size, hipStream_t stream) {
    static int grid = 0;
    if (grid == 0) {
        if (n_in != 19 || in_sizes[0] != MTOK * DM || out_size != MTOK * DM || ws_size < WS_END) {
            fprintf(stderr, "kernel_launch: shape mismatch n_in %d in0 %d out %d ws %zu (need %zu)\n", n_in, n_in > 0 ? in_sizes[0] : -1, out_size, ws_size, (size_t)WS_END); grid = -1; return; }
        int dev = 0, cus = 0, per_cu = 0;
        if (hipGetDevice(&dev) != hipSuccess || hipDeviceGetAttribute(&cus, hipDeviceAttributeMultiprocessorCount, dev) != hipSuccess) { grid = -1; return; }
        if (hipFuncSetAttribute((const void*)mega_fwd, hipFuncAttributeMaxDynamicSharedMemorySize, LDS_BYTES) != hipSuccess) { fprintf(stderr, "kernel_launch: hipFuncSetAttribute failed\n"); grid = -1; return; }
        if (hipOccupancyMaxActiveBlocksPerMultiprocessor(&per_cu, (const void*)mega_fwd, NTHR, LDS_BYTES) != hipSuccess || per_cu < 1)
            fprintf(stderr, "kernel_launch: note: occupancy query reports %d workgroups per CU\n", per_cu);
        (void)hipGetLastError();
        grid = cus;
    }
    if (grid < 0) return;
    if (hipMemsetAsync((char*)d_ws + WS_CTL, 0, CTL_ZERO_BYTES, stream) != hipSuccess) { fprintf(stderr, "kernel_launch: memset failed\n"); return; }
    Args a{};
    for (int i = 0; i < 19; ++i) a.in[i] = (const float*)d_in[i];
    a.out = (float*)d_out; a.ws = (unsigned char*)d_ws; a.ph_lo = 0; a.ph_hi = 1 << 20;
    hipLaunchKernelGGL(mega_fwd, dim3(grid), dim3(NTHR), LDS_BYTES, stream, a);
    const hipError_t le = hipPeekAtLastError();
    if (le != hipSuccess) fprintf(stderr, "kernel_launch: launch failed: %s\n", hipGetErrorName(le));
}
```

```cpp
#include <hip/hip_runtime.h>
#include <cstdio>
#include <cstdint>
namespace pg8 {
#define PG8_LAS __attribute__((address_space(3)))
typedef unsigned short bf16_t;
typedef short bf16x8 __attribute__((ext_vector_type(8)));
typedef float f32x4 __attribute__((ext_vector_type(4)));
typedef unsigned u32x4 __attribute__((ext_vector_type(4)));
constexpr int BM = 256, BK = 64, HALF = 128, HTB = HALF * BK * 2  , STAGE_BYTES = 8 * HTB, NXCD = 8, WGM = 8;

__host__ __device__ __forceinline__ int lds_byte(int r, int c) { const int st = (r >> 4) * 2 + (c >> 5), rr = r & 15, cc = c & 31, ob = rr * 64 + cc * 2; return st * 1024 + (ob ^ (((ob >> 9) & 1) << 5)); }
__host__ __device__ __forceinline__ void stage_rc(int b, int& R, int& C) { const int st = b / 1024, sb = b % 1024, swz = sb ^ (((sb >> 9) & 1) << 5); R = (st >> 1) * 16 + swz / 64; C = (st & 1) * 32 + (swz % 64) / 2; }
__host__ __device__ __forceinline__ int perm32(int rho) { const int n = rho >> 4, i = rho & 15; return 8 * (i >> 2) + 4 * n + (i & 3); }

struct Unit { int pm, pn; };
struct Gemm { const bf16_t* A; const bf16_t* Bt; int M, N, K; };

struct StaticOrder {
    int nM, nN, nwg, G, c;
    __host__ __device__ void init(int M, int N, int G_, int c_) { nM = M / BM; nN = N / BM; nwg = nM * nN; G = G_; c = c_; }
    __host__ __device__ bool next(int i, Unit& u) const {
        const long L = (long)i * G + c; if (L >= nwg) return false;
        int wgid = (int)L; { const int q = nwg / NXCD, r = nwg % NXCD, xcd = wgid % NXCD, off = wgid / NXCD; wgid = (xcd < r ? xcd * (q + 1) : r * (q + 1) + (xcd - r) * q) + off; }
        const int nig = WGM * nN, gid = wgid / nig, fm = gid * WGM, gsz = (nM - fm) < WGM ? (nM - fm) : WGM;
        u.pm = fm + ((wgid % nig) % gsz); u.pn = (wgid % nig) / gsz; return true;
    }
    __device__ __forceinline__ void a_ready(const Unit&) const {}
    __device__ __forceinline__ void done(const Unit&) const {}
};

__device__ __forceinline__ unsigned cvt_pk_bf16(float lo, float hi) { unsigned r; asm volatile("v_cvt_pk_bf16_f32 %0, %1, %2" : "=v"(r) : "v"(lo), "v"(hi)); return r; }
typedef float f32x2 __attribute__((ext_vector_type(2)));
__device__ __forceinline__ f32x2 gelu_pk(f32x2 v) {
    const f32x2 av = __builtin_elementwise_abs(v), d = av * 0.2316418882f + 1.0f;
    f32x2 t; t.x = __builtin_amdgcn_rcpf(d.x); t.y = __builtin_amdgcn_rcpf(d.y);
    f32x2 q = t * 0.5307027145f + (-0.7265760135f); q = q * t + 0.7107068705f; q = q * t + (-0.142248368f); q = q * t + 0.127414796f; q = q * t;
    const f32x2 s = (v * v) * (-0.72134752044f);
    f32x2 e; e.x = __builtin_amdgcn_exp2f(s.x); e.y = __builtin_amdgcn_exp2f(s.y);
    const f32x2 m = v * (q * e), r = v - m;
    f32x2 o; o.x = v.x < 0.f ? m.x : r.x; o.y = v.y < 0.f ? m.y : r.y; return o;
}

template <int ACT  > struct EpiBf16 {
    static constexpr bool PERM = true, AFTER_DRAIN = false; static_assert(ACT == 0 || ACT == 1, "EpiBf16: ACT is 0 (none) or 1 (gelu_pk)");
    bf16_t* O; int ldc; const float* bias; int split_cols; size_t split_stride; float scale0;
    __device__ __forceinline__ void operator()(const f32x4 (&acc)[2][2][4][2], const Unit& u, int wr, int wc, int fr, int fq) const {
        const int row0 = u.pm * BM + wr * 64 + fr; int colt = u.pn * BM; bf16_t* base = O;
        float sc = 1.f; if (split_cols) { const int t = colt / split_cols; base += (size_t)t * split_stride; colt -= t * split_cols; if (t == 0) sc = scale0; }
        const int col0 = colt + wc * 32 + 8 * fq, bcol0 = u.pn * BM + wc * 32 + 8 * fq;
        f32x4 bv[2][2];
#pragma unroll
        for (int bj = 0; bj < 2; ++bj)
#pragma unroll
            for (int n = 0; n < 2; ++n) bv[bj][n] = bias ? *(const f32x4*)(bias + bcol0 + bj * HALF + 4 * n) : (f32x4){0.f, 0.f, 0.f, 0.f};
#pragma unroll
        for (int ai = 0; ai < 2; ++ai)
#pragma unroll
            for (int m = 0; m < 4; ++m) { bf16_t* rowp = base + (size_t)(row0 + ai * HALF + m * 16) * ldc + col0;
#pragma unroll
                for (int bj = 0; bj < 2; ++bj) { f32x4 v0 = acc[ai][bj][m][0] + bv[bj][0], v1 = acc[ai][bj][m][1] + bv[bj][1];
                    if (ACT == 1) { f32x2 a = gelu_pk((f32x2){v0[0], v0[1]}), b = gelu_pk((f32x2){v0[2], v0[3]}), c = gelu_pk((f32x2){v1[0], v1[1]}), d = gelu_pk((f32x2){v1[2], v1[3]});
                        v0 = (f32x4){a.x, a.y, b.x, b.y}; v1 = (f32x4){c.x, c.y, d.x, d.y}; }
                    v0 = v0 * sc; v1 = v1 * sc; u32x4 w; w.x = cvt_pk_bf16(v0[0], v0[1]); w.y = cvt_pk_bf16(v0[2], v0[3]); w.z = cvt_pk_bf16(v1[0], v1[1]); w.w = cvt_pk_bf16(v1[2], v1[3]);
                    *(u32x4*)(rowp + bj * HALF) = w; } }
    }
};


struct EpiRes {
    static constexpr bool PERM = false, AFTER_DRAIN = false;
    float* Y; const float* res; int ldc; float alpha;
    __device__ __forceinline__ void operator()(const f32x4 (&acc)[2][2][4][2], const Unit& u, int wr, int wc, int fr, int fq) const {
        const int row0 = u.pm * BM + wr * 64 + fr, col0 = u.pn * BM + wc * 32 + 4 * fq;
#pragma unroll
        for (int ai = 0; ai < 2; ++ai)
#pragma unroll
            for (int m = 0; m < 4; ++m) { const size_t off = (size_t)(row0 + ai * HALF + m * 16) * ldc + col0;
#pragma unroll
                for (int bj = 0; bj < 2; ++bj)
#pragma unroll
                    for (int n = 0; n < 2; ++n) { const f32x4 r = *(const f32x4*)(res + off + bj * HALF + n * 16);
                        *(f32x4*)(Y + off + bj * HALF + n * 16) = r * alpha + acc[ai][bj][m][n]; } }
    }
};
struct RangeOrder {
    int nM, nN, ntot, c0, nw, c;
    __host__ __device__ void init(int M, int N, int c0_, int nw_, int c_) { nM = M / BM; nN = N / BM; ntot = nM * nN; c0 = c0_; nw = nw_; c = c_; }
    __host__ __device__ bool next(int i, Unit& u) const {
        if (c < c0 || c >= c0 + nw) return false;
        const int L = i * nw + (c - c0); if (L >= ntot) return false;
        u.pm = L / nN; u.pn = L % nN; return true;
    }
    __device__ __forceinline__ void a_ready(const Unit&) const {}
    __device__ __forceinline__ void done(const Unit&) const {}
};

struct ZeroOrder : StaticOrder {
    __host__ __device__ bool next(int i, Unit& u) const { const bool r = StaticOrder::next(i, u); u.pm = 0; u.pn = 0; return r; }
};
template <class Epi, class Sched, bool ALIGN_EPI = false, bool SP2 = false>
__device__ __forceinline__ void gemm_phase(PG8_LAS unsigned char* lds, const Gemm g, const Sched& S, const Epi& E) {
    int tid_l = threadIdx.x; asm volatile("" : "+v"(tid_l)); const int tid = tid_l, wid = __builtin_amdgcn_readfirstlane(tid >> 6), lane = tid & 63, wr = wid >> 2, wc = wid & 3, fr = lane & 15, fq = lane >> 4;
    const int K = g.K, nt = K / BK;
    unsigned voffA[2], voffB[2];
#pragma unroll
    for (int i = 0; i < 2; ++i) { int R, C; stage_rc(tid * 16 + i * 8192, R, C); const int Rb = Epi::PERM ? ((R & ~31) + perm32(R & 31)) : R;
        voffA[i] = (unsigned)(R * K + C) * 2u; voffB[i] = (unsigned)(Rb * K + C) * 2u; }
    const size_t kstep = (size_t)(BK * 2);
    const size_t hstep = (size_t)HALF * K * 2;
    const size_t tstep = 2 * hstep;
    const unsigned ldsw = (unsigned)wid * 1024u;
    const int aoff = lds_byte(wr * 64 + fr, fq * 8), boff = lds_byte(wc * 32 + fr, fq * 8);
#define PG8_SA(b, h) (((b) * 2 + (h)) * HTB)
#define PG8_SB(b, h) ((4 + (b) * 2 + (h)) * HTB)
#define PG8_STAGE(bufoff, gbase, voff) do { _Pragma("unroll") for (int _i = 0; _i < 2; ++_i) \
        __builtin_amdgcn_global_load_lds((const unsigned*)((const char*)(gbase) + (voff)[_i]), (PG8_LAS unsigned*)(lds + (bufoff) + ldsw + _i * 8192), 16, 0, 0); } while (0)
#define PG8_LDA(dst, b, h) do { _Pragma("unroll") for (int m = 0; m < 4; ++m) _Pragma("unroll") for (int k = 0; k < 2; ++k) dst[m][k] = *(const PG8_LAS bf16x8*)(lds + PG8_SA(b, h) + aoff + m * 2048 + k * 1024); } while (0)
#define PG8_LDB(dst, b, h) do { _Pragma("unroll") for (int n = 0; n < 2; ++n) _Pragma("unroll") for (int k = 0; k < 2; ++k) dst[n][k] = *(const PG8_LAS bf16x8*)(lds + PG8_SB(b, h) + boff + n * 2048 + k * 1024); } while (0)
#define PG8_MMA(ai, bj, At, Bt) do { __builtin_amdgcn_s_setprio(1); _Pragma("unroll") for (int m = 0; m < 4; ++m) _Pragma("unroll") for (int n = 0; n < 2; ++n) _Pragma("unroll") for (int k = 0; k < 2; ++k) \
        acc[ai][bj][m][n] = __builtin_amdgcn_mfma_f32_16x16x32_bf16(Bt[n][k], At[m][k], acc[ai][bj][m][n], 0, 0, 0); __builtin_amdgcn_s_setprio(0); } while (0)
#define PG8_WAIT_V(n) asm volatile("s_waitcnt vmcnt(" #n ")" ::: "memory")
#define PG8_WAIT_L(n) asm volatile("s_waitcnt lgkmcnt(" #n ")" ::: "memory")
#define PG8_BAR __builtin_amdgcn_s_barrier()
#define PG8_SCHED __builtin_amdgcn_sched_barrier(0)
    Unit cur, nxt; int ui = 0;
    if (!S.next(0, cur)) return;
    f32x4 acc[2][2][4][2];
#pragma unroll
    for (int a = 0; a < 2; ++a)
#pragma unroll
        for (int b = 0; b < 2; ++b)
#pragma unroll
            for (int m = 0; m < 4; ++m)
#pragma unroll
                for (int n = 0; n < 2; ++n) acc[a][b][m][n] = (f32x4){0.f, 0.f, 0.f, 0.f};
    bf16x8 At[4][2], B0[2][2], B1[2][2];
    const char* cA = (const char*)g.A + (size_t)cur.pm * tstep; const char* cB = (const char*)g.Bt + (size_t)cur.pn * tstep;
    S.a_ready(cur);
    if constexpr (SP2) {
        PG8_STAGE(PG8_SB(0, 0), cB, voffB); PG8_STAGE(PG8_SB(0, 1), cB + hstep, voffB); PG8_STAGE(PG8_SA(0, 0), cA, voffA); PG8_STAGE(PG8_SA(0, 1), cA + hstep, voffA);
        if (wr == 1) PG8_BAR;
        PG8_WAIT_V(2); PG8_BAR;
        PG8_STAGE(PG8_SB(1, 0), cB + kstep, voffB); PG8_STAGE(PG8_SA(1, 0), cA + kstep, voffA); PG8_STAGE(PG8_SB(1, 1), cB + hstep + kstep, voffB);
        PG8_WAIT_V(6); PG8_BAR;
    } else {
        PG8_STAGE(PG8_SB(0, 0), cB, voffB); PG8_STAGE(PG8_SA(0, 0), cA, voffA); PG8_STAGE(PG8_SB(0, 1), cB + hstep, voffB); PG8_STAGE(PG8_SA(0, 1), cA + hstep, voffA);
        if (wr == 1) PG8_BAR;
        PG8_WAIT_V(4); PG8_BAR;
        PG8_STAGE(PG8_SB(1, 0), cB + kstep, voffB); PG8_STAGE(PG8_SA(1, 0), cA + kstep, voffA); PG8_STAGE(PG8_SB(1, 1), cB + hstep + kstep, voffB);
        PG8_WAIT_V(6); PG8_BAR;
    }
    for (;;) {
        const bool has_next = S.next(ui + 1, nxt);
        const char* nA = has_next ? (const char*)g.A + (size_t)nxt.pm * tstep : cA; const char* nB = has_next ? (const char*)g.Bt + (size_t)nxt.pn * tstep : cB;
        for (int t = 0; t < nt; t += 2) {
            const bool last = (t == nt - 2);
            const char* a1 = cA + (size_t)(t + 1) * kstep;
            const char* a2 = last ? nA : cA + (size_t)(t + 2) * kstep; const char* b2 = last ? nB : cB + (size_t)(t + 2) * kstep;
            const char* a3 = a2 + kstep; const char* b3 = b2 + kstep;
            if (last && has_next) S.a_ready(nxt);
            if constexpr (SP2) {
            PG8_LDB(B0, 0, 0); PG8_LDB(B1, 0, 1); PG8_SCHED; PG8_LDA(At, 0, 0); PG8_STAGE(PG8_SA(1, 1), a1 + hstep, voffA);
            PG8_WAIT_V(8); PG8_WAIT_L(0); PG8_BAR; PG8_MMA(0, 0, At, B0); PG8_MMA(0, 1, At, B1); PG8_BAR; PG8_SCHED;
            PG8_LDA(At, 0, 1); PG8_STAGE(PG8_SB(0, 0), b2, voffB); PG8_STAGE(PG8_SB(0, 1), b2 + hstep, voffB); PG8_STAGE(PG8_SA(0, 0), a2, voffA);
            PG8_WAIT_V(8); PG8_WAIT_L(0); PG8_BAR; PG8_MMA(1, 0, At, B0); PG8_MMA(1, 1, At, B1); PG8_BAR; PG8_SCHED;
            PG8_LDB(B0, 1, 0); PG8_LDB(B1, 1, 1); PG8_SCHED; PG8_LDA(At, 1, 0); PG8_STAGE(PG8_SA(0, 1), a2 + hstep, voffA);
            PG8_WAIT_V(8); PG8_WAIT_L(0); PG8_BAR; PG8_MMA(0, 0, At, B0); PG8_MMA(0, 1, At, B1); PG8_BAR; PG8_SCHED;
            PG8_LDA(At, 1, 1); PG8_STAGE(PG8_SB(1, 0), b3, voffB); PG8_STAGE(PG8_SB(1, 1), b3 + hstep, voffB); PG8_STAGE(PG8_SA(1, 0), a3, voffA);
            PG8_WAIT_V(8); PG8_WAIT_L(0); PG8_BAR; PG8_MMA(1, 0, At, B0); PG8_MMA(1, 1, At, B1); PG8_BAR; PG8_SCHED;
            } else {
            PG8_LDB(B0, 0, 0); PG8_SCHED; PG8_LDA(At, 0, 0); PG8_STAGE(PG8_SA(1, 1), a1 + hstep, voffA);
            PG8_WAIT_L(8); PG8_BAR; PG8_WAIT_L(0); PG8_MMA(0, 0, At, B0); PG8_BAR; PG8_SCHED;
            PG8_LDB(B1, 0, 1); PG8_STAGE(PG8_SB(0, 0), b2, voffB);
            PG8_BAR; PG8_WAIT_L(0); PG8_MMA(0, 1, At, B1); PG8_BAR;
            PG8_LDA(At, 0, 1); PG8_STAGE(PG8_SA(0, 0), a2, voffA);
            PG8_BAR; PG8_WAIT_L(0); PG8_MMA(1, 0, At, B0); PG8_BAR; PG8_SCHED;
            PG8_STAGE(PG8_SB(0, 1), b2 + hstep, voffB);
            PG8_WAIT_V(6); PG8_BAR; PG8_MMA(1, 1, At, B1); PG8_BAR;
            PG8_LDB(B0, 1, 0); PG8_SCHED; PG8_LDA(At, 1, 0); PG8_STAGE(PG8_SA(0, 1), a2 + hstep, voffA);
            PG8_WAIT_L(8); PG8_BAR; PG8_WAIT_L(0); PG8_MMA(0, 0, At, B0); PG8_BAR; PG8_SCHED;
            PG8_LDB(B1, 1, 1); PG8_STAGE(PG8_SB(1, 0), b3, voffB);
            PG8_BAR; PG8_WAIT_L(0); PG8_MMA(0, 1, At, B1); PG8_BAR;
            PG8_LDA(At, 1, 1); PG8_STAGE(PG8_SA(1, 0), a3, voffA);
            PG8_BAR; PG8_WAIT_L(0); PG8_MMA(1, 0, At, B0); PG8_BAR; PG8_SCHED;
            PG8_STAGE(PG8_SB(1, 1), b3 + hstep, voffB);
            PG8_WAIT_V(6); PG8_BAR; PG8_MMA(1, 1, At, B1); PG8_BAR;
            }
        }
        if constexpr (ALIGN_EPI) { if (wr == 0) PG8_BAR; }
        if constexpr (!Epi::AFTER_DRAIN) { E(acc, cur, wr, wc, fr, fq); S.done(cur); }
        if (!has_next) break;
#pragma unroll
        for (int a = 0; a < 2; ++a)
#pragma unroll
            for (int b = 0; b < 2; ++b)
#pragma unroll
                for (int m = 0; m < 4; ++m)
#pragma unroll
                    for (int n = 0; n < 2; ++n) acc[a][b][m][n] = (f32x4){0.f, 0.f, 0.f, 0.f};
        cur = nxt; cA = nA; cB = nB; ++ui;
        if constexpr (ALIGN_EPI) { if (wr == 1) PG8_BAR; }
    }
    PG8_WAIT_V(0);
    if constexpr (!ALIGN_EPI) { if (wr == 0) PG8_BAR; }
    PG8_BAR;
    if constexpr (Epi::AFTER_DRAIN) { E.fused(acc, cur, wr, wc, fr, fq, lds, wid, lane); S.done(cur); }
#undef PG8_SA
#undef PG8_SB
#undef PG8_STAGE
#undef PG8_LDA
#undef PG8_LDB
#undef PG8_MMA
#undef PG8_WAIT_V
#undef PG8_WAIT_L
#undef PG8_BAR
#undef PG8_SCHED
}
}

#ifndef PG8_SP2
#define PG8_SP2 true
#endif
#ifndef PG8_ALIGN
#define PG8_ALIGN true
#endif
constexpr int NWAVES = 8, NTHR = 512;
constexpr int BATCH = 2, SEQ = 8192, DM = 4096, MTOK = BATCH * SEQ;
constexpr int HD = 128;
constexpr int A_HEADS = 16, B_HEADS = 16, A_W = 2048, B_W = 2048, AB_IN = 4 * A_W + 3 * B_W;
constexpr int NSA_H = 32, NSA_G = 4, NSA_R = 8, KVW = 512, NSA_IN = 4096 + 6 * KVW + 96, NSA_INP = 7424;
constexpr int NCMP = 511, NCMPP = 512, NSLC = 128, NTOP = 16, WINDOW = 512;
constexpr int NMEM = 256, XH = 4, XW = 512;
constexpr int DFF = 11008, DFF2 = 22016;
constexpr float LN_EPS = 1e-5f, RMS_EPS = 1e-6f;
constexpr float DN_ALPHA = 1.41421356237309515f;
constexpr size_t MiB = (size_t)1 << 20;
constexpr size_t WS_CTL = 0, CTL_ZERO_BYTES = 1 * MiB;
constexpr size_t WS_W_ABIN = 1 * MiB;
constexpr size_t WS_W_ABOUT = WS_W_ABIN + 112 * MiB;
constexpr size_t WS_W_NSAIN = WS_W_ABOUT + 32 * MiB;
constexpr size_t WS_W_NSAOUT = WS_W_NSAIN + 58 * MiB;
constexpr size_t WS_W_XQ = WS_W_NSAOUT + 32 * MiB;
constexpr size_t WS_W_XKV = WS_W_XQ + 8 * MiB;
constexpr size_t WS_W_XO = WS_W_XKV + 16 * MiB;
constexpr size_t WS_W_UP = WS_W_XO + 8 * MiB;
constexpr size_t WS_W_DOWN = WS_W_UP + 344 * MiB;
constexpr size_t WS_W_C1 = WS_W_DOWN + 172 * MiB;
constexpr size_t WS_W_C2 = WS_W_C1 + 2 * MiB;
constexpr size_t WS_MEMB = WS_W_C2 + 1 * MiB;
constexpr size_t WS_HB = WS_MEMB + 4 * MiB;
constexpr size_t WS_Y = WS_HB + 128 * MiB;
constexpr size_t WS_BIG = WS_Y + 256 * MiB;
constexpr size_t WS_G = WS_BIG + 688 * MiB;
constexpr size_t WS_O = WS_G + 344 * MiB;
constexpr size_t WS_MISC = WS_O + 128 * MiB;
constexpr size_t WS_END = WS_MISC + 64 * MiB;
constexpr size_t WS_XQ = WS_MISC;
constexpr size_t WS_XO = WS_MISC + 16 * MiB;
constexpr size_t WS_XKV = WS_MISC + 32 * MiB;
constexpr size_t WS_LB = WS_MISC + 34 * MiB;
constexpr size_t WS_PROJ0 = WS_BIG;
constexpr size_t WS_SPREV = WS_BIG + 448 * MiB;
constexpr size_t WS_QT = WS_G;
constexpr size_t WS_OINTRA = WS_G + 64 * MiB;
constexpr size_t WS_DEC = WS_G + 192 * MiB;
constexpr size_t WS_DS = WS_Y;
constexpr size_t WS_PROJ1 = WS_BIG;
constexpr size_t WS_QROT = WS_BIG + 232 * MiB;
constexpr size_t WS_KSROT = WS_BIG + 360 * MiB;
constexpr size_t WS_KWROT = WS_BIG + 376 * MiB;
constexpr size_t WS_KCMP = WS_BIG + 392 * MiB;
constexpr size_t WS_VCMP = WS_BIG + 393 * MiB;
constexpr size_t WS_OVL = WS_BIG + 394 * MiB;
constexpr size_t WS_SEL = WS_BIG + 395 * MiB;
constexpr size_t WS_IMP = WS_Y;
constexpr size_t WS_O32 = WS_G;
static_assert(WS_SPREV + 128 * MiB <= WS_G && WS_DEC + 2 * MiB <= WS_O && WS_SEL + MiB <= WS_G, "ws map");
constexpr int CW_TMO = 0, CW_CODE = 1;
constexpr int CW_BAR = 4096;
constexpr int RING_OFF = 0, RING_BYTES = 131072;
constexpr int LDSCTL_OFF = RING_BYTES, MISC_OFF = LDSCTL_OFF + 320;
constexpr int LDS_BYTES = 147456;
static_assert(MISC_OFF + 128 <= LDS_BYTES, "LDS map");

#define GAS __attribute__((address_space(1)))
#define LAS __attribute__((address_space(3)))
typedef unsigned short bf16;
typedef unsigned v4u __attribute__((ext_vector_type(4)));
typedef unsigned v2u __attribute__((ext_vector_type(2)));
typedef float f32x4 __attribute__((ext_vector_type(4)));
typedef float f32x2 __attribute__((ext_vector_type(2)));
typedef float f32x16 __attribute__((ext_vector_type(16)));
typedef short bf16x8 __attribute__((ext_vector_type(8)));
typedef short s16x4 __attribute__((ext_vector_type(4)));
typedef GAS unsigned gu32;
#define RLX_AGENT __ATOMIC_RELAXED, __HIP_MEMORY_SCOPE_AGENT
#define LDS_WAIT() asm volatile("s_waitcnt lgkmcnt(0)" ::: "memory")
#define VM_WAIT() asm volatile("s_waitcnt vmcnt(0)" ::: "memory")
#define SBAR() __builtin_amdgcn_sched_barrier(0)
__device__ __forceinline__ unsigned f2bf(float f) { unsigned u = __builtin_bit_cast(unsigned, f); return (u + 0x7fffu + ((u >> 16) & 1u)) >> 16; }
__device__ __forceinline__ unsigned pk2(float lo, float hi) { return f2bf(lo) | (f2bf(hi) << 16); }
__device__ __forceinline__ float bf2f(unsigned short b) { return __builtin_bit_cast(float, (unsigned)b << 16); }
__device__ __forceinline__ float bflo(unsigned w) { return __builtin_bit_cast(float, w << 16); }
__device__ __forceinline__ float bfhi(unsigned w) { return __builtin_bit_cast(float, w & 0xffff0000u); }
__device__ __forceinline__ unsigned cvtpk(float lo, float hi) { unsigned r; asm volatile("v_cvt_pk_bf16_f32 %0, %1, %2" : "=v"(r) : "v"(lo), "v"(hi)); return r; }
__device__ __forceinline__ float wave_sum(float v) {
#pragma unroll
    for (int o = 1; o < 64; o <<= 1) v += __shfl_xor(v, o);
    return v;
}
__device__ __forceinline__ float sigmoidf_(float x) { return __builtin_amdgcn_rcpf(1.f + __builtin_amdgcn_exp2f(-1.4426950408889634f * x)); }
__device__ __forceinline__ float gelu1(float v) { pg8::f32x2 r = pg8::gelu_pk((pg8::f32x2){v, 0.f}); return r.x; }
#define XB_TMO      128
#define XB_XCNT(j)  (256  + 64 * (j))
#define XB_XSUB(j)  (1280 + 64 * (j))
#define XB_XGEN(j)  (2304 + 64 * (j))
#define XB_TOP      3328
#define XB_TOPGEN   3392
#define XCD_BAR_WORDS 3456
#define XB_SPIN_CAP (1u << 18)
#define LAS __attribute__((address_space(3)))

__device__ __forceinline__ unsigned xb_ld(unsigned* p)              { return __hip_atomic_load(p, __ATOMIC_RELAXED, __HIP_MEMORY_SCOPE_AGENT); }
__device__ __forceinline__ unsigned xb_add(unsigned* p, unsigned v) { return __hip_atomic_fetch_add(p, v, __ATOMIC_RELAXED, __HIP_MEMORY_SCOPE_AGENT); }
__device__ __forceinline__ unsigned xb_xcc_id() { return (unsigned)__builtin_amdgcn_s_getreg((3 << 11) | 20) & 0xFu; }
#define XB_SPIN(cond, bar) do { unsigned _sp = 0; while (cond) { __builtin_amdgcn_s_sleep(1); \
    if ((++_sp & 255u) == 0u) { if (xb_ld(&(bar)[XB_TMO])) break; if (_sp > XB_SPIN_CAP) { atomicAdd(&(bar)[XB_TMO], 1u); break; } } } } while (0)

struct XcdBarrier {
    unsigned* bar; unsigned x;
    volatile LAS unsigned* st;
};

__device__ __forceinline__ XcdBarrier xcd_barrier_post(unsigned* bar, volatile LAS unsigned* st) {
    XcdBarrier b; b.bar = bar; b.x = xb_xcc_id(); b.st = st;
    if (threadIdx.x == 0) (void)xb_add(&bar[XB_XCNT(b.x)], 1u);
    return b;
}
__device__ __forceinline__ void xcd_barrier_complete(unsigned* bar, unsigned x, unsigned& nloc, unsigned& nx) {
    const unsigned G = gridDim.x * gridDim.y * gridDim.z;
    unsigned sum, cnt, mine, sp = 0u;
    for (;;) {
        sum = 0u; cnt = 0u; mine = 0u;
#pragma unroll
        for (unsigned j = 0; j < 16; ++j) { const unsigned c = xb_ld(&bar[XB_XCNT(j)]); sum += c; cnt += (c > 0u) ? 1u : 0u; mine = (j == x) ? c : mine; }
        if (sum == G) break;
        __builtin_amdgcn_s_sleep(1);
        if ((++sp & 255u) == 0u) { if (xb_ld(&bar[XB_TMO])) break; if (sp > XB_SPIN_CAP) { atomicAdd(&bar[XB_TMO], 1u); break; } }
    }
    nloc = mine > 0u ? mine : 1u; nx = cnt > 0u ? cnt : 1u;
}

__device__ __forceinline__ void xcd_barrier(const XcdBarrier& b) {
    asm volatile("s_waitcnt vmcnt(0)" ::: "memory");
    __syncthreads();
    if (threadIdx.x == 0) {
        unsigned* bar = b.bar;
        __builtin_amdgcn_s_waitcnt(0);
        unsigned nloc = b.st[0], nx = b.st[1];
        if (nloc == 0u) { xcd_barrier_complete(bar, b.x, nloc, nx); b.st[0] = nloc; b.st[1] = nx; }
        const unsigned old = xb_add(&bar[XB_XSUB(b.x)], 1u);
        const unsigned gen = old / nloc;
        if (old + 1u == (gen + 1u) * nloc) {
            __builtin_amdgcn_fence(__ATOMIC_RELEASE, "agent");
            asm volatile("s_waitcnt vmcnt(0)" ::: "memory");
            const unsigned og = xb_add(&bar[XB_TOP], 1u);
            const unsigned tg = og / nx;
            if (og + 1u == (tg + 1u) * nx) xb_add(&bar[XB_TOPGEN], 1u);
            else XB_SPIN(xb_ld(&bar[XB_TOPGEN]) == tg, bar);
            __builtin_amdgcn_fence(__ATOMIC_ACQUIRE, "agent");
            xb_add(&bar[XB_XGEN(b.x)], 1u);
            asm volatile("s_waitcnt vmcnt(0)" ::: "memory");
        } else {
            XB_SPIN(xb_ld(&bar[XB_XGEN(b.x)]) == gen, bar);
            __builtin_amdgcn_fence(__ATOMIC_ACQUIRE, "agent");
            asm volatile("s_waitcnt vmcnt(0)" ::: "memory");
        }
    }
    __syncthreads();
}


constexpr int ATT_D = 128, KVBLK = 64;
constexpr int SHM_V = KVBLK * ATT_D * 2, SHM_K = KVBLK * ATT_D * 2;
constexpr int ATT_K_OFF = 0, ATT_V_OFF = SHM_K, ATT_BUF = SHM_K + SHM_V, ATT_WS_OFF = 2 * ATT_BUF;
constexpr int ATT_X_OFF = ATT_WS_OFF + NWAVES * 256;
#define KSWZ(row, colB) ((row) * 256 + ((colB) ^ (((row) & 7) << 4)))
__device__ __forceinline__ int crow(int r, int hi) { return (r & 3) + 8 * (r >> 2) + 4 * hi; }
__device__ __forceinline__ int v_st(int k, int c) { const int kk = (k & ~0xC) | ((k & 4) << 1) | ((k & 8) >> 1); return ((kk >> 3) * 4 + (c >> 5)) * 512 + ((kk & 7) * 32 + (c & 31)) * 2; }
__device__ __forceinline__ int v_rd_base(int lane) { return ((lane & 3) << 3) | (((lane >> 2) & 3) << 6) | (((lane >> 4) & 1) << 5) | (((lane >> 5) & 1) << 8); }
constexpr int v_rd_off(int d0, int ks, int half) { return d0 * 512 + ks * 4096 + half * 2048; }
template <int OFF> __device__ __forceinline__ s16x4 tr_read(int vb) {
  s16x4 r; asm volatile("ds_read_b64_tr_b16 %0, %1 offset:%2" : "=&v"(r) : "v"(vb), "i"(OFF) : "memory"); return r;
}
__device__ __forceinline__ void qkt(f32x16& p0, f32x16& p1, const LAS char* Ks, const bf16x8* qr, int r32, int hi) {
  p0 = f32x16{}; p1 = f32x16{};
#pragma unroll
  for (int d0 = 0; d0 < 8; ++d0) { const int cb = (d0 * 16 + hi * 8) * 2;
    const bf16x8 b0 = *(const LAS bf16x8*)(Ks + KSWZ(r32, cb));
    const bf16x8 b1 = *(const LAS bf16x8*)(Ks + KSWZ(32 + r32, cb));
    p0 = __builtin_amdgcn_mfma_f32_32x32x16_bf16(b0, qr[d0], p0, 0, 0, 0);
    p1 = __builtin_amdgcn_mfma_f32_32x32x16_bf16(b1, qr[d0], p1, 0, 0, 0); }
}
__device__ __forceinline__ void pack_p(const f32x16& p0, const f32x16& p1, bf16x8& pa0, bf16x8& pa1, bf16x8& pa2, bf16x8& pa3) {
#define PK4(P, BASE, OUT) do { unsigned a0 = cvtpk(P[BASE + 0], P[BASE + 1]), a1 = cvtpk(P[BASE + 2], P[BASE + 3]);   \
    unsigned b0 = cvtpk(P[BASE + 4], P[BASE + 5]), b1 = cvtpk(P[BASE + 6], P[BASE + 7]);                              \
    auto r0 = __builtin_amdgcn_permlane32_swap(a0, b0, false, false); auto r1 = __builtin_amdgcn_permlane32_swap(a1, b1, false, false); \
    v4u w = {r0[0], r1[0], r0[1], r1[1]}; OUT = __builtin_bit_cast(bf16x8, w); } while (0)
  PK4(p0, 0, pa0); PK4(p0, 8, pa1); PK4(p1, 0, pa2); PK4(p1, 8, pa3);
#undef PK4
}
template <int D0> __device__ __forceinline__ void pv_one(f32x16& od, int vb, bf16x8 pa0, bf16x8 pa1, bf16x8 pa2, bf16x8 pa3) {
  const s16x4 l0 = tr_read<v_rd_off(D0, 0, 0)>(vb), h0 = tr_read<v_rd_off(D0, 0, 1)>(vb), l1 = tr_read<v_rd_off(D0, 1, 0)>(vb), h1 = tr_read<v_rd_off(D0, 1, 1)>(vb);
  const s16x4 l2 = tr_read<v_rd_off(D0, 2, 0)>(vb), h2 = tr_read<v_rd_off(D0, 2, 1)>(vb), l3 = tr_read<v_rd_off(D0, 3, 0)>(vb), h3 = tr_read<v_rd_off(D0, 3, 1)>(vb);
  asm volatile("s_waitcnt lgkmcnt(0)" ::: "memory"); SBAR();
#define PKV(L, H) (bf16x8){L[0], L[1], L[2], L[3], H[0], H[1], H[2], H[3]}
  od = __builtin_amdgcn_mfma_f32_32x32x16_bf16(pa0, PKV(l0, h0), od, 0, 0, 0);
  od = __builtin_amdgcn_mfma_f32_32x32x16_bf16(pa1, PKV(l1, h1), od, 0, 0, 0);
  od = __builtin_amdgcn_mfma_f32_32x32x16_bf16(pa2, PKV(l2, h2), od, 0, 0, 0);
  od = __builtin_amdgcn_mfma_f32_32x32x16_bf16(pa3, PKV(l3, h3), od, 0, 0, 0);
#undef PKV
}
__device__ __forceinline__ void pv_d0(f32x16* o, int vb, bf16x8 pa0, bf16x8 pa1, bf16x8 pa2, bf16x8 pa3) {
  pv_one<0>(o[0], vb, pa0, pa1, pa2, pa3); pv_one<1>(o[1], vb, pa0, pa1, pa2, pa3); pv_one<2>(o[2], vb, pa0, pa1, pa2, pa3); pv_one<3>(o[3], vb, pa0, pa1, pa2, pa3);
}
struct KVStage { bf16x8 ks0, ks1, vs0, vs1; };
__device__ __forceinline__ void kv_load(KVStage& s, const bf16* Kh, const bf16* Vh, long ldk, long ldv, int k0, int sr, int sc) {
  s.ks0 = *(const bf16x8*)(Kh + (long)(k0 + sr) * ldk + sc); s.ks1 = *(const bf16x8*)(Kh + (long)(k0 + 32 + sr) * ldk + sc);
  s.vs0 = *(const bf16x8*)(Vh + (long)(k0 + sr) * ldv + sc); s.vs1 = *(const bf16x8*)(Vh + (long)(k0 + 32 + sr) * ldv + sc);
}
__device__ __forceinline__ void kv_write(const KVStage& s, LAS char* lds, int sr, int sc) {
  *(LAS bf16x8*)(lds + ATT_V_OFF + v_st(sr, sc)) = s.vs0; *(LAS bf16x8*)(lds + ATT_V_OFF + v_st(32 + sr, sc)) = s.vs1;
  *(LAS bf16x8*)(lds + ATT_K_OFF + KSWZ(sr, sc * 2)) = s.ks0; *(LAS bf16x8*)(lds + ATT_K_OFF + KSWZ(32 + sr, sc * 2)) = s.ks1;
}
struct KVDma { int ko[2], vo[2]; };
__device__ __forceinline__ void kv_dma_init(KVDma& d, int ldk, int ldv, int wid, int lane) {
#pragma unroll
  for (int i = 0; i < 2; ++i) { const int p = wid * 2 + i;
    const int row = p * 4 + (lane >> 4), cp = lane & 15; d.ko[i] = row * ldk + ((cp ^ (row & 7)) << 3);
    const int sub = p * 2 + (lane >> 5), kk = (sub >> 2) * 8 + ((lane & 31) >> 2), k = (kk & ~0xC) | ((kk & 4) << 1) | ((kk & 8) >> 1), c = (sub & 3) * 32 + (lane & 3) * 8;
    d.vo[i] = k * ldv + c; }
}
__device__ __forceinline__ void kv_dma(const KVDma& d, const bf16* Kt, const bf16* Vt, LAS char* lds, int buf, int wid) {
#pragma unroll
  for (int i = 0; i < 2; ++i) {
    __builtin_amdgcn_global_load_lds((const unsigned*)(Kt + d.ko[i]), (LAS unsigned*)(lds + buf + ATT_K_OFF + (wid * 2 + i) * 1024), 16, 0, 0);
    __builtin_amdgcn_global_load_lds((const unsigned*)(Vt + d.vo[i]), (LAS unsigned*)(lds + buf + ATT_V_OFF + (wid * 2 + i) * 1024), 16, 0, 0); }
}
__device__ __forceinline__ void rescale_o(f32x16* o, float a, LAS float* al_l, int r32, int hi) {
  if (__any(a < 1.f)) { if (hi == 0) al_l[r32] = a; LDS_WAIT();
#pragma unroll
    for (int r = 0; r < 16; ++r) { const float f = al_l[crow(r, hi)];
#pragma unroll
      for (int d = 0; d < 4; ++d) o[d][r] *= f; }
    LDS_WAIT(); }
}
constexpr float ATT_SCALE = 0.088388347648318440f, ATT_C = ATT_SCALE * 1.4426950408889634f, ATT_THR = 8.f;
template <bool MASKED>
__device__ __forceinline__ void softmax_tile(f32x16& p0, f32x16& p1, unsigned vm0, unsigned vm1, float& m_reg, float& l_reg, float& alpha) {
  if (MASKED) {
#pragma unroll
    for (int r = 0; r < 16; ++r) { p0[r] = ((vm0 >> r) & 1u) ? p0[r] : -1e30f; p1[r] = ((vm1 >> r) & 1u) ? p1[r] : -1e30f; }
  }
  float pmax = p0[0];
#pragma unroll
  for (int r = 1; r < 16; ++r) pmax = fmaxf(pmax, p0[r]);
#pragma unroll
  for (int r = 0; r < 16; ++r) pmax = fmaxf(pmax, p1[r]);
  { auto rr = __builtin_amdgcn_permlane32_swap(__float_as_uint(pmax), __float_as_uint(pmax), false, false);
    pmax = fmaxf(__uint_as_float(rr[0]), __uint_as_float(rr[1])); }
  float mn;
  if (__all(pmax - m_reg <= ATT_THR / ATT_SCALE)) { mn = m_reg; alpha = 1.f; }
  else { mn = fmaxf(m_reg, pmax); alpha = __builtin_amdgcn_exp2f((m_reg - mn) * ATT_C); m_reg = mn; }
  const float mnC = -mn * ATT_C;
#pragma unroll
  for (int r = 0; r < 16; ++r) { p0[r] = __builtin_amdgcn_exp2f(fmaf(p0[r], ATT_C, mnC)); p1[r] = __builtin_amdgcn_exp2f(fmaf(p1[r], ATT_C, mnC)); }
  if (MASKED) {
#pragma unroll
    for (int r = 0; r < 16; ++r) { p0[r] = ((vm0 >> r) & 1u) ? p0[r] : 0.f; p1[r] = ((vm1 >> r) & 1u) ? p1[r] : 0.f; }
  }
  float ps = 0.f;
#pragma unroll
  for (int r = 0; r < 16; ++r) ps += p0[r] + p1[r];
  { auto rr = __builtin_amdgcn_permlane32_swap(__float_as_uint(ps), __float_as_uint(ps), false, false);
    ps = __uint_as_float(rr[0]) + __uint_as_float(rr[1]); }
  l_reg = l_reg * alpha + ps;
}
__device__ __forceinline__ void load_q(bf16x8* qr, const bf16* Qw) {
#pragma unroll
  for (int d0 = 0; d0 < 8; ++d0) qr[d0] = *(const bf16x8*)(Qw + d0 * 16);
}

struct Frame {
    LAS unsigned char* lds;
    unsigned char* ws;
    int tid, lane, wave, G, bid;
    __device__ __forceinline__ void fresh() { int t = threadIdx.x; asm volatile("" : "+v"(t)); tid = t; lane = t & 63; wave = __builtin_amdgcn_readfirstlane(t >> 6);
        int g_ = gridDim.x, b_ = blockIdx.x; asm volatile("" : "+s"(g_), "+s"(b_)); G = g_; bid = b_; }
};
struct Args { const float* in[19]; float* out; unsigned char* ws; int ph_lo, ph_hi; };
enum { IN_X = 0, IN_MEM, IN_AB_W_IN, IN_HGRN_LB, IN_HGRN_NW, IN_AB_W_OUT, IN_NSA_W_IN, IN_NSA_CMP_POS, IN_NSA_CMP_W1, IN_NSA_CMP_W2, IN_NSA_W_OUT,
       IN_XA_WQ, IN_XA_WKV, IN_XA_WO, IN_FFN_UP, IN_FFN_CONV, IN_FFN_DOWN, IN_LN_G, IN_LN_B };

__device__ __forceinline__ void p0_transpose_item(const float* W, int K, int N, bf16* WT, LAS float* scr, int item, int lane) {
    const int nblk = N / 32, kb = item / nblk, nb = item % nblk, k0 = 64 * kb, n0 = 32 * nb;
#pragma unroll 8
    for (int i = 0; i < 32; ++i) { const int kk = 2 * i + (lane >> 5); scr[kk * 33 + (lane & 31)] = W[(size_t)(k0 + kk) * N + n0 + (lane & 31)]; }
    LDS_WAIT(); asm volatile("" ::: "memory");
    const int c = lane & 7;
#pragma unroll
    for (int j = 0; j < 4; ++j) { const int n = (lane >> 3) + 8 * j; const LAS float* s = scr + (8 * c) * 33 + n;
        v4u o; o.x = pk2(s[0 * 33], s[1 * 33]); o.y = pk2(s[2 * 33], s[3 * 33]); o.z = pk2(s[4 * 33], s[5 * 33]); o.w = pk2(s[6 * 33], s[7 * 33]);
        *(GAS v4u*)(WT + (size_t)(n0 + n) * K + k0 + 8 * c) = o; }
    LDS_WAIT(); asm volatile("" ::: "memory");
}
__device__ __forceinline__ void transpose_mat(Frame& F, const float* W, int K, int N, bf16* WT) {
    LAS float* scr = (LAS float*)(F.lds + RING_OFF + F.wave * 16384);
    const int gw = F.bid * NWAVES + F.wave, NGW = F.G * NWAVES;
    const int nitems = (K / 64) * (N / 32);
    for (int it = gw; it < nitems; it += NGW) p0_transpose_item(W, K, N, WT, scr, it, F.lane);
}
__device__ __forceinline__ void cvt_flat(Frame& F, const float* src, bf16* dst, long n8) {
    for (long i = (long)F.bid * NTHR + F.tid; i < n8; i += (long)F.G * NTHR) {
        const f32x4 a = *(const f32x4*)(src + i * 8), b = *(const f32x4*)(src + i * 8 + 4);
        v4u o; o.x = pk2(a.x, a.y); o.y = pk2(a.z, a.w); o.z = pk2(b.x, b.y); o.w = pk2(b.z, b.w);
        *(v4u*)(dst + i * 8) = o; }
}
__device__ __forceinline__ void p0_prologue(Frame& F, const Args& A) {
    unsigned char* ws = F.ws;
    transpose_mat(F, A.in[IN_AB_W_IN], DM, AB_IN, (bf16*)(ws + WS_W_ABIN));
    transpose_mat(F, A.in[IN_AB_W_OUT], DM, DM, (bf16*)(ws + WS_W_ABOUT));
    transpose_mat(F, A.in[IN_NSA_W_IN], DM, NSA_IN, (bf16*)(ws + WS_W_NSAIN));
    transpose_mat(F, A.in[IN_NSA_W_OUT], DM, DM, (bf16*)(ws + WS_W_NSAOUT));
    for (int l = 0; l < 2; ++l) {
        transpose_mat(F, A.in[IN_XA_WQ] + (size_t)l * DM * XW, DM, XW, (bf16*)(ws + WS_W_XQ) + (size_t)l * XW * DM);
        transpose_mat(F, A.in[IN_XA_WKV] + (size_t)l * DM * 2 * XW, DM, 2 * XW, (bf16*)(ws + WS_W_XKV) + (size_t)l * 2 * XW * DM);
        transpose_mat(F, A.in[IN_XA_WO] + (size_t)l * XW * DM, XW, DM, (bf16*)(ws + WS_W_XO) + (size_t)l * DM * XW);
        transpose_mat(F, A.in[IN_FFN_UP] + (size_t)l * DM * DFF2, DM, DFF2, (bf16*)(ws + WS_W_UP) + (size_t)l * DFF2 * DM);
        transpose_mat(F, A.in[IN_FFN_DOWN] + (size_t)l * DFF * DM, DFF, DM, (bf16*)(ws + WS_W_DOWN) + (size_t)l * DM * DFF);
        transpose_mat(F, A.in[IN_NSA_CMP_W1] + (size_t)l * 32 * HD * HD, 32 * HD, HD, (bf16*)(ws + WS_W_C1) + (size_t)l * HD * 32 * HD);
        transpose_mat(F, A.in[IN_NSA_CMP_W2] + (size_t)l * HD * HD, HD, HD, (bf16*)(ws + WS_W_C2) + (size_t)l * HD * HD);
    }
    cvt_flat(F, A.in[IN_X], (bf16*)(ws + WS_HB), (long)MTOK * DM / 8);
    cvt_flat(F, A.in[IN_MEM], (bf16*)(ws + WS_MEMB), (long)BATCH * NMEM * DM / 8);
    { v4u z = {0u, 0u, 0u, 0u}; v4u* p = (v4u*)((bf16*)(ws + WS_W_NSAIN) + (size_t)NSA_IN * DM); const long n = (long)(NSA_INP - NSA_IN) * DM / 8;
      for (long i = (long)F.bid * NTHR + F.tid; i < n; i += (long)F.G * NTHR) p[i] = z; }
    { const float* lbp = A.in[IN_HGRN_LB]; float* lbo = (float*)(ws + WS_LB);
      for (int i = F.bid * NTHR + F.tid; i < A_W; i += F.G * NTHR) { const float a = lbp[i], b = lbp[A_W + i], m = fmaxf(a, b), ea = __expf(a - m), eb = __expf(b - m); lbo[i] = ea / (ea + eb); } }
}

__device__ __forceinline__ void ln_phase(Frame& F, const float* Y, const float* g, const float* b, float* h32, bf16* hb) {
    const int gw = F.bid * NWAVES + F.wave, NGW = F.G * NWAVES;
    for (int m = gw; m < MTOK; m += NGW) {
        const f32x4* yr = (const f32x4*)(Y + (size_t)m * DM) + F.lane;
        f32x4 v[16]; float s = 0.f;
#pragma unroll
        for (int j = 0; j < 16; ++j) { v[j] = yr[64 * j]; s += (v[j].x + v[j].y) + (v[j].z + v[j].w); }
        const float mean = wave_sum(s) * (1.f / DM); float s2 = 0.f;
#pragma unroll
        for (int j = 0; j < 16; ++j) { v[j] = v[j] - mean; s2 += (v[j].x * v[j].x + v[j].y * v[j].y) + (v[j].z * v[j].z + v[j].w * v[j].w); }
        const float rstd = 1.f / sqrtf(wave_sum(s2) * (1.f / DM) + LN_EPS);
        f32x4* o4 = (f32x4*)(h32 + (size_t)m * DM) + F.lane; v2u* o2 = (v2u*)(hb + (size_t)m * DM) + F.lane;
        const f32x4* g4 = (const f32x4*)g + F.lane; const f32x4* b4 = (const f32x4*)b + F.lane;
#pragma unroll
        for (int j = 0; j < 16; ++j) { const f32x4 r = v[j] * rstd * g4[64 * j] + b4[64 * j]; o4[64 * j] = r; v2u w; w.x = pk2(r.x, r.y); w.y = pk2(r.z, r.w); o2[64 * j] = w; }
    }
}

__device__ __forceinline__ void convglu_phase(Frame& F, const bf16* UP, const float* cw, bf16* Gm) {
    constexpr int NCG = DFF / 8, RB = 16, NRB = MTOK / RB;
    const long nitems = (long)NCG * NRB;
    for (long it = (long)F.bid * NTHR + F.tid; it < nitems; it += (long)F.G * NTHR) {
        const int cg = (int)(it % NCG), rb = (int)(it / NCG), c0 = cg * 8, t0 = rb * RB;
        float w0[8], w1[8], w2[8];
#pragma unroll
        for (int j = 0; j < 8; ++j) { w0[j] = cw[c0 + j]; w1[j] = cw[DFF + c0 + j]; w2[j] = cw[2 * DFF + c0 + j]; }
        float am2[8], am1[8];
        if ((t0 & (SEQ - 1)) == 0) {
#pragma unroll
            for (int j = 0; j < 8; ++j) { am2[j] = 0.f; am1[j] = 0.f; }
        } else {
            const v4u x2 = *(const v4u*)(UP + (size_t)(t0 - 2) * DFF2 + c0), x1 = *(const v4u*)(UP + (size_t)(t0 - 1) * DFF2 + c0);
            am2[0] = bflo(x2.x); am2[1] = bfhi(x2.x); am2[2] = bflo(x2.y); am2[3] = bfhi(x2.y); am2[4] = bflo(x2.z); am2[5] = bfhi(x2.z); am2[6] = bflo(x2.w); am2[7] = bfhi(x2.w);
            am1[0] = bflo(x1.x); am1[1] = bfhi(x1.x); am1[2] = bflo(x1.y); am1[3] = bfhi(x1.y); am1[4] = bflo(x1.z); am1[5] = bfhi(x1.z); am1[6] = bflo(x1.w); am1[7] = bfhi(x1.w);
        }
#pragma unroll 4
        for (int r = 0; r < RB; ++r) {
            const size_t row = (size_t)(t0 + r);
            const v4u xa = *(const v4u*)(UP + row * DFF2 + c0), xu = *(const v4u*)(UP + row * DFF2 + DFF + c0);
            float a[8], u[8];
            a[0] = bflo(xa.x); a[1] = bfhi(xa.x); a[2] = bflo(xa.y); a[3] = bfhi(xa.y); a[4] = bflo(xa.z); a[5] = bfhi(xa.z); a[6] = bflo(xa.w); a[7] = bfhi(xa.w);
            u[0] = bflo(xu.x); u[1] = bfhi(xu.x); u[2] = bflo(xu.y); u[3] = bfhi(xu.y); u[4] = bflo(xu.z); u[5] = bfhi(xu.z); u[6] = bflo(xu.w); u[7] = bfhi(xu.w);
            float o[8];
#pragma unroll
            for (int j = 0; j < 8; j += 2) {
                const float c0v = w2[j] * a[j] + w1[j] * am1[j] + w0[j] * am2[j], c1v = w2[j + 1] * a[j + 1] + w1[j + 1] * am1[j + 1] + w0[j + 1] * am2[j + 1];
                const pg8::f32x2 gg = pg8::gelu_pk((pg8::f32x2){c0v, c1v}); o[j] = gg.x * u[j]; o[j + 1] = gg.y * u[j + 1]; }
            v4u w; w.x = pk2(o[0], o[1]); w.y = pk2(o[2], o[3]); w.z = pk2(o[4], o[5]); w.w = pk2(o[6], o[7]);
            *(v4u*)(Gm + row * DFF + c0) = w;
#pragma unroll
            for (int j = 0; j < 8; ++j) { am2[j] = am1[j]; am1[j] = a[j]; }
        }
    }
}

__device__ __forceinline__ void xattn_phase(Frame& F, const bf16* XQ, const bf16* XKV, bf16* XO) {
    const int tid = F.tid, wid = F.wave, lane = F.lane, r32 = lane & 31, hi = lane >> 5;
    LAS char* lds = (LAS char*)F.lds;
    LAS float* wsc = (LAS float*)(lds + ATT_WS_OFF + wid * 256);
    const int vb0 = (int)(uintptr_t)(lds + ATT_V_OFF) + v_rd_base(lane);
    KVDma dm; kv_dma_init(dm, 2 * XW, 2 * XW, wid, lane);
    constexpr int NU = (MTOK / 256) * XH;
    for (int u = F.bid; u < NU; u += F.G) {
        const int head = u % XH, rbk = u / XH, row0 = rbk * 256, b = row0 / SEQ;
        const bf16* Kh = XKV + (size_t)b * NMEM * 2 * XW + head * HD; const bf16* Vh = Kh + XW;
        bf16x8 qr[8]; load_q(qr, XQ + (size_t)(row0 + wid * 32 + r32) * XW + head * HD + hi * 8);
        float m_reg = -1e30f, l_reg = 0.f; f32x16 o[4] = {};
        __syncthreads();
        kv_dma(dm, Kh, Vh, lds, 0, wid);
        for (int j = 0; j < NMEM / KVBLK; ++j) {
            const int buf = (j & 1) * ATT_BUF;
            VM_WAIT(); __syncthreads();
            if (j + 1 < NMEM / KVBLK) kv_dma(dm, Kh + (size_t)(j + 1) * KVBLK * 2 * XW, Vh + (size_t)(j + 1) * KVBLK * 2 * XW, lds, ATT_BUF - buf, wid);
            f32x16 p0, p1; qkt(p0, p1, lds + buf + ATT_K_OFF, qr, r32, hi);
            float alpha; softmax_tile<false>(p0, p1, 0u, 0u, m_reg, l_reg, alpha);
            rescale_o(o, alpha, wsc, r32, hi);
            bf16x8 pa0, pa1, pa2, pa3; pack_p(p0, p1, pa0, pa1, pa2, pa3);
            pv_d0(o, vb0 + buf, pa0, pa1, pa2, pa3);
        }
        if (hi == 0) wsc[32 + r32] = l_reg; LDS_WAIT();
        bf16* Ow = XO + (size_t)(row0 + wid * 32) * XW + head * HD;
#pragma unroll
        for (int r = 0; r < 16; ++r) { const int orow = crow(r, hi); const float rl = __builtin_amdgcn_rcpf(wsc[32 + orow]);
#pragma unroll
            for (int d0 = 0; d0 < 4; ++d0) Ow[(size_t)orow * XW + d0 * 32 + r32] = (bf16)f2bf(o[d0][r] * rl); }
        LDS_WAIT();
    }
}

template <int K>
__device__ __forceinline__ f32x4 mma_tile(const LAS char* A, int lda, const LAS char* B, int ldb, int fr, int fq) {
    f32x4 acc = {0.f, 0.f, 0.f, 0.f};
#pragma unroll
    for (int k0 = 0; k0 < K; k0 += 32) {
        const bf16x8 a = *(const LAS bf16x8*)(A + fr * lda + (k0 + 8 * fq) * 2);
        const bf16x8 b = *(const LAS bf16x8*)(B + fr * ldb + (k0 + 8 * fq) * 2);
        acc = __builtin_amdgcn_mfma_f32_16x16x32_bf16(a, b, acc, 0, 0, 0);
    }
    return acc;
}
constexpr int HG_CH = 64, HG_NC = SEQ / HG_CH, HG_ITEMS = BATCH * A_HEADS * HG_NC;
constexpr int HG_QT = 0, HG_KT = 17408, HG_KH = 34816, HG_VT = 53248, HG_PT = 71680, HG_SEG = 80896;
constexpr int HG_SP = 17408, HG_OT = 52224;
__device__ __forceinline__ void hgrn_phase_a(Frame& F, const bf16* P0, const float* lbv, bf16* QTg, float* OINTRA, float* DS, float* DEC) {
    LAS char* lds = (LAS char*)F.lds;
    const int tid = F.tid, wid = F.wave, lane = F.lane, fr = lane & 15, fq = lane >> 4;
    const int d = tid & 127, sq = tid >> 7;
    for (int it = F.bid; it < HG_ITEMS; it += F.G) {
        const int c = it % HG_NC, bh = it / HG_NC, h = bh % A_HEADS, b = bh / A_HEADS;
        const size_t row0 = (size_t)b * SEQ + (size_t)c * HG_CH;
        const float lb = lbv[h * HD + d], omlb = 1.f - lb;
        float cum[16], kk[16];
        { float run = 0.f;
#pragma unroll
          for (int j = 0; j < 16; ++j) { const float z = bf2f(P0[(row0 + 16 * sq + j) * AB_IN + A_W + h * HD + d]); const float sg = sigmoidf_(z);
              run += __logf(lb + omlb * sg); cum[j] = run; kk[j] = omlb * (1.f - sg); }
          ((LAS float*)(lds + HG_SEG))[sq * 128 + d] = run; }
        LDS_WAIT(); __syncthreads();
        float base = 0.f, total = 0.f;
#pragma unroll
        for (int q = 0; q < 4; ++q) { const float sgm = ((LAS float*)(lds + HG_SEG))[q * 128 + d]; total += sgm; if (q < sq) base += sgm; }
        unsigned kh[8], vt[8];
#pragma unroll
        for (int j = 0; j < 16; j += 2) {
            float e[2][3]; unsigned short vr[2];
#pragma unroll
            for (int jj = 0; jj < 2; ++jj) { const int s = 16 * sq + j + jj; const float bb = base + cum[j + jj];
                const float q = bf2f(P0[(row0 + s) * AB_IN + h * HD + d]); vr[jj] = P0[(row0 + s) * AB_IN + 2 * A_W + h * HD + d];
                const float qt = q * __expf(bb), kt = kk[j + jj] * __expf(-bb), kht = kk[j + jj] * __expf(total - bb);
                const unsigned short qb16 = (unsigned short)f2bf(qt);
                *(LAS unsigned short*)(lds + HG_QT + s * 272 + d * 2) = qb16; QTg[(row0 + s) * A_W + h * HD + d] = qb16;
                *(LAS unsigned short*)(lds + HG_KT + s * 272 + d * 2) = (unsigned short)f2bf(kt);
                e[jj][0] = kht; }
            kh[j >> 1] = pk2(e[0][0], e[1][0]); vt[j >> 1] = (unsigned)vr[0] | ((unsigned)vr[1] << 16);
        }
        { LAS v4u* pk = (LAS v4u*)(lds + HG_KH + d * 144 + sq * 32); pk[0] = (v4u){kh[0], kh[1], kh[2], kh[3]}; pk[1] = (v4u){kh[4], kh[5], kh[6], kh[7]};
          LAS v4u* pv = (LAS v4u*)(lds + HG_VT + d * 144 + sq * 32); pv[0] = (v4u){vt[0], vt[1], vt[2], vt[3]}; pv[1] = (v4u){vt[4], vt[5], vt[6], vt[7]}; }
        if (sq == 3) DEC[(size_t)it * HD + d] = __expf(total);
        LDS_WAIT(); __syncthreads();
#pragma unroll
        for (int k = 0; k < 2; ++k) { const int tau = 2 * wid + k, ti = tau >> 2, si = tau & 3;
            f32x4 acc = {0.f, 0.f, 0.f, 0.f};
            if (si <= ti) acc = mma_tile<128>(lds + HG_QT + ti * 16 * 272, 272, lds + HG_KT + si * 16 * 272, 272, fr, fq);
#pragma unroll
            for (int i = 0; i < 4; ++i) { const int t = 16 * ti + 4 * fq + i, s = 16 * si + fr; const float v = (s <= t) ? acc[i] : 0.f;
                *(LAS unsigned short*)(lds + HG_PT + t * 144 + s * 2) = (unsigned short)f2bf(v); } }
        LDS_WAIT(); __syncthreads();
#pragma unroll
        for (int k = 0; k < 4; ++k) { const int tau = wid + 8 * k, ti = tau >> 3, vi = tau & 7;
            const f32x4 acc = mma_tile<64>(lds + HG_PT + ti * 16 * 144, 144, lds + HG_VT + vi * 16 * 144, 144, fr, fq);
#pragma unroll
            for (int i = 0; i < 4; ++i) OINTRA[(row0 + 16 * ti + 4 * fq + i) * A_W + h * HD + 16 * vi + fr] = acc[i]; }
#pragma unroll
        for (int k = 0; k < 8; ++k) { const int tau = wid + 8 * k, vi = tau >> 3, ki = tau & 7;
            const f32x4 acc = mma_tile<64>(lds + HG_VT + vi * 16 * 144, 144, lds + HG_KH + ki * 16 * 144, 144, fr, fq);
#pragma unroll
            for (int i = 0; i < 4; ++i) DS[((size_t)it * HD + 16 * vi + 4 * fq + i) * HD + 16 * ki + fr] = acc[i]; }
        LDS_WAIT(); __syncthreads();
    }
}
__device__ __forceinline__ void hgrn_phase_b(Frame& F, const float* DS, const float* DEC, bf16* SPREV) {
    const int tid = F.tid, dvl = tid >> 5, dk4 = (tid & 31) * 4;
    for (int item = F.bid; item < BATCH * A_HEADS * 8; item += F.G) {
        const int sl = item & 7, bh = item >> 3, dv = sl * 16 + dvl;
        f32x4 S = {0.f, 0.f, 0.f, 0.f};
        for (int c0 = 0; c0 < HG_NC; c0 += 8) {
            f32x4 ds[8], dc[8];
#pragma unroll
            for (int k = 0; k < 8; ++k) { const size_t it = (size_t)bh * HG_NC + c0 + k; ds[k] = *(const f32x4*)(DS + (it * HD + dv) * HD + dk4); dc[k] = *(const f32x4*)(DEC + it * HD + dk4); }
#pragma unroll
            for (int k = 0; k < 8; ++k) { const size_t it = (size_t)bh * HG_NC + c0 + k;
                v2u w; w.x = pk2(S.x, S.y); w.y = pk2(S.z, S.w); *(v2u*)(SPREV + (it * HD + dv) * HD + dk4) = w;
                S = S * dc[k] + ds[k]; }
        }
    }
}
__device__ __forceinline__ void hgrn_phase_c(Frame& F, const bf16* P0, const bf16* QTg, const float* OINTRA, const bf16* SPREV, const float* nw, bf16* Ob) {
    LAS char* lds = (LAS char*)F.lds;
    const int tid = F.tid, wid = F.wave, lane = F.lane, fr = lane & 15, fq = lane >> 4;
    for (int it = F.bid; it < HG_ITEMS; it += F.G) {
        const int c = it % HG_NC, bh = it / HG_NC, h = bh % A_HEADS, b = bh / A_HEADS;
        const size_t row0 = (size_t)b * SEQ + (size_t)c * HG_CH;
        { const int s = tid >> 3, ch = (tid & 7) * 16; const bf16* src = QTg + (row0 + s) * A_W + h * HD + ch;
          const v4u x0 = *(const v4u*)src, x1 = *(const v4u*)(src + 8); LAS v4u* dst = (LAS v4u*)(lds + HG_QT + s * 272 + ch * 2); dst[0] = x0; dst[1] = x1; }
        { const int dv = tid >> 2, ch = (tid & 3) * 32; const bf16* src = SPREV + ((size_t)it * HD + dv) * HD + ch;
          const v4u x0 = *(const v4u*)src, x1 = *(const v4u*)(src + 8), x2 = *(const v4u*)(src + 16), x3 = *(const v4u*)(src + 24);
          LAS v4u* dst = (LAS v4u*)(lds + HG_SP + dv * 272 + ch * 2); dst[0] = x0; dst[1] = x1; dst[2] = x2; dst[3] = x3; }
        LDS_WAIT(); __syncthreads();
#pragma unroll
        for (int k = 0; k < 4; ++k) { const int tau = wid + 8 * k, ti = tau >> 3, vi = tau & 7;
            const f32x4 acc = mma_tile<128>(lds + HG_QT + ti * 16 * 272, 272, lds + HG_SP + vi * 16 * 272, 272, fr, fq);
#pragma unroll
            for (int i = 0; i < 4; ++i) { const int t = 16 * ti + 4 * fq + i, dv = 16 * vi + fr;
                *(LAS float*)(lds + HG_OT + (t * 132 + dv) * 4) = acc[i] + OINTRA[(row0 + t) * A_W + h * HD + dv]; } }
        LDS_WAIT(); __syncthreads();
#pragma unroll
        for (int k = 0; k < 8; ++k) { const int t = wid * 8 + k;
            const float v0 = *(LAS float*)(lds + HG_OT + (t * 132 + lane) * 4), v1 = *(LAS float*)(lds + HG_OT + (t * 132 + 64 + lane) * 4);
            const float ss = wave_sum(v0 * v0 + v1 * v1); const float r = 1.f / sqrtf(ss * (1.f / HD) + RMS_EPS);
            const float g0 = bf2f(P0[(row0 + t) * AB_IN + 3 * A_W + h * HD + lane]), g1 = bf2f(P0[(row0 + t) * AB_IN + 3 * A_W + h * HD + 64 + lane]);
            Ob[(row0 + t) * DM + h * HD + lane] = (bf16)f2bf(v0 * r * nw[lane] * g0 * sigmoidf_(g0));
            Ob[(row0 + t) * DM + h * HD + 64 + lane] = (bf16)f2bf(v1 * r * nw[64 + lane] * g1 * sigmoidf_(g1)); }
        LDS_WAIT(); __syncthreads();
    }
}

constexpr float SB_CUT = -160.f;
__device__ __forceinline__ void sb_phase(Frame& F, const bf16* P0, bf16* Ob) {
    const int tid = F.tid, wid = F.wave, lane = F.lane, r32 = lane & 31, hi = lane >> 5;
    LAS char* lds = (LAS char*)F.lds;
    const int vb0 = (int)(uintptr_t)(lds + ATT_V_OFF) + v_rd_base(lane);
    KVDma dm; kv_dma_init(dm, AB_IN, AB_IN, wid, lane);
    constexpr int NQB = SEQ / 256, NU = BATCH * B_HEADS * NQB;
    for (int rd = 0; ; ++rd) {
        const int idx = (rd & 1) ? rd * F.G + (F.G - 1 - F.bid) : rd * F.G + F.bid;
        if (rd * F.G >= NU) break;
        if (idx >= NU) continue;
        const int qb = NQB - 1 - idx / (BATCH * B_HEADS), bh = idx % (BATCH * B_HEADS), head = bh % B_HEADS, b = bh / B_HEADS;
        const size_t rowb = (size_t)b * SEQ; const int q0 = qb * 256;
        const bf16* Kh = P0 + rowb * AB_IN + 4 * A_W + B_W + head * HD; const bf16* Vh = Kh + B_W;
        const int tw0 = q0 + wid * 32, t = tw0 + r32;
        bf16x8 qr[8]; load_q(qr, P0 + (rowb + t) * AB_IN + 4 * A_W + head * HD + hi * 8);
        float R = 0.f; f32x16 o[4] = {};
        const int jtop = (q0 + 254) >> 6;
        LAS unsigned* dflag = (LAS unsigned*)(lds + ATT_X_OFF);
        if (lane == 0) { dflag[wid] = 0u; dflag[8 + wid] = 0u; }
        LDS_WAIT(); __syncthreads();
        kv_dma(dm, Kh + (size_t)jtop * KVBLK * AB_IN, Vh + (size_t)jtop * KVBLK * AB_IN, lds, 0, wid);
        int buf = 0;
        for (int j = jtop; j >= 0; --j, buf = ATT_BUF - buf) {
            VM_WAIT(); __syncthreads();
            { unsigned alld = 1u;
#pragma unroll
              for (int w = 0; w < NWAVES; ++w) alld &= dflag[((j + 1) & 1) * 8 + w];
              if (__builtin_amdgcn_readfirstlane(alld)) break; }
            if (j > 0) kv_dma(dm, Kh + (size_t)(j - 1) * KVBLK * AB_IN, Vh + (size_t)(j - 1) * KVBLK * AB_IN, lds, ATT_BUF - buf, wid);
            const int k0 = j * KVBLK;
            if (k0 < tw0 + 31) {
                f32x16 p0, p1; qkt(p0, p1, lds + buf + ATT_K_OFF, qr, r32, hi);
                const bool need_mask = (k0 + 63 >= tw0);
                float L0[16], L1[16];
#pragma unroll
                for (int r = 0; r < 16; ++r) {
                    const float z0 = p0[r] * ATT_C, z1 = p1[r] * ATT_C;
                    float l0 = -(fmaxf(z0, 0.f) + __builtin_amdgcn_logf(1.f + __builtin_amdgcn_exp2f(-fabsf(z0))));
                    float l1 = -(fmaxf(z1, 0.f) + __builtin_amdgcn_logf(1.f + __builtin_amdgcn_exp2f(-fabsf(z1))));
                    if (need_mask) { if (k0 + crow(r, hi) >= t) l0 = 0.f; if (k0 + 32 + crow(r, hi) >= t) l1 = 0.f; }
                    L0[r] = l0; L1[r] = l1; p0[r] = z0 + l0; p1[r] = z1 + l1;
                }
                SBAR();
                float Sg[16];
#pragma unroll
                for (int gi = 0; gi < 4; ++gi) {
                    const float a = (L0[4 * gi] + L0[4 * gi + 1]) + (L0[4 * gi + 2] + L0[4 * gi + 3]), c = (L1[4 * gi] + L1[4 * gi + 1]) + (L1[4 * gi + 2] + L1[4 * gi + 3]);
                    auto ra = __builtin_amdgcn_permlane32_swap(__float_as_uint(a), __float_as_uint(a), false, false);
                    auto rc = __builtin_amdgcn_permlane32_swap(__float_as_uint(c), __float_as_uint(c), false, false);
                    Sg[2 * gi] = __uint_as_float(ra[0]); Sg[2 * gi + 1] = __uint_as_float(ra[1]); Sg[8 + 2 * gi] = __uint_as_float(rc[0]); Sg[8 + 2 * gi + 1] = __uint_as_float(rc[1]);
                }
                float run = R;
#pragma unroll
                for (int s = 15; s >= 0; --s) { const float tt = run; run += Sg[s]; Sg[s] = tt; }
                const float Rn = run;
                SBAR();
#pragma unroll
                for (int gi = 0; gi < 4; ++gi) {
                    float base0 = hi ? Sg[2 * gi + 1] : Sg[2 * gi], base1 = hi ? Sg[8 + 2 * gi + 1] : Sg[8 + 2 * gi];
                    float r3 = base0, r2 = r3 + L0[4 * gi + 3], r1 = r2 + L0[4 * gi + 2], r0 = r1 + L0[4 * gi + 1];
                    p0[4 * gi + 3] = __builtin_amdgcn_exp2f(p0[4 * gi + 3] + r3); p0[4 * gi + 2] = __builtin_amdgcn_exp2f(p0[4 * gi + 2] + r2);
                    p0[4 * gi + 1] = __builtin_amdgcn_exp2f(p0[4 * gi + 1] + r1); p0[4 * gi + 0] = __builtin_amdgcn_exp2f(p0[4 * gi + 0] + r0);
                    r3 = base1; r2 = r3 + L1[4 * gi + 3]; r1 = r2 + L1[4 * gi + 2]; r0 = r1 + L1[4 * gi + 1];
                    p1[4 * gi + 3] = __builtin_amdgcn_exp2f(p1[4 * gi + 3] + r3); p1[4 * gi + 2] = __builtin_amdgcn_exp2f(p1[4 * gi + 2] + r2);
                    p1[4 * gi + 1] = __builtin_amdgcn_exp2f(p1[4 * gi + 1] + r1); p1[4 * gi + 0] = __builtin_amdgcn_exp2f(p1[4 * gi + 0] + r0);
                }
                R = Rn;
                { const unsigned dn = __all(R < SB_CUT) ? 1u : 0u; if (lane == 0) dflag[(j & 1) * 8 + wid] = dn; }
                if (need_mask) {
#pragma unroll
                    for (int r = 0; r < 16; ++r) { if (k0 + crow(r, hi) >= t) p0[r] = 0.f; if (k0 + 32 + crow(r, hi) >= t) p1[r] = 0.f; }
                }
                bf16x8 pa0, pa1, pa2, pa3; pack_p(p0, p1, pa0, pa1, pa2, pa3);
                pv_d0(o, vb0 + buf, pa0, pa1, pa2, pa3);
            }
        }
        bf16* Ow = Ob + (rowb + tw0) * DM + A_W + head * HD;
#pragma unroll
        for (int r = 0; r < 16; ++r) { const int orow = crow(r, hi);
#pragma unroll
            for (int d0 = 0; d0 < 4; ++d0) Ow[(size_t)orow * DM + d0 * 32 + r32] = (bf16)f2bf(o[d0][r]); }
    }
}

constexpr int P1_KC = 4096, P1_VC = 4608, P1_KS = 5120, P1_VS = 5632, P1_KW = 6144, P1_VW = 6656, P1_GL = 7168;
__device__ __forceinline__ void nsa_rope_phase(Frame& F, const bf16* P1, bf16* QROT, bf16* KSROT, bf16* KWROT, bf16* OVL) {
    const int gw = F.bid * NWAVES + F.wave, NGW = F.G * NWAVES, lane = F.lane;
    const float inv_freq = powf(10000.0f, -(float)lane * (1.0f / 64.0f));
    for (int m = gw; m < MTOK; m += NGW) {
        const int t = m & (SEQ - 1);
        float sn, cs; sincosf((float)t * inv_freq, &sn, &cs);
        const bf16* row = P1 + (size_t)m * NSA_INP;
        for (int hh = 0; hh < 40; ++hh) {
            const bf16* src; bf16* dst;
            if (hh < 32) { src = row + hh * HD; dst = QROT + (size_t)m * DM + hh * HD; }
            else if (hh < 36) { src = row + P1_KS + (hh - 32) * HD; dst = KSROT + (size_t)m * KVW + (hh - 32) * HD; }
            else { src = row + P1_KW + (hh - 36) * HD; dst = KWROT + (size_t)m * KVW + (hh - 36) * HD; }
            const float x1 = bf2f(src[lane]), x2 = bf2f(src[64 + lane]);
            dst[lane] = (bf16)f2bf(x1 * cs - x2 * sn); dst[64 + lane] = (bf16)f2bf(x2 * cs + x1 * sn);
        }
    }
    for (int i = F.bid * NTHR + F.tid; i < NCMPP * NSLC; i += F.G * NTHR) { const int n = i / NSLC, j = i % NSLC;
        OVL[i] = (n < NCMP && n >= 4 * j - 1 && n <= 4 * j + 3) ? (bf16)0x3f80u : (bf16)0u; }
}
constexpr int CM_A = 0, CM_B = 17408, CM_H = 17408 + 34816;
__device__ __forceinline__ void nsa_compress_phase(Frame& F, const bf16* P1, const float* pos, const bf16* W1t, const bf16* W2t, bf16* KCMP, bf16* VCMP) {
    LAS char* lds = (LAS char*)F.lds;
    const int tid = F.tid, wid = F.wave, lane = F.lane, fr = lane & 15, fq = lane >> 4;
    for (int item = F.bid; item < 128; item += F.G) {
        const int nt = item & 7, g = (item >> 3) & 3, b = (item >> 5) & 1, which = item >> 6;
        const bf16* w1 = W1t + (size_t)which * HD * 32 * HD; const bf16* w2 = W2t + (size_t)which * HD * HD;
        const float* posw = pos + (size_t)which * 32 * HD;
        f32x4 acc[4];
#pragma unroll
        for (int k = 0; k < 4; ++k) acc[k] = (f32x4){0.f, 0.f, 0.f, 0.f};
        for (int l = 0; l < 32; ++l) {
            { const int r = tid >> 3, ch = (tid & 7) * 16, n = nt * 64 + r; unsigned w[8];
              if (n < NCMP) { const bf16* src = P1 + ((size_t)b * SEQ + 16 * n + l) * NSA_INP + P1_KC + which * KVW + g * HD + ch;
                  const v4u x0 = *(const v4u*)src, x1 = *(const v4u*)(src + 8); const unsigned xs[8] = {x0.x, x0.y, x0.z, x0.w, x1.x, x1.y, x1.z, x1.w};
#pragma unroll
                  for (int q = 0; q < 8; ++q) w[q] = pk2(bflo(xs[q]) + posw[l * HD + ch + 2 * q], bfhi(xs[q]) + posw[l * HD + ch + 2 * q + 1]);
              } else {
#pragma unroll
                  for (int q = 0; q < 8; ++q) w[q] = 0u; }
              LAS v4u* dst = (LAS v4u*)(lds + CM_A + r * 272 + ch * 2); dst[0] = (v4u){w[0], w[1], w[2], w[3]}; dst[1] = (v4u){w[4], w[5], w[6], w[7]}; }
            { const int e = tid >> 2, ch = (tid & 3) * 32; const bf16* src = w1 + (size_t)e * 32 * HD + l * HD + ch;
              const v4u x0 = *(const v4u*)src, x1 = *(const v4u*)(src + 8), x2 = *(const v4u*)(src + 16), x3 = *(const v4u*)(src + 24);
              LAS v4u* dst = (LAS v4u*)(lds + CM_B + e * 272 + ch * 2); dst[0] = x0; dst[1] = x1; dst[2] = x2; dst[3] = x3; }
            LDS_WAIT(); __syncthreads();
#pragma unroll
            for (int k = 0; k < 4; ++k) { const int tau = wid + 8 * k, ni = tau >> 3, ei = tau & 7;
                acc[k] += mma_tile<128>(lds + CM_A + ni * 16 * 272, 272, lds + CM_B + ei * 16 * 272, 272, fr, fq); }
            LDS_WAIT(); __syncthreads();
        }
#pragma unroll
        for (int k = 0; k < 4; ++k) { const int tau = wid + 8 * k, ni = tau >> 3, ei = tau & 7;
#pragma unroll
            for (int i = 0; i < 4; ++i) *(LAS unsigned short*)(lds + CM_H + (16 * ni + 4 * fq + i) * 272 + (16 * ei + fr) * 2) = (unsigned short)f2bf(gelu1(acc[k][i])); }
        { const int f = tid >> 2, ch = (tid & 3) * 32; const bf16* src = w2 + (size_t)f * HD + ch;
          const v4u x0 = *(const v4u*)src, x1 = *(const v4u*)(src + 8), x2 = *(const v4u*)(src + 16), x3 = *(const v4u*)(src + 24);
          LAS v4u* dst = (LAS v4u*)(lds + CM_B + f * 272 + ch * 2); dst[0] = x0; dst[1] = x1; dst[2] = x2; dst[3] = x3; }
        LDS_WAIT(); __syncthreads();
        bf16* outp = which ? VCMP : KCMP;
#pragma unroll
        for (int k = 0; k < 4; ++k) { const int tau = wid + 8 * k, ni = tau >> 3, fi = tau & 7;
            const f32x4 a2 = mma_tile<128>(lds + CM_H + ni * 16 * 272, 272, lds + CM_B + fi * 16 * 272, 272, fr, fq);
#pragma unroll
            for (int i = 0; i < 4; ++i) { const int n = nt * 64 + 16 * ni + 4 * fq + i;
                outp[(((size_t)b * NCMPP + n) * NSA_G + g) * HD + 16 * fi + fr] = (n < NCMP) ? (bf16)f2bf(a2[i]) : (bf16)0u; } }
        LDS_WAIT(); __syncthreads();
    }
}
__device__ __forceinline__ unsigned pick4(const unsigned (&a)[4], int i) { return i == 0 ? a[0] : (i == 1 ? a[1] : (i == 2 ? a[2] : a[3])); }
template <int MODE>
__device__ __forceinline__ void nsa_attn_phase(Frame& F, const bf16* P1, const bf16* Qsrc, const bf16* Ksrc, const bf16* Vsrc, const unsigned* SEL, float* O32, float* IMP, bf16* Ob) {
    const int tid = F.tid, wid = F.wave, lane = F.lane, r32 = lane & 31, hi = lane >> 5;
    LAS char* lds = (LAS char*)F.lds;
    LAS float* wsc = (LAS float*)(lds + ATT_WS_OFF + wid * 256);
    const int vb0 = (int)(uintptr_t)(lds + ATT_V_OFF) + v_rd_base(lane);
    KVDma dm; kv_dma_init(dm, MODE <= 1 ? NSA_G * HD : KVW, MODE == 0 ? NSA_G * HD : (MODE == 1 ? NSLC : NSA_INP), wid, lane);
    constexpr int NTB = SEQ / 32, NU = BATCH * NSA_G * NTB;
    for (int rd = 0; ; ++rd) {
        const int idx = (rd & 1) ? rd * F.G + (F.G - 1 - F.bid) : rd * F.G + F.bid;
        if (rd * F.G >= NU) break;
        if (idx >= NU) continue;
        const int tb = NTB - 1 - idx / (BATCH * NSA_G), bg = idx % (BATCH * NSA_G), g = bg % NSA_G, b = bg / NSA_G;
        const size_t rowb = (size_t)b * SEQ; const int t0 = tb * 32;
        const int t = (MODE == 2) ? t0 + 4 * wid + (r32 >> 3) : t0 + r32, head = (MODE == 2) ? g * NSA_R + (r32 & 7) : g * NSA_R + wid;
        const bf16* Kh; const bf16* Vh; long ldk, ldv; int jlo, jhi;
        if (MODE <= 1) { Kh = Ksrc + ((size_t)b * NCMPP * NSA_G + g) * HD; ldk = NSA_G * HD; jlo = 0; jhi = (t0 >> 4) >> 6;
            if (MODE == 0) { Vh = Vsrc + ((size_t)b * NCMPP * NSA_G + g) * HD; ldv = NSA_G * HD; } else { Vh = Vsrc; ldv = NSLC; } }
        else { Kh = Ksrc + rowb * KVW + g * HD; ldk = KVW; Vh = P1 + rowb * NSA_INP + (MODE == 2 ? P1_VS : P1_VW) + g * HD; ldv = NSA_INP;
            jhi = (t0 + 31) >> 6; jlo = (MODE == 2) ? 0 : ((t0 - (WINDOW - 1) > 0 ? t0 - (WINDOW - 1) : 0) >> 6); }
        bf16x8 qr[8]; load_q(qr, Qsrc + (rowb + t) * (MODE <= 1 ? NSA_INP : DM) + head * HD + hi * 8);
        unsigned selw[4] = {0u, 0u, 0u, 0u}, uni[4] = {~0u, ~0u, ~0u, ~0u}, wn[4] = {~0u, ~0u, ~0u, ~0u};
        if (MODE == 2) { const v4u sv = *(const v4u*)(SEL + ((rowb + t) * NSA_G + g) * 4); selw[0] = sv.x; selw[1] = sv.y; selw[2] = sv.z; selw[3] = sv.w;
            LAS unsigned* un = (LAS unsigned*)(lds + ATT_X_OFF);
#pragma unroll
            for (int q = 0; q < 4; ++q) { unsigned x = selw[q]; x |= __shfl_xor(x, 8); x |= __shfl_xor(x, 16); wn[q] = __builtin_amdgcn_readfirstlane(x); if (lane == 0) un[wid * 4 + q] = wn[q]; }
            LDS_WAIT(); __syncthreads();
#pragma unroll
            for (int q = 0; q < 4; ++q) { unsigned x = 0u;
#pragma unroll
                for (int w = 0; w < NWAVES; ++w) x |= un[w * 4 + q];
                uni[q] = __builtin_amdgcn_readfirstlane(x); } }
        float m_reg = -1e30f, l_reg = 0.f; f32x16 o[4] = {};
        const int cur = t >> 6;
#define NSA_NEXT(jj) do { if (MODE == 2) { while ((jj) <= jhi && !((pick4(uni, (jj) >> 5) >> ((jj) & 31)) & 1u)) ++(jj); } } while (0)
        int j = jlo; NSA_NEXT(j);
        __syncthreads();
        if (j <= jhi) kv_dma(dm, Kh + (size_t)j * KVBLK * ldk, Vh + (size_t)j * KVBLK * ldv, lds, 0, wid);
        int buf = 0;
        while (j <= jhi) {
            int jn = j + 1; NSA_NEXT(jn);
            const int k0 = j * KVBLK;
            VM_WAIT(); __syncthreads();
            if (jn <= jhi) kv_dma(dm, Kh + (size_t)jn * KVBLK * ldk, Vh + (size_t)jn * KVBLK * ldv, lds, ATT_BUF - buf, wid);
            if (MODE == 2 && !((pick4(wn, j >> 5) >> (j & 31)) & 1u)) { j = jn; buf = ATT_BUF - buf; continue; }
            f32x16 p0, p1; qkt(p0, p1, lds + buf + ATT_K_OFF, qr, r32, hi);
            unsigned vm0 = 0u, vm1 = 0u; bool full;
            if (MODE <= 1) { full = (16 * (k0 + 63) + 31 <= t0);
                if (!full) {
#pragma unroll
                    for (int r = 0; r < 16; ++r) { vm0 |= (16 * (k0 + crow(r, hi)) + 31 <= t) ? (1u << r) : 0u; vm1 |= (16 * (k0 + 32 + crow(r, hi)) + 31 <= t) ? (1u << r) : 0u; } } }
            else if (MODE == 2) { full = false; const bool mine = (pick4(selw, j >> 5) >> (j & 31)) & 1u;
                if (mine) { if (j < cur) { vm0 = 0xffffu; vm1 = 0xffffu; } else {
#pragma unroll
                    for (int r = 0; r < 16; ++r) { vm0 |= (k0 + crow(r, hi) <= t) ? (1u << r) : 0u; vm1 |= (k0 + 32 + crow(r, hi) <= t) ? (1u << r) : 0u; } } } }
            else { full = (k0 > t0 + 31 - WINDOW) && (k0 + 63 <= t0);
                if (!full) {
#pragma unroll
                    for (int r = 0; r < 16; ++r) { const int ka = k0 + crow(r, hi), kb = ka + 32;
                        vm0 |= (ka <= t && ka > t - WINDOW) ? (1u << r) : 0u; vm1 |= (kb <= t && kb > t - WINDOW) ? (1u << r) : 0u; } } }
            float alpha;
            if (full) softmax_tile<false>(p0, p1, 0u, 0u, m_reg, l_reg, alpha); else softmax_tile<true>(p0, p1, vm0, vm1, m_reg, l_reg, alpha);
            rescale_o(o, alpha, wsc, r32, hi);
            bf16x8 pa0, pa1, pa2, pa3; pack_p(p0, p1, pa0, pa1, pa2, pa3);
            pv_d0(o, vb0 + buf, pa0, pa1, pa2, pa3);
            j = jn; buf = ATT_BUF - buf;
        }
#undef NSA_NEXT
        { float fac = l_reg > 0.f ? __builtin_amdgcn_rcpf(l_reg) : 0.f;
          if (MODE != 1) { const int br = MODE == 0 ? 0 : (MODE == 2 ? 1 : 2); fac *= sigmoidf_(bf2f(P1[(rowb + t) * NSA_INP + P1_GL + head * 3 + br])); }
          if (hi == 0) wsc[32 + r32] = fac; LDS_WAIT(); }
        if (MODE == 1) {
            float fc[16];
#pragma unroll
            for (int r = 0; r < 16; ++r) fc[r] = wsc[32 + crow(r, hi)];
            LDS_WAIT(); __syncthreads();
#pragma unroll
            for (int r = 0; r < 16; ++r) { const int orow = crow(r, hi);
#pragma unroll
                for (int d0 = 0; d0 < 4; ++d0) *(LAS float*)(lds + ((wid * 32 + orow) * 128 + d0 * 32 + r32) * 4) = o[d0][r] * fc[r]; }
            LDS_WAIT(); __syncthreads();
            { const int tok = tid >> 4, j8 = (tid & 15) * 8; f32x4 s0 = {0.f, 0.f, 0.f, 0.f}, s1 = {0.f, 0.f, 0.f, 0.f};
#pragma unroll
              for (int w = 0; w < 8; ++w) { const LAS f32x4* pp = (const LAS f32x4*)(lds + ((w * 32 + tok) * 128 + j8) * 4); s0 += pp[0]; s1 += pp[1]; }
              f32x4* dst = (f32x4*)(IMP + ((rowb + t0 + tok) * NSA_G + g) * NSLC + j8); dst[0] = s0; dst[1] = s1; }
            LDS_WAIT(); __syncthreads();
        } else {
#pragma unroll
            for (int r = 0; r < 16; ++r) { const int orow = crow(r, hi); const float fc = wsc[32 + orow];
                const size_t off = (MODE == 2) ? (rowb + t0 + 4 * wid + (orow >> 3)) * DM + (g * NSA_R + (orow & 7)) * HD + r32 : (rowb + t0 + orow) * DM + head * HD + r32;
#pragma unroll
                for (int d0 = 0; d0 < 4; ++d0) {
                    if (MODE == 0) O32[off + d0 * 32] = o[d0][r] * fc;
                    else if (MODE == 2) O32[off + d0 * 32] += o[d0][r] * fc;
                    else Ob[off + d0 * 32] = (bf16)f2bf(O32[off + d0 * 32] + o[d0][r] * fc); } }
            LDS_WAIT();
        }
    }
}
__device__ __forceinline__ void nsa_topk_phase(Frame& F, const float* IMP, unsigned* SEL) {
    LAS float* sc = (LAS float*)(F.lds + F.wave * 1024);
    const int gw = F.bid * NWAVES + F.wave, NGW = F.G * NWAVES, lane = F.lane;
    for (int it = gw; it < MTOK * NSA_G; it += NGW) {
        const int m = it / NSA_G, t = m & (SEQ - 1), cur = t >> 6;
        const float* ip = IMP + (size_t)it * NSLC;
        const float a0 = ip[lane], a1 = ip[64 + lane];
        sc[lane] = a0; sc[64 + lane] = a1; LDS_WAIT();
        const int j0 = lane, j1 = lane + 64;
        const bool f0 = (j0 == 0) || (j0 == cur) || (j0 == cur - 1), f1 = (j1 == cur) || (j1 == cur - 1);
        const bool c0 = !f0 && j0 <= cur, c1 = !f1 && j1 <= cur;
        const int nforced = cur >= 2 ? 3 : cur + 1, slots = NTOP - nforced;
        int rk0 = 0, rk1 = 0;
        const int ncand_hi = cur < NSLC ? cur : NSLC - 1;
        for (int i = 1; i <= ncand_hi; ++i) {
            const bool fi = (i == cur) || (i == cur - 1); if (fi) continue;
            const float v = sc[i];
            rk0 += (v > a0 || (v == a0 && i < j0)) ? 1 : 0; rk1 += (v > a1 || (v == a1 && i < j1)) ? 1 : 0;
        }
        const bool s0 = (f0 && j0 <= cur) || (c0 && rk0 < slots), s1 = (f1 && j1 <= cur) || (c1 && rk1 < slots);
        const unsigned long long m0 = __ballot(s0), m1 = __ballot(s1);
        if (lane == 0) { v4u w = {(unsigned)m0, (unsigned)(m0 >> 32), (unsigned)m1, (unsigned)(m1 >> 32)}; *(v4u*)(SEL + (size_t)it * 4) = w; }
        LDS_WAIT();
    }
}

#ifndef STAGE
#define STAGE 3
#endif
#define ZERO_OB_PHASE PH_BEGIN { v4u z = {0u, 0u, 0u, 0u}; v4u* p = (v4u*)Ob; const long n = (long)MTOK * DM / 8; \
            for (long i = (long)F.bid * NTHR + F.tid; i < n; i += (long)F.G * NTHR) p[i] = z; } PH_END
#define MIXER0_PHASES \
    PH_BEGIN REP(10) hgrn_phase_a(F, BIG, (const float*)(ws + WS_LB), (bf16*)(ws + WS_QT), (float*)(ws + WS_OINTRA), (float*)(ws + WS_DS), (float*)(ws + WS_DEC)); \
             REP(11) sb_phase(F, BIG, Ob); PH_END \
    PH_BEGIN REP(12) hgrn_phase_b(F, (const float*)(ws + WS_DS), (const float*)(ws + WS_DEC), (bf16*)(ws + WS_SPREV)); PH_END \
    PH_BEGIN REP(13) hgrn_phase_c(F, BIG, (const bf16*)(ws + WS_QT), (const float*)(ws + WS_OINTRA), (const bf16*)(ws + WS_SPREV), args.in[IN_HGRN_NW], Ob); PH_END
#if STAGE <= 2
#define MIXER1_PHASES ZERO_OB_PHASE
#else
#define MIXER1_PHASES \
    PH_BEGIN REP(14) { nsa_rope_phase(F, BIG, (bf16*)(ws + WS_QROT), (bf16*)(ws + WS_KSROT), (bf16*)(ws + WS_KWROT), (bf16*)(ws + WS_OVL)); \
             nsa_compress_phase(F, BIG, args.in[IN_NSA_CMP_POS], (const bf16*)(ws + WS_W_C1), (const bf16*)(ws + WS_W_C2), (bf16*)(ws + WS_KCMP), (bf16*)(ws + WS_VCMP)); } PH_END \
    PH_BEGIN REP(15) { nsa_attn_phase<0>(F, BIG, BIG, (const bf16*)(ws + WS_KCMP), (const bf16*)(ws + WS_VCMP), nullptr, (float*)(ws + WS_O32), nullptr, nullptr); \
             nsa_attn_phase<1>(F, BIG, BIG, (const bf16*)(ws + WS_KCMP), (const bf16*)(ws + WS_OVL), nullptr, nullptr, (float*)(ws + WS_IMP), nullptr); } PH_END \
    PH_BEGIN REP(16) nsa_topk_phase(F, (const float*)(ws + WS_IMP), (unsigned*)(ws + WS_SEL)); PH_END \
    PH_BEGIN nsa_attn_phase<2>(F, BIG, (const bf16*)(ws + WS_QROT), (const bf16*)(ws + WS_KSROT), nullptr, (const unsigned*)(ws + WS_SEL), (float*)(ws + WS_O32), nullptr, nullptr); PH_END \
    PH_BEGIN REP(17) nsa_attn_phase<3>(F, BIG, (const bf16*)(ws + WS_QROT), (const bf16*)(ws + WS_KWROT), nullptr, nullptr, (float*)(ws + WS_O32), nullptr, Ob); PH_END
#endif
#ifndef REPMASK
#define REPMASK 0u
#endif
#define REP(gid) for (int r_ = 0; r_ <= (int)((REPMASK >> (gid)) & 1u); ++r_)
#define PH_BEGIN if (pc >= lo && pc < hi) { F.fresh();
#define PH_END   if (pc + 1 < hi) { XcdBarrier bb_ = bar; asm volatile("" : "+s"(bb_.bar), "+s"(bb_.x)); xcd_barrier(bb_); } } ++pc;
template <int l>
__device__ __forceinline__ void layer_body(Frame& F, const Args& args, const XcdBarrier& bar, int& pc, const int lo, const int hi) {
    unsigned char* ws = args.ws;
    bf16* HB = (bf16*)(ws + WS_HB); float* Y = (float*)(ws + WS_Y); float* H32 = args.out;
    bf16* BIG = (bf16*)(ws + WS_BIG); bf16* Gm = (bf16*)(ws + WS_G); bf16* Ob = (bf16*)(ws + WS_O);
    bf16* XQ = (bf16*)(ws + WS_XQ); bf16* XO = (bf16*)(ws + WS_XO);
        const float* res0 = l == 0 ? args.in[IN_X] : H32;
        PH_BEGIN REP(1) {
            const int N = l == 0 ? AB_IN : NSA_INP;
            pg8::Gemm g{HB, l == 0 ? (const bf16*)(ws + WS_W_ABIN) : (const bf16*)(ws + WS_W_NSAIN), MTOK, N, DM};
            pg8::StaticOrder S; S.init(MTOK, N, F.G, F.bid);
            pg8::EpiBf16<0> E{BIG, N, nullptr, 0, 0, 1.f};
            pg8::gemm_phase<pg8::EpiBf16<0>, pg8::StaticOrder, PG8_ALIGN, PG8_SP2>(F.lds + RING_OFF, g, S, E);
        } PH_END
#if STAGE <= 1
        ZERO_OB_PHASE
#else
        if (l == 0) {
            MIXER0_PHASES
        } else {
            MIXER1_PHASES
        }
#endif
        PH_BEGIN REP(2) {
            pg8::Gemm g{Ob, l == 0 ? (const bf16*)(ws + WS_W_ABOUT) : (const bf16*)(ws + WS_W_NSAOUT), MTOK, DM, DM};
            pg8::StaticOrder S; S.init(MTOK, DM, F.G, F.bid);
            pg8::EpiRes E{Y, res0, DM, DN_ALPHA};
            pg8::gemm_phase<pg8::EpiRes, pg8::StaticOrder, PG8_ALIGN, PG8_SP2>(F.lds + RING_OFF, g, S, E);
        } PH_END
        PH_BEGIN REP(7) ln_phase(F, Y, args.in[IN_LN_G] + (size_t)(l * 3 + 0) * DM, args.in[IN_LN_B] + (size_t)(l * 3 + 0) * DM, H32, HB); PH_END
        PH_BEGIN REP(3) {
            {   pg8::Gemm g{HB, (const bf16*)(ws + WS_W_XQ) + (size_t)l * XW * DM, MTOK, XW, DM};
                pg8::RangeOrder S; S.init(MTOK, XW, 0, 128, F.bid);
                pg8::EpiBf16<0> E{XQ, XW, nullptr, 0, 0, 1.f};
                pg8::gemm_phase<pg8::EpiBf16<0>, pg8::RangeOrder, PG8_ALIGN, PG8_SP2>(F.lds + RING_OFF, g, S, E); }
            {   pg8::Gemm g{(const bf16*)(ws + WS_MEMB), (const bf16*)(ws + WS_W_XKV) + (size_t)l * 2 * XW * DM, BATCH * NMEM, 2 * XW, DM};
                pg8::RangeOrder S; S.init(BATCH * NMEM, 2 * XW, 128, 8, F.bid);
                pg8::EpiBf16<0> E{(bf16*)(ws + WS_XKV) + (size_t)l * BATCH * NMEM * 2 * XW, 2 * XW, nullptr, 0, 0, 1.f};
                pg8::gemm_phase<pg8::EpiBf16<0>, pg8::RangeOrder, PG8_ALIGN, PG8_SP2>(F.lds + RING_OFF, g, S, E); }
        } PH_END
        PH_BEGIN REP(9) xattn_phase(F, XQ, (const bf16*)(ws + WS_XKV) + (size_t)l * BATCH * NMEM * 2 * XW, XO); PH_END
        PH_BEGIN REP(4) {
            pg8::Gemm g{XO, (const bf16*)(ws + WS_W_XO) + (size_t)l * DM * XW, MTOK, DM, XW};
            pg8::StaticOrder S; S.init(MTOK, DM, F.G, F.bid);
            pg8::EpiRes E{Y, H32, DM, DN_ALPHA};
            pg8::gemm_phase<pg8::EpiRes, pg8::StaticOrder, PG8_ALIGN, PG8_SP2>(F.lds + RING_OFF, g, S, E);
        } PH_END
        PH_BEGIN REP(7) ln_phase(F, Y, args.in[IN_LN_G] + (size_t)(l * 3 + 1) * DM, args.in[IN_LN_B] + (size_t)(l * 3 + 1) * DM, H32, HB); PH_END
        PH_BEGIN REP(5) {
            pg8::Gemm g{HB, (const bf16*)(ws + WS_W_UP) + (size_t)l * DFF2 * DM, MTOK, DFF2, DM};
            pg8::StaticOrder S; S.init(MTOK, DFF2, F.G, F.bid);
            pg8::EpiBf16<0> E{BIG, DFF2, nullptr, 0, 0, 1.f};
            pg8::gemm_phase<pg8::EpiBf16<0>, pg8::StaticOrder, PG8_ALIGN, PG8_SP2>(F.lds + RING_OFF, g, S, E);
        } PH_END
#if (REPMASK >> 20) & 1
        PH_BEGIN {
            pg8::Gemm g{HB, (const bf16*)(ws + WS_W_UP) + (size_t)l * DFF2 * DM, MTOK, DFF2, DM};
            pg8::ZeroOrder S; S.init(MTOK, DFF2, F.G, F.bid);
            pg8::EpiBf16<0> E{Gm, DFF2, nullptr, 0, 0, 1.f};
            pg8::gemm_phase<pg8::EpiBf16<0>, pg8::ZeroOrder, PG8_ALIGN, PG8_SP2>(F.lds + RING_OFF, g, S, E);
        } PH_END
#endif
        PH_BEGIN REP(8) convglu_phase(F, BIG, args.in[IN_FFN_CONV] + (size_t)l * 3 * DFF, Gm); PH_END
        PH_BEGIN REP(6) {
            pg8::Gemm g{Gm, (const bf16*)(ws + WS_W_DOWN) + (size_t)l * DM * DFF, MTOK, DM, DFF};
            pg8::StaticOrder S; S.init(MTOK, DM, F.G, F.bid);
            pg8::EpiRes E{Y, H32, DM, DN_ALPHA};
            pg8::gemm_phase<pg8::EpiRes, pg8::StaticOrder, PG8_ALIGN, PG8_SP2>(F.lds + RING_OFF, g, S, E);
        } PH_END
        PH_BEGIN REP(7) ln_phase(F, Y, args.in[IN_LN_G] + (size_t)(l * 3 + 2) * DM, args.in[IN_LN_B] + (size_t)(l * 3 + 2) * DM, H32, HB); PH_END
}
__global__ void __launch_bounds__(NTHR, 2) mega_fwd(Args args) {
    extern __shared__ __attribute__((aligned(16))) unsigned char lds_raw[];
    Frame F;
    F.lds = (LAS unsigned char*)lds_raw; F.ws = args.ws;
    F.tid = threadIdx.x; F.lane = F.tid & 63; F.wave = __builtin_amdgcn_readfirstlane(F.tid >> 6); F.G = gridDim.x;
    unsigned char* ws = args.ws;
    gu32* ctl = (gu32*)(ws + WS_CTL);
    for (int u = F.tid; u < (LDS_BYTES - LDSCTL_OFF) / 4; u += NTHR) ((LAS unsigned*)(F.lds + LDSCTL_OFF))[u] = 0u;
    __syncthreads();
    volatile LAS unsigned* MISC = (volatile LAS unsigned*)(F.lds + MISC_OFF);
    XcdBarrier bar = xcd_barrier_post((unsigned*)(ctl + CW_BAR), MISC + 8);
    const int lo = args.ph_lo, hi = args.ph_hi; int pc = 0;
    bf16* HB = (bf16*)(ws + WS_HB); float* Y = (float*)(ws + WS_Y); float* H32 = args.out;
    bf16* BIG = (bf16*)(ws + WS_BIG); bf16* Gm = (bf16*)(ws + WS_G); bf16* Ob = (bf16*)(ws + WS_O);
    bf16* XQ = (bf16*)(ws + WS_XQ); bf16* XO = (bf16*)(ws + WS_XO);

    PH_BEGIN REP(0) p0_prologue(F, args); PH_END

    layer_body<0>(F, args, bar, pc, lo, hi);
    layer_body<1>(F, args, bar, pc, lo, hi);
}

extern "C" void kernel_launch(void* const* d_in, const int* in_sizes, int n_in, void* d_out, int out_size, void* d_ws, size_t ws_size, hipStream_t stream) {
    static int grid = 0;
    if (grid == 0) {
        if (n_in != 19 || in_sizes[0] != MTOK * DM || out_size != MTOK * DM || ws_size < WS_END) {
            fprintf(stderr, "kernel_launch: shape mismatch n_in %d in0 %d out %d ws %zu (need %zu)\n", n_in, n_in > 0 ? in_sizes[0] : -1, out_size, ws_size, (size_t)WS_END); grid = -1; return; }
        int dev = 0, cus = 0, per_cu = 0;
        if (hipGetDevice(&dev) != hipSuccess || hipDeviceGetAttribute(&cus, hipDeviceAttributeMultiprocessorCount, dev) != hipSuccess) { grid = -1; return; }
        if (hipFuncSetAttribute((const void*)mega_fwd, hipFuncAttributeMaxDynamicSharedMemorySize, LDS_BYTES) != hipSuccess) { fprintf(stderr, "kernel_launch: hipFuncSetAttribute failed\n"); grid = -1; return; }
        if (hipOccupancyMaxActiveBlocksPerMultiprocessor(&per_cu, (const void*)mega_fwd, NTHR, LDS_BYTES) != hipSuccess || per_cu < 1)
            fprintf(stderr, "kernel_launch: note: occupancy query reports %d workgroups per CU\n", per_cu);
        (void)hipGetLastError();
        grid = cus;
    }
    if (grid < 0) return;
    if (hipMemsetAsync((char*)d_ws + WS_CTL, 0, CTL_ZERO_BYTES, stream) != hipSuccess) { fprintf(stderr, "kernel_launch: memset failed\n"); return; }
    Args a{};
    for (int i = 0; i < 19; ++i) a.in[i] = (const float*)d_in[i];
    a.out = (float*)d_out; a.ws = (unsigned char*)d_ws; a.ph_lo = 0; a.ph_hi = 1 << 20;
    hipLaunchKernelGGL(mega_fwd, dim3(grid), dim3(NTHR), LDS_BYTES, stream, a);
    const hipError_t le = hipPeekAtLastError();
    if (le != hipSuccess) fprintf(stderr, "kernel_launch: launch failed: %s\n", hipGetErrorName(le));
}
```

```cpp
#include <hip/hip_runtime.h>
#include <cstdio>
#include <cstdint>
namespace pg8 {
#define PG8_LAS __attribute__((address_space(3)))
typedef unsigned short bf16_t;
typedef short bf16x8 __attribute__((ext_vector_type(8)));
typedef float f32x4 __attribute__((ext_vector_type(4)));
typedef unsigned u32x4 __attribute__((ext_vector_type(4)));
constexpr int BM = 256, BK = 64, HALF = 128, HTB = HALF * BK * 2  , STAGE_BYTES = 8 * HTB, NXCD = 8, WGM = 8;

__host__ __device__ __forceinline__ int lds_byte(int r, int c) { const int st = (r >> 4) * 2 + (c >> 5), rr = r & 15, cc = c & 31, ob = rr * 64 + cc * 2; return st * 1024 + (ob ^ (((ob >> 9) & 1) << 5)); }
__host__ __device__ __forceinline__ void stage_rc(int b, int& R, int& C) { const int st = b / 1024, sb = b % 1024, swz = sb ^ (((sb >> 9) & 1) << 5); R = (st >> 1) * 16 + swz / 64; C = (st & 1) * 32 + (swz % 64) / 2; }
__host__ __device__ __forceinline__ int perm32(int rho) { const int n = rho >> 4, i = rho & 15; return 8 * (i >> 2) + 4 * n + (i & 3); }

struct Unit { int pm, pn; };
struct Gemm { const bf16_t* A; const bf16_t* Bt; int M, N, K; };

struct StaticOrder {
    int nM, nN, nwg, G, c;
    __host__ __device__ void init(int M, int N, int G_, int c_) { nM = M / BM; nN = N / BM; nwg = nM * nN; G = G_; c = c_; }
    __host__ __device__ bool next(int i, Unit& u) const {
        const long L = (long)i * G + c; if (L >= nwg) return false;
        int wgid = (int)L; { const int q = nwg / NXCD, r = nwg % NXCD, xcd = wgid % NXCD, off = wgid / NXCD; wgid = (xcd < r ? xcd * (q + 1) : r * (q + 1) + (xcd - r) * q) + off; }
        const int nig = WGM * nN, gid = wgid / nig, fm = gid * WGM, gsz = (nM - fm) < WGM ? (nM - fm) : WGM;
        u.pm = fm + ((wgid % nig) % gsz); u.pn = (wgid % nig) / gsz; return true;
    }
    __device__ __forceinline__ void a_ready(const Unit&) const {}
    __device__ __forceinline__ void done(const Unit&) const {}
};

__device__ __forceinline__ unsigned cvt_pk_bf16(float lo, float hi) { unsigned r; asm volatile("v_cvt_pk_bf16_f32 %0, %1, %2" : "=v"(r) : "v"(lo), "v"(hi)); return r; }
typedef float f32x2 __attribute__((ext_vector_type(2)));
__device__ __forceinline__ f32x2 gelu_pk(f32x2 v) {
    const f32x2 av = __builtin_elementwise_abs(v), d = av * 0.2316418882f + 1.0f;
    f32x2 t; t.x = __builtin_amdgcn_rcpf(d.x); t.y = __builtin_amdgcn_rcpf(d.y);
    f32x2 q = t * 0.5307027145f + (-0.7265760135f); q = q * t + 0.7107068705f; q = q * t + (-0.142248368f); q = q * t + 0.127414796f; q = q * t;
    const f32x2 s = (v * v) * (-0.72134752044f);
    f32x2 e; e.x = __builtin_amdgcn_exp2f(s.x); e.y = __builtin_amdgcn_exp2f(s.y);
    const f32x2 m = v * (q * e), r = v - m;
    f32x2 o; o.x = v.x < 0.f ? m.x : r.x; o.y = v.y < 0.f ? m.y : r.y; return o;
}

template <int ACT  > struct EpiBf16 {
    static constexpr bool PERM = true, AFTER_DRAIN = false; static_assert(ACT == 0 || ACT == 1, "EpiBf16: ACT is 0 (none) or 1 (gelu_pk)");
    bf16_t* O; int ldc; const float* bias; int split_cols; size_t split_stride; float scale0;
    __device__ __forceinline__ void operator()(const f32x4 (&acc)[2][2][4][2], const Unit& u, int wr, int wc, int fr, int fq) const {
        const int row0 = u.pm * BM + wr * 64 + fr; int colt = u.pn * BM; bf16_t* base = O;
        float sc = 1.f; if (split_cols) { const int t = colt / split_cols; base += (size_t)t * split_stride; colt -= t * split_cols; if (t == 0) sc = scale0; }
        const int col0 = colt + wc * 32 + 8 * fq, bcol0 = u.pn * BM + wc * 32 + 8 * fq;
        f32x4 bv[2][2];
#pragma unroll
        for (int bj = 0; bj < 2; ++bj)
#pragma unroll
            for (int n = 0; n < 2; ++n) bv[bj][n] = bias ? *(const f32x4*)(bias + bcol0 + bj * HALF + 4 * n) : (f32x4){0.f, 0.f, 0.f, 0.f};
#pragma unroll
        for (int ai = 0; ai < 2; ++ai)
#pragma unroll
            for (int m = 0; m < 4; ++m) { bf16_t* rowp = base + (size_t)(row0 + ai * HALF + m * 16) * ldc + col0;
#pragma unroll
                for (int bj = 0; bj < 2; ++bj) { f32x4 v0 = acc[ai][bj][m][0] + bv[bj][0], v1 = acc[ai][bj][m][1] + bv[bj][1];
                    if (ACT == 1) { f32x2 a = gelu_pk((f32x2){v0[0], v0[1]}), b = gelu_pk((f32x2){v0[2], v0[3]}), c = gelu_pk((f32x2){v1[0], v1[1]}), d = gelu_pk((f32x2){v1[2], v1[3]});
                        v0 = (f32x4){a.x, a.y, b.x, b.y}; v1 = (f32x4){c.x, c.y, d.x, d.y}; }
                    v0 = v0 * sc; v1 = v1 * sc; u32x4 w; w.x = cvt_pk_bf16(v0[0], v0[1]); w.y = cvt_pk_bf16(v0[2], v0[3]); w.z = cvt_pk_bf16(v1[0], v1[1]); w.w = cvt_pk_bf16(v1[2], v1[3]);
                    *(u32x4*)(rowp + bj * HALF) = w; } }
    }
};


struct EpiRes {
    static constexpr bool PERM = false, AFTER_DRAIN = false;
    float* Y; const float* res; int ldc; float alpha;
    __device__ __forceinline__ void operator()(const f32x4 (&acc)[2][2][4][2], const Unit& u, int wr, int wc, int fr, int fq) const {
        const int row0 = u.pm * BM + wr * 64 + fr, col0 = u.pn * BM + wc * 32 + 4 * fq;
#pragma unroll
        for (int ai = 0; ai < 2; ++ai)
#pragma unroll
            for (int m = 0; m < 4; ++m) { const size_t off = (size_t)(row0 + ai * HALF + m * 16) * ldc + col0;
#pragma unroll
                for (int bj = 0; bj < 2; ++bj)
#pragma unroll
                    for (int n = 0; n < 2; ++n) { const f32x4 r = *(const f32x4*)(res + off + bj * HALF + n * 16);
                        *(f32x4*)(Y + off + bj * HALF + n * 16) = r * alpha + acc[ai][bj][m][n]; } }
    }
};
struct RangeOrder {
    int nM, nN, ntot, c0, nw, c;
    __host__ __device__ void init(int M, int N, int c0_, int nw_, int c_) { nM = M / BM; nN = N / BM; ntot = nM * nN; c0 = c0_; nw = nw_; c = c_; }
    __host__ __device__ bool next(int i, Unit& u) const {
        if (c < c0 || c >= c0 + nw) return false;
        const int L = i * nw + (c - c0); if (L >= ntot) return false;
        u.pm = L / nN; u.pn = L % nN; return true;
    }
    __device__ __forceinline__ void a_ready(const Unit&) const {}
    __device__ __forceinline__ void done(const Unit&) const {}
};

struct ZeroOrder : StaticOrder {
    __host__ __device__ bool next(int i, Unit& u) const { const bool r = StaticOrder::next(i, u); u.pm = 0; u.pn = 0; return r; }
};

struct EpiResBf {
    static constexpr bool PERM = true, AFTER_DRAIN = false;
    bf16_t* Y; const bf16_t* res; int ldc; float alpha;
    __device__ __forceinline__ void operator()(const f32x4 (&acc)[2][2][4][2], const Unit& u, int wr, int wc, int fr, int fq) const {
        const int row0 = u.pm * BM + wr * 64 + fr, col0 = u.pn * BM + wc * 32 + 8 * fq;
#pragma unroll
        for (int ai = 0; ai < 2; ++ai)
#pragma unroll
            for (int m = 0; m < 4; ++m) { const size_t off = (size_t)(row0 + ai * HALF + m * 16) * ldc + col0;
#pragma unroll
                for (int bj = 0; bj < 2; ++bj) { const u32x4 r = *(const u32x4*)(res + off + bj * HALF);
                    const f32x4 v0 = acc[ai][bj][m][0], v1 = acc[ai][bj][m][1];
                    u32x4 w;
                    w.x = cvt_pk_bf16(__builtin_bit_cast(float, r.x << 16) * alpha + v0[0], __builtin_bit_cast(float, r.x & 0xffff0000u) * alpha + v0[1]);
                    w.y = cvt_pk_bf16(__builtin_bit_cast(float, r.y << 16) * alpha + v0[2], __builtin_bit_cast(float, r.y & 0xffff0000u) * alpha + v0[3]);
                    w.z = cvt_pk_bf16(__builtin_bit_cast(float, r.z << 16) * alpha + v1[0], __builtin_bit_cast(float, r.z & 0xffff0000u) * alpha + v1[1]);
                    w.w = cvt_pk_bf16(__builtin_bit_cast(float, r.w << 16) * alpha + v1[2], __builtin_bit_cast(float, r.w & 0xffff0000u) * alpha + v1[3]);
                    *(u32x4*)(Y + off + bj * HALF) = w; } }
    }
};

struct EpiResF {
    static constexpr bool PERM = true, AFTER_DRAIN = false;
    float* Y; const bf16_t* res; int ldc; float alpha;
    __device__ __forceinline__ void operator()(const f32x4 (&acc)[2][2][4][2], const Unit& u, int wr, int wc, int fr, int fq) const {
        const int row0 = u.pm * BM + wr * 64 + fr, col0 = u.pn * BM + wc * 32 + 8 * fq;
#pragma unroll
        for (int ai = 0; ai < 2; ++ai)
#pragma unroll
            for (int m = 0; m < 4; ++m) { const size_t off = (size_t)(row0 + ai * HALF + m * 16) * ldc + col0;
#pragma unroll
                for (int bj = 0; bj < 2; ++bj) { const u32x4 r = *(const u32x4*)(res + off + bj * HALF);
                    f32x4 o0, o1;
                    o0[0] = __builtin_bit_cast(float, r.x << 16); o0[1] = __builtin_bit_cast(float, r.x & 0xffff0000u); o0[2] = __builtin_bit_cast(float, r.y << 16); o0[3] = __builtin_bit_cast(float, r.y & 0xffff0000u);
                    o1[0] = __builtin_bit_cast(float, r.z << 16); o1[1] = __builtin_bit_cast(float, r.z & 0xffff0000u); o1[2] = __builtin_bit_cast(float, r.w << 16); o1[3] = __builtin_bit_cast(float, r.w & 0xffff0000u);
                    *(f32x4*)(Y + off + bj * HALF) = o0 * alpha + acc[ai][bj][m][0]; *(f32x4*)(Y + off + bj * HALF + 4) = o1 * alpha + acc[ai][bj][m][1]; } }
    }
};

struct EpiResLn {
    static constexpr bool PERM = true, AFTER_DRAIN = false;
    bf16_t* Y; const float* stats; const float* g; const float* b; int ldc; float alpha;
    __device__ __forceinline__ void operator()(const f32x4 (&acc)[2][2][4][2], const Unit& u, int wr, int wc, int fr, int fq) const {
        const int row0 = u.pm * BM + wr * 64 + fr, col0 = u.pn * BM + wc * 32 + 8 * fq;
        f32x4 gv[2][2], bv[2][2];
#pragma unroll
        for (int bj = 0; bj < 2; ++bj)
#pragma unroll
            for (int n = 0; n < 2; ++n) { gv[bj][n] = *(const f32x4*)(g + col0 + bj * HALF + 4 * n) * alpha; bv[bj][n] = *(const f32x4*)(b + col0 + bj * HALF + 4 * n) * alpha; }
#pragma unroll
        for (int ai = 0; ai < 2; ++ai)
#pragma unroll
            for (int m = 0; m < 4; ++m) { const int row = row0 + ai * HALF + m * 16; const size_t off = (size_t)row * ldc + col0;
                const float mean = stats[2 * row], rstd = stats[2 * row + 1];
#pragma unroll
                for (int bj = 0; bj < 2; ++bj) { const u32x4 r = *(const u32x4*)(Y + off + bj * HALF);
                    f32x4 y0, y1;
                    y0[0] = __builtin_bit_cast(float, r.x << 16); y0[1] = __builtin_bit_cast(float, r.x & 0xffff0000u); y0[2] = __builtin_bit_cast(float, r.y << 16); y0[3] = __builtin_bit_cast(float, r.y & 0xffff0000u);
                    y1[0] = __builtin_bit_cast(float, r.z << 16); y1[1] = __builtin_bit_cast(float, r.z & 0xffff0000u); y1[2] = __builtin_bit_cast(float, r.w << 16); y1[3] = __builtin_bit_cast(float, r.w & 0xffff0000u);
                    const f32x4 o0 = (y0 - mean) * rstd * gv[bj][0] + bv[bj][0] + acc[ai][bj][m][0], o1 = (y1 - mean) * rstd * gv[bj][1] + bv[bj][1] + acc[ai][bj][m][1];
                    u32x4 w; w.x = cvt_pk_bf16(o0[0], o0[1]); w.y = cvt_pk_bf16(o0[2], o0[3]); w.z = cvt_pk_bf16(o1[0], o1[1]); w.w = cvt_pk_bf16(o1[2], o1[3]);
                    *(u32x4*)(Y + off + bj * HALF) = w; } }
    }
};
template <class Epi, class Sched, bool ALIGN_EPI = false, bool SP2 = false>
__device__ __forceinline__ void gemm_phase(PG8_LAS unsigned char* lds, const Gemm g, const Sched& S, const Epi& E) {
    int tid_l = threadIdx.x; asm volatile("" : "+v"(tid_l)); const int tid = tid_l, wid = __builtin_amdgcn_readfirstlane(tid >> 6), lane = tid & 63, wr = wid >> 2, wc = wid & 3, fr = lane & 15, fq = lane >> 4;
    const int K = g.K, nt = K / BK;
    unsigned voffA[2], voffB[2];
#pragma unroll
    for (int i = 0; i < 2; ++i) { int R, C; stage_rc(tid * 16 + i * 8192, R, C); const int Rb = Epi::PERM ? ((R & ~31) + perm32(R & 31)) : R;
        voffA[i] = (unsigned)(R * K + C) * 2u; voffB[i] = (unsigned)(Rb * K + C) * 2u; }
    const size_t kstep = (size_t)(BK * 2);
    const size_t hstep = (size_t)HALF * K * 2;
    const size_t tstep = 2 * hstep;
    const unsigned ldsw = (unsigned)wid * 1024u;
    const int aoff = lds_byte(wr * 64 + fr, fq * 8), boff = lds_byte(wc * 32 + fr, fq * 8);
#define PG8_SA(b, h) (((b) * 2 + (h)) * HTB)
#define PG8_SB(b, h) ((4 + (b) * 2 + (h)) * HTB)
#define PG8_STAGE(bufoff, gbase, voff) do { _Pragma("unroll") for (int _i = 0; _i < 2; ++_i) \
        __builtin_amdgcn_global_load_lds((const unsigned*)((const char*)(gbase) + (voff)[_i]), (PG8_LAS unsigned*)(lds + (bufoff) + ldsw + _i * 8192), 16, 0, 0); } while (0)
#define PG8_LDA(dst, b, h) do { _Pragma("unroll") for (int m = 0; m < 4; ++m) _Pragma("unroll") for (int k = 0; k < 2; ++k) dst[m][k] = *(const PG8_LAS bf16x8*)(lds + PG8_SA(b, h) + aoff + m * 2048 + k * 1024); } while (0)
#define PG8_LDB(dst, b, h) do { _Pragma("unroll") for (int n = 0; n < 2; ++n) _Pragma("unroll") for (int k = 0; k < 2; ++k) dst[n][k] = *(const PG8_LAS bf16x8*)(lds + PG8_SB(b, h) + boff + n * 2048 + k * 1024); } while (0)
#define PG8_MMA(ai, bj, At, Bt) do { __builtin_amdgcn_s_setprio(1); _Pragma("unroll") for (int m = 0; m < 4; ++m) _Pragma("unroll") for (int n = 0; n < 2; ++n) _Pragma("unroll") for (int k = 0; k < 2; ++k) \
        acc[ai][bj][m][n] = __builtin_amdgcn_mfma_f32_16x16x32_bf16(Bt[n][k], At[m][k], acc[ai][bj][m][n], 0, 0, 0); __builtin_amdgcn_s_setprio(0); } while (0)
#define PG8_WAIT_V(n) asm volatile("s_waitcnt vmcnt(" #n ")" ::: "memory")
#define PG8_WAIT_L(n) asm volatile("s_waitcnt lgkmcnt(" #n ")" ::: "memory")
#define PG8_BAR __builtin_amdgcn_s_barrier()
#define PG8_SCHED __builtin_amdgcn_sched_barrier(0)
    Unit cur, nxt; int ui = 0;
    if (!S.next(0, cur)) return;
    f32x4 acc[2][2][4][2];
#pragma unroll
    for (int a = 0; a < 2; ++a)
#pragma unroll
        for (int b = 0; b < 2; ++b)
#pragma unroll
            for (int m = 0; m < 4; ++m)
#pragma unroll
                for (int n = 0; n < 2; ++n) acc[a][b][m][n] = (f32x4){0.f, 0.f, 0.f, 0.f};
    bf16x8 At[4][2], B0[2][2], B1[2][2];
    const char* cA = (const char*)g.A + (size_t)cur.pm * tstep; const char* cB = (const char*)g.Bt + (size_t)cur.pn * tstep;
    S.a_ready(cur);
    if constexpr (SP2) {
        PG8_STAGE(PG8_SB(0, 0), cB, voffB); PG8_STAGE(PG8_SB(0, 1), cB + hstep, voffB); PG8_STAGE(PG8_SA(0, 0), cA, voffA); PG8_STAGE(PG8_SA(0, 1), cA + hstep, voffA);
        if (wr == 1) PG8_BAR;
        PG8_WAIT_V(2); PG8_BAR;
        PG8_STAGE(PG8_SB(1, 0), cB + kstep, voffB); PG8_STAGE(PG8_SA(1, 0), cA + kstep, voffA); PG8_STAGE(PG8_SB(1, 1), cB + hstep + kstep, voffB);
        PG8_WAIT_V(6); PG8_BAR;
    } else {
        PG8_STAGE(PG8_SB(0, 0), cB, voffB); PG8_STAGE(PG8_SA(0, 0), cA, voffA); PG8_STAGE(PG8_SB(0, 1), cB + hstep, voffB); PG8_STAGE(PG8_SA(0, 1), cA + hstep, voffA);
        if (wr == 1) PG8_BAR;
        PG8_WAIT_V(4); PG8_BAR;
        PG8_STAGE(PG8_SB(1, 0), cB + kstep, voffB); PG8_STAGE(PG8_SA(1, 0), cA + kstep, voffA); PG8_STAGE(PG8_SB(1, 1), cB + hstep + kstep, voffB);
        PG8_WAIT_V(6); PG8_BAR;
    }
    for (;;) {
        const bool has_next = S.next(ui + 1, nxt);
        const char* nA = has_next ? (const char*)g.A + (size_t)nxt.pm * tstep : cA; const char* nB = has_next ? (const char*)g.Bt + (size_t)nxt.pn * tstep : cB;
        for (int t = 0; t < nt; t += 2) {
            const bool last = (t == nt - 2);
            const char* a1 = cA + (size_t)(t + 1) * kstep;
            const char* a2 = last ? nA : cA + (size_t)(t + 2) * kstep; const char* b2 = last ? nB : cB + (size_t)(t + 2) * kstep;
            const char* a3 = a2 + kstep; const char* b3 = b2 + kstep;
            if (last && has_next) S.a_ready(nxt);
            if constexpr (SP2) {
            PG8_LDB(B0, 0, 0); PG8_LDB(B1, 0, 1); PG8_SCHED; PG8_LDA(At, 0, 0); PG8_STAGE(PG8_SA(1, 1), a1 + hstep, voffA);
            PG8_WAIT_V(8); PG8_WAIT_L(0); PG8_BAR; PG8_MMA(0, 0, At, B0); PG8_MMA(0, 1, At, B1); PG8_BAR; PG8_SCHED;
            PG8_LDA(At, 0, 1); PG8_STAGE(PG8_SB(0, 0), b2, voffB); PG8_STAGE(PG8_SB(0, 1), b2 + hstep, voffB); PG8_STAGE(PG8_SA(0, 0), a2, voffA);
            PG8_WAIT_V(8); PG8_WAIT_L(0); PG8_BAR; PG8_MMA(1, 0, At, B0); PG8_MMA(1, 1, At, B1); PG8_BAR; PG8_SCHED;
            PG8_LDB(B0, 1, 0); PG8_LDB(B1, 1, 1); PG8_SCHED; PG8_LDA(At, 1, 0); PG8_STAGE(PG8_SA(0, 1), a2 + hstep, voffA);
            PG8_WAIT_V(8); PG8_WAIT_L(0); PG8_BAR; PG8_MMA(0, 0, At, B0); PG8_MMA(0, 1, At, B1); PG8_BAR; PG8_SCHED;
            PG8_LDA(At, 1, 1); PG8_STAGE(PG8_SB(1, 0), b3, voffB); PG8_STAGE(PG8_SB(1, 1), b3 + hstep, voffB); PG8_STAGE(PG8_SA(1, 0), a3, voffA);
            PG8_WAIT_V(8); PG8_WAIT_L(0); PG8_BAR; PG8_MMA(1, 0, At, B0); PG8_MMA(1, 1, At, B1); PG8_BAR; PG8_SCHED;
            } else {
            PG8_LDB(B0, 0, 0); PG8_SCHED; PG8_LDA(At, 0, 0); PG8_STAGE(PG8_SA(1, 1), a1 + hstep, voffA);
            PG8_WAIT_L(8); PG8_BAR; PG8_WAIT_L(0); PG8_MMA(0, 0, At, B0); PG8_BAR; PG8_SCHED;
            PG8_LDB(B1, 0, 1); PG8_STAGE(PG8_SB(0, 0), b2, voffB);
            PG8_BAR; PG8_WAIT_L(0); PG8_MMA(0, 1, At, B1); PG8_BAR;
            PG8_LDA(At, 0, 1); PG8_STAGE(PG8_SA(0, 0), a2, voffA);
            PG8_BAR; PG8_WAIT_L(0); PG8_MMA(1, 0, At, B0); PG8_BAR; PG8_SCHED;
            PG8_STAGE(PG8_SB(0, 1), b2 + hstep, voffB);
            PG8_WAIT_V(6); PG8_BAR; PG8_MMA(1, 1, At, B1); PG8_BAR;
            PG8_LDB(B0, 1, 0); PG8_SCHED; PG8_LDA(At, 1, 0); PG8_STAGE(PG8_SA(0, 1), a2 + hstep, voffA);
            PG8_WAIT_L(8); PG8_BAR; PG8_WAIT_L(0); PG8_MMA(0, 0, At, B0); PG8_BAR; PG8_SCHED;
            PG8_LDB(B1, 1, 1); PG8_STAGE(PG8_SB(1, 0), b3, voffB);
            PG8_BAR; PG8_WAIT_L(0); PG8_MMA(0, 1, At, B1); PG8_BAR;
            PG8_LDA(At, 1, 1); PG8_STAGE(PG8_SA(1, 0), a3, voffA);
            PG8_BAR; PG8_WAIT_L(0); PG8_MMA(1, 0, At, B0); PG8_BAR; PG8_SCHED;
            PG8_STAGE(PG8_SB(1, 1), b3 + hstep, voffB);
            PG8_WAIT_V(6); PG8_BAR; PG8_MMA(1, 1, At, B1); PG8_BAR;
            }
        }
        if constexpr (ALIGN_EPI) { if (wr == 0) PG8_BAR; }
        if constexpr (!Epi::AFTER_DRAIN) { E(acc, cur, wr, wc, fr, fq); S.done(cur); }
        if (!has_next) break;
#pragma unroll
        for (int a = 0; a < 2; ++a)
#pragma unroll
            for (int b = 0; b < 2; ++b)
#pragma unroll
                for (int m = 0; m < 4; ++m)
#pragma unroll
                    for (int n = 0; n < 2; ++n) acc[a][b][m][n] = (f32x4){0.f, 0.f, 0.f, 0.f};
        cur = nxt; cA = nA; cB = nB; ++ui;
        if constexpr (ALIGN_EPI) { if (wr == 1) PG8_BAR; }
    }
    PG8_WAIT_V(0);
    if constexpr (!ALIGN_EPI) { if (wr == 0) PG8_BAR; }
    PG8_BAR;
    if constexpr (Epi::AFTER_DRAIN) { E.fused(acc, cur, wr, wc, fr, fq, lds, wid, lane); S.done(cur); }
#undef PG8_SA
#undef PG8_SB
#undef PG8_STAGE
#undef PG8_LDA
#undef PG8_LDB
#undef PG8_MMA
#undef PG8_WAIT_V
#undef PG8_WAIT_L
#undef PG8_BAR
#undef PG8_SCHED
}
}

#ifndef PG8_SP2
#define PG8_SP2 true
#endif
#ifndef PG8_ALIGN
#define PG8_ALIGN true
#endif
constexpr int NWAVES = 8, NTHR = 512;
constexpr int BATCH = 2, SEQ = 8192, DM = 4096, MTOK = BATCH * SEQ;
constexpr int HD = 128;
constexpr int A_HEADS = 16, B_HEADS = 16, A_W = 2048, B_W = 2048, AB_IN = 4 * A_W + 3 * B_W;
constexpr int NSA_H = 32, NSA_G = 4, NSA_R = 8, KVW = 512, NSA_IN = 4096 + 6 * KVW + 96, NSA_INP = 7424;
constexpr int NCMP = 511, NCMPP = 512, NSLC = 128, NTOP = 16, WINDOW = 512;
constexpr int NMEM = 256, XH = 4, XW = 512;
constexpr int DFF = 11008, DFF2 = 22016;
constexpr float LN_EPS = 1e-5f, RMS_EPS = 1e-6f;
constexpr float DN_ALPHA = 1.41421356237309515f;
constexpr size_t MiB = (size_t)1 << 20;
constexpr size_t WS_CTL = 0, CTL_ZERO_BYTES = 1 * MiB;
constexpr size_t WS_W_ABIN = 1 * MiB;
constexpr size_t WS_W_ABOUT = WS_W_ABIN + 112 * MiB;
constexpr size_t WS_W_NSAIN = WS_W_ABOUT + 32 * MiB;
constexpr size_t WS_W_NSAOUT = WS_W_NSAIN + 58 * MiB;
constexpr size_t WS_W_XQ = WS_W_NSAOUT + 32 * MiB;
constexpr size_t WS_W_XKV = WS_W_XQ + 8 * MiB;
constexpr size_t WS_W_XO = WS_W_XKV + 16 * MiB;
constexpr size_t WS_W_UP = WS_W_XO + 8 * MiB;
constexpr size_t WS_W_DOWN = WS_W_UP + 344 * MiB;
constexpr size_t WS_W_C1 = WS_W_DOWN + 172 * MiB;
constexpr size_t WS_W_C2 = WS_W_C1 + 2 * MiB;
constexpr size_t WS_MEMB = WS_W_C2 + 1 * MiB;
constexpr size_t WS_HB = WS_MEMB + 4 * MiB;
constexpr size_t WS_Y = WS_HB + 128 * MiB;
constexpr size_t WS_BIG = WS_Y + 256 * MiB;
constexpr size_t WS_G = WS_BIG + 688 * MiB;
constexpr size_t WS_O = WS_G + 344 * MiB;
constexpr size_t WS_MISC = WS_O + 128 * MiB;
constexpr size_t WS_END = WS_MISC + 64 * MiB;
constexpr size_t WS_XQ = WS_MISC;
constexpr size_t WS_XO = WS_MISC + 16 * MiB;
constexpr size_t WS_XKV = WS_MISC + 32 * MiB;
constexpr size_t WS_LB = WS_MISC + 34 * MiB;
constexpr size_t WS_STATS = WS_MISC + 35 * MiB;
constexpr size_t WS_PROJ0 = WS_BIG;
constexpr size_t WS_SPREV = WS_BIG + 448 * MiB;
constexpr size_t WS_QT = WS_G;
constexpr size_t WS_OINTRA = WS_G + 64 * MiB;
constexpr size_t WS_DEC = WS_G + 192 * MiB;
constexpr size_t WS_DS = WS_Y;
constexpr size_t WS_PROJ1 = WS_BIG;
constexpr size_t WS_QROT = WS_BIG + 232 * MiB;
constexpr size_t WS_KSROT = WS_BIG + 360 * MiB;
constexpr size_t WS_KWROT = WS_BIG + 376 * MiB;
constexpr size_t WS_KCMP = WS_BIG + 392 * MiB;
constexpr size_t WS_VCMP = WS_BIG + 393 * MiB;
constexpr size_t WS_OVL = WS_BIG + 394 * MiB;
constexpr size_t WS_SEL = WS_BIG + 395 * MiB;
constexpr size_t WS_IMP = WS_G + 256 * MiB;
constexpr size_t WS_O32 = WS_G;
static_assert(WS_SPREV + 128 * MiB <= WS_G && WS_DEC + 2 * MiB <= WS_O && WS_SEL + MiB <= WS_G, "ws map");
constexpr int CW_TMO = 0, CW_CODE = 1;
constexpr int CW_BAR = 4096;
constexpr int RING_OFF = 0, RING_BYTES = 131072;
constexpr int LDSCTL_OFF = RING_BYTES, MISC_OFF = LDSCTL_OFF + 320;
constexpr int LDS_BYTES = 147456;
static_assert(MISC_OFF + 128 <= LDS_BYTES, "LDS map");

#define GAS __attribute__((address_space(1)))
#define LAS __attribute__((address_space(3)))
typedef unsigned short bf16;
typedef unsigned v4u __attribute__((ext_vector_type(4)));
typedef unsigned v2u __attribute__((ext_vector_type(2)));
typedef float f32x4 __attribute__((ext_vector_type(4)));
typedef float f32x2 __attribute__((ext_vector_type(2)));
typedef float f32x16 __attribute__((ext_vector_type(16)));
typedef short bf16x8 __attribute__((ext_vector_type(8)));
typedef short s16x4 __attribute__((ext_vector_type(4)));
typedef GAS unsigned gu32;
#define RLX_AGENT __ATOMIC_RELAXED, __HIP_MEMORY_SCOPE_AGENT
#define LDS_WAIT() asm volatile("s_waitcnt lgkmcnt(0)" ::: "memory")
#define VM_WAIT() asm volatile("s_waitcnt vmcnt(0)" ::: "memory")
#define SBAR() __builtin_amdgcn_sched_barrier(0)
__device__ __forceinline__ unsigned f2bf(float f) { unsigned u = __builtin_bit_cast(unsigned, f); return (u + 0x7fffu + ((u >> 16) & 1u)) >> 16; }
__device__ __forceinline__ unsigned pk2(float lo, float hi) { return f2bf(lo) | (f2bf(hi) << 16); }
__device__ __forceinline__ float bf2f(unsigned short b) { return __builtin_bit_cast(float, (unsigned)b << 16); }
__device__ __forceinline__ float bflo(unsigned w) { return __builtin_bit_cast(float, w << 16); }
__device__ __forceinline__ float bfhi(unsigned w) { return __builtin_bit_cast(float, w & 0xffff0000u); }
__device__ __forceinline__ unsigned cvtpk(float lo, float hi) { unsigned r; asm volatile("v_cvt_pk_bf16_f32 %0, %1, %2" : "=v"(r) : "v"(lo), "v"(hi)); return r; }
__device__ __forceinline__ float wave_sum(float v) {
#pragma unroll
    for (int o = 1; o < 64; o <<= 1) v += __shfl_xor(v, o);
    return v;
}
__device__ __forceinline__ float sigmoidf_(float x) { return __builtin_amdgcn_rcpf(1.f + __builtin_amdgcn_exp2f(-1.4426950408889634f * x)); }
__device__ __forceinline__ float gelu1(float v) { pg8::f32x2 r = pg8::gelu_pk((pg8::f32x2){v, 0.f}); return r.x; }
#define XB_TMO      128
#define XB_XCNT(j)  (256  + 64 * (j))
#define XB_XSUB(j)  (1280 + 64 * (j))
#define XB_XGEN(j)  (2304 + 64 * (j))
#define XB_TOP      3328
#define XB_TOPGEN   3392
#define XCD_BAR_WORDS 3456
#define XB_SPIN_CAP (1u << 18)
#define LAS __attribute__((address_space(3)))

__device__ __forceinline__ unsigned xb_ld(unsigned* p)              { return __hip_atomic_load(p, __ATOMIC_RELAXED, __HIP_MEMORY_SCOPE_AGENT); }
__device__ __forceinline__ unsigned xb_add(unsigned* p, unsigned v) { return __hip_atomic_fetch_add(p, v, __ATOMIC_RELAXED, __HIP_MEMORY_SCOPE_AGENT); }
__device__ __forceinline__ unsigned xb_xcc_id() { return (unsigned)__builtin_amdgcn_s_getreg((3 << 11) | 20) & 0xFu; }
#define XB_SPIN(cond, bar) do { unsigned _sp = 0; while (cond) { __builtin_amdgcn_s_sleep(1); \
    if ((++_sp & 255u) == 0u) { if (xb_ld(&(bar)[XB_TMO])) break; if (_sp > XB_SPIN_CAP) { atomicAdd(&(bar)[XB_TMO], 1u); break; } } } } while (0)

struct XcdBarrier {
    unsigned* bar; unsigned x;
    volatile LAS unsigned* st;
};

__device__ __forceinline__ XcdBarrier xcd_barrier_post(unsigned* bar, volatile LAS unsigned* st) {
    XcdBarrier b; b.bar = bar; b.x = xb_xcc_id(); b.st = st;
    if (threadIdx.x == 0) (void)xb_add(&bar[XB_XCNT(b.x)], 1u);
    return b;
}
__device__ __forceinline__ void xcd_barrier_complete(unsigned* bar, unsigned x, unsigned& nloc, unsigned& nx) {
    const unsigned G = gridDim.x * gridDim.y * gridDim.z;
    unsigned sum, cnt, mine, sp = 0u;
    for (;;) {
        sum = 0u; cnt = 0u; mine = 0u;
#pragma unroll
        for (unsigned j = 0; j < 16; ++j) { const unsigned c = xb_ld(&bar[XB_XCNT(j)]); sum += c; cnt += (c > 0u) ? 1u : 0u; mine = (j == x) ? c : mine; }
        if (sum == G) break;
        __builtin_amdgcn_s_sleep(1);
        if ((++sp & 255u) == 0u) { if (xb_ld(&bar[XB_TMO])) break; if (sp > XB_SPIN_CAP) { atomicAdd(&bar[XB_TMO], 1u); break; } }
    }
    nloc = mine > 0u ? mine : 1u; nx = cnt > 0u ? cnt : 1u;
}

__device__ __forceinline__ void xcd_barrier(const XcdBarrier& b) {
    asm volatile("s_waitcnt vmcnt(0)" ::: "memory");
    __syncthreads();
    if (threadIdx.x == 0) {
        unsigned* bar = b.bar;
        __builtin_amdgcn_s_waitcnt(0);
        unsigned nloc = b.st[0], nx = b.st[1];
        if (nloc == 0u) { xcd_barrier_complete(bar, b.x, nloc, nx); b.st[0] = nloc; b.st[1] = nx; }
        const unsigned old = xb_add(&bar[XB_XSUB(b.x)], 1u);
        const unsigned gen = old / nloc;
        if (old + 1u == (gen + 1u) * nloc) {
            __builtin_amdgcn_fence(__ATOMIC_RELEASE, "agent");
            asm volatile("s_waitcnt vmcnt(0)" ::: "memory");
            const unsigned og = xb_add(&bar[XB_TOP], 1u);
            const unsigned tg = og / nx;
            if (og + 1u == (tg + 1u) * nx) xb_add(&bar[XB_TOPGEN], 1u);
            else XB_SPIN(xb_ld(&bar[XB_TOPGEN]) == tg, bar);
            __builtin_amdgcn_fence(__ATOMIC_ACQUIRE, "agent");
            xb_add(&bar[XB_XGEN(b.x)], 1u);
            asm volatile("s_waitcnt vmcnt(0)" ::: "memory");
        } else {
            XB_SPIN(xb_ld(&bar[XB_XGEN(b.x)]) == gen, bar);
            __builtin_amdgcn_fence(__ATOMIC_ACQUIRE, "agent");
            asm volatile("s_waitcnt vmcnt(0)" ::: "memory");
        }
    }
    __syncthreads();
}


constexpr int ATT_D = 128, KVBLK = 64;
constexpr int SHM_V = KVBLK * ATT_D * 2, SHM_K = KVBLK * ATT_D * 2;
constexpr int ATT_K_OFF = 0, ATT_V_OFF = SHM_K, ATT_BUF = SHM_K + SHM_V, ATT_WS_OFF = 2 * ATT_BUF;
constexpr int ATT_X_OFF = ATT_WS_OFF + NWAVES * 256;
#define KSWZ(row, colB) ((row) * 256 + ((colB) ^ (((row) & 7) << 4)))
__device__ __forceinline__ int crow(int r, int hi) { return (r & 3) + 8 * (r >> 2) + 4 * hi; }
__device__ __forceinline__ int v_st(int k, int c) { const int kk = (k & ~0xC) | ((k & 4) << 1) | ((k & 8) >> 1); return ((kk >> 3) * 4 + (c >> 5)) * 512 + ((kk & 7) * 32 + (c & 31)) * 2; }
__device__ __forceinline__ int v_rd_base(int lane) { return ((lane & 3) << 3) | (((lane >> 2) & 3) << 6) | (((lane >> 4) & 1) << 5) | (((lane >> 5) & 1) << 8); }
constexpr int v_rd_off(int d0, int ks, int half) { return d0 * 512 + ks * 4096 + half * 2048; }
template <int OFF> __device__ __forceinline__ s16x4 tr_read(int vb) {
  s16x4 r; asm volatile("ds_read_b64_tr_b16 %0, %1 offset:%2" : "=&v"(r) : "v"(vb), "i"(OFF) : "memory"); return r;
}
__device__ __forceinline__ void qkt(f32x16& p0, f32x16& p1, const LAS char* Ks, const bf16x8* qr, int r32, int hi) {
  p0 = f32x16{}; p1 = f32x16{};
#pragma unroll
  for (int d0 = 0; d0 < 8; ++d0) { const int cb = (d0 * 16 + hi * 8) * 2;
    const bf16x8 b0 = *(const LAS bf16x8*)(Ks + KSWZ(r32, cb));
    const bf16x8 b1 = *(const LAS bf16x8*)(Ks + KSWZ(32 + r32, cb));
    p0 = __builtin_amdgcn_mfma_f32_32x32x16_bf16(b0, qr[d0], p0, 0, 0, 0);
    p1 = __builtin_amdgcn_mfma_f32_32x32x16_bf16(b1, qr[d0], p1, 0, 0, 0); }
}
__device__ __forceinline__ void pack_p(const f32x16& p0, const f32x16& p1, bf16x8& pa0, bf16x8& pa1, bf16x8& pa2, bf16x8& pa3) {
#define PK4(P, BASE, OUT) do { unsigned a0 = cvtpk(P[BASE + 0], P[BASE + 1]), a1 = cvtpk(P[BASE + 2], P[BASE + 3]);   \
    unsigned b0 = cvtpk(P[BASE + 4], P[BASE + 5]), b1 = cvtpk(P[BASE + 6], P[BASE + 7]);                              \
    auto r0 = __builtin_amdgcn_permlane32_swap(a0, b0, false, false); auto r1 = __builtin_amdgcn_permlane32_swap(a1, b1, false, false); \
    v4u w = {r0[0], r1[0], r0[1], r1[1]}; OUT = __builtin_bit_cast(bf16x8, w); } while (0)
  PK4(p0, 0, pa0); PK4(p0, 8, pa1); PK4(p1, 0, pa2); PK4(p1, 8, pa3);
#undef PK4
}
template <int D0> __device__ __forceinline__ void pv_one(f32x16& od, int vb, bf16x8 pa0, bf16x8 pa1, bf16x8 pa2, bf16x8 pa3) {
  const s16x4 l0 = tr_read<v_rd_off(D0, 0, 0)>(vb), h0 = tr_read<v_rd_off(D0, 0, 1)>(vb), l1 = tr_read<v_rd_off(D0, 1, 0)>(vb), h1 = tr_read<v_rd_off(D0, 1, 1)>(vb);
  const s16x4 l2 = tr_read<v_rd_off(D0, 2, 0)>(vb), h2 = tr_read<v_rd_off(D0, 2, 1)>(vb), l3 = tr_read<v_rd_off(D0, 3, 0)>(vb), h3 = tr_read<v_rd_off(D0, 3, 1)>(vb);
  asm volatile("s_waitcnt lgkmcnt(0)" ::: "memory"); SBAR();
#define PKV(L, H) (bf16x8){L[0], L[1], L[2], L[3], H[0], H[1], H[2], H[3]}
  od = __builtin_amdgcn_mfma_f32_32x32x16_bf16(pa0, PKV(l0, h0), od, 0, 0, 0);
  od = __builtin_amdgcn_mfma_f32_32x32x16_bf16(pa1, PKV(l1, h1), od, 0, 0, 0);
  od = __builtin_amdgcn_mfma_f32_32x32x16_bf16(pa2, PKV(l2, h2), od, 0, 0, 0);
  od = __builtin_amdgcn_mfma_f32_32x32x16_bf16(pa3, PKV(l3, h3), od, 0, 0, 0);
#undef PKV
}
__device__ __forceinline__ void pv_d0(f32x16* o, int vb, bf16x8 pa0, bf16x8 pa1, bf16x8 pa2, bf16x8 pa3) {
  pv_one<0>(o[0], vb, pa0, pa1, pa2, pa3); pv_one<1>(o[1], vb, pa0, pa1, pa2, pa3); pv_one<2>(o[2], vb, pa0, pa1, pa2, pa3); pv_one<3>(o[3], vb, pa0, pa1, pa2, pa3);
}
struct KVStage { bf16x8 ks0, ks1, vs0, vs1; };
__device__ __forceinline__ void kv_load(KVStage& s, const bf16* Kh, const bf16* Vh, long ldk, long ldv, int k0, int sr, int sc) {
  s.ks0 = *(const bf16x8*)(Kh + (long)(k0 + sr) * ldk + sc); s.ks1 = *(const bf16x8*)(Kh + (long)(k0 + 32 + sr) * ldk + sc);
  s.vs0 = *(const bf16x8*)(Vh + (long)(k0 + sr) * ldv + sc); s.vs1 = *(const bf16x8*)(Vh + (long)(k0 + 32 + sr) * ldv + sc);
}
__device__ __forceinline__ void kv_write(const KVStage& s, LAS char* lds, int sr, int sc) {
  *(LAS bf16x8*)(lds + ATT_V_OFF + v_st(sr, sc)) = s.vs0; *(LAS bf16x8*)(lds + ATT_V_OFF + v_st(32 + sr, sc)) = s.vs1;
  *(LAS bf16x8*)(lds + ATT_K_OFF + KSWZ(sr, sc * 2)) = s.ks0; *(LAS bf16x8*)(lds + ATT_K_OFF + KSWZ(32 + sr, sc * 2)) = s.ks1;
}
struct KVDma { int ko[2], vo[2]; };
__device__ __forceinline__ void kv_dma_init(KVDma& d, int ldk, int ldv, int wid, int lane) {
#pragma unroll
  for (int i = 0; i < 2; ++i) { const int p = wid * 2 + i;
    const int row = p * 4 + (lane >> 4), cp = lane & 15; d.ko[i] = row * ldk + ((cp ^ (row & 7)) << 3);
    const int sub = p * 2 + (lane >> 5), kk = (sub >> 2) * 8 + ((lane & 31) >> 2), k = (kk & ~0xC) | ((kk & 4) << 1) | ((kk & 8) >> 1), c = (sub & 3) * 32 + (lane & 3) * 8;
    d.vo[i] = k * ldv + c; }
}
__device__ __forceinline__ void kv_dma(const KVDma& d, const bf16* Kt, const bf16* Vt, LAS char* lds, int buf, int wid) {
#pragma unroll
  for (int i = 0; i < 2; ++i) {
    __builtin_amdgcn_global_load_lds((const unsigned*)(Kt + d.ko[i]), (LAS unsigned*)(lds + buf + ATT_K_OFF + (wid * 2 + i) * 1024), 16, 0, 0);
    __builtin_amdgcn_global_load_lds((const unsigned*)(Vt + d.vo[i]), (LAS unsigned*)(lds + buf + ATT_V_OFF + (wid * 2 + i) * 1024), 16, 0, 0); }
}
__device__ __forceinline__ void rescale_o(f32x16* o, float a, LAS float* al_l, int r32, int hi) {
  if (__any(a < 1.f)) { if (hi == 0) al_l[r32] = a; LDS_WAIT();
#pragma unroll
    for (int r = 0; r < 16; ++r) { const float f = al_l[crow(r, hi)];
#pragma unroll
      for (int d = 0; d < 4; ++d) o[d][r] *= f; }
    LDS_WAIT(); }
}
constexpr float ATT_SCALE = 0.088388347648318440f, ATT_C = ATT_SCALE * 1.4426950408889634f, ATT_THR = 8.f;
template <bool MASKED>
__device__ __forceinline__ void softmax_tile(f32x16& p0, f32x16& p1, unsigned vm0, unsigned vm1, float& m_reg, float& l_reg, float& alpha) {
  if (MASKED) {
#pragma unroll
    for (int r = 0; r < 16; ++r) { p0[r] = ((vm0 >> r) & 1u) ? p0[r] : -1e30f; p1[r] = ((vm1 >> r) & 1u) ? p1[r] : -1e30f; }
  }
  float pmax = p0[0];
#pragma unroll
  for (int r = 1; r < 16; ++r) pmax = fmaxf(pmax, p0[r]);
#pragma unroll
  for (int r = 0; r < 16; ++r) pmax = fmaxf(pmax, p1[r]);
  { auto rr = __builtin_amdgcn_permlane32_swap(__float_as_uint(pmax), __float_as_uint(pmax), false, false);
    pmax = fmaxf(__uint_as_float(rr[0]), __uint_as_float(rr[1])); }
  float mn;
  if (__all(pmax - m_reg <= ATT_THR / ATT_SCALE)) { mn = m_reg; alpha = 1.f; }
  else { mn = fmaxf(m_reg, pmax); alpha = __builtin_amdgcn_exp2f((m_reg - mn) * ATT_C); m_reg = mn; }
  const float mnC = -mn * ATT_C;
#pragma unroll
  for (int r = 0; r < 16; ++r) { p0[r] = __builtin_amdgcn_exp2f(fmaf(p0[r], ATT_C, mnC)); p1[r] = __builtin_amdgcn_exp2f(fmaf(p1[r], ATT_C, mnC)); }
  if (MASKED) {
#pragma unroll
    for (int r = 0; r < 16; ++r) { p0[r] = ((vm0 >> r) & 1u) ? p0[r] : 0.f; p1[r] = ((vm1 >> r) & 1u) ? p1[r] : 0.f; }
  }
  float ps = 0.f;
#pragma unroll
  for (int r = 0; r < 16; ++r) ps += p0[r] + p1[r];
  { auto rr = __builtin_amdgcn_permlane32_swap(__float_as_uint(ps), __float_as_uint(ps), false, false);
    ps = __uint_as_float(rr[0]) + __uint_as_float(rr[1]); }
  l_reg = l_reg * alpha + ps;
}
__device__ __forceinline__ void load_q(bf16x8* qr, const bf16* Qw) {
#pragma unroll
  for (int d0 = 0; d0 < 8; ++d0) qr[d0] = *(const bf16x8*)(Qw + d0 * 16);
}

struct Frame {
    LAS unsigned char* lds;
    unsigned char* ws;
    int tid, lane, wave, G, bid;
    __device__ __forceinline__ void fresh() { int t = threadIdx.x; asm volatile("" : "+v"(t)); tid = t; lane = t & 63; wave = __builtin_amdgcn_readfirstlane(t >> 6);
        int g_ = gridDim.x, b_ = blockIdx.x; asm volatile("" : "+s"(g_), "+s"(b_)); G = g_; bid = b_; }
};
struct Args { const float* in[19]; float* out; unsigned char* ws; int ph_lo, ph_hi; };
enum { IN_X = 0, IN_MEM, IN_AB_W_IN, IN_HGRN_LB, IN_HGRN_NW, IN_AB_W_OUT, IN_NSA_W_IN, IN_NSA_CMP_POS, IN_NSA_CMP_W1, IN_NSA_CMP_W2, IN_NSA_W_OUT,
       IN_XA_WQ, IN_XA_WKV, IN_XA_WO, IN_FFN_UP, IN_FFN_CONV, IN_FFN_DOWN, IN_LN_G, IN_LN_B };

__device__ __forceinline__ void p0_transpose_item(const float* W, int K, int N, bf16* WT, LAS float* scr, int item, int lane) {
    const int nblk = N / 32, kb = item / nblk, nb = item % nblk, k0 = 64 * kb, n0 = 32 * nb;
#pragma unroll 8
    for (int i = 0; i < 32; ++i) { const int kk = 2 * i + (lane >> 5); scr[kk * 33 + (lane & 31)] = W[(size_t)(k0 + kk) * N + n0 + (lane & 31)]; }
    LDS_WAIT(); asm volatile("" ::: "memory");
    const int c = lane & 7;
#pragma unroll
    for (int j = 0; j < 4; ++j) { const int n = (lane >> 3) + 8 * j; const LAS float* s = scr + (8 * c) * 33 + n;
        v4u o; o.x = pk2(s[0 * 33], s[1 * 33]); o.y = pk2(s[2 * 33], s[3 * 33]); o.z = pk2(s[4 * 33], s[5 * 33]); o.w = pk2(s[6 * 33], s[7 * 33]);
        *(GAS v4u*)(WT + (size_t)(n0 + n) * K + k0 + 8 * c) = o; }
    LDS_WAIT(); asm volatile("" ::: "memory");
}
__device__ __forceinline__ void transpose_mat(Frame& F, const float* W, int K, int N, bf16* WT) {
    LAS float* scr = (LAS float*)(F.lds + RING_OFF + F.wave * 16384);
    const int gw = F.bid * NWAVES + F.wave, NGW = F.G * NWAVES;
    const int nitems = (K / 64) * (N / 32);
    for (int it = gw; it < nitems; it += NGW) p0_transpose_item(W, K, N, WT, scr, it, F.lane);
}
__device__ __forceinline__ void cvt_flat(Frame& F, const float* src, bf16* dst, long n8) {
    for (long i = (long)F.bid * NTHR + F.tid; i < n8; i += (long)F.G * NTHR) {
        const f32x4 a = *(const f32x4*)(src + i * 8), b = *(const f32x4*)(src + i * 8 + 4);
        v4u o; o.x = pk2(a.x, a.y); o.y = pk2(a.z, a.w); o.z = pk2(b.x, b.y); o.w = pk2(b.z, b.w);
        *(v4u*)(dst + i * 8) = o; }
}
__device__ __forceinline__ void p0_prologue(Frame& F, const Args& A) {
    unsigned char* ws = F.ws;
    transpose_mat(F, A.in[IN_AB_W_IN], DM, AB_IN, (bf16*)(ws + WS_W_ABIN));
    transpose_mat(F, A.in[IN_AB_W_OUT], DM, DM, (bf16*)(ws + WS_W_ABOUT));
    transpose_mat(F, A.in[IN_NSA_W_IN], DM, NSA_IN, (bf16*)(ws + WS_W_NSAIN));
    transpose_mat(F, A.in[IN_NSA_W_OUT], DM, DM, (bf16*)(ws + WS_W_NSAOUT));
    for (int l = 0; l < 2; ++l) {
        transpose_mat(F, A.in[IN_XA_WQ] + (size_t)l * DM * XW, DM, XW, (bf16*)(ws + WS_W_XQ) + (size_t)l * XW * DM);
        transpose_mat(F, A.in[IN_XA_WKV] + (size_t)l * DM * 2 * XW, DM, 2 * XW, (bf16*)(ws + WS_W_XKV) + (size_t)l * 2 * XW * DM);
        transpose_mat(F, A.in[IN_XA_WO] + (size_t)l * XW * DM, XW, DM, (bf16*)(ws + WS_W_XO) + (size_t)l * DM * XW);
        transpose_mat(F, A.in[IN_FFN_UP] + (size_t)l * DM * DFF2, DM, DFF2, (bf16*)(ws + WS_W_UP) + (size_t)l * DFF2 * DM);
        transpose_mat(F, A.in[IN_FFN_DOWN] + (size_t)l * DFF * DM, DFF, DM, (bf16*)(ws + WS_W_DOWN) + (size_t)l * DM * DFF);
        transpose_mat(F, A.in[IN_NSA_CMP_W1] + (size_t)l * 32 * HD * HD, 32 * HD, HD, (bf16*)(ws + WS_W_C1) + (size_t)l * HD * 32 * HD);
        transpose_mat(F, A.in[IN_NSA_CMP_W2] + (size_t)l * HD * HD, HD, HD, (bf16*)(ws + WS_W_C2) + (size_t)l * HD * HD);
    }
    cvt_flat(F, A.in[IN_X], (bf16*)(ws + WS_HB), (long)MTOK * DM / 8);
    cvt_flat(F, A.in[IN_MEM], (bf16*)(ws + WS_MEMB), (long)BATCH * NMEM * DM / 8);
    { v4u z = {0u, 0u, 0u, 0u}; v4u* p = (v4u*)((bf16*)(ws + WS_W_NSAIN) + (size_t)NSA_IN * DM); const long n = (long)(NSA_INP - NSA_IN) * DM / 8;
      for (long i = (long)F.bid * NTHR + F.tid; i < n; i += (long)F.G * NTHR) p[i] = z; }
    { const float* lbp = A.in[IN_HGRN_LB]; float* lbo = (float*)(ws + WS_LB);
      for (int i = F.bid * NTHR + F.tid; i < A_W; i += F.G * NTHR) { const float a = lbp[i], b = lbp[A_W + i], m = fmaxf(a, b), ea = __expf(a - m), eb = __expf(b - m); lbo[i] = ea / (ea + eb); } }
}

__device__ __forceinline__ void ln_phase(Frame& F, const bf16* Y, const float* g, const float* b, float* h32, bf16* hb, float* stats) {
    const int gw = F.bid * NWAVES + F.wave, NGW = F.G * NWAVES;
    for (int m = gw; m < MTOK; m += NGW) {
        const v4u* yr = (const v4u*)(Y + (size_t)m * DM) + F.lane;
        float v[8][8]; float s = 0.f;
#pragma unroll
        for (int j = 0; j < 8; ++j) { const v4u x = yr[64 * j];
            v[j][0] = bflo(x.x); v[j][1] = bfhi(x.x); v[j][2] = bflo(x.y); v[j][3] = bfhi(x.y); v[j][4] = bflo(x.z); v[j][5] = bfhi(x.z); v[j][6] = bflo(x.w); v[j][7] = bfhi(x.w);
#pragma unroll
            for (int q = 0; q < 8; ++q) s += v[j][q]; }
        const float mean = wave_sum(s) * (1.f / DM); float s2 = 0.f;
#pragma unroll
        for (int j = 0; j < 8; ++j)
#pragma unroll
            for (int q = 0; q < 8; ++q) { v[j][q] -= mean; s2 += v[j][q] * v[j][q]; }
        const float rstd = 1.f / sqrtf(wave_sum(s2) * (1.f / DM) + LN_EPS);
        if (F.lane == 0) { stats[2 * m] = mean; stats[2 * m + 1] = rstd; }
#pragma unroll
        for (int j = 0; j < 8; ++j) { const int c0 = 8 * F.lane + 512 * j;
            const f32x4 g0 = *(const f32x4*)(g + c0), g1 = *(const f32x4*)(g + c0 + 4), b0 = *(const f32x4*)(b + c0), b1 = *(const f32x4*)(b + c0 + 4);
            f32x4 r0, r1;
            r0.x = v[j][0] * rstd * g0.x + b0.x; r0.y = v[j][1] * rstd * g0.y + b0.y; r0.z = v[j][2] * rstd * g0.z + b0.z; r0.w = v[j][3] * rstd * g0.w + b0.w;
            r1.x = v[j][4] * rstd * g1.x + b1.x; r1.y = v[j][5] * rstd * g1.y + b1.y; r1.z = v[j][6] * rstd * g1.z + b1.z; r1.w = v[j][7] * rstd * g1.w + b1.w;
            if (h32) { *(f32x4*)(h32 + (size_t)m * DM + c0) = r0; *(f32x4*)(h32 + (size_t)m * DM + c0 + 4) = r1; }
            v4u w; w.x = pk2(r0.x, r0.y); w.y = pk2(r0.z, r0.w); w.z = pk2(r1.x, r1.y); w.w = pk2(r1.z, r1.w);
            *(v4u*)(hb + (size_t)m * DM + c0) = w; }
    }
}

__device__ __forceinline__ void convglu_phase(Frame& F, const bf16* UP, const float* cw, bf16* Gm) {
    constexpr int NCG = DFF / 8, RB = 16, NRB = MTOK / RB;
    const long nitems = (long)NCG * NRB;
    for (long it = (long)F.bid * NTHR + F.tid; it < nitems; it += (long)F.G * NTHR) {
        const int cg = (int)(it % NCG), rb = (int)(it / NCG), c0 = cg * 8, t0 = rb * RB;
        float w0[8], w1[8], w2[8];
#pragma unroll
        for (int j = 0; j < 8; ++j) { w0[j] = cw[c0 + j]; w1[j] = cw[DFF + c0 + j]; w2[j] = cw[2 * DFF + c0 + j]; }
        float am2[8], am1[8];
        if ((t0 & (SEQ - 1)) == 0) {
#pragma unroll
            for (int j = 0; j < 8; ++j) { am2[j] = 0.f; am1[j] = 0.f; }
        } else {
            const v4u x2 = *(const v4u*)(UP + (size_t)(t0 - 2) * DFF2 + c0), x1 = *(const v4u*)(UP + (size_t)(t0 - 1) * DFF2 + c0);
            am2[0] = bflo(x2.x); am2[1] = bfhi(x2.x); am2[2] = bflo(x2.y); am2[3] = bfhi(x2.y); am2[4] = bflo(x2.z); am2[5] = bfhi(x2.z); am2[6] = bflo(x2.w); am2[7] = bfhi(x2.w);
            am1[0] = bflo(x1.x); am1[1] = bfhi(x1.x); am1[2] = bflo(x1.y); am1[3] = bfhi(x1.y); am1[4] = bflo(x1.z); am1[5] = bfhi(x1.z); am1[6] = bflo(x1.w); am1[7] = bfhi(x1.w);
        }
#pragma unroll 4
        for (int r = 0; r < RB; ++r) {
            const size_t row = (size_t)(t0 + r);
            const v4u xa = *(const v4u*)(UP + row * DFF2 + c0), xu = *(const v4u*)(UP + row * DFF2 + DFF + c0);
            float a[8], u[8];
            a[0] = bflo(xa.x); a[1] = bfhi(xa.x); a[2] = bflo(xa.y); a[3] = bfhi(xa.y); a[4] = bflo(xa.z); a[5] = bfhi(xa.z); a[6] = bflo(xa.w); a[7] = bfhi(xa.w);
            u[0] = bflo(xu.x); u[1] = bfhi(xu.x); u[2] = bflo(xu.y); u[3] = bfhi(xu.y); u[4] = bflo(xu.z); u[5] = bfhi(xu.z); u[6] = bflo(xu.w); u[7] = bfhi(xu.w);
            float o[8];
#pragma unroll
            for (int j = 0; j < 8; j += 2) {
                const float c0v = w2[j] * a[j] + w1[j] * am1[j] + w0[j] * am2[j], c1v = w2[j + 1] * a[j + 1] + w1[j + 1] * am1[j + 1] + w0[j + 1] * am2[j + 1];
                const pg8::f32x2 gg = pg8::gelu_pk((pg8::f32x2){c0v, c1v}); o[j] = gg.x * u[j]; o[j + 1] = gg.y * u[j + 1]; }
            v4u w; w.x = pk2(o[0], o[1]); w.y = pk2(o[2], o[3]); w.z = pk2(o[4], o[5]); w.w = pk2(o[6], o[7]);
            *(v4u*)(Gm + row * DFF + c0) = w;
#pragma unroll
            for (int j = 0; j < 8; ++j) { am2[j] = am1[j]; am1[j] = a[j]; }
        }
    }
}

__device__ __forceinline__ void xattn_phase(Frame& F, const bf16* XQ, const bf16* XKV, bf16* XO) {
    const int tid = F.tid, wid = F.wave, lane = F.lane, r32 = lane & 31, hi = lane >> 5;
    LAS char* lds = (LAS char*)F.lds;
    LAS float* wsc = (LAS float*)(lds + ATT_WS_OFF + wid * 256);
    const int vb0 = (int)(uintptr_t)(lds + ATT_V_OFF) + v_rd_base(lane);
    KVDma dm; kv_dma_init(dm, 2 * XW, 2 * XW, wid, lane);
    constexpr int NU = (MTOK / 256) * XH;
    for (int u = F.bid; u < NU; u += F.G) {
        const int head = u % XH, rbk = u / XH, row0 = rbk * 256, b = row0 / SEQ;
        const bf16* Kh = XKV + (size_t)b * NMEM * 2 * XW + head * HD; const bf16* Vh = Kh + XW;
        bf16x8 qr[8]; load_q(qr, XQ + (size_t)(row0 + wid * 32 + r32) * XW + head * HD + hi * 8);
        float m_reg = -1e30f, l_reg = 0.f; f32x16 o[4] = {};
        __syncthreads();
        kv_dma(dm, Kh, Vh, lds, 0, wid);
        for (int j = 0; j < NMEM / KVBLK; ++j) {
            const int buf = (j & 1) * ATT_BUF;
            VM_WAIT(); __syncthreads();
            if (j + 1 < NMEM / KVBLK) kv_dma(dm, Kh + (size_t)(j + 1) * KVBLK * 2 * XW, Vh + (size_t)(j + 1) * KVBLK * 2 * XW, lds, ATT_BUF - buf, wid);
            f32x16 p0, p1; qkt(p0, p1, lds + buf + ATT_K_OFF, qr, r32, hi);
            float alpha; softmax_tile<false>(p0, p1, 0u, 0u, m_reg, l_reg, alpha);
            rescale_o(o, alpha, wsc, r32, hi);
            bf16x8 pa0, pa1, pa2, pa3; pack_p(p0, p1, pa0, pa1, pa2, pa3);
            pv_d0(o, vb0 + buf, pa0, pa1, pa2, pa3);
        }
        if (hi == 0) wsc[32 + r32] = l_reg; LDS_WAIT();
        bf16* Ow = XO + (size_t)(row0 + wid * 32) * XW + head * HD;
#pragma unroll
        for (int r = 0; r < 16; ++r) { const int orow = crow(r, hi); const float rl = __builtin_amdgcn_rcpf(wsc[32 + orow]);
#pragma unroll
            for (int d0 = 0; d0 < 4; ++d0) Ow[(size_t)orow * XW + d0 * 32 + r32] = (bf16)f2bf(o[d0][r] * rl); }
        LDS_WAIT();
    }
}

template <int K>
__device__ __forceinline__ f32x4 mma_tile(const LAS char* A, int lda, const LAS char* B, int ldb, int fr, int fq) {
    f32x4 acc = {0.f, 0.f, 0.f, 0.f};
#pragma unroll
    for (int k0 = 0; k0 < K; k0 += 32) {
        const bf16x8 a = *(const LAS bf16x8*)(A + fr * lda + (k0 + 8 * fq) * 2);
        const bf16x8 b = *(const LAS bf16x8*)(B + fr * ldb + (k0 + 8 * fq) * 2);
        acc = __builtin_amdgcn_mfma_f32_16x16x32_bf16(a, b, acc, 0, 0, 0);
    }
    return acc;
}
constexpr int HG_CH = 64, HG_NC = SEQ / HG_CH, HG_ITEMS = BATCH * A_HEADS * HG_NC;
constexpr int HG_QT = 0, HG_KT = 17408, HG_KH = 34816, HG_VT = 53248, HG_PT = 71680, HG_SEG = 80896;
constexpr int HG_SP = 17408, HG_OT = 52224;
__device__ __forceinline__ void hgrn_phase_a(Frame& F, const bf16* P0, const float* lbv, bf16* QTg, float* OINTRA, float* DS, float* DEC) {
    LAS char* lds = (LAS char*)F.lds;
    const int tid = F.tid, wid = F.wave, lane = F.lane, fr = lane & 15, fq = lane >> 4;
    const int d = tid & 127, sq = tid >> 7;
    for (int it = F.bid; it < HG_ITEMS; it += F.G) {
        const int c = it % HG_NC, bh = it / HG_NC, h = bh % A_HEADS, b = bh / A_HEADS;
        const size_t row0 = (size_t)b * SEQ + (size_t)c * HG_CH;
        const float lb = lbv[h * HD + d], omlb = 1.f - lb;
        float cum[16], kk[16];
        { float run = 0.f;
#pragma unroll
          for (int j = 0; j < 16; ++j) { const float z = bf2f(P0[(row0 + 16 * sq + j) * AB_IN + A_W + h * HD + d]); const float sg = sigmoidf_(z);
              run += __logf(lb + omlb * sg); cum[j] = run; kk[j] = omlb * (1.f - sg); }
          ((LAS float*)(lds + HG_SEG))[sq * 128 + d] = run; }
        LDS_WAIT(); __syncthreads();
        float base = 0.f, total = 0.f;
#pragma unroll
        for (int q = 0; q < 4; ++q) { const float sgm = ((LAS float*)(lds + HG_SEG))[q * 128 + d]; total += sgm; if (q < sq) base += sgm; }
        unsigned kh[8], vt[8];
#pragma unroll
        for (int j = 0; j < 16; j += 2) {
            float e[2][3]; unsigned short vr[2];
#pragma unroll
            for (int jj = 0; jj < 2; ++jj) { const int s = 16 * sq + j + jj; const float bb = base + cum[j + jj];
                const float q = bf2f(P0[(row0 + s) * AB_IN + h * HD + d]); vr[jj] = P0[(row0 + s) * AB_IN + 2 * A_W + h * HD + d];
                const float qt = q * __expf(bb), kt = kk[j + jj] * __expf(-bb), kht = kk[j + jj] * __expf(total - bb);
                const unsigned short qb16 = (unsigned short)f2bf(qt);
                *(LAS unsigned short*)(lds + HG_QT + s * 272 + d * 2) = qb16; QTg[(row0 + s) * A_W + h * HD + d] = qb16;
                *(LAS unsigned short*)(lds + HG_KT + s * 272 + d * 2) = (unsigned short)f2bf(kt);
                e[jj][0] = kht; }
            kh[j >> 1] = pk2(e[0][0], e[1][0]); vt[j >> 1] = (unsigned)vr[0] | ((unsigned)vr[1] << 16);
        }
        { LAS v4u* pk = (LAS v4u*)(lds + HG_KH + d * 144 + sq * 32); pk[0] = (v4u){kh[0], kh[1], kh[2], kh[3]}; pk[1] = (v4u){kh[4], kh[5], kh[6], kh[7]};
          LAS v4u* pv = (LAS v4u*)(lds + HG_VT + d * 144 + sq * 32); pv[0] = (v4u){vt[0], vt[1], vt[2], vt[3]}; pv[1] = (v4u){vt[4], vt[5], vt[6], vt[7]}; }
        if (sq == 3) DEC[(size_t)it * HD + d] = __expf(total);
        LDS_WAIT(); __syncthreads();
#pragma unroll
        for (int k = 0; k < 2; ++k) { const int tau = 2 * wid + k, ti = tau >> 2, si = tau & 3;
            f32x4 acc = {0.f, 0.f, 0.f, 0.f};
            if (si <= ti) acc = mma_tile<128>(lds + HG_QT + ti * 16 * 272, 272, lds + HG_KT + si * 16 * 272, 272, fr, fq);
#pragma unroll
            for (int i = 0; i < 4; ++i) { const int t = 16 * ti + 4 * fq + i, s = 16 * si + fr; const float v = (s <= t) ? acc[i] : 0.f;
                *(LAS unsigned short*)(lds + HG_PT + t * 144 + s * 2) = (unsigned short)f2bf(v); } }
        LDS_WAIT(); __syncthreads();
#pragma unroll
        for (int k = 0; k < 4; ++k) { const int tau = wid + 8 * k, ti = tau >> 3, vi = tau & 7;
            const f32x4 acc = mma_tile<64>(lds + HG_PT + ti * 16 * 144, 144, lds + HG_VT + vi * 16 * 144, 144, fr, fq);
#pragma unroll
            for (int i = 0; i < 4; ++i) OINTRA[(row0 + 16 * ti + 4 * fq + i) * A_W + h * HD + 16 * vi + fr] = acc[i]; }
#pragma unroll
        for (int k = 0; k < 8; ++k) { const int tau = wid + 8 * k, vi = tau >> 3, ki = tau & 7;
            const f32x4 acc = mma_tile<64>(lds + HG_VT + vi * 16 * 144, 144, lds + HG_KH + ki * 16 * 144, 144, fr, fq);
#pragma unroll
            for (int i = 0; i < 4; ++i) DS[((size_t)it * HD + 16 * vi + 4 * fq + i) * HD + 16 * ki + fr] = acc[i]; }
        LDS_WAIT(); __syncthreads();
    }
}
__device__ __forceinline__ void hgrn_phase_b(Frame& F, const float* DS, const float* DEC, bf16* SPREV) {
    const int tid = F.tid, dvl = tid >> 5, dk4 = (tid & 31) * 4;
    for (int item = F.bid; item < BATCH * A_HEADS * 8; item += F.G) {
        const int sl = item & 7, bh = item >> 3, dv = sl * 16 + dvl;
        f32x4 S = {0.f, 0.f, 0.f, 0.f};
        for (int c0 = 0; c0 < HG_NC; c0 += 8) {
            f32x4 ds[8], dc[8];
#pragma unroll
            for (int k = 0; k < 8; ++k) { const size_t it = (size_t)bh * HG_NC + c0 + k; ds[k] = *(const f32x4*)(DS + (it * HD + dv) * HD + dk4); dc[k] = *(const f32x4*)(DEC + it * HD + dk4); }
#pragma unroll
            for (int k = 0; k < 8; ++k) { const size_t it = (size_t)bh * HG_NC + c0 + k;
                v2u w; w.x = pk2(S.x, S.y); w.y = pk2(S.z, S.w); *(v2u*)(SPREV + (it * HD + dv) * HD + dk4) = w;
                S = S * dc[k] + ds[k]; }
        }
    }
}
__device__ __forceinline__ void hgrn_phase_c(Frame& F, const bf16* P0, const bf16* QTg, const float* OINTRA, const bf16* SPREV, const float* nw, bf16* Ob) {
    LAS char* lds = (LAS char*)F.lds;
    const int tid = F.tid, wid = F.wave, lane = F.lane, fr = lane & 15, fq = lane >> 4;
    for (int it = F.bid; it < HG_ITEMS; it += F.G) {
        const int c = it % HG_NC, bh = it / HG_NC, h = bh % A_HEADS, b = bh / A_HEADS;
        const size_t row0 = (size_t)b * SEQ + (size_t)c * HG_CH;
        { const int s = tid >> 3, ch = (tid & 7) * 16; const bf16* src = QTg + (row0 + s) * A_W + h * HD + ch;
          const v4u x0 = *(const v4u*)src, x1 = *(const v4u*)(src + 8); LAS v4u* dst = (LAS v4u*)(lds + HG_QT + s * 272 + ch * 2); dst[0] = x0; dst[1] = x1; }
        { const int dv = tid >> 2, ch = (tid & 3) * 32; const bf16* src = SPREV + ((size_t)it * HD + dv) * HD + ch;
          const v4u x0 = *(const v4u*)src, x1 = *(const v4u*)(src + 8), x2 = *(const v4u*)(src + 16), x3 = *(const v4u*)(src + 24);
          LAS v4u* dst = (LAS v4u*)(lds + HG_SP + dv * 272 + ch * 2); dst[0] = x0; dst[1] = x1; dst[2] = x2; dst[3] = x3; }
        LDS_WAIT(); __syncthreads();
#pragma unroll
        for (int k = 0; k < 4; ++k) { const int tau = wid + 8 * k, ti = tau >> 3, vi = tau & 7;
            const f32x4 acc = mma_tile<128>(lds + HG_QT + ti * 16 * 272, 272, lds + HG_SP + vi * 16 * 272, 272, fr, fq);
#pragma unroll
            for (int i = 0; i < 4; ++i) { const int t = 16 * ti + 4 * fq + i, dv = 16 * vi + fr;
                *(LAS float*)(lds + HG_OT + (t * 132 + dv) * 4) = acc[i] + OINTRA[(row0 + t) * A_W + h * HD + dv]; } }
        LDS_WAIT(); __syncthreads();
#pragma unroll
        for (int k = 0; k < 8; ++k) { const int t = wid * 8 + k;
            const float v0 = *(LAS float*)(lds + HG_OT + (t * 132 + lane) * 4), v1 = *(LAS float*)(lds + HG_OT + (t * 132 + 64 + lane) * 4);
            const float ss = wave_sum(v0 * v0 + v1 * v1); const float r = 1.f / sqrtf(ss * (1.f / HD) + RMS_EPS);
            const float g0 = bf2f(P0[(row0 + t) * AB_IN + 3 * A_W + h * HD + lane]), g1 = bf2f(P0[(row0 + t) * AB_IN + 3 * A_W + h * HD + 64 + lane]);
            Ob[(row0 + t) * DM + h * HD + lane] = (bf16)f2bf(v0 * r * nw[lane] * g0 * sigmoidf_(g0));
            Ob[(row0 + t) * DM + h * HD + 64 + lane] = (bf16)f2bf(v1 * r * nw[64 + lane] * g1 * sigmoidf_(g1)); }
        LDS_WAIT(); __syncthreads();
    }
}

constexpr float SB_CUT = -160.f;
__device__ __forceinline__ void sb_phase(Frame& F, const bf16* P0, bf16* Ob) {
    const int tid = F.tid, wid = F.wave, lane = F.lane, r32 = lane & 31, hi = lane >> 5;
    LAS char* lds = (LAS char*)F.lds;
    const int vb0 = (int)(uintptr_t)(lds + ATT_V_OFF) + v_rd_base(lane);
    KVDma dm; kv_dma_init(dm, AB_IN, AB_IN, wid, lane);
    constexpr int NQB = SEQ / 256, NU = BATCH * B_HEADS * NQB;
    for (int rd = 0; ; ++rd) {
        const int idx = (rd & 1) ? rd * F.G + (F.G - 1 - F.bid) : rd * F.G + F.bid;
        if (rd * F.G >= NU) break;
        if (idx >= NU) continue;
        const int qb = NQB - 1 - idx / (BATCH * B_HEADS), bh = idx % (BATCH * B_HEADS), head = bh % B_HEADS, b = bh / B_HEADS;
        const size_t rowb = (size_t)b * SEQ; const int q0 = qb * 256;
        const bf16* Kh = P0 + rowb * AB_IN + 4 * A_W + B_W + head * HD; const bf16* Vh = Kh + B_W;
        const int tw0 = q0 + wid * 32, t = tw0 + r32;
        bf16x8 qr[8]; load_q(qr, P0 + (rowb + t) * AB_IN + 4 * A_W + head * HD + hi * 8);
        float R = 0.f; f32x16 o[4] = {};
        const int jtop = (q0 + 254) >> 6;
        LAS unsigned* dflag = (LAS unsigned*)(lds + ATT_X_OFF);
        if (lane == 0) { dflag[wid] = 0u; dflag[8 + wid] = 0u; }
        LDS_WAIT(); __syncthreads();
        kv_dma(dm, Kh + (size_t)jtop * KVBLK * AB_IN, Vh + (size_t)jtop * KVBLK * AB_IN, lds, 0, wid);
        int buf = 0;
        for (int j = jtop; j >= 0; --j, buf = ATT_BUF - buf) {
            VM_WAIT(); __syncthreads();
            { unsigned alld = 1u;
#pragma unroll
              for (int w = 0; w < NWAVES; ++w) alld &= dflag[((j + 1) & 1) * 8 + w];
              if (__builtin_amdgcn_readfirstlane(alld)) break; }
            if (j > 0) kv_dma(dm, Kh + (size_t)(j - 1) * KVBLK * AB_IN, Vh + (size_t)(j - 1) * KVBLK * AB_IN, lds, ATT_BUF - buf, wid);
            const int k0 = j * KVBLK;
            if (k0 < tw0 + 31) {
                f32x16 p0, p1; qkt(p0, p1, lds + buf + ATT_K_OFF, qr, r32, hi);
                const bool need_mask = (k0 + 63 >= tw0);
                float L0[16], L1[16];
#pragma unroll
                for (int r = 0; r < 16; ++r) {
                    const float z0 = p0[r] * ATT_C, z1 = p1[r] * ATT_C;
                    float l0 = -(fmaxf(z0, 0.f) + __builtin_amdgcn_logf(1.f + __builtin_amdgcn_exp2f(-fabsf(z0))));
                    float l1 = -(fmaxf(z1, 0.f) + __builtin_amdgcn_logf(1.f + __builtin_amdgcn_exp2f(-fabsf(z1))));
                    if (need_mask) { if (k0 + crow(r, hi) >= t) l0 = 0.f; if (k0 + 32 + crow(r, hi) >= t) l1 = 0.f; }
                    L0[r] = l0; L1[r] = l1; p0[r] = z0 + l0; p1[r] = z1 + l1;
                }
                SBAR();
                float Sg[16];
#pragma unroll
                for (int gi = 0; gi < 4; ++gi) {
                    const float a = (L0[4 * gi] + L0[4 * gi + 1]) + (L0[4 * gi + 2] + L0[4 * gi + 3]), c = (L1[4 * gi] + L1[4 * gi + 1]) + (L1[4 * gi + 2] + L1[4 * gi + 3]);
                    auto ra = __builtin_amdgcn_permlane32_swap(__float_as_uint(a), __float_as_uint(a), false, false);
                    auto rc = __builtin_amdgcn_permlane32_swap(__float_as_uint(c), __float_as_uint(c), false, false);
                    Sg[2 * gi] = __uint_as_float(ra[0]); Sg[2 * gi + 1] = __uint_as_float(ra[1]); Sg[8 + 2 * gi] = __uint_as_float(rc[0]); Sg[8 + 2 * gi + 1] = __uint_as_float(rc[1]);
                }
                float run = R;
#pragma unroll
                for (int s = 15; s >= 0; --s) { const float tt = run; run += Sg[s]; Sg[s] = tt; }
                const float Rn = run;
                SBAR();
#pragma unroll
                for (int gi = 0; gi < 4; ++gi) {
                    float base0 = hi ? Sg[2 * gi + 1] : Sg[2 * gi], base1 = hi ? Sg[8 + 2 * gi + 1] : Sg[8 + 2 * gi];
                    float r3 = base0, r2 = r3 + L0[4 * gi + 3], r1 = r2 + L0[4 * gi + 2], r0 = r1 + L0[4 * gi + 1];
                    p0[4 * gi + 3] = __builtin_amdgcn_exp2f(p0[4 * gi + 3] + r3); p0[4 * gi + 2] = __builtin_amdgcn_exp2f(p0[4 * gi + 2] + r2);
                    p0[4 * gi + 1] = __builtin_amdgcn_exp2f(p0[4 * gi + 1] + r1); p0[4 * gi + 0] = __builtin_amdgcn_exp2f(p0[4 * gi + 0] + r0);
                    r3 = base1; r2 = r3 + L1[4 * gi + 3]; r1 = r2 + L1[4 * gi + 2]; r0 = r1 + L1[4 * gi + 1];
                    p1[4 * gi + 3] = __builtin_amdgcn_exp2f(p1[4 * gi + 3] + r3); p1[4 * gi + 2] = __builtin_amdgcn_exp2f(p1[4 * gi + 2] + r2);
                    p1[4 * gi + 1] = __builtin_amdgcn_exp2f(p1[4 * gi + 1] + r1); p1[4 * gi + 0] = __builtin_amdgcn_exp2f(p1[4 * gi + 0] + r0);
                }
                R = Rn;
                { const unsigned dn = __all(R < SB_CUT) ? 1u : 0u; if (lane == 0) dflag[(j & 1) * 8 + wid] = dn; }
                if (need_mask) {
#pragma unroll
                    for (int r = 0; r < 16; ++r) { if (k0 + crow(r, hi) >= t) p0[r] = 0.f; if (k0 + 32 + crow(r, hi) >= t) p1[r] = 0.f; }
                }
                bf16x8 pa0, pa1, pa2, pa3; pack_p(p0, p1, pa0, pa1, pa2, pa3);
                pv_d0(o, vb0 + buf, pa0, pa1, pa2, pa3);
            }
        }
        bf16* Ow = Ob + (rowb + tw0) * DM + A_W + head * HD;
#pragma unroll
        for (int r = 0; r < 16; ++r) { const int orow = crow(r, hi);
#pragma unroll
            for (int d0 = 0; d0 < 4; ++d0) Ow[(size_t)orow * DM + d0 * 32 + r32] = (bf16)f2bf(o[d0][r]); }
    }
}

constexpr int P1_KC = 4096, P1_VC = 4608, P1_KS = 5120, P1_VS = 5632, P1_KW = 6144, P1_VW = 6656, P1_GL = 7168;
__device__ __forceinline__ void nsa_rope_phase(Frame& F, const bf16* P1, bf16* QROT, bf16* KSROT, bf16* KWROT, bf16* OVL) {
    const int gw = F.bid * NWAVES + F.wave, NGW = F.G * NWAVES, lane = F.lane;
    const float inv_freq = powf(10000.0f, -(float)lane * (1.0f / 64.0f));
    for (int m = gw; m < MTOK; m += NGW) {
        const int t = m & (SEQ - 1);
        float sn, cs; sincosf((float)t * inv_freq, &sn, &cs);
        const bf16* row = P1 + (size_t)m * NSA_INP;
        for (int hh = 0; hh < 40; ++hh) {
            const bf16* src; bf16* dst;
            if (hh < 32) { src = row + hh * HD; dst = QROT + (size_t)m * DM + hh * HD; }
            else if (hh < 36) { src = row + P1_KS + (hh - 32) * HD; dst = KSROT + (size_t)m * KVW + (hh - 32) * HD; }
            else { src = row + P1_KW + (hh - 36) * HD; dst = KWROT + (size_t)m * KVW + (hh - 36) * HD; }
            const float x1 = bf2f(src[lane]), x2 = bf2f(src[64 + lane]);
            dst[lane] = (bf16)f2bf(x1 * cs - x2 * sn); dst[64 + lane] = (bf16)f2bf(x2 * cs + x1 * sn);
        }
    }
    for (int i = F.bid * NTHR + F.tid; i < NCMPP * NSLC; i += F.G * NTHR) { const int n = i / NSLC, j = i % NSLC;
        OVL[i] = (n < NCMP && n >= 4 * j - 1 && n <= 4 * j + 3) ? (bf16)0x3f80u : (bf16)0u; }
}
constexpr int CM_A = 0, CM_B = 17408, CM_H = 17408 + 34816;
__device__ __forceinline__ void nsa_compress_phase(Frame& F, const bf16* P1, const float* pos, const bf16* W1t, const bf16* W2t, bf16* KCMP, bf16* VCMP) {
    LAS char* lds = (LAS char*)F.lds;
    const int tid = F.tid, wid = F.wave, lane = F.lane, fr = lane & 15, fq = lane >> 4;
    for (int item = F.bid; item < 128; item += F.G) {
        const int nt = item & 7, g = (item >> 3) & 3, b = (item >> 5) & 1, which = item >> 6;
        const bf16* w1 = W1t + (size_t)which * HD * 32 * HD; const bf16* w2 = W2t + (size_t)which * HD * HD;
        const float* posw = pos + (size_t)which * 32 * HD;
        f32x4 acc[4];
#pragma unroll
        for (int k = 0; k < 4; ++k) acc[k] = (f32x4){0.f, 0.f, 0.f, 0.f};
        for (int l = 0; l < 32; ++l) {
            { const int r = tid >> 3, ch = (tid & 7) * 16, n = nt * 64 + r; unsigned w[8];
              if (n < NCMP) { const bf16* src = P1 + ((size_t)b * SEQ + 16 * n + l) * NSA_INP + P1_KC + which * KVW + g * HD + ch;
                  const v4u x0 = *(const v4u*)src, x1 = *(const v4u*)(src + 8); const unsigned xs[8] = {x0.x, x0.y, x0.z, x0.w, x1.x, x1.y, x1.z, x1.w};
#pragma unroll
                  for (int q = 0; q < 8; ++q) w[q] = pk2(bflo(xs[q]) + posw[l * HD + ch + 2 * q], bfhi(xs[q]) + posw[l * HD + ch + 2 * q + 1]);
              } else {
#pragma unroll
                  for (int q = 0; q < 8; ++q) w[q] = 0u; }
              LAS v4u* dst = (LAS v4u*)(lds + CM_A + r * 272 + ch * 2); dst[0] = (v4u){w[0], w[1], w[2], w[3]}; dst[1] = (v4u){w[4], w[5], w[6], w[7]}; }
            { const int e = tid >> 2, ch = (tid & 3) * 32; const bf16* src = w1 + (size_t)e * 32 * HD + l * HD + ch;
              const v4u x0 = *(const v4u*)src, x1 = *(const v4u*)(src + 8), x2 = *(const v4u*)(src + 16), x3 = *(const v4u*)(src + 24);
              LAS v4u* dst = (LAS v4u*)(lds + CM_B + e * 272 + ch * 2); dst[0] = x0; dst[1] = x1; dst[2] = x2; dst[3] = x3; }
            LDS_WAIT(); __syncthreads();
#pragma unroll
            for (int k = 0; k < 4; ++k) { const int tau = wid + 8 * k, ni = tau >> 3, ei = tau & 7;
                acc[k] += mma_tile<128>(lds + CM_A + ni * 16 * 272, 272, lds + CM_B + ei * 16 * 272, 272, fr, fq); }
            LDS_WAIT(); __syncthreads();
        }
#pragma unroll
        for (int k = 0; k < 4; ++k) { const int tau = wid + 8 * k, ni = tau >> 3, ei = tau & 7;
#pragma unroll
            for (int i = 0; i < 4; ++i) *(LAS unsigned short*)(lds + CM_H + (16 * ni + 4 * fq + i) * 272 + (16 * ei + fr) * 2) = (unsigned short)f2bf(gelu1(acc[k][i])); }
        { const int f = tid >> 2, ch = (tid & 3) * 32; const bf16* src = w2 + (size_t)f * HD + ch;
          const v4u x0 = *(const v4u*)src, x1 = *(const v4u*)(src + 8), x2 = *(const v4u*)(src + 16), x3 = *(const v4u*)(src + 24);
          LAS v4u* dst = (LAS v4u*)(lds + CM_B + f * 272 + ch * 2); dst[0] = x0; dst[1] = x1; dst[2] = x2; dst[3] = x3; }
        LDS_WAIT(); __syncthreads();
        bf16* outp = which ? VCMP : KCMP;
#pragma unroll
        for (int k = 0; k < 4; ++k) { const int tau = wid + 8 * k, ni = tau >> 3, fi = tau & 7;
            const f32x4 a2 = mma_tile<128>(lds + CM_H + ni * 16 * 272, 272, lds + CM_B + fi * 16 * 272, 272, fr, fq);
#pragma unroll
            for (int i = 0; i < 4; ++i) { const int n = nt * 64 + 16 * ni + 4 * fq + i;
                outp[(((size_t)b * NCMPP + n) * NSA_G + g) * HD + 16 * fi + fr] = (n < NCMP) ? (bf16)f2bf(a2[i]) : (bf16)0u; } }
        LDS_WAIT(); __syncthreads();
    }
}
__device__ __forceinline__ unsigned pick4(const unsigned (&a)[4], int i) { return i == 0 ? a[0] : (i == 1 ? a[1] : (i == 2 ? a[2] : a[3])); }
template <int MODE>
__device__ __forceinline__ void nsa_attn_phase(Frame& F, const bf16* P1, const bf16* Qsrc, const bf16* Ksrc, const bf16* Vsrc, const unsigned* SEL, float* O32, float* IMP, bf16* Ob, bool probe_nostore = false) {
    const int tid = F.tid, wid = F.wave, lane = F.lane, r32 = lane & 31, hi = lane >> 5;
    LAS char* lds = (LAS char*)F.lds;
    LAS float* wsc = (LAS float*)(lds + ATT_WS_OFF + wid * 256);
    const int vb0 = (int)(uintptr_t)(lds + ATT_V_OFF) + v_rd_base(lane);
    KVDma dm; kv_dma_init(dm, MODE <= 1 ? NSA_G * HD : KVW, MODE == 0 ? NSA_G * HD : (MODE == 1 ? NSLC : NSA_INP), wid, lane);
    constexpr int NTB = SEQ / 32, NU = BATCH * NSA_G * NTB;
    for (int rd = 0; ; ++rd) {
        const int idx = (rd & 1) ? rd * F.G + (F.G - 1 - F.bid) : rd * F.G + F.bid;
        if (rd * F.G >= NU) break;
        if (idx >= NU) continue;
        const int tb = NTB - 1 - idx / (BATCH * NSA_G), bg = idx % (BATCH * NSA_G), g = bg % NSA_G, b = bg / NSA_G;
        const size_t rowb = (size_t)b * SEQ; const int t0 = tb * 32;
        const int t = (MODE == 2) ? t0 + 4 * wid + (r32 >> 3) : t0 + r32, head = (MODE == 2) ? g * NSA_R + (r32 & 7) : g * NSA_R + wid;
        const bf16* Kh; const bf16* Vh; long ldk, ldv; int jlo, jhi;
        if (MODE <= 1) { Kh = Ksrc + ((size_t)b * NCMPP * NSA_G + g) * HD; ldk = NSA_G * HD; jlo = 0; jhi = (t0 >> 4) >> 6;
            if (MODE == 0) { Vh = Vsrc + ((size_t)b * NCMPP * NSA_G + g) * HD; ldv = NSA_G * HD; } else { Vh = Vsrc; ldv = NSLC; } }
        else { Kh = Ksrc + rowb * KVW + g * HD; ldk = KVW; Vh = P1 + rowb * NSA_INP + (MODE == 2 ? P1_VS : P1_VW) + g * HD; ldv = NSA_INP;
            jhi = (t0 + 31) >> 6; jlo = (MODE == 2) ? 0 : ((t0 - (WINDOW - 1) > 0 ? t0 - (WINDOW - 1) : 0) >> 6); }
        bf16x8 qr[8]; load_q(qr, Qsrc + (rowb + t) * (MODE <= 1 ? NSA_INP : DM) + head * HD + hi * 8);
        unsigned selw[4] = {0u, 0u, 0u, 0u}, uni[4] = {~0u, ~0u, ~0u, ~0u}, wn[4] = {~0u, ~0u, ~0u, ~0u};
        if (MODE == 2) { const v4u sv = *(const v4u*)(SEL + ((rowb + t) * NSA_G + g) * 4); selw[0] = sv.x; selw[1] = sv.y; selw[2] = sv.z; selw[3] = sv.w;
            LAS unsigned* un = (LAS unsigned*)(lds + ATT_X_OFF);
#pragma unroll
            for (int q = 0; q < 4; ++q) { unsigned x = selw[q]; x |= __shfl_xor(x, 8); x |= __shfl_xor(x, 16); wn[q] = __builtin_amdgcn_readfirstlane(x); if (lane == 0) un[wid * 4 + q] = wn[q]; }
            LDS_WAIT(); __syncthreads();
#pragma unroll
            for (int q = 0; q < 4; ++q) { unsigned x = 0u;
#pragma unroll
                for (int w = 0; w < NWAVES; ++w) x |= un[w * 4 + q];
                uni[q] = __builtin_amdgcn_readfirstlane(x); } }
        float m_reg = -1e30f, l_reg = 0.f; f32x16 o[4] = {};
        const int cur = t >> 6;
#define NSA_NEXT(jj) do { if (MODE == 2) { while ((jj) <= jhi && !((pick4(uni, (jj) >> 5) >> ((jj) & 31)) & 1u)) ++(jj); } } while (0)
        int j = jlo; NSA_NEXT(j);
        __syncthreads();
        if (j <= jhi) kv_dma(dm, Kh + (size_t)j * KVBLK * ldk, Vh + (size_t)j * KVBLK * ldv, lds, 0, wid);
        int buf = 0;
        while (j <= jhi) {
            int jn = j + 1; NSA_NEXT(jn);
            const int k0 = j * KVBLK;
            VM_WAIT(); __syncthreads();
            if (jn <= jhi) kv_dma(dm, Kh + (size_t)jn * KVBLK * ldk, Vh + (size_t)jn * KVBLK * ldv, lds, ATT_BUF - buf, wid);
            if (MODE == 2 && !((pick4(wn, j >> 5) >> (j & 31)) & 1u)) { j = jn; buf = ATT_BUF - buf; continue; }
            f32x16 p0, p1; qkt(p0, p1, lds + buf + ATT_K_OFF, qr, r32, hi);
            unsigned vm0 = 0u, vm1 = 0u; bool full;
            if (MODE <= 1) { full = (16 * (k0 + 63) + 31 <= t0);
                if (!full) {
#pragma unroll
                    for (int r = 0; r < 16; ++r) { vm0 |= (16 * (k0 + crow(r, hi)) + 31 <= t) ? (1u << r) : 0u; vm1 |= (16 * (k0 + 32 + crow(r, hi)) + 31 <= t) ? (1u << r) : 0u; } } }
            else if (MODE == 2) { full = false; const bool mine = (pick4(selw, j >> 5) >> (j & 31)) & 1u;
                if (mine) { if (j < cur) { vm0 = 0xffffu; vm1 = 0xffffu; } else {
#pragma unroll
                    for (int r = 0; r < 16; ++r) { vm0 |= (k0 + crow(r, hi) <= t) ? (1u << r) : 0u; vm1 |= (k0 + 32 + crow(r, hi) <= t) ? (1u << r) : 0u; } } } }
            else { full = (k0 > t0 + 31 - WINDOW) && (k0 + 63 <= t0);
                if (!full) {
#pragma unroll
                    for (int r = 0; r < 16; ++r) { const int ka = k0 + crow(r, hi), kb = ka + 32;
                        vm0 |= (ka <= t && ka > t - WINDOW) ? (1u << r) : 0u; vm1 |= (kb <= t && kb > t - WINDOW) ? (1u << r) : 0u; } } }
            float alpha;
            if (full) softmax_tile<false>(p0, p1, 0u, 0u, m_reg, l_reg, alpha); else softmax_tile<true>(p0, p1, vm0, vm1, m_reg, l_reg, alpha);
            rescale_o(o, alpha, wsc, r32, hi);
            bf16x8 pa0, pa1, pa2, pa3; pack_p(p0, p1, pa0, pa1, pa2, pa3);
            pv_d0(o, vb0 + buf, pa0, pa1, pa2, pa3);
            j = jn; buf = ATT_BUF - buf;
        }
#undef NSA_NEXT
        { float fac = l_reg > 0.f ? __builtin_amdgcn_rcpf(l_reg) : 0.f;
          if (MODE != 1) { const int br = MODE == 0 ? 0 : (MODE == 2 ? 1 : 2); fac *= sigmoidf_(bf2f(P1[(rowb + t) * NSA_INP + P1_GL + head * 3 + br])); }
          if (hi == 0) wsc[32 + r32] = fac; LDS_WAIT(); }
        if (MODE == 1) {
            float fc[16];
#pragma unroll
            for (int r = 0; r < 16; ++r) fc[r] = wsc[32 + crow(r, hi)];
            LDS_WAIT(); __syncthreads();
#pragma unroll
            for (int r = 0; r < 16; ++r) { const int orow = crow(r, hi);
#pragma unroll
                for (int d0 = 0; d0 < 4; ++d0) *(LAS float*)(lds + ((wid * 32 + orow) * 128 + d0 * 32 + r32) * 4) = o[d0][r] * fc[r]; }
            LDS_WAIT(); __syncthreads();
            { const int tok = tid >> 4, j8 = (tid & 15) * 8; f32x4 s0 = {0.f, 0.f, 0.f, 0.f}, s1 = {0.f, 0.f, 0.f, 0.f};
#pragma unroll
              for (int w = 0; w < 8; ++w) { const LAS f32x4* pp = (const LAS f32x4*)(lds + ((w * 32 + tok) * 128 + j8) * 4); s0 += pp[0]; s1 += pp[1]; }
              f32x4* dst = (f32x4*)(IMP + ((rowb + t0 + tok) * NSA_G + g) * NSLC + j8); dst[0] = s0; dst[1] = s1; }
            LDS_WAIT(); __syncthreads();
        } else {
#pragma unroll
            for (int r = 0; r < 16; ++r) { const int orow = crow(r, hi); const float fc = wsc[32 + orow];
                const size_t off = (MODE == 2) ? (rowb + t0 + 4 * wid + (orow >> 3)) * DM + (g * NSA_R + (orow & 7)) * HD + r32 : (rowb + t0 + orow) * DM + head * HD + r32;
#pragma unroll
                for (int d0 = 0; d0 < 4; ++d0) {
                    if (MODE == 0) O32[off + d0 * 32] = o[d0][r] * fc;
                    else if (MODE == 2) { if (!probe_nostore) O32[off + d0 * 32] += o[d0][r] * fc; }
                    else Ob[off + d0 * 32] = (bf16)f2bf(O32[off + d0 * 32] + o[d0][r] * fc); } }
            LDS_WAIT();
        }
    }
}
__device__ __forceinline__ void nsa_topk_phase(Frame& F, const float* IMP, unsigned* SEL) {
    LAS float* sc = (LAS float*)(F.lds + F.wave * 1024);
    const int gw = F.bid * NWAVES + F.wave, NGW = F.G * NWAVES, lane = F.lane;
    for (int it = gw; it < MTOK * NSA_G; it += NGW) {
        const int m = it / NSA_G, t = m & (SEQ - 1), cur = t >> 6;
        const float* ip = IMP + (size_t)it * NSLC;
        const float a0 = ip[lane], a1 = ip[64 + lane];
        sc[lane] = a0; sc[64 + lane] = a1; LDS_WAIT();
        const int j0 = lane, j1 = lane + 64;
        const bool f0 = (j0 == 0) || (j0 == cur) || (j0 == cur - 1), f1 = (j1 == cur) || (j1 == cur - 1);
        const bool c0 = !f0 && j0 <= cur, c1 = !f1 && j1 <= cur;
        const int nforced = cur >= 2 ? 3 : cur + 1, slots = NTOP - nforced;
        int rk0 = 0, rk1 = 0;
        const int ncand_hi = cur < NSLC ? cur : NSLC - 1;
        for (int i = 1; i <= ncand_hi; ++i) {
            const bool fi = (i == cur) || (i == cur - 1); if (fi) continue;
            const float v = sc[i];
            rk0 += (v > a0 || (v == a0 && i < j0)) ? 1 : 0; rk1 += (v > a1 || (v == a1 && i < j1)) ? 1 : 0;
        }
        const bool s0 = (f0 && j0 <= cur) || (c0 && rk0 < slots), s1 = (f1 && j1 <= cur) || (c1 && rk1 < slots);
        const unsigned long long m0 = __ballot(s0), m1 = __ballot(s1);
        if (lane == 0) { v4u w = {(unsigned)m0, (unsigned)(m0 >> 32), (unsigned)m1, (unsigned)(m1 >> 32)}; *(v4u*)(SEL + (size_t)it * 4) = w; }
        LDS_WAIT();
    }
}

#ifndef STAGE
#define STAGE 3
#endif
#define ZERO_OB_PHASE PH_BEGIN { v4u z = {0u, 0u, 0u, 0u}; v4u* p = (v4u*)Ob; const long n = (long)MTOK * DM / 8; \
            for (long i = (long)F.bid * NTHR + F.tid; i < n; i += (long)F.G * NTHR) p[i] = z; } PH_END
#define MIXER0_PHASES \
    PH_BEGIN REP(10) hgrn_phase_a(F, BIG, (const float*)(ws + WS_LB), (bf16*)(ws + WS_QT), (float*)(ws + WS_OINTRA), (float*)(ws + WS_DS), (float*)(ws + WS_DEC)); \
             REP(11) sb_phase(F, BIG, Ob); PH_END \
    PH_BEGIN REP(12) hgrn_phase_b(F, (const float*)(ws + WS_DS), (const float*)(ws + WS_DEC), (bf16*)(ws + WS_SPREV)); PH_END \
    PH_BEGIN REP(13) hgrn_phase_c(F, BIG, (const bf16*)(ws + WS_QT), (const float*)(ws + WS_OINTRA), (const bf16*)(ws + WS_SPREV), args.in[IN_HGRN_NW], Ob); PH_END
#if STAGE <= 2
#define MIXER1_PHASES ZERO_OB_PHASE
#else
#define MIXER1_PHASES \
    PH_BEGIN REP(14) { nsa_rope_phase(F, BIG, (bf16*)(ws + WS_QROT), (bf16*)(ws + WS_KSROT), (bf16*)(ws + WS_KWROT), (bf16*)(ws + WS_OVL)); \
             nsa_compress_phase(F, BIG, args.in[IN_NSA_CMP_POS], (const bf16*)(ws + WS_W_C1), (const bf16*)(ws + WS_W_C2), (bf16*)(ws + WS_KCMP), (bf16*)(ws + WS_VCMP)); } PH_END \
    PH_BEGIN REP(15) { nsa_attn_phase<0>(F, BIG, BIG, (const bf16*)(ws + WS_KCMP), (const bf16*)(ws + WS_VCMP), nullptr, (float*)(ws + WS_O32), nullptr, nullptr); \
             nsa_attn_phase<1>(F, BIG, BIG, (const bf16*)(ws + WS_KCMP), (const bf16*)(ws + WS_OVL), nullptr, nullptr, (float*)(ws + WS_IMP), nullptr); } PH_END \
    PH_BEGIN REP(16) nsa_topk_phase(F, (const float*)(ws + WS_IMP), (unsigned*)(ws + WS_SEL)); PH_END \
    PH_BEGIN REP(18) nsa_attn_phase<2>(F, BIG, (const bf16*)(ws + WS_QROT), (const bf16*)(ws + WS_KSROT), nullptr, (const unsigned*)(ws + WS_SEL), (float*)(ws + WS_O32), nullptr, nullptr, r_ > 0); PH_END \
    PH_BEGIN REP(17) nsa_attn_phase<3>(F, BIG, (const bf16*)(ws + WS_QROT), (const bf16*)(ws + WS_KWROT), nullptr, nullptr, (float*)(ws + WS_O32), nullptr, Ob); PH_END
#endif
#ifndef REPMASK
#define REPMASK 0u
#endif
#define REP(gid) for (int r_ = 0; r_ <= (int)((REPMASK >> (gid)) & 1u); ++r_)
#define PH_BEGIN if (pc >= lo && pc < hi) { F.fresh();
#define PH_END   if (pc + 1 < hi) { XcdBarrier bb_ = bar; asm volatile("" : "+s"(bb_.bar), "+s"(bb_.x)); xcd_barrier(bb_); } } ++pc;
template <int l>
__device__ __forceinline__ void layer_body(Frame& F, const Args& args, const XcdBarrier& bar, int& pc, const int lo, const int hi) {
    unsigned char* ws = args.ws;
    bf16* HB = (bf16*)(ws + WS_HB); bf16* Y = (bf16*)(ws + WS_Y); float* H32 = args.out;
    bf16* BIG = (bf16*)(ws + WS_BIG); bf16* Gm = (bf16*)(ws + WS_G); bf16* Ob = (bf16*)(ws + WS_O);
    bf16* XQ = (bf16*)(ws + WS_XQ); bf16* XO = (bf16*)(ws + WS_XO);
        PH_BEGIN REP(1) {
            const int N = l == 0 ? AB_IN : NSA_INP;
            pg8::Gemm g{HB, l == 0 ? (const bf16*)(ws + WS_W_ABIN) : (const bf16*)(ws + WS_W_NSAIN), MTOK, N, DM};
            pg8::StaticOrder S; S.init(MTOK, N, F.G, F.bid);
            pg8::EpiBf16<0> E{BIG, N, nullptr, 0, 0, 1.f};
            pg8::gemm_phase<pg8::EpiBf16<0>, pg8::StaticOrder, PG8_ALIGN, PG8_SP2>(F.lds + RING_OFF, g, S, E);
        } PH_END
#if STAGE <= 1
        ZERO_OB_PHASE
#else
        if (l == 0) {
            MIXER0_PHASES
        } else {
            MIXER1_PHASES
        }
#endif
        PH_BEGIN REP(2) {
            pg8::Gemm g{Ob, l == 0 ? (const bf16*)(ws + WS_W_ABOUT) : (const bf16*)(ws + WS_W_NSAOUT), MTOK, DM, DM};
            pg8::StaticOrder S; S.init(MTOK, DM, F.G, F.bid);
            if (l == 0) { pg8::EpiResBf E{Y, HB, DM, DN_ALPHA};
                pg8::gemm_phase<pg8::EpiResBf, pg8::StaticOrder, PG8_ALIGN, PG8_SP2>(F.lds + RING_OFF, g, S, E); }
            else { pg8::EpiResLn E{Y, (const float*)(ws + WS_STATS), args.in[IN_LN_G] + (size_t)2 * DM, args.in[IN_LN_B] + (size_t)2 * DM, DM, DN_ALPHA};
                pg8::gemm_phase<pg8::EpiResLn, pg8::StaticOrder, PG8_ALIGN, PG8_SP2>(F.lds + RING_OFF, g, S, E); }
        } PH_END
        PH_BEGIN REP(7) ln_phase(F, Y, args.in[IN_LN_G] + (size_t)(l * 3 + 0) * DM, args.in[IN_LN_B] + (size_t)(l * 3 + 0) * DM, nullptr, HB, (float*)(ws + WS_STATS)); PH_END
        PH_BEGIN REP(3) {
            {   pg8::Gemm g{HB, (const bf16*)(ws + WS_W_XQ) + (size_t)l * XW * DM, MTOK, XW, DM};
                pg8::RangeOrder S; S.init(MTOK, XW, 0, 128, F.bid);
                pg8::EpiBf16<0> E{XQ, XW, nullptr, 0, 0, 1.f};
                pg8::gemm_phase<pg8::EpiBf16<0>, pg8::RangeOrder, PG8_ALIGN, PG8_SP2>(F.lds + RING_OFF, g, S, E); }
            {   pg8::Gemm g{(const bf16*)(ws + WS_MEMB), (const bf16*)(ws + WS_W_XKV) + (size_t)l * 2 * XW * DM, BATCH * NMEM, 2 * XW, DM};
                pg8::RangeOrder S; S.init(BATCH * NMEM, 2 * XW, 128, 8, F.bid);
                pg8::EpiBf16<0> E{(bf16*)(ws + WS_XKV) + (size_t)l * BATCH * NMEM * 2 * XW, 2 * XW, nullptr, 0, 0, 1.f};
                pg8::gemm_phase<pg8::EpiBf16<0>, pg8::RangeOrder, PG8_ALIGN, PG8_SP2>(F.lds + RING_OFF, g, S, E); }
        } PH_END
        PH_BEGIN REP(9) xattn_phase(F, XQ, (const bf16*)(ws + WS_XKV) + (size_t)l * BATCH * NMEM * 2 * XW, XO); PH_END
        PH_BEGIN REP(4) {
            pg8::Gemm g{XO, (const bf16*)(ws + WS_W_XO) + (size_t)l * DM * XW, MTOK, DM, XW};
            pg8::StaticOrder S; S.init(MTOK, DM, F.G, F.bid);
            pg8::EpiResLn E{Y, (const float*)(ws + WS_STATS), args.in[IN_LN_G] + (size_t)(l * 3 + 0) * DM, args.in[IN_LN_B] + (size_t)(l * 3 + 0) * DM, DM, DN_ALPHA};
            pg8::gemm_phase<pg8::EpiResLn, pg8::StaticOrder, PG8_ALIGN, PG8_SP2>(F.lds + RING_OFF, g, S, E);
        } PH_END
        PH_BEGIN REP(7) ln_phase(F, Y, args.in[IN_LN_G] + (size_t)(l * 3 + 1) * DM, args.in[IN_LN_B] + (size_t)(l * 3 + 1) * DM, nullptr, HB, (float*)(ws + WS_STATS)); PH_END
        PH_BEGIN REP(5) {
            pg8::Gemm g{HB, (const bf16*)(ws + WS_W_UP) + (size_t)l * DFF2 * DM, MTOK, DFF2, DM};
            pg8::StaticOrder S; S.init(MTOK, DFF2, F.G, F.bid);
            pg8::EpiBf16<0> E{BIG, DFF2, nullptr, 0, 0, 1.f};
            pg8::gemm_phase<pg8::EpiBf16<0>, pg8::StaticOrder, PG8_ALIGN, PG8_SP2>(F.lds + RING_OFF, g, S, E);
        } PH_END
#if (REPMASK >> 20) & 1
        PH_BEGIN {
            pg8::Gemm g{HB, (const bf16*)(ws + WS_W_UP) + (size_t)l * DFF2 * DM, MTOK, DFF2, DM};
            pg8::ZeroOrder S; S.init(MTOK, DFF2, F.G, F.bid);
            pg8::EpiBf16<0> E{Gm, DFF2, nullptr, 0, 0, 1.f};
            pg8::gemm_phase<pg8::EpiBf16<0>, pg8::ZeroOrder, PG8_ALIGN, PG8_SP2>(F.lds + RING_OFF, g, S, E);
        } PH_END
#endif
        PH_BEGIN REP(8) convglu_phase(F, BIG, args.in[IN_FFN_CONV] + (size_t)l * 3 * DFF, Gm); PH_END
        PH_BEGIN REP(6) {
            pg8::Gemm g{Gm, (const bf16*)(ws + WS_W_DOWN) + (size_t)l * DM * DFF, MTOK, DM, DFF};
            pg8::StaticOrder S; S.init(MTOK, DM, F.G, F.bid);
            pg8::EpiResLn E{Y, (const float*)(ws + WS_STATS), args.in[IN_LN_G] + (size_t)(l * 3 + 1) * DM, args.in[IN_LN_B] + (size_t)(l * 3 + 1) * DM, DM, DN_ALPHA};
            pg8::gemm_phase<pg8::EpiResLn, pg8::StaticOrder, PG8_ALIGN, PG8_SP2>(F.lds + RING_OFF, g, S, E);
        } PH_END
        PH_BEGIN REP(7) ln_phase(F, Y, args.in[IN_LN_G] + (size_t)(l * 3 + 2) * DM, args.in[IN_LN_B] + (size_t)(l * 3 + 2) * DM, l == 1 ? H32 : nullptr, HB, (float*)(ws + WS_STATS)); PH_END
}
__global__ void __launch_bounds__(NTHR, 2) mega_fwd(Args args) {
    extern __shared__ __attribute__((aligned(16))) unsigned char lds_raw[];
    Frame F;
    F.lds = (LAS unsigned char*)lds_raw; F.ws = args.ws;
    F.tid = threadIdx.x; F.lane = F.tid & 63; F.wave = __builtin_amdgcn_readfirstlane(F.tid >> 6); F.G = gridDim.x;
    unsigned char* ws = args.ws;
    gu32* ctl = (gu32*)(ws + WS_CTL);
    for (int u = F.tid; u < (LDS_BYTES - LDSCTL_OFF) / 4; u += NTHR) ((LAS unsigned*)(F.lds + LDSCTL_OFF))[u] = 0u;
    __syncthreads();
    volatile LAS unsigned* MISC = (volatile LAS unsigned*)(F.lds + MISC_OFF);
    XcdBarrier bar = xcd_barrier_post((unsigned*)(ctl + CW_BAR), MISC + 8);
    const int lo = args.ph_lo, hi = args.ph_hi; int pc = 0;
    bf16* HB = (bf16*)(ws + WS_HB); bf16* Y = (bf16*)(ws + WS_Y); float* H32 = args.out;
    bf16* BIG = (bf16*)(ws + WS_BIG); bf16* Gm = (bf16*)(ws + WS_G); bf16* Ob = (bf16*)(ws + WS_O);
    bf16* XQ = (bf16*)(ws + WS_XQ); bf16* XO = (bf16*)(ws + WS_XO);

    PH_BEGIN REP(0) p0_prologue(F, args); PH_END

    layer_body<0>(F, args, bar, pc, lo, hi);
    layer_body<1>(F, args, bar, pc, lo, hi);
}

extern "C" void kernel_launch(void* const* d_in, const int* in_sizes, int n_in, void* d_out, int out_size, void* d_ws, size_t ws_size, hipStream_t stream) {
    static int grid = 0;
    if (grid == 0) {
        if (n_in != 19 || in_sizes[0] != MTOK * DM || out_size != MTOK * DM || ws_size < WS_END) {
            fprintf(stderr, "kernel_launch: shape mismatch n_in %d in0 %d out %d ws %zu (need %zu)\n", n_in, n_in > 0 ? in_sizes[0] : -1, out_size, ws_size, (size_t)WS_END); grid = -1; return; }
        int dev = 0, cus = 0, per_cu = 0;
        if (hipGetDevice(&dev) != hipSuccess || hipDeviceGetAttribute(&cus, hipDeviceAttributeMultiprocessorCount, dev) != hipSuccess) { grid = -1; return; }
        if (hipFuncSetAttribute((const void*)mega_fwd, hipFuncAttributeMaxDynamicSharedMemorySize, LDS_BYTES) != hipSuccess) { fprintf(stderr, "kernel_launch: hipFuncSetAttribute failed\n"); grid = -1; return; }
        if (hipOccupancyMaxActiveBlocksPerMultiprocessor(&per_cu, (const void*)mega_fwd, NTHR, LDS_BYTES) != hipSuccess || per_cu < 1)
            fprintf(stderr, "kernel_launch: note: occupancy query reports %d workgroups per CU\n", per_cu);
        (void)hipGetLastError();
        grid = cus;
    }
    if (grid < 0) return;
    if (hipMemsetAsync((char*)d_ws + WS_CTL, 0, CTL_ZERO_BYTES, stream) != hipSuccess) { fprintf(stderr, "kernel_launch: memset failed\n"); return; }
    Args a{};
    for (int i = 0; i < 19; ++i) a.in[i] = (const float*)d_in[i];
    a.out = (float*)d_out; a.ws = (unsigned char*)d_ws; a.ph_lo = 0; a.ph_hi = 1 << 20;
    hipLaunchKernelGGL(mega_fwd, dim3(grid), dim3(NTHR), LDS_BYTES, stream, a);
    const hipError_t le = hipPeekAtLastError();
    if (le != hipSuccess) fprintf(stderr, "kernel_launch: launch failed: %s\n", hipGetErrorName(le));
}
```

```cpp
#include <hip/hip_runtime.h>
#include <cstdio>
#include <cstdint>
namespace pg8 {
#define PG8_LAS __attribute__((address_space(3)))
typedef unsigned short bf16_t;
typedef short bf16x8 __attribute__((ext_vector_type(8)));
typedef float f32x4 __attribute__((ext_vector_type(4)));
typedef unsigned u32x4 __attribute__((ext_vector_type(4)));
constexpr int BM = 256, BK = 64, HALF = 128, HTB = HALF * BK * 2  , STAGE_BYTES = 8 * HTB, NXCD = 8, WGM = 8;

__host__ __device__ __forceinline__ int lds_byte(int r, int c) { const int st = (r >> 4) * 2 + (c >> 5), rr = r & 15, cc = c & 31, ob = rr * 64 + cc * 2; return st * 1024 + (ob ^ (((ob >> 9) & 1) << 5)); }
__host__ __device__ __forceinline__ void stage_rc(int b, int& R, int& C) { const int st = b / 1024, sb = b % 1024, swz = sb ^ (((sb >> 9) & 1) << 5); R = (st >> 1) * 16 + swz / 64; C = (st & 1) * 32 + (swz % 64) / 2; }
__host__ __device__ __forceinline__ int perm32(int rho) { const int n = rho >> 4, i = rho & 15; return 8 * (i >> 2) + 4 * n + (i & 3); }

struct Unit { int pm, pn; };
struct Gemm { const bf16_t* A; const bf16_t* Bt; int M, N, K; };

struct StaticOrder {
    int nM, nN, nwg, G, c;
    __host__ __device__ void init(int M, int N, int G_, int c_) { nM = M / BM; nN = N / BM; nwg = nM * nN; G = G_; c = c_; }
    __host__ __device__ bool next(int i, Unit& u) const {
        const long L = (long)i * G + c; if (L >= nwg) return false;
        int wgid = (int)L; { const int q = nwg / NXCD, r = nwg % NXCD, xcd = wgid % NXCD, off = wgid / NXCD; wgid = (xcd < r ? xcd * (q + 1) : r * (q + 1) + (xcd - r) * q) + off; }
        const int nig = WGM * nN, gid = wgid / nig, fm = gid * WGM, gsz = (nM - fm) < WGM ? (nM - fm) : WGM;
        u.pm = fm + ((wgid % nig) % gsz); u.pn = (wgid % nig) / gsz; return true;
    }
    __device__ __forceinline__ void a_ready(const Unit&) const {}
    __device__ __forceinline__ void done(const Unit&) const {}
};

__device__ __forceinline__ unsigned cvt_pk_bf16(float lo, float hi) { unsigned r; asm volatile("v_cvt_pk_bf16_f32 %0, %1, %2" : "=v"(r) : "v"(lo), "v"(hi)); return r; }
typedef float f32x2 __attribute__((ext_vector_type(2)));
__device__ __forceinline__ f32x2 gelu_pk(f32x2 v) {
    const f32x2 av = __builtin_elementwise_abs(v), d = av * 0.2316418882f + 1.0f;
    f32x2 t; t.x = __builtin_amdgcn_rcpf(d.x); t.y = __builtin_amdgcn_rcpf(d.y);
    f32x2 q = t * 0.5307027145f + (-0.7265760135f); q = q * t + 0.7107068705f; q = q * t + (-0.142248368f); q = q * t + 0.127414796f; q = q * t;
    const f32x2 s = (v * v) * (-0.72134752044f);
    f32x2 e; e.x = __builtin_amdgcn_exp2f(s.x); e.y = __builtin_amdgcn_exp2f(s.y);
    const f32x2 m = v * (q * e), r = v - m;
    f32x2 o; o.x = v.x < 0.f ? m.x : r.x; o.y = v.y < 0.f ? m.y : r.y; return o;
}

template <int ACT  > struct EpiBf16 {
    static constexpr bool PERM = true, AFTER_DRAIN = false; static_assert(ACT == 0 || ACT == 1, "EpiBf16: ACT is 0 (none) or 1 (gelu_pk)");
    bf16_t* O; int ldc; const float* bias; int split_cols; size_t split_stride; float scale0;
    __device__ __forceinline__ void operator()(const f32x4 (&acc)[2][2][4][2], const Unit& u, int wr, int wc, int fr, int fq) const {
        const int row0 = u.pm * BM + wr * 64 + fr; int colt = u.pn * BM; bf16_t* base = O;
        float sc = 1.f; if (split_cols) { const int t = colt / split_cols; base += (size_t)t * split_stride; colt -= t * split_cols; if (t == 0) sc = scale0; }
        const int col0 = colt + wc * 32 + 8 * fq, bcol0 = u.pn * BM + wc * 32 + 8 * fq;
        f32x4 bv[2][2];
#pragma unroll
        for (int bj = 0; bj < 2; ++bj)
#pragma unroll
            for (int n = 0; n < 2; ++n) bv[bj][n] = bias ? *(const f32x4*)(bias + bcol0 + bj * HALF + 4 * n) : (f32x4){0.f, 0.f, 0.f, 0.f};
#pragma unroll
        for (int ai = 0; ai < 2; ++ai)
#pragma unroll
            for (int m = 0; m < 4; ++m) { bf16_t* rowp = base + (size_t)(row0 + ai * HALF + m * 16) * ldc + col0;
#pragma unroll
                for (int bj = 0; bj < 2; ++bj) { f32x4 v0 = acc[ai][bj][m][0] + bv[bj][0], v1 = acc[ai][bj][m][1] + bv[bj][1];
                    if (ACT == 1) { f32x2 a = gelu_pk((f32x2){v0[0], v0[1]}), b = gelu_pk((f32x2){v0[2], v0[3]}), c = gelu_pk((f32x2){v1[0], v1[1]}), d = gelu_pk((f32x2){v1[2], v1[3]});
                        v0 = (f32x4){a.x, a.y, b.x, b.y}; v1 = (f32x4){c.x, c.y, d.x, d.y}; }
                    v0 = v0 * sc; v1 = v1 * sc; u32x4 w; w.x = cvt_pk_bf16(v0[0], v0[1]); w.y = cvt_pk_bf16(v0[2], v0[3]); w.z = cvt_pk_bf16(v1[0], v1[1]); w.w = cvt_pk_bf16(v1[2], v1[3]);
                    *(u32x4*)(rowp + bj * HALF) = w; } }
    }
};


struct EpiRes {
    static constexpr bool PERM = false, AFTER_DRAIN = false;
    float* Y; const float* res; int ldc; float alpha;
    __device__ __forceinline__ void operator()(const f32x4 (&acc)[2][2][4][2], const Unit& u, int wr, int wc, int fr, int fq) const {
        const int row0 = u.pm * BM + wr * 64 + fr, col0 = u.pn * BM + wc * 32 + 4 * fq;
#pragma unroll
        for (int ai = 0; ai < 2; ++ai)
#pragma unroll
            for (int m = 0; m < 4; ++m) { const size_t off = (size_t)(row0 + ai * HALF + m * 16) * ldc + col0;
#pragma unroll
                for (int bj = 0; bj < 2; ++bj)
#pragma unroll
                    for (int n = 0; n < 2; ++n) { const f32x4 r = *(const f32x4*)(res + off + bj * HALF + n * 16);
                        *(f32x4*)(Y + off + bj * HALF + n * 16) = r * alpha + acc[ai][bj][m][n]; } }
    }
};
struct RangeOrder {
    int nM, nN, ntot, c0, nw, c;
    __host__ __device__ void init(int M, int N, int c0_, int nw_, int c_) { nM = M / BM; nN = N / BM; ntot = nM * nN; c0 = c0_; nw = nw_; c = c_; }
    __host__ __device__ bool next(int i, Unit& u) const {
        if (c < c0 || c >= c0 + nw) return false;
        const int L = i * nw + (c - c0); if (L >= ntot) return false;
        u.pm = L / nN; u.pn = L % nN; return true;
    }
    __device__ __forceinline__ void a_ready(const Unit&) const {}
    __device__ __forceinline__ void done(const Unit&) const {}
};

struct ZeroOrder : StaticOrder {
    __host__ __device__ bool next(int i, Unit& u) const { const bool r = StaticOrder::next(i, u); u.pm = 0; u.pn = 0; return r; }
};

struct EpiResBf {
    static constexpr bool PERM = true, AFTER_DRAIN = false;
    bf16_t* Y; const bf16_t* res; int ldc; float alpha;
    __device__ __forceinline__ void operator()(const f32x4 (&acc)[2][2][4][2], const Unit& u, int wr, int wc, int fr, int fq) const {
        const int row0 = u.pm * BM + wr * 64 + fr, col0 = u.pn * BM + wc * 32 + 8 * fq;
#pragma unroll
        for (int ai = 0; ai < 2; ++ai)
#pragma unroll
            for (int m = 0; m < 4; ++m) { const size_t off = (size_t)(row0 + ai * HALF + m * 16) * ldc + col0;
#pragma unroll
                for (int bj = 0; bj < 2; ++bj) { const u32x4 r = *(const u32x4*)(res + off + bj * HALF);
                    const f32x4 v0 = acc[ai][bj][m][0], v1 = acc[ai][bj][m][1];
                    u32x4 w;
                    w.x = cvt_pk_bf16(__builtin_bit_cast(float, r.x << 16) * alpha + v0[0], __builtin_bit_cast(float, r.x & 0xffff0000u) * alpha + v0[1]);
                    w.y = cvt_pk_bf16(__builtin_bit_cast(float, r.y << 16) * alpha + v0[2], __builtin_bit_cast(float, r.y & 0xffff0000u) * alpha + v0[3]);
                    w.z = cvt_pk_bf16(__builtin_bit_cast(float, r.z << 16) * alpha + v1[0], __builtin_bit_cast(float, r.z & 0xffff0000u) * alpha + v1[1]);
                    w.w = cvt_pk_bf16(__builtin_bit_cast(float, r.w << 16) * alpha + v1[2], __builtin_bit_cast(float, r.w & 0xffff0000u) * alpha + v1[3]);
                    *(u32x4*)(Y + off + bj * HALF) = w; } }
    }
};

struct EpiResF {
    static constexpr bool PERM = true, AFTER_DRAIN = false;
    float* Y; const bf16_t* res; int ldc; float alpha;
    __device__ __forceinline__ void operator()(const f32x4 (&acc)[2][2][4][2], const Unit& u, int wr, int wc, int fr, int fq) const {
        const int row0 = u.pm * BM + wr * 64 + fr, col0 = u.pn * BM + wc * 32 + 8 * fq;
#pragma unroll
        for (int ai = 0; ai < 2; ++ai)
#pragma unroll
            for (int m = 0; m < 4; ++m) { const size_t off = (size_t)(row0 + ai * HALF + m * 16) * ldc + col0;
#pragma unroll
                for (int bj = 0; bj < 2; ++bj) { const u32x4 r = *(const u32x4*)(res + off + bj * HALF);
                    f32x4 o0, o1;
                    o0[0] = __builtin_bit_cast(float, r.x << 16); o0[1] = __builtin_bit_cast(float, r.x & 0xffff0000u); o0[2] = __builtin_bit_cast(float, r.y << 16); o0[3] = __builtin_bit_cast(float, r.y & 0xffff0000u);
                    o1[0] = __builtin_bit_cast(float, r.z << 16); o1[1] = __builtin_bit_cast(float, r.z & 0xffff0000u); o1[2] = __builtin_bit_cast(float, r.w << 16); o1[3] = __builtin_bit_cast(float, r.w & 0xffff0000u);
                    *(f32x4*)(Y + off + bj * HALF) = o0 * alpha + acc[ai][bj][m][0]; *(f32x4*)(Y + off + bj * HALF + 4) = o1 * alpha + acc[ai][bj][m][1]; } }
    }
};

struct EpiResLn {
    static constexpr bool PERM = true, AFTER_DRAIN = false;
    bf16_t* Y; const float* stats; const float* g; const float* b; int ldc; float alpha;
    __device__ __forceinline__ void operator()(const f32x4 (&acc)[2][2][4][2], const Unit& u, int wr, int wc, int fr, int fq) const {
        const int row0 = u.pm * BM + wr * 64 + fr, col0 = u.pn * BM + wc * 32 + 8 * fq;
        f32x4 gv[2][2], bv[2][2];
#pragma unroll
        for (int bj = 0; bj < 2; ++bj)
#pragma unroll
            for (int n = 0; n < 2; ++n) { gv[bj][n] = *(const f32x4*)(g + col0 + bj * HALF + 4 * n) * alpha; bv[bj][n] = *(const f32x4*)(b + col0 + bj * HALF + 4 * n) * alpha; }
#pragma unroll
        for (int ai = 0; ai < 2; ++ai)
#pragma unroll
            for (int m = 0; m < 4; ++m) { const int row = row0 + ai * HALF + m * 16; const size_t off = (size_t)row * ldc + col0;
                const float mean = stats[2 * row], rstd = stats[2 * row + 1];
#pragma unroll
                for (int bj = 0; bj < 2; ++bj) { const u32x4 r = *(const u32x4*)(Y + off + bj * HALF);
                    f32x4 y0, y1;
                    y0[0] = __builtin_bit_cast(float, r.x << 16); y0[1] = __builtin_bit_cast(float, r.x & 0xffff0000u); y0[2] = __builtin_bit_cast(float, r.y << 16); y0[3] = __builtin_bit_cast(float, r.y & 0xffff0000u);
                    y1[0] = __builtin_bit_cast(float, r.z << 16); y1[1] = __builtin_bit_cast(float, r.z & 0xffff0000u); y1[2] = __builtin_bit_cast(float, r.w << 16); y1[3] = __builtin_bit_cast(float, r.w & 0xffff0000u);
                    const f32x4 o0 = (y0 - mean) * rstd * gv[bj][0] + bv[bj][0] + acc[ai][bj][m][0], o1 = (y1 - mean) * rstd * gv[bj][1] + bv[bj][1] + acc[ai][bj][m][1];
                    u32x4 w; w.x = cvt_pk_bf16(o0[0], o0[1]); w.y = cvt_pk_bf16(o0[2], o0[3]); w.z = cvt_pk_bf16(o1[0], o1[1]); w.w = cvt_pk_bf16(o1[2], o1[3]);
                    *(u32x4*)(Y + off + bj * HALF) = w; } }
    }
};
template <class Epi, class Sched, bool ALIGN_EPI = false, bool SP2 = false>
__device__ __forceinline__ void gemm_phase(PG8_LAS unsigned char* lds, const Gemm g, const Sched& S, const Epi& E) {
    int tid_l = threadIdx.x; asm volatile("" : "+v"(tid_l)); const int tid = tid_l, wid = __builtin_amdgcn_readfirstlane(tid >> 6), lane = tid & 63, wr = wid >> 2, wc = wid & 3, fr = lane & 15, fq = lane >> 4;
    const int K = g.K, nt = K / BK;
    unsigned voffA[2], voffB[2];
#pragma unroll
    for (int i = 0; i < 2; ++i) { int R, C; stage_rc(tid * 16 + i * 8192, R, C); const int Rb = Epi::PERM ? ((R & ~31) + perm32(R & 31)) : R;
        voffA[i] = (unsigned)(R * K + C) * 2u; voffB[i] = (unsigned)(Rb * K + C) * 2u; }
    const size_t kstep = (size_t)(BK * 2);
    const size_t hstep = (size_t)HALF * K * 2;
    const size_t tstep = 2 * hstep;
    const unsigned ldsw = (unsigned)wid * 1024u;
    const int aoff = lds_byte(wr * 64 + fr, fq * 8), boff = lds_byte(wc * 32 + fr, fq * 8);
#define PG8_SA(b, h) (((b) * 2 + (h)) * HTB)
#define PG8_SB(b, h) ((4 + (b) * 2 + (h)) * HTB)
#define PG8_STAGE(bufoff, gbase, voff) do { _Pragma("unroll") for (int _i = 0; _i < 2; ++_i) \
        __builtin_amdgcn_global_load_lds((const unsigned*)((const char*)(gbase) + (voff)[_i]), (PG8_LAS unsigned*)(lds + (bufoff) + ldsw + _i * 8192), 16, 0, 0); } while (0)
#define PG8_LDA(dst, b, h) do { _Pragma("unroll") for (int m = 0; m < 4; ++m) _Pragma("unroll") for (int k = 0; k < 2; ++k) dst[m][k] = *(const PG8_LAS bf16x8*)(lds + PG8_SA(b, h) + aoff + m * 2048 + k * 1024); } while (0)
#define PG8_LDB(dst, b, h) do { _Pragma("unroll") for (int n = 0; n < 2; ++n) _Pragma("unroll") for (int k = 0; k < 2; ++k) dst[n][k] = *(const PG8_LAS bf16x8*)(lds + PG8_SB(b, h) + boff + n * 2048 + k * 1024); } while (0)
#define PG8_MMA(ai, bj, At, Bt) do { __builtin_amdgcn_s_setprio(1); _Pragma("unroll") for (int m = 0; m < 4; ++m) _Pragma("unroll") for (int n = 0; n < 2; ++n) _Pragma("unroll") for (int k = 0; k < 2; ++k) \
        acc[ai][bj][m][n] = __builtin_amdgcn_mfma_f32_16x16x32_bf16(Bt[n][k], At[m][k], acc[ai][bj][m][n], 0, 0, 0); __builtin_amdgcn_s_setprio(0); } while (0)
#define PG8_WAIT_V(n) asm volatile("s_waitcnt vmcnt(" #n ")" ::: "memory")
#define PG8_WAIT_L(n) asm volatile("s_waitcnt lgkmcnt(" #n ")" ::: "memory")
#define PG8_BAR __builtin_amdgcn_s_barrier()
#define PG8_SCHED __builtin_amdgcn_sched_barrier(0)
    Unit cur, nxt; int ui = 0;
    if (!S.next(0, cur)) return;
    f32x4 acc[2][2][4][2];
#pragma unroll
    for (int a = 0; a < 2; ++a)
#pragma unroll
        for (int b = 0; b < 2; ++b)
#pragma unroll
            for (int m = 0; m < 4; ++m)
#pragma unroll
                for (int n = 0; n < 2; ++n) acc[a][b][m][n] = (f32x4){0.f, 0.f, 0.f, 0.f};
    bf16x8 At[4][2], B0[2][2], B1[2][2];
    const char* cA = (const char*)g.A + (size_t)cur.pm * tstep; const char* cB = (const char*)g.Bt + (size_t)cur.pn * tstep;
    S.a_ready(cur);
    if constexpr (SP2) {
        PG8_STAGE(PG8_SB(0, 0), cB, voffB); PG8_STAGE(PG8_SB(0, 1), cB + hstep, voffB); PG8_STAGE(PG8_SA(0, 0), cA, voffA); PG8_STAGE(PG8_SA(0, 1), cA + hstep, voffA);
        if (wr == 1) PG8_BAR;
        PG8_WAIT_V(2); PG8_BAR;
        PG8_STAGE(PG8_SB(1, 0), cB + kstep, voffB); PG8_STAGE(PG8_SA(1, 0), cA + kstep, voffA); PG8_STAGE(PG8_SB(1, 1), cB + hstep + kstep, voffB);
        PG8_WAIT_V(6); PG8_BAR;
    } else {
        PG8_STAGE(PG8_SB(0, 0), cB, voffB); PG8_STAGE(PG8_SA(0, 0), cA, voffA); PG8_STAGE(PG8_SB(0, 1), cB + hstep, voffB); PG8_STAGE(PG8_SA(0, 1), cA + hstep, voffA);
        if (wr == 1) PG8_BAR;
        PG8_WAIT_V(4); PG8_BAR;
        PG8_STAGE(PG8_SB(1, 0), cB + kstep, voffB); PG8_STAGE(PG8_SA(1, 0), cA + kstep, voffA); PG8_STAGE(PG8_SB(1, 1), cB + hstep + kstep, voffB);
        PG8_WAIT_V(6); PG8_BAR;
    }
    for (;;) {
        const bool has_next = S.next(ui + 1, nxt);
        const char* nA = has_next ? (const char*)g.A + (size_t)nxt.pm * tstep : cA; const char* nB = has_next ? (const char*)g.Bt + (size_t)nxt.pn * tstep : cB;
        for (int t = 0; t < nt; t += 2) {
            const bool last = (t == nt - 2);
            const char* a1 = cA + (size_t)(t + 1) * kstep;
            const char* a2 = last ? nA : cA + (size_t)(t + 2) * kstep; const char* b2 = last ? nB : cB + (size_t)(t + 2) * kstep;
            const char* a3 = a2 + kstep; const char* b3 = b2 + kstep;
            if (last && has_next) S.a_ready(nxt);
            if constexpr (SP2) {
            PG8_LDB(B0, 0, 0); PG8_LDB(B1, 0, 1); PG8_SCHED; PG8_LDA(At, 0, 0); PG8_STAGE(PG8_SA(1, 1), a1 + hstep, voffA);
            PG8_WAIT_V(8); PG8_WAIT_L(0); PG8_BAR; PG8_MMA(0, 0, At, B0); PG8_MMA(0, 1, At, B1); PG8_BAR; PG8_SCHED;
            PG8_LDA(At, 0, 1); PG8_STAGE(PG8_SB(0, 0), b2, voffB); PG8_STAGE(PG8_SB(0, 1), b2 + hstep, voffB); PG8_STAGE(PG8_SA(0, 0), a2, voffA);
            PG8_WAIT_V(8); PG8_WAIT_L(0); PG8_BAR; PG8_MMA(1, 0, At, B0); PG8_MMA(1, 1, At, B1); PG8_BAR; PG8_SCHED;
            PG8_LDB(B0, 1, 0); PG8_LDB(B1, 1, 1); PG8_SCHED; PG8_LDA(At, 1, 0); PG8_STAGE(PG8_SA(0, 1), a2 + hstep, voffA);
            PG8_WAIT_V(8); PG8_WAIT_L(0); PG8_BAR; PG8_MMA(0, 0, At, B0); PG8_MMA(0, 1, At, B1); PG8_BAR; PG8_SCHED;
            PG8_LDA(At, 1, 1); PG8_STAGE(PG8_SB(1, 0), b3, voffB); PG8_STAGE(PG8_SB(1, 1), b3 + hstep, voffB); PG8_STAGE(PG8_SA(1, 0), a3, voffA);
            PG8_WAIT_V(8); PG8_WAIT_L(0); PG8_BAR; PG8_MMA(1, 0, At, B0); PG8_MMA(1, 1, At, B1); PG8_BAR; PG8_SCHED;
            } else {
            PG8_LDB(B0, 0, 0); PG8_SCHED; PG8_LDA(At, 0, 0); PG8_STAGE(PG8_SA(1, 1), a1 + hstep, voffA);
            PG8_WAIT_L(8); PG8_BAR; PG8_WAIT_L(0); PG8_MMA(0, 0, At, B0); PG8_BAR; PG8_SCHED;
            PG8_LDB(B1, 0, 1); PG8_STAGE(PG8_SB(0, 0), b2, voffB);
            PG8_BAR; PG8_WAIT_L(0); PG8_MMA(0, 1, At, B1); PG8_BAR;
            PG8_LDA(At, 0, 1); PG8_STAGE(PG8_SA(0, 0), a2, voffA);
            PG8_BAR; PG8_WAIT_L(0); PG8_MMA(1, 0, At, B0); PG8_BAR; PG8_SCHED;
            PG8_STAGE(PG8_SB(0, 1), b2 + hstep, voffB);
            PG8_WAIT_V(6); PG8_BAR; PG8_MMA(1, 1, At, B1); PG8_BAR;
            PG8_LDB(B0, 1, 0); PG8_SCHED; PG8_LDA(At, 1, 0); PG8_STAGE(PG8_SA(0, 1), a2 + hstep, voffA);
            PG8_WAIT_L(8); PG8_BAR; PG8_WAIT_L(0); PG8_MMA(0, 0, At, B0); PG8_BAR; PG8_SCHED;
            PG8_LDB(B1, 1, 1); PG8_STAGE(PG8_SB(1, 0), b3, voffB);
            PG8_BAR; PG8_WAIT_L(0); PG8_MMA(0, 1, At, B1); PG8_BAR;
            PG8_LDA(At, 1, 1); PG8_STAGE(PG8_SA(1, 0), a3, voffA);
            PG8_BAR; PG8_WAIT_L(0); PG8_MMA(1, 0, At, B0); PG8_BAR; PG8_SCHED;
            PG8_STAGE(PG8_SB(1, 1), b3 + hstep, voffB);
            PG8_WAIT_V(6); PG8_BAR; PG8_MMA(1, 1, At, B1); PG8_BAR;
            }
        }
        if constexpr (ALIGN_EPI) { if (wr == 0) PG8_BAR; }
        if constexpr (!Epi::AFTER_DRAIN) { E(acc, cur, wr, wc, fr, fq); S.done(cur); }
        if (!has_next) break;
#pragma unroll
        for (int a = 0; a < 2; ++a)
#pragma unroll
            for (int b = 0; b < 2; ++b)
#pragma unroll
                for (int m = 0; m < 4; ++m)
#pragma unroll
                    for (int n = 0; n < 2; ++n) acc[a][b][m][n] = (f32x4){0.f, 0.f, 0.f, 0.f};
        cur = nxt; cA = nA; cB = nB; ++ui;
        if constexpr (ALIGN_EPI) { if (wr == 1) PG8_BAR; }
    }
    PG8_WAIT_V(0);
    if constexpr (!ALIGN_EPI) { if (wr == 0) PG8_BAR; }
    PG8_BAR;
    if constexpr (Epi::AFTER_DRAIN) { E.fused(acc, cur, wr, wc, fr, fq, lds, wid, lane); S.done(cur); }
#undef PG8_SA
#undef PG8_SB
#undef PG8_STAGE
#undef PG8_LDA
#undef PG8_LDB
#undef PG8_MMA
#undef PG8_WAIT_V
#undef PG8_WAIT_L
#undef PG8_BAR
#undef PG8_SCHED
}
}

#ifndef PG8_SP2
#define PG8_SP2 true
#endif
#ifndef PG8_ALIGN
#define PG8_ALIGN true
#endif
constexpr int NWAVES = 8, NTHR = 512;
constexpr int BATCH = 2, SEQ = 8192, DM = 4096, MTOK = BATCH * SEQ;
constexpr int HD = 128;
constexpr int A_HEADS = 16, B_HEADS = 16, A_W = 2048, B_W = 2048, AB_IN = 4 * A_W + 3 * B_W;
constexpr int NSA_H = 32, NSA_G = 4, NSA_R = 8, KVW = 512, NSA_IN = 4096 + 6 * KVW + 96, NSA_INP = 7424;
constexpr int NCMP = 511, NCMPP = 512, NSLC = 128, NTOP = 16, WINDOW = 512;
constexpr int NMEM = 256, XH = 4, XW = 512;
constexpr int DFF = 11008, DFF2 = 22016;
constexpr float LN_EPS = 1e-5f, RMS_EPS = 1e-6f;
constexpr float DN_ALPHA = 1.41421356237309515f;
constexpr size_t MiB = (size_t)1 << 20;
constexpr size_t WS_CTL = 0, CTL_ZERO_BYTES = 1 * MiB;
constexpr size_t WS_W_ABIN = 1 * MiB;
constexpr size_t WS_W_ABOUT = WS_W_ABIN + 112 * MiB;
constexpr size_t WS_W_NSAIN = WS_W_ABOUT + 32 * MiB;
constexpr size_t WS_W_NSAOUT = WS_W_NSAIN + 58 * MiB;
constexpr size_t WS_W_XQ = WS_W_NSAOUT + 32 * MiB;
constexpr size_t WS_W_XKV = WS_W_XQ + 8 * MiB;
constexpr size_t WS_W_XO = WS_W_XKV + 16 * MiB;
constexpr size_t WS_W_UP = WS_W_XO + 8 * MiB;
constexpr size_t WS_W_DOWN = WS_W_UP + 344 * MiB;
constexpr size_t WS_W_C1 = WS_W_DOWN + 172 * MiB;
constexpr size_t WS_W_C2 = WS_W_C1 + 2 * MiB;
constexpr size_t WS_MEMB = WS_W_C2 + 1 * MiB;
constexpr size_t WS_HB = WS_MEMB + 4 * MiB;
constexpr size_t WS_Y = WS_HB + 128 * MiB;
constexpr size_t WS_BIG = WS_Y + 256 * MiB;
constexpr size_t WS_G = WS_BIG + 688 * MiB;
constexpr size_t WS_O = WS_G + 344 * MiB;
constexpr size_t WS_MISC = WS_O + 128 * MiB;
constexpr size_t WS_END = WS_MISC + 64 * MiB;
constexpr size_t WS_XQ = WS_MISC;
constexpr size_t WS_XO = WS_MISC + 16 * MiB;
constexpr size_t WS_XKV = WS_MISC + 32 * MiB;
constexpr size_t WS_LB = WS_MISC + 34 * MiB;
constexpr size_t WS_ROPE = WS_MISC + 36 * MiB;
constexpr size_t WS_STATS = WS_MISC + 35 * MiB;
constexpr size_t WS_PROJ0 = WS_BIG;
constexpr size_t WS_SPREV = WS_BIG + 448 * MiB;
constexpr size_t WS_QT = WS_G;
constexpr size_t WS_OINTRA = WS_G + 64 * MiB;
constexpr size_t WS_DEC = WS_G + 192 * MiB;
constexpr size_t WS_DS = WS_Y;
constexpr size_t WS_PROJ1 = WS_BIG;
constexpr size_t WS_QROT = WS_BIG + 232 * MiB;
constexpr size_t WS_KSROT = WS_BIG + 360 * MiB;
constexpr size_t WS_KWROT = WS_BIG + 376 * MiB;
constexpr size_t WS_KCMP = WS_BIG + 392 * MiB;
constexpr size_t WS_VCMP = WS_BIG + 393 * MiB;
constexpr size_t WS_OVL = WS_BIG + 394 * MiB;
constexpr size_t WS_SEL = WS_BIG + 395 * MiB;
constexpr size_t WS_IMP = WS_G + 256 * MiB;
constexpr size_t WS_O32 = WS_G;
static_assert(WS_SPREV + 128 * MiB <= WS_G && WS_DEC + 2 * MiB <= WS_O && WS_SEL + MiB <= WS_G, "ws map");
constexpr int CW_TMO = 0, CW_CODE = 1;
constexpr int CW_BAR = 4096;
constexpr int RING_OFF = 0, RING_BYTES = 131072;
constexpr int LDSCTL_OFF = RING_BYTES, MISC_OFF = LDSCTL_OFF + 320;
constexpr int LDS_BYTES = 147456;
static_assert(MISC_OFF + 128 <= LDS_BYTES, "LDS map");

#define GAS __attribute__((address_space(1)))
#define LAS __attribute__((address_space(3)))
typedef unsigned short bf16;
typedef unsigned v4u __attribute__((ext_vector_type(4)));
typedef unsigned v2u __attribute__((ext_vector_type(2)));
typedef float f32x4 __attribute__((ext_vector_type(4)));
typedef float f32x2 __attribute__((ext_vector_type(2)));
typedef float f32x16 __attribute__((ext_vector_type(16)));
typedef short bf16x8 __attribute__((ext_vector_type(8)));
typedef short s16x4 __attribute__((ext_vector_type(4)));
typedef GAS unsigned gu32;
#define RLX_AGENT __ATOMIC_RELAXED, __HIP_MEMORY_SCOPE_AGENT
#define LDS_WAIT() asm volatile("s_waitcnt lgkmcnt(0)" ::: "memory")
#define VM_WAIT() asm volatile("s_waitcnt vmcnt(0)" ::: "memory")
#define SBAR() __builtin_amdgcn_sched_barrier(0)
__device__ __forceinline__ unsigned f2bf(float f) { unsigned u = __builtin_bit_cast(unsigned, f); return (u + 0x7fffu + ((u >> 16) & 1u)) >> 16; }
__device__ __forceinline__ unsigned pk2(float lo, float hi) { return f2bf(lo) | (f2bf(hi) << 16); }
__device__ __forceinline__ float bf2f(unsigned short b) { return __builtin_bit_cast(float, (unsigned)b << 16); }
__device__ __forceinline__ float bflo(unsigned w) { return __builtin_bit_cast(float, w << 16); }
__device__ __forceinline__ float bfhi(unsigned w) { return __builtin_bit_cast(float, w & 0xffff0000u); }
__device__ __forceinline__ unsigned cvtpk(float lo, float hi) { unsigned r; asm volatile("v_cvt_pk_bf16_f32 %0, %1, %2" : "=v"(r) : "v"(lo), "v"(hi)); return r; }
__device__ __forceinline__ float wave_sum(float v) {
#pragma unroll
    for (int o = 1; o < 64; o <<= 1) v += __shfl_xor(v, o);
    return v;
}
__device__ __forceinline__ float sigmoidf_(float x) { return __builtin_amdgcn_rcpf(1.f + __builtin_amdgcn_exp2f(-1.4426950408889634f * x)); }
__device__ __forceinline__ float gelu1(float v) { pg8::f32x2 r = pg8::gelu_pk((pg8::f32x2){v, 0.f}); return r.x; }
#define XB_TMO      128
#define XB_XCNT(j)  (256  + 64 * (j))
#define XB_XSUB(j)  (1280 + 64 * (j))
#define XB_XGEN(j)  (2304 + 64 * (j))
#define XB_TOP      3328
#define XB_TOPGEN   3392
#define XCD_BAR_WORDS 3456
#define XB_SPIN_CAP (1u << 18)
#define LAS __attribute__((address_space(3)))

__device__ __forceinline__ unsigned xb_ld(unsigned* p)              { return __hip_atomic_load(p, __ATOMIC_RELAXED, __HIP_MEMORY_SCOPE_AGENT); }
__device__ __forceinline__ unsigned xb_add(unsigned* p, unsigned v) { return __hip_atomic_fetch_add(p, v, __ATOMIC_RELAXED, __HIP_MEMORY_SCOPE_AGENT); }
__device__ __forceinline__ unsigned xb_xcc_id() { return (unsigned)__builtin_amdgcn_s_getreg((3 << 11) | 20) & 0xFu; }
#define XB_SPIN(cond, bar) do { unsigned _sp = 0; while (cond) { __builtin_amdgcn_s_sleep(1); \
    if ((++_sp & 255u) == 0u) { if (xb_ld(&(bar)[XB_TMO])) break; if (_sp > XB_SPIN_CAP) { atomicAdd(&(bar)[XB_TMO], 1u); break; } } } } while (0)

struct XcdBarrier {
    unsigned* bar; unsigned x;
    volatile LAS unsigned* st;
};

__device__ __forceinline__ XcdBarrier xcd_barrier_post(unsigned* bar, volatile LAS unsigned* st) {
    XcdBarrier b; b.bar = bar; b.x = xb_xcc_id(); b.st = st;
    if (threadIdx.x == 0) (void)xb_add(&bar[XB_XCNT(b.x)], 1u);
    return b;
}
__device__ __forceinline__ void xcd_barrier_complete(unsigned* bar, unsigned x, unsigned& nloc, unsigned& nx) {
    const unsigned G = gridDim.x * gridDim.y * gridDim.z;
    unsigned sum, cnt, mine, sp = 0u;
    for (;;) {
        sum = 0u; cnt = 0u; mine = 0u;
#pragma unroll
        for (unsigned j = 0; j < 16; ++j) { const unsigned c = xb_ld(&bar[XB_XCNT(j)]); sum += c; cnt += (c > 0u) ? 1u : 0u; mine = (j == x) ? c : mine; }
        if (sum == G) break;
        __builtin_amdgcn_s_sleep(1);
        if ((++sp & 255u) == 0u) { if (xb_ld(&bar[XB_TMO])) break; if (sp > XB_SPIN_CAP) { atomicAdd(&bar[XB_TMO], 1u); break; } }
    }
    nloc = mine > 0u ? mine : 1u; nx = cnt > 0u ? cnt : 1u;
}

__device__ __forceinline__ void xcd_barrier(const XcdBarrier& b) {
    asm volatile("s_waitcnt vmcnt(0)" ::: "memory");
    __syncthreads();
    if (threadIdx.x == 0) {
        unsigned* bar = b.bar;
        __builtin_amdgcn_s_waitcnt(0);
        unsigned nloc = b.st[0], nx = b.st[1];
        if (nloc == 0u) { xcd_barrier_complete(bar, b.x, nloc, nx); b.st[0] = nloc; b.st[1] = nx; }
        const unsigned old = xb_add(&bar[XB_XSUB(b.x)], 1u);
        const unsigned gen = old / nloc;
        if (old + 1u == (gen + 1u) * nloc) {
            __builtin_amdgcn_fence(__ATOMIC_RELEASE, "agent");
            asm volatile("s_waitcnt vmcnt(0)" ::: "memory");
            const unsigned og = xb_add(&bar[XB_TOP], 1u);
            const unsigned tg = og / nx;
            if (og + 1u == (tg + 1u) * nx) xb_add(&bar[XB_TOPGEN], 1u);
            else XB_SPIN(xb_ld(&bar[XB_TOPGEN]) == tg, bar);
            __builtin_amdgcn_fence(__ATOMIC_ACQUIRE, "agent");
            xb_add(&bar[XB_XGEN(b.x)], 1u);
            asm volatile("s_waitcnt vmcnt(0)" ::: "memory");
        } else {
            XB_SPIN(xb_ld(&bar[XB_XGEN(b.x)]) == gen, bar);
            __builtin_amdgcn_fence(__ATOMIC_ACQUIRE, "agent");
            asm volatile("s_waitcnt vmcnt(0)" ::: "memory");
        }
    }
    __syncthreads();
}


constexpr int ATT_D = 128, KVBLK = 64;
constexpr int SHM_V = KVBLK * ATT_D * 2, SHM_K = KVBLK * ATT_D * 2;
constexpr int ATT_K_OFF = 0, ATT_V_OFF = SHM_K, ATT_BUF = SHM_K + SHM_V, ATT_WS_OFF = 2 * ATT_BUF;
constexpr int ATT_X_OFF = ATT_WS_OFF + NWAVES * 256;
#define KSWZ(row, colB) ((row) * 256 + ((colB) ^ (((row) & 7) << 4)))
__device__ __forceinline__ int crow(int r, int hi) { return (r & 3) + 8 * (r >> 2) + 4 * hi; }
__device__ __forceinline__ int v_st(int k, int c) { const int kk = (k & ~0xC) | ((k & 4) << 1) | ((k & 8) >> 1); return ((kk >> 3) * 4 + (c >> 5)) * 512 + ((kk & 7) * 32 + (c & 31)) * 2; }
__device__ __forceinline__ int v_rd_base(int lane) { return ((lane & 3) << 3) | (((lane >> 2) & 3) << 6) | (((lane >> 4) & 1) << 5) | (((lane >> 5) & 1) << 8); }
constexpr int v_rd_off(int d0, int ks, int half) { return d0 * 512 + ks * 4096 + half * 2048; }
template <int OFF> __device__ __forceinline__ s16x4 tr_read(int vb) {
  s16x4 r; asm volatile("ds_read_b64_tr_b16 %0, %1 offset:%2" : "=&v"(r) : "v"(vb), "i"(OFF) : "memory"); return r;
}
__device__ __forceinline__ void qkt(f32x16& p0, f32x16& p1, const LAS char* Ks, const bf16x8* qr, int r32, int hi) {
  p0 = f32x16{}; p1 = f32x16{};
#pragma unroll
  for (int d0 = 0; d0 < 8; ++d0) { const int cb = (d0 * 16 + hi * 8) * 2;
    const bf16x8 b0 = *(const LAS bf16x8*)(Ks + KSWZ(r32, cb));
    const bf16x8 b1 = *(const LAS bf16x8*)(Ks + KSWZ(32 + r32, cb));
    p0 = __builtin_amdgcn_mfma_f32_32x32x16_bf16(b0, qr[d0], p0, 0, 0, 0);
    p1 = __builtin_amdgcn_mfma_f32_32x32x16_bf16(b1, qr[d0], p1, 0, 0, 0); }
}
__device__ __forceinline__ void pack_p(const f32x16& p0, const f32x16& p1, bf16x8& pa0, bf16x8& pa1, bf16x8& pa2, bf16x8& pa3) {
#define PK4(P, BASE, OUT) do { unsigned a0 = cvtpk(P[BASE + 0], P[BASE + 1]), a1 = cvtpk(P[BASE + 2], P[BASE + 3]);   \
    unsigned b0 = cvtpk(P[BASE + 4], P[BASE + 5]), b1 = cvtpk(P[BASE + 6], P[BASE + 7]);                              \
    auto r0 = __builtin_amdgcn_permlane32_swap(a0, b0, false, false); auto r1 = __builtin_amdgcn_permlane32_swap(a1, b1, false, false); \
    v4u w = {r0[0], r1[0], r0[1], r1[1]}; OUT = __builtin_bit_cast(bf16x8, w); } while (0)
  PK4(p0, 0, pa0); PK4(p0, 8, pa1); PK4(p1, 0, pa2); PK4(p1, 8, pa3);
#undef PK4
}
template <int D0> __device__ __forceinline__ void pv_one(f32x16& od, int vb, bf16x8 pa0, bf16x8 pa1, bf16x8 pa2, bf16x8 pa3) {
  const s16x4 l0 = tr_read<v_rd_off(D0, 0, 0)>(vb), h0 = tr_read<v_rd_off(D0, 0, 1)>(vb), l1 = tr_read<v_rd_off(D0, 1, 0)>(vb), h1 = tr_read<v_rd_off(D0, 1, 1)>(vb);
  const s16x4 l2 = tr_read<v_rd_off(D0, 2, 0)>(vb), h2 = tr_read<v_rd_off(D0, 2, 1)>(vb), l3 = tr_read<v_rd_off(D0, 3, 0)>(vb), h3 = tr_read<v_rd_off(D0, 3, 1)>(vb);
  asm volatile("s_waitcnt lgkmcnt(0)" ::: "memory"); SBAR();
#define PKV(L, H) (bf16x8){L[0], L[1], L[2], L[3], H[0], H[1], H[2], H[3]}
  od = __builtin_amdgcn_mfma_f32_32x32x16_bf16(pa0, PKV(l0, h0), od, 0, 0, 0);
  od = __builtin_amdgcn_mfma_f32_32x32x16_bf16(pa1, PKV(l1, h1), od, 0, 0, 0);
  od = __builtin_amdgcn_mfma_f32_32x32x16_bf16(pa2, PKV(l2, h2), od, 0, 0, 0);
  od = __builtin_amdgcn_mfma_f32_32x32x16_bf16(pa3, PKV(l3, h3), od, 0, 0, 0);
#undef PKV
}
__device__ __forceinline__ void pv_d0(f32x16* o, int vb, bf16x8 pa0, bf16x8 pa1, bf16x8 pa2, bf16x8 pa3) {
  pv_one<0>(o[0], vb, pa0, pa1, pa2, pa3); pv_one<1>(o[1], vb, pa0, pa1, pa2, pa3); pv_one<2>(o[2], vb, pa0, pa1, pa2, pa3); pv_one<3>(o[3], vb, pa0, pa1, pa2, pa3);
}
struct KVStage { bf16x8 ks0, ks1, vs0, vs1; };
__device__ __forceinline__ void kv_load(KVStage& s, const bf16* Kh, const bf16* Vh, long ldk, long ldv, int k0, int sr, int sc) {
  s.ks0 = *(const bf16x8*)(Kh + (long)(k0 + sr) * ldk + sc); s.ks1 = *(const bf16x8*)(Kh + (long)(k0 + 32 + sr) * ldk + sc);
  s.vs0 = *(const bf16x8*)(Vh + (long)(k0 + sr) * ldv + sc); s.vs1 = *(const bf16x8*)(Vh + (long)(k0 + 32 + sr) * ldv + sc);
}
__device__ __forceinline__ void kv_write(const KVStage& s, LAS char* lds, int sr, int sc) {
  *(LAS bf16x8*)(lds + ATT_V_OFF + v_st(sr, sc)) = s.vs0; *(LAS bf16x8*)(lds + ATT_V_OFF + v_st(32 + sr, sc)) = s.vs1;
  *(LAS bf16x8*)(lds + ATT_K_OFF + KSWZ(sr, sc * 2)) = s.ks0; *(LAS bf16x8*)(lds + ATT_K_OFF + KSWZ(32 + sr, sc * 2)) = s.ks1;
}
struct KVDma { int ko[2], vo[2]; };
__device__ __forceinline__ void kv_dma_init(KVDma& d, int ldk, int ldv, int wid, int lane) {
#pragma unroll
  for (int i = 0; i < 2; ++i) { const int p = wid * 2 + i;
    const int row = p * 4 + (lane >> 4), cp = lane & 15; d.ko[i] = row * ldk + ((cp ^ (row & 7)) << 3);
    const int sub = p * 2 + (lane >> 5), kk = (sub >> 2) * 8 + ((lane & 31) >> 2), k = (kk & ~0xC) | ((kk & 4) << 1) | ((kk & 8) >> 1), c = (sub & 3) * 32 + (lane & 3) * 8;
    d.vo[i] = k * ldv + c; }
}
__device__ __forceinline__ void kv_dma(const KVDma& d, const bf16* Kt, const bf16* Vt, LAS char* lds, int buf, int wid) {
#pragma unroll
  for (int i = 0; i < 2; ++i) {
    __builtin_amdgcn_global_load_lds((const unsigned*)(Kt + d.ko[i]), (LAS unsigned*)(lds + buf + ATT_K_OFF + (wid * 2 + i) * 1024), 16, 0, 0);
    __builtin_amdgcn_global_load_lds((const unsigned*)(Vt + d.vo[i]), (LAS unsigned*)(lds + buf + ATT_V_OFF + (wid * 2 + i) * 1024), 16, 0, 0); }
}
__device__ __forceinline__ void rescale_o(f32x16* o, float a, LAS float* al_l, int r32, int hi) {
  if (__any(a < 1.f)) { if (hi == 0) al_l[r32] = a; LDS_WAIT();
#pragma unroll
    for (int r = 0; r < 16; ++r) { const float f = al_l[crow(r, hi)];
#pragma unroll
      for (int d = 0; d < 4; ++d) o[d][r] *= f; }
    LDS_WAIT(); }
}
constexpr float ATT_SCALE = 0.088388347648318440f, ATT_C = ATT_SCALE * 1.4426950408889634f, ATT_THR = 8.f;
__device__ __forceinline__ void softmax_tile(f32x16& p0, f32x16& p1, float& m_reg, float& l_reg, float& alpha) {
  float pmax = p0[0];
#pragma unroll
  for (int r = 1; r < 16; ++r) pmax = fmaxf(pmax, p0[r]);
#pragma unroll
  for (int r = 0; r < 16; ++r) pmax = fmaxf(pmax, p1[r]);
  { auto rr = __builtin_amdgcn_permlane32_swap(__float_as_uint(pmax), __float_as_uint(pmax), false, false);
    pmax = fmaxf(__uint_as_float(rr[0]), __uint_as_float(rr[1])); }
  float mn;
  if (__all(pmax - m_reg <= ATT_THR / ATT_SCALE)) { mn = m_reg; alpha = 1.f; }
  else { mn = fmaxf(m_reg, pmax); alpha = __builtin_amdgcn_exp2f((m_reg - mn) * ATT_C); m_reg = mn; }
  const float mnC = -mn * ATT_C;
#pragma unroll
  for (int r = 0; r < 16; ++r) { p0[r] = __builtin_amdgcn_exp2f(fmaf(p0[r], ATT_C, mnC)); p1[r] = __builtin_amdgcn_exp2f(fmaf(p1[r], ATT_C, mnC)); }
  float ps = 0.f;
#pragma unroll
  for (int r = 0; r < 16; ++r) ps += p0[r] + p1[r];
  { auto rr = __builtin_amdgcn_permlane32_swap(__float_as_uint(ps), __float_as_uint(ps), false, false);
    ps = __uint_as_float(rr[0]) + __uint_as_float(rr[1]); }
  l_reg = l_reg * alpha + ps;
}
__device__ __forceinline__ void load_q(bf16x8* qr, const bf16* Qw) {
#pragma unroll
  for (int d0 = 0; d0 < 8; ++d0) qr[d0] = *(const bf16x8*)(Qw + d0 * 16);
}

struct Frame {
    LAS unsigned char* lds;
    unsigned char* ws;
    int tid, lane, wave, G, bid;
    __device__ __forceinline__ void fresh() { int t = threadIdx.x; asm volatile("" : "+v"(t)); tid = t; lane = t & 63; wave = __builtin_amdgcn_readfirstlane(t >> 6);
        int g_ = gridDim.x, b_ = blockIdx.x; asm volatile("" : "+s"(g_), "+s"(b_)); G = g_; bid = b_; }
};
struct Args { const float* in[19]; float* out; unsigned char* ws; int ph_lo, ph_hi; };
enum { IN_X = 0, IN_MEM, IN_AB_W_IN, IN_HGRN_LB, IN_HGRN_NW, IN_AB_W_OUT, IN_NSA_W_IN, IN_NSA_CMP_POS, IN_NSA_CMP_W1, IN_NSA_CMP_W2, IN_NSA_W_OUT,
       IN_XA_WQ, IN_XA_WKV, IN_XA_WO, IN_FFN_UP, IN_FFN_CONV, IN_FFN_DOWN, IN_LN_G, IN_LN_B };

__device__ __forceinline__ void p0_transpose_item(const float* W, int K, int N, bf16* WT, LAS float* scr, int item, int lane) {
    const int nblk = N / 32, kb = item / nblk, nb = item % nblk, k0 = 64 * kb, n0 = 32 * nb;
#pragma unroll 8
    for (int i = 0; i < 32; ++i) { const int kk = 2 * i + (lane >> 5); scr[kk * 33 + (lane & 31)] = W[(size_t)(k0 + kk) * N + n0 + (lane & 31)]; }
    LDS_WAIT(); asm volatile("" ::: "memory");
    const int c = lane & 7;
#pragma unroll
    for (int j = 0; j < 4; ++j) { const int n = (lane >> 3) + 8 * j; const LAS float* s = scr + (8 * c) * 33 + n;
        v4u o; o.x = pk2(s[0 * 33], s[1 * 33]); o.y = pk2(s[2 * 33], s[3 * 33]); o.z = pk2(s[4 * 33], s[5 * 33]); o.w = pk2(s[6 * 33], s[7 * 33]);
        *(GAS v4u*)(WT + (size_t)(n0 + n) * K + k0 + 8 * c) = o; }
    LDS_WAIT(); asm volatile("" ::: "memory");
}
__device__ __forceinline__ void transpose_mat(Frame& F, const float* W, int K, int N, bf16* WT) {
    LAS float* scr = (LAS float*)(F.lds + RING_OFF + F.wave * 16384);
    const int gw = F.bid * NWAVES + F.wave, NGW = F.G * NWAVES;
    const int nitems = (K / 64) * (N / 32);
    for (int it = gw; it < nitems; it += NGW) p0_transpose_item(W, K, N, WT, scr, it, F.lane);
}
__device__ __forceinline__ void cvt_flat(Frame& F, const float* src, bf16* dst, long n8) {
    for (long i = (long)F.bid * NTHR + F.tid; i < n8; i += (long)F.G * NTHR) {
        const f32x4 a = *(const f32x4*)(src + i * 8), b = *(const f32x4*)(src + i * 8 + 4);
        v4u o; o.x = pk2(a.x, a.y); o.y = pk2(a.z, a.w); o.z = pk2(b.x, b.y); o.w = pk2(b.z, b.w);
        *(v4u*)(dst + i * 8) = o; }
}
__device__ __forceinline__ void p0_prologue(Frame& F, const Args& A) {
    unsigned char* ws = F.ws;
    transpose_mat(F, A.in[IN_AB_W_IN], DM, AB_IN, (bf16*)(ws + WS_W_ABIN));
    transpose_mat(F, A.in[IN_AB_W_OUT], DM, DM, (bf16*)(ws + WS_W_ABOUT));
    transpose_mat(F, A.in[IN_NSA_W_IN], DM, NSA_IN, (bf16*)(ws + WS_W_NSAIN));
    transpose_mat(F, A.in[IN_NSA_W_OUT], DM, DM, (bf16*)(ws + WS_W_NSAOUT));
    for (int l = 0; l < 2; ++l) {
        transpose_mat(F, A.in[IN_XA_WQ] + (size_t)l * DM * XW, DM, XW, (bf16*)(ws + WS_W_XQ) + (size_t)l * XW * DM);
        transpose_mat(F, A.in[IN_XA_WKV] + (size_t)l * DM * 2 * XW, DM, 2 * XW, (bf16*)(ws + WS_W_XKV) + (size_t)l * 2 * XW * DM);
        transpose_mat(F, A.in[IN_XA_WO] + (size_t)l * XW * DM, XW, DM, (bf16*)(ws + WS_W_XO) + (size_t)l * DM * XW);
        transpose_mat(F, A.in[IN_FFN_UP] + (size_t)l * DM * DFF2, DM, DFF2, (bf16*)(ws + WS_W_UP) + (size_t)l * DFF2 * DM);
        transpose_mat(F, A.in[IN_FFN_DOWN] + (size_t)l * DFF * DM, DFF, DM, (bf16*)(ws + WS_W_DOWN) + (size_t)l * DM * DFF);
        transpose_mat(F, A.in[IN_NSA_CMP_W1] + (size_t)l * 32 * HD * HD, 32 * HD, HD, (bf16*)(ws + WS_W_C1) + (size_t)l * HD * 32 * HD);
        transpose_mat(F, A.in[IN_NSA_CMP_W2] + (size_t)l * HD * HD, HD, HD, (bf16*)(ws + WS_W_C2) + (size_t)l * HD * HD);
    }
    cvt_flat(F, A.in[IN_X], (bf16*)(ws + WS_HB), (long)MTOK * DM / 8);
    cvt_flat(F, A.in[IN_MEM], (bf16*)(ws + WS_MEMB), (long)BATCH * NMEM * DM / 8);
    { v4u z = {0u, 0u, 0u, 0u}; v4u* p = (v4u*)((bf16*)(ws + WS_W_NSAIN) + (size_t)NSA_IN * DM); const long n = (long)(NSA_INP - NSA_IN) * DM / 8;
      for (long i = (long)F.bid * NTHR + F.tid; i < n; i += (long)F.G * NTHR) p[i] = z; }
    { float* tab = (float*)(ws + WS_ROPE);
      for (int i = F.bid * NTHR + F.tid; i < SEQ * 64; i += F.G * NTHR) { const int t = i >> 6, d = i & 63;
          float sn, cs; sincosf((float)t * powf(10000.0f, -(float)d * (1.0f / 64.0f)), &sn, &cs); tab[(size_t)t * 128 + d] = cs; tab[(size_t)t * 128 + 64 + d] = sn; } }
    { const float* lbp = A.in[IN_HGRN_LB]; float* lbo = (float*)(ws + WS_LB);
      for (int i = F.bid * NTHR + F.tid; i < A_W; i += F.G * NTHR) { const float a = lbp[i], b = lbp[A_W + i], m = fmaxf(a, b), ea = __expf(a - m), eb = __expf(b - m); lbo[i] = ea / (ea + eb); } }
}

__device__ __forceinline__ void ln_phase(Frame& F, const bf16* Y, const float* g, const float* b, float* h32, bf16* hb, float* stats) {
    const int gw = F.bid * NWAVES + F.wave, NGW = F.G * NWAVES;
    for (int m = gw; m < MTOK; m += NGW) {
        const v4u* yr = (const v4u*)(Y + (size_t)m * DM) + F.lane;
        float v[8][8]; float s = 0.f;
#pragma unroll
        for (int j = 0; j < 8; ++j) { const v4u x = yr[64 * j];
            v[j][0] = bflo(x.x); v[j][1] = bfhi(x.x); v[j][2] = bflo(x.y); v[j][3] = bfhi(x.y); v[j][4] = bflo(x.z); v[j][5] = bfhi(x.z); v[j][6] = bflo(x.w); v[j][7] = bfhi(x.w);
#pragma unroll
            for (int q = 0; q < 8; ++q) s += v[j][q]; }
        const float mean = wave_sum(s) * (1.f / DM); float s2 = 0.f;
#pragma unroll
        for (int j = 0; j < 8; ++j)
#pragma unroll
            for (int q = 0; q < 8; ++q) { v[j][q] -= mean; s2 += v[j][q] * v[j][q]; }
        const float rstd = 1.f / sqrtf(wave_sum(s2) * (1.f / DM) + LN_EPS);
        if (F.lane == 0) { stats[2 * m] = mean; stats[2 * m + 1] = rstd; }
#pragma unroll
        for (int j = 0; j < 8; ++j) { const int c0 = 8 * F.lane + 512 * j;
            const f32x4 g0 = *(const f32x4*)(g + c0), g1 = *(const f32x4*)(g + c0 + 4), b0 = *(const f32x4*)(b + c0), b1 = *(const f32x4*)(b + c0 + 4);
            f32x4 r0, r1;
            r0.x = v[j][0] * rstd * g0.x + b0.x; r0.y = v[j][1] * rstd * g0.y + b0.y; r0.z = v[j][2] * rstd * g0.z + b0.z; r0.w = v[j][3] * rstd * g0.w + b0.w;
            r1.x = v[j][4] * rstd * g1.x + b1.x; r1.y = v[j][5] * rstd * g1.y + b1.y; r1.z = v[j][6] * rstd * g1.z + b1.z; r1.w = v[j][7] * rstd * g1.w + b1.w;
            if (h32) { *(f32x4*)(h32 + (size_t)m * DM + c0) = r0; *(f32x4*)(h32 + (size_t)m * DM + c0 + 4) = r1; }
            v4u w; w.x = pk2(r0.x, r0.y); w.y = pk2(r0.z, r0.w); w.z = pk2(r1.x, r1.y); w.w = pk2(r1.z, r1.w);
            *(v4u*)(hb + (size_t)m * DM + c0) = w; }
    }
}

__device__ __forceinline__ void convglu_phase(Frame& F, const bf16* UP, const float* cw, bf16* Gm) {
    constexpr int NCG = DFF / 8, RB = 16, NRB = MTOK / RB;
    const long nitems = (long)NCG * NRB;
    for (long it = (long)F.bid * NTHR + F.tid; it < nitems; it += (long)F.G * NTHR) {
        const int cg = (int)(it % NCG), rb = (int)(it / NCG), c0 = cg * 8, t0 = rb * RB;
        float w0[8], w1[8], w2[8];
#pragma unroll
        for (int j = 0; j < 8; ++j) { w0[j] = cw[c0 + j]; w1[j] = cw[DFF + c0 + j]; w2[j] = cw[2 * DFF + c0 + j]; }
        float am2[8], am1[8];
        if ((t0 & (SEQ - 1)) == 0) {
#pragma unroll
            for (int j = 0; j < 8; ++j) { am2[j] = 0.f; am1[j] = 0.f; }
        } else {
            const v4u x2 = *(const v4u*)(UP + (size_t)(t0 - 2) * DFF2 + c0), x1 = *(const v4u*)(UP + (size_t)(t0 - 1) * DFF2 + c0);
            am2[0] = bflo(x2.x); am2[1] = bfhi(x2.x); am2[2] = bflo(x2.y); am2[3] = bfhi(x2.y); am2[4] = bflo(x2.z); am2[5] = bfhi(x2.z); am2[6] = bflo(x2.w); am2[7] = bfhi(x2.w);
            am1[0] = bflo(x1.x); am1[1] = bfhi(x1.x); am1[2] = bflo(x1.y); am1[3] = bfhi(x1.y); am1[4] = bflo(x1.z); am1[5] = bfhi(x1.z); am1[6] = bflo(x1.w); am1[7] = bfhi(x1.w);
        }
#pragma unroll 4
        for (int r = 0; r < RB; ++r) {
            const size_t row = (size_t)(t0 + r);
            const v4u xa = *(const v4u*)(UP + row * DFF2 + c0), xu = *(const v4u*)(UP + row * DFF2 + DFF + c0);
            float a[8], u[8];
            a[0] = bflo(xa.x); a[1] = bfhi(xa.x); a[2] = bflo(xa.y); a[3] = bfhi(xa.y); a[4] = bflo(xa.z); a[5] = bfhi(xa.z); a[6] = bflo(xa.w); a[7] = bfhi(xa.w);
            u[0] = bflo(xu.x); u[1] = bfhi(xu.x); u[2] = bflo(xu.y); u[3] = bfhi(xu.y); u[4] = bflo(xu.z); u[5] = bfhi(xu.z); u[6] = bflo(xu.w); u[7] = bfhi(xu.w);
            float o[8];
#pragma unroll
            for (int j = 0; j < 8; j += 2) {
                const float c0v = w2[j] * a[j] + w1[j] * am1[j] + w0[j] * am2[j], c1v = w2[j + 1] * a[j + 1] + w1[j + 1] * am1[j + 1] + w0[j + 1] * am2[j + 1];
                const pg8::f32x2 gg = pg8::gelu_pk((pg8::f32x2){c0v, c1v}); o[j] = gg.x * u[j]; o[j + 1] = gg.y * u[j + 1]; }
            v4u w; w.x = pk2(o[0], o[1]); w.y = pk2(o[2], o[3]); w.z = pk2(o[4], o[5]); w.w = pk2(o[6], o[7]);
            *(v4u*)(Gm + row * DFF + c0) = w;
#pragma unroll
            for (int j = 0; j < 8; ++j) { am2[j] = am1[j]; am1[j] = a[j]; }
        }
    }
}

__device__ __forceinline__ void xattn_phase(Frame& F, const bf16* XQ, const bf16* XKV, bf16* XO) {
    const int tid = F.tid, wid = F.wave, lane = F.lane, r32 = lane & 31, hi = lane >> 5;
    LAS char* lds = (LAS char*)F.lds;
    LAS float* wsc = (LAS float*)(lds + ATT_WS_OFF + wid * 256);
    const int vb0 = (int)(uintptr_t)(lds + ATT_V_OFF) + v_rd_base(lane);
    KVDma dm; kv_dma_init(dm, 2 * XW, 2 * XW, wid, lane);
    constexpr int NU = (MTOK / 256) * XH;
    for (int u = F.bid; u < NU; u += F.G) {
        const int head = u % XH, rbk = u / XH, row0 = rbk * 256, b = row0 / SEQ;
        const bf16* Kh = XKV + (size_t)b * NMEM * 2 * XW + head * HD; const bf16* Vh = Kh + XW;
        bf16x8 qr[8]; load_q(qr, XQ + (size_t)(row0 + wid * 32 + r32) * XW + head * HD + hi * 8);
        float m_reg = -1e30f, l_reg = 0.f; f32x16 o[4] = {};
        __syncthreads();
        kv_dma(dm, Kh, Vh, lds, 0, wid);
        for (int j = 0; j < NMEM / KVBLK; ++j) {
            const int buf = (j & 1) * ATT_BUF;
            VM_WAIT(); __syncthreads();
            if (j + 1 < NMEM / KVBLK) kv_dma(dm, Kh + (size_t)(j + 1) * KVBLK * 2 * XW, Vh + (size_t)(j + 1) * KVBLK * 2 * XW, lds, ATT_BUF - buf, wid);
            f32x16 p0, p1; qkt(p0, p1, lds + buf + ATT_K_OFF, qr, r32, hi);
            float alpha; softmax_tile(p0, p1, m_reg, l_reg, alpha);
            rescale_o(o, alpha, wsc, r32, hi);
            bf16x8 pa0, pa1, pa2, pa3; pack_p(p0, p1, pa0, pa1, pa2, pa3);
            pv_d0(o, vb0 + buf, pa0, pa1, pa2, pa3);
        }
        if (hi == 0) wsc[32 + r32] = l_reg; LDS_WAIT();
        bf16* Ow = XO + (size_t)(row0 + wid * 32) * XW + head * HD;
#pragma unroll
        for (int r = 0; r < 16; ++r) { const int orow = crow(r, hi); const float rl = __builtin_amdgcn_rcpf(wsc[32 + orow]);
#pragma unroll
            for (int d0 = 0; d0 < 4; ++d0) Ow[(size_t)orow * XW + d0 * 32 + r32] = (bf16)f2bf(o[d0][r] * rl); }
        LDS_WAIT();
    }
}

template <int K>
__device__ __forceinline__ f32x4 mma_tile(const LAS char* A, int lda, const LAS char* B, int ldb, int fr, int fq) {
    f32x4 acc = {0.f, 0.f, 0.f, 0.f};
#pragma unroll
    for (int k0 = 0; k0 < K; k0 += 32) {
        const bf16x8 a = *(const LAS bf16x8*)(A + fr * lda + (k0 + 8 * fq) * 2);
        const bf16x8 b = *(const LAS bf16x8*)(B + fr * ldb + (k0 + 8 * fq) * 2);
        acc = __builtin_amdgcn_mfma_f32_16x16x32_bf16(a, b, acc, 0, 0, 0);
    }
    return acc;
}
constexpr int HG_CH = 64, HG_NC = SEQ / HG_CH, HG_ITEMS = BATCH * A_HEADS * HG_NC;
constexpr int HG_QT = 0, HG_KT = 17408, HG_KH = 34816, HG_VT = 53248, HG_PT = 71680, HG_SEG = 80896;
constexpr int HG_SP = 17408, HG_OT = 52224;
__device__ __forceinline__ void hgrn_phase_a(Frame& F, const bf16* P0, const float* lbv, bf16* QTg, float* OINTRA, float* DS, float* DEC) {
    LAS char* lds = (LAS char*)F.lds;
    const int tid = F.tid, wid = F.wave, lane = F.lane, fr = lane & 15, fq = lane >> 4;
    const int d = tid & 127, sq = tid >> 7;
    for (int it = F.bid; it < HG_ITEMS; it += F.G) {
        const int c = it % HG_NC, bh = it / HG_NC, h = bh % A_HEADS, b = bh / A_HEADS;
        const size_t row0 = (size_t)b * SEQ + (size_t)c * HG_CH;
        const float lb = lbv[h * HD + d], omlb = 1.f - lb;
        float cum[16], kk[16];
        { float run = 0.f;
#pragma unroll
          for (int j = 0; j < 16; ++j) { const float z = bf2f(P0[(row0 + 16 * sq + j) * AB_IN + A_W + h * HD + d]); const float sg = sigmoidf_(z);
              run += __logf(lb + omlb * sg); cum[j] = run; kk[j] = omlb * (1.f - sg); }
          ((LAS float*)(lds + HG_SEG))[sq * 128 + d] = run; }
        LDS_WAIT(); __syncthreads();
        float base = 0.f, total = 0.f;
#pragma unroll
        for (int q = 0; q < 4; ++q) { const float sgm = ((LAS float*)(lds + HG_SEG))[q * 128 + d]; total += sgm; if (q < sq) base += sgm; }
        unsigned kh[8], vt[8];
#pragma unroll
        for (int j = 0; j < 16; j += 2) {
            float e[2][3]; unsigned short vr[2];
#pragma unroll
            for (int jj = 0; jj < 2; ++jj) { const int s = 16 * sq + j + jj; const float bb = base + cum[j + jj];
                const float q = bf2f(P0[(row0 + s) * AB_IN + h * HD + d]); vr[jj] = P0[(row0 + s) * AB_IN + 2 * A_W + h * HD + d];
                const float qt = q * __expf(bb), kt = kk[j + jj] * __expf(-bb), kht = kk[j + jj] * __expf(total - bb);
                const unsigned short qb16 = (unsigned short)f2bf(qt);
                *(LAS unsigned short*)(lds + HG_QT + s * 272 + d * 2) = qb16; QTg[(row0 + s) * A_W + h * HD + d] = qb16;
                *(LAS unsigned short*)(lds + HG_KT + s * 272 + d * 2) = (unsigned short)f2bf(kt);
                e[jj][0] = kht; }
            kh[j >> 1] = pk2(e[0][0], e[1][0]); vt[j >> 1] = (unsigned)vr[0] | ((unsigned)vr[1] << 16);
        }
        { LAS v4u* pk = (LAS v4u*)(lds + HG_KH + d * 144 + sq * 32); pk[0] = (v4u){kh[0], kh[1], kh[2], kh[3]}; pk[1] = (v4u){kh[4], kh[5], kh[6], kh[7]};
          LAS v4u* pv = (LAS v4u*)(lds + HG_VT + d * 144 + sq * 32); pv[0] = (v4u){vt[0], vt[1], vt[2], vt[3]}; pv[1] = (v4u){vt[4], vt[5], vt[6], vt[7]}; }
        if (sq == 3) DEC[(size_t)it * HD + d] = __expf(total);
        LDS_WAIT(); __syncthreads();
#pragma unroll
        for (int k = 0; k < 2; ++k) { const int tau = 2 * wid + k, ti = tau >> 2, si = tau & 3;
            f32x4 acc = {0.f, 0.f, 0.f, 0.f};
            if (si <= ti) acc = mma_tile<128>(lds + HG_QT + ti * 16 * 272, 272, lds + HG_KT + si * 16 * 272, 272, fr, fq);
#pragma unroll
            for (int i = 0; i < 4; ++i) { const int t = 16 * ti + 4 * fq + i, s = 16 * si + fr; const float v = (s <= t) ? acc[i] : 0.f;
                *(LAS unsigned short*)(lds + HG_PT + t * 144 + s * 2) = (unsigned short)f2bf(v); } }
        LDS_WAIT(); __syncthreads();
#pragma unroll
        for (int k = 0; k < 4; ++k) { const int tau = wid + 8 * k, ti = tau >> 3, vi = tau & 7;
            const f32x4 acc = mma_tile<64>(lds + HG_PT + ti * 16 * 144, 144, lds + HG_VT + vi * 16 * 144, 144, fr, fq);
#pragma unroll
            for (int i = 0; i < 4; ++i) OINTRA[(row0 + 16 * ti + 4 * fq + i) * A_W + h * HD + 16 * vi + fr] = acc[i]; }
#pragma unroll
        for (int k = 0; k < 8; ++k) { const int tau = wid + 8 * k, vi = tau >> 3, ki = tau & 7;
            const f32x4 acc = mma_tile<64>(lds + HG_VT + vi * 16 * 144, 144, lds + HG_KH + ki * 16 * 144, 144, fr, fq);
#pragma unroll
            for (int i = 0; i < 4; ++i) DS[((size_t)it * HD + 16 * vi + 4 * fq + i) * HD + 16 * ki + fr] = acc[i]; }
        LDS_WAIT(); __syncthreads();
    }
}
__device__ __forceinline__ void hgrn_phase_b(Frame& F, const float* DS, const float* DEC, bf16* SPREV) {
    const int tid = F.tid, dvl = tid >> 5, dk4 = (tid & 31) * 4;
    for (int item = F.bid; item < BATCH * A_HEADS * 8; item += F.G) {
        const int sl = item & 7, bh = item >> 3, dv = sl * 16 + dvl;
        f32x4 S = {0.f, 0.f, 0.f, 0.f};
        for (int c0 = 0; c0 < HG_NC; c0 += 8) {
            f32x4 ds[8], dc[8];
#pragma unroll
            for (int k = 0; k < 8; ++k) { const size_t it = (size_t)bh * HG_NC + c0 + k; ds[k] = *(const f32x4*)(DS + (it * HD + dv) * HD + dk4); dc[k] = *(const f32x4*)(DEC + it * HD + dk4); }
#pragma unroll
            for (int k = 0; k < 8; ++k) { const size_t it = (size_t)bh * HG_NC + c0 + k;
                v2u w; w.x = pk2(S.x, S.y); w.y = pk2(S.z, S.w); *(v2u*)(SPREV + (it * HD + dv) * HD + dk4) = w;
                S = S * dc[k] + ds[k]; }
        }
    }
}
__device__ __forceinline__ void hgrn_phase_c(Frame& F, const bf16* P0, const bf16* QTg, const float* OINTRA, const bf16* SPREV, const float* nw, bf16* Ob) {
    LAS char* lds = (LAS char*)F.lds;
    const int tid = F.tid, wid = F.wave, lane = F.lane, fr = lane & 15, fq = lane >> 4;
    for (int it = F.bid; it < HG_ITEMS; it += F.G) {
        const int c = it % HG_NC, bh = it / HG_NC, h = bh % A_HEADS, b = bh / A_HEADS;
        const size_t row0 = (size_t)b * SEQ + (size_t)c * HG_CH;
        { const int s = tid >> 3, ch = (tid & 7) * 16; const bf16* src = QTg + (row0 + s) * A_W + h * HD + ch;
          const v4u x0 = *(const v4u*)src, x1 = *(const v4u*)(src + 8); LAS v4u* dst = (LAS v4u*)(lds + HG_QT + s * 272 + ch * 2); dst[0] = x0; dst[1] = x1; }
        { const int dv = tid >> 2, ch = (tid & 3) * 32; const bf16* src = SPREV + ((size_t)it * HD + dv) * HD + ch;
          const v4u x0 = *(const v4u*)src, x1 = *(const v4u*)(src + 8), x2 = *(const v4u*)(src + 16), x3 = *(const v4u*)(src + 24);
          LAS v4u* dst = (LAS v4u*)(lds + HG_SP + dv * 272 + ch * 2); dst[0] = x0; dst[1] = x1; dst[2] = x2; dst[3] = x3; }
        LDS_WAIT(); __syncthreads();
#pragma unroll
        for (int k = 0; k < 4; ++k) { const int tau = wid + 8 * k, ti = tau >> 3, vi = tau & 7;
            const f32x4 acc = mma_tile<128>(lds + HG_QT + ti * 16 * 272, 272, lds + HG_SP + vi * 16 * 272, 272, fr, fq);
#pragma unroll
            for (int i = 0; i < 4; ++i) { const int t = 16 * ti + 4 * fq + i, dv = 16 * vi + fr;
                *(LAS float*)(lds + HG_OT + (t * 132 + dv) * 4) = acc[i] + OINTRA[(row0 + t) * A_W + h * HD + dv]; } }
        LDS_WAIT(); __syncthreads();
#pragma unroll
        for (int k = 0; k < 8; ++k) { const int t = wid * 8 + k;
            const float v0 = *(LAS float*)(lds + HG_OT + (t * 132 + lane) * 4), v1 = *(LAS float*)(lds + HG_OT + (t * 132 + 64 + lane) * 4);
            const float ss = wave_sum(v0 * v0 + v1 * v1); const float r = 1.f / sqrtf(ss * (1.f / HD) + RMS_EPS);
            const float g0 = bf2f(P0[(row0 + t) * AB_IN + 3 * A_W + h * HD + lane]), g1 = bf2f(P0[(row0 + t) * AB_IN + 3 * A_W + h * HD + 64 + lane]);
            Ob[(row0 + t) * DM + h * HD + lane] = (bf16)f2bf(v0 * r * nw[lane] * g0 * sigmoidf_(g0));
            Ob[(row0 + t) * DM + h * HD + 64 + lane] = (bf16)f2bf(v1 * r * nw[64 + lane] * g1 * sigmoidf_(g1)); }
        LDS_WAIT(); __syncthreads();
    }
}

constexpr float SB_CUT = -160.f;
__device__ __forceinline__ void sb_phase(Frame& F, const bf16* P0, bf16* Ob) {
    const int tid = F.tid, wid = F.wave, lane = F.lane, r32 = lane & 31, hi = lane >> 5;
    LAS char* lds = (LAS char*)F.lds;
    const int vb0 = (int)(uintptr_t)(lds + ATT_V_OFF) + v_rd_base(lane);
    KVDma dm; kv_dma_init(dm, AB_IN, AB_IN, wid, lane);
    constexpr int NQB = SEQ / 256, NU = BATCH * B_HEADS * NQB;
    for (int rd = 0; ; ++rd) {
        const int idx = (rd & 1) ? rd * F.G + (F.G - 1 - F.bid) : rd * F.G + F.bid;
        if (rd * F.G >= NU) break;
        if (idx >= NU) continue;
        const int qb = NQB - 1 - idx / (BATCH * B_HEADS), bh = idx % (BATCH * B_HEADS), head = bh % B_HEADS, b = bh / B_HEADS;
        const size_t rowb = (size_t)b * SEQ; const int q0 = qb * 256;
        const bf16* Kh = P0 + rowb * AB_IN + 4 * A_W + B_W + head * HD; const bf16* Vh = Kh + B_W;
        const int tw0 = q0 + wid * 32, t = tw0 + r32;
        bf16x8 qr[8]; load_q(qr, P0 + (rowb + t) * AB_IN + 4 * A_W + head * HD + hi * 8);
        float R = 0.f; f32x16 o[4] = {};
        const int jtop = (q0 + 254) >> 6;
        LAS unsigned* dflag = (LAS unsigned*)(lds + ATT_X_OFF);
        if (lane == 0) { dflag[wid] = 0u; dflag[8 + wid] = 0u; }
        LDS_WAIT(); __syncthreads();
        kv_dma(dm, Kh + (size_t)jtop * KVBLK * AB_IN, Vh + (size_t)jtop * KVBLK * AB_IN, lds, 0, wid);
        int buf = 0;
        for (int j = jtop; j >= 0; --j, buf = ATT_BUF - buf) {
            VM_WAIT(); __syncthreads();
            { unsigned alld = 1u;
#pragma unroll
              for (int w = 0; w < NWAVES; ++w) alld &= dflag[((j + 1) & 1) * 8 + w];
              if (__builtin_amdgcn_readfirstlane(alld)) break; }
            if (j > 0) kv_dma(dm, Kh + (size_t)(j - 1) * KVBLK * AB_IN, Vh + (size_t)(j - 1) * KVBLK * AB_IN, lds, ATT_BUF - buf, wid);
            const int k0 = j * KVBLK;
            if (k0 < tw0 + 31) {
                f32x16 p0, p1; qkt(p0, p1, lds + buf + ATT_K_OFF, qr, r32, hi);
                const bool need_mask = (k0 + 63 >= tw0);
                float L0[16], L1[16];
#pragma unroll
                for (int r = 0; r < 16; ++r) {
                    const float z0 = p0[r] * ATT_C, z1 = p1[r] * ATT_C;
                    float l0 = -(fmaxf(z0, 0.f) + __builtin_amdgcn_logf(1.f + __builtin_amdgcn_exp2f(-fabsf(z0))));
                    float l1 = -(fmaxf(z1, 0.f) + __builtin_amdgcn_logf(1.f + __builtin_amdgcn_exp2f(-fabsf(z1))));
                    if (need_mask) { if (k0 + crow(r, hi) >= t) l0 = 0.f; if (k0 + 32 + crow(r, hi) >= t) l1 = 0.f; }
                    L0[r] = l0; L1[r] = l1; p0[r] = z0 + l0; p1[r] = z1 + l1;
                }
                SBAR();
                float Sg[16];
#pragma unroll
                for (int gi = 0; gi < 4; ++gi) {
                    const float a = (L0[4 * gi] + L0[4 * gi + 1]) + (L0[4 * gi + 2] + L0[4 * gi + 3]), c = (L1[4 * gi] + L1[4 * gi + 1]) + (L1[4 * gi + 2] + L1[4 * gi + 3]);
                    auto ra = __builtin_amdgcn_permlane32_swap(__float_as_uint(a), __float_as_uint(a), false, false);
                    auto rc = __builtin_amdgcn_permlane32_swap(__float_as_uint(c), __float_as_uint(c), false, false);
                    Sg[2 * gi] = __uint_as_float(ra[0]); Sg[2 * gi + 1] = __uint_as_float(ra[1]); Sg[8 + 2 * gi] = __uint_as_float(rc[0]); Sg[8 + 2 * gi + 1] = __uint_as_float(rc[1]);
                }
                float run = R;
#pragma unroll
                for (int s = 15; s >= 0; --s) { const float tt = run; run += Sg[s]; Sg[s] = tt; }
                const float Rn = run;
                SBAR();
#pragma unroll
                for (int gi = 0; gi < 4; ++gi) {
                    float base0 = hi ? Sg[2 * gi + 1] : Sg[2 * gi], base1 = hi ? Sg[8 + 2 * gi + 1] : Sg[8 + 2 * gi];
                    float r3 = base0, r2 = r3 + L0[4 * gi + 3], r1 = r2 + L0[4 * gi + 2], r0 = r1 + L0[4 * gi + 1];
                    p0[4 * gi + 3] = __builtin_amdgcn_exp2f(p0[4 * gi + 3] + r3); p0[4 * gi + 2] = __builtin_amdgcn_exp2f(p0[4 * gi + 2] + r2);
                    p0[4 * gi + 1] = __builtin_amdgcn_exp2f(p0[4 * gi + 1] + r1); p0[4 * gi + 0] = __builtin_amdgcn_exp2f(p0[4 * gi + 0] + r0);
                    r3 = base1; r2 = r3 + L1[4 * gi + 3]; r1 = r2 + L1[4 * gi + 2]; r0 = r1 + L1[4 * gi + 1];
                    p1[4 * gi + 3] = __builtin_amdgcn_exp2f(p1[4 * gi + 3] + r3); p1[4 * gi + 2] = __builtin_amdgcn_exp2f(p1[4 * gi + 2] + r2);
                    p1[4 * gi + 1] = __builtin_amdgcn_exp2f(p1[4 * gi + 1] + r1); p1[4 * gi + 0] = __builtin_amdgcn_exp2f(p1[4 * gi + 0] + r0);
                }
                R = Rn;
                { const unsigned dn = __all(R < SB_CUT) ? 1u : 0u; if (lane == 0) dflag[(j & 1) * 8 + wid] = dn; }
                if (need_mask) {
#pragma unroll
                    for (int r = 0; r < 16; ++r) { if (k0 + crow(r, hi) >= t) p0[r] = 0.f; if (k0 + 32 + crow(r, hi) >= t) p1[r] = 0.f; }
                }
                bf16x8 pa0, pa1, pa2, pa3; pack_p(p0, p1, pa0, pa1, pa2, pa3);
                pv_d0(o, vb0 + buf, pa0, pa1, pa2, pa3);
            }
        }
        bf16* Ow = Ob + (rowb + tw0) * DM + A_W + head * HD;
#pragma unroll
        for (int r = 0; r < 16; ++r) { const int orow = crow(r, hi);
#pragma unroll
            for (int d0 = 0; d0 < 4; ++d0) Ow[(size_t)orow * DM + d0 * 32 + r32] = (bf16)f2bf(o[d0][r]); }
    }
}

constexpr int P1_KC = 4096, P1_VC = 4608, P1_KS = 5120, P1_VS = 5632, P1_KW = 6144, P1_VW = 6656, P1_GL = 7168;
__device__ __forceinline__ void nsa_rope_phase(Frame& F, const bf16* P1, const float* TAB, bf16* QROT, bf16* KSROT, bf16* KWROT, bf16* OVL) {
    const int gw = F.bid * NWAVES + F.wave, NGW = F.G * NWAVES, lane = F.lane, hsub = lane >> 3, d0 = (lane & 7) * 8;
    for (int m = gw; m < MTOK; m += NGW) {
        const int t = m & (SEQ - 1);
        const f32x4 c0 = *(const f32x4*)(TAB + (size_t)t * 128 + d0), c1 = *(const f32x4*)(TAB + (size_t)t * 128 + d0 + 4);
        const f32x4 s0 = *(const f32x4*)(TAB + (size_t)t * 128 + 64 + d0), s1 = *(const f32x4*)(TAB + (size_t)t * 128 + 64 + d0 + 4);
        const float cs[8] = {c0.x, c0.y, c0.z, c0.w, c1.x, c1.y, c1.z, c1.w}, sn[8] = {s0.x, s0.y, s0.z, s0.w, s1.x, s1.y, s1.z, s1.w};
        const bf16* row = P1 + (size_t)m * NSA_INP;
#pragma unroll
        for (int hb = 0; hb < 5; ++hb) {
            const int hh = hb * 8 + hsub;
            const bf16* src; bf16* dst;
            if (hh < 32) { src = row + hh * HD; dst = QROT + (size_t)m * DM + hh * HD; }
            else if (hh < 36) { src = row + P1_KS + (hh - 32) * HD; dst = KSROT + (size_t)m * KVW + (hh - 32) * HD; }
            else { src = row + P1_KW + (hh - 36) * HD; dst = KWROT + (size_t)m * KVW + (hh - 36) * HD; }
            const v4u a = *(const v4u*)(src + d0), bq = *(const v4u*)(src + 64 + d0);
            const unsigned aw[4] = {a.x, a.y, a.z, a.w}, bw[4] = {bq.x, bq.y, bq.z, bq.w}; unsigned o1[4], o2[4];
#pragma unroll
            for (int q = 0; q < 4; ++q) { const float x1l = bflo(aw[q]), x1h = bfhi(aw[q]), x2l = bflo(bw[q]), x2h = bfhi(bw[q]);
                o1[q] = pk2(x1l * cs[2 * q] - x2l * sn[2 * q], x1h * cs[2 * q + 1] - x2h * sn[2 * q + 1]);
                o2[q] = pk2(x2l * cs[2 * q] + x1l * sn[2 * q], x2h * cs[2 * q + 1] + x1h * sn[2 * q + 1]); }
            *(v4u*)(dst + d0) = (v4u){o1[0], o1[1], o1[2], o1[3]}; *(v4u*)(dst + 64 + d0) = (v4u){o2[0], o2[1], o2[2], o2[3]};
        }
    }
    for (int i = F.bid * NTHR + F.tid; i < NCMPP * NSLC; i += F.G * NTHR) { const int n = i / NSLC, j = i % NSLC;
        OVL[i] = (n < NCMP && n >= 4 * j - 1 && n <= 4 * j + 3) ? (bf16)0x3f80u : (bf16)0u; }
}
constexpr int CM_A = 0, CM_B = 17408, CM_H = 17408 + 34816;
__device__ __forceinline__ void nsa_compress_phase(Frame& F, const bf16* P1, const float* pos, const bf16* W1t, const bf16* W2t, bf16* KCMP, bf16* VCMP) {
    LAS char* lds = (LAS char*)F.lds;
    const int tid = F.tid, wid = F.wave, lane = F.lane, fr = lane & 15, fq = lane >> 4;
    for (int item = F.bid; item < 128; item += F.G) {
        const int nt = item & 7, g = (item >> 3) & 3, b = (item >> 5) & 1, which = item >> 6;
        const bf16* w1 = W1t + (size_t)which * HD * 32 * HD; const bf16* w2 = W2t + (size_t)which * HD * HD;
        const float* posw = pos + (size_t)which * 32 * HD;
        f32x4 acc[4];
#pragma unroll
        for (int k = 0; k < 4; ++k) acc[k] = (f32x4){0.f, 0.f, 0.f, 0.f};
        for (int l = 0; l < 32; ++l) {
            { const int r = tid >> 3, ch = (tid & 7) * 16, n = nt * 64 + r; unsigned w[8];
              if (n < NCMP) { const bf16* src = P1 + ((size_t)b * SEQ + 16 * n + l) * NSA_INP + P1_KC + which * KVW + g * HD + ch;
                  const v4u x0 = *(const v4u*)src, x1 = *(const v4u*)(src + 8); const unsigned xs[8] = {x0.x, x0.y, x0.z, x0.w, x1.x, x1.y, x1.z, x1.w};
#pragma unroll
                  for (int q = 0; q < 8; ++q) w[q] = pk2(bflo(xs[q]) + posw[l * HD + ch + 2 * q], bfhi(xs[q]) + posw[l * HD + ch + 2 * q + 1]);
              } else {
#pragma unroll
                  for (int q = 0; q < 8; ++q) w[q] = 0u; }
              LAS v4u* dst = (LAS v4u*)(lds + CM_A + r * 272 + ch * 2); dst[0] = (v4u){w[0], w[1], w[2], w[3]}; dst[1] = (v4u){w[4], w[5], w[6], w[7]}; }
            { const int e = tid >> 2, ch = (tid & 3) * 32; const bf16* src = w1 + (size_t)e * 32 * HD + l * HD + ch;
              const v4u x0 = *(const v4u*)src, x1 = *(const v4u*)(src + 8), x2 = *(const v4u*)(src + 16), x3 = *(const v4u*)(src + 24);
              LAS v4u* dst = (LAS v4u*)(lds + CM_B + e * 272 + ch * 2); dst[0] = x0; dst[1] = x1; dst[2] = x2; dst[3] = x3; }
            LDS_WAIT(); __syncthreads();
#pragma unroll
            for (int k = 0; k < 4; ++k) { const int tau = wid + 8 * k, ni = tau >> 3, ei = tau & 7;
                acc[k] += mma_tile<128>(lds + CM_A + ni * 16 * 272, 272, lds + CM_B + ei * 16 * 272, 272, fr, fq); }
            LDS_WAIT(); __syncthreads();
        }
#pragma unroll
        for (int k = 0; k < 4; ++k) { const int tau = wid + 8 * k, ni = tau >> 3, ei = tau & 7;
#pragma unroll
            for (int i = 0; i < 4; ++i) *(LAS unsigned short*)(lds + CM_H + (16 * ni + 4 * fq + i) * 272 + (16 * ei + fr) * 2) = (unsigned short)f2bf(gelu1(acc[k][i])); }
        { const int f = tid >> 2, ch = (tid & 3) * 32; const bf16* src = w2 + (size_t)f * HD + ch;
          const v4u x0 = *(const v4u*)src, x1 = *(const v4u*)(src + 8), x2 = *(const v4u*)(src + 16), x3 = *(const v4u*)(src + 24);
          LAS v4u* dst = (LAS v4u*)(lds + CM_B + f * 272 + ch * 2); dst[0] = x0; dst[1] = x1; dst[2] = x2; dst[3] = x3; }
        LDS_WAIT(); __syncthreads();
        bf16* outp = which ? VCMP : KCMP;
#pragma unroll
        for (int k = 0; k < 4; ++k) { const int tau = wid + 8 * k, ni = tau >> 3, fi = tau & 7;
            const f32x4 a2 = mma_tile<128>(lds + CM_H + ni * 16 * 272, 272, lds + CM_B + fi * 16 * 272, 272, fr, fq);
#pragma unroll
            for (int i = 0; i < 4; ++i) { const int n = nt * 64 + 16 * ni + 4 * fq + i;
                outp[(((size_t)b * NCMPP + n) * NSA_G + g) * HD + 16 * fi + fr] = (n < NCMP) ? (bf16)f2bf(a2[i]) : (bf16)0u; } }
        LDS_WAIT(); __syncthreads();
    }
}
__device__ __forceinline__ unsigned pick4(const unsigned (&a)[4], int i) { return i == 0 ? a[0] : (i == 1 ? a[1] : (i == 2 ? a[2] : a[3])); }
template <int MODE>
__device__ __forceinline__ void nsa_attn_phase(Frame& F, const bf16* P1, const bf16* Qsrc, const bf16* Ksrc, const bf16* Vsrc, const unsigned* SEL, float* O32, float* IMP, bf16* Ob, bool probe_nostore = false) {
    const int tid = F.tid, wid = F.wave, lane = F.lane, r32 = lane & 31, hi = lane >> 5;
    LAS char* lds = (LAS char*)F.lds;
    LAS float* wsc = (LAS float*)(lds + ATT_WS_OFF + wid * 256);
    const int vb0 = (int)(uintptr_t)(lds + ATT_V_OFF) + v_rd_base(lane);
    KVDma dm; kv_dma_init(dm, MODE <= 1 ? NSA_G * HD : KVW, MODE == 0 ? NSA_G * HD : (MODE == 1 ? NSLC : NSA_INP), wid, lane);
    constexpr int NTB = SEQ / 32, NU = BATCH * NSA_G * NTB;
    for (int rd = 0; ; ++rd) {
        const int idx = (rd & 1) ? rd * F.G + (F.G - 1 - F.bid) : rd * F.G + F.bid;
        if (rd * F.G >= NU) break;
        if (idx >= NU) continue;
        const int tb = NTB - 1 - idx / (BATCH * NSA_G), bg = idx % (BATCH * NSA_G), g = bg % NSA_G, b = bg / NSA_G;
        const size_t rowb = (size_t)b * SEQ; const int t0 = tb * 32;
        const int t = (MODE == 2) ? t0 + 4 * wid + (r32 >> 3) : t0 + r32, head = (MODE == 2) ? g * NSA_R + (r32 & 7) : g * NSA_R + wid;
        const bf16* Kh; const bf16* Vh; long ldk, ldv; int jlo, jhi;
        if (MODE <= 1) { Kh = Ksrc + ((size_t)b * NCMPP * NSA_G + g) * HD; ldk = NSA_G * HD; jlo = 0; jhi = (t0 >> 4) >> 6;
            if (MODE == 0) { Vh = Vsrc + ((size_t)b * NCMPP * NSA_G + g) * HD; ldv = NSA_G * HD; } else { Vh = Vsrc; ldv = NSLC; } }
        else { Kh = Ksrc + rowb * KVW + g * HD; ldk = KVW; Vh = P1 + rowb * NSA_INP + (MODE == 2 ? P1_VS : P1_VW) + g * HD; ldv = NSA_INP;
            jhi = (t0 + 31) >> 6; jlo = (MODE == 2) ? 0 : ((t0 - (WINDOW - 1) > 0 ? t0 - (WINDOW - 1) : 0) >> 6); }
        bf16x8 qr[8]; load_q(qr, Qsrc + (rowb + t) * (MODE <= 1 ? NSA_INP : DM) + head * HD + hi * 8);
        unsigned selw[4] = {0u, 0u, 0u, 0u}, uni[4] = {~0u, ~0u, ~0u, ~0u}, wn[4] = {~0u, ~0u, ~0u, ~0u};
        if (MODE == 2) { const v4u sv = *(const v4u*)(SEL + ((rowb + t) * NSA_G + g) * 4); selw[0] = sv.x; selw[1] = sv.y; selw[2] = sv.z; selw[3] = sv.w;
            LAS unsigned* un = (LAS unsigned*)(lds + ATT_X_OFF);
#pragma unroll
            for (int q = 0; q < 4; ++q) { unsigned x = selw[q]; x |= __shfl_xor(x, 8); x |= __shfl_xor(x, 16); wn[q] = __builtin_amdgcn_readfirstlane(x); if (lane == 0) un[wid * 4 + q] = wn[q]; }
            LDS_WAIT(); __syncthreads();
#pragma unroll
            for (int q = 0; q < 4; ++q) { unsigned x = 0u;
#pragma unroll
                for (int w = 0; w < NWAVES; ++w) x |= un[w * 4 + q];
                uni[q] = __builtin_amdgcn_readfirstlane(x); } }
        float m_reg = -1e30f, l_reg = 0.f; f32x16 o[4] = {};
        const int cur = t >> 6;
#define NSA_NEXT(jj) do { if (MODE == 2) { while ((jj) <= jhi && !((pick4(uni, (jj) >> 5) >> ((jj) & 31)) & 1u)) ++(jj); } } while (0)
        int j = jlo; NSA_NEXT(j);
        __syncthreads();
        if (j <= jhi) kv_dma(dm, Kh + (size_t)j * KVBLK * ldk, Vh + (size_t)j * KVBLK * ldv, lds, 0, wid);
        int buf = 0;
        while (j <= jhi) {
            int jn = j + 1; NSA_NEXT(jn);
            const int k0 = j * KVBLK;
            VM_WAIT(); __syncthreads();
            if (jn <= jhi) kv_dma(dm, Kh + (size_t)jn * KVBLK * ldk, Vh + (size_t)jn * KVBLK * ldv, lds, ATT_BUF - buf, wid);
            if (MODE == 2 && !((pick4(wn, j >> 5) >> (j & 31)) & 1u)) { j = jn; buf = ATT_BUF - buf; continue; }
            f32x16 p0, p1; qkt(p0, p1, lds + buf + ATT_K_OFF, qr, r32, hi);
            constexpr float NINF = -__builtin_inff();
            if (MODE <= 1) { if (!(16 * (k0 + 63) + 31 <= t0)) {
#pragma unroll
                    for (int r = 0; r < 16; ++r) { if (!(16 * (k0 + crow(r, hi)) + 31 <= t)) p0[r] = NINF; if (!(16 * (k0 + 32 + crow(r, hi)) + 31 <= t)) p1[r] = NINF; } } }
            else if (MODE == 2) { const bool mine = (pick4(selw, j >> 5) >> (j & 31)) & 1u; const int lim = mine ? (j < cur ? 0x7fffffff : t) : -1;
#pragma unroll
                for (int r = 0; r < 16; ++r) { if (k0 + crow(r, hi) > lim) p0[r] = NINF; if (k0 + 32 + crow(r, hi) > lim) p1[r] = NINF; } }
            else { if (!((k0 > t0 + 31 - WINDOW) && (k0 + 63 <= t0))) {
#pragma unroll
                    for (int r = 0; r < 16; ++r) { const int ka = k0 + crow(r, hi), kb = ka + 32;
                        if (!(ka <= t && ka > t - WINDOW)) p0[r] = NINF; if (!(kb <= t && kb > t - WINDOW)) p1[r] = NINF; } } }
            float alpha; softmax_tile(p0, p1, m_reg, l_reg, alpha);
            rescale_o(o, alpha, wsc, r32, hi);
            bf16x8 pa0, pa1, pa2, pa3; pack_p(p0, p1, pa0, pa1, pa2, pa3);
            pv_d0(o, vb0 + buf, pa0, pa1, pa2, pa3);
            j = jn; buf = ATT_BUF - buf;
        }
#undef NSA_NEXT
        { float fac = l_reg > 0.f ? __builtin_amdgcn_rcpf(l_reg) : 0.f;
          if (MODE != 1) { const int br = MODE == 0 ? 0 : (MODE == 2 ? 1 : 2); fac *= sigmoidf_(bf2f(P1[(rowb + t) * NSA_INP + P1_GL + head * 3 + br])); }
          if (hi == 0) wsc[32 + r32] = fac; LDS_WAIT(); }
        if (MODE == 1) {
            float fc[16];
#pragma unroll
            for (int r = 0; r < 16; ++r) fc[r] = wsc[32 + crow(r, hi)];
            LDS_WAIT(); __syncthreads();
#pragma unroll
            for (int r = 0; r < 16; ++r) { const int orow = crow(r, hi);
#pragma unroll
                for (int d0 = 0; d0 < 4; ++d0) *(LAS float*)(lds + ((wid * 32 + orow) * 128 + d0 * 32 + r32) * 4) = o[d0][r] * fc[r]; }
            LDS_WAIT(); __syncthreads();
            { const int tok = tid >> 4, j8 = (tid & 15) * 8; f32x4 s0 = {0.f, 0.f, 0.f, 0.f}, s1 = {0.f, 0.f, 0.f, 0.f};
#pragma unroll
              for (int w = 0; w < 8; ++w) { const LAS f32x4* pp = (const LAS f32x4*)(lds + ((w * 32 + tok) * 128 + j8) * 4); s0 += pp[0]; s1 += pp[1]; }
              f32x4* dst = (f32x4*)(IMP + ((rowb + t0 + tok) * NSA_G + g) * NSLC + j8); dst[0] = s0; dst[1] = s1; }
            LDS_WAIT(); __syncthreads();
        } else {
#pragma unroll
            for (int r = 0; r < 16; ++r) { const int orow = crow(r, hi); const float fc = wsc[32 + orow];
                const size_t off = (MODE == 2) ? (rowb + t0 + 4 * wid + (orow >> 3)) * DM + (g * NSA_R + (orow & 7)) * HD + r32 : (rowb + t0 + orow) * DM + head * HD + r32;
#pragma unroll
                for (int d0 = 0; d0 < 4; ++d0) {
                    if (MODE == 0) O32[off + d0 * 32] = o[d0][r] * fc;
                    else if (MODE == 2) { if (!probe_nostore) O32[off + d0 * 32] += o[d0][r] * fc; }
                    else Ob[off + d0 * 32] = (bf16)f2bf(O32[off + d0 * 32] + o[d0][r] * fc); } }
            LDS_WAIT();
        }
    }
}
__device__ __forceinline__ void nsa_topk_phase(Frame& F, const float* IMP, unsigned* SEL) {
    LAS float* sc = (LAS float*)(F.lds + F.wave * 1024);
    const int gw = F.bid * NWAVES + F.wave, NGW = F.G * NWAVES, lane = F.lane;
    for (int it = gw; it < MTOK * NSA_G; it += NGW) {
        const int m = it / NSA_G, t = m & (SEQ - 1), cur = t >> 6;
        const float* ip = IMP + (size_t)it * NSLC;
        const float a0 = ip[lane], a1 = ip[64 + lane];
        sc[lane] = a0; sc[64 + lane] = a1; LDS_WAIT();
        const int j0 = lane, j1 = lane + 64;
        const bool f0 = (j0 == 0) || (j0 == cur) || (j0 == cur - 1), f1 = (j1 == cur) || (j1 == cur - 1);
        const bool c0 = !f0 && j0 <= cur, c1 = !f1 && j1 <= cur;
        const int nforced = cur >= 2 ? 3 : cur + 1, slots = NTOP - nforced;
        int rk0 = 0, rk1 = 0;
        const int ncand_hi = cur < NSLC ? cur : NSLC - 1;
        for (int i = 1; i <= ncand_hi; ++i) {
            const bool fi = (i == cur) || (i == cur - 1); if (fi) continue;
            const float v = sc[i];
            rk0 += (v > a0 || (v == a0 && i < j0)) ? 1 : 0; rk1 += (v > a1 || (v == a1 && i < j1)) ? 1 : 0;
        }
        const bool s0 = (f0 && j0 <= cur) || (c0 && rk0 < slots), s1 = (f1 && j1 <= cur) || (c1 && rk1 < slots);
        const unsigned long long m0 = __ballot(s0), m1 = __ballot(s1);
        if (lane == 0) { v4u w = {(unsigned)m0, (unsigned)(m0 >> 32), (unsigned)m1, (unsigned)(m1 >> 32)}; *(v4u*)(SEL + (size_t)it * 4) = w; }
        LDS_WAIT();
    }
}

#ifndef STAGE
#define STAGE 3
#endif
#define ZERO_OB_PHASE PH_BEGIN { v4u z = {0u, 0u, 0u, 0u}; v4u* p = (v4u*)Ob; const long n = (long)MTOK * DM / 8; \
            for (long i = (long)F.bid * NTHR + F.tid; i < n; i += (long)F.G * NTHR) p[i] = z; } PH_END
#define MIXER0_PHASES \
    PH_BEGIN REP(10) hgrn_phase_a(F, BIG, (const float*)(ws + WS_LB), (bf16*)(ws + WS_QT), (float*)(ws + WS_OINTRA), (float*)(ws + WS_DS), (float*)(ws + WS_DEC)); \
             REP(11) sb_phase(F, BIG, Ob); PH_END \
    PH_BEGIN REP(12) hgrn_phase_b(F, (const float*)(ws + WS_DS), (const float*)(ws + WS_DEC), (bf16*)(ws + WS_SPREV)); PH_END \
    PH_BEGIN REP(13) hgrn_phase_c(F, BIG, (const bf16*)(ws + WS_QT), (const float*)(ws + WS_OINTRA), (const bf16*)(ws + WS_SPREV), args.in[IN_HGRN_NW], Ob); PH_END
#if STAGE <= 2
#define MIXER1_PHASES ZERO_OB_PHASE
#else
#define MIXER1_PHASES \
    PH_BEGIN REP(14) { nsa_rope_phase(F, BIG, (const float*)(ws + WS_ROPE), (bf16*)(ws + WS_QROT), (bf16*)(ws + WS_KSROT), (bf16*)(ws + WS_KWROT), (bf16*)(ws + WS_OVL)); \
             nsa_compress_phase(F, BIG, args.in[IN_NSA_CMP_POS], (const bf16*)(ws + WS_W_C1), (const bf16*)(ws + WS_W_C2), (bf16*)(ws + WS_KCMP), (bf16*)(ws + WS_VCMP)); } PH_END \
    PH_BEGIN REP(15) { nsa_attn_phase<0>(F, BIG, BIG, (const bf16*)(ws + WS_KCMP), (const bf16*)(ws + WS_VCMP), nullptr, (float*)(ws + WS_O32), nullptr, nullptr); \
             nsa_attn_phase<1>(F, BIG, BIG, (const bf16*)(ws + WS_KCMP), (const bf16*)(ws + WS_OVL), nullptr, nullptr, (float*)(ws + WS_IMP), nullptr); } PH_END \
    PH_BEGIN REP(16) nsa_topk_phase(F, (const float*)(ws + WS_IMP), (unsigned*)(ws + WS_SEL)); PH_END \
    PH_BEGIN REP(18) nsa_attn_phase<2>(F, BIG, (const bf16*)(ws + WS_QROT), (const bf16*)(ws + WS_KSROT), nullptr, (const unsigned*)(ws + WS_SEL), (float*)(ws + WS_O32), nullptr, nullptr, r_ > 0); PH_END \
    PH_BEGIN REP(17) nsa_attn_phase<3>(F, BIG, (const bf16*)(ws + WS_QROT), (const bf16*)(ws + WS_KWROT), nullptr, nullptr, (float*)(ws + WS_O32), nullptr, Ob); PH_END
#endif
#ifndef REPMASK
#define REPMASK 0u
#endif
#define REP(gid) for (int r_ = 0; r_ <= (int)((REPMASK >> (gid)) & 1u); ++r_)
#define PH_BEGIN if (pc >= lo && pc < hi) { F.fresh();
#define PH_END   if (pc + 1 < hi) { XcdBarrier bb_ = bar; asm volatile("" : "+s"(bb_.bar), "+s"(bb_.x)); xcd_barrier(bb_); } } ++pc;
template <int l>
__device__ __forceinline__ void layer_body(Frame& F, const Args& args, const XcdBarrier& bar, int& pc, const int lo, const int hi) {
    unsigned char* ws = args.ws;
    bf16* HB = (bf16*)(ws + WS_HB); bf16* Y = (bf16*)(ws + WS_Y); float* H32 = args.out;
    bf16* BIG = (bf16*)(ws + WS_BIG); bf16* Gm = (bf16*)(ws + WS_G); bf16* Ob = (bf16*)(ws + WS_O);
    bf16* XQ = (bf16*)(ws + WS_XQ); bf16* XO = (bf16*)(ws + WS_XO);
        PH_BEGIN REP(1) {
            const int N = l == 0 ? AB_IN : NSA_INP;
            pg8::Gemm g{HB, l == 0 ? (const bf16*)(ws + WS_W_ABIN) : (const bf16*)(ws + WS_W_NSAIN), MTOK, N, DM};
            pg8::StaticOrder S; S.init(MTOK, N, F.G, F.bid);
            pg8::EpiBf16<0> E{BIG, N, nullptr, 0, 0, 1.f};
            pg8::gemm_phase<pg8::EpiBf16<0>, pg8::StaticOrder, PG8_ALIGN, PG8_SP2>(F.lds + RING_OFF, g, S, E);
        } PH_END
#if STAGE <= 1
        ZERO_OB_PHASE
#else
        if (l == 0) {
            MIXER0_PHASES
        } else {
            MIXER1_PHASES
        }
#endif
        PH_BEGIN REP(2) {
            pg8::Gemm g{Ob, l == 0 ? (const bf16*)(ws + WS_W_ABOUT) : (const bf16*)(ws + WS_W_NSAOUT), MTOK, DM, DM};
            pg8::StaticOrder S; S.init(MTOK, DM, F.G, F.bid);
            if (l == 0) { pg8::EpiResBf E{Y, HB, DM, DN_ALPHA};
                pg8::gemm_phase<pg8::EpiResBf, pg8::StaticOrder, PG8_ALIGN, PG8_SP2>(F.lds + RING_OFF, g, S, E); }
            else { pg8::EpiResLn E{Y, (const float*)(ws + WS_STATS), args.in[IN_LN_G] + (size_t)2 * DM, args.in[IN_LN_B] + (size_t)2 * DM, DM, DN_ALPHA};
                pg8::gemm_phase<pg8::EpiResLn, pg8::StaticOrder, PG8_ALIGN, PG8_SP2>(F.lds + RING_OFF, g, S, E); }
        } PH_END
        PH_BEGIN REP(7) ln_phase(F, Y, args.in[IN_LN_G] + (size_t)(l * 3 + 0) * DM, args.in[IN_LN_B] + (size_t)(l * 3 + 0) * DM, nullptr, HB, (float*)(ws + WS_STATS)); PH_END
        PH_BEGIN REP(3) {
            {   pg8::Gemm g{HB, (const bf16*)(ws + WS_W_XQ) + (size_t)l * XW * DM, MTOK, XW, DM};
                pg8::RangeOrder S; S.init(MTOK, XW, 0, 128, F.bid);
                pg8::EpiBf16<0> E{XQ, XW, nullptr, 0, 0, 1.f};
                pg8::gemm_phase<pg8::EpiBf16<0>, pg8::RangeOrder, PG8_ALIGN, PG8_SP2>(F.lds + RING_OFF, g, S, E); }
            {   pg8::Gemm g{(const bf16*)(ws + WS_MEMB), (const bf16*)(ws + WS_W_XKV) + (size_t)l * 2 * XW * DM, BATCH * NMEM, 2 * XW, DM};
                pg8::RangeOrder S; S.init(BATCH * NMEM, 2 * XW, 128, 8, F.bid);
                pg8::EpiBf16<0> E{(bf16*)(ws + WS_XKV) + (size_t)l * BATCH * NMEM * 2 * XW, 2 * XW, nullptr, 0, 0, 1.f};
                pg8::gemm_phase<pg8::EpiBf16<0>, pg8::RangeOrder, PG8_ALIGN, PG8_SP2>(F.lds + RING_OFF, g, S, E); }
        } PH_END
        PH_BEGIN REP(9) xattn_phase(F, XQ, (const bf16*)(ws + WS_XKV) + (size_t)l * BATCH * NMEM * 2 * XW, XO); PH_END
        PH_BEGIN REP(4) {
            pg8::Gemm g{XO, (const bf16*)(ws + WS_W_XO) + (size_t)l * DM * XW, MTOK, DM, XW};
            pg8::StaticOrder S; S.init(MTOK, DM, F.G, F.bid);
            pg8::EpiResLn E{Y, (const float*)(ws + WS_STATS), args.in[IN_LN_G] + (size_t)(l * 3 + 0) * DM, args.in[IN_LN_B] + (size_t)(l * 3 + 0) * DM, DM, DN_ALPHA};
            pg8::gemm_phase<pg8::EpiResLn, pg8::StaticOrder, PG8_ALIGN, PG8_SP2>(F.lds + RING_OFF, g, S, E);
        } PH_END
        PH_BEGIN REP(7) ln_phase(F, Y, args.in[IN_LN_G] + (size_t)(l * 3 + 1) * DM, args.in[IN_LN_B] + (size_t)(l * 3 + 1) * DM, nullptr, HB, (float*)(ws + WS_STATS)); PH_END
        PH_BEGIN REP(5) {
            pg8::Gemm g{HB, (const bf16*)(ws + WS_W_UP) + (size_t)l * DFF2 * DM, MTOK, DFF2, DM};
            pg8::StaticOrder S; S.init(MTOK, DFF2, F.G, F.bid);
            pg8::EpiBf16<0> E{BIG, DFF2, nullptr, 0, 0, 1.f};
            pg8::gemm_phase<pg8::EpiBf16<0>, pg8::StaticOrder, PG8_ALIGN, PG8_SP2>(F.lds + RING_OFF, g, S, E);
        } PH_END
#if (REPMASK >> 20) & 1
        PH_BEGIN {
            pg8::Gemm g{HB, (const bf16*)(ws + WS_W_UP) + (size_t)l * DFF2 * DM, MTOK, DFF2, DM};
            pg8::ZeroOrder S; S.init(MTOK, DFF2, F.G, F.bid);
            pg8::EpiBf16<0> E{Gm, DFF2, nullptr, 0, 0, 1.f};
            pg8::gemm_phase<pg8::EpiBf16<0>, pg8::ZeroOrder, PG8_ALIGN, PG8_SP2>(F.lds + RING_OFF, g, S, E);
        } PH_END
#endif
        PH_BEGIN REP(8) convglu_phase(F, BIG, args.in[IN_FFN_CONV] + (size_t)l * 3 * DFF, Gm); PH_END
        PH_BEGIN REP(6) {
            pg8::Gemm g{Gm, (const bf16*)(ws + WS_W_DOWN) + (size_t)l * DM * DFF, MTOK, DM, DFF};
            pg8::StaticOrder S; S.init(MTOK, DM, F.G, F.bid);
            pg8::EpiResLn E{Y, (const float*)(ws + WS_STATS), args.in[IN_LN_G] + (size_t)(l * 3 + 1) * DM, args.in[IN_LN_B] + (size_t)(l * 3 + 1) * DM, DM, DN_ALPHA};
            pg8::gemm_phase<pg8::EpiResLn, pg8::StaticOrder, PG8_ALIGN, PG8_SP2>(F.lds + RING_OFF, g, S, E);
        } PH_END
        PH_BEGIN REP(7) ln_phase(F, Y, args.in[IN_LN_G] + (size_t)(l * 3 + 2) * DM, args.in[IN_LN_B] + (size_t)(l * 3 + 2) * DM, l == 1 ? H32 : nullptr, HB, (float*)(ws + WS_STATS)); PH_END
}
__global__ void __launch_bounds__(NTHR, 2) mega_fwd(Args args) {
    extern __shared__ __attribute__((aligned(16))) unsigned char lds_raw[];
    Frame F;
    F.lds = (LAS unsigned char*)lds_raw; F.ws = args.ws;
    F.tid = threadIdx.x; F.lane = F.tid & 63; F.wave = __builtin_amdgcn_readfirstlane(F.tid >> 6); F.G = gridDim.x;
    unsigned char* ws = args.ws;
    gu32* ctl = (gu32*)(ws + WS_CTL);
    for (int u = F.tid; u < (LDS_BYTES - LDSCTL_OFF) / 4; u += NTHR) ((LAS unsigned*)(F.lds + LDSCTL_OFF))[u] = 0u;
    __syncthreads();
    volatile LAS unsigned* MISC = (volatile LAS unsigned*)(F.lds + MISC_OFF);
    XcdBarrier bar = xcd_barrier_post((unsigned*)(ctl + CW_BAR), MISC + 8);
    const int lo = args.ph_lo, hi = args.ph_hi; int pc = 0;
    bf16* HB = (bf16*)(ws + WS_HB); bf16* Y = (bf16*)(ws + WS_Y); float* H32 = args.out;
    bf16* BIG = (bf16*)(ws + WS_BIG); bf16* Gm = (bf16*)(ws + WS_G); bf16* Ob = (bf16*)(ws + WS_O);
    bf16* XQ = (bf16*)(ws + WS_XQ); bf16* XO = (bf16*)(ws + WS_XO);

    PH_BEGIN REP(0) p0_prologue(F, args); PH_END

    layer_body<0>(F, args, bar, pc, lo, hi);
    layer_body<1>(F, args, bar, pc, lo, hi);
}

extern "C" void kernel_launch(void* const* d_in, const int* in_sizes, int n_in, void* d_out, int out_size, void* d_ws, size_t ws_size, hipStream_t stream) {
    static int grid = 0;
    if (grid == 0) {
        if (n_in != 19 || in_sizes[0] != MTOK * DM || out_size != MTOK * DM || ws_size < WS_END) {
            fprintf(stderr, "kernel_launch: shape mismatch n_in %d in0 %d out %d ws %zu (need %zu)\n", n_in, n_in > 0 ? in_sizes[0] : -1, out_size, ws_size, (size_t)WS_END); grid = -1; return; }
        int dev = 0, cus = 0, per_cu = 0;
        if (hipGetDevice(&dev) != hipSuccess || hipDeviceGetAttribute(&cus, hipDeviceAttributeMultiprocessorCount, dev) != hipSuccess) { grid = -1; return; }
        if (hipFuncSetAttribute((const void*)mega_fwd, hipFuncAttributeMaxDynamicSharedMemorySize, LDS_BYTES) != hipSuccess) { fprintf(stderr, "kernel_launch: hipFuncSetAttribute failed\n"); grid = -1; return; }
        if (hipOccupancyMaxActiveBlocksPerMultiprocessor(&per_cu, (const void*)mega_fwd, NTHR, LDS_BYTES) != hipSuccess || per_cu < 1)
            fprintf(stderr, "kernel_launch: note: occupancy query reports %d workgroups per CU\n", per_cu);
        (void)hipGetLastError();
        grid = cus;
    }
    if (grid < 0) return;
    if (hipMemsetAsync((char*)d_ws + WS_CTL, 0, CTL_ZERO_BYTES, stream) != hipSuccess) { fprintf(stderr, "kernel_launch: memset failed\n"); return; }
    Args a{};
    for (int i = 0; i < 19; ++i) a.in[i] = (const float*)d_in[i];
    a.out = (float*)d_out; a.ws = (unsigned char*)d_ws; a.ph_lo = 0; a.ph_hi = 1 << 20;
    hipLaunchKernelGGL(mega_fwd, dim3(grid), dim3(NTHR), LDS_BYTES, stream, a);
    const hipError_t le = hipPeekAtLastError();
    if (le != hipSuccess) fprintf(stderr, "kernel_launch: launch failed: %s\n", hipGetErrorName(le));
}
```

```cpp
#include <hip/hip_runtime.h>
#include <cstdio>
#include <cstdint>
namespace pg8 {
#define PG8_LAS __attribute__((address_space(3)))
typedef unsigned short bf16_t;
typedef short bf16x8 __attribute__((ext_vector_type(8)));
typedef float f32x4 __attribute__((ext_vector_type(4)));
typedef unsigned u32x4 __attribute__((ext_vector_type(4)));
constexpr int BM = 256, BK = 64, HALF = 128, HTB = HALF * BK * 2  , STAGE_BYTES = 8 * HTB, NXCD = 8, WGM = 8;

__host__ __device__ __forceinline__ int lds_byte(int r, int c) { const int st = (r >> 4) * 2 + (c >> 5), rr = r & 15, cc = c & 31, ob = rr * 64 + cc * 2; return st * 1024 + (ob ^ (((ob >> 9) & 1) << 5)); }
__host__ __device__ __forceinline__ void stage_rc(int b, int& R, int& C) { const int st = b / 1024, sb = b % 1024, swz = sb ^ (((sb >> 9) & 1) << 5); R = (st >> 1) * 16 + swz / 64; C = (st & 1) * 32 + (swz % 64) / 2; }
__host__ __device__ __forceinline__ int perm32(int rho) { const int n = rho >> 4, i = rho & 15; return 8 * (i >> 2) + 4 * n + (i & 3); }

struct Unit { int pm, pn; };
struct Gemm { const bf16_t* A; const bf16_t* Bt; int M, N, K; };

struct StaticOrder {
    int nM, nN, nwg, G, c;
    __host__ __device__ void init(int M, int N, int G_, int c_) { nM = M / BM; nN = N / BM; nwg = nM * nN; G = G_; c = c_; }
    __host__ __device__ bool next(int i, Unit& u) const {
        const long L = (long)i * G + c; if (L >= nwg) return false;
        int wgid = (int)L; { const int q = nwg / NXCD, r = nwg % NXCD, xcd = wgid % NXCD, off = wgid / NXCD; wgid = (xcd < r ? xcd * (q + 1) : r * (q + 1) + (xcd - r) * q) + off; }
        const int nig = WGM * nN, gid = wgid / nig, fm = gid * WGM, gsz = (nM - fm) < WGM ? (nM - fm) : WGM;
        u.pm = fm + ((wgid % nig) % gsz); u.pn = (wgid % nig) / gsz; return true;
    }
    __device__ __forceinline__ void a_ready(const Unit&) const {}
    __device__ __forceinline__ void done(const Unit&) const {}
};

__device__ __forceinline__ unsigned cvt_pk_bf16(float lo, float hi) { unsigned r; asm volatile("v_cvt_pk_bf16_f32 %0, %1, %2" : "=v"(r) : "v"(lo), "v"(hi)); return r; }
typedef float f32x2 __attribute__((ext_vector_type(2)));
__device__ __forceinline__ f32x2 gelu_pk(f32x2 v) {
    const f32x2 av = __builtin_elementwise_abs(v), d = av * 0.2316418882f + 1.0f;
    f32x2 t; t.x = __builtin_amdgcn_rcpf(d.x); t.y = __builtin_amdgcn_rcpf(d.y);
    f32x2 q = t * 0.5307027145f + (-0.7265760135f); q = q * t + 0.7107068705f; q = q * t + (-0.142248368f); q = q * t + 0.127414796f; q = q * t;
    const f32x2 s = (v * v) * (-0.72134752044f);
    f32x2 e; e.x = __builtin_amdgcn_exp2f(s.x); e.y = __builtin_amdgcn_exp2f(s.y);
    const f32x2 m = v * (q * e), r = v - m;
    f32x2 o; o.x = v.x < 0.f ? m.x : r.x; o.y = v.y < 0.f ? m.y : r.y; return o;
}

template <int ACT  > struct EpiBf16 {
    static constexpr bool PERM = true, AFTER_DRAIN = false; static_assert(ACT == 0 || ACT == 1, "EpiBf16: ACT is 0 (none) or 1 (gelu_pk)");
    bf16_t* O; int ldc; const float* bias; int split_cols; size_t split_stride; float scale0;
    __device__ __forceinline__ void operator()(const f32x4 (&acc)[2][2][4][2], const Unit& u, int wr, int wc, int fr, int fq) const {
        const int row0 = u.pm * BM + wr * 64 + fr; int colt = u.pn * BM; bf16_t* base = O;
        float sc = 1.f; if (split_cols) { const int t = colt / split_cols; base += (size_t)t * split_stride; colt -= t * split_cols; if (t == 0) sc = scale0; }
        const int col0 = colt + wc * 32 + 8 * fq, bcol0 = u.pn * BM + wc * 32 + 8 * fq;
        f32x4 bv[2][2];
#pragma unroll
        for (int bj = 0; bj < 2; ++bj)
#pragma unroll
            for (int n = 0; n < 2; ++n) bv[bj][n] = bias ? *(const f32x4*)(bias + bcol0 + bj * HALF + 4 * n) : (f32x4){0.f, 0.f, 0.f, 0.f};
#pragma unroll
        for (int ai = 0; ai < 2; ++ai)
#pragma unroll
            for (int m = 0; m < 4; ++m) { bf16_t* rowp = base + (size_t)(row0 + ai * HALF + m * 16) * ldc + col0;
#pragma unroll
                for (int bj = 0; bj < 2; ++bj) { f32x4 v0 = acc[ai][bj][m][0] + bv[bj][0], v1 = acc[ai][bj][m][1] + bv[bj][1];
                    if (ACT == 1) { f32x2 a = gelu_pk((f32x2){v0[0], v0[1]}), b = gelu_pk((f32x2){v0[2], v0[3]}), c = gelu_pk((f32x2){v1[0], v1[1]}), d = gelu_pk((f32x2){v1[2], v1[3]});
                        v0 = (f32x4){a.x, a.y, b.x, b.y}; v1 = (f32x4){c.x, c.y, d.x, d.y}; }
                    v0 = v0 * sc; v1 = v1 * sc; u32x4 w; w.x = cvt_pk_bf16(v0[0], v0[1]); w.y = cvt_pk_bf16(v0[2], v0[3]); w.z = cvt_pk_bf16(v1[0], v1[1]); w.w = cvt_pk_bf16(v1[2], v1[3]);
                    *(u32x4*)(rowp + bj * HALF) = w; } }
    }
};


struct EpiRes {
    static constexpr bool PERM = false, AFTER_DRAIN = false;
    float* Y; const float* res; int ldc; float alpha;
    __device__ __forceinline__ void operator()(const f32x4 (&acc)[2][2][4][2], const Unit& u, int wr, int wc, int fr, int fq) const {
        const int row0 = u.pm * BM + wr * 64 + fr, col0 = u.pn * BM + wc * 32 + 4 * fq;
#pragma unroll
        for (int ai = 0; ai < 2; ++ai)
#pragma unroll
            for (int m = 0; m < 4; ++m) { const size_t off = (size_t)(row0 + ai * HALF + m * 16) * ldc + col0;
#pragma unroll
                for (int bj = 0; bj < 2; ++bj)
#pragma unroll
                    for (int n = 0; n < 2; ++n) { const f32x4 r = *(const f32x4*)(res + off + bj * HALF + n * 16);
                        *(f32x4*)(Y + off + bj * HALF + n * 16) = r * alpha + acc[ai][bj][m][n]; } }
    }
};
struct RangeOrder {
    int nM, nN, ntot, c0, nw, c;
    __host__ __device__ void init(int M, int N, int c0_, int nw_, int c_) { nM = M / BM; nN = N / BM; ntot = nM * nN; c0 = c0_; nw = nw_; c = c_; }
    __host__ __device__ bool next(int i, Unit& u) const {
        if (c < c0 || c >= c0 + nw) return false;
        const int L = i * nw + (c - c0); if (L >= ntot) return false;
        u.pm = L / nN; u.pn = L % nN; return true;
    }
    __device__ __forceinline__ void a_ready(const Unit&) const {}
    __device__ __forceinline__ void done(const Unit&) const {}
};

struct ZeroOrder : StaticOrder {
    __host__ __device__ bool next(int i, Unit& u) const { const bool r = StaticOrder::next(i, u); u.pm = 0; u.pn = 0; return r; }
};

struct EpiResBf {
    static constexpr bool PERM = true, AFTER_DRAIN = false;
    bf16_t* Y; const bf16_t* res; int ldc; float alpha;
    __device__ __forceinline__ void operator()(const f32x4 (&acc)[2][2][4][2], const Unit& u, int wr, int wc, int fr, int fq) const {
        const int row0 = u.pm * BM + wr * 64 + fr, col0 = u.pn * BM + wc * 32 + 8 * fq;
#pragma unroll
        for (int ai = 0; ai < 2; ++ai)
#pragma unroll
            for (int m = 0; m < 4; ++m) { const size_t off = (size_t)(row0 + ai * HALF + m * 16) * ldc + col0;
#pragma unroll
                for (int bj = 0; bj < 2; ++bj) { const u32x4 r = *(const u32x4*)(res + off + bj * HALF);
                    const f32x4 v0 = acc[ai][bj][m][0], v1 = acc[ai][bj][m][1];
                    u32x4 w;
                    w.x = cvt_pk_bf16(__builtin_bit_cast(float, r.x << 16) * alpha + v0[0], __builtin_bit_cast(float, r.x & 0xffff0000u) * alpha + v0[1]);
                    w.y = cvt_pk_bf16(__builtin_bit_cast(float, r.y << 16) * alpha + v0[2], __builtin_bit_cast(float, r.y & 0xffff0000u) * alpha + v0[3]);
                    w.z = cvt_pk_bf16(__builtin_bit_cast(float, r.z << 16) * alpha + v1[0], __builtin_bit_cast(float, r.z & 0xffff0000u) * alpha + v1[1]);
                    w.w = cvt_pk_bf16(__builtin_bit_cast(float, r.w << 16) * alpha + v1[2], __builtin_bit_cast(float, r.w & 0xffff0000u) * alpha + v1[3]);
                    *(u32x4*)(Y + off + bj * HALF) = w; } }
    }
};

struct EpiResF {
    static constexpr bool PERM = true, AFTER_DRAIN = false;
    float* Y; const bf16_t* res; int ldc; float alpha;
    __device__ __forceinline__ void operator()(const f32x4 (&acc)[2][2][4][2], const Unit& u, int wr, int wc, int fr, int fq) const {
        const int row0 = u.pm * BM + wr * 64 + fr, col0 = u.pn * BM + wc * 32 + 8 * fq;
#pragma unroll
        for (int ai = 0; ai < 2; ++ai)
#pragma unroll
            for (int m = 0; m < 4; ++m) { const size_t off = (size_t)(row0 + ai * HALF + m * 16) * ldc + col0;
#pragma unroll
                for (int bj = 0; bj < 2; ++bj) { const u32x4 r = *(const u32x4*)(res + off + bj * HALF);
                    f32x4 o0, o1;
                    o0[0] = __builtin_bit_cast(float, r.x << 16); o0[1] = __builtin_bit_cast(float, r.x & 0xffff0000u); o0[2] = __builtin_bit_cast(float, r.y << 16); o0[3] = __builtin_bit_cast(float, r.y & 0xffff0000u);
                    o1[0] = __builtin_bit_cast(float, r.z << 16); o1[1] = __builtin_bit_cast(float, r.z & 0xffff0000u); o1[2] = __builtin_bit_cast(float, r.w << 16); o1[3] = __builtin_bit_cast(float, r.w & 0xffff0000u);
                    *(f32x4*)(Y + off + bj * HALF) = o0 * alpha + acc[ai][bj][m][0]; *(f32x4*)(Y + off + bj * HALF + 4) = o1 * alpha + acc[ai][bj][m][1]; } }
    }
};

struct EpiResLn {
    static constexpr bool PERM = true, AFTER_DRAIN = false;
    bf16_t* Y; const float* stats; const float* g; const float* b; int ldc; float alpha;
    __device__ __forceinline__ void operator()(const f32x4 (&acc)[2][2][4][2], const Unit& u, int wr, int wc, int fr, int fq) const {
        const int row0 = u.pm * BM + wr * 64 + fr, col0 = u.pn * BM + wc * 32 + 8 * fq;
        f32x4 gv[2][2], bv[2][2];
#pragma unroll
        for (int bj = 0; bj < 2; ++bj)
#pragma unroll
            for (int n = 0; n < 2; ++n) { gv[bj][n] = *(const f32x4*)(g + col0 + bj * HALF + 4 * n) * alpha; bv[bj][n] = *(const f32x4*)(b + col0 + bj * HALF + 4 * n) * alpha; }
#pragma unroll
        for (int ai = 0; ai < 2; ++ai)
#pragma unroll
            for (int m = 0; m < 4; ++m) { const int row = row0 + ai * HALF + m * 16; const size_t off = (size_t)row * ldc + col0;
                const float mean = stats[2 * row], rstd = stats[2 * row + 1];
#pragma unroll
                for (int bj = 0; bj < 2; ++bj) { const u32x4 r = *(const u32x4*)(Y + off + bj * HALF);
                    f32x4 y0, y1;
                    y0[0] = __builtin_bit_cast(float, r.x << 16); y0[1] = __builtin_bit_cast(float, r.x & 0xffff0000u); y0[2] = __builtin_bit_cast(float, r.y << 16); y0[3] = __builtin_bit_cast(float, r.y & 0xffff0000u);
                    y1[0] = __builtin_bit_cast(float, r.z << 16); y1[1] = __builtin_bit_cast(float, r.z & 0xffff0000u); y1[2] = __builtin_bit_cast(float, r.w << 16); y1[3] = __builtin_bit_cast(float, r.w & 0xffff0000u);
                    const f32x4 o0 = (y0 - mean) * rstd * gv[bj][0] + bv[bj][0] + acc[ai][bj][m][0], o1 = (y1 - mean) * rstd * gv[bj][1] + bv[bj][1] + acc[ai][bj][m][1];
                    u32x4 w; w.x = cvt_pk_bf16(o0[0], o0[1]); w.y = cvt_pk_bf16(o0[2], o0[3]); w.z = cvt_pk_bf16(o1[0], o1[1]); w.w = cvt_pk_bf16(o1[2], o1[3]);
                    *(u32x4*)(Y + off + bj * HALF) = w; } }
    }
};

constexpr float RS_SCALE = 1048576.0f, RS_INV = 1.0f / 1048576.0f;
__device__ __forceinline__ void row_stats(const long long* rs, int row, float& mean, float& rstd) {
    const long long a = rs[2 * (size_t)row], b = rs[2 * (size_t)row + 1];
    mean = (float)a * (RS_INV / 4096.0f); const float var = (float)b * (RS_INV / 4096.0f) - mean * mean; rstd = 1.0f / sqrtf(var + 1e-5f);
}
constexpr float FOLD_SCALE = 4294967296.0f, FOLD_INV = 1.0f / 4294967296.0f;
struct EpiBf16Ln {
    static constexpr bool PERM = true, AFTER_DRAIN = false;
    bf16_t* O; int ldc; const long long* rs; const long long* cs; const long long* b2;
    __device__ __forceinline__ void operator()(const f32x4 (&acc)[2][2][4][2], const Unit& u, int wr, int wc, int fr, int fq) const {
        const int row0 = u.pm * BM + wr * 64 + fr, col0 = u.pn * BM + wc * 32 + 8 * fq;
        f32x4 cv[2][2], bv[2][2];
#pragma unroll
        for (int bj = 0; bj < 2; ++bj)
#pragma unroll
            for (int n = 0; n < 2; ++n)
#pragma unroll
                for (int q = 0; q < 4; ++q) { cv[bj][n][q] = (float)cs[col0 + bj * HALF + 4 * n + q] * FOLD_INV; bv[bj][n][q] = (float)b2[col0 + bj * HALF + 4 * n + q] * FOLD_INV; }
#pragma unroll
        for (int ai = 0; ai < 2; ++ai)
#pragma unroll
            for (int m = 0; m < 4; ++m) { const int row = row0 + ai * HALF + m * 16; float mean, rstd; row_stats(rs, row, mean, rstd);
                bf16_t* rowp = O + (size_t)row * ldc + col0;
#pragma unroll
                for (int bj = 0; bj < 2; ++bj) { const f32x4 v0 = (acc[ai][bj][m][0] - cv[bj][0] * mean) * rstd + bv[bj][0], v1 = (acc[ai][bj][m][1] - cv[bj][1] * mean) * rstd + bv[bj][1];
                    u32x4 w; w.x = cvt_pk_bf16(v0[0], v0[1]); w.y = cvt_pk_bf16(v0[2], v0[3]); w.z = cvt_pk_bf16(v1[0], v1[1]); w.w = cvt_pk_bf16(v1[2], v1[3]);
                    *(u32x4*)(rowp + bj * HALF) = w; } }
    }
};
__device__ __forceinline__ void row_sums_add(long long* rso, int row, const f32x4& a, const f32x4& b, const f32x4& c, const f32x4& d, int fq) {
    float s1 = ((a[0] + a[1]) + (a[2] + a[3])) + ((b[0] + b[1]) + (b[2] + b[3])) + ((c[0] + c[1]) + (c[2] + c[3])) + ((d[0] + d[1]) + (d[2] + d[3]));
    float s2 = ((a[0] * a[0] + a[1] * a[1]) + (a[2] * a[2] + a[3] * a[3])) + ((b[0] * b[0] + b[1] * b[1]) + (b[2] * b[2] + b[3] * b[3]))
             + ((c[0] * c[0] + c[1] * c[1]) + (c[2] * c[2] + c[3] * c[3])) + ((d[0] * d[0] + d[1] * d[1]) + (d[2] * d[2] + d[3] * d[3]));
    s1 += __shfl_xor(s1, 16); s1 += __shfl_xor(s1, 32); s2 += __shfl_xor(s2, 16); s2 += __shfl_xor(s2, 32);
    if (fq == 0) { atomicAdd((unsigned long long*)(rso + 2 * (size_t)row), (unsigned long long)(long long)rintf(s1 * RS_SCALE)); atomicAdd((unsigned long long*)(rso + 2 * (size_t)row + 1), (unsigned long long)(long long)rintf(s2 * RS_SCALE)); }
}
struct EpiRes0 {
    static constexpr bool PERM = true, AFTER_DRAIN = false;
    bf16_t* Y; const bf16_t* res; int ldc; float alpha; long long* rso;
    __device__ __forceinline__ void operator()(const f32x4 (&acc)[2][2][4][2], const Unit& u, int wr, int wc, int fr, int fq) const {
        const int row0 = u.pm * BM + wr * 64 + fr, col0 = u.pn * BM + wc * 32 + 8 * fq;
#pragma unroll
        for (int ai = 0; ai < 2; ++ai)
#pragma unroll
            for (int m = 0; m < 4; ++m) { const int row = row0 + ai * HALF + m * 16; const size_t off = (size_t)row * ldc + col0; f32x4 o[2][2];
#pragma unroll
                for (int bj = 0; bj < 2; ++bj) { const u32x4 r = *(const u32x4*)(res + off + bj * HALF);
                    f32x4 y0, y1;
                    y0[0] = __builtin_bit_cast(float, r.x << 16); y0[1] = __builtin_bit_cast(float, r.x & 0xffff0000u); y0[2] = __builtin_bit_cast(float, r.y << 16); y0[3] = __builtin_bit_cast(float, r.y & 0xffff0000u);
                    y1[0] = __builtin_bit_cast(float, r.z << 16); y1[1] = __builtin_bit_cast(float, r.z & 0xffff0000u); y1[2] = __builtin_bit_cast(float, r.w << 16); y1[3] = __builtin_bit_cast(float, r.w & 0xffff0000u);
                    o[bj][0] = y0 * alpha + acc[ai][bj][m][0]; o[bj][1] = y1 * alpha + acc[ai][bj][m][1];
                    u32x4 w; w.x = cvt_pk_bf16(o[bj][0][0], o[bj][0][1]); w.y = cvt_pk_bf16(o[bj][0][2], o[bj][0][3]); w.z = cvt_pk_bf16(o[bj][1][0], o[bj][1][1]); w.w = cvt_pk_bf16(o[bj][1][2], o[bj][1][3]);
                    *(u32x4*)(Y + off + bj * HALF) = w; }
                row_sums_add(rso, row, o[0][0], o[0][1], o[1][0], o[1][1], fq); }
    }
};
struct EpiResLn2 {
    static constexpr bool PERM = true, AFTER_DRAIN = false;
    bf16_t* Y; const long long* rsi; const float* g; const float* b; int ldc; float alpha; long long* rso;
    __device__ __forceinline__ void operator()(const f32x4 (&acc)[2][2][4][2], const Unit& u, int wr, int wc, int fr, int fq) const {
        const int row0 = u.pm * BM + wr * 64 + fr, col0 = u.pn * BM + wc * 32 + 8 * fq;
        f32x4 gv[2][2], bv[2][2];
#pragma unroll
        for (int bj = 0; bj < 2; ++bj)
#pragma unroll
            for (int n = 0; n < 2; ++n) { gv[bj][n] = *(const f32x4*)(g + col0 + bj * HALF + 4 * n) * alpha; bv[bj][n] = *(const f32x4*)(b + col0 + bj * HALF + 4 * n) * alpha; }
#pragma unroll
        for (int ai = 0; ai < 2; ++ai)
#pragma unroll
            for (int m = 0; m < 4; ++m) { const int row = row0 + ai * HALF + m * 16; const size_t off = (size_t)row * ldc + col0; float mean, rstd; row_stats(rsi, row, mean, rstd); f32x4 o[2][2];
#pragma unroll
                for (int bj = 0; bj < 2; ++bj) { const u32x4 r = *(const u32x4*)(Y + off + bj * HALF);
                    f32x4 y0, y1;
                    y0[0] = __builtin_bit_cast(float, r.x << 16); y0[1] = __builtin_bit_cast(float, r.x & 0xffff0000u); y0[2] = __builtin_bit_cast(float, r.y << 16); y0[3] = __builtin_bit_cast(float, r.y & 0xffff0000u);
                    y1[0] = __builtin_bit_cast(float, r.z << 16); y1[1] = __builtin_bit_cast(float, r.z & 0xffff0000u); y1[2] = __builtin_bit_cast(float, r.w << 16); y1[3] = __builtin_bit_cast(float, r.w & 0xffff0000u);
                    o[bj][0] = (y0 - mean) * rstd * gv[bj][0] + bv[bj][0] + acc[ai][bj][m][0]; o[bj][1] = (y1 - mean) * rstd * gv[bj][1] + bv[bj][1] + acc[ai][bj][m][1];
                    u32x4 w; w.x = cvt_pk_bf16(o[bj][0][0], o[bj][0][1]); w.y = cvt_pk_bf16(o[bj][0][2], o[bj][0][3]); w.z = cvt_pk_bf16(o[bj][1][0], o[bj][1][1]); w.w = cvt_pk_bf16(o[bj][1][2], o[bj][1][3]);
                    *(u32x4*)(Y + off + bj * HALF) = w; }
                row_sums_add(rso, row, o[0][0], o[0][1], o[1][0], o[1][1], fq); }
    }
};
template <class Epi, class Sched, bool ALIGN_EPI = false, bool SP2 = false>
__device__ __forceinline__ void gemm_phase(PG8_LAS unsigned char* lds, const Gemm g, const Sched& S, const Epi& E) {
    int tid_l = threadIdx.x; asm volatile("" : "+v"(tid_l)); const int tid = tid_l, wid = __builtin_amdgcn_readfirstlane(tid >> 6), lane = tid & 63, wr = wid >> 2, wc = wid & 3, fr = lane & 15, fq = lane >> 4;
    const int K = g.K, nt = K / BK;
    unsigned voffA[2], voffB[2];
#pragma unroll
    for (int i = 0; i < 2; ++i) { int R, C; stage_rc(tid * 16 + i * 8192, R, C); const int Rb = Epi::PERM ? ((R & ~31) + perm32(R & 31)) : R;
        voffA[i] = (unsigned)(R * K + C) * 2u; voffB[i] = (unsigned)(Rb * K + C) * 2u; }
    const size_t kstep = (size_t)(BK * 2);
    const size_t hstep = (size_t)HALF * K * 2;
    const size_t tstep = 2 * hstep;
    const unsigned ldsw = (unsigned)wid * 1024u;
    const int aoff = lds_byte(wr * 64 + fr, fq * 8), boff = lds_byte(wc * 32 + fr, fq * 8);
#define PG8_SA(b, h) (((b) * 2 + (h)) * HTB)
#define PG8_SB(b, h) ((4 + (b) * 2 + (h)) * HTB)
#define PG8_STAGE(bufoff, gbase, voff) do { _Pragma("unroll") for (int _i = 0; _i < 2; ++_i) \
        __builtin_amdgcn_global_load_lds((const unsigned*)((const char*)(gbase) + (voff)[_i]), (PG8_LAS unsigned*)(lds + (bufoff) + ldsw + _i * 8192), 16, 0, 0); } while (0)
#define PG8_LDA(dst, b, h) do { _Pragma("unroll") for (int m = 0; m < 4; ++m) _Pragma("unroll") for (int k = 0; k < 2; ++k) dst[m][k] = *(const PG8_LAS bf16x8*)(lds + PG8_SA(b, h) + aoff + m * 2048 + k * 1024); } while (0)
#define PG8_LDB(dst, b, h) do { _Pragma("unroll") for (int n = 0; n < 2; ++n) _Pragma("unroll") for (int k = 0; k < 2; ++k) dst[n][k] = *(const PG8_LAS bf16x8*)(lds + PG8_SB(b, h) + boff + n * 2048 + k * 1024); } while (0)
#define PG8_MMA(ai, bj, At, Bt) do { __builtin_amdgcn_s_setprio(1); _Pragma("unroll") for (int m = 0; m < 4; ++m) _Pragma("unroll") for (int n = 0; n < 2; ++n) _Pragma("unroll") for (int k = 0; k < 2; ++k) \
        acc[ai][bj][m][n] = __builtin_amdgcn_mfma_f32_16x16x32_bf16(Bt[n][k], At[m][k], acc[ai][bj][m][n], 0, 0, 0); __builtin_amdgcn_s_setprio(0); } while (0)
#define PG8_WAIT_V(n) asm volatile("s_waitcnt vmcnt(" #n ")" ::: "memory")
#define PG8_WAIT_L(n) asm volatile("s_waitcnt lgkmcnt(" #n ")" ::: "memory")
#define PG8_BAR __builtin_amdgcn_s_barrier()
#define PG8_SCHED __builtin_amdgcn_sched_barrier(0)
    Unit cur, nxt; int ui = 0;
    if (!S.next(0, cur)) return;
    f32x4 acc[2][2][4][2];
#pragma unroll
    for (int a = 0; a < 2; ++a)
#pragma unroll
        for (int b = 0; b < 2; ++b)
#pragma unroll
            for (int m = 0; m < 4; ++m)
#pragma unroll
                for (int n = 0; n < 2; ++n) acc[a][b][m][n] = (f32x4){0.f, 0.f, 0.f, 0.f};
    bf16x8 At[4][2], B0[2][2], B1[2][2];
    const char* cA = (const char*)g.A + (size_t)cur.pm * tstep; const char* cB = (const char*)g.Bt + (size_t)cur.pn * tstep;
    S.a_ready(cur);
    if constexpr (SP2) {
        PG8_STAGE(PG8_SB(0, 0), cB, voffB); PG8_STAGE(PG8_SB(0, 1), cB + hstep, voffB); PG8_STAGE(PG8_SA(0, 0), cA, voffA); PG8_STAGE(PG8_SA(0, 1), cA + hstep, voffA);
        if (wr == 1) PG8_BAR;
        PG8_WAIT_V(2); PG8_BAR;
        PG8_STAGE(PG8_SB(1, 0), cB + kstep, voffB); PG8_STAGE(PG8_SA(1, 0), cA + kstep, voffA); PG8_STAGE(PG8_SB(1, 1), cB + hstep + kstep, voffB);
        PG8_WAIT_V(6); PG8_BAR;
    } else {
        PG8_STAGE(PG8_SB(0, 0), cB, voffB); PG8_STAGE(PG8_SA(0, 0), cA, voffA); PG8_STAGE(PG8_SB(0, 1), cB + hstep, voffB); PG8_STAGE(PG8_SA(0, 1), cA + hstep, voffA);
        if (wr == 1) PG8_BAR;
        PG8_WAIT_V(4); PG8_BAR;
        PG8_STAGE(PG8_SB(1, 0), cB + kstep, voffB); PG8_STAGE(PG8_SA(1, 0), cA + kstep, voffA); PG8_STAGE(PG8_SB(1, 1), cB + hstep + kstep, voffB);
        PG8_WAIT_V(6); PG8_BAR;
    }
    for (;;) {
        const bool has_next = S.next(ui + 1, nxt);
        const char* nA = has_next ? (const char*)g.A + (size_t)nxt.pm * tstep : cA; const char* nB = has_next ? (const char*)g.Bt + (size_t)nxt.pn * tstep : cB;
        for (int t = 0; t < nt; t += 2) {
            const bool last = (t == nt - 2);
            const char* a1 = cA + (size_t)(t + 1) * kstep;
            const char* a2 = last ? nA : cA + (size_t)(t + 2) * kstep; const char* b2 = last ? nB : cB + (size_t)(t + 2) * kstep;
            const char* a3 = a2 + kstep; const char* b3 = b2 + kstep;
            if (last && has_next) S.a_ready(nxt);
            if constexpr (SP2) {
            PG8_LDB(B0, 0, 0); PG8_LDB(B1, 0, 1); PG8_SCHED; PG8_LDA(At, 0, 0); PG8_STAGE(PG8_SA(1, 1), a1 + hstep, voffA);
            PG8_WAIT_V(8); PG8_WAIT_L(0); PG8_BAR; PG8_MMA(0, 0, At, B0); PG8_MMA(0, 1, At, B1); PG8_BAR; PG8_SCHED;
            PG8_LDA(At, 0, 1); PG8_STAGE(PG8_SB(0, 0), b2, voffB); PG8_STAGE(PG8_SB(0, 1), b2 + hstep, voffB); PG8_STAGE(PG8_SA(0, 0), a2, voffA);
            PG8_WAIT_V(8); PG8_WAIT_L(0); PG8_BAR; PG8_MMA(1, 0, At, B0); PG8_MMA(1, 1, At, B1); PG8_BAR; PG8_SCHED;
            PG8_LDB(B0, 1, 0); PG8_LDB(B1, 1, 1); PG8_SCHED; PG8_LDA(At, 1, 0); PG8_STAGE(PG8_SA(0, 1), a2 + hstep, voffA);
            PG8_WAIT_V(8); PG8_WAIT_L(0); PG8_BAR; PG8_MMA(0, 0, At, B0); PG8_MMA(0, 1, At, B1); PG8_BAR; PG8_SCHED;
            PG8_LDA(At, 1, 1); PG8_STAGE(PG8_SB(1, 0), b3, voffB); PG8_STAGE(PG8_SB(1, 1), b3 + hstep, voffB); PG8_STAGE(PG8_SA(1, 0), a3, voffA);
            PG8_WAIT_V(8); PG8_WAIT_L(0); PG8_BAR; PG8_MMA(1, 0, At, B0); PG8_MMA(1, 1, At, B1); PG8_BAR; PG8_SCHED;
            } else {
            PG8_LDB(B0, 0, 0); PG8_SCHED; PG8_LDA(At, 0, 0); PG8_STAGE(PG8_SA(1, 1), a1 + hstep, voffA);
            PG8_WAIT_L(8); PG8_BAR; PG8_WAIT_L(0); PG8_MMA(0, 0, At, B0); PG8_BAR; PG8_SCHED;
            PG8_LDB(B1, 0, 1); PG8_STAGE(PG8_SB(0, 0), b2, voffB);
            PG8_BAR; PG8_WAIT_L(0); PG8_MMA(0, 1, At, B1); PG8_BAR;
            PG8_LDA(At, 0, 1); PG8_STAGE(PG8_SA(0, 0), a2, voffA);
            PG8_BAR; PG8_WAIT_L(0); PG8_MMA(1, 0, At, B0); PG8_BAR; PG8_SCHED;
            PG8_STAGE(PG8_SB(0, 1), b2 + hstep, voffB);
            PG8_WAIT_V(6); PG8_BAR; PG8_MMA(1, 1, At, B1); PG8_BAR;
            PG8_LDB(B0, 1, 0); PG8_SCHED; PG8_LDA(At, 1, 0); PG8_STAGE(PG8_SA(0, 1), a2 + hstep, voffA);
            PG8_WAIT_L(8); PG8_BAR; PG8_WAIT_L(0); PG8_MMA(0, 0, At, B0); PG8_BAR; PG8_SCHED;
            PG8_LDB(B1, 1, 1); PG8_STAGE(PG8_SB(1, 0), b3, voffB);
            PG8_BAR; PG8_WAIT_L(0); PG8_MMA(0, 1, At, B1); PG8_BAR;
            PG8_LDA(At, 1, 1); PG8_STAGE(PG8_SA(1, 0), a3, voffA);
            PG8_BAR; PG8_WAIT_L(0); PG8_MMA(1, 0, At, B0); PG8_BAR; PG8_SCHED;
            PG8_STAGE(PG8_SB(1, 1), b3 + hstep, voffB);
            PG8_WAIT_V(6); PG8_BAR; PG8_MMA(1, 1, At, B1); PG8_BAR;
            }
        }
        if constexpr (ALIGN_EPI) { if (wr == 0) PG8_BAR; }
        if constexpr (!Epi::AFTER_DRAIN) { E(acc, cur, wr, wc, fr, fq); S.done(cur); }
        if (!has_next) break;
#pragma unroll
        for (int a = 0; a < 2; ++a)
#pragma unroll
            for (int b = 0; b < 2; ++b)
#pragma unroll
                for (int m = 0; m < 4; ++m)
#pragma unroll
                    for (int n = 0; n < 2; ++n) acc[a][b][m][n] = (f32x4){0.f, 0.f, 0.f, 0.f};
        cur = nxt; cA = nA; cB = nB; ++ui;
        if constexpr (ALIGN_EPI) { if (wr == 1) PG8_BAR; }
    }
    PG8_WAIT_V(0);
    if constexpr (!ALIGN_EPI) { if (wr == 0) PG8_BAR; }
    PG8_BAR;
    if constexpr (Epi::AFTER_DRAIN) { E.fused(acc, cur, wr, wc, fr, fq, lds, wid, lane); S.done(cur); }
#undef PG8_SA
#undef PG8_SB
#undef PG8_STAGE
#undef PG8_LDA
#undef PG8_LDB
#undef PG8_MMA
#undef PG8_WAIT_V
#undef PG8_WAIT_L
#undef PG8_BAR
#undef PG8_SCHED
}
}

#ifndef PG8_SP2
#define PG8_SP2 true
#endif
#ifndef PG8_ALIGN
#define PG8_ALIGN true
#endif
constexpr int NWAVES = 8, NTHR = 512;
constexpr int BATCH = 2, SEQ = 8192, DM = 4096, MTOK = BATCH * SEQ;
constexpr int HD = 128;
constexpr int A_HEADS = 16, B_HEADS = 16, A_W = 2048, B_W = 2048, AB_IN = 4 * A_W + 3 * B_W;
constexpr int NSA_H = 32, NSA_G = 4, NSA_R = 8, KVW = 512, NSA_IN = 4096 + 6 * KVW + 96, NSA_INP = 7424;
constexpr int NCMP = 511, NCMPP = 512, NSLC = 128, NTOP = 16, WINDOW = 512;
constexpr int NMEM = 256, XH = 4, XW = 512;
constexpr int DFF = 11008, DFF2 = 22016;
constexpr float LN_EPS = 1e-5f, RMS_EPS = 1e-6f;
constexpr float DN_ALPHA = 1.41421356237309515f;
constexpr size_t MiB = (size_t)1 << 20;
constexpr size_t WS_CTL = 0, CTL_ZERO_BYTES = 4 * MiB;
constexpr size_t WS_FOLD = 64 * 1024;
constexpr int FO_XQ = 0, FO_UP = 2 * 512, FO_NSA = FO_UP + 2 * 22016, FO_N = FO_NSA + 7424;
constexpr size_t WS_RSUM = 1 * MiB;
static_assert(WS_FOLD + (size_t)2 * FO_N * 8 <= WS_RSUM && WS_RSUM + (size_t)6 * 16384 * 2 * 8 <= CTL_ZERO_BYTES, "CTL map");
constexpr size_t WS_W_ABIN = 4 * MiB;
constexpr size_t WS_W_ABOUT = WS_W_ABIN + 112 * MiB;
constexpr size_t WS_W_NSAIN = WS_W_ABOUT + 32 * MiB;
constexpr size_t WS_W_NSAOUT = WS_W_NSAIN + 58 * MiB;
constexpr size_t WS_W_XQ = WS_W_NSAOUT + 32 * MiB;
constexpr size_t WS_W_XKV = WS_W_XQ + 8 * MiB;
constexpr size_t WS_W_XO = WS_W_XKV + 16 * MiB;
constexpr size_t WS_W_UP = WS_W_XO + 8 * MiB;
constexpr size_t WS_W_DOWN = WS_W_UP + 344 * MiB;
constexpr size_t WS_W_C1 = WS_W_DOWN + 172 * MiB;
constexpr size_t WS_W_C2 = WS_W_C1 + 2 * MiB;
constexpr size_t WS_MEMB = WS_W_C2 + 1 * MiB;
constexpr size_t WS_HB = WS_MEMB + 4 * MiB;
constexpr size_t WS_Y = WS_HB + 128 * MiB;
constexpr size_t WS_BIG = WS_Y + 256 * MiB;
constexpr size_t WS_G = WS_BIG + 688 * MiB;
constexpr size_t WS_O = WS_G + 344 * MiB;
constexpr size_t WS_MISC = WS_O + 128 * MiB;
constexpr size_t WS_END = WS_MISC + 64 * MiB;
constexpr size_t WS_XQ = WS_MISC;
constexpr size_t WS_XO = WS_MISC + 16 * MiB;
constexpr size_t WS_XKV = WS_MISC + 32 * MiB;
constexpr size_t WS_LB = WS_MISC + 34 * MiB;
constexpr size_t WS_ROPE = WS_MISC + 36 * MiB;
constexpr size_t WS_STATS = WS_MISC + 35 * MiB;
constexpr size_t WS_PROJ0 = WS_BIG;
constexpr size_t WS_SPREV = WS_BIG + 448 * MiB;
constexpr size_t WS_QT = WS_G;
constexpr size_t WS_OINTRA = WS_G + 64 * MiB;
constexpr size_t WS_DEC = WS_G + 192 * MiB;
constexpr size_t WS_DS = WS_Y;
constexpr size_t WS_PROJ1 = WS_BIG;
constexpr size_t WS_QROT = WS_BIG + 232 * MiB;
constexpr size_t WS_KSROT = WS_BIG + 360 * MiB;
constexpr size_t WS_KWROT = WS_BIG + 376 * MiB;
constexpr size_t WS_KCMP = WS_BIG + 392 * MiB;
constexpr size_t WS_VCMP = WS_BIG + 393 * MiB;
constexpr size_t WS_OVL = WS_BIG + 394 * MiB;
constexpr size_t WS_SEL = WS_BIG + 395 * MiB;
constexpr size_t WS_IMP = WS_G + 256 * MiB;
constexpr size_t WS_O32 = WS_G;
static_assert(WS_SPREV + 128 * MiB <= WS_G && WS_DEC + 2 * MiB <= WS_O && WS_SEL + MiB <= WS_G, "ws map");
constexpr int CW_TMO = 0, CW_CODE = 1;
constexpr int CW_BAR = 4096;
constexpr int RING_OFF = 0, RING_BYTES = 131072;
constexpr int LDSCTL_OFF = RING_BYTES, MISC_OFF = LDSCTL_OFF + 320;
constexpr int LDS_BYTES = 147456;
static_assert(MISC_OFF + 128 <= LDS_BYTES, "LDS map");

#define GAS __attribute__((address_space(1)))
#define LAS __attribute__((address_space(3)))
typedef unsigned short bf16;
typedef unsigned v4u __attribute__((ext_vector_type(4)));
typedef unsigned v2u __attribute__((ext_vector_type(2)));
typedef float f32x4 __attribute__((ext_vector_type(4)));
typedef float f32x2 __attribute__((ext_vector_type(2)));
typedef float f32x16 __attribute__((ext_vector_type(16)));
typedef short bf16x8 __attribute__((ext_vector_type(8)));
typedef short s16x4 __attribute__((ext_vector_type(4)));
typedef GAS unsigned gu32;
#define RLX_AGENT __ATOMIC_RELAXED, __HIP_MEMORY_SCOPE_AGENT
#define LDS_WAIT() asm volatile("s_waitcnt lgkmcnt(0)" ::: "memory")
#define VM_WAIT() asm volatile("s_waitcnt vmcnt(0)" ::: "memory")
#define SBAR() __builtin_amdgcn_sched_barrier(0)
__device__ __forceinline__ unsigned f2bf(float f) { unsigned u = __builtin_bit_cast(unsigned, f); return (u + 0x7fffu + ((u >> 16) & 1u)) >> 16; }
__device__ __forceinline__ unsigned pk2(float lo, float hi) { return f2bf(lo) | (f2bf(hi) << 16); }
__device__ __forceinline__ float bf2f(unsigned short b) { return __builtin_bit_cast(float, (unsigned)b << 16); }
__device__ __forceinline__ float bflo(unsigned w) { return __builtin_bit_cast(float, w << 16); }
__device__ __forceinline__ float bfhi(unsigned w) { return __builtin_bit_cast(float, w & 0xffff0000u); }
__device__ __forceinline__ unsigned cvtpk(float lo, float hi) { unsigned r; asm volatile("v_cvt_pk_bf16_f32 %0, %1, %2" : "=v"(r) : "v"(lo), "v"(hi)); return r; }
__device__ __forceinline__ float wave_sum(float v) {
#pragma unroll
    for (int o = 1; o < 64; o <<= 1) v += __shfl_xor(v, o);
    return v;
}
__device__ __forceinline__ float sigmoidf_(float x) { return __builtin_amdgcn_rcpf(1.f + __builtin_amdgcn_exp2f(-1.4426950408889634f * x)); }
__device__ __forceinline__ float gelu1(float v) { pg8::f32x2 r = pg8::gelu_pk((pg8::f32x2){v, 0.f}); return r.x; }
#define XB_TMO      128
#define XB_XCNT(j)  (256  + 64 * (j))
#define XB_XSUB(j)  (1280 + 64 * (j))
#define XB_XGEN(j)  (2304 + 64 * (j))
#define XB_TOP      3328
#define XB_TOPGEN   3392
#define XCD_BAR_WORDS 3456
#define XB_SPIN_CAP (1u << 18)
#define LAS __attribute__((address_space(3)))

__device__ __forceinline__ unsigned xb_ld(unsigned* p)              { return __hip_atomic_load(p, __ATOMIC_RELAXED, __HIP_MEMORY_SCOPE_AGENT); }
__device__ __forceinline__ unsigned xb_add(unsigned* p, unsigned v) { return __hip_atomic_fetch_add(p, v, __ATOMIC_RELAXED, __HIP_MEMORY_SCOPE_AGENT); }
__device__ __forceinline__ unsigned xb_xcc_id() { return (unsigned)__builtin_amdgcn_s_getreg((3 << 11) | 20) & 0xFu; }
#define XB_SPIN(cond, bar) do { unsigned _sp = 0; while (cond) { __builtin_amdgcn_s_sleep(1); \
    if ((++_sp & 255u) == 0u) { if (xb_ld(&(bar)[XB_TMO])) break; if (_sp > XB_SPIN_CAP) { atomicAdd(&(bar)[XB_TMO], 1u); break; } } } } while (0)

struct XcdBarrier {
    unsigned* bar; unsigned x;
    volatile LAS unsigned* st;
};

__device__ __forceinline__ XcdBarrier xcd_barrier_post(unsigned* bar, volatile LAS unsigned* st) {
    XcdBarrier b; b.bar = bar; b.x = xb_xcc_id(); b.st = st;
    if (threadIdx.x == 0) (void)xb_add(&bar[XB_XCNT(b.x)], 1u);
    return b;
}
__device__ __forceinline__ void xcd_barrier_complete(unsigned* bar, unsigned x, unsigned& nloc, unsigned& nx) {
    const unsigned G = gridDim.x * gridDim.y * gridDim.z;
    unsigned sum, cnt, mine, sp = 0u;
    for (;;) {
        sum = 0u; cnt = 0u; mine = 0u;
#pragma unroll
        for (unsigned j = 0; j < 16; ++j) { const unsigned c = xb_ld(&bar[XB_XCNT(j)]); sum += c; cnt += (c > 0u) ? 1u : 0u; mine = (j == x) ? c : mine; }
        if (sum == G) break;
        __builtin_amdgcn_s_sleep(1);
        if ((++sp & 255u) == 0u) { if (xb_ld(&bar[XB_TMO])) break; if (sp > XB_SPIN_CAP) { atomicAdd(&bar[XB_TMO], 1u); break; } }
    }
    nloc = mine > 0u ? mine : 1u; nx = cnt > 0u ? cnt : 1u;
}

__device__ __forceinline__ void xcd_barrier(const XcdBarrier& b) {
    asm volatile("s_waitcnt vmcnt(0)" ::: "memory");
    __syncthreads();
    if (threadIdx.x == 0) {
        unsigned* bar = b.bar;
        __builtin_amdgcn_s_waitcnt(0);
        unsigned nloc = b.st[0], nx = b.st[1];
        if (nloc == 0u) { xcd_barrier_complete(bar, b.x, nloc, nx); b.st[0] = nloc; b.st[1] = nx; }
        const unsigned old = xb_add(&bar[XB_XSUB(b.x)], 1u);
        const unsigned gen = old / nloc;
        if (old + 1u == (gen + 1u) * nloc) {
            __builtin_amdgcn_fence(__ATOMIC_RELEASE, "agent");
            asm volatile("s_waitcnt vmcnt(0)" ::: "memory");
            const unsigned og = xb_add(&bar[XB_TOP], 1u);
            const unsigned tg = og / nx;
            if (og + 1u == (tg + 1u) * nx) xb_add(&bar[XB_TOPGEN], 1u);
            else XB_SPIN(xb_ld(&bar[XB_TOPGEN]) == tg, bar);
            __builtin_amdgcn_fence(__ATOMIC_ACQUIRE, "agent");
            xb_add(&bar[XB_XGEN(b.x)], 1u);
            asm volatile("s_waitcnt vmcnt(0)" ::: "memory");
        } else {
            XB_SPIN(xb_ld(&bar[XB_XGEN(b.x)]) == gen, bar);
            __builtin_amdgcn_fence(__ATOMIC_ACQUIRE, "agent");
            asm volatile("s_waitcnt vmcnt(0)" ::: "memory");
        }
    }
    __syncthreads();
}


constexpr int ATT_D = 128, KVBLK = 64;
constexpr int SHM_V = KVBLK * ATT_D * 2, SHM_K = KVBLK * ATT_D * 2;
constexpr int ATT_K_OFF = 0, ATT_V_OFF = SHM_K, ATT_BUF = SHM_K + SHM_V, ATT_SET = 2 * ATT_BUF;
constexpr int ATT_WS_OFF = RING_BYTES + 512;
constexpr int ATT_X_OFF = ATT_WS_OFF + NWAVES * 256;
static_assert(2 * ATT_SET <= RING_BYTES && ATT_X_OFF + 1024 <= LDS_BYTES, "attention LDS map");
#define KSWZ(row, colB) ((row) * 256 + ((colB) ^ (((row) & 7) << 4)))
__device__ __forceinline__ int crow(int r, int hi) { return (r & 3) + 8 * (r >> 2) + 4 * hi; }
__device__ __forceinline__ int v_st(int k, int c) { const int kk = (k & ~0xC) | ((k & 4) << 1) | ((k & 8) >> 1); return ((kk >> 3) * 4 + (c >> 5)) * 512 + ((kk & 7) * 32 + (c & 31)) * 2; }
__device__ __forceinline__ int v_rd_base(int lane) { return ((lane & 3) << 3) | (((lane >> 2) & 3) << 6) | (((lane >> 4) & 1) << 5) | (((lane >> 5) & 1) << 8); }
constexpr int v_rd_off(int d0, int ks, int half) { return d0 * 512 + ks * 4096 + half * 2048; }
template <int OFF> __device__ __forceinline__ s16x4 tr_read(int vb) {
  s16x4 r; asm volatile("ds_read_b64_tr_b16 %0, %1 offset:%2" : "=&v"(r) : "v"(vb), "i"(OFF) : "memory"); return r;
}
__device__ __forceinline__ void qkt(f32x16& p0, f32x16& p1, const LAS char* Ks, const bf16x8* qr, int r32, int hi) {
  p0 = f32x16{}; p1 = f32x16{};
#pragma unroll
  for (int d0 = 0; d0 < 8; ++d0) { const int cb = (d0 * 16 + hi * 8) * 2;
    const bf16x8 b0 = *(const LAS bf16x8*)(Ks + KSWZ(r32, cb));
    const bf16x8 b1 = *(const LAS bf16x8*)(Ks + KSWZ(32 + r32, cb));
    p0 = __builtin_amdgcn_mfma_f32_32x32x16_bf16(b0, qr[d0], p0, 0, 0, 0);
    p1 = __builtin_amdgcn_mfma_f32_32x32x16_bf16(b1, qr[d0], p1, 0, 0, 0); }
}
__device__ __forceinline__ void pack_p(const f32x16& p0, const f32x16& p1, bf16x8& pa0, bf16x8& pa1, bf16x8& pa2, bf16x8& pa3) {
#define PK4(P, BASE, OUT) do { unsigned a0 = cvtpk(P[BASE + 0], P[BASE + 1]), a1 = cvtpk(P[BASE + 2], P[BASE + 3]);   \
    unsigned b0 = cvtpk(P[BASE + 4], P[BASE + 5]), b1 = cvtpk(P[BASE + 6], P[BASE + 7]);                              \
    auto r0 = __builtin_amdgcn_permlane32_swap(a0, b0, false, false); auto r1 = __builtin_amdgcn_permlane32_swap(a1, b1, false, false); \
    v4u w = {r0[0], r1[0], r0[1], r1[1]}; OUT = __builtin_bit_cast(bf16x8, w); } while (0)
  PK4(p0, 0, pa0); PK4(p0, 8, pa1); PK4(p1, 0, pa2); PK4(p1, 8, pa3);
#undef PK4
}
template <int D0> __device__ __forceinline__ void pv_one(f32x16& od, int vb, bf16x8 pa0, bf16x8 pa1, bf16x8 pa2, bf16x8 pa3) {
  const s16x4 l0 = tr_read<v_rd_off(D0, 0, 0)>(vb), h0 = tr_read<v_rd_off(D0, 0, 1)>(vb), l1 = tr_read<v_rd_off(D0, 1, 0)>(vb), h1 = tr_read<v_rd_off(D0, 1, 1)>(vb);
  const s16x4 l2 = tr_read<v_rd_off(D0, 2, 0)>(vb), h2 = tr_read<v_rd_off(D0, 2, 1)>(vb), l3 = tr_read<v_rd_off(D0, 3, 0)>(vb), h3 = tr_read<v_rd_off(D0, 3, 1)>(vb);
  asm volatile("s_waitcnt lgkmcnt(0)" ::: "memory"); SBAR();
#define PKV(L, H) (bf16x8){L[0], L[1], L[2], L[3], H[0], H[1], H[2], H[3]}
  od = __builtin_amdgcn_mfma_f32_32x32x16_bf16(pa0, PKV(l0, h0), od, 0, 0, 0);
  od = __builtin_amdgcn_mfma_f32_32x32x16_bf16(pa1, PKV(l1, h1), od, 0, 0, 0);
  od = __builtin_amdgcn_mfma_f32_32x32x16_bf16(pa2, PKV(l2, h2), od, 0, 0, 0);
  od = __builtin_amdgcn_mfma_f32_32x32x16_bf16(pa3, PKV(l3, h3), od, 0, 0, 0);
#undef PKV
}
__device__ __forceinline__ void pv_d0(f32x16* o, int vb, bf16x8 pa0, bf16x8 pa1, bf16x8 pa2, bf16x8 pa3) {
  pv_one<0>(o[0], vb, pa0, pa1, pa2, pa3); pv_one<1>(o[1], vb, pa0, pa1, pa2, pa3); pv_one<2>(o[2], vb, pa0, pa1, pa2, pa3); pv_one<3>(o[3], vb, pa0, pa1, pa2, pa3);
}
struct KVStage { bf16x8 ks0, ks1, vs0, vs1; };
__device__ __forceinline__ void kv_load(KVStage& s, const bf16* Kh, const bf16* Vh, long ldk, long ldv, int k0, int sr, int sc) {
  s.ks0 = *(const bf16x8*)(Kh + (long)(k0 + sr) * ldk + sc); s.ks1 = *(const bf16x8*)(Kh + (long)(k0 + 32 + sr) * ldk + sc);
  s.vs0 = *(const bf16x8*)(Vh + (long)(k0 + sr) * ldv + sc); s.vs1 = *(const bf16x8*)(Vh + (long)(k0 + 32 + sr) * ldv + sc);
}
__device__ __forceinline__ void kv_write(const KVStage& s, LAS char* lds, int sr, int sc) {
  *(LAS bf16x8*)(lds + ATT_V_OFF + v_st(sr, sc)) = s.vs0; *(LAS bf16x8*)(lds + ATT_V_OFF + v_st(32 + sr, sc)) = s.vs1;
  *(LAS bf16x8*)(lds + ATT_K_OFF + KSWZ(sr, sc * 2)) = s.ks0; *(LAS bf16x8*)(lds + ATT_K_OFF + KSWZ(32 + sr, sc * 2)) = s.ks1;
}
struct KVDma { int ko[2], vo[2]; };
__device__ __forceinline__ void kv_dma_init(KVDma& d, int ldk, int ldv, int wid, int lane) {
#pragma unroll
  for (int i = 0; i < 2; ++i) { const int p = wid * 2 + i;
    const int row = p * 4 + (lane >> 4), cp = lane & 15; d.ko[i] = row * ldk + ((cp ^ (row & 7)) << 3);
    const int sub = p * 2 + (lane >> 5), kk = (sub >> 2) * 8 + ((lane & 31) >> 2), k = (kk & ~0xC) | ((kk & 4) << 1) | ((kk & 8) >> 1), c = (sub & 3) * 32 + (lane & 3) * 8;
    d.vo[i] = k * ldv + c; }
}
__device__ __forceinline__ void kv_dma(const KVDma& d, const bf16* Kt, const bf16* Vt, LAS char* lds, int buf, int wid) {
#pragma unroll
  for (int i = 0; i < 2; ++i) {
    __builtin_amdgcn_global_load_lds((const unsigned*)(Kt + d.ko[i]), (LAS unsigned*)(lds + buf + ATT_K_OFF + (wid * 2 + i) * 1024), 16, 0, 0);
    __builtin_amdgcn_global_load_lds((const unsigned*)(Vt + d.vo[i]), (LAS unsigned*)(lds + buf + ATT_V_OFF + (wid * 2 + i) * 1024), 16, 0, 0); }
}
__device__ __forceinline__ void rescale_o(f32x16* o, float a, LAS float* al_l, int r32, int hi) {
  if (__any(a < 1.f)) { if (hi == 0) al_l[r32] = a; LDS_WAIT();
#pragma unroll
    for (int r = 0; r < 16; ++r) { const float f = al_l[crow(r, hi)];
#pragma unroll
      for (int d = 0; d < 4; ++d) o[d][r] *= f; }
    LDS_WAIT(); }
}
constexpr float ATT_SCALE = 0.088388347648318440f, ATT_C = ATT_SCALE * 1.4426950408889634f, ATT_THR = 8.f;
__device__ __forceinline__ void softmax_tile(f32x16& p0, f32x16& p1, float& m_reg, float& l_reg, float& alpha) {
  float pmax = p0[0];
#pragma unroll
  for (int r = 1; r < 16; ++r) pmax = fmaxf(pmax, p0[r]);
#pragma unroll
  for (int r = 0; r < 16; ++r) pmax = fmaxf(pmax, p1[r]);
  { auto rr = __builtin_amdgcn_permlane32_swap(__float_as_uint(pmax), __float_as_uint(pmax), false, false);
    pmax = fmaxf(__uint_as_float(rr[0]), __uint_as_float(rr[1])); }
  float mn;
  if (__all(pmax - m_reg <= ATT_THR / ATT_SCALE)) { mn = m_reg; alpha = 1.f; }
  else { mn = fmaxf(m_reg, pmax); alpha = __builtin_amdgcn_exp2f((m_reg - mn) * ATT_C); m_reg = mn; }
  const float mnC = -mn * ATT_C;
#pragma unroll
  for (int r = 0; r < 16; ++r) { p0[r] = __builtin_amdgcn_exp2f(fmaf(p0[r], ATT_C, mnC)); p1[r] = __builtin_amdgcn_exp2f(fmaf(p1[r], ATT_C, mnC)); }
  float ps = 0.f;
#pragma unroll
  for (int r = 0; r < 16; ++r) ps += p0[r] + p1[r];
  { auto rr = __builtin_amdgcn_permlane32_swap(__float_as_uint(ps), __float_as_uint(ps), false, false);
    ps = __uint_as_float(rr[0]) + __uint_as_float(rr[1]); }
  l_reg = l_reg * alpha + ps;
}
__device__ __forceinline__ void attn_finish(f32x16& p0, f32x16& p1, f32x16* o, float& m_reg, float& l_reg, LAS float* wsc, int vb, int r32, int hi) {
  float alpha; softmax_tile(p0, p1, m_reg, l_reg, alpha);
  rescale_o(o, alpha, wsc, r32, hi);
  bf16x8 pa0, pa1, pa2, pa3; pack_p(p0, p1, pa0, pa1, pa2, pa3);
  pv_d0(o, vb, pa0, pa1, pa2, pa3);
}
__device__ __forceinline__ void load_q(bf16x8* qr, const bf16* Qw) {
#pragma unroll
  for (int d0 = 0; d0 < 8; ++d0) qr[d0] = *(const bf16x8*)(Qw + d0 * 16);
}

struct Frame {
    LAS unsigned char* lds;
    unsigned char* ws;
    int tid, lane, wave, G, bid;
    __device__ __forceinline__ void fresh() { int t = threadIdx.x; asm volatile("" : "+v"(t)); tid = t; lane = t & 63; wave = __builtin_amdgcn_readfirstlane(t >> 6);
        int g_ = gridDim.x, b_ = blockIdx.x; asm volatile("" : "+s"(g_), "+s"(b_)); G = g_; bid = b_; }
};
struct Args { const float* in[19]; float* out; unsigned char* ws; int ph_lo, ph_hi; };
enum { IN_X = 0, IN_MEM, IN_AB_W_IN, IN_HGRN_LB, IN_HGRN_NW, IN_AB_W_OUT, IN_NSA_W_IN, IN_NSA_CMP_POS, IN_NSA_CMP_W1, IN_NSA_CMP_W2, IN_NSA_W_OUT,
       IN_XA_WQ, IN_XA_WKV, IN_XA_WO, IN_FFN_UP, IN_FFN_CONV, IN_FFN_DOWN, IN_LN_G, IN_LN_B };

__device__ __forceinline__ void p0_transpose_item(const float* W, int K, int N, bf16* WT, LAS float* scr, int item, int lane) {
    const int nblk = N / 32, kb = item / nblk, nb = item % nblk, k0 = 64 * kb, n0 = 32 * nb;
#pragma unroll 8
    for (int i = 0; i < 32; ++i) { const int kk = 2 * i + (lane >> 5); scr[kk * 33 + (lane & 31)] = W[(size_t)(k0 + kk) * N + n0 + (lane & 31)]; }
    LDS_WAIT(); asm volatile("" ::: "memory");
    const int c = lane & 7;
#pragma unroll
    for (int j = 0; j < 4; ++j) { const int n = (lane >> 3) + 8 * j; const LAS float* s = scr + (8 * c) * 33 + n;
        v4u o; o.x = pk2(s[0 * 33], s[1 * 33]); o.y = pk2(s[2 * 33], s[3 * 33]); o.z = pk2(s[4 * 33], s[5 * 33]); o.w = pk2(s[6 * 33], s[7 * 33]);
        *(GAS v4u*)(WT + (size_t)(n0 + n) * K + k0 + 8 * c) = o; }
    LDS_WAIT(); asm volatile("" ::: "memory");
}
__device__ __forceinline__ void p0_transpose_item_fold(const float* W, int K, int N, bf16* WT, LAS float* scr, int item, int lane, const float* g, const float* b, long long* cs, long long* b2) {
    const int nblk = N / 32, kb = item / nblk, nb = item % nblk, k0 = 64 * kb, n0 = 32 * nb;
#pragma unroll 8
    for (int i = 0; i < 32; ++i) { const int kk = 2 * i + (lane >> 5); scr[kk * 33 + (lane & 31)] = W[(size_t)(k0 + kk) * N + n0 + (lane & 31)]; }
    LDS_WAIT(); asm volatile("" ::: "memory");
    const int c = lane & 7;
    const f32x4 g0 = *(const f32x4*)(g + k0 + 8 * c), g1 = *(const f32x4*)(g + k0 + 8 * c + 4), b0 = *(const f32x4*)(b + k0 + 8 * c), b1 = *(const f32x4*)(b + k0 + 8 * c + 4);
    const float gg[8] = {g0.x, g0.y, g0.z, g0.w, g1.x, g1.y, g1.z, g1.w}, bb[8] = {b0.x, b0.y, b0.z, b0.w, b1.x, b1.y, b1.z, b1.w};
#pragma unroll
    for (int j = 0; j < 4; ++j) { const int n = (lane >> 3) + 8 * j; const LAS float* s = scr + (8 * c) * 33 + n;
        float sc = 0.f, sb = 0.f; unsigned w[4];
#pragma unroll
        for (int q = 0; q < 4; ++q) { const float x0 = s[(2 * q) * 33], x1 = s[(2 * q + 1) * 33]; const unsigned r0 = f2bf(x0 * gg[2 * q]), r1 = f2bf(x1 * gg[2 * q + 1]);
            w[q] = r0 | (r1 << 16); sc += bf2f((unsigned short)r0) + bf2f((unsigned short)r1); sb += x0 * bb[2 * q] + x1 * bb[2 * q + 1]; }
        *(GAS v4u*)(WT + (size_t)(n0 + n) * K + k0 + 8 * c) = (v4u){w[0], w[1], w[2], w[3]};
        sc += __shfl_xor(sc, 1); sc += __shfl_xor(sc, 2); sc += __shfl_xor(sc, 4); sb += __shfl_xor(sb, 1); sb += __shfl_xor(sb, 2); sb += __shfl_xor(sb, 4);
        if (c == 0) { atomicAdd((unsigned long long*)(cs + n0 + n), (unsigned long long)(long long)rintf(sc * pg8::FOLD_SCALE)); atomicAdd((unsigned long long*)(b2 + n0 + n), (unsigned long long)(long long)rintf(sb * pg8::FOLD_SCALE)); } }
    LDS_WAIT(); asm volatile("" ::: "memory");
}
__device__ __forceinline__ void transpose_mat_fold(Frame& F, const float* W, int K, int N, bf16* WT, const float* g, const float* b, long long* cs, long long* b2) {
    LAS float* scr = (LAS float*)(F.lds + RING_OFF + F.wave * 16384);
    const int gw = F.bid * NWAVES + F.wave, NGW = F.G * NWAVES;
    const int nitems = (K / 64) * (N / 32);
    for (int it = gw; it < nitems; it += NGW) p0_transpose_item_fold(W, K, N, WT, scr, it, F.lane, g, b, cs, b2);
}
__device__ __forceinline__ void transpose_mat(Frame& F, const float* W, int K, int N, bf16* WT) {
    LAS float* scr = (LAS float*)(F.lds + RING_OFF + F.wave * 16384);
    const int gw = F.bid * NWAVES + F.wave, NGW = F.G * NWAVES;
    const int nitems = (K / 64) * (N / 32);
    for (int it = gw; it < nitems; it += NGW) p0_transpose_item(W, K, N, WT, scr, it, F.lane);
}
__device__ __forceinline__ void cvt_flat(Frame& F, const float* src, bf16* dst, long n8) {
    for (long i = (long)F.bid * NTHR + F.tid; i < n8; i += (long)F.G * NTHR) {
        const f32x4 a = *(const f32x4*)(src + i * 8), b = *(const f32x4*)(src + i * 8 + 4);
        v4u o; o.x = pk2(a.x, a.y); o.y = pk2(a.z, a.w); o.z = pk2(b.x, b.y); o.w = pk2(b.z, b.w);
        *(v4u*)(dst + i * 8) = o; }
}
__device__ __forceinline__ void p0_prologue(Frame& F, const Args& A) {
    unsigned char* ws = F.ws;
    transpose_mat(F, A.in[IN_AB_W_IN], DM, AB_IN, (bf16*)(ws + WS_W_ABIN));
    transpose_mat(F, A.in[IN_AB_W_OUT], DM, DM, (bf16*)(ws + WS_W_ABOUT));
    long long* cs = (long long*)(ws + WS_FOLD); long long* b2 = cs + FO_N;
    transpose_mat_fold(F, A.in[IN_NSA_W_IN], DM, NSA_IN, (bf16*)(ws + WS_W_NSAIN), A.in[IN_LN_G] + 2 * DM, A.in[IN_LN_B] + 2 * DM, cs + FO_NSA, b2 + FO_NSA);
    transpose_mat(F, A.in[IN_NSA_W_OUT], DM, DM, (bf16*)(ws + WS_W_NSAOUT));
    for (int l = 0; l < 2; ++l) {
        transpose_mat_fold(F, A.in[IN_XA_WQ] + (size_t)l * DM * XW, DM, XW, (bf16*)(ws + WS_W_XQ) + (size_t)l * XW * DM, A.in[IN_LN_G] + (size_t)(3 * l) * DM, A.in[IN_LN_B] + (size_t)(3 * l) * DM, cs + FO_XQ + l * XW, b2 + FO_XQ + l * XW);
        transpose_mat(F, A.in[IN_XA_WKV] + (size_t)l * DM * 2 * XW, DM, 2 * XW, (bf16*)(ws + WS_W_XKV) + (size_t)l * 2 * XW * DM);
        transpose_mat(F, A.in[IN_XA_WO] + (size_t)l * XW * DM, XW, DM, (bf16*)(ws + WS_W_XO) + (size_t)l * DM * XW);
        transpose_mat_fold(F, A.in[IN_FFN_UP] + (size_t)l * DM * DFF2, DM, DFF2, (bf16*)(ws + WS_W_UP) + (size_t)l * DFF2 * DM, A.in[IN_LN_G] + (size_t)(3 * l + 1) * DM, A.in[IN_LN_B] + (size_t)(3 * l + 1) * DM, cs + FO_UP + l * DFF2, b2 + FO_UP + l * DFF2);
        transpose_mat(F, A.in[IN_FFN_DOWN] + (size_t)l * DFF * DM, DFF, DM, (bf16*)(ws + WS_W_DOWN) + (size_t)l * DM * DFF);
        transpose_mat(F, A.in[IN_NSA_CMP_W1] + (size_t)l * 32 * HD * HD, 32 * HD, HD, (bf16*)(ws + WS_W_C1) + (size_t)l * HD * 32 * HD);
        transpose_mat(F, A.in[IN_NSA_CMP_W2] + (size_t)l * HD * HD, HD, HD, (bf16*)(ws + WS_W_C2) + (size_t)l * HD * HD);
    }
    cvt_flat(F, A.in[IN_X], (bf16*)(ws + WS_HB), (long)MTOK * DM / 8);
    cvt_flat(F, A.in[IN_MEM], (bf16*)(ws + WS_MEMB), (long)BATCH * NMEM * DM / 8);
    { v4u z = {0u, 0u, 0u, 0u}; v4u* p = (v4u*)((bf16*)(ws + WS_W_NSAIN) + (size_t)NSA_IN * DM); const long n = (long)(NSA_INP - NSA_IN) * DM / 8;
      for (long i = (long)F.bid * NTHR + F.tid; i < n; i += (long)F.G * NTHR) p[i] = z; }
    { float* tab = (float*)(ws + WS_ROPE);
      for (int i = F.bid * NTHR + F.tid; i < SEQ * 64; i += F.G * NTHR) { const int t = i >> 6, d = i & 63;
          float sn, cs; sincosf((float)t * powf(10000.0f, -(float)d * (1.0f / 64.0f)), &sn, &cs); tab[(size_t)t * 128 + d] = cs; tab[(size_t)t * 128 + 64 + d] = sn; } }
    { const float* lbp = A.in[IN_HGRN_LB]; float* lbo = (float*)(ws + WS_LB);
      for (int i = F.bid * NTHR + F.tid; i < A_W; i += F.G * NTHR) { const float a = lbp[i], b = lbp[A_W + i], m = fmaxf(a, b), ea = __expf(a - m), eb = __expf(b - m); lbo[i] = ea / (ea + eb); } }
}

__device__ __forceinline__ void ln_phase(Frame& F, const bf16* Y, const float* g, const float* b, float* h32) {
    const int gw = F.bid * NWAVES + F.wave, NGW = F.G * NWAVES;
    for (int m = gw; m < MTOK; m += NGW) {
        const v4u* yr = (const v4u*)(Y + (size_t)m * DM) + F.lane;
        float v[8][8]; float s = 0.f;
#pragma unroll
        for (int j = 0; j < 8; ++j) { const v4u x = yr[64 * j];
            v[j][0] = bflo(x.x); v[j][1] = bfhi(x.x); v[j][2] = bflo(x.y); v[j][3] = bfhi(x.y); v[j][4] = bflo(x.z); v[j][5] = bfhi(x.z); v[j][6] = bflo(x.w); v[j][7] = bfhi(x.w);
#pragma unroll
            for (int q = 0; q < 8; ++q) s += v[j][q]; }
        const float mean = wave_sum(s) * (1.f / DM); float s2 = 0.f;
#pragma unroll
        for (int j = 0; j < 8; ++j)
#pragma unroll
            for (int q = 0; q < 8; ++q) { v[j][q] -= mean; s2 += v[j][q] * v[j][q]; }
        const float rstd = 1.f / sqrtf(wave_sum(s2) * (1.f / DM) + LN_EPS);
#pragma unroll
        for (int j = 0; j < 8; ++j) { const int c0 = 8 * F.lane + 512 * j;
            const f32x4 g0 = *(const f32x4*)(g + c0), g1 = *(const f32x4*)(g + c0 + 4), b0 = *(const f32x4*)(b + c0), b1 = *(const f32x4*)(b + c0 + 4);
            f32x4 r0, r1;
            r0.x = v[j][0] * rstd * g0.x + b0.x; r0.y = v[j][1] * rstd * g0.y + b0.y; r0.z = v[j][2] * rstd * g0.z + b0.z; r0.w = v[j][3] * rstd * g0.w + b0.w;
            r1.x = v[j][4] * rstd * g1.x + b1.x; r1.y = v[j][5] * rstd * g1.y + b1.y; r1.z = v[j][6] * rstd * g1.z + b1.z; r1.w = v[j][7] * rstd * g1.w + b1.w;
            *(f32x4*)(h32 + (size_t)m * DM + c0) = r0; *(f32x4*)(h32 + (size_t)m * DM + c0 + 4) = r1; }
    }
}

__device__ __forceinline__ void convglu_phase(Frame& F, const bf16* UP, const float* cw, bf16* Gm) {
    constexpr int NCG = DFF / 8, RB = 16, NRB = MTOK / RB;
    const long nitems = (long)NCG * NRB;
    for (long it = (long)F.bid * NTHR + F.tid; it < nitems; it += (long)F.G * NTHR) {
        const int cg = (int)(it % NCG), rb = (int)(it / NCG), c0 = cg * 8, t0 = rb * RB;
        float w0[8], w1[8], w2[8];
#pragma unroll
        for (int j = 0; j < 8; ++j) { w0[j] = cw[c0 + j]; w1[j] = cw[DFF + c0 + j]; w2[j] = cw[2 * DFF + c0 + j]; }
        float am2[8], am1[8];
        if ((t0 & (SEQ - 1)) == 0) {
#pragma unroll
            for (int j = 0; j < 8; ++j) { am2[j] = 0.f; am1[j] = 0.f; }
        } else {
            const v4u x2 = *(const v4u*)(UP + (size_t)(t0 - 2) * DFF2 + c0), x1 = *(const v4u*)(UP + (size_t)(t0 - 1) * DFF2 + c0);
            am2[0] = bflo(x2.x); am2[1] = bfhi(x2.x); am2[2] = bflo(x2.y); am2[3] = bfhi(x2.y); am2[4] = bflo(x2.z); am2[5] = bfhi(x2.z); am2[6] = bflo(x2.w); am2[7] = bfhi(x2.w);
            am1[0] = bflo(x1.x); am1[1] = bfhi(x1.x); am1[2] = bflo(x1.y); am1[3] = bfhi(x1.y); am1[4] = bflo(x1.z); am1[5] = bfhi(x1.z); am1[6] = bflo(x1.w); am1[7] = bfhi(x1.w);
        }
#pragma unroll 4
        for (int r = 0; r < RB; ++r) {
            const size_t row = (size_t)(t0 + r);
            const v4u xa = *(const v4u*)(UP + row * DFF2 + c0), xu = *(const v4u*)(UP + row * DFF2 + DFF + c0);
            float a[8], u[8];
            a[0] = bflo(xa.x); a[1] = bfhi(xa.x); a[2] = bflo(xa.y); a[3] = bfhi(xa.y); a[4] = bflo(xa.z); a[5] = bfhi(xa.z); a[6] = bflo(xa.w); a[7] = bfhi(xa.w);
            u[0] = bflo(xu.x); u[1] = bfhi(xu.x); u[2] = bflo(xu.y); u[3] = bfhi(xu.y); u[4] = bflo(xu.z); u[5] = bfhi(xu.z); u[6] = bflo(xu.w); u[7] = bfhi(xu.w);
            float o[8];
#pragma unroll
            for (int j = 0; j < 8; j += 2) {
                const float c0v = w2[j] * a[j] + w1[j] * am1[j] + w0[j] * am2[j], c1v = w2[j + 1] * a[j + 1] + w1[j + 1] * am1[j + 1] + w0[j + 1] * am2[j + 1];
                const pg8::f32x2 gg = pg8::gelu_pk((pg8::f32x2){c0v, c1v}); o[j] = gg.x * u[j]; o[j + 1] = gg.y * u[j + 1]; }
            v4u w; w.x = pk2(o[0], o[1]); w.y = pk2(o[2], o[3]); w.z = pk2(o[4], o[5]); w.w = pk2(o[6], o[7]);
            *(v4u*)(Gm + row * DFF + c0) = w;
#pragma unroll
            for (int j = 0; j < 8; ++j) { am2[j] = am1[j]; am1[j] = a[j]; }
        }
    }
}

__device__ __forceinline__ void xattn_phase(Frame& F, const bf16* XQ, const bf16* XKV, bf16* XO) {
    const int tid = F.tid, wid = F.wave, lane = F.lane, r32 = lane & 31, hi = lane >> 5;
    LAS char* lds = (LAS char*)F.lds;
    LAS float* wsc = (LAS float*)(lds + ATT_WS_OFF + wid * 256);
    const int vb0 = (int)(uintptr_t)(lds + ATT_V_OFF) + v_rd_base(lane);
    KVDma dm; kv_dma_init(dm, 2 * XW, 2 * XW, wid, lane);
    constexpr int NU = (MTOK / 256) * XH;
    for (int u = F.bid; u < NU; u += F.G) {
        const int head = u % XH, rbk = u / XH, row0 = rbk * 256, b = row0 / SEQ;
        const bf16* Kh = XKV + (size_t)b * NMEM * 2 * XW + head * HD; const bf16* Vh = Kh + XW;
        bf16x8 qr[8]; load_q(qr, XQ + (size_t)(row0 + wid * 32 + r32) * XW + head * HD + hi * 8);
        float m_reg = -1e30f, l_reg = 0.f; f32x16 o[4] = {};
        __syncthreads();
        kv_dma(dm, Kh, Vh, lds, 0, wid);
        for (int j = 0; j < NMEM / KVBLK; ++j) {
            const int buf = (j & 1) * ATT_BUF;
            VM_WAIT(); __syncthreads();
            if (j + 1 < NMEM / KVBLK) kv_dma(dm, Kh + (size_t)(j + 1) * KVBLK * 2 * XW, Vh + (size_t)(j + 1) * KVBLK * 2 * XW, lds, ATT_BUF - buf, wid);
            f32x16 p0, p1; qkt(p0, p1, lds + buf + ATT_K_OFF, qr, r32, hi);
            float alpha; softmax_tile(p0, p1, m_reg, l_reg, alpha);
            rescale_o(o, alpha, wsc, r32, hi);
            bf16x8 pa0, pa1, pa2, pa3; pack_p(p0, p1, pa0, pa1, pa2, pa3);
            pv_d0(o, vb0 + buf, pa0, pa1, pa2, pa3);
        }
        if (hi == 0) wsc[32 + r32] = l_reg; LDS_WAIT();
        bf16* Ow = XO + (size_t)(row0 + wid * 32) * XW + head * HD;
#pragma unroll
        for (int r = 0; r < 16; ++r) { const int orow = crow(r, hi); const float rl = __builtin_amdgcn_rcpf(wsc[32 + orow]);
#pragma unroll
            for (int d0 = 0; d0 < 4; ++d0) Ow[(size_t)orow * XW + d0 * 32 + r32] = (bf16)f2bf(o[d0][r] * rl); }
        LDS_WAIT();
    }
}

template <int K>
__device__ __forceinline__ f32x4 mma_tile(const LAS char* A, int lda, const LAS char* B, int ldb, int fr, int fq) {
    f32x4 acc = {0.f, 0.f, 0.f, 0.f};
#pragma unroll
    for (int k0 = 0; k0 < K; k0 += 32) {
        const bf16x8 a = *(const LAS bf16x8*)(A + fr * lda + (k0 + 8 * fq) * 2);
        const bf16x8 b = *(const LAS bf16x8*)(B + fr * ldb + (k0 + 8 * fq) * 2);
        acc = __builtin_amdgcn_mfma_f32_16x16x32_bf16(a, b, acc, 0, 0, 0);
    }
    return acc;
}
constexpr int HG_CH = 64, HG_NC = SEQ / HG_CH, HG_ITEMS = BATCH * A_HEADS * HG_NC;
constexpr int HG_QT = 0, HG_KT = 17408, HG_KH = 34816, HG_VT = 53248, HG_PT = 71680, HG_SEG = 80896;
constexpr int HG_SP = 17408, HG_OT = 52224;
__device__ __forceinline__ void hgrn_phase_a(Frame& F, const bf16* P0, const float* lbv, bf16* QTg, bf16* OINTRA, bf16* DS, float* DEC) {
    LAS char* lds = (LAS char*)F.lds;
    const int tid = F.tid, wid = F.wave, lane = F.lane, fr = lane & 15, fq = lane >> 4;
    const int d = tid & 127, sq = tid >> 7;
    for (int it = F.bid; it < HG_ITEMS; it += F.G) {
        const int c = it % HG_NC, bh = it / HG_NC, h = bh % A_HEADS, b = bh / A_HEADS;
        const size_t row0 = (size_t)b * SEQ + (size_t)c * HG_CH;
        const float lb = lbv[h * HD + d], omlb = 1.f - lb;
        float cum[16], kk[16];
        { float run = 0.f;
#pragma unroll
          for (int j = 0; j < 16; ++j) { const float z = bf2f(P0[(row0 + 16 * sq + j) * AB_IN + A_W + h * HD + d]); const float sg = sigmoidf_(z);
              run += __logf(lb + omlb * sg); cum[j] = run; kk[j] = omlb * (1.f - sg); }
          ((LAS float*)(lds + HG_SEG))[sq * 128 + d] = run; }
        LDS_WAIT(); __syncthreads();
        float base = 0.f, total = 0.f;
#pragma unroll
        for (int q = 0; q < 4; ++q) { const float sgm = ((LAS float*)(lds + HG_SEG))[q * 128 + d]; total += sgm; if (q < sq) base += sgm; }
        unsigned kh[8], vt[8];
#pragma unroll
        for (int j = 0; j < 16; j += 2) {
            float e[2][3]; unsigned short vr[2];
#pragma unroll
            for (int jj = 0; jj < 2; ++jj) { const int s = 16 * sq + j + jj; const float bb = base + cum[j + jj];
                const float q = bf2f(P0[(row0 + s) * AB_IN + h * HD + d]); vr[jj] = P0[(row0 + s) * AB_IN + 2 * A_W + h * HD + d];
                const float qt = q * __expf(bb), kt = kk[j + jj] * __expf(-bb), kht = kk[j + jj] * __expf(total - bb);
                const unsigned short qb16 = (unsigned short)f2bf(qt);
                *(LAS unsigned short*)(lds + HG_QT + s * 272 + d * 2) = qb16; QTg[(row0 + s) * A_W + h * HD + d] = qb16;
                *(LAS unsigned short*)(lds + HG_KT + s * 272 + d * 2) = (unsigned short)f2bf(kt);
                e[jj][0] = kht; }
            kh[j >> 1] = pk2(e[0][0], e[1][0]); vt[j >> 1] = (unsigned)vr[0] | ((unsigned)vr[1] << 16);
        }
        { LAS v4u* pk = (LAS v4u*)(lds + HG_KH + d * 144 + sq * 32); pk[0] = (v4u){kh[0], kh[1], kh[2], kh[3]}; pk[1] = (v4u){kh[4], kh[5], kh[6], kh[7]};
          LAS v4u* pv = (LAS v4u*)(lds + HG_VT + d * 144 + sq * 32); pv[0] = (v4u){vt[0], vt[1], vt[2], vt[3]}; pv[1] = (v4u){vt[4], vt[5], vt[6], vt[7]}; }
        if (sq == 3) DEC[(size_t)it * HD + d] = __expf(total);
        LDS_WAIT(); __syncthreads();
#pragma unroll
        for (int k = 0; k < 2; ++k) { const int tau = 2 * wid + k, ti = tau >> 2, si = tau & 3;
            f32x4 acc = {0.f, 0.f, 0.f, 0.f};
            if (si <= ti) acc = mma_tile<128>(lds + HG_QT + ti * 16 * 272, 272, lds + HG_KT + si * 16 * 272, 272, fr, fq);
#pragma unroll
            for (int i = 0; i < 4; ++i) { const int t = 16 * ti + 4 * fq + i, s = 16 * si + fr; const float v = (s <= t) ? acc[i] : 0.f;
                *(LAS unsigned short*)(lds + HG_PT + t * 144 + s * 2) = (unsigned short)f2bf(v); } }
        LDS_WAIT(); __syncthreads();
#pragma unroll
        for (int k = 0; k < 4; ++k) { const int tau = wid + 8 * k, ti = tau >> 3, vi = tau & 7;
            const f32x4 acc = mma_tile<64>(lds + HG_VT + vi * 16 * 144, 144, lds + HG_PT + ti * 16 * 144, 144, fr, fq);
            v2u w; w.x = pk2(acc[0], acc[1]); w.y = pk2(acc[2], acc[3]);
            *(v2u*)(OINTRA + (row0 + 16 * ti + fr) * A_W + h * HD + 16 * vi + 4 * fq) = w; }
#pragma unroll
        for (int k = 0; k < 8; ++k) { const int tau = wid + 8 * k, vi = tau >> 3, ki = tau & 7;
            const f32x4 acc = mma_tile<64>(lds + HG_KH + ki * 16 * 144, 144, lds + HG_VT + vi * 16 * 144, 144, fr, fq);
            v2u w; w.x = pk2(acc[0], acc[1]); w.y = pk2(acc[2], acc[3]);
            *(v2u*)(DS + ((size_t)it * HD + 16 * vi + fr) * HD + 16 * ki + 4 * fq) = w; }
        LDS_WAIT(); __syncthreads();
    }
}
__device__ __forceinline__ void hgrn_phase_b(Frame& F, const bf16* DS, const float* DEC, bf16* SPREV) {
    const int tid = F.tid, dvl = tid >> 5, dk4 = (tid & 31) * 4;
    for (int item = F.bid; item < BATCH * A_HEADS * 8; item += F.G) {
        const int sl = item & 7, bh = item >> 3, dv = sl * 16 + dvl;
        f32x4 S = {0.f, 0.f, 0.f, 0.f};
        for (int c0 = 0; c0 < HG_NC; c0 += 8) {
            f32x4 ds[8], dc[8];
#pragma unroll
            for (int k = 0; k < 8; ++k) { const size_t it = (size_t)bh * HG_NC + c0 + k; const v2u x = *(const v2u*)(DS + (it * HD + dv) * HD + dk4);
                ds[k] = (f32x4){bflo(x.x), bfhi(x.x), bflo(x.y), bfhi(x.y)}; dc[k] = *(const f32x4*)(DEC + it * HD + dk4); }
#pragma unroll
            for (int k = 0; k < 8; ++k) { const size_t it = (size_t)bh * HG_NC + c0 + k;
                v2u w; w.x = pk2(S.x, S.y); w.y = pk2(S.z, S.w); *(v2u*)(SPREV + (it * HD + dv) * HD + dk4) = w;
                S = S * dc[k] + ds[k]; }
        }
    }
}
__device__ __forceinline__ void hgrn_phase_c(Frame& F, const bf16* P0, const bf16* QTg, const bf16* OINTRA, const bf16* SPREV, const float* nw, bf16* Ob) {
    LAS char* lds = (LAS char*)F.lds;
    const int tid = F.tid, wid = F.wave, lane = F.lane, fr = lane & 15, fq = lane >> 4;
    for (int it = F.bid; it < HG_ITEMS; it += F.G) {
        const int c = it % HG_NC, bh = it / HG_NC, h = bh % A_HEADS, b = bh / A_HEADS;
        const size_t row0 = (size_t)b * SEQ + (size_t)c * HG_CH;
        { const int s = tid >> 3, ch = (tid & 7) * 16; const bf16* src = QTg + (row0 + s) * A_W + h * HD + ch;
          const v4u x0 = *(const v4u*)src, x1 = *(const v4u*)(src + 8); LAS v4u* dst = (LAS v4u*)(lds + HG_QT + s * 272 + ch * 2); dst[0] = x0; dst[1] = x1; }
        { const int dv = tid >> 2, ch = (tid & 3) * 32; const bf16* src = SPREV + ((size_t)it * HD + dv) * HD + ch;
          const v4u x0 = *(const v4u*)src, x1 = *(const v4u*)(src + 8), x2 = *(const v4u*)(src + 16), x3 = *(const v4u*)(src + 24);
          LAS v4u* dst = (LAS v4u*)(lds + HG_SP + dv * 272 + ch * 2); dst[0] = x0; dst[1] = x1; dst[2] = x2; dst[3] = x3; }
        LDS_WAIT(); __syncthreads();
#pragma unroll
        for (int k = 0; k < 4; ++k) { const int tau = wid + 8 * k, ti = tau >> 3, vi = tau & 7;
            const f32x4 acc = mma_tile<128>(lds + HG_SP + vi * 16 * 272, 272, lds + HG_QT + ti * 16 * 272, 272, fr, fq);
            const int t = 16 * ti + fr, dv = 16 * vi + 4 * fq; const v2u oi = *(const v2u*)(OINTRA + (row0 + t) * A_W + h * HD + dv);
            *(LAS f32x4*)(lds + HG_OT + (t * 132 + dv) * 4) = (f32x4){acc[0] + bflo(oi.x), acc[1] + bfhi(oi.x), acc[2] + bflo(oi.y), acc[3] + bfhi(oi.y)}; }
        LDS_WAIT(); __syncthreads();
#pragma unroll
        for (int k = 0; k < 8; ++k) { const int t = wid * 8 + k;
            const float v0 = *(LAS float*)(lds + HG_OT + (t * 132 + lane) * 4), v1 = *(LAS float*)(lds + HG_OT + (t * 132 + 64 + lane) * 4);
            const float ss = wave_sum(v0 * v0 + v1 * v1); const float r = 1.f / sqrtf(ss * (1.f / HD) + RMS_EPS);
            const float g0 = bf2f(P0[(row0 + t) * AB_IN + 3 * A_W + h * HD + lane]), g1 = bf2f(P0[(row0 + t) * AB_IN + 3 * A_W + h * HD + 64 + lane]);
            Ob[(row0 + t) * DM + h * HD + lane] = (bf16)f2bf(v0 * r * nw[lane] * g0 * sigmoidf_(g0));
            Ob[(row0 + t) * DM + h * HD + 64 + lane] = (bf16)f2bf(v1 * r * nw[64 + lane] * g1 * sigmoidf_(g1)); }
        LDS_WAIT(); __syncthreads();
    }
}

constexpr float SB_CUT = -160.f;
__device__ __forceinline__ void sb_phase(Frame& F, const bf16* P0, bf16* Ob) {
    const int tid = F.tid, wid = F.wave, lane = F.lane, r32 = lane & 31, hi = lane >> 5;
    LAS char* lds = (LAS char*)F.lds;
    const int vb0 = (int)(uintptr_t)(lds + ATT_V_OFF) + v_rd_base(lane);
    KVDma dm; kv_dma_init(dm, AB_IN, AB_IN, wid, lane);
    constexpr int NQB = SEQ / 256, NU = BATCH * B_HEADS * NQB;
    for (int rd = 0; ; ++rd) {
        const int idx = (rd & 1) ? rd * F.G + (F.G - 1 - F.bid) : rd * F.G + F.bid;
        if (rd * F.G >= NU) break;
        if (idx >= NU) continue;
        const int qb = NQB - 1 - idx / (BATCH * B_HEADS), bh = idx % (BATCH * B_HEADS), head = bh % B_HEADS, b = bh / B_HEADS;
        const size_t rowb = (size_t)b * SEQ; const int q0 = qb * 256;
        const bf16* Kh = P0 + rowb * AB_IN + 4 * A_W + B_W + head * HD; const bf16* Vh = Kh + B_W;
        const int tw0 = q0 + wid * 32, t = tw0 + r32;
        bf16x8 qr[8]; load_q(qr, P0 + (rowb + t) * AB_IN + 4 * A_W + head * HD + hi * 8);
        float R = 0.f; f32x16 o[4] = {};
        const int jtop = (q0 + 254) >> 6;
        LAS unsigned* dflag = (LAS unsigned*)(lds + ATT_X_OFF);
        if (lane == 0) { dflag[wid] = 0u; dflag[8 + wid] = 0u; }
        LDS_WAIT(); __syncthreads();
        kv_dma(dm, Kh + (size_t)jtop * KVBLK * AB_IN, Vh + (size_t)jtop * KVBLK * AB_IN, lds, 0, wid);
        int buf = 0;
        for (int j = jtop; j >= 0; --j, buf = ATT_BUF - buf) {
            VM_WAIT(); __syncthreads();
            { unsigned alld = 1u;
#pragma unroll
              for (int w = 0; w < NWAVES; ++w) alld &= dflag[((j + 1) & 1) * 8 + w];
              if (__builtin_amdgcn_readfirstlane(alld)) break; }
            if (j > 0) kv_dma(dm, Kh + (size_t)(j - 1) * KVBLK * AB_IN, Vh + (size_t)(j - 1) * KVBLK * AB_IN, lds, ATT_BUF - buf, wid);
            const int k0 = j * KVBLK;
            if (k0 < tw0 + 31) {
                f32x16 p0, p1; qkt(p0, p1, lds + buf + ATT_K_OFF, qr, r32, hi);
                const bool need_mask = (k0 + 63 >= tw0);
                float L0[16], L1[16];
#pragma unroll
                for (int r = 0; r < 16; ++r) {
                    const float z0 = p0[r] * ATT_C, z1 = p1[r] * ATT_C;
                    float l0 = -(fmaxf(z0, 0.f) + __builtin_amdgcn_logf(1.f + __builtin_amdgcn_exp2f(-fabsf(z0))));
                    float l1 = -(fmaxf(z1, 0.f) + __builtin_amdgcn_logf(1.f + __builtin_amdgcn_exp2f(-fabsf(z1))));
                    if (need_mask) { if (k0 + crow(r, hi) >= t) l0 = 0.f; if (k0 + 32 + crow(r, hi) >= t) l1 = 0.f; }
                    L0[r] = l0; L1[r] = l1; p0[r] = z0 + l0; p1[r] = z1 + l1;
                }
                SBAR();
                float Sg[16];
#pragma unroll
                for (int gi = 0; gi < 4; ++gi) {
                    const float a = (L0[4 * gi] + L0[4 * gi + 1]) + (L0[4 * gi + 2] + L0[4 * gi + 3]), c = (L1[4 * gi] + L1[4 * gi + 1]) + (L1[4 * gi + 2] + L1[4 * gi + 3]);
                    auto ra = __builtin_amdgcn_permlane32_swap(__float_as_uint(a), __float_as_uint(a), false, false);
                    auto rc = __builtin_amdgcn_permlane32_swap(__float_as_uint(c), __float_as_uint(c), false, false);
                    Sg[2 * gi] = __uint_as_float(ra[0]); Sg[2 * gi + 1] = __uint_as_float(ra[1]); Sg[8 + 2 * gi] = __uint_as_float(rc[0]); Sg[8 + 2 * gi + 1] = __uint_as_float(rc[1]);
                }
                float run = R;
#pragma unroll
                for (int s = 15; s >= 0; --s) { const float tt = run; run += Sg[s]; Sg[s] = tt; }
                const float Rn = run;
                SBAR();
#pragma unroll
                for (int gi = 0; gi < 4; ++gi) {
                    float base0 = hi ? Sg[2 * gi + 1] : Sg[2 * gi], base1 = hi ? Sg[8 + 2 * gi + 1] : Sg[8 + 2 * gi];
                    float r3 = base0, r2 = r3 + L0[4 * gi + 3], r1 = r2 + L0[4 * gi + 2], r0 = r1 + L0[4 * gi + 1];
                    p0[4 * gi + 3] = __builtin_amdgcn_exp2f(p0[4 * gi + 3] + r3); p0[4 * gi + 2] = __builtin_amdgcn_exp2f(p0[4 * gi + 2] + r2);
                    p0[4 * gi + 1] = __builtin_amdgcn_exp2f(p0[4 * gi + 1] + r1); p0[4 * gi + 0] = __builtin_amdgcn_exp2f(p0[4 * gi + 0] + r0);
                    r3 = base1; r2 = r3 + L1[4 * gi + 3]; r1 = r2 + L1[4 * gi + 2]; r0 = r1 + L1[4 * gi + 1];
                    p1[4 * gi + 3] = __builtin_amdgcn_exp2f(p1[4 * gi + 3] + r3); p1[4 * gi + 2] = __builtin_amdgcn_exp2f(p1[4 * gi + 2] + r2);
                    p1[4 * gi + 1] = __builtin_amdgcn_exp2f(p1[4 * gi + 1] + r1); p1[4 * gi + 0] = __builtin_amdgcn_exp2f(p1[4 * gi + 0] + r0);
                }
                R = Rn;
                { const unsigned dn = __all(R < SB_CUT) ? 1u : 0u; if (lane == 0) dflag[(j & 1) * 8 + wid] = dn; }
                if (need_mask) {
#pragma unroll
                    for (int r = 0; r < 16; ++r) { if (k0 + crow(r, hi) >= t) p0[r] = 0.f; if (k0 + 32 + crow(r, hi) >= t) p1[r] = 0.f; }
                }
                bf16x8 pa0, pa1, pa2, pa3; pack_p(p0, p1, pa0, pa1, pa2, pa3);
                pv_d0(o, vb0 + buf, pa0, pa1, pa2, pa3);
            }
        }
        bf16* Ow = Ob + (rowb + tw0) * DM + A_W + head * HD;
#pragma unroll
        for (int r = 0; r < 16; ++r) { const int orow = crow(r, hi);
#pragma unroll
            for (int d0 = 0; d0 < 4; ++d0) Ow[(size_t)orow * DM + d0 * 32 + r32] = (bf16)f2bf(o[d0][r]); }
    }
}

constexpr int P1_KC = 4096, P1_VC = 4608, P1_KS = 5120, P1_VS = 5632, P1_KW = 6144, P1_VW = 6656, P1_GL = 7168;
__device__ __forceinline__ void nsa_rope_phase(Frame& F, const bf16* P1, const float* TAB, bf16* QROT, bf16* KSROT, bf16* KWROT, bf16* OVL) {
    const int gw = F.bid * NWAVES + F.wave, NGW = F.G * NWAVES, lane = F.lane, hsub = lane >> 3, d0 = (lane & 7) * 8;
    for (int m = gw; m < MTOK; m += NGW) {
        const int t = m & (SEQ - 1);
        const f32x4 c0 = *(const f32x4*)(TAB + (size_t)t * 128 + d0), c1 = *(const f32x4*)(TAB + (size_t)t * 128 + d0 + 4);
        const f32x4 s0 = *(const f32x4*)(TAB + (size_t)t * 128 + 64 + d0), s1 = *(const f32x4*)(TAB + (size_t)t * 128 + 64 + d0 + 4);
        const float cs[8] = {c0.x, c0.y, c0.z, c0.w, c1.x, c1.y, c1.z, c1.w}, sn[8] = {s0.x, s0.y, s0.z, s0.w, s1.x, s1.y, s1.z, s1.w};
        const bf16* row = P1 + (size_t)m * NSA_INP;
#pragma unroll
        for (int hb = 0; hb < 5; ++hb) {
            const int hh = hb * 8 + hsub;
            const bf16* src; bf16* dst;
            if (hh < 32) { src = row + hh * HD; dst = QROT + (size_t)m * DM + hh * HD; }
            else if (hh < 36) { src = row + P1_KS + (hh - 32) * HD; dst = KSROT + (size_t)m * KVW + (hh - 32) * HD; }
            else { src = row + P1_KW + (hh - 36) * HD; dst = KWROT + (size_t)m * KVW + (hh - 36) * HD; }
            const v4u a = *(const v4u*)(src + d0), bq = *(const v4u*)(src + 64 + d0);
            const unsigned aw[4] = {a.x, a.y, a.z, a.w}, bw[4] = {bq.x, bq.y, bq.z, bq.w}; unsigned o1[4], o2[4];
#pragma unroll
            for (int q = 0; q < 4; ++q) { const float x1l = bflo(aw[q]), x1h = bfhi(aw[q]), x2l = bflo(bw[q]), x2h = bfhi(bw[q]);
                o1[q] = pk2(x1l * cs[2 * q] - x2l * sn[2 * q], x1h * cs[2 * q + 1] - x2h * sn[2 * q + 1]);
                o2[q] = pk2(x2l * cs[2 * q] + x1l * sn[2 * q], x2h * cs[2 * q + 1] + x1h * sn[2 * q + 1]); }
            *(v4u*)(dst + d0) = (v4u){o1[0], o1[1], o1[2], o1[3]}; *(v4u*)(dst + 64 + d0) = (v4u){o2[0], o2[1], o2[2], o2[3]};
        }
    }
    for (int i = F.bid * NTHR + F.tid; i < NCMPP * NSLC; i += F.G * NTHR) { const int n = i / NSLC, j = i % NSLC;
        OVL[i] = (n < NCMP && n >= 4 * j - 1 && n <= 4 * j + 3) ? (bf16)0x3f80u : (bf16)0u; }
}
constexpr int CM_A = 0, CM_B = 17408, CM_H = 17408 + 34816;
__device__ __forceinline__ void nsa_compress_phase(Frame& F, const bf16* P1, const float* pos, const bf16* W1t, const bf16* W2t, bf16* KCMP, bf16* VCMP) {
    LAS char* lds = (LAS char*)F.lds;
    const int tid = F.tid, wid = F.wave, lane = F.lane, fr = lane & 15, fq = lane >> 4;
    for (int item = F.bid; item < 128; item += F.G) {
        const int nt = item & 7, g = (item >> 3) & 3, b = (item >> 5) & 1, which = item >> 6;
        const bf16* w1 = W1t + (size_t)which * HD * 32 * HD; const bf16* w2 = W2t + (size_t)which * HD * HD;
        const float* posw = pos + (size_t)which * 32 * HD;
        f32x4 acc[4];
#pragma unroll
        for (int k = 0; k < 4; ++k) acc[k] = (f32x4){0.f, 0.f, 0.f, 0.f};
        for (int l = 0; l < 32; ++l) {
            { const int r = tid >> 3, ch = (tid & 7) * 16, n = nt * 64 + r; unsigned w[8];
              if (n < NCMP) { const bf16* src = P1 + ((size_t)b * SEQ + 16 * n + l) * NSA_INP + P1_KC + which * KVW + g * HD + ch;
                  const v4u x0 = *(const v4u*)src, x1 = *(const v4u*)(src + 8); const unsigned xs[8] = {x0.x, x0.y, x0.z, x0.w, x1.x, x1.y, x1.z, x1.w};
#pragma unroll
                  for (int q = 0; q < 8; ++q) w[q] = pk2(bflo(xs[q]) + posw[l * HD + ch + 2 * q], bfhi(xs[q]) + posw[l * HD + ch + 2 * q + 1]);
              } else {
#pragma unroll
                  for (int q = 0; q < 8; ++q) w[q] = 0u; }
              LAS v4u* dst = (LAS v4u*)(lds + CM_A + r * 272 + ch * 2); dst[0] = (v4u){w[0], w[1], w[2], w[3]}; dst[1] = (v4u){w[4], w[5], w[6], w[7]}; }
            { const int e = tid >> 2, ch = (tid & 3) * 32; const bf16* src = w1 + (size_t)e * 32 * HD + l * HD + ch;
              const v4u x0 = *(const v4u*)src, x1 = *(const v4u*)(src + 8), x2 = *(const v4u*)(src + 16), x3 = *(const v4u*)(src + 24);
              LAS v4u* dst = (LAS v4u*)(lds + CM_B + e * 272 + ch * 2); dst[0] = x0; dst[1] = x1; dst[2] = x2; dst[3] = x3; }
            LDS_WAIT(); __syncthreads();
#pragma unroll
            for (int k = 0; k < 4; ++k) { const int tau = wid + 8 * k, ni = tau >> 3, ei = tau & 7;
                acc[k] += mma_tile<128>(lds + CM_A + ni * 16 * 272, 272, lds + CM_B + ei * 16 * 272, 272, fr, fq); }
            LDS_WAIT(); __syncthreads();
        }
#pragma unroll
        for (int k = 0; k < 4; ++k) { const int tau = wid + 8 * k, ni = tau >> 3, ei = tau & 7;
#pragma unroll
            for (int i = 0; i < 4; ++i) *(LAS unsigned short*)(lds + CM_H + (16 * ni + 4 * fq + i) * 272 + (16 * ei + fr) * 2) = (unsigned short)f2bf(gelu1(acc[k][i])); }
        { const int f = tid >> 2, ch = (tid & 3) * 32; const bf16* src = w2 + (size_t)f * HD + ch;
          const v4u x0 = *(const v4u*)src, x1 = *(const v4u*)(src + 8), x2 = *(const v4u*)(src + 16), x3 = *(const v4u*)(src + 24);
          LAS v4u* dst = (LAS v4u*)(lds + CM_B + f * 272 + ch * 2); dst[0] = x0; dst[1] = x1; dst[2] = x2; dst[3] = x3; }
        LDS_WAIT(); __syncthreads();
        bf16* outp = which ? VCMP : KCMP;
#pragma unroll
        for (int k = 0; k < 4; ++k) { const int tau = wid + 8 * k, ni = tau >> 3, fi = tau & 7;
            const f32x4 a2 = mma_tile<128>(lds + CM_H + ni * 16 * 272, 272, lds + CM_B + fi * 16 * 272, 272, fr, fq);
#pragma unroll
            for (int i = 0; i < 4; ++i) { const int n = nt * 64 + 16 * ni + 4 * fq + i;
                outp[(((size_t)b * NCMPP + n) * NSA_G + g) * HD + 16 * fi + fr] = (n < NCMP) ? (bf16)f2bf(a2[i]) : (bf16)0u; } }
        LDS_WAIT(); __syncthreads();
    }
}
__device__ __forceinline__ unsigned pick4(const unsigned (&a)[4], int i) { return i == 0 ? a[0] : (i == 1 ? a[1] : (i == 2 ? a[2] : a[3])); }
template <int MODE>
__device__ __forceinline__ void nsa_attn_phase(Frame& F, const bf16* P1, const bf16* Qsrc, const bf16* Ksrc, const bf16* Vsrc, const unsigned* SEL, float* O32, float* IMP, bf16* Ob, bool probe_nostore = false) {
    const int tid = F.tid, wid = F.wave, lane = F.lane, r32 = lane & 31, hi = lane >> 5;
    LAS char* lds = (LAS char*)F.lds;
    LAS float* wsc = (LAS float*)(lds + ATT_WS_OFF + wid * 256);
    const int vb0 = (int)(uintptr_t)(lds + ATT_V_OFF) + v_rd_base(lane);
    KVDma dm; kv_dma_init(dm, MODE <= 1 ? NSA_G * HD : KVW, MODE == 0 ? NSA_G * HD : (MODE == 1 ? NSLC : NSA_INP), wid, lane);
    constexpr int NTB = SEQ / 32, NU = BATCH * NSA_G * NTB;
    for (int rd = 0; ; ++rd) {
        const int idx = (rd & 1) ? rd * F.G + (F.G - 1 - F.bid) : rd * F.G + F.bid;
        if (rd * F.G >= NU) break;
        if (idx >= NU) continue;
        const int tb = NTB - 1 - idx / (BATCH * NSA_G), bg = idx % (BATCH * NSA_G), g = bg % NSA_G, b = bg / NSA_G;
        const size_t rowb = (size_t)b * SEQ; const int t0 = tb * 32;
        const int t = (MODE == 2) ? t0 + 4 * wid + (r32 >> 3) : t0 + r32, head = (MODE == 2) ? g * NSA_R + (r32 & 7) : g * NSA_R + wid;
        const bf16* Kh; const bf16* Vh; long ldk, ldv; int jlo, jhi;
        if (MODE <= 1) { Kh = Ksrc + ((size_t)b * NCMPP * NSA_G + g) * HD; ldk = NSA_G * HD; jlo = 0; jhi = (t0 >> 4) >> 6;
            if (MODE == 0) { Vh = Vsrc + ((size_t)b * NCMPP * NSA_G + g) * HD; ldv = NSA_G * HD; } else { Vh = Vsrc; ldv = NSLC; } }
        else { Kh = Ksrc + rowb * KVW + g * HD; ldk = KVW; Vh = P1 + rowb * NSA_INP + (MODE == 2 ? P1_VS : P1_VW) + g * HD; ldv = NSA_INP;
            jhi = (t0 + 31) >> 6; jlo = (MODE == 2) ? 0 : ((t0 - (WINDOW - 1) > 0 ? t0 - (WINDOW - 1) : 0) >> 6); }
        bf16x8 qr[8]; load_q(qr, Qsrc + (rowb + t) * (MODE <= 1 ? NSA_INP : DM) + head * HD + hi * 8);
        unsigned selw[4] = {0u, 0u, 0u, 0u}, uni[4] = {~0u, ~0u, ~0u, ~0u}, wn[4] = {~0u, ~0u, ~0u, ~0u};
        if (MODE == 2) { const v4u sv = *(const v4u*)(SEL + ((rowb + t) * NSA_G + g) * 4); selw[0] = sv.x; selw[1] = sv.y; selw[2] = sv.z; selw[3] = sv.w;
            LAS unsigned* un = (LAS unsigned*)(lds + ATT_X_OFF);
#pragma unroll
            for (int q = 0; q < 4; ++q) { unsigned x = selw[q]; x |= __shfl_xor(x, 8); x |= __shfl_xor(x, 16); wn[q] = __builtin_amdgcn_readfirstlane(x); if (lane == 0) un[wid * 4 + q] = wn[q]; }
            LDS_WAIT(); __syncthreads();
#pragma unroll
            for (int q = 0; q < 4; ++q) { unsigned x = 0u;
#pragma unroll
                for (int w = 0; w < NWAVES; ++w) x |= un[w * 4 + q];
                uni[q] = __builtin_amdgcn_readfirstlane(x); } }
        float m_reg = -1e30f, l_reg = 0.f; f32x16 o[4] = {};
        const int cur = t >> 6;
#define NSA_NEXT(jj) do { if (MODE == 2) { while ((jj) <= jhi && !((pick4(uni, (jj) >> 5) >> ((jj) & 31)) & 1u)) ++(jj); } } while (0)
#define NSA_NEED(jj) (MODE != 2 || ((pick4(wn, (jj) >> 5) >> ((jj) & 31)) & 1u))
#define NSA_MASK(P0, P1, JJ) do { const int k0 = (JJ) * KVBLK; constexpr float NINF = -__builtin_inff(); \
            if (MODE <= 1) { if (!(16 * (k0 + 63) + 31 <= t0)) { \
                    _Pragma("unroll") for (int r = 0; r < 16; ++r) { if (!(16 * (k0 + crow(r, hi)) + 31 <= t)) P0[r] = NINF; if (!(16 * (k0 + 32 + crow(r, hi)) + 31 <= t)) P1[r] = NINF; } } } \
            else if (MODE == 2) { const bool mine = (pick4(selw, (JJ) >> 5) >> ((JJ) & 31)) & 1u; const int lim = mine ? ((JJ) < cur ? 0x7fffffff : t) : -1; \
                _Pragma("unroll") for (int r = 0; r < 16; ++r) { if (k0 + crow(r, hi) > lim) P0[r] = NINF; if (k0 + 32 + crow(r, hi) > lim) P1[r] = NINF; } } \
            else { if (!((k0 > t0 + 31 - WINDOW) && (k0 + 63 <= t0))) { \
                    _Pragma("unroll") for (int r = 0; r < 16; ++r) { const int ka = k0 + crow(r, hi), kb = ka + 32; \
                        if (!(ka <= t && ka > t - WINDOW)) P0[r] = NINF; if (!(kb <= t && kb > t - WINDOW)) P1[r] = NINF; } } } } while (0)
        int ja = jlo; NSA_NEXT(ja); int jb = ja + 1; NSA_NEXT(jb);
        __syncthreads();
        if (ja <= jhi) kv_dma(dm, Kh + (size_t)ja * KVBLK * ldk, Vh + (size_t)ja * KVBLK * ldv, lds, 0, wid);
        if (jb <= jhi) kv_dma(dm, Kh + (size_t)jb * KVBLK * ldk, Vh + (size_t)jb * KVBLK * ldv, lds, ATT_BUF, wid);
        int set = 0;
        while (ja <= jhi) {
            int jc = jb + 1; NSA_NEXT(jc); int jd = jc + 1; NSA_NEXT(jd);
            VM_WAIT(); __syncthreads();
            if (jc <= jhi) kv_dma(dm, Kh + (size_t)jc * KVBLK * ldk, Vh + (size_t)jc * KVBLK * ldv, lds, ATT_SET - set, wid);
            if (jd <= jhi) kv_dma(dm, Kh + (size_t)jd * KVBLK * ldk, Vh + (size_t)jd * KVBLK * ldv, lds, ATT_SET - set + ATT_BUF, wid);
            const bool nA = NSA_NEED(ja), nB = (jb <= jhi) && NSA_NEED(jb);
            f32x16 a0, a1, b0, b1;
            if (nA) qkt(a0, a1, lds + set + ATT_K_OFF, qr, r32, hi);
            if (nB) qkt(b0, b1, lds + set + ATT_BUF + ATT_K_OFF, qr, r32, hi);
            if (nA) { NSA_MASK(a0, a1, ja); attn_finish(a0, a1, o, m_reg, l_reg, wsc, vb0 + set, r32, hi); }
            if (nB) { NSA_MASK(b0, b1, jb); attn_finish(b0, b1, o, m_reg, l_reg, wsc, vb0 + set + ATT_BUF, r32, hi); }
            ja = jc; jb = jd; set = ATT_SET - set;
        }
#undef NSA_MASK
#undef NSA_NEED
#undef NSA_NEXT
        { float fac = l_reg > 0.f ? __builtin_amdgcn_rcpf(l_reg) : 0.f;
          if (MODE != 1) { const int br = MODE == 0 ? 0 : (MODE == 2 ? 1 : 2); fac *= sigmoidf_(bf2f(P1[(rowb + t) * NSA_INP + P1_GL + head * 3 + br])); }
          if (hi == 0) wsc[32 + r32] = fac; LDS_WAIT(); }
        if (MODE == 1) {
            float fc[16];
#pragma unroll
            for (int r = 0; r < 16; ++r) fc[r] = wsc[32 + crow(r, hi)];
            LDS_WAIT(); __syncthreads();
#pragma unroll
            for (int r = 0; r < 16; ++r) { const int orow = crow(r, hi);
#pragma unroll
                for (int d0 = 0; d0 < 4; ++d0) *(LAS float*)(lds + ((wid * 32 + orow) * 128 + d0 * 32 + r32) * 4) = o[d0][r] * fc[r]; }
            LDS_WAIT(); __syncthreads();
            { const int tok = tid >> 4, j8 = (tid & 15) * 8; f32x4 s0 = {0.f, 0.f, 0.f, 0.f}, s1 = {0.f, 0.f, 0.f, 0.f};
#pragma unroll
              for (int w = 0; w < 8; ++w) { const LAS f32x4* pp = (const LAS f32x4*)(lds + ((w * 32 + tok) * 128 + j8) * 4); s0 += pp[0]; s1 += pp[1]; }
              f32x4* dst = (f32x4*)(IMP + ((rowb + t0 + tok) * NSA_G + g) * NSLC + j8); dst[0] = s0; dst[1] = s1; }
            LDS_WAIT(); __syncthreads();
        } else {
#pragma unroll
            for (int r = 0; r < 16; ++r) { const int orow = crow(r, hi); const float fc = wsc[32 + orow];
                const size_t off = (MODE == 2) ? (rowb + t0 + 4 * wid + (orow >> 3)) * DM + (g * NSA_R + (orow & 7)) * HD + r32 : (rowb + t0 + orow) * DM + head * HD + r32;
#pragma unroll
                for (int d0 = 0; d0 < 4; ++d0) {
                    if (MODE == 0) O32[off + d0 * 32] = o[d0][r] * fc;
                    else if (MODE == 2) { if (!probe_nostore) O32[off + d0 * 32] += o[d0][r] * fc; }
                    else Ob[off + d0 * 32] = (bf16)f2bf(O32[off + d0 * 32] + o[d0][r] * fc); } }
            LDS_WAIT();
        }
    }
}
__device__ __forceinline__ void nsa_topk_phase(Frame& F, const float* IMP, unsigned* SEL) {
    LAS float* sc = (LAS float*)(F.lds + F.wave * 1024);
    const int gw = F.bid * NWAVES + F.wave, NGW = F.G * NWAVES, lane = F.lane;
    for (int it = gw; it < MTOK * NSA_G; it += NGW) {
        const int m = it / NSA_G, t = m & (SEQ - 1), cur = t >> 6;
        const float* ip = IMP + (size_t)it * NSLC;
        const float a0 = ip[lane], a1 = ip[64 + lane];
        sc[lane] = a0; sc[64 + lane] = a1; LDS_WAIT();
        const int j0 = lane, j1 = lane + 64;
        const bool f0 = (j0 == 0) || (j0 == cur) || (j0 == cur - 1), f1 = (j1 == cur) || (j1 == cur - 1);
        const bool c0 = !f0 && j0 <= cur, c1 = !f1 && j1 <= cur;
        const int nforced = cur >= 2 ? 3 : cur + 1, slots = NTOP - nforced;
        int rk0 = 0, rk1 = 0;
        const int ncand_hi = cur < NSLC ? cur : NSLC - 1;
        for (int i = 1; i <= ncand_hi; ++i) {
            const bool fi = (i == cur) || (i == cur - 1); if (fi) continue;
            const float v = sc[i];
            rk0 += (v > a0 || (v == a0 && i < j0)) ? 1 : 0; rk1 += (v > a1 || (v == a1 && i < j1)) ? 1 : 0;
        }
        const bool s0 = (f0 && j0 <= cur) || (c0 && rk0 < slots), s1 = (f1 && j1 <= cur) || (c1 && rk1 < slots);
        const unsigned long long m0 = __ballot(s0), m1 = __ballot(s1);
        if (lane == 0) { v4u w = {(unsigned)m0, (unsigned)(m0 >> 32), (unsigned)m1, (unsigned)(m1 >> 32)}; *(v4u*)(SEL + (size_t)it * 4) = w; }
        LDS_WAIT();
    }
}

#ifndef STAGE
#define STAGE 3
#endif
#define ZERO_OB_PHASE PH_BEGIN { v4u z = {0u, 0u, 0u, 0u}; v4u* p = (v4u*)Ob; const long n = (long)MTOK * DM / 8; \
            for (long i = (long)F.bid * NTHR + F.tid; i < n; i += (long)F.G * NTHR) p[i] = z; } PH_END
#define MIXER0_PHASES \
    PH_BEGIN REP(10) hgrn_phase_a(F, BIG, (const float*)(ws + WS_LB), (bf16*)(ws + WS_QT), (bf16*)(ws + WS_OINTRA), (bf16*)(ws + WS_DS), (float*)(ws + WS_DEC)); \
             REP(11) sb_phase(F, BIG, Ob); PH_END \
    PH_BEGIN REP(12) hgrn_phase_b(F, (const bf16*)(ws + WS_DS), (const float*)(ws + WS_DEC), (bf16*)(ws + WS_SPREV)); PH_END \
    PH_BEGIN REP(13) hgrn_phase_c(F, BIG, (const bf16*)(ws + WS_QT), (const bf16*)(ws + WS_OINTRA), (const bf16*)(ws + WS_SPREV), args.in[IN_HGRN_NW], Ob); PH_END
#if STAGE <= 2
#define MIXER1_PHASES ZERO_OB_PHASE
#else
#define MIXER1_PHASES \
    PH_BEGIN REP(14) { nsa_rope_phase(F, BIG, (const float*)(ws + WS_ROPE), (bf16*)(ws + WS_QROT), (bf16*)(ws + WS_KSROT), (bf16*)(ws + WS_KWROT), (bf16*)(ws + WS_OVL)); \
             nsa_compress_phase(F, BIG, args.in[IN_NSA_CMP_POS], (const bf16*)(ws + WS_W_C1), (const bf16*)(ws + WS_W_C2), (bf16*)(ws + WS_KCMP), (bf16*)(ws + WS_VCMP)); } PH_END \
    PH_BEGIN { REP(15) nsa_attn_phase<0>(F, BIG, BIG, (const bf16*)(ws + WS_KCMP), (const bf16*)(ws + WS_VCMP), nullptr, (float*)(ws + WS_O32), nullptr, nullptr); \
             REP(15) nsa_attn_phase<1>(F, BIG, BIG, (const bf16*)(ws + WS_KCMP), (const bf16*)(ws + WS_OVL), nullptr, nullptr, (float*)(ws + WS_IMP), nullptr); } PH_END \
    PH_BEGIN REP(16) nsa_topk_phase(F, (const float*)(ws + WS_IMP), (unsigned*)(ws + WS_SEL)); PH_END \
    PH_BEGIN REP(18) nsa_attn_phase<2>(F, BIG, (const bf16*)(ws + WS_QROT), (const bf16*)(ws + WS_KSROT), nullptr, (const unsigned*)(ws + WS_SEL), (float*)(ws + WS_O32), nullptr, nullptr, r_ > 0); PH_END \
    PH_BEGIN REP(17) nsa_attn_phase<3>(F, BIG, (const bf16*)(ws + WS_QROT), (const bf16*)(ws + WS_KWROT), nullptr, nullptr, (float*)(ws + WS_O32), nullptr, Ob); PH_END
#endif
#ifndef REPMASK
#define REPMASK 0u
#endif
#define REP(gid) for (int r_ = 0; r_ <= (int)((REPMASK >> (gid)) & 1u); ++r_)
#define PH_BEGIN if (pc >= lo && pc < hi) { F.fresh();
#define PH_END   if (pc + 1 < hi) { XcdBarrier bb_ = bar; asm volatile("" : "+s"(bb_.bar), "+s"(bb_.x)); xcd_barrier(bb_); } } ++pc;
template <int l>
__device__ __forceinline__ void layer_body(Frame& F, const Args& args, const XcdBarrier& bar, int& pc, const int lo, const int hi) {
    unsigned char* ws = args.ws;
    bf16* HB = (bf16*)(ws + WS_HB); bf16* Y = (bf16*)(ws + WS_Y); float* H32 = args.out;
    bf16* BIG = (bf16*)(ws + WS_BIG); bf16* Gm = (bf16*)(ws + WS_G); bf16* Ob = (bf16*)(ws + WS_O);
    bf16* XQ = (bf16*)(ws + WS_XQ); bf16* XO = (bf16*)(ws + WS_XO);
#define RS(k) ((long long*)(ws + WS_RSUM) + (size_t)(k) * MTOK * 2)
#define LNG(k) (args.in[IN_LN_G] + (size_t)(k) * DM)
#define LNB(k) (args.in[IN_LN_B] + (size_t)(k) * DM)
    const long long* cs = (const long long*)(ws + WS_FOLD); const long long* b2 = cs + FO_N;
        PH_BEGIN REP(1) {
            const int N = l == 0 ? AB_IN : NSA_INP;
            pg8::StaticOrder S; S.init(MTOK, N, F.G, F.bid);
            if (l == 0) { pg8::Gemm g{HB, (const bf16*)(ws + WS_W_ABIN), MTOK, N, DM}; pg8::EpiBf16<0> E{BIG, N, nullptr, 0, 0, 1.f};
                pg8::gemm_phase<pg8::EpiBf16<0>, pg8::StaticOrder, PG8_ALIGN, PG8_SP2>(F.lds + RING_OFF, g, S, E); }
            else { pg8::Gemm g{Y, (const bf16*)(ws + WS_W_NSAIN), MTOK, N, DM}; pg8::EpiBf16Ln E{BIG, N, RS(2), cs + FO_NSA, b2 + FO_NSA};
                pg8::gemm_phase<pg8::EpiBf16Ln, pg8::StaticOrder, PG8_ALIGN, PG8_SP2>(F.lds + RING_OFF, g, S, E); }
        } PH_END
#if STAGE <= 1
        ZERO_OB_PHASE
#else
        if (l == 0) {
            MIXER0_PHASES
        } else {
            MIXER1_PHASES
        }
#endif
        PH_BEGIN REP(2) {
            pg8::Gemm g{Ob, l == 0 ? (const bf16*)(ws + WS_W_ABOUT) : (const bf16*)(ws + WS_W_NSAOUT), MTOK, DM, DM};
            pg8::StaticOrder S; S.init(MTOK, DM, F.G, F.bid);
            if (l == 0) { pg8::EpiRes0 E{Y, HB, DM, DN_ALPHA, RS(0)};
                pg8::gemm_phase<pg8::EpiRes0, pg8::StaticOrder, PG8_ALIGN, PG8_SP2>(F.lds + RING_OFF, g, S, E); }
            else { pg8::EpiResLn2 E{Y, RS(2), LNG(2), LNB(2), DM, DN_ALPHA, RS(3)};
                pg8::gemm_phase<pg8::EpiResLn2, pg8::StaticOrder, PG8_ALIGN, PG8_SP2>(F.lds + RING_OFF, g, S, E); }
        } PH_END
        PH_BEGIN REP(3) {
            {   pg8::Gemm g{Y, (const bf16*)(ws + WS_W_XQ) + (size_t)l * XW * DM, MTOK, XW, DM};
                pg8::RangeOrder S; S.init(MTOK, XW, 0, 128, F.bid);
                pg8::EpiBf16Ln E{XQ, XW, RS(3 * l), cs + FO_XQ + l * XW, b2 + FO_XQ + l * XW};
                pg8::gemm_phase<pg8::EpiBf16Ln, pg8::RangeOrder, PG8_ALIGN, PG8_SP2>(F.lds + RING_OFF, g, S, E); }
            {   pg8::Gemm g{(const bf16*)(ws + WS_MEMB), (const bf16*)(ws + WS_W_XKV) + (size_t)l * 2 * XW * DM, BATCH * NMEM, 2 * XW, DM};
                pg8::RangeOrder S; S.init(BATCH * NMEM, 2 * XW, 128, 8, F.bid);
                pg8::EpiBf16<0> E{(bf16*)(ws + WS_XKV) + (size_t)l * BATCH * NMEM * 2 * XW, 2 * XW, nullptr, 0, 0, 1.f};
                pg8::gemm_phase<pg8::EpiBf16<0>, pg8::RangeOrder, PG8_ALIGN, PG8_SP2>(F.lds + RING_OFF, g, S, E); }
        } PH_END
        PH_BEGIN REP(9) xattn_phase(F, XQ, (const bf16*)(ws + WS_XKV) + (size_t)l * BATCH * NMEM * 2 * XW, XO); PH_END
        PH_BEGIN REP(4) {
            pg8::Gemm g{XO, (const bf16*)(ws + WS_W_XO) + (size_t)l * DM * XW, MTOK, DM, XW};
            pg8::StaticOrder S; S.init(MTOK, DM, F.G, F.bid);
            pg8::EpiResLn2 E{Y, RS(3 * l), LNG(3 * l), LNB(3 * l), DM, DN_ALPHA, RS(3 * l + 1)};
            pg8::gemm_phase<pg8::EpiResLn2, pg8::StaticOrder, PG8_ALIGN, PG8_SP2>(F.lds + RING_OFF, g, S, E);
        } PH_END
        PH_BEGIN REP(5) {
            pg8::Gemm g{Y, (const bf16*)(ws + WS_W_UP) + (size_t)l * DFF2 * DM, MTOK, DFF2, DM};
            pg8::StaticOrder S; S.init(MTOK, DFF2, F.G, F.bid);
            pg8::EpiBf16Ln E{BIG, DFF2, RS(3 * l + 1), cs + FO_UP + l * DFF2, b2 + FO_UP + l * DFF2};
            pg8::gemm_phase<pg8::EpiBf16Ln, pg8::StaticOrder, PG8_ALIGN, PG8_SP2>(F.lds + RING_OFF, g, S, E);
        } PH_END
#if (REPMASK >> 20) & 1
        PH_BEGIN {
            pg8::Gemm g{HB, (const bf16*)(ws + WS_W_UP) + (size_t)l * DFF2 * DM, MTOK, DFF2, DM};
            pg8::ZeroOrder S; S.init(MTOK, DFF2, F.G, F.bid);
            pg8::EpiBf16<0> E{Gm, DFF2, nullptr, 0, 0, 1.f};
            pg8::gemm_phase<pg8::EpiBf16<0>, pg8::ZeroOrder, PG8_ALIGN, PG8_SP2>(F.lds + RING_OFF, g, S, E);
        } PH_END
#endif
        PH_BEGIN REP(8) convglu_phase(F, BIG, args.in[IN_FFN_CONV] + (size_t)l * 3 * DFF, Gm); PH_END
        PH_BEGIN REP(6) {
            pg8::Gemm g{Gm, (const bf16*)(ws + WS_W_DOWN) + (size_t)l * DM * DFF, MTOK, DM, DFF};
            pg8::StaticOrder S; S.init(MTOK, DM, F.G, F.bid);
            pg8::EpiResLn2 E{Y, RS(3 * l + 1), LNG(3 * l + 1), LNB(3 * l + 1), DM, DN_ALPHA, RS(3 * l + 2)};
            pg8::gemm_phase<pg8::EpiResLn2, pg8::StaticOrder, PG8_ALIGN, PG8_SP2>(F.lds + RING_OFF, g, S, E);
        } PH_END
        if (l == 1) { PH_BEGIN REP(7) ln_phase(F, Y, LNG(5), LNB(5), H32); PH_END }
#undef RS
#undef LNG
#undef LNB
}
__global__ void __launch_bounds__(NTHR, 2) mega_fwd(Args args) {
    extern __shared__ __attribute__((aligned(16))) unsigned char lds_raw[];
    Frame F;
    F.lds = (LAS unsigned char*)lds_raw; F.ws = args.ws;
    F.tid = threadIdx.x; F.lane = F.tid & 63; F.wave = __builtin_amdgcn_readfirstlane(F.tid >> 6); F.G = gridDim.x;
    unsigned char* ws = args.ws;
    gu32* ctl = (gu32*)(ws + WS_CTL);
    for (int u = F.tid; u < (LDS_BYTES - LDSCTL_OFF) / 4; u += NTHR) ((LAS unsigned*)(F.lds + LDSCTL_OFF))[u] = 0u;
    __syncthreads();
    volatile LAS unsigned* MISC = (volatile LAS unsigned*)(F.lds + MISC_OFF);
    XcdBarrier bar = xcd_barrier_post((unsigned*)(ctl + CW_BAR), MISC + 8);
    const int lo = args.ph_lo, hi = args.ph_hi; int pc = 0;
    bf16* HB = (bf16*)(ws + WS_HB); bf16* Y = (bf16*)(ws + WS_Y); float* H32 = args.out;
    bf16* BIG = (bf16*)(ws + WS_BIG); bf16* Gm = (bf16*)(ws + WS_G); bf16* Ob = (bf16*)(ws + WS_O);
    bf16* XQ = (bf16*)(ws + WS_XQ); bf16* XO = (bf16*)(ws + WS_XO);

    PH_BEGIN REP(0) p0_prologue(F, args); PH_END

#if (REPMASK >> 21) & 1
    for (int e_ = 0; e_ < 40; ++e_) { PH_BEGIN PH_END }
#endif
    layer_body<0>(F, args, bar, pc, lo, hi);
    layer_body<1>(F, args, bar, pc, lo, hi);
}

extern "C" void kernel_launch(void* const* d_in, const int* in_sizes, int n_in, void* d_out, int out_size, void* d_ws, size_t ws_size, hipStream_t stream) {
    static int grid = 0;
    if (grid == 0) {
        if (n_in != 19 || in_sizes[0] != MTOK * DM || out_size != MTOK * DM || ws_size < WS_END) {
            fprintf(stderr, "kernel_launch: shape mismatch n_in %d in0 %d out %d ws %zu (need %zu)\n", n_in, n_in > 0 ? in_sizes[0] : -1, out_size, ws_size, (size_t)WS_END); grid = -1; return; }
        int dev = 0, cus = 0, per_cu = 0;
        if (hipGetDevice(&dev) != hipSuccess || hipDeviceGetAttribute(&cus, hipDeviceAttributeMultiprocessorCount, dev) != hipSuccess) { grid = -1; return; }
        if (hipFuncSetAttribute((const void*)mega_fwd, hipFuncAttributeMaxDynamicSharedMemorySize, LDS_BYTES) != hipSuccess) { fprintf(stderr, "kernel_launch: hipFuncSetAttribute failed\n"); grid = -1; return; }
        if (hipOccupancyMaxActiveBlocksPerMultiprocessor(&per_cu, (const void*)mega_fwd, NTHR, LDS_BYTES) != hipSuccess || per_cu < 1)
            fprintf(stderr, "kernel_launch: note: occupancy query reports %d workgroups per CU\n", per_cu);
        (void)hipGetLastError();
        grid = cus;
    }
    if (grid < 0) return;
    if (hipMemsetAsync((char*)d_ws + WS_CTL, 0, CTL_ZERO_BYTES, stream) != hipSuccess) { fprintf(stderr, "kernel_launch: memset failed\n"); return; }
    Args a{};
    for (int i = 0; i < 19; ++i) a.in[i] = (const float*)d_in[i];
    a.out = (float*)d_out; a.ws = (unsigned char*)d_ws; a.ph_lo = 0; a.ph_hi = 1 << 20;
    hipLaunchKernelGGL(mega_fwd, dim3(grid), dim3(NTHR), LDS_BYTES, stream, a);
    const hipError_t le = hipPeekAtLastError();
    if (le != hipSuccess) fprintf(stderr, "kernel_launch: launch failed: %s\n", hipGetErrorName(le));
}
```

```cpp
#include <hip/hip_runtime.h>
#include <cstdio>
#include <cstdint>
namespace pg8 {
#define PG8_LAS __attribute__((address_space(3)))
typedef unsigned short bf16_t;
typedef short bf16x8 __attribute__((ext_vector_type(8)));
typedef float f32x4 __attribute__((ext_vector_type(4)));
typedef unsigned u32x4 __attribute__((ext_vector_type(4)));
constexpr int BM = 256, BK = 64, HALF = 128, HTB = HALF * BK * 2  , STAGE_BYTES = 8 * HTB, NXCD = 8, WGM = 8;

__host__ __device__ __forceinline__ int lds_byte(int r, int c) { const int st = (r >> 4) * 2 + (c >> 5), rr = r & 15, cc = c & 31, ob = rr * 64 + cc * 2; return st * 1024 + (ob ^ (((ob >> 9) & 1) << 5)); }
__host__ __device__ __forceinline__ void stage_rc(int b, int& R, int& C) { const int st = b / 1024, sb = b % 1024, swz = sb ^ (((sb >> 9) & 1) << 5); R = (st >> 1) * 16 + swz / 64; C = (st & 1) * 32 + (swz % 64) / 2; }
__host__ __device__ __forceinline__ int perm32(int rho) { const int n = rho >> 4, i = rho & 15; return 8 * (i >> 2) + 4 * n + (i & 3); }

struct Unit { int pm, pn; };
struct Gemm { const bf16_t* A; const bf16_t* Bt; int M, N, K; };

struct StaticOrder {
    int nM, nN, nwg, G, c;
    __host__ __device__ void init(int M, int N, int G_, int c_) { nM = M / BM; nN = N / BM; nwg = nM * nN; G = G_; c = c_; }
    __host__ __device__ bool next(int i, Unit& u) const {
        const long L = (long)i * G + c; if (L >= nwg) return false;
        int wgid = (int)L; { const int q = nwg / NXCD, r = nwg % NXCD, xcd = wgid % NXCD, off = wgid / NXCD; wgid = (xcd < r ? xcd * (q + 1) : r * (q + 1) + (xcd - r) * q) + off; }
        const int nig = WGM * nN, gid = wgid / nig, fm = gid * WGM, gsz = (nM - fm) < WGM ? (nM - fm) : WGM;
        u.pm = fm + ((wgid % nig) % gsz); u.pn = (wgid % nig) / gsz; return true;
    }
    __device__ __forceinline__ void a_ready(const Unit&) const {}
    __device__ __forceinline__ void done(const Unit&) const {}
};

__device__ __forceinline__ unsigned cvt_pk_bf16(float lo, float hi) { unsigned r; asm volatile("v_cvt_pk_bf16_f32 %0, %1, %2" : "=v"(r) : "v"(lo), "v"(hi)); return r; }
typedef float f32x2 __attribute__((ext_vector_type(2)));
__device__ __forceinline__ f32x2 gelu_pk(f32x2 v) {
    const f32x2 av = __builtin_elementwise_abs(v), d = av * 0.2316418882f + 1.0f;
    f32x2 t; t.x = __builtin_amdgcn_rcpf(d.x); t.y = __builtin_amdgcn_rcpf(d.y);
    f32x2 q = t * 0.5307027145f + (-0.7265760135f); q = q * t + 0.7107068705f; q = q * t + (-0.142248368f); q = q * t + 0.127414796f; q = q * t;
    const f32x2 s = (v * v) * (-0.72134752044f);
    f32x2 e; e.x = __builtin_amdgcn_exp2f(s.x); e.y = __builtin_amdgcn_exp2f(s.y);
    const f32x2 m = v * (q * e), r = v - m;
    f32x2 o; o.x = v.x < 0.f ? m.x : r.x; o.y = v.y < 0.f ? m.y : r.y; return o;
}

template <int ACT  > struct EpiBf16 {
    static constexpr bool PERM = true, AFTER_DRAIN = false; static_assert(ACT == 0 || ACT == 1, "EpiBf16: ACT is 0 (none) or 1 (gelu_pk)");
    bf16_t* O; int ldc; const float* bias; int split_cols; size_t split_stride; float scale0;
    __device__ __forceinline__ void operator()(const f32x4 (&acc)[2][2][4][2], const Unit& u, int wr, int wc, int fr, int fq) const {
        const int row0 = u.pm * BM + wr * 64 + fr; int colt = u.pn * BM; bf16_t* base = O;
        float sc = 1.f; if (split_cols) { const int t = colt / split_cols; base += (size_t)t * split_stride; colt -= t * split_cols; if (t == 0) sc = scale0; }
        const int col0 = colt + wc * 32 + 8 * fq, bcol0 = u.pn * BM + wc * 32 + 8 * fq;
        f32x4 bv[2][2];
#pragma unroll
        for (int bj = 0; bj < 2; ++bj)
#pragma unroll
            for (int n = 0; n < 2; ++n) bv[bj][n] = bias ? *(const f32x4*)(bias + bcol0 + bj * HALF + 4 * n) : (f32x4){0.f, 0.f, 0.f, 0.f};
#pragma unroll
        for (int ai = 0; ai < 2; ++ai)
#pragma unroll
            for (int m = 0; m < 4; ++m) { bf16_t* rowp = base + (size_t)(row0 + ai * HALF + m * 16) * ldc + col0;
#pragma unroll
                for (int bj = 0; bj < 2; ++bj) { f32x4 v0 = acc[ai][bj][m][0] + bv[bj][0], v1 = acc[ai][bj][m][1] + bv[bj][1];
                    if (ACT == 1) { f32x2 a = gelu_pk((f32x2){v0[0], v0[1]}), b = gelu_pk((f32x2){v0[2], v0[3]}), c = gelu_pk((f32x2){v1[0], v1[1]}), d = gelu_pk((f32x2){v1[2], v1[3]});
                        v0 = (f32x4){a.x, a.y, b.x, b.y}; v1 = (f32x4){c.x, c.y, d.x, d.y}; }
                    v0 = v0 * sc; v1 = v1 * sc; u32x4 w; w.x = cvt_pk_bf16(v0[0], v0[1]); w.y = cvt_pk_bf16(v0[2], v0[3]); w.z = cvt_pk_bf16(v1[0], v1[1]); w.w = cvt_pk_bf16(v1[2], v1[3]);
                    *(u32x4*)(rowp + bj * HALF) = w; } }
    }
};


struct EpiRes {
    static constexpr bool PERM = false, AFTER_DRAIN = false;
    float* Y; const float* res; int ldc; float alpha;
    __device__ __forceinline__ void operator()(const f32x4 (&acc)[2][2][4][2], const Unit& u, int wr, int wc, int fr, int fq) const {
        const int row0 = u.pm * BM + wr * 64 + fr, col0 = u.pn * BM + wc * 32 + 4 * fq;
#pragma unroll
        for (int ai = 0; ai < 2; ++ai)
#pragma unroll
            for (int m = 0; m < 4; ++m) { const size_t off = (size_t)(row0 + ai * HALF + m * 16) * ldc + col0;
#pragma unroll
                for (int bj = 0; bj < 2; ++bj)
#pragma unroll
                    for (int n = 0; n < 2; ++n) { const f32x4 r = *(const f32x4*)(res + off + bj * HALF + n * 16);
                        *(f32x4*)(Y + off + bj * HALF + n * 16) = r * alpha + acc[ai][bj][m][n]; } }
    }
};
struct RangeOrder {
    int nM, nN, ntot, c0, nw, c;
    __host__ __device__ void init(int M, int N, int c0_, int nw_, int c_) { nM = M / BM; nN = N / BM; ntot = nM * nN; c0 = c0_; nw = nw_; c = c_; }
    __host__ __device__ bool next(int i, Unit& u) const {
        if (c < c0 || c >= c0 + nw) return false;
        const int L = i * nw + (c - c0); if (L >= ntot) return false;
        u.pm = L / nN; u.pn = L % nN; return true;
    }
    __device__ __forceinline__ void a_ready(const Unit&) const {}
    __device__ __forceinline__ void done(const Unit&) const {}
};

struct ZeroOrder : StaticOrder {
    __host__ __device__ bool next(int i, Unit& u) const { const bool r = StaticOrder::next(i, u); u.pm = 0; u.pn = 0; return r; }
};

struct EpiResBf {
    static constexpr bool PERM = true, AFTER_DRAIN = false;
    bf16_t* Y; const bf16_t* res; int ldc; float alpha;
    __device__ __forceinline__ void operator()(const f32x4 (&acc)[2][2][4][2], const Unit& u, int wr, int wc, int fr, int fq) const {
        const int row0 = u.pm * BM + wr * 64 + fr, col0 = u.pn * BM + wc * 32 + 8 * fq;
#pragma unroll
        for (int ai = 0; ai < 2; ++ai)
#pragma unroll
            for (int m = 0; m < 4; ++m) { const size_t off = (size_t)(row0 + ai * HALF + m * 16) * ldc + col0;
#pragma unroll
                for (int bj = 0; bj < 2; ++bj) { const u32x4 r = *(const u32x4*)(res + off + bj * HALF);
                    const f32x4 v0 = acc[ai][bj][m][0], v1 = acc[ai][bj][m][1];
                    u32x4 w;
                    w.x = cvt_pk_bf16(__builtin_bit_cast(float, r.x << 16) * alpha + v0[0], __builtin_bit_cast(float, r.x & 0xffff0000u) * alpha + v0[1]);
                    w.y = cvt_pk_bf16(__builtin_bit_cast(float, r.y << 16) * alpha + v0[2], __builtin_bit_cast(float, r.y & 0xffff0000u) * alpha + v0[3]);
                    w.z = cvt_pk_bf16(__builtin_bit_cast(float, r.z << 16) * alpha + v1[0], __builtin_bit_cast(float, r.z & 0xffff0000u) * alpha + v1[1]);
                    w.w = cvt_pk_bf16(__builtin_bit_cast(float, r.w << 16) * alpha + v1[2], __builtin_bit_cast(float, r.w & 0xffff0000u) * alpha + v1[3]);
                    *(u32x4*)(Y + off + bj * HALF) = w; } }
    }
};

struct EpiResF {
    static constexpr bool PERM = true, AFTER_DRAIN = false;
    float* Y; const bf16_t* res; int ldc; float alpha;
    __device__ __forceinline__ void operator()(const f32x4 (&acc)[2][2][4][2], const Unit& u, int wr, int wc, int fr, int fq) const {
        const int row0 = u.pm * BM + wr * 64 + fr, col0 = u.pn * BM + wc * 32 + 8 * fq;
#pragma unroll
        for (int ai = 0; ai < 2; ++ai)
#pragma unroll
            for (int m = 0; m < 4; ++m) { const size_t off = (size_t)(row0 + ai * HALF + m * 16) * ldc + col0;
#pragma unroll
                for (int bj = 0; bj < 2; ++bj) { const u32x4 r = *(const u32x4*)(res + off + bj * HALF);
                    f32x4 o0, o1;
                    o0[0] = __builtin_bit_cast(float, r.x << 16); o0[1] = __builtin_bit_cast(float, r.x & 0xffff0000u); o0[2] = __builtin_bit_cast(float, r.y << 16); o0[3] = __builtin_bit_cast(float, r.y & 0xffff0000u);
                    o1[0] = __builtin_bit_cast(float, r.z << 16); o1[1] = __builtin_bit_cast(float, r.z & 0xffff0000u); o1[2] = __builtin_bit_cast(float, r.w << 16); o1[3] = __builtin_bit_cast(float, r.w & 0xffff0000u);
                    *(f32x4*)(Y + off + bj * HALF) = o0 * alpha + acc[ai][bj][m][0]; *(f32x4*)(Y + off + bj * HALF + 4) = o1 * alpha + acc[ai][bj][m][1]; } }
    }
};

struct EpiResLn {
    static constexpr bool PERM = true, AFTER_DRAIN = false;
    bf16_t* Y; const float* stats; const float* g; const float* b; int ldc; float alpha;
    __device__ __forceinline__ void operator()(const f32x4 (&acc)[2][2][4][2], const Unit& u, int wr, int wc, int fr, int fq) const {
        const int row0 = u.pm * BM + wr * 64 + fr, col0 = u.pn * BM + wc * 32 + 8 * fq;
        f32x4 gv[2][2], bv[2][2];
#pragma unroll
        for (int bj = 0; bj < 2; ++bj)
#pragma unroll
            for (int n = 0; n < 2; ++n) { gv[bj][n] = *(const f32x4*)(g + col0 + bj * HALF + 4 * n) * alpha; bv[bj][n] = *(const f32x4*)(b + col0 + bj * HALF + 4 * n) * alpha; }
#pragma unroll
        for (int ai = 0; ai < 2; ++ai)
#pragma unroll
            for (int m = 0; m < 4; ++m) { const int row = row0 + ai * HALF + m * 16; const size_t off = (size_t)row * ldc + col0;
                const float mean = stats[2 * row], rstd = stats[2 * row + 1];
#pragma unroll
                for (int bj = 0; bj < 2; ++bj) { const u32x4 r = *(const u32x4*)(Y + off + bj * HALF);
                    f32x4 y0, y1;
                    y0[0] = __builtin_bit_cast(float, r.x << 16); y0[1] = __builtin_bit_cast(float, r.x & 0xffff0000u); y0[2] = __builtin_bit_cast(float, r.y << 16); y0[3] = __builtin_bit_cast(float, r.y & 0xffff0000u);
                    y1[0] = __builtin_bit_cast(float, r.z << 16); y1[1] = __builtin_bit_cast(float, r.z & 0xffff0000u); y1[2] = __builtin_bit_cast(float, r.w << 16); y1[3] = __builtin_bit_cast(float, r.w & 0xffff0000u);
                    const f32x4 o0 = (y0 - mean) * rstd * gv[bj][0] + bv[bj][0] + acc[ai][bj][m][0], o1 = (y1 - mean) * rstd * gv[bj][1] + bv[bj][1] + acc[ai][bj][m][1];
                    u32x4 w; w.x = cvt_pk_bf16(o0[0], o0[1]); w.y = cvt_pk_bf16(o0[2], o0[3]); w.z = cvt_pk_bf16(o1[0], o1[1]); w.w = cvt_pk_bf16(o1[2], o1[3]);
                    *(u32x4*)(Y + off + bj * HALF) = w; } }
    }
};

constexpr float RS_SCALE = 1048576.0f, RS_INV = 1.0f / 1048576.0f;
__device__ __forceinline__ float fx20_to_f(long long v) { return (float)(int)(v >> 20) + (float)((unsigned)v & 0xFFFFFu) * RS_INV; }
__device__ __forceinline__ long long f_to_fx20(float s) { const float fl = floorf(s); return ((long long)(int)fl << 20) + (long long)(unsigned)((s - fl) * RS_SCALE + 0.5f); }
__device__ __forceinline__ void row_stats(const long long* rs, int row, float& mean, float& rstd) {
    const long long a = rs[2 * (size_t)row], b = rs[2 * (size_t)row + 1];
    mean = fx20_to_f(a) * (1.0f / 4096.0f); const float var = fx20_to_f(b) * (1.0f / 4096.0f) - mean * mean; rstd = 1.0f / sqrtf(var + 1e-5f);
}
constexpr float FOLD_SCALE = 4294967296.0f, FOLD_INV = 1.0f / 4294967296.0f;
struct EpiBf16Ln {
    static constexpr bool PERM = true, AFTER_DRAIN = false;
    bf16_t* O; int ldc; const long long* rs; const float* cs; const float* b2;
    __device__ __forceinline__ void operator()(const f32x4 (&acc)[2][2][4][2], const Unit& u, int wr, int wc, int fr, int fq) const {
        const int row0 = u.pm * BM + wr * 64 + fr, col0 = u.pn * BM + wc * 32 + 8 * fq;
        f32x4 cv[2][2], bv[2][2];
#pragma unroll
        for (int bj = 0; bj < 2; ++bj)
#pragma unroll
            for (int n = 0; n < 2; ++n) { cv[bj][n] = *(const f32x4*)(cs + col0 + bj * HALF + 4 * n); bv[bj][n] = *(const f32x4*)(b2 + col0 + bj * HALF + 4 * n); }
#pragma unroll
        for (int ai = 0; ai < 2; ++ai)
#pragma unroll
            for (int m = 0; m < 4; ++m) { const int row = row0 + ai * HALF + m * 16; float mean, rstd; row_stats(rs, row, mean, rstd);
                bf16_t* rowp = O + (size_t)row * ldc + col0;
#pragma unroll
                for (int bj = 0; bj < 2; ++bj) { const f32x4 v0 = (acc[ai][bj][m][0] - cv[bj][0] * mean) * rstd + bv[bj][0], v1 = (acc[ai][bj][m][1] - cv[bj][1] * mean) * rstd + bv[bj][1];
                    u32x4 w; w.x = cvt_pk_bf16(v0[0], v0[1]); w.y = cvt_pk_bf16(v0[2], v0[3]); w.z = cvt_pk_bf16(v1[0], v1[1]); w.w = cvt_pk_bf16(v1[2], v1[3]);
                    *(u32x4*)(rowp + bj * HALF) = w; } }
    }
};
__device__ __forceinline__ void row_sums_add(long long* rso, int row, const f32x4& a, const f32x4& b, const f32x4& c, const f32x4& d, int fq) {
    float s1 = ((a[0] + a[1]) + (a[2] + a[3])) + ((b[0] + b[1]) + (b[2] + b[3])) + ((c[0] + c[1]) + (c[2] + c[3])) + ((d[0] + d[1]) + (d[2] + d[3]));
    float s2 = ((a[0] * a[0] + a[1] * a[1]) + (a[2] * a[2] + a[3] * a[3])) + ((b[0] * b[0] + b[1] * b[1]) + (b[2] * b[2] + b[3] * b[3]))
             + ((c[0] * c[0] + c[1] * c[1]) + (c[2] * c[2] + c[3] * c[3])) + ((d[0] * d[0] + d[1] * d[1]) + (d[2] * d[2] + d[3] * d[3]));
    s1 += __shfl_xor(s1, 16); s1 += __shfl_xor(s1, 32); s2 += __shfl_xor(s2, 16); s2 += __shfl_xor(s2, 32);
    if (fq == 0) { atomicAdd((unsigned long long*)(rso + 2 * (size_t)row), (unsigned long long)f_to_fx20(s1)); atomicAdd((unsigned long long*)(rso + 2 * (size_t)row + 1), (unsigned long long)f_to_fx20(s2)); }
}
struct EpiRes0 {
    static constexpr bool PERM = true, AFTER_DRAIN = false;
    bf16_t* Y; const bf16_t* res; int ldc; float alpha; long long* rso;
    __device__ __forceinline__ void operator()(const f32x4 (&acc)[2][2][4][2], const Unit& u, int wr, int wc, int fr, int fq) const {
        const int row0 = u.pm * BM + wr * 64 + fr, col0 = u.pn * BM + wc * 32 + 8 * fq;
#pragma unroll
        for (int ai = 0; ai < 2; ++ai)
#pragma unroll
            for (int m = 0; m < 4; ++m) { const int row = row0 + ai * HALF + m * 16; const size_t off = (size_t)row * ldc + col0; f32x4 o[2][2];
#pragma unroll
                for (int bj = 0; bj < 2; ++bj) { const u32x4 r = *(const u32x4*)(res + off + bj * HALF);
                    f32x4 y0, y1;
                    y0[0] = __builtin_bit_cast(float, r.x << 16); y0[1] = __builtin_bit_cast(float, r.x & 0xffff0000u); y0[2] = __builtin_bit_cast(float, r.y << 16); y0[3] = __builtin_bit_cast(float, r.y & 0xffff0000u);
                    y1[0] = __builtin_bit_cast(float, r.z << 16); y1[1] = __builtin_bit_cast(float, r.z & 0xffff0000u); y1[2] = __builtin_bit_cast(float, r.w << 16); y1[3] = __builtin_bit_cast(float, r.w & 0xffff0000u);
                    o[bj][0] = y0 * alpha + acc[ai][bj][m][0]; o[bj][1] = y1 * alpha + acc[ai][bj][m][1];
                    u32x4 w; w.x = cvt_pk_bf16(o[bj][0][0], o[bj][0][1]); w.y = cvt_pk_bf16(o[bj][0][2], o[bj][0][3]); w.z = cvt_pk_bf16(o[bj][1][0], o[bj][1][1]); w.w = cvt_pk_bf16(o[bj][1][2], o[bj][1][3]);
                    *(u32x4*)(Y + off + bj * HALF) = w; }
                row_sums_add(rso, row, o[0][0], o[0][1], o[1][0], o[1][1], fq); }
    }
};
struct EpiResLn2 {
    static constexpr bool PERM = true, AFTER_DRAIN = false;
    bf16_t* Y; const long long* rsi; const float* g; const float* b; int ldc; float alpha; long long* rso;
    __device__ __forceinline__ void operator()(const f32x4 (&acc)[2][2][4][2], const Unit& u, int wr, int wc, int fr, int fq) const {
        const int row0 = u.pm * BM + wr * 64 + fr, col0 = u.pn * BM + wc * 32 + 8 * fq;
        f32x4 gv[2][2], bv[2][2];
#pragma unroll
        for (int bj = 0; bj < 2; ++bj)
#pragma unroll
            for (int n = 0; n < 2; ++n) { gv[bj][n] = *(const f32x4*)(g + col0 + bj * HALF + 4 * n) * alpha; bv[bj][n] = *(const f32x4*)(b + col0 + bj * HALF + 4 * n) * alpha; }
#pragma unroll
        for (int ai = 0; ai < 2; ++ai)
#pragma unroll
            for (int m = 0; m < 4; ++m) { const int row = row0 + ai * HALF + m * 16; const size_t off = (size_t)row * ldc + col0; float mean, rstd; row_stats(rsi, row, mean, rstd); f32x4 o[2][2];
#pragma unroll
                for (int bj = 0; bj < 2; ++bj) { const u32x4 r = *(const u32x4*)(Y + off + bj * HALF);
                    f32x4 y0, y1;
                    y0[0] = __builtin_bit_cast(float, r.x << 16); y0[1] = __builtin_bit_cast(float, r.x & 0xffff0000u); y0[2] = __builtin_bit_cast(float, r.y << 16); y0[3] = __builtin_bit_cast(float, r.y & 0xffff0000u);
                    y1[0] = __builtin_bit_cast(float, r.z << 16); y1[1] = __builtin_bit_cast(float, r.z & 0xffff0000u); y1[2] = __builtin_bit_cast(float, r.w << 16); y1[3] = __builtin_bit_cast(float, r.w & 0xffff0000u);
                    o[bj][0] = (y0 - mean) * rstd * gv[bj][0] + bv[bj][0] + acc[ai][bj][m][0]; o[bj][1] = (y1 - mean) * rstd * gv[bj][1] + bv[bj][1] + acc[ai][bj][m][1];
                    u32x4 w; w.x = cvt_pk_bf16(o[bj][0][0], o[bj][0][1]); w.y = cvt_pk_bf16(o[bj][0][2], o[bj][0][3]); w.z = cvt_pk_bf16(o[bj][1][0], o[bj][1][1]); w.w = cvt_pk_bf16(o[bj][1][2], o[bj][1][3]);
                    *(u32x4*)(Y + off + bj * HALF) = w; }
                row_sums_add(rso, row, o[0][0], o[0][1], o[1][0], o[1][1], fq); }
    }
};
template <class Epi, class Sched, bool ALIGN_EPI = false, bool SP2 = false>
__device__ __forceinline__ void gemm_phase(PG8_LAS unsigned char* lds, const Gemm g, const Sched& S, const Epi& E) {
    int tid_l = threadIdx.x; asm volatile("" : "+v"(tid_l)); const int tid = tid_l, wid = __builtin_amdgcn_readfirstlane(tid >> 6), lane = tid & 63, wr = wid >> 2, wc = wid & 3, fr = lane & 15, fq = lane >> 4;
    const int K = g.K, nt = K / BK;
    unsigned voffA[2], voffB[2];
#pragma unroll
    for (int i = 0; i < 2; ++i) { int R, C; stage_rc(tid * 16 + i * 8192, R, C); const int Rb = Epi::PERM ? ((R & ~31) + perm32(R & 31)) : R;
        voffA[i] = (unsigned)(R * K + C) * 2u; voffB[i] = (unsigned)(Rb * K + C) * 2u; }
    const size_t kstep = (size_t)(BK * 2);
    const size_t hstep = (size_t)HALF * K * 2;
    const size_t tstep = 2 * hstep;
    const unsigned ldsw = (unsigned)wid * 1024u;
    const int aoff = lds_byte(wr * 64 + fr, fq * 8), boff = lds_byte(wc * 32 + fr, fq * 8);
#define PG8_SA(b, h) (((b) * 2 + (h)) * HTB)
#define PG8_SB(b, h) ((4 + (b) * 2 + (h)) * HTB)
#define PG8_STAGE(bufoff, gbase, voff) do { _Pragma("unroll") for (int _i = 0; _i < 2; ++_i) \
        __builtin_amdgcn_global_load_lds((const unsigned*)((const char*)(gbase) + (voff)[_i]), (PG8_LAS unsigned*)(lds + (bufoff) + ldsw + _i * 8192), 16, 0, 0); } while (0)
#define PG8_LDA(dst, b, h) do { _Pragma("unroll") for (int m = 0; m < 4; ++m) _Pragma("unroll") for (int k = 0; k < 2; ++k) dst[m][k] = *(const PG8_LAS bf16x8*)(lds + PG8_SA(b, h) + aoff + m * 2048 + k * 1024); } while (0)
#define PG8_LDB(dst, b, h) do { _Pragma("unroll") for (int n = 0; n < 2; ++n) _Pragma("unroll") for (int k = 0; k < 2; ++k) dst[n][k] = *(const PG8_LAS bf16x8*)(lds + PG8_SB(b, h) + boff + n * 2048 + k * 1024); } while (0)
#define PG8_MMA(ai, bj, At, Bt) do { __builtin_amdgcn_s_setprio(1); _Pragma("unroll") for (int m = 0; m < 4; ++m) _Pragma("unroll") for (int n = 0; n < 2; ++n) _Pragma("unroll") for (int k = 0; k < 2; ++k) \
        acc[ai][bj][m][n] = __builtin_amdgcn_mfma_f32_16x16x32_bf16(Bt[n][k], At[m][k], acc[ai][bj][m][n], 0, 0, 0); __builtin_amdgcn_s_setprio(0); } while (0)
#define PG8_WAIT_V(n) asm volatile("s_waitcnt vmcnt(" #n ")" ::: "memory")
#define PG8_WAIT_L(n) asm volatile("s_waitcnt lgkmcnt(" #n ")" ::: "memory")
#define PG8_BAR __builtin_amdgcn_s_barrier()
#define PG8_SCHED __builtin_amdgcn_sched_barrier(0)
    Unit cur, nxt; int ui = 0;
    if (!S.next(0, cur)) return;
    f32x4 acc[2][2][4][2];
#pragma unroll
    for (int a = 0; a < 2; ++a)
#pragma unroll
        for (int b = 0; b < 2; ++b)
#pragma unroll
            for (int m = 0; m < 4; ++m)
#pragma unroll
                for (int n = 0; n < 2; ++n) acc[a][b][m][n] = (f32x4){0.f, 0.f, 0.f, 0.f};
    bf16x8 At[4][2], B0[2][2], B1[2][2];
    const char* cA = (const char*)g.A + (size_t)cur.pm * tstep; const char* cB = (const char*)g.Bt + (size_t)cur.pn * tstep;
    S.a_ready(cur);
    if constexpr (SP2) {
        PG8_STAGE(PG8_SB(0, 0), cB, voffB); PG8_STAGE(PG8_SB(0, 1), cB + hstep, voffB); PG8_STAGE(PG8_SA(0, 0), cA, voffA); PG8_STAGE(PG8_SA(0, 1), cA + hstep, voffA);
        if (wr == 1) PG8_BAR;
        PG8_WAIT_V(2); PG8_BAR;
        PG8_STAGE(PG8_SB(1, 0), cB + kstep, voffB); PG8_STAGE(PG8_SA(1, 0), cA + kstep, voffA); PG8_STAGE(PG8_SB(1, 1), cB + hstep + kstep, voffB);
        PG8_WAIT_V(6); PG8_BAR;
    } else {
        PG8_STAGE(PG8_SB(0, 0), cB, voffB); PG8_STAGE(PG8_SA(0, 0), cA, voffA); PG8_STAGE(PG8_SB(0, 1), cB + hstep, voffB); PG8_STAGE(PG8_SA(0, 1), cA + hstep, voffA);
        if (wr == 1) PG8_BAR;
        PG8_WAIT_V(4); PG8_BAR;
        PG8_STAGE(PG8_SB(1, 0), cB + kstep, voffB); PG8_STAGE(PG8_SA(1, 0), cA + kstep, voffA); PG8_STAGE(PG8_SB(1, 1), cB + hstep + kstep, voffB);
        PG8_WAIT_V(6); PG8_BAR;
    }
    for (;;) {
        const bool has_next = S.next(ui + 1, nxt);
        const char* nA = has_next ? (const char*)g.A + (size_t)nxt.pm * tstep : cA; const char* nB = has_next ? (const char*)g.Bt + (size_t)nxt.pn * tstep : cB;
        for (int t = 0; t < nt; t += 2) {
            const bool last = (t == nt - 2);
            const char* a1 = cA + (size_t)(t + 1) * kstep;
            const char* a2 = last ? nA : cA + (size_t)(t + 2) * kstep; const char* b2 = last ? nB : cB + (size_t)(t + 2) * kstep;
            const char* a3 = a2 + kstep; const char* b3 = b2 + kstep;
            if (last && has_next) S.a_ready(nxt);
            if constexpr (SP2) {
            PG8_LDB(B0, 0, 0); PG8_LDB(B1, 0, 1); PG8_SCHED; PG8_LDA(At, 0, 0); PG8_STAGE(PG8_SA(1, 1), a1 + hstep, voffA);
            PG8_WAIT_V(8); PG8_WAIT_L(0); PG8_BAR; PG8_MMA(0, 0, At, B0); PG8_MMA(0, 1, At, B1); PG8_BAR; PG8_SCHED;
            PG8_LDA(At, 0, 1); PG8_STAGE(PG8_SB(0, 0), b2, voffB); PG8_STAGE(PG8_SB(0, 1), b2 + hstep, voffB); PG8_STAGE(PG8_SA(0, 0), a2, voffA);
            PG8_WAIT_V(8); PG8_WAIT_L(0); PG8_BAR; PG8_MMA(1, 0, At, B0); PG8_MMA(1, 1, At, B1); PG8_BAR; PG8_SCHED;
            PG8_LDB(B0, 1, 0); PG8_LDB(B1, 1, 1); PG8_SCHED; PG8_LDA(At, 1, 0); PG8_STAGE(PG8_SA(0, 1), a2 + hstep, voffA);
            PG8_WAIT_V(8); PG8_WAIT_L(0); PG8_BAR; PG8_MMA(0, 0, At, B0); PG8_MMA(0, 1, At, B1); PG8_BAR; PG8_SCHED;
            PG8_LDA(At, 1, 1); PG8_STAGE(PG8_SB(1, 0), b3, voffB); PG8_STAGE(PG8_SB(1, 1), b3 + hstep, voffB); PG8_STAGE(PG8_SA(1, 0), a3, voffA);
            PG8_WAIT_V(8); PG8_WAIT_L(0); PG8_BAR; PG8_MMA(1, 0, At, B0); PG8_MMA(1, 1, At, B1); PG8_BAR; PG8_SCHED;
            } else {
            PG8_LDB(B0, 0, 0); PG8_SCHED; PG8_LDA(At, 0, 0); PG8_STAGE(PG8_SA(1, 1), a1 + hstep, voffA);
            PG8_WAIT_L(8); PG8_BAR; PG8_WAIT_L(0); PG8_MMA(0, 0, At, B0); PG8_BAR; PG8_SCHED;
            PG8_LDB(B1, 0, 1); PG8_STAGE(PG8_SB(0, 0), b2, voffB);
            PG8_BAR; PG8_WAIT_L(0); PG8_MMA(0, 1, At, B1); PG8_BAR;
            PG8_LDA(At, 0, 1); PG8_STAGE(PG8_SA(0, 0), a2, voffA);
            PG8_BAR; PG8_WAIT_L(0); PG8_MMA(1, 0, At, B0); PG8_BAR; PG8_SCHED;
            PG8_STAGE(PG8_SB(0, 1), b2 + hstep, voffB);
            PG8_WAIT_V(6); PG8_BAR; PG8_MMA(1, 1, At, B1); PG8_BAR;
            PG8_LDB(B0, 1, 0); PG8_SCHED; PG8_LDA(At, 1, 0); PG8_STAGE(PG8_SA(0, 1), a2 + hstep, voffA);
            PG8_WAIT_L(8); PG8_BAR; PG8_WAIT_L(0); PG8_MMA(0, 0, At, B0); PG8_BAR; PG8_SCHED;
            PG8_LDB(B1, 1, 1); PG8_STAGE(PG8_SB(1, 0), b3, voffB);
            PG8_BAR; PG8_WAIT_L(0); PG8_MMA(0, 1, At, B1); PG8_BAR;
            PG8_LDA(At, 1, 1); PG8_STAGE(PG8_SA(1, 0), a3, voffA);
            PG8_BAR; PG8_WAIT_L(0); PG8_MMA(1, 0, At, B0); PG8_BAR; PG8_SCHED;
            PG8_STAGE(PG8_SB(1, 1), b3 + hstep, voffB);
            PG8_WAIT_V(6); PG8_BAR; PG8_MMA(1, 1, At, B1); PG8_BAR;
            }
        }
        if constexpr (ALIGN_EPI) { if (wr == 0) PG8_BAR; }
        if constexpr (!Epi::AFTER_DRAIN) { E(acc, cur, wr, wc, fr, fq); S.done(cur); }
        if (!has_next) break;
#pragma unroll
        for (int a = 0; a < 2; ++a)
#pragma unroll
            for (int b = 0; b < 2; ++b)
#pragma unroll
                for (int m = 0; m < 4; ++m)
#pragma unroll
                    for (int n = 0; n < 2; ++n) acc[a][b][m][n] = (f32x4){0.f, 0.f, 0.f, 0.f};
        cur = nxt; cA = nA; cB = nB; ++ui;
        if constexpr (ALIGN_EPI) { if (wr == 1) PG8_BAR; }
    }
    PG8_WAIT_V(0);
    if constexpr (!ALIGN_EPI) { if (wr == 0) PG8_BAR; }
    PG8_BAR;
    if constexpr (Epi::AFTER_DRAIN) { E.fused(acc, cur, wr, wc, fr, fq, lds, wid, lane); S.done(cur); }
#undef PG8_SA
#undef PG8_SB
#undef PG8_STAGE
#undef PG8_LDA
#undef PG8_LDB
#undef PG8_MMA
#undef PG8_WAIT_V
#undef PG8_WAIT_L
#undef PG8_BAR
#undef PG8_SCHED
}
}

#ifndef PG8_SP2
#define PG8_SP2 true
#endif
#ifndef PG8_ALIGN
#define PG8_ALIGN true
#endif
constexpr int NWAVES = 8, NTHR = 512;
constexpr int BATCH = 2, SEQ = 8192, DM = 4096, MTOK = BATCH * SEQ;
constexpr int HD = 128;
constexpr int A_HEADS = 16, B_HEADS = 16, A_W = 2048, B_W = 2048, AB_IN = 4 * A_W + 3 * B_W;
constexpr int NSA_H = 32, NSA_G = 4, NSA_R = 8, KVW = 512, NSA_IN = 4096 + 6 * KVW + 96, NSA_INP = 7424;
constexpr int NCMP = 511, NCMPP = 512, NSLC = 128, NTOP = 16, WINDOW = 512;
constexpr int NMEM = 256, XH = 4, XW = 512;
constexpr int DFF = 11008, DFF2 = 22016;
constexpr float LN_EPS = 1e-5f, RMS_EPS = 1e-6f;
constexpr float DN_ALPHA = 1.41421356237309515f;
constexpr size_t MiB = (size_t)1 << 20;
constexpr size_t WS_CTL = 0, CTL_ZERO_BYTES = 4 * MiB;
constexpr size_t WS_FOLD = 64 * 1024;
constexpr int FO_XQ = 0, FO_UP = 2 * 512, FO_NSA = FO_UP + 2 * 22016, FO_N = FO_NSA + 7424;
constexpr size_t WS_RSUM = 1 * MiB;
static_assert(WS_FOLD + (size_t)2 * FO_N * 8 <= WS_RSUM && WS_RSUM + (size_t)6 * 16384 * 2 * 8 <= CTL_ZERO_BYTES, "CTL map");
constexpr size_t WS_W_ABIN = 4 * MiB;
constexpr size_t WS_W_ABOUT = WS_W_ABIN + 112 * MiB;
constexpr size_t WS_W_NSAIN = WS_W_ABOUT + 32 * MiB;
constexpr size_t WS_W_NSAOUT = WS_W_NSAIN + 58 * MiB;
constexpr size_t WS_W_XQ = WS_W_NSAOUT + 32 * MiB;
constexpr size_t WS_W_XKV = WS_W_XQ + 8 * MiB;
constexpr size_t WS_W_XO = WS_W_XKV + 16 * MiB;
constexpr size_t WS_W_UP = WS_W_XO + 8 * MiB;
constexpr size_t WS_W_DOWN = WS_W_UP + 344 * MiB;
constexpr size_t WS_W_C1 = WS_W_DOWN + 172 * MiB;
constexpr size_t WS_W_C2 = WS_W_C1 + 2 * MiB;
constexpr size_t WS_MEMB = WS_W_C2 + 1 * MiB;
constexpr size_t WS_HB = WS_MEMB + 4 * MiB;
constexpr size_t WS_Y = WS_HB + 128 * MiB;
constexpr size_t WS_BIG = WS_Y + 256 * MiB;
constexpr size_t WS_G = WS_BIG + 688 * MiB;
constexpr size_t WS_O = WS_G + 344 * MiB;
constexpr size_t WS_MISC = WS_O + 128 * MiB;
constexpr size_t WS_END = WS_MISC + 64 * MiB;
constexpr size_t WS_XQ = WS_MISC;
constexpr size_t WS_XO = WS_MISC + 16 * MiB;
constexpr size_t WS_XKV = WS_MISC + 32 * MiB;
constexpr size_t WS_LB = WS_MISC + 34 * MiB;
constexpr size_t WS_FOLDF = WS_MISC + 40 * MiB;
constexpr size_t WS_ROPE = WS_MISC + 36 * MiB;
constexpr size_t WS_STATS = WS_MISC + 35 * MiB;
constexpr size_t WS_PROJ0 = WS_BIG;
constexpr size_t WS_SPREV = WS_BIG + 448 * MiB;
constexpr size_t WS_QT = WS_G;
constexpr size_t WS_OINTRA = WS_G + 64 * MiB;
constexpr size_t WS_DEC = WS_G + 192 * MiB;
constexpr size_t WS_DS = WS_Y;
constexpr size_t WS_PROJ1 = WS_BIG;
constexpr size_t WS_QROT = WS_BIG + 232 * MiB;
constexpr size_t WS_KSROT = WS_BIG + 360 * MiB;
constexpr size_t WS_KWROT = WS_BIG + 376 * MiB;
constexpr size_t WS_KCMP = WS_BIG + 392 * MiB;
constexpr size_t WS_VCMP = WS_BIG + 393 * MiB;
constexpr size_t WS_OVL = WS_BIG + 394 * MiB;
constexpr size_t WS_SEL = WS_BIG + 395 * MiB;
constexpr size_t WS_IMP = WS_G + 256 * MiB;
constexpr size_t WS_O32 = WS_G;
static_assert(WS_SPREV + 128 * MiB <= WS_G && WS_DEC + 2 * MiB <= WS_O && WS_SEL + MiB <= WS_G, "ws map");
constexpr int CW_TMO = 0, CW_CODE = 1;
constexpr int CW_BAR = 4096;
constexpr int RING_OFF = 0, RING_BYTES = 131072;
constexpr int LDSCTL_OFF = RING_BYTES, MISC_OFF = LDSCTL_OFF + 320;
constexpr int LDS_BYTES = 147456;
static_assert(MISC_OFF + 128 <= LDS_BYTES, "LDS map");

#define GAS __attribute__((address_space(1)))
#define LAS __attribute__((address_space(3)))
typedef unsigned short bf16;
typedef unsigned v4u __attribute__((ext_vector_type(4)));
typedef unsigned v2u __attribute__((ext_vector_type(2)));
typedef float f32x4 __attribute__((ext_vector_type(4)));
typedef float f32x2 __attribute__((ext_vector_type(2)));
typedef float f32x16 __attribute__((ext_vector_type(16)));
typedef short bf16x8 __attribute__((ext_vector_type(8)));
typedef short s16x4 __attribute__((ext_vector_type(4)));
typedef GAS unsigned gu32;
#define RLX_AGENT __ATOMIC_RELAXED, __HIP_MEMORY_SCOPE_AGENT
#define LDS_WAIT() asm volatile("s_waitcnt lgkmcnt(0)" ::: "memory")
#define VM_WAIT() asm volatile("s_waitcnt vmcnt(0)" ::: "memory")
#define SBAR() __builtin_amdgcn_sched_barrier(0)
__device__ __forceinline__ unsigned f2bf(float f) { unsigned u = __builtin_bit_cast(unsigned, f); return (u + 0x7fffu + ((u >> 16) & 1u)) >> 16; }
__device__ __forceinline__ unsigned pk2(float lo, float hi) { return f2bf(lo) | (f2bf(hi) << 16); }
__device__ __forceinline__ float bf2f(unsigned short b) { return __builtin_bit_cast(float, (unsigned)b << 16); }
__device__ __forceinline__ float bflo(unsigned w) { return __builtin_bit_cast(float, w << 16); }
__device__ __forceinline__ float bfhi(unsigned w) { return __builtin_bit_cast(float, w & 0xffff0000u); }
__device__ __forceinline__ unsigned cvtpk(float lo, float hi) { unsigned r; asm volatile("v_cvt_pk_bf16_f32 %0, %1, %2" : "=v"(r) : "v"(lo), "v"(hi)); return r; }
__device__ __forceinline__ float wave_sum(float v) {
#pragma unroll
    for (int o = 1; o < 64; o <<= 1) v += __shfl_xor(v, o);
    return v;
}
__device__ __forceinline__ float sigmoidf_(float x) { return __builtin_amdgcn_rcpf(1.f + __builtin_amdgcn_exp2f(-1.4426950408889634f * x)); }
__device__ __forceinline__ float gelu1(float v) { pg8::f32x2 r = pg8::gelu_pk((pg8::f32x2){v, 0.f}); return r.x; }
#define XB_TMO      128
#define XB_XCNT(j)  (256  + 64 * (j))
#define XB_XSUB(j)  (1280 + 64 * (j))
#define XB_XGEN(j)  (2304 + 64 * (j))
#define XB_TOP      3328
#define XB_TOPGEN   3392
#define XCD_BAR_WORDS 3456
#define XB_SPIN_CAP (1u << 18)
#define LAS __attribute__((address_space(3)))

__device__ __forceinline__ unsigned xb_ld(unsigned* p)              { return __hip_atomic_load(p, __ATOMIC_RELAXED, __HIP_MEMORY_SCOPE_AGENT); }
__device__ __forceinline__ unsigned xb_add(unsigned* p, unsigned v) { return __hip_atomic_fetch_add(p, v, __ATOMIC_RELAXED, __HIP_MEMORY_SCOPE_AGENT); }
__device__ __forceinline__ unsigned xb_xcc_id() { return (unsigned)__builtin_amdgcn_s_getreg((3 << 11) | 20) & 0xFu; }
#define XB_SPIN(cond, bar) do { unsigned _sp = 0; while (cond) { __builtin_amdgcn_s_sleep(1); \
    if ((++_sp & 255u) == 0u) { if (xb_ld(&(bar)[XB_TMO])) break; if (_sp > XB_SPIN_CAP) { atomicAdd(&(bar)[XB_TMO], 1u); break; } } } } while (0)

struct XcdBarrier {
    unsigned* bar; unsigned x;
    volatile LAS unsigned* st;
};

__device__ __forceinline__ XcdBarrier xcd_barrier_post(unsigned* bar, volatile LAS unsigned* st) {
    XcdBarrier b; b.bar = bar; b.x = xb_xcc_id(); b.st = st;
    if (threadIdx.x == 0) (void)xb_add(&bar[XB_XCNT(b.x)], 1u);
    return b;
}
__device__ __forceinline__ void xcd_barrier_complete(unsigned* bar, unsigned x, unsigned& nloc, unsigned& nx) {
    const unsigned G = gridDim.x * gridDim.y * gridDim.z;
    unsigned sum, cnt, mine, sp = 0u;
    for (;;) {
        sum = 0u; cnt = 0u; mine = 0u;
#pragma unroll
        for (unsigned j = 0; j < 16; ++j) { const unsigned c = xb_ld(&bar[XB_XCNT(j)]); sum += c; cnt += (c > 0u) ? 1u : 0u; mine = (j == x) ? c : mine; }
        if (sum == G) break;
        __builtin_amdgcn_s_sleep(1);
        if ((++sp & 255u) == 0u) { if (xb_ld(&bar[XB_TMO])) break; if (sp > XB_SPIN_CAP) { atomicAdd(&bar[XB_TMO], 1u); break; } }
    }
    nloc = mine > 0u ? mine : 1u; nx = cnt > 0u ? cnt : 1u;
}

__device__ __forceinline__ void xcd_barrier(const XcdBarrier& b) {
    asm volatile("s_waitcnt vmcnt(0)" ::: "memory");
    __syncthreads();
    if (threadIdx.x == 0) {
        unsigned* bar = b.bar;
        __builtin_amdgcn_s_waitcnt(0);
        unsigned nloc = b.st[0], nx = b.st[1];
        if (nloc == 0u) { xcd_barrier_complete(bar, b.x, nloc, nx); b.st[0] = nloc; b.st[1] = nx; }
        const unsigned old = xb_add(&bar[XB_XSUB(b.x)], 1u);
        const unsigned gen = old / nloc;
        if (old + 1u == (gen + 1u) * nloc) {
            __builtin_amdgcn_fence(__ATOMIC_RELEASE, "agent");
            asm volatile("s_waitcnt vmcnt(0)" ::: "memory");
            const unsigned og = xb_add(&bar[XB_TOP], 1u);
            const unsigned tg = og / nx;
            if (og + 1u == (tg + 1u) * nx) xb_add(&bar[XB_TOPGEN], 1u);
            else XB_SPIN(xb_ld(&bar[XB_TOPGEN]) == tg, bar);
            __builtin_amdgcn_fence(__ATOMIC_ACQUIRE, "agent");
            xb_add(&bar[XB_XGEN(b.x)], 1u);
            asm volatile("s_waitcnt vmcnt(0)" ::: "memory");
        } else {
            XB_SPIN(xb_ld(&bar[XB_XGEN(b.x)]) == gen, bar);
            __builtin_amdgcn_fence(__ATOMIC_ACQUIRE, "agent");
            asm volatile("s_waitcnt vmcnt(0)" ::: "memory");
        }
    }
    __syncthreads();
}


constexpr int ATT_D = 128, KVBLK = 64;
constexpr int SHM_V = KVBLK * ATT_D * 2, SHM_K = KVBLK * ATT_D * 2;
constexpr int ATT_K_OFF = 0, ATT_V_OFF = SHM_K, ATT_BUF = SHM_K + SHM_V, ATT_SET = 2 * ATT_BUF;
constexpr int ATT_WS_OFF = RING_BYTES + 512;
constexpr int ATT_X_OFF = ATT_WS_OFF + NWAVES * 256;
static_assert(2 * ATT_SET <= RING_BYTES && ATT_X_OFF + 1024 <= LDS_BYTES, "attention LDS map");
#define KSWZ(row, colB) ((row) * 256 + ((colB) ^ (((row) & 7) << 4)))
__device__ __forceinline__ int crow(int r, int hi) { return (r & 3) + 8 * (r >> 2) + 4 * hi; }
__device__ __forceinline__ int v_st(int k, int c) { const int kk = (k & ~0xC) | ((k & 4) << 1) | ((k & 8) >> 1); return ((kk >> 3) * 4 + (c >> 5)) * 512 + ((kk & 7) * 32 + (c & 31)) * 2; }
__device__ __forceinline__ int v_rd_base(int lane) { return ((lane & 3) << 3) | (((lane >> 2) & 3) << 6) | (((lane >> 4) & 1) << 5) | (((lane >> 5) & 1) << 8); }
constexpr int v_rd_off(int d0, int ks, int half) { return d0 * 512 + ks * 4096 + half * 2048; }
template <int OFF> __device__ __forceinline__ s16x4 tr_read(int vb) {
  s16x4 r; asm volatile("ds_read_b64_tr_b16 %0, %1 offset:%2" : "=&v"(r) : "v"(vb), "i"(OFF) : "memory"); return r;
}
__device__ __forceinline__ void qkt(f32x16& p0, f32x16& p1, const LAS char* Ks, const bf16x8* qr, int r32, int hi) {
  p0 = f32x16{}; p1 = f32x16{};
#pragma unroll
  for (int d0 = 0; d0 < 8; ++d0) { const int cb = (d0 * 16 + hi * 8) * 2;
    const bf16x8 b0 = *(const LAS bf16x8*)(Ks + KSWZ(r32, cb));
    const bf16x8 b1 = *(const LAS bf16x8*)(Ks + KSWZ(32 + r32, cb));
    p0 = __builtin_amdgcn_mfma_f32_32x32x16_bf16(b0, qr[d0], p0, 0, 0, 0);
    p1 = __builtin_amdgcn_mfma_f32_32x32x16_bf16(b1, qr[d0], p1, 0, 0, 0); }
}
__device__ __forceinline__ void pack_p(const f32x16& p0, const f32x16& p1, bf16x8& pa0, bf16x8& pa1, bf16x8& pa2, bf16x8& pa3) {
#define PK4(P, BASE, OUT) do { unsigned a0 = cvtpk(P[BASE + 0], P[BASE + 1]), a1 = cvtpk(P[BASE + 2], P[BASE + 3]);   \
    unsigned b0 = cvtpk(P[BASE + 4], P[BASE + 5]), b1 = cvtpk(P[BASE + 6], P[BASE + 7]);                              \
    auto r0 = __builtin_amdgcn_permlane32_swap(a0, b0, false, false); auto r1 = __builtin_amdgcn_permlane32_swap(a1, b1, false, false); \
    v4u w = {r0[0], r1[0], r0[1], r1[1]}; OUT = __builtin_bit_cast(bf16x8, w); } while (0)
  PK4(p0, 0, pa0); PK4(p0, 8, pa1); PK4(p1, 0, pa2); PK4(p1, 8, pa3);
#undef PK4
}
template <int D0> __device__ __forceinline__ void pv_one(f32x16& od, int vb, bf16x8 pa0, bf16x8 pa1, bf16x8 pa2, bf16x8 pa3) {
  const s16x4 l0 = tr_read<v_rd_off(D0, 0, 0)>(vb), h0 = tr_read<v_rd_off(D0, 0, 1)>(vb), l1 = tr_read<v_rd_off(D0, 1, 0)>(vb), h1 = tr_read<v_rd_off(D0, 1, 1)>(vb);
  const s16x4 l2 = tr_read<v_rd_off(D0, 2, 0)>(vb), h2 = tr_read<v_rd_off(D0, 2, 1)>(vb), l3 = tr_read<v_rd_off(D0, 3, 0)>(vb), h3 = tr_read<v_rd_off(D0, 3, 1)>(vb);
  asm volatile("s_waitcnt lgkmcnt(0)" ::: "memory"); SBAR();
#define PKV(L, H) (bf16x8){L[0], L[1], L[2], L[3], H[0], H[1], H[2], H[3]}
  od = __builtin_amdgcn_mfma_f32_32x32x16_bf16(pa0, PKV(l0, h0), od, 0, 0, 0);
  od = __builtin_amdgcn_mfma_f32_32x32x16_bf16(pa1, PKV(l1, h1), od, 0, 0, 0);
  od = __builtin_amdgcn_mfma_f32_32x32x16_bf16(pa2, PKV(l2, h2), od, 0, 0, 0);
  od = __builtin_amdgcn_mfma_f32_32x32x16_bf16(pa3, PKV(l3, h3), od, 0, 0, 0);
#undef PKV
}
__device__ __forceinline__ void pv_d0(f32x16* o, int vb, bf16x8 pa0, bf16x8 pa1, bf16x8 pa2, bf16x8 pa3) {
  pv_one<0>(o[0], vb, pa0, pa1, pa2, pa3); pv_one<1>(o[1], vb, pa0, pa1, pa2, pa3); pv_one<2>(o[2], vb, pa0, pa1, pa2, pa3); pv_one<3>(o[3], vb, pa0, pa1, pa2, pa3);
}
struct KVStage { bf16x8 ks0, ks1, vs0, vs1; };
__device__ __forceinline__ void kv_load(KVStage& s, const bf16* Kh, const bf16* Vh, long ldk, long ldv, int k0, int sr, int sc) {
  s.ks0 = *(const bf16x8*)(Kh + (long)(k0 + sr) * ldk + sc); s.ks1 = *(const bf16x8*)(Kh + (long)(k0 + 32 + sr) * ldk + sc);
  s.vs0 = *(const bf16x8*)(Vh + (long)(k0 + sr) * ldv + sc); s.vs1 = *(const bf16x8*)(Vh + (long)(k0 + 32 + sr) * ldv + sc);
}
__device__ __forceinline__ void kv_write(const KVStage& s, LAS char* lds, int sr, int sc) {
  *(LAS bf16x8*)(lds + ATT_V_OFF + v_st(sr, sc)) = s.vs0; *(LAS bf16x8*)(lds + ATT_V_OFF + v_st(32 + sr, sc)) = s.vs1;
  *(LAS bf16x8*)(lds + ATT_K_OFF + KSWZ(sr, sc * 2)) = s.ks0; *(LAS bf16x8*)(lds + ATT_K_OFF + KSWZ(32 + sr, sc * 2)) = s.ks1;
}
struct KVDma { int ko[2], vo[2]; };
__device__ __forceinline__ void kv_dma_init(KVDma& d, int ldk, int ldv, int wid, int lane) {
#pragma unroll
  for (int i = 0; i < 2; ++i) { const int p = wid * 2 + i;
    const int row = p * 4 + (lane >> 4), cp = lane & 15; d.ko[i] = row * ldk + ((cp ^ (row & 7)) << 3);
    const int sub = p * 2 + (lane >> 5), kk = (sub >> 2) * 8 + ((lane & 31) >> 2), k = (kk & ~0xC) | ((kk & 4) << 1) | ((kk & 8) >> 1), c = (sub & 3) * 32 + (lane & 3) * 8;
    d.vo[i] = k * ldv + c; }
}
__device__ __forceinline__ void kv_dma(const KVDma& d, const bf16* Kt, const bf16* Vt, LAS char* lds, int buf, int wid) {
#pragma unroll
  for (int i = 0; i < 2; ++i) {
    __builtin_amdgcn_global_load_lds((const unsigned*)(Kt + d.ko[i]), (LAS unsigned*)(lds + buf + ATT_K_OFF + (wid * 2 + i) * 1024), 16, 0, 0);
    __builtin_amdgcn_global_load_lds((const unsigned*)(Vt + d.vo[i]), (LAS unsigned*)(lds + buf + ATT_V_OFF + (wid * 2 + i) * 1024), 16, 0, 0); }
}
__device__ __forceinline__ void rescale_o(f32x16* o, float a, LAS float* al_l, int r32, int hi) {
  if (__any(a < 1.f)) { if (hi == 0) al_l[r32] = a; LDS_WAIT();
#pragma unroll
    for (int r = 0; r < 16; ++r) { const float f = al_l[crow(r, hi)];
#pragma unroll
      for (int d = 0; d < 4; ++d) o[d][r] *= f; }
    LDS_WAIT(); }
}
constexpr float ATT_SCALE = 0.088388347648318440f, ATT_C = ATT_SCALE * 1.4426950408889634f, ATT_THR = 8.f;
__device__ __forceinline__ void softmax_tile(f32x16& p0, f32x16& p1, float& m_reg, float& l_reg, float& alpha) {
  float pmax = p0[0];
#pragma unroll
  for (int r = 1; r < 16; ++r) pmax = fmaxf(pmax, p0[r]);
#pragma unroll
  for (int r = 0; r < 16; ++r) pmax = fmaxf(pmax, p1[r]);
  { auto rr = __builtin_amdgcn_permlane32_swap(__float_as_uint(pmax), __float_as_uint(pmax), false, false);
    pmax = fmaxf(__uint_as_float(rr[0]), __uint_as_float(rr[1])); }
  float mn;
  if (__all(pmax - m_reg <= ATT_THR / ATT_SCALE)) { mn = m_reg; alpha = 1.f; }
  else { mn = fmaxf(m_reg, pmax); alpha = __builtin_amdgcn_exp2f((m_reg - mn) * ATT_C); m_reg = mn; }
  const float mnC = -mn * ATT_C;
#pragma unroll
  for (int r = 0; r < 16; ++r) { p0[r] = __builtin_amdgcn_exp2f(fmaf(p0[r], ATT_C, mnC)); p1[r] = __builtin_amdgcn_exp2f(fmaf(p1[r], ATT_C, mnC)); }
  float ps = 0.f;
#pragma unroll
  for (int r = 0; r < 16; ++r) ps += p0[r] + p1[r];
  { auto rr = __builtin_amdgcn_permlane32_swap(__float_as_uint(ps), __float_as_uint(ps), false, false);
    ps = __uint_as_float(rr[0]) + __uint_as_float(rr[1]); }
  l_reg = l_reg * alpha + ps;
}
__device__ __forceinline__ void attn_finish(f32x16& p0, f32x16& p1, f32x16* o, float& m_reg, float& l_reg, LAS float* wsc, int vb, int r32, int hi) {
  float alpha; softmax_tile(p0, p1, m_reg, l_reg, alpha);
  rescale_o(o, alpha, wsc, r32, hi);
  bf16x8 pa0, pa1, pa2, pa3; pack_p(p0, p1, pa0, pa1, pa2, pa3);
  pv_d0(o, vb, pa0, pa1, pa2, pa3);
}
__device__ __forceinline__ void load_q(bf16x8* qr, const bf16* Qw) {
#pragma unroll
  for (int d0 = 0; d0 < 8; ++d0) qr[d0] = *(const bf16x8*)(Qw + d0 * 16);
}

struct Frame {
    LAS unsigned char* lds;
    unsigned char* ws;
    int tid, lane, wave, G, bid;
    __device__ __forceinline__ void fresh() { int t = threadIdx.x; asm volatile("" : "+v"(t)); tid = t; lane = t & 63; wave = __builtin_amdgcn_readfirstlane(t >> 6);
        int g_ = gridDim.x, b_ = blockIdx.x; asm volatile("" : "+s"(g_), "+s"(b_)); G = g_; bid = b_; }
};
struct Args { const float* in[19]; float* out; unsigned char* ws; int ph_lo, ph_hi; };
enum { IN_X = 0, IN_MEM, IN_AB_W_IN, IN_HGRN_LB, IN_HGRN_NW, IN_AB_W_OUT, IN_NSA_W_IN, IN_NSA_CMP_POS, IN_NSA_CMP_W1, IN_NSA_CMP_W2, IN_NSA_W_OUT,
       IN_XA_WQ, IN_XA_WKV, IN_XA_WO, IN_FFN_UP, IN_FFN_CONV, IN_FFN_DOWN, IN_LN_G, IN_LN_B };

__device__ __forceinline__ void p0_transpose_item(const float* W, int K, int N, bf16* WT, LAS float* scr, int item, int lane) {
    const int nblk = N / 32, kb = item / nblk, nb = item % nblk, k0 = 64 * kb, n0 = 32 * nb;
#pragma unroll 8
    for (int i = 0; i < 32; ++i) { const int kk = 2 * i + (lane >> 5); scr[kk * 33 + (lane & 31)] = W[(size_t)(k0 + kk) * N + n0 + (lane & 31)]; }
    LDS_WAIT(); asm volatile("" ::: "memory");
    const int c = lane & 7;
#pragma unroll
    for (int j = 0; j < 4; ++j) { const int n = (lane >> 3) + 8 * j; const LAS float* s = scr + (8 * c) * 33 + n;
        v4u o; o.x = pk2(s[0 * 33], s[1 * 33]); o.y = pk2(s[2 * 33], s[3 * 33]); o.z = pk2(s[4 * 33], s[5 * 33]); o.w = pk2(s[6 * 33], s[7 * 33]);
        *(GAS v4u*)(WT + (size_t)(n0 + n) * K + k0 + 8 * c) = o; }
    LDS_WAIT(); asm volatile("" ::: "memory");
}
__device__ __forceinline__ void p0_transpose_item_fold(const float* W, int K, int N, bf16* WT, LAS float* scr, int item, int lane, const float* g, const float* b, long long* cs, long long* b2) {
    const int nblk = N / 32, kb = item / nblk, nb = item % nblk, k0 = 64 * kb, n0 = 32 * nb;
#pragma unroll 8
    for (int i = 0; i < 32; ++i) { const int kk = 2 * i + (lane >> 5); scr[kk * 33 + (lane & 31)] = W[(size_t)(k0 + kk) * N + n0 + (lane & 31)]; }
    LDS_WAIT(); asm volatile("" ::: "memory");
    const int c = lane & 7;
    const f32x4 g0 = *(const f32x4*)(g + k0 + 8 * c), g1 = *(const f32x4*)(g + k0 + 8 * c + 4), b0 = *(const f32x4*)(b + k0 + 8 * c), b1 = *(const f32x4*)(b + k0 + 8 * c + 4);
    const float gg[8] = {g0.x, g0.y, g0.z, g0.w, g1.x, g1.y, g1.z, g1.w}, bb[8] = {b0.x, b0.y, b0.z, b0.w, b1.x, b1.y, b1.z, b1.w};
#pragma unroll
    for (int j = 0; j < 4; ++j) { const int n = (lane >> 3) + 8 * j; const LAS float* s = scr + (8 * c) * 33 + n;
        float sc = 0.f, sb = 0.f; unsigned w[4];
#pragma unroll
        for (int q = 0; q < 4; ++q) { const float x0 = s[(2 * q) * 33], x1 = s[(2 * q + 1) * 33]; const unsigned r0 = f2bf(x0 * gg[2 * q]), r1 = f2bf(x1 * gg[2 * q + 1]);
            w[q] = r0 | (r1 << 16); sc += bf2f((unsigned short)r0) + bf2f((unsigned short)r1); sb += x0 * bb[2 * q] + x1 * bb[2 * q + 1]; }
        *(GAS v4u*)(WT + (size_t)(n0 + n) * K + k0 + 8 * c) = (v4u){w[0], w[1], w[2], w[3]};
        sc += __shfl_xor(sc, 1); sc += __shfl_xor(sc, 2); sc += __shfl_xor(sc, 4); sb += __shfl_xor(sb, 1); sb += __shfl_xor(sb, 2); sb += __shfl_xor(sb, 4);
        if (c == 0) { atomicAdd((unsigned long long*)(cs + n0 + n), (unsigned long long)(long long)rintf(sc * pg8::FOLD_SCALE)); atomicAdd((unsigned long long*)(b2 + n0 + n), (unsigned long long)(long long)rintf(sb * pg8::FOLD_SCALE)); } }
    LDS_WAIT(); asm volatile("" ::: "memory");
}
__device__ __forceinline__ void transpose_mat_fold(Frame& F, const float* W, int K, int N, bf16* WT, const float* g, const float* b, long long* cs, long long* b2) {
    LAS float* scr = (LAS float*)(F.lds + RING_OFF + F.wave * 16384);
    const int gw = F.bid * NWAVES + F.wave, NGW = F.G * NWAVES;
    const int nitems = (K / 64) * (N / 32);
    for (int it = gw; it < nitems; it += NGW) p0_transpose_item_fold(W, K, N, WT, scr, it, F.lane, g, b, cs, b2);
}
__device__ __forceinline__ void transpose_mat(Frame& F, const float* W, int K, int N, bf16* WT) {
    LAS float* scr = (LAS float*)(F.lds + RING_OFF + F.wave * 16384);
    const int gw = F.bid * NWAVES + F.wave, NGW = F.G * NWAVES;
    const int nitems = (K / 64) * (N / 32);
    for (int it = gw; it < nitems; it += NGW) p0_transpose_item(W, K, N, WT, scr, it, F.lane);
}
__device__ __forceinline__ void cvt_flat(Frame& F, const float* src, bf16* dst, long n8) {
    for (long i = (long)F.bid * NTHR + F.tid; i < n8; i += (long)F.G * NTHR) {
        const f32x4 a = *(const f32x4*)(src + i * 8), b = *(const f32x4*)(src + i * 8 + 4);
        v4u o; o.x = pk2(a.x, a.y); o.y = pk2(a.z, a.w); o.z = pk2(b.x, b.y); o.w = pk2(b.z, b.w);
        *(v4u*)(dst + i * 8) = o; }
}
__device__ __forceinline__ void p0_prologue(Frame& F, const Args& A) {
    unsigned char* ws = F.ws;
    transpose_mat(F, A.in[IN_AB_W_IN], DM, AB_IN, (bf16*)(ws + WS_W_ABIN));
    transpose_mat(F, A.in[IN_AB_W_OUT], DM, DM, (bf16*)(ws + WS_W_ABOUT));
    long long* cs = (long long*)(ws + WS_FOLD); long long* b2 = cs + FO_N;
    transpose_mat_fold(F, A.in[IN_NSA_W_IN], DM, NSA_IN, (bf16*)(ws + WS_W_NSAIN), A.in[IN_LN_G] + 2 * DM, A.in[IN_LN_B] + 2 * DM, cs + FO_NSA, b2 + FO_NSA);
    transpose_mat(F, A.in[IN_NSA_W_OUT], DM, DM, (bf16*)(ws + WS_W_NSAOUT));
    for (int l = 0; l < 2; ++l) {
        transpose_mat_fold(F, A.in[IN_XA_WQ] + (size_t)l * DM * XW, DM, XW, (bf16*)(ws + WS_W_XQ) + (size_t)l * XW * DM, A.in[IN_LN_G] + (size_t)(3 * l) * DM, A.in[IN_LN_B] + (size_t)(3 * l) * DM, cs + FO_XQ + l * XW, b2 + FO_XQ + l * XW);
        transpose_mat(F, A.in[IN_XA_WKV] + (size_t)l * DM * 2 * XW, DM, 2 * XW, (bf16*)(ws + WS_W_XKV) + (size_t)l * 2 * XW * DM);
        transpose_mat(F, A.in[IN_XA_WO] + (size_t)l * XW * DM, XW, DM, (bf16*)(ws + WS_W_XO) + (size_t)l * DM * XW);
        transpose_mat_fold(F, A.in[IN_FFN_UP] + (size_t)l * DM * DFF2, DM, DFF2, (bf16*)(ws + WS_W_UP) + (size_t)l * DFF2 * DM, A.in[IN_LN_G] + (size_t)(3 * l + 1) * DM, A.in[IN_LN_B] + (size_t)(3 * l + 1) * DM, cs + FO_UP + l * DFF2, b2 + FO_UP + l * DFF2);
        transpose_mat(F, A.in[IN_FFN_DOWN] + (size_t)l * DFF * DM, DFF, DM, (bf16*)(ws + WS_W_DOWN) + (size_t)l * DM * DFF);
        transpose_mat(F, A.in[IN_NSA_CMP_W1] + (size_t)l * 32 * HD * HD, 32 * HD, HD, (bf16*)(ws + WS_W_C1) + (size_t)l * HD * 32 * HD);
        transpose_mat(F, A.in[IN_NSA_CMP_W2] + (size_t)l * HD * HD, HD, HD, (bf16*)(ws + WS_W_C2) + (size_t)l * HD * HD);
    }
    cvt_flat(F, A.in[IN_X], (bf16*)(ws + WS_HB), (long)MTOK * DM / 8);
    cvt_flat(F, A.in[IN_MEM], (bf16*)(ws + WS_MEMB), (long)BATCH * NMEM * DM / 8);
    { v4u z = {0u, 0u, 0u, 0u}; v4u* p = (v4u*)((bf16*)(ws + WS_W_NSAIN) + (size_t)NSA_IN * DM); const long n = (long)(NSA_INP - NSA_IN) * DM / 8;
      for (long i = (long)F.bid * NTHR + F.tid; i < n; i += (long)F.G * NTHR) p[i] = z; }
    { float* tab = (float*)(ws + WS_ROPE);
      for (int i = F.bid * NTHR + F.tid; i < SEQ * 64; i += F.G * NTHR) { const int t = i >> 6, d = i & 63;
          float sn, cs; sincosf((float)t * powf(10000.0f, -(float)d * (1.0f / 64.0f)), &sn, &cs); tab[(size_t)t * 128 + d] = cs; tab[(size_t)t * 128 + 64 + d] = sn; } }
    { const float* lbp = A.in[IN_HGRN_LB]; float* lbo = (float*)(ws + WS_LB);
      for (int i = F.bid * NTHR + F.tid; i < A_W; i += F.G * NTHR) { const float a = lbp[i], b = lbp[A_W + i], m = fmaxf(a, b), ea = __expf(a - m), eb = __expf(b - m); lbo[i] = ea / (ea + eb); } }
}

__device__ __forceinline__ void ln_phase(Frame& F, const bf16* Y, const float* g, const float* b, float* h32) {
    const int gw = F.bid * NWAVES + F.wave, NGW = F.G * NWAVES;
    for (int m = gw; m < MTOK; m += NGW) {
        const v4u* yr = (const v4u*)(Y + (size_t)m * DM) + F.lane;
        float v[8][8]; float s = 0.f;
#pragma unroll
        for (int j = 0; j < 8; ++j) { const v4u x = yr[64 * j];
            v[j][0] = bflo(x.x); v[j][1] = bfhi(x.x); v[j][2] = bflo(x.y); v[j][3] = bfhi(x.y); v[j][4] = bflo(x.z); v[j][5] = bfhi(x.z); v[j][6] = bflo(x.w); v[j][7] = bfhi(x.w);
#pragma unroll
            for (int q = 0; q < 8; ++q) s += v[j][q]; }
        const float mean = wave_sum(s) * (1.f / DM); float s2 = 0.f;
#pragma unroll
        for (int j = 0; j < 8; ++j)
#pragma unroll
            for (int q = 0; q < 8; ++q) { v[j][q] -= mean; s2 += v[j][q] * v[j][q]; }
        const float rstd = 1.f / sqrtf(wave_sum(s2) * (1.f / DM) + LN_EPS);
#pragma unroll
        for (int j = 0; j < 8; ++j) { const int c0 = 8 * F.lane + 512 * j;
            const f32x4 g0 = *(const f32x4*)(g + c0), g1 = *(const f32x4*)(g + c0 + 4), b0 = *(const f32x4*)(b + c0), b1 = *(const f32x4*)(b + c0 + 4);
            f32x4 r0, r1;
            r0.x = v[j][0] * rstd * g0.x + b0.x; r0.y = v[j][1] * rstd * g0.y + b0.y; r0.z = v[j][2] * rstd * g0.z + b0.z; r0.w = v[j][3] * rstd * g0.w + b0.w;
            r1.x = v[j][4] * rstd * g1.x + b1.x; r1.y = v[j][5] * rstd * g1.y + b1.y; r1.z = v[j][6] * rstd * g1.z + b1.z; r1.w = v[j][7] * rstd * g1.w + b1.w;
            *(f32x4*)(h32 + (size_t)m * DM + c0) = r0; *(f32x4*)(h32 + (size_t)m * DM + c0 + 4) = r1; }
    }
}

__device__ __forceinline__ void convglu_phase(Frame& F, const bf16* UP, const float* cw, bf16* Gm) {
    constexpr int NCG = DFF / 8, RB = 16, NRB = MTOK / RB;
    const long nitems = (long)NCG * NRB;
    for (long it = (long)F.bid * NTHR + F.tid; it < nitems; it += (long)F.G * NTHR) {
        const int cg = (int)(it % NCG), rb = (int)(it / NCG), c0 = cg * 8, t0 = rb * RB;
        float w0[8], w1[8], w2[8];
#pragma unroll
        for (int j = 0; j < 8; ++j) { w0[j] = cw[c0 + j]; w1[j] = cw[DFF + c0 + j]; w2[j] = cw[2 * DFF + c0 + j]; }
        float am2[8], am1[8];
        if ((t0 & (SEQ - 1)) == 0) {
#pragma unroll
            for (int j = 0; j < 8; ++j) { am2[j] = 0.f; am1[j] = 0.f; }
        } else {
            const v4u x2 = *(const v4u*)(UP + (size_t)(t0 - 2) * DFF2 + c0), x1 = *(const v4u*)(UP + (size_t)(t0 - 1) * DFF2 + c0);
            am2[0] = bflo(x2.x); am2[1] = bfhi(x2.x); am2[2] = bflo(x2.y); am2[3] = bfhi(x2.y); am2[4] = bflo(x2.z); am2[5] = bfhi(x2.z); am2[6] = bflo(x2.w); am2[7] = bfhi(x2.w);
            am1[0] = bflo(x1.x); am1[1] = bfhi(x1.x); am1[2] = bflo(x1.y); am1[3] = bfhi(x1.y); am1[4] = bflo(x1.z); am1[5] = bfhi(x1.z); am1[6] = bflo(x1.w); am1[7] = bfhi(x1.w);
        }
#pragma unroll 4
        for (int r = 0; r < RB; ++r) {
            const size_t row = (size_t)(t0 + r);
            const v4u xa = *(const v4u*)(UP + row * DFF2 + c0), xu = *(const v4u*)(UP + row * DFF2 + DFF + c0);
            float a[8], u[8];
            a[0] = bflo(xa.x); a[1] = bfhi(xa.x); a[2] = bflo(xa.y); a[3] = bfhi(xa.y); a[4] = bflo(xa.z); a[5] = bfhi(xa.z); a[6] = bflo(xa.w); a[7] = bfhi(xa.w);
            u[0] = bflo(xu.x); u[1] = bfhi(xu.x); u[2] = bflo(xu.y); u[3] = bfhi(xu.y); u[4] = bflo(xu.z); u[5] = bfhi(xu.z); u[6] = bflo(xu.w); u[7] = bfhi(xu.w);
            float o[8];
#pragma unroll
            for (int j = 0; j < 8; j += 2) {
                const float c0v = w2[j] * a[j] + w1[j] * am1[j] + w0[j] * am2[j], c1v = w2[j + 1] * a[j + 1] + w1[j + 1] * am1[j + 1] + w0[j + 1] * am2[j + 1];
                const pg8::f32x2 gg = pg8::gelu_pk((pg8::f32x2){c0v, c1v}); o[j] = gg.x * u[j]; o[j + 1] = gg.y * u[j + 1]; }
            v4u w; w.x = pk2(o[0], o[1]); w.y = pk2(o[2], o[3]); w.z = pk2(o[4], o[5]); w.w = pk2(o[6], o[7]);
            *(v4u*)(Gm + row * DFF + c0) = w;
#pragma unroll
            for (int j = 0; j < 8; ++j) { am2[j] = am1[j]; am1[j] = a[j]; }
        }
    }
}

__device__ __forceinline__ void xattn_phase(Frame& F, const bf16* XQ, const bf16* XKV, bf16* XO) {
    const int tid = F.tid, wid = F.wave, lane = F.lane, r32 = lane & 31, hi = lane >> 5;
    LAS char* lds = (LAS char*)F.lds;
    LAS float* wsc = (LAS float*)(lds + ATT_WS_OFF + wid * 256);
    const int vb0 = (int)(uintptr_t)(lds + ATT_V_OFF) + v_rd_base(lane);
    KVDma dm; kv_dma_init(dm, 2 * XW, 2 * XW, wid, lane);
    constexpr int NU = (MTOK / 256) * XH;
    for (int u = F.bid; u < NU; u += F.G) {
        const int head = u % XH, rbk = u / XH, row0 = rbk * 256, b = row0 / SEQ;
        const bf16* Kh = XKV + (size_t)b * NMEM * 2 * XW + head * HD; const bf16* Vh = Kh + XW;
        bf16x8 qr[8]; load_q(qr, XQ + (size_t)(row0 + wid * 32 + r32) * XW + head * HD + hi * 8);
        float m_reg = -1e30f, l_reg = 0.f; f32x16 o[4] = {};
        __syncthreads();
        kv_dma(dm, Kh, Vh, lds, 0, wid);
        for (int j = 0; j < NMEM / KVBLK; ++j) {
            const int buf = (j & 1) * ATT_BUF;
            VM_WAIT(); __syncthreads();
            if (j + 1 < NMEM / KVBLK) kv_dma(dm, Kh + (size_t)(j + 1) * KVBLK * 2 * XW, Vh + (size_t)(j + 1) * KVBLK * 2 * XW, lds, ATT_BUF - buf, wid);
            f32x16 p0, p1; qkt(p0, p1, lds + buf + ATT_K_OFF, qr, r32, hi);
            float alpha; softmax_tile(p0, p1, m_reg, l_reg, alpha);
            rescale_o(o, alpha, wsc, r32, hi);
            bf16x8 pa0, pa1, pa2, pa3; pack_p(p0, p1, pa0, pa1, pa2, pa3);
            pv_d0(o, vb0 + buf, pa0, pa1, pa2, pa3);
        }
        if (hi == 0) wsc[32 + r32] = l_reg; LDS_WAIT();
        bf16* Ow = XO + (size_t)(row0 + wid * 32) * XW + head * HD;
#pragma unroll
        for (int r = 0; r < 16; ++r) { const int orow = crow(r, hi); const float rl = __builtin_amdgcn_rcpf(wsc[32 + orow]);
#pragma unroll
            for (int d0 = 0; d0 < 4; ++d0) Ow[(size_t)orow * XW + d0 * 32 + r32] = (bf16)f2bf(o[d0][r] * rl); }
        LDS_WAIT();
    }
}

template <int K>
__device__ __forceinline__ f32x4 mma_tile(const LAS char* A, int lda, const LAS char* B, int ldb, int fr, int fq) {
    f32x4 acc = {0.f, 0.f, 0.f, 0.f};
#pragma unroll
    for (int k0 = 0; k0 < K; k0 += 32) {
        const bf16x8 a = *(const LAS bf16x8*)(A + fr * lda + (k0 + 8 * fq) * 2);
        const bf16x8 b = *(const LAS bf16x8*)(B + fr * ldb + (k0 + 8 * fq) * 2);
        acc = __builtin_amdgcn_mfma_f32_16x16x32_bf16(a, b, acc, 0, 0, 0);
    }
    return acc;
}
constexpr int HG_CH = 64, HG_NC = SEQ / HG_CH, HG_ITEMS = BATCH * A_HEADS * HG_NC;
constexpr int HG_QT = 0, HG_KT = 17408, HG_KH = 34816, HG_VT = 53248, HG_PT = 71680, HG_SEG = 80896;
constexpr int HG_SP = 17408, HG_OT = 52224;
__device__ __forceinline__ void hgrn_phase_a(Frame& F, const bf16* P0, const float* lbv, bf16* QTg, bf16* OINTRA, bf16* DS, float* DEC) {
    LAS char* lds = (LAS char*)F.lds;
    const int tid = F.tid, wid = F.wave, lane = F.lane, fr = lane & 15, fq = lane >> 4;
    const int d = tid & 127, sq = tid >> 7;
    for (int it = F.bid; it < HG_ITEMS; it += F.G) {
        const int c = it % HG_NC, bh = it / HG_NC, h = bh % A_HEADS, b = bh / A_HEADS;
        const size_t row0 = (size_t)b * SEQ + (size_t)c * HG_CH;
        const float lb = lbv[h * HD + d], omlb = 1.f - lb;
        float cum[16], kk[16];
        { float run = 0.f;
#pragma unroll
          for (int j = 0; j < 16; ++j) { const float z = bf2f(P0[(row0 + 16 * sq + j) * AB_IN + A_W + h * HD + d]); const float sg = sigmoidf_(z);
              run += __logf(lb + omlb * sg); cum[j] = run; kk[j] = omlb * (1.f - sg); }
          ((LAS float*)(lds + HG_SEG))[sq * 128 + d] = run; }
        LDS_WAIT(); __syncthreads();
        float base = 0.f, total = 0.f;
#pragma unroll
        for (int q = 0; q < 4; ++q) { const float sgm = ((LAS float*)(lds + HG_SEG))[q * 128 + d]; total += sgm; if (q < sq) base += sgm; }
        unsigned kh[8], vt[8];
#pragma unroll
        for (int j = 0; j < 16; j += 2) {
            float e[2][3]; unsigned short vr[2];
#pragma unroll
            for (int jj = 0; jj < 2; ++jj) { const int s = 16 * sq + j + jj; const float bb = base + cum[j + jj];
                const float q = bf2f(P0[(row0 + s) * AB_IN + h * HD + d]); vr[jj] = P0[(row0 + s) * AB_IN + 2 * A_W + h * HD + d];
                const float qt = q * __expf(bb), kt = kk[j + jj] * __expf(-bb), kht = kk[j + jj] * __expf(total - bb);
                const unsigned short qb16 = (unsigned short)f2bf(qt);
                *(LAS unsigned short*)(lds + HG_QT + s * 272 + d * 2) = qb16; QTg[(row0 + s) * A_W + h * HD + d] = qb16;
                *(LAS unsigned short*)(lds + HG_KT + s * 272 + d * 2) = (unsigned short)f2bf(kt);
                e[jj][0] = kht; }
            kh[j >> 1] = pk2(e[0][0], e[1][0]); vt[j >> 1] = (unsigned)vr[0] | ((unsigned)vr[1] << 16);
        }
        { LAS v4u* pk = (LAS v4u*)(lds + HG_KH + d * 144 + sq * 32); pk[0] = (v4u){kh[0], kh[1], kh[2], kh[3]}; pk[1] = (v4u){kh[4], kh[5], kh[6], kh[7]};
          LAS v4u* pv = (LAS v4u*)(lds + HG_VT + d * 144 + sq * 32); pv[0] = (v4u){vt[0], vt[1], vt[2], vt[3]}; pv[1] = (v4u){vt[4], vt[5], vt[6], vt[7]}; }
        if (sq == 3) DEC[(size_t)it * HD + d] = __expf(total);
        LDS_WAIT(); __syncthreads();
#pragma unroll
        for (int k = 0; k < 2; ++k) { const int tau = 2 * wid + k, ti = tau >> 2, si = tau & 3;
            f32x4 acc = {0.f, 0.f, 0.f, 0.f};
            if (si <= ti) acc = mma_tile<128>(lds + HG_QT + ti * 16 * 272, 272, lds + HG_KT + si * 16 * 272, 272, fr, fq);
#pragma unroll
            for (int i = 0; i < 4; ++i) { const int t = 16 * ti + 4 * fq + i, s = 16 * si + fr; const float v = (s <= t) ? acc[i] : 0.f;
                *(LAS unsigned short*)(lds + HG_PT + t * 144 + s * 2) = (unsigned short)f2bf(v); } }
        LDS_WAIT(); __syncthreads();
#pragma unroll
        for (int k = 0; k < 4; ++k) { const int tau = wid + 8 * k, ti = tau >> 3, vi = tau & 7;
            const f32x4 acc = mma_tile<64>(lds + HG_VT + vi * 16 * 144, 144, lds + HG_PT + ti * 16 * 144, 144, fr, fq);
            v2u w; w.x = pk2(acc[0], acc[1]); w.y = pk2(acc[2], acc[3]);
            *(v2u*)(OINTRA + (row0 + 16 * ti + fr) * A_W + h * HD + 16 * vi + 4 * fq) = w; }
#pragma unroll
        for (int k = 0; k < 8; ++k) { const int tau = wid + 8 * k, vi = tau >> 3, ki = tau & 7;
            const f32x4 acc = mma_tile<64>(lds + HG_KH + ki * 16 * 144, 144, lds + HG_VT + vi * 16 * 144, 144, fr, fq);
            v2u w; w.x = pk2(acc[0], acc[1]); w.y = pk2(acc[2], acc[3]);
            *(v2u*)(DS + ((size_t)it * HD + 16 * vi + fr) * HD + 16 * ki + 4 * fq) = w; }
        LDS_WAIT(); __syncthreads();
    }
}
__device__ __forceinline__ void hgrn_phase_b(Frame& F, const bf16* DS, const float* DEC, bf16* SPREV) {
    const int tid = F.tid, dvl = tid >> 5, dk4 = (tid & 31) * 4;
    for (int item = F.bid; item < BATCH * A_HEADS * 8; item += F.G) {
        const int sl = item & 7, bh = item >> 3, dv = sl * 16 + dvl;
        f32x4 S = {0.f, 0.f, 0.f, 0.f};
        for (int c0 = 0; c0 < HG_NC; c0 += 8) {
            f32x4 ds[8], dc[8];
#pragma unroll
            for (int k = 0; k < 8; ++k) { const size_t it = (size_t)bh * HG_NC + c0 + k; const v2u x = *(const v2u*)(DS + (it * HD + dv) * HD + dk4);
                ds[k] = (f32x4){bflo(x.x), bfhi(x.x), bflo(x.y), bfhi(x.y)}; dc[k] = *(const f32x4*)(DEC + it * HD + dk4); }
#pragma unroll
            for (int k = 0; k < 8; ++k) { const size_t it = (size_t)bh * HG_NC + c0 + k;
                v2u w; w.x = pk2(S.x, S.y); w.y = pk2(S.z, S.w); *(v2u*)(SPREV + (it * HD + dv) * HD + dk4) = w;
                S = S * dc[k] + ds[k]; }
        }
    }
}
__device__ __forceinline__ void hgrn_phase_c(Frame& F, const bf16* P0, const bf16* QTg, const bf16* OINTRA, const bf16* SPREV, const float* nw, bf16* Ob) {
    LAS char* lds = (LAS char*)F.lds;
    const int tid = F.tid, wid = F.wave, lane = F.lane, fr = lane & 15, fq = lane >> 4;
    for (int it = F.bid; it < HG_ITEMS; it += F.G) {
        const int c = it % HG_NC, bh = it / HG_NC, h = bh % A_HEADS, b = bh / A_HEADS;
        const size_t row0 = (size_t)b * SEQ + (size_t)c * HG_CH;
        { const int s = tid >> 3, ch = (tid & 7) * 16; const bf16* src = QTg + (row0 + s) * A_W + h * HD + ch;
          const v4u x0 = *(const v4u*)src, x1 = *(const v4u*)(src + 8); LAS v4u* dst = (LAS v4u*)(lds + HG_QT + s * 272 + ch * 2); dst[0] = x0; dst[1] = x1; }
        { const int dv = tid >> 2, ch = (tid & 3) * 32; const bf16* src = SPREV + ((size_t)it * HD + dv) * HD + ch;
          const v4u x0 = *(const v4u*)src, x1 = *(const v4u*)(src + 8), x2 = *(const v4u*)(src + 16), x3 = *(const v4u*)(src + 24);
          LAS v4u* dst = (LAS v4u*)(lds + HG_SP + dv * 272 + ch * 2); dst[0] = x0; dst[1] = x1; dst[2] = x2; dst[3] = x3; }
        LDS_WAIT(); __syncthreads();
#pragma unroll
        for (int k = 0; k < 4; ++k) { const int tau = wid + 8 * k, ti = tau >> 3, vi = tau & 7;
            const f32x4 acc = mma_tile<128>(lds + HG_SP + vi * 16 * 272, 272, lds + HG_QT + ti * 16 * 272, 272, fr, fq);
            const int t = 16 * ti + fr, dv = 16 * vi + 4 * fq; const v2u oi = *(const v2u*)(OINTRA + (row0 + t) * A_W + h * HD + dv);
            *(LAS f32x4*)(lds + HG_OT + (t * 132 + dv) * 4) = (f32x4){acc[0] + bflo(oi.x), acc[1] + bfhi(oi.x), acc[2] + bflo(oi.y), acc[3] + bfhi(oi.y)}; }
        LDS_WAIT(); __syncthreads();
#pragma unroll
        for (int k = 0; k < 8; ++k) { const int t = wid * 8 + k;
            const float v0 = *(LAS float*)(lds + HG_OT + (t * 132 + lane) * 4), v1 = *(LAS float*)(lds + HG_OT + (t * 132 + 64 + lane) * 4);
            const float ss = wave_sum(v0 * v0 + v1 * v1); const float r = 1.f / sqrtf(ss * (1.f / HD) + RMS_EPS);
            const float g0 = bf2f(P0[(row0 + t) * AB_IN + 3 * A_W + h * HD + lane]), g1 = bf2f(P0[(row0 + t) * AB_IN + 3 * A_W + h * HD + 64 + lane]);
            Ob[(row0 + t) * DM + h * HD + lane] = (bf16)f2bf(v0 * r * nw[lane] * g0 * sigmoidf_(g0));
            Ob[(row0 + t) * DM + h * HD + 64 + lane] = (bf16)f2bf(v1 * r * nw[64 + lane] * g1 * sigmoidf_(g1)); }
        LDS_WAIT(); __syncthreads();
    }
}

constexpr float SB_CUT = -160.f;
__device__ __forceinline__ void sb_phase(Frame& F, const bf16* P0, bf16* Ob) {
    const int tid = F.tid, wid = F.wave, lane = F.lane, r32 = lane & 31, hi = lane >> 5;
    LAS char* lds = (LAS char*)F.lds;
    const int vb0 = (int)(uintptr_t)(lds + ATT_V_OFF) + v_rd_base(lane);
    KVDma dm; kv_dma_init(dm, AB_IN, AB_IN, wid, lane);
    constexpr int NQB = SEQ / 256, NU = BATCH * B_HEADS * NQB;
    for (int rd = 0; ; ++rd) {
        const int idx = (rd & 1) ? rd * F.G + (F.G - 1 - F.bid) : rd * F.G + F.bid;
        if (rd * F.G >= NU) break;
        if (idx >= NU) continue;
        const int qb = NQB - 1 - idx / (BATCH * B_HEADS), bh = idx % (BATCH * B_HEADS), head = bh % B_HEADS, b = bh / B_HEADS;
        const size_t rowb = (size_t)b * SEQ; const int q0 = qb * 256;
        const bf16* Kh = P0 + rowb * AB_IN + 4 * A_W + B_W + head * HD; const bf16* Vh = Kh + B_W;
        const int tw0 = q0 + wid * 32, t = tw0 + r32;
        bf16x8 qr[8]; load_q(qr, P0 + (rowb + t) * AB_IN + 4 * A_W + head * HD + hi * 8);
        float R = 0.f; f32x16 o[4] = {};
        const int jtop = (q0 + 254) >> 6;
        LAS unsigned* dflag = (LAS unsigned*)(lds + ATT_X_OFF);
        if (lane == 0) { dflag[wid] = 0u; dflag[8 + wid] = 0u; }
        LDS_WAIT(); __syncthreads();
        kv_dma(dm, Kh + (size_t)jtop * KVBLK * AB_IN, Vh + (size_t)jtop * KVBLK * AB_IN, lds, 0, wid);
        int buf = 0;
        for (int j = jtop; j >= 0; --j, buf = ATT_BUF - buf) {
            VM_WAIT(); __syncthreads();
            { unsigned alld = 1u;
#pragma unroll
              for (int w = 0; w < NWAVES; ++w) alld &= dflag[((j + 1) & 1) * 8 + w];
              if (__builtin_amdgcn_readfirstlane(alld)) break; }
            if (j > 0) kv_dma(dm, Kh + (size_t)(j - 1) * KVBLK * AB_IN, Vh + (size_t)(j - 1) * KVBLK * AB_IN, lds, ATT_BUF - buf, wid);
            const int k0 = j * KVBLK;
            if (k0 < tw0 + 31) {
                f32x16 p0, p1; qkt(p0, p1, lds + buf + ATT_K_OFF, qr, r32, hi);
                const bool need_mask = (k0 + 63 >= tw0);
                float L0[16], L1[16];
#pragma unroll
                for (int r = 0; r < 16; ++r) {
                    const float z0 = p0[r] * ATT_C, z1 = p1[r] * ATT_C;
                    float l0 = -(fmaxf(z0, 0.f) + __builtin_amdgcn_logf(1.f + __builtin_amdgcn_exp2f(-fabsf(z0))));
                    float l1 = -(fmaxf(z1, 0.f) + __builtin_amdgcn_logf(1.f + __builtin_amdgcn_exp2f(-fabsf(z1))));
                    if (need_mask) { if (k0 + crow(r, hi) >= t) l0 = 0.f; if (k0 + 32 + crow(r, hi) >= t) l1 = 0.f; }
                    L0[r] = l0; L1[r] = l1; p0[r] = z0 + l0; p1[r] = z1 + l1;
                }
                SBAR();
                float Sg[16];
#pragma unroll
                for (int gi = 0; gi < 4; ++gi) {
                    const float a = (L0[4 * gi] + L0[4 * gi + 1]) + (L0[4 * gi + 2] + L0[4 * gi + 3]), c = (L1[4 * gi] + L1[4 * gi + 1]) + (L1[4 * gi + 2] + L1[4 * gi + 3]);
                    auto ra = __builtin_amdgcn_permlane32_swap(__float_as_uint(a), __float_as_uint(a), false, false);
                    auto rc = __builtin_amdgcn_permlane32_swap(__float_as_uint(c), __float_as_uint(c), false, false);
                    Sg[2 * gi] = __uint_as_float(ra[0]); Sg[2 * gi + 1] = __uint_as_float(ra[1]); Sg[8 + 2 * gi] = __uint_as_float(rc[0]); Sg[8 + 2 * gi + 1] = __uint_as_float(rc[1]);
                }
                float run = R;
#pragma unroll
                for (int s = 15; s >= 0; --s) { const float tt = run; run += Sg[s]; Sg[s] = tt; }
                const float Rn = run;
                SBAR();
#pragma unroll
                for (int gi = 0; gi < 4; ++gi) {
                    float base0 = hi ? Sg[2 * gi + 1] : Sg[2 * gi], base1 = hi ? Sg[8 + 2 * gi + 1] : Sg[8 + 2 * gi];
                    float r3 = base0, r2 = r3 + L0[4 * gi + 3], r1 = r2 + L0[4 * gi + 2], r0 = r1 + L0[4 * gi + 1];
                    p0[4 * gi + 3] = __builtin_amdgcn_exp2f(p0[4 * gi + 3] + r3); p0[4 * gi + 2] = __builtin_amdgcn_exp2f(p0[4 * gi + 2] + r2);
                    p0[4 * gi + 1] = __builtin_amdgcn_exp2f(p0[4 * gi + 1] + r1); p0[4 * gi + 0] = __builtin_amdgcn_exp2f(p0[4 * gi + 0] + r0);
                    r3 = base1; r2 = r3 + L1[4 * gi + 3]; r1 = r2 + L1[4 * gi + 2]; r0 = r1 + L1[4 * gi + 1];
                    p1[4 * gi + 3] = __builtin_amdgcn_exp2f(p1[4 * gi + 3] + r3); p1[4 * gi + 2] = __builtin_amdgcn_exp2f(p1[4 * gi + 2] + r2);
                    p1[4 * gi + 1] = __builtin_amdgcn_exp2f(p1[4 * gi + 1] + r1); p1[4 * gi + 0] = __builtin_amdgcn_exp2f(p1[4 * gi + 0] + r0);
                }
                R = Rn;
                { const unsigned dn = __all(R < SB_CUT) ? 1u : 0u; if (lane == 0) dflag[(j & 1) * 8 + wid] = dn; }
                if (need_mask) {
#pragma unroll
                    for (int r = 0; r < 16; ++r) { if (k0 + crow(r, hi) >= t) p0[r] = 0.f; if (k0 + 32 + crow(r, hi) >= t) p1[r] = 0.f; }
                }
                bf16x8 pa0, pa1, pa2, pa3; pack_p(p0, p1, pa0, pa1, pa2, pa3);
                pv_d0(o, vb0 + buf, pa0, pa1, pa2, pa3);
            }
        }
        bf16* Ow = Ob + (rowb + tw0) * DM + A_W + head * HD;
#pragma unroll
        for (int r = 0; r < 16; ++r) { const int orow = crow(r, hi);
#pragma unroll
            for (int d0 = 0; d0 < 4; ++d0) Ow[(size_t)orow * DM + d0 * 32 + r32] = (bf16)f2bf(o[d0][r]); }
    }
}

constexpr int P1_KC = 4096, P1_VC = 4608, P1_KS = 5120, P1_VS = 5632, P1_KW = 6144, P1_VW = 6656, P1_GL = 7168;
__device__ __forceinline__ void nsa_rope_phase(Frame& F, const bf16* P1, const float* TAB, bf16* QROT, bf16* KSROT, bf16* KWROT, bf16* OVL) {
    const int gw = F.bid * NWAVES + F.wave, NGW = F.G * NWAVES, lane = F.lane, hsub = lane >> 3, d0 = (lane & 7) * 8;
    for (int m = gw; m < MTOK; m += NGW) {
        const int t = m & (SEQ - 1);
        const f32x4 c0 = *(const f32x4*)(TAB + (size_t)t * 128 + d0), c1 = *(const f32x4*)(TAB + (size_t)t * 128 + d0 + 4);
        const f32x4 s0 = *(const f32x4*)(TAB + (size_t)t * 128 + 64 + d0), s1 = *(const f32x4*)(TAB + (size_t)t * 128 + 64 + d0 + 4);
        const float cs[8] = {c0.x, c0.y, c0.z, c0.w, c1.x, c1.y, c1.z, c1.w}, sn[8] = {s0.x, s0.y, s0.z, s0.w, s1.x, s1.y, s1.z, s1.w};
        const bf16* row = P1 + (size_t)m * NSA_INP;
#pragma unroll
        for (int hb = 0; hb < 5; ++hb) {
            const int hh = hb * 8 + hsub;
            const bf16* src; bf16* dst;
            if (hh < 32) { src = row + hh * HD; dst = QROT + (size_t)m * DM + hh * HD; }
            else if (hh < 36) { src = row + P1_KS + (hh - 32) * HD; dst = KSROT + (size_t)m * KVW + (hh - 32) * HD; }
            else { src = row + P1_KW + (hh - 36) * HD; dst = KWROT + (size_t)m * KVW + (hh - 36) * HD; }
            const v4u a = *(const v4u*)(src + d0), bq = *(const v4u*)(src + 64 + d0);
            const unsigned aw[4] = {a.x, a.y, a.z, a.w}, bw[4] = {bq.x, bq.y, bq.z, bq.w}; unsigned o1[4], o2[4];
#pragma unroll
            for (int q = 0; q < 4; ++q) { const float x1l = bflo(aw[q]), x1h = bfhi(aw[q]), x2l = bflo(bw[q]), x2h = bfhi(bw[q]);
                o1[q] = pk2(x1l * cs[2 * q] - x2l * sn[2 * q], x1h * cs[2 * q + 1] - x2h * sn[2 * q + 1]);
                o2[q] = pk2(x2l * cs[2 * q] + x1l * sn[2 * q], x2h * cs[2 * q + 1] + x1h * sn[2 * q + 1]); }
            *(v4u*)(dst + d0) = (v4u){o1[0], o1[1], o1[2], o1[3]}; *(v4u*)(dst + 64 + d0) = (v4u){o2[0], o2[1], o2[2], o2[3]};
        }
    }
    for (int i = F.bid * NTHR + F.tid; i < NCMPP * NSLC; i += F.G * NTHR) { const int n = i / NSLC, j = i % NSLC;
        OVL[i] = (n < NCMP && n >= 4 * j - 1 && n <= 4 * j + 3) ? (bf16)0x3f80u : (bf16)0u; }
}
constexpr int CM_A = 0, CM_B = 17408, CM_H = 17408 + 34816;
__device__ __forceinline__ void nsa_compress_phase(Frame& F, const bf16* P1, const float* pos, const bf16* W1t, const bf16* W2t, bf16* KCMP, bf16* VCMP) {
    LAS char* lds = (LAS char*)F.lds;
    const int tid = F.tid, wid = F.wave, lane = F.lane, fr = lane & 15, fq = lane >> 4;
    for (int item = F.bid; item < 128; item += F.G) {
        const int nt = item & 7, g = (item >> 3) & 3, b = (item >> 5) & 1, which = item >> 6;
        const bf16* w1 = W1t + (size_t)which * HD * 32 * HD; const bf16* w2 = W2t + (size_t)which * HD * HD;
        const float* posw = pos + (size_t)which * 32 * HD;
        f32x4 acc[4];
#pragma unroll
        for (int k = 0; k < 4; ++k) acc[k] = (f32x4){0.f, 0.f, 0.f, 0.f};
        for (int l = 0; l < 32; ++l) {
            { const int r = tid >> 3, ch = (tid & 7) * 16, n = nt * 64 + r; unsigned w[8];
              if (n < NCMP) { const bf16* src = P1 + ((size_t)b * SEQ + 16 * n + l) * NSA_INP + P1_KC + which * KVW + g * HD + ch;
                  const v4u x0 = *(const v4u*)src, x1 = *(const v4u*)(src + 8); const unsigned xs[8] = {x0.x, x0.y, x0.z, x0.w, x1.x, x1.y, x1.z, x1.w};
#pragma unroll
                  for (int q = 0; q < 8; ++q) w[q] = pk2(bflo(xs[q]) + posw[l * HD + ch + 2 * q], bfhi(xs[q]) + posw[l * HD + ch + 2 * q + 1]);
              } else {
#pragma unroll
                  for (int q = 0; q < 8; ++q) w[q] = 0u; }
              LAS v4u* dst = (LAS v4u*)(lds + CM_A + r * 272 + ch * 2); dst[0] = (v4u){w[0], w[1], w[2], w[3]}; dst[1] = (v4u){w[4], w[5], w[6], w[7]}; }
            { const int e = tid >> 2, ch = (tid & 3) * 32; const bf16* src = w1 + (size_t)e * 32 * HD + l * HD + ch;
              const v4u x0 = *(const v4u*)src, x1 = *(const v4u*)(src + 8), x2 = *(const v4u*)(src + 16), x3 = *(const v4u*)(src + 24);
              LAS v4u* dst = (LAS v4u*)(lds + CM_B + e * 272 + ch * 2); dst[0] = x0; dst[1] = x1; dst[2] = x2; dst[3] = x3; }
            LDS_WAIT(); __syncthreads();
#pragma unroll
            for (int k = 0; k < 4; ++k) { const int tau = wid + 8 * k, ni = tau >> 3, ei = tau & 7;
                acc[k] += mma_tile<128>(lds + CM_A + ni * 16 * 272, 272, lds + CM_B + ei * 16 * 272, 272, fr, fq); }
            LDS_WAIT(); __syncthreads();
        }
#pragma unroll
        for (int k = 0; k < 4; ++k) { const int tau = wid + 8 * k, ni = tau >> 3, ei = tau & 7;
#pragma unroll
            for (int i = 0; i < 4; ++i) *(LAS unsigned short*)(lds + CM_H + (16 * ni + 4 * fq + i) * 272 + (16 * ei + fr) * 2) = (unsigned short)f2bf(gelu1(acc[k][i])); }
        { const int f = tid >> 2, ch = (tid & 3) * 32; const bf16* src = w2 + (size_t)f * HD + ch;
          const v4u x0 = *(const v4u*)src, x1 = *(const v4u*)(src + 8), x2 = *(const v4u*)(src + 16), x3 = *(const v4u*)(src + 24);
          LAS v4u* dst = (LAS v4u*)(lds + CM_B + f * 272 + ch * 2); dst[0] = x0; dst[1] = x1; dst[2] = x2; dst[3] = x3; }
        LDS_WAIT(); __syncthreads();
        bf16* outp = which ? VCMP : KCMP;
#pragma unroll
        for (int k = 0; k < 4; ++k) { const int tau = wid + 8 * k, ni = tau >> 3, fi = tau & 7;
            const f32x4 a2 = mma_tile<128>(lds + CM_H + ni * 16 * 272, 272, lds + CM_B + fi * 16 * 272, 272, fr, fq);
#pragma unroll
            for (int i = 0; i < 4; ++i) { const int n = nt * 64 + 16 * ni + 4 * fq + i;
                outp[(((size_t)b * NCMPP + n) * NSA_G + g) * HD + 16 * fi + fr] = (n < NCMP) ? (bf16)f2bf(a2[i]) : (bf16)0u; } }
        LDS_WAIT(); __syncthreads();
    }
}
__device__ __forceinline__ unsigned pick4(const unsigned (&a)[4], int i) { return i == 0 ? a[0] : (i == 1 ? a[1] : (i == 2 ? a[2] : a[3])); }
template <int MODE>
__device__ __forceinline__ void nsa_attn_phase(Frame& F, const bf16* P1, const bf16* Qsrc, const bf16* Ksrc, const bf16* Vsrc, const unsigned* SEL, float* O32, float* IMP, bf16* Ob, bool probe_nostore = false) {
    const int tid = F.tid, wid = F.wave, lane = F.lane, r32 = lane & 31, hi = lane >> 5;
    LAS char* lds = (LAS char*)F.lds;
    LAS float* wsc = (LAS float*)(lds + ATT_WS_OFF + wid * 256);
    const int vb0 = (int)(uintptr_t)(lds + ATT_V_OFF) + v_rd_base(lane);
    KVDma dm; kv_dma_init(dm, MODE <= 1 ? NSA_G * HD : KVW, MODE == 0 ? NSA_G * HD : (MODE == 1 ? NSLC : NSA_INP), wid, lane);
    constexpr int NTB = SEQ / 32, NU = BATCH * NSA_G * NTB;
    for (int rd = 0; ; ++rd) {
        const int idx = (rd & 1) ? rd * F.G + (F.G - 1 - F.bid) : rd * F.G + F.bid;
        if (rd * F.G >= NU) break;
        if (idx >= NU) continue;
        const int tb = NTB - 1 - idx / (BATCH * NSA_G), bg = idx % (BATCH * NSA_G), g = bg % NSA_G, b = bg / NSA_G;
        const size_t rowb = (size_t)b * SEQ; const int t0 = tb * 32;
        const int t = (MODE == 2) ? t0 + 4 * wid + (r32 >> 3) : t0 + r32, head = (MODE == 2) ? g * NSA_R + (r32 & 7) : g * NSA_R + wid;
        const bf16* Kh; const bf16* Vh; long ldk, ldv; int jlo, jhi;
        if (MODE <= 1) { Kh = Ksrc + ((size_t)b * NCMPP * NSA_G + g) * HD; ldk = NSA_G * HD; jlo = 0; jhi = (t0 >> 4) >> 6;
            if (MODE == 0) { Vh = Vsrc + ((size_t)b * NCMPP * NSA_G + g) * HD; ldv = NSA_G * HD; } else { Vh = Vsrc; ldv = NSLC; } }
        else { Kh = Ksrc + rowb * KVW + g * HD; ldk = KVW; Vh = P1 + rowb * NSA_INP + (MODE == 2 ? P1_VS : P1_VW) + g * HD; ldv = NSA_INP;
            jhi = (t0 + 31) >> 6; jlo = (MODE == 2) ? 0 : ((t0 - (WINDOW - 1) > 0 ? t0 - (WINDOW - 1) : 0) >> 6); }
        bf16x8 qr[8]; load_q(qr, Qsrc + (rowb + t) * (MODE <= 1 ? NSA_INP : DM) + head * HD + hi * 8);
        unsigned selw[4] = {0u, 0u, 0u, 0u}, uni[4] = {~0u, ~0u, ~0u, ~0u}, wn[4] = {~0u, ~0u, ~0u, ~0u};
        if (MODE == 2) { const v4u sv = *(const v4u*)(SEL + ((rowb + t) * NSA_G + g) * 4); selw[0] = sv.x; selw[1] = sv.y; selw[2] = sv.z; selw[3] = sv.w;
            LAS unsigned* un = (LAS unsigned*)(lds + ATT_X_OFF);
#pragma unroll
            for (int q = 0; q < 4; ++q) { unsigned x = selw[q]; x |= __shfl_xor(x, 8); x |= __shfl_xor(x, 16); wn[q] = __builtin_amdgcn_readfirstlane(x); if (lane == 0) un[wid * 4 + q] = wn[q]; }
            LDS_WAIT(); __syncthreads();
#pragma unroll
            for (int q = 0; q < 4; ++q) { unsigned x = 0u;
#pragma unroll
                for (int w = 0; w < NWAVES; ++w) x |= un[w * 4 + q];
                uni[q] = __builtin_amdgcn_readfirstlane(x); } }
        float m_reg = -1e30f, l_reg = 0.f; f32x16 o[4] = {};
        const int cur = t >> 6;
#define NSA_NEXT(jj) do { if (MODE == 2) { while ((jj) <= jhi && !((pick4(uni, (jj) >> 5) >> ((jj) & 31)) & 1u)) ++(jj); } } while (0)
#define NSA_NEED(jj) (MODE != 2 || ((pick4(wn, (jj) >> 5) >> ((jj) & 31)) & 1u))
#define NSA_MASK(P0, P1, JJ) do { const int k0 = (JJ) * KVBLK; constexpr float NINF = -__builtin_inff(); \
            if (MODE <= 1) { if (!(16 * (k0 + 63) + 31 <= t0)) { \
                    _Pragma("unroll") for (int r = 0; r < 16; ++r) { if (!(16 * (k0 + crow(r, hi)) + 31 <= t)) P0[r] = NINF; if (!(16 * (k0 + 32 + crow(r, hi)) + 31 <= t)) P1[r] = NINF; } } } \
            else if (MODE == 2) { const bool mine = (pick4(selw, (JJ) >> 5) >> ((JJ) & 31)) & 1u; const int lim = mine ? ((JJ) < cur ? 0x7fffffff : t) : -1; \
                _Pragma("unroll") for (int r = 0; r < 16; ++r) { if (k0 + crow(r, hi) > lim) P0[r] = NINF; if (k0 + 32 + crow(r, hi) > lim) P1[r] = NINF; } } \
            else { if (!((k0 > t0 + 31 - WINDOW) && (k0 + 63 <= t0))) { \
                    _Pragma("unroll") for (int r = 0; r < 16; ++r) { const int ka = k0 + crow(r, hi), kb = ka + 32; \
                        if (!(ka <= t && ka > t - WINDOW)) P0[r] = NINF; if (!(kb <= t && kb > t - WINDOW)) P1[r] = NINF; } } } } while (0)
        int ja = jlo; NSA_NEXT(ja); int jb = ja + 1; NSA_NEXT(jb);
        __syncthreads();
        if (ja <= jhi) kv_dma(dm, Kh + (size_t)ja * KVBLK * ldk, Vh + (size_t)ja * KVBLK * ldv, lds, 0, wid);
        if (jb <= jhi) kv_dma(dm, Kh + (size_t)jb * KVBLK * ldk, Vh + (size_t)jb * KVBLK * ldv, lds, ATT_BUF, wid);
        int set = 0;
        while (ja <= jhi) {
            int jc = jb + 1; NSA_NEXT(jc); int jd = jc + 1; NSA_NEXT(jd);
            VM_WAIT(); __syncthreads();
            if (jc <= jhi) kv_dma(dm, Kh + (size_t)jc * KVBLK * ldk, Vh + (size_t)jc * KVBLK * ldv, lds, ATT_SET - set, wid);
            if (jd <= jhi) kv_dma(dm, Kh + (size_t)jd * KVBLK * ldk, Vh + (size_t)jd * KVBLK * ldv, lds, ATT_SET - set + ATT_BUF, wid);
            const bool nA = NSA_NEED(ja), nB = (jb <= jhi) && NSA_NEED(jb);
            f32x16 a0, a1, b0, b1;
            if (nA) qkt(a0, a1, lds + set + ATT_K_OFF, qr, r32, hi);
            if (nB) qkt(b0, b1, lds + set + ATT_BUF + ATT_K_OFF, qr, r32, hi);
            if (nA) { NSA_MASK(a0, a1, ja); attn_finish(a0, a1, o, m_reg, l_reg, wsc, vb0 + set, r32, hi); }
            if (nB) { NSA_MASK(b0, b1, jb); attn_finish(b0, b1, o, m_reg, l_reg, wsc, vb0 + set + ATT_BUF, r32, hi); }
            ja = jc; jb = jd; set = ATT_SET - set;
        }
#undef NSA_MASK
#undef NSA_NEED
#undef NSA_NEXT
        { float fac = l_reg > 0.f ? __builtin_amdgcn_rcpf(l_reg) : 0.f;
          if (MODE != 1) { const int br = MODE == 0 ? 0 : (MODE == 2 ? 1 : 2); fac *= sigmoidf_(bf2f(P1[(rowb + t) * NSA_INP + P1_GL + head * 3 + br])); }
          if (hi == 0) wsc[32 + r32] = fac; LDS_WAIT(); }
        if (MODE == 1) {
            float fc[16];
#pragma unroll
            for (int r = 0; r < 16; ++r) fc[r] = wsc[32 + crow(r, hi)];
            LDS_WAIT(); __syncthreads();
#pragma unroll
            for (int r = 0; r < 16; ++r) { const int orow = crow(r, hi);
#pragma unroll
                for (int d0 = 0; d0 < 4; ++d0) *(LAS float*)(lds + ((wid * 32 + orow) * 128 + d0 * 32 + r32) * 4) = o[d0][r] * fc[r]; }
            LDS_WAIT(); __syncthreads();
            { const int tok = tid >> 4, j8 = (tid & 15) * 8; f32x4 s0 = {0.f, 0.f, 0.f, 0.f}, s1 = {0.f, 0.f, 0.f, 0.f};
#pragma unroll
              for (int w = 0; w < 8; ++w) { const LAS f32x4* pp = (const LAS f32x4*)(lds + ((w * 32 + tok) * 128 + j8) * 4); s0 += pp[0]; s1 += pp[1]; }
              f32x4* dst = (f32x4*)(IMP + ((rowb + t0 + tok) * NSA_G + g) * NSLC + j8); dst[0] = s0; dst[1] = s1; }
            LDS_WAIT(); __syncthreads();
        } else {
#pragma unroll
            for (int r = 0; r < 16; ++r) { const int orow = crow(r, hi); const float fc = wsc[32 + orow];
                const size_t off = (MODE == 2) ? (rowb + t0 + 4 * wid + (orow >> 3)) * DM + (g * NSA_R + (orow & 7)) * HD + r32 : (rowb + t0 + orow) * DM + head * HD + r32;
#pragma unroll
                for (int d0 = 0; d0 < 4; ++d0) {
                    if (MODE == 0) O32[off + d0 * 32] = o[d0][r] * fc;
                    else if (MODE == 2) { if (!probe_nostore) O32[off + d0 * 32] += o[d0][r] * fc; }
                    else Ob[off + d0 * 32] = (bf16)f2bf(O32[off + d0 * 32] + o[d0][r] * fc); } }
            LDS_WAIT();
        }
    }
}
__device__ __forceinline__ void nsa_topk_phase(Frame& F, const float* IMP, unsigned* SEL) {
    LAS float* sc = (LAS float*)(F.lds + F.wave * 1024);
    const int gw = F.bid * NWAVES + F.wave, NGW = F.G * NWAVES, lane = F.lane;
    for (int it = gw; it < MTOK * NSA_G; it += NGW) {
        const int m = it / NSA_G, t = m & (SEQ - 1), cur = t >> 6;
        const float* ip = IMP + (size_t)it * NSLC;
        const float a0 = ip[lane], a1 = ip[64 + lane];
        sc[lane] = a0; sc[64 + lane] = a1; LDS_WAIT();
        const int j0 = lane, j1 = lane + 64;
        const bool f0 = (j0 == 0) || (j0 == cur) || (j0 == cur - 1), f1 = (j1 == cur) || (j1 == cur - 1);
        const bool c0 = !f0 && j0 <= cur, c1 = !f1 && j1 <= cur;
        const int nforced = cur >= 2 ? 3 : cur + 1, slots = NTOP - nforced;
        int rk0 = 0, rk1 = 0;
        const int ncand_hi = cur < NSLC ? cur : NSLC - 1;
        for (int i = 1; i <= ncand_hi; ++i) {
            const bool fi = (i == cur) || (i == cur - 1); if (fi) continue;
            const float v = sc[i];
            rk0 += (v > a0 || (v == a0 && i < j0)) ? 1 : 0; rk1 += (v > a1 || (v == a1 && i < j1)) ? 1 : 0;
        }
        const bool s0 = (f0 && j0 <= cur) || (c0 && rk0 < slots), s1 = (f1 && j1 <= cur) || (c1 && rk1 < slots);
        const unsigned long long m0 = __ballot(s0), m1 = __ballot(s1);
        if (lane == 0) { v4u w = {(unsigned)m0, (unsigned)(m0 >> 32), (unsigned)m1, (unsigned)(m1 >> 32)}; *(v4u*)(SEL + (size_t)it * 4) = w; }
        LDS_WAIT();
    }
}

#ifndef STAGE
#define STAGE 3
#endif
#define ZERO_OB_PHASE PH_BEGIN { v4u z = {0u, 0u, 0u, 0u}; v4u* p = (v4u*)Ob; const long n = (long)MTOK * DM / 8; \
            for (long i = (long)F.bid * NTHR + F.tid; i < n; i += (long)F.G * NTHR) p[i] = z; } PH_END
#define MIXER0_PHASES \
    PH_BEGIN { const long long* fs_ = (const long long*)(ws + WS_FOLD); float* fd_ = (float*)(ws + WS_FOLDF); \
               for (int i = F.bid * NTHR + F.tid; i < 2 * FO_N; i += F.G * NTHR) { const long long v = fs_[i]; fd_[i] = (float)(int)(v >> 32) + (float)(unsigned)v * pg8::FOLD_INV; } } \
             REP(10) hgrn_phase_a(F, BIG, (const float*)(ws + WS_LB), (bf16*)(ws + WS_QT), (bf16*)(ws + WS_OINTRA), (bf16*)(ws + WS_DS), (float*)(ws + WS_DEC)); \
             REP(11) sb_phase(F, BIG, Ob); PH_END \
    PH_BEGIN REP(12) hgrn_phase_b(F, (const bf16*)(ws + WS_DS), (const float*)(ws + WS_DEC), (bf16*)(ws + WS_SPREV)); PH_END \
    PH_BEGIN REP(13) hgrn_phase_c(F, BIG, (const bf16*)(ws + WS_QT), (const bf16*)(ws + WS_OINTRA), (const bf16*)(ws + WS_SPREV), args.in[IN_HGRN_NW], Ob); PH_END
#if STAGE <= 2
#define MIXER1_PHASES ZERO_OB_PHASE
#else
#define MIXER1_PHASES \
    PH_BEGIN REP(14) { nsa_rope_phase(F, BIG, (const float*)(ws + WS_ROPE), (bf16*)(ws + WS_QROT), (bf16*)(ws + WS_KSROT), (bf16*)(ws + WS_KWROT), (bf16*)(ws + WS_OVL)); \
             nsa_compress_phase(F, BIG, args.in[IN_NSA_CMP_POS], (const bf16*)(ws + WS_W_C1), (const bf16*)(ws + WS_W_C2), (bf16*)(ws + WS_KCMP), (bf16*)(ws + WS_VCMP)); } PH_END \
    PH_BEGIN { REP(15) nsa_attn_phase<0>(F, BIG, BIG, (const bf16*)(ws + WS_KCMP), (const bf16*)(ws + WS_VCMP), nullptr, (float*)(ws + WS_O32), nullptr, nullptr); \
             REP(15) nsa_attn_phase<1>(F, BIG, BIG, (const bf16*)(ws + WS_KCMP), (const bf16*)(ws + WS_OVL), nullptr, nullptr, (float*)(ws + WS_IMP), nullptr); } PH_END \
    PH_BEGIN REP(16) nsa_topk_phase(F, (const float*)(ws + WS_IMP), (unsigned*)(ws + WS_SEL)); PH_END \
    PH_BEGIN REP(18) nsa_attn_phase<2>(F, BIG, (const bf16*)(ws + WS_QROT), (const bf16*)(ws + WS_KSROT), nullptr, (const unsigned*)(ws + WS_SEL), (float*)(ws + WS_O32), nullptr, nullptr, r_ > 0); PH_END \
    PH_BEGIN REP(17) nsa_attn_phase<3>(F, BIG, (const bf16*)(ws + WS_QROT), (const bf16*)(ws + WS_KWROT), nullptr, nullptr, (float*)(ws + WS_O32), nullptr, Ob); PH_END
#endif
#ifndef REPMASK
#define REPMASK 0u
#endif
#define REP(gid) for (int r_ = 0; r_ <= (int)((REPMASK >> (gid)) & 1u); ++r_)
#define PH_BEGIN if (pc >= lo && pc < hi) { F.fresh();
#define PH_END   if (pc + 1 < hi) { XcdBarrier bb_ = bar; asm volatile("" : "+s"(bb_.bar), "+s"(bb_.x)); xcd_barrier(bb_); } } ++pc;
template <int l>
__device__ __forceinline__ void layer_body(Frame& F, const Args& args, const XcdBarrier& bar, int& pc, const int lo, const int hi) {
    unsigned char* ws = args.ws;
    bf16* HB = (bf16*)(ws + WS_HB); bf16* Y = (bf16*)(ws + WS_Y); float* H32 = args.out;
    bf16* BIG = (bf16*)(ws + WS_BIG); bf16* Gm = (bf16*)(ws + WS_G); bf16* Ob = (bf16*)(ws + WS_O);
    bf16* XQ = (bf16*)(ws + WS_XQ); bf16* XO = (bf16*)(ws + WS_XO);
#define RS(k) ((long long*)(ws + WS_RSUM) + (size_t)(k) * MTOK * 2)
#define LNG(k) (args.in[IN_LN_G] + (size_t)(k) * DM)
#define LNB(k) (args.in[IN_LN_B] + (size_t)(k) * DM)
    const float* cs = (const float*)(ws + WS_FOLDF); const float* b2 = cs + FO_N;
        PH_BEGIN REP(1) {
            const int N = l == 0 ? AB_IN : NSA_INP;
            pg8::StaticOrder S; S.init(MTOK, N, F.G, F.bid);
            if (l == 0) { pg8::Gemm g{HB, (const bf16*)(ws + WS_W_ABIN), MTOK, N, DM}; pg8::EpiBf16<0> E{BIG, N, nullptr, 0, 0, 1.f};
                pg8::gemm_phase<pg8::EpiBf16<0>, pg8::StaticOrder, PG8_ALIGN, PG8_SP2>(F.lds + RING_OFF, g, S, E); }
            else { pg8::Gemm g{Y, (const bf16*)(ws + WS_W_NSAIN), MTOK, N, DM}; pg8::EpiBf16Ln E{BIG, N, RS(2), cs + FO_NSA, b2 + FO_NSA};
                pg8::gemm_phase<pg8::EpiBf16Ln, pg8::StaticOrder, PG8_ALIGN, PG8_SP2>(F.lds + RING_OFF, g, S, E); }
        } PH_END
#if STAGE <= 1
        ZERO_OB_PHASE
#else
        if (l == 0) {
            MIXER0_PHASES
        } else {
            MIXER1_PHASES
        }
#endif
        PH_BEGIN REP(2) {
            pg8::Gemm g{Ob, l == 0 ? (const bf16*)(ws + WS_W_ABOUT) : (const bf16*)(ws + WS_W_NSAOUT), MTOK, DM, DM};
            pg8::StaticOrder S; S.init(MTOK, DM, F.G, F.bid);
            if (l == 0) { pg8::EpiRes0 E{Y, HB, DM, DN_ALPHA, RS(0)};
                pg8::gemm_phase<pg8::EpiRes0, pg8::StaticOrder, PG8_ALIGN, PG8_SP2>(F.lds + RING_OFF, g, S, E); }
            else { pg8::EpiResLn2 E{Y, RS(2), LNG(2), LNB(2), DM, DN_ALPHA, RS(3)};
                pg8::gemm_phase<pg8::EpiResLn2, pg8::StaticOrder, PG8_ALIGN, PG8_SP2>(F.lds + RING_OFF, g, S, E); }
        } PH_END
        PH_BEGIN REP(3) {
            {   pg8::Gemm g{Y, (const bf16*)(ws + WS_W_XQ) + (size_t)l * XW * DM, MTOK, XW, DM};
                pg8::RangeOrder S; S.init(MTOK, XW, 0, 128, F.bid);
                pg8::EpiBf16Ln E{XQ, XW, RS(3 * l), cs + FO_XQ + l * XW, b2 + FO_XQ + l * XW};
                pg8::gemm_phase<pg8::EpiBf16Ln, pg8::RangeOrder, PG8_ALIGN, PG8_SP2>(F.lds + RING_OFF, g, S, E); }
            {   pg8::Gemm g{(const bf16*)(ws + WS_MEMB), (const bf16*)(ws + WS_W_XKV) + (size_t)l * 2 * XW * DM, BATCH * NMEM, 2 * XW, DM};
                pg8::RangeOrder S; S.init(BATCH * NMEM, 2 * XW, 128, 8, F.bid);
                pg8::EpiBf16<0> E{(bf16*)(ws + WS_XKV) + (size_t)l * BATCH * NMEM * 2 * XW, 2 * XW, nullptr, 0, 0, 1.f};
                pg8::gemm_phase<pg8::EpiBf16<0>, pg8::RangeOrder, PG8_ALIGN, PG8_SP2>(F.lds + RING_OFF, g, S, E); }
        } PH_END
        PH_BEGIN REP(9) xattn_phase(F, XQ, (const bf16*)(ws + WS_XKV) + (size_t)l * BATCH * NMEM * 2 * XW, XO); PH_END
        PH_BEGIN REP(4) {
            pg8::Gemm g{XO, (const bf16*)(ws + WS_W_XO) + (size_t)l * DM * XW, MTOK, DM, XW};
            pg8::StaticOrder S; S.init(MTOK, DM, F.G, F.bid);
            pg8::EpiResLn2 E{Y, RS(3 * l), LNG(3 * l), LNB(3 * l), DM, DN_ALPHA, RS(3 * l + 1)};
            pg8::gemm_phase<pg8::EpiResLn2, pg8::StaticOrder, PG8_ALIGN, PG8_SP2>(F.lds + RING_OFF, g, S, E);
        } PH_END
        PH_BEGIN REP(5) {
#if (REPMASK >> 22) & 1
            if (r_ > 0) { XcdBarrier bb_ = bar; asm volatile("" : "+s"(bb_.bar), "+s"(bb_.x)); xcd_barrier(bb_); }
#endif
            pg8::Gemm g{Y, (const bf16*)(ws + WS_W_UP) + (size_t)l * DFF2 * DM, MTOK, DFF2, DM};
            pg8::StaticOrder S; S.init(MTOK, DFF2, F.G, F.bid);
            pg8::EpiBf16Ln E{BIG, DFF2, RS(3 * l + 1), cs + FO_UP + l * DFF2, b2 + FO_UP + l * DFF2};
            pg8::gemm_phase<pg8::EpiBf16Ln, pg8::StaticOrder, PG8_ALIGN, PG8_SP2>(F.lds + RING_OFF, g, S, E);
        } PH_END
#if (REPMASK >> 20) & 1
        PH_BEGIN {
            pg8::Gemm g{HB, (const bf16*)(ws + WS_W_UP) + (size_t)l * DFF2 * DM, MTOK, DFF2, DM};
            pg8::ZeroOrder S; S.init(MTOK, DFF2, F.G, F.bid);
            pg8::EpiBf16<0> E{Gm, DFF2, nullptr, 0, 0, 1.f};
            pg8::gemm_phase<pg8::EpiBf16<0>, pg8::ZeroOrder, PG8_ALIGN, PG8_SP2>(F.lds + RING_OFF, g, S, E);
        } PH_END
#endif
        PH_BEGIN REP(8) convglu_phase(F, BIG, args.in[IN_FFN_CONV] + (size_t)l * 3 * DFF, Gm); PH_END
        PH_BEGIN REP(6) {
            pg8::Gemm g{Gm, (const bf16*)(ws + WS_W_DOWN) + (size_t)l * DM * DFF, MTOK, DM, DFF};
            pg8::StaticOrder S; S.init(MTOK, DM, F.G, F.bid);
            pg8::EpiResLn2 E{Y, RS(3 * l + 1), LNG(3 * l + 1), LNB(3 * l + 1), DM, DN_ALPHA, RS(3 * l + 2)};
            pg8::gemm_phase<pg8::EpiResLn2, pg8::StaticOrder, PG8_ALIGN, PG8_SP2>(F.lds + RING_OFF, g, S, E);
        } PH_END
        if (l == 1) { PH_BEGIN REP(7) ln_phase(F, Y, LNG(5), LNB(5), H32); PH_END }
#undef RS
#undef LNG
#undef LNB
}
__global__ void __launch_bounds__(NTHR, 2) mega_fwd(Args args) {
    extern __shared__ __attribute__((aligned(16))) unsigned char lds_raw[];
    Frame F;
    F.lds = (LAS unsigned char*)lds_raw; F.ws = args.ws;
    F.tid = threadIdx.x; F.lane = F.tid & 63; F.wave = __builtin_amdgcn_readfirstlane(F.tid >> 6); F.G = gridDim.x;
    unsigned char* ws = args.ws;
    gu32* ctl = (gu32*)(ws + WS_CTL);
    for (int u = F.tid; u < (LDS_BYTES - LDSCTL_OFF) / 4; u += NTHR) ((LAS unsigned*)(F.lds + LDSCTL_OFF))[u] = 0u;
    __syncthreads();
    volatile LAS unsigned* MISC = (volatile LAS unsigned*)(F.lds + MISC_OFF);
    XcdBarrier bar = xcd_barrier_post((unsigned*)(ctl + CW_BAR), MISC + 8);
    const int lo = args.ph_lo, hi = args.ph_hi; int pc = 0;
    bf16* HB = (bf16*)(ws + WS_HB); bf16* Y = (bf16*)(ws + WS_Y); float* H32 = args.out;
    bf16* BIG = (bf16*)(ws + WS_BIG); bf16* Gm = (bf16*)(ws + WS_G); bf16* Ob = (bf16*)(ws + WS_O);
    bf16* XQ = (bf16*)(ws + WS_XQ); bf16* XO = (bf16*)(ws + WS_XO);

    PH_BEGIN REP(0) p0_prologue(F, args); PH_END

#if (REPMASK >> 21) & 1
    for (int e_ = 0; e_ < 40; ++e_) { PH_BEGIN PH_END }
#endif
    layer_body<0>(F, args, bar, pc, lo, hi);
    layer_body<1>(F, args, bar, pc, lo, hi);
}

extern "C" void kernel_launch(void* const* d_in, const int* in_sizes, int n_in, void* d_out, int out_size, void* d_ws, size_t ws_size, hipStream_t stream) {
    static int grid = 0;
    if (grid == 0) {
        if (n_in != 19 || in_sizes[0] != MTOK * DM || out_size != MTOK * DM || ws_size < WS_END) {
            fprintf(stderr, "kernel_launch: shape mismatch n_in %d in0 %d out %d ws %zu (need %zu)\n", n_in, n_in > 0 ? in_sizes[0] : -1, out_size, ws_size, (size_t)WS_END); grid = -1; return; }
        int dev = 0, cus = 0, per_cu = 0;
        if (hipGetDevice(&dev) != hipSuccess || hipDeviceGetAttribute(&cus, hipDeviceAttributeMultiprocessorCount, dev) != hipSuccess) { grid = -1; return; }
        if (hipFuncSetAttribute((const void*)mega_fwd, hipFuncAttributeMaxDynamicSharedMemorySize, LDS_BYTES) != hipSuccess) { fprintf(stderr, "kernel_launch: hipFuncSetAttribute failed\n"); grid = -1; return; }
        if (hipOccupancyMaxActiveBlocksPerMultiprocessor(&per_cu, (const void*)mega_fwd, NTHR, LDS_BYTES) != hipSuccess || per_cu < 1)
            fprintf(stderr, "kernel_launch: note: occupancy query reports %d workgroups per CU\n", per_cu);
        (void)hipGetLastError();
        grid = cus;
    }
    if (grid < 0) return;
    if (hipMemsetAsync((char*)d_ws + WS_CTL, 0, CTL_ZERO_BYTES, stream) != hipSuccess) { fprintf(stderr, "kernel_launch: memset failed\n"); return; }
    Args a{};
    for (int i = 0; i < 19; ++i) a.in[i] = (const float*)d_in[i];
    a.out = (float*)d_out; a.ws = (unsigned char*)d_ws; a.ph_lo = 0; a.ph_hi = 1 << 20;
    hipLaunchKernelGGL(mega_fwd, dim3(grid), dim3(NTHR), LDS_BYTES, stream, a);
    const hipError_t le = hipPeekAtLastError();
    if (le != hipSuccess) fprintf(stderr, "kernel_launch: launch failed: %s\n", hipGetErrorName(le));
}
```

```cpp
#include <hip/hip_runtime.h>
#include <cstdio>
#include <cstdint>
namespace pg8 {
#define PG8_LAS __attribute__((address_space(3)))
typedef unsigned short bf16_t;
typedef short bf16x8 __attribute__((ext_vector_type(8)));
typedef float f32x4 __attribute__((ext_vector_type(4)));
typedef unsigned u32x4 __attribute__((ext_vector_type(4)));
constexpr int BM = 256, BK = 64, HALF = 128, HTB = HALF * BK * 2  , STAGE_BYTES = 8 * HTB, NXCD = 8, WGM = 8;

__host__ __device__ __forceinline__ int lds_byte(int r, int c) { const int st = (r >> 4) * 2 + (c >> 5), rr = r & 15, cc = c & 31, ob = rr * 64 + cc * 2; return st * 1024 + (ob ^ (((ob >> 9) & 1) << 5)); }
__host__ __device__ __forceinline__ void stage_rc(int b, int& R, int& C) { const int st = b / 1024, sb = b % 1024, swz = sb ^ (((sb >> 9) & 1) << 5); R = (st >> 1) * 16 + swz / 64; C = (st & 1) * 32 + (swz % 64) / 2; }
__host__ __device__ __forceinline__ int perm32(int rho) { const int n = rho >> 4, i = rho & 15; return 8 * (i >> 2) + 4 * n + (i & 3); }

struct Unit { int pm, pn; };
struct Gemm { const bf16_t* A; const bf16_t* Bt; int M, N, K; };

struct StaticOrder {
    int nM, nN, nwg, G, c;
    __host__ __device__ void init(int M, int N, int G_, int c_) { nM = M / BM; nN = N / BM; nwg = nM * nN; G = G_; c = c_; }
    __host__ __device__ bool next(int i, Unit& u) const {
        const long L = (long)i * G + c; if (L >= nwg) return false;
        int wgid = (int)L; { const int q = nwg / NXCD, r = nwg % NXCD, xcd = wgid % NXCD, off = wgid / NXCD; wgid = (xcd < r ? xcd * (q + 1) : r * (q + 1) + (xcd - r) * q) + off; }
        const int nig = WGM * nN, gid = wgid / nig, fm = gid * WGM, gsz = (nM - fm) < WGM ? (nM - fm) : WGM;
        u.pm = fm + ((wgid % nig) % gsz); u.pn = (wgid % nig) / gsz; return true;
    }
    __device__ __forceinline__ void a_ready(const Unit&) const {}
    __device__ __forceinline__ void done(const Unit&) const {}
};

__device__ __forceinline__ unsigned cvt_pk_bf16(float lo, float hi) { unsigned r; asm volatile("v_cvt_pk_bf16_f32 %0, %1, %2" : "=v"(r) : "v"(lo), "v"(hi)); return r; }
typedef float f32x2 __attribute__((ext_vector_type(2)));
__device__ __forceinline__ f32x2 gelu_pk(f32x2 v) {
    const f32x2 av = __builtin_elementwise_abs(v), d = av * 0.2316418882f + 1.0f;
    f32x2 t; t.x = __builtin_amdgcn_rcpf(d.x); t.y = __builtin_amdgcn_rcpf(d.y);
    f32x2 q = t * 0.5307027145f + (-0.7265760135f); q = q * t + 0.7107068705f; q = q * t + (-0.142248368f); q = q * t + 0.127414796f; q = q * t;
    const f32x2 s = (v * v) * (-0.72134752044f);
    f32x2 e; e.x = __builtin_amdgcn_exp2f(s.x); e.y = __builtin_amdgcn_exp2f(s.y);
    const f32x2 m = v * (q * e), r = v - m;
    f32x2 o; o.x = v.x < 0.f ? m.x : r.x; o.y = v.y < 0.f ? m.y : r.y; return o;
}

template <int ACT  > struct EpiBf16 {
    static constexpr bool PERM = true, AFTER_DRAIN = false; static_assert(ACT == 0 || ACT == 1, "EpiBf16: ACT is 0 (none) or 1 (gelu_pk)");
    bf16_t* O; int ldc; const float* bias; int split_cols; size_t split_stride; float scale0;
    __device__ __forceinline__ void operator()(const f32x4 (&acc)[2][2][4][2], const Unit& u, int wr, int wc, int fr, int fq) const {
        const int row0 = u.pm * BM + wr * 64 + fr; int colt = u.pn * BM; bf16_t* base = O;
        float sc = 1.f; if (split_cols) { const int t = colt / split_cols; base += (size_t)t * split_stride; colt -= t * split_cols; if (t == 0) sc = scale0; }
        const int col0 = colt + wc * 32 + 8 * fq, bcol0 = u.pn * BM + wc * 32 + 8 * fq;
        f32x4 bv[2][2];
#pragma unroll
        for (int bj = 0; bj < 2; ++bj)
#pragma unroll
            for (int n = 0; n < 2; ++n) bv[bj][n] = bias ? *(const f32x4*)(bias + bcol0 + bj * HALF + 4 * n) : (f32x4){0.f, 0.f, 0.f, 0.f};
#pragma unroll
        for (int ai = 0; ai < 2; ++ai)
#pragma unroll
            for (int m = 0; m < 4; ++m) { bf16_t* rowp = base + (size_t)(row0 + ai * HALF + m * 16) * ldc + col0;
#pragma unroll
                for (int bj = 0; bj < 2; ++bj) { f32x4 v0 = acc[ai][bj][m][0] + bv[bj][0], v1 = acc[ai][bj][m][1] + bv[bj][1];
                    if (ACT == 1) { f32x2 a = gelu_pk((f32x2){v0[0], v0[1]}), b = gelu_pk((f32x2){v0[2], v0[3]}), c = gelu_pk((f32x2){v1[0], v1[1]}), d = gelu_pk((f32x2){v1[2], v1[3]});
                        v0 = (f32x4){a.x, a.y, b.x, b.y}; v1 = (f32x4){c.x, c.y, d.x, d.y}; }
                    v0 = v0 * sc; v1 = v1 * sc; u32x4 w; w.x = cvt_pk_bf16(v0[0], v0[1]); w.y = cvt_pk_bf16(v0[2], v0[3]); w.z = cvt_pk_bf16(v1[0], v1[1]); w.w = cvt_pk_bf16(v1[2], v1[3]);
                    *(u32x4*)(rowp + bj * HALF) = w; } }
    }
};


struct EpiRes {
    static constexpr bool PERM = false, AFTER_DRAIN = false;
    float* Y; const float* res; int ldc; float alpha;
    __device__ __forceinline__ void operator()(const f32x4 (&acc)[2][2][4][2], const Unit& u, int wr, int wc, int fr, int fq) const {
        const int row0 = u.pm * BM + wr * 64 + fr, col0 = u.pn * BM + wc * 32 + 4 * fq;
#pragma unroll
        for (int ai = 0; ai < 2; ++ai)
#pragma unroll
            for (int m = 0; m < 4; ++m) { const size_t off = (size_t)(row0 + ai * HALF + m * 16) * ldc + col0;
#pragma unroll
                for (int bj = 0; bj < 2; ++bj)
#pragma unroll
                    for (int n = 0; n < 2; ++n) { const f32x4 r = *(const f32x4*)(res + off + bj * HALF + n * 16);
                        *(f32x4*)(Y + off + bj * HALF + n * 16) = r * alpha + acc[ai][bj][m][n]; } }
    }
};
struct RangeOrder {
    int nM, nN, ntot, c0, nw, c;
    __host__ __device__ void init(int M, int N, int c0_, int nw_, int c_) { nM = M / BM; nN = N / BM; ntot = nM * nN; c0 = c0_; nw = nw_; c = c_; }
    __host__ __device__ bool next(int i, Unit& u) const {
        if (c < c0 || c >= c0 + nw) return false;
        const int L = i * nw + (c - c0); if (L >= ntot) return false;
        u.pm = L / nN; u.pn = L % nN; return true;
    }
    __device__ __forceinline__ void a_ready(const Unit&) const {}
    __device__ __forceinline__ void done(const Unit&) const {}
};

struct ZeroOrder : StaticOrder {
    __host__ __device__ bool next(int i, Unit& u) const { const bool r = StaticOrder::next(i, u); u.pm = 0; u.pn = 0; return r; }
};

struct EpiResBf {
    static constexpr bool PERM = true, AFTER_DRAIN = false;
    bf16_t* Y; const bf16_t* res; int ldc; float alpha;
    __device__ __forceinline__ void operator()(const f32x4 (&acc)[2][2][4][2], const Unit& u, int wr, int wc, int fr, int fq) const {
        const int row0 = u.pm * BM + wr * 64 + fr, col0 = u.pn * BM + wc * 32 + 8 * fq;
#pragma unroll
        for (int ai = 0; ai < 2; ++ai)
#pragma unroll
            for (int m = 0; m < 4; ++m) { const size_t off = (size_t)(row0 + ai * HALF + m * 16) * ldc + col0;
#pragma unroll
                for (int bj = 0; bj < 2; ++bj) { const u32x4 r = *(const u32x4*)(res + off + bj * HALF);
                    const f32x4 v0 = acc[ai][bj][m][0], v1 = acc[ai][bj][m][1];
                    u32x4 w;
                    w.x = cvt_pk_bf16(__builtin_bit_cast(float, r.x << 16) * alpha + v0[0], __builtin_bit_cast(float, r.x & 0xffff0000u) * alpha + v0[1]);
                    w.y = cvt_pk_bf16(__builtin_bit_cast(float, r.y << 16) * alpha + v0[2], __builtin_bit_cast(float, r.y & 0xffff0000u) * alpha + v0[3]);
                    w.z = cvt_pk_bf16(__builtin_bit_cast(float, r.z << 16) * alpha + v1[0], __builtin_bit_cast(float, r.z & 0xffff0000u) * alpha + v1[1]);
                    w.w = cvt_pk_bf16(__builtin_bit_cast(float, r.w << 16) * alpha + v1[2], __builtin_bit_cast(float, r.w & 0xffff0000u) * alpha + v1[3]);
                    *(u32x4*)(Y + off + bj * HALF) = w; } }
    }
};

struct EpiResF {
    static constexpr bool PERM = true, AFTER_DRAIN = false;
    float* Y; const bf16_t* res; int ldc; float alpha;
    __device__ __forceinline__ void operator()(const f32x4 (&acc)[2][2][4][2], const Unit& u, int wr, int wc, int fr, int fq) const {
        const int row0 = u.pm * BM + wr * 64 + fr, col0 = u.pn * BM + wc * 32 + 8 * fq;
#pragma unroll
        for (int ai = 0; ai < 2; ++ai)
#pragma unroll
            for (int m = 0; m < 4; ++m) { const size_t off = (size_t)(row0 + ai * HALF + m * 16) * ldc + col0;
#pragma unroll
                for (int bj = 0; bj < 2; ++bj) { const u32x4 r = *(const u32x4*)(res + off + bj * HALF);
                    f32x4 o0, o1;
                    o0[0] = __builtin_bit_cast(float, r.x << 16); o0[1] = __builtin_bit_cast(float, r.x & 0xffff0000u); o0[2] = __builtin_bit_cast(float, r.y << 16); o0[3] = __builtin_bit_cast(float, r.y & 0xffff0000u);
                    o1[0] = __builtin_bit_cast(float, r.z << 16); o1[1] = __builtin_bit_cast(float, r.z & 0xffff0000u); o1[2] = __builtin_bit_cast(float, r.w << 16); o1[3] = __builtin_bit_cast(float, r.w & 0xffff0000u);
                    *(f32x4*)(Y + off + bj * HALF) = o0 * alpha + acc[ai][bj][m][0]; *(f32x4*)(Y + off + bj * HALF + 4) = o1 * alpha + acc[ai][bj][m][1]; } }
    }
};

struct EpiResLn {
    static constexpr bool PERM = true, AFTER_DRAIN = false;
    bf16_t* Y; const float* stats; const float* g; const float* b; int ldc; float alpha;
    __device__ __forceinline__ void operator()(const f32x4 (&acc)[2][2][4][2], const Unit& u, int wr, int wc, int fr, int fq) const {
        const int row0 = u.pm * BM + wr * 64 + fr, col0 = u.pn * BM + wc * 32 + 8 * fq;
        f32x4 gv[2][2], bv[2][2];
#pragma unroll
        for (int bj = 0; bj < 2; ++bj)
#pragma unroll
            for (int n = 0; n < 2; ++n) { gv[bj][n] = *(const f32x4*)(g + col0 + bj * HALF + 4 * n) * alpha; bv[bj][n] = *(const f32x4*)(b + col0 + bj * HALF + 4 * n) * alpha; }
#pragma unroll
        for (int ai = 0; ai < 2; ++ai)
#pragma unroll
            for (int m = 0; m < 4; ++m) { const int row = row0 + ai * HALF + m * 16; const size_t off = (size_t)row * ldc + col0;
                const float mean = stats[2 * row], rstd = stats[2 * row + 1];
#pragma unroll
                for (int bj = 0; bj < 2; ++bj) { const u32x4 r = *(const u32x4*)(Y + off + bj * HALF);
                    f32x4 y0, y1;
                    y0[0] = __builtin_bit_cast(float, r.x << 16); y0[1] = __builtin_bit_cast(float, r.x & 0xffff0000u); y0[2] = __builtin_bit_cast(float, r.y << 16); y0[3] = __builtin_bit_cast(float, r.y & 0xffff0000u);
                    y1[0] = __builtin_bit_cast(float, r.z << 16); y1[1] = __builtin_bit_cast(float, r.z & 0xffff0000u); y1[2] = __builtin_bit_cast(float, r.w << 16); y1[3] = __builtin_bit_cast(float, r.w & 0xffff0000u);
                    const f32x4 o0 = (y0 - mean) * rstd * gv[bj][0] + bv[bj][0] + acc[ai][bj][m][0], o1 = (y1 - mean) * rstd * gv[bj][1] + bv[bj][1] + acc[ai][bj][m][1];
                    u32x4 w; w.x = cvt_pk_bf16(o0[0], o0[1]); w.y = cvt_pk_bf16(o0[2], o0[3]); w.z = cvt_pk_bf16(o1[0], o1[1]); w.w = cvt_pk_bf16(o1[2], o1[3]);
                    *(u32x4*)(Y + off + bj * HALF) = w; } }
    }
};

constexpr float RS_SCALE = 1048576.0f, RS_INV = 1.0f / 1048576.0f;
__device__ __forceinline__ float fx20_to_f(long long v) { return (float)(int)(v >> 20) + (float)((unsigned)v & 0xFFFFFu) * RS_INV; }
__device__ __forceinline__ long long f_to_fx20(float s) { const float fl = floorf(s); return ((long long)(int)fl << 20) + (long long)(unsigned)((s - fl) * RS_SCALE + 0.5f); }
__device__ __forceinline__ void row_stats(const long long* rs, int row, float& mean, float& rstd) {
    const long long a = rs[2 * (size_t)row], b = rs[2 * (size_t)row + 1];
    mean = fx20_to_f(a) * (1.0f / 4096.0f); const float var = fx20_to_f(b) * (1.0f / 4096.0f) - mean * mean; rstd = 1.0f / sqrtf(var + 1e-5f);
}
constexpr float FOLD_SCALE = 4294967296.0f, FOLD_INV = 1.0f / 4294967296.0f;
struct EpiBf16Ln {
    static constexpr bool PERM = true, AFTER_DRAIN = false;
    bf16_t* O; int ldc; const long long* rs; const float* cs; const float* b2;
    __device__ __forceinline__ void operator()(const f32x4 (&acc)[2][2][4][2], const Unit& u, int wr, int wc, int fr, int fq) const {
        const int row0 = u.pm * BM + wr * 64 + fr, col0 = u.pn * BM + wc * 32 + 8 * fq;
        f32x4 cv[2][2], bv[2][2];
#pragma unroll
        for (int bj = 0; bj < 2; ++bj)
#pragma unroll
            for (int n = 0; n < 2; ++n) { cv[bj][n] = *(const f32x4*)(cs + col0 + bj * HALF + 4 * n); bv[bj][n] = *(const f32x4*)(b2 + col0 + bj * HALF + 4 * n); }
#pragma unroll
        for (int ai = 0; ai < 2; ++ai)
#pragma unroll
            for (int m = 0; m < 4; ++m) { const int row = row0 + ai * HALF + m * 16; float mean, rstd; row_stats(rs, row, mean, rstd);
                bf16_t* rowp = O + (size_t)row * ldc + col0;
#pragma unroll
                for (int bj = 0; bj < 2; ++bj) { const f32x4 v0 = (acc[ai][bj][m][0] - cv[bj][0] * mean) * rstd + bv[bj][0], v1 = (acc[ai][bj][m][1] - cv[bj][1] * mean) * rstd + bv[bj][1];
                    u32x4 w; w.x = cvt_pk_bf16(v0[0], v0[1]); w.y = cvt_pk_bf16(v0[2], v0[3]); w.z = cvt_pk_bf16(v1[0], v1[1]); w.w = cvt_pk_bf16(v1[2], v1[3]);
                    *(u32x4*)(rowp + bj * HALF) = w; } }
    }
};
__device__ __forceinline__ void row_sums_add(long long* rso, int row, const f32x4& a, const f32x4& b, const f32x4& c, const f32x4& d, int fq) {
    float s1 = ((a[0] + a[1]) + (a[2] + a[3])) + ((b[0] + b[1]) + (b[2] + b[3])) + ((c[0] + c[1]) + (c[2] + c[3])) + ((d[0] + d[1]) + (d[2] + d[3]));
    float s2 = ((a[0] * a[0] + a[1] * a[1]) + (a[2] * a[2] + a[3] * a[3])) + ((b[0] * b[0] + b[1] * b[1]) + (b[2] * b[2] + b[3] * b[3]))
             + ((c[0] * c[0] + c[1] * c[1]) + (c[2] * c[2] + c[3] * c[3])) + ((d[0] * d[0] + d[1] * d[1]) + (d[2] * d[2] + d[3] * d[3]));
    s1 += __shfl_xor(s1, 16); s1 += __shfl_xor(s1, 32); s2 += __shfl_xor(s2, 16); s2 += __shfl_xor(s2, 32);
    if (fq == 0) { atomicAdd((unsigned long long*)(rso + 2 * (size_t)row), (unsigned long long)f_to_fx20(s1)); atomicAdd((unsigned long long*)(rso + 2 * (size_t)row + 1), (unsigned long long)f_to_fx20(s2)); }
}
struct EpiRes0 {
    static constexpr bool PERM = true, AFTER_DRAIN = false;
    bf16_t* Y; const bf16_t* res; int ldc; float alpha; long long* rso;
    __device__ __forceinline__ void operator()(const f32x4 (&acc)[2][2][4][2], const Unit& u, int wr, int wc, int fr, int fq) const {
        const int row0 = u.pm * BM + wr * 64 + fr, col0 = u.pn * BM + wc * 32 + 8 * fq;
#pragma unroll
        for (int ai = 0; ai < 2; ++ai)
#pragma unroll
            for (int m = 0; m < 4; ++m) { const int row = row0 + ai * HALF + m * 16; const size_t off = (size_t)row * ldc + col0; f32x4 o[2][2];
#pragma unroll
                for (int bj = 0; bj < 2; ++bj) { const u32x4 r = *(const u32x4*)(res + off + bj * HALF);
                    f32x4 y0, y1;
                    y0[0] = __builtin_bit_cast(float, r.x << 16); y0[1] = __builtin_bit_cast(float, r.x & 0xffff0000u); y0[2] = __builtin_bit_cast(float, r.y << 16); y0[3] = __builtin_bit_cast(float, r.y & 0xffff0000u);
                    y1[0] = __builtin_bit_cast(float, r.z << 16); y1[1] = __builtin_bit_cast(float, r.z & 0xffff0000u); y1[2] = __builtin_bit_cast(float, r.w << 16); y1[3] = __builtin_bit_cast(float, r.w & 0xffff0000u);
                    o[bj][0] = y0 * alpha + acc[ai][bj][m][0]; o[bj][1] = y1 * alpha + acc[ai][bj][m][1];
                    u32x4 w; w.x = cvt_pk_bf16(o[bj][0][0], o[bj][0][1]); w.y = cvt_pk_bf16(o[bj][0][2], o[bj][0][3]); w.z = cvt_pk_bf16(o[bj][1][0], o[bj][1][1]); w.w = cvt_pk_bf16(o[bj][1][2], o[bj][1][3]);
                    *(u32x4*)(Y + off + bj * HALF) = w; }
                row_sums_add(rso, row, o[0][0], o[0][1], o[1][0], o[1][1], fq); }
    }
};
struct EpiResLn2 {
    static constexpr bool PERM = true, AFTER_DRAIN = false;
    bf16_t* Y; const long long* rsi; const float* g; const float* b; int ldc; float alpha; long long* rso;
    __device__ __forceinline__ void operator()(const f32x4 (&acc)[2][2][4][2], const Unit& u, int wr, int wc, int fr, int fq) const {
        const int row0 = u.pm * BM + wr * 64 + fr, col0 = u.pn * BM + wc * 32 + 8 * fq;
        f32x4 gv[2][2], bv[2][2];
#pragma unroll
        for (int bj = 0; bj < 2; ++bj)
#pragma unroll
            for (int n = 0; n < 2; ++n) { gv[bj][n] = *(const f32x4*)(g + col0 + bj * HALF + 4 * n) * alpha; bv[bj][n] = *(const f32x4*)(b + col0 + bj * HALF + 4 * n) * alpha; }
#pragma unroll
        for (int ai = 0; ai < 2; ++ai)
#pragma unroll
            for (int m = 0; m < 4; ++m) { const int row = row0 + ai * HALF + m * 16; const size_t off = (size_t)row * ldc + col0; float mean, rstd; row_stats(rsi, row, mean, rstd); f32x4 o[2][2];
#pragma unroll
                for (int bj = 0; bj < 2; ++bj) { const u32x4 r = *(const u32x4*)(Y + off + bj * HALF);
                    f32x4 y0, y1;
                    y0[0] = __builtin_bit_cast(float, r.x << 16); y0[1] = __builtin_bit_cast(float, r.x & 0xffff0000u); y0[2] = __builtin_bit_cast(float, r.y << 16); y0[3] = __builtin_bit_cast(float, r.y & 0xffff0000u);
                    y1[0] = __builtin_bit_cast(float, r.z << 16); y1[1] = __builtin_bit_cast(float, r.z & 0xffff0000u); y1[2] = __builtin_bit_cast(float, r.w << 16); y1[3] = __builtin_bit_cast(float, r.w & 0xffff0000u);
                    o[bj][0] = (y0 - mean) * rstd * gv[bj][0] + bv[bj][0] + acc[ai][bj][m][0]; o[bj][1] = (y1 - mean) * rstd * gv[bj][1] + bv[bj][1] + acc[ai][bj][m][1];
                    u32x4 w; w.x = cvt_pk_bf16(o[bj][0][0], o[bj][0][1]); w.y = cvt_pk_bf16(o[bj][0][2], o[bj][0][3]); w.z = cvt_pk_bf16(o[bj][1][0], o[bj][1][1]); w.w = cvt_pk_bf16(o[bj][1][2], o[bj][1][3]);
                    *(u32x4*)(Y + off + bj * HALF) = w; }
                row_sums_add(rso, row, o[0][0], o[0][1], o[1][0], o[1][1], fq); }
    }
};
template <class Epi, class Sched, bool ALIGN_EPI = false, bool SP2 = false>
__device__ __forceinline__ void gemm_phase(PG8_LAS unsigned char* lds, const Gemm g, const Sched& S, const Epi& E) {
    int tid_l = threadIdx.x; asm volatile("" : "+v"(tid_l)); const int tid = tid_l, wid = __builtin_amdgcn_readfirstlane(tid >> 6), lane = tid & 63, wr = wid >> 2, wc = wid & 3, fr = lane & 15, fq = lane >> 4;
    const int K = g.K, nt = K / BK;
    unsigned voffA[2], voffB[2];
#pragma unroll
    for (int i = 0; i < 2; ++i) { int R, C; stage_rc(tid * 16 + i * 8192, R, C); const int Rb = Epi::PERM ? ((R & ~31) + perm32(R & 31)) : R;
        voffA[i] = (unsigned)(R * K + C) * 2u; voffB[i] = (unsigned)(Rb * K + C) * 2u; }
    const size_t kstep = (size_t)(BK * 2);
    const size_t hstep = (size_t)HALF * K * 2;
    const size_t tstep = 2 * hstep;
    const unsigned ldsw = (unsigned)wid * 1024u;
    const int aoff = lds_byte(wr * 64 + fr, fq * 8), boff = lds_byte(wc * 32 + fr, fq * 8);
#define PG8_SA(b, h) (((b) * 2 + (h)) * HTB)
#define PG8_SB(b, h) ((4 + (b) * 2 + (h)) * HTB)
#define PG8_STAGE(bufoff, gbase, voff) do { _Pragma("unroll") for (int _i = 0; _i < 2; ++_i) \
        __builtin_amdgcn_global_load_lds((const unsigned*)((const char*)(gbase) + (voff)[_i]), (PG8_LAS unsigned*)(lds + (bufoff) + ldsw + _i * 8192), 16, 0, 0); } while (0)
#define PG8_LDA(dst, b, h) do { _Pragma("unroll") for (int m = 0; m < 4; ++m) _Pragma("unroll") for (int k = 0; k < 2; ++k) dst[m][k] = *(const PG8_LAS bf16x8*)(lds + PG8_SA(b, h) + aoff + m * 2048 + k * 1024); } while (0)
#define PG8_LDB(dst, b, h) do { _Pragma("unroll") for (int n = 0; n < 2; ++n) _Pragma("unroll") for (int k = 0; k < 2; ++k) dst[n][k] = *(const PG8_LAS bf16x8*)(lds + PG8_SB(b, h) + boff + n * 2048 + k * 1024); } while (0)
#define PG8_MMA(ai, bj, At, Bt) do { __builtin_amdgcn_s_setprio(1); _Pragma("unroll") for (int m = 0; m < 4; ++m) _Pragma("unroll") for (int n = 0; n < 2; ++n) _Pragma("unroll") for (int k = 0; k < 2; ++k) \
        acc[ai][bj][m][n] = __builtin_amdgcn_mfma_f32_16x16x32_bf16(Bt[n][k], At[m][k], acc[ai][bj][m][n], 0, 0, 0); __builtin_amdgcn_s_setprio(0); } while (0)
#define PG8_WAIT_V(n) asm volatile("s_waitcnt vmcnt(" #n ")" ::: "memory")
#define PG8_WAIT_L(n) asm volatile("s_waitcnt lgkmcnt(" #n ")" ::: "memory")
#define PG8_BAR __builtin_amdgcn_s_barrier()
#define PG8_SCHED __builtin_amdgcn_sched_barrier(0)
    Unit cur, nxt; int ui = 0;
    if (!S.next(0, cur)) return;
    f32x4 acc[2][2][4][2];
#pragma unroll
    for (int a = 0; a < 2; ++a)
#pragma unroll
        for (int b = 0; b < 2; ++b)
#pragma unroll
            for (int m = 0; m < 4; ++m)
#pragma unroll
                for (int n = 0; n < 2; ++n) acc[a][b][m][n] = (f32x4){0.f, 0.f, 0.f, 0.f};
    bf16x8 At[4][2], B0[2][2], B1[2][2];
    const char* cA = (const char*)g.A + (size_t)cur.pm * tstep; const char* cB = (const char*)g.Bt + (size_t)cur.pn * tstep;
    S.a_ready(cur);
    if constexpr (SP2) {
        PG8_STAGE(PG8_SB(0, 0), cB, voffB); PG8_STAGE(PG8_SB(0, 1), cB + hstep, voffB); PG8_STAGE(PG8_SA(0, 0), cA, voffA); PG8_STAGE(PG8_SA(0, 1), cA + hstep, voffA);
        if (wr == 1) PG8_BAR;
        PG8_WAIT_V(2); PG8_BAR;
        PG8_STAGE(PG8_SB(1, 0), cB + kstep, voffB); PG8_STAGE(PG8_SA(1, 0), cA + kstep, voffA); PG8_STAGE(PG8_SB(1, 1), cB + hstep + kstep, voffB);
        PG8_WAIT_V(6); PG8_BAR;
    } else {
        PG8_STAGE(PG8_SB(0, 0), cB, voffB); PG8_STAGE(PG8_SA(0, 0), cA, voffA); PG8_STAGE(PG8_SB(0, 1), cB + hstep, voffB); PG8_STAGE(PG8_SA(0, 1), cA + hstep, voffA);
        if (wr == 1) PG8_BAR;
        PG8_WAIT_V(4); PG8_BAR;
        PG8_STAGE(PG8_SB(1, 0), cB + kstep, voffB); PG8_STAGE(PG8_SA(1, 0), cA + kstep, voffA); PG8_STAGE(PG8_SB(1, 1), cB + hstep + kstep, voffB);
        PG8_WAIT_V(6); PG8_BAR;
    }
    for (;;) {
        const bool has_next = S.next(ui + 1, nxt);
        const char* nA = has_next ? (const char*)g.A + (size_t)nxt.pm * tstep : cA; const char* nB = has_next ? (const char*)g.Bt + (size_t)nxt.pn * tstep : cB;
        for (int t = 0; t < nt; t += 2) {
            const bool last = (t == nt - 2);
            const char* a1 = cA + (size_t)(t + 1) * kstep;
            const char* a2 = last ? nA : cA + (size_t)(t + 2) * kstep; const char* b2 = last ? nB : cB + (size_t)(t + 2) * kstep;
            const char* a3 = a2 + kstep; const char* b3 = b2 + kstep;
            if (last && has_next) S.a_ready(nxt);
            if constexpr (SP2) {
            PG8_LDB(B0, 0, 0); PG8_LDB(B1, 0, 1); PG8_SCHED; PG8_LDA(At, 0, 0); PG8_STAGE(PG8_SA(1, 1), a1 + hstep, voffA);
            PG8_WAIT_V(8); PG8_WAIT_L(0); PG8_BAR; PG8_MMA(0, 0, At, B0); PG8_MMA(0, 1, At, B1); PG8_BAR; PG8_SCHED;
            PG8_LDA(At, 0, 1); PG8_STAGE(PG8_SB(0, 0), b2, voffB); PG8_STAGE(PG8_SB(0, 1), b2 + hstep, voffB); PG8_STAGE(PG8_SA(0, 0), a2, voffA);
            PG8_WAIT_V(8); PG8_WAIT_L(0); PG8_BAR; PG8_MMA(1, 0, At, B0); PG8_MMA(1, 1, At, B1); PG8_BAR; PG8_SCHED;
            PG8_LDB(B0, 1, 0); PG8_LDB(B1, 1, 1); PG8_SCHED; PG8_LDA(At, 1, 0); PG8_STAGE(PG8_SA(0, 1), a2 + hstep, voffA);
            PG8_WAIT_V(8); PG8_WAIT_L(0); PG8_BAR; PG8_MMA(0, 0, At, B0); PG8_MMA(0, 1, At, B1); PG8_BAR; PG8_SCHED;
            PG8_LDA(At, 1, 1); PG8_STAGE(PG8_SB(1, 0), b3, voffB); PG8_STAGE(PG8_SB(1, 1), b3 + hstep, voffB); PG8_STAGE(PG8_SA(1, 0), a3, voffA);
            PG8_WAIT_V(8); PG8_WAIT_L(0); PG8_BAR; PG8_MMA(1, 0, At, B0); PG8_MMA(1, 1, At, B1); PG8_BAR; PG8_SCHED;
            } else {
            PG8_LDB(B0, 0, 0); PG8_SCHED; PG8_LDA(At, 0, 0); PG8_STAGE(PG8_SA(1, 1), a1 + hstep, voffA);
            PG8_WAIT_L(8); PG8_BAR; PG8_WAIT_L(0); PG8_MMA(0, 0, At, B0); PG8_BAR; PG8_SCHED;
            PG8_LDB(B1, 0, 1); PG8_STAGE(PG8_SB(0, 0), b2, voffB);
            PG8_BAR; PG8_WAIT_L(0); PG8_MMA(0, 1, At, B1); PG8_BAR;
            PG8_LDA(At, 0, 1); PG8_STAGE(PG8_SA(0, 0), a2, voffA);
            PG8_BAR; PG8_WAIT_L(0); PG8_MMA(1, 0, At, B0); PG8_BAR; PG8_SCHED;
            PG8_STAGE(PG8_SB(0, 1), b2 + hstep, voffB);
            PG8_WAIT_V(6); PG8_BAR; PG8_MMA(1, 1, At, B1); PG8_BAR;
            PG8_LDB(B0, 1, 0); PG8_SCHED; PG8_LDA(At, 1, 0); PG8_STAGE(PG8_SA(0, 1), a2 + hstep, voffA);
            PG8_WAIT_L(8); PG8_BAR; PG8_WAIT_L(0); PG8_MMA(0, 0, At, B0); PG8_BAR; PG8_SCHED;
            PG8_LDB(B1, 1, 1); PG8_STAGE(PG8_SB(1, 0), b3, voffB);
            PG8_BAR; PG8_WAIT_L(0); PG8_MMA(0, 1, At, B1); PG8_BAR;
            PG8_LDA(At, 1, 1); PG8_STAGE(PG8_SA(1, 0), a3, voffA);
            PG8_BAR; PG8_WAIT_L(0); PG8_MMA(1, 0, At, B0); PG8_BAR; PG8_SCHED;
            PG8_STAGE(PG8_SB(1, 1), b3 + hstep, voffB);
            PG8_WAIT_V(6); PG8_BAR; PG8_MMA(1, 1, At, B1); PG8_BAR;
            }
        }
        if constexpr (ALIGN_EPI) { if (wr == 0) PG8_BAR; }
        if constexpr (!Epi::AFTER_DRAIN) { E(acc, cur, wr, wc, fr, fq); S.done(cur); }
        if (!has_next) break;
#pragma unroll
        for (int a = 0; a < 2; ++a)
#pragma unroll
            for (int b = 0; b < 2; ++b)
#pragma unroll
                for (int m = 0; m < 4; ++m)
#pragma unroll
                    for (int n = 0; n < 2; ++n) acc[a][b][m][n] = (f32x4){0.f, 0.f, 0.f, 0.f};
        cur = nxt; cA = nA; cB = nB; ++ui;
        if constexpr (ALIGN_EPI) { if (wr == 1) PG8_BAR; }
    }
    PG8_WAIT_V(0);
    if constexpr (!ALIGN_EPI) { if (wr == 0) PG8_BAR; }
    PG8_BAR;
    if constexpr (Epi::AFTER_DRAIN) { E.fused(acc, cur, wr, wc, fr, fq, lds, wid, lane); S.done(cur); }
#undef PG8_SA
#undef PG8_SB
#undef PG8_STAGE
#undef PG8_LDA
#undef PG8_LDB
#undef PG8_MMA
#undef PG8_WAIT_V
#undef PG8_WAIT_L
#undef PG8_BAR
#undef PG8_SCHED
}
}

#ifndef PG8_SP2
#define PG8_SP2 true
#endif
#ifndef PG8_ALIGN
#define PG8_ALIGN true
#endif
constexpr int NWAVES = 8, NTHR = 512;
constexpr int BATCH = 2, SEQ = 8192, DM = 4096, MTOK = BATCH * SEQ;
constexpr int HD = 128;
constexpr int A_HEADS = 16, B_HEADS = 16, A_W = 2048, B_W = 2048, AB_IN = 4 * A_W + 3 * B_W;
constexpr int NSA_H = 32, NSA_G = 4, NSA_R = 8, KVW = 512, NSA_IN = 4096 + 6 * KVW + 96, NSA_INP = 7424;
constexpr int NCMP = 511, NCMPP = 512, NSLC = 128, NTOP = 16, WINDOW = 512;
constexpr int NMEM = 256, XH = 4, XW = 512;
constexpr int DFF = 11008, DFF2 = 22016;
constexpr float LN_EPS = 1e-5f, RMS_EPS = 1e-6f;
constexpr float DN_ALPHA = 1.41421356237309515f;
constexpr size_t MiB = (size_t)1 << 20;
constexpr size_t WS_CTL = 0, CTL_ZERO_BYTES = 4 * MiB;
constexpr size_t WS_FOLD = 64 * 1024;
constexpr int FO_XQ = 0, FO_UP = 2 * 512, FO_NSA = FO_UP + 2 * 22016, FO_N = FO_NSA + 7424;
constexpr size_t WS_RSUM = 1 * MiB;
static_assert(WS_FOLD + (size_t)2 * FO_N * 8 <= WS_RSUM && WS_RSUM + (size_t)6 * 16384 * 2 * 8 <= CTL_ZERO_BYTES, "CTL map");
constexpr size_t WS_W_ABIN = 4 * MiB;
constexpr size_t WS_W_ABOUT = WS_W_ABIN + 112 * MiB;
constexpr size_t WS_W_NSAIN = WS_W_ABOUT + 32 * MiB;
constexpr size_t WS_W_NSAOUT = WS_W_NSAIN + 58 * MiB;
constexpr size_t WS_W_XQ = WS_W_NSAOUT + 32 * MiB;
constexpr size_t WS_W_XKV = WS_W_XQ + 8 * MiB;
constexpr size_t WS_W_XO = WS_W_XKV + 16 * MiB;
constexpr size_t WS_W_UP = WS_W_XO + 8 * MiB;
constexpr size_t WS_W_DOWN = WS_W_UP + 344 * MiB;
constexpr size_t WS_W_C1 = WS_W_DOWN + 172 * MiB;
constexpr size_t WS_W_C2 = WS_W_C1 + 2 * MiB;
constexpr size_t WS_MEMB = WS_W_C2 + 1 * MiB;
constexpr size_t WS_HB = WS_MEMB + 4 * MiB;
constexpr size_t WS_Y = WS_HB + 128 * MiB;
constexpr size_t WS_BIG = WS_Y + 256 * MiB;
constexpr size_t WS_G = WS_BIG + 688 * MiB;
constexpr size_t WS_O = WS_G + 344 * MiB;
constexpr size_t WS_MISC = WS_O + 128 * MiB;
constexpr size_t WS_END = WS_MISC + 64 * MiB;
constexpr size_t WS_XQ = WS_MISC;
constexpr size_t WS_XO = WS_MISC + 16 * MiB;
constexpr size_t WS_XKV = WS_MISC + 32 * MiB;
constexpr size_t WS_LB = WS_MISC + 34 * MiB;
constexpr size_t WS_FOLDF = WS_MISC + 40 * MiB;
constexpr size_t WS_ROPE = WS_MISC + 36 * MiB;
constexpr size_t WS_STATS = WS_MISC + 35 * MiB;
constexpr size_t WS_PROJ0 = WS_BIG;
constexpr size_t WS_SPREV = WS_BIG + 448 * MiB;
constexpr size_t WS_QT = WS_G;
constexpr size_t WS_OINTRA = WS_G + 64 * MiB;
constexpr size_t WS_DEC = WS_G + 192 * MiB;
constexpr size_t WS_DS = WS_Y;
constexpr size_t WS_PROJ1 = WS_BIG;
constexpr size_t WS_QROT = WS_BIG + 232 * MiB;
constexpr size_t WS_KSROT = WS_BIG + 360 * MiB;
constexpr size_t WS_KWROT = WS_BIG + 376 * MiB;
constexpr size_t WS_KCMP = WS_BIG + 392 * MiB;
constexpr size_t WS_VCMP = WS_BIG + 393 * MiB;
constexpr size_t WS_OVL = WS_BIG + 394 * MiB;
constexpr size_t WS_SEL = WS_BIG + 395 * MiB;
constexpr size_t WS_IMP = WS_G + 256 * MiB;
constexpr size_t WS_O32 = WS_G;
static_assert(WS_SPREV + 128 * MiB <= WS_G && WS_DEC + 2 * MiB <= WS_O && WS_SEL + MiB <= WS_G, "ws map");
constexpr int CW_TMO = 0, CW_CODE = 1;
constexpr int CW_BAR = 4096;
constexpr int RING_OFF = 0, RING_BYTES = 131072;
constexpr int LDSCTL_OFF = RING_BYTES, MISC_OFF = LDSCTL_OFF + 320;
constexpr int LDS_BYTES = 147456;
static_assert(MISC_OFF + 128 <= LDS_BYTES, "LDS map");

#define GAS __attribute__((address_space(1)))
#define LAS __attribute__((address_space(3)))
typedef unsigned short bf16;
typedef unsigned v4u __attribute__((ext_vector_type(4)));
typedef unsigned v2u __attribute__((ext_vector_type(2)));
typedef float f32x4 __attribute__((ext_vector_type(4)));
typedef float f32x2 __attribute__((ext_vector_type(2)));
typedef float f32x16 __attribute__((ext_vector_type(16)));
typedef short bf16x8 __attribute__((ext_vector_type(8)));
typedef short s16x4 __attribute__((ext_vector_type(4)));
typedef GAS unsigned gu32;
#define RLX_AGENT __ATOMIC_RELAXED, __HIP_MEMORY_SCOPE_AGENT
#define LDS_WAIT() asm volatile("s_waitcnt lgkmcnt(0)" ::: "memory")
#define VM_WAIT() asm volatile("s_waitcnt vmcnt(0)" ::: "memory")
#define SBAR() __builtin_amdgcn_sched_barrier(0)
__device__ __forceinline__ unsigned f2bf(float f) { unsigned u = __builtin_bit_cast(unsigned, f); return (u + 0x7fffu + ((u >> 16) & 1u)) >> 16; }
__device__ __forceinline__ unsigned pk2(float lo, float hi) { return f2bf(lo) | (f2bf(hi) << 16); }
__device__ __forceinline__ float bf2f(unsigned short b) { return __builtin_bit_cast(float, (unsigned)b << 16); }
__device__ __forceinline__ float bflo(unsigned w) { return __builtin_bit_cast(float, w << 16); }
__device__ __forceinline__ float bfhi(unsigned w) { return __builtin_bit_cast(float, w & 0xffff0000u); }
__device__ __forceinline__ unsigned cvtpk(float lo, float hi) { unsigned r; asm volatile("v_cvt_pk_bf16_f32 %0, %1, %2" : "=v"(r) : "v"(lo), "v"(hi)); return r; }
__device__ __forceinline__ float wave_sum(float v) {
#pragma unroll
    for (int o = 1; o < 64; o <<= 1) v += __shfl_xor(v, o);
    return v;
}
__device__ __forceinline__ float sigmoidf_(float x) { return __builtin_amdgcn_rcpf(1.f + __builtin_amdgcn_exp2f(-1.4426950408889634f * x)); }
__device__ __forceinline__ float gelu1(float v) { pg8::f32x2 r = pg8::gelu_pk((pg8::f32x2){v, 0.f}); return r.x; }
#define XB_TMO      128
#define XB_XCNT(j)  (256  + 64 * (j))
#define XB_XSUB(j)  (1280 + 64 * (j))
#define XB_XGEN(j)  (2304 + 64 * (j))
#define XB_TOP      3328
#define XB_TOPGEN   3392
#define XCD_BAR_WORDS 3456
#define XB_SPIN_CAP (1u << 18)
#define LAS __attribute__((address_space(3)))

__device__ __forceinline__ unsigned xb_ld(unsigned* p)              { return __hip_atomic_load(p, __ATOMIC_RELAXED, __HIP_MEMORY_SCOPE_AGENT); }
__device__ __forceinline__ unsigned xb_add(unsigned* p, unsigned v) { return __hip_atomic_fetch_add(p, v, __ATOMIC_RELAXED, __HIP_MEMORY_SCOPE_AGENT); }
__device__ __forceinline__ unsigned xb_xcc_id() { return (unsigned)__builtin_amdgcn_s_getreg((3 << 11) | 20) & 0xFu; }
#define XB_SPIN(cond, bar) do { unsigned _sp = 0; while (cond) { __builtin_amdgcn_s_sleep(1); \
    if ((++_sp & 255u) == 0u) { if (xb_ld(&(bar)[XB_TMO])) break; if (_sp > XB_SPIN_CAP) { atomicAdd(&(bar)[XB_TMO], 1u); break; } } } } while (0)

struct XcdBarrier {
    unsigned* bar; unsigned x;
    volatile LAS unsigned* st;
};

__device__ __forceinline__ XcdBarrier xcd_barrier_post(unsigned* bar, volatile LAS unsigned* st) {
    XcdBarrier b; b.bar = bar; b.x = xb_xcc_id(); b.st = st;
    if (threadIdx.x == 0) (void)xb_add(&bar[XB_XCNT(b.x)], 1u);
    return b;
}
__device__ __forceinline__ void xcd_barrier_complete(unsigned* bar, unsigned x, unsigned& nloc, unsigned& nx) {
    const unsigned G = gridDim.x * gridDim.y * gridDim.z;
    unsigned sum, cnt, mine, sp = 0u;
    for (;;) {
        sum = 0u; cnt = 0u; mine = 0u;
#pragma unroll
        for (unsigned j = 0; j < 16; ++j) { const unsigned c = xb_ld(&bar[XB_XCNT(j)]); sum += c; cnt += (c > 0u) ? 1u : 0u; mine = (j == x) ? c : mine; }
        if (sum == G) break;
        __builtin_amdgcn_s_sleep(1);
        if ((++sp & 255u) == 0u) { if (xb_ld(&bar[XB_TMO])) break; if (sp > XB_SPIN_CAP) { atomicAdd(&bar[XB_TMO], 1u); break; } }
    }
    nloc = mine > 0u ? mine : 1u; nx = cnt > 0u ? cnt : 1u;
}

__device__ __forceinline__ void xcd_barrier(const XcdBarrier& b) {
    asm volatile("s_waitcnt vmcnt(0)" ::: "memory");
    __syncthreads();
    if (threadIdx.x == 0) {
        unsigned* bar = b.bar;
        __builtin_amdgcn_s_waitcnt(0);
        unsigned nloc = b.st[0], nx = b.st[1];
        if (nloc == 0u) { xcd_barrier_complete(bar, b.x, nloc, nx); b.st[0] = nloc; b.st[1] = nx; }
        const unsigned old = xb_add(&bar[XB_XSUB(b.x)], 1u);
        const unsigned gen = old / nloc;
        if (old + 1u == (gen + 1u) * nloc) {
            __builtin_amdgcn_fence(__ATOMIC_RELEASE, "agent");
            asm volatile("s_waitcnt vmcnt(0)" ::: "memory");
            const unsigned og = xb_add(&bar[XB_TOP], 1u);
            const unsigned tg = og / nx;
            if (og + 1u == (tg + 1u) * nx) xb_add(&bar[XB_TOPGEN], 1u);
            else XB_SPIN(xb_ld(&bar[XB_TOPGEN]) == tg, bar);
            __builtin_amdgcn_fence(__ATOMIC_ACQUIRE, "agent");
            xb_add(&bar[XB_XGEN(b.x)], 1u);
            asm volatile("s_waitcnt vmcnt(0)" ::: "memory");
        } else {
            XB_SPIN(xb_ld(&bar[XB_XGEN(b.x)]) == gen, bar);
            __builtin_amdgcn_fence(__ATOMIC_ACQUIRE, "agent");
            asm volatile("s_waitcnt vmcnt(0)" ::: "memory");
        }
    }
    __syncthreads();
}


constexpr int ATT_D = 128, KVBLK = 64;
constexpr int SHM_V = KVBLK * ATT_D * 2, SHM_K = KVBLK * ATT_D * 2;
constexpr int ATT_K_OFF = 0, ATT_V_OFF = SHM_K, ATT_BUF = SHM_K + SHM_V, ATT_SET = 2 * ATT_BUF;
constexpr int ATT_WS_OFF = RING_BYTES + 512;
constexpr int ATT_X_OFF = ATT_WS_OFF + NWAVES * 256;
static_assert(2 * ATT_SET <= RING_BYTES && ATT_X_OFF + 1024 <= LDS_BYTES, "attention LDS map");
#define KSWZ(row, colB) ((row) * 256 + ((colB) ^ (((row) & 7) << 4)))
__device__ __forceinline__ int crow(int r, int hi) { return (r & 3) + 8 * (r >> 2) + 4 * hi; }
__device__ __forceinline__ int v_st(int k, int c) { const int kk = (k & ~0xC) | ((k & 4) << 1) | ((k & 8) >> 1); return ((kk >> 3) * 4 + (c >> 5)) * 512 + ((kk & 7) * 32 + (c & 31)) * 2; }
__device__ __forceinline__ int v_rd_base(int lane) { return ((lane & 3) << 3) | (((lane >> 2) & 3) << 6) | (((lane >> 4) & 1) << 5) | (((lane >> 5) & 1) << 8); }
constexpr int v_rd_off(int d0, int ks, int half) { return d0 * 512 + ks * 4096 + half * 2048; }
template <int OFF> __device__ __forceinline__ s16x4 tr_read(int vb) {
  s16x4 r; asm volatile("ds_read_b64_tr_b16 %0, %1 offset:%2" : "=&v"(r) : "v"(vb), "i"(OFF) : "memory"); return r;
}
__device__ __forceinline__ void qkt(f32x16& p0, f32x16& p1, const LAS char* Ks, const bf16x8* qr, int r32, int hi) {
  p0 = f32x16{}; p1 = f32x16{};
#pragma unroll
  for (int d0 = 0; d0 < 8; ++d0) { const int cb = (d0 * 16 + hi * 8) * 2;
    const bf16x8 b0 = *(const LAS bf16x8*)(Ks + KSWZ(r32, cb));
    const bf16x8 b1 = *(const LAS bf16x8*)(Ks + KSWZ(32 + r32, cb));
    p0 = __builtin_amdgcn_mfma_f32_32x32x16_bf16(b0, qr[d0], p0, 0, 0, 0);
    p1 = __builtin_amdgcn_mfma_f32_32x32x16_bf16(b1, qr[d0], p1, 0, 0, 0); }
}
__device__ __forceinline__ void pack_p(const f32x16& p0, const f32x16& p1, bf16x8& pa0, bf16x8& pa1, bf16x8& pa2, bf16x8& pa3) {
#define PK4(P, BASE, OUT) do { unsigned a0 = cvtpk(P[BASE + 0], P[BASE + 1]), a1 = cvtpk(P[BASE + 2], P[BASE + 3]);   \
    unsigned b0 = cvtpk(P[BASE + 4], P[BASE + 5]), b1 = cvtpk(P[BASE + 6], P[BASE + 7]);                              \
    auto r0 = __builtin_amdgcn_permlane32_swap(a0, b0, false, false); auto r1 = __builtin_amdgcn_permlane32_swap(a1, b1, false, false); \
    v4u w = {r0[0], r1[0], r0[1], r1[1]}; OUT = __builtin_bit_cast(bf16x8, w); } while (0)
  PK4(p0, 0, pa0); PK4(p0, 8, pa1); PK4(p1, 0, pa2); PK4(p1, 8, pa3);
#undef PK4
}
template <int D0> __device__ __forceinline__ void pv_one(f32x16& od, int vb, bf16x8 pa0, bf16x8 pa1, bf16x8 pa2, bf16x8 pa3) {
  const s16x4 l0 = tr_read<v_rd_off(D0, 0, 0)>(vb), h0 = tr_read<v_rd_off(D0, 0, 1)>(vb), l1 = tr_read<v_rd_off(D0, 1, 0)>(vb), h1 = tr_read<v_rd_off(D0, 1, 1)>(vb);
  const s16x4 l2 = tr_read<v_rd_off(D0, 2, 0)>(vb), h2 = tr_read<v_rd_off(D0, 2, 1)>(vb), l3 = tr_read<v_rd_off(D0, 3, 0)>(vb), h3 = tr_read<v_rd_off(D0, 3, 1)>(vb);
  asm volatile("s_waitcnt lgkmcnt(0)" ::: "memory"); SBAR();
#define PKV(L, H) (bf16x8){L[0], L[1], L[2], L[3], H[0], H[1], H[2], H[3]}
  od = __builtin_amdgcn_mfma_f32_32x32x16_bf16(pa0, PKV(l0, h0), od, 0, 0, 0);
  od = __builtin_amdgcn_mfma_f32_32x32x16_bf16(pa1, PKV(l1, h1), od, 0, 0, 0);
  od = __builtin_amdgcn_mfma_f32_32x32x16_bf16(pa2, PKV(l2, h2), od, 0, 0, 0);
  od = __builtin_amdgcn_mfma_f32_32x32x16_bf16(pa3, PKV(l3, h3), od, 0, 0, 0);
#undef PKV
}
__device__ __forceinline__ void pv_d0(f32x16* o, int vb, bf16x8 pa0, bf16x8 pa1, bf16x8 pa2, bf16x8 pa3) {
  pv_one<0>(o[0], vb, pa0, pa1, pa2, pa3); pv_one<1>(o[1], vb, pa0, pa1, pa2, pa3); pv_one<2>(o[2], vb, pa0, pa1, pa2, pa3); pv_one<3>(o[3], vb, pa0, pa1, pa2, pa3);
}
struct KVStage { bf16x8 ks0, ks1, vs0, vs1; };
__device__ __forceinline__ void kv_load(KVStage& s, const bf16* Kh, const bf16* Vh, long ldk, long ldv, int k0, int sr, int sc) {
  s.ks0 = *(const bf16x8*)(Kh + (long)(k0 + sr) * ldk + sc); s.ks1 = *(const bf16x8*)(Kh + (long)(k0 + 32 + sr) * ldk + sc);
  s.vs0 = *(const bf16x8*)(Vh + (long)(k0 + sr) * ldv + sc); s.vs1 = *(const bf16x8*)(Vh + (long)(k0 + 32 + sr) * ldv + sc);
}
__device__ __forceinline__ void kv_write(const KVStage& s, LAS char* lds, int sr, int sc) {
  *(LAS bf16x8*)(lds + ATT_V_OFF + v_st(sr, sc)) = s.vs0; *(LAS bf16x8*)(lds + ATT_V_OFF + v_st(32 + sr, sc)) = s.vs1;
  *(LAS bf16x8*)(lds + ATT_K_OFF + KSWZ(sr, sc * 2)) = s.ks0; *(LAS bf16x8*)(lds + ATT_K_OFF + KSWZ(32 + sr, sc * 2)) = s.ks1;
}
struct KVDma { int ko[2], vo[2]; };
__device__ __forceinline__ void kv_dma_init(KVDma& d, int ldk, int ldv, int wid, int lane) {
#pragma unroll
  for (int i = 0; i < 2; ++i) { const int p = wid * 2 + i;
    const int row = p * 4 + (lane >> 4), cp = lane & 15; d.ko[i] = row * ldk + ((cp ^ (row & 7)) << 3);
    const int sub = p * 2 + (lane >> 5), kk = (sub >> 2) * 8 + ((lane & 31) >> 2), k = (kk & ~0xC) | ((kk & 4) << 1) | ((kk & 8) >> 1), c = (sub & 3) * 32 + (lane & 3) * 8;
    d.vo[i] = k * ldv + c; }
}
__device__ __forceinline__ void kv_dma(const KVDma& d, const bf16* Kt, const bf16* Vt, LAS char* lds, int buf, int wid) {
#pragma unroll
  for (int i = 0; i < 2; ++i) {
    __builtin_amdgcn_global_load_lds((const unsigned*)(Kt + d.ko[i]), (LAS unsigned*)(lds + buf + ATT_K_OFF + (wid * 2 + i) * 1024), 16, 0, 0);
    __builtin_amdgcn_global_load_lds((const unsigned*)(Vt + d.vo[i]), (LAS unsigned*)(lds + buf + ATT_V_OFF + (wid * 2 + i) * 1024), 16, 0, 0); }
}
__device__ __forceinline__ void rescale_o(f32x16* o, float a, LAS float* al_l, int r32, int hi) {
  if (__any(a < 1.f)) { if (hi == 0) al_l[r32] = a; LDS_WAIT();
#pragma unroll
    for (int r = 0; r < 16; ++r) { const float f = al_l[crow(r, hi)];
#pragma unroll
      for (int d = 0; d < 4; ++d) o[d][r] *= f; }
    LDS_WAIT(); }
}
constexpr float ATT_SCALE = 0.088388347648318440f, ATT_C = ATT_SCALE * 1.4426950408889634f, ATT_THR = 8.f;
__device__ __forceinline__ void softmax_tile(f32x16& p0, f32x16& p1, float& m_reg, float& l_reg, float& alpha) {
  float pmax = p0[0];
#pragma unroll
  for (int r = 1; r < 16; ++r) pmax = fmaxf(pmax, p0[r]);
#pragma unroll
  for (int r = 0; r < 16; ++r) pmax = fmaxf(pmax, p1[r]);
  { auto rr = __builtin_amdgcn_permlane32_swap(__float_as_uint(pmax), __float_as_uint(pmax), false, false);
    pmax = fmaxf(__uint_as_float(rr[0]), __uint_as_float(rr[1])); }
  float mn;
  if (__all(pmax - m_reg <= ATT_THR / ATT_SCALE)) { mn = m_reg; alpha = 1.f; }
  else { mn = fmaxf(m_reg, pmax); alpha = __builtin_amdgcn_exp2f((m_reg - mn) * ATT_C); m_reg = mn; }
  const float mnC = -mn * ATT_C;
#pragma unroll
  for (int r = 0; r < 16; ++r) { p0[r] = __builtin_amdgcn_exp2f(fmaf(p0[r], ATT_C, mnC)); p1[r] = __builtin_amdgcn_exp2f(fmaf(p1[r], ATT_C, mnC)); }
  float ps = 0.f;
#pragma unroll
  for (int r = 0; r < 16; ++r) ps += p0[r] + p1[r];
  { auto rr = __builtin_amdgcn_permlane32_swap(__float_as_uint(ps), __float_as_uint(ps), false, false);
    ps = __uint_as_float(rr[0]) + __uint_as_float(rr[1]); }
  l_reg = l_reg * alpha + ps;
}
__device__ __forceinline__ void attn_finish(f32x16& p0, f32x16& p1, f32x16* o, float& m_reg, float& l_reg, LAS float* wsc, int vb, int r32, int hi) {
  float alpha; softmax_tile(p0, p1, m_reg, l_reg, alpha);
  rescale_o(o, alpha, wsc, r32, hi);
  bf16x8 pa0, pa1, pa2, pa3; pack_p(p0, p1, pa0, pa1, pa2, pa3);
  pv_d0(o, vb, pa0, pa1, pa2, pa3);
}
__device__ __forceinline__ void load_q(bf16x8* qr, const bf16* Qw) {
#pragma unroll
  for (int d0 = 0; d0 < 8; ++d0) qr[d0] = *(const bf16x8*)(Qw + d0 * 16);
}

struct Frame {
    LAS unsigned char* lds;
    unsigned char* ws;
    int tid, lane, wave, G, bid;
    __device__ __forceinline__ void fresh() { int t = threadIdx.x; asm volatile("" : "+v"(t)); tid = t; lane = t & 63; wave = __builtin_amdgcn_readfirstlane(t >> 6);
        int g_ = gridDim.x, b_ = blockIdx.x; asm volatile("" : "+s"(g_), "+s"(b_)); G = g_; bid = b_; }
};
struct Args { const float* in[19]; float* out; unsigned char* ws; int ph_lo, ph_hi; };
enum { IN_X = 0, IN_MEM, IN_AB_W_IN, IN_HGRN_LB, IN_HGRN_NW, IN_AB_W_OUT, IN_NSA_W_IN, IN_NSA_CMP_POS, IN_NSA_CMP_W1, IN_NSA_CMP_W2, IN_NSA_W_OUT,
       IN_XA_WQ, IN_XA_WKV, IN_XA_WO, IN_FFN_UP, IN_FFN_CONV, IN_FFN_DOWN, IN_LN_G, IN_LN_B };

__device__ __forceinline__ void p0_transpose_item(const float* W, int K, int N, bf16* WT, LAS float* scr, int item, int lane) {
    const int nblk = N / 32, kb = item / nblk, nb = item % nblk, k0 = 64 * kb, n0 = 32 * nb;
#pragma unroll 8
    for (int i = 0; i < 32; ++i) { const int kk = 2 * i + (lane >> 5); scr[kk * 33 + (lane & 31)] = W[(size_t)(k0 + kk) * N + n0 + (lane & 31)]; }
    LDS_WAIT(); asm volatile("" ::: "memory");
    const int c = lane & 7;
#pragma unroll
    for (int j = 0; j < 4; ++j) { const int n = (lane >> 3) + 8 * j; const LAS float* s = scr + (8 * c) * 33 + n;
        v4u o; o.x = pk2(s[0 * 33], s[1 * 33]); o.y = pk2(s[2 * 33], s[3 * 33]); o.z = pk2(s[4 * 33], s[5 * 33]); o.w = pk2(s[6 * 33], s[7 * 33]);
        *(GAS v4u*)(WT + (size_t)(n0 + n) * K + k0 + 8 * c) = o; }
    LDS_WAIT(); asm volatile("" ::: "memory");
}
__device__ __forceinline__ void p0_transpose_item_fold(const float* W, int K, int N, bf16* WT, LAS float* scr, int item, int lane, const float* g, const float* b, long long* cs, long long* b2) {
    const int nblk = N / 32, kb = item / nblk, nb = item % nblk, k0 = 64 * kb, n0 = 32 * nb;
#pragma unroll 8
    for (int i = 0; i < 32; ++i) { const int kk = 2 * i + (lane >> 5); scr[kk * 33 + (lane & 31)] = W[(size_t)(k0 + kk) * N + n0 + (lane & 31)]; }
    LDS_WAIT(); asm volatile("" ::: "memory");
    const int c = lane & 7;
    const f32x4 g0 = *(const f32x4*)(g + k0 + 8 * c), g1 = *(const f32x4*)(g + k0 + 8 * c + 4), b0 = *(const f32x4*)(b + k0 + 8 * c), b1 = *(const f32x4*)(b + k0 + 8 * c + 4);
    const float gg[8] = {g0.x, g0.y, g0.z, g0.w, g1.x, g1.y, g1.z, g1.w}, bb[8] = {b0.x, b0.y, b0.z, b0.w, b1.x, b1.y, b1.z, b1.w};
#pragma unroll
    for (int j = 0; j < 4; ++j) { const int n = (lane >> 3) + 8 * j; const LAS float* s = scr + (8 * c) * 33 + n;
        float sc = 0.f, sb = 0.f; unsigned w[4];
#pragma unroll
        for (int q = 0; q < 4; ++q) { const float x0 = s[(2 * q) * 33], x1 = s[(2 * q + 1) * 33]; const unsigned r0 = f2bf(x0 * gg[2 * q]), r1 = f2bf(x1 * gg[2 * q + 1]);
            w[q] = r0 | (r1 << 16); sc += bf2f((unsigned short)r0) + bf2f((unsigned short)r1); sb += x0 * bb[2 * q] + x1 * bb[2 * q + 1]; }
        *(GAS v4u*)(WT + (size_t)(n0 + n) * K + k0 + 8 * c) = (v4u){w[0], w[1], w[2], w[3]};
        sc += __shfl_xor(sc, 1); sc += __shfl_xor(sc, 2); sc += __shfl_xor(sc, 4); sb += __shfl_xor(sb, 1); sb += __shfl_xor(sb, 2); sb += __shfl_xor(sb, 4);
        if (c == 0) { atomicAdd((unsigned long long*)(cs + n0 + n), (unsigned long long)(long long)rintf(sc * pg8::FOLD_SCALE)); atomicAdd((unsigned long long*)(b2 + n0 + n), (unsigned long long)(long long)rintf(sb * pg8::FOLD_SCALE)); } }
    LDS_WAIT(); asm volatile("" ::: "memory");
}
__device__ __forceinline__ void transpose_mat_fold(Frame& F, const float* W, int K, int N, bf16* WT, const float* g, const float* b, long long* cs, long long* b2, int c0 = 0, int nw = 1 << 30, int part = 0, int nparts = 1) {
    if (F.bid < c0 || F.bid >= c0 + nw) return;
    LAS float* scr = (LAS float*)(F.lds + RING_OFF + F.wave * 16384);
    const int nwg = nw < F.G ? nw : F.G, gw = (F.bid - c0) * NWAVES + F.wave, NGW = nwg * NWAVES;
    const int nitems = (K / 64) * (N / 32), ilo = (int)((long)nitems * part / nparts), ihi = (int)((long)nitems * (part + 1) / nparts);
    for (int it = ilo + gw; it < ihi; it += NGW) p0_transpose_item_fold(W, K, N, WT, scr, it, F.lane, g, b, cs, b2);
}
__device__ __forceinline__ void transpose_mat(Frame& F, const float* W, int K, int N, bf16* WT, int c0 = 0, int nw = 1 << 30) {
    if (F.bid < c0 || F.bid >= c0 + nw) return;
    LAS float* scr = (LAS float*)(F.lds + RING_OFF + F.wave * 16384);
    const int nwg = nw < F.G ? nw : F.G, gw = (F.bid - c0) * NWAVES + F.wave, NGW = nwg * NWAVES;
    const int nitems = (K / 64) * (N / 32);
    for (int it = gw; it < nitems; it += NGW) p0_transpose_item(W, K, N, WT, scr, it, F.lane);
}
__device__ __forceinline__ void fold_finalize(Frame& F, int lo, int n) {
    const long long* fs = (const long long*)(F.ws + WS_FOLD); float* fd = (float*)(F.ws + WS_FOLDF);
    for (int i = F.bid * NTHR + F.tid; i < 2 * n; i += F.G * NTHR) { const int j = (i < n) ? lo + i : FO_N + lo + (i - n); const long long v = fs[j]; fd[j] = (float)(int)(v >> 32) + (float)(unsigned)v * pg8::FOLD_INV; }
}
enum { CJ_DOWN0, CJ_NSA, CJ_L1A, CJ_L1B, CJ_DOWN1 };
template <int JOB>
__device__ __forceinline__ void convert_job(Frame& F, const Args& A, int c0, int nw) {
    unsigned char* ws = F.ws; long long* cs = (long long*)(ws + WS_FOLD); long long* b2 = cs + FO_N;
    if (JOB == CJ_DOWN0 || JOB == CJ_DOWN1) { const int l = JOB == CJ_DOWN1; transpose_mat(F, A.in[IN_FFN_DOWN] + (size_t)l * DFF * DM, DFF, DM, (bf16*)(ws + WS_W_DOWN) + (size_t)l * DM * DFF, c0, nw); }
    if (JOB == CJ_NSA) {
        transpose_mat_fold(F, A.in[IN_NSA_W_IN], DM, NSA_IN, (bf16*)(ws + WS_W_NSAIN), A.in[IN_LN_G] + 2 * DM, A.in[IN_LN_B] + 2 * DM, cs + FO_NSA, b2 + FO_NSA, c0, nw);
        transpose_mat(F, A.in[IN_NSA_W_OUT], DM, DM, (bf16*)(ws + WS_W_NSAOUT), c0, nw); }
    if (JOB == CJ_L1A || JOB == CJ_L1B) { const int l = 1;
        if (JOB == CJ_L1A) {
            transpose_mat_fold(F, A.in[IN_XA_WQ] + (size_t)l * DM * XW, DM, XW, (bf16*)(ws + WS_W_XQ) + (size_t)l * XW * DM, A.in[IN_LN_G] + (size_t)(3 * l) * DM, A.in[IN_LN_B] + (size_t)(3 * l) * DM, cs + FO_XQ + l * XW, b2 + FO_XQ + l * XW, c0, nw);
            transpose_mat(F, A.in[IN_XA_WKV] + (size_t)l * DM * 2 * XW, DM, 2 * XW, (bf16*)(ws + WS_W_XKV) + (size_t)l * 2 * XW * DM, c0, nw);
            transpose_mat(F, A.in[IN_XA_WO] + (size_t)l * XW * DM, XW, DM, (bf16*)(ws + WS_W_XO) + (size_t)l * DM * XW, c0, nw); }
        transpose_mat_fold(F, A.in[IN_FFN_UP] + (size_t)l * DM * DFF2, DM, DFF2, (bf16*)(ws + WS_W_UP) + (size_t)l * DFF2 * DM, A.in[IN_LN_G] + (size_t)(3 * l + 1) * DM, A.in[IN_LN_B] + (size_t)(3 * l + 1) * DM,
                           cs + FO_UP + l * DFF2, b2 + FO_UP + l * DFF2, c0, nw, JOB == CJ_L1A ? 0 : 1, 2); }
}
__device__ __forceinline__ void cvt_flat(Frame& F, const float* src, bf16* dst, long n8) {
    for (long i = (long)F.bid * NTHR + F.tid; i < n8; i += (long)F.G * NTHR) {
        const f32x4 a = *(const f32x4*)(src + i * 8), b = *(const f32x4*)(src + i * 8 + 4);
        v4u o; o.x = pk2(a.x, a.y); o.y = pk2(a.z, a.w); o.z = pk2(b.x, b.y); o.w = pk2(b.z, b.w);
        *(v4u*)(dst + i * 8) = o; }
}
__device__ __forceinline__ void p0_prologue(Frame& F, const Args& A) {
    unsigned char* ws = F.ws;
    long long* cs = (long long*)(ws + WS_FOLD); long long* b2 = cs + FO_N;
    transpose_mat(F, A.in[IN_AB_W_IN], DM, AB_IN, (bf16*)(ws + WS_W_ABIN));
    transpose_mat(F, A.in[IN_AB_W_OUT], DM, DM, (bf16*)(ws + WS_W_ABOUT));
    { const int l = 0;
        transpose_mat_fold(F, A.in[IN_XA_WQ] + (size_t)l * DM * XW, DM, XW, (bf16*)(ws + WS_W_XQ) + (size_t)l * XW * DM, A.in[IN_LN_G] + (size_t)(3 * l) * DM, A.in[IN_LN_B] + (size_t)(3 * l) * DM, cs + FO_XQ + l * XW, b2 + FO_XQ + l * XW);
        transpose_mat(F, A.in[IN_XA_WKV] + (size_t)l * DM * 2 * XW, DM, 2 * XW, (bf16*)(ws + WS_W_XKV) + (size_t)l * 2 * XW * DM);
        transpose_mat(F, A.in[IN_XA_WO] + (size_t)l * XW * DM, XW, DM, (bf16*)(ws + WS_W_XO) + (size_t)l * DM * XW);
        transpose_mat_fold(F, A.in[IN_FFN_UP] + (size_t)l * DM * DFF2, DM, DFF2, (bf16*)(ws + WS_W_UP) + (size_t)l * DFF2 * DM, A.in[IN_LN_G] + (size_t)(3 * l + 1) * DM, A.in[IN_LN_B] + (size_t)(3 * l + 1) * DM, cs + FO_UP + l * DFF2, b2 + FO_UP + l * DFF2); }
    for (int l = 0; l < 2; ++l) {
        transpose_mat(F, A.in[IN_NSA_CMP_W1] + (size_t)l * 32 * HD * HD, 32 * HD, HD, (bf16*)(ws + WS_W_C1) + (size_t)l * HD * 32 * HD);
        transpose_mat(F, A.in[IN_NSA_CMP_W2] + (size_t)l * HD * HD, HD, HD, (bf16*)(ws + WS_W_C2) + (size_t)l * HD * HD);
    }
    cvt_flat(F, A.in[IN_X], (bf16*)(ws + WS_HB), (long)MTOK * DM / 8);
    cvt_flat(F, A.in[IN_MEM], (bf16*)(ws + WS_MEMB), (long)BATCH * NMEM * DM / 8);
    { v4u z = {0u, 0u, 0u, 0u}; v4u* p = (v4u*)((bf16*)(ws + WS_W_NSAIN) + (size_t)NSA_IN * DM); const long n = (long)(NSA_INP - NSA_IN) * DM / 8;
      for (long i = (long)F.bid * NTHR + F.tid; i < n; i += (long)F.G * NTHR) p[i] = z; }
    { float* tab = (float*)(ws + WS_ROPE);
      for (int i = F.bid * NTHR + F.tid; i < SEQ * 64; i += F.G * NTHR) { const int t = i >> 6, d = i & 63;
          float sn, cs; sincosf((float)t * powf(10000.0f, -(float)d * (1.0f / 64.0f)), &sn, &cs); tab[(size_t)t * 128 + d] = cs; tab[(size_t)t * 128 + 64 + d] = sn; } }
    { const float* lbp = A.in[IN_HGRN_LB]; float* lbo = (float*)(ws + WS_LB);
      for (int i = F.bid * NTHR + F.tid; i < A_W; i += F.G * NTHR) { const float a = lbp[i], b = lbp[A_W + i], m = fmaxf(a, b), ea = __expf(a - m), eb = __expf(b - m); lbo[i] = ea / (ea + eb); } }
}

__device__ __forceinline__ void ln_phase(Frame& F, const bf16* Y, const float* g, const float* b, float* h32) {
    const int gw = F.bid * NWAVES + F.wave, NGW = F.G * NWAVES;
    for (int m = gw; m < MTOK; m += NGW) {
        const v4u* yr = (const v4u*)(Y + (size_t)m * DM) + F.lane;
        float v[8][8]; float s = 0.f;
#pragma unroll
        for (int j = 0; j < 8; ++j) { const v4u x = yr[64 * j];
            v[j][0] = bflo(x.x); v[j][1] = bfhi(x.x); v[j][2] = bflo(x.y); v[j][3] = bfhi(x.y); v[j][4] = bflo(x.z); v[j][5] = bfhi(x.z); v[j][6] = bflo(x.w); v[j][7] = bfhi(x.w);
#pragma unroll
            for (int q = 0; q < 8; ++q) s += v[j][q]; }
        const float mean = wave_sum(s) * (1.f / DM); float s2 = 0.f;
#pragma unroll
        for (int j = 0; j < 8; ++j)
#pragma unroll
            for (int q = 0; q < 8; ++q) { v[j][q] -= mean; s2 += v[j][q] * v[j][q]; }
        const float rstd = 1.f / sqrtf(wave_sum(s2) * (1.f / DM) + LN_EPS);
#pragma unroll
        for (int j = 0; j < 8; ++j) { const int c0 = 8 * F.lane + 512 * j;
            const f32x4 g0 = *(const f32x4*)(g + c0), g1 = *(const f32x4*)(g + c0 + 4), b0 = *(const f32x4*)(b + c0), b1 = *(const f32x4*)(b + c0 + 4);
            f32x4 r0, r1;
            r0.x = v[j][0] * rstd * g0.x + b0.x; r0.y = v[j][1] * rstd * g0.y + b0.y; r0.z = v[j][2] * rstd * g0.z + b0.z; r0.w = v[j][3] * rstd * g0.w + b0.w;
            r1.x = v[j][4] * rstd * g1.x + b1.x; r1.y = v[j][5] * rstd * g1.y + b1.y; r1.z = v[j][6] * rstd * g1.z + b1.z; r1.w = v[j][7] * rstd * g1.w + b1.w;
            *(f32x4*)(h32 + (size_t)m * DM + c0) = r0; *(f32x4*)(h32 + (size_t)m * DM + c0 + 4) = r1; }
    }
}

__device__ __forceinline__ void convglu_phase(Frame& F, const bf16* UP, const float* cw, bf16* Gm) {
    constexpr int NCG = DFF / 8, RB = 16, NRB = MTOK / RB;
    const long nitems = (long)NCG * NRB;
    for (long it = (long)F.bid * NTHR + F.tid; it < nitems; it += (long)F.G * NTHR) {
        const int cg = (int)(it % NCG), rb = (int)(it / NCG), c0 = cg * 8, t0 = rb * RB;
        float w0[8], w1[8], w2[8];
#pragma unroll
        for (int j = 0; j < 8; ++j) { w0[j] = cw[c0 + j]; w1[j] = cw[DFF + c0 + j]; w2[j] = cw[2 * DFF + c0 + j]; }
        float am2[8], am1[8];
        if ((t0 & (SEQ - 1)) == 0) {
#pragma unroll
            for (int j = 0; j < 8; ++j) { am2[j] = 0.f; am1[j] = 0.f; }
        } else {
            const v4u x2 = *(const v4u*)(UP + (size_t)(t0 - 2) * DFF2 + c0), x1 = *(const v4u*)(UP + (size_t)(t0 - 1) * DFF2 + c0);
            am2[0] = bflo(x2.x); am2[1] = bfhi(x2.x); am2[2] = bflo(x2.y); am2[3] = bfhi(x2.y); am2[4] = bflo(x2.z); am2[5] = bfhi(x2.z); am2[6] = bflo(x2.w); am2[7] = bfhi(x2.w);
            am1[0] = bflo(x1.x); am1[1] = bfhi(x1.x); am1[2] = bflo(x1.y); am1[3] = bfhi(x1.y); am1[4] = bflo(x1.z); am1[5] = bfhi(x1.z); am1[6] = bflo(x1.w); am1[7] = bfhi(x1.w);
        }
#pragma unroll 4
        for (int r = 0; r < RB; ++r) {
            const size_t row = (size_t)(t0 + r);
            const v4u xa = *(const v4u*)(UP + row * DFF2 + c0), xu = *(const v4u*)(UP + row * DFF2 + DFF + c0);
            float a[8], u[8];
            a[0] = bflo(xa.x); a[1] = bfhi(xa.x); a[2] = bflo(xa.y); a[3] = bfhi(xa.y); a[4] = bflo(xa.z); a[5] = bfhi(xa.z); a[6] = bflo(xa.w); a[7] = bfhi(xa.w);
            u[0] = bflo(xu.x); u[1] = bfhi(xu.x); u[2] = bflo(xu.y); u[3] = bfhi(xu.y); u[4] = bflo(xu.z); u[5] = bfhi(xu.z); u[6] = bflo(xu.w); u[7] = bfhi(xu.w);
            float o[8];
#pragma unroll
            for (int j = 0; j < 8; j += 2) {
                const float c0v = w2[j] * a[j] + w1[j] * am1[j] + w0[j] * am2[j], c1v = w2[j + 1] * a[j + 1] + w1[j + 1] * am1[j + 1] + w0[j + 1] * am2[j + 1];
                const pg8::f32x2 gg = pg8::gelu_pk((pg8::f32x2){c0v, c1v}); o[j] = gg.x * u[j]; o[j + 1] = gg.y * u[j + 1]; }
            v4u w; w.x = pk2(o[0], o[1]); w.y = pk2(o[2], o[3]); w.z = pk2(o[4], o[5]); w.w = pk2(o[6], o[7]);
            *(v4u*)(Gm + row * DFF + c0) = w;
#pragma unroll
            for (int j = 0; j < 8; ++j) { am2[j] = am1[j]; am1[j] = a[j]; }
        }
    }
}

__device__ __forceinline__ void xattn_phase(Frame& F, const bf16* XQ, const bf16* XKV, bf16* XO) {
    const int tid = F.tid, wid = F.wave, lane = F.lane, r32 = lane & 31, hi = lane >> 5;
    LAS char* lds = (LAS char*)F.lds;
    LAS float* wsc = (LAS float*)(lds + ATT_WS_OFF + wid * 256);
    const int vb0 = (int)(uintptr_t)(lds + ATT_V_OFF) + v_rd_base(lane);
    KVDma dm; kv_dma_init(dm, 2 * XW, 2 * XW, wid, lane);
    constexpr int NU = (MTOK / 256) * XH;
    for (int u = F.bid; u < NU; u += F.G) {
        const int head = u % XH, rbk = u / XH, row0 = rbk * 256, b = row0 / SEQ;
        const bf16* Kh = XKV + (size_t)b * NMEM * 2 * XW + head * HD; const bf16* Vh = Kh + XW;
        bf16x8 qr[8]; load_q(qr, XQ + (size_t)(row0 + wid * 32 + r32) * XW + head * HD + hi * 8);
        float m_reg = -1e30f, l_reg = 0.f; f32x16 o[4] = {};
        __syncthreads();
        kv_dma(dm, Kh, Vh, lds, 0, wid);
        for (int j = 0; j < NMEM / KVBLK; ++j) {
            const int buf = (j & 1) * ATT_BUF;
            VM_WAIT(); __syncthreads();
            if (j + 1 < NMEM / KVBLK) kv_dma(dm, Kh + (size_t)(j + 1) * KVBLK * 2 * XW, Vh + (size_t)(j + 1) * KVBLK * 2 * XW, lds, ATT_BUF - buf, wid);
            f32x16 p0, p1; qkt(p0, p1, lds + buf + ATT_K_OFF, qr, r32, hi);
            float alpha; softmax_tile(p0, p1, m_reg, l_reg, alpha);
            rescale_o(o, alpha, wsc, r32, hi);
            bf16x8 pa0, pa1, pa2, pa3; pack_p(p0, p1, pa0, pa1, pa2, pa3);
            pv_d0(o, vb0 + buf, pa0, pa1, pa2, pa3);
        }
        if (hi == 0) wsc[32 + r32] = l_reg; LDS_WAIT();
        bf16* Ow = XO + (size_t)(row0 + wid * 32) * XW + head * HD;
#pragma unroll
        for (int r = 0; r < 16; ++r) { const int orow = crow(r, hi); const float rl = __builtin_amdgcn_rcpf(wsc[32 + orow]);
#pragma unroll
            for (int d0 = 0; d0 < 4; ++d0) Ow[(size_t)orow * XW + d0 * 32 + r32] = (bf16)f2bf(o[d0][r] * rl); }
        LDS_WAIT();
    }
}

template <int K>
__device__ __forceinline__ f32x4 mma_tile(const LAS char* A, int lda, const LAS char* B, int ldb, int fr, int fq) {
    f32x4 acc = {0.f, 0.f, 0.f, 0.f};
#pragma unroll
    for (int k0 = 0; k0 < K; k0 += 32) {
        const bf16x8 a = *(const LAS bf16x8*)(A + fr * lda + (k0 + 8 * fq) * 2);
        const bf16x8 b = *(const LAS bf16x8*)(B + fr * ldb + (k0 + 8 * fq) * 2);
        acc = __builtin_amdgcn_mfma_f32_16x16x32_bf16(a, b, acc, 0, 0, 0);
    }
    return acc;
}
constexpr int HG_CH = 64, HG_NC = SEQ / HG_CH, HG_ITEMS = BATCH * A_HEADS * HG_NC;
constexpr int HG_QT = 0, HG_KT = 17408, HG_KH = 34816, HG_VT = 53248, HG_PT = 71680, HG_SEG = 80896;
constexpr int HG_SP = 17408, HG_OT = 52224;
__device__ __forceinline__ void hgrn_phase_a(Frame& F, const bf16* P0, const float* lbv, bf16* QTg, bf16* OINTRA, bf16* DS, float* DEC) {
    LAS char* lds = (LAS char*)F.lds;
    const int tid = F.tid, wid = F.wave, lane = F.lane, fr = lane & 15, fq = lane >> 4;
    const int d = tid & 127, sq = tid >> 7;
    for (int it = F.bid; it < HG_ITEMS; it += F.G) {
        const int c = it % HG_NC, bh = it / HG_NC, h = bh % A_HEADS, b = bh / A_HEADS;
        const size_t row0 = (size_t)b * SEQ + (size_t)c * HG_CH;
        const float lb = lbv[h * HD + d], omlb = 1.f - lb;
        float cum[16], kk[16];
        { float run = 0.f;
#pragma unroll
          for (int j = 0; j < 16; ++j) { const float z = bf2f(P0[(row0 + 16 * sq + j) * AB_IN + A_W + h * HD + d]); const float sg = sigmoidf_(z);
              run += __logf(lb + omlb * sg); cum[j] = run; kk[j] = omlb * (1.f - sg); }
          ((LAS float*)(lds + HG_SEG))[sq * 128 + d] = run; }
        LDS_WAIT(); __syncthreads();
        float base = 0.f, total = 0.f;
#pragma unroll
        for (int q = 0; q < 4; ++q) { const float sgm = ((LAS float*)(lds + HG_SEG))[q * 128 + d]; total += sgm; if (q < sq) base += sgm; }
        unsigned kh[8], vt[8];
#pragma unroll
        for (int j = 0; j < 16; j += 2) {
            float e[2][3]; unsigned short vr[2];
#pragma unroll
            for (int jj = 0; jj < 2; ++jj) { const int s = 16 * sq + j + jj; const float bb = base + cum[j + jj];
                const float q = bf2f(P0[(row0 + s) * AB_IN + h * HD + d]); vr[jj] = P0[(row0 + s) * AB_IN + 2 * A_W + h * HD + d];
                const float qt = q * __expf(bb), kt = kk[j + jj] * __expf(-bb), kht = kk[j + jj] * __expf(total - bb);
                const unsigned short qb16 = (unsigned short)f2bf(qt);
                *(LAS unsigned short*)(lds + HG_QT + s * 272 + d * 2) = qb16; QTg[(row0 + s) * A_W + h * HD + d] = qb16;
                *(LAS unsigned short*)(lds + HG_KT + s * 272 + d * 2) = (unsigned short)f2bf(kt);
                e[jj][0] = kht; }
            kh[j >> 1] = pk2(e[0][0], e[1][0]); vt[j >> 1] = (unsigned)vr[0] | ((unsigned)vr[1] << 16);
        }
        { LAS v4u* pk = (LAS v4u*)(lds + HG_KH + d * 144 + sq * 32); pk[0] = (v4u){kh[0], kh[1], kh[2], kh[3]}; pk[1] = (v4u){kh[4], kh[5], kh[6], kh[7]};
          LAS v4u* pv = (LAS v4u*)(lds + HG_VT + d * 144 + sq * 32); pv[0] = (v4u){vt[0], vt[1], vt[2], vt[3]}; pv[1] = (v4u){vt[4], vt[5], vt[6], vt[7]}; }
        if (sq == 3) DEC[(size_t)it * HD + d] = __expf(total);
        LDS_WAIT(); __syncthreads();
#pragma unroll
        for (int k = 0; k < 2; ++k) { const int tau = 2 * wid + k, ti = tau >> 2, si = tau & 3;
            f32x4 acc = {0.f, 0.f, 0.f, 0.f};
            if (si <= ti) acc = mma_tile<128>(lds + HG_QT + ti * 16 * 272, 272, lds + HG_KT + si * 16 * 272, 272, fr, fq);
#pragma unroll
            for (int i = 0; i < 4; ++i) { const int t = 16 * ti + 4 * fq + i, s = 16 * si + fr; const float v = (s <= t) ? acc[i] : 0.f;
                *(LAS unsigned short*)(lds + HG_PT + t * 144 + s * 2) = (unsigned short)f2bf(v); } }
        LDS_WAIT(); __syncthreads();
#pragma unroll
        for (int k = 0; k < 4; ++k) { const int tau = wid + 8 * k, ti = tau >> 3, vi = tau & 7;
            const f32x4 acc = mma_tile<64>(lds + HG_VT + vi * 16 * 144, 144, lds + HG_PT + ti * 16 * 144, 144, fr, fq);
            v2u w; w.x = pk2(acc[0], acc[1]); w.y = pk2(acc[2], acc[3]);
            *(v2u*)(OINTRA + (row0 + 16 * ti + fr) * A_W + h * HD + 16 * vi + 4 * fq) = w; }
#pragma unroll
        for (int k = 0; k < 8; ++k) { const int tau = wid + 8 * k, vi = tau >> 3, ki = tau & 7;
            const f32x4 acc = mma_tile<64>(lds + HG_KH + ki * 16 * 144, 144, lds + HG_VT + vi * 16 * 144, 144, fr, fq);
            v2u w; w.x = pk2(acc[0], acc[1]); w.y = pk2(acc[2], acc[3]);
            *(v2u*)(DS + ((size_t)it * HD + 16 * vi + fr) * HD + 16 * ki + 4 * fq) = w; }
        LDS_WAIT(); __syncthreads();
    }
}
__device__ __forceinline__ void hgrn_phase_b(Frame& F, const bf16* DS, const float* DEC, bf16* SPREV) {
    const int tid = F.tid, dvl = tid >> 5, dk4 = (tid & 31) * 4;
    for (int item = F.bid; item < BATCH * A_HEADS * 8; item += F.G) {
        const int sl = item & 7, bh = item >> 3, dv = sl * 16 + dvl;
        f32x4 S = {0.f, 0.f, 0.f, 0.f};
        for (int c0 = 0; c0 < HG_NC; c0 += 8) {
            f32x4 ds[8], dc[8];
#pragma unroll
            for (int k = 0; k < 8; ++k) { const size_t it = (size_t)bh * HG_NC + c0 + k; const v2u x = *(const v2u*)(DS + (it * HD + dv) * HD + dk4);
                ds[k] = (f32x4){bflo(x.x), bfhi(x.x), bflo(x.y), bfhi(x.y)}; dc[k] = *(const f32x4*)(DEC + it * HD + dk4); }
#pragma unroll
            for (int k = 0; k < 8; ++k) { const size_t it = (size_t)bh * HG_NC + c0 + k;
                v2u w; w.x = pk2(S.x, S.y); w.y = pk2(S.z, S.w); *(v2u*)(SPREV + (it * HD + dv) * HD + dk4) = w;
                S = S * dc[k] + ds[k]; }
        }
    }
}
__device__ __forceinline__ void hgrn_phase_c(Frame& F, const bf16* P0, const bf16* QTg, const bf16* OINTRA, const bf16* SPREV, const float* nw, bf16* Ob) {
    LAS char* lds = (LAS char*)F.lds;
    const int tid = F.tid, wid = F.wave, lane = F.lane, fr = lane & 15, fq = lane >> 4;
    for (int it = F.bid; it < HG_ITEMS; it += F.G) {
        const int c = it % HG_NC, bh = it / HG_NC, h = bh % A_HEADS, b = bh / A_HEADS;
        const size_t row0 = (size_t)b * SEQ + (size_t)c * HG_CH;
        { const int s = tid >> 3, ch = (tid & 7) * 16; const bf16* src = QTg + (row0 + s) * A_W + h * HD + ch;
          const v4u x0 = *(const v4u*)src, x1 = *(const v4u*)(src + 8); LAS v4u* dst = (LAS v4u*)(lds + HG_QT + s * 272 + ch * 2); dst[0] = x0; dst[1] = x1; }
        { const int dv = tid >> 2, ch = (tid & 3) * 32; const bf16* src = SPREV + ((size_t)it * HD + dv) * HD + ch;
          const v4u x0 = *(const v4u*)src, x1 = *(const v4u*)(src + 8), x2 = *(const v4u*)(src + 16), x3 = *(const v4u*)(src + 24);
          LAS v4u* dst = (LAS v4u*)(lds + HG_SP + dv * 272 + ch * 2); dst[0] = x0; dst[1] = x1; dst[2] = x2; dst[3] = x3; }
        LDS_WAIT(); __syncthreads();
#pragma unroll
        for (int k = 0; k < 4; ++k) { const int tau = wid + 8 * k, ti = tau >> 3, vi = tau & 7;
            const f32x4 acc = mma_tile<128>(lds + HG_SP + vi * 16 * 272, 272, lds + HG_QT + ti * 16 * 272, 272, fr, fq);
            const int t = 16 * ti + fr, dv = 16 * vi + 4 * fq; const v2u oi = *(const v2u*)(OINTRA + (row0 + t) * A_W + h * HD + dv);
            *(LAS f32x4*)(lds + HG_OT + (t * 132 + dv) * 4) = (f32x4){acc[0] + bflo(oi.x), acc[1] + bfhi(oi.x), acc[2] + bflo(oi.y), acc[3] + bfhi(oi.y)}; }
        LDS_WAIT(); __syncthreads();
#pragma unroll
        for (int k = 0; k < 8; ++k) { const int t = wid * 8 + k;
            const float v0 = *(LAS float*)(lds + HG_OT + (t * 132 + lane) * 4), v1 = *(LAS float*)(lds + HG_OT + (t * 132 + 64 + lane) * 4);
            const float ss = wave_sum(v0 * v0 + v1 * v1); const float r = 1.f / sqrtf(ss * (1.f / HD) + RMS_EPS);
            const float g0 = bf2f(P0[(row0 + t) * AB_IN + 3 * A_W + h * HD + lane]), g1 = bf2f(P0[(row0 + t) * AB_IN + 3 * A_W + h * HD + 64 + lane]);
            Ob[(row0 + t) * DM + h * HD + lane] = (bf16)f2bf(v0 * r * nw[lane] * g0 * sigmoidf_(g0));
            Ob[(row0 + t) * DM + h * HD + 64 + lane] = (bf16)f2bf(v1 * r * nw[64 + lane] * g1 * sigmoidf_(g1)); }
        LDS_WAIT(); __syncthreads();
    }
}

constexpr float SB_CUT = -160.f;
__device__ __forceinline__ void sb_phase(Frame& F, const bf16* P0, bf16* Ob) {
    const int tid = F.tid, wid = F.wave, lane = F.lane, r32 = lane & 31, hi = lane >> 5;
    LAS char* lds = (LAS char*)F.lds;
    const int vb0 = (int)(uintptr_t)(lds + ATT_V_OFF) + v_rd_base(lane);
    KVDma dm; kv_dma_init(dm, AB_IN, AB_IN, wid, lane);
    constexpr int NQB = SEQ / 256, NU = BATCH * B_HEADS * NQB;
    for (int rd = 0; ; ++rd) {
        const int idx = (rd & 1) ? rd * F.G + (F.G - 1 - F.bid) : rd * F.G + F.bid;
        if (rd * F.G >= NU) break;
        if (idx >= NU) continue;
        const int qb = NQB - 1 - idx / (BATCH * B_HEADS), bh = idx % (BATCH * B_HEADS), head = bh % B_HEADS, b = bh / B_HEADS;
        const size_t rowb = (size_t)b * SEQ; const int q0 = qb * 256;
        const bf16* Kh = P0 + rowb * AB_IN + 4 * A_W + B_W + head * HD; const bf16* Vh = Kh + B_W;
        const int tw0 = q0 + wid * 32, t = tw0 + r32;
        bf16x8 qr[8]; load_q(qr, P0 + (rowb + t) * AB_IN + 4 * A_W + head * HD + hi * 8);
        float R = 0.f; f32x16 o[4] = {};
        const int jtop = (q0 + 254) >> 6;
        LAS unsigned* dflag = (LAS unsigned*)(lds + ATT_X_OFF);
        if (lane == 0) { dflag[wid] = 0u; dflag[8 + wid] = 0u; }
        LDS_WAIT(); __syncthreads();
        kv_dma(dm, Kh + (size_t)jtop * KVBLK * AB_IN, Vh + (size_t)jtop * KVBLK * AB_IN, lds, 0, wid);
        int buf = 0;
        for (int j = jtop; j >= 0; --j, buf = ATT_BUF - buf) {
            VM_WAIT(); __syncthreads();
            { unsigned alld = 1u;
#pragma unroll
              for (int w = 0; w < NWAVES; ++w) alld &= dflag[((j + 1) & 1) * 8 + w];
              if (__builtin_amdgcn_readfirstlane(alld)) break; }
            if (j > 0) kv_dma(dm, Kh + (size_t)(j - 1) * KVBLK * AB_IN, Vh + (size_t)(j - 1) * KVBLK * AB_IN, lds, ATT_BUF - buf, wid);
            const int k0 = j * KVBLK;
            if (k0 < tw0 + 31) {
                f32x16 p0, p1; qkt(p0, p1, lds + buf + ATT_K_OFF, qr, r32, hi);
                const bool need_mask = (k0 + 63 >= tw0);
                float L0[16], L1[16];
#pragma unroll
                for (int r = 0; r < 16; ++r) {
                    const float z0 = p0[r] * ATT_C, z1 = p1[r] * ATT_C;
                    float l0 = -(fmaxf(z0, 0.f) + __builtin_amdgcn_logf(1.f + __builtin_amdgcn_exp2f(-fabsf(z0))));
                    float l1 = -(fmaxf(z1, 0.f) + __builtin_amdgcn_logf(1.f + __builtin_amdgcn_exp2f(-fabsf(z1))));
                    if (need_mask) { if (k0 + crow(r, hi) >= t) l0 = 0.f; if (k0 + 32 + crow(r, hi) >= t) l1 = 0.f; }
                    L0[r] = l0; L1[r] = l1; p0[r] = z0 + l0; p1[r] = z1 + l1;
                }
                SBAR();
                float Sg[16];
#pragma unroll
                for (int gi = 0; gi < 4; ++gi) {
                    const float a = (L0[4 * gi] + L0[4 * gi + 1]) + (L0[4 * gi + 2] + L0[4 * gi + 3]), c = (L1[4 * gi] + L1[4 * gi + 1]) + (L1[4 * gi + 2] + L1[4 * gi + 3]);
                    auto ra = __builtin_amdgcn_permlane32_swap(__float_as_uint(a), __float_as_uint(a), false, false);
                    auto rc = __builtin_amdgcn_permlane32_swap(__float_as_uint(c), __float_as_uint(c), false, false);
                    Sg[2 * gi] = __uint_as_float(ra[0]); Sg[2 * gi + 1] = __uint_as_float(ra[1]); Sg[8 + 2 * gi] = __uint_as_float(rc[0]); Sg[8 + 2 * gi + 1] = __uint_as_float(rc[1]);
                }
                float run = R;
#pragma unroll
                for (int s = 15; s >= 0; --s) { const float tt = run; run += Sg[s]; Sg[s] = tt; }
                const float Rn = run;
                SBAR();
#pragma unroll
                for (int gi = 0; gi < 4; ++gi) {
                    float base0 = hi ? Sg[2 * gi + 1] : Sg[2 * gi], base1 = hi ? Sg[8 + 2 * gi + 1] : Sg[8 + 2 * gi];
                    float r3 = base0, r2 = r3 + L0[4 * gi + 3], r1 = r2 + L0[4 * gi + 2], r0 = r1 + L0[4 * gi + 1];
                    p0[4 * gi + 3] = __builtin_amdgcn_exp2f(p0[4 * gi + 3] + r3); p0[4 * gi + 2] = __builtin_amdgcn_exp2f(p0[4 * gi + 2] + r2);
                    p0[4 * gi + 1] = __builtin_amdgcn_exp2f(p0[4 * gi + 1] + r1); p0[4 * gi + 0] = __builtin_amdgcn_exp2f(p0[4 * gi + 0] + r0);
                    r3 = base1; r2 = r3 + L1[4 * gi + 3]; r1 = r2 + L1[4 * gi + 2]; r0 = r1 + L1[4 * gi + 1];
                    p1[4 * gi + 3] = __builtin_amdgcn_exp2f(p1[4 * gi + 3] + r3); p1[4 * gi + 2] = __builtin_amdgcn_exp2f(p1[4 * gi + 2] + r2);
                    p1[4 * gi + 1] = __builtin_amdgcn_exp2f(p1[4 * gi + 1] + r1); p1[4 * gi + 0] = __builtin_amdgcn_exp2f(p1[4 * gi + 0] + r0);
                }
                R = Rn;
                { const unsigned dn = __all(R < SB_CUT) ? 1u : 0u; if (lane == 0) dflag[(j & 1) * 8 + wid] = dn; }
                if (need_mask) {
#pragma unroll
                    for (int r = 0; r < 16; ++r) { if (k0 + crow(r, hi) >= t) p0[r] = 0.f; if (k0 + 32 + crow(r, hi) >= t) p1[r] = 0.f; }
                }
                bf16x8 pa0, pa1, pa2, pa3; pack_p(p0, p1, pa0, pa1, pa2, pa3);
                pv_d0(o, vb0 + buf, pa0, pa1, pa2, pa3);
            }
        }
        bf16* Ow = Ob + (rowb + tw0) * DM + A_W + head * HD;
#pragma unroll
        for (int r = 0; r < 16; ++r) { const int orow = crow(r, hi);
#pragma unroll
            for (int d0 = 0; d0 < 4; ++d0) Ow[(size_t)orow * DM + d0 * 32 + r32] = (bf16)f2bf(o[d0][r]); }
    }
}

constexpr int P1_KC = 4096, P1_VC = 4608, P1_KS = 5120, P1_VS = 5632, P1_KW = 6144, P1_VW = 6656, P1_GL = 7168;
__device__ __forceinline__ void nsa_rope_phase(Frame& F, const bf16* P1, const float* TAB, bf16* QROT, bf16* KSROT, bf16* KWROT, bf16* OVL) {
    const int gw = F.bid * NWAVES + F.wave, NGW = F.G * NWAVES, lane = F.lane, hsub = lane >> 3, d0 = (lane & 7) * 8;
    for (int m = gw; m < MTOK; m += NGW) {
        const int t = m & (SEQ - 1);
        const f32x4 c0 = *(const f32x4*)(TAB + (size_t)t * 128 + d0), c1 = *(const f32x4*)(TAB + (size_t)t * 128 + d0 + 4);
        const f32x4 s0 = *(const f32x4*)(TAB + (size_t)t * 128 + 64 + d0), s1 = *(const f32x4*)(TAB + (size_t)t * 128 + 64 + d0 + 4);
        const float cs[8] = {c0.x, c0.y, c0.z, c0.w, c1.x, c1.y, c1.z, c1.w}, sn[8] = {s0.x, s0.y, s0.z, s0.w, s1.x, s1.y, s1.z, s1.w};
        const bf16* row = P1 + (size_t)m * NSA_INP;
#pragma unroll
        for (int hb = 0; hb < 5; ++hb) {
            const int hh = hb * 8 + hsub;
            const bf16* src; bf16* dst;
            if (hh < 32) { src = row + hh * HD; dst = QROT + (size_t)m * DM + hh * HD; }
            else if (hh < 36) { src = row + P1_KS + (hh - 32) * HD; dst = KSROT + (size_t)m * KVW + (hh - 32) * HD; }
            else { src = row + P1_KW + (hh - 36) * HD; dst = KWROT + (size_t)m * KVW + (hh - 36) * HD; }
            const v4u a = *(const v4u*)(src + d0), bq = *(const v4u*)(src + 64 + d0);
            const unsigned aw[4] = {a.x, a.y, a.z, a.w}, bw[4] = {bq.x, bq.y, bq.z, bq.w}; unsigned o1[4], o2[4];
#pragma unroll
            for (int q = 0; q < 4; ++q) { const float x1l = bflo(aw[q]), x1h = bfhi(aw[q]), x2l = bflo(bw[q]), x2h = bfhi(bw[q]);
                o1[q] = pk2(x1l * cs[2 * q] - x2l * sn[2 * q], x1h * cs[2 * q + 1] - x2h * sn[2 * q + 1]);
                o2[q] = pk2(x2l * cs[2 * q] + x1l * sn[2 * q], x2h * cs[2 * q + 1] + x1h * sn[2 * q + 1]); }
            *(v4u*)(dst + d0) = (v4u){o1[0], o1[1], o1[2], o1[3]}; *(v4u*)(dst + 64 + d0) = (v4u){o2[0], o2[1], o2[2], o2[3]};
        }
    }
    for (int i = F.bid * NTHR + F.tid; i < NCMPP * NSLC; i += F.G * NTHR) { const int n = i / NSLC, j = i % NSLC;
        OVL[i] = (n < NCMP && n >= 4 * j - 1 && n <= 4 * j + 3) ? (bf16)0x3f80u : (bf16)0u; }
}
constexpr int CM_A = 0, CM_B = 17408, CM_H = 17408 + 34816;
__device__ __forceinline__ void nsa_compress_phase(Frame& F, const bf16* P1, const float* pos, const bf16* W1t, const bf16* W2t, bf16* KCMP, bf16* VCMP) {
    LAS char* lds = (LAS char*)F.lds;
    const int tid = F.tid, wid = F.wave, lane = F.lane, fr = lane & 15, fq = lane >> 4;
    for (int item = F.bid; item < 128; item += F.G) {
        const int nt = item & 7, g = (item >> 3) & 3, b = (item >> 5) & 1, which = item >> 6;
        const bf16* w1 = W1t + (size_t)which * HD * 32 * HD; const bf16* w2 = W2t + (size_t)which * HD * HD;
        const float* posw = pos + (size_t)which * 32 * HD;
        f32x4 acc[4];
#pragma unroll
        for (int k = 0; k < 4; ++k) acc[k] = (f32x4){0.f, 0.f, 0.f, 0.f};
        for (int l = 0; l < 32; ++l) {
            { const int r = tid >> 3, ch = (tid & 7) * 16, n = nt * 64 + r; unsigned w[8];
              if (n < NCMP) { const bf16* src = P1 + ((size_t)b * SEQ + 16 * n + l) * NSA_INP + P1_KC + which * KVW + g * HD + ch;
                  const v4u x0 = *(const v4u*)src, x1 = *(const v4u*)(src + 8); const unsigned xs[8] = {x0.x, x0.y, x0.z, x0.w, x1.x, x1.y, x1.z, x1.w};
#pragma unroll
                  for (int q = 0; q < 8; ++q) w[q] = pk2(bflo(xs[q]) + posw[l * HD + ch + 2 * q], bfhi(xs[q]) + posw[l * HD + ch + 2 * q + 1]);
              } else {
#pragma unroll
                  for (int q = 0; q < 8; ++q) w[q] = 0u; }
              LAS v4u* dst = (LAS v4u*)(lds + CM_A + r * 272 + ch * 2); dst[0] = (v4u){w[0], w[1], w[2], w[3]}; dst[1] = (v4u){w[4], w[5], w[6], w[7]}; }
            { const int e = tid >> 2, ch = (tid & 3) * 32; const bf16* src = w1 + (size_t)e * 32 * HD + l * HD + ch;
              const v4u x0 = *(const v4u*)src, x1 = *(const v4u*)(src + 8), x2 = *(const v4u*)(src + 16), x3 = *(const v4u*)(src + 24);
              LAS v4u* dst = (LAS v4u*)(lds + CM_B + e * 272 + ch * 2); dst[0] = x0; dst[1] = x1; dst[2] = x2; dst[3] = x3; }
            LDS_WAIT(); __syncthreads();
#pragma unroll
            for (int k = 0; k < 4; ++k) { const int tau = wid + 8 * k, ni = tau >> 3, ei = tau & 7;
                acc[k] += mma_tile<128>(lds + CM_A + ni * 16 * 272, 272, lds + CM_B + ei * 16 * 272, 272, fr, fq); }
            LDS_WAIT(); __syncthreads();
        }
#pragma unroll
        for (int k = 0; k < 4; ++k) { const int tau = wid + 8 * k, ni = tau >> 3, ei = tau & 7;
#pragma unroll
            for (int i = 0; i < 4; ++i) *(LAS unsigned short*)(lds + CM_H + (16 * ni + 4 * fq + i) * 272 + (16 * ei + fr) * 2) = (unsigned short)f2bf(gelu1(acc[k][i])); }
        { const int f = tid >> 2, ch = (tid & 3) * 32; const bf16* src = w2 + (size_t)f * HD + ch;
          const v4u x0 = *(const v4u*)src, x1 = *(const v4u*)(src + 8), x2 = *(const v4u*)(src + 16), x3 = *(const v4u*)(src + 24);
          LAS v4u* dst = (LAS v4u*)(lds + CM_B + f * 272 + ch * 2); dst[0] = x0; dst[1] = x1; dst[2] = x2; dst[3] = x3; }
        LDS_WAIT(); __syncthreads();
        bf16* outp = which ? VCMP : KCMP;
#pragma unroll
        for (int k = 0; k < 4; ++k) { const int tau = wid + 8 * k, ni = tau >> 3, fi = tau & 7;
            const f32x4 a2 = mma_tile<128>(lds + CM_H + ni * 16 * 272, 272, lds + CM_B + fi * 16 * 272, 272, fr, fq);
#pragma unroll
            for (int i = 0; i < 4; ++i) { const int n = nt * 64 + 16 * ni + 4 * fq + i;
                outp[(((size_t)b * NCMPP + n) * NSA_G + g) * HD + 16 * fi + fr] = (n < NCMP) ? (bf16)f2bf(a2[i]) : (bf16)0u; } }
        LDS_WAIT(); __syncthreads();
    }
}
__device__ __forceinline__ unsigned pick4(const unsigned (&a)[4], int i) { return i == 0 ? a[0] : (i == 1 ? a[1] : (i == 2 ? a[2] : a[3])); }
template <int MODE>
__device__ __forceinline__ void nsa_attn_phase(Frame& F, const bf16* P1, const bf16* Qsrc, const bf16* Ksrc, const bf16* Vsrc, const unsigned* SEL, float* O32, float* IMP, bf16* Ob, bool probe_nostore = false) {
    const int tid = F.tid, wid = F.wave, lane = F.lane, r32 = lane & 31, hi = lane >> 5;
    LAS char* lds = (LAS char*)F.lds;
    LAS float* wsc = (LAS float*)(lds + ATT_WS_OFF + wid * 256);
    const int vb0 = (int)(uintptr_t)(lds + ATT_V_OFF) + v_rd_base(lane);
    KVDma dm; kv_dma_init(dm, MODE <= 1 ? NSA_G * HD : KVW, MODE == 0 ? NSA_G * HD : (MODE == 1 ? NSLC : NSA_INP), wid, lane);
    constexpr int NTB = SEQ / 32, NU = BATCH * NSA_G * NTB;
    for (int rd = 0; ; ++rd) {
        const int idx = (rd & 1) ? rd * F.G + (F.G - 1 - F.bid) : rd * F.G + F.bid;
        if (rd * F.G >= NU) break;
        if (idx >= NU) continue;
        const int tb = NTB - 1 - idx / (BATCH * NSA_G), bg = idx % (BATCH * NSA_G), g = bg % NSA_G, b = bg / NSA_G;
        const size_t rowb = (size_t)b * SEQ; const int t0 = tb * 32;
        const int t = (MODE == 2) ? t0 + 4 * wid + (r32 >> 3) : t0 + r32, head = (MODE == 2) ? g * NSA_R + (r32 & 7) : g * NSA_R + wid;
        const bf16* Kh; const bf16* Vh; long ldk, ldv; int jlo, jhi;
        if (MODE <= 1) { Kh = Ksrc + ((size_t)b * NCMPP * NSA_G + g) * HD; ldk = NSA_G * HD; jlo = 0; jhi = (t0 >> 4) >> 6;
            if (MODE == 0) { Vh = Vsrc + ((size_t)b * NCMPP * NSA_G + g) * HD; ldv = NSA_G * HD; } else { Vh = Vsrc; ldv = NSLC; } }
        else { Kh = Ksrc + rowb * KVW + g * HD; ldk = KVW; Vh = P1 + rowb * NSA_INP + (MODE == 2 ? P1_VS : P1_VW) + g * HD; ldv = NSA_INP;
            jhi = (t0 + 31) >> 6; jlo = (MODE == 2) ? 0 : ((t0 - (WINDOW - 1) > 0 ? t0 - (WINDOW - 1) : 0) >> 6); }
        bf16x8 qr[8]; load_q(qr, Qsrc + (rowb + t) * (MODE <= 1 ? NSA_INP : DM) + head * HD + hi * 8);
        unsigned selw[4] = {0u, 0u, 0u, 0u}, uni[4] = {~0u, ~0u, ~0u, ~0u}, wn[4] = {~0u, ~0u, ~0u, ~0u};
        if (MODE == 2) { const v4u sv = *(const v4u*)(SEL + ((rowb + t) * NSA_G + g) * 4); selw[0] = sv.x; selw[1] = sv.y; selw[2] = sv.z; selw[3] = sv.w;
            LAS unsigned* un = (LAS unsigned*)(lds + ATT_X_OFF);
#pragma unroll
            for (int q = 0; q < 4; ++q) { unsigned x = selw[q]; x |= __shfl_xor(x, 8); x |= __shfl_xor(x, 16); wn[q] = __builtin_amdgcn_readfirstlane(x); if (lane == 0) un[wid * 4 + q] = wn[q]; }
            LDS_WAIT(); __syncthreads();
#pragma unroll
            for (int q = 0; q < 4; ++q) { unsigned x = 0u;
#pragma unroll
                for (int w = 0; w < NWAVES; ++w) x |= un[w * 4 + q];
                uni[q] = __builtin_amdgcn_readfirstlane(x); } }
        float m_reg = -1e30f, l_reg = 0.f; f32x16 o[4] = {};
        const int cur = t >> 6;
#define NSA_NEXT(jj) do { if (MODE == 2) { while ((jj) <= jhi && !((pick4(uni, (jj) >> 5) >> ((jj) & 31)) & 1u)) ++(jj); } } while (0)
#define NSA_NEED(jj) (MODE != 2 || ((pick4(wn, (jj) >> 5) >> ((jj) & 31)) & 1u))
#define NSA_MASK(P0, P1, JJ) do { const int k0 = (JJ) * KVBLK; constexpr float NINF = -__builtin_inff(); \
            if (MODE <= 1) { if (!(16 * (k0 + 63) + 31 <= t0)) { \
                    _Pragma("unroll") for (int r = 0; r < 16; ++r) { if (!(16 * (k0 + crow(r, hi)) + 31 <= t)) P0[r] = NINF; if (!(16 * (k0 + 32 + crow(r, hi)) + 31 <= t)) P1[r] = NINF; } } } \
            else if (MODE == 2) { const bool mine = (pick4(selw, (JJ) >> 5) >> ((JJ) & 31)) & 1u; const int lim = mine ? ((JJ) < cur ? 0x7fffffff : t) : -1; \
                _Pragma("unroll") for (int r = 0; r < 16; ++r) { if (k0 + crow(r, hi) > lim) P0[r] = NINF; if (k0 + 32 + crow(r, hi) > lim) P1[r] = NINF; } } \
            else { if (!((k0 > t0 + 31 - WINDOW) && (k0 + 63 <= t0))) { \
                    _Pragma("unroll") for (int r = 0; r < 16; ++r) { const int ka = k0 + crow(r, hi), kb = ka + 32; \
                        if (!(ka <= t && ka > t - WINDOW)) P0[r] = NINF; if (!(kb <= t && kb > t - WINDOW)) P1[r] = NINF; } } } } while (0)
        int ja = jlo; NSA_NEXT(ja); int jb = ja + 1; NSA_NEXT(jb);
        __syncthreads();
        if (ja <= jhi) kv_dma(dm, Kh + (size_t)ja * KVBLK * ldk, Vh + (size_t)ja * KVBLK * ldv, lds, 0, wid);
        if (jb <= jhi) kv_dma(dm, Kh + (size_t)jb * KVBLK * ldk, Vh + (size_t)jb * KVBLK * ldv, lds, ATT_BUF, wid);
        int set = 0;
        while (ja <= jhi) {
            int jc = jb + 1; NSA_NEXT(jc); int jd = jc + 1; NSA_NEXT(jd);
            VM_WAIT(); __syncthreads();
            if (jc <= jhi) kv_dma(dm, Kh + (size_t)jc * KVBLK * ldk, Vh + (size_t)jc * KVBLK * ldv, lds, ATT_SET - set, wid);
            if (jd <= jhi) kv_dma(dm, Kh + (size_t)jd * KVBLK * ldk, Vh + (size_t)jd * KVBLK * ldv, lds, ATT_SET - set + ATT_BUF, wid);
            const bool nA = NSA_NEED(ja), nB = (jb <= jhi) && NSA_NEED(jb);
            f32x16 a0, a1, b0, b1;
            if (nA) qkt(a0, a1, lds + set + ATT_K_OFF, qr, r32, hi);
            if (nB) qkt(b0, b1, lds + set + ATT_BUF + ATT_K_OFF, qr, r32, hi);
            if (nA) { NSA_MASK(a0, a1, ja); attn_finish(a0, a1, o, m_reg, l_reg, wsc, vb0 + set, r32, hi); }
            if (nB) { NSA_MASK(b0, b1, jb); attn_finish(b0, b1, o, m_reg, l_reg, wsc, vb0 + set + ATT_BUF, r32, hi); }
            ja = jc; jb = jd; set = ATT_SET - set;
        }
#undef NSA_MASK
#undef NSA_NEED
#undef NSA_NEXT
        { float fac = l_reg > 0.f ? __builtin_amdgcn_rcpf(l_reg) : 0.f;
          if (MODE != 1) { const int br = MODE == 0 ? 0 : (MODE == 2 ? 1 : 2); fac *= sigmoidf_(bf2f(P1[(rowb + t) * NSA_INP + P1_GL + head * 3 + br])); }
          if (hi == 0) wsc[32 + r32] = fac; LDS_WAIT(); }
        if (MODE == 1) {
            float fc[16];
#pragma unroll
            for (int r = 0; r < 16; ++r) fc[r] = wsc[32 + crow(r, hi)];
            LDS_WAIT(); __syncthreads();
#pragma unroll
            for (int r = 0; r < 16; ++r) { const int orow = crow(r, hi);
#pragma unroll
                for (int d0 = 0; d0 < 4; ++d0) *(LAS float*)(lds + ((wid * 32 + orow) * 128 + d0 * 32 + r32) * 4) = o[d0][r] * fc[r]; }
            LDS_WAIT(); __syncthreads();
            { const int tok = tid >> 4, j8 = (tid & 15) * 8; f32x4 s0 = {0.f, 0.f, 0.f, 0.f}, s1 = {0.f, 0.f, 0.f, 0.f};
#pragma unroll
              for (int w = 0; w < 8; ++w) { const LAS f32x4* pp = (const LAS f32x4*)(lds + ((w * 32 + tok) * 128 + j8) * 4); s0 += pp[0]; s1 += pp[1]; }
              f32x4* dst = (f32x4*)(IMP + ((rowb + t0 + tok) * NSA_G + g) * NSLC + j8); dst[0] = s0; dst[1] = s1; }
            LDS_WAIT(); __syncthreads();
        } else {
#pragma unroll
            for (int r = 0; r < 16; ++r) { const int orow = crow(r, hi); const float fc = wsc[32 + orow];
                const size_t off = (MODE == 2) ? (rowb + t0 + 4 * wid + (orow >> 3)) * DM + (g * NSA_R + (orow & 7)) * HD + r32 : (rowb + t0 + orow) * DM + head * HD + r32;
#pragma unroll
                for (int d0 = 0; d0 < 4; ++d0) {
                    if (MODE == 0) O32[off + d0 * 32] = o[d0][r] * fc;
                    else if (MODE == 2) { if (!probe_nostore) O32[off + d0 * 32] += o[d0][r] * fc; }
                    else Ob[off + d0 * 32] = (bf16)f2bf(O32[off + d0 * 32] + o[d0][r] * fc); } }
            LDS_WAIT();
        }
    }
}
__device__ __forceinline__ void nsa_topk_phase(Frame& F, const float* IMP, unsigned* SEL) {
    LAS float* sc = (LAS float*)(F.lds + F.wave * 1024);
    const int gw = F.bid * NWAVES + F.wave, NGW = F.G * NWAVES, lane = F.lane;
    for (int it = gw; it < MTOK * NSA_G; it += NGW) {
        const int m = it / NSA_G, t = m & (SEQ - 1), cur = t >> 6;
        const float* ip = IMP + (size_t)it * NSLC;
        const float a0 = ip[lane], a1 = ip[64 + lane];
        sc[lane] = a0; sc[64 + lane] = a1; LDS_WAIT();
        const int j0 = lane, j1 = lane + 64;
        const bool f0 = (j0 == 0) || (j0 == cur) || (j0 == cur - 1), f1 = (j1 == cur) || (j1 == cur - 1);
        const bool c0 = !f0 && j0 <= cur, c1 = !f1 && j1 <= cur;
        const int nforced = cur >= 2 ? 3 : cur + 1, slots = NTOP - nforced;
        int rk0 = 0, rk1 = 0;
        const int ncand_hi = cur < NSLC ? cur : NSLC - 1;
        for (int i = 1; i <= ncand_hi; ++i) {
            const bool fi = (i == cur) || (i == cur - 1); if (fi) continue;
            const float v = sc[i];
            rk0 += (v > a0 || (v == a0 && i < j0)) ? 1 : 0; rk1 += (v > a1 || (v == a1 && i < j1)) ? 1 : 0;
        }
        const bool s0 = (f0 && j0 <= cur) || (c0 && rk0 < slots), s1 = (f1 && j1 <= cur) || (c1 && rk1 < slots);
        const unsigned long long m0 = __ballot(s0), m1 = __ballot(s1);
        if (lane == 0) { v4u w = {(unsigned)m0, (unsigned)(m0 >> 32), (unsigned)m1, (unsigned)(m1 >> 32)}; *(v4u*)(SEL + (size_t)it * 4) = w; }
        LDS_WAIT();
    }
}

#ifndef STAGE
#define STAGE 3
#endif
#define ZERO_OB_PHASE PH_BEGIN { v4u z = {0u, 0u, 0u, 0u}; v4u* p = (v4u*)Ob; const long n = (long)MTOK * DM / 8; \
            for (long i = (long)F.bid * NTHR + F.tid; i < n; i += (long)F.G * NTHR) p[i] = z; } PH_END
#define MIXER0_PHASES \
    PH_BEGIN { fold_finalize(F, FO_XQ, XW); fold_finalize(F, FO_UP, DFF2); } \
             REP(10) hgrn_phase_a(F, BIG, (const float*)(ws + WS_LB), (bf16*)(ws + WS_QT), (bf16*)(ws + WS_OINTRA), (bf16*)(ws + WS_DS), (float*)(ws + WS_DEC)); \
             REP(11) sb_phase(F, BIG, Ob); PH_END \
    PH_BEGIN REP(12) hgrn_phase_b(F, (const bf16*)(ws + WS_DS), (const float*)(ws + WS_DEC), (bf16*)(ws + WS_SPREV)); PH_END \
    PH_BEGIN REP(13) hgrn_phase_c(F, BIG, (const bf16*)(ws + WS_QT), (const bf16*)(ws + WS_OINTRA), (const bf16*)(ws + WS_SPREV), args.in[IN_HGRN_NW], Ob); PH_END
#if STAGE <= 2
#define MIXER1_PHASES ZERO_OB_PHASE
#else
#define MIXER1_PHASES \
    PH_BEGIN { fold_finalize(F, FO_XQ + XW, XW); } REP(14) { nsa_rope_phase(F, BIG, (const float*)(ws + WS_ROPE), (bf16*)(ws + WS_QROT), (bf16*)(ws + WS_KSROT), (bf16*)(ws + WS_KWROT), (bf16*)(ws + WS_OVL)); \
             nsa_compress_phase(F, BIG, args.in[IN_NSA_CMP_POS], (const bf16*)(ws + WS_W_C1), (const bf16*)(ws + WS_W_C2), (bf16*)(ws + WS_KCMP), (bf16*)(ws + WS_VCMP)); } PH_END \
    PH_BEGIN { REP(15) nsa_attn_phase<0>(F, BIG, BIG, (const bf16*)(ws + WS_KCMP), (const bf16*)(ws + WS_VCMP), nullptr, (float*)(ws + WS_O32), nullptr, nullptr); \
             REP(15) nsa_attn_phase<1>(F, BIG, BIG, (const bf16*)(ws + WS_KCMP), (const bf16*)(ws + WS_OVL), nullptr, nullptr, (float*)(ws + WS_IMP), nullptr); } PH_END \
    PH_BEGIN REP(16) nsa_topk_phase(F, (const float*)(ws + WS_IMP), (unsigned*)(ws + WS_SEL)); PH_END \
    PH_BEGIN REP(18) nsa_attn_phase<2>(F, BIG, (const bf16*)(ws + WS_QROT), (const bf16*)(ws + WS_KSROT), nullptr, (const unsigned*)(ws + WS_SEL), (float*)(ws + WS_O32), nullptr, nullptr, r_ > 0); PH_END \
    PH_BEGIN REP(17) nsa_attn_phase<3>(F, BIG, (const bf16*)(ws + WS_QROT), (const bf16*)(ws + WS_KWROT), nullptr, nullptr, (float*)(ws + WS_O32), nullptr, Ob); PH_END
#endif
#ifndef REPMASK
#define REPMASK 0u
#endif
#define REP(gid) for (int r_ = 0; r_ <= (int)((REPMASK >> (gid)) & 1u); ++r_)
#define PH_BEGIN if (pc >= lo && pc < hi) { F.fresh();
#define PH_END   if (pc + 1 < hi) { XcdBarrier bb_ = bar; asm volatile("" : "+s"(bb_.bar), "+s"(bb_.x)); xcd_barrier(bb_); } } ++pc;
template <int l>
__device__ __forceinline__ void layer_body(Frame& F, const Args& args, const XcdBarrier& bar, int& pc, const int lo, const int hi) {
    unsigned char* ws = args.ws;
    bf16* HB = (bf16*)(ws + WS_HB); bf16* Y = (bf16*)(ws + WS_Y); float* H32 = args.out;
    bf16* BIG = (bf16*)(ws + WS_BIG); bf16* Gm = (bf16*)(ws + WS_G); bf16* Ob = (bf16*)(ws + WS_O);
    bf16* XQ = (bf16*)(ws + WS_XQ); bf16* XO = (bf16*)(ws + WS_XO);
#define RS(k) ((long long*)(ws + WS_RSUM) + (size_t)(k) * MTOK * 2)
#define LNG(k) (args.in[IN_LN_G] + (size_t)(k) * DM)
#define LNB(k) (args.in[IN_LN_B] + (size_t)(k) * DM)
    const float* cs = (const float*)(ws + WS_FOLDF); const float* b2 = cs + FO_N;
        PH_BEGIN REP(1) {
            const int N = l == 0 ? AB_IN : NSA_INP;
            pg8::StaticOrder S; S.init(MTOK, N, F.G, F.bid);
            if (l == 0) { pg8::Gemm g{HB, (const bf16*)(ws + WS_W_ABIN), MTOK, N, DM}; pg8::EpiBf16<0> E{BIG, N, nullptr, 0, 0, 1.f};
                pg8::gemm_phase<pg8::EpiBf16<0>, pg8::StaticOrder, PG8_ALIGN, PG8_SP2>(F.lds + RING_OFF, g, S, E); }
            else { pg8::Gemm g{Y, (const bf16*)(ws + WS_W_NSAIN), MTOK, N, DM}; pg8::EpiBf16Ln E{BIG, N, RS(2), cs + FO_NSA, b2 + FO_NSA};
                pg8::gemm_phase<pg8::EpiBf16Ln, pg8::StaticOrder, PG8_ALIGN, PG8_SP2>(F.lds + RING_OFF, g, S, E);
                if (r_ == 0) convert_job<CJ_L1A>(F, args, 64, 192); }
        } PH_END
#if STAGE <= 1
        ZERO_OB_PHASE
#else
        if (l == 0) {
            MIXER0_PHASES
        } else {
            MIXER1_PHASES
        }
#endif
        PH_BEGIN REP(2) {
            pg8::Gemm g{Ob, l == 0 ? (const bf16*)(ws + WS_W_ABOUT) : (const bf16*)(ws + WS_W_NSAOUT), MTOK, DM, DM};
            pg8::StaticOrder S; S.init(MTOK, DM, F.G, F.bid);
            if (l == 0) { pg8::EpiRes0 E{Y, HB, DM, DN_ALPHA, RS(0)};
                pg8::gemm_phase<pg8::EpiRes0, pg8::StaticOrder, PG8_ALIGN, PG8_SP2>(F.lds + RING_OFF, g, S, E); }
            else { pg8::EpiResLn2 E{Y, RS(2), LNG(2), LNB(2), DM, DN_ALPHA, RS(3)};
                pg8::gemm_phase<pg8::EpiResLn2, pg8::StaticOrder, PG8_ALIGN, PG8_SP2>(F.lds + RING_OFF, g, S, E); }
        } PH_END
        PH_BEGIN REP(3) {
            {   pg8::Gemm g{Y, (const bf16*)(ws + WS_W_XQ) + (size_t)l * XW * DM, MTOK, XW, DM};
                pg8::RangeOrder S; S.init(MTOK, XW, 0, 128, F.bid);
                pg8::EpiBf16Ln E{XQ, XW, RS(3 * l), cs + FO_XQ + l * XW, b2 + FO_XQ + l * XW};
                pg8::gemm_phase<pg8::EpiBf16Ln, pg8::RangeOrder, PG8_ALIGN, PG8_SP2>(F.lds + RING_OFF, g, S, E); }
            {   pg8::Gemm g{(const bf16*)(ws + WS_MEMB), (const bf16*)(ws + WS_W_XKV) + (size_t)l * 2 * XW * DM, BATCH * NMEM, 2 * XW, DM};
                pg8::RangeOrder S; S.init(BATCH * NMEM, 2 * XW, 128, 8, F.bid);
                pg8::EpiBf16<0> E{(bf16*)(ws + WS_XKV) + (size_t)l * BATCH * NMEM * 2 * XW, 2 * XW, nullptr, 0, 0, 1.f};
                pg8::gemm_phase<pg8::EpiBf16<0>, pg8::RangeOrder, PG8_ALIGN, PG8_SP2>(F.lds + RING_OFF, g, S, E); }
            if (r_ == 0) { if (l == 0) convert_job<CJ_DOWN0>(F, args, 136, 120); else convert_job<CJ_L1B>(F, args, 136, 120); }
        } PH_END
        PH_BEGIN { if (l == 1) fold_finalize(F, FO_UP + DFF2, DFF2); } REP(9) xattn_phase(F, XQ, (const bf16*)(ws + WS_XKV) + (size_t)l * BATCH * NMEM * 2 * XW, XO); PH_END
        PH_BEGIN REP(4) {
            pg8::Gemm g{XO, (const bf16*)(ws + WS_W_XO) + (size_t)l * DM * XW, MTOK, DM, XW};
            pg8::StaticOrder S; S.init(MTOK, DM, F.G, F.bid);
            pg8::EpiResLn2 E{Y, RS(3 * l), LNG(3 * l), LNB(3 * l), DM, DN_ALPHA, RS(3 * l + 1)};
            pg8::gemm_phase<pg8::EpiResLn2, pg8::StaticOrder, PG8_ALIGN, PG8_SP2>(F.lds + RING_OFF, g, S, E);
        } PH_END
        PH_BEGIN REP(5) {
#if (REPMASK >> 22) & 1
            if (r_ > 0) { XcdBarrier bb_ = bar; asm volatile("" : "+s"(bb_.bar), "+s"(bb_.x)); xcd_barrier(bb_); }
#endif
            pg8::Gemm g{Y, (const bf16*)(ws + WS_W_UP) + (size_t)l * DFF2 * DM, MTOK, DFF2, DM};
            pg8::StaticOrder S; S.init(MTOK, DFF2, F.G, F.bid);
            pg8::EpiBf16Ln E{BIG, DFF2, RS(3 * l + 1), cs + FO_UP + l * DFF2, b2 + FO_UP + l * DFF2};
            pg8::gemm_phase<pg8::EpiBf16Ln, pg8::StaticOrder, PG8_ALIGN, PG8_SP2>(F.lds + RING_OFF, g, S, E);
            if (r_ == 0) { if (l == 0) convert_job<CJ_NSA>(F, args, 128, 128); else convert_job<CJ_DOWN1>(F, args, 128, 128); }
        } PH_END
#if (REPMASK >> 20) & 1
        PH_BEGIN {
            pg8::Gemm g{HB, (const bf16*)(ws + WS_W_UP) + (size_t)l * DFF2 * DM, MTOK, DFF2, DM};
            pg8::ZeroOrder S; S.init(MTOK, DFF2, F.G, F.bid);
            pg8::EpiBf16<0> E{Gm, DFF2, nullptr, 0, 0, 1.f};
            pg8::gemm_phase<pg8::EpiBf16<0>, pg8::ZeroOrder, PG8_ALIGN, PG8_SP2>(F.lds + RING_OFF, g, S, E);
        } PH_END
#endif
        PH_BEGIN { if (l == 0) fold_finalize(F, FO_NSA, NSA_INP); } REP(8) convglu_phase(F, BIG, args.in[IN_FFN_CONV] + (size_t)l * 3 * DFF, Gm); PH_END
        PH_BEGIN REP(6) {
            pg8::Gemm g{Gm, (const bf16*)(ws + WS_W_DOWN) + (size_t)l * DM * DFF, MTOK, DM, DFF};
            pg8::StaticOrder S; S.init(MTOK, DM, F.G, F.bid);
            pg8::EpiResLn2 E{Y, RS(3 * l + 1), LNG(3 * l + 1), LNB(3 * l + 1), DM, DN_ALPHA, RS(3 * l + 2)};
            pg8::gemm_phase<pg8::EpiResLn2, pg8::StaticOrder, PG8_ALIGN, PG8_SP2>(F.lds + RING_OFF, g, S, E);
        } PH_END
        if (l == 1) { PH_BEGIN REP(7) ln_phase(F, Y, LNG(5), LNB(5), H32); PH_END }
#undef RS
#undef LNG
#undef LNB
}
__global__ void __launch_bounds__(NTHR, 2) mega_fwd(Args args) {
    extern __shared__ __attribute__((aligned(16))) unsigned char lds_raw[];
    Frame F;
    F.lds = (LAS unsigned char*)lds_raw; F.ws = args.ws;
    F.tid = threadIdx.x; F.lane = F.tid & 63; F.wave = __builtin_amdgcn_readfirstlane(F.tid >> 6); F.G = gridDim.x;
    unsigned char* ws = args.ws;
    gu32* ctl = (gu32*)(ws + WS_CTL);
    for (int u = F.tid; u < (LDS_BYTES - LDSCTL_OFF) / 4; u += NTHR) ((LAS unsigned*)(F.lds + LDSCTL_OFF))[u] = 0u;
    __syncthreads();
    volatile LAS unsigned* MISC = (volatile LAS unsigned*)(F.lds + MISC_OFF);
    XcdBarrier bar = xcd_barrier_post((unsigned*)(ctl + CW_BAR), MISC + 8);
    const int lo = args.ph_lo, hi = args.ph_hi; int pc = 0;
    bf16* HB = (bf16*)(ws + WS_HB); bf16* Y = (bf16*)(ws + WS_Y); float* H32 = args.out;
    bf16* BIG = (bf16*)(ws + WS_BIG); bf16* Gm = (bf16*)(ws + WS_G); bf16* Ob = (bf16*)(ws + WS_O);
    bf16* XQ = (bf16*)(ws + WS_XQ); bf16* XO = (bf16*)(ws + WS_XO);

    PH_BEGIN REP(0) p0_prologue(F, args); PH_END

#if (REPMASK >> 21) & 1
    for (int e_ = 0; e_ < 40; ++e_) { PH_BEGIN PH_END }
#endif
    layer_body<0>(F, args, bar, pc, lo, hi);
    layer_body<1>(F, args, bar, pc, lo, hi);
}

extern "C" void kernel_launch(void* const* d_in, const int* in_sizes, int n_in, void* d_out, int out_size, void* d_ws, size_t ws_size, hipStream_t stream) {
    static int grid = 0;
    if (grid == 0) {
        if (n_in != 19 || in_sizes[0] != MTOK * DM || out_size != MTOK * DM || ws_size < WS_END) {
            fprintf(stderr, "kernel_launch: shape mismatch n_in %d in0 %d out %d ws %zu (need %zu)\n", n_in, n_in > 0 ? in_sizes[0] : -1, out_size, ws_size, (size_t)WS_END); grid = -1; return; }
        int dev = 0, cus = 0, per_cu = 0;
        if (hipGetDevice(&dev) != hipSuccess || hipDeviceGetAttribute(&cus, hipDeviceAttributeMultiprocessorCount, dev) != hipSuccess) { grid = -1; return; }
        if (hipFuncSetAttribute((const void*)mega_fwd, hipFuncAttributeMaxDynamicSharedMemorySize, LDS_BYTES) != hipSuccess) { fprintf(stderr, "kernel_launch: hipFuncSetAttribute failed\n"); grid = -1; return; }
        if (hipOccupancyMaxActiveBlocksPerMultiprocessor(&per_cu, (const void*)mega_fwd, NTHR, LDS_BYTES) != hipSuccess || per_cu < 1)
            fprintf(stderr, "kernel_launch: note: occupancy query reports %d workgroups per CU\n", per_cu);
        (void)hipGetLastError();
        grid = cus;
    }
    if (grid < 0) return;
    if (hipMemsetAsync((char*)d_ws + WS_CTL, 0, CTL_ZERO_BYTES, stream) != hipSuccess) { fprintf(stderr, "kernel_launch: memset failed\n"); return; }
    Args a{};
    for (int i = 0; i < 19; ++i) a.in[i] = (const float*)d_in[i];
    a.out = (float*)d_out; a.ws = (unsigned char*)d_ws; a.ph_lo = 0; a.ph_hi = 1 << 20;
    hipLaunchKernelGGL(mega_fwd, dim3(grid), dim3(NTHR), LDS_BYTES, stream, a);
    const hipError_t le = hipPeekAtLastError();
    if (le != hipSuccess) fprintf(stderr, "kernel_launch: launch failed: %s\n", hipGetErrorName(le));
}
```

```cpp
#include <hip/hip_runtime.h>
#include <cstdio>
#include <cstdint>
namespace pg8 {
#define PG8_LAS __attribute__((address_space(3)))
typedef unsigned short bf16_t;
typedef short bf16x8 __attribute__((ext_vector_type(8)));
typedef float f32x4 __attribute__((ext_vector_type(4)));
typedef unsigned u32x4 __attribute__((ext_vector_type(4)));
constexpr int BM = 256, BK = 64, HALF = 128, HTB = HALF * BK * 2  , STAGE_BYTES = 8 * HTB, NXCD = 8, WGM = 8;

__host__ __device__ __forceinline__ int lds_byte(int r, int c) { const int st = (r >> 4) * 2 + (c >> 5), rr = r & 15, cc = c & 31, ob = rr * 64 + cc * 2; return st * 1024 + (ob ^ (((ob >> 9) & 1) << 5)); }
__host__ __device__ __forceinline__ void stage_rc(int b, int& R, int& C) { const int st = b / 1024, sb = b % 1024, swz = sb ^ (((sb >> 9) & 1) << 5); R = (st >> 1) * 16 + swz / 64; C = (st & 1) * 32 + (swz % 64) / 2; }
__host__ __device__ __forceinline__ int perm32(int rho) { const int n = rho >> 4, i = rho & 15; return 8 * (i >> 2) + 4 * n + (i & 3); }

struct Unit { int pm, pn; };
struct Gemm { const bf16_t* A; const bf16_t* Bt; int M, N, K; };

struct StaticOrder {
    int nM, nN, nwg, G, c;
    __host__ __device__ void init(int M, int N, int G_, int c_) { nM = M / BM; nN = N / BM; nwg = nM * nN; G = G_; c = c_; }
    __host__ __device__ bool next(int i, Unit& u) const {
        const long L = (long)i * G + c; if (L >= nwg) return false;
        int wgid = (int)L; { const int q = nwg / NXCD, r = nwg % NXCD, xcd = wgid % NXCD, off = wgid / NXCD; wgid = (xcd < r ? xcd * (q + 1) : r * (q + 1) + (xcd - r) * q) + off; }
        const int nig = WGM * nN, gid = wgid / nig, fm = gid * WGM, gsz = (nM - fm) < WGM ? (nM - fm) : WGM;
        u.pm = fm + ((wgid % nig) % gsz); u.pn = (wgid % nig) / gsz; return true;
    }
    __device__ __forceinline__ void a_ready(const Unit&) const {}
    __device__ __forceinline__ void done(const Unit&) const {}
};

__device__ __forceinline__ unsigned cvt_pk_bf16(float lo, float hi) { unsigned r; asm volatile("v_cvt_pk_bf16_f32 %0, %1, %2" : "=v"(r) : "v"(lo), "v"(hi)); return r; }
typedef float f32x2 __attribute__((ext_vector_type(2)));
__device__ __forceinline__ f32x2 gelu_pk(f32x2 v) {
    const f32x2 av = __builtin_elementwise_abs(v), d = av * 0.2316418882f + 1.0f;
    f32x2 t; t.x = __builtin_amdgcn_rcpf(d.x); t.y = __builtin_amdgcn_rcpf(d.y);
    f32x2 q = t * 0.5307027145f + (-0.7265760135f); q = q * t + 0.7107068705f; q = q * t + (-0.142248368f); q = q * t + 0.127414796f; q = q * t;
    const f32x2 s = (v * v) * (-0.72134752044f);
    f32x2 e; e.x = __builtin_amdgcn_exp2f(s.x); e.y = __builtin_amdgcn_exp2f(s.y);
    const f32x2 m = v * (q * e), r = v - m;
    f32x2 o; o.x = v.x < 0.f ? m.x : r.x; o.y = v.y < 0.f ? m.y : r.y; return o;
}

template <int ACT  > struct EpiBf16 {
    static constexpr bool PERM = true, AFTER_DRAIN = false; static_assert(ACT == 0 || ACT == 1, "EpiBf16: ACT is 0 (none) or 1 (gelu_pk)");
    bf16_t* O; int ldc; const float* bias; int split_cols; size_t split_stride; float scale0;
    __device__ __forceinline__ void operator()(const f32x4 (&acc)[2][2][4][2], const Unit& u, int wr, int wc, int fr, int fq) const {
        const int row0 = u.pm * BM + wr * 64 + fr; int colt = u.pn * BM; bf16_t* base = O;
        float sc = 1.f; if (split_cols) { const int t = colt / split_cols; base += (size_t)t * split_stride; colt -= t * split_cols; if (t == 0) sc = scale0; }
        const int col0 = colt + wc * 32 + 8 * fq, bcol0 = u.pn * BM + wc * 32 + 8 * fq;
        f32x4 bv[2][2];
#pragma unroll
        for (int bj = 0; bj < 2; ++bj)
#pragma unroll
            for (int n = 0; n < 2; ++n) bv[bj][n] = bias ? *(const f32x4*)(bias + bcol0 + bj * HALF + 4 * n) : (f32x4){0.f, 0.f, 0.f, 0.f};
#pragma unroll
        for (int ai = 0; ai < 2; ++ai)
#pragma unroll
            for (int m = 0; m < 4; ++m) { bf16_t* rowp = base + (size_t)(row0 + ai * HALF + m * 16) * ldc + col0;
#pragma unroll
                for (int bj = 0; bj < 2; ++bj) { f32x4 v0 = acc[ai][bj][m][0] + bv[bj][0], v1 = acc[ai][bj][m][1] + bv[bj][1];
                    if (ACT == 1) { f32x2 a = gelu_pk((f32x2){v0[0], v0[1]}), b = gelu_pk((f32x2){v0[2], v0[3]}), c = gelu_pk((f32x2){v1[0], v1[1]}), d = gelu_pk((f32x2){v1[2], v1[3]});
                        v0 = (f32x4){a.x, a.y, b.x, b.y}; v1 = (f32x4){c.x, c.y, d.x, d.y}; }
                    v0 = v0 * sc; v1 = v1 * sc; u32x4 w; w.x = cvt_pk_bf16(v0[0], v0[1]); w.y = cvt_pk_bf16(v0[2], v0[3]); w.z = cvt_pk_bf16(v1[0], v1[1]); w.w = cvt_pk_bf16(v1[2], v1[3]);
                    *(u32x4*)(rowp + bj * HALF) = w; } }
    }
};


struct EpiRes {
    static constexpr bool PERM = false, AFTER_DRAIN = false;
    float* Y; const float* res; int ldc; float alpha;
    __device__ __forceinline__ void operator()(const f32x4 (&acc)[2][2][4][2], const Unit& u, int wr, int wc, int fr, int fq) const {
        const int row0 = u.pm * BM + wr * 64 + fr, col0 = u.pn * BM + wc * 32 + 4 * fq;
#pragma unroll
        for (int ai = 0; ai < 2; ++ai)
#pragma unroll
            for (int m = 0; m < 4; ++m) { const size_t off = (size_t)(row0 + ai * HALF + m * 16) * ldc + col0;
#pragma unroll
                for (int bj = 0; bj < 2; ++bj)
#pragma unroll
                    for (int n = 0; n < 2; ++n) { const f32x4 r = *(const f32x4*)(res + off + bj * HALF + n * 16);
                        *(f32x4*)(Y + off + bj * HALF + n * 16) = r * alpha + acc[ai][bj][m][n]; } }
    }
};
struct RangeOrder {
    int nM, nN, ntot, c0, nw, c;
    __host__ __device__ void init(int M, int N, int c0_, int nw_, int c_) { nM = M / BM; nN = N / BM; ntot = nM * nN; c0 = c0_; nw = nw_; c = c_; }
    __host__ __device__ bool next(int i, Unit& u) const {
        if (c < c0 || c >= c0 + nw) return false;
        const int L = i * nw + (c - c0); if (L >= ntot) return false;
        u.pm = L / nN; u.pn = L % nN; return true;
    }
    __device__ __forceinline__ void a_ready(const Unit&) const {}
    __device__ __forceinline__ void done(const Unit&) const {}
};

struct ZeroOrder : StaticOrder {
    __host__ __device__ bool next(int i, Unit& u) const { const bool r = StaticOrder::next(i, u); u.pm = 0; u.pn = 0; return r; }
};

struct EpiResBf {
    static constexpr bool PERM = true, AFTER_DRAIN = false;
    bf16_t* Y; const bf16_t* res; int ldc; float alpha;
    __device__ __forceinline__ void operator()(const f32x4 (&acc)[2][2][4][2], const Unit& u, int wr, int wc, int fr, int fq) const {
        const int row0 = u.pm * BM + wr * 64 + fr, col0 = u.pn * BM + wc * 32 + 8 * fq;
#pragma unroll
        for (int ai = 0; ai < 2; ++ai)
#pragma unroll
            for (int m = 0; m < 4; ++m) { const size_t off = (size_t)(row0 + ai * HALF + m * 16) * ldc + col0;
#pragma unroll
                for (int bj = 0; bj < 2; ++bj) { const u32x4 r = *(const u32x4*)(res + off + bj * HALF);
                    const f32x4 v0 = acc[ai][bj][m][0], v1 = acc[ai][bj][m][1];
                    u32x4 w;
                    w.x = cvt_pk_bf16(__builtin_bit_cast(float, r.x << 16) * alpha + v0[0], __builtin_bit_cast(float, r.x & 0xffff0000u) * alpha + v0[1]);
                    w.y = cvt_pk_bf16(__builtin_bit_cast(float, r.y << 16) * alpha + v0[2], __builtin_bit_cast(float, r.y & 0xffff0000u) * alpha + v0[3]);
                    w.z = cvt_pk_bf16(__builtin_bit_cast(float, r.z << 16) * alpha + v1[0], __builtin_bit_cast(float, r.z & 0xffff0000u) * alpha + v1[1]);
                    w.w = cvt_pk_bf16(__builtin_bit_cast(float, r.w << 16) * alpha + v1[2], __builtin_bit_cast(float, r.w & 0xffff0000u) * alpha + v1[3]);
                    *(u32x4*)(Y + off + bj * HALF) = w; } }
    }
};

struct EpiResF {
    static constexpr bool PERM = true, AFTER_DRAIN = false;
    float* Y; const bf16_t* res; int ldc; float alpha;
    __device__ __forceinline__ void operator()(const f32x4 (&acc)[2][2][4][2], const Unit& u, int wr, int wc, int fr, int fq) const {
        const int row0 = u.pm * BM + wr * 64 + fr, col0 = u.pn * BM + wc * 32 + 8 * fq;
#pragma unroll
        for (int ai = 0; ai < 2; ++ai)
#pragma unroll
            for (int m = 0; m < 4; ++m) { const size_t off = (size_t)(row0 + ai * HALF + m * 16) * ldc + col0;
#pragma unroll
                for (int bj = 0; bj < 2; ++bj) { const u32x4 r = *(const u32x4*)(res + off + bj * HALF);
                    f32x4 o0, o1;
                    o0[0] = __builtin_bit_cast(float, r.x << 16); o0[1] = __builtin_bit_cast(float, r.x & 0xffff0000u); o0[2] = __builtin_bit_cast(float, r.y << 16); o0[3] = __builtin_bit_cast(float, r.y & 0xffff0000u);
                    o1[0] = __builtin_bit_cast(float, r.z << 16); o1[1] = __builtin_bit_cast(float, r.z & 0xffff0000u); o1[2] = __builtin_bit_cast(float, r.w << 16); o1[3] = __builtin_bit_cast(float, r.w & 0xffff0000u);
                    *(f32x4*)(Y + off + bj * HALF) = o0 * alpha + acc[ai][bj][m][0]; *(f32x4*)(Y + off + bj * HALF + 4) = o1 * alpha + acc[ai][bj][m][1]; } }
    }
};

struct EpiResLn {
    static constexpr bool PERM = true, AFTER_DRAIN = false;
    bf16_t* Y; const float* stats; const float* g; const float* b; int ldc; float alpha;
    __device__ __forceinline__ void operator()(const f32x4 (&acc)[2][2][4][2], const Unit& u, int wr, int wc, int fr, int fq) const {
        const int row0 = u.pm * BM + wr * 64 + fr, col0 = u.pn * BM + wc * 32 + 8 * fq;
        f32x4 gv[2][2], bv[2][2];
#pragma unroll
        for (int bj = 0; bj < 2; ++bj)
#pragma unroll
            for (int n = 0; n < 2; ++n) { gv[bj][n] = *(const f32x4*)(g + col0 + bj * HALF + 4 * n) * alpha; bv[bj][n] = *(const f32x4*)(b + col0 + bj * HALF + 4 * n) * alpha; }
#pragma unroll
        for (int ai = 0; ai < 2; ++ai)
#pragma unroll
            for (int m = 0; m < 4; ++m) { const int row = row0 + ai * HALF + m * 16; const size_t off = (size_t)row * ldc + col0;
                const float mean = stats[2 * row], rstd = stats[2 * row + 1];
#pragma unroll
                for (int bj = 0; bj < 2; ++bj) { const u32x4 r = *(const u32x4*)(Y + off + bj * HALF);
                    f32x4 y0, y1;
                    y0[0] = __builtin_bit_cast(float, r.x << 16); y0[1] = __builtin_bit_cast(float, r.x & 0xffff0000u); y0[2] = __builtin_bit_cast(float, r.y << 16); y0[3] = __builtin_bit_cast(float, r.y & 0xffff0000u);
                    y1[0] = __builtin_bit_cast(float, r.z << 16); y1[1] = __builtin_bit_cast(float, r.z & 0xffff0000u); y1[2] = __builtin_bit_cast(float, r.w << 16); y1[3] = __builtin_bit_cast(float, r.w & 0xffff0000u);
                    const f32x4 o0 = (y0 - mean) * rstd * gv[bj][0] + bv[bj][0] + acc[ai][bj][m][0], o1 = (y1 - mean) * rstd * gv[bj][1] + bv[bj][1] + acc[ai][bj][m][1];
                    u32x4 w; w.x = cvt_pk_bf16(o0[0], o0[1]); w.y = cvt_pk_bf16(o0[2], o0[3]); w.z = cvt_pk_bf16(o1[0], o1[1]); w.w = cvt_pk_bf16(o1[2], o1[3]);
                    *(u32x4*)(Y + off + bj * HALF) = w; } }
    }
};

constexpr float RS_SCALE = 1048576.0f, RS_INV = 1.0f / 1048576.0f;
__device__ __forceinline__ float fx20_to_f(long long v) { return (float)(int)(v >> 20) + (float)((unsigned)v & 0xFFFFFu) * RS_INV; }
__device__ __forceinline__ long long f_to_fx20(float s) { const float fl = floorf(s); return ((long long)(int)fl << 20) + (long long)(unsigned)((s - fl) * RS_SCALE + 0.5f); }
__device__ __forceinline__ void row_stats(const long long* rs, int row, float& mean, float& rstd) {
    const long long a = rs[2 * (size_t)row], b = rs[2 * (size_t)row + 1];
    mean = fx20_to_f(a) * (1.0f / 4096.0f); const float var = fx20_to_f(b) * (1.0f / 4096.0f) - mean * mean; rstd = 1.0f / sqrtf(var + 1e-5f);
}
constexpr float FOLD_SCALE = 4294967296.0f, FOLD_INV = 1.0f / 4294967296.0f;
struct EpiBf16Ln {
    static constexpr bool PERM = true, AFTER_DRAIN = false;
    bf16_t* O; int ldc; const long long* rs; const float* cs; const float* b2;
    __device__ __forceinline__ void operator()(const f32x4 (&acc)[2][2][4][2], const Unit& u, int wr, int wc, int fr, int fq) const {
        const int row0 = u.pm * BM + wr * 64 + fr, col0 = u.pn * BM + wc * 32 + 8 * fq;
        f32x4 cv[2][2], bv[2][2];
#pragma unroll
        for (int bj = 0; bj < 2; ++bj)
#pragma unroll
            for (int n = 0; n < 2; ++n) { cv[bj][n] = *(const f32x4*)(cs + col0 + bj * HALF + 4 * n); bv[bj][n] = *(const f32x4*)(b2 + col0 + bj * HALF + 4 * n); }
#pragma unroll
        for (int ai = 0; ai < 2; ++ai)
#pragma unroll
            for (int m = 0; m < 4; ++m) { const int row = row0 + ai * HALF + m * 16; float mean, rstd; row_stats(rs, row, mean, rstd);
                bf16_t* rowp = O + (size_t)row * ldc + col0;
#pragma unroll
                for (int bj = 0; bj < 2; ++bj) { const f32x4 v0 = (acc[ai][bj][m][0] - cv[bj][0] * mean) * rstd + bv[bj][0], v1 = (acc[ai][bj][m][1] - cv[bj][1] * mean) * rstd + bv[bj][1];
                    u32x4 w; w.x = cvt_pk_bf16(v0[0], v0[1]); w.y = cvt_pk_bf16(v0[2], v0[3]); w.z = cvt_pk_bf16(v1[0], v1[1]); w.w = cvt_pk_bf16(v1[2], v1[3]);
                    *(u32x4*)(rowp + bj * HALF) = w; } }
    }
};
__device__ __forceinline__ void row_sums_add(long long* rso, int row, const f32x4& a, const f32x4& b, const f32x4& c, const f32x4& d, int fq) {
    float s1 = ((a[0] + a[1]) + (a[2] + a[3])) + ((b[0] + b[1]) + (b[2] + b[3])) + ((c[0] + c[1]) + (c[2] + c[3])) + ((d[0] + d[1]) + (d[2] + d[3]));
    float s2 = ((a[0] * a[0] + a[1] * a[1]) + (a[2] * a[2] + a[3] * a[3])) + ((b[0] * b[0] + b[1] * b[1]) + (b[2] * b[2] + b[3] * b[3]))
             + ((c[0] * c[0] + c[1] * c[1]) + (c[2] * c[2] + c[3] * c[3])) + ((d[0] * d[0] + d[1] * d[1]) + (d[2] * d[2] + d[3] * d[3]));
    s1 += __shfl_xor(s1, 16); s1 += __shfl_xor(s1, 32); s2 += __shfl_xor(s2, 16); s2 += __shfl_xor(s2, 32);
    if (fq == 0) { atomicAdd((unsigned long long*)(rso + 2 * (size_t)row), (unsigned long long)f_to_fx20(s1)); atomicAdd((unsigned long long*)(rso + 2 * (size_t)row + 1), (unsigned long long)f_to_fx20(s2)); }
}
struct EpiRes0 {
    static constexpr bool PERM = true, AFTER_DRAIN = false;
    bf16_t* Y; const bf16_t* res; int ldc; float alpha; long long* rso;
    __device__ __forceinline__ void operator()(const f32x4 (&acc)[2][2][4][2], const Unit& u, int wr, int wc, int fr, int fq) const {
        const int row0 = u.pm * BM + wr * 64 + fr, col0 = u.pn * BM + wc * 32 + 8 * fq;
#pragma unroll
        for (int ai = 0; ai < 2; ++ai)
#pragma unroll
            for (int m = 0; m < 4; ++m) { const int row = row0 + ai * HALF + m * 16; const size_t off = (size_t)row * ldc + col0; f32x4 o[2][2];
#pragma unroll
                for (int bj = 0; bj < 2; ++bj) { const u32x4 r = *(const u32x4*)(res + off + bj * HALF);
                    f32x4 y0, y1;
                    y0[0] = __builtin_bit_cast(float, r.x << 16); y0[1] = __builtin_bit_cast(float, r.x & 0xffff0000u); y0[2] = __builtin_bit_cast(float, r.y << 16); y0[3] = __builtin_bit_cast(float, r.y & 0xffff0000u);
                    y1[0] = __builtin_bit_cast(float, r.z << 16); y1[1] = __builtin_bit_cast(float, r.z & 0xffff0000u); y1[2] = __builtin_bit_cast(float, r.w << 16); y1[3] = __builtin_bit_cast(float, r.w & 0xffff0000u);
                    o[bj][0] = y0 * alpha + acc[ai][bj][m][0]; o[bj][1] = y1 * alpha + acc[ai][bj][m][1];
                    u32x4 w; w.x = cvt_pk_bf16(o[bj][0][0], o[bj][0][1]); w.y = cvt_pk_bf16(o[bj][0][2], o[bj][0][3]); w.z = cvt_pk_bf16(o[bj][1][0], o[bj][1][1]); w.w = cvt_pk_bf16(o[bj][1][2], o[bj][1][3]);
                    *(u32x4*)(Y + off + bj * HALF) = w; }
                row_sums_add(rso, row, o[0][0], o[0][1], o[1][0], o[1][1], fq); }
    }
};
struct EpiResLn2 {
    static constexpr bool PERM = true, AFTER_DRAIN = false;
    bf16_t* Y; const long long* rsi; const float* g; const float* b; int ldc; float alpha; long long* rso;
    __device__ __forceinline__ void operator()(const f32x4 (&acc)[2][2][4][2], const Unit& u, int wr, int wc, int fr, int fq) const {
        const int row0 = u.pm * BM + wr * 64 + fr, col0 = u.pn * BM + wc * 32 + 8 * fq;
        f32x4 gv[2][2], bv[2][2];
#pragma unroll
        for (int bj = 0; bj < 2; ++bj)
#pragma unroll
            for (int n = 0; n < 2; ++n) { gv[bj][n] = *(const f32x4*)(g + col0 + bj * HALF + 4 * n) * alpha; bv[bj][n] = *(const f32x4*)(b + col0 + bj * HALF + 4 * n) * alpha; }
#pragma unroll
        for (int ai = 0; ai < 2; ++ai)
#pragma unroll
            for (int m = 0; m < 4; ++m) { const int row = row0 + ai * HALF + m * 16; const size_t off = (size_t)row * ldc + col0; float mean, rstd; row_stats(rsi, row, mean, rstd); f32x4 o[2][2];
#pragma unroll
                for (int bj = 0; bj < 2; ++bj) { const u32x4 r = *(const u32x4*)(Y + off + bj * HALF);
                    f32x4 y0, y1;
                    y0[0] = __builtin_bit_cast(float, r.x << 16); y0[1] = __builtin_bit_cast(float, r.x & 0xffff0000u); y0[2] = __builtin_bit_cast(float, r.y << 16); y0[3] = __builtin_bit_cast(float, r.y & 0xffff0000u);
                    y1[0] = __builtin_bit_cast(float, r.z << 16); y1[1] = __builtin_bit_cast(float, r.z & 0xffff0000u); y1[2] = __builtin_bit_cast(float, r.w << 16); y1[3] = __builtin_bit_cast(float, r.w & 0xffff0000u);
                    o[bj][0] = (y0 - mean) * rstd * gv[bj][0] + bv[bj][0] + acc[ai][bj][m][0]; o[bj][1] = (y1 - mean) * rstd * gv[bj][1] + bv[bj][1] + acc[ai][bj][m][1];
                    u32x4 w; w.x = cvt_pk_bf16(o[bj][0][0], o[bj][0][1]); w.y = cvt_pk_bf16(o[bj][0][2], o[bj][0][3]); w.z = cvt_pk_bf16(o[bj][1][0], o[bj][1][1]); w.w = cvt_pk_bf16(o[bj][1][2], o[bj][1][3]);
                    *(u32x4*)(Y + off + bj * HALF) = w; }
                row_sums_add(rso, row, o[0][0], o[0][1], o[1][0], o[1][1], fq); }
    }
};
template <class Epi, class Sched, bool ALIGN_EPI = false, bool SP2 = false>
__device__ __forceinline__ void gemm_phase(PG8_LAS unsigned char* lds, const Gemm g, const Sched& S, const Epi& E) {
    int tid_l = threadIdx.x; asm volatile("" : "+v"(tid_l)); const int tid = tid_l, wid = __builtin_amdgcn_readfirstlane(tid >> 6), lane = tid & 63, wr = wid >> 2, wc = wid & 3, fr = lane & 15, fq = lane >> 4;
    const int K = g.K, nt = K / BK;
    unsigned voffA[2], voffB[2];
#pragma unroll
    for (int i = 0; i < 2; ++i) { int R, C; stage_rc(tid * 16 + i * 8192, R, C); const int Rb = Epi::PERM ? ((R & ~31) + perm32(R & 31)) : R;
        voffA[i] = (unsigned)(R * K + C) * 2u; voffB[i] = (unsigned)(Rb * K + C) * 2u; }
    const size_t kstep = (size_t)(BK * 2);
    const size_t hstep = (size_t)HALF * K * 2;
    const size_t tstep = 2 * hstep;
    const unsigned ldsw = (unsigned)wid * 1024u;
    const int aoff = lds_byte(wr * 64 + fr, fq * 8), boff = lds_byte(wc * 32 + fr, fq * 8);
#define PG8_SA(b, h) (((b) * 2 + (h)) * HTB)
#define PG8_SB(b, h) ((4 + (b) * 2 + (h)) * HTB)
#define PG8_STAGE(bufoff, gbase, voff) do { _Pragma("unroll") for (int _i = 0; _i < 2; ++_i) \
        __builtin_amdgcn_global_load_lds((const unsigned*)((const char*)(gbase) + (voff)[_i]), (PG8_LAS unsigned*)(lds + (bufoff) + ldsw + _i * 8192), 16, 0, 0); } while (0)
#define PG8_LDA(dst, b, h) do { _Pragma("unroll") for (int m = 0; m < 4; ++m) _Pragma("unroll") for (int k = 0; k < 2; ++k) dst[m][k] = *(const PG8_LAS bf16x8*)(lds + PG8_SA(b, h) + aoff + m * 2048 + k * 1024); } while (0)
#define PG8_LDB(dst, b, h) do { _Pragma("unroll") for (int n = 0; n < 2; ++n) _Pragma("unroll") for (int k = 0; k < 2; ++k) dst[n][k] = *(const PG8_LAS bf16x8*)(lds + PG8_SB(b, h) + boff + n * 2048 + k * 1024); } while (0)
#define PG8_MMA(ai, bj, At, Bt) do { __builtin_amdgcn_s_setprio(1); _Pragma("unroll") for (int m = 0; m < 4; ++m) _Pragma("unroll") for (int n = 0; n < 2; ++n) _Pragma("unroll") for (int k = 0; k < 2; ++k) \
        acc[ai][bj][m][n] = __builtin_amdgcn_mfma_f32_16x16x32_bf16(Bt[n][k], At[m][k], acc[ai][bj][m][n], 0, 0, 0); __builtin_amdgcn_s_setprio(0); } while (0)
#define PG8_WAIT_V(n) asm volatile("s_waitcnt vmcnt(" #n ")" ::: "memory")
#define PG8_WAIT_L(n) asm volatile("s_waitcnt lgkmcnt(" #n ")" ::: "memory")
#define PG8_BAR __builtin_amdgcn_s_barrier()
#define PG8_SCHED __builtin_amdgcn_sched_barrier(0)
    Unit cur, nxt; int ui = 0;
    if (!S.next(0, cur)) return;
    f32x4 acc[2][2][4][2];
#pragma unroll
    for (int a = 0; a < 2; ++a)
#pragma unroll
        for (int b = 0; b < 2; ++b)
#pragma unroll
            for (int m = 0; m < 4; ++m)
#pragma unroll
                for (int n = 0; n < 2; ++n) acc[a][b][m][n] = (f32x4){0.f, 0.f, 0.f, 0.f};
    bf16x8 At[4][2], B0[2][2], B1[2][2];
    const char* cA = (const char*)g.A + (size_t)cur.pm * tstep; const char* cB = (const char*)g.Bt + (size_t)cur.pn * tstep;
    S.a_ready(cur);
    if constexpr (SP2) {
        PG8_STAGE(PG8_SB(0, 0), cB, voffB); PG8_STAGE(PG8_SB(0, 1), cB + hstep, voffB); PG8_STAGE(PG8_SA(0, 0), cA, voffA); PG8_STAGE(PG8_SA(0, 1), cA + hstep, voffA);
        if (wr == 1) PG8_BAR;
        PG8_WAIT_V(2); PG8_BAR;
        PG8_STAGE(PG8_SB(1, 0), cB + kstep, voffB); PG8_STAGE(PG8_SA(1, 0), cA + kstep, voffA); PG8_STAGE(PG8_SB(1, 1), cB + hstep + kstep, voffB);
        PG8_WAIT_V(6); PG8_BAR;
    } else {
        PG8_STAGE(PG8_SB(0, 0), cB, voffB); PG8_STAGE(PG8_SA(0, 0), cA, voffA); PG8_STAGE(PG8_SB(0, 1), cB + hstep, voffB); PG8_STAGE(PG8_SA(0, 1), cA + hstep, voffA);
        if (wr == 1) PG8_BAR;
        PG8_WAIT_V(4); PG8_BAR;
        PG8_STAGE(PG8_SB(1, 0), cB + kstep, voffB); PG8_STAGE(PG8_SA(1, 0), cA + kstep, voffA); PG8_STAGE(PG8_SB(1, 1), cB + hstep + kstep, voffB);
        PG8_WAIT_V(6); PG8_BAR;
    }
    for (;;) {
        const bool has_next = S.next(ui + 1, nxt);
        const char* nA = has_next ? (const char*)g.A + (size_t)nxt.pm * tstep : cA; const char* nB = has_next ? (const char*)g.Bt + (size_t)nxt.pn * tstep : cB;
        for (int t = 0; t < nt; t += 2) {
            const bool last = (t == nt - 2);
            const char* a1 = cA + (size_t)(t + 1) * kstep;
            const char* a2 = last ? nA : cA + (size_t)(t + 2) * kstep; const char* b2 = last ? nB : cB + (size_t)(t + 2) * kstep;
            const char* a3 = a2 + kstep; const char* b3 = b2 + kstep;
            if (last && has_next) S.a_ready(nxt);
            if constexpr (SP2) {
            PG8_LDB(B0, 0, 0); PG8_LDB(B1, 0, 1); PG8_SCHED; PG8_LDA(At, 0, 0); PG8_STAGE(PG8_SA(1, 1), a1 + hstep, voffA);
            PG8_WAIT_V(8); PG8_WAIT_L(0); PG8_BAR; PG8_MMA(0, 0, At, B0); PG8_MMA(0, 1, At, B1); PG8_BAR; PG8_SCHED;
            PG8_LDA(At, 0, 1); PG8_STAGE(PG8_SB(0, 0), b2, voffB); PG8_STAGE(PG8_SB(0, 1), b2 + hstep, voffB); PG8_STAGE(PG8_SA(0, 0), a2, voffA);
            PG8_WAIT_V(8); PG8_WAIT_L(0); PG8_BAR; PG8_MMA(1, 0, At, B0); PG8_MMA(1, 1, At, B1); PG8_BAR; PG8_SCHED;
            PG8_LDB(B0, 1, 0); PG8_LDB(B1, 1, 1); PG8_SCHED; PG8_LDA(At, 1, 0); PG8_STAGE(PG8_SA(0, 1), a2 + hstep, voffA);
            PG8_WAIT_V(8); PG8_WAIT_L(0); PG8_BAR; PG8_MMA(0, 0, At, B0); PG8_MMA(0, 1, At, B1); PG8_BAR; PG8_SCHED;
            PG8_LDA(At, 1, 1); PG8_STAGE(PG8_SB(1, 0), b3, voffB); PG8_STAGE(PG8_SB(1, 1), b3 + hstep, voffB); PG8_STAGE(PG8_SA(1, 0), a3, voffA);
            PG8_WAIT_V(8); PG8_WAIT_L(0); PG8_BAR; PG8_MMA(1, 0, At, B0); PG8_MMA(1, 1, At, B1); PG8_BAR; PG8_SCHED;
            } else {
            PG8_LDB(B0, 0, 0); PG8_SCHED; PG8_LDA(At, 0, 0); PG8_STAGE(PG8_SA(1, 1), a1 + hstep, voffA);
            PG8_WAIT_L(8); PG8_BAR; PG8_WAIT_L(0); PG8_MMA(0, 0, At, B0); PG8_BAR; PG8_SCHED;
            PG8_LDB(B1, 0, 1); PG8_STAGE(PG8_SB(0, 0), b2, voffB);
            PG8_BAR; PG8_WAIT_L(0); PG8_MMA(0, 1, At, B1); PG8_BAR;
            PG8_LDA(At, 0, 1); PG8_STAGE(PG8_SA(0, 0), a2, voffA);
            PG8_BAR; PG8_WAIT_L(0); PG8_MMA(1, 0, At, B0); PG8_BAR; PG8_SCHED;
            PG8_STAGE(PG8_SB(0, 1), b2 + hstep, voffB);
            PG8_WAIT_V(6); PG8_BAR; PG8_MMA(1, 1, At, B1); PG8_BAR;
            PG8_LDB(B0, 1, 0); PG8_SCHED; PG8_LDA(At, 1, 0); PG8_STAGE(PG8_SA(0, 1), a2 + hstep, voffA);
            PG8_WAIT_L(8); PG8_BAR; PG8_WAIT_L(0); PG8_MMA(0, 0, At, B0); PG8_BAR; PG8_SCHED;
            PG8_LDB(B1, 1, 1); PG8_STAGE(PG8_SB(1, 0), b3, voffB);
            PG8_BAR; PG8_WAIT_L(0); PG8_MMA(0, 1, At, B1); PG8_BAR;
            PG8_LDA(At, 1, 1); PG8_STAGE(PG8_SA(1, 0), a3, voffA);
            PG8_BAR; PG8_WAIT_L(0); PG8_MMA(1, 0, At, B0); PG8_BAR; PG8_SCHED;
            PG8_STAGE(PG8_SB(1, 1), b3 + hstep, voffB);
            PG8_WAIT_V(6); PG8_BAR; PG8_MMA(1, 1, At, B1); PG8_BAR;
            }
        }
        if constexpr (ALIGN_EPI) { if (wr == 0) PG8_BAR; }
        if constexpr (!Epi::AFTER_DRAIN) { E(acc, cur, wr, wc, fr, fq); S.done(cur); }
        if (!has_next) break;
#pragma unroll
        for (int a = 0; a < 2; ++a)
#pragma unroll
            for (int b = 0; b < 2; ++b)
#pragma unroll
                for (int m = 0; m < 4; ++m)
#pragma unroll
                    for (int n = 0; n < 2; ++n) acc[a][b][m][n] = (f32x4){0.f, 0.f, 0.f, 0.f};
        cur = nxt; cA = nA; cB = nB; ++ui;
        if constexpr (ALIGN_EPI) { if (wr == 1) PG8_BAR; }
    }
    PG8_WAIT_V(0);
    if constexpr (!ALIGN_EPI) { if (wr == 0) PG8_BAR; }
    PG8_BAR;
    if constexpr (Epi::AFTER_DRAIN) { E.fused(acc, cur, wr, wc, fr, fq, lds, wid, lane); S.done(cur); }
#undef PG8_SA
#undef PG8_SB
#undef PG8_STAGE
#undef PG8_LDA
#undef PG8_LDB
#undef PG8_MMA
#undef PG8_WAIT_V
#undef PG8_WAIT_L
#undef PG8_BAR
#undef PG8_SCHED
}
}

#ifndef PG8_SP2
#define PG8_SP2 true
#endif
#ifndef PG8_ALIGN
#define PG8_ALIGN true
#endif
constexpr int NWAVES = 8, NTHR = 512;
constexpr int BATCH = 2, SEQ = 8192, DM = 4096, MTOK = BATCH * SEQ;
constexpr int HD = 128;
constexpr int A_HEADS = 16, B_HEADS = 16, A_W = 2048, B_W = 2048, AB_IN = 4 * A_W + 3 * B_W;
constexpr int NSA_H = 32, NSA_G = 4, NSA_R = 8, KVW = 512, NSA_IN = 4096 + 6 * KVW + 96, NSA_INP = 7424;
constexpr int NCMP = 511, NCMPP = 512, NSLC = 128, NTOP = 16, WINDOW = 512;
constexpr int NMEM = 256, XH = 4, XW = 512;
constexpr int DFF = 11008, DFF2 = 22016;
constexpr float LN_EPS = 1e-5f, RMS_EPS = 1e-6f;
constexpr float DN_ALPHA = 1.41421356237309515f;
constexpr size_t MiB = (size_t)1 << 20;
constexpr size_t WS_CTL = 0, CTL_ZERO_BYTES = 4 * MiB;
constexpr size_t WS_FOLD = 64 * 1024;
constexpr int FO_XQ = 0, FO_UP = 2 * 512, FO_NSA = FO_UP + 2 * 22016, FO_N = FO_NSA + 7424;
constexpr size_t WS_RSUM = 1 * MiB;
static_assert(WS_FOLD + (size_t)2 * FO_N * 8 <= WS_RSUM && WS_RSUM + (size_t)6 * 16384 * 2 * 8 <= CTL_ZERO_BYTES, "CTL map");
constexpr size_t WS_W_ABIN = 4 * MiB;
constexpr size_t WS_W_ABOUT = WS_W_ABIN + 112 * MiB;
constexpr size_t WS_W_NSAIN = WS_W_ABOUT + 32 * MiB;
constexpr size_t WS_W_NSAOUT = WS_W_NSAIN + 58 * MiB;
constexpr size_t WS_W_XQ = WS_W_NSAOUT + 32 * MiB;
constexpr size_t WS_W_XKV = WS_W_XQ + 8 * MiB;
constexpr size_t WS_W_XO = WS_W_XKV + 16 * MiB;
constexpr size_t WS_W_UP = WS_W_XO + 8 * MiB;
constexpr size_t WS_W_DOWN = WS_W_UP + 344 * MiB;
constexpr size_t WS_W_C1 = WS_W_DOWN + 172 * MiB;
constexpr size_t WS_W_C2 = WS_W_C1 + 2 * MiB;
constexpr size_t WS_MEMB = WS_W_C2 + 1 * MiB;
constexpr size_t WS_HB = WS_MEMB + 4 * MiB;
constexpr size_t WS_Y = WS_HB + 128 * MiB;
constexpr size_t WS_BIG = WS_Y + 256 * MiB;
constexpr size_t WS_G = WS_BIG + 688 * MiB;
constexpr size_t WS_O = WS_G + 344 * MiB;
constexpr size_t WS_MISC = WS_O + 128 * MiB;
constexpr size_t WS_END = WS_MISC + 64 * MiB;
constexpr size_t WS_XQ = WS_MISC;
constexpr size_t WS_XO = WS_MISC + 16 * MiB;
constexpr size_t WS_XKV = WS_MISC + 32 * MiB;
constexpr size_t WS_LB = WS_MISC + 34 * MiB;
constexpr size_t WS_FOLDF = WS_MISC + 40 * MiB;
constexpr size_t WS_ROPE = WS_MISC + 36 * MiB;
constexpr size_t WS_STATS = WS_MISC + 35 * MiB;
constexpr size_t WS_PROJ0 = WS_BIG;
constexpr size_t WS_SPREV = WS_BIG + 448 * MiB;
constexpr size_t WS_QT = WS_G;
constexpr size_t WS_OINTRA = WS_G + 64 * MiB;
constexpr size_t WS_DEC = WS_G + 192 * MiB;
constexpr size_t WS_DS = WS_Y;
constexpr size_t WS_PROJ1 = WS_BIG;
constexpr size_t WS_QROT = WS_BIG + 232 * MiB;
constexpr size_t WS_KSROT = WS_BIG + 360 * MiB;
constexpr size_t WS_KWROT = WS_BIG + 376 * MiB;
constexpr size_t WS_KCMP = WS_BIG + 392 * MiB;
constexpr size_t WS_VCMP = WS_BIG + 393 * MiB;
constexpr size_t WS_OVL = WS_BIG + 394 * MiB;
constexpr size_t WS_SEL = WS_BIG + 395 * MiB;
constexpr size_t WS_IMP = WS_G + 256 * MiB;
constexpr size_t WS_O32 = WS_G;
static_assert(WS_SPREV + 128 * MiB <= WS_G && WS_DEC + 2 * MiB <= WS_O && WS_SEL + MiB <= WS_G, "ws map");
constexpr int CW_TMO = 0, CW_CODE = 1;
constexpr int CW_BAR = 4096;
constexpr int RING_OFF = 0, RING_BYTES = 131072;
constexpr int LDSCTL_OFF = RING_BYTES, MISC_OFF = LDSCTL_OFF + 320;
constexpr int LDS_BYTES = 147456;
static_assert(MISC_OFF + 128 <= LDS_BYTES, "LDS map");

#define GAS __attribute__((address_space(1)))
#define LAS __attribute__((address_space(3)))
typedef unsigned short bf16;
typedef unsigned v4u __attribute__((ext_vector_type(4)));
typedef unsigned v2u __attribute__((ext_vector_type(2)));
typedef float f32x4 __attribute__((ext_vector_type(4)));
typedef float f32x2 __attribute__((ext_vector_type(2)));
typedef float f32x16 __attribute__((ext_vector_type(16)));
typedef short bf16x8 __attribute__((ext_vector_type(8)));
typedef short s16x4 __attribute__((ext_vector_type(4)));
typedef GAS unsigned gu32;
#define RLX_AGENT __ATOMIC_RELAXED, __HIP_MEMORY_SCOPE_AGENT
#define LDS_WAIT() asm volatile("s_waitcnt lgkmcnt(0)" ::: "memory")
#define VM_WAIT() asm volatile("s_waitcnt vmcnt(0)" ::: "memory")
#define SBAR() __builtin_amdgcn_sched_barrier(0)
__device__ __forceinline__ unsigned f2bf(float f) { unsigned u = __builtin_bit_cast(unsigned, f); return (u + 0x7fffu + ((u >> 16) & 1u)) >> 16; }
__device__ __forceinline__ unsigned pk2(float lo, float hi) { return f2bf(lo) | (f2bf(hi) << 16); }
__device__ __forceinline__ float bf2f(unsigned short b) { return __builtin_bit_cast(float, (unsigned)b << 16); }
__device__ __forceinline__ float bflo(unsigned w) { return __builtin_bit_cast(float, w << 16); }
__device__ __forceinline__ float bfhi(unsigned w) { return __builtin_bit_cast(float, w & 0xffff0000u); }
__device__ __forceinline__ unsigned cvtpk(float lo, float hi) { unsigned r; asm volatile("v_cvt_pk_bf16_f32 %0, %1, %2" : "=v"(r) : "v"(lo), "v"(hi)); return r; }
__device__ __forceinline__ float wave_sum(float v) {
#pragma unroll
    for (int o = 1; o < 64; o <<= 1) v += __shfl_xor(v, o);
    return v;
}
__device__ __forceinline__ float sigmoidf_(float x) { return __builtin_amdgcn_rcpf(1.f + __builtin_amdgcn_exp2f(-1.4426950408889634f * x)); }
__device__ __forceinline__ float gelu1(float v) { pg8::f32x2 r = pg8::gelu_pk((pg8::f32x2){v, 0.f}); return r.x; }
#define XB_TMO      128
#define XB_XCNT(j)  (256  + 64 * (j))
#define XB_XSUB(j)  (1280 + 64 * (j))
#define XB_XGEN(j)  (2304 + 64 * (j))
#define XB_TOP      3328
#define XB_TOPGEN   3392
#define XCD_BAR_WORDS 3456
#define XB_SPIN_CAP (1u << 18)
#define LAS __attribute__((address_space(3)))

__device__ __forceinline__ unsigned xb_ld(unsigned* p)              { return __hip_atomic_load(p, __ATOMIC_RELAXED, __HIP_MEMORY_SCOPE_AGENT); }
__device__ __forceinline__ unsigned xb_add(unsigned* p, unsigned v) { return __hip_atomic_fetch_add(p, v, __ATOMIC_RELAXED, __HIP_MEMORY_SCOPE_AGENT); }
__device__ __forceinline__ unsigned xb_xcc_id() { return (unsigned)__builtin_amdgcn_s_getreg((3 << 11) | 20) & 0xFu; }
#define XB_SPIN(cond, bar) do { unsigned _sp = 0; while (cond) { __builtin_amdgcn_s_sleep(1); \
    if ((++_sp & 255u) == 0u) { if (xb_ld(&(bar)[XB_TMO])) break; if (_sp > XB_SPIN_CAP) { atomicAdd(&(bar)[XB_TMO], 1u); break; } } } } while (0)

struct XcdBarrier {
    unsigned* bar; unsigned x;
    volatile LAS unsigned* st;
};

__device__ __forceinline__ XcdBarrier xcd_barrier_post(unsigned* bar, volatile LAS unsigned* st) {
    XcdBarrier b; b.bar = bar; b.x = xb_xcc_id(); b.st = st;
    if (threadIdx.x == 0) (void)xb_add(&bar[XB_XCNT(b.x)], 1u);
    return b;
}
__device__ __forceinline__ void xcd_barrier_complete(unsigned* bar, unsigned x, unsigned& nloc, unsigned& nx) {
    const unsigned G = gridDim.x * gridDim.y * gridDim.z;
    unsigned sum, cnt, mine, sp = 0u;
    for (;;) {
        sum = 0u; cnt = 0u; mine = 0u;
#pragma unroll
        for (unsigned j = 0; j < 16; ++j) { const unsigned c = xb_ld(&bar[XB_XCNT(j)]); sum += c; cnt += (c > 0u) ? 1u : 0u; mine = (j == x) ? c : mine; }
        if (sum == G) break;
        __builtin_amdgcn_s_sleep(1);
        if ((++sp & 255u) == 0u) { if (xb_ld(&bar[XB_TMO])) break; if (sp > XB_SPIN_CAP) { atomicAdd(&bar[XB_TMO], 1u); break; } }
    }
    nloc = mine > 0u ? mine : 1u; nx = cnt > 0u ? cnt : 1u;
}

__device__ __forceinline__ void xcd_barrier(const XcdBarrier& b) {
    asm volatile("s_waitcnt vmcnt(0)" ::: "memory");
    __syncthreads();
    if (threadIdx.x == 0) {
        unsigned* bar = b.bar;
        __builtin_amdgcn_s_waitcnt(0);
        unsigned nloc = b.st[0], nx = b.st[1];
        if (nloc == 0u) { xcd_barrier_complete(bar, b.x, nloc, nx); b.st[0] = nloc; b.st[1] = nx; }
        const unsigned old = xb_add(&bar[XB_XSUB(b.x)], 1u);
        const unsigned gen = old / nloc;
        if (old + 1u == (gen + 1u) * nloc) {
            __builtin_amdgcn_fence(__ATOMIC_RELEASE, "agent");
            asm volatile("s_waitcnt vmcnt(0)" ::: "memory");
            const unsigned og = xb_add(&bar[XB_TOP], 1u);
            const unsigned tg = og / nx;
            if (og + 1u == (tg + 1u) * nx) xb_add(&bar[XB_TOPGEN], 1u);
            else XB_SPIN(xb_ld(&bar[XB_TOPGEN]) == tg, bar);
            __builtin_amdgcn_fence(__ATOMIC_ACQUIRE, "agent");
            xb_add(&bar[XB_XGEN(b.x)], 1u);
            asm volatile("s_waitcnt vmcnt(0)" ::: "memory");
        } else {
            XB_SPIN(xb_ld(&bar[XB_XGEN(b.x)]) == gen, bar);
            __builtin_amdgcn_fence(__ATOMIC_ACQUIRE, "agent");
            asm volatile("s_waitcnt vmcnt(0)" ::: "memory");
        }
    }
    __syncthreads();
}


constexpr int ATT_D = 128, KVBLK = 64;
constexpr int SHM_V = KVBLK * ATT_D * 2, SHM_K = KVBLK * ATT_D * 2;
constexpr int ATT_K_OFF = 0, ATT_V_OFF = SHM_K, ATT_BUF = SHM_K + SHM_V, ATT_SET = 2 * ATT_BUF;
constexpr int ATT_WS_OFF = RING_BYTES + 512;
constexpr int ATT_X_OFF = ATT_WS_OFF + NWAVES * 256;
static_assert(2 * ATT_SET <= RING_BYTES && ATT_X_OFF + 1024 <= LDS_BYTES, "attention LDS map");
#define KSWZ(row, colB) ((row) * 256 + ((colB) ^ (((row) & 7) << 4)))
__device__ __forceinline__ int crow(int r, int hi) { return (r & 3) + 8 * (r >> 2) + 4 * hi; }
__device__ __forceinline__ int v_st(int k, int c) { const int kk = (k & ~0xC) | ((k & 4) << 1) | ((k & 8) >> 1); return ((kk >> 3) * 4 + (c >> 5)) * 512 + ((kk & 7) * 32 + (c & 31)) * 2; }
__device__ __forceinline__ int v_rd_base(int lane) { return ((lane & 3) << 3) | (((lane >> 2) & 3) << 6) | (((lane >> 4) & 1) << 5) | (((lane >> 5) & 1) << 8); }
constexpr int v_rd_off(int d0, int ks, int half) { return d0 * 512 + ks * 4096 + half * 2048; }
template <int OFF> __device__ __forceinline__ s16x4 tr_read(int vb) {
  s16x4 r; asm volatile("ds_read_b64_tr_b16 %0, %1 offset:%2" : "=&v"(r) : "v"(vb), "i"(OFF) : "memory"); return r;
}
__device__ __forceinline__ void qkt(f32x16& p0, f32x16& p1, const LAS char* Ks, const bf16x8* qr, int r32, int hi) {
  p0 = f32x16{}; p1 = f32x16{};
#pragma unroll
  for (int d0 = 0; d0 < 8; ++d0) { const int cb = (d0 * 16 + hi * 8) * 2;
    const bf16x8 b0 = *(const LAS bf16x8*)(Ks + KSWZ(r32, cb));
    const bf16x8 b1 = *(const LAS bf16x8*)(Ks + KSWZ(32 + r32, cb));
    p0 = __builtin_amdgcn_mfma_f32_32x32x16_bf16(b0, qr[d0], p0, 0, 0, 0);
    p1 = __builtin_amdgcn_mfma_f32_32x32x16_bf16(b1, qr[d0], p1, 0, 0, 0); }
}
__device__ __forceinline__ void pack_p(const f32x16& p0, const f32x16& p1, bf16x8& pa0, bf16x8& pa1, bf16x8& pa2, bf16x8& pa3) {
#define PK4(P, BASE, OUT) do { unsigned a0 = cvtpk(P[BASE + 0], P[BASE + 1]), a1 = cvtpk(P[BASE + 2], P[BASE + 3]);   \
    unsigned b0 = cvtpk(P[BASE + 4], P[BASE + 5]), b1 = cvtpk(P[BASE + 6], P[BASE + 7]);                              \
    auto r0 = __builtin_amdgcn_permlane32_swap(a0, b0, false, false); auto r1 = __builtin_amdgcn_permlane32_swap(a1, b1, false, false); \
    v4u w = {r0[0], r1[0], r0[1], r1[1]}; OUT = __builtin_bit_cast(bf16x8, w); } while (0)
  PK4(p0, 0, pa0); PK4(p0, 8, pa1); PK4(p1, 0, pa2); PK4(p1, 8, pa3);
#undef PK4
}
template <int D0> __device__ __forceinline__ void pv_one(f32x16& od, int vb, bf16x8 pa0, bf16x8 pa1, bf16x8 pa2, bf16x8 pa3) {
  const s16x4 l0 = tr_read<v_rd_off(D0, 0, 0)>(vb), h0 = tr_read<v_rd_off(D0, 0, 1)>(vb), l1 = tr_read<v_rd_off(D0, 1, 0)>(vb), h1 = tr_read<v_rd_off(D0, 1, 1)>(vb);
  const s16x4 l2 = tr_read<v_rd_off(D0, 2, 0)>(vb), h2 = tr_read<v_rd_off(D0, 2, 1)>(vb), l3 = tr_read<v_rd_off(D0, 3, 0)>(vb), h3 = tr_read<v_rd_off(D0, 3, 1)>(vb);
  asm volatile("s_waitcnt lgkmcnt(0)" ::: "memory"); SBAR();
#define PKV(L, H) (bf16x8){L[0], L[1], L[2], L[3], H[0], H[1], H[2], H[3]}
  od = __builtin_amdgcn_mfma_f32_32x32x16_bf16(pa0, PKV(l0, h0), od, 0, 0, 0);
  od = __builtin_amdgcn_mfma_f32_32x32x16_bf16(pa1, PKV(l1, h1), od, 0, 0, 0);
  od = __builtin_amdgcn_mfma_f32_32x32x16_bf16(pa2, PKV(l2, h2), od, 0, 0, 0);
  od = __builtin_amdgcn_mfma_f32_32x32x16_bf16(pa3, PKV(l3, h3), od, 0, 0, 0);
#undef PKV
}
__device__ __forceinline__ void pv_d0(f32x16* o, int vb, bf16x8 pa0, bf16x8 pa1, bf16x8 pa2, bf16x8 pa3) {
  pv_one<0>(o[0], vb, pa0, pa1, pa2, pa3); pv_one<1>(o[1], vb, pa0, pa1, pa2, pa3); pv_one<2>(o[2], vb, pa0, pa1, pa2, pa3); pv_one<3>(o[3], vb, pa0, pa1, pa2, pa3);
}
struct KVStage { bf16x8 ks0, ks1, vs0, vs1; };
__device__ __forceinline__ void kv_load(KVStage& s, const bf16* Kh, const bf16* Vh, long ldk, long ldv, int k0, int sr, int sc) {
  s.ks0 = *(const bf16x8*)(Kh + (long)(k0 + sr) * ldk + sc); s.ks1 = *(const bf16x8*)(Kh + (long)(k0 + 32 + sr) * ldk + sc);
  s.vs0 = *(const bf16x8*)(Vh + (long)(k0 + sr) * ldv + sc); s.vs1 = *(const bf16x8*)(Vh + (long)(k0 + 32 + sr) * ldv + sc);
}
__device__ __forceinline__ void kv_write(const KVStage& s, LAS char* lds, int sr, int sc) {
  *(LAS bf16x8*)(lds + ATT_V_OFF + v_st(sr, sc)) = s.vs0; *(LAS bf16x8*)(lds + ATT_V_OFF + v_st(32 + sr, sc)) = s.vs1;
  *(LAS bf16x8*)(lds + ATT_K_OFF + KSWZ(sr, sc * 2)) = s.ks0; *(LAS bf16x8*)(lds + ATT_K_OFF + KSWZ(32 + sr, sc * 2)) = s.ks1;
}
struct KVDma { int ko[2], vo[2]; };
__device__ __forceinline__ void kv_dma_init(KVDma& d, int ldk, int ldv, int wid, int lane) {
#pragma unroll
  for (int i = 0; i < 2; ++i) { const int p = wid * 2 + i;
    const int row = p * 4 + (lane >> 4), cp = lane & 15; d.ko[i] = row * ldk + ((cp ^ (row & 7)) << 3);
    const int sub = p * 2 + (lane >> 5), kk = (sub >> 2) * 8 + ((lane & 31) >> 2), k = (kk & ~0xC) | ((kk & 4) << 1) | ((kk & 8) >> 1), c = (sub & 3) * 32 + (lane & 3) * 8;
    d.vo[i] = k * ldv + c; }
}
__device__ __forceinline__ void kv_dma(const KVDma& d, const bf16* Kt, const bf16* Vt, LAS char* lds, int buf, int wid) {
#pragma unroll
  for (int i = 0; i < 2; ++i) {
    __builtin_amdgcn_global_load_lds((const unsigned*)(Kt + d.ko[i]), (LAS unsigned*)(lds + buf + ATT_K_OFF + (wid * 2 + i) * 1024), 16, 0, 0);
    __builtin_amdgcn_global_load_lds((const unsigned*)(Vt + d.vo[i]), (LAS unsigned*)(lds + buf + ATT_V_OFF + (wid * 2 + i) * 1024), 16, 0, 0); }
}
__device__ __forceinline__ void rescale_o(f32x16* o, float a, LAS float* al_l, int r32, int hi) {
  if (__any(a < 1.f)) { if (hi == 0) al_l[r32] = a; LDS_WAIT();
#pragma unroll
    for (int r = 0; r < 16; ++r) { const float f = al_l[crow(r, hi)];
#pragma unroll
      for (int d = 0; d < 4; ++d) o[d][r] *= f; }
    LDS_WAIT(); }
}
constexpr float ATT_SCALE = 0.088388347648318440f, ATT_C = ATT_SCALE * 1.4426950408889634f, ATT_THR = 8.f;
__device__ __forceinline__ void softmax_tile(f32x16& p0, f32x16& p1, float& m_reg, float& l_reg, float& alpha) {
  float pmax = p0[0];
#pragma unroll
  for (int r = 1; r < 16; ++r) pmax = fmaxf(pmax, p0[r]);
#pragma unroll
  for (int r = 0; r < 16; ++r) pmax = fmaxf(pmax, p1[r]);
  { auto rr = __builtin_amdgcn_permlane32_swap(__float_as_uint(pmax), __float_as_uint(pmax), false, false);
    pmax = fmaxf(__uint_as_float(rr[0]), __uint_as_float(rr[1])); }
  float mn;
  if (__all(pmax - m_reg <= ATT_THR / ATT_SCALE)) { mn = m_reg; alpha = 1.f; }
  else { mn = fmaxf(m_reg, pmax); alpha = __builtin_amdgcn_exp2f((m_reg - mn) * ATT_C); m_reg = mn; }
  const float mnC = -mn * ATT_C;
#pragma unroll
  for (int r = 0; r < 16; ++r) { p0[r] = __builtin_amdgcn_exp2f(fmaf(p0[r], ATT_C, mnC)); p1[r] = __builtin_amdgcn_exp2f(fmaf(p1[r], ATT_C, mnC)); }
  float ps = 0.f;
#pragma unroll
  for (int r = 0; r < 16; ++r) ps += p0[r] + p1[r];
  { auto rr = __builtin_amdgcn_permlane32_swap(__float_as_uint(ps), __float_as_uint(ps), false, false);
    ps = __uint_as_float(rr[0]) + __uint_as_float(rr[1]); }
  l_reg = l_reg * alpha + ps;
}
__device__ __forceinline__ void attn_finish(f32x16& p0, f32x16& p1, f32x16* o, float& m_reg, float& l_reg, LAS float* wsc, int vb, int r32, int hi) {
  float alpha; softmax_tile(p0, p1, m_reg, l_reg, alpha);
  rescale_o(o, alpha, wsc, r32, hi);
  bf16x8 pa0, pa1, pa2, pa3; pack_p(p0, p1, pa0, pa1, pa2, pa3);
  pv_d0(o, vb, pa0, pa1, pa2, pa3);
}
__device__ __forceinline__ void load_q(bf16x8* qr, const bf16* Qw) {
#pragma unroll
  for (int d0 = 0; d0 < 8; ++d0) qr[d0] = *(const bf16x8*)(Qw + d0 * 16);
}

struct Frame {
    LAS unsigned char* lds;
    unsigned char* ws;
    int tid, lane, wave, G, bid;
    __device__ __forceinline__ void fresh() { int t = threadIdx.x; asm volatile("" : "+v"(t)); tid = t; lane = t & 63; wave = __builtin_amdgcn_readfirstlane(t >> 6);
        int g_ = gridDim.x, b_ = blockIdx.x; asm volatile("" : "+s"(g_), "+s"(b_)); G = g_; bid = b_; }
};
struct Args { const float* in[19]; float* out; unsigned char* ws; int ph_lo, ph_hi; };
enum { IN_X = 0, IN_MEM, IN_AB_W_IN, IN_HGRN_LB, IN_HGRN_NW, IN_AB_W_OUT, IN_NSA_W_IN, IN_NSA_CMP_POS, IN_NSA_CMP_W1, IN_NSA_CMP_W2, IN_NSA_W_OUT,
       IN_XA_WQ, IN_XA_WKV, IN_XA_WO, IN_FFN_UP, IN_FFN_CONV, IN_FFN_DOWN, IN_LN_G, IN_LN_B };

__device__ __forceinline__ void p0_transpose_item(const float* W, int K, int N, bf16* WT, LAS float* scr, int item, int lane) {
    const int nblk = N / 32, kb = item / nblk, nb = item % nblk, k0 = 64 * kb, n0 = 32 * nb;
#pragma unroll 8
    for (int i = 0; i < 32; ++i) { const int kk = 2 * i + (lane >> 5); scr[kk * 33 + (lane & 31)] = W[(size_t)(k0 + kk) * N + n0 + (lane & 31)]; }
    LDS_WAIT(); asm volatile("" ::: "memory");
    const int c = lane & 7;
#pragma unroll
    for (int j = 0; j < 4; ++j) { const int n = (lane >> 3) + 8 * j; const LAS float* s = scr + (8 * c) * 33 + n;
        v4u o; o.x = pk2(s[0 * 33], s[1 * 33]); o.y = pk2(s[2 * 33], s[3 * 33]); o.z = pk2(s[4 * 33], s[5 * 33]); o.w = pk2(s[6 * 33], s[7 * 33]);
        *(GAS v4u*)(WT + (size_t)(n0 + n) * K + k0 + 8 * c) = o; }
    LDS_WAIT(); asm volatile("" ::: "memory");
}
__device__ __forceinline__ void p0_transpose_item_fold(const float* W, int K, int N, bf16* WT, LAS float* scr, int item, int lane, const float* g, const float* b, long long* cs, long long* b2) {
    const int nblk = N / 32, kb = item / nblk, nb = item % nblk, k0 = 64 * kb, n0 = 32 * nb;
#pragma unroll 8
    for (int i = 0; i < 32; ++i) { const int kk = 2 * i + (lane >> 5); scr[kk * 33 + (lane & 31)] = W[(size_t)(k0 + kk) * N + n0 + (lane & 31)]; }
    LDS_WAIT(); asm volatile("" ::: "memory");
    const int c = lane & 7;
    const f32x4 g0 = *(const f32x4*)(g + k0 + 8 * c), g1 = *(const f32x4*)(g + k0 + 8 * c + 4), b0 = *(const f32x4*)(b + k0 + 8 * c), b1 = *(const f32x4*)(b + k0 + 8 * c + 4);
    const float gg[8] = {g0.x, g0.y, g0.z, g0.w, g1.x, g1.y, g1.z, g1.w}, bb[8] = {b0.x, b0.y, b0.z, b0.w, b1.x, b1.y, b1.z, b1.w};
#pragma unroll
    for (int j = 0; j < 4; ++j) { const int n = (lane >> 3) + 8 * j; const LAS float* s = scr + (8 * c) * 33 + n;
        float sc = 0.f, sb = 0.f; unsigned w[4];
#pragma unroll
        for (int q = 0; q < 4; ++q) { const float x0 = s[(2 * q) * 33], x1 = s[(2 * q + 1) * 33]; const unsigned r0 = f2bf(x0 * gg[2 * q]), r1 = f2bf(x1 * gg[2 * q + 1]);
            w[q] = r0 | (r1 << 16); sc += bf2f((unsigned short)r0) + bf2f((unsigned short)r1); sb += x0 * bb[2 * q] + x1 * bb[2 * q + 1]; }
        *(GAS v4u*)(WT + (size_t)(n0 + n) * K + k0 + 8 * c) = (v4u){w[0], w[1], w[2], w[3]};
        sc += __shfl_xor(sc, 1); sc += __shfl_xor(sc, 2); sc += __shfl_xor(sc, 4); sb += __shfl_xor(sb, 1); sb += __shfl_xor(sb, 2); sb += __shfl_xor(sb, 4);
        if (c == 0) { atomicAdd((unsigned long long*)(cs + n0 + n), (unsigned long long)(long long)rintf(sc * pg8::FOLD_SCALE)); atomicAdd((unsigned long long*)(b2 + n0 + n), (unsigned long long)(long long)rintf(sb * pg8::FOLD_SCALE)); } }
    LDS_WAIT(); asm volatile("" ::: "memory");
}
__device__ __forceinline__ void transpose_mat_fold(Frame& F, const float* W, int K, int N, bf16* WT, const float* g, const float* b, long long* cs, long long* b2, int c0 = 0, int nw = 1 << 30, int part = 0, int nparts = 1) {
    if (F.bid < c0 || F.bid >= c0 + nw) return;
    LAS float* scr = (LAS float*)(F.lds + RING_OFF + F.wave * 16384);
    const int nwg = nw < F.G ? nw : F.G, gw = (F.bid - c0) * NWAVES + F.wave, NGW = nwg * NWAVES;
    const int nitems = (K / 64) * (N / 32), ilo = (int)((long)nitems * part / nparts), ihi = (int)((long)nitems * (part + 1) / nparts);
    for (int it = ilo + gw; it < ihi; it += NGW) p0_transpose_item_fold(W, K, N, WT, scr, it, F.lane, g, b, cs, b2);
}
__device__ __forceinline__ void transpose_mat(Frame& F, const float* W, int K, int N, bf16* WT, int c0 = 0, int nw = 1 << 30) {
    if (F.bid < c0 || F.bid >= c0 + nw) return;
    LAS float* scr = (LAS float*)(F.lds + RING_OFF + F.wave * 16384);
    const int nwg = nw < F.G ? nw : F.G, gw = (F.bid - c0) * NWAVES + F.wave, NGW = nwg * NWAVES;
    const int nitems = (K / 64) * (N / 32);
    for (int it = gw; it < nitems; it += NGW) p0_transpose_item(W, K, N, WT, scr, it, F.lane);
}
__device__ __forceinline__ void fold_finalize(Frame& F, int lo, int n) {
    const long long* fs = (const long long*)(F.ws + WS_FOLD); float* fd = (float*)(F.ws + WS_FOLDF);
    for (int i = F.bid * NTHR + F.tid; i < 2 * n; i += F.G * NTHR) { const int j = (i < n) ? lo + i : FO_N + lo + (i - n); const long long v = fs[j]; fd[j] = (float)(int)(v >> 32) + (float)(unsigned)v * pg8::FOLD_INV; }
}
enum { CJ_DOWN0, CJ_NSA, CJ_L1A, CJ_L1B, CJ_DOWN1 };
template <int JOB>
__device__ __forceinline__ void convert_job(Frame& F, const Args& A, int c0, int nw) {
    unsigned char* ws = F.ws; long long* cs = (long long*)(ws + WS_FOLD); long long* b2 = cs + FO_N;
    if (JOB == CJ_DOWN0 || JOB == CJ_DOWN1) { const int l = JOB == CJ_DOWN1; transpose_mat(F, A.in[IN_FFN_DOWN] + (size_t)l * DFF * DM, DFF, DM, (bf16*)(ws + WS_W_DOWN) + (size_t)l * DM * DFF, c0, nw); }
    if (JOB == CJ_NSA) {
        transpose_mat_fold(F, A.in[IN_NSA_W_IN], DM, NSA_IN, (bf16*)(ws + WS_W_NSAIN), A.in[IN_LN_G] + 2 * DM, A.in[IN_LN_B] + 2 * DM, cs + FO_NSA, b2 + FO_NSA, c0, nw);
        transpose_mat(F, A.in[IN_NSA_W_OUT], DM, DM, (bf16*)(ws + WS_W_NSAOUT), c0, nw); }
    if (JOB == CJ_L1A || JOB == CJ_L1B) { const int l = 1;
        if (JOB == CJ_L1A) {
            transpose_mat_fold(F, A.in[IN_XA_WQ] + (size_t)l * DM * XW, DM, XW, (bf16*)(ws + WS_W_XQ) + (size_t)l * XW * DM, A.in[IN_LN_G] + (size_t)(3 * l) * DM, A.in[IN_LN_B] + (size_t)(3 * l) * DM, cs + FO_XQ + l * XW, b2 + FO_XQ + l * XW, c0, nw);
            transpose_mat(F, A.in[IN_XA_WKV] + (size_t)l * DM * 2 * XW, DM, 2 * XW, (bf16*)(ws + WS_W_XKV) + (size_t)l * 2 * XW * DM, c0, nw);
            transpose_mat(F, A.in[IN_XA_WO] + (size_t)l * XW * DM, XW, DM, (bf16*)(ws + WS_W_XO) + (size_t)l * DM * XW, c0, nw); }
        transpose_mat_fold(F, A.in[IN_FFN_UP] + (size_t)l * DM * DFF2, DM, DFF2, (bf16*)(ws + WS_W_UP) + (size_t)l * DFF2 * DM, A.in[IN_LN_G] + (size_t)(3 * l + 1) * DM, A.in[IN_LN_B] + (size_t)(3 * l + 1) * DM,
                           cs + FO_UP + l * DFF2, b2 + FO_UP + l * DFF2, c0, nw, JOB == CJ_L1A ? 0 : 1, 2); }
}
__device__ __forceinline__ void cvt_flat(Frame& F, const float* src, bf16* dst, long n8) {
    for (long i = (long)F.bid * NTHR + F.tid; i < n8; i += (long)F.G * NTHR) {
        const f32x4 a = *(const f32x4*)(src + i * 8), b = *(const f32x4*)(src + i * 8 + 4);
        v4u o; o.x = pk2(a.x, a.y); o.y = pk2(a.z, a.w); o.z = pk2(b.x, b.y); o.w = pk2(b.z, b.w);
        *(v4u*)(dst + i * 8) = o; }
}
__device__ __forceinline__ void p0_prologue(Frame& F, const Args& A) {
    unsigned char* ws = F.ws;
    long long* cs = (long long*)(ws + WS_FOLD); long long* b2 = cs + FO_N;
    transpose_mat(F, A.in[IN_AB_W_IN], DM, AB_IN, (bf16*)(ws + WS_W_ABIN));
    transpose_mat(F, A.in[IN_AB_W_OUT], DM, DM, (bf16*)(ws + WS_W_ABOUT));
    { const int l = 0;
        transpose_mat_fold(F, A.in[IN_XA_WQ] + (size_t)l * DM * XW, DM, XW, (bf16*)(ws + WS_W_XQ) + (size_t)l * XW * DM, A.in[IN_LN_G] + (size_t)(3 * l) * DM, A.in[IN_LN_B] + (size_t)(3 * l) * DM, cs + FO_XQ + l * XW, b2 + FO_XQ + l * XW);
        transpose_mat(F, A.in[IN_XA_WKV] + (size_t)l * DM * 2 * XW, DM, 2 * XW, (bf16*)(ws + WS_W_XKV) + (size_t)l * 2 * XW * DM);
        transpose_mat(F, A.in[IN_XA_WO] + (size_t)l * XW * DM, XW, DM, (bf16*)(ws + WS_W_XO) + (size_t)l * DM * XW);
        transpose_mat_fold(F, A.in[IN_FFN_UP] + (size_t)l * DM * DFF2, DM, DFF2, (bf16*)(ws + WS_W_UP) + (size_t)l * DFF2 * DM, A.in[IN_LN_G] + (size_t)(3 * l + 1) * DM, A.in[IN_LN_B] + (size_t)(3 * l + 1) * DM, cs + FO_UP + l * DFF2, b2 + FO_UP + l * DFF2); }
    for (int l = 0; l < 2; ++l) {
        transpose_mat(F, A.in[IN_NSA_CMP_W1] + (size_t)l * 32 * HD * HD, 32 * HD, HD, (bf16*)(ws + WS_W_C1) + (size_t)l * HD * 32 * HD);
        transpose_mat(F, A.in[IN_NSA_CMP_W2] + (size_t)l * HD * HD, HD, HD, (bf16*)(ws + WS_W_C2) + (size_t)l * HD * HD);
    }
    cvt_flat(F, A.in[IN_X], (bf16*)(ws + WS_HB), (long)MTOK * DM / 8);
    cvt_flat(F, A.in[IN_MEM], (bf16*)(ws + WS_MEMB), (long)BATCH * NMEM * DM / 8);
    { v4u z = {0u, 0u, 0u, 0u}; v4u* p = (v4u*)((bf16*)(ws + WS_W_NSAIN) + (size_t)NSA_IN * DM); const long n = (long)(NSA_INP - NSA_IN) * DM / 8;
      for (long i = (long)F.bid * NTHR + F.tid; i < n; i += (long)F.G * NTHR) p[i] = z; }
    { float* tab = (float*)(ws + WS_ROPE);
      for (int i = F.bid * NTHR + F.tid; i < SEQ * 64; i += F.G * NTHR) { const int t = i >> 6, d = i & 63;
          float sn, cs; sincosf((float)t * powf(10000.0f, -(float)d * (1.0f / 64.0f)), &sn, &cs); tab[(size_t)t * 128 + d] = cs; tab[(size_t)t * 128 + 64 + d] = sn; } }
    { const float* lbp = A.in[IN_HGRN_LB]; float* lbo = (float*)(ws + WS_LB);
      for (int i = F.bid * NTHR + F.tid; i < A_W; i += F.G * NTHR) { const float a = lbp[i], b = lbp[A_W + i], m = fmaxf(a, b), ea = __expf(a - m), eb = __expf(b - m); lbo[i] = ea / (ea + eb); } }
}

__device__ __forceinline__ void ln_phase(Frame& F, const bf16* Y, const float* g, const float* b, float* h32) {
    const int gw = F.bid * NWAVES + F.wave, NGW = F.G * NWAVES;
    for (int m = gw; m < MTOK; m += NGW) {
        const v4u* yr = (const v4u*)(Y + (size_t)m * DM) + F.lane;
        float v[8][8]; float s = 0.f;
#pragma unroll
        for (int j = 0; j < 8; ++j) { const v4u x = yr[64 * j];
            v[j][0] = bflo(x.x); v[j][1] = bfhi(x.x); v[j][2] = bflo(x.y); v[j][3] = bfhi(x.y); v[j][4] = bflo(x.z); v[j][5] = bfhi(x.z); v[j][6] = bflo(x.w); v[j][7] = bfhi(x.w);
#pragma unroll
            for (int q = 0; q < 8; ++q) s += v[j][q]; }
        const float mean = wave_sum(s) * (1.f / DM); float s2 = 0.f;
#pragma unroll
        for (int j = 0; j < 8; ++j)
#pragma unroll
            for (int q = 0; q < 8; ++q) { v[j][q] -= mean; s2 += v[j][q] * v[j][q]; }
        const float rstd = 1.f / sqrtf(wave_sum(s2) * (1.f / DM) + LN_EPS);
#pragma unroll
        for (int j = 0; j < 8; ++j) { const int c0 = 8 * F.lane + 512 * j;
            const f32x4 g0 = *(const f32x4*)(g + c0), g1 = *(const f32x4*)(g + c0 + 4), b0 = *(const f32x4*)(b + c0), b1 = *(const f32x4*)(b + c0 + 4);
            f32x4 r0, r1;
            r0.x = v[j][0] * rstd * g0.x + b0.x; r0.y = v[j][1] * rstd * g0.y + b0.y; r0.z = v[j][2] * rstd * g0.z + b0.z; r0.w = v[j][3] * rstd * g0.w + b0.w;
            r1.x = v[j][4] * rstd * g1.x + b1.x; r1.y = v[j][5] * rstd * g1.y + b1.y; r1.z = v[j][6] * rstd * g1.z + b1.z; r1.w = v[j][7] * rstd * g1.w + b1.w;
            *(f32x4*)(h32 + (size_t)m * DM + c0) = r0; *(f32x4*)(h32 + (size_t)m * DM + c0 + 4) = r1; }
    }
}

__device__ __forceinline__ void convglu_phase(Frame& F, const bf16* UP, const float* cw, bf16* Gm) {
    constexpr int NCG = DFF / 8, RB = 16, NRB = MTOK / RB;
    const long nitems = (long)NCG * NRB;
    for (long it = (long)F.bid * NTHR + F.tid; it < nitems; it += (long)F.G * NTHR) {
        const int cg = (int)(it % NCG), rb = (int)(it / NCG), c0 = cg * 8, t0 = rb * RB;
        float w0[8], w1[8], w2[8];
#pragma unroll
        for (int j = 0; j < 8; ++j) { w0[j] = cw[c0 + j]; w1[j] = cw[DFF + c0 + j]; w2[j] = cw[2 * DFF + c0 + j]; }
        float am2[8], am1[8];
        if ((t0 & (SEQ - 1)) == 0) {
#pragma unroll
            for (int j = 0; j < 8; ++j) { am2[j] = 0.f; am1[j] = 0.f; }
        } else {
            const v4u x2 = *(const v4u*)(UP + (size_t)(t0 - 2) * DFF2 + c0), x1 = *(const v4u*)(UP + (size_t)(t0 - 1) * DFF2 + c0);
            am2[0] = bflo(x2.x); am2[1] = bfhi(x2.x); am2[2] = bflo(x2.y); am2[3] = bfhi(x2.y); am2[4] = bflo(x2.z); am2[5] = bfhi(x2.z); am2[6] = bflo(x2.w); am2[7] = bfhi(x2.w);
            am1[0] = bflo(x1.x); am1[1] = bfhi(x1.x); am1[2] = bflo(x1.y); am1[3] = bfhi(x1.y); am1[4] = bflo(x1.z); am1[5] = bfhi(x1.z); am1[6] = bflo(x1.w); am1[7] = bfhi(x1.w);
        }
#pragma unroll 4
        for (int r = 0; r < RB; ++r) {
            const size_t row = (size_t)(t0 + r);
            const v4u xa = *(const v4u*)(UP + row * DFF2 + c0), xu = *(const v4u*)(UP + row * DFF2 + DFF + c0);
            float a[8], u[8];
            a[0] = bflo(xa.x); a[1] = bfhi(xa.x); a[2] = bflo(xa.y); a[3] = bfhi(xa.y); a[4] = bflo(xa.z); a[5] = bfhi(xa.z); a[6] = bflo(xa.w); a[7] = bfhi(xa.w);
            u[0] = bflo(xu.x); u[1] = bfhi(xu.x); u[2] = bflo(xu.y); u[3] = bfhi(xu.y); u[4] = bflo(xu.z); u[5] = bfhi(xu.z); u[6] = bflo(xu.w); u[7] = bfhi(xu.w);
            float o[8];
#pragma unroll
            for (int j = 0; j < 8; j += 2) {
                const float c0v = w2[j] * a[j] + w1[j] * am1[j] + w0[j] * am2[j], c1v = w2[j + 1] * a[j + 1] + w1[j + 1] * am1[j + 1] + w0[j + 1] * am2[j + 1];
                const pg8::f32x2 gg = pg8::gelu_pk((pg8::f32x2){c0v, c1v}); o[j] = gg.x * u[j]; o[j + 1] = gg.y * u[j + 1]; }
            v4u w; w.x = pk2(o[0], o[1]); w.y = pk2(o[2], o[3]); w.z = pk2(o[4], o[5]); w.w = pk2(o[6], o[7]);
            *(v4u*)(Gm + row * DFF + c0) = w;
#pragma unroll
            for (int j = 0; j < 8; ++j) { am2[j] = am1[j]; am1[j] = a[j]; }
        }
    }
}

__device__ __forceinline__ void xattn_phase(Frame& F, const bf16* XQ, const bf16* XKV, bf16* XO) {
    const int tid = F.tid, wid = F.wave, lane = F.lane, r32 = lane & 31, hi = lane >> 5;
    LAS char* lds = (LAS char*)F.lds;
    LAS float* wsc = (LAS float*)(lds + ATT_WS_OFF + wid * 256);
    const int vb0 = (int)(uintptr_t)(lds + ATT_V_OFF) + v_rd_base(lane);
    KVDma dm; kv_dma_init(dm, 2 * XW, 2 * XW, wid, lane);
    constexpr int NU = (MTOK / 256) * XH;
    for (int u = F.bid; u < NU; u += F.G) {
        const int head = u % XH, rbk = u / XH, row0 = rbk * 256, b = row0 / SEQ;
        const bf16* Kh = XKV + (size_t)b * NMEM * 2 * XW + head * HD; const bf16* Vh = Kh + XW;
        bf16x8 qr[8]; load_q(qr, XQ + (size_t)(row0 + wid * 32 + r32) * XW + head * HD + hi * 8);
        float m_reg = -1e30f, l_reg = 0.f; f32x16 o[4] = {};
        __syncthreads();
        kv_dma(dm, Kh, Vh, lds, 0, wid);
        for (int j = 0; j < NMEM / KVBLK; ++j) {
            const int buf = (j & 1) * ATT_BUF;
            VM_WAIT(); __syncthreads();
            if (j + 1 < NMEM / KVBLK) kv_dma(dm, Kh + (size_t)(j + 1) * KVBLK * 2 * XW, Vh + (size_t)(j + 1) * KVBLK * 2 * XW, lds, ATT_BUF - buf, wid);
            f32x16 p0, p1; qkt(p0, p1, lds + buf + ATT_K_OFF, qr, r32, hi);
            float alpha; softmax_tile(p0, p1, m_reg, l_reg, alpha);
            rescale_o(o, alpha, wsc, r32, hi);
            bf16x8 pa0, pa1, pa2, pa3; pack_p(p0, p1, pa0, pa1, pa2, pa3);
            pv_d0(o, vb0 + buf, pa0, pa1, pa2, pa3);
        }
        if (hi == 0) wsc[32 + r32] = l_reg; LDS_WAIT();
        bf16* Ow = XO + (size_t)(row0 + wid * 32) * XW + head * HD;
#pragma unroll
        for (int r = 0; r < 16; ++r) { const int orow = crow(r, hi); const float rl = __builtin_amdgcn_rcpf(wsc[32 + orow]);
#pragma unroll
            for (int d0 = 0; d0 < 4; ++d0) Ow[(size_t)orow * XW + d0 * 32 + r32] = (bf16)f2bf(o[d0][r] * rl); }
        LDS_WAIT();
    }
}

template <int K>
__device__ __forceinline__ f32x4 mma_tile(const LAS char* A, int lda, const LAS char* B, int ldb, int fr, int fq) {
    f32x4 acc = {0.f, 0.f, 0.f, 0.f};
#pragma unroll
    for (int k0 = 0; k0 < K; k0 += 32) {
        const bf16x8 a = *(const LAS bf16x8*)(A + fr * lda + (k0 + 8 * fq) * 2);
        const bf16x8 b = *(const LAS bf16x8*)(B + fr * ldb + (k0 + 8 * fq) * 2);
        acc = __builtin_amdgcn_mfma_f32_16x16x32_bf16(a, b, acc, 0, 0, 0);
    }
    return acc;
}
constexpr int HG_CH = 64, HG_NC = SEQ / HG_CH, HG_ITEMS = BATCH * A_HEADS * HG_NC;
constexpr int HG_QT = 0, HG_KT = 17408, HG_KH = 34816, HG_VT = 53248, HG_PT = 71680, HG_SEG = 80896;
constexpr int HG_SP = 17408, HG_OT = 52224;
constexpr int HG_WT = 80896, HG_KHS = 86016, HG_VS = 103424;
__device__ __forceinline__ void hgrn_phase_a(Frame& F, const bf16* P0, const float* lbv, bf16* QTg, bf16* OINTRA, bf16* DS, float* DEC) {
    LAS char* lds = (LAS char*)F.lds;
    const int tid = F.tid, wid = F.wave, lane = F.lane, fr = lane & 15, fq = lane >> 4;
    const int dg = tid & 15, sq = tid >> 4;
    const int d = tid & 127, sq16 = tid >> 7;
    for (int it = F.bid; it < HG_ITEMS; it += F.G) {
        const int c = it % HG_NC, bh = it / HG_NC, h = bh % A_HEADS, b = bh / A_HEADS;
        const size_t row0 = (size_t)b * SEQ + (size_t)c * HG_CH;
        float lb[8], q[2][8], kk[2][8], cum[2][8]; v4u vraw[2];
        { const f32x4 l0 = *(const f32x4*)(lbv + h * HD + 8 * dg), l1 = *(const f32x4*)(lbv + h * HD + 8 * dg + 4);
          lb[0] = l0.x; lb[1] = l0.y; lb[2] = l0.z; lb[3] = l0.w; lb[4] = l1.x; lb[5] = l1.y; lb[6] = l1.z; lb[7] = l1.w; }
#pragma unroll
        for (int rr = 0; rr < 2; ++rr) { const bf16* rowp = P0 + (row0 + 2 * sq + rr) * AB_IN + h * HD + 8 * dg;
            const v4u zq = *(const v4u*)(rowp + A_W), qq = *(const v4u*)rowp; vraw[rr] = *(const v4u*)(rowp + 2 * A_W);
            const unsigned zw[4] = {zq.x, zq.y, zq.z, zq.w}, qw[4] = {qq.x, qq.y, qq.z, qq.w};
#pragma unroll
            for (int j = 0; j < 8; ++j) { const float z = (j & 1) ? bfhi(zw[j >> 1]) : bflo(zw[j >> 1]); q[rr][j] = (j & 1) ? bfhi(qw[j >> 1]) : bflo(qw[j >> 1]);
                const float sg = sigmoidf_(z), omlb = 1.f - lb[j]; kk[rr][j] = omlb * (1.f - sg);
                const float lf = __logf(lb[j] + omlb * sg); cum[rr][j] = rr ? cum[0][j] + lf : lf; } }
        float pre[8];
#pragma unroll
        for (int j = 0; j < 8; ++j) { const float seg = cum[1][j]; float x = seg; const float t1 = __shfl_up(x, 16); if (lane >= 16) x += t1; const float t2 = __shfl_up(x, 32); if (lane >= 32) x += t2;
            pre[j] = x - seg; if (lane >= 48) ((LAS float*)(lds + HG_WT))[wid * 128 + 8 * dg + j] = x; }
        LDS_WAIT(); __syncthreads();
        float total[8];
#pragma unroll
        for (int j = 0; j < 8; ++j) total[j] = 0.f;
#pragma unroll
        for (int w = 0; w < NWAVES; ++w) { const f32x4 a0 = *(const LAS f32x4*)(lds + HG_WT + (w * 128 + 8 * dg) * 4), a1 = *(const LAS f32x4*)(lds + HG_WT + (w * 128 + 8 * dg + 4) * 4);
            const float av[8] = {a0.x, a0.y, a0.z, a0.w, a1.x, a1.y, a1.z, a1.w};
#pragma unroll
            for (int j = 0; j < 8; ++j) { total[j] += av[j]; if (w < wid) pre[j] += av[j]; } }
#pragma unroll
        for (int rr = 0; rr < 2; ++rr) { const int s = 2 * sq + rr; unsigned qt[4], kt[4], kh[4];
#pragma unroll
            for (int j = 0; j < 8; j += 2) { const float b0 = pre[j] + cum[rr][j], b1 = pre[j + 1] + cum[rr][j + 1];
                qt[j >> 1] = pk2(q[rr][j] * __expf(b0), q[rr][j + 1] * __expf(b1));
                kt[j >> 1] = pk2(kk[rr][j] * __expf(-b0), kk[rr][j + 1] * __expf(-b1));
                kh[j >> 1] = pk2(kk[rr][j] * __expf(total[j] - b0), kk[rr][j + 1] * __expf(total[j + 1] - b1)); }
            const v4u qv = {qt[0], qt[1], qt[2], qt[3]};
            *(LAS v4u*)(lds + HG_QT + s * 272 + dg * 16) = qv; *(v4u*)(QTg + (row0 + s) * A_W + h * HD + 8 * dg) = qv;
            *(LAS v4u*)(lds + HG_KT + s * 272 + dg * 16) = (v4u){kt[0], kt[1], kt[2], kt[3]};
            *(LAS v4u*)(lds + HG_KHS + s * 272 + dg * 16) = (v4u){kh[0], kh[1], kh[2], kh[3]};
            *(LAS v4u*)(lds + HG_VS + s * 272 + dg * 16) = vraw[rr]; }
        if (sq == 31) { f32x4 e0, e1; e0.x = __expf(total[0]); e0.y = __expf(total[1]); e0.z = __expf(total[2]); e0.w = __expf(total[3]); e1.x = __expf(total[4]); e1.y = __expf(total[5]); e1.z = __expf(total[6]); e1.w = __expf(total[7]);
            *(f32x4*)(DEC + (size_t)it * HD + 8 * dg) = e0; *(f32x4*)(DEC + (size_t)it * HD + 8 * dg + 4) = e1; }
        LDS_WAIT(); __syncthreads();
        { unsigned kh[8], vt[8];
#pragma unroll
          for (int j = 0; j < 16; j += 2) { const int s = 16 * sq16 + j;
              kh[j >> 1] = (unsigned)*(const LAS unsigned short*)(lds + HG_KHS + s * 272 + d * 2) | ((unsigned)*(const LAS unsigned short*)(lds + HG_KHS + (s + 1) * 272 + d * 2) << 16);
              vt[j >> 1] = (unsigned)*(const LAS unsigned short*)(lds + HG_VS + s * 272 + d * 2) | ((unsigned)*(const LAS unsigned short*)(lds + HG_VS + (s + 1) * 272 + d * 2) << 16); }
          LAS v4u* pk = (LAS v4u*)(lds + HG_KH + d * 144 + sq16 * 32); pk[0] = (v4u){kh[0], kh[1], kh[2], kh[3]}; pk[1] = (v4u){kh[4], kh[5], kh[6], kh[7]};
          LAS v4u* pv = (LAS v4u*)(lds + HG_VT + d * 144 + sq16 * 32); pv[0] = (v4u){vt[0], vt[1], vt[2], vt[3]}; pv[1] = (v4u){vt[4], vt[5], vt[6], vt[7]}; }
        LDS_WAIT(); __syncthreads();
#pragma unroll
        for (int k = 0; k < 2; ++k) { const int tau = 2 * wid + k, ti = tau >> 2, si = tau & 3;
            f32x4 acc = {0.f, 0.f, 0.f, 0.f};
            if (si <= ti) acc = mma_tile<128>(lds + HG_QT + ti * 16 * 272, 272, lds + HG_KT + si * 16 * 272, 272, fr, fq);
#pragma unroll
            for (int i = 0; i < 4; ++i) { const int t = 16 * ti + 4 * fq + i, s = 16 * si + fr; const float v = (s <= t) ? acc[i] : 0.f;
                *(LAS unsigned short*)(lds + HG_PT + t * 144 + s * 2) = (unsigned short)f2bf(v); } }
        LDS_WAIT(); __syncthreads();
#pragma unroll
        for (int k = 0; k < 4; ++k) { const int tau = wid + 8 * k, ti = tau >> 3, vi = tau & 7;
            const f32x4 acc = mma_tile<64>(lds + HG_VT + vi * 16 * 144, 144, lds + HG_PT + ti * 16 * 144, 144, fr, fq);
            v2u w; w.x = pk2(acc[0], acc[1]); w.y = pk2(acc[2], acc[3]);
            *(v2u*)(OINTRA + (row0 + 16 * ti + fr) * A_W + h * HD + 16 * vi + 4 * fq) = w; }
#pragma unroll
        for (int k = 0; k < 8; ++k) { const int tau = wid + 8 * k, vi = tau >> 3, ki = tau & 7;
            const f32x4 acc = mma_tile<64>(lds + HG_KH + ki * 16 * 144, 144, lds + HG_VT + vi * 16 * 144, 144, fr, fq);
            v2u w; w.x = pk2(acc[0], acc[1]); w.y = pk2(acc[2], acc[3]);
            *(v2u*)(DS + ((size_t)it * HD + 16 * vi + fr) * HD + 16 * ki + 4 * fq) = w; }
        LDS_WAIT(); __syncthreads();
    }
}
__device__ __forceinline__ void hgrn_phase_b(Frame& F, const bf16* DS, const float* DEC, bf16* SPREV) {
    const int tid = F.tid, dvl = tid >> 5, dk4 = (tid & 31) * 4;
    for (int item = F.bid; item < BATCH * A_HEADS * 8; item += F.G) {
        const int sl = item & 7, bh = item >> 3, dv = sl * 16 + dvl;
        f32x4 S = {0.f, 0.f, 0.f, 0.f};
        for (int c0 = 0; c0 < HG_NC; c0 += 8) {
            f32x4 ds[8], dc[8];
#pragma unroll
            for (int k = 0; k < 8; ++k) { const size_t it = (size_t)bh * HG_NC + c0 + k; const v2u x = *(const v2u*)(DS + (it * HD + dv) * HD + dk4);
                ds[k] = (f32x4){bflo(x.x), bfhi(x.x), bflo(x.y), bfhi(x.y)}; dc[k] = *(const f32x4*)(DEC + it * HD + dk4); }
#pragma unroll
            for (int k = 0; k < 8; ++k) { const size_t it = (size_t)bh * HG_NC + c0 + k;
                v2u w; w.x = pk2(S.x, S.y); w.y = pk2(S.z, S.w); *(v2u*)(SPREV + (it * HD + dv) * HD + dk4) = w;
                S = S * dc[k] + ds[k]; }
        }
    }
}
__device__ __forceinline__ void hgrn_phase_c(Frame& F, const bf16* P0, const bf16* QTg, const bf16* OINTRA, const bf16* SPREV, const float* nw, bf16* Ob) {
    LAS char* lds = (LAS char*)F.lds;
    const int tid = F.tid, wid = F.wave, lane = F.lane, fr = lane & 15, fq = lane >> 4;
    for (int it = F.bid; it < HG_ITEMS; it += F.G) {
        const int c = it % HG_NC, bh = it / HG_NC, h = bh % A_HEADS, b = bh / A_HEADS;
        const size_t row0 = (size_t)b * SEQ + (size_t)c * HG_CH;
        { const int s = tid >> 3, ch = (tid & 7) * 16; const bf16* src = QTg + (row0 + s) * A_W + h * HD + ch;
          const v4u x0 = *(const v4u*)src, x1 = *(const v4u*)(src + 8); LAS v4u* dst = (LAS v4u*)(lds + HG_QT + s * 272 + ch * 2); dst[0] = x0; dst[1] = x1; }
        { const int dv = tid >> 2, ch = (tid & 3) * 32; const bf16* src = SPREV + ((size_t)it * HD + dv) * HD + ch;
          const v4u x0 = *(const v4u*)src, x1 = *(const v4u*)(src + 8), x2 = *(const v4u*)(src + 16), x3 = *(const v4u*)(src + 24);
          LAS v4u* dst = (LAS v4u*)(lds + HG_SP + dv * 272 + ch * 2); dst[0] = x0; dst[1] = x1; dst[2] = x2; dst[3] = x3; }
        LDS_WAIT(); __syncthreads();
#pragma unroll
        for (int k = 0; k < 4; ++k) { const int tau = wid + 8 * k, ti = tau >> 3, vi = tau & 7;
            const f32x4 acc = mma_tile<128>(lds + HG_SP + vi * 16 * 272, 272, lds + HG_QT + ti * 16 * 272, 272, fr, fq);
            const int t = 16 * ti + fr, dv = 16 * vi + 4 * fq; const v2u oi = *(const v2u*)(OINTRA + (row0 + t) * A_W + h * HD + dv);
            *(LAS f32x4*)(lds + HG_OT + (t * 132 + dv) * 4) = (f32x4){acc[0] + bflo(oi.x), acc[1] + bfhi(oi.x), acc[2] + bflo(oi.y), acc[3] + bfhi(oi.y)}; }
        LDS_WAIT(); __syncthreads();
        { const int t = tid >> 3, dv0 = (tid & 7) * 16;
          float v[16]; float ss = 0.f;
#pragma unroll
          for (int q4 = 0; q4 < 4; ++q4) { const f32x4 x = *(const LAS f32x4*)(lds + HG_OT + (t * 132 + dv0 + 4 * q4) * 4); v[4 * q4] = x.x; v[4 * q4 + 1] = x.y; v[4 * q4 + 2] = x.z; v[4 * q4 + 3] = x.w;
              ss += (x.x * x.x + x.y * x.y) + (x.z * x.z + x.w * x.w); }
          ss += __shfl_xor(ss, 1); ss += __shfl_xor(ss, 2); ss += __shfl_xor(ss, 4);
          const float r = 1.f / sqrtf(ss * (1.f / HD) + RMS_EPS);
          const bf16* gp = P0 + (row0 + t) * AB_IN + 3 * A_W + h * HD + dv0; const v4u g0 = *(const v4u*)gp, g1 = *(const v4u*)(gp + 8);
          const unsigned gw[8] = {g0.x, g0.y, g0.z, g0.w, g1.x, g1.y, g1.z, g1.w}; unsigned o[8];
#pragma unroll
          for (int j = 0; j < 8; ++j) { const float ga = bflo(gw[j]), gb = bfhi(gw[j]);
              o[j] = pk2(v[2 * j] * r * nw[dv0 + 2 * j] * ga * sigmoidf_(ga), v[2 * j + 1] * r * nw[dv0 + 2 * j + 1] * gb * sigmoidf_(gb)); }
          bf16* op = Ob + (row0 + t) * DM + h * HD + dv0; *(v4u*)op = (v4u){o[0], o[1], o[2], o[3]}; *(v4u*)(op + 8) = (v4u){o[4], o[5], o[6], o[7]}; }
        LDS_WAIT(); __syncthreads();
    }
}

constexpr float SB_CUT = -160.f;
__device__ __forceinline__ void sb_phase(Frame& F, const bf16* P0, bf16* Ob) {
    const int tid = F.tid, wid = F.wave, lane = F.lane, r32 = lane & 31, hi = lane >> 5;
    LAS char* lds = (LAS char*)F.lds;
    const int vb0 = (int)(uintptr_t)(lds + ATT_V_OFF) + v_rd_base(lane);
    KVDma dm; kv_dma_init(dm, AB_IN, AB_IN, wid, lane);
    constexpr int NQB = SEQ / 256, NU = BATCH * B_HEADS * NQB;
    for (int rd = 0; ; ++rd) {
        const int idx = (rd & 1) ? rd * F.G + (F.G - 1 - F.bid) : rd * F.G + F.bid;
        if (rd * F.G >= NU) break;
        if (idx >= NU) continue;
        const int qb = NQB - 1 - idx / (BATCH * B_HEADS), bh = idx % (BATCH * B_HEADS), head = bh % B_HEADS, b = bh / B_HEADS;
        const size_t rowb = (size_t)b * SEQ; const int q0 = qb * 256;
        const bf16* Kh = P0 + rowb * AB_IN + 4 * A_W + B_W + head * HD; const bf16* Vh = Kh + B_W;
        const int tw0 = q0 + wid * 32, t = tw0 + r32;
        bf16x8 qr[8]; load_q(qr, P0 + (rowb + t) * AB_IN + 4 * A_W + head * HD + hi * 8);
        float R = 0.f; f32x16 o[4] = {};
        const int jtop = (q0 + 254) >> 6;
        LAS unsigned* dflag = (LAS unsigned*)(lds + ATT_X_OFF);
        if (lane == 0) { dflag[wid] = 0u; dflag[8 + wid] = 0u; }
        LDS_WAIT(); __syncthreads();
        kv_dma(dm, Kh + (size_t)jtop * KVBLK * AB_IN, Vh + (size_t)jtop * KVBLK * AB_IN, lds, 0, wid);
        int buf = 0;
        for (int j = jtop; j >= 0; --j, buf = ATT_BUF - buf) {
            VM_WAIT(); __syncthreads();
            { unsigned alld = 1u;
#pragma unroll
              for (int w = 0; w < NWAVES; ++w) alld &= dflag[((j + 1) & 1) * 8 + w];
              if (__builtin_amdgcn_readfirstlane(alld)) break; }
            if (j > 0) kv_dma(dm, Kh + (size_t)(j - 1) * KVBLK * AB_IN, Vh + (size_t)(j - 1) * KVBLK * AB_IN, lds, ATT_BUF - buf, wid);
            const int k0 = j * KVBLK;
            if (k0 < tw0 + 31) {
                f32x16 p0, p1; qkt(p0, p1, lds + buf + ATT_K_OFF, qr, r32, hi);
                const bool need_mask = (k0 + 63 >= tw0);
                float L0[16], L1[16];
#pragma unroll
                for (int r = 0; r < 16; ++r) {
                    const float z0 = p0[r] * ATT_C, z1 = p1[r] * ATT_C;
                    float l0 = -(fmaxf(z0, 0.f) + __builtin_amdgcn_logf(1.f + __builtin_amdgcn_exp2f(-fabsf(z0))));
                    float l1 = -(fmaxf(z1, 0.f) + __builtin_amdgcn_logf(1.f + __builtin_amdgcn_exp2f(-fabsf(z1))));
                    if (need_mask) { if (k0 + crow(r, hi) >= t) l0 = 0.f; if (k0 + 32 + crow(r, hi) >= t) l1 = 0.f; }
                    L0[r] = l0; L1[r] = l1; p0[r] = z0 + l0; p1[r] = z1 + l1;
                }
                SBAR();
                float Sg[16];
#pragma unroll
                for (int gi = 0; gi < 4; ++gi) {
                    const float a = (L0[4 * gi] + L0[4 * gi + 1]) + (L0[4 * gi + 2] + L0[4 * gi + 3]), c = (L1[4 * gi] + L1[4 * gi + 1]) + (L1[4 * gi + 2] + L1[4 * gi + 3]);
                    auto ra = __builtin_amdgcn_permlane32_swap(__float_as_uint(a), __float_as_uint(a), false, false);
                    auto rc = __builtin_amdgcn_permlane32_swap(__float_as_uint(c), __float_as_uint(c), false, false);
                    Sg[2 * gi] = __uint_as_float(ra[0]); Sg[2 * gi + 1] = __uint_as_float(ra[1]); Sg[8 + 2 * gi] = __uint_as_float(rc[0]); Sg[8 + 2 * gi + 1] = __uint_as_float(rc[1]);
                }
                float run = R;
#pragma unroll
                for (int s = 15; s >= 0; --s) { const float tt = run; run += Sg[s]; Sg[s] = tt; }
                const float Rn = run;
                SBAR();
#pragma unroll
                for (int gi = 0; gi < 4; ++gi) {
                    float base0 = hi ? Sg[2 * gi + 1] : Sg[2 * gi], base1 = hi ? Sg[8 + 2 * gi + 1] : Sg[8 + 2 * gi];
                    float r3 = base0, r2 = r3 + L0[4 * gi + 3], r1 = r2 + L0[4 * gi + 2], r0 = r1 + L0[4 * gi + 1];
                    p0[4 * gi + 3] = __builtin_amdgcn_exp2f(p0[4 * gi + 3] + r3); p0[4 * gi + 2] = __builtin_amdgcn_exp2f(p0[4 * gi + 2] + r2);
                    p0[4 * gi + 1] = __builtin_amdgcn_exp2f(p0[4 * gi + 1] + r1); p0[4 * gi + 0] = __builtin_amdgcn_exp2f(p0[4 * gi + 0] + r0);
                    r3 = base1; r2 = r3 + L1[4 * gi + 3]; r1 = r2 + L1[4 * gi + 2]; r0 = r1 + L1[4 * gi + 1];
                    p1[4 * gi + 3] = __builtin_amdgcn_exp2f(p1[4 * gi + 3] + r3); p1[4 * gi + 2] = __builtin_amdgcn_exp2f(p1[4 * gi + 2] + r2);
                    p1[4 * gi + 1] = __builtin_amdgcn_exp2f(p1[4 * gi + 1] + r1); p1[4 * gi + 0] = __builtin_amdgcn_exp2f(p1[4 * gi + 0] + r0);
                }
                R = Rn;
                { const unsigned dn = __all(R < SB_CUT) ? 1u : 0u; if (lane == 0) dflag[(j & 1) * 8 + wid] = dn; }
                if (need_mask) {
#pragma unroll
                    for (int r = 0; r < 16; ++r) { if (k0 + crow(r, hi) >= t) p0[r] = 0.f; if (k0 + 32 + crow(r, hi) >= t) p1[r] = 0.f; }
                }
                bf16x8 pa0, pa1, pa2, pa3; pack_p(p0, p1, pa0, pa1, pa2, pa3);
                pv_d0(o, vb0 + buf, pa0, pa1, pa2, pa3);
            }
        }
        bf16* Ow = Ob + (rowb + tw0) * DM + A_W + head * HD;
#pragma unroll
        for (int r = 0; r < 16; ++r) { const int orow = crow(r, hi);
#pragma unroll
            for (int d0 = 0; d0 < 4; ++d0) Ow[(size_t)orow * DM + d0 * 32 + r32] = (bf16)f2bf(o[d0][r]); }
    }
}

constexpr int P1_KC = 4096, P1_VC = 4608, P1_KS = 5120, P1_VS = 5632, P1_KW = 6144, P1_VW = 6656, P1_GL = 7168;
__device__ __forceinline__ void nsa_rope_phase(Frame& F, const bf16* P1, const float* TAB, bf16* QROT, bf16* KSROT, bf16* KWROT, bf16* OVL) {
    const int gw = F.bid * NWAVES + F.wave, NGW = F.G * NWAVES, lane = F.lane, hsub = lane >> 3, d0 = (lane & 7) * 8;
    for (int m = gw; m < MTOK; m += NGW) {
        const int t = m & (SEQ - 1);
        const f32x4 c0 = *(const f32x4*)(TAB + (size_t)t * 128 + d0), c1 = *(const f32x4*)(TAB + (size_t)t * 128 + d0 + 4);
        const f32x4 s0 = *(const f32x4*)(TAB + (size_t)t * 128 + 64 + d0), s1 = *(const f32x4*)(TAB + (size_t)t * 128 + 64 + d0 + 4);
        const float cs[8] = {c0.x, c0.y, c0.z, c0.w, c1.x, c1.y, c1.z, c1.w}, sn[8] = {s0.x, s0.y, s0.z, s0.w, s1.x, s1.y, s1.z, s1.w};
        const bf16* row = P1 + (size_t)m * NSA_INP;
#pragma unroll
        for (int hb = 0; hb < 5; ++hb) {
            const int hh = hb * 8 + hsub;
            const bf16* src; bf16* dst;
            if (hh < 32) { src = row + hh * HD; dst = QROT + (size_t)m * DM + hh * HD; }
            else if (hh < 36) { src = row + P1_KS + (hh - 32) * HD; dst = KSROT + (size_t)m * KVW + (hh - 32) * HD; }
            else { src = row + P1_KW + (hh - 36) * HD; dst = KWROT + (size_t)m * KVW + (hh - 36) * HD; }
            const v4u a = *(const v4u*)(src + d0), bq = *(const v4u*)(src + 64 + d0);
            const unsigned aw[4] = {a.x, a.y, a.z, a.w}, bw[4] = {bq.x, bq.y, bq.z, bq.w}; unsigned o1[4], o2[4];
#pragma unroll
            for (int q = 0; q < 4; ++q) { const float x1l = bflo(aw[q]), x1h = bfhi(aw[q]), x2l = bflo(bw[q]), x2h = bfhi(bw[q]);
                o1[q] = pk2(x1l * cs[2 * q] - x2l * sn[2 * q], x1h * cs[2 * q + 1] - x2h * sn[2 * q + 1]);
                o2[q] = pk2(x2l * cs[2 * q] + x1l * sn[2 * q], x2h * cs[2 * q + 1] + x1h * sn[2 * q + 1]); }
            *(v4u*)(dst + d0) = (v4u){o1[0], o1[1], o1[2], o1[3]}; *(v4u*)(dst + 64 + d0) = (v4u){o2[0], o2[1], o2[2], o2[3]};
        }
    }
    for (int i = F.bid * NTHR + F.tid; i < NCMPP * NSLC; i += F.G * NTHR) { const int n = i / NSLC, j = i % NSLC;
        OVL[i] = (n < NCMP && n >= 4 * j - 1 && n <= 4 * j + 3) ? (bf16)0x3f80u : (bf16)0u; }
}
constexpr int CM_A = 0, CM_B = 17408, CM_H = 17408 + 34816;
__device__ __forceinline__ void nsa_compress_phase(Frame& F, const bf16* P1, const float* pos, const bf16* W1t, const bf16* W2t, bf16* KCMP, bf16* VCMP) {
    LAS char* lds = (LAS char*)F.lds;
    const int tid = F.tid, wid = F.wave, lane = F.lane, fr = lane & 15, fq = lane >> 4;
    for (int item = F.bid; item < 128; item += F.G) {
        const int nt = item & 7, g = (item >> 3) & 3, b = (item >> 5) & 1, which = item >> 6;
        const bf16* w1 = W1t + (size_t)which * HD * 32 * HD; const bf16* w2 = W2t + (size_t)which * HD * HD;
        const float* posw = pos + (size_t)which * 32 * HD;
        f32x4 acc[4];
#pragma unroll
        for (int k = 0; k < 4; ++k) acc[k] = (f32x4){0.f, 0.f, 0.f, 0.f};
        for (int l = 0; l < 32; ++l) {
            { const int r = tid >> 3, ch = (tid & 7) * 16, n = nt * 64 + r; unsigned w[8];
              if (n < NCMP) { const bf16* src = P1 + ((size_t)b * SEQ + 16 * n + l) * NSA_INP + P1_KC + which * KVW + g * HD + ch;
                  const v4u x0 = *(const v4u*)src, x1 = *(const v4u*)(src + 8); const unsigned xs[8] = {x0.x, x0.y, x0.z, x0.w, x1.x, x1.y, x1.z, x1.w};
#pragma unroll
                  for (int q = 0; q < 8; ++q) w[q] = pk2(bflo(xs[q]) + posw[l * HD + ch + 2 * q], bfhi(xs[q]) + posw[l * HD + ch + 2 * q + 1]);
              } else {
#pragma unroll
                  for (int q = 0; q < 8; ++q) w[q] = 0u; }
              LAS v4u* dst = (LAS v4u*)(lds + CM_A + r * 272 + ch * 2); dst[0] = (v4u){w[0], w[1], w[2], w[3]}; dst[1] = (v4u){w[4], w[5], w[6], w[7]}; }
            { const int e = tid >> 2, ch = (tid & 3) * 32; const bf16* src = w1 + (size_t)e * 32 * HD + l * HD + ch;
              const v4u x0 = *(const v4u*)src, x1 = *(const v4u*)(src + 8), x2 = *(const v4u*)(src + 16), x3 = *(const v4u*)(src + 24);
              LAS v4u* dst = (LAS v4u*)(lds + CM_B + e * 272 + ch * 2); dst[0] = x0; dst[1] = x1; dst[2] = x2; dst[3] = x3; }
            LDS_WAIT(); __syncthreads();
#pragma unroll
            for (int k = 0; k < 4; ++k) { const int tau = wid + 8 * k, ni = tau >> 3, ei = tau & 7;
                acc[k] += mma_tile<128>(lds + CM_A + ni * 16 * 272, 272, lds + CM_B + ei * 16 * 272, 272, fr, fq); }
            LDS_WAIT(); __syncthreads();
        }
#pragma unroll
        for (int k = 0; k < 4; ++k) { const int tau = wid + 8 * k, ni = tau >> 3, ei = tau & 7;
#pragma unroll
            for (int i = 0; i < 4; ++i) *(LAS unsigned short*)(lds + CM_H + (16 * ni + 4 * fq + i) * 272 + (16 * ei + fr) * 2) = (unsigned short)f2bf(gelu1(acc[k][i])); }
        { const int f = tid >> 2, ch = (tid & 3) * 32; const bf16* src = w2 + (size_t)f * HD + ch;
          const v4u x0 = *(const v4u*)src, x1 = *(const v4u*)(src + 8), x2 = *(const v4u*)(src + 16), x3 = *(const v4u*)(src + 24);
          LAS v4u* dst = (LAS v4u*)(lds + CM_B + f * 272 + ch * 2); dst[0] = x0; dst[1] = x1; dst[2] = x2; dst[3] = x3; }
        LDS_WAIT(); __syncthreads();
        bf16* outp = which ? VCMP : KCMP;
#pragma unroll
        for (int k = 0; k < 4; ++k) { const int tau = wid + 8 * k, ni = tau >> 3, fi = tau & 7;
            const f32x4 a2 = mma_tile<128>(lds + CM_H + ni * 16 * 272, 272, lds + CM_B + fi * 16 * 272, 272, fr, fq);
#pragma unroll
            for (int i = 0; i < 4; ++i) { const int n = nt * 64 + 16 * ni + 4 * fq + i;
                outp[(((size_t)b * NCMPP + n) * NSA_G + g) * HD + 16 * fi + fr] = (n < NCMP) ? (bf16)f2bf(a2[i]) : (bf16)0u; } }
        LDS_WAIT(); __syncthreads();
    }
}
__device__ __forceinline__ unsigned pick4(const unsigned (&a)[4], int i) { return i == 0 ? a[0] : (i == 1 ? a[1] : (i == 2 ? a[2] : a[3])); }
template <int MODE>
__device__ __forceinline__ void nsa_attn_phase(Frame& F, const bf16* P1, const bf16* Qsrc, const bf16* Ksrc, const bf16* Vsrc, const unsigned* SEL, float* O32, float* IMP, bf16* Ob, bool probe_nostore = false) {
    const int tid = F.tid, wid = F.wave, lane = F.lane, r32 = lane & 31, hi = lane >> 5;
    LAS char* lds = (LAS char*)F.lds;
    LAS float* wsc = (LAS float*)(lds + ATT_WS_OFF + wid * 256);
    const int vb0 = (int)(uintptr_t)(lds + ATT_V_OFF) + v_rd_base(lane);
    KVDma dm; kv_dma_init(dm, MODE <= 1 ? NSA_G * HD : KVW, MODE == 0 ? NSA_G * HD : (MODE == 1 ? NSLC : NSA_INP), wid, lane);
    constexpr int NTB = SEQ / 32, NU = BATCH * NSA_G * NTB;
    for (int rd = 0; ; ++rd) {
        const int idx = (rd & 1) ? rd * F.G + (F.G - 1 - F.bid) : rd * F.G + F.bid;
        if (rd * F.G >= NU) break;
        if (idx >= NU) continue;
        const int tb = NTB - 1 - idx / (BATCH * NSA_G), bg = idx % (BATCH * NSA_G), g = bg % NSA_G, b = bg / NSA_G;
        const size_t rowb = (size_t)b * SEQ; const int t0 = tb * 32;
        const int t = (MODE == 2) ? t0 + 4 * wid + (r32 >> 3) : t0 + r32, head = (MODE == 2) ? g * NSA_R + (r32 & 7) : g * NSA_R + wid;
        const bf16* Kh; const bf16* Vh; long ldk, ldv; int jlo, jhi;
        if (MODE <= 1) { Kh = Ksrc + ((size_t)b * NCMPP * NSA_G + g) * HD; ldk = NSA_G * HD; jlo = 0; jhi = (t0 >> 4) >> 6;
            if (MODE == 0) { Vh = Vsrc + ((size_t)b * NCMPP * NSA_G + g) * HD; ldv = NSA_G * HD; } else { Vh = Vsrc; ldv = NSLC; } }
        else { Kh = Ksrc + rowb * KVW + g * HD; ldk = KVW; Vh = P1 + rowb * NSA_INP + (MODE == 2 ? P1_VS : P1_VW) + g * HD; ldv = NSA_INP;
            jhi = (t0 + 31) >> 6; jlo = (MODE == 2) ? 0 : ((t0 - (WINDOW - 1) > 0 ? t0 - (WINDOW - 1) : 0) >> 6); }
        bf16x8 qr[8]; load_q(qr, Qsrc + (rowb + t) * (MODE <= 1 ? NSA_INP : DM) + head * HD + hi * 8);
        unsigned selw[4] = {0u, 0u, 0u, 0u}, uni[4] = {~0u, ~0u, ~0u, ~0u}, wn[4] = {~0u, ~0u, ~0u, ~0u};
        if (MODE == 2) { const v4u sv = *(const v4u*)(SEL + ((rowb + t) * NSA_G + g) * 4); selw[0] = sv.x; selw[1] = sv.y; selw[2] = sv.z; selw[3] = sv.w;
            LAS unsigned* un = (LAS unsigned*)(lds + ATT_X_OFF);
#pragma unroll
            for (int q = 0; q < 4; ++q) { unsigned x = selw[q]; x |= __shfl_xor(x, 8); x |= __shfl_xor(x, 16); wn[q] = __builtin_amdgcn_readfirstlane(x); if (lane == 0) un[wid * 4 + q] = wn[q]; }
            LDS_WAIT(); __syncthreads();
#pragma unroll
            for (int q = 0; q < 4; ++q) { unsigned x = 0u;
#pragma unroll
                for (int w = 0; w < NWAVES; ++w) x |= un[w * 4 + q];
                uni[q] = __builtin_amdgcn_readfirstlane(x); } }
        float m_reg = -1e30f, l_reg = 0.f; f32x16 o[4] = {};
        const int cur = t >> 6;
#define NSA_NEXT(jj) do { if (MODE == 2) { while ((jj) <= jhi && !((pick4(uni, (jj) >> 5) >> ((jj) & 31)) & 1u)) ++(jj); } } while (0)
#define NSA_NEED(jj) (MODE != 2 || ((pick4(wn, (jj) >> 5) >> ((jj) & 31)) & 1u))
#define NSA_MASK(P0, P1, JJ) do { const int k0 = (JJ) * KVBLK; constexpr float NINF = -__builtin_inff(); \
            if (MODE <= 1) { if (!(16 * (k0 + 63) + 31 <= t0)) { \
                    _Pragma("unroll") for (int r = 0; r < 16; ++r) { if (!(16 * (k0 + crow(r, hi)) + 31 <= t)) P0[r] = NINF; if (!(16 * (k0 + 32 + crow(r, hi)) + 31 <= t)) P1[r] = NINF; } } } \
            else if (MODE == 2) { const bool mine = (pick4(selw, (JJ) >> 5) >> ((JJ) & 31)) & 1u; const int lim = mine ? ((JJ) < cur ? 0x7fffffff : t) : -1; \
                _Pragma("unroll") for (int r = 0; r < 16; ++r) { if (k0 + crow(r, hi) > lim) P0[r] = NINF; if (k0 + 32 + crow(r, hi) > lim) P1[r] = NINF; } } \
            else { if (!((k0 > t0 + 31 - WINDOW) && (k0 + 63 <= t0))) { \
                    _Pragma("unroll") for (int r = 0; r < 16; ++r) { const int ka = k0 + crow(r, hi), kb = ka + 32; \
                        if (!(ka <= t && ka > t - WINDOW)) P0[r] = NINF; if (!(kb <= t && kb > t - WINDOW)) P1[r] = NINF; } } } } while (0)
        int ja = jlo; NSA_NEXT(ja); int jb = ja + 1; NSA_NEXT(jb);
        __syncthreads();
        if (ja <= jhi) kv_dma(dm, Kh + (size_t)ja * KVBLK * ldk, Vh + (size_t)ja * KVBLK * ldv, lds, 0, wid);
        if (jb <= jhi) kv_dma(dm, Kh + (size_t)jb * KVBLK * ldk, Vh + (size_t)jb * KVBLK * ldv, lds, ATT_BUF, wid);
        int set = 0;
        while (ja <= jhi) {
            int jc = jb + 1; NSA_NEXT(jc); int jd = jc + 1; NSA_NEXT(jd);
            VM_WAIT(); __syncthreads();
            if (jc <= jhi) kv_dma(dm, Kh + (size_t)jc * KVBLK * ldk, Vh + (size_t)jc * KVBLK * ldv, lds, ATT_SET - set, wid);
            if (jd <= jhi) kv_dma(dm, Kh + (size_t)jd * KVBLK * ldk, Vh + (size_t)jd * KVBLK * ldv, lds, ATT_SET - set + ATT_BUF, wid);
            const bool nA = NSA_NEED(ja), nB = (jb <= jhi) && NSA_NEED(jb);
            f32x16 a0, a1, b0, b1;
            if (nA) qkt(a0, a1, lds + set + ATT_K_OFF, qr, r32, hi);
            if (nB) qkt(b0, b1, lds + set + ATT_BUF + ATT_K_OFF, qr, r32, hi);
            if (nA) { NSA_MASK(a0, a1, ja); attn_finish(a0, a1, o, m_reg, l_reg, wsc, vb0 + set, r32, hi); }
            if (nB) { NSA_MASK(b0, b1, jb); attn_finish(b0, b1, o, m_reg, l_reg, wsc, vb0 + set + ATT_BUF, r32, hi); }
            ja = jc; jb = jd; set = ATT_SET - set;
        }
#undef NSA_MASK
#undef NSA_NEED
#undef NSA_NEXT
        { float fac = l_reg > 0.f ? __builtin_amdgcn_rcpf(l_reg) : 0.f;
          if (MODE != 1) { const int br = MODE == 0 ? 0 : (MODE == 2 ? 1 : 2); fac *= sigmoidf_(bf2f(P1[(rowb + t) * NSA_INP + P1_GL + head * 3 + br])); }
          if (hi == 0) wsc[32 + r32] = fac; LDS_WAIT(); }
        if (MODE == 1) {
            float fc[16];
#pragma unroll
            for (int r = 0; r < 16; ++r) fc[r] = wsc[32 + crow(r, hi)];
            LDS_WAIT(); __syncthreads();
#pragma unroll
            for (int r = 0; r < 16; ++r) { const int orow = crow(r, hi);
#pragma unroll
                for (int d0 = 0; d0 < 4; ++d0) *(LAS float*)(lds + ((wid * 32 + orow) * 128 + d0 * 32 + r32) * 4) = o[d0][r] * fc[r]; }
            LDS_WAIT(); __syncthreads();
            { const int tok = tid >> 4, j8 = (tid & 15) * 8; f32x4 s0 = {0.f, 0.f, 0.f, 0.f}, s1 = {0.f, 0.f, 0.f, 0.f};
#pragma unroll
              for (int w = 0; w < 8; ++w) { const LAS f32x4* pp = (const LAS f32x4*)(lds + ((w * 32 + tok) * 128 + j8) * 4); s0 += pp[0]; s1 += pp[1]; }
              f32x4* dst = (f32x4*)(IMP + ((rowb + t0 + tok) * NSA_G + g) * NSLC + j8); dst[0] = s0; dst[1] = s1; }
            LDS_WAIT(); __syncthreads();
        } else {
#pragma unroll
            for (int r = 0; r < 16; ++r) { const int orow = crow(r, hi); const float fc = wsc[32 + orow];
                const size_t off = (MODE == 2) ? (rowb + t0 + 4 * wid + (orow >> 3)) * DM + (g * NSA_R + (orow & 7)) * HD + r32 : (rowb + t0 + orow) * DM + head * HD + r32;
#pragma unroll
                for (int d0 = 0; d0 < 4; ++d0) {
                    if (MODE == 0) O32[off + d0 * 32] = o[d0][r] * fc;
                    else if (MODE == 2) { if (!probe_nostore) O32[off + d0 * 32] += o[d0][r] * fc; }
                    else Ob[off + d0 * 32] = (bf16)f2bf(O32[off + d0 * 32] + o[d0][r] * fc); } }
            LDS_WAIT();
        }
    }
}
__device__ __forceinline__ void nsa_topk_phase(Frame& F, const float* IMP, unsigned* SEL) {
    LAS float* sc = (LAS float*)(F.lds + F.wave * 1024);
    const int gw = F.bid * NWAVES + F.wave, NGW = F.G * NWAVES, lane = F.lane;
    for (int it = gw; it < MTOK * NSA_G; it += NGW) {
        const int m = it / NSA_G, t = m & (SEQ - 1), cur = t >> 6;
        const float* ip = IMP + (size_t)it * NSLC;
        const float a0 = ip[lane], a1 = ip[64 + lane];
        sc[lane] = a0; sc[64 + lane] = a1; LDS_WAIT();
        const int j0 = lane, j1 = lane + 64;
        const bool f0 = (j0 == 0) || (j0 == cur) || (j0 == cur - 1), f1 = (j1 == cur) || (j1 == cur - 1);
        const bool c0 = !f0 && j0 <= cur, c1 = !f1 && j1 <= cur;
        const int nforced = cur >= 2 ? 3 : cur + 1, slots = NTOP - nforced;
        int rk0 = 0, rk1 = 0;
        const int ncand_hi = cur < NSLC ? cur : NSLC - 1;
        for (int i = 1; i <= ncand_hi; ++i) {
            const bool fi = (i == cur) || (i == cur - 1); if (fi) continue;
            const float v = sc[i];
            rk0 += (v > a0 || (v == a0 && i < j0)) ? 1 : 0; rk1 += (v > a1 || (v == a1 && i < j1)) ? 1 : 0;
        }
        const bool s0 = (f0 && j0 <= cur) || (c0 && rk0 < slots), s1 = (f1 && j1 <= cur) || (c1 && rk1 < slots);
        const unsigned long long m0 = __ballot(s0), m1 = __ballot(s1);
        if (lane == 0) { v4u w = {(unsigned)m0, (unsigned)(m0 >> 32), (unsigned)m1, (unsigned)(m1 >> 32)}; *(v4u*)(SEL + (size_t)it * 4) = w; }
        LDS_WAIT();
    }
}

#ifndef STAGE
#define STAGE 3
#endif
#define ZERO_OB_PHASE PH_BEGIN { v4u z = {0u, 0u, 0u, 0u}; v4u* p = (v4u*)Ob; const long n = (long)MTOK * DM / 8; \
            for (long i = (long)F.bid * NTHR + F.tid; i < n; i += (long)F.G * NTHR) p[i] = z; } PH_END
#define MIXER0_PHASES \
    PH_BEGIN { fold_finalize(F, FO_XQ, XW); fold_finalize(F, FO_UP, DFF2); } \
             REP(10) hgrn_phase_a(F, BIG, (const float*)(ws + WS_LB), (bf16*)(ws + WS_QT), (bf16*)(ws + WS_OINTRA), (bf16*)(ws + WS_DS), (float*)(ws + WS_DEC)); \
             REP(11) sb_phase(F, BIG, Ob); PH_END \
    PH_BEGIN REP(12) hgrn_phase_b(F, (const bf16*)(ws + WS_DS), (const float*)(ws + WS_DEC), (bf16*)(ws + WS_SPREV)); PH_END \
    PH_BEGIN REP(13) hgrn_phase_c(F, BIG, (const bf16*)(ws + WS_QT), (const bf16*)(ws + WS_OINTRA), (const bf16*)(ws + WS_SPREV), args.in[IN_HGRN_NW], Ob); PH_END
#if STAGE <= 2
#define MIXER1_PHASES ZERO_OB_PHASE
#else
#define MIXER1_PHASES \
    PH_BEGIN { fold_finalize(F, FO_XQ + XW, XW); } REP(14) { nsa_rope_phase(F, BIG, (const float*)(ws + WS_ROPE), (bf16*)(ws + WS_QROT), (bf16*)(ws + WS_KSROT), (bf16*)(ws + WS_KWROT), (bf16*)(ws + WS_OVL)); \
             nsa_compress_phase(F, BIG, args.in[IN_NSA_CMP_POS], (const bf16*)(ws + WS_W_C1), (const bf16*)(ws + WS_W_C2), (bf16*)(ws + WS_KCMP), (bf16*)(ws + WS_VCMP)); } PH_END \
    PH_BEGIN { REP(15) nsa_attn_phase<0>(F, BIG, BIG, (const bf16*)(ws + WS_KCMP), (const bf16*)(ws + WS_VCMP), nullptr, (float*)(ws + WS_O32), nullptr, nullptr); \
             REP(15) nsa_attn_phase<1>(F, BIG, BIG, (const bf16*)(ws + WS_KCMP), (const bf16*)(ws + WS_OVL), nullptr, nullptr, (float*)(ws + WS_IMP), nullptr); } PH_END \
    PH_BEGIN REP(16) nsa_topk_phase(F, (const float*)(ws + WS_IMP), (unsigned*)(ws + WS_SEL)); PH_END \
    PH_BEGIN REP(18) nsa_attn_phase<2>(F, BIG, (const bf16*)(ws + WS_QROT), (const bf16*)(ws + WS_KSROT), nullptr, (const unsigned*)(ws + WS_SEL), (float*)(ws + WS_O32), nullptr, nullptr, r_ > 0); PH_END \
    PH_BEGIN REP(17) nsa_attn_phase<3>(F, BIG, (const bf16*)(ws + WS_QROT), (const bf16*)(ws + WS_KWROT), nullptr, nullptr, (float*)(ws + WS_O32), nullptr, Ob); PH_END
#endif
#ifndef REPMASK
#define REPMASK 0u
#endif
#define REP(gid) for (int r_ = 0; r_ <= (int)((REPMASK >> (gid)) & 1u); ++r_)
#define PH_BEGIN if (pc >= lo && pc < hi) { F.fresh();
#define PH_END   if (pc + 1 < hi) { XcdBarrier bb_ = bar; asm volatile("" : "+s"(bb_.bar), "+s"(bb_.x)); xcd_barrier(bb_); } } ++pc;
template <int l>
__device__ __forceinline__ void layer_body(Frame& F, const Args& args, const XcdBarrier& bar, int& pc, const int lo, const int hi) {
    unsigned char* ws = args.ws;
    bf16* HB = (bf16*)(ws + WS_HB); bf16* Y = (bf16*)(ws + WS_Y); float* H32 = args.out;
    bf16* BIG = (bf16*)(ws + WS_BIG); bf16* Gm = (bf16*)(ws + WS_G); bf16* Ob = (bf16*)(ws + WS_O);
    bf16* XQ = (bf16*)(ws + WS_XQ); bf16* XO = (bf16*)(ws + WS_XO);
#define RS(k) ((long long*)(ws + WS_RSUM) + (size_t)(k) * MTOK * 2)
#define LNG(k) (args.in[IN_LN_G] + (size_t)(k) * DM)
#define LNB(k) (args.in[IN_LN_B] + (size_t)(k) * DM)
    const float* cs = (const float*)(ws + WS_FOLDF); const float* b2 = cs + FO_N;
        PH_BEGIN REP(1) {
            const int N = l == 0 ? AB_IN : NSA_INP;
            pg8::StaticOrder S; S.init(MTOK, N, F.G, F.bid);
            if (l == 0) { pg8::Gemm g{HB, (const bf16*)(ws + WS_W_ABIN), MTOK, N, DM}; pg8::EpiBf16<0> E{BIG, N, nullptr, 0, 0, 1.f};
                pg8::gemm_phase<pg8::EpiBf16<0>, pg8::StaticOrder, PG8_ALIGN, PG8_SP2>(F.lds + RING_OFF, g, S, E); }
            else { pg8::Gemm g{Y, (const bf16*)(ws + WS_W_NSAIN), MTOK, N, DM}; pg8::EpiBf16Ln E{BIG, N, RS(2), cs + FO_NSA, b2 + FO_NSA};
                pg8::gemm_phase<pg8::EpiBf16Ln, pg8::StaticOrder, PG8_ALIGN, PG8_SP2>(F.lds + RING_OFF, g, S, E);
                if (r_ == 0) convert_job<CJ_L1A>(F, args, 64, 192); }
        } PH_END
#if STAGE <= 1
        ZERO_OB_PHASE
#else
        if (l == 0) {
            MIXER0_PHASES
        } else {
            MIXER1_PHASES
        }
#endif
        PH_BEGIN REP(2) {
            pg8::Gemm g{Ob, l == 0 ? (const bf16*)(ws + WS_W_ABOUT) : (const bf16*)(ws + WS_W_NSAOUT), MTOK, DM, DM};
            pg8::StaticOrder S; S.init(MTOK, DM, F.G, F.bid);
            if (l == 0) { pg8::EpiRes0 E{Y, HB, DM, DN_ALPHA, RS(0)};
                pg8::gemm_phase<pg8::EpiRes0, pg8::StaticOrder, PG8_ALIGN, PG8_SP2>(F.lds + RING_OFF, g, S, E); }
            else { pg8::EpiResLn2 E{Y, RS(2), LNG(2), LNB(2), DM, DN_ALPHA, RS(3)};
                pg8::gemm_phase<pg8::EpiResLn2, pg8::StaticOrder, PG8_ALIGN, PG8_SP2>(F.lds + RING_OFF, g, S, E); }
        } PH_END
        PH_BEGIN REP(3) {
            {   pg8::Gemm g{Y, (const bf16*)(ws + WS_W_XQ) + (size_t)l * XW * DM, MTOK, XW, DM};
                pg8::RangeOrder S; S.init(MTOK, XW, 0, 128, F.bid);
                pg8::EpiBf16Ln E{XQ, XW, RS(3 * l), cs + FO_XQ + l * XW, b2 + FO_XQ + l * XW};
                pg8::gemm_phase<pg8::EpiBf16Ln, pg8::RangeOrder, PG8_ALIGN, PG8_SP2>(F.lds + RING_OFF, g, S, E); }
            {   pg8::Gemm g{(const bf16*)(ws + WS_MEMB), (const bf16*)(ws + WS_W_XKV) + (size_t)l * 2 * XW * DM, BATCH * NMEM, 2 * XW, DM};
                pg8::RangeOrder S; S.init(BATCH * NMEM, 2 * XW, 128, 8, F.bid);
                pg8::EpiBf16<0> E{(bf16*)(ws + WS_XKV) + (size_t)l * BATCH * NMEM * 2 * XW, 2 * XW, nullptr, 0, 0, 1.f};
                pg8::gemm_phase<pg8::EpiBf16<0>, pg8::RangeOrder, PG8_ALIGN, PG8_SP2>(F.lds + RING_OFF, g, S, E); }
            if (r_ == 0) { if (l == 0) convert_job<CJ_DOWN0>(F, args, 136, 120); else convert_job<CJ_L1B>(F, args, 136, 120); }
        } PH_END
        PH_BEGIN { if (l == 1) fold_finalize(F, FO_UP + DFF2, DFF2); } REP(9) xattn_phase(F, XQ, (const bf16*)(ws + WS_XKV) + (size_t)l * BATCH * NMEM * 2 * XW, XO); PH_END
        PH_BEGIN REP(4) {
            pg8::Gemm g{XO, (const bf16*)(ws + WS_W_XO) + (size_t)l * DM * XW, MTOK, DM, XW};
            pg8::StaticOrder S; S.init(MTOK, DM, F.G, F.bid);
            pg8::EpiResLn2 E{Y, RS(3 * l), LNG(3 * l), LNB(3 * l), DM, DN_ALPHA, RS(3 * l + 1)};
            pg8::gemm_phase<pg8::EpiResLn2, pg8::StaticOrder, PG8_ALIGN, PG8_SP2>(F.lds + RING_OFF, g, S, E);
        } PH_END
        PH_BEGIN REP(5) {
#if (REPMASK >> 22) & 1
            if (r_ > 0) { XcdBarrier bb_ = bar; asm volatile("" : "+s"(bb_.bar), "+s"(bb_.x)); xcd_barrier(bb_); }
#endif
            pg8::Gemm g{Y, (const bf16*)(ws + WS_W_UP) + (size_t)l * DFF2 * DM, MTOK, DFF2, DM};
            pg8::StaticOrder S; S.init(MTOK, DFF2, F.G, F.bid);
            pg8::EpiBf16Ln E{BIG, DFF2, RS(3 * l + 1), cs + FO_UP + l * DFF2, b2 + FO_UP + l * DFF2};
            pg8::gemm_phase<pg8::EpiBf16Ln, pg8::StaticOrder, PG8_ALIGN, PG8_SP2>(F.lds + RING_OFF, g, S, E);
            if (r_ == 0) { if (l == 0) convert_job<CJ_NSA>(F, args, 128, 128); else convert_job<CJ_DOWN1>(F, args, 128, 128); }
        } PH_END
#if (REPMASK >> 20) & 1
        PH_BEGIN {
            pg8::Gemm g{HB, (const bf16*)(ws + WS_W_UP) + (size_t)l * DFF2 * DM, MTOK, DFF2, DM};
            pg8::ZeroOrder S; S.init(MTOK, DFF2, F.G, F.bid);
            pg8::EpiBf16<0> E{Gm, DFF2, nullptr, 0, 0, 1.f};
            pg8::gemm_phase<pg8::EpiBf16<0>, pg8::ZeroOrder, PG8_ALIGN, PG8_SP2>(F.lds + RING_OFF, g, S, E);
        } PH_END
#endif
        PH_BEGIN { if (l == 0) fold_finalize(F, FO_NSA, NSA_INP); } REP(8) convglu_phase(F, BIG, args.in[IN_FFN_CONV] + (size_t)l * 3 * DFF, Gm); PH_END
        PH_BEGIN REP(6) {
            pg8::Gemm g{Gm, (const bf16*)(ws + WS_W_DOWN) + (size_t)l * DM * DFF, MTOK, DM, DFF};
            pg8::StaticOrder S; S.init(MTOK, DM, F.G, F.bid);
            pg8::EpiResLn2 E{Y, RS(3 * l + 1), LNG(3 * l + 1), LNB(3 * l + 1), DM, DN_ALPHA, RS(3 * l + 2)};
            pg8::gemm_phase<pg8::EpiResLn2, pg8::StaticOrder, PG8_ALIGN, PG8_SP2>(F.lds + RING_OFF, g, S, E);
        } PH_END
        if (l == 1) { PH_BEGIN REP(7) ln_phase(F, Y, LNG(5), LNB(5), H32); PH_END }
#undef RS
#undef LNG
#undef LNB
}
__global__ void __launch_bounds__(NTHR, 2) mega_fwd(Args args) {
    extern __shared__ __attribute__((aligned(16))) unsigned char lds_raw[];
    Frame F;
    F.lds = (LAS unsigned char*)lds_raw; F.ws = args.ws;
    F.tid = threadIdx.x; F.lane = F.tid & 63; F.wave = __builtin_amdgcn_readfirstlane(F.tid >> 6); F.G = gridDim.x;
    unsigned char* ws = args.ws;
    gu32* ctl = (gu32*)(ws + WS_CTL);
    for (int u = F.tid; u < (LDS_BYTES - LDSCTL_OFF) / 4; u += NTHR) ((LAS unsigned*)(F.lds + LDSCTL_OFF))[u] = 0u;
    __syncthreads();
    volatile LAS unsigned* MISC = (volatile LAS unsigned*)(F.lds + MISC_OFF);
    XcdBarrier bar = xcd_barrier_post((unsigned*)(ctl + CW_BAR), MISC + 8);
    const int lo = args.ph_lo, hi = args.ph_hi; int pc = 0;
    bf16* HB = (bf16*)(ws + WS_HB); bf16* Y = (bf16*)(ws + WS_Y); float* H32 = args.out;
    bf16* BIG = (bf16*)(ws + WS_BIG); bf16* Gm = (bf16*)(ws + WS_G); bf16* Ob = (bf16*)(ws + WS_O);
    bf16* XQ = (bf16*)(ws + WS_XQ); bf16* XO = (bf16*)(ws + WS_XO);

    PH_BEGIN REP(0) p0_prologue(F, args); PH_END

#if (REPMASK >> 21) & 1
    for (int e_ = 0; e_ < 40; ++e_) { PH_BEGIN PH_END }
#endif
    layer_body<0>(F, args, bar, pc, lo, hi);
    layer_body<1>(F, args, bar, pc, lo, hi);
}

extern "C" void kernel_launch(void* const* d_in, const int* in_sizes, int n_in, void* d_out, int out_size, void* d_ws, size_t ws_size, hipStream_t stream) {
    static int grid = 0;
    if (grid == 0) {
        if (n_in != 19 || in_sizes[0] != MTOK * DM || out_size != MTOK * DM || ws_size < WS_END) {
            fprintf(stderr, "kernel_launch: shape mismatch n_in %d in0 %d out %d ws %zu (need %zu)\n", n_in, n_in > 0 ? in_sizes[0] : -1, out_size, ws_size, (size_t)WS_END); grid = -1; return; }
        int dev = 0, cus = 0, per_cu = 0;
        if (hipGetDevice(&dev) != hipSuccess || hipDeviceGetAttribute(&cus, hipDeviceAttributeMultiprocessorCount, dev) != hipSuccess) { grid = -1; return; }
        if (hipFuncSetAttribute((const void*)mega_fwd, hipFuncAttributeMaxDynamicSharedMemorySize, LDS_BYTES) != hipSuccess) { fprintf(stderr, "kernel_launch: hipFuncSetAttribute failed\n"); grid = -1; return; }
        if (hipOccupancyMaxActiveBlocksPerMultiprocessor(&per_cu, (const void*)mega_fwd, NTHR, LDS_BYTES) != hipSuccess || per_cu < 1)
            fprintf(stderr, "kernel_launch: note: occupancy query reports %d workgroups per CU\n", per_cu);
        (void)hipGetLastError();
        grid = cus;
    }
    if (grid < 0) return;
    if (hipMemsetAsync((char*)d_ws + WS_CTL, 0, CTL_ZERO_BYTES, stream) != hipSuccess) { fprintf(stderr, "kernel_launch: memset failed\n"); return; }
    Args a{};
    for (int i = 0; i < 19; ++i) a.in[i] = (const float*)d_in[i];
    a.out = (float*)d_out; a.ws = (unsigned char*)d_ws; a.ph_lo = 0; a.ph_hi = 1 << 20;
    hipLaunchKernelGGL(mega_fwd, dim3(grid), dim3(NTHR), LDS_BYTES, stream, a);
    const hipError_t le = hipPeekAtLastError();
    if (le != hipSuccess) fprintf(stderr, "kernel_launch: launch failed: %s\n", hipGetErrorName(le));
}
```

```cpp
#include <hip/hip_runtime.h>
#include <cstdio>
#include <cstdint>
namespace pg8 {
#define PG8_LAS __attribute__((address_space(3)))
typedef unsigned short bf16_t;
typedef short bf16x8 __attribute__((ext_vector_type(8)));
typedef float f32x4 __attribute__((ext_vector_type(4)));
typedef unsigned u32x4 __attribute__((ext_vector_type(4)));
constexpr int BM = 256, BK = 64, HALF = 128, HTB = HALF * BK * 2  , STAGE_BYTES = 8 * HTB, NXCD = 8, WGM = 8;

__host__ __device__ __forceinline__ int lds_byte(int r, int c) { const int st = (r >> 4) * 2 + (c >> 5), rr = r & 15, cc = c & 31, ob = rr * 64 + cc * 2; return st * 1024 + (ob ^ (((ob >> 9) & 1) << 5)); }
__host__ __device__ __forceinline__ void stage_rc(int b, int& R, int& C) { const int st = b / 1024, sb = b % 1024, swz = sb ^ (((sb >> 9) & 1) << 5); R = (st >> 1) * 16 + swz / 64; C = (st & 1) * 32 + (swz % 64) / 2; }
__host__ __device__ __forceinline__ int perm32(int rho) { const int n = rho >> 4, i = rho & 15; return 8 * (i >> 2) + 4 * n + (i & 3); }

struct Unit { int pm, pn; };
struct Gemm { const bf16_t* A; const bf16_t* Bt; int M, N, K; };

struct StaticOrder {
    int nM, nN, nwg, G, c;
    __host__ __device__ void init(int M, int N, int G_, int c_) { nM = M / BM; nN = N / BM; nwg = nM * nN; G = G_; c = c_; }
    __host__ __device__ bool next(int i, Unit& u) const {
        const long L = (long)i * G + c; if (L >= nwg) return false;
        int wgid = (int)L; { const int q = nwg / NXCD, r = nwg % NXCD, xcd = wgid % NXCD, off = wgid / NXCD; wgid = (xcd < r ? xcd * (q + 1) : r * (q + 1) + (xcd - r) * q) + off; }
        const int nig = WGM * nN, gid = wgid / nig, fm = gid * WGM, gsz = (nM - fm) < WGM ? (nM - fm) : WGM;
        u.pm = fm + ((wgid % nig) % gsz); u.pn = (wgid % nig) / gsz; return true;
    }
    __device__ __forceinline__ void a_ready(const Unit&) const {}
    __device__ __forceinline__ void done(const Unit&) const {}
};

__device__ __forceinline__ unsigned cvt_pk_bf16(float lo, float hi) { unsigned r; asm volatile("v_cvt_pk_bf16_f32 %0, %1, %2" : "=v"(r) : "v"(lo), "v"(hi)); return r; }
typedef float f32x2 __attribute__((ext_vector_type(2)));
__device__ __forceinline__ f32x2 gelu_pk(f32x2 v) {
    const f32x2 av = __builtin_elementwise_abs(v), d = av * 0.2316418882f + 1.0f;
    f32x2 t; t.x = __builtin_amdgcn_rcpf(d.x); t.y = __builtin_amdgcn_rcpf(d.y);
    f32x2 q = t * 0.5307027145f + (-0.7265760135f); q = q * t + 0.7107068705f; q = q * t + (-0.142248368f); q = q * t + 0.127414796f; q = q * t;
    const f32x2 s = (v * v) * (-0.72134752044f);
    f32x2 e; e.x = __builtin_amdgcn_exp2f(s.x); e.y = __builtin_amdgcn_exp2f(s.y);
    const f32x2 m = v * (q * e), r = v - m;
    f32x2 o; o.x = v.x < 0.f ? m.x : r.x; o.y = v.y < 0.f ? m.y : r.y; return o;
}

template <int ACT  > struct EpiBf16 {
    static constexpr bool PERM = true, AFTER_DRAIN = false; static_assert(ACT == 0 || ACT == 1, "EpiBf16: ACT is 0 (none) or 1 (gelu_pk)");
    bf16_t* O; int ldc; const float* bias; int split_cols; size_t split_stride; float scale0;
    __device__ __forceinline__ void operator()(const f32x4 (&acc)[2][2][4][2], const Unit& u, int wr, int wc, int fr, int fq) const {
        const int row0 = u.pm * BM + wr * 64 + fr; int colt = u.pn * BM; bf16_t* base = O;
        float sc = 1.f; if (split_cols) { const int t = colt / split_cols; base += (size_t)t * split_stride; colt -= t * split_cols; if (t == 0) sc = scale0; }
        const int col0 = colt + wc * 32 + 8 * fq, bcol0 = u.pn * BM + wc * 32 + 8 * fq;
        f32x4 bv[2][2];
#pragma unroll
        for (int bj = 0; bj < 2; ++bj)
#pragma unroll
            for (int n = 0; n < 2; ++n) bv[bj][n] = bias ? *(const f32x4*)(bias + bcol0 + bj * HALF + 4 * n) : (f32x4){0.f, 0.f, 0.f, 0.f};
#pragma unroll
        for (int ai = 0; ai < 2; ++ai)
#pragma unroll
            for (int m = 0; m < 4; ++m) { bf16_t* rowp = base + (size_t)(row0 + ai * HALF + m * 16) * ldc + col0;
#pragma unroll
                for (int bj = 0; bj < 2; ++bj) { f32x4 v0 = acc[ai][bj][m][0] + bv[bj][0], v1 = acc[ai][bj][m][1] + bv[bj][1];
                    if (ACT == 1) { f32x2 a = gelu_pk((f32x2){v0[0], v0[1]}), b = gelu_pk((f32x2){v0[2], v0[3]}), c = gelu_pk((f32x2){v1[0], v1[1]}), d = gelu_pk((f32x2){v1[2], v1[3]});
                        v0 = (f32x4){a.x, a.y, b.x, b.y}; v1 = (f32x4){c.x, c.y, d.x, d.y}; }
                    v0 = v0 * sc; v1 = v1 * sc; u32x4 w; w.x = cvt_pk_bf16(v0[0], v0[1]); w.y = cvt_pk_bf16(v0[2], v0[3]); w.z = cvt_pk_bf16(v1[0], v1[1]); w.w = cvt_pk_bf16(v1[2], v1[3]);
                    *(u32x4*)(rowp + bj * HALF) = w; } }
    }
};


struct EpiRes {
    static constexpr bool PERM = false, AFTER_DRAIN = false;
    float* Y; const float* res; int ldc; float alpha;
    __device__ __forceinline__ void operator()(const f32x4 (&acc)[2][2][4][2], const Unit& u, int wr, int wc, int fr, int fq) const {
        const int row0 = u.pm * BM + wr * 64 + fr, col0 = u.pn * BM + wc * 32 + 4 * fq;
#pragma unroll
        for (int ai = 0; ai < 2; ++ai)
#pragma unroll
            for (int m = 0; m < 4; ++m) { const size_t off = (size_t)(row0 + ai * HALF + m * 16) * ldc + col0;
#pragma unroll
                for (int bj = 0; bj < 2; ++bj)
#pragma unroll
                    for (int n = 0; n < 2; ++n) { const f32x4 r = *(const f32x4*)(res + off + bj * HALF + n * 16);
                        *(f32x4*)(Y + off + bj * HALF + n * 16) = r * alpha + acc[ai][bj][m][n]; } }
    }
};
struct RangeOrder {
    int nM, nN, ntot, c0, nw, c;
    __host__ __device__ void init(int M, int N, int c0_, int nw_, int c_) { nM = M / BM; nN = N / BM; ntot = nM * nN; c0 = c0_; nw = nw_; c = c_; }
    __host__ __device__ bool next(int i, Unit& u) const {
        if (c < c0 || c >= c0 + nw) return false;
        const int L = i * nw + (c - c0); if (L >= ntot) return false;
        u.pm = L / nN; u.pn = L % nN; return true;
    }
    __device__ __forceinline__ void a_ready(const Unit&) const {}
    __device__ __forceinline__ void done(const Unit&) const {}
};

struct ZeroOrder : StaticOrder {
    __host__ __device__ bool next(int i, Unit& u) const { const bool r = StaticOrder::next(i, u); u.pm = 0; u.pn = 0; return r; }
};

struct EpiResBf {
    static constexpr bool PERM = true, AFTER_DRAIN = false;
    bf16_t* Y; const bf16_t* res; int ldc; float alpha;
    __device__ __forceinline__ void operator()(const f32x4 (&acc)[2][2][4][2], const Unit& u, int wr, int wc, int fr, int fq) const {
        const int row0 = u.pm * BM + wr * 64 + fr, col0 = u.pn * BM + wc * 32 + 8 * fq;
#pragma unroll
        for (int ai = 0; ai < 2; ++ai)
#pragma unroll
            for (int m = 0; m < 4; ++m) { const size_t off = (size_t)(row0 + ai * HALF + m * 16) * ldc + col0;
#pragma unroll
                for (int bj = 0; bj < 2; ++bj) { const u32x4 r = *(const u32x4*)(res + off + bj * HALF);
                    const f32x4 v0 = acc[ai][bj][m][0], v1 = acc[ai][bj][m][1];
                    u32x4 w;
                    w.x = cvt_pk_bf16(__builtin_bit_cast(float, r.x << 16) * alpha + v0[0], __builtin_bit_cast(float, r.x & 0xffff0000u) * alpha + v0[1]);
                    w.y = cvt_pk_bf16(__builtin_bit_cast(float, r.y << 16) * alpha + v0[2], __builtin_bit_cast(float, r.y & 0xffff0000u) * alpha + v0[3]);
                    w.z = cvt_pk_bf16(__builtin_bit_cast(float, r.z << 16) * alpha + v1[0], __builtin_bit_cast(float, r.z & 0xffff0000u) * alpha + v1[1]);
                    w.w = cvt_pk_bf16(__builtin_bit_cast(float, r.w << 16) * alpha + v1[2], __builtin_bit_cast(float, r.w & 0xffff0000u) * alpha + v1[3]);
                    *(u32x4*)(Y + off + bj * HALF) = w; } }
    }
};

struct EpiResF {
    static constexpr bool PERM = true, AFTER_DRAIN = false;
    float* Y; const bf16_t* res; int ldc; float alpha;
    __device__ __forceinline__ void operator()(const f32x4 (&acc)[2][2][4][2], const Unit& u, int wr, int wc, int fr, int fq) const {
        const int row0 = u.pm * BM + wr * 64 + fr, col0 = u.pn * BM + wc * 32 + 8 * fq;
#pragma unroll
        for (int ai = 0; ai < 2; ++ai)
#pragma unroll
            for (int m = 0; m < 4; ++m) { const size_t off = (size_t)(row0 + ai * HALF + m * 16) * ldc + col0;
#pragma unroll
                for (int bj = 0; bj < 2; ++bj) { const u32x4 r = *(const u32x4*)(res + off + bj * HALF);
                    f32x4 o0, o1;
                    o0[0] = __builtin_bit_cast(float, r.x << 16); o0[1] = __builtin_bit_cast(float, r.x & 0xffff0000u); o0[2] = __builtin_bit_cast(float, r.y << 16); o0[3] = __builtin_bit_cast(float, r.y & 0xffff0000u);
                    o1[0] = __builtin_bit_cast(float, r.z << 16); o1[1] = __builtin_bit_cast(float, r.z & 0xffff0000u); o1[2] = __builtin_bit_cast(float, r.w << 16); o1[3] = __builtin_bit_cast(float, r.w & 0xffff0000u);
                    *(f32x4*)(Y + off + bj * HALF) = o0 * alpha + acc[ai][bj][m][0]; *(f32x4*)(Y + off + bj * HALF + 4) = o1 * alpha + acc[ai][bj][m][1]; } }
    }
};

struct EpiResLn {
    static constexpr bool PERM = true, AFTER_DRAIN = false;
    bf16_t* Y; const float* stats; const float* g; const float* b; int ldc; float alpha;
    __device__ __forceinline__ void operator()(const f32x4 (&acc)[2][2][4][2], const Unit& u, int wr, int wc, int fr, int fq) const {
        const int row0 = u.pm * BM + wr * 64 + fr, col0 = u.pn * BM + wc * 32 + 8 * fq;
        f32x4 gv[2][2], bv[2][2];
#pragma unroll
        for (int bj = 0; bj < 2; ++bj)
#pragma unroll
            for (int n = 0; n < 2; ++n) { gv[bj][n] = *(const f32x4*)(g + col0 + bj * HALF + 4 * n) * alpha; bv[bj][n] = *(const f32x4*)(b + col0 + bj * HALF + 4 * n) * alpha; }
#pragma unroll
        for (int ai = 0; ai < 2; ++ai)
#pragma unroll
            for (int m = 0; m < 4; ++m) { const int row = row0 + ai * HALF + m * 16; const size_t off = (size_t)row * ldc + col0;
                const float mean = stats[2 * row], rstd = stats[2 * row + 1];
#pragma unroll
                for (int bj = 0; bj < 2; ++bj) { const u32x4 r = *(const u32x4*)(Y + off + bj * HALF);
                    f32x4 y0, y1;
                    y0[0] = __builtin_bit_cast(float, r.x << 16); y0[1] = __builtin_bit_cast(float, r.x & 0xffff0000u); y0[2] = __builtin_bit_cast(float, r.y << 16); y0[3] = __builtin_bit_cast(float, r.y & 0xffff0000u);
                    y1[0] = __builtin_bit_cast(float, r.z << 16); y1[1] = __builtin_bit_cast(float, r.z & 0xffff0000u); y1[2] = __builtin_bit_cast(float, r.w << 16); y1[3] = __builtin_bit_cast(float, r.w & 0xffff0000u);
                    const f32x4 o0 = (y0 - mean) * rstd * gv[bj][0] + bv[bj][0] + acc[ai][bj][m][0], o1 = (y1 - mean) * rstd * gv[bj][1] + bv[bj][1] + acc[ai][bj][m][1];
                    u32x4 w; w.x = cvt_pk_bf16(o0[0], o0[1]); w.y = cvt_pk_bf16(o0[2], o0[3]); w.z = cvt_pk_bf16(o1[0], o1[1]); w.w = cvt_pk_bf16(o1[2], o1[3]);
                    *(u32x4*)(Y + off + bj * HALF) = w; } }
    }
};

constexpr float RS_SCALE = 1048576.0f, RS_INV = 1.0f / 1048576.0f;
__device__ __forceinline__ float fx20_to_f(long long v) { return (float)(int)(v >> 20) + (float)((unsigned)v & 0xFFFFFu) * RS_INV; }
__device__ __forceinline__ long long f_to_fx20(float s) { const float fl = floorf(s); return ((long long)(int)fl << 20) + (long long)(unsigned)((s - fl) * RS_SCALE + 0.5f); }
__device__ __forceinline__ void row_stats(const long long* rs, int row, float& mean, float& rstd) {
    const long long a = rs[2 * (size_t)row], b = rs[2 * (size_t)row + 1];
    mean = fx20_to_f(a) * (1.0f / 4096.0f); const float var = fx20_to_f(b) * (1.0f / 4096.0f) - mean * mean; rstd = 1.0f / sqrtf(var + 1e-5f);
}
constexpr float FOLD_SCALE = 4294967296.0f, FOLD_INV = 1.0f / 4294967296.0f;
struct EpiBf16Ln {
    static constexpr bool PERM = true, AFTER_DRAIN = false;
    bf16_t* O; int ldc; const long long* rs; const float* cs; const float* b2;
    __device__ __forceinline__ void operator()(const f32x4 (&acc)[2][2][4][2], const Unit& u, int wr, int wc, int fr, int fq) const {
        const int row0 = u.pm * BM + wr * 64 + fr, col0 = u.pn * BM + wc * 32 + 8 * fq;
        f32x4 cv[2][2], bv[2][2];
#pragma unroll
        for (int bj = 0; bj < 2; ++bj)
#pragma unroll
            for (int n = 0; n < 2; ++n) { cv[bj][n] = *(const f32x4*)(cs + col0 + bj * HALF + 4 * n); bv[bj][n] = *(const f32x4*)(b2 + col0 + bj * HALF + 4 * n); }
#pragma unroll
        for (int ai = 0; ai < 2; ++ai)
#pragma unroll
            for (int m = 0; m < 4; ++m) { const int row = row0 + ai * HALF + m * 16; float mean, rstd; row_stats(rs, row, mean, rstd);
                bf16_t* rowp = O + (size_t)row * ldc + col0;
#pragma unroll
                for (int bj = 0; bj < 2; ++bj) { const f32x4 v0 = (acc[ai][bj][m][0] - cv[bj][0] * mean) * rstd + bv[bj][0], v1 = (acc[ai][bj][m][1] - cv[bj][1] * mean) * rstd + bv[bj][1];
                    u32x4 w; w.x = cvt_pk_bf16(v0[0], v0[1]); w.y = cvt_pk_bf16(v0[2], v0[3]); w.z = cvt_pk_bf16(v1[0], v1[1]); w.w = cvt_pk_bf16(v1[2], v1[3]);
                    *(u32x4*)(rowp + bj * HALF) = w; } }
    }
};
__device__ __forceinline__ void row_sums_add(long long* rso, int row, const f32x4& a, const f32x4& b, const f32x4& c, const f32x4& d, int fq) {
    float s1 = ((a[0] + a[1]) + (a[2] + a[3])) + ((b[0] + b[1]) + (b[2] + b[3])) + ((c[0] + c[1]) + (c[2] + c[3])) + ((d[0] + d[1]) + (d[2] + d[3]));
    float s2 = ((a[0] * a[0] + a[1] * a[1]) + (a[2] * a[2] + a[3] * a[3])) + ((b[0] * b[0] + b[1] * b[1]) + (b[2] * b[2] + b[3] * b[3]))
             + ((c[0] * c[0] + c[1] * c[1]) + (c[2] * c[2] + c[3] * c[3])) + ((d[0] * d[0] + d[1] * d[1]) + (d[2] * d[2] + d[3] * d[3]));
    s1 += __shfl_xor(s1, 16); s1 += __shfl_xor(s1, 32); s2 += __shfl_xor(s2, 16); s2 += __shfl_xor(s2, 32);
    if (fq == 0) { atomicAdd((unsigned long long*)(rso + 2 * (size_t)row), (unsigned long long)f_to_fx20(s1)); atomicAdd((unsigned long long*)(rso + 2 * (size_t)row + 1), (unsigned long long)f_to_fx20(s2)); }
}
struct EpiRes0 {
    static constexpr bool PERM = true, AFTER_DRAIN = false;
    bf16_t* Y; const bf16_t* res; int ldc; float alpha; long long* rso;
    __device__ __forceinline__ void operator()(const f32x4 (&acc)[2][2][4][2], const Unit& u, int wr, int wc, int fr, int fq) const {
        const int row0 = u.pm * BM + wr * 64 + fr, col0 = u.pn * BM + wc * 32 + 8 * fq;
#pragma unroll
        for (int ai = 0; ai < 2; ++ai)
#pragma unroll
            for (int m = 0; m < 4; ++m) { const int row = row0 + ai * HALF + m * 16; const size_t off = (size_t)row * ldc + col0; f32x4 o[2][2];
#pragma unroll
                for (int bj = 0; bj < 2; ++bj) { const u32x4 r = *(const u32x4*)(res + off + bj * HALF);
                    f32x4 y0, y1;
                    y0[0] = __builtin_bit_cast(float, r.x << 16); y0[1] = __builtin_bit_cast(float, r.x & 0xffff0000u); y0[2] = __builtin_bit_cast(float, r.y << 16); y0[3] = __builtin_bit_cast(float, r.y & 0xffff0000u);
                    y1[0] = __builtin_bit_cast(float, r.z << 16); y1[1] = __builtin_bit_cast(float, r.z & 0xffff0000u); y1[2] = __builtin_bit_cast(float, r.w << 16); y1[3] = __builtin_bit_cast(float, r.w & 0xffff0000u);
                    o[bj][0] = y0 * alpha + acc[ai][bj][m][0]; o[bj][1] = y1 * alpha + acc[ai][bj][m][1];
                    u32x4 w; w.x = cvt_pk_bf16(o[bj][0][0], o[bj][0][1]); w.y = cvt_pk_bf16(o[bj][0][2], o[bj][0][3]); w.z = cvt_pk_bf16(o[bj][1][0], o[bj][1][1]); w.w = cvt_pk_bf16(o[bj][1][2], o[bj][1][3]);
                    *(u32x4*)(Y + off + bj * HALF) = w; }
                row_sums_add(rso, row, o[0][0], o[0][1], o[1][0], o[1][1], fq); }
    }
};
struct EpiResLn2 {
    static constexpr bool PERM = true, AFTER_DRAIN = false;
    bf16_t* Y; const long long* rsi; const float* g; const float* b; int ldc; float alpha; long long* rso;
    __device__ __forceinline__ void operator()(const f32x4 (&acc)[2][2][4][2], const Unit& u, int wr, int wc, int fr, int fq) const {
        const int row0 = u.pm * BM + wr * 64 + fr, col0 = u.pn * BM + wc * 32 + 8 * fq;
        f32x4 gv[2][2], bv[2][2];
#pragma unroll
        for (int bj = 0; bj < 2; ++bj)
#pragma unroll
            for (int n = 0; n < 2; ++n) { gv[bj][n] = *(const f32x4*)(g + col0 + bj * HALF + 4 * n) * alpha; bv[bj][n] = *(const f32x4*)(b + col0 + bj * HALF + 4 * n) * alpha; }
#pragma unroll
        for (int ai = 0; ai < 2; ++ai)
#pragma unroll
            for (int m = 0; m < 4; ++m) { const int row = row0 + ai * HALF + m * 16; const size_t off = (size_t)row * ldc + col0; float mean, rstd; row_stats(rsi, row, mean, rstd); f32x4 o[2][2];
#pragma unroll
                for (int bj = 0; bj < 2; ++bj) { const u32x4 r = *(const u32x4*)(Y + off + bj * HALF);
                    f32x4 y0, y1;
                    y0[0] = __builtin_bit_cast(float, r.x << 16); y0[1] = __builtin_bit_cast(float, r.x & 0xffff0000u); y0[2] = __builtin_bit_cast(float, r.y << 16); y0[3] = __builtin_bit_cast(float, r.y & 0xffff0000u);
                    y1[0] = __builtin_bit_cast(float, r.z << 16); y1[1] = __builtin_bit_cast(float, r.z & 0xffff0000u); y1[2] = __builtin_bit_cast(float, r.w << 16); y1[3] = __builtin_bit_cast(float, r.w & 0xffff0000u);
                    o[bj][0] = (y0 - mean) * rstd * gv[bj][0] + bv[bj][0] + acc[ai][bj][m][0]; o[bj][1] = (y1 - mean) * rstd * gv[bj][1] + bv[bj][1] + acc[ai][bj][m][1];
                    u32x4 w; w.x = cvt_pk_bf16(o[bj][0][0], o[bj][0][1]); w.y = cvt_pk_bf16(o[bj][0][2], o[bj][0][3]); w.z = cvt_pk_bf16(o[bj][1][0], o[bj][1][1]); w.w = cvt_pk_bf16(o[bj][1][2], o[bj][1][3]);
                    *(u32x4*)(Y + off + bj * HALF) = w; }
                row_sums_add(rso, row, o[0][0], o[0][1], o[1][0], o[1][1], fq); }
    }
};
template <class Epi, class Sched, bool ALIGN_EPI = false, bool SP2 = false>
__device__ __forceinline__ void gemm_phase(PG8_LAS unsigned char* lds, const Gemm g, const Sched& S, const Epi& E) {
    int tid_l = threadIdx.x; asm volatile("" : "+v"(tid_l)); const int tid = tid_l, wid = __builtin_amdgcn_readfirstlane(tid >> 6), lane = tid & 63, wr = wid >> 2, wc = wid & 3, fr = lane & 15, fq = lane >> 4;
    const int K = g.K, nt = K / BK;
    unsigned voffA[2], voffB[2];
#pragma unroll
    for (int i = 0; i < 2; ++i) { int R, C; stage_rc(tid * 16 + i * 8192, R, C); const int Rb = Epi::PERM ? ((R & ~31) + perm32(R & 31)) : R;
        voffA[i] = (unsigned)(R * K + C) * 2u; voffB[i] = (unsigned)(Rb * K + C) * 2u; }
    const size_t kstep = (size_t)(BK * 2);
    const size_t hstep = (size_t)HALF * K * 2;
    const size_t tstep = 2 * hstep;
    const unsigned ldsw = (unsigned)wid * 1024u;
    const int aoff = lds_byte(wr * 64 + fr, fq * 8), boff = lds_byte(wc * 32 + fr, fq * 8);
#define PG8_SA(b, h) (((b) * 2 + (h)) * HTB)
#define PG8_SB(b, h) ((4 + (b) * 2 + (h)) * HTB)
#define PG8_STAGE(bufoff, gbase, voff) do { _Pragma("unroll") for (int _i = 0; _i < 2; ++_i) \
        __builtin_amdgcn_global_load_lds((const unsigned*)((const char*)(gbase) + (voff)[_i]), (PG8_LAS unsigned*)(lds + (bufoff) + ldsw + _i * 8192), 16, 0, 0); } while (0)
#define PG8_LDA(dst, b, h) do { _Pragma("unroll") for (int m = 0; m < 4; ++m) _Pragma("unroll") for (int k = 0; k < 2; ++k) dst[m][k] = *(const PG8_LAS bf16x8*)(lds + PG8_SA(b, h) + aoff + m * 2048 + k * 1024); } while (0)
#define PG8_LDB(dst, b, h) do { _Pragma("unroll") for (int n = 0; n < 2; ++n) _Pragma("unroll") for (int k = 0; k < 2; ++k) dst[n][k] = *(const PG8_LAS bf16x8*)(lds + PG8_SB(b, h) + boff + n * 2048 + k * 1024); } while (0)
#define PG8_MMA(ai, bj, At, Bt) do { __builtin_amdgcn_s_setprio(1); _Pragma("unroll") for (int m = 0; m < 4; ++m) _Pragma("unroll") for (int n = 0; n < 2; ++n) _Pragma("unroll") for (int k = 0; k < 2; ++k) \
        acc[ai][bj][m][n] = __builtin_amdgcn_mfma_f32_16x16x32_bf16(Bt[n][k], At[m][k], acc[ai][bj][m][n], 0, 0, 0); __builtin_amdgcn_s_setprio(0); } while (0)
#define PG8_WAIT_V(n) asm volatile("s_waitcnt vmcnt(" #n ")" ::: "memory")
#define PG8_WAIT_L(n) asm volatile("s_waitcnt lgkmcnt(" #n ")" ::: "memory")
#define PG8_BAR __builtin_amdgcn_s_barrier()
#define PG8_SCHED __builtin_amdgcn_sched_barrier(0)
    Unit cur, nxt; int ui = 0;
    if (!S.next(0, cur)) return;
    f32x4 acc[2][2][4][2];
#pragma unroll
    for (int a = 0; a < 2; ++a)
#pragma unroll
        for (int b = 0; b < 2; ++b)
#pragma unroll
            for (int m = 0; m < 4; ++m)
#pragma unroll
                for (int n = 0; n < 2; ++n) acc[a][b][m][n] = (f32x4){0.f, 0.f, 0.f, 0.f};
    bf16x8 At[4][2], B0[2][2], B1[2][2];
    const char* cA = (const char*)g.A + (size_t)cur.pm * tstep; const char* cB = (const char*)g.Bt + (size_t)cur.pn * tstep;
    S.a_ready(cur);
    if constexpr (SP2) {
        PG8_STAGE(PG8_SB(0, 0), cB, voffB); PG8_STAGE(PG8_SB(0, 1), cB + hstep, voffB); PG8_STAGE(PG8_SA(0, 0), cA, voffA); PG8_STAGE(PG8_SA(0, 1), cA + hstep, voffA);
        if (wr == 1) PG8_BAR;
        PG8_WAIT_V(2); PG8_BAR;
        PG8_STAGE(PG8_SB(1, 0), cB + kstep, voffB); PG8_STAGE(PG8_SA(1, 0), cA + kstep, voffA); PG8_STAGE(PG8_SB(1, 1), cB + hstep + kstep, voffB);
        PG8_WAIT_V(6); PG8_BAR;
    } else {
        PG8_STAGE(PG8_SB(0, 0), cB, voffB); PG8_STAGE(PG8_SA(0, 0), cA, voffA); PG8_STAGE(PG8_SB(0, 1), cB + hstep, voffB); PG8_STAGE(PG8_SA(0, 1), cA + hstep, voffA);
        if (wr == 1) PG8_BAR;
        PG8_WAIT_V(4); PG8_BAR;
        PG8_STAGE(PG8_SB(1, 0), cB + kstep, voffB); PG8_STAGE(PG8_SA(1, 0), cA + kstep, voffA); PG8_STAGE(PG8_SB(1, 1), cB + hstep + kstep, voffB);
        PG8_WAIT_V(6); PG8_BAR;
    }
    for (;;) {
        const bool has_next = S.next(ui + 1, nxt);
        const char* nA = has_next ? (const char*)g.A + (size_t)nxt.pm * tstep : cA; const char* nB = has_next ? (const char*)g.Bt + (size_t)nxt.pn * tstep : cB;
        for (int t = 0; t < nt; t += 2) {
            const bool last = (t == nt - 2);
            const char* a1 = cA + (size_t)(t + 1) * kstep;
            const char* a2 = last ? nA : cA + (size_t)(t + 2) * kstep; const char* b2 = last ? nB : cB + (size_t)(t + 2) * kstep;
            const char* a3 = a2 + kstep; const char* b3 = b2 + kstep;
            if (last && has_next) S.a_ready(nxt);
            if constexpr (SP2) {
            PG8_LDB(B0, 0, 0); PG8_LDB(B1, 0, 1); PG8_SCHED; PG8_LDA(At, 0, 0); PG8_STAGE(PG8_SA(1, 1), a1 + hstep, voffA);
            PG8_WAIT_V(8); PG8_WAIT_L(0); PG8_BAR; PG8_MMA(0, 0, At, B0); PG8_MMA(0, 1, At, B1); PG8_BAR; PG8_SCHED;
            PG8_LDA(At, 0, 1); PG8_STAGE(PG8_SB(0, 0), b2, voffB); PG8_STAGE(PG8_SB(0, 1), b2 + hstep, voffB); PG8_STAGE(PG8_SA(0, 0), a2, voffA);
            PG8_WAIT_V(8); PG8_WAIT_L(0); PG8_BAR; PG8_MMA(1, 0, At, B0); PG8_MMA(1, 1, At, B1); PG8_BAR; PG8_SCHED;
            PG8_LDB(B0, 1, 0); PG8_LDB(B1, 1, 1); PG8_SCHED; PG8_LDA(At, 1, 0); PG8_STAGE(PG8_SA(0, 1), a2 + hstep, voffA);
            PG8_WAIT_V(8); PG8_WAIT_L(0); PG8_BAR; PG8_MMA(0, 0, At, B0); PG8_MMA(0, 1, At, B1); PG8_BAR; PG8_SCHED;
            PG8_LDA(At, 1, 1); PG8_STAGE(PG8_SB(1, 0), b3, voffB); PG8_STAGE(PG8_SB(1, 1), b3 + hstep, voffB); PG8_STAGE(PG8_SA(1, 0), a3, voffA);
            PG8_WAIT_V(8); PG8_WAIT_L(0); PG8_BAR; PG8_MMA(1, 0, At, B0); PG8_MMA(1, 1, At, B1); PG8_BAR; PG8_SCHED;
            } else {
            PG8_LDB(B0, 0, 0); PG8_SCHED; PG8_LDA(At, 0, 0); PG8_STAGE(PG8_SA(1, 1), a1 + hstep, voffA);
            PG8_WAIT_L(8); PG8_BAR; PG8_WAIT_L(0); PG8_MMA(0, 0, At, B0); PG8_BAR; PG8_SCHED;
            PG8_LDB(B1, 0, 1); PG8_STAGE(PG8_SB(0, 0), b2, voffB);
            PG8_BAR; PG8_WAIT_L(0); PG8_MMA(0, 1, At, B1); PG8_BAR;
            PG8_LDA(At, 0, 1); PG8_STAGE(PG8_SA(0, 0), a2, voffA);
            PG8_BAR; PG8_WAIT_L(0); PG8_MMA(1, 0, At, B0); PG8_BAR; PG8_SCHED;
            PG8_STAGE(PG8_SB(0, 1), b2 + hstep, voffB);
            PG8_WAIT_V(6); PG8_BAR; PG8_MMA(1, 1, At, B1); PG8_BAR;
            PG8_LDB(B0, 1, 0); PG8_SCHED; PG8_LDA(At, 1, 0); PG8_STAGE(PG8_SA(0, 1), a2 + hstep, voffA);
            PG8_WAIT_L(8); PG8_BAR; PG8_WAIT_L(0); PG8_MMA(0, 0, At, B0); PG8_BAR; PG8_SCHED;
            PG8_LDB(B1, 1, 1); PG8_STAGE(PG8_SB(1, 0), b3, voffB);
            PG8_BAR; PG8_WAIT_L(0); PG8_MMA(0, 1, At, B1); PG8_BAR;
            PG8_LDA(At, 1, 1); PG8_STAGE(PG8_SA(1, 0), a3, voffA);
            PG8_BAR; PG8_WAIT_L(0); PG8_MMA(1, 0, At, B0); PG8_BAR; PG8_SCHED;
            PG8_STAGE(PG8_SB(1, 1), b3 + hstep, voffB);
            PG8_WAIT_V(6); PG8_BAR; PG8_MMA(1, 1, At, B1); PG8_BAR;
            }
        }
        if constexpr (ALIGN_EPI) { if (wr == 0) PG8_BAR; }
        if constexpr (!Epi::AFTER_DRAIN) { E(acc, cur, wr, wc, fr, fq); S.done(cur); }
        if (!has_next) break;
#pragma unroll
        for (int a = 0; a < 2; ++a)
#pragma unroll
            for (int b = 0; b < 2; ++b)
#pragma unroll
                for (int m = 0; m < 4; ++m)
#pragma unroll
                    for (int n = 0; n < 2; ++n) acc[a][b][m][n] = (f32x4){0.f, 0.f, 0.f, 0.f};
        cur = nxt; cA = nA; cB = nB; ++ui;
        if constexpr (ALIGN_EPI) { if (wr == 1) PG8_BAR; }
    }
    PG8_WAIT_V(0);
    if constexpr (!ALIGN_EPI) { if (wr == 0) PG8_BAR; }
    PG8_BAR;
    if constexpr (Epi::AFTER_DRAIN) { E.fused(acc, cur, wr, wc, fr, fq, lds, wid, lane); S.done(cur); }
#undef PG8_SA
#undef PG8_SB
#undef PG8_STAGE
#undef PG8_LDA
#undef PG8_LDB
#undef PG8_MMA
#undef PG8_WAIT_V
#undef PG8_WAIT_L
#undef PG8_BAR
#undef PG8_SCHED
}
}

#ifndef PG8_SP2
#define PG8_SP2 true
#endif
#ifndef PG8_ALIGN
#define PG8_ALIGN true
#endif
constexpr int NWAVES = 8, NTHR = 512;
constexpr int BATCH = 2, SEQ = 8192, DM = 4096, MTOK = BATCH * SEQ;
constexpr int HD = 128;
constexpr int A_HEADS = 16, B_HEADS = 16, A_W = 2048, B_W = 2048, AB_IN = 4 * A_W + 3 * B_W;
constexpr int NSA_H = 32, NSA_G = 4, NSA_R = 8, KVW = 512, NSA_IN = 4096 + 6 * KVW + 96, NSA_INP = 7424;
constexpr int NCMP = 511, NCMPP = 512, NSLC = 128, NTOP = 16, WINDOW = 512;
constexpr int NMEM = 256, XH = 4, XW = 512;
constexpr int DFF = 11008, DFF2 = 22016;
constexpr float LN_EPS = 1e-5f, RMS_EPS = 1e-6f;
constexpr float DN_ALPHA = 1.41421356237309515f;
constexpr size_t MiB = (size_t)1 << 20;
constexpr size_t WS_CTL = 0, CTL_ZERO_BYTES = 4 * MiB;
constexpr size_t WS_FOLD = 64 * 1024;
constexpr int FO_XQ = 0, FO_UP = 2 * 512, FO_NSA = FO_UP + 2 * 22016, FO_N = FO_NSA + 7424;
constexpr size_t WS_RSUM = 1 * MiB;
static_assert(WS_FOLD + (size_t)2 * FO_N * 8 <= WS_RSUM && WS_RSUM + (size_t)6 * 16384 * 2 * 8 <= CTL_ZERO_BYTES, "CTL map");
constexpr size_t WS_W_ABIN = 4 * MiB;
constexpr size_t WS_W_ABOUT = WS_W_ABIN + 112 * MiB;
constexpr size_t WS_W_NSAIN = WS_W_ABOUT + 32 * MiB;
constexpr size_t WS_W_NSAOUT = WS_W_NSAIN + 58 * MiB;
constexpr size_t WS_W_XQ = WS_W_NSAOUT + 32 * MiB;
constexpr size_t WS_W_XKV = WS_W_XQ + 8 * MiB;
constexpr size_t WS_W_XO = WS_W_XKV + 16 * MiB;
constexpr size_t WS_W_UP = WS_W_XO + 8 * MiB;
constexpr size_t WS_W_DOWN = WS_W_UP + 344 * MiB;
constexpr size_t WS_W_C1 = WS_W_DOWN + 172 * MiB;
constexpr size_t WS_W_C2 = WS_W_C1 + 2 * MiB;
constexpr size_t WS_MEMB = WS_W_C2 + 1 * MiB;
constexpr size_t WS_HB = WS_MEMB + 4 * MiB;
constexpr size_t WS_Y = WS_HB + 128 * MiB;
constexpr size_t WS_BIG = WS_Y + 256 * MiB;
constexpr size_t WS_G = WS_BIG + 688 * MiB;
constexpr size_t WS_O = WS_G + 344 * MiB;
constexpr size_t WS_MISC = WS_O + 128 * MiB;
constexpr size_t WS_END = WS_MISC + 64 * MiB;
constexpr size_t WS_XQ = WS_MISC;
constexpr size_t WS_XO = WS_MISC + 16 * MiB;
constexpr size_t WS_XKV = WS_MISC + 32 * MiB;
constexpr size_t WS_LB = WS_MISC + 34 * MiB;
constexpr size_t WS_FOLDF = WS_MISC + 40 * MiB;
constexpr size_t WS_ROPE = WS_MISC + 36 * MiB;
constexpr size_t WS_STATS = WS_MISC + 35 * MiB;
constexpr size_t WS_PROJ0 = WS_BIG;
constexpr size_t WS_SPREV = WS_BIG + 448 * MiB;
constexpr size_t WS_QT = WS_G;
constexpr size_t WS_OINTRA = WS_G + 64 * MiB;
constexpr size_t WS_DEC = WS_G + 192 * MiB;
constexpr size_t WS_DS = WS_Y;
constexpr size_t WS_PROJ1 = WS_BIG;
constexpr size_t WS_QROT = WS_BIG + 232 * MiB;
constexpr size_t WS_KSROT = WS_BIG + 360 * MiB;
constexpr size_t WS_KWROT = WS_BIG + 376 * MiB;
constexpr size_t WS_KCMP = WS_BIG + 392 * MiB;
constexpr size_t WS_VCMP = WS_BIG + 393 * MiB;
constexpr size_t WS_OVL = WS_BIG + 394 * MiB;
constexpr size_t WS_SEL = WS_BIG + 395 * MiB;
constexpr size_t WS_IMP = WS_G + 256 * MiB;
constexpr size_t WS_O32 = WS_G;
static_assert(WS_SPREV + 128 * MiB <= WS_G && WS_DEC + 2 * MiB <= WS_O && WS_SEL + MiB <= WS_G, "ws map");
constexpr int CW_TMO = 0, CW_CODE = 1;
constexpr int CW_BAR = 4096;
constexpr int RING_OFF = 0, RING_BYTES = 131072;
constexpr int LDSCTL_OFF = RING_BYTES, MISC_OFF = LDSCTL_OFF + 320;
constexpr int LDS_BYTES = 147456;
static_assert(MISC_OFF + 128 <= LDS_BYTES, "LDS map");

#define GAS __attribute__((address_space(1)))
#define LAS __attribute__((address_space(3)))
typedef unsigned short bf16;
typedef unsigned v4u __attribute__((ext_vector_type(4)));
typedef unsigned v2u __attribute__((ext_vector_type(2)));
typedef float f32x4 __attribute__((ext_vector_type(4)));
typedef float f32x2 __attribute__((ext_vector_type(2)));
typedef float f32x16 __attribute__((ext_vector_type(16)));
typedef short bf16x8 __attribute__((ext_vector_type(8)));
typedef short s16x4 __attribute__((ext_vector_type(4)));
typedef GAS unsigned gu32;
#define RLX_AGENT __ATOMIC_RELAXED, __HIP_MEMORY_SCOPE_AGENT
#define LDS_WAIT() asm volatile("s_waitcnt lgkmcnt(0)" ::: "memory")
#define VM_WAIT() asm volatile("s_waitcnt vmcnt(0)" ::: "memory")
#define SBAR() __builtin_amdgcn_sched_barrier(0)
__device__ __forceinline__ unsigned f2bf(float f) { unsigned u = __builtin_bit_cast(unsigned, f); return (u + 0x7fffu + ((u >> 16) & 1u)) >> 16; }
__device__ __forceinline__ unsigned pk2(float lo, float hi) { return f2bf(lo) | (f2bf(hi) << 16); }
__device__ __forceinline__ float bf2f(unsigned short b) { return __builtin_bit_cast(float, (unsigned)b << 16); }
__device__ __forceinline__ float bflo(unsigned w) { return __builtin_bit_cast(float, w << 16); }
__device__ __forceinline__ float bfhi(unsigned w) { return __builtin_bit_cast(float, w & 0xffff0000u); }
__device__ __forceinline__ unsigned cvtpk(float lo, float hi) { unsigned r; asm volatile("v_cvt_pk_bf16_f32 %0, %1, %2" : "=v"(r) : "v"(lo), "v"(hi)); return r; }
__device__ __forceinline__ float wave_sum(float v) {
#pragma unroll
    for (int o = 1; o < 64; o <<= 1) v += __shfl_xor(v, o);
    return v;
}
__device__ __forceinline__ float sigmoidf_(float x) { return __builtin_amdgcn_rcpf(1.f + __builtin_amdgcn_exp2f(-1.4426950408889634f * x)); }
__device__ __forceinline__ float gelu1(float v) { pg8::f32x2 r = pg8::gelu_pk((pg8::f32x2){v, 0.f}); return r.x; }
#define XB_TMO      128
#define XB_XCNT(j)  (256  + 64 * (j))
#define XB_XSUB(j)  (1280 + 64 * (j))
#define XB_XGEN(j)  (2304 + 64 * (j))
#define XB_TOP      3328
#define XB_TOPGEN   3392
#define XCD_BAR_WORDS 3456
#define XB_SPIN_CAP (1u << 18)
#define LAS __attribute__((address_space(3)))

__device__ __forceinline__ unsigned xb_ld(unsigned* p)              { return __hip_atomic_load(p, __ATOMIC_RELAXED, __HIP_MEMORY_SCOPE_AGENT); }
__device__ __forceinline__ unsigned xb_add(unsigned* p, unsigned v) { return __hip_atomic_fetch_add(p, v, __ATOMIC_RELAXED, __HIP_MEMORY_SCOPE_AGENT); }
__device__ __forceinline__ unsigned xb_xcc_id() { return (unsigned)__builtin_amdgcn_s_getreg((3 << 11) | 20) & 0xFu; }
#define XB_SPIN(cond, bar) do { unsigned _sp = 0; while (cond) { __builtin_amdgcn_s_sleep(1); \
    if ((++_sp & 255u) == 0u) { if (xb_ld(&(bar)[XB_TMO])) break; if (_sp > XB_SPIN_CAP) { atomicAdd(&(bar)[XB_TMO], 1u); break; } } } } while (0)

struct XcdBarrier {
    unsigned* bar; unsigned x;
    volatile LAS unsigned* st;
};

__device__ __forceinline__ XcdBarrier xcd_barrier_post(unsigned* bar, volatile LAS unsigned* st) {
    XcdBarrier b; b.bar = bar; b.x = xb_xcc_id(); b.st = st;
    if (threadIdx.x == 0) (void)xb_add(&bar[XB_XCNT(b.x)], 1u);
    return b;
}
__device__ __forceinline__ void xcd_barrier_complete(unsigned* bar, unsigned x, unsigned& nloc, unsigned& nx) {
    const unsigned G = gridDim.x * gridDim.y * gridDim.z;
    unsigned sum, cnt, mine, sp = 0u;
    for (;;) {
        sum = 0u; cnt = 0u; mine = 0u;
#pragma unroll
        for (unsigned j = 0; j < 16; ++j) { const unsigned c = xb_ld(&bar[XB_XCNT(j)]); sum += c; cnt += (c > 0u) ? 1u : 0u; mine = (j == x) ? c : mine; }
        if (sum == G) break;
        __builtin_amdgcn_s_sleep(1);
        if ((++sp & 255u) == 0u) { if (xb_ld(&bar[XB_TMO])) break; if (sp > XB_SPIN_CAP) { atomicAdd(&bar[XB_TMO], 1u); break; } }
    }
    nloc = mine > 0u ? mine : 1u; nx = cnt > 0u ? cnt : 1u;
}

__device__ __forceinline__ void xcd_barrier(const XcdBarrier& b) {
    asm volatile("s_waitcnt vmcnt(0)" ::: "memory");
    __syncthreads();
    if (threadIdx.x == 0) {
        unsigned* bar = b.bar;
        __builtin_amdgcn_s_waitcnt(0);
        unsigned nloc = b.st[0], nx = b.st[1];
        if (nloc == 0u) { xcd_barrier_complete(bar, b.x, nloc, nx); b.st[0] = nloc; b.st[1] = nx; }
        const unsigned old = xb_add(&bar[XB_XSUB(b.x)], 1u);
        const unsigned gen = old / nloc;
        if (old + 1u == (gen + 1u) * nloc) {
            __builtin_amdgcn_fence(__ATOMIC_RELEASE, "agent");
            asm volatile("s_waitcnt vmcnt(0)" ::: "memory");
            const unsigned og = xb_add(&bar[XB_TOP], 1u);
            const unsigned tg = og / nx;
            if (og + 1u == (tg + 1u) * nx) xb_add(&bar[XB_TOPGEN], 1u);
            else XB_SPIN(xb_ld(&bar[XB_TOPGEN]) == tg, bar);
            __builtin_amdgcn_fence(__ATOMIC_ACQUIRE, "agent");
            xb_add(&bar[XB_XGEN(b.x)], 1u);
            asm volatile("s_waitcnt vmcnt(0)" ::: "memory");
        } else {
            XB_SPIN(xb_ld(&bar[XB_XGEN(b.x)]) == gen, bar);
            __builtin_amdgcn_fence(__ATOMIC_ACQUIRE, "agent");
            asm volatile("s_waitcnt vmcnt(0)" ::: "memory");
        }
    }
    __syncthreads();
}


constexpr int ATT_D = 128, KVBLK = 64;
constexpr int SHM_V = KVBLK * ATT_D * 2, SHM_K = KVBLK * ATT_D * 2;
constexpr int ATT_K_OFF = 0, ATT_V_OFF = SHM_K, ATT_BUF = SHM_K + SHM_V, ATT_SET = 2 * ATT_BUF;
constexpr int ATT_WS_OFF = RING_BYTES + 512;
constexpr int ATT_X_OFF = ATT_WS_OFF + NWAVES * 256;
static_assert(2 * ATT_SET <= RING_BYTES && ATT_X_OFF + 1024 <= LDS_BYTES, "attention LDS map");
#define KSWZ(row, colB) ((row) * 256 + ((colB) ^ (((row) & 7) << 4)))
__device__ __forceinline__ int crow(int r, int hi) { return (r & 3) + 8 * (r >> 2) + 4 * hi; }
__device__ __forceinline__ int v_st(int k, int c) { const int kk = (k & ~0xC) | ((k & 4) << 1) | ((k & 8) >> 1); return ((kk >> 3) * 4 + (c >> 5)) * 512 + ((kk & 7) * 32 + (c & 31)) * 2; }
__device__ __forceinline__ int v_rd_base(int lane) { return ((lane & 3) << 3) | (((lane >> 2) & 3) << 6) | (((lane >> 4) & 1) << 5) | (((lane >> 5) & 1) << 8); }
constexpr int v_rd_off(int d0, int ks, int half) { return d0 * 512 + ks * 4096 + half * 2048; }
template <int OFF> __device__ __forceinline__ s16x4 tr_read(int vb) {
  s16x4 r; asm volatile("ds_read_b64_tr_b16 %0, %1 offset:%2" : "=&v"(r) : "v"(vb), "i"(OFF) : "memory"); return r;
}
__device__ __forceinline__ void qkt(f32x16& p0, f32x16& p1, const LAS char* Ks, const bf16x8* qr, int r32, int hi) {
  p0 = f32x16{}; p1 = f32x16{};
#pragma unroll
  for (int d0 = 0; d0 < 8; ++d0) { const int cb = (d0 * 16 + hi * 8) * 2;
    const bf16x8 b0 = *(const LAS bf16x8*)(Ks + KSWZ(r32, cb));
    const bf16x8 b1 = *(const LAS bf16x8*)(Ks + KSWZ(32 + r32, cb));
    p0 = __builtin_amdgcn_mfma_f32_32x32x16_bf16(b0, qr[d0], p0, 0, 0, 0);
    p1 = __builtin_amdgcn_mfma_f32_32x32x16_bf16(b1, qr[d0], p1, 0, 0, 0); }
}
__device__ __forceinline__ void pack_p(const f32x16& p0, const f32x16& p1, bf16x8& pa0, bf16x8& pa1, bf16x8& pa2, bf16x8& pa3) {
#define PK4(P, BASE, OUT) do { unsigned a0 = cvtpk(P[BASE + 0], P[BASE + 1]), a1 = cvtpk(P[BASE + 2], P[BASE + 3]);   \
    unsigned b0 = cvtpk(P[BASE + 4], P[BASE + 5]), b1 = cvtpk(P[BASE + 6], P[BASE + 7]);                              \
    auto r0 = __builtin_amdgcn_permlane32_swap(a0, b0, false, false); auto r1 = __builtin_amdgcn_permlane32_swap(a1, b1, false, false); \
    v4u w = {r0[0], r1[0], r0[1], r1[1]}; OUT = __builtin_bit_cast(bf16x8, w); } while (0)
  PK4(p0, 0, pa0); PK4(p0, 8, pa1); PK4(p1, 0, pa2); PK4(p1, 8, pa3);
#undef PK4
}
template <int D0> __device__ __forceinline__ void pv_one(f32x16& od, int vb, bf16x8 pa0, bf16x8 pa1, bf16x8 pa2, bf16x8 pa3) {
  const s16x4 l0 = tr_read<v_rd_off(D0, 0, 0)>(vb), h0 = tr_read<v_rd_off(D0, 0, 1)>(vb), l1 = tr_read<v_rd_off(D0, 1, 0)>(vb), h1 = tr_read<v_rd_off(D0, 1, 1)>(vb);
  const s16x4 l2 = tr_read<v_rd_off(D0, 2, 0)>(vb), h2 = tr_read<v_rd_off(D0, 2, 1)>(vb), l3 = tr_read<v_rd_off(D0, 3, 0)>(vb), h3 = tr_read<v_rd_off(D0, 3, 1)>(vb);
  asm volatile("s_waitcnt lgkmcnt(0)" ::: "memory"); SBAR();
#define PKV(L, H) (bf16x8){L[0], L[1], L[2], L[3], H[0], H[1], H[2], H[3]}
  od = __builtin_amdgcn_mfma_f32_32x32x16_bf16(pa0, PKV(l0, h0), od, 0, 0, 0);
  od = __builtin_amdgcn_mfma_f32_32x32x16_bf16(pa1, PKV(l1, h1), od, 0, 0, 0);
  od = __builtin_amdgcn_mfma_f32_32x32x16_bf16(pa2, PKV(l2, h2), od, 0, 0, 0);
  od = __builtin_amdgcn_mfma_f32_32x32x16_bf16(pa3, PKV(l3, h3), od, 0, 0, 0);
#undef PKV
}
__device__ __forceinline__ void pv_d0(f32x16* o, int vb, bf16x8 pa0, bf16x8 pa1, bf16x8 pa2, bf16x8 pa3) {
  pv_one<0>(o[0], vb, pa0, pa1, pa2, pa3); pv_one<1>(o[1], vb, pa0, pa1, pa2, pa3); pv_one<2>(o[2], vb, pa0, pa1, pa2, pa3); pv_one<3>(o[3], vb, pa0, pa1, pa2, pa3);
}
struct KVStage { bf16x8 ks0, ks1, vs0, vs1; };
__device__ __forceinline__ void kv_load(KVStage& s, const bf16* Kh, const bf16* Vh, long ldk, long ldv, int k0, int sr, int sc) {
  s.ks0 = *(const bf16x8*)(Kh + (long)(k0 + sr) * ldk + sc); s.ks1 = *(const bf16x8*)(Kh + (long)(k0 + 32 + sr) * ldk + sc);
  s.vs0 = *(const bf16x8*)(Vh + (long)(k0 + sr) * ldv + sc); s.vs1 = *(const bf16x8*)(Vh + (long)(k0 + 32 + sr) * ldv + sc);
}
__device__ __forceinline__ void kv_write(const KVStage& s, LAS char* lds, int sr, int sc) {
  *(LAS bf16x8*)(lds + ATT_V_OFF + v_st(sr, sc)) = s.vs0; *(LAS bf16x8*)(lds + ATT_V_OFF + v_st(32 + sr, sc)) = s.vs1;
  *(LAS bf16x8*)(lds + ATT_K_OFF + KSWZ(sr, sc * 2)) = s.ks0; *(LAS bf16x8*)(lds + ATT_K_OFF + KSWZ(32 + sr, sc * 2)) = s.ks1;
}
struct KVDma { int ko[2], vo[2]; };
__device__ __forceinline__ void kv_dma_init(KVDma& d, int ldk, int ldv, int wid, int lane) {
#pragma unroll
  for (int i = 0; i < 2; ++i) { const int p = wid * 2 + i;
    const int row = p * 4 + (lane >> 4), cp = lane & 15; d.ko[i] = row * ldk + ((cp ^ (row & 7)) << 3);
    const int sub = p * 2 + (lane >> 5), kk = (sub >> 2) * 8 + ((lane & 31) >> 2), k = (kk & ~0xC) | ((kk & 4) << 1) | ((kk & 8) >> 1), c = (sub & 3) * 32 + (lane & 3) * 8;
    d.vo[i] = k * ldv + c; }
}
__device__ __forceinline__ void kv_dma(const KVDma& d, const bf16* Kt, const bf16* Vt, LAS char* lds, int buf, int wid) {
#pragma unroll
  for (int i = 0; i < 2; ++i) {
    __builtin_amdgcn_global_load_lds((const unsigned*)(Kt + d.ko[i]), (LAS unsigned*)(lds + buf + ATT_K_OFF + (wid * 2 + i) * 1024), 16, 0, 0);
    __builtin_amdgcn_global_load_lds((const unsigned*)(Vt + d.vo[i]), (LAS unsigned*)(lds + buf + ATT_V_OFF + (wid * 2 + i) * 1024), 16, 0, 0); }
}
__device__ __forceinline__ void rescale_o(f32x16* o, float a, LAS float* al_l, int r32, int hi) {
  if (__any(a < 1.f)) { if (hi == 0) al_l[r32] = a; LDS_WAIT();
#pragma unroll
    for (int r = 0; r < 16; ++r) { const float f = al_l[crow(r, hi)];
#pragma unroll
      for (int d = 0; d < 4; ++d) o[d][r] *= f; }
    LDS_WAIT(); }
}
constexpr float ATT_SCALE = 0.088388347648318440f, ATT_C = ATT_SCALE * 1.4426950408889634f, ATT_THR = 8.f;
__device__ __forceinline__ void softmax_tile(f32x16& p0, f32x16& p1, float& m_reg, float& l_reg, float& alpha) {
  float pmax = p0[0];
#pragma unroll
  for (int r = 1; r < 16; ++r) pmax = fmaxf(pmax, p0[r]);
#pragma unroll
  for (int r = 0; r < 16; ++r) pmax = fmaxf(pmax, p1[r]);
  { auto rr = __builtin_amdgcn_permlane32_swap(__float_as_uint(pmax), __float_as_uint(pmax), false, false);
    pmax = fmaxf(__uint_as_float(rr[0]), __uint_as_float(rr[1])); }
  float mn;
  if (__all(pmax - m_reg <= ATT_THR / ATT_SCALE)) { mn = m_reg; alpha = 1.f; }
  else { mn = fmaxf(m_reg, pmax); alpha = __builtin_amdgcn_exp2f((m_reg - mn) * ATT_C); m_reg = mn; }
  const float mnC = -mn * ATT_C;
#pragma unroll
  for (int r = 0; r < 16; ++r) { p0[r] = __builtin_amdgcn_exp2f(fmaf(p0[r], ATT_C, mnC)); p1[r] = __builtin_amdgcn_exp2f(fmaf(p1[r], ATT_C, mnC)); }
  float ps = 0.f;
#pragma unroll
  for (int r = 0; r < 16; ++r) ps += p0[r] + p1[r];
  { auto rr = __builtin_amdgcn_permlane32_swap(__float_as_uint(ps), __float_as_uint(ps), false, false);
    ps = __uint_as_float(rr[0]) + __uint_as_float(rr[1]); }
  l_reg = l_reg * alpha + ps;
}
__device__ __forceinline__ void attn_finish(f32x16& p0, f32x16& p1, f32x16* o, float& m_reg, float& l_reg, LAS float* wsc, int vb, int r32, int hi) {
  float alpha; softmax_tile(p0, p1, m_reg, l_reg, alpha);
  rescale_o(o, alpha, wsc, r32, hi);
  bf16x8 pa0, pa1, pa2, pa3; pack_p(p0, p1, pa0, pa1, pa2, pa3);
  pv_d0(o, vb, pa0, pa1, pa2, pa3);
}
__device__ __forceinline__ void load_q(bf16x8* qr, const bf16* Qw) {
#pragma unroll
  for (int d0 = 0; d0 < 8; ++d0) qr[d0] = *(const bf16x8*)(Qw + d0 * 16);
}

struct Frame {
    LAS unsigned char* lds;
    unsigned char* ws;
    int tid, lane, wave, G, bid;
    __device__ __forceinline__ void fresh() { int t = threadIdx.x; asm volatile("" : "+v"(t)); tid = t; lane = t & 63; wave = __builtin_amdgcn_readfirstlane(t >> 6);
        int g_ = gridDim.x, b_ = blockIdx.x; asm volatile("" : "+s"(g_), "+s"(b_)); G = g_; bid = b_; }
};
struct Args { const float* in[19]; float* out; unsigned char* ws; int ph_lo, ph_hi; };
enum { IN_X = 0, IN_MEM, IN_AB_W_IN, IN_HGRN_LB, IN_HGRN_NW, IN_AB_W_OUT, IN_NSA_W_IN, IN_NSA_CMP_POS, IN_NSA_CMP_W1, IN_NSA_CMP_W2, IN_NSA_W_OUT,
       IN_XA_WQ, IN_XA_WKV, IN_XA_WO, IN_FFN_UP, IN_FFN_CONV, IN_FFN_DOWN, IN_LN_G, IN_LN_B };

__device__ __forceinline__ void p0_transpose_item(const float* W, int K, int N, bf16* WT, LAS float* scr, int item, int lane) {
    const int nblk = N / 32, kb = item / nblk, nb = item % nblk, k0 = 64 * kb, n0 = 32 * nb;
#pragma unroll 8
    for (int i = 0; i < 32; ++i) { const int kk = 2 * i + (lane >> 5); scr[kk * 33 + (lane & 31)] = W[(size_t)(k0 + kk) * N + n0 + (lane & 31)]; }
    LDS_WAIT(); asm volatile("" ::: "memory");
    const int c = lane & 7;
#pragma unroll
    for (int j = 0; j < 4; ++j) { const int n = (lane >> 3) + 8 * j; const LAS float* s = scr + (8 * c) * 33 + n;
        v4u o; o.x = pk2(s[0 * 33], s[1 * 33]); o.y = pk2(s[2 * 33], s[3 * 33]); o.z = pk2(s[4 * 33], s[5 * 33]); o.w = pk2(s[6 * 33], s[7 * 33]);
        *(GAS v4u*)(WT + (size_t)(n0 + n) * K + k0 + 8 * c) = o; }
    LDS_WAIT(); asm volatile("" ::: "memory");
}
__device__ __forceinline__ void p0_transpose_item_fold(const float* W, int K, int N, bf16* WT, LAS float* scr, int item, int lane, const float* g, const float* b, long long* cs, long long* b2) {
    const int nblk = N / 32, kb = item / nblk, nb = item % nblk, k0 = 64 * kb, n0 = 32 * nb;
#pragma unroll 8
    for (int i = 0; i < 32; ++i) { const int kk = 2 * i + (lane >> 5); scr[kk * 33 + (lane & 31)] = W[(size_t)(k0 + kk) * N + n0 + (lane & 31)]; }
    LDS_WAIT(); asm volatile("" ::: "memory");
    const int c = lane & 7;
    const f32x4 g0 = *(const f32x4*)(g + k0 + 8 * c), g1 = *(const f32x4*)(g + k0 + 8 * c + 4), b0 = *(const f32x4*)(b + k0 + 8 * c), b1 = *(const f32x4*)(b + k0 + 8 * c + 4);
    const float gg[8] = {g0.x, g0.y, g0.z, g0.w, g1.x, g1.y, g1.z, g1.w}, bb[8] = {b0.x, b0.y, b0.z, b0.w, b1.x, b1.y, b1.z, b1.w};
#pragma unroll
    for (int j = 0; j < 4; ++j) { const int n = (lane >> 3) + 8 * j; const LAS float* s = scr + (8 * c) * 33 + n;
        float sc = 0.f, sb = 0.f; unsigned w[4];
#pragma unroll
        for (int q = 0; q < 4; ++q) { const float x0 = s[(2 * q) * 33], x1 = s[(2 * q + 1) * 33]; const unsigned r0 = f2bf(x0 * gg[2 * q]), r1 = f2bf(x1 * gg[2 * q + 1]);
            w[q] = r0 | (r1 << 16); sc += bf2f((unsigned short)r0) + bf2f((unsigned short)r1); sb += x0 * bb[2 * q] + x1 * bb[2 * q + 1]; }
        *(GAS v4u*)(WT + (size_t)(n0 + n) * K + k0 + 8 * c) = (v4u){w[0], w[1], w[2], w[3]};
        sc += __shfl_xor(sc, 1); sc += __shfl_xor(sc, 2); sc += __shfl_xor(sc, 4); sb += __shfl_xor(sb, 1); sb += __shfl_xor(sb, 2); sb += __shfl_xor(sb, 4);
        if (c == 0) { atomicAdd((unsigned long long*)(cs + n0 + n), (unsigned long long)(long long)rintf(sc * pg8::FOLD_SCALE)); atomicAdd((unsigned long long*)(b2 + n0 + n), (unsigned long long)(long long)rintf(sb * pg8::FOLD_SCALE)); } }
    LDS_WAIT(); asm volatile("" ::: "memory");
}
__device__ __forceinline__ void transpose_mat_fold(Frame& F, const float* W, int K, int N, bf16* WT, const float* g, const float* b, long long* cs, long long* b2, int c0 = 0, int nw = 1 << 30, int part = 0, int nparts = 1) {
    if (F.bid < c0 || F.bid >= c0 + nw) return;
    LAS float* scr = (LAS float*)(F.lds + RING_OFF + F.wave * 16384);
    const int nwg = nw < F.G ? nw : F.G, gw = (F.bid - c0) * NWAVES + F.wave, NGW = nwg * NWAVES;
    const int nitems = (K / 64) * (N / 32), ilo = (int)((long)nitems * part / nparts), ihi = (int)((long)nitems * (part + 1) / nparts);
    for (int it = ilo + gw; it < ihi; it += NGW) p0_transpose_item_fold(W, K, N, WT, scr, it, F.lane, g, b, cs, b2);
}
__device__ __forceinline__ void transpose_mat(Frame& F, const float* W, int K, int N, bf16* WT, int c0 = 0, int nw = 1 << 30) {
    if (F.bid < c0 || F.bid >= c0 + nw) return;
    LAS float* scr = (LAS float*)(F.lds + RING_OFF + F.wave * 16384);
    const int nwg = nw < F.G ? nw : F.G, gw = (F.bid - c0) * NWAVES + F.wave, NGW = nwg * NWAVES;
    const int nitems = (K / 64) * (N / 32);
    for (int it = gw; it < nitems; it += NGW) p0_transpose_item(W, K, N, WT, scr, it, F.lane);
}
__device__ __forceinline__ void fold_finalize(Frame& F, int lo, int n) {
    const long long* fs = (const long long*)(F.ws + WS_FOLD); float* fd = (float*)(F.ws + WS_FOLDF);
    for (int i = F.bid * NTHR + F.tid; i < 2 * n; i += F.G * NTHR) { const int j = (i < n) ? lo + i : FO_N + lo + (i - n); const long long v = fs[j]; fd[j] = (float)(int)(v >> 32) + (float)(unsigned)v * pg8::FOLD_INV; }
}
enum { CJ_DOWN0, CJ_NSA, CJ_L1A, CJ_L1B, CJ_DOWN1 };
template <int JOB>
__device__ __forceinline__ void convert_job(Frame& F, const Args& A, int c0, int nw) {
    unsigned char* ws = F.ws; long long* cs = (long long*)(ws + WS_FOLD); long long* b2 = cs + FO_N;
    if (JOB == CJ_DOWN0 || JOB == CJ_DOWN1) { const int l = JOB == CJ_DOWN1; transpose_mat(F, A.in[IN_FFN_DOWN] + (size_t)l * DFF * DM, DFF, DM, (bf16*)(ws + WS_W_DOWN) + (size_t)l * DM * DFF, c0, nw); }
    if (JOB == CJ_NSA) {
        transpose_mat_fold(F, A.in[IN_NSA_W_IN], DM, NSA_IN, (bf16*)(ws + WS_W_NSAIN), A.in[IN_LN_G] + 2 * DM, A.in[IN_LN_B] + 2 * DM, cs + FO_NSA, b2 + FO_NSA, c0, nw);
        transpose_mat(F, A.in[IN_NSA_W_OUT], DM, DM, (bf16*)(ws + WS_W_NSAOUT), c0, nw); }
    if (JOB == CJ_L1A || JOB == CJ_L1B) { const int l = 1;
        if (JOB == CJ_L1A) {
            transpose_mat_fold(F, A.in[IN_XA_WQ] + (size_t)l * DM * XW, DM, XW, (bf16*)(ws + WS_W_XQ) + (size_t)l * XW * DM, A.in[IN_LN_G] + (size_t)(3 * l) * DM, A.in[IN_LN_B] + (size_t)(3 * l) * DM, cs + FO_XQ + l * XW, b2 + FO_XQ + l * XW, c0, nw);
            transpose_mat(F, A.in[IN_XA_WKV] + (size_t)l * DM * 2 * XW, DM, 2 * XW, (bf16*)(ws + WS_W_XKV) + (size_t)l * 2 * XW * DM, c0, nw);
            transpose_mat(F, A.in[IN_XA_WO] + (size_t)l * XW * DM, XW, DM, (bf16*)(ws + WS_W_XO) + (size_t)l * DM * XW, c0, nw); }
        transpose_mat_fold(F, A.in[IN_FFN_UP] + (size_t)l * DM * DFF2, DM, DFF2, (bf16*)(ws + WS_W_UP) + (size_t)l * DFF2 * DM, A.in[IN_LN_G] + (size_t)(3 * l + 1) * DM, A.in[IN_LN_B] + (size_t)(3 * l + 1) * DM,
                           cs + FO_UP + l * DFF2, b2 + FO_UP + l * DFF2, c0, nw, JOB == CJ_L1A ? 0 : 1, 2); }
}
__device__ __forceinline__ void cvt_flat(Frame& F, const float* src, bf16* dst, long n8) {
    for (long i = (long)F.bid * NTHR + F.tid; i < n8; i += (long)F.G * NTHR) {
        const f32x4 a = *(const f32x4*)(src + i * 8), b = *(const f32x4*)(src + i * 8 + 4);
        v4u o; o.x = pk2(a.x, a.y); o.y = pk2(a.z, a.w); o.z = pk2(b.x, b.y); o.w = pk2(b.z, b.w);
        *(v4u*)(dst + i * 8) = o; }
}
__device__ __forceinline__ void p0_prologue(Frame& F, const Args& A) {
    unsigned char* ws = F.ws;
    long long* cs = (long long*)(ws + WS_FOLD); long long* b2 = cs + FO_N;
    transpose_mat(F, A.in[IN_AB_W_IN], DM, AB_IN, (bf16*)(ws + WS_W_ABIN));
    transpose_mat(F, A.in[IN_AB_W_OUT], DM, DM, (bf16*)(ws + WS_W_ABOUT));
    { const int l = 0;
        transpose_mat_fold(F, A.in[IN_XA_WQ] + (size_t)l * DM * XW, DM, XW, (bf16*)(ws + WS_W_XQ) + (size_t)l * XW * DM, A.in[IN_LN_G] + (size_t)(3 * l) * DM, A.in[IN_LN_B] + (size_t)(3 * l) * DM, cs + FO_XQ + l * XW, b2 + FO_XQ + l * XW);
        transpose_mat(F, A.in[IN_XA_WKV] + (size_t)l * DM * 2 * XW, DM, 2 * XW, (bf16*)(ws + WS_W_XKV) + (size_t)l * 2 * XW * DM);
        transpose_mat(F, A.in[IN_XA_WO] + (size_t)l * XW * DM, XW, DM, (bf16*)(ws + WS_W_XO) + (size_t)l * DM * XW);
        transpose_mat_fold(F, A.in[IN_FFN_UP] + (size_t)l * DM * DFF2, DM, DFF2, (bf16*)(ws + WS_W_UP) + (size_t)l * DFF2 * DM, A.in[IN_LN_G] + (size_t)(3 * l + 1) * DM, A.in[IN_LN_B] + (size_t)(3 * l + 1) * DM, cs + FO_UP + l * DFF2, b2 + FO_UP + l * DFF2); }
    for (int l = 0; l < 2; ++l) {
        transpose_mat(F, A.in[IN_NSA_CMP_W1] + (size_t)l * 32 * HD * HD, 32 * HD, HD, (bf16*)(ws + WS_W_C1) + (size_t)l * HD * 32 * HD);
        transpose_mat(F, A.in[IN_NSA_CMP_W2] + (size_t)l * HD * HD, HD, HD, (bf16*)(ws + WS_W_C2) + (size_t)l * HD * HD);
    }
    cvt_flat(F, A.in[IN_X], (bf16*)(ws + WS_HB), (long)MTOK * DM / 8);
    cvt_flat(F, A.in[IN_MEM], (bf16*)(ws + WS_MEMB), (long)BATCH * NMEM * DM / 8);
    { v4u z = {0u, 0u, 0u, 0u}; v4u* p = (v4u*)((bf16*)(ws + WS_W_NSAIN) + (size_t)NSA_IN * DM); const long n = (long)(NSA_INP - NSA_IN) * DM / 8;
      for (long i = (long)F.bid * NTHR + F.tid; i < n; i += (long)F.G * NTHR) p[i] = z; }
    { float* tab = (float*)(ws + WS_ROPE);
      for (int i = F.bid * NTHR + F.tid; i < SEQ * 64; i += F.G * NTHR) { const int t = i >> 6, d = i & 63;
          float sn, cs; sincosf((float)t * powf(10000.0f, -(float)d * (1.0f / 64.0f)), &sn, &cs); tab[(size_t)t * 128 + d] = cs; tab[(size_t)t * 128 + 64 + d] = sn; } }
    { const float* lbp = A.in[IN_HGRN_LB]; float* lbo = (float*)(ws + WS_LB);
      for (int i = F.bid * NTHR + F.tid; i < A_W; i += F.G * NTHR) { const float a = lbp[i], b = lbp[A_W + i], m = fmaxf(a, b), ea = __expf(a - m), eb = __expf(b - m); lbo[i] = ea / (ea + eb); } }
}

__device__ __forceinline__ void ln_phase(Frame& F, const bf16* Y, const float* g, const float* b, float* h32) {
    const int gw = F.bid * NWAVES + F.wave, NGW = F.G * NWAVES;
    for (int m = gw; m < MTOK; m += NGW) {
        const v4u* yr = (const v4u*)(Y + (size_t)m * DM) + F.lane;
        float v[8][8]; float s = 0.f;
#pragma unroll
        for (int j = 0; j < 8; ++j) { const v4u x = yr[64 * j];
            v[j][0] = bflo(x.x); v[j][1] = bfhi(x.x); v[j][2] = bflo(x.y); v[j][3] = bfhi(x.y); v[j][4] = bflo(x.z); v[j][5] = bfhi(x.z); v[j][6] = bflo(x.w); v[j][7] = bfhi(x.w);
#pragma unroll
            for (int q = 0; q < 8; ++q) s += v[j][q]; }
        const float mean = wave_sum(s) * (1.f / DM); float s2 = 0.f;
#pragma unroll
        for (int j = 0; j < 8; ++j)
#pragma unroll
            for (int q = 0; q < 8; ++q) { v[j][q] -= mean; s2 += v[j][q] * v[j][q]; }
        const float rstd = 1.f / sqrtf(wave_sum(s2) * (1.f / DM) + LN_EPS);
#pragma unroll
        for (int j = 0; j < 8; ++j) { const int c0 = 8 * F.lane + 512 * j;
            const f32x4 g0 = *(const f32x4*)(g + c0), g1 = *(const f32x4*)(g + c0 + 4), b0 = *(const f32x4*)(b + c0), b1 = *(const f32x4*)(b + c0 + 4);
            f32x4 r0, r1;
            r0.x = v[j][0] * rstd * g0.x + b0.x; r0.y = v[j][1] * rstd * g0.y + b0.y; r0.z = v[j][2] * rstd * g0.z + b0.z; r0.w = v[j][3] * rstd * g0.w + b0.w;
            r1.x = v[j][4] * rstd * g1.x + b1.x; r1.y = v[j][5] * rstd * g1.y + b1.y; r1.z = v[j][6] * rstd * g1.z + b1.z; r1.w = v[j][7] * rstd * g1.w + b1.w;
            *(f32x4*)(h32 + (size_t)m * DM + c0) = r0; *(f32x4*)(h32 + (size_t)m * DM + c0 + 4) = r1; }
    }
}

__device__ __forceinline__ void convglu_phase(Frame& F, const bf16* UP, const float* cw, bf16* Gm) {
    constexpr int NCG = DFF / 8, RB = 16, NRB = MTOK / RB;
    const long nitems = (long)NCG * NRB;
    for (long it = (long)F.bid * NTHR + F.tid; it < nitems; it += (long)F.G * NTHR) {
        const int cg = (int)(it % NCG), rb = (int)(it / NCG), c0 = cg * 8, t0 = rb * RB;
        float w0[8], w1[8], w2[8];
#pragma unroll
        for (int j = 0; j < 8; ++j) { w0[j] = cw[c0 + j]; w1[j] = cw[DFF + c0 + j]; w2[j] = cw[2 * DFF + c0 + j]; }
        float am2[8], am1[8];
        if ((t0 & (SEQ - 1)) == 0) {
#pragma unroll
            for (int j = 0; j < 8; ++j) { am2[j] = 0.f; am1[j] = 0.f; }
        } else {
            const v4u x2 = *(const v4u*)(UP + (size_t)(t0 - 2) * DFF2 + c0), x1 = *(const v4u*)(UP + (size_t)(t0 - 1) * DFF2 + c0);
            am2[0] = bflo(x2.x); am2[1] = bfhi(x2.x); am2[2] = bflo(x2.y); am2[3] = bfhi(x2.y); am2[4] = bflo(x2.z); am2[5] = bfhi(x2.z); am2[6] = bflo(x2.w); am2[7] = bfhi(x2.w);
            am1[0] = bflo(x1.x); am1[1] = bfhi(x1.x); am1[2] = bflo(x1.y); am1[3] = bfhi(x1.y); am1[4] = bflo(x1.z); am1[5] = bfhi(x1.z); am1[6] = bflo(x1.w); am1[7] = bfhi(x1.w);
        }
#pragma unroll 4
        for (int r = 0; r < RB; ++r) {
            const size_t row = (size_t)(t0 + r);
            const v4u xa = *(const v4u*)(UP + row * DFF2 + c0), xu = *(const v4u*)(UP + row * DFF2 + DFF + c0);
            float a[8], u[8];
            a[0] = bflo(xa.x); a[1] = bfhi(xa.x); a[2] = bflo(xa.y); a[3] = bfhi(xa.y); a[4] = bflo(xa.z); a[5] = bfhi(xa.z); a[6] = bflo(xa.w); a[7] = bfhi(xa.w);
            u[0] = bflo(xu.x); u[1] = bfhi(xu.x); u[2] = bflo(xu.y); u[3] = bfhi(xu.y); u[4] = bflo(xu.z); u[5] = bfhi(xu.z); u[6] = bflo(xu.w); u[7] = bfhi(xu.w);
            float o[8];
#pragma unroll
            for (int j = 0; j < 8; j += 2) {
                const float c0v = w2[j] * a[j] + w1[j] * am1[j] + w0[j] * am2[j], c1v = w2[j + 1] * a[j + 1] + w1[j + 1] * am1[j + 1] + w0[j + 1] * am2[j + 1];
                const pg8::f32x2 gg = pg8::gelu_pk((pg8::f32x2){c0v, c1v}); o[j] = gg.x * u[j]; o[j + 1] = gg.y * u[j + 1]; }
            v4u w; w.x = pk2(o[0], o[1]); w.y = pk2(o[2], o[3]); w.z = pk2(o[4], o[5]); w.w = pk2(o[6], o[7]);
            *(v4u*)(Gm + row * DFF + c0) = w;
#pragma unroll
            for (int j = 0; j < 8; ++j) { am2[j] = am1[j]; am1[j] = a[j]; }
        }
    }
}

__device__ __forceinline__ void xattn_phase(Frame& F, const bf16* XQ, const bf16* XKV, bf16* XO) {
    const int tid = F.tid, wid = F.wave, lane = F.lane, r32 = lane & 31, hi = lane >> 5;
    LAS char* lds = (LAS char*)F.lds;
    LAS float* wsc = (LAS float*)(lds + ATT_WS_OFF + wid * 256);
    const int vb0 = (int)(uintptr_t)(lds + ATT_V_OFF) + v_rd_base(lane);
    KVDma dm; kv_dma_init(dm, 2 * XW, 2 * XW, wid, lane);
    constexpr int NU = (MTOK / 256) * XH;
    for (int u = F.bid; u < NU; u += F.G) {
        const int head = u % XH, rbk = u / XH, row0 = rbk * 256, b = row0 / SEQ;
        const bf16* Kh = XKV + (size_t)b * NMEM * 2 * XW + head * HD; const bf16* Vh = Kh + XW;
        bf16x8 qr[8]; load_q(qr, XQ + (size_t)(row0 + wid * 32 + r32) * XW + head * HD + hi * 8);
        float m_reg = -1e30f, l_reg = 0.f; f32x16 o[4] = {};
        __syncthreads();
        kv_dma(dm, Kh, Vh, lds, 0, wid);
        for (int j = 0; j < NMEM / KVBLK; ++j) {
            const int buf = (j & 1) * ATT_BUF;
            VM_WAIT(); __syncthreads();
            if (j + 1 < NMEM / KVBLK) kv_dma(dm, Kh + (size_t)(j + 1) * KVBLK * 2 * XW, Vh + (size_t)(j + 1) * KVBLK * 2 * XW, lds, ATT_BUF - buf, wid);
            f32x16 p0, p1; qkt(p0, p1, lds + buf + ATT_K_OFF, qr, r32, hi);
            float alpha; softmax_tile(p0, p1, m_reg, l_reg, alpha);
            rescale_o(o, alpha, wsc, r32, hi);
            bf16x8 pa0, pa1, pa2, pa3; pack_p(p0, p1, pa0, pa1, pa2, pa3);
            pv_d0(o, vb0 + buf, pa0, pa1, pa2, pa3);
        }
        if (hi == 0) wsc[32 + r32] = l_reg; LDS_WAIT();
        bf16* Ow = XO + (size_t)(row0 + wid * 32) * XW + head * HD;
#pragma unroll
        for (int r = 0; r < 16; ++r) { const int orow = crow(r, hi); const float rl = __builtin_amdgcn_rcpf(wsc[32 + orow]);
#pragma unroll
            for (int d0 = 0; d0 < 4; ++d0) Ow[(size_t)orow * XW + d0 * 32 + r32] = (bf16)f2bf(o[d0][r] * rl); }
        LDS_WAIT();
    }
}

template <int K>
__device__ __forceinline__ f32x4 mma_tile(const LAS char* A, int lda, const LAS char* B, int ldb, int fr, int fq) {
    f32x4 acc = {0.f, 0.f, 0.f, 0.f};
#pragma unroll
    for (int k0 = 0; k0 < K; k0 += 32) {
        const bf16x8 a = *(const LAS bf16x8*)(A + fr * lda + (k0 + 8 * fq) * 2);
        const bf16x8 b = *(const LAS bf16x8*)(B + fr * ldb + (k0 + 8 * fq) * 2);
        acc = __builtin_amdgcn_mfma_f32_16x16x32_bf16(a, b, acc, 0, 0, 0);
    }
    return acc;
}
constexpr int HG_CH = 64, HG_NC = SEQ / HG_CH, HG_ITEMS = BATCH * A_HEADS * HG_NC;
constexpr int HG_QT = 0, HG_KT = 17408, HG_KH = 34816, HG_VT = 53248, HG_PT = 71680, HG_SEG = 80896;
constexpr int HG_SP = 17408, HG_OT = 52224;
constexpr int HG_WT = 80896, HG_KHS = 86016, HG_VS = 103424;
__device__ __forceinline__ void hgrn_phase_a(Frame& F, const bf16* P0, const float* lbv, bf16* QTg, bf16* OINTRA, bf16* DS, float* DEC) {
    LAS char* lds = (LAS char*)F.lds;
    const int tid = F.tid, wid = F.wave, lane = F.lane, fr = lane & 15, fq = lane >> 4;
    const int dg = tid & 15, sq = tid >> 4;
    const int d = tid & 127, sq16 = tid >> 7;
    for (int it = F.bid; it < HG_ITEMS; it += F.G) {
        const int c = it % HG_NC, bh = it / HG_NC, h = bh % A_HEADS, b = bh / A_HEADS;
        const size_t row0 = (size_t)b * SEQ + (size_t)c * HG_CH;
        float lb[8], q[2][8], kk[2][8], cum[2][8]; v4u vraw[2];
        { const f32x4 l0 = *(const f32x4*)(lbv + h * HD + 8 * dg), l1 = *(const f32x4*)(lbv + h * HD + 8 * dg + 4);
          lb[0] = l0.x; lb[1] = l0.y; lb[2] = l0.z; lb[3] = l0.w; lb[4] = l1.x; lb[5] = l1.y; lb[6] = l1.z; lb[7] = l1.w; }
#pragma unroll
        for (int rr = 0; rr < 2; ++rr) { const bf16* rowp = P0 + (row0 + 2 * sq + rr) * AB_IN + h * HD + 8 * dg;
            const v4u zq = *(const v4u*)(rowp + A_W), qq = *(const v4u*)rowp; vraw[rr] = *(const v4u*)(rowp + 2 * A_W);
            const unsigned zw[4] = {zq.x, zq.y, zq.z, zq.w}, qw[4] = {qq.x, qq.y, qq.z, qq.w};
#pragma unroll
            for (int j = 0; j < 8; ++j) { const float z = (j & 1) ? bfhi(zw[j >> 1]) : bflo(zw[j >> 1]); q[rr][j] = (j & 1) ? bfhi(qw[j >> 1]) : bflo(qw[j >> 1]);
                const float sg = sigmoidf_(z), omlb = 1.f - lb[j]; kk[rr][j] = omlb * (1.f - sg);
                const float lf = __logf(lb[j] + omlb * sg); cum[rr][j] = rr ? cum[0][j] + lf : lf; } }
        float pre[8];
#pragma unroll
        for (int j = 0; j < 8; ++j) { const float seg = cum[1][j]; float x = seg; const float t1 = __shfl_up(x, 16); if (lane >= 16) x += t1; const float t2 = __shfl_up(x, 32); if (lane >= 32) x += t2;
            pre[j] = x - seg; if (lane >= 48) ((LAS float*)(lds + HG_WT))[wid * 128 + 8 * dg + j] = x; }
        LDS_WAIT(); __syncthreads();
        float total[8];
#pragma unroll
        for (int j = 0; j < 8; ++j) total[j] = 0.f;
#pragma unroll
        for (int w = 0; w < NWAVES; ++w) { const f32x4 a0 = *(const LAS f32x4*)(lds + HG_WT + (w * 128 + 8 * dg) * 4), a1 = *(const LAS f32x4*)(lds + HG_WT + (w * 128 + 8 * dg + 4) * 4);
            const float av[8] = {a0.x, a0.y, a0.z, a0.w, a1.x, a1.y, a1.z, a1.w};
#pragma unroll
            for (int j = 0; j < 8; ++j) { total[j] += av[j]; if (w < wid) pre[j] += av[j]; } }
#pragma unroll
        for (int rr = 0; rr < 2; ++rr) { const int s = 2 * sq + rr; unsigned qt[4], kt[4], kh[4];
#pragma unroll
            for (int j = 0; j < 8; j += 2) { const float b0 = pre[j] + cum[rr][j], b1 = pre[j + 1] + cum[rr][j + 1];
                qt[j >> 1] = pk2(q[rr][j] * __expf(b0), q[rr][j + 1] * __expf(b1));
                kt[j >> 1] = pk2(kk[rr][j] * __expf(-b0), kk[rr][j + 1] * __expf(-b1));
                kh[j >> 1] = pk2(kk[rr][j] * __expf(total[j] - b0), kk[rr][j + 1] * __expf(total[j + 1] - b1)); }
            const v4u qv = {qt[0], qt[1], qt[2], qt[3]};
            *(LAS v4u*)(lds + HG_QT + s * 272 + dg * 16) = qv; *(v4u*)(QTg + (row0 + s) * A_W + h * HD + 8 * dg) = qv;
            *(LAS v4u*)(lds + HG_KT + s * 272 + dg * 16) = (v4u){kt[0], kt[1], kt[2], kt[3]};
            *(LAS v4u*)(lds + HG_KHS + s * 272 + dg * 16) = (v4u){kh[0], kh[1], kh[2], kh[3]};
            *(LAS v4u*)(lds + HG_VS + s * 272 + dg * 16) = vraw[rr]; }
        if (sq == 31) { f32x4 e0, e1; e0.x = __expf(total[0]); e0.y = __expf(total[1]); e0.z = __expf(total[2]); e0.w = __expf(total[3]); e1.x = __expf(total[4]); e1.y = __expf(total[5]); e1.z = __expf(total[6]); e1.w = __expf(total[7]);
            *(f32x4*)(DEC + (size_t)it * HD + 8 * dg) = e0; *(f32x4*)(DEC + (size_t)it * HD + 8 * dg + 4) = e1; }
        LDS_WAIT(); __syncthreads();
        { unsigned kh[8], vt[8];
#pragma unroll
          for (int j = 0; j < 16; j += 2) { const int s = 16 * sq16 + j;
              kh[j >> 1] = (unsigned)*(const LAS unsigned short*)(lds + HG_KHS + s * 272 + d * 2) | ((unsigned)*(const LAS unsigned short*)(lds + HG_KHS + (s + 1) * 272 + d * 2) << 16);
              vt[j >> 1] = (unsigned)*(const LAS unsigned short*)(lds + HG_VS + s * 272 + d * 2) | ((unsigned)*(const LAS unsigned short*)(lds + HG_VS + (s + 1) * 272 + d * 2) << 16); }
          LAS v4u* pk = (LAS v4u*)(lds + HG_KH + d * 144 + sq16 * 32); pk[0] = (v4u){kh[0], kh[1], kh[2], kh[3]}; pk[1] = (v4u){kh[4], kh[5], kh[6], kh[7]};
          LAS v4u* pv = (LAS v4u*)(lds + HG_VT + d * 144 + sq16 * 32); pv[0] = (v4u){vt[0], vt[1], vt[2], vt[3]}; pv[1] = (v4u){vt[4], vt[5], vt[6], vt[7]}; }
        LDS_WAIT(); __syncthreads();
#pragma unroll
        for (int k = 0; k < 2; ++k) { const int tau = 2 * wid + k, ti = tau >> 2, si = tau & 3;
            f32x4 acc = {0.f, 0.f, 0.f, 0.f};
            if (si <= ti) acc = mma_tile<128>(lds + HG_QT + ti * 16 * 272, 272, lds + HG_KT + si * 16 * 272, 272, fr, fq);
#pragma unroll
            for (int i = 0; i < 4; ++i) { const int t = 16 * ti + 4 * fq + i, s = 16 * si + fr; const float v = (s <= t) ? acc[i] : 0.f;
                *(LAS unsigned short*)(lds + HG_PT + t * 144 + s * 2) = (unsigned short)f2bf(v); } }
        LDS_WAIT(); __syncthreads();
#pragma unroll
        for (int k = 0; k < 4; ++k) { const int tau = wid + 8 * k, ti = tau >> 3, vi = tau & 7;
            const f32x4 acc = mma_tile<64>(lds + HG_VT + vi * 16 * 144, 144, lds + HG_PT + ti * 16 * 144, 144, fr, fq);
            v2u w; w.x = pk2(acc[0], acc[1]); w.y = pk2(acc[2], acc[3]);
            *(v2u*)(OINTRA + (row0 + 16 * ti + fr) * A_W + h * HD + 16 * vi + 4 * fq) = w; }
#pragma unroll
        for (int k = 0; k < 8; ++k) { const int tau = wid + 8 * k, vi = tau >> 3, ki = tau & 7;
            const f32x4 acc = mma_tile<64>(lds + HG_KH + ki * 16 * 144, 144, lds + HG_VT + vi * 16 * 144, 144, fr, fq);
            v2u w; w.x = pk2(acc[0], acc[1]); w.y = pk2(acc[2], acc[3]);
            *(v2u*)(DS + ((size_t)it * HD + 16 * vi + fr) * HD + 16 * ki + 4 * fq) = w; }
        LDS_WAIT(); __syncthreads();
    }
}
__device__ __forceinline__ void hgrn_phase_b(Frame& F, const bf16* DS, const float* DEC, bf16* SPREV) {
    const int tid = F.tid, dvl = tid >> 5, dk4 = (tid & 31) * 4;
    for (int item = F.bid; item < BATCH * A_HEADS * 8; item += F.G) {
        const int sl = item & 7, bh = item >> 3, dv = sl * 16 + dvl;
        f32x4 S = {0.f, 0.f, 0.f, 0.f};
        for (int c0 = 0; c0 < HG_NC; c0 += 8) {
            f32x4 ds[8], dc[8];
#pragma unroll
            for (int k = 0; k < 8; ++k) { const size_t it = (size_t)bh * HG_NC + c0 + k; const v2u x = *(const v2u*)(DS + (it * HD + dv) * HD + dk4);
                ds[k] = (f32x4){bflo(x.x), bfhi(x.x), bflo(x.y), bfhi(x.y)}; dc[k] = *(const f32x4*)(DEC + it * HD + dk4); }
#pragma unroll
            for (int k = 0; k < 8; ++k) { const size_t it = (size_t)bh * HG_NC + c0 + k;
                v2u w; w.x = pk2(S.x, S.y); w.y = pk2(S.z, S.w); *(v2u*)(SPREV + (it * HD + dv) * HD + dk4) = w;
                S = S * dc[k] + ds[k]; }
        }
    }
}
__device__ __forceinline__ void hgrn_phase_c(Frame& F, const bf16* P0, const bf16* QTg, const bf16* OINTRA, const bf16* SPREV, const float* nw, bf16* Ob) {
    LAS char* lds = (LAS char*)F.lds;
    const int tid = F.tid, wid = F.wave, lane = F.lane, fr = lane & 15, fq = lane >> 4;
    for (int it = F.bid; it < HG_ITEMS; it += F.G) {
        const int c = it % HG_NC, bh = it / HG_NC, h = bh % A_HEADS, b = bh / A_HEADS;
        const size_t row0 = (size_t)b * SEQ + (size_t)c * HG_CH;
        { const int s = tid >> 3, ch = (tid & 7) * 16; const bf16* src = QTg + (row0 + s) * A_W + h * HD + ch;
          const v4u x0 = *(const v4u*)src, x1 = *(const v4u*)(src + 8); LAS v4u* dst = (LAS v4u*)(lds + HG_QT + s * 272 + ch * 2); dst[0] = x0; dst[1] = x1; }
        { const int dv = tid >> 2, ch = (tid & 3) * 32; const bf16* src = SPREV + ((size_t)it * HD + dv) * HD + ch;
          const v4u x0 = *(const v4u*)src, x1 = *(const v4u*)(src + 8), x2 = *(const v4u*)(src + 16), x3 = *(const v4u*)(src + 24);
          LAS v4u* dst = (LAS v4u*)(lds + HG_SP + dv * 272 + ch * 2); dst[0] = x0; dst[1] = x1; dst[2] = x2; dst[3] = x3; }
        LDS_WAIT(); __syncthreads();
#pragma unroll
        for (int k = 0; k < 4; ++k) { const int tau = wid + 8 * k, ti = tau >> 3, vi = tau & 7;
            const f32x4 acc = mma_tile<128>(lds + HG_SP + vi * 16 * 272, 272, lds + HG_QT + ti * 16 * 272, 272, fr, fq);
            const int t = 16 * ti + fr, dv = 16 * vi + 4 * fq; const v2u oi = *(const v2u*)(OINTRA + (row0 + t) * A_W + h * HD + dv);
            *(LAS f32x4*)(lds + HG_OT + (t * 132 + dv) * 4) = (f32x4){acc[0] + bflo(oi.x), acc[1] + bfhi(oi.x), acc[2] + bflo(oi.y), acc[3] + bfhi(oi.y)}; }
        LDS_WAIT(); __syncthreads();
        { const int t = tid >> 3, dv0 = (tid & 7) * 16;
          float v[16]; float ss = 0.f;
#pragma unroll
          for (int q4 = 0; q4 < 4; ++q4) { const f32x4 x = *(const LAS f32x4*)(lds + HG_OT + (t * 132 + dv0 + 4 * q4) * 4); v[4 * q4] = x.x; v[4 * q4 + 1] = x.y; v[4 * q4 + 2] = x.z; v[4 * q4 + 3] = x.w;
              ss += (x.x * x.x + x.y * x.y) + (x.z * x.z + x.w * x.w); }
          ss += __shfl_xor(ss, 1); ss += __shfl_xor(ss, 2); ss += __shfl_xor(ss, 4);
          const float r = 1.f / sqrtf(ss * (1.f / HD) + RMS_EPS);
          const bf16* gp = P0 + (row0 + t) * AB_IN + 3 * A_W + h * HD + dv0; const v4u g0 = *(const v4u*)gp, g1 = *(const v4u*)(gp + 8);
          const unsigned gw[8] = {g0.x, g0.y, g0.z, g0.w, g1.x, g1.y, g1.z, g1.w}; unsigned o[8];
#pragma unroll
          for (int j = 0; j < 8; ++j) { const float ga = bflo(gw[j]), gb = bfhi(gw[j]);
              o[j] = pk2(v[2 * j] * r * nw[dv0 + 2 * j] * ga * sigmoidf_(ga), v[2 * j + 1] * r * nw[dv0 + 2 * j + 1] * gb * sigmoidf_(gb)); }
          bf16* op = Ob + (row0 + t) * DM + h * HD + dv0; *(v4u*)op = (v4u){o[0], o[1], o[2], o[3]}; *(v4u*)(op + 8) = (v4u){o[4], o[5], o[6], o[7]}; }
        LDS_WAIT(); __syncthreads();
    }
}

constexpr float SB_CUT = -160.f;
__device__ __forceinline__ void sb_phase(Frame& F, const bf16* P0, bf16* Ob) {
    const int tid = F.tid, wid = F.wave, lane = F.lane, r32 = lane & 31, hi = lane >> 5;
    LAS char* lds = (LAS char*)F.lds;
    const int vb0 = (int)(uintptr_t)(lds + ATT_V_OFF) + v_rd_base(lane);
    KVDma dm; kv_dma_init(dm, AB_IN, AB_IN, wid, lane);
    constexpr int NQB = SEQ / 256, NU = BATCH * B_HEADS * NQB;
    for (int rd = 0; ; ++rd) {
        const int idx = (rd & 1) ? rd * F.G + (F.G - 1 - F.bid) : rd * F.G + F.bid;
        if (rd * F.G >= NU) break;
        if (idx >= NU) continue;
        const int qb = NQB - 1 - idx / (BATCH * B_HEADS), bh = idx % (BATCH * B_HEADS), head = bh % B_HEADS, b = bh / B_HEADS;
        const size_t rowb = (size_t)b * SEQ; const int q0 = qb * 256;
        const bf16* Kh = P0 + rowb * AB_IN + 4 * A_W + B_W + head * HD; const bf16* Vh = Kh + B_W;
        const int tw0 = q0 + wid * 32, t = tw0 + r32;
        bf16x8 qr[8]; load_q(qr, P0 + (rowb + t) * AB_IN + 4 * A_W + head * HD + hi * 8);
        float R = 0.f; f32x16 o[4] = {};
        const int jtop = (q0 + 254) >> 6;
        LAS unsigned* dflag = (LAS unsigned*)(lds + ATT_X_OFF);
        if (lane == 0) { dflag[wid] = 0u; dflag[8 + wid] = 0u; }
        LDS_WAIT(); __syncthreads();
        kv_dma(dm, Kh + (size_t)jtop * KVBLK * AB_IN, Vh + (size_t)jtop * KVBLK * AB_IN, lds, 0, wid);
        int buf = 0;
        for (int j = jtop; j >= 0; --j, buf = ATT_BUF - buf) {
            VM_WAIT(); __syncthreads();
            { unsigned alld = 1u;
#pragma unroll
              for (int w = 0; w < NWAVES; ++w) alld &= dflag[((j + 1) & 1) * 8 + w];
              if (__builtin_amdgcn_readfirstlane(alld)) break; }
            if (j > 0) kv_dma(dm, Kh + (size_t)(j - 1) * KVBLK * AB_IN, Vh + (size_t)(j - 1) * KVBLK * AB_IN, lds, ATT_BUF - buf, wid);
            const int k0 = j * KVBLK;
            if (k0 < tw0 + 31) {
                f32x16 p0, p1; qkt(p0, p1, lds + buf + ATT_K_OFF, qr, r32, hi);
                const bool need_mask = (k0 + 63 >= tw0);
                float L0[16], L1[16];
#pragma unroll
                for (int r = 0; r < 16; ++r) {
                    const float z0 = p0[r] * ATT_C, z1 = p1[r] * ATT_C;
                    float l0 = -(fmaxf(z0, 0.f) + __builtin_amdgcn_logf(1.f + __builtin_amdgcn_exp2f(-fabsf(z0))));
                    float l1 = -(fmaxf(z1, 0.f) + __builtin_amdgcn_logf(1.f + __builtin_amdgcn_exp2f(-fabsf(z1))));
                    if (need_mask) { if (k0 + crow(r, hi) >= t) l0 = 0.f; if (k0 + 32 + crow(r, hi) >= t) l1 = 0.f; }
                    L0[r] = l0; L1[r] = l1; p0[r] = z0 + l0; p1[r] = z1 + l1;
                }
                SBAR();
                float Sg[16];
#pragma unroll
                for (int gi = 0; gi < 4; ++gi) {
                    const float a = (L0[4 * gi] + L0[4 * gi + 1]) + (L0[4 * gi + 2] + L0[4 * gi + 3]), c = (L1[4 * gi] + L1[4 * gi + 1]) + (L1[4 * gi + 2] + L1[4 * gi + 3]);
                    auto ra = __builtin_amdgcn_permlane32_swap(__float_as_uint(a), __float_as_uint(a), false, false);
                    auto rc = __builtin_amdgcn_permlane32_swap(__float_as_uint(c), __float_as_uint(c), false, false);
                    Sg[2 * gi] = __uint_as_float(ra[0]); Sg[2 * gi + 1] = __uint_as_float(ra[1]); Sg[8 + 2 * gi] = __uint_as_float(rc[0]); Sg[8 + 2 * gi + 1] = __uint_as_float(rc[1]);
                }
                float run = R;
#pragma unroll
                for (int s = 15; s >= 0; --s) { const float tt = run; run += Sg[s]; Sg[s] = tt; }
                const float Rn = run;
                SBAR();
#pragma unroll
                for (int gi = 0; gi < 4; ++gi) {
                    float base0 = hi ? Sg[2 * gi + 1] : Sg[2 * gi], base1 = hi ? Sg[8 + 2 * gi + 1] : Sg[8 + 2 * gi];
                    float r3 = base0, r2 = r3 + L0[4 * gi + 3], r1 = r2 + L0[4 * gi + 2], r0 = r1 + L0[4 * gi + 1];
                    p0[4 * gi + 3] = __builtin_amdgcn_exp2f(p0[4 * gi + 3] + r3); p0[4 * gi + 2] = __builtin_amdgcn_exp2f(p0[4 * gi + 2] + r2);
                    p0[4 * gi + 1] = __builtin_amdgcn_exp2f(p0[4 * gi + 1] + r1); p0[4 * gi + 0] = __builtin_amdgcn_exp2f(p0[4 * gi + 0] + r0);
                    r3 = base1; r2 = r3 + L1[4 * gi + 3]; r1 = r2 + L1[4 * gi + 2]; r0 = r1 + L1[4 * gi + 1];
                    p1[4 * gi + 3] = __builtin_amdgcn_exp2f(p1[4 * gi + 3] + r3); p1[4 * gi + 2] = __builtin_amdgcn_exp2f(p1[4 * gi + 2] + r2);
                    p1[4 * gi + 1] = __builtin_amdgcn_exp2f(p1[4 * gi + 1] + r1); p1[4 * gi + 0] = __builtin_amdgcn_exp2f(p1[4 * gi + 0] + r0);
                }
                R = Rn;
                { const unsigned dn = __all(R < SB_CUT) ? 1u : 0u; if (lane == 0) dflag[(j & 1) * 8 + wid] = dn; }
                if (need_mask) {
#pragma unroll
                    for (int r = 0; r < 16; ++r) { if (k0 + crow(r, hi) >= t) p0[r] = 0.f; if (k0 + 32 + crow(r, hi) >= t) p1[r] = 0.f; }
                }
                bf16x8 pa0, pa1, pa2, pa3; pack_p(p0, p1, pa0, pa1, pa2, pa3);
                pv_d0(o, vb0 + buf, pa0, pa1, pa2, pa3);
            }
        }
        bf16* Ow = Ob + (rowb + tw0) * DM + A_W + head * HD;
#pragma unroll
        for (int r = 0; r < 16; ++r) { const int orow = crow(r, hi);
#pragma unroll
            for (int d0 = 0; d0 < 4; ++d0) Ow[(size_t)orow * DM + d0 * 32 + r32] = (bf16)f2bf(o[d0][r]); }
    }
}

constexpr int P1_KC = 4096, P1_VC = 4608, P1_KS = 5120, P1_VS = 5632, P1_KW = 6144, P1_VW = 6656, P1_GL = 7168;
__device__ __forceinline__ void nsa_rope_phase(Frame& F, const bf16* P1, const float* TAB, bf16* QROT, bf16* KSROT, bf16* KWROT, bf16* OVL) {
    const int gw = F.bid * NWAVES + F.wave, NGW = F.G * NWAVES, lane = F.lane, hsub = lane >> 3, d0 = (lane & 7) * 8;
    for (int m = gw; m < MTOK; m += NGW) {
        const int t = m & (SEQ - 1);
        const f32x4 c0 = *(const f32x4*)(TAB + (size_t)t * 128 + d0), c1 = *(const f32x4*)(TAB + (size_t)t * 128 + d0 + 4);
        const f32x4 s0 = *(const f32x4*)(TAB + (size_t)t * 128 + 64 + d0), s1 = *(const f32x4*)(TAB + (size_t)t * 128 + 64 + d0 + 4);
        const float cs[8] = {c0.x, c0.y, c0.z, c0.w, c1.x, c1.y, c1.z, c1.w}, sn[8] = {s0.x, s0.y, s0.z, s0.w, s1.x, s1.y, s1.z, s1.w};
        const bf16* row = P1 + (size_t)m * NSA_INP;
#pragma unroll
        for (int hb = 0; hb < 5; ++hb) {
            const int hh = hb * 8 + hsub;
            const bf16* src; bf16* dst;
            if (hh < 32) { src = row + hh * HD; dst = QROT + (size_t)m * DM + hh * HD; }
            else if (hh < 36) { src = row + P1_KS + (hh - 32) * HD; dst = KSROT + (size_t)m * KVW + (hh - 32) * HD; }
            else { src = row + P1_KW + (hh - 36) * HD; dst = KWROT + (size_t)m * KVW + (hh - 36) * HD; }
            const v4u a = *(const v4u*)(src + d0), bq = *(const v4u*)(src + 64 + d0);
            const unsigned aw[4] = {a.x, a.y, a.z, a.w}, bw[4] = {bq.x, bq.y, bq.z, bq.w}; unsigned o1[4], o2[4];
#pragma unroll
            for (int q = 0; q < 4; ++q) { const float x1l = bflo(aw[q]), x1h = bfhi(aw[q]), x2l = bflo(bw[q]), x2h = bfhi(bw[q]);
                o1[q] = pk2(x1l * cs[2 * q] - x2l * sn[2 * q], x1h * cs[2 * q + 1] - x2h * sn[2 * q + 1]);
                o2[q] = pk2(x2l * cs[2 * q] + x1l * sn[2 * q], x2h * cs[2 * q + 1] + x1h * sn[2 * q + 1]); }
            *(v4u*)(dst + d0) = (v4u){o1[0], o1[1], o1[2], o1[3]}; *(v4u*)(dst + 64 + d0) = (v4u){o2[0], o2[1], o2[2], o2[3]};
        }
    }
    for (int i = F.bid * NTHR + F.tid; i < NCMPP * NSLC; i += F.G * NTHR) { const int n = i / NSLC, j = i % NSLC;
        OVL[i] = (n < NCMP && n >= 4 * j - 1 && n <= 4 * j + 3) ? (bf16)0x3f80u : (bf16)0u; }
}
constexpr int CM_A = 0, CM_B = 17408, CM_H = 17408 + 34816;
__device__ __forceinline__ void nsa_compress_phase(Frame& F, const bf16* P1, const float* pos, const bf16* W1t, const bf16* W2t, bf16* KCMP, bf16* VCMP) {
    LAS char* lds = (LAS char*)F.lds;
    const int tid = F.tid, wid = F.wave, lane = F.lane, fr = lane & 15, fq = lane >> 4;
    for (int item = F.bid; item < 128; item += F.G) {
        const int nt = item & 7, g = (item >> 3) & 3, b = (item >> 5) & 1, which = item >> 6;
        const bf16* w1 = W1t + (size_t)which * HD * 32 * HD; const bf16* w2 = W2t + (size_t)which * HD * HD;
        const float* posw = pos + (size_t)which * 32 * HD;
        f32x4 acc[4];
#pragma unroll
        for (int k = 0; k < 4; ++k) acc[k] = (f32x4){0.f, 0.f, 0.f, 0.f};
        for (int l = 0; l < 32; ++l) {
            { const int r = tid >> 3, ch = (tid & 7) * 16, n = nt * 64 + r; unsigned w[8];
              if (n < NCMP) { const bf16* src = P1 + ((size_t)b * SEQ + 16 * n + l) * NSA_INP + P1_KC + which * KVW + g * HD + ch;
                  const v4u x0 = *(const v4u*)src, x1 = *(const v4u*)(src + 8); const unsigned xs[8] = {x0.x, x0.y, x0.z, x0.w, x1.x, x1.y, x1.z, x1.w};
#pragma unroll
                  for (int q = 0; q < 8; ++q) w[q] = pk2(bflo(xs[q]) + posw[l * HD + ch + 2 * q], bfhi(xs[q]) + posw[l * HD + ch + 2 * q + 1]);
              } else {
#pragma unroll
                  for (int q = 0; q < 8; ++q) w[q] = 0u; }
              LAS v4u* dst = (LAS v4u*)(lds + CM_A + r * 272 + ch * 2); dst[0] = (v4u){w[0], w[1], w[2], w[3]}; dst[1] = (v4u){w[4], w[5], w[6], w[7]}; }
            { const int e = tid >> 2, ch = (tid & 3) * 32; const bf16* src = w1 + (size_t)e * 32 * HD + l * HD + ch;
              const v4u x0 = *(const v4u*)src, x1 = *(const v4u*)(src + 8), x2 = *(const v4u*)(src + 16), x3 = *(const v4u*)(src + 24);
              LAS v4u* dst = (LAS v4u*)(lds + CM_B + e * 272 + ch * 2); dst[0] = x0; dst[1] = x1; dst[2] = x2; dst[3] = x3; }
            LDS_WAIT(); __syncthreads();
#pragma unroll
            for (int k = 0; k < 4; ++k) { const int tau = wid + 8 * k, ni = tau >> 3, ei = tau & 7;
                acc[k] += mma_tile<128>(lds + CM_A + ni * 16 * 272, 272, lds + CM_B + ei * 16 * 272, 272, fr, fq); }
            LDS_WAIT(); __syncthreads();
        }
#pragma unroll
        for (int k = 0; k < 4; ++k) { const int tau = wid + 8 * k, ni = tau >> 3, ei = tau & 7;
#pragma unroll
            for (int i = 0; i < 4; ++i) *(LAS unsigned short*)(lds + CM_H + (16 * ni + 4 * fq + i) * 272 + (16 * ei + fr) * 2) = (unsigned short)f2bf(gelu1(acc[k][i])); }
        { const int f = tid >> 2, ch = (tid & 3) * 32; const bf16* src = w2 + (size_t)f * HD + ch;
          const v4u x0 = *(const v4u*)src, x1 = *(const v4u*)(src + 8), x2 = *(const v4u*)(src + 16), x3 = *(const v4u*)(src + 24);
          LAS v4u* dst = (LAS v4u*)(lds + CM_B + f * 272 + ch * 2); dst[0] = x0; dst[1] = x1; dst[2] = x2; dst[3] = x3; }
        LDS_WAIT(); __syncthreads();
        bf16* outp = which ? VCMP : KCMP;
#pragma unroll
        for (int k = 0; k < 4; ++k) { const int tau = wid + 8 * k, ni = tau >> 3, fi = tau & 7;
            const f32x4 a2 = mma_tile<128>(lds + CM_H + ni * 16 * 272, 272, lds + CM_B + fi * 16 * 272, 272, fr, fq);
#pragma unroll
            for (int i = 0; i < 4; ++i) { const int n = nt * 64 + 16 * ni + 4 * fq + i;
                outp[(((size_t)b * NCMPP + n) * NSA_G + g) * HD + 16 * fi + fr] = (n < NCMP) ? (bf16)f2bf(a2[i]) : (bf16)0u; } }
        LDS_WAIT(); __syncthreads();
    }
}
__device__ __forceinline__ unsigned pick4(const unsigned (&a)[4], int i) { return i == 0 ? a[0] : (i == 1 ? a[1] : (i == 2 ? a[2] : a[3])); }
template <int MODE>
__device__ __forceinline__ void nsa_attn_phase(Frame& F, const bf16* P1, const bf16* Qsrc, const bf16* Ksrc, const bf16* Vsrc, const unsigned* SEL, float* O32, float* IMP, bf16* Ob, bool probe_nostore = false) {
    const int tid = F.tid, wid = F.wave, lane = F.lane, r32 = lane & 31, hi = lane >> 5;
    LAS char* lds = (LAS char*)F.lds;
    LAS float* wsc = (LAS float*)(lds + ATT_WS_OFF + wid * 256);
    const int vb0 = (int)(uintptr_t)(lds + ATT_V_OFF) + v_rd_base(lane);
    KVDma dm; kv_dma_init(dm, MODE <= 1 ? NSA_G * HD : KVW, MODE == 0 ? NSA_G * HD : (MODE == 1 ? NSLC : NSA_INP), wid, lane);
    constexpr int NTB = SEQ / 32, NU = BATCH * NSA_G * NTB;
    for (int rd = 0; ; ++rd) {
        const int idx = (rd & 1) ? rd * F.G + (F.G - 1 - F.bid) : rd * F.G + F.bid;
        if (rd * F.G >= NU) break;
        if (idx >= NU) continue;
        const int tb = NTB - 1 - idx / (BATCH * NSA_G), bg = idx % (BATCH * NSA_G), g = bg % NSA_G, b = bg / NSA_G;
        const size_t rowb = (size_t)b * SEQ; const int t0 = tb * 32;
        const int t = (MODE == 2) ? t0 + 4 * wid + (r32 >> 3) : t0 + r32, head = (MODE == 2) ? g * NSA_R + (r32 & 7) : g * NSA_R + wid;
        const bf16* Kh; const bf16* Vh; long ldk, ldv; int jlo, jhi;
        if (MODE <= 1) { Kh = Ksrc + ((size_t)b * NCMPP * NSA_G + g) * HD; ldk = NSA_G * HD; jlo = 0; jhi = (t0 >> 4) >> 6;
            if (MODE == 0) { Vh = Vsrc + ((size_t)b * NCMPP * NSA_G + g) * HD; ldv = NSA_G * HD; } else { Vh = Vsrc; ldv = NSLC; } }
        else { Kh = Ksrc + rowb * KVW + g * HD; ldk = KVW; Vh = P1 + rowb * NSA_INP + (MODE == 2 ? P1_VS : P1_VW) + g * HD; ldv = NSA_INP;
            jhi = (t0 + 31) >> 6; jlo = (MODE == 2) ? 0 : ((t0 - (WINDOW - 1) > 0 ? t0 - (WINDOW - 1) : 0) >> 6); }
        unsigned selw[4] = {0u, 0u, 0u, 0u}, wn[4] = {~0u, ~0u, ~0u, ~0u};
        if (MODE == 2) { const v4u sv = *(const v4u*)(SEL + ((rowb + t) * NSA_G + g) * 4); selw[0] = sv.x; selw[1] = sv.y; selw[2] = sv.z; selw[3] = sv.w;
            LAS unsigned* un = (LAS unsigned*)(lds + ATT_X_OFF);
#pragma unroll
            for (int q = 0; q < 4; ++q) { unsigned x = selw[q]; x |= __shfl_xor(x, 8); x |= __shfl_xor(x, 16); wn[q] = __builtin_amdgcn_readfirstlane(x); if (lane == 0) un[wid * 4 + q] = wn[q]; }
            LDS_WAIT(); __syncthreads();
            LAS int* plist = (LAS int*)(lds + ATT_X_OFF + 128);
            if (wid == 0) {
                unsigned m0 = 0u, m1 = 0u;
                int lane_l = lane; asm volatile("" : "+v"(lane_l));
                const LAS unsigned* ub = un + (lane_l >> 5);
#pragma unroll
                for (int w = 0; w < NWAVES; ++w) { m0 |= ((ub[w * 4] >> (lane & 31)) & 1u) << w; m1 |= ((ub[w * 4 + 2] >> (lane & 31)) & 1u) << w; }
                bool v0 = m0 != 0u && lane <= jhi, v1 = m1 != 0u && lane + 64 <= jhi; int np = 0;
                for (;;) {
                    const unsigned long long a0 = __ballot(v0), a1 = __ballot(v1);
                    if (!(a0 | a1)) break;
                    const int ja_ = a0 ? __builtin_ctzll(a0) : 64 + __builtin_ctzll(a1);
                    const unsigned ma = (ja_ < 64) ? (unsigned)__shfl((int)m0, ja_) : (unsigned)__shfl((int)m1, ja_ - 64);
                    if (lane == (ja_ & 63)) { if (ja_ < 64) v0 = false; else v1 = false; }
                    unsigned long long c0 = __ballot(v0 && !(m0 & ma)), c1 = __ballot(v1 && !(m1 & ma));
                    if (!(c0 | c1)) { c0 = __ballot(v0 && m0 == 0xffu); c1 = __ballot(v1 && m1 == 0xffu); }
                    if (!(c0 | c1)) { c0 = __ballot(v0); c1 = __ballot(v1); }
                    int jb_ = -1;
                    if (c0 | c1) { jb_ = c0 ? __builtin_ctzll(c0) : 64 + __builtin_ctzll(c1); if (lane == (jb_ & 63)) { if (jb_ < 64) v0 = false; else v1 = false; } }
                    if (lane == 0) { plist[2 * np] = ja_; plist[2 * np + 1] = jb_; }
                    ++np;
                }
                if (lane == 0) { plist[2 * np] = -1; plist[2 * np + 1] = -1; }
            }
            LDS_WAIT(); }
        bf16x8 qr[8]; load_q(qr, Qsrc + (rowb + t) * (MODE <= 1 ? NSA_INP : DM) + head * HD + hi * 8);
        float m_reg = -1e30f, l_reg = 0.f; f32x16 o[4] = {};
        const int cur = t >> 6;
#define NSA_NEED(jj) (MODE != 2 || ((pick4(wn, (jj) >> 5) >> ((jj) & 31)) & 1u))
#define NSA_MASK(P0, P1, JJ) do { const int k0 = (JJ) * KVBLK; constexpr float NINF = -__builtin_inff(); \
            if (MODE <= 1) { if (!(16 * (k0 + 63) + 31 <= t0)) { \
                    _Pragma("unroll") for (int r = 0; r < 16; ++r) { if (!(16 * (k0 + crow(r, hi)) + 31 <= t)) P0[r] = NINF; if (!(16 * (k0 + 32 + crow(r, hi)) + 31 <= t)) P1[r] = NINF; } } } \
            else if (MODE == 2) { const bool mine = (pick4(selw, (JJ) >> 5) >> ((JJ) & 31)) & 1u; const int lim = mine ? ((JJ) < cur ? 0x7fffffff : t) : -1; \
                _Pragma("unroll") for (int r = 0; r < 16; ++r) { if (k0 + crow(r, hi) > lim) P0[r] = NINF; if (k0 + 32 + crow(r, hi) > lim) P1[r] = NINF; } } \
            else { if (!((k0 > t0 + 31 - WINDOW) && (k0 + 63 <= t0))) { \
                    _Pragma("unroll") for (int r = 0; r < 16; ++r) { const int ka = k0 + crow(r, hi), kb = ka + 32; \
                        if (!(ka <= t && ka > t - WINDOW)) P0[r] = NINF; if (!(kb <= t && kb > t - WINDOW)) P1[r] = NINF; } } } } while (0)
        const int pbase = __builtin_amdgcn_readfirstlane((int)(uintptr_t)(lds + ATT_X_OFF + 128)); int pp = 0;
#define PLIST(i) (*(const LAS int*)(uintptr_t)(unsigned)(pbase + 4 * (i)))
        int ja, jb;
        __syncthreads();
        if (MODE == 2) { ja = PLIST(0); jb = PLIST(1); ja = __builtin_amdgcn_readfirstlane(ja); jb = __builtin_amdgcn_readfirstlane(jb); if (ja < 0) ja = jhi + 1; }
        else { ja = jlo; jb = ja + 1; if (jb > jhi) jb = -1; }
        if (ja <= jhi) kv_dma(dm, Kh + (size_t)ja * KVBLK * ldk, Vh + (size_t)ja * KVBLK * ldv, lds, 0, wid);
        if (jb >= 0) kv_dma(dm, Kh + (size_t)jb * KVBLK * ldk, Vh + (size_t)jb * KVBLK * ldv, lds, ATT_BUF, wid);
        int set = 0;
#pragma nounroll
        while (ja <= jhi) {
            int jc, jd;
            if (MODE == 2) { ++pp; jc = PLIST(2 * pp); jd = PLIST(2 * pp + 1); jc = __builtin_amdgcn_readfirstlane(jc); jd = __builtin_amdgcn_readfirstlane(jd); if (jc < 0) jc = jhi + 1; }
            else { jc = (jb >= 0 ? jb : ja) + 1; jd = jc + 1; if (jd > jhi) jd = -1; }
            VM_WAIT(); __syncthreads();
            if (jc <= jhi) kv_dma(dm, Kh + (size_t)jc * KVBLK * ldk, Vh + (size_t)jc * KVBLK * ldv, lds, ATT_SET - set, wid);
            if (jc <= jhi && jd >= 0) kv_dma(dm, Kh + (size_t)jd * KVBLK * ldk, Vh + (size_t)jd * KVBLK * ldv, lds, ATT_SET - set + ATT_BUF, wid);
            const bool nA = NSA_NEED(ja), nB = (jb >= 0) && NSA_NEED(jb);
            f32x16 a0, a1, b0, b1;
            if (nA) qkt(a0, a1, lds + set + ATT_K_OFF, qr, r32, hi);
            if (nB) qkt(b0, b1, lds + set + ATT_BUF + ATT_K_OFF, qr, r32, hi);
            if (nA) { NSA_MASK(a0, a1, ja); attn_finish(a0, a1, o, m_reg, l_reg, wsc, vb0 + set, r32, hi); }
            if (nB) { NSA_MASK(b0, b1, jb); attn_finish(b0, b1, o, m_reg, l_reg, wsc, vb0 + set + ATT_BUF, r32, hi); }
            ja = jc; jb = (jc <= jhi) ? jd : -1; set = ATT_SET - set;
        }
#undef PLIST
#undef NSA_MASK
#undef NSA_NEED
        { float fac = l_reg > 0.f ? __builtin_amdgcn_rcpf(l_reg) : 0.f;
          if (MODE != 1) { const int br = MODE == 0 ? 0 : (MODE == 2 ? 1 : 2); fac *= sigmoidf_(bf2f(P1[(rowb + t) * NSA_INP + P1_GL + head * 3 + br])); }
          if (hi == 0) wsc[32 + r32] = fac; LDS_WAIT(); }
        if (MODE == 1) {
            float fc[16];
#pragma unroll
            for (int r = 0; r < 16; ++r) fc[r] = wsc[32 + crow(r, hi)];
            LDS_WAIT(); __syncthreads();
#pragma unroll
            for (int r = 0; r < 16; ++r) { const int orow = crow(r, hi);
#pragma unroll
                for (int d0 = 0; d0 < 4; ++d0) *(LAS float*)(lds + ((wid * 32 + orow) * 128 + d0 * 32 + r32) * 4) = o[d0][r] * fc[r]; }
            LDS_WAIT(); __syncthreads();
            { const int tok = tid >> 4, j8 = (tid & 15) * 8; f32x4 s0 = {0.f, 0.f, 0.f, 0.f}, s1 = {0.f, 0.f, 0.f, 0.f};
#pragma unroll
              for (int w = 0; w < 8; ++w) { const LAS f32x4* pp = (const LAS f32x4*)(lds + ((w * 32 + tok) * 128 + j8) * 4); s0 += pp[0]; s1 += pp[1]; }
              f32x4* dst = (f32x4*)(IMP + ((rowb + t0 + tok) * NSA_G + g) * NSLC + j8); dst[0] = s0; dst[1] = s1; }
            LDS_WAIT(); __syncthreads();
        } else {
#pragma unroll
            for (int r = 0; r < 16; ++r) { const int orow = crow(r, hi); const float fc = wsc[32 + orow];
                const size_t off = (MODE == 2) ? (rowb + t0 + 4 * wid + (orow >> 3)) * DM + (g * NSA_R + (orow & 7)) * HD + r32 : (rowb + t0 + orow) * DM + head * HD + r32;
#pragma unroll
                for (int d0 = 0; d0 < 4; ++d0) {
                    if (MODE == 0) O32[off + d0 * 32] = o[d0][r] * fc;
                    else if (MODE == 3) { if (!probe_nostore) O32[off + d0 * 32] += o[d0][r] * fc; }
                    else Ob[off + d0 * 32] = (bf16)f2bf(O32[off + d0 * 32] + o[d0][r] * fc); } }
            LDS_WAIT();
        }
    }
}
__device__ __forceinline__ void nsa_topk_phase(Frame& F, const float* IMP, unsigned* SEL) {
    LAS float* sc = (LAS float*)(F.lds + F.wave * 1024);
    const int gw = F.bid * NWAVES + F.wave, NGW = F.G * NWAVES, lane = F.lane;
    for (int it = gw; it < MTOK * NSA_G; it += NGW) {
        const int m = it / NSA_G, t = m & (SEQ - 1), cur = t >> 6;
        const float* ip = IMP + (size_t)it * NSLC;
        const float a0 = ip[lane], a1 = ip[64 + lane];
        sc[lane] = a0; sc[64 + lane] = a1; LDS_WAIT();
        const int j0 = lane, j1 = lane + 64;
        const bool f0 = (j0 == 0) || (j0 == cur) || (j0 == cur - 1), f1 = (j1 == cur) || (j1 == cur - 1);
        const bool c0 = !f0 && j0 <= cur, c1 = !f1 && j1 <= cur;
        const int nforced = cur >= 2 ? 3 : cur + 1, slots = NTOP - nforced;
        int rk0 = 0, rk1 = 0;
        const int ncand_hi = cur < NSLC ? cur : NSLC - 1;
        for (int i = 1; i <= ncand_hi; ++i) {
            const bool fi = (i == cur) || (i == cur - 1); if (fi) continue;
            const float v = sc[i];
            rk0 += (v > a0 || (v == a0 && i < j0)) ? 1 : 0; rk1 += (v > a1 || (v == a1 && i < j1)) ? 1 : 0;
        }
        const bool s0 = (f0 && j0 <= cur) || (c0 && rk0 < slots), s1 = (f1 && j1 <= cur) || (c1 && rk1 < slots);
        const unsigned long long m0 = __ballot(s0), m1 = __ballot(s1);
        if (lane == 0) { v4u w = {(unsigned)m0, (unsigned)(m0 >> 32), (unsigned)m1, (unsigned)(m1 >> 32)}; *(v4u*)(SEL + (size_t)it * 4) = w; }
        LDS_WAIT();
    }
}

#ifndef STAGE
#define STAGE 3
#endif
#define ZERO_OB_PHASE PH_BEGIN { v4u z = {0u, 0u, 0u, 0u}; v4u* p = (v4u*)Ob; const long n = (long)MTOK * DM / 8; \
            for (long i = (long)F.bid * NTHR + F.tid; i < n; i += (long)F.G * NTHR) p[i] = z; } PH_END
#define MIXER0_PHASES \
    PH_BEGIN { fold_finalize(F, FO_XQ, XW); fold_finalize(F, FO_UP, DFF2); } \
             REP(10) hgrn_phase_a(F, BIG, (const float*)(ws + WS_LB), (bf16*)(ws + WS_QT), (bf16*)(ws + WS_OINTRA), (bf16*)(ws + WS_DS), (float*)(ws + WS_DEC)); \
             REP(11) sb_phase(F, BIG, Ob); PH_END \
    PH_BEGIN REP(12) hgrn_phase_b(F, (const bf16*)(ws + WS_DS), (const float*)(ws + WS_DEC), (bf16*)(ws + WS_SPREV)); PH_END \
    PH_BEGIN REP(13) hgrn_phase_c(F, BIG, (const bf16*)(ws + WS_QT), (const bf16*)(ws + WS_OINTRA), (const bf16*)(ws + WS_SPREV), args.in[IN_HGRN_NW], Ob); PH_END
#if STAGE <= 2
#define MIXER1_PHASES ZERO_OB_PHASE
#else
#define MIXER1_PHASES \
    PH_BEGIN { fold_finalize(F, FO_XQ + XW, XW); } REP(14) { nsa_rope_phase(F, BIG, (const float*)(ws + WS_ROPE), (bf16*)(ws + WS_QROT), (bf16*)(ws + WS_KSROT), (bf16*)(ws + WS_KWROT), (bf16*)(ws + WS_OVL)); \
             nsa_compress_phase(F, BIG, args.in[IN_NSA_CMP_POS], (const bf16*)(ws + WS_W_C1), (const bf16*)(ws + WS_W_C2), (bf16*)(ws + WS_KCMP), (bf16*)(ws + WS_VCMP)); } PH_END \
    PH_BEGIN { REP(15) nsa_attn_phase<0>(F, BIG, BIG, (const bf16*)(ws + WS_KCMP), (const bf16*)(ws + WS_VCMP), nullptr, (float*)(ws + WS_O32), nullptr, nullptr); \
             F.fresh(); REP(15) nsa_attn_phase<1>(F, BIG, BIG, (const bf16*)(ws + WS_KCMP), (const bf16*)(ws + WS_OVL), nullptr, nullptr, (float*)(ws + WS_IMP), nullptr); \
             F.fresh(); REP(17) nsa_attn_phase<3>(F, BIG, (const bf16*)(ws + WS_QROT), (const bf16*)(ws + WS_KWROT), nullptr, nullptr, (float*)(ws + WS_O32), nullptr, nullptr, r_ > 0); } PH_END \
    PH_BEGIN REP(16) nsa_topk_phase(F, (const float*)(ws + WS_IMP), (unsigned*)(ws + WS_SEL)); PH_END \
    PH_BEGIN REP(18) nsa_attn_phase<2>(F, BIG, (const bf16*)(ws + WS_QROT), (const bf16*)(ws + WS_KSROT), nullptr, (const unsigned*)(ws + WS_SEL), (float*)(ws + WS_O32), nullptr, Ob); PH_END
#endif
#ifndef REPMASK
#define REPMASK 0u
#endif
#define REP(gid) for (int r_ = 0; r_ <= (int)((REPMASK >> (gid)) & 1u); ++r_)
#define PH_BEGIN if (pc >= lo && pc < hi) { F.fresh();
#if (REPMASK >> 23) & 1
#define PH_END   if (pc + 1 < hi) { const unsigned long long tb0_ = __builtin_amdgcn_s_memrealtime(); XcdBarrier bb_ = bar; asm volatile("" : "+s"(bb_.bar), "+s"(bb_.x)); xcd_barrier(bb_); \
        const unsigned w_ = (unsigned)(__builtin_amdgcn_s_memrealtime() - tb0_); tbar_acc += w_; if (threadIdx.x == 0) atomicMax((unsigned*)(args.ws + 3 * MiB) + pc, 0x7fffffffu - w_); } } ++pc;
#else
#define PH_END   if (pc + 1 < hi) { XcdBarrier bb_ = bar; asm volatile("" : "+s"(bb_.bar), "+s"(bb_.x)); xcd_barrier(bb_); } } ++pc;
#endif
template <int l>
__device__ __forceinline__ void layer_body(Frame& F, const Args& args, const XcdBarrier& bar, int& pc, const int lo, const int hi, unsigned long long& tbar_acc) {
    unsigned char* ws = args.ws;
    bf16* HB = (bf16*)(ws + WS_HB); bf16* Y = (bf16*)(ws + WS_Y); float* H32 = args.out;
    bf16* BIG = (bf16*)(ws + WS_BIG); bf16* Gm = (bf16*)(ws + WS_G); bf16* Ob = (bf16*)(ws + WS_O);
    bf16* XQ = (bf16*)(ws + WS_XQ); bf16* XO = (bf16*)(ws + WS_XO);
#define RS(k) ((long long*)(ws + WS_RSUM) + (size_t)(k) * MTOK * 2)
#define LNG(k) (args.in[IN_LN_G] + (size_t)(k) * DM)
#define LNB(k) (args.in[IN_LN_B] + (size_t)(k) * DM)
    const float* cs = (const float*)(ws + WS_FOLDF); const float* b2 = cs + FO_N;
        PH_BEGIN REP(1) {
            const int N = l == 0 ? AB_IN : NSA_INP;
            pg8::StaticOrder S; S.init(MTOK, N, F.G, F.bid);
            if (l == 0) { pg8::Gemm g{HB, (const bf16*)(ws + WS_W_ABIN), MTOK, N, DM}; pg8::EpiBf16<0> E{BIG, N, nullptr, 0, 0, 1.f};
                pg8::gemm_phase<pg8::EpiBf16<0>, pg8::StaticOrder, PG8_ALIGN, PG8_SP2>(F.lds + RING_OFF, g, S, E); }
            else { pg8::Gemm g{Y, (const bf16*)(ws + WS_W_NSAIN), MTOK, N, DM}; pg8::EpiBf16Ln E{BIG, N, RS(2), cs + FO_NSA, b2 + FO_NSA};
                pg8::gemm_phase<pg8::EpiBf16Ln, pg8::StaticOrder, PG8_ALIGN, PG8_SP2>(F.lds + RING_OFF, g, S, E);
                if (r_ == 0) convert_job<CJ_L1A>(F, args, 64, 192); }
        } PH_END
#if STAGE <= 1
        ZERO_OB_PHASE
#else
        if (l == 0) {
            MIXER0_PHASES
        } else {
            MIXER1_PHASES
        }
#endif
        PH_BEGIN REP(2) {
            pg8::Gemm g{Ob, l == 0 ? (const bf16*)(ws + WS_W_ABOUT) : (const bf16*)(ws + WS_W_NSAOUT), MTOK, DM, DM};
            pg8::StaticOrder S; S.init(MTOK, DM, F.G, F.bid);
            if (l == 0) { pg8::EpiRes0 E{Y, HB, DM, DN_ALPHA, RS(0)};
                pg8::gemm_phase<pg8::EpiRes0, pg8::StaticOrder, PG8_ALIGN, PG8_SP2>(F.lds + RING_OFF, g, S, E); }
            else { pg8::EpiResLn2 E{Y, RS(2), LNG(2), LNB(2), DM, DN_ALPHA, RS(3)};
                pg8::gemm_phase<pg8::EpiResLn2, pg8::StaticOrder, PG8_ALIGN, PG8_SP2>(F.lds + RING_OFF, g, S, E); }
        } PH_END
        PH_BEGIN REP(3) {
            {   pg8::Gemm g{Y, (const bf16*)(ws + WS_W_XQ) + (size_t)l * XW * DM, MTOK, XW, DM};
                pg8::RangeOrder S; S.init(MTOK, XW, 0, 128, F.bid);
                pg8::EpiBf16Ln E{XQ, XW, RS(3 * l), cs + FO_XQ + l * XW, b2 + FO_XQ + l * XW};
                pg8::gemm_phase<pg8::EpiBf16Ln, pg8::RangeOrder, PG8_ALIGN, PG8_SP2>(F.lds + RING_OFF, g, S, E); }
            {   pg8::Gemm g{(const bf16*)(ws + WS_MEMB), (const bf16*)(ws + WS_W_XKV) + (size_t)l * 2 * XW * DM, BATCH * NMEM, 2 * XW, DM};
                pg8::RangeOrder S; S.init(BATCH * NMEM, 2 * XW, 128, 8, F.bid);
                pg8::EpiBf16<0> E{(bf16*)(ws + WS_XKV) + (size_t)l * BATCH * NMEM * 2 * XW, 2 * XW, nullptr, 0, 0, 1.f};
                pg8::gemm_phase<pg8::EpiBf16<0>, pg8::RangeOrder, PG8_ALIGN, PG8_SP2>(F.lds + RING_OFF, g, S, E); }
            if (r_ == 0) { if (l == 0) convert_job<CJ_DOWN0>(F, args, 136, 120); else convert_job<CJ_L1B>(F, args, 136, 120); }
        } PH_END
        PH_BEGIN { if (l == 1) fold_finalize(F, FO_UP + DFF2, DFF2); } REP(9) xattn_phase(F, XQ, (const bf16*)(ws + WS_XKV) + (size_t)l * BATCH * NMEM * 2 * XW, XO); PH_END
        PH_BEGIN REP(4) {
            pg8::Gemm g{XO, (const bf16*)(ws + WS_W_XO) + (size_t)l * DM * XW, MTOK, DM, XW};
            pg8::StaticOrder S; S.init(MTOK, DM, F.G, F.bid);
            pg8::EpiResLn2 E{Y, RS(3 * l), LNG(3 * l), LNB(3 * l), DM, DN_ALPHA, RS(3 * l + 1)};
            pg8::gemm_phase<pg8::EpiResLn2, pg8::StaticOrder, PG8_ALIGN, PG8_SP2>(F.lds + RING_OFF, g, S, E);
        } PH_END
        PH_BEGIN REP(5) {
#if (REPMASK >> 22) & 1
            if (r_ > 0) { XcdBarrier bb_ = bar; asm volatile("" : "+s"(bb_.bar), "+s"(bb_.x)); xcd_barrier(bb_); }
#endif
            pg8::Gemm g{Y, (const bf16*)(ws + WS_W_UP) + (size_t)l * DFF2 * DM, MTOK, DFF2, DM};
            pg8::StaticOrder S; S.init(MTOK, DFF2, F.G, F.bid);
            pg8::EpiBf16Ln E{BIG, DFF2, RS(3 * l + 1), cs + FO_UP + l * DFF2, b2 + FO_UP + l * DFF2};
            pg8::gemm_phase<pg8::EpiBf16Ln, pg8::StaticOrder, PG8_ALIGN, PG8_SP2>(F.lds + RING_OFF, g, S, E);
            if (r_ == 0) { if (l == 0) convert_job<CJ_NSA>(F, args, 128, 128); else convert_job<CJ_DOWN1>(F, args, 128, 128); }
        } PH_END
#if (REPMASK >> 20) & 1
        PH_BEGIN {
            pg8::Gemm g{HB, (const bf16*)(ws + WS_W_UP) + (size_t)l * DFF2 * DM, MTOK, DFF2, DM};
            pg8::ZeroOrder S; S.init(MTOK, DFF2, F.G, F.bid);
            pg8::EpiBf16<0> E{Gm, DFF2, nullptr, 0, 0, 1.f};
            pg8::gemm_phase<pg8::EpiBf16<0>, pg8::ZeroOrder, PG8_ALIGN, PG8_SP2>(F.lds + RING_OFF, g, S, E);
        } PH_END
#endif
        PH_BEGIN { if (l == 0) fold_finalize(F, FO_NSA, NSA_INP); } REP(8) convglu_phase(F, BIG, args.in[IN_FFN_CONV] + (size_t)l * 3 * DFF, Gm); PH_END
        PH_BEGIN REP(6) {
            pg8::Gemm g{Gm, (const bf16*)(ws + WS_W_DOWN) + (size_t)l * DM * DFF, MTOK, DM, DFF};
            pg8::StaticOrder S; S.init(MTOK, DM, F.G, F.bid);
            pg8::EpiResLn2 E{Y, RS(3 * l + 1), LNG(3 * l + 1), LNB(3 * l + 1), DM, DN_ALPHA, RS(3 * l + 2)};
            pg8::gemm_phase<pg8::EpiResLn2, pg8::StaticOrder, PG8_ALIGN, PG8_SP2>(F.lds + RING_OFF, g, S, E);
        } PH_END
        if (l == 1) { PH_BEGIN REP(7) ln_phase(F, Y, LNG(5), LNB(5), H32); PH_END }
#undef RS
#undef LNG
#undef LNB
}
__global__ void __launch_bounds__(NTHR, 2) mega_fwd(Args args) {
    extern __shared__ __attribute__((aligned(16))) unsigned char lds_raw[];
    Frame F;
    F.lds = (LAS unsigned char*)lds_raw; F.ws = args.ws;
    F.tid = threadIdx.x; F.lane = F.tid & 63; F.wave = __builtin_amdgcn_readfirstlane(F.tid >> 6); F.G = gridDim.x;
    unsigned char* ws = args.ws;
    gu32* ctl = (gu32*)(ws + WS_CTL);
    for (int u = F.tid; u < (LDS_BYTES - LDSCTL_OFF) / 4; u += NTHR) ((LAS unsigned*)(F.lds + LDSCTL_OFF))[u] = 0u;
    __syncthreads();
    volatile LAS unsigned* MISC = (volatile LAS unsigned*)(F.lds + MISC_OFF);
    XcdBarrier bar = xcd_barrier_post((unsigned*)(ctl + CW_BAR), MISC + 8);
    const int lo = args.ph_lo, hi = args.ph_hi; int pc = 0; unsigned long long tbar_acc = 0ull;
    bf16* HB = (bf16*)(ws + WS_HB); bf16* Y = (bf16*)(ws + WS_Y); float* H32 = args.out;
    bf16* BIG = (bf16*)(ws + WS_BIG); bf16* Gm = (bf16*)(ws + WS_G); bf16* Ob = (bf16*)(ws + WS_O);
    bf16* XQ = (bf16*)(ws + WS_XQ); bf16* XO = (bf16*)(ws + WS_XO);

    PH_BEGIN REP(0) p0_prologue(F, args); PH_END

#if (REPMASK >> 21) & 1
    for (int e_ = 0; e_ < 40; ++e_) { PH_BEGIN PH_END }
#endif
    layer_body<0>(F, args, bar, pc, lo, hi, tbar_acc);
    layer_body<1>(F, args, bar, pc, lo, hi, tbar_acc);
#if (REPMASK >> 23) & 1
#ifndef PROBE_BID
#define PROBE_BID 0
#endif
#if (REPMASK >> 24) & 1
    if (blockIdx.x == 0) { unsigned long long tot_ = 0ull; for (int k_ = 0; k_ < pc; ++k_) { const unsigned v_ = __hip_atomic_load((unsigned*)(args.ws + 3 * MiB) + k_, __ATOMIC_RELAXED, __HIP_MEMORY_SCOPE_AGENT); if (v_) tot_ += 0x7fffffffu - v_; }
        const unsigned long long t0_ = __builtin_amdgcn_s_memrealtime(); while (__builtin_amdgcn_s_memrealtime() - t0_ < tot_) __builtin_amdgcn_s_sleep(8); }
#else
    if (blockIdx.x == PROBE_BID) { const unsigned long long t0_ = __builtin_amdgcn_s_memrealtime(); while (__builtin_amdgcn_s_memrealtime() - t0_ < tbar_acc) __builtin_amdgcn_s_sleep(8); }
#endif
#endif
}

extern "C" void kernel_launch(void* const* d_in, const int* in_sizes, int n_in, void* d_out, int out_size, void* d_ws, size_t ws_size, hipStream_t stream) {
    static int grid = 0;
    if (grid == 0) {
        if (n_in != 19 || in_sizes[0] != MTOK * DM || out_size != MTOK * DM || ws_size < WS_END) {
            fprintf(stderr, "kernel_launch: shape mismatch n_in %d in0 %d out %d ws %zu (need %zu)\n", n_in, n_in > 0 ? in_sizes[0] : -1, out_size, ws_size, (size_t)WS_END); grid = -1; return; }
        int dev = 0, cus = 0, per_cu = 0;
        if (hipGetDevice(&dev) != hipSuccess || hipDeviceGetAttribute(&cus, hipDeviceAttributeMultiprocessorCount, dev) != hipSuccess) { grid = -1; return; }
        if (hipFuncSetAttribute((const void*)mega_fwd, hipFuncAttributeMaxDynamicSharedMemorySize, LDS_BYTES) != hipSuccess) { fprintf(stderr, "kernel_launch: hipFuncSetAttribute failed\n"); grid = -1; return; }
        if (hipOccupancyMaxActiveBlocksPerMultiprocessor(&per_cu, (const void*)mega_fwd, NTHR, LDS_BYTES) != hipSuccess || per_cu < 1)
            fprintf(stderr, "kernel_launch: note: occupancy query reports %d workgroups per CU\n", per_cu);
        (void)hipGetLastError();
        grid = cus;
    }
    if (grid < 0) return;
    if (hipMemsetAsync((char*)d_ws + WS_CTL, 0, CTL_ZERO_BYTES, stream) != hipSuccess) { fprintf(stderr, "kernel_launch: memset failed\n"); return; }
    Args a{};
    for (int i = 0; i < 19; ++i) a.in[i] = (const float*)d_in[i];
    a.out = (float*)d_out; a.ws = (unsigned char*)d_ws; a.ph_lo = 0; a.ph_hi = 1 << 20;
    hipLaunchKernelGGL(mega_fwd, dim3(grid), dim3(NTHR), LDS_BYTES, stream, a);
    const hipError_t le = hipPeekAtLastError();
    if (le != hipSuccess) fprintf(stderr, "kernel_launch: launch failed: %s\n", hipGetErrorName(le));
}
```

```cpp
#include <hip/hip_runtime.h>
#include <cstdio>
#include <cstdint>
namespace pg8 {
#define PG8_LAS __attribute__((address_space(3)))
typedef unsigned short bf16_t;
typedef short bf16x8 __attribute__((ext_vector_type(8)));
typedef float f32x4 __attribute__((ext_vector_type(4)));
typedef unsigned u32x4 __attribute__((ext_vector_type(4)));
constexpr int BM = 256, BK = 64, HALF = 128, HTB = HALF * BK * 2  , STAGE_BYTES = 8 * HTB, NXCD = 8, WGM = 8;

__host__ __device__ __forceinline__ int lds_byte(int r, int c) { const int st = (r >> 4) * 2 + (c >> 5), rr = r & 15, cc = c & 31, ob = rr * 64 + cc * 2; return st * 1024 + (ob ^ (((ob >> 9) & 1) << 5)); }
__host__ __device__ __forceinline__ void stage_rc(int b, int& R, int& C) { const int st = b / 1024, sb = b % 1024, swz = sb ^ (((sb >> 9) & 1) << 5); R = (st >> 1) * 16 + swz / 64; C = (st & 1) * 32 + (swz % 64) / 2; }
__host__ __device__ __forceinline__ int perm32(int rho) { const int n = rho >> 4, i = rho & 15; return 8 * (i >> 2) + 4 * n + (i & 3); }

struct Unit { int pm, pn; };
struct Gemm { const bf16_t* A; const bf16_t* Bt; int M, N, K; };

struct StaticOrder {
    int nM, nN, nwg, G, c;
    __host__ __device__ void init(int M, int N, int G_, int c_) { nM = M / BM; nN = N / BM; nwg = nM * nN; G = G_; c = c_; }
    __host__ __device__ bool next(int i, Unit& u) const {
        const long L = (long)i * G + c; if (L >= nwg) return false;
        int wgid = (int)L; { const int q = nwg / NXCD, r = nwg % NXCD, xcd = wgid % NXCD, off = wgid / NXCD; wgid = (xcd < r ? xcd * (q + 1) : r * (q + 1) + (xcd - r) * q) + off; }
        const int nig = WGM * nN, gid = wgid / nig, fm = gid * WGM, gsz = (nM - fm) < WGM ? (nM - fm) : WGM;
        u.pm = fm + ((wgid % nig) % gsz); u.pn = (wgid % nig) / gsz; return true;
    }
    __device__ __forceinline__ void a_ready(const Unit&) const {}
    __device__ __forceinline__ void done(const Unit&) const {}
};

__device__ __forceinline__ unsigned cvt_pk_bf16(float lo, float hi) { unsigned r; asm volatile("v_cvt_pk_bf16_f32 %0, %1, %2" : "=v"(r) : "v"(lo), "v"(hi)); return r; }
typedef float f32x2 __attribute__((ext_vector_type(2)));
__device__ __forceinline__ f32x2 gelu_pk(f32x2 v) {
    const f32x2 av = __builtin_elementwise_abs(v), d = av * 0.2316418882f + 1.0f;
    f32x2 t; t.x = __builtin_amdgcn_rcpf(d.x); t.y = __builtin_amdgcn_rcpf(d.y);
    f32x2 q = t * 0.5307027145f + (-0.7265760135f); q = q * t + 0.7107068705f; q = q * t + (-0.142248368f); q = q * t + 0.127414796f; q = q * t;
    const f32x2 s = (v * v) * (-0.72134752044f);
    f32x2 e; e.x = __builtin_amdgcn_exp2f(s.x); e.y = __builtin_amdgcn_exp2f(s.y);
    const f32x2 m = v * (q * e), r = v - m;
    f32x2 o; o.x = v.x < 0.f ? m.x : r.x; o.y = v.y < 0.f ? m.y : r.y; return o;
}

template <int ACT  > struct EpiBf16 {
    static constexpr bool PERM = true, AFTER_DRAIN = false; static_assert(ACT == 0 || ACT == 1, "EpiBf16: ACT is 0 (none) or 1 (gelu_pk)");
    bf16_t* O; int ldc; const float* bias; int split_cols; size_t split_stride; float scale0;
    __device__ __forceinline__ void operator()(const f32x4 (&acc)[2][2][4][2], const Unit& u, int wr, int wc, int fr, int fq) const {
        const int row0 = u.pm * BM + wr * 64 + fr; int colt = u.pn * BM; bf16_t* base = O;
        float sc = 1.f; if (split_cols) { const int t = colt / split_cols; base += (size_t)t * split_stride; colt -= t * split_cols; if (t == 0) sc = scale0; }
        const int col0 = colt + wc * 32 + 8 * fq, bcol0 = u.pn * BM + wc * 32 + 8 * fq;
        f32x4 bv[2][2];
#pragma unroll
        for (int bj = 0; bj < 2; ++bj)
#pragma unroll
            for (int n = 0; n < 2; ++n) bv[bj][n] = bias ? *(const f32x4*)(bias + bcol0 + bj * HALF + 4 * n) : (f32x4){0.f, 0.f, 0.f, 0.f};
#pragma unroll
        for (int ai = 0; ai < 2; ++ai)
#pragma unroll
            for (int m = 0; m < 4; ++m) { bf16_t* rowp = base + (size_t)(row0 + ai * HALF + m * 16) * ldc + col0;
#pragma unroll
                for (int bj = 0; bj < 2; ++bj) { f32x4 v0 = acc[ai][bj][m][0] + bv[bj][0], v1 = acc[ai][bj][m][1] + bv[bj][1];
                    if (ACT == 1) { f32x2 a = gelu_pk((f32x2){v0[0], v0[1]}), b = gelu_pk((f32x2){v0[2], v0[3]}), c = gelu_pk((f32x2){v1[0], v1[1]}), d = gelu_pk((f32x2){v1[2], v1[3]});
                        v0 = (f32x4){a.x, a.y, b.x, b.y}; v1 = (f32x4){c.x, c.y, d.x, d.y}; }
                    v0 = v0 * sc; v1 = v1 * sc; u32x4 w; w.x = cvt_pk_bf16(v0[0], v0[1]); w.y = cvt_pk_bf16(v0[2], v0[3]); w.z = cvt_pk_bf16(v1[0], v1[1]); w.w = cvt_pk_bf16(v1[2], v1[3]);
                    *(u32x4*)(rowp + bj * HALF) = w; } }
    }
};


struct EpiRes {
    static constexpr bool PERM = false, AFTER_DRAIN = false;
    float* Y; const float* res; int ldc; float alpha;
    __device__ __forceinline__ void operator()(const f32x4 (&acc)[2][2][4][2], const Unit& u, int wr, int wc, int fr, int fq) const {
        const int row0 = u.pm * BM + wr * 64 + fr, col0 = u.pn * BM + wc * 32 + 4 * fq;
#pragma unroll
        for (int ai = 0; ai < 2; ++ai)
#pragma unroll
            for (int m = 0; m < 4; ++m) { const size_t off = (size_t)(row0 + ai * HALF + m * 16) * ldc + col0;
#pragma unroll
                for (int bj = 0; bj < 2; ++bj)
#pragma unroll
                    for (int n = 0; n < 2; ++n) { const f32x4 r = *(const f32x4*)(res + off + bj * HALF + n * 16);
                        *(f32x4*)(Y + off + bj * HALF + n * 16) = r * alpha + acc[ai][bj][m][n]; } }
    }
};
struct RangeOrder {
    int nM, nN, ntot, c0, nw, c;
    __host__ __device__ void init(int M, int N, int c0_, int nw_, int c_) { nM = M / BM; nN = N / BM; ntot = nM * nN; c0 = c0_; nw = nw_; c = c_; }
    __host__ __device__ bool next(int i, Unit& u) const {
        if (c < c0 || c >= c0 + nw) return false;
        const int L = i * nw + (c - c0); if (L >= ntot) return false;
        u.pm = L / nN; u.pn = L % nN; return true;
    }
    __device__ __forceinline__ void a_ready(const Unit&) const {}
    __device__ __forceinline__ void done(const Unit&) const {}
};

struct ZeroOrder : StaticOrder {
    __host__ __device__ bool next(int i, Unit& u) const { const bool r = StaticOrder::next(i, u); u.pm = 0; u.pn = 0; return r; }
};

struct EpiResBf {
    static constexpr bool PERM = true, AFTER_DRAIN = false;
    bf16_t* Y; const bf16_t* res; int ldc; float alpha;
    __device__ __forceinline__ void operator()(const f32x4 (&acc)[2][2][4][2], const Unit& u, int wr, int wc, int fr, int fq) const {
        const int row0 = u.pm * BM + wr * 64 + fr, col0 = u.pn * BM + wc * 32 + 8 * fq;
#pragma unroll
        for (int ai = 0; ai < 2; ++ai)
#pragma unroll
            for (int m = 0; m < 4; ++m) { const size_t off = (size_t)(row0 + ai * HALF + m * 16) * ldc + col0;
#pragma unroll
                for (int bj = 0; bj < 2; ++bj) { const u32x4 r = *(const u32x4*)(res + off + bj * HALF);
                    const f32x4 v0 = acc[ai][bj][m][0], v1 = acc[ai][bj][m][1];
                    u32x4 w;
                    w.x = cvt_pk_bf16(__builtin_bit_cast(float, r.x << 16) * alpha + v0[0], __builtin_bit_cast(float, r.x & 0xffff0000u) * alpha + v0[1]);
                    w.y = cvt_pk_bf16(__builtin_bit_cast(float, r.y << 16) * alpha + v0[2], __builtin_bit_cast(float, r.y & 0xffff0000u) * alpha + v0[3]);
                    w.z = cvt_pk_bf16(__builtin_bit_cast(float, r.z << 16) * alpha + v1[0], __builtin_bit_cast(float, r.z & 0xffff0000u) * alpha + v1[1]);
                    w.w = cvt_pk_bf16(__builtin_bit_cast(float, r.w << 16) * alpha + v1[2], __builtin_bit_cast(float, r.w & 0xffff0000u) * alpha + v1[3]);
                    *(u32x4*)(Y + off + bj * HALF) = w; } }
    }
};

struct EpiResF {
    static constexpr bool PERM = true, AFTER_DRAIN = false;
    float* Y; const bf16_t* res; int ldc; float alpha;
    __device__ __forceinline__ void operator()(const f32x4 (&acc)[2][2][4][2], const Unit& u, int wr, int wc, int fr, int fq) const {
        const int row0 = u.pm * BM + wr * 64 + fr, col0 = u.pn * BM + wc * 32 + 8 * fq;
#pragma unroll
        for (int ai = 0; ai < 2; ++ai)
#pragma unroll
            for (int m = 0; m < 4; ++m) { const size_t off = (size_t)(row0 + ai * HALF + m * 16) * ldc + col0;
#pragma unroll
                for (int bj = 0; bj < 2; ++bj) { const u32x4 r = *(const u32x4*)(res + off + bj * HALF);
                    f32x4 o0, o1;
                    o0[0] = __builtin_bit_cast(float, r.x << 16); o0[1] = __builtin_bit_cast(float, r.x & 0xffff0000u); o0[2] = __builtin_bit_cast(float, r.y << 16); o0[3] = __builtin_bit_cast(float, r.y & 0xffff0000u);
                    o1[0] = __builtin_bit_cast(float, r.z << 16); o1[1] = __builtin_bit_cast(float, r.z & 0xffff0000u); o1[2] = __builtin_bit_cast(float, r.w << 16); o1[3] = __builtin_bit_cast(float, r.w & 0xffff0000u);
                    *(f32x4*)(Y + off + bj * HALF) = o0 * alpha + acc[ai][bj][m][0]; *(f32x4*)(Y + off + bj * HALF + 4) = o1 * alpha + acc[ai][bj][m][1]; } }
    }
};

struct EpiResLn {
    static constexpr bool PERM = true, AFTER_DRAIN = false;
    bf16_t* Y; const float* stats; const float* g; const float* b; int ldc; float alpha;
    __device__ __forceinline__ void operator()(const f32x4 (&acc)[2][2][4][2], const Unit& u, int wr, int wc, int fr, int fq) const {
        const int row0 = u.pm * BM + wr * 64 + fr, col0 = u.pn * BM + wc * 32 + 8 * fq;
        f32x4 gv[2][2], bv[2][2];
#pragma unroll
        for (int bj = 0; bj < 2; ++bj)
#pragma unroll
            for (int n = 0; n < 2; ++n) { gv[bj][n] = *(const f32x4*)(g + col0 + bj * HALF + 4 * n) * alpha; bv[bj][n] = *(const f32x4*)(b + col0 + bj * HALF + 4 * n) * alpha; }
#pragma unroll
        for (int ai = 0; ai < 2; ++ai)
#pragma unroll
            for (int m = 0; m < 4; ++m) { const int row = row0 + ai * HALF + m * 16; const size_t off = (size_t)row * ldc + col0;
                const float mean = stats[2 * row], rstd = stats[2 * row + 1];
#pragma unroll
                for (int bj = 0; bj < 2; ++bj) { const u32x4 r = *(const u32x4*)(Y + off + bj * HALF);
                    f32x4 y0, y1;
                    y0[0] = __builtin_bit_cast(float, r.x << 16); y0[1] = __builtin_bit_cast(float, r.x & 0xffff0000u); y0[2] = __builtin_bit_cast(float, r.y << 16); y0[3] = __builtin_bit_cast(float, r.y & 0xffff0000u);
                    y1[0] = __builtin_bit_cast(float, r.z << 16); y1[1] = __builtin_bit_cast(float, r.z & 0xffff0000u); y1[2] = __builtin_bit_cast(float, r.w << 16); y1[3] = __builtin_bit_cast(float, r.w & 0xffff0000u);
                    const f32x4 o0 = (y0 - mean) * rstd * gv[bj][0] + bv[bj][0] + acc[ai][bj][m][0], o1 = (y1 - mean) * rstd * gv[bj][1] + bv[bj][1] + acc[ai][bj][m][1];
                    u32x4 w; w.x = cvt_pk_bf16(o0[0], o0[1]); w.y = cvt_pk_bf16(o0[2], o0[3]); w.z = cvt_pk_bf16(o1[0], o1[1]); w.w = cvt_pk_bf16(o1[2], o1[3]);
                    *(u32x4*)(Y + off + bj * HALF) = w; } }
    }
};

constexpr float RS_SCALE = 1048576.0f, RS_INV = 1.0f / 1048576.0f;
__device__ __forceinline__ float fx20_to_f(long long v) { return (float)(int)(v >> 20) + (float)((unsigned)v & 0xFFFFFu) * RS_INV; }
__device__ __forceinline__ long long f_to_fx20(float s) { const float fl = floorf(s); return ((long long)(int)fl << 20) + (long long)(unsigned)((s - fl) * RS_SCALE + 0.5f); }
__device__ __forceinline__ void row_stats(const long long* rs, int row, float& mean, float& rstd) {
    const long long a = rs[2 * (size_t)row], b = rs[2 * (size_t)row + 1];
    mean = fx20_to_f(a) * (1.0f / 4096.0f); const float var = fx20_to_f(b) * (1.0f / 4096.0f) - mean * mean; rstd = 1.0f / sqrtf(var + 1e-5f);
}
constexpr float FOLD_SCALE = 4294967296.0f, FOLD_INV = 1.0f / 4294967296.0f;
struct EpiBf16Ln {
    static constexpr bool PERM = true, AFTER_DRAIN = false;
    bf16_t* O; int ldc; const long long* rs; const float* cs; const float* b2;
    __device__ __forceinline__ void operator()(const f32x4 (&acc)[2][2][4][2], const Unit& u, int wr, int wc, int fr, int fq) const {
        const int row0 = u.pm * BM + wr * 64 + fr, col0 = u.pn * BM + wc * 32 + 8 * fq;
        f32x4 cv[2][2], bv[2][2];
#pragma unroll
        for (int bj = 0; bj < 2; ++bj)
#pragma unroll
            for (int n = 0; n < 2; ++n) { cv[bj][n] = *(const f32x4*)(cs + col0 + bj * HALF + 4 * n); bv[bj][n] = *(const f32x4*)(b2 + col0 + bj * HALF + 4 * n); }
#pragma unroll
        for (int ai = 0; ai < 2; ++ai)
#pragma unroll
            for (int m = 0; m < 4; ++m) { const int row = row0 + ai * HALF + m * 16; float mean, rstd; row_stats(rs, row, mean, rstd);
                bf16_t* rowp = O + (size_t)row * ldc + col0;
#pragma unroll
                for (int bj = 0; bj < 2; ++bj) { const f32x4 v0 = (acc[ai][bj][m][0] - cv[bj][0] * mean) * rstd + bv[bj][0], v1 = (acc[ai][bj][m][1] - cv[bj][1] * mean) * rstd + bv[bj][1];
                    u32x4 w; w.x = cvt_pk_bf16(v0[0], v0[1]); w.y = cvt_pk_bf16(v0[2], v0[3]); w.z = cvt_pk_bf16(v1[0], v1[1]); w.w = cvt_pk_bf16(v1[2], v1[3]);
                    *(u32x4*)(rowp + bj * HALF) = w; } }
    }
};
__device__ __forceinline__ void row_sums_add(long long* rso, int row, const f32x4& a, const f32x4& b, const f32x4& c, const f32x4& d, int fq) {
    float s1 = ((a[0] + a[1]) + (a[2] + a[3])) + ((b[0] + b[1]) + (b[2] + b[3])) + ((c[0] + c[1]) + (c[2] + c[3])) + ((d[0] + d[1]) + (d[2] + d[3]));
    float s2 = ((a[0] * a[0] + a[1] * a[1]) + (a[2] * a[2] + a[3] * a[3])) + ((b[0] * b[0] + b[1] * b[1]) + (b[2] * b[2] + b[3] * b[3]))
             + ((c[0] * c[0] + c[1] * c[1]) + (c[2] * c[2] + c[3] * c[3])) + ((d[0] * d[0] + d[1] * d[1]) + (d[2] * d[2] + d[3] * d[3]));
    s1 += __shfl_xor(s1, 16); s1 += __shfl_xor(s1, 32); s2 += __shfl_xor(s2, 16); s2 += __shfl_xor(s2, 32);
    if (fq == 0) { atomicAdd((unsigned long long*)(rso + 2 * (size_t)row), (unsigned long long)f_to_fx20(s1)); atomicAdd((unsigned long long*)(rso + 2 * (size_t)row + 1), (unsigned long long)f_to_fx20(s2)); }
}
struct EpiRes0 {
    static constexpr bool PERM = true, AFTER_DRAIN = false;
    bf16_t* Y; const bf16_t* res; int ldc; float alpha; long long* rso;
    __device__ __forceinline__ void operator()(const f32x4 (&acc)[2][2][4][2], const Unit& u, int wr, int wc, int fr, int fq) const {
        const int row0 = u.pm * BM + wr * 64 + fr, col0 = u.pn * BM + wc * 32 + 8 * fq;
#pragma unroll
        for (int ai = 0; ai < 2; ++ai)
#pragma unroll
            for (int m = 0; m < 4; ++m) { const int row = row0 + ai * HALF + m * 16; const size_t off = (size_t)row * ldc + col0; f32x4 o[2][2];
#pragma unroll
                for (int bj = 0; bj < 2; ++bj) { const u32x4 r = *(const u32x4*)(res + off + bj * HALF);
                    f32x4 y0, y1;
                    y0[0] = __builtin_bit_cast(float, r.x << 16); y0[1] = __builtin_bit_cast(float, r.x & 0xffff0000u); y0[2] = __builtin_bit_cast(float, r.y << 16); y0[3] = __builtin_bit_cast(float, r.y & 0xffff0000u);
                    y1[0] = __builtin_bit_cast(float, r.z << 16); y1[1] = __builtin_bit_cast(float, r.z & 0xffff0000u); y1[2] = __builtin_bit_cast(float, r.w << 16); y1[3] = __builtin_bit_cast(float, r.w & 0xffff0000u);
                    o[bj][0] = y0 * alpha + acc[ai][bj][m][0]; o[bj][1] = y1 * alpha + acc[ai][bj][m][1];
                    u32x4 w; w.x = cvt_pk_bf16(o[bj][0][0], o[bj][0][1]); w.y = cvt_pk_bf16(o[bj][0][2], o[bj][0][3]); w.z = cvt_pk_bf16(o[bj][1][0], o[bj][1][1]); w.w = cvt_pk_bf16(o[bj][1][2], o[bj][1][3]);
                    *(u32x4*)(Y + off + bj * HALF) = w; }
                row_sums_add(rso, row, o[0][0], o[0][1], o[1][0], o[1][1], fq); }
    }
};
struct EpiResLn2 {
    static constexpr bool PERM = true, AFTER_DRAIN = false;
    bf16_t* Y; const long long* rsi; const float* g; const float* b; int ldc; float alpha; long long* rso;
    __device__ __forceinline__ void operator()(const f32x4 (&acc)[2][2][4][2], const Unit& u, int wr, int wc, int fr, int fq) const {
        const int row0 = u.pm * BM + wr * 64 + fr, col0 = u.pn * BM + wc * 32 + 8 * fq;
        f32x4 gv[2][2], bv[2][2];
#pragma unroll
        for (int bj = 0; bj < 2; ++bj)
#pragma unroll
            for (int n = 0; n < 2; ++n) { gv[bj][n] = *(const f32x4*)(g + col0 + bj * HALF + 4 * n) * alpha; bv[bj][n] = *(const f32x4*)(b + col0 + bj * HALF + 4 * n) * alpha; }
#pragma unroll
        for (int ai = 0; ai < 2; ++ai)
#pragma unroll
            for (int m = 0; m < 4; ++m) { const int row = row0 + ai * HALF + m * 16; const size_t off = (size_t)row * ldc + col0; float mean, rstd; row_stats(rsi, row, mean, rstd); f32x4 o[2][2];
#pragma unroll
                for (int bj = 0; bj < 2; ++bj) { const u32x4 r = *(const u32x4*)(Y + off + bj * HALF);
                    f32x4 y0, y1;
                    y0[0] = __builtin_bit_cast(float, r.x << 16); y0[1] = __builtin_bit_cast(float, r.x & 0xffff0000u); y0[2] = __builtin_bit_cast(float, r.y << 16); y0[3] = __builtin_bit_cast(float, r.y & 0xffff0000u);
                    y1[0] = __builtin_bit_cast(float, r.z << 16); y1[1] = __builtin_bit_cast(float, r.z & 0xffff0000u); y1[2] = __builtin_bit_cast(float, r.w << 16); y1[3] = __builtin_bit_cast(float, r.w & 0xffff0000u);
                    o[bj][0] = (y0 - mean) * rstd * gv[bj][0] + bv[bj][0] + acc[ai][bj][m][0]; o[bj][1] = (y1 - mean) * rstd * gv[bj][1] + bv[bj][1] + acc[ai][bj][m][1];
                    u32x4 w; w.x = cvt_pk_bf16(o[bj][0][0], o[bj][0][1]); w.y = cvt_pk_bf16(o[bj][0][2], o[bj][0][3]); w.z = cvt_pk_bf16(o[bj][1][0], o[bj][1][1]); w.w = cvt_pk_bf16(o[bj][1][2], o[bj][1][3]);
                    *(u32x4*)(Y + off + bj * HALF) = w; }
                row_sums_add(rso, row, o[0][0], o[0][1], o[1][0], o[1][1], fq); }
    }
};
template <class Epi, class Sched, bool ALIGN_EPI = false, bool SP2 = false>
__device__ __forceinline__ void gemm_phase(PG8_LAS unsigned char* lds, const Gemm g, const Sched& S, const Epi& E) {
    int tid_l = threadIdx.x; asm volatile("" : "+v"(tid_l)); const int tid = tid_l, wid = __builtin_amdgcn_readfirstlane(tid >> 6), lane = tid & 63, wr = wid >> 2, wc = wid & 3, fr = lane & 15, fq = lane >> 4;
    const int K = g.K, nt = K / BK;
    unsigned voffA[2], voffB[2];
#pragma unroll
    for (int i = 0; i < 2; ++i) { int R, C; stage_rc(tid * 16 + i * 8192, R, C); const int Rb = Epi::PERM ? ((R & ~31) + perm32(R & 31)) : R;
        voffA[i] = (unsigned)(R * K + C) * 2u; voffB[i] = (unsigned)(Rb * K + C) * 2u; }
    const size_t kstep = (size_t)(BK * 2);
    const size_t hstep = (size_t)HALF * K * 2;
    const size_t tstep = 2 * hstep;
    const unsigned ldsw = (unsigned)wid * 1024u;
    const int aoff = lds_byte(wr * 64 + fr, fq * 8), boff = lds_byte(wc * 32 + fr, fq * 8);
#define PG8_SA(b, h) (((b) * 2 + (h)) * HTB)
#define PG8_SB(b, h) ((4 + (b) * 2 + (h)) * HTB)
#define PG8_STAGE(bufoff, gbase, voff) do { _Pragma("unroll") for (int _i = 0; _i < 2; ++_i) \
        __builtin_amdgcn_global_load_lds((const unsigned*)((const char*)(gbase) + (voff)[_i]), (PG8_LAS unsigned*)(lds + (bufoff) + ldsw + _i * 8192), 16, 0, 0); } while (0)
#define PG8_LDA(dst, b, h) do { _Pragma("unroll") for (int m = 0; m < 4; ++m) _Pragma("unroll") for (int k = 0; k < 2; ++k) dst[m][k] = *(const PG8_LAS bf16x8*)(lds + PG8_SA(b, h) + aoff + m * 2048 + k * 1024); } while (0)
#define PG8_LDB(dst, b, h) do { _Pragma("unroll") for (int n = 0; n < 2; ++n) _Pragma("unroll") for (int k = 0; k < 2; ++k) dst[n][k] = *(const PG8_LAS bf16x8*)(lds + PG8_SB(b, h) + boff + n * 2048 + k * 1024); } while (0)
#define PG8_MMA(ai, bj, At, Bt) do { __builtin_amdgcn_s_setprio(1); _Pragma("unroll") for (int m = 0; m < 4; ++m) _Pragma("unroll") for (int n = 0; n < 2; ++n) _Pragma("unroll") for (int k = 0; k < 2; ++k) \
        acc[ai][bj][m][n] = __builtin_amdgcn_mfma_f32_16x16x32_bf16(Bt[n][k], At[m][k], acc[ai][bj][m][n], 0, 0, 0); __builtin_amdgcn_s_setprio(0); } while (0)
#define PG8_WAIT_V(n) asm volatile("s_waitcnt vmcnt(" #n ")" ::: "memory")
#define PG8_WAIT_L(n) asm volatile("s_waitcnt lgkmcnt(" #n ")" ::: "memory")
#define PG8_BAR __builtin_amdgcn_s_barrier()
#define PG8_SCHED __builtin_amdgcn_sched_barrier(0)
    Unit cur, nxt; int ui = 0;
    if (!S.next(0, cur)) return;
    f32x4 acc[2][2][4][2];
#pragma unroll
    for (int a = 0; a < 2; ++a)
#pragma unroll
        for (int b = 0; b < 2; ++b)
#pragma unroll
            for (int m = 0; m < 4; ++m)
#pragma unroll
                for (int n = 0; n < 2; ++n) acc[a][b][m][n] = (f32x4){0.f, 0.f, 0.f, 0.f};
    bf16x8 At[4][2], B0[2][2], B1[2][2];
    const char* cA = (const char*)g.A + (size_t)cur.pm * tstep; const char* cB = (const char*)g.Bt + (size_t)cur.pn * tstep;
    S.a_ready(cur);
    if constexpr (SP2) {
        PG8_STAGE(PG8_SB(0, 0), cB, voffB); PG8_STAGE(PG8_SB(0, 1), cB + hstep, voffB); PG8_STAGE(PG8_SA(0, 0), cA, voffA); PG8_STAGE(PG8_SA(0, 1), cA + hstep, voffA);
        if (wr == 1) PG8_BAR;
        PG8_WAIT_V(2); PG8_BAR;
        PG8_STAGE(PG8_SB(1, 0), cB + kstep, voffB); PG8_STAGE(PG8_SA(1, 0), cA + kstep, voffA); PG8_STAGE(PG8_SB(1, 1), cB + hstep + kstep, voffB);
        PG8_WAIT_V(6); PG8_BAR;
    } else {
        PG8_STAGE(PG8_SB(0, 0), cB, voffB); PG8_STAGE(PG8_SA(0, 0), cA, voffA); PG8_STAGE(PG8_SB(0, 1), cB + hstep, voffB); PG8_STAGE(PG8_SA(0, 1), cA + hstep, voffA);
        if (wr == 1) PG8_BAR;
        PG8_WAIT_V(4); PG8_BAR;
        PG8_STAGE(PG8_SB(1, 0), cB + kstep, voffB); PG8_STAGE(PG8_SA(1, 0), cA + kstep, voffA); PG8_STAGE(PG8_SB(1, 1), cB + hstep + kstep, voffB);
        PG8_WAIT_V(6); PG8_BAR;
    }
    for (;;) {
        const bool has_next = S.next(ui + 1, nxt);
        const char* nA = has_next ? (const char*)g.A + (size_t)nxt.pm * tstep : cA; const char* nB = has_next ? (const char*)g.Bt + (size_t)nxt.pn * tstep : cB;
        for (int t = 0; t < nt; t += 2) {
            const bool last = (t == nt - 2);
            const char* a1 = cA + (size_t)(t + 1) * kstep;
            const char* a2 = last ? nA : cA + (size_t)(t + 2) * kstep; const char* b2 = last ? nB : cB + (size_t)(t + 2) * kstep;
            const char* a3 = a2 + kstep; const char* b3 = b2 + kstep;
            if (last && has_next) S.a_ready(nxt);
            if constexpr (SP2) {
            PG8_LDB(B0, 0, 0); PG8_LDB(B1, 0, 1); PG8_SCHED; PG8_LDA(At, 0, 0); PG8_STAGE(PG8_SA(1, 1), a1 + hstep, voffA);
            PG8_WAIT_V(8); PG8_WAIT_L(0); PG8_BAR; PG8_MMA(0, 0, At, B0); PG8_MMA(0, 1, At, B1); PG8_BAR; PG8_SCHED;
            PG8_LDA(At, 0, 1); PG8_STAGE(PG8_SB(0, 0), b2, voffB); PG8_STAGE(PG8_SB(0, 1), b2 + hstep, voffB); PG8_STAGE(PG8_SA(0, 0), a2, voffA);
            PG8_WAIT_V(8); PG8_WAIT_L(0); PG8_BAR; PG8_MMA(1, 0, At, B0); PG8_MMA(1, 1, At, B1); PG8_BAR; PG8_SCHED;
            PG8_LDB(B0, 1, 0); PG8_LDB(B1, 1, 1); PG8_SCHED; PG8_LDA(At, 1, 0); PG8_STAGE(PG8_SA(0, 1), a2 + hstep, voffA);
            PG8_WAIT_V(8); PG8_WAIT_L(0); PG8_BAR; PG8_MMA(0, 0, At, B0); PG8_MMA(0, 1, At, B1); PG8_BAR; PG8_SCHED;
            PG8_LDA(At, 1, 1); PG8_STAGE(PG8_SB(1, 0), b3, voffB); PG8_STAGE(PG8_SB(1, 1), b3 + hstep, voffB); PG8_STAGE(PG8_SA(1, 0), a3, voffA);
            PG8_WAIT_V(8); PG8_WAIT_L(0); PG8_BAR; PG8_MMA(1, 0, At, B0); PG8_MMA(1, 1, At, B1); PG8_BAR; PG8_SCHED;
            } else {
            PG8_LDB(B0, 0, 0); PG8_SCHED; PG8_LDA(At, 0, 0); PG8_STAGE(PG8_SA(1, 1), a1 + hstep, voffA);
            PG8_WAIT_L(8); PG8_BAR; PG8_WAIT_L(0); PG8_MMA(0, 0, At, B0); PG8_BAR; PG8_SCHED;
            PG8_LDB(B1, 0, 1); PG8_STAGE(PG8_SB(0, 0), b2, voffB);
            PG8_BAR; PG8_WAIT_L(0); PG8_MMA(0, 1, At, B1); PG8_BAR;
            PG8_LDA(At, 0, 1); PG8_STAGE(PG8_SA(0, 0), a2, voffA);
            PG8_BAR; PG8_WAIT_L(0); PG8_MMA(1, 0, At, B0); PG8_BAR; PG8_SCHED;
            PG8_STAGE(PG8_SB(0, 1), b2 + hstep, voffB);
            PG8_WAIT_V(6); PG8_BAR; PG8_MMA(1, 1, At, B1); PG8_BAR;
            PG8_LDB(B0, 1, 0); PG8_SCHED; PG8_LDA(At, 1, 0); PG8_STAGE(PG8_SA(0, 1), a2 + hstep, voffA);
            PG8_WAIT_L(8); PG8_BAR; PG8_WAIT_L(0); PG8_MMA(0, 0, At, B0); PG8_BAR; PG8_SCHED;
            PG8_LDB(B1, 1, 1); PG8_STAGE(PG8_SB(1, 0), b3, voffB);
            PG8_BAR; PG8_WAIT_L(0); PG8_MMA(0, 1, At, B1); PG8_BAR;
            PG8_LDA(At, 1, 1); PG8_STAGE(PG8_SA(1, 0), a3, voffA);
            PG8_BAR; PG8_WAIT_L(0); PG8_MMA(1, 0, At, B0); PG8_BAR; PG8_SCHED;
            PG8_STAGE(PG8_SB(1, 1), b3 + hstep, voffB);
            PG8_WAIT_V(6); PG8_BAR; PG8_MMA(1, 1, At, B1); PG8_BAR;
            }
        }
        if constexpr (ALIGN_EPI) { if (wr == 0) PG8_BAR; }
        if constexpr (!Epi::AFTER_DRAIN) { E(acc, cur, wr, wc, fr, fq); S.done(cur); }
        if (!has_next) break;
#pragma unroll
        for (int a = 0; a < 2; ++a)
#pragma unroll
            for (int b = 0; b < 2; ++b)
#pragma unroll
                for (int m = 0; m < 4; ++m)
#pragma unroll
                    for (int n = 0; n < 2; ++n) acc[a][b][m][n] = (f32x4){0.f, 0.f, 0.f, 0.f};
        cur = nxt; cA = nA; cB = nB; ++ui;
        if constexpr (ALIGN_EPI) { if (wr == 1) PG8_BAR; }
    }
    PG8_WAIT_V(0);
    if constexpr (!ALIGN_EPI) { if (wr == 0) PG8_BAR; }
    PG8_BAR;
    if constexpr (Epi::AFTER_DRAIN) { E.fused(acc, cur, wr, wc, fr, fq, lds, wid, lane); S.done(cur); }
#undef PG8_SA
#undef PG8_SB
#undef PG8_STAGE
#undef PG8_LDA
#undef PG8_LDB
#undef PG8_MMA
#undef PG8_WAIT_V
#undef PG8_WAIT_L
#undef PG8_BAR
#undef PG8_SCHED
}
}

#ifndef PG8_SP2
#define PG8_SP2 true
#endif
#ifndef PG8_ALIGN
#define PG8_ALIGN true
#endif
constexpr int NWAVES = 8, NTHR = 512;
constexpr int BATCH = 2, SEQ = 8192, DM = 4096, MTOK = BATCH * SEQ;
constexpr int HD = 128;
constexpr int A_HEADS = 16, B_HEADS = 16, A_W = 2048, B_W = 2048, AB_IN = 4 * A_W + 3 * B_W;
constexpr int NSA_H = 32, NSA_G = 4, NSA_R = 8, KVW = 512, NSA_IN = 4096 + 6 * KVW + 96, NSA_INP = 7424;
constexpr int NCMP = 511, NCMPP = 512, NSLC = 128, NTOP = 16, WINDOW = 512;
constexpr int NMEM = 256, XH = 4, XW = 512;
constexpr int DFF = 11008, DFF2 = 22016;
constexpr float LN_EPS = 1e-5f, RMS_EPS = 1e-6f;
constexpr float DN_ALPHA = 1.41421356237309515f;
constexpr size_t MiB = (size_t)1 << 20;
constexpr size_t WS_CTL = 0, CTL_ZERO_BYTES = 4 * MiB;
constexpr size_t WS_FOLD = 64 * 1024;
constexpr int FO_XQ = 0, FO_UP = 2 * 512, FO_NSA = FO_UP + 2 * 22016, FO_N = FO_NSA + 7424;
constexpr size_t WS_RSUM = 1 * MiB;
static_assert(WS_FOLD + (size_t)2 * FO_N * 8 <= WS_RSUM && WS_RSUM + (size_t)6 * 16384 * 2 * 8 <= CTL_ZERO_BYTES, "CTL map");
constexpr size_t WS_W_ABIN = 4 * MiB;
constexpr size_t WS_W_ABOUT = WS_W_ABIN + 112 * MiB;
constexpr size_t WS_W_NSAIN = WS_W_ABOUT + 32 * MiB;
constexpr size_t WS_W_NSAOUT = WS_W_NSAIN + 58 * MiB;
constexpr size_t WS_W_XQ = WS_W_NSAOUT + 32 * MiB;
constexpr size_t WS_W_XKV = WS_W_XQ + 8 * MiB;
constexpr size_t WS_W_XO = WS_W_XKV + 16 * MiB;
constexpr size_t WS_W_UP = WS_W_XO + 8 * MiB;
constexpr size_t WS_W_DOWN = WS_W_UP + 344 * MiB;
constexpr size_t WS_W_C1 = WS_W_DOWN + 172 * MiB;
constexpr size_t WS_W_C2 = WS_W_C1 + 2 * MiB;
constexpr size_t WS_MEMB = WS_W_C2 + 1 * MiB;
constexpr size_t WS_HB = WS_MEMB + 4 * MiB;
constexpr size_t WS_Y = WS_HB + 128 * MiB;
constexpr size_t WS_BIG = WS_Y + 256 * MiB;
constexpr size_t WS_G = WS_BIG + 688 * MiB;
constexpr size_t WS_O = WS_G + 344 * MiB;
constexpr size_t WS_MISC = WS_O + 128 * MiB;
constexpr size_t WS_END = WS_MISC + 64 * MiB;
constexpr size_t WS_XQ = WS_MISC;
constexpr size_t WS_XO = WS_MISC + 16 * MiB;
constexpr size_t WS_XKV = WS_MISC + 32 * MiB;
constexpr size_t WS_LB = WS_MISC + 34 * MiB;
constexpr size_t WS_FOLDF = WS_MISC + 40 * MiB;
constexpr size_t WS_ROPE = WS_MISC + 36 * MiB;
constexpr size_t WS_STATS = WS_MISC + 35 * MiB;
constexpr size_t WS_PROJ0 = WS_BIG;
constexpr size_t WS_SPREV = WS_BIG + 448 * MiB;
constexpr size_t WS_QT = WS_G;
constexpr size_t WS_OINTRA = WS_G + 64 * MiB;
constexpr size_t WS_DEC = WS_G + 192 * MiB;
constexpr size_t WS_DS = WS_Y;
constexpr size_t WS_PROJ1 = WS_BIG;
constexpr size_t WS_QROT = WS_BIG + 232 * MiB;
constexpr size_t WS_KSROT = WS_BIG + 360 * MiB;
constexpr size_t WS_KWROT = WS_BIG + 376 * MiB;
constexpr size_t WS_KCMP = WS_BIG + 392 * MiB;
constexpr size_t WS_VCMP = WS_BIG + 393 * MiB;
constexpr size_t WS_OVL = WS_BIG + 394 * MiB;
constexpr size_t WS_SEL = WS_BIG + 395 * MiB;
constexpr size_t WS_IMP = WS_G + 256 * MiB;
constexpr size_t WS_O32 = WS_G;
static_assert(WS_SPREV + 128 * MiB <= WS_G && WS_DEC + 2 * MiB <= WS_O && WS_SEL + MiB <= WS_G, "ws map");
constexpr int CW_TMO = 0, CW_CODE = 1;
constexpr int CW_BAR = 4096;
constexpr int RING_OFF = 0, RING_BYTES = 131072;
constexpr int LDSCTL_OFF = RING_BYTES, MISC_OFF = LDSCTL_OFF + 320;
constexpr int LDS_BYTES = 147456;
static_assert(MISC_OFF + 128 <= LDS_BYTES, "LDS map");

#define GAS __attribute__((address_space(1)))
#define LAS __attribute__((address_space(3)))
typedef unsigned short bf16;
typedef unsigned v4u __attribute__((ext_vector_type(4)));
typedef unsigned v2u __attribute__((ext_vector_type(2)));
typedef float f32x4 __attribute__((ext_vector_type(4)));
typedef float f32x2 __attribute__((ext_vector_type(2)));
typedef float f32x16 __attribute__((ext_vector_type(16)));
typedef short bf16x8 __attribute__((ext_vector_type(8)));
typedef short s16x4 __attribute__((ext_vector_type(4)));
typedef GAS unsigned gu32;
#define RLX_AGENT __ATOMIC_RELAXED, __HIP_MEMORY_SCOPE_AGENT
#define LDS_WAIT() asm volatile("s_waitcnt lgkmcnt(0)" ::: "memory")
#define VM_WAIT() asm volatile("s_waitcnt vmcnt(0)" ::: "memory")
#define SBAR() __builtin_amdgcn_sched_barrier(0)
__device__ __forceinline__ unsigned f2bf(float f) { unsigned u = __builtin_bit_cast(unsigned, f); return (u + 0x7fffu + ((u >> 16) & 1u)) >> 16; }
__device__ __forceinline__ unsigned pk2(float lo, float hi) { return f2bf(lo) | (f2bf(hi) << 16); }
__device__ __forceinline__ float bf2f(unsigned short b) { return __builtin_bit_cast(float, (unsigned)b << 16); }
__device__ __forceinline__ float bflo(unsigned w) { return __builtin_bit_cast(float, w << 16); }
__device__ __forceinline__ float bfhi(unsigned w) { return __builtin_bit_cast(float, w & 0xffff0000u); }
__device__ __forceinline__ unsigned cvtpk(float lo, float hi) { unsigned r; asm volatile("v_cvt_pk_bf16_f32 %0, %1, %2" : "=v"(r) : "v"(lo), "v"(hi)); return r; }
__device__ __forceinline__ float wave_sum(float v) {
#pragma unroll
    for (int o = 1; o < 64; o <<= 1) v += __shfl_xor(v, o);
    return v;
}
__device__ __forceinline__ float sigmoidf_(float x) { return __builtin_amdgcn_rcpf(1.f + __builtin_amdgcn_exp2f(-1.4426950408889634f * x)); }
__device__ __forceinline__ float gelu1(float v) { pg8::f32x2 r = pg8::gelu_pk((pg8::f32x2){v, 0.f}); return r.x; }
#define XB_TMO      128
#define XB_XCNT(j)  (256  + 64 * (j))
#define XB_XSUB(j)  (1280 + 64 * (j))
#define XB_XGEN(j)  (2304 + 64 * (j))
#define XB_TOP      3328
#define XB_TOPGEN   3392
#define XCD_BAR_WORDS 3456
#define XB_SPIN_CAP (1u << 18)
#define LAS __attribute__((address_space(3)))

__device__ __forceinline__ unsigned xb_ld(unsigned* p)              { return __hip_atomic_load(p, __ATOMIC_RELAXED, __HIP_MEMORY_SCOPE_AGENT); }
__device__ __forceinline__ unsigned xb_add(unsigned* p, unsigned v) { return __hip_atomic_fetch_add(p, v, __ATOMIC_RELAXED, __HIP_MEMORY_SCOPE_AGENT); }
__device__ __forceinline__ unsigned xb_xcc_id() { return (unsigned)__builtin_amdgcn_s_getreg((3 << 11) | 20) & 0xFu; }
#define XB_SPIN(cond, bar) do { unsigned _sp = 0; while (cond) { __builtin_amdgcn_s_sleep(1); \
    if ((++_sp & 255u) == 0u) { if (xb_ld(&(bar)[XB_TMO])) break; if (_sp > XB_SPIN_CAP) { atomicAdd(&(bar)[XB_TMO], 1u); break; } } } } while (0)

struct XcdBarrier {
    unsigned* bar; unsigned x;
    volatile LAS unsigned* st;
};

__device__ __forceinline__ XcdBarrier xcd_barrier_post(unsigned* bar, volatile LAS unsigned* st) {
    XcdBarrier b; b.bar = bar; b.x = xb_xcc_id(); b.st = st;
    if (threadIdx.x == 0) (void)xb_add(&bar[XB_XCNT(b.x)], 1u);
    return b;
}
__device__ __forceinline__ void xcd_barrier_complete(unsigned* bar, unsigned x, unsigned& nloc, unsigned& nx) {
    const unsigned G = gridDim.x * gridDim.y * gridDim.z;
    unsigned sum, cnt, mine, sp = 0u;
    for (;;) {
        sum = 0u; cnt = 0u; mine = 0u;
#pragma unroll
        for (unsigned j = 0; j < 16; ++j) { const unsigned c = xb_ld(&bar[XB_XCNT(j)]); sum += c; cnt += (c > 0u) ? 1u : 0u; mine = (j == x) ? c : mine; }
        if (sum == G) break;
        __builtin_amdgcn_s_sleep(1);
        if ((++sp & 255u) == 0u) { if (xb_ld(&bar[XB_TMO])) break; if (sp > XB_SPIN_CAP) { atomicAdd(&bar[XB_TMO], 1u); break; } }
    }
    nloc = mine > 0u ? mine : 1u; nx = cnt > 0u ? cnt : 1u;
}

__device__ __forceinline__ void xcd_barrier(const XcdBarrier& b) {
    asm volatile("s_waitcnt vmcnt(0)" ::: "memory");
    __syncthreads();
    if (threadIdx.x == 0) {
        unsigned* bar = b.bar;
        __builtin_amdgcn_s_waitcnt(0);
        unsigned nloc = b.st[0], nx = b.st[1];
        if (nloc == 0u) { xcd_barrier_complete(bar, b.x, nloc, nx); b.st[0] = nloc; b.st[1] = nx; }
        const unsigned old = xb_add(&bar[XB_XSUB(b.x)], 1u);
        const unsigned gen = old / nloc;
        if (old + 1u == (gen + 1u) * nloc) {
            __builtin_amdgcn_fence(__ATOMIC_RELEASE, "agent");
            asm volatile("s_waitcnt vmcnt(0)" ::: "memory");
            const unsigned og = xb_add(&bar[XB_TOP], 1u);
            const unsigned tg = og / nx;
            if (og + 1u == (tg + 1u) * nx) xb_add(&bar[XB_TOPGEN], 1u);
            else XB_SPIN(xb_ld(&bar[XB_TOPGEN]) == tg, bar);
            __builtin_amdgcn_fence(__ATOMIC_ACQUIRE, "agent");
            xb_add(&bar[XB_XGEN(b.x)], 1u);
            asm volatile("s_waitcnt vmcnt(0)" ::: "memory");
        } else {
            XB_SPIN(xb_ld(&bar[XB_XGEN(b.x)]) == gen, bar);
            __builtin_amdgcn_fence(__ATOMIC_ACQUIRE, "agent");
            asm volatile("s_waitcnt vmcnt(0)" ::: "memory");
        }
    }
    __syncthreads();
}


constexpr int ATT_D = 128, KVBLK = 64;
constexpr int SHM_V = KVBLK * ATT_D * 2, SHM_K = KVBLK * ATT_D * 2;
constexpr int ATT_K_OFF = 0, ATT_V_OFF = SHM_K, ATT_BUF = SHM_K + SHM_V, ATT_SET = 2 * ATT_BUF;
constexpr int ATT_WS_OFF = RING_BYTES + 512;
constexpr int ATT_X_OFF = ATT_WS_OFF + NWAVES * 256;
static_assert(2 * ATT_SET <= RING_BYTES && ATT_X_OFF + 2048 + NTHR * 16 <= LDS_BYTES, "attention LDS map");
#define KSWZ(row, colB) ((row) * 256 + ((colB) ^ (((row) & 7) << 4)))
__device__ __forceinline__ int crow(int r, int hi) { return (r & 3) + 8 * (r >> 2) + 4 * hi; }
__device__ __forceinline__ int v_st(int k, int c) { const int kk = (k & ~0xC) | ((k & 4) << 1) | ((k & 8) >> 1); return ((kk >> 3) * 4 + (c >> 5)) * 512 + ((kk & 7) * 32 + (c & 31)) * 2; }
__device__ __forceinline__ int v_rd_base(int lane) { return ((lane & 3) << 3) | (((lane >> 2) & 3) << 6) | (((lane >> 4) & 1) << 5) | (((lane >> 5) & 1) << 8); }
constexpr int v_rd_off(int d0, int ks, int half) { return d0 * 512 + ks * 4096 + half * 2048; }
template <int OFF> __device__ __forceinline__ s16x4 tr_read(int vb) {
  s16x4 r; asm volatile("ds_read_b64_tr_b16 %0, %1 offset:%2" : "=&v"(r) : "v"(vb), "i"(OFF) : "memory"); return r;
}
__device__ __forceinline__ void qkt(f32x16& p0, f32x16& p1, const LAS char* Ks, const bf16x8* qr, int r32, int hi) {
  p0 = f32x16{}; p1 = f32x16{};
#pragma unroll
  for (int d0 = 0; d0 < 8; ++d0) { const int cb = (d0 * 16 + hi * 8) * 2;
    const bf16x8 b0 = *(const LAS bf16x8*)(Ks + KSWZ(r32, cb));
    const bf16x8 b1 = *(const LAS bf16x8*)(Ks + KSWZ(32 + r32, cb));
    p0 = __builtin_amdgcn_mfma_f32_32x32x16_bf16(b0, qr[d0], p0, 0, 0, 0);
    p1 = __builtin_amdgcn_mfma_f32_32x32x16_bf16(b1, qr[d0], p1, 0, 0, 0); }
}
__device__ __forceinline__ void pack_p(const f32x16& p0, const f32x16& p1, bf16x8& pa0, bf16x8& pa1, bf16x8& pa2, bf16x8& pa3) {
#define PK4(P, BASE, OUT) do { unsigned a0 = cvtpk(P[BASE + 0], P[BASE + 1]), a1 = cvtpk(P[BASE + 2], P[BASE + 3]);   \
    unsigned b0 = cvtpk(P[BASE + 4], P[BASE + 5]), b1 = cvtpk(P[BASE + 6], P[BASE + 7]);                              \
    auto r0 = __builtin_amdgcn_permlane32_swap(a0, b0, false, false); auto r1 = __builtin_amdgcn_permlane32_swap(a1, b1, false, false); \
    v4u w = {r0[0], r1[0], r0[1], r1[1]}; OUT = __builtin_bit_cast(bf16x8, w); } while (0)
  PK4(p0, 0, pa0); PK4(p0, 8, pa1); PK4(p1, 0, pa2); PK4(p1, 8, pa3);
#undef PK4
}
template <int D0> __device__ __forceinline__ void pv_one(f32x16& od, int vb, bf16x8 pa0, bf16x8 pa1, bf16x8 pa2, bf16x8 pa3) {
  const s16x4 l0 = tr_read<v_rd_off(D0, 0, 0)>(vb), h0 = tr_read<v_rd_off(D0, 0, 1)>(vb), l1 = tr_read<v_rd_off(D0, 1, 0)>(vb), h1 = tr_read<v_rd_off(D0, 1, 1)>(vb);
  const s16x4 l2 = tr_read<v_rd_off(D0, 2, 0)>(vb), h2 = tr_read<v_rd_off(D0, 2, 1)>(vb), l3 = tr_read<v_rd_off(D0, 3, 0)>(vb), h3 = tr_read<v_rd_off(D0, 3, 1)>(vb);
  asm volatile("s_waitcnt lgkmcnt(0)" ::: "memory"); SBAR();
#define PKV(L, H) (bf16x8){L[0], L[1], L[2], L[3], H[0], H[1], H[2], H[3]}
  od = __builtin_amdgcn_mfma_f32_32x32x16_bf16(pa0, PKV(l0, h0), od, 0, 0, 0);
  od = __builtin_amdgcn_mfma_f32_32x32x16_bf16(pa1, PKV(l1, h1), od, 0, 0, 0);
  od = __builtin_amdgcn_mfma_f32_32x32x16_bf16(pa2, PKV(l2, h2), od, 0, 0, 0);
  od = __builtin_amdgcn_mfma_f32_32x32x16_bf16(pa3, PKV(l3, h3), od, 0, 0, 0);
#undef PKV
}
__device__ __forceinline__ void pv_d0(f32x16* o, int vb, bf16x8 pa0, bf16x8 pa1, bf16x8 pa2, bf16x8 pa3) {
  pv_one<0>(o[0], vb, pa0, pa1, pa2, pa3); pv_one<1>(o[1], vb, pa0, pa1, pa2, pa3); pv_one<2>(o[2], vb, pa0, pa1, pa2, pa3); pv_one<3>(o[3], vb, pa0, pa1, pa2, pa3);
}
struct KVStage { bf16x8 ks0, ks1, vs0, vs1; };
__device__ __forceinline__ void kv_load(KVStage& s, const bf16* Kh, const bf16* Vh, long ldk, long ldv, int k0, int sr, int sc) {
  s.ks0 = *(const bf16x8*)(Kh + (long)(k0 + sr) * ldk + sc); s.ks1 = *(const bf16x8*)(Kh + (long)(k0 + 32 + sr) * ldk + sc);
  s.vs0 = *(const bf16x8*)(Vh + (long)(k0 + sr) * ldv + sc); s.vs1 = *(const bf16x8*)(Vh + (long)(k0 + 32 + sr) * ldv + sc);
}
__device__ __forceinline__ void kv_write(const KVStage& s, LAS char* lds, int sr, int sc) {
  *(LAS bf16x8*)(lds + ATT_V_OFF + v_st(sr, sc)) = s.vs0; *(LAS bf16x8*)(lds + ATT_V_OFF + v_st(32 + sr, sc)) = s.vs1;
  *(LAS bf16x8*)(lds + ATT_K_OFF + KSWZ(sr, sc * 2)) = s.ks0; *(LAS bf16x8*)(lds + ATT_K_OFF + KSWZ(32 + sr, sc * 2)) = s.ks1;
}
struct KVDma { int ko[2], vo[2]; };
__device__ __forceinline__ void kv_dma_init(KVDma& d, int ldk, int ldv, int wid, int lane) {
#pragma unroll
  for (int i = 0; i < 2; ++i) { const int p = wid * 2 + i;
    const int row = p * 4 + (lane >> 4), cp = lane & 15; d.ko[i] = row * ldk + ((cp ^ (row & 7)) << 3);
    const int sub = p * 2 + (lane >> 5), kk = (sub >> 2) * 8 + ((lane & 31) >> 2), k = (kk & ~0xC) | ((kk & 4) << 1) | ((kk & 8) >> 1), c = (sub & 3) * 32 + (lane & 3) * 8;
    d.vo[i] = k * ldv + c; }
}
__device__ __forceinline__ void kv_dma(const KVDma& d, const bf16* Kt, const bf16* Vt, LAS char* lds, int buf, int wid) {
#pragma unroll
  for (int i = 0; i < 2; ++i) {
    __builtin_amdgcn_global_load_lds((const unsigned*)(Kt + d.ko[i]), (LAS unsigned*)(lds + buf + ATT_K_OFF + (wid * 2 + i) * 1024), 16, 0, 0);
    __builtin_amdgcn_global_load_lds((const unsigned*)(Vt + d.vo[i]), (LAS unsigned*)(lds + buf + ATT_V_OFF + (wid * 2 + i) * 1024), 16, 0, 0); }
}
__device__ __forceinline__ void rescale_o(f32x16* o, float a, LAS float* al_l, int r32, int hi) {
  if (__any(a < 1.f)) { if (hi == 0) al_l[r32] = a; LDS_WAIT();
#pragma unroll
    for (int r = 0; r < 16; ++r) { const float f = al_l[crow(r, hi)];
#pragma unroll
      for (int d = 0; d < 4; ++d) o[d][r] *= f; }
    LDS_WAIT(); }
}
constexpr float ATT_SCALE = 0.088388347648318440f, ATT_C = ATT_SCALE * 1.4426950408889634f, ATT_THR = 8.f;
__device__ __forceinline__ void softmax_tile(f32x16& p0, f32x16& p1, float& m_reg, float& l_reg, float& alpha) {
  float pmax = p0[0];
#pragma unroll
  for (int r = 1; r < 16; ++r) pmax = fmaxf(pmax, p0[r]);
#pragma unroll
  for (int r = 0; r < 16; ++r) pmax = fmaxf(pmax, p1[r]);
  { auto rr = __builtin_amdgcn_permlane32_swap(__float_as_uint(pmax), __float_as_uint(pmax), false, false);
    pmax = fmaxf(__uint_as_float(rr[0]), __uint_as_float(rr[1])); }
  float mn;
  if (__all(pmax - m_reg <= ATT_THR / ATT_SCALE)) { mn = m_reg; alpha = 1.f; }
  else { mn = fmaxf(m_reg, pmax); alpha = __builtin_amdgcn_exp2f((m_reg - mn) * ATT_C); m_reg = mn; }
  const float mnC = -mn * ATT_C;
#pragma unroll
  for (int r = 0; r < 16; ++r) { p0[r] = __builtin_amdgcn_exp2f(fmaf(p0[r], ATT_C, mnC)); p1[r] = __builtin_amdgcn_exp2f(fmaf(p1[r], ATT_C, mnC)); }
  float ps = 0.f;
#pragma unroll
  for (int r = 0; r < 16; ++r) ps += p0[r] + p1[r];
  { auto rr = __builtin_amdgcn_permlane32_swap(__float_as_uint(ps), __float_as_uint(ps), false, false);
    ps = __uint_as_float(rr[0]) + __uint_as_float(rr[1]); }
  l_reg = l_reg * alpha + ps;
}
__device__ __forceinline__ void attn_finish(f32x16& p0, f32x16& p1, f32x16* o, float& m_reg, float& l_reg, LAS float* wsc, int vb, int r32, int hi) {
  float alpha; softmax_tile(p0, p1, m_reg, l_reg, alpha);
  rescale_o(o, alpha, wsc, r32, hi);
  bf16x8 pa0, pa1, pa2, pa3; pack_p(p0, p1, pa0, pa1, pa2, pa3);
  pv_d0(o, vb, pa0, pa1, pa2, pa3);
}
__device__ __forceinline__ void load_q(bf16x8* qr, const bf16* Qw) {
#pragma unroll
  for (int d0 = 0; d0 < 8; ++d0) qr[d0] = *(const bf16x8*)(Qw + d0 * 16);
}

struct Frame {
    LAS unsigned char* lds;
    unsigned char* ws;
    int tid, lane, wave, G, bid;
    __device__ __forceinline__ void fresh() { int t = threadIdx.x; asm volatile("" : "+v"(t)); tid = t; lane = t & 63; wave = __builtin_amdgcn_readfirstlane(t >> 6);
        int g_ = gridDim.x, b_ = blockIdx.x; asm volatile("" : "+s"(g_), "+s"(b_)); G = g_; bid = b_; }
};
struct Args { const float* in[19]; float* out; unsigned char* ws; int ph_lo, ph_hi; };
typedef const Args __attribute__((address_space(4))) KArgs;
__device__ __forceinline__ KArgs* karg() { KArgs* p = (KArgs*)__builtin_amdgcn_kernarg_segment_ptr(); asm volatile("" : "+s"(p)); return p; }
#define KIN(i) ((const float*)karg()->in[i])
enum { IN_X = 0, IN_MEM, IN_AB_W_IN, IN_HGRN_LB, IN_HGRN_NW, IN_AB_W_OUT, IN_NSA_W_IN, IN_NSA_CMP_POS, IN_NSA_CMP_W1, IN_NSA_CMP_W2, IN_NSA_W_OUT,
       IN_XA_WQ, IN_XA_WKV, IN_XA_WO, IN_FFN_UP, IN_FFN_CONV, IN_FFN_DOWN, IN_LN_G, IN_LN_B };

__device__ __forceinline__ void p0_transpose_item(const float* W, int K, int N, bf16* WT, LAS float* scr, int item, int lane) {
    const int nblk = N / 32, kb = item / nblk, nb = item % nblk, k0 = 64 * kb, n0 = 32 * nb;
#pragma unroll 8
    for (int i = 0; i < 32; ++i) { const int kk = 2 * i + (lane >> 5); scr[kk * 33 + (lane & 31)] = W[(size_t)(k0 + kk) * N + n0 + (lane & 31)]; }
    LDS_WAIT(); asm volatile("" ::: "memory");
    const int c = lane & 7;
#pragma unroll
    for (int j = 0; j < 4; ++j) { const int n = (lane >> 3) + 8 * j; const LAS float* s = scr + (8 * c) * 33 + n;
        v4u o; o.x = pk2(s[0 * 33], s[1 * 33]); o.y = pk2(s[2 * 33], s[3 * 33]); o.z = pk2(s[4 * 33], s[5 * 33]); o.w = pk2(s[6 * 33], s[7 * 33]);
        *(GAS v4u*)(WT + (size_t)(n0 + n) * K + k0 + 8 * c) = o; }
    LDS_WAIT(); asm volatile("" ::: "memory");
}
__device__ __forceinline__ void p0_transpose_item_fold(const float* W, int K, int N, bf16* WT, LAS float* scr, int item, int lane, const float* g, const float* b, long long* cs, long long* b2) {
    const int nblk = N / 32, kb = item / nblk, nb = item % nblk, k0 = 64 * kb, n0 = 32 * nb;
#pragma unroll 8
    for (int i = 0; i < 32; ++i) { const int kk = 2 * i + (lane >> 5); scr[kk * 33 + (lane & 31)] = W[(size_t)(k0 + kk) * N + n0 + (lane & 31)]; }
    LDS_WAIT(); asm volatile("" ::: "memory");
    const int c = lane & 7;
    const f32x4 g0 = *(const f32x4*)(g + k0 + 8 * c), g1 = *(const f32x4*)(g + k0 + 8 * c + 4), b0 = *(const f32x4*)(b + k0 + 8 * c), b1 = *(const f32x4*)(b + k0 + 8 * c + 4);
    const float gg[8] = {g0.x, g0.y, g0.z, g0.w, g1.x, g1.y, g1.z, g1.w}, bb[8] = {b0.x, b0.y, b0.z, b0.w, b1.x, b1.y, b1.z, b1.w};
#pragma unroll
    for (int j = 0; j < 4; ++j) { const int n = (lane >> 3) + 8 * j; const LAS float* s = scr + (8 * c) * 33 + n;
        float sc = 0.f, sb = 0.f; unsigned w[4];
#pragma unroll
        for (int q = 0; q < 4; ++q) { const float x0 = s[(2 * q) * 33], x1 = s[(2 * q + 1) * 33]; const unsigned r0 = f2bf(x0 * gg[2 * q]), r1 = f2bf(x1 * gg[2 * q + 1]);
            w[q] = r0 | (r1 << 16); sc += bf2f((unsigned short)r0) + bf2f((unsigned short)r1); sb += x0 * bb[2 * q] + x1 * bb[2 * q + 1]; }
        *(GAS v4u*)(WT + (size_t)(n0 + n) * K + k0 + 8 * c) = (v4u){w[0], w[1], w[2], w[3]};
        sc += __shfl_xor(sc, 1); sc += __shfl_xor(sc, 2); sc += __shfl_xor(sc, 4); sb += __shfl_xor(sb, 1); sb += __shfl_xor(sb, 2); sb += __shfl_xor(sb, 4);
        if (c == 0) { atomicAdd((unsigned long long*)(cs + n0 + n), (unsigned long long)(long long)rintf(sc * pg8::FOLD_SCALE)); atomicAdd((unsigned long long*)(b2 + n0 + n), (unsigned long long)(long long)rintf(sb * pg8::FOLD_SCALE)); } }
    LDS_WAIT(); asm volatile("" ::: "memory");
}
__device__ __forceinline__ void transpose_mat_fold(Frame& F, const float* W, int K, int N, bf16* WT, const float* g, const float* b, long long* cs, long long* b2, int c0 = 0, int nw = 1 << 30, int part = 0, int nparts = 1) {
    if (F.bid < c0 || F.bid >= c0 + nw) return;
    LAS float* scr = (LAS float*)(F.lds + RING_OFF + F.wave * 16384);
    const int nwg = nw < F.G ? nw : F.G, gw = (F.bid - c0) * NWAVES + F.wave, NGW = nwg * NWAVES;
    const int nitems = (K / 64) * (N / 32), ilo = (int)((long)nitems * part / nparts), ihi = (int)((long)nitems * (part + 1) / nparts);
    for (int it = ilo + gw; it < ihi; it += NGW) p0_transpose_item_fold(W, K, N, WT, scr, it, F.lane, g, b, cs, b2);
}
__device__ __forceinline__ void transpose_mat(Frame& F, const float* W, int K, int N, bf16* WT, int c0 = 0, int nw = 1 << 30) {
    if (F.bid < c0 || F.bid >= c0 + nw) return;
    LAS float* scr = (LAS float*)(F.lds + RING_OFF + F.wave * 16384);
    const int nwg = nw < F.G ? nw : F.G, gw = (F.bid - c0) * NWAVES + F.wave, NGW = nwg * NWAVES;
    const int nitems = (K / 64) * (N / 32);
    for (int it = gw; it < nitems; it += NGW) p0_transpose_item(W, K, N, WT, scr, it, F.lane);
}
__device__ __forceinline__ void fold_finalize(Frame& F, int lo, int n) {
    const long long* fs = (const long long*)(F.ws + WS_FOLD); float* fd = (float*)(F.ws + WS_FOLDF);
    for (int i = F.bid * NTHR + F.tid; i < 2 * n; i += F.G * NTHR) { const int j = (i < n) ? lo + i : FO_N + lo + (i - n); const long long v = fs[j]; fd[j] = (float)(int)(v >> 32) + (float)(unsigned)v * pg8::FOLD_INV; }
}
enum { CJ_DOWN0, CJ_NSA, CJ_L1A, CJ_L1B, CJ_DOWN1 };
template <int JOB>
__device__ __forceinline__ void convert_job(Frame& F, const Args& A, int c0, int nw) {
    unsigned char* ws = F.ws; long long* cs = (long long*)(ws + WS_FOLD); long long* b2 = cs + FO_N;
    if (JOB == CJ_DOWN0 || JOB == CJ_DOWN1) { const int l = JOB == CJ_DOWN1; transpose_mat(F, KIN(IN_FFN_DOWN) + (size_t)l * DFF * DM, DFF, DM, (bf16*)(ws + WS_W_DOWN) + (size_t)l * DM * DFF, c0, nw); }
    if (JOB == CJ_NSA) {
        transpose_mat_fold(F, KIN(IN_NSA_W_IN), DM, NSA_IN, (bf16*)(ws + WS_W_NSAIN), KIN(IN_LN_G) + 2 * DM, KIN(IN_LN_B) + 2 * DM, cs + FO_NSA, b2 + FO_NSA, c0, nw);
        transpose_mat(F, KIN(IN_NSA_W_OUT), DM, DM, (bf16*)(ws + WS_W_NSAOUT), c0, nw); }
    if (JOB == CJ_L1A || JOB == CJ_L1B) { const int l = 1;
        if (JOB == CJ_L1A) {
            transpose_mat_fold(F, KIN(IN_XA_WQ) + (size_t)l * DM * XW, DM, XW, (bf16*)(ws + WS_W_XQ) + (size_t)l * XW * DM, KIN(IN_LN_G) + (size_t)(3 * l) * DM, KIN(IN_LN_B) + (size_t)(3 * l) * DM, cs + FO_XQ + l * XW, b2 + FO_XQ + l * XW, c0, nw);
            transpose_mat(F, KIN(IN_XA_WKV) + (size_t)l * DM * 2 * XW, DM, 2 * XW, (bf16*)(ws + WS_W_XKV) + (size_t)l * 2 * XW * DM, c0, nw);
            transpose_mat(F, KIN(IN_XA_WO) + (size_t)l * XW * DM, XW, DM, (bf16*)(ws + WS_W_XO) + (size_t)l * DM * XW, c0, nw); }
        transpose_mat_fold(F, KIN(IN_FFN_UP) + (size_t)l * DM * DFF2, DM, DFF2, (bf16*)(ws + WS_W_UP) + (size_t)l * DFF2 * DM, KIN(IN_LN_G) + (size_t)(3 * l + 1) * DM, KIN(IN_LN_B) + (size_t)(3 * l + 1) * DM,
                           cs + FO_UP + l * DFF2, b2 + FO_UP + l * DFF2, c0, nw, JOB == CJ_L1A ? 0 : 1, 2); }
}
__device__ __forceinline__ void cvt_flat(Frame& F, const float* src, bf16* dst, long n8) {
    for (long i = (long)F.bid * NTHR + F.tid; i < n8; i += (long)F.G * NTHR) {
        const f32x4 a = *(const f32x4*)(src + i * 8), b = *(const f32x4*)(src + i * 8 + 4);
        v4u o; o.x = pk2(a.x, a.y); o.y = pk2(a.z, a.w); o.z = pk2(b.x, b.y); o.w = pk2(b.z, b.w);
        *(v4u*)(dst + i * 8) = o; }
}
__device__ __forceinline__ void p0_prologue(Frame& F, const Args& A) {
    unsigned char* ws = F.ws;
    long long* cs = (long long*)(ws + WS_FOLD); long long* b2 = cs + FO_N;
    transpose_mat(F, KIN(IN_AB_W_IN), DM, AB_IN, (bf16*)(ws + WS_W_ABIN));
    transpose_mat(F, KIN(IN_AB_W_OUT), DM, DM, (bf16*)(ws + WS_W_ABOUT));
    { const int l = 0;
        transpose_mat_fold(F, KIN(IN_XA_WQ) + (size_t)l * DM * XW, DM, XW, (bf16*)(ws + WS_W_XQ) + (size_t)l * XW * DM, KIN(IN_LN_G) + (size_t)(3 * l) * DM, KIN(IN_LN_B) + (size_t)(3 * l) * DM, cs + FO_XQ + l * XW, b2 + FO_XQ + l * XW);
        transpose_mat(F, KIN(IN_XA_WKV) + (size_t)l * DM * 2 * XW, DM, 2 * XW, (bf16*)(ws + WS_W_XKV) + (size_t)l * 2 * XW * DM);
        transpose_mat(F, KIN(IN_XA_WO) + (size_t)l * XW * DM, XW, DM, (bf16*)(ws + WS_W_XO) + (size_t)l * DM * XW);
        transpose_mat_fold(F, KIN(IN_FFN_UP) + (size_t)l * DM * DFF2, DM, DFF2, (bf16*)(ws + WS_W_UP) + (size_t)l * DFF2 * DM, KIN(IN_LN_G) + (size_t)(3 * l + 1) * DM, KIN(IN_LN_B) + (size_t)(3 * l + 1) * DM, cs + FO_UP + l * DFF2, b2 + FO_UP + l * DFF2); }
    for (int l = 0; l < 2; ++l) {
        transpose_mat(F, KIN(IN_NSA_CMP_W1) + (size_t)l * 32 * HD * HD, 32 * HD, HD, (bf16*)(ws + WS_W_C1) + (size_t)l * HD * 32 * HD);
        transpose_mat(F, KIN(IN_NSA_CMP_W2) + (size_t)l * HD * HD, HD, HD, (bf16*)(ws + WS_W_C2) + (size_t)l * HD * HD);
    }
    cvt_flat(F, KIN(IN_X), (bf16*)(ws + WS_HB), (long)MTOK * DM / 8);
    cvt_flat(F, KIN(IN_MEM), (bf16*)(ws + WS_MEMB), (long)BATCH * NMEM * DM / 8);
    { v4u z = {0u, 0u, 0u, 0u}; v4u* p = (v4u*)((bf16*)(ws + WS_W_NSAIN) + (size_t)NSA_IN * DM); const long n = (long)(NSA_INP - NSA_IN) * DM / 8;
      for (long i = (long)F.bid * NTHR + F.tid; i < n; i += (long)F.G * NTHR) p[i] = z; }
    { float* tab = (float*)(ws + WS_ROPE);
      for (int i = F.bid * NTHR + F.tid; i < SEQ * 64; i += F.G * NTHR) { const int t = i >> 6, d = i & 63;
          float sn, cs; sincosf((float)t * powf(10000.0f, -(float)d * (1.0f / 64.0f)), &sn, &cs); tab[(size_t)t * 128 + d] = cs; tab[(size_t)t * 128 + 64 + d] = sn; } }
    { const float* lbp = KIN(IN_HGRN_LB); float* lbo = (float*)(ws + WS_LB);
      for (int i = F.bid * NTHR + F.tid; i < A_W; i += F.G * NTHR) { const float a = lbp[i], b = lbp[A_W + i], m = fmaxf(a, b), ea = __expf(a - m), eb = __expf(b - m); lbo[i] = ea / (ea + eb); } }
}

__device__ __forceinline__ void ln_phase(Frame& F, const bf16* Y, const float* g, const float* b, float* h32) {
    const int gw = F.bid * NWAVES + F.wave, NGW = F.G * NWAVES;
    for (int m = gw; m < MTOK; m += NGW) {
        const v4u* yr = (const v4u*)(Y + (size_t)m * DM) + F.lane;
        float v[8][8]; float s = 0.f;
#pragma unroll
        for (int j = 0; j < 8; ++j) { const v4u x = yr[64 * j];
            v[j][0] = bflo(x.x); v[j][1] = bfhi(x.x); v[j][2] = bflo(x.y); v[j][3] = bfhi(x.y); v[j][4] = bflo(x.z); v[j][5] = bfhi(x.z); v[j][6] = bflo(x.w); v[j][7] = bfhi(x.w);
#pragma unroll
            for (int q = 0; q < 8; ++q) s += v[j][q]; }
        const float mean = wave_sum(s) * (1.f / DM); float s2 = 0.f;
#pragma unroll
        for (int j = 0; j < 8; ++j)
#pragma unroll
            for (int q = 0; q < 8; ++q) { v[j][q] -= mean; s2 += v[j][q] * v[j][q]; }
        const float rstd = 1.f / sqrtf(wave_sum(s2) * (1.f / DM) + LN_EPS);
#pragma unroll
        for (int j = 0; j < 8; ++j) { const int c0 = 8 * F.lane + 512 * j;
            const f32x4 g0 = *(const f32x4*)(g + c0), g1 = *(const f32x4*)(g + c0 + 4), b0 = *(const f32x4*)(b + c0), b1 = *(const f32x4*)(b + c0 + 4);
            f32x4 r0, r1;
            r0.x = v[j][0] * rstd * g0.x + b0.x; r0.y = v[j][1] * rstd * g0.y + b0.y; r0.z = v[j][2] * rstd * g0.z + b0.z; r0.w = v[j][3] * rstd * g0.w + b0.w;
            r1.x = v[j][4] * rstd * g1.x + b1.x; r1.y = v[j][5] * rstd * g1.y + b1.y; r1.z = v[j][6] * rstd * g1.z + b1.z; r1.w = v[j][7] * rstd * g1.w + b1.w;
            *(f32x4*)(h32 + (size_t)m * DM + c0) = r0; *(f32x4*)(h32 + (size_t)m * DM + c0 + 4) = r1; }
    }
}

__device__ __forceinline__ void convglu_phase(Frame& F, const bf16* UP, const float* cw, bf16* Gm) {
    constexpr int NCG = DFF / 8, RB = 16, NRB = MTOK / RB;
    const long nitems = (long)NCG * NRB;
    for (long it = (long)F.bid * NTHR + F.tid; it < nitems; it += (long)F.G * NTHR) {
        const int cg = (int)(it % NCG), rb = (int)(it / NCG), c0 = cg * 8, t0 = rb * RB;
        float w0[8], w1[8], w2[8];
#pragma unroll
        for (int j = 0; j < 8; ++j) { w0[j] = cw[c0 + j]; w1[j] = cw[DFF + c0 + j]; w2[j] = cw[2 * DFF + c0 + j]; }
        float am2[8], am1[8];
        if ((t0 & (SEQ - 1)) == 0) {
#pragma unroll
            for (int j = 0; j < 8; ++j) { am2[j] = 0.f; am1[j] = 0.f; }
        } else {
            const v4u x2 = *(const v4u*)(UP + (size_t)(t0 - 2) * DFF2 + c0), x1 = *(const v4u*)(UP + (size_t)(t0 - 1) * DFF2 + c0);
            am2[0] = bflo(x2.x); am2[1] = bfhi(x2.x); am2[2] = bflo(x2.y); am2[3] = bfhi(x2.y); am2[4] = bflo(x2.z); am2[5] = bfhi(x2.z); am2[6] = bflo(x2.w); am2[7] = bfhi(x2.w);
            am1[0] = bflo(x1.x); am1[1] = bfhi(x1.x); am1[2] = bflo(x1.y); am1[3] = bfhi(x1.y); am1[4] = bflo(x1.z); am1[5] = bfhi(x1.z); am1[6] = bflo(x1.w); am1[7] = bfhi(x1.w);
        }
#pragma unroll 4
        for (int r = 0; r < RB; ++r) {
            const size_t row = (size_t)(t0 + r);
            const v4u xa = *(const v4u*)(UP + row * DFF2 + c0), xu = *(const v4u*)(UP + row * DFF2 + DFF + c0);
            float a[8], u[8];
            a[0] = bflo(xa.x); a[1] = bfhi(xa.x); a[2] = bflo(xa.y); a[3] = bfhi(xa.y); a[4] = bflo(xa.z); a[5] = bfhi(xa.z); a[6] = bflo(xa.w); a[7] = bfhi(xa.w);
            u[0] = bflo(xu.x); u[1] = bfhi(xu.x); u[2] = bflo(xu.y); u[3] = bfhi(xu.y); u[4] = bflo(xu.z); u[5] = bfhi(xu.z); u[6] = bflo(xu.w); u[7] = bfhi(xu.w);
            float o[8];
#pragma unroll
            for (int j = 0; j < 8; j += 2) {
                const float c0v = w2[j] * a[j] + w1[j] * am1[j] + w0[j] * am2[j], c1v = w2[j + 1] * a[j + 1] + w1[j + 1] * am1[j + 1] + w0[j + 1] * am2[j + 1];
                const pg8::f32x2 gg = pg8::gelu_pk((pg8::f32x2){c0v, c1v}); o[j] = gg.x * u[j]; o[j + 1] = gg.y * u[j + 1]; }
            v4u w; w.x = pk2(o[0], o[1]); w.y = pk2(o[2], o[3]); w.z = pk2(o[4], o[5]); w.w = pk2(o[6], o[7]);
            *(v4u*)(Gm + row * DFF + c0) = w;
#pragma unroll
            for (int j = 0; j < 8; ++j) { am2[j] = am1[j]; am1[j] = a[j]; }
        }
    }
}

__device__ __forceinline__ void xattn_phase(Frame& F, const bf16* XQ, const bf16* XKV, bf16* XO) {
    const int tid = F.tid, wid = F.wave, lane = F.lane, r32 = lane & 31, hi = lane >> 5;
    LAS char* lds = (LAS char*)F.lds;
    LAS float* wsc = (LAS float*)(lds + ATT_WS_OFF + wid * 256);
    const int vb0 = (int)(uintptr_t)(lds + ATT_V_OFF) + v_rd_base(lane);
    KVDma dm; kv_dma_init(dm, 2 * XW, 2 * XW, wid, lane);
    constexpr int NU = (MTOK / 256) * XH;
    for (int u = F.bid; u < NU; u += F.G) {
        const int head = u % XH, rbk = u / XH, row0 = rbk * 256, b = row0 / SEQ;
        const bf16* Kh = XKV + (size_t)b * NMEM * 2 * XW + head * HD; const bf16* Vh = Kh + XW;
        bf16x8 qr[8]; load_q(qr, XQ + (size_t)(row0 + wid * 32 + r32) * XW + head * HD + hi * 8);
        float m_reg = -1e30f, l_reg = 0.f; f32x16 o[4] = {};
        __syncthreads();
        kv_dma(dm, Kh, Vh, lds, 0, wid);
        for (int j = 0; j < NMEM / KVBLK; ++j) {
            const int buf = (j & 1) * ATT_BUF;
            VM_WAIT(); __syncthreads();
            if (j + 1 < NMEM / KVBLK) kv_dma(dm, Kh + (size_t)(j + 1) * KVBLK * 2 * XW, Vh + (size_t)(j + 1) * KVBLK * 2 * XW, lds, ATT_BUF - buf, wid);
            f32x16 p0, p1; qkt(p0, p1, lds + buf + ATT_K_OFF, qr, r32, hi);
            float alpha; softmax_tile(p0, p1, m_reg, l_reg, alpha);
            rescale_o(o, alpha, wsc, r32, hi);
            bf16x8 pa0, pa1, pa2, pa3; pack_p(p0, p1, pa0, pa1, pa2, pa3);
            pv_d0(o, vb0 + buf, pa0, pa1, pa2, pa3);
        }
        if (hi == 0) wsc[32 + r32] = l_reg; LDS_WAIT();
        bf16* Ow = XO + (size_t)(row0 + wid * 32) * XW + head * HD;
#pragma unroll
        for (int r = 0; r < 16; ++r) { const int orow = crow(r, hi); const float rl = __builtin_amdgcn_rcpf(wsc[32 + orow]);
#pragma unroll
            for (int d0 = 0; d0 < 4; ++d0) Ow[(size_t)orow * XW + d0 * 32 + r32] = (bf16)f2bf(o[d0][r] * rl); }
        LDS_WAIT();
    }
}

template <int K>
__device__ __forceinline__ f32x4 mma_tile(const LAS char* A, int lda, const LAS char* B, int ldb, int fr, int fq) {
    f32x4 acc = {0.f, 0.f, 0.f, 0.f};
#pragma unroll
    for (int k0 = 0; k0 < K; k0 += 32) {
        const bf16x8 a = *(const LAS bf16x8*)(A + fr * lda + (k0 + 8 * fq) * 2);
        const bf16x8 b = *(const LAS bf16x8*)(B + fr * ldb + (k0 + 8 * fq) * 2);
        acc = __builtin_amdgcn_mfma_f32_16x16x32_bf16(a, b, acc, 0, 0, 0);
    }
    return acc;
}
constexpr int HG_CH = 64, HG_NC = SEQ / HG_CH, HG_ITEMS = BATCH * A_HEADS * HG_NC;
constexpr int HG_QT = 0, HG_KT = 17408, HG_KH = 34816, HG_VT = 53248, HG_PT = 71680, HG_SEG = 80896;
constexpr int HG_SP = 17408, HG_OT = 52224;
constexpr int HG_WT = 80896, HG_KHS = 86016, HG_VS = 103424;
__device__ __forceinline__ void hgrn_phase_a(Frame& F, const bf16* P0, const float* lbv, bf16* QTg, bf16* OINTRA, bf16* DS, float* DEC) {
    LAS char* lds = (LAS char*)F.lds;
    const int tid = F.tid, wid = F.wave, lane = F.lane, fr = lane & 15, fq = lane >> 4;
    const int dg = tid & 15, sq = tid >> 4;
    const int d = tid & 127, sq16 = tid >> 7;
    for (int it = F.bid; it < HG_ITEMS; it += F.G) {
        const int c = it % HG_NC, bh = it / HG_NC, h = bh % A_HEADS, b = bh / A_HEADS;
        const size_t row0 = (size_t)b * SEQ + (size_t)c * HG_CH;
        float lb[8], q[2][8], kk[2][8], cum[2][8]; v4u vraw[2];
        { const f32x4 l0 = *(const f32x4*)(lbv + h * HD + 8 * dg), l1 = *(const f32x4*)(lbv + h * HD + 8 * dg + 4);
          lb[0] = l0.x; lb[1] = l0.y; lb[2] = l0.z; lb[3] = l0.w; lb[4] = l1.x; lb[5] = l1.y; lb[6] = l1.z; lb[7] = l1.w; }
#pragma unroll
        for (int rr = 0; rr < 2; ++rr) { const bf16* rowp = P0 + (row0 + 2 * sq + rr) * AB_IN + h * HD + 8 * dg;
            const v4u zq = *(const v4u*)(rowp + A_W), qq = *(const v4u*)rowp; vraw[rr] = *(const v4u*)(rowp + 2 * A_W);
            const unsigned zw[4] = {zq.x, zq.y, zq.z, zq.w}, qw[4] = {qq.x, qq.y, qq.z, qq.w};
#pragma unroll
            for (int j = 0; j < 8; ++j) { const float z = (j & 1) ? bfhi(zw[j >> 1]) : bflo(zw[j >> 1]); q[rr][j] = (j & 1) ? bfhi(qw[j >> 1]) : bflo(qw[j >> 1]);
                const float sg = sigmoidf_(z), omlb = 1.f - lb[j]; kk[rr][j] = omlb * (1.f - sg);
                const float lf = __logf(lb[j] + omlb * sg); cum[rr][j] = rr ? cum[0][j] + lf : lf; } }
        float pre[8];
#pragma unroll
        for (int j = 0; j < 8; ++j) { const float seg = cum[1][j]; float x = seg; const float t1 = __shfl_up(x, 16); if (lane >= 16) x += t1; const float t2 = __shfl_up(x, 32); if (lane >= 32) x += t2;
            pre[j] = x - seg; if (lane >= 48) ((LAS float*)(lds + HG_WT))[wid * 128 + 8 * dg + j] = x; }
        LDS_WAIT(); __syncthreads();
        float total[8];
#pragma unroll
        for (int j = 0; j < 8; ++j) total[j] = 0.f;
#pragma unroll
        for (int w = 0; w < NWAVES; ++w) { const f32x4 a0 = *(const LAS f32x4*)(lds + HG_WT + (w * 128 + 8 * dg) * 4), a1 = *(const LAS f32x4*)(lds + HG_WT + (w * 128 + 8 * dg + 4) * 4);
            const float av[8] = {a0.x, a0.y, a0.z, a0.w, a1.x, a1.y, a1.z, a1.w};
#pragma unroll
            for (int j = 0; j < 8; ++j) { total[j] += av[j]; if (w < wid) pre[j] += av[j]; } }
#pragma unroll
        for (int rr = 0; rr < 2; ++rr) { const int s = 2 * sq + rr; unsigned qt[4], kt[4], kh[4];
#pragma unroll
            for (int j = 0; j < 8; j += 2) { const float b0 = pre[j] + cum[rr][j], b1 = pre[j + 1] + cum[rr][j + 1];
                qt[j >> 1] = pk2(q[rr][j] * __expf(b0), q[rr][j + 1] * __expf(b1));
                kt[j >> 1] = pk2(kk[rr][j] * __expf(-b0), kk[rr][j + 1] * __expf(-b1));
                kh[j >> 1] = pk2(kk[rr][j] * __expf(total[j] - b0), kk[rr][j + 1] * __expf(total[j + 1] - b1)); }
            const v4u qv = {qt[0], qt[1], qt[2], qt[3]};
            *(LAS v4u*)(lds + HG_QT + s * 272 + dg * 16) = qv; *(v4u*)(QTg + (row0 + s) * A_W + h * HD + 8 * dg) = qv;
            *(LAS v4u*)(lds + HG_KT + s * 272 + dg * 16) = (v4u){kt[0], kt[1], kt[2], kt[3]};
            *(LAS v4u*)(lds + HG_KHS + s * 272 + dg * 16) = (v4u){kh[0], kh[1], kh[2], kh[3]};
            *(LAS v4u*)(lds + HG_VS + s * 272 + dg * 16) = vraw[rr]; }
        if (sq == 31) { f32x4 e0, e1; e0.x = __expf(total[0]); e0.y = __expf(total[1]); e0.z = __expf(total[2]); e0.w = __expf(total[3]); e1.x = __expf(total[4]); e1.y = __expf(total[5]); e1.z = __expf(total[6]); e1.w = __expf(total[7]);
            *(f32x4*)(DEC + (size_t)it * HD + 8 * dg) = e0; *(f32x4*)(DEC + (size_t)it * HD + 8 * dg + 4) = e1; }
        LDS_WAIT(); __syncthreads();
        { unsigned kh[8], vt[8];
#pragma unroll
          for (int j = 0; j < 16; j += 2) { const int s = 16 * sq16 + j;
              kh[j >> 1] = (unsigned)*(const LAS unsigned short*)(lds + HG_KHS + s * 272 + d * 2) | ((unsigned)*(const LAS unsigned short*)(lds + HG_KHS + (s + 1) * 272 + d * 2) << 16);
              vt[j >> 1] = (unsigned)*(const LAS unsigned short*)(lds + HG_VS + s * 272 + d * 2) | ((unsigned)*(const LAS unsigned short*)(lds + HG_VS + (s + 1) * 272 + d * 2) << 16); }
          LAS v4u* pk = (LAS v4u*)(lds + HG_KH + d * 144 + sq16 * 32); pk[0] = (v4u){kh[0], kh[1], kh[2], kh[3]}; pk[1] = (v4u){kh[4], kh[5], kh[6], kh[7]};
          LAS v4u* pv = (LAS v4u*)(lds + HG_VT + d * 144 + sq16 * 32); pv[0] = (v4u){vt[0], vt[1], vt[2], vt[3]}; pv[1] = (v4u){vt[4], vt[5], vt[6], vt[7]}; }
        LDS_WAIT(); __syncthreads();
#pragma unroll
        for (int k = 0; k < 2; ++k) { const int tau = 2 * wid + k, ti = tau >> 2, si = tau & 3;
            f32x4 acc = {0.f, 0.f, 0.f, 0.f};
            if (si <= ti) acc = mma_tile<128>(lds + HG_QT + ti * 16 * 272, 272, lds + HG_KT + si * 16 * 272, 272, fr, fq);
#pragma unroll
            for (int i = 0; i < 4; ++i) { const int t = 16 * ti + 4 * fq + i, s = 16 * si + fr; const float v = (s <= t) ? acc[i] : 0.f;
                *(LAS unsigned short*)(lds + HG_PT + t * 144 + s * 2) = (unsigned short)f2bf(v); } }
        LDS_WAIT(); __syncthreads();
#pragma unroll
        for (int k = 0; k < 4; ++k) { const int tau = wid + 8 * k, ti = tau >> 3, vi = tau & 7;
            const f32x4 acc = mma_tile<64>(lds + HG_VT + vi * 16 * 144, 144, lds + HG_PT + ti * 16 * 144, 144, fr, fq);
            v2u w; w.x = pk2(acc[0], acc[1]); w.y = pk2(acc[2], acc[3]);
            *(v2u*)(OINTRA + (row0 + 16 * ti + fr) * A_W + h * HD + 16 * vi + 4 * fq) = w; }
#pragma unroll
        for (int k = 0; k < 8; ++k) { const int tau = wid + 8 * k, vi = tau >> 3, ki = tau & 7;
            const f32x4 acc = mma_tile<64>(lds + HG_KH + ki * 16 * 144, 144, lds + HG_VT + vi * 16 * 144, 144, fr, fq);
            v2u w; w.x = pk2(acc[0], acc[1]); w.y = pk2(acc[2], acc[3]);
            *(v2u*)(DS + ((size_t)it * HD + 16 * vi + fr) * HD + 16 * ki + 4 * fq) = w; }
        LDS_WAIT(); __syncthreads();
    }
}
__device__ __forceinline__ void hgrn_phase_b(Frame& F, const bf16* DS, const float* DEC, bf16* SPREV) {
    const int tid = F.tid, dvl = tid >> 5, dk4 = (tid & 31) * 4;
    for (int item = F.bid; item < BATCH * A_HEADS * 8; item += F.G) {
        const int sl = item & 7, bh = item >> 3, dv = sl * 16 + dvl;
        f32x4 S = {0.f, 0.f, 0.f, 0.f};
        for (int c0 = 0; c0 < HG_NC; c0 += 8) {
            f32x4 ds[8], dc[8];
#pragma unroll
            for (int k = 0; k < 8; ++k) { const size_t it = (size_t)bh * HG_NC + c0 + k; const v2u x = *(const v2u*)(DS + (it * HD + dv) * HD + dk4);
                ds[k] = (f32x4){bflo(x.x), bfhi(x.x), bflo(x.y), bfhi(x.y)}; dc[k] = *(const f32x4*)(DEC + it * HD + dk4); }
#pragma unroll
            for (int k = 0; k < 8; ++k) { const size_t it = (size_t)bh * HG_NC + c0 + k;
                v2u w; w.x = pk2(S.x, S.y); w.y = pk2(S.z, S.w); *(v2u*)(SPREV + (it * HD + dv) * HD + dk4) = w;
                S = S * dc[k] + ds[k]; }
        }
    }
}
__device__ __forceinline__ void hgrn_phase_c(Frame& F, const bf16* P0, const bf16* QTg, const bf16* OINTRA, const bf16* SPREV, const float* nw, bf16* Ob) {
    LAS char* lds = (LAS char*)F.lds;
    const int tid = F.tid, wid = F.wave, lane = F.lane, fr = lane & 15, fq = lane >> 4;
    for (int it = F.bid; it < HG_ITEMS; it += F.G) {
        const int c = it % HG_NC, bh = it / HG_NC, h = bh % A_HEADS, b = bh / A_HEADS;
        const size_t row0 = (size_t)b * SEQ + (size_t)c * HG_CH;
        { const int s = tid >> 3, ch = (tid & 7) * 16; const bf16* src = QTg + (row0 + s) * A_W + h * HD + ch;
          const v4u x0 = *(const v4u*)src, x1 = *(const v4u*)(src + 8); LAS v4u* dst = (LAS v4u*)(lds + HG_QT + s * 272 + ch * 2); dst[0] = x0; dst[1] = x1; }
        { const int dv = tid >> 2, ch = (tid & 3) * 32; const bf16* src = SPREV + ((size_t)it * HD + dv) * HD + ch;
          const v4u x0 = *(const v4u*)src, x1 = *(const v4u*)(src + 8), x2 = *(const v4u*)(src + 16), x3 = *(const v4u*)(src + 24);
          LAS v4u* dst = (LAS v4u*)(lds + HG_SP + dv * 272 + ch * 2); dst[0] = x0; dst[1] = x1; dst[2] = x2; dst[3] = x3; }
        LDS_WAIT(); __syncthreads();
#pragma unroll
        for (int k = 0; k < 4; ++k) { const int tau = wid + 8 * k, ti = tau >> 3, vi = tau & 7;
            const f32x4 acc = mma_tile<128>(lds + HG_SP + vi * 16 * 272, 272, lds + HG_QT + ti * 16 * 272, 272, fr, fq);
            const int t = 16 * ti + fr, dv = 16 * vi + 4 * fq; const v2u oi = *(const v2u*)(OINTRA + (row0 + t) * A_W + h * HD + dv);
            *(LAS f32x4*)(lds + HG_OT + (t * 132 + dv) * 4) = (f32x4){acc[0] + bflo(oi.x), acc[1] + bfhi(oi.x), acc[2] + bflo(oi.y), acc[3] + bfhi(oi.y)}; }
        LDS_WAIT(); __syncthreads();
        { const int t = tid >> 3, dv0 = (tid & 7) * 16;
          float v[16]; float ss = 0.f;
#pragma unroll
          for (int q4 = 0; q4 < 4; ++q4) { const f32x4 x = *(const LAS f32x4*)(lds + HG_OT + (t * 132 + dv0 + 4 * q4) * 4); v[4 * q4] = x.x; v[4 * q4 + 1] = x.y; v[4 * q4 + 2] = x.z; v[4 * q4 + 3] = x.w;
              ss += (x.x * x.x + x.y * x.y) + (x.z * x.z + x.w * x.w); }
          ss += __shfl_xor(ss, 1); ss += __shfl_xor(ss, 2); ss += __shfl_xor(ss, 4);
          const float r = 1.f / sqrtf(ss * (1.f / HD) + RMS_EPS);
          const bf16* gp = P0 + (row0 + t) * AB_IN + 3 * A_W + h * HD + dv0; const v4u g0 = *(const v4u*)gp, g1 = *(const v4u*)(gp + 8);
          const unsigned gw[8] = {g0.x, g0.y, g0.z, g0.w, g1.x, g1.y, g1.z, g1.w}; unsigned o[8];
#pragma unroll
          for (int j = 0; j < 8; ++j) { const float ga = bflo(gw[j]), gb = bfhi(gw[j]);
              o[j] = pk2(v[2 * j] * r * nw[dv0 + 2 * j] * ga * sigmoidf_(ga), v[2 * j + 1] * r * nw[dv0 + 2 * j + 1] * gb * sigmoidf_(gb)); }
          bf16* op = Ob + (row0 + t) * DM + h * HD + dv0; *(v4u*)op = (v4u){o[0], o[1], o[2], o[3]}; *(v4u*)(op + 8) = (v4u){o[4], o[5], o[6], o[7]}; }
        LDS_WAIT(); __syncthreads();
    }
}

constexpr float SB_CUT = -160.f;
__device__ __forceinline__ void sb_phase(Frame& F, const bf16* P0, bf16* Ob) {
    const int tid = F.tid, wid = F.wave, lane = F.lane, r32 = lane & 31, hi = lane >> 5;
    LAS char* lds = (LAS char*)F.lds;
    const int vb0 = (int)(uintptr_t)(lds + ATT_V_OFF) + v_rd_base(lane);
    KVDma dm; kv_dma_init(dm, AB_IN, AB_IN, wid, lane);
    constexpr int NQB = SEQ / 256, NU = BATCH * B_HEADS * NQB;
    for (int rd = 0; ; ++rd) {
        const int idx = (rd & 1) ? rd * F.G + (F.G - 1 - F.bid) : rd * F.G + F.bid;
        if (rd * F.G >= NU) break;
        if (idx >= NU) continue;
        const int qb = NQB - 1 - idx / (BATCH * B_HEADS), bh = idx % (BATCH * B_HEADS), head = bh % B_HEADS, b = bh / B_HEADS;
        const size_t rowb = (size_t)b * SEQ; const int q0 = qb * 256;
        const bf16* Kh = P0 + rowb * AB_IN + 4 * A_W + B_W + head * HD; const bf16* Vh = Kh + B_W;
        const int tw0 = q0 + wid * 32, t = tw0 + r32;
        bf16x8 qr[8]; load_q(qr, P0 + (rowb + t) * AB_IN + 4 * A_W + head * HD + hi * 8);
        float R = 0.f; f32x16 o[4] = {};
        const int jtop = (q0 + 254) >> 6;
        LAS unsigned* dflag = (LAS unsigned*)(lds + ATT_X_OFF);
        if (lane == 0) { dflag[wid] = 0u; dflag[8 + wid] = 0u; }
        LDS_WAIT(); __syncthreads();
        kv_dma(dm, Kh + (size_t)jtop * KVBLK * AB_IN, Vh + (size_t)jtop * KVBLK * AB_IN, lds, 0, wid);
        int buf = 0;
        for (int j = jtop; j >= 0; --j, buf = ATT_BUF - buf) {
            VM_WAIT(); __syncthreads();
            { unsigned alld = 1u;
#pragma unroll
              for (int w = 0; w < NWAVES; ++w) alld &= dflag[((j + 1) & 1) * 8 + w];
              if (__builtin_amdgcn_readfirstlane(alld)) break; }
            if (j > 0) kv_dma(dm, Kh + (size_t)(j - 1) * KVBLK * AB_IN, Vh + (size_t)(j - 1) * KVBLK * AB_IN, lds, ATT_BUF - buf, wid);
            const int k0 = j * KVBLK;
            if (k0 < tw0 + 31) {
                f32x16 p0, p1; qkt(p0, p1, lds + buf + ATT_K_OFF, qr, r32, hi);
                const bool need_mask = (k0 + 63 >= tw0);
                float L0[16], L1[16];
#pragma unroll
                for (int r = 0; r < 16; ++r) {
                    const float z0 = p0[r] * ATT_C, z1 = p1[r] * ATT_C;
                    float l0 = -(fmaxf(z0, 0.f) + __builtin_amdgcn_logf(1.f + __builtin_amdgcn_exp2f(-fabsf(z0))));
                    float l1 = -(fmaxf(z1, 0.f) + __builtin_amdgcn_logf(1.f + __builtin_amdgcn_exp2f(-fabsf(z1))));
                    if (need_mask) { if (k0 + crow(r, hi) >= t) l0 = 0.f; if (k0 + 32 + crow(r, hi) >= t) l1 = 0.f; }
                    L0[r] = l0; L1[r] = l1; p0[r] = z0 + l0; p1[r] = z1 + l1;
                }
                SBAR();
                float Sg[16];
#pragma unroll
                for (int gi = 0; gi < 4; ++gi) {
                    const float a = (L0[4 * gi] + L0[4 * gi + 1]) + (L0[4 * gi + 2] + L0[4 * gi + 3]), c = (L1[4 * gi] + L1[4 * gi + 1]) + (L1[4 * gi + 2] + L1[4 * gi + 3]);
                    auto ra = __builtin_amdgcn_permlane32_swap(__float_as_uint(a), __float_as_uint(a), false, false);
                    auto rc = __builtin_amdgcn_permlane32_swap(__float_as_uint(c), __float_as_uint(c), false, false);
                    Sg[2 * gi] = __uint_as_float(ra[0]); Sg[2 * gi + 1] = __uint_as_float(ra[1]); Sg[8 + 2 * gi] = __uint_as_float(rc[0]); Sg[8 + 2 * gi + 1] = __uint_as_float(rc[1]);
                }
                float run = R;
#pragma unroll
                for (int s = 15; s >= 0; --s) { const float tt = run; run += Sg[s]; Sg[s] = tt; }
                const float Rn = run;
                SBAR();
#pragma unroll
                for (int gi = 0; gi < 4; ++gi) {
                    float base0 = hi ? Sg[2 * gi + 1] : Sg[2 * gi], base1 = hi ? Sg[8 + 2 * gi + 1] : Sg[8 + 2 * gi];
                    float r3 = base0, r2 = r3 + L0[4 * gi + 3], r1 = r2 + L0[4 * gi + 2], r0 = r1 + L0[4 * gi + 1];
                    p0[4 * gi + 3] = __builtin_amdgcn_exp2f(p0[4 * gi + 3] + r3); p0[4 * gi + 2] = __builtin_amdgcn_exp2f(p0[4 * gi + 2] + r2);
                    p0[4 * gi + 1] = __builtin_amdgcn_exp2f(p0[4 * gi + 1] + r1); p0[4 * gi + 0] = __builtin_amdgcn_exp2f(p0[4 * gi + 0] + r0);
                    r3 = base1; r2 = r3 + L1[4 * gi + 3]; r1 = r2 + L1[4 * gi + 2]; r0 = r1 + L1[4 * gi + 1];
                    p1[4 * gi + 3] = __builtin_amdgcn_exp2f(p1[4 * gi + 3] + r3); p1[4 * gi + 2] = __builtin_amdgcn_exp2f(p1[4 * gi + 2] + r2);
                    p1[4 * gi + 1] = __builtin_amdgcn_exp2f(p1[4 * gi + 1] + r1); p1[4 * gi + 0] = __builtin_amdgcn_exp2f(p1[4 * gi + 0] + r0);
                }
                R = Rn;
                { const unsigned dn = __all(R < SB_CUT) ? 1u : 0u; if (lane == 0) dflag[(j & 1) * 8 + wid] = dn; }
                if (need_mask) {
#pragma unroll
                    for (int r = 0; r < 16; ++r) { if (k0 + crow(r, hi) >= t) p0[r] = 0.f; if (k0 + 32 + crow(r, hi) >= t) p1[r] = 0.f; }
                }
                bf16x8 pa0, pa1, pa2, pa3; pack_p(p0, p1, pa0, pa1, pa2, pa3);
                pv_d0(o, vb0 + buf, pa0, pa1, pa2, pa3);
            }
        }
        bf16* Ow = Ob + (rowb + tw0) * DM + A_W + head * HD;
#pragma unroll
        for (int r = 0; r < 16; ++r) { const int orow = crow(r, hi);
#pragma unroll
            for (int d0 = 0; d0 < 4; ++d0) Ow[(size_t)orow * DM + d0 * 32 + r32] = (bf16)f2bf(o[d0][r]); }
    }
}

constexpr int P1_KC = 4096, P1_VC = 4608, P1_KS = 5120, P1_VS = 5632, P1_KW = 6144, P1_VW = 6656, P1_GL = 7168;
__device__ __forceinline__ void nsa_rope_phase(Frame& F, const bf16* P1, const float* TAB, bf16* QROT, bf16* KSROT, bf16* KWROT, bf16* OVL) {
    const int gw = F.bid * NWAVES + F.wave, NGW = F.G * NWAVES, lane = F.lane, hsub = lane >> 3, d0 = (lane & 7) * 8;
    for (int m = gw; m < MTOK; m += NGW) {
        const int t = m & (SEQ - 1);
        const f32x4 c0 = *(const f32x4*)(TAB + (size_t)t * 128 + d0), c1 = *(const f32x4*)(TAB + (size_t)t * 128 + d0 + 4);
        const f32x4 s0 = *(const f32x4*)(TAB + (size_t)t * 128 + 64 + d0), s1 = *(const f32x4*)(TAB + (size_t)t * 128 + 64 + d0 + 4);
        const float cs[8] = {c0.x, c0.y, c0.z, c0.w, c1.x, c1.y, c1.z, c1.w}, sn[8] = {s0.x, s0.y, s0.z, s0.w, s1.x, s1.y, s1.z, s1.w};
        const bf16* row = P1 + (size_t)m * NSA_INP;
#pragma unroll
        for (int hb = 0; hb < 5; ++hb) {
            const int hh = hb * 8 + hsub;
            const bf16* src; bf16* dst;
            if (hh < 32) { src = row + hh * HD; dst = QROT + (size_t)m * DM + hh * HD; }
            else if (hh < 36) { src = row + P1_KS + (hh - 32) * HD; dst = KSROT + (size_t)m * KVW + (hh - 32) * HD; }
            else { src = row + P1_KW + (hh - 36) * HD; dst = KWROT + (size_t)m * KVW + (hh - 36) * HD; }
            const v4u a = *(const v4u*)(src + d0), bq = *(const v4u*)(src + 64 + d0);
            const unsigned aw[4] = {a.x, a.y, a.z, a.w}, bw[4] = {bq.x, bq.y, bq.z, bq.w}; unsigned o1[4], o2[4];
#pragma unroll
            for (int q = 0; q < 4; ++q) { const float x1l = bflo(aw[q]), x1h = bfhi(aw[q]), x2l = bflo(bw[q]), x2h = bfhi(bw[q]);
                o1[q] = pk2(x1l * cs[2 * q] - x2l * sn[2 * q], x1h * cs[2 * q + 1] - x2h * sn[2 * q + 1]);
                o2[q] = pk2(x2l * cs[2 * q] + x1l * sn[2 * q], x2h * cs[2 * q + 1] + x1h * sn[2 * q + 1]); }
            *(v4u*)(dst + d0) = (v4u){o1[0], o1[1], o1[2], o1[3]}; *(v4u*)(dst + 64 + d0) = (v4u){o2[0], o2[1], o2[2], o2[3]};
        }
    }
    for (int i = F.bid * NTHR + F.tid; i < NCMPP * NSLC; i += F.G * NTHR) { const int n = i / NSLC, j = i % NSLC;
        OVL[i] = (n < NCMP && n >= 4 * j - 1 && n <= 4 * j + 3) ? (bf16)0x3f80u : (bf16)0u; }
}
constexpr int CM_A = 0, CM_B = 17408, CM_H = 17408 + 34816;
__device__ __forceinline__ void nsa_compress_phase(Frame& F, const bf16* P1, const float* pos, const bf16* W1t, const bf16* W2t, bf16* KCMP, bf16* VCMP) {
    LAS char* lds = (LAS char*)F.lds;
    const int tid = F.tid, wid = F.wave, lane = F.lane, fr = lane & 15, fq = lane >> 4;
    for (int item = F.bid; item < 128; item += F.G) {
        const int nt = item & 7, g = (item >> 3) & 3, b = (item >> 5) & 1, which = item >> 6;
        const bf16* w1 = W1t + (size_t)which * HD * 32 * HD; const bf16* w2 = W2t + (size_t)which * HD * HD;
        const float* posw = pos + (size_t)which * 32 * HD;
        f32x4 acc[4];
#pragma unroll
        for (int k = 0; k < 4; ++k) acc[k] = (f32x4){0.f, 0.f, 0.f, 0.f};
        for (int l = 0; l < 32; ++l) {
            { const int r = tid >> 3, ch = (tid & 7) * 16, n = nt * 64 + r; unsigned w[8];
              if (n < NCMP) { const bf16* src = P1 + ((size_t)b * SEQ + 16 * n + l) * NSA_INP + P1_KC + which * KVW + g * HD + ch;
                  const v4u x0 = *(const v4u*)src, x1 = *(const v4u*)(src + 8); const unsigned xs[8] = {x0.x, x0.y, x0.z, x0.w, x1.x, x1.y, x1.z, x1.w};
#pragma unroll
                  for (int q = 0; q < 8; ++q) w[q] = pk2(bflo(xs[q]) + posw[l * HD + ch + 2 * q], bfhi(xs[q]) + posw[l * HD + ch + 2 * q + 1]);
              } else {
#pragma unroll
                  for (int q = 0; q < 8; ++q) w[q] = 0u; }
              LAS v4u* dst = (LAS v4u*)(lds + CM_A + r * 272 + ch * 2); dst[0] = (v4u){w[0], w[1], w[2], w[3]}; dst[1] = (v4u){w[4], w[5], w[6], w[7]}; }
            { const int e = tid >> 2, ch = (tid & 3) * 32; const bf16* src = w1 + (size_t)e * 32 * HD + l * HD + ch;
              const v4u x0 = *(const v4u*)src, x1 = *(const v4u*)(src + 8), x2 = *(const v4u*)(src + 16), x3 = *(const v4u*)(src + 24);
              LAS v4u* dst = (LAS v4u*)(lds + CM_B + e * 272 + ch * 2); dst[0] = x0; dst[1] = x1; dst[2] = x2; dst[3] = x3; }
            LDS_WAIT(); __syncthreads();
#pragma unroll
            for (int k = 0; k < 4; ++k) { const int tau = wid + 8 * k, ni = tau >> 3, ei = tau & 7;
                acc[k] += mma_tile<128>(lds + CM_A + ni * 16 * 272, 272, lds + CM_B + ei * 16 * 272, 272, fr, fq); }
            LDS_WAIT(); __syncthreads();
        }
#pragma unroll
        for (int k = 0; k < 4; ++k) { const int tau = wid + 8 * k, ni = tau >> 3, ei = tau & 7;
#pragma unroll
            for (int i = 0; i < 4; ++i) *(LAS unsigned short*)(lds + CM_H + (16 * ni + 4 * fq + i) * 272 + (16 * ei + fr) * 2) = (unsigned short)f2bf(gelu1(acc[k][i])); }
        { const int f = tid >> 2, ch = (tid & 3) * 32; const bf16* src = w2 + (size_t)f * HD + ch;
          const v4u x0 = *(const v4u*)src, x1 = *(const v4u*)(src + 8), x2 = *(const v4u*)(src + 16), x3 = *(const v4u*)(src + 24);
          LAS v4u* dst = (LAS v4u*)(lds + CM_B + f * 272 + ch * 2); dst[0] = x0; dst[1] = x1; dst[2] = x2; dst[3] = x3; }
        LDS_WAIT(); __syncthreads();
        bf16* outp = which ? VCMP : KCMP;
#pragma unroll
        for (int k = 0; k < 4; ++k) { const int tau = wid + 8 * k, ni = tau >> 3, fi = tau & 7;
            const f32x4 a2 = mma_tile<128>(lds + CM_H + ni * 16 * 272, 272, lds + CM_B + fi * 16 * 272, 272, fr, fq);
#pragma unroll
            for (int i = 0; i < 4; ++i) { const int n = nt * 64 + 16 * ni + 4 * fq + i;
                outp[(((size_t)b * NCMPP + n) * NSA_G + g) * HD + 16 * fi + fr] = (n < NCMP) ? (bf16)f2bf(a2[i]) : (bf16)0u; } }
        LDS_WAIT(); __syncthreads();
    }
}
__device__ __forceinline__ unsigned pick4(const unsigned (&a)[4], int i) { return i == 0 ? a[0] : (i == 1 ? a[1] : (i == 2 ? a[2] : a[3])); }
template <int MODE>
__device__ __forceinline__ void nsa_attn_phase(Frame& F, const bf16* P1, const bf16* Qsrc, const bf16* Ksrc, const bf16* Vsrc, const unsigned* SEL, float* O32, float* IMP, bf16* Ob, bool probe_nostore = false) {
    const int tid = F.tid, wid = F.wave, lane = F.lane, r32 = lane & 31, hi = lane >> 5;
    LAS char* lds = (LAS char*)F.lds;
    LAS float* wsc = (LAS float*)(lds + ATT_WS_OFF + wid * 256);
    const int vb0 = (int)(uintptr_t)(lds + ATT_V_OFF) + v_rd_base(lane);
    KVDma dm; kv_dma_init(dm, MODE <= 1 ? NSA_G * HD : KVW, MODE == 0 ? NSA_G * HD : (MODE == 1 ? NSLC : NSA_INP), wid, lane);
    constexpr int NTB = SEQ / 32, NU = BATCH * NSA_G * NTB;
    for (int rd = 0; ; ++rd) {
        int idx;
        { idx = (rd & 1) ? rd * F.G + (F.G - 1 - F.bid) : rd * F.G + F.bid; if (rd * F.G >= NU) break; if (idx >= NU) continue; }
        const int tb = NTB - 1 - idx / (BATCH * NSA_G), bg = idx % (BATCH * NSA_G), g = bg % NSA_G, b = bg / NSA_G;
        const size_t rowb = (size_t)b * SEQ; const int t0 = tb * 32;
        const int t = (MODE == 2) ? t0 + 4 * wid + (r32 >> 3) : t0 + r32, head = (MODE == 2) ? g * NSA_R + (r32 & 7) : g * NSA_R + wid;
        const bf16* Kh; const bf16* Vh; long ldk, ldv; int jlo, jhi;
        if (MODE <= 1) { Kh = Ksrc + ((size_t)b * NCMPP * NSA_G + g) * HD; ldk = NSA_G * HD; jlo = 0; jhi = (t0 >> 4) >> 6;
            if (MODE == 0) { Vh = Vsrc + ((size_t)b * NCMPP * NSA_G + g) * HD; ldv = NSA_G * HD; } else { Vh = Vsrc; ldv = NSLC; } }
        else { Kh = Ksrc + rowb * KVW + g * HD; ldk = KVW; Vh = P1 + rowb * NSA_INP + (MODE == 2 ? P1_VS : P1_VW) + g * HD; ldv = NSA_INP;
            jhi = (t0 + 31) >> 6; jlo = (MODE == 2) ? 0 : ((t0 - (WINDOW - 1) > 0 ? t0 - (WINDOW - 1) : 0) >> 6); }
        unsigned wn[4] = {~0u, ~0u, ~0u, ~0u};
        if (MODE == 2) { const v4u sv = *(const v4u*)(SEL + ((rowb + t) * NSA_G + g) * 4); unsigned selw[4]; selw[0] = sv.x; selw[1] = sv.y; selw[2] = sv.z; selw[3] = sv.w;
            *(LAS v4u*)(lds + ATT_X_OFF + 2048 + (wid * 64 + lane) * 16) = sv;
            LAS unsigned* un = (LAS unsigned*)(lds + ATT_X_OFF);
#pragma unroll
            for (int q = 0; q < 4; ++q) { unsigned x = selw[q]; x |= __shfl_xor(x, 8); x |= __shfl_xor(x, 16); wn[q] = __builtin_amdgcn_readfirstlane(x); if (lane == 0) un[wid * 4 + q] = wn[q]; }
            LDS_WAIT(); __syncthreads();
            LAS int* plist = (LAS int*)(lds + ATT_X_OFF + 128);
            if (wid == 0) {
                unsigned m0 = 0u, m1 = 0u;
                int lane_l = lane; asm volatile("" : "+v"(lane_l));
                const LAS unsigned* ub = un + (lane_l >> 5);
#pragma unroll
                for (int w = 0; w < NWAVES; ++w) { m0 |= ((ub[w * 4] >> (lane & 31)) & 1u) << w; m1 |= ((ub[w * 4 + 2] >> (lane & 31)) & 1u) << w; }
                bool v0 = m0 != 0u && lane <= jhi, v1 = m1 != 0u && lane + 64 <= jhi; int np = 0;
                for (;;) {
                    const unsigned long long a0 = __ballot(v0), a1 = __ballot(v1);
                    if (!(a0 | a1)) break;
                    const int ja_ = a0 ? __builtin_ctzll(a0) : 64 + __builtin_ctzll(a1);
                    const unsigned ma = (ja_ < 64) ? (unsigned)__shfl((int)m0, ja_) : (unsigned)__shfl((int)m1, ja_ - 64);
                    if (lane == (ja_ & 63)) { if (ja_ < 64) v0 = false; else v1 = false; }
                    unsigned long long c0 = __ballot(v0 && !(m0 & ma)), c1 = __ballot(v1 && !(m1 & ma));
                    if (!(c0 | c1)) { c0 = __ballot(v0 && m0 == 0xffu); c1 = __ballot(v1 && m1 == 0xffu); }
                    if (!(c0 | c1)) { c0 = __ballot(v0); c1 = __ballot(v1); }
                    int jb_ = -1;
                    if (c0 | c1) { jb_ = c0 ? __builtin_ctzll(c0) : 64 + __builtin_ctzll(c1); if (lane == (jb_ & 63)) { if (jb_ < 64) v0 = false; else v1 = false; } }
                    if (lane == 0) { plist[2 * np] = ja_; plist[2 * np + 1] = jb_; }
                    ++np;
                }
                if (lane == 0) { int neg1 = -1; asm volatile("" : "+v"(neg1)); plist[2 * np] = neg1; plist[2 * np + 1] = neg1; }
            }
            LDS_WAIT(); }
        bf16x8 qr[8]; load_q(qr, Qsrc + (rowb + t) * (MODE <= 1 ? NSA_INP : DM) + head * HD + hi * 8);
        float m_reg = -1e30f, l_reg = 0.f; f32x16 o[4] = {};
        const int cur = t >> 6;
#define NSA_NEED(jj) (MODE != 2 || ((pick4(wn, (jj) >> 5) >> ((jj) & 31)) & 1u))
#define NSA_MASK(P0, P1, JJ) do { const int k0 = (JJ) * KVBLK; constexpr float NINF = -__builtin_inff(); \
            if (MODE <= 1) { if (!(16 * (k0 + 63) + 31 <= t0)) { \
                    _Pragma("unroll") for (int r = 0; r < 16; ++r) { if (!(16 * (k0 + crow(r, hi)) + 31 <= t)) P0[r] = NINF; if (!(16 * (k0 + 32 + crow(r, hi)) + 31 <= t)) P1[r] = NINF; } } } \
            else if (MODE == 2) { const bool mine = (*(const LAS unsigned*)(lds + ATT_X_OFF + 2048 + (wid * 64 + lane) * 16 + ((JJ) >> 5) * 4) >> ((JJ) & 31)) & 1u; const int lim = mine ? ((JJ) < cur ? 0x7fffffff : t) : -1; \
                _Pragma("unroll") for (int r = 0; r < 16; ++r) { if (k0 + crow(r, hi) > lim) P0[r] = NINF; if (k0 + 32 + crow(r, hi) > lim) P1[r] = NINF; } } \
            else { if (!((k0 > t0 + 31 - WINDOW) && (k0 + 63 <= t0))) { \
                    _Pragma("unroll") for (int r = 0; r < 16; ++r) { const int ka = k0 + crow(r, hi), kb = ka + 32; \
                        if (!(ka <= t && ka > t - WINDOW)) P0[r] = NINF; if (!(kb <= t && kb > t - WINDOW)) P1[r] = NINF; } } } } while (0)
        const int pbase = __builtin_amdgcn_readfirstlane((int)(uintptr_t)(lds + ATT_X_OFF + 128)); int pp = 0;
#define PLIST(i) (*(const LAS int*)(uintptr_t)(unsigned)(pbase + 4 * (i)))
        int ja, jb;
        __syncthreads();
        if (MODE == 2) { ja = PLIST(0); jb = PLIST(1); ja = __builtin_amdgcn_readfirstlane(ja); jb = __builtin_amdgcn_readfirstlane(jb); if (ja < 0) ja = jhi + 1; }
        else { ja = jlo; jb = ja + 1; if (jb > jhi) jb = -1; }
        if (ja <= jhi) kv_dma(dm, Kh + (size_t)ja * KVBLK * ldk, Vh + (size_t)ja * KVBLK * ldv, lds, 0, wid);
        if (jb >= 0) kv_dma(dm, Kh + (size_t)jb * KVBLK * ldk, Vh + (size_t)jb * KVBLK * ldv, lds, ATT_BUF, wid);
        int set = 0;
#pragma nounroll
        while (ja <= jhi) {
            int jc, jd;
            if (MODE == 2) { ++pp; jc = PLIST(2 * pp); jd = PLIST(2 * pp + 1); jc = __builtin_amdgcn_readfirstlane(jc); jd = __builtin_amdgcn_readfirstlane(jd); if (jc < 0) jc = jhi + 1; }
            else { jc = (jb >= 0 ? jb : ja) + 1; jd = jc + 1; if (jd > jhi) jd = -1; }
            VM_WAIT(); __syncthreads();
            if (jc <= jhi) kv_dma(dm, Kh + (size_t)jc * KVBLK * ldk, Vh + (size_t)jc * KVBLK * ldv, lds, ATT_SET - set, wid);
            if (jc <= jhi && jd >= 0) kv_dma(dm, Kh + (size_t)jd * KVBLK * ldk, Vh + (size_t)jd * KVBLK * ldv, lds, ATT_SET - set + ATT_BUF, wid);
            const bool nA = NSA_NEED(ja), nB = (jb >= 0) && NSA_NEED(jb);
            f32x16 a0, a1, b0, b1;
            if (nA) qkt(a0, a1, lds + set + ATT_K_OFF, qr, r32, hi);
            if (nB) qkt(b0, b1, lds + set + ATT_BUF + ATT_K_OFF, qr, r32, hi);
            if (nA) { NSA_MASK(a0, a1, ja); attn_finish(a0, a1, o, m_reg, l_reg, wsc, vb0 + set, r32, hi); }
            if (nB) { NSA_MASK(b0, b1, jb); attn_finish(b0, b1, o, m_reg, l_reg, wsc, vb0 + set + ATT_BUF, r32, hi); }
            ja = jc; jb = (jc <= jhi) ? jd : -1; set = ATT_SET - set;
        }
#undef PLIST
#undef NSA_MASK
#undef NSA_NEED
        { float fac = l_reg > 0.f ? __builtin_amdgcn_rcpf(l_reg) : 0.f;
          if (MODE != 1) { const int br = MODE == 0 ? 0 : (MODE == 2 ? 1 : 2); fac *= sigmoidf_(bf2f(P1[(rowb + t) * NSA_INP + P1_GL + head * 3 + br])); }
          if (hi == 0) wsc[32 + r32] = fac; LDS_WAIT(); }
        if (MODE == 1) {
            float fc[16];
#pragma unroll
            for (int r = 0; r < 16; ++r) fc[r] = wsc[32 + crow(r, hi)];
            LDS_WAIT(); __syncthreads();
#pragma unroll
            for (int r = 0; r < 16; ++r) { const int orow = crow(r, hi);
#pragma unroll
                for (int d0 = 0; d0 < 4; ++d0) *(LAS float*)(lds + ((wid * 32 + orow) * 128 + d0 * 32 + r32) * 4) = o[d0][r] * fc[r]; }
            LDS_WAIT(); __syncthreads();
            { const int tok = tid >> 4, j8 = (tid & 15) * 8; f32x4 s0 = {0.f, 0.f, 0.f, 0.f}, s1 = {0.f, 0.f, 0.f, 0.f};
#pragma unroll
              for (int w = 0; w < 8; ++w) { const LAS f32x4* pp = (const LAS f32x4*)(lds + ((w * 32 + tok) * 128 + j8) * 4); s0 += pp[0]; s1 += pp[1]; }
              f32x4* dst = (f32x4*)(IMP + ((rowb + t0 + tok) * NSA_G + g) * NSLC + j8); dst[0] = s0; dst[1] = s1; }
            LDS_WAIT(); __syncthreads();
        } else {
#pragma unroll
            for (int r = 0; r < 16; ++r) { const int orow = crow(r, hi); const float fc = wsc[32 + orow];
                const size_t off = (MODE == 2) ? (rowb + t0 + 4 * wid + (orow >> 3)) * DM + (g * NSA_R + (orow & 7)) * HD + r32 : (rowb + t0 + orow) * DM + head * HD + r32;
#pragma unroll
                for (int d0 = 0; d0 < 4; ++d0) {
                    if (MODE == 0) O32[off + d0 * 32] = o[d0][r] * fc;
                    else if (MODE == 3) { if (!probe_nostore) O32[off + d0 * 32] += o[d0][r] * fc; }
                    else Ob[off + d0 * 32] = (bf16)f2bf(O32[off + d0 * 32] + o[d0][r] * fc); } }
            LDS_WAIT();
        }
    }
}
__device__ __forceinline__ void nsa_topk_phase(Frame& F, const float* IMP, unsigned* SEL) {
    LAS float* sc = (LAS float*)(F.lds + F.wave * 1024);
    const int gw = F.bid * NWAVES + F.wave, NGW = F.G * NWAVES, lane = F.lane;
    for (int it = gw; it < MTOK * NSA_G; it += NGW) {
        const int m = it / NSA_G, t = m & (SEQ - 1), cur = t >> 6;
        const float* ip = IMP + (size_t)it * NSLC;
        const float a0 = ip[lane], a1 = ip[64 + lane];
        sc[lane] = a0; sc[64 + lane] = a1; LDS_WAIT();
        const int j0 = lane, j1 = lane + 64;
        const bool f0 = (j0 == 0) || (j0 == cur) || (j0 == cur - 1), f1 = (j1 == cur) || (j1 == cur - 1);
        const bool c0 = !f0 && j0 <= cur, c1 = !f1 && j1 <= cur;
        const int nforced = cur >= 2 ? 3 : cur + 1, slots = NTOP - nforced;
        int rk0 = 0, rk1 = 0;
        const int ncand_hi = cur < NSLC ? cur : NSLC - 1;
        for (int i = 1; i <= ncand_hi; ++i) {
            const bool fi = (i == cur) || (i == cur - 1); if (fi) continue;
            const float v = sc[i];
            rk0 += (v > a0 || (v == a0 && i < j0)) ? 1 : 0; rk1 += (v > a1 || (v == a1 && i < j1)) ? 1 : 0;
        }
        const bool s0 = (f0 && j0 <= cur) || (c0 && rk0 < slots), s1 = (f1 && j1 <= cur) || (c1 && rk1 < slots);
        const unsigned long long m0 = __ballot(s0), m1 = __ballot(s1);
        if (lane == 0) { v4u w = {(unsigned)m0, (unsigned)(m0 >> 32), (unsigned)m1, (unsigned)(m1 >> 32)}; *(v4u*)(SEL + (size_t)it * 4) = w; }
        LDS_WAIT();
    }
}

#ifndef STAGE
#define STAGE 3
#endif
#define ZERO_OB_PHASE PH_BEGIN { v4u z = {0u, 0u, 0u, 0u}; v4u* p = (v4u*)Ob; const long n = (long)MTOK * DM / 8; \
            for (long i = (long)F.bid * NTHR + F.tid; i < n; i += (long)F.G * NTHR) p[i] = z; } PH_END
#define MIXER0_PHASES \
    PH_BEGIN { fold_finalize(F, FO_XQ, XW); fold_finalize(F, FO_UP, DFF2); } \
             REP(10) hgrn_phase_a(F, BIG, (const float*)(ws + WS_LB), (bf16*)(ws + WS_QT), (bf16*)(ws + WS_OINTRA), (bf16*)(ws + WS_DS), (float*)(ws + WS_DEC)); \
             REP(11) sb_phase(F, BIG, Ob); PH_END \
    PH_BEGIN REP(12) hgrn_phase_b(F, (const bf16*)(ws + WS_DS), (const float*)(ws + WS_DEC), (bf16*)(ws + WS_SPREV)); PH_END \
    PH_BEGIN REP(13) hgrn_phase_c(F, BIG, (const bf16*)(ws + WS_QT), (const bf16*)(ws + WS_OINTRA), (const bf16*)(ws + WS_SPREV), KIN(IN_HGRN_NW), Ob); PH_END
#if STAGE <= 2
#define MIXER1_PHASES ZERO_OB_PHASE
#else
#define MIXER1_PHASES \
    PH_BEGIN { fold_finalize(F, FO_XQ + XW, XW); } REP(14) { nsa_rope_phase(F, BIG, (const float*)(ws + WS_ROPE), (bf16*)(ws + WS_QROT), (bf16*)(ws + WS_KSROT), (bf16*)(ws + WS_KWROT), (bf16*)(ws + WS_OVL)); \
             nsa_compress_phase(F, BIG, KIN(IN_NSA_CMP_POS), (const bf16*)(ws + WS_W_C1), (const bf16*)(ws + WS_W_C2), (bf16*)(ws + WS_KCMP), (bf16*)(ws + WS_VCMP)); } PH_END \
    PH_BEGIN { REP(15) nsa_attn_phase<0>(F, BIG, BIG, (const bf16*)(ws + WS_KCMP), (const bf16*)(ws + WS_VCMP), nullptr, (float*)(ws + WS_O32), nullptr, nullptr); \
             F.fresh(); REP(15) nsa_attn_phase<1>(F, BIG, BIG, (const bf16*)(ws + WS_KCMP), (const bf16*)(ws + WS_OVL), nullptr, nullptr, (float*)(ws + WS_IMP), nullptr); \
             F.fresh(); REP(17) nsa_attn_phase<3>(F, BIG, (const bf16*)(ws + WS_QROT), (const bf16*)(ws + WS_KWROT), nullptr, nullptr, (float*)(ws + WS_O32), nullptr, nullptr, r_ > 0); } PH_END \
    PH_BEGIN REP(16) nsa_topk_phase(F, (const float*)(ws + WS_IMP), (unsigned*)(ws + WS_SEL)); PH_END \
    PH_BEGIN REP(18) nsa_attn_phase<2>(F, BIG, (const bf16*)(ws + WS_QROT), (const bf16*)(ws + WS_KSROT), nullptr, (const unsigned*)(ws + WS_SEL), (float*)(ws + WS_O32), nullptr, Ob); PH_END
#endif
#ifndef REPMASK
#define REPMASK 0u
#endif
#define REP(gid) for (int r_ = 0; r_ <= (int)((REPMASK >> (gid)) & 1u); ++r_)
#define PH_BEGIN if (pc >= lo && pc < hi) { F.fresh();
#if (REPMASK >> 23) & 1
#define PH_END   if (pc + 1 < hi) { const unsigned long long tb0_ = __builtin_amdgcn_s_memrealtime(); XcdBarrier bb_ = bar; asm volatile("" : "+s"(bb_.bar), "+s"(bb_.x)); xcd_barrier(bb_); \
        const unsigned w_ = (unsigned)(__builtin_amdgcn_s_memrealtime() - tb0_); tbar_acc += w_; if (threadIdx.x == 0) { atomicMax((unsigned*)(args.ws + 3 * MiB) + pc, 0x7fffffffu - w_); atomicMax((unsigned*)(args.ws + 3 * MiB) + 256 + pc, w_); } } } ++pc;
#else
#define PH_END   if (pc + 1 < hi) { XcdBarrier bb_ = bar; asm volatile("" : "+s"(bb_.bar), "+s"(bb_.x)); xcd_barrier(bb_); } } ++pc;
#endif
template <int l>
__device__ __forceinline__ void layer_body(Frame& F, const Args& args, const XcdBarrier& bar, int& pc, const int lo, const int hi, unsigned long long& tbar_acc) {
    unsigned char* ws = F.ws;
    bf16* HB = (bf16*)(ws + WS_HB); bf16* Y = (bf16*)(ws + WS_Y); float* H32 = (float*)karg()->out;
    bf16* BIG = (bf16*)(ws + WS_BIG); bf16* Gm = (bf16*)(ws + WS_G); bf16* Ob = (bf16*)(ws + WS_O);
    bf16* XQ = (bf16*)(ws + WS_XQ); bf16* XO = (bf16*)(ws + WS_XO);
#define RS(k) ((long long*)(ws + WS_RSUM) + (size_t)(k) * MTOK * 2)
#define LNG(k) (KIN(IN_LN_G) + (size_t)(k) * DM)
#define LNB(k) (KIN(IN_LN_B) + (size_t)(k) * DM)
    const float* cs = (const float*)(ws + WS_FOLDF); const float* b2 = cs + FO_N;
        PH_BEGIN REP(1) {
            const int N = l == 0 ? AB_IN : NSA_INP;
            pg8::StaticOrder S; S.init(MTOK, N, F.G, F.bid);
            if (l == 0) { pg8::Gemm g{HB, (const bf16*)(ws + WS_W_ABIN), MTOK, N, DM}; pg8::EpiBf16<0> E{BIG, N, nullptr, 0, 0, 1.f};
                pg8::gemm_phase<pg8::EpiBf16<0>, pg8::StaticOrder, PG8_ALIGN, PG8_SP2>(F.lds + RING_OFF, g, S, E); }
            else { pg8::Gemm g{Y, (const bf16*)(ws + WS_W_NSAIN), MTOK, N, DM}; pg8::EpiBf16Ln E{BIG, N, RS(2), cs + FO_NSA, b2 + FO_NSA};
                pg8::gemm_phase<pg8::EpiBf16Ln, pg8::StaticOrder, PG8_ALIGN, PG8_SP2>(F.lds + RING_OFF, g, S, E);
                if (r_ == 0) convert_job<CJ_L1A>(F, args, 64, 192); }
        } PH_END
#if STAGE <= 1
        ZERO_OB_PHASE
#else
        if (l == 0) {
            MIXER0_PHASES
        } else {
            MIXER1_PHASES
        }
#endif
        PH_BEGIN REP(2) {
            pg8::Gemm g{Ob, l == 0 ? (const bf16*)(ws + WS_W_ABOUT) : (const bf16*)(ws + WS_W_NSAOUT), MTOK, DM, DM};
            pg8::StaticOrder S; S.init(MTOK, DM, F.G, F.bid);
            if (l == 0) { pg8::EpiRes0 E{Y, HB, DM, DN_ALPHA, RS(0)};
                pg8::gemm_phase<pg8::EpiRes0, pg8::StaticOrder, PG8_ALIGN, PG8_SP2>(F.lds + RING_OFF, g, S, E); }
            else { pg8::EpiResLn2 E{Y, RS(2), LNG(2), LNB(2), DM, DN_ALPHA, RS(3)};
                pg8::gemm_phase<pg8::EpiResLn2, pg8::StaticOrder, PG8_ALIGN, PG8_SP2>(F.lds + RING_OFF, g, S, E); }
        } PH_END
        PH_BEGIN REP(3) {
            {   pg8::Gemm g{Y, (const bf16*)(ws + WS_W_XQ) + (size_t)l * XW * DM, MTOK, XW, DM};
                pg8::RangeOrder S; S.init(MTOK, XW, 0, 128, F.bid);
                pg8::EpiBf16Ln E{XQ, XW, RS(3 * l), cs + FO_XQ + l * XW, b2 + FO_XQ + l * XW};
                pg8::gemm_phase<pg8::EpiBf16Ln, pg8::RangeOrder, PG8_ALIGN, PG8_SP2>(F.lds + RING_OFF, g, S, E); }
            {   pg8::Gemm g{(const bf16*)(ws + WS_MEMB), (const bf16*)(ws + WS_W_XKV) + (size_t)l * 2 * XW * DM, BATCH * NMEM, 2 * XW, DM};
                pg8::RangeOrder S; S.init(BATCH * NMEM, 2 * XW, 128, 8, F.bid);
                pg8::EpiBf16<0> E{(bf16*)(ws + WS_XKV) + (size_t)l * BATCH * NMEM * 2 * XW, 2 * XW, nullptr, 0, 0, 1.f};
                pg8::gemm_phase<pg8::EpiBf16<0>, pg8::RangeOrder, PG8_ALIGN, PG8_SP2>(F.lds + RING_OFF, g, S, E); }
            if (r_ == 0) { if (l == 0) convert_job<CJ_DOWN0>(F, args, 136, 120); else convert_job<CJ_L1B>(F, args, 136, 120); }
        } PH_END
        PH_BEGIN { if (l == 1) fold_finalize(F, FO_UP + DFF2, DFF2); } REP(9) xattn_phase(F, XQ, (const bf16*)(ws + WS_XKV) + (size_t)l * BATCH * NMEM * 2 * XW, XO); PH_END
        PH_BEGIN REP(4) {
            pg8::Gemm g{XO, (const bf16*)(ws + WS_W_XO) + (size_t)l * DM * XW, MTOK, DM, XW};
            pg8::StaticOrder S; S.init(MTOK, DM, F.G, F.bid);
            pg8::EpiResLn2 E{Y, RS(3 * l), LNG(3 * l), LNB(3 * l), DM, DN_ALPHA, RS(3 * l + 1)};
            pg8::gemm_phase<pg8::EpiResLn2, pg8::StaticOrder, PG8_ALIGN, PG8_SP2>(F.lds + RING_OFF, g, S, E);
        } PH_END
        PH_BEGIN REP(5) {
#if (REPMASK >> 22) & 1
            if (r_ > 0) { XcdBarrier bb_ = bar; asm volatile("" : "+s"(bb_.bar), "+s"(bb_.x)); xcd_barrier(bb_); }
#endif
            pg8::Gemm g{Y, (const bf16*)(ws + WS_W_UP) + (size_t)l * DFF2 * DM, MTOK, DFF2, DM};
            pg8::StaticOrder S; S.init(MTOK, DFF2, F.G, F.bid);
            pg8::EpiBf16Ln E{BIG, DFF2, RS(3 * l + 1), cs + FO_UP + l * DFF2, b2 + FO_UP + l * DFF2};
            pg8::gemm_phase<pg8::EpiBf16Ln, pg8::StaticOrder, PG8_ALIGN, PG8_SP2>(F.lds + RING_OFF, g, S, E);
            if (r_ == 0) { if (l == 0) convert_job<CJ_NSA>(F, args, 128, 128); else convert_job<CJ_DOWN1>(F, args, 128, 128); }
        } PH_END
#if (REPMASK >> 20) & 1
        PH_BEGIN {
            pg8::Gemm g{HB, (const bf16*)(ws + WS_W_UP) + (size_t)l * DFF2 * DM, MTOK, DFF2, DM};
            pg8::ZeroOrder S; S.init(MTOK, DFF2, F.G, F.bid);
            pg8::EpiBf16<0> E{Gm, DFF2, nullptr, 0, 0, 1.f};
            pg8::gemm_phase<pg8::EpiBf16<0>, pg8::ZeroOrder, PG8_ALIGN, PG8_SP2>(F.lds + RING_OFF, g, S, E);
        } PH_END
#endif
        PH_BEGIN { if (l == 0) fold_finalize(F, FO_NSA, NSA_INP); } REP(8) convglu_phase(F, BIG, KIN(IN_FFN_CONV) + (size_t)l * 3 * DFF, Gm); PH_END
        PH_BEGIN REP(6) {
            pg8::Gemm g{Gm, (const bf16*)(ws + WS_W_DOWN) + (size_t)l * DM * DFF, MTOK, DM, DFF};
            pg8::StaticOrder S; S.init(MTOK, DM, F.G, F.bid);
            pg8::EpiResLn2 E{Y, RS(3 * l + 1), LNG(3 * l + 1), LNB(3 * l + 1), DM, DN_ALPHA, RS(3 * l + 2)};
            pg8::gemm_phase<pg8::EpiResLn2, pg8::StaticOrder, PG8_ALIGN, PG8_SP2>(F.lds + RING_OFF, g, S, E);
        } PH_END
        if (l == 1) { PH_BEGIN REP(7) ln_phase(F, Y, LNG(5), LNB(5), H32); PH_END }
#undef RS
#undef LNG
#undef LNB
}
__global__ void __launch_bounds__(NTHR, 2) mega_fwd(Args args) {
    extern __shared__ __attribute__((aligned(16))) unsigned char lds_raw[];
    Frame F;
    F.lds = (LAS unsigned char*)lds_raw; F.ws = args.ws;
    F.tid = threadIdx.x; F.lane = F.tid & 63; F.wave = __builtin_amdgcn_readfirstlane(F.tid >> 6); F.G = gridDim.x;
    unsigned char* ws = args.ws;
    gu32* ctl = (gu32*)(ws + WS_CTL);
    for (int u = F.tid; u < (LDS_BYTES - LDSCTL_OFF) / 4; u += NTHR) ((LAS unsigned*)(F.lds + LDSCTL_OFF))[u] = 0u;
    __syncthreads();
    volatile LAS unsigned* MISC = (volatile LAS unsigned*)(F.lds + MISC_OFF);
    XcdBarrier bar = xcd_barrier_post((unsigned*)(ctl + CW_BAR), MISC + 8);
    const int lo = args.ph_lo, hi = args.ph_hi; int pc = 0; unsigned long long tbar_acc = 0ull;
    bf16* HB = (bf16*)(ws + WS_HB); bf16* Y = (bf16*)(ws + WS_Y); float* H32 = (float*)karg()->out;
    bf16* BIG = (bf16*)(ws + WS_BIG); bf16* Gm = (bf16*)(ws + WS_G); bf16* Ob = (bf16*)(ws + WS_O);
    bf16* XQ = (bf16*)(ws + WS_XQ); bf16* XO = (bf16*)(ws + WS_XO);

    PH_BEGIN REP(0) p0_prologue(F, args); PH_END

#if (REPMASK >> 21) & 1
    for (int e_ = 0; e_ < 40; ++e_) { PH_BEGIN PH_END }
#endif
    layer_body<0>(F, args, bar, pc, lo, hi, tbar_acc);
    layer_body<1>(F, args, bar, pc, lo, hi, tbar_acc);
#if (REPMASK >> 23) & 1
#ifndef PROBE_BID
#define PROBE_BID 0
#endif
#if (REPMASK >> 24) & 1
    if (blockIdx.x == 0) { unsigned long long tot_ = 0ull; for (int k_ = 0; k_ < pc; ++k_) { const unsigned v_ = __hip_atomic_load((unsigned*)(args.ws + 3 * MiB) + k_, __ATOMIC_RELAXED, __HIP_MEMORY_SCOPE_AGENT); const unsigned x_ = __hip_atomic_load((unsigned*)(args.ws + 3 * MiB) + 256 + k_, __ATOMIC_RELAXED, __HIP_MEMORY_SCOPE_AGENT);
#ifdef PROBE_SPREAD_MASK
            if (v_ && ((PROBE_SPREAD_MASK >> k_) & 1ull)) tot_ += x_ - (0x7fffffffu - v_);
#else
            if (v_) tot_ += 0x7fffffffu - v_;
#endif
        }
        const unsigned long long t0_ = __builtin_amdgcn_s_memrealtime(); while (__builtin_amdgcn_s_memrealtime() - t0_ < tot_) __builtin_amdgcn_s_sleep(8); }
#else
    if (blockIdx.x == PROBE_BID) { const unsigned long long t0_ = __builtin_amdgcn_s_memrealtime(); while (__builtin_amdgcn_s_memrealtime() - t0_ < tbar_acc) __builtin_amdgcn_s_sleep(8); }
#endif
#endif
}

extern "C" void kernel_launch(void* const* d_in, const int* in_sizes, int n_in, void* d_out, int out_size, void* d_ws, size_t ws_size, hipStream_t stream) {
    static int grid = 0;
    if (grid == 0) {
        if (n_in != 19 || in_sizes[0] != MTOK * DM || out_size != MTOK * DM || ws_size < WS_END) {
            fprintf(stderr, "kernel_launch: shape mismatch n_in %d in0 %d out %d ws %zu (need %zu)\n", n_in, n_in > 0 ? in_sizes[0] : -1, out_size, ws_size, (size_t)WS_END); grid = -1; return; }
        int dev = 0, cus = 0, per_cu = 0;
        if (hipGetDevice(&dev) != hipSuccess || hipDeviceGetAttribute(&cus, hipDeviceAttributeMultiprocessorCount, dev) != hipSuccess) { grid = -1; return; }
        if (hipFuncSetAttribute((const void*)mega_fwd, hipFuncAttributeMaxDynamicSharedMemorySize, LDS_BYTES) != hipSuccess) { fprintf(stderr, "kernel_launch: hipFuncSetAttribute failed\n"); grid = -1; return; }
        if (hipOccupancyMaxActiveBlocksPerMultiprocessor(&per_cu, (const void*)mega_fwd, NTHR, LDS_BYTES) != hipSuccess || per_cu < 1)
            fprintf(stderr, "kernel_launch: note: occupancy query reports %d workgroups per CU\n", per_cu);
        (void)hipGetLastError();
        grid = cus;
        if (grid != 256) { fprintf(stderr, "kernel_launch: built for a 256-CU device (workgroup ranges of the cross-attention and conversion phases); this device reports %d; nothing launched\n", cus); grid = -1; return; }
    }
    if (grid < 0) return;
    if (hipMemsetAsync((char*)d_ws + WS_CTL, 0, CTL_ZERO_BYTES, stream) != hipSuccess) { fprintf(stderr, "kernel_launch: memset failed\n"); return; }
    Args a{};
    for (int i = 0; i < 19; ++i) a.in[i] = (const float*)d_in[i];
    a.out = (float*)d_out; a.ws = (unsigned char*)d_ws; a.ph_lo = 0; a.ph_hi = 1 << 20;
    hipLaunchKernelGGL(mega_fwd, dim3(grid), dim3(NTHR), LDS_BYTES, stream, a);
    const hipError_t le = hipPeekAtLastError();
    if (le != hipSuccess) fprintf(stderr, "kernel_launch: launch failed: %s\n", hipGetErrorName(le));
}
```

```cpp
#include <hip/hip_runtime.h>
#include <cstdio>
#include <cstdint>
namespace pg8 {
#define PG8_LAS __attribute__((address_space(3)))
typedef unsigned short bf16_t;
typedef short bf16x8 __attribute__((ext_vector_type(8)));
typedef float f32x4 __attribute__((ext_vector_type(4)));
typedef unsigned u32x4 __attribute__((ext_vector_type(4)));
constexpr int BM = 256, BK = 64, HALF = 128, HTB = HALF * BK * 2  , STAGE_BYTES = 8 * HTB, NXCD = 8, WGM = 8;

__host__ __device__ __forceinline__ int lds_byte(int r, int c) { const int st = (r >> 4) * 2 + (c >> 5), rr = r & 15, cc = c & 31, ob = rr * 64 + cc * 2; return st * 1024 + (ob ^ (((ob >> 9) & 1) << 5)); }
__host__ __device__ __forceinline__ void stage_rc(int b, int& R, int& C) { const int st = b / 1024, sb = b % 1024, swz = sb ^ (((sb >> 9) & 1) << 5); R = (st >> 1) * 16 + swz / 64; C = (st & 1) * 32 + (swz % 64) / 2; }
__host__ __device__ __forceinline__ int perm32(int rho) { const int n = rho >> 4, i = rho & 15; return 8 * (i >> 2) + 4 * n + (i & 3); }

struct Unit { int pm, pn; };
struct Gemm { const bf16_t* A; const bf16_t* Bt; int M, N, K; };

struct StaticOrder {
    int nM, nN, nwg, G, c;
    __host__ __device__ void init(int M, int N, int G_, int c_) { nM = M / BM; nN = N / BM; nwg = nM * nN; G = G_; c = c_; }
    __host__ __device__ bool next(int i, Unit& u) const {
        const long L = (long)i * G + c; if (L >= nwg) return false;
        int wgid = (int)L; { const int q = nwg / NXCD, r = nwg % NXCD, xcd = wgid % NXCD, off = wgid / NXCD; wgid = (xcd < r ? xcd * (q + 1) : r * (q + 1) + (xcd - r) * q) + off; }
        const int nig = WGM * nN, gid = wgid / nig, fm = gid * WGM, gsz = (nM - fm) < WGM ? (nM - fm) : WGM;
        u.pm = fm + ((wgid % nig) % gsz); u.pn = (wgid % nig) / gsz; return true;
    }
    __device__ __forceinline__ void a_ready(const Unit&) const {}
    __device__ __forceinline__ void done(const Unit&) const {}
};

__device__ __forceinline__ unsigned cvt_pk_bf16(float lo, float hi) { unsigned r; asm volatile("v_cvt_pk_bf16_f32 %0, %1, %2" : "=v"(r) : "v"(lo), "v"(hi)); return r; }
typedef float f32x2 __attribute__((ext_vector_type(2)));
__device__ __forceinline__ f32x2 gelu_pk(f32x2 v) {
    const f32x2 av = __builtin_elementwise_abs(v), d = av * 0.2316418882f + 1.0f;
    f32x2 t; t.x = __builtin_amdgcn_rcpf(d.x); t.y = __builtin_amdgcn_rcpf(d.y);
    f32x2 q = t * 0.5307027145f + (-0.7265760135f); q = q * t + 0.7107068705f; q = q * t + (-0.142248368f); q = q * t + 0.127414796f; q = q * t;
    const f32x2 s = (v * v) * (-0.72134752044f);
    f32x2 e; e.x = __builtin_amdgcn_exp2f(s.x); e.y = __builtin_amdgcn_exp2f(s.y);
    const f32x2 m = v * (q * e), r = v - m;
    f32x2 o; o.x = v.x < 0.f ? m.x : r.x; o.y = v.y < 0.f ? m.y : r.y; return o;
}

template <int ACT  > struct EpiBf16 {
    static constexpr bool PERM = true, AFTER_DRAIN = false; static_assert(ACT == 0 || ACT == 1, "EpiBf16: ACT is 0 (none) or 1 (gelu_pk)");
    bf16_t* O; int ldc; const float* bias; int split_cols; size_t split_stride; float scale0;
    __device__ __forceinline__ void operator()(const f32x4 (&acc)[2][2][4][2], const Unit& u, int wr, int wc, int fr, int fq) const {
        const int row0 = u.pm * BM + wr * 64 + fr; int colt = u.pn * BM; bf16_t* base = O;
        float sc = 1.f; if (split_cols) { const int t = colt / split_cols; base += (size_t)t * split_stride; colt -= t * split_cols; if (t == 0) sc = scale0; }
        const int col0 = colt + wc * 32 + 8 * fq, bcol0 = u.pn * BM + wc * 32 + 8 * fq;
        f32x4 bv[2][2];
#pragma unroll
        for (int bj = 0; bj < 2; ++bj)
#pragma unroll
            for (int n = 0; n < 2; ++n) bv[bj][n] = bias ? *(const f32x4*)(bias + bcol0 + bj * HALF + 4 * n) : (f32x4){0.f, 0.f, 0.f, 0.f};
#pragma unroll
        for (int ai = 0; ai < 2; ++ai)
#pragma unroll
            for (int m = 0; m < 4; ++m) { bf16_t* rowp = base + (size_t)(row0 + ai * HALF + m * 16) * ldc + col0;
#pragma unroll
                for (int bj = 0; bj < 2; ++bj) { f32x4 v0 = acc[ai][bj][m][0] + bv[bj][0], v1 = acc[ai][bj][m][1] + bv[bj][1];
                    if (ACT == 1) { f32x2 a = gelu_pk((f32x2){v0[0], v0[1]}), b = gelu_pk((f32x2){v0[2], v0[3]}), c = gelu_pk((f32x2){v1[0], v1[1]}), d = gelu_pk((f32x2){v1[2], v1[3]});
                        v0 = (f32x4){a.x, a.y, b.x, b.y}; v1 = (f32x4){c.x, c.y, d.x, d.y}; }
                    v0 = v0 * sc; v1 = v1 * sc; u32x4 w; w.x = cvt_pk_bf16(v0[0], v0[1]); w.y = cvt_pk_bf16(v0[2], v0[3]); w.z = cvt_pk_bf16(v1[0], v1[1]); w.w = cvt_pk_bf16(v1[2], v1[3]);
                    *(u32x4*)(rowp + bj * HALF) = w; } }
    }
};


struct EpiRes {
    static constexpr bool PERM = false, AFTER_DRAIN = false;
    float* Y; const float* res; int ldc; float alpha;
    __device__ __forceinline__ void operator()(const f32x4 (&acc)[2][2][4][2], const Unit& u, int wr, int wc, int fr, int fq) const {
        const int row0 = u.pm * BM + wr * 64 + fr, col0 = u.pn * BM + wc * 32 + 4 * fq;
#pragma unroll
        for (int ai = 0; ai < 2; ++ai)
#pragma unroll
            for (int m = 0; m < 4; ++m) { const size_t off = (size_t)(row0 + ai * HALF + m * 16) * ldc + col0;
#pragma unroll
                for (int bj = 0; bj < 2; ++bj)
#pragma unroll
                    for (int n = 0; n < 2; ++n) { const f32x4 r = *(const f32x4*)(res + off + bj * HALF + n * 16);
                        *(f32x4*)(Y + off + bj * HALF + n * 16) = r * alpha + acc[ai][bj][m][n]; } }
    }
};
struct RangeOrder {
    int nM, nN, ntot, c0, nw, c;
    __host__ __device__ void init(int M, int N, int c0_, int nw_, int c_) { nM = M / BM; nN = N / BM; ntot = nM * nN; c0 = c0_; nw = nw_; c = c_; }
    __host__ __device__ bool next(int i, Unit& u) const {
        if (c < c0 || c >= c0 + nw) return false;
        const int L = i * nw + (c - c0); if (L >= ntot) return false;
        u.pm = L / nN; u.pn = L % nN; return true;
    }
    __device__ __forceinline__ void a_ready(const Unit&) const {}
    __device__ __forceinline__ void done(const Unit&) const {}
};

struct ZeroOrder : StaticOrder {
    __host__ __device__ bool next(int i, Unit& u) const { const bool r = StaticOrder::next(i, u); u.pm = 0; u.pn = 0; return r; }
};

struct EpiResBf {
    static constexpr bool PERM = true, AFTER_DRAIN = false;
    bf16_t* Y; const bf16_t* res; int ldc; float alpha;
    __device__ __forceinline__ void operator()(const f32x4 (&acc)[2][2][4][2], const Unit& u, int wr, int wc, int fr, int fq) const {
        const int row0 = u.pm * BM + wr * 64 + fr, col0 = u.pn * BM + wc * 32 + 8 * fq;
#pragma unroll
        for (int ai = 0; ai < 2; ++ai)
#pragma unroll
            for (int m = 0; m < 4; ++m) { const size_t off = (size_t)(row0 + ai * HALF + m * 16) * ldc + col0;
#pragma unroll
                for (int bj = 0; bj < 2; ++bj) { const u32x4 r = *(const u32x4*)(res + off + bj * HALF);
                    const f32x4 v0 = acc[ai][bj][m][0], v1 = acc[ai][bj][m][1];
                    u32x4 w;
                    w.x = cvt_pk_bf16(__builtin_bit_cast(float, r.x << 16) * alpha + v0[0], __builtin_bit_cast(float, r.x & 0xffff0000u) * alpha + v0[1]);
                    w.y = cvt_pk_bf16(__builtin_bit_cast(float, r.y << 16) * alpha + v0[2], __builtin_bit_cast(float, r.y & 0xffff0000u) * alpha + v0[3]);
                    w.z = cvt_pk_bf16(__builtin_bit_cast(float, r.z << 16) * alpha + v1[0], __builtin_bit_cast(float, r.z & 0xffff0000u) * alpha + v1[1]);
                    w.w = cvt_pk_bf16(__builtin_bit_cast(float, r.w << 16) * alpha + v1[2], __builtin_bit_cast(float, r.w & 0xffff0000u) * alpha + v1[3]);
                    *(u32x4*)(Y + off + bj * HALF) = w; } }
    }
};

struct EpiResF {
    static constexpr bool PERM = true, AFTER_DRAIN = false;
    float* Y; const bf16_t* res; int ldc; float alpha;
    __device__ __forceinline__ void operator()(const f32x4 (&acc)[2][2][4][2], const Unit& u, int wr, int wc, int fr, int fq) const {
        const int row0 = u.pm * BM + wr * 64 + fr, col0 = u.pn * BM + wc * 32 + 8 * fq;
#pragma unroll
        for (int ai = 0; ai < 2; ++ai)
#pragma unroll
            for (int m = 0; m < 4; ++m) { const size_t off = (size_t)(row0 + ai * HALF + m * 16) * ldc + col0;
#pragma unroll
                for (int bj = 0; bj < 2; ++bj) { const u32x4 r = *(const u32x4*)(res + off + bj * HALF);
                    f32x4 o0, o1;
                    o0[0] = __builtin_bit_cast(float, r.x << 16); o0[1] = __builtin_bit_cast(float, r.x & 0xffff0000u); o0[2] = __builtin_bit_cast(float, r.y << 16); o0[3] = __builtin_bit_cast(float, r.y & 0xffff0000u);
                    o1[0] = __builtin_bit_cast(float, r.z << 16); o1[1] = __builtin_bit_cast(float, r.z & 0xffff0000u); o1[2] = __builtin_bit_cast(float, r.w << 16); o1[3] = __builtin_bit_cast(float, r.w & 0xffff0000u);
                    *(f32x4*)(Y + off + bj * HALF) = o0 * alpha + acc[ai][bj][m][0]; *(f32x4*)(Y + off + bj * HALF + 4) = o1 * alpha + acc[ai][bj][m][1]; } }
    }
};

struct EpiResLn {
    static constexpr bool PERM = true, AFTER_DRAIN = false;
    bf16_t* Y; const float* stats; const float* g; const float* b; int ldc; float alpha;
    __device__ __forceinline__ void operator()(const f32x4 (&acc)[2][2][4][2], const Unit& u, int wr, int wc, int fr, int fq) const {
        const int row0 = u.pm * BM + wr * 64 + fr, col0 = u.pn * BM + wc * 32 + 8 * fq;
        f32x4 gv[2][2], bv[2][2];
#pragma unroll
        for (int bj = 0; bj < 2; ++bj)
#pragma unroll
            for (int n = 0; n < 2; ++n) { gv[bj][n] = *(const f32x4*)(g + col0 + bj * HALF + 4 * n) * alpha; bv[bj][n] = *(const f32x4*)(b + col0 + bj * HALF + 4 * n) * alpha; }
#pragma unroll
        for (int ai = 0; ai < 2; ++ai)
#pragma unroll
            for (int m = 0; m < 4; ++m) { const int row = row0 + ai * HALF + m * 16; const size_t off = (size_t)row * ldc + col0;
                const float mean = stats[2 * row], rstd = stats[2 * row + 1];
#pragma unroll
                for (int bj = 0; bj < 2; ++bj) { const u32x4 r = *(const u32x4*)(Y + off + bj * HALF);
                    f32x4 y0, y1;
                    y0[0] = __builtin_bit_cast(float, r.x << 16); y0[1] = __builtin_bit_cast(float, r.x & 0xffff0000u); y0[2] = __builtin_bit_cast(float, r.y << 16); y0[3] = __builtin_bit_cast(float, r.y & 0xffff0000u);
                    y1[0] = __builtin_bit_cast(float, r.z << 16); y1[1] = __builtin_bit_cast(float, r.z & 0xffff0000u); y1[2] = __builtin_bit_cast(float, r.w << 16); y1[3] = __builtin_bit_cast(float, r.w & 0xffff0000u);
                    const f32x4 o0 = (y0 - mean) * rstd * gv[bj][0] + bv[bj][0] + acc[ai][bj][m][0], o1 = (y1 - mean) * rstd * gv[bj][1] + bv[bj][1] + acc[ai][bj][m][1];
                    u32x4 w; w.x = cvt_pk_bf16(o0[0], o0[1]); w.y = cvt_pk_bf16(o0[2], o0[3]); w.z = cvt_pk_bf16(o1[0], o1[1]); w.w = cvt_pk_bf16(o1[2], o1[3]);
                    *(u32x4*)(Y + off + bj * HALF) = w; } }
    }
};

constexpr float RS_SCALE = 1048576.0f, RS_INV = 1.0f / 1048576.0f;
__device__ __forceinline__ float fx20_to_f(long long v) { return (float)(int)(v >> 20) + (float)((unsigned)v & 0xFFFFFu) * RS_INV; }
__device__ __forceinline__ long long f_to_fx20(float s) { const float fl = floorf(s); return ((long long)(int)fl << 20) + (long long)(unsigned)((s - fl) * RS_SCALE + 0.5f); }
__device__ __forceinline__ void row_stats(const long long* rs, int row, float& mean, float& rstd) {
    const long long a = rs[2 * (size_t)row], b = rs[2 * (size_t)row + 1];
    mean = fx20_to_f(a) * (1.0f / 4096.0f); const float var = fx20_to_f(b) * (1.0f / 4096.0f) - mean * mean; rstd = 1.0f / sqrtf(var + 1e-5f);
}
constexpr float FOLD_SCALE = 4294967296.0f, FOLD_INV = 1.0f / 4294967296.0f;
struct EpiBf16Ln {
    static constexpr bool PERM = true, AFTER_DRAIN = false;
    bf16_t* O; int ldc; const long long* rs; const float* cs; const float* b2;
    __device__ __forceinline__ void operator()(const f32x4 (&acc)[2][2][4][2], const Unit& u, int wr, int wc, int fr, int fq) const {
        const int row0 = u.pm * BM + wr * 64 + fr, col0 = u.pn * BM + wc * 32 + 8 * fq;
        f32x4 cv[2][2], bv[2][2];
#pragma unroll
        for (int bj = 0; bj < 2; ++bj)
#pragma unroll
            for (int n = 0; n < 2; ++n) { cv[bj][n] = *(const f32x4*)(cs + col0 + bj * HALF + 4 * n); bv[bj][n] = *(const f32x4*)(b2 + col0 + bj * HALF + 4 * n); }
#pragma unroll
        for (int ai = 0; ai < 2; ++ai)
#pragma unroll
            for (int m = 0; m < 4; ++m) { const int row = row0 + ai * HALF + m * 16; float mean, rstd; row_stats(rs, row, mean, rstd);
                bf16_t* rowp = O + (size_t)row * ldc + col0;
#pragma unroll
                for (int bj = 0; bj < 2; ++bj) { const f32x4 v0 = (acc[ai][bj][m][0] - cv[bj][0] * mean) * rstd + bv[bj][0], v1 = (acc[ai][bj][m][1] - cv[bj][1] * mean) * rstd + bv[bj][1];
                    u32x4 w; w.x = cvt_pk_bf16(v0[0], v0[1]); w.y = cvt_pk_bf16(v0[2], v0[3]); w.z = cvt_pk_bf16(v1[0], v1[1]); w.w = cvt_pk_bf16(v1[2], v1[3]);
                    *(u32x4*)(rowp + bj * HALF) = w; } }
    }
};
__device__ __forceinline__ void row_sums_add(long long* rso, int row, const f32x4& a, const f32x4& b, const f32x4& c, const f32x4& d, int fq) {
    float s1 = ((a[0] + a[1]) + (a[2] + a[3])) + ((b[0] + b[1]) + (b[2] + b[3])) + ((c[0] + c[1]) + (c[2] + c[3])) + ((d[0] + d[1]) + (d[2] + d[3]));
    float s2 = ((a[0] * a[0] + a[1] * a[1]) + (a[2] * a[2] + a[3] * a[3])) + ((b[0] * b[0] + b[1] * b[1]) + (b[2] * b[2] + b[3] * b[3]))
             + ((c[0] * c[0] + c[1] * c[1]) + (c[2] * c[2] + c[3] * c[3])) + ((d[0] * d[0] + d[1] * d[1]) + (d[2] * d[2] + d[3] * d[3]));
    s1 += __shfl_xor(s1, 16); s1 += __shfl_xor(s1, 32); s2 += __shfl_xor(s2, 16); s2 += __shfl_xor(s2, 32);
    if (fq == 0) { atomicAdd((unsigned long long*)(rso + 2 * (size_t)row), (unsigned long long)f_to_fx20(s1)); atomicAdd((unsigned long long*)(rso + 2 * (size_t)row + 1), (unsigned long long)f_to_fx20(s2)); }
}
struct EpiRes0 {
    static constexpr bool PERM = true, AFTER_DRAIN = false;
    bf16_t* Y; const bf16_t* res; int ldc; float alpha; long long* rso;
    __device__ __forceinline__ void operator()(const f32x4 (&acc)[2][2][4][2], const Unit& u, int wr, int wc, int fr, int fq) const {
        const int row0 = u.pm * BM + wr * 64 + fr, col0 = u.pn * BM + wc * 32 + 8 * fq;
#pragma unroll
        for (int ai = 0; ai < 2; ++ai)
#pragma unroll
            for (int m = 0; m < 4; ++m) { const int row = row0 + ai * HALF + m * 16; const size_t off = (size_t)row * ldc + col0; f32x4 o[2][2];
#pragma unroll
                for (int bj = 0; bj < 2; ++bj) { const u32x4 r = *(const u32x4*)(res + off + bj * HALF);
                    f32x4 y0, y1;
                    y0[0] = __builtin_bit_cast(float, r.x << 16); y0[1] = __builtin_bit_cast(float, r.x & 0xffff0000u); y0[2] = __builtin_bit_cast(float, r.y << 16); y0[3] = __builtin_bit_cast(float, r.y & 0xffff0000u);
                    y1[0] = __builtin_bit_cast(float, r.z << 16); y1[1] = __builtin_bit_cast(float, r.z & 0xffff0000u); y1[2] = __builtin_bit_cast(float, r.w << 16); y1[3] = __builtin_bit_cast(float, r.w & 0xffff0000u);
                    o[bj][0] = y0 * alpha + acc[ai][bj][m][0]; o[bj][1] = y1 * alpha + acc[ai][bj][m][1];
                    u32x4 w; w.x = cvt_pk_bf16(o[bj][0][0], o[bj][0][1]); w.y = cvt_pk_bf16(o[bj][0][2], o[bj][0][3]); w.z = cvt_pk_bf16(o[bj][1][0], o[bj][1][1]); w.w = cvt_pk_bf16(o[bj][1][2], o[bj][1][3]);
                    *(u32x4*)(Y + off + bj * HALF) = w; }
                row_sums_add(rso, row, o[0][0], o[0][1], o[1][0], o[1][1], fq); }
    }
};
struct EpiResLn2 {
    static constexpr bool PERM = true, AFTER_DRAIN = false;
    bf16_t* Y; const long long* rsi; const float* g; const float* b; int ldc; float alpha; long long* rso;
    __device__ __forceinline__ void operator()(const f32x4 (&acc)[2][2][4][2], const Unit& u, int wr, int wc, int fr, int fq) const {
        const int row0 = u.pm * BM + wr * 64 + fr, col0 = u.pn * BM + wc * 32 + 8 * fq;
        f32x4 gv[2][2], bv[2][2];
#pragma unroll
        for (int bj = 0; bj < 2; ++bj)
#pragma unroll
            for (int n = 0; n < 2; ++n) { gv[bj][n] = *(const f32x4*)(g + col0 + bj * HALF + 4 * n) * alpha; bv[bj][n] = *(const f32x4*)(b + col0 + bj * HALF + 4 * n) * alpha; }
#pragma unroll
        for (int ai = 0; ai < 2; ++ai)
#pragma unroll
            for (int m = 0; m < 4; ++m) { const int row = row0 + ai * HALF + m * 16; const size_t off = (size_t)row * ldc + col0; float mean, rstd; row_stats(rsi, row, mean, rstd); f32x4 o[2][2];
#pragma unroll
                for (int bj = 0; bj < 2; ++bj) { const u32x4 r = *(const u32x4*)(Y + off + bj * HALF);
                    f32x4 y0, y1;
                    y0[0] = __builtin_bit_cast(float, r.x << 16); y0[1] = __builtin_bit_cast(float, r.x & 0xffff0000u); y0[2] = __builtin_bit_cast(float, r.y << 16); y0[3] = __builtin_bit_cast(float, r.y & 0xffff0000u);
                    y1[0] = __builtin_bit_cast(float, r.z << 16); y1[1] = __builtin_bit_cast(float, r.z & 0xffff0000u); y1[2] = __builtin_bit_cast(float, r.w << 16); y1[3] = __builtin_bit_cast(float, r.w & 0xffff0000u);
                    o[bj][0] = (y0 - mean) * rstd * gv[bj][0] + bv[bj][0] + acc[ai][bj][m][0]; o[bj][1] = (y1 - mean) * rstd * gv[bj][1] + bv[bj][1] + acc[ai][bj][m][1];
                    u32x4 w; w.x = cvt_pk_bf16(o[bj][0][0], o[bj][0][1]); w.y = cvt_pk_bf16(o[bj][0][2], o[bj][0][3]); w.z = cvt_pk_bf16(o[bj][1][0], o[bj][1][1]); w.w = cvt_pk_bf16(o[bj][1][2], o[bj][1][3]);
                    *(u32x4*)(Y + off + bj * HALF) = w; }
                row_sums_add(rso, row, o[0][0], o[0][1], o[1][0], o[1][1], fq); }
    }
};

struct EpiBf16LnTok {
    static constexpr bool PERM = true, AFTER_DRAIN = false, AROWPERM = true;
    bf16_t* O; int ldc; const long long* rs; const float* cs; const float* b2;
    __device__ __forceinline__ void operator()(const f32x4 (&acc)[2][2][4][2], const Unit& u, int wr, int wc, int fr, int fq) const {
        const int row0 = u.pm * BM + 128 * wr + 8 * fr, col0 = u.pn * BM + wc * 32 + 8 * fq;
        f32x4 cv[2][2], bv[2][2];
#pragma unroll
        for (int bj = 0; bj < 2; ++bj)
#pragma unroll
            for (int n = 0; n < 2; ++n) { cv[bj][n] = *(const f32x4*)(cs + col0 + bj * HALF + 4 * n); bv[bj][n] = *(const f32x4*)(b2 + col0 + bj * HALF + 4 * n); }
#pragma unroll
        for (int ai = 0; ai < 2; ++ai)
#pragma unroll
            for (int m = 0; m < 4; ++m) { const int row = row0 + 4 * ai + m; float mean, rstd; row_stats(rs, row, mean, rstd);
                bf16_t* rowp = O + (size_t)row * ldc + col0;
#pragma unroll
                for (int bj = 0; bj < 2; ++bj) { const f32x4 v0 = (acc[ai][bj][m][0] - cv[bj][0] * mean) * rstd + bv[bj][0], v1 = (acc[ai][bj][m][1] - cv[bj][1] * mean) * rstd + bv[bj][1];
                    u32x4 w; w.x = cvt_pk_bf16(v0[0], v0[1]); w.y = cvt_pk_bf16(v0[2], v0[3]); w.z = cvt_pk_bf16(v1[0], v1[1]); w.w = cvt_pk_bf16(v1[2], v1[3]);
                    *(u32x4*)(rowp + bj * HALF) = w; } }
    }
};

__device__ __forceinline__ float dpp_shr1(float x) { return __builtin_bit_cast(float, __builtin_amdgcn_update_dpp(0, __builtin_bit_cast(int, x), 0x111, 0xf, 0xf, true)); }
struct EpiConvGlu {
    static constexpr bool PERM = true, AFTER_DRAIN = false, AROWPERM = true;
    bf16_t* G; bf16_t* side; const long long* rs; const float* cs; const float* b2; const float* cw; int dff;
    __device__ __forceinline__ void operator()(const f32x4 (&acc)[2][2][4][2], const Unit& u, int wr, int wc, int fr, int fq) const {
        const int row0 = u.pm * BM + 128 * wr + 8 * fr, colg = u.pn * BM + wc * 32 + 8 * fq, ch0 = u.pn * HALF + wc * 32 + 8 * fq;
        float mean_[8], rstd_[8];
#pragma unroll
        for (int j = 0; j < 8; ++j) row_stats(rs, row0 + j, mean_[j], rstd_[j]);
        unsigned gout[8][4];
        const int bnd = row0 >> 7;
#pragma unroll
        for (int n = 0; n < 2; ++n) {
            const f32x4 ca = *(const f32x4*)(cs + colg + 4 * n), ba = *(const f32x4*)(b2 + colg + 4 * n), cu = *(const f32x4*)(cs + colg + HALF + 4 * n), bu = *(const f32x4*)(b2 + colg + HALF + 4 * n);
            const f32x4 w0 = *(const f32x4*)(cw + ch0 + 4 * n), w1 = *(const f32x4*)(cw + dff + ch0 + 4 * n), w2 = *(const f32x4*)(cw + 2 * dff + ch0 + 4 * n);
            f32x4 a[8], uu[8];
#pragma unroll
            for (int j = 0; j < 8; ++j) { a[j] = (acc[j >> 2][0][j & 3][n] - ca * mean_[j]) * rstd_[j] + ba; uu[j] = (acc[j >> 2][1][j & 3][n] - cu * mean_[j]) * rstd_[j] + bu; }
            f32x4 p6, p7;
#pragma unroll
            for (int q = 0; q < 4; ++q) { p6[q] = dpp_shr1(a[6][q]); p7[q] = dpp_shr1(a[7][q]); }
            if (fr == 15 && bnd + 1 < 128) { bf16_t* sp = side + ((size_t)(bnd + 1) * 6) * dff + ch0 + 4 * n;
                *(unsigned long long*)(sp) = (unsigned long long)cvt_pk_bf16(a[6][0], a[6][1]) | ((unsigned long long)cvt_pk_bf16(a[6][2], a[6][3]) << 32);
                *(unsigned long long*)(sp + dff) = (unsigned long long)cvt_pk_bf16(a[7][0], a[7][1]) | ((unsigned long long)cvt_pk_bf16(a[7][2], a[7][3]) << 32); }
            if (fr == 0) { bf16_t* sp = side + ((size_t)bnd * 6 + 2) * dff + ch0 + 4 * n;
                *(unsigned long long*)(sp) = (unsigned long long)cvt_pk_bf16(a[0][0], a[0][1]) | ((unsigned long long)cvt_pk_bf16(a[0][2], a[0][3]) << 32);
                *(unsigned long long*)(sp + dff) = (unsigned long long)cvt_pk_bf16(a[1][0], a[1][1]) | ((unsigned long long)cvt_pk_bf16(a[1][2], a[1][3]) << 32);
                *(unsigned long long*)(sp + 2 * dff) = (unsigned long long)cvt_pk_bf16(uu[0][0], uu[0][1]) | ((unsigned long long)cvt_pk_bf16(uu[0][2], uu[0][3]) << 32);
                *(unsigned long long*)(sp + 3 * dff) = (unsigned long long)cvt_pk_bf16(uu[1][0], uu[1][1]) | ((unsigned long long)cvt_pk_bf16(uu[1][2], uu[1][3]) << 32); }
#pragma unroll
            for (int j = 0; j < 8; ++j) { const f32x4 am1 = (j == 0) ? p7 : a[j ? j - 1 : 0], am2 = (j == 0) ? p6 : (j == 1 ? p7 : a[j > 1 ? j - 2 : 0]);
                const f32x4 c = w2 * a[j] + w1 * am1 + w0 * am2;
                const f32x2 g01 = gelu_pk((f32x2){c[0], c[1]}), g23 = gelu_pk((f32x2){c[2], c[3]});
                gout[j][2 * n] = cvt_pk_bf16(g01.x * uu[j][0], g01.y * uu[j][1]); gout[j][2 * n + 1] = cvt_pk_bf16(g23.x * uu[j][2], g23.y * uu[j][3]); }
        }
#pragma unroll
        for (int j = 0; j < 8; ++j) if (!(fr == 0 && j < 2)) { u32x4 w; w.x = gout[j][0]; w.y = gout[j][1]; w.z = gout[j][2]; w.w = gout[j][3]; *(u32x4*)(G + (size_t)(row0 + j) * dff + ch0) = w; }
    }
};
template <class E, class = void> struct arowperm_v { static constexpr bool value = false; };
template <class E> struct arowperm_v<E, decltype((void)E::AROWPERM)> { static constexpr bool value = E::AROWPERM; };
template <class Epi, class Sched, bool ALIGN_EPI = false, bool SP2 = false>
__device__ __forceinline__ void gemm_phase(PG8_LAS unsigned char* lds, const Gemm g, const Sched& S, const Epi& E) {
    int tid_l = threadIdx.x; asm volatile("" : "+v"(tid_l)); const int tid = tid_l, wid = __builtin_amdgcn_readfirstlane(tid >> 6), lane = tid & 63, wr = wid >> 2, wc = wid & 3, fr = lane & 15, fq = lane >> 4;
    const int K = g.K, nt = K / BK;
    unsigned voffA[2], voffB[2];
#pragma unroll
    for (int i = 0; i < 2; ++i) { int R, C; stage_rc(tid * 16 + i * 8192, R, C); const int Rb = Epi::PERM ? ((R & ~31) + perm32(R & 31)) : R;
        const int Ra = arowperm_v<Epi>::value ? (128 * (R >> 6) + 8 * (R & 15) + ((R >> 4) & 3)) : R;
        voffA[i] = (unsigned)(Ra * K + C) * 2u; voffB[i] = (unsigned)(Rb * K + C) * 2u; }
    const size_t hstepA = arowperm_v<Epi>::value ? (size_t)4 * K * 2 : (size_t)HALF * K * 2;
    const size_t kstep = (size_t)(BK * 2);
    const size_t hstep = (size_t)HALF * K * 2;
    const size_t tstep = 2 * hstep;
    const unsigned ldsw = (unsigned)wid * 1024u;
    const int aoff = lds_byte(wr * 64 + fr, fq * 8), boff = lds_byte(wc * 32 + fr, fq * 8);
#define PG8_SA(b, h) (((b) * 2 + (h)) * HTB)
#define PG8_SB(b, h) ((4 + (b) * 2 + (h)) * HTB)
#define PG8_STAGE(bufoff, gbase, voff) do { _Pragma("unroll") for (int _i = 0; _i < 2; ++_i) \
        __builtin_amdgcn_global_load_lds((const unsigned*)((const char*)(gbase) + (voff)[_i]), (PG8_LAS unsigned*)(lds + (bufoff) + ldsw + _i * 8192), 16, 0, 0); } while (0)
#define PG8_LDA(dst, b, h) do { _Pragma("unroll") for (int m = 0; m < 4; ++m) _Pragma("unroll") for (int k = 0; k < 2; ++k) dst[m][k] = *(const PG8_LAS bf16x8*)(lds + PG8_SA(b, h) + aoff + m * 2048 + k * 1024); } while (0)
#define PG8_LDB(dst, b, h) do { _Pragma("unroll") for (int n = 0; n < 2; ++n) _Pragma("unroll") for (int k = 0; k < 2; ++k) dst[n][k] = *(const PG8_LAS bf16x8*)(lds + PG8_SB(b, h) + boff + n * 2048 + k * 1024); } while (0)
#define PG8_MMA(ai, bj, At, Bt) do { __builtin_amdgcn_s_setprio(1); _Pragma("unroll") for (int m = 0; m < 4; ++m) _Pragma("unroll") for (int n = 0; n < 2; ++n) _Pragma("unroll") for (int k = 0; k < 2; ++k) \
        acc[ai][bj][m][n] = __builtin_amdgcn_mfma_f32_16x16x32_bf16(Bt[n][k], At[m][k], acc[ai][bj][m][n], 0, 0, 0); __builtin_amdgcn_s_setprio(0); } while (0)
#define PG8_WAIT_V(n) asm volatile("s_waitcnt vmcnt(" #n ")" ::: "memory")
#define PG8_WAIT_L(n) asm volatile("s_waitcnt lgkmcnt(" #n ")" ::: "memory")
#define PG8_BAR __builtin_amdgcn_s_barrier()
#define PG8_SCHED __builtin_amdgcn_sched_barrier(0)
    Unit cur, nxt; int ui = 0;
    if (!S.next(0, cur)) return;
    f32x4 acc[2][2][4][2];
#pragma unroll
    for (int a = 0; a < 2; ++a)
#pragma unroll
        for (int b = 0; b < 2; ++b)
#pragma unroll
            for (int m = 0; m < 4; ++m)
#pragma unroll
                for (int n = 0; n < 2; ++n) acc[a][b][m][n] = (f32x4){0.f, 0.f, 0.f, 0.f};
    bf16x8 At[4][2], B0[2][2], B1[2][2];
    const char* cA = (const char*)g.A + (size_t)cur.pm * tstep; const char* cB = (const char*)g.Bt + (size_t)cur.pn * tstep;
    S.a_ready(cur);
    if constexpr (SP2) {
        PG8_STAGE(PG8_SB(0, 0), cB, voffB); PG8_STAGE(PG8_SB(0, 1), cB + hstep, voffB); PG8_STAGE(PG8_SA(0, 0), cA, voffA); PG8_STAGE(PG8_SA(0, 1), cA + hstepA, voffA);
        if (wr == 1) PG8_BAR;
        PG8_WAIT_V(2); PG8_BAR;
        PG8_STAGE(PG8_SB(1, 0), cB + kstep, voffB); PG8_STAGE(PG8_SA(1, 0), cA + kstep, voffA); PG8_STAGE(PG8_SB(1, 1), cB + hstep + kstep, voffB);
        PG8_WAIT_V(6); PG8_BAR;
    } else {
        PG8_STAGE(PG8_SB(0, 0), cB, voffB); PG8_STAGE(PG8_SA(0, 0), cA, voffA); PG8_STAGE(PG8_SB(0, 1), cB + hstep, voffB); PG8_STAGE(PG8_SA(0, 1), cA + hstepA, voffA);
        if (wr == 1) PG8_BAR;
        PG8_WAIT_V(4); PG8_BAR;
        PG8_STAGE(PG8_SB(1, 0), cB + kstep, voffB); PG8_STAGE(PG8_SA(1, 0), cA + kstep, voffA); PG8_STAGE(PG8_SB(1, 1), cB + hstep + kstep, voffB);
        PG8_WAIT_V(6); PG8_BAR;
    }
    for (;;) {
        const bool has_next = S.next(ui + 1, nxt);
        const char* nA = has_next ? (const char*)g.A + (size_t)nxt.pm * tstep : cA; const char* nB = has_next ? (const char*)g.Bt + (size_t)nxt.pn * tstep : cB;
        for (int t = 0; t < nt; t += 2) {
            const bool last = (t == nt - 2);
            const char* a1 = cA + (size_t)(t + 1) * kstep;
            const char* a2 = last ? nA : cA + (size_t)(t + 2) * kstep; const char* b2 = last ? nB : cB + (size_t)(t + 2) * kstep;
            const char* a3 = a2 + kstep; const char* b3 = b2 + kstep;
            if (last && has_next) S.a_ready(nxt);
            if constexpr (SP2) {
            PG8_LDB(B0, 0, 0); PG8_LDB(B1, 0, 1); PG8_SCHED; PG8_LDA(At, 0, 0); PG8_STAGE(PG8_SA(1, 1), a1 + hstepA, voffA);
            PG8_WAIT_V(8); PG8_WAIT_L(0); PG8_BAR; PG8_MMA(0, 0, At, B0); PG8_MMA(0, 1, At, B1); PG8_BAR; PG8_SCHED;
            PG8_LDA(At, 0, 1); PG8_STAGE(PG8_SB(0, 0), b2, voffB); PG8_STAGE(PG8_SB(0, 1), b2 + hstep, voffB); PG8_STAGE(PG8_SA(0, 0), a2, voffA);
            PG8_WAIT_V(8); PG8_WAIT_L(0); PG8_BAR; PG8_MMA(1, 0, At, B0); PG8_MMA(1, 1, At, B1); PG8_BAR; PG8_SCHED;
            PG8_LDB(B0, 1, 0); PG8_LDB(B1, 1, 1); PG8_SCHED; PG8_LDA(At, 1, 0); PG8_STAGE(PG8_SA(0, 1), a2 + hstepA, voffA);
            PG8_WAIT_V(8); PG8_WAIT_L(0); PG8_BAR; PG8_MMA(0, 0, At, B0); PG8_MMA(0, 1, At, B1); PG8_BAR; PG8_SCHED;
            PG8_LDA(At, 1, 1); PG8_STAGE(PG8_SB(1, 0), b3, voffB); PG8_STAGE(PG8_SB(1, 1), b3 + hstep, voffB); PG8_STAGE(PG8_SA(1, 0), a3, voffA);
            PG8_WAIT_V(8); PG8_WAIT_L(0); PG8_BAR; PG8_MMA(1, 0, At, B0); PG8_MMA(1, 1, At, B1); PG8_BAR; PG8_SCHED;
            } else {
            PG8_LDB(B0, 0, 0); PG8_SCHED; PG8_LDA(At, 0, 0); PG8_STAGE(PG8_SA(1, 1), a1 + hstepA, voffA);
            PG8_WAIT_L(8); PG8_BAR; PG8_WAIT_L(0); PG8_MMA(0, 0, At, B0); PG8_BAR; PG8_SCHED;
            PG8_LDB(B1, 0, 1); PG8_STAGE(PG8_SB(0, 0), b2, voffB);
            PG8_BAR; PG8_WAIT_L(0); PG8_MMA(0, 1, At, B1); PG8_BAR;
            PG8_LDA(At, 0, 1); PG8_STAGE(PG8_SA(0, 0), a2, voffA);
            PG8_BAR; PG8_WAIT_L(0); PG8_MMA(1, 0, At, B0); PG8_BAR; PG8_SCHED;
            PG8_STAGE(PG8_SB(0, 1), b2 + hstep, voffB);
            PG8_WAIT_V(6); PG8_BAR; PG8_MMA(1, 1, At, B1); PG8_BAR;
            PG8_LDB(B0, 1, 0); PG8_SCHED; PG8_LDA(At, 1, 0); PG8_STAGE(PG8_SA(0, 1), a2 + hstepA, voffA);
            PG8_WAIT_L(8); PG8_BAR; PG8_WAIT_L(0); PG8_MMA(0, 0, At, B0); PG8_BAR; PG8_SCHED;
            PG8_LDB(B1, 1, 1); PG8_STAGE(PG8_SB(1, 0), b3, voffB);
            PG8_BAR; PG8_WAIT_L(0); PG8_MMA(0, 1, At, B1); PG8_BAR;
            PG8_LDA(At, 1, 1); PG8_STAGE(PG8_SA(1, 0), a3, voffA);
            PG8_BAR; PG8_WAIT_L(0); PG8_MMA(1, 0, At, B0); PG8_BAR; PG8_SCHED;
            PG8_STAGE(PG8_SB(1, 1), b3 + hstep, voffB);
            PG8_WAIT_V(6); PG8_BAR; PG8_MMA(1, 1, At, B1); PG8_BAR;
            }
        }
        if constexpr (ALIGN_EPI) { if (wr == 0) PG8_BAR; }
        if constexpr (!Epi::AFTER_DRAIN) { E(acc, cur, wr, wc, fr, fq); S.done(cur); }
        if (!has_next) break;
#pragma unroll
        for (int a = 0; a < 2; ++a)
#pragma unroll
            for (int b = 0; b < 2; ++b)
#pragma unroll
                for (int m = 0; m < 4; ++m)
#pragma unroll
                    for (int n = 0; n < 2; ++n) acc[a][b][m][n] = (f32x4){0.f, 0.f, 0.f, 0.f};
        cur = nxt; cA = nA; cB = nB; ++ui;
        if constexpr (ALIGN_EPI) { if (wr == 1) PG8_BAR; }
    }
    PG8_WAIT_V(0);
    if constexpr (!ALIGN_EPI) { if (wr == 0) PG8_BAR; }
    PG8_BAR;
    if constexpr (Epi::AFTER_DRAIN) { E.fused(acc, cur, wr, wc, fr, fq, lds, wid, lane); S.done(cur); }
#undef PG8_SA
#undef PG8_SB
#undef PG8_STAGE
#undef PG8_LDA
#undef PG8_LDB
#undef PG8_MMA
#undef PG8_WAIT_V
#undef PG8_WAIT_L
#undef PG8_BAR
#undef PG8_SCHED
}
}

#ifndef PG8_SP2
#define PG8_SP2 true
#endif
#ifndef PG8_ALIGN
#define PG8_ALIGN true
#endif
constexpr int NWAVES = 8, NTHR = 512;
constexpr int BATCH = 2, SEQ = 8192, DM = 4096, MTOK = BATCH * SEQ;
constexpr int HD = 128;
constexpr int A_HEADS = 16, B_HEADS = 16, A_W = 2048, B_W = 2048, AB_IN = 4 * A_W + 3 * B_W;
constexpr int NSA_H = 32, NSA_G = 4, NSA_R = 8, KVW = 512, NSA_IN = 4096 + 6 * KVW + 96, NSA_INP = 7424;
constexpr int NCMP = 511, NCMPP = 512, NSLC = 128, NTOP = 16, WINDOW = 512;
constexpr int NMEM = 256, XH = 4, XW = 512;
constexpr int DFF = 11008, DFF2 = 22016;
constexpr float LN_EPS = 1e-5f, RMS_EPS = 1e-6f;
constexpr float DN_ALPHA = 1.41421356237309515f;
constexpr size_t MiB = (size_t)1 << 20;
constexpr size_t WS_CTL = 0, CTL_ZERO_BYTES = 4 * MiB;
constexpr size_t WS_FOLD = 64 * 1024;
constexpr int FO_XQ = 0, FO_UP = 2 * 512, FO_NSA = FO_UP + 2 * 22016, FO_N = FO_NSA + 7424;
constexpr size_t WS_RSUM = 1 * MiB;
static_assert(WS_FOLD + (size_t)2 * FO_N * 8 <= WS_RSUM && WS_RSUM + (size_t)6 * 16384 * 2 * 8 <= CTL_ZERO_BYTES, "CTL map");
constexpr size_t WS_W_ABIN = 4 * MiB;
constexpr size_t WS_W_ABOUT = WS_W_ABIN + 112 * MiB;
constexpr size_t WS_W_NSAIN = WS_W_ABOUT + 32 * MiB;
constexpr size_t WS_W_NSAOUT = WS_W_NSAIN + 58 * MiB;
constexpr size_t WS_W_XQ = WS_W_NSAOUT + 32 * MiB;
constexpr size_t WS_W_XKV = WS_W_XQ + 8 * MiB;
constexpr size_t WS_W_XO = WS_W_XKV + 16 * MiB;
constexpr size_t WS_W_UP = WS_W_XO + 8 * MiB;
constexpr size_t WS_W_DOWN = WS_W_UP + 344 * MiB;
constexpr size_t WS_W_C1 = WS_W_DOWN + 172 * MiB;
constexpr size_t WS_W_C2 = WS_W_C1 + 2 * MiB;
constexpr size_t WS_MEMB = WS_W_C2 + 1 * MiB;
constexpr size_t WS_HB = WS_MEMB + 4 * MiB;
constexpr size_t WS_Y = WS_HB + 128 * MiB;
constexpr size_t WS_BIG = WS_Y + 256 * MiB;
constexpr size_t WS_G = WS_BIG + 688 * MiB;
constexpr size_t WS_O = WS_G + 344 * MiB;
constexpr size_t WS_MISC = WS_O + 128 * MiB;
constexpr size_t WS_END = WS_MISC + 64 * MiB;
constexpr size_t WS_XQ = WS_MISC;
constexpr size_t WS_XO = WS_MISC + 16 * MiB;
constexpr size_t WS_XKV = WS_MISC + 32 * MiB;
constexpr size_t WS_LB = WS_MISC + 34 * MiB;
constexpr size_t WS_SIDE = WS_MISC + 42 * MiB;
constexpr size_t WS_FOLDF = WS_MISC + 40 * MiB;
constexpr size_t WS_ROPE = WS_MISC + 36 * MiB;
constexpr size_t WS_STATS = WS_MISC + 35 * MiB;
constexpr size_t WS_PROJ0 = WS_BIG;
constexpr size_t WS_SPREV = WS_BIG + 448 * MiB;
constexpr size_t WS_QT = WS_G;
constexpr size_t WS_OINTRA = WS_G + 64 * MiB;
constexpr size_t WS_DEC = WS_G + 192 * MiB;
constexpr size_t WS_DS = WS_Y;
constexpr size_t WS_PROJ1 = WS_BIG;
constexpr size_t WS_QROT = WS_BIG + 232 * MiB;
constexpr size_t WS_KSROT = WS_BIG + 360 * MiB;
constexpr size_t WS_KWROT = WS_BIG + 376 * MiB;
constexpr size_t WS_KCMP = WS_BIG + 392 * MiB;
constexpr size_t WS_VCMP = WS_BIG + 393 * MiB;
constexpr size_t WS_OVL = WS_BIG + 394 * MiB;
constexpr size_t WS_SEL = WS_BIG + 395 * MiB;
constexpr size_t WS_IMP = WS_G + 256 * MiB;
constexpr size_t WS_O32 = WS_G;
static_assert(WS_SPREV + 128 * MiB <= WS_G && WS_DEC + 2 * MiB <= WS_O && WS_SEL + MiB <= WS_G, "ws map");
constexpr int CW_TMO = 0, CW_CODE = 1;
constexpr int CW_BAR = 4096;
constexpr int RING_OFF = 0, RING_BYTES = 131072;
constexpr int LDSCTL_OFF = RING_BYTES, MISC_OFF = LDSCTL_OFF + 320;
constexpr int LDS_BYTES = 147456;
static_assert(MISC_OFF + 128 <= LDS_BYTES, "LDS map");

#define GAS __attribute__((address_space(1)))
#define LAS __attribute__((address_space(3)))
typedef unsigned short bf16;
typedef unsigned v4u __attribute__((ext_vector_type(4)));
typedef unsigned v2u __attribute__((ext_vector_type(2)));
typedef float f32x4 __attribute__((ext_vector_type(4)));
typedef float f32x2 __attribute__((ext_vector_type(2)));
typedef float f32x16 __attribute__((ext_vector_type(16)));
typedef short bf16x8 __attribute__((ext_vector_type(8)));
typedef short s16x4 __attribute__((ext_vector_type(4)));
typedef GAS unsigned gu32;
#define RLX_AGENT __ATOMIC_RELAXED, __HIP_MEMORY_SCOPE_AGENT
#define LDS_WAIT() asm volatile("s_waitcnt lgkmcnt(0)" ::: "memory")
#define VM_WAIT() asm volatile("s_waitcnt vmcnt(0)" ::: "memory")
#define SBAR() __builtin_amdgcn_sched_barrier(0)
__device__ __forceinline__ unsigned f2bf(float f) { unsigned u = __builtin_bit_cast(unsigned, f); return (u + 0x7fffu + ((u >> 16) & 1u)) >> 16; }
__device__ __forceinline__ unsigned pk2(float lo, float hi) { return f2bf(lo) | (f2bf(hi) << 16); }
__device__ __forceinline__ float bf2f(unsigned short b) { return __builtin_bit_cast(float, (unsigned)b << 16); }
__device__ __forceinline__ float bflo(unsigned w) { return __builtin_bit_cast(float, w << 16); }
__device__ __forceinline__ float bfhi(unsigned w) { return __builtin_bit_cast(float, w & 0xffff0000u); }
__device__ __forceinline__ unsigned cvtpk(float lo, float hi) { unsigned r; asm volatile("v_cvt_pk_bf16_f32 %0, %1, %2" : "=v"(r) : "v"(lo), "v"(hi)); return r; }
__device__ __forceinline__ float wave_sum(float v) {
#pragma unroll
    for (int o = 1; o < 64; o <<= 1) v += __shfl_xor(v, o);
    return v;
}
__device__ __forceinline__ float sigmoidf_(float x) { return __builtin_amdgcn_rcpf(1.f + __builtin_amdgcn_exp2f(-1.4426950408889634f * x)); }
__device__ __forceinline__ float gelu1(float v) { pg8::f32x2 r = pg8::gelu_pk((pg8::f32x2){v, 0.f}); return r.x; }
#define XB_TMO      128
#define XB_XCNT(j)  (256  + 64 * (j))
#define XB_XSUB(j)  (1280 + 64 * (j))
#define XB_XGEN(j)  (2304 + 64 * (j))
#define XB_TOP      3328
#define XB_TOPGEN   3392
#define XCD_BAR_WORDS 3456
#define XB_SPIN_CAP (1u << 18)
#define LAS __attribute__((address_space(3)))

__device__ __forceinline__ unsigned xb_ld(unsigned* p)              { return __hip_atomic_load(p, __ATOMIC_RELAXED, __HIP_MEMORY_SCOPE_AGENT); }
__device__ __forceinline__ unsigned xb_add(unsigned* p, unsigned v) { return __hip_atomic_fetch_add(p, v, __ATOMIC_RELAXED, __HIP_MEMORY_SCOPE_AGENT); }
__device__ __forceinline__ unsigned xb_xcc_id() { return (unsigned)__builtin_amdgcn_s_getreg((3 << 11) | 20) & 0xFu; }
#define XB_SPIN(cond, bar) do { unsigned _sp = 0; while (cond) { __builtin_amdgcn_s_sleep(1); \
    if ((++_sp & 255u) == 0u) { if (xb_ld(&(bar)[XB_TMO])) break; if (_sp > XB_SPIN_CAP) { atomicAdd(&(bar)[XB_TMO], 1u); break; } } } } while (0)

struct XcdBarrier {
    unsigned* bar; unsigned x;
    volatile LAS unsigned* st;
};

__device__ __forceinline__ XcdBarrier xcd_barrier_post(unsigned* bar, volatile LAS unsigned* st) {
    XcdBarrier b; b.bar = bar; b.x = xb_xcc_id(); b.st = st;
    if (threadIdx.x == 0) (void)xb_add(&bar[XB_XCNT(b.x)], 1u);
    return b;
}
__device__ __forceinline__ void xcd_barrier_complete(unsigned* bar, unsigned x, unsigned& nloc, unsigned& nx) {
    const unsigned G = gridDim.x * gridDim.y * gridDim.z;
    unsigned sum, cnt, mine, sp = 0u;
    for (;;) {
        sum = 0u; cnt = 0u; mine = 0u;
#pragma unroll
        for (unsigned j = 0; j < 16; ++j) { const unsigned c = xb_ld(&bar[XB_XCNT(j)]); sum += c; cnt += (c > 0u) ? 1u : 0u; mine = (j == x) ? c : mine; }
        if (sum == G) break;
        __builtin_amdgcn_s_sleep(1);
        if ((++sp & 255u) == 0u) { if (xb_ld(&bar[XB_TMO])) break; if (sp > XB_SPIN_CAP) { atomicAdd(&bar[XB_TMO], 1u); break; } }
    }
    nloc = mine > 0u ? mine : 1u; nx = cnt > 0u ? cnt : 1u;
}

__device__ __forceinline__ void xcd_barrier(const XcdBarrier& b) {
    asm volatile("s_waitcnt vmcnt(0)" ::: "memory");
    __syncthreads();
    if (threadIdx.x == 0) {
        unsigned* bar = b.bar;
        __builtin_amdgcn_s_waitcnt(0);
        unsigned nloc = b.st[0], nx = b.st[1];
        if (nloc == 0u) { xcd_barrier_complete(bar, b.x, nloc, nx); b.st[0] = nloc; b.st[1] = nx; }
        const unsigned old = xb_add(&bar[XB_XSUB(b.x)], 1u);
        const unsigned gen = old / nloc;
        if (old + 1u == (gen + 1u) * nloc) {
            __builtin_amdgcn_fence(__ATOMIC_RELEASE, "agent");
            asm volatile("s_waitcnt vmcnt(0)" ::: "memory");
            const unsigned og = xb_add(&bar[XB_TOP], 1u);
            const unsigned tg = og / nx;
            if (og + 1u == (tg + 1u) * nx) xb_add(&bar[XB_TOPGEN], 1u);
            else XB_SPIN(xb_ld(&bar[XB_TOPGEN]) == tg, bar);
            __builtin_amdgcn_fence(__ATOMIC_ACQUIRE, "agent");
            xb_add(&bar[XB_XGEN(b.x)], 1u);
            asm volatile("s_waitcnt vmcnt(0)" ::: "memory");
        } else {
            XB_SPIN(xb_ld(&bar[XB_XGEN(b.x)]) == gen, bar);
            __builtin_amdgcn_fence(__ATOMIC_ACQUIRE, "agent");
            asm volatile("s_waitcnt vmcnt(0)" ::: "memory");
        }
    }
    __syncthreads();
}


constexpr int ATT_D = 128, KVBLK = 64;
constexpr int SHM_V = KVBLK * ATT_D * 2, SHM_K = KVBLK * ATT_D * 2;
constexpr int ATT_K_OFF = 0, ATT_V_OFF = SHM_K, ATT_BUF = SHM_K + SHM_V, ATT_SET = 2 * ATT_BUF;
constexpr int ATT_WS_OFF = RING_BYTES + 512;
constexpr int ATT_X_OFF = ATT_WS_OFF + NWAVES * 256;
static_assert(2 * ATT_SET <= RING_BYTES && ATT_X_OFF + 2048 + NTHR * 16 <= LDS_BYTES, "attention LDS map");
#define KSWZ(row, colB) ((row) * 256 + ((colB) ^ (((row) & 7) << 4)))
__device__ __forceinline__ int crow(int r, int hi) { return (r & 3) + 8 * (r >> 2) + 4 * hi; }
__device__ __forceinline__ int v_st(int k, int c) { const int kk = (k & ~0xC) | ((k & 4) << 1) | ((k & 8) >> 1); return ((kk >> 3) * 4 + (c >> 5)) * 512 + ((kk & 7) * 32 + (c & 31)) * 2; }
__device__ __forceinline__ int v_rd_base(int lane) { return ((lane & 3) << 3) | (((lane >> 2) & 3) << 6) | (((lane >> 4) & 1) << 5) | (((lane >> 5) & 1) << 8); }
constexpr int v_rd_off(int d0, int ks, int half) { return d0 * 512 + ks * 4096 + half * 2048; }
template <int OFF> __device__ __forceinline__ s16x4 tr_read(int vb) {
  s16x4 r; asm volatile("ds_read_b64_tr_b16 %0, %1 offset:%2" : "=&v"(r) : "v"(vb), "i"(OFF) : "memory"); return r;
}
__device__ __forceinline__ void qkt(f32x16& p0, f32x16& p1, const LAS char* Ks, const bf16x8* qr, int r32, int hi) {
  p0 = f32x16{}; p1 = f32x16{};
#pragma unroll
  for (int d0 = 0; d0 < 8; ++d0) { const int cb = (d0 * 16 + hi * 8) * 2;
    const bf16x8 b0 = *(const LAS bf16x8*)(Ks + KSWZ(r32, cb));
    const bf16x8 b1 = *(const LAS bf16x8*)(Ks + KSWZ(32 + r32, cb));
    p0 = __builtin_amdgcn_mfma_f32_32x32x16_bf16(b0, qr[d0], p0, 0, 0, 0);
    p1 = __builtin_amdgcn_mfma_f32_32x32x16_bf16(b1, qr[d0], p1, 0, 0, 0); }
}
__device__ __forceinline__ void pack_p(const f32x16& p0, const f32x16& p1, bf16x8& pa0, bf16x8& pa1, bf16x8& pa2, bf16x8& pa3) {
#define PK4(P, BASE, OUT) do { unsigned a0 = cvtpk(P[BASE + 0], P[BASE + 1]), a1 = cvtpk(P[BASE + 2], P[BASE + 3]);   \
    unsigned b0 = cvtpk(P[BASE + 4], P[BASE + 5]), b1 = cvtpk(P[BASE + 6], P[BASE + 7]);                              \
    auto r0 = __builtin_amdgcn_permlane32_swap(a0, b0, false, false); auto r1 = __builtin_amdgcn_permlane32_swap(a1, b1, false, false); \
    v4u w = {r0[0], r1[0], r0[1], r1[1]}; OUT = __builtin_bit_cast(bf16x8, w); } while (0)
  PK4(p0, 0, pa0); PK4(p0, 8, pa1); PK4(p1, 0, pa2); PK4(p1, 8, pa3);
#undef PK4
}
template <int D0> __device__ __forceinline__ void pv_one(f32x16& od, int vb, bf16x8 pa0, bf16x8 pa1, bf16x8 pa2, bf16x8 pa3) {
  const s16x4 l0 = tr_read<v_rd_off(D0, 0, 0)>(vb), h0 = tr_read<v_rd_off(D0, 0, 1)>(vb), l1 = tr_read<v_rd_off(D0, 1, 0)>(vb), h1 = tr_read<v_rd_off(D0, 1, 1)>(vb);
  const s16x4 l2 = tr_read<v_rd_off(D0, 2, 0)>(vb), h2 = tr_read<v_rd_off(D0, 2, 1)>(vb), l3 = tr_read<v_rd_off(D0, 3, 0)>(vb), h3 = tr_read<v_rd_off(D0, 3, 1)>(vb);
  asm volatile("s_waitcnt lgkmcnt(0)" ::: "memory"); SBAR();
#define PKV(L, H) (bf16x8){L[0], L[1], L[2], L[3], H[0], H[1], H[2], H[3]}
  od = __builtin_amdgcn_mfma_f32_32x32x16_bf16(pa0, PKV(l0, h0), od, 0, 0, 0);
  od = __builtin_amdgcn_mfma_f32_32x32x16_bf16(pa1, PKV(l1, h1), od, 0, 0, 0);
  od = __builtin_amdgcn_mfma_f32_32x32x16_bf16(pa2, PKV(l2, h2), od, 0, 0, 0);
  od = __builtin_amdgcn_mfma_f32_32x32x16_bf16(pa3, PKV(l3, h3), od, 0, 0, 0);
#undef PKV
}
__device__ __forceinline__ void pv_d0(f32x16* o, int vb, bf16x8 pa0, bf16x8 pa1, bf16x8 pa2, bf16x8 pa3) {
  pv_one<0>(o[0], vb, pa0, pa1, pa2, pa3); pv_one<1>(o[1], vb, pa0, pa1, pa2, pa3); pv_one<2>(o[2], vb, pa0, pa1, pa2, pa3); pv_one<3>(o[3], vb, pa0, pa1, pa2, pa3);
}
struct KVStage { bf16x8 ks0, ks1, vs0, vs1; };
__device__ __forceinline__ void kv_load(KVStage& s, const bf16* Kh, const bf16* Vh, long ldk, long ldv, int k0, int sr, int sc) {
  s.ks0 = *(const bf16x8*)(Kh + (long)(k0 + sr) * ldk + sc); s.ks1 = *(const bf16x8*)(Kh + (long)(k0 + 32 + sr) * ldk + sc);
  s.vs0 = *(const bf16x8*)(Vh + (long)(k0 + sr) * ldv + sc); s.vs1 = *(const bf16x8*)(Vh + (long)(k0 + 32 + sr) * ldv + sc);
}
__device__ __forceinline__ void kv_write(const KVStage& s, LAS char* lds, int sr, int sc) {
  *(LAS bf16x8*)(lds + ATT_V_OFF + v_st(sr, sc)) = s.vs0; *(LAS bf16x8*)(lds + ATT_V_OFF + v_st(32 + sr, sc)) = s.vs1;
  *(LAS bf16x8*)(lds + ATT_K_OFF + KSWZ(sr, sc * 2)) = s.ks0; *(LAS bf16x8*)(lds + ATT_K_OFF + KSWZ(32 + sr, sc * 2)) = s.ks1;
}
struct KVDma { int ko[2], vo[2]; };
__device__ __forceinline__ void kv_dma_init(KVDma& d, int ldk, int ldv, int wid, int lane) {
#pragma unroll
  for (int i = 0; i < 2; ++i) { const int p = wid * 2 + i;
    const int row = p * 4 + (lane >> 4), cp = lane & 15; d.ko[i] = row * ldk + ((cp ^ (row & 7)) << 3);
    const int sub = p * 2 + (lane >> 5), kk = (sub >> 2) * 8 + ((lane & 31) >> 2), k = (kk & ~0xC) | ((kk & 4) << 1) | ((kk & 8) >> 1), c = (sub & 3) * 32 + (lane & 3) * 8;
    d.vo[i] = k * ldv + c; }
}
__device__ __forceinline__ void kv_dma(const KVDma& d, const bf16* Kt, const bf16* Vt, LAS char* lds, int buf, int wid) {
#pragma unroll
  for (int i = 0; i < 2; ++i) {
    __builtin_amdgcn_global_load_lds((const unsigned*)(Kt + d.ko[i]), (LAS unsigned*)(lds + buf + ATT_K_OFF + (wid * 2 + i) * 1024), 16, 0, 0);
    __builtin_amdgcn_global_load_lds((const unsigned*)(Vt + d.vo[i]), (LAS unsigned*)(lds + buf + ATT_V_OFF + (wid * 2 + i) * 1024), 16, 0, 0); }
}
__device__ __forceinline__ void rescale_o(f32x16* o, float a, LAS float* al_l, int r32, int hi) {
  if (__any(a < 1.f)) { if (hi == 0) al_l[r32] = a; LDS_WAIT();
#pragma unroll
    for (int r = 0; r < 16; ++r) { const float f = al_l[crow(r, hi)];
#pragma unroll
      for (int d = 0; d < 4; ++d) o[d][r] *= f; }
    LDS_WAIT(); }
}
constexpr float ATT_SCALE = 0.088388347648318440f, ATT_C = ATT_SCALE * 1.4426950408889634f, ATT_THR = 8.f;
__device__ __forceinline__ void softmax_tile(f32x16& p0, f32x16& p1, float& m_reg, float& l_reg, float& alpha) {
  float pmax = p0[0];
#pragma unroll
  for (int r = 1; r < 16; ++r) pmax = fmaxf(pmax, p0[r]);
#pragma unroll
  for (int r = 0; r < 16; ++r) pmax = fmaxf(pmax, p1[r]);
  { auto rr = __builtin_amdgcn_permlane32_swap(__float_as_uint(pmax), __float_as_uint(pmax), false, false);
    pmax = fmaxf(__uint_as_float(rr[0]), __uint_as_float(rr[1])); }
  float mn;
  if (__all(pmax - m_reg <= ATT_THR / ATT_SCALE)) { mn = m_reg; alpha = 1.f; }
  else { mn = fmaxf(m_reg, pmax); alpha = __builtin_amdgcn_exp2f((m_reg - mn) * ATT_C); m_reg = mn; }
  const float mnC = -mn * ATT_C;
#pragma unroll
  for (int r = 0; r < 16; ++r) { p0[r] = __builtin_amdgcn_exp2f(fmaf(p0[r], ATT_C, mnC)); p1[r] = __builtin_amdgcn_exp2f(fmaf(p1[r], ATT_C, mnC)); }
  float ps = 0.f;
#pragma unroll
  for (int r = 0; r < 16; ++r) ps += p0[r] + p1[r];
  { auto rr = __builtin_amdgcn_permlane32_swap(__float_as_uint(ps), __float_as_uint(ps), false, false);
    ps = __uint_as_float(rr[0]) + __uint_as_float(rr[1]); }
  l_reg = l_reg * alpha + ps;
}
__device__ __forceinline__ void attn_finish(f32x16& p0, f32x16& p1, f32x16* o, float& m_reg, float& l_reg, LAS float* wsc, int vb, int r32, int hi) {
  float alpha; softmax_tile(p0, p1, m_reg, l_reg, alpha);
  rescale_o(o, alpha, wsc, r32, hi);
  bf16x8 pa0, pa1, pa2, pa3; pack_p(p0, p1, pa0, pa1, pa2, pa3);
  pv_d0(o, vb, pa0, pa1, pa2, pa3);
}
__device__ __forceinline__ void load_q(bf16x8* qr, const bf16* Qw) {
#pragma unroll
  for (int d0 = 0; d0 < 8; ++d0) qr[d0] = *(const bf16x8*)(Qw + d0 * 16);
}

struct Frame {
    LAS unsigned char* lds;
    unsigned char* ws;
    int tid, lane, wave, G, bid;
    __device__ __forceinline__ void fresh() { int t = threadIdx.x; asm volatile("" : "+v"(t)); tid = t; lane = t & 63; wave = __builtin_amdgcn_readfirstlane(t >> 6);
        int g_ = gridDim.x, b_ = blockIdx.x; asm volatile("" : "+s"(g_), "+s"(b_)); G = g_; bid = b_; }
};
struct Args { const float* in[19]; float* out; unsigned char* ws; int ph_lo, ph_hi; };
typedef const Args __attribute__((address_space(4))) KArgs;
__device__ __forceinline__ KArgs* karg() { KArgs* p = (KArgs*)__builtin_amdgcn_kernarg_segment_ptr(); asm volatile("" : "+s"(p)); return p; }
#define KIN(i) ((const float*)karg()->in[i])
enum { IN_X = 0, IN_MEM, IN_AB_W_IN, IN_HGRN_LB, IN_HGRN_NW, IN_AB_W_OUT, IN_NSA_W_IN, IN_NSA_CMP_POS, IN_NSA_CMP_W1, IN_NSA_CMP_W2, IN_NSA_W_OUT,
       IN_XA_WQ, IN_XA_WKV, IN_XA_WO, IN_FFN_UP, IN_FFN_CONV, IN_FFN_DOWN, IN_LN_G, IN_LN_B };

__device__ __forceinline__ void p0_transpose_item(const float* W, int K, int N, bf16* WT, LAS float* scr, int item, int lane) {
    const int nblk = N / 32, kb = item / nblk, nb = item % nblk, k0 = 64 * kb, n0 = 32 * nb;
#pragma unroll 8
    for (int i = 0; i < 32; ++i) { const int kk = 2 * i + (lane >> 5); scr[kk * 33 + (lane & 31)] = W[(size_t)(k0 + kk) * N + n0 + (lane & 31)]; }
    LDS_WAIT(); asm volatile("" ::: "memory");
    const int c = lane & 7;
#pragma unroll
    for (int j = 0; j < 4; ++j) { const int n = (lane >> 3) + 8 * j; const LAS float* s = scr + (8 * c) * 33 + n;
        v4u o; o.x = pk2(s[0 * 33], s[1 * 33]); o.y = pk2(s[2 * 33], s[3 * 33]); o.z = pk2(s[4 * 33], s[5 * 33]); o.w = pk2(s[6 * 33], s[7 * 33]);
        *(GAS v4u*)(WT + (size_t)(n0 + n) * K + k0 + 8 * c) = o; }
    LDS_WAIT(); asm volatile("" ::: "memory");
}
__device__ __forceinline__ int up_col(int n) { const int isu = n >= DFF, ch = isu ? n - DFF : n; return (ch >> 7) * 256 + isu * 128 + (ch & 127); }
__device__ __forceinline__ void p0_transpose_item_fold(const float* W, int K, int N, bf16* WT, LAS float* scr, int item, int lane, const float* g, const float* b, long long* cs, long long* b2, bool upmap = false) {
    const int nblk = N / 32, kb = item / nblk, nb = item % nblk, k0 = 64 * kb, n0 = 32 * nb, n0m = upmap ? up_col(n0) : n0;
#pragma unroll 8
    for (int i = 0; i < 32; ++i) { const int kk = 2 * i + (lane >> 5); scr[kk * 33 + (lane & 31)] = W[(size_t)(k0 + kk) * N + n0 + (lane & 31)]; }
    LDS_WAIT(); asm volatile("" ::: "memory");
    const int c = lane & 7;
    const f32x4 g0 = *(const f32x4*)(g + k0 + 8 * c), g1 = *(const f32x4*)(g + k0 + 8 * c + 4), b0 = *(const f32x4*)(b + k0 + 8 * c), b1 = *(const f32x4*)(b + k0 + 8 * c + 4);
    const float gg[8] = {g0.x, g0.y, g0.z, g0.w, g1.x, g1.y, g1.z, g1.w}, bb[8] = {b0.x, b0.y, b0.z, b0.w, b1.x, b1.y, b1.z, b1.w};
#pragma unroll
    for (int j = 0; j < 4; ++j) { const int n = (lane >> 3) + 8 * j; const LAS float* s = scr + (8 * c) * 33 + n;
        float sc = 0.f, sb = 0.f; unsigned w[4];
#pragma unroll
        for (int q = 0; q < 4; ++q) { const float x0 = s[(2 * q) * 33], x1 = s[(2 * q + 1) * 33]; const unsigned r0 = f2bf(x0 * gg[2 * q]), r1 = f2bf(x1 * gg[2 * q + 1]);
            w[q] = r0 | (r1 << 16); sc += bf2f((unsigned short)r0) + bf2f((unsigned short)r1); sb += x0 * bb[2 * q] + x1 * bb[2 * q + 1]; }
        *(GAS v4u*)(WT + (size_t)(n0m + n) * K + k0 + 8 * c) = (v4u){w[0], w[1], w[2], w[3]};
        sc += __shfl_xor(sc, 1); sc += __shfl_xor(sc, 2); sc += __shfl_xor(sc, 4); sb += __shfl_xor(sb, 1); sb += __shfl_xor(sb, 2); sb += __shfl_xor(sb, 4);
        if (c == 0) { atomicAdd((unsigned long long*)(cs + n0m + n), (unsigned long long)(long long)rintf(sc * pg8::FOLD_SCALE)); atomicAdd((unsigned long long*)(b2 + n0m + n), (unsigned long long)(long long)rintf(sb * pg8::FOLD_SCALE)); } }
    LDS_WAIT(); asm volatile("" ::: "memory");
}
__device__ __forceinline__ void transpose_mat_fold(Frame& F, const float* W, int K, int N, bf16* WT, const float* g, const float* b, long long* cs, long long* b2, int c0 = 0, int nw = 1 << 30, int part = 0, int nparts = 1, bool upmap = false) {
    if (F.bid < c0 || F.bid >= c0 + nw) return;
    LAS float* scr = (LAS float*)(F.lds + RING_OFF + F.wave * 16384);
    const int nwg = nw < F.G ? nw : F.G, gw = (F.bid - c0) * NWAVES + F.wave, NGW = nwg * NWAVES;
    const int nitems = (K / 64) * (N / 32), ilo = (int)((long)nitems * part / nparts), ihi = (int)((long)nitems * (part + 1) / nparts);
    for (int it = ilo + gw; it < ihi; it += NGW) p0_transpose_item_fold(W, K, N, WT, scr, it, F.lane, g, b, cs, b2, upmap);
}
__device__ __forceinline__ void transpose_mat(Frame& F, const float* W, int K, int N, bf16* WT, int c0 = 0, int nw = 1 << 30) {
    if (F.bid < c0 || F.bid >= c0 + nw) return;
    LAS float* scr = (LAS float*)(F.lds + RING_OFF + F.wave * 16384);
    const int nwg = nw < F.G ? nw : F.G, gw = (F.bid - c0) * NWAVES + F.wave, NGW = nwg * NWAVES;
    const int nitems = (K / 64) * (N / 32);
    for (int it = gw; it < nitems; it += NGW) p0_transpose_item(W, K, N, WT, scr, it, F.lane);
}
__device__ __forceinline__ void fold_finalize(Frame& F, int lo, int n) {
    const long long* fs = (const long long*)(F.ws + WS_FOLD); float* fd = (float*)(F.ws + WS_FOLDF);
    for (int i = F.bid * NTHR + F.tid; i < 2 * n; i += F.G * NTHR) { const int j = (i < n) ? lo + i : FO_N + lo + (i - n); const long long v = fs[j]; fd[j] = (float)(int)(v >> 32) + (float)(unsigned)v * pg8::FOLD_INV; }
}
enum { CJ_DOWN0, CJ_NSA, CJ_L1A, CJ_L1B, CJ_DOWN1 };
template <int JOB>
__device__ __forceinline__ void convert_job(Frame& F, const Args& A, int c0, int nw) {
    unsigned char* ws = F.ws; long long* cs = (long long*)(ws + WS_FOLD); long long* b2 = cs + FO_N;
    if (JOB == CJ_DOWN0 || JOB == CJ_DOWN1) { const int l = JOB == CJ_DOWN1; transpose_mat(F, KIN(IN_FFN_DOWN) + (size_t)l * DFF * DM, DFF, DM, (bf16*)(ws + WS_W_DOWN) + (size_t)l * DM * DFF, c0, nw); }
    if (JOB == CJ_NSA) {
        transpose_mat_fold(F, KIN(IN_NSA_W_IN), DM, NSA_IN, (bf16*)(ws + WS_W_NSAIN), KIN(IN_LN_G) + 2 * DM, KIN(IN_LN_B) + 2 * DM, cs + FO_NSA, b2 + FO_NSA, c0, nw);
        transpose_mat(F, KIN(IN_NSA_W_OUT), DM, DM, (bf16*)(ws + WS_W_NSAOUT), c0, nw); }
    if (JOB == CJ_L1A || JOB == CJ_L1B) { const int l = 1;
        if (JOB == CJ_L1A) {
            transpose_mat_fold(F, KIN(IN_XA_WQ) + (size_t)l * DM * XW, DM, XW, (bf16*)(ws + WS_W_XQ) + (size_t)l * XW * DM, KIN(IN_LN_G) + (size_t)(3 * l) * DM, KIN(IN_LN_B) + (size_t)(3 * l) * DM, cs + FO_XQ + l * XW, b2 + FO_XQ + l * XW, c0, nw);
            transpose_mat(F, KIN(IN_XA_WKV) + (size_t)l * DM * 2 * XW, DM, 2 * XW, (bf16*)(ws + WS_W_XKV) + (size_t)l * 2 * XW * DM, c0, nw);
            transpose_mat(F, KIN(IN_XA_WO) + (size_t)l * XW * DM, XW, DM, (bf16*)(ws + WS_W_XO) + (size_t)l * DM * XW, c0, nw); }
        transpose_mat_fold(F, KIN(IN_FFN_UP) + (size_t)l * DM * DFF2, DM, DFF2, (bf16*)(ws + WS_W_UP) + (size_t)l * DFF2 * DM, KIN(IN_LN_G) + (size_t)(3 * l + 1) * DM, KIN(IN_LN_B) + (size_t)(3 * l + 1) * DM,
                           cs + FO_UP + l * DFF2, b2 + FO_UP + l * DFF2, c0, nw, JOB == CJ_L1A ? 0 : 1, 2, true); }
}
__device__ __forceinline__ void cvt_flat(Frame& F, const float* src, bf16* dst, long n8) {
    for (long i = (long)F.bid * NTHR + F.tid; i < n8; i += (long)F.G * NTHR) {
        const f32x4 a = *(const f32x4*)(src + i * 8), b = *(const f32x4*)(src + i * 8 + 4);
        v4u o; o.x = pk2(a.x, a.y); o.y = pk2(a.z, a.w); o.z = pk2(b.x, b.y); o.w = pk2(b.z, b.w);
        *(v4u*)(dst + i * 8) = o; }
}
__device__ __forceinline__ void p0_prologue(Frame& F, const Args& A) {
    unsigned char* ws = F.ws;
    long long* cs = (long long*)(ws + WS_FOLD); long long* b2 = cs + FO_N;
    transpose_mat(F, KIN(IN_AB_W_IN), DM, AB_IN, (bf16*)(ws + WS_W_ABIN));
    transpose_mat(F, KIN(IN_AB_W_OUT), DM, DM, (bf16*)(ws + WS_W_ABOUT));
    { const int l = 0;
        transpose_mat_fold(F, KIN(IN_XA_WQ) + (size_t)l * DM * XW, DM, XW, (bf16*)(ws + WS_W_XQ) + (size_t)l * XW * DM, KIN(IN_LN_G) + (size_t)(3 * l) * DM, KIN(IN_LN_B) + (size_t)(3 * l) * DM, cs + FO_XQ + l * XW, b2 + FO_XQ + l * XW);
        transpose_mat(F, KIN(IN_XA_WKV) + (size_t)l * DM * 2 * XW, DM, 2 * XW, (bf16*)(ws + WS_W_XKV) + (size_t)l * 2 * XW * DM);
        transpose_mat(F, KIN(IN_XA_WO) + (size_t)l * XW * DM, XW, DM, (bf16*)(ws + WS_W_XO) + (size_t)l * DM * XW);
        transpose_mat_fold(F, KIN(IN_FFN_UP) + (size_t)l * DM * DFF2, DM, DFF2, (bf16*)(ws + WS_W_UP) + (size_t)l * DFF2 * DM, KIN(IN_LN_G) + (size_t)(3 * l + 1) * DM, KIN(IN_LN_B) + (size_t)(3 * l + 1) * DM, cs + FO_UP + l * DFF2, b2 + FO_UP + l * DFF2, 0, 1 << 30, 0, 1, true); }
    for (int l = 0; l < 2; ++l) {
        transpose_mat(F, KIN(IN_NSA_CMP_W1) + (size_t)l * 32 * HD * HD, 32 * HD, HD, (bf16*)(ws + WS_W_C1) + (size_t)l * HD * 32 * HD);
        transpose_mat(F, KIN(IN_NSA_CMP_W2) + (size_t)l * HD * HD, HD, HD, (bf16*)(ws + WS_W_C2) + (size_t)l * HD * HD);
    }
    cvt_flat(F, KIN(IN_X), (bf16*)(ws + WS_HB), (long)MTOK * DM / 8);
    cvt_flat(F, KIN(IN_MEM), (bf16*)(ws + WS_MEMB), (long)BATCH * NMEM * DM / 8);
    { v4u z = {0u, 0u, 0u, 0u}; v4u* p = (v4u*)((bf16*)(ws + WS_W_NSAIN) + (size_t)NSA_IN * DM); const long n = (long)(NSA_INP - NSA_IN) * DM / 8;
      for (long i = (long)F.bid * NTHR + F.tid; i < n; i += (long)F.G * NTHR) p[i] = z; }
    { float* tab = (float*)(ws + WS_ROPE);
      for (int i = F.bid * NTHR + F.tid; i < SEQ * 64; i += F.G * NTHR) { const int t = i >> 6, d = i & 63;
          float sn, cs; sincosf((float)t * powf(10000.0f, -(float)d * (1.0f / 64.0f)), &sn, &cs); tab[(size_t)t * 128 + d] = cs; tab[(size_t)t * 128 + 64 + d] = sn; } }
    { const float* lbp = KIN(IN_HGRN_LB); float* lbo = (float*)(ws + WS_LB);
      for (int i = F.bid * NTHR + F.tid; i < A_W; i += F.G * NTHR) { const float a = lbp[i], b = lbp[A_W + i], m = fmaxf(a, b), ea = __expf(a - m), eb = __expf(b - m); lbo[i] = ea / (ea + eb); } }
}

__device__ __forceinline__ void ln_phase(Frame& F, const bf16* Y, const float* g, const float* b, float* h32) {
    const int gw = F.bid * NWAVES + F.wave, NGW = F.G * NWAVES;
    for (int m = gw; m < MTOK; m += NGW) {
        const v4u* yr = (const v4u*)(Y + (size_t)m * DM) + F.lane;
        float v[8][8]; float s = 0.f;
#pragma unroll
        for (int j = 0; j < 8; ++j) { const v4u x = yr[64 * j];
            v[j][0] = bflo(x.x); v[j][1] = bfhi(x.x); v[j][2] = bflo(x.y); v[j][3] = bfhi(x.y); v[j][4] = bflo(x.z); v[j][5] = bfhi(x.z); v[j][6] = bflo(x.w); v[j][7] = bfhi(x.w);
#pragma unroll
            for (int q = 0; q < 8; ++q) s += v[j][q]; }
        const float mean = wave_sum(s) * (1.f / DM); float s2 = 0.f;
#pragma unroll
        for (int j = 0; j < 8; ++j)
#pragma unroll
            for (int q = 0; q < 8; ++q) { v[j][q] -= mean; s2 += v[j][q] * v[j][q]; }
        const float rstd = 1.f / sqrtf(wave_sum(s2) * (1.f / DM) + LN_EPS);
#pragma unroll
        for (int j = 0; j < 8; ++j) { const int c0 = 8 * F.lane + 512 * j;
            const f32x4 g0 = *(const f32x4*)(g + c0), g1 = *(const f32x4*)(g + c0 + 4), b0 = *(const f32x4*)(b + c0), b1 = *(const f32x4*)(b + c0 + 4);
            f32x4 r0, r1;
            r0.x = v[j][0] * rstd * g0.x + b0.x; r0.y = v[j][1] * rstd * g0.y + b0.y; r0.z = v[j][2] * rstd * g0.z + b0.z; r0.w = v[j][3] * rstd * g0.w + b0.w;
            r1.x = v[j][4] * rstd * g1.x + b1.x; r1.y = v[j][5] * rstd * g1.y + b1.y; r1.z = v[j][6] * rstd * g1.z + b1.z; r1.w = v[j][7] * rstd * g1.w + b1.w;
            *(f32x4*)(h32 + (size_t)m * DM + c0) = r0; *(f32x4*)(h32 + (size_t)m * DM + c0 + 4) = r1; }
    }
}

__device__ __forceinline__ void cg_unpack(const v4u x, float* o) { o[0] = bflo(x.x); o[1] = bfhi(x.x); o[2] = bflo(x.y); o[3] = bfhi(x.y); o[4] = bflo(x.z); o[5] = bfhi(x.z); o[6] = bflo(x.w); o[7] = bfhi(x.w); }
__device__ __forceinline__ void convglu_fixup_phase(Frame& F, const bf16* SIDE, const float* cw, bf16* Gm) {
    constexpr int NCG = DFF / 8, NRUN = MTOK / 128;
    for (int it = F.bid * NTHR + F.tid; it < NCG * NRUN; it += F.G * NTHR) {
        const int cg = it % NCG, run = it / NCG, c0 = cg * 8, t0 = run * 128;
        float w0[8], w1[8], w2[8], am2[8], am1[8], a0[8], a1[8], u0[8], u1[8];
#pragma unroll
        for (int j = 0; j < 8; ++j) { w0[j] = cw[c0 + j]; w1[j] = cw[DFF + c0 + j]; w2[j] = cw[2 * DFF + c0 + j]; }
        const bf16* sp = SIDE + (size_t)run * 6 * DFF + c0;
        if ((t0 & (SEQ - 1)) == 0) {
#pragma unroll
            for (int j = 0; j < 8; ++j) { am2[j] = 0.f; am1[j] = 0.f; }
        } else { cg_unpack(*(const v4u*)sp, am2); cg_unpack(*(const v4u*)(sp + DFF), am1); }
        cg_unpack(*(const v4u*)(sp + 2 * DFF), a0); cg_unpack(*(const v4u*)(sp + 3 * DFF), a1); cg_unpack(*(const v4u*)(sp + 4 * DFF), u0); cg_unpack(*(const v4u*)(sp + 5 * DFF), u1);
        unsigned o0[4], o1[4];
#pragma unroll
        for (int j = 0; j < 8; j += 2) {
            const pg8::f32x2 g0 = pg8::gelu_pk((pg8::f32x2){w2[j] * a0[j] + w1[j] * am1[j] + w0[j] * am2[j], w2[j + 1] * a0[j + 1] + w1[j + 1] * am1[j + 1] + w0[j + 1] * am2[j + 1]});
            const pg8::f32x2 g1 = pg8::gelu_pk((pg8::f32x2){w2[j] * a1[j] + w1[j] * a0[j] + w0[j] * am1[j], w2[j + 1] * a1[j + 1] + w1[j + 1] * a0[j + 1] + w0[j + 1] * am1[j + 1]});
            o0[j >> 1] = pk2(g0.x * u0[j], g0.y * u0[j + 1]); o1[j >> 1] = pk2(g1.x * u1[j], g1.y * u1[j + 1]); }
        *(v4u*)(Gm + (size_t)t0 * DFF + c0) = (v4u){o0[0], o0[1], o0[2], o0[3]}; *(v4u*)(Gm + (size_t)(t0 + 1) * DFF + c0) = (v4u){o1[0], o1[1], o1[2], o1[3]};
    }
}

__device__ __forceinline__ void xattn_phase(Frame& F, const bf16* XQ, const bf16* XKV, bf16* XO) {
    const int tid = F.tid, wid = F.wave, lane = F.lane, r32 = lane & 31, hi = lane >> 5;
    LAS char* lds = (LAS char*)F.lds;
    LAS float* wsc = (LAS float*)(lds + ATT_WS_OFF + wid * 256);
    const int vb0 = (int)(uintptr_t)(lds + ATT_V_OFF) + v_rd_base(lane);
    KVDma dm; kv_dma_init(dm, 2 * XW, 2 * XW, wid, lane);
    constexpr int NU = (MTOK / 256) * XH;
    for (int u = F.bid; u < NU; u += F.G) {
        const int head = u % XH, rbk = u / XH, row0 = rbk * 256, b = row0 / SEQ;
        const bf16* Kh = XKV + (size_t)b * NMEM * 2 * XW + head * HD; const bf16* Vh = Kh + XW;
        bf16x8 qr[8]; load_q(qr, XQ + (size_t)(row0 + wid * 32 + r32) * XW + head * HD + hi * 8);
        float m_reg = -1e30f, l_reg = 0.f; f32x16 o[4] = {};
        __syncthreads();
        kv_dma(dm, Kh, Vh, lds, 0, wid);
        for (int j = 0; j < NMEM / KVBLK; ++j) {
            const int buf = (j & 1) * ATT_BUF;
            VM_WAIT(); __syncthreads();
            if (j + 1 < NMEM / KVBLK) kv_dma(dm, Kh + (size_t)(j + 1) * KVBLK * 2 * XW, Vh + (size_t)(j + 1) * KVBLK * 2 * XW, lds, ATT_BUF - buf, wid);
            f32x16 p0, p1; qkt(p0, p1, lds + buf + ATT_K_OFF, qr, r32, hi);
            float alpha; softmax_tile(p0, p1, m_reg, l_reg, alpha);
            rescale_o(o, alpha, wsc, r32, hi);
            bf16x8 pa0, pa1, pa2, pa3; pack_p(p0, p1, pa0, pa1, pa2, pa3);
            pv_d0(o, vb0 + buf, pa0, pa1, pa2, pa3);
        }
        if (hi == 0) wsc[32 + r32] = l_reg; LDS_WAIT();
        bf16* Ow = XO + (size_t)(row0 + wid * 32) * XW + head * HD;
#pragma unroll
        for (int r = 0; r < 16; ++r) { const int orow = crow(r, hi); const float rl = __builtin_amdgcn_rcpf(wsc[32 + orow]);
#pragma unroll
            for (int d0 = 0; d0 < 4; ++d0) Ow[(size_t)orow * XW + d0 * 32 + r32] = (bf16)f2bf(o[d0][r] * rl); }
        LDS_WAIT();
    }
}

template <int K>
__device__ __forceinline__ f32x4 mma_tile(const LAS char* A, int lda, const LAS char* B, int ldb, int fr, int fq) {
    f32x4 acc = {0.f, 0.f, 0.f, 0.f};
#pragma unroll
    for (int k0 = 0; k0 < K; k0 += 32) {
        const bf16x8 a = *(const LAS bf16x8*)(A + fr * lda + (k0 + 8 * fq) * 2);
        const bf16x8 b = *(const LAS bf16x8*)(B + fr * ldb + (k0 + 8 * fq) * 2);
        acc = __builtin_amdgcn_mfma_f32_16x16x32_bf16(a, b, acc, 0, 0, 0);
    }
    return acc;
}
constexpr int HG_CH = 64, HG_NC = SEQ / HG_CH, HG_ITEMS = BATCH * A_HEADS * HG_NC;
constexpr int HG_QT = 0, HG_KT = 17408, HG_KH = 34816, HG_VT = 53248, HG_PT = 71680, HG_SEG = 80896;
constexpr int HG_SP = 17408, HG_OT = 52224;
constexpr int HG_WT = 80896, HG_KHS = 86016, HG_VS = 103424;
__device__ __forceinline__ void hgrn_phase_a(Frame& F, const bf16* P0, const float* lbv, bf16* QTg, bf16* OINTRA, bf16* DS, float* DEC) {
    LAS char* lds = (LAS char*)F.lds;
    const int tid = F.tid, wid = F.wave, lane = F.lane, fr = lane & 15, fq = lane >> 4;
    const int dg = tid & 15, sq = tid >> 4;
    const int d = tid & 127, sq16 = tid >> 7;
    for (int it = F.bid; it < HG_ITEMS; it += F.G) {
        const int c = it % HG_NC, bh = it / HG_NC, h = bh % A_HEADS, b = bh / A_HEADS;
        const size_t row0 = (size_t)b * SEQ + (size_t)c * HG_CH;
        float lb[8], q[2][8], kk[2][8], cum[2][8]; v4u vraw[2];
        { const f32x4 l0 = *(const f32x4*)(lbv + h * HD + 8 * dg), l1 = *(const f32x4*)(lbv + h * HD + 8 * dg + 4);
          lb[0] = l0.x; lb[1] = l0.y; lb[2] = l0.z; lb[3] = l0.w; lb[4] = l1.x; lb[5] = l1.y; lb[6] = l1.z; lb[7] = l1.w; }
#pragma unroll
        for (int rr = 0; rr < 2; ++rr) { const bf16* rowp = P0 + (row0 + 2 * sq + rr) * AB_IN + h * HD + 8 * dg;
            const v4u zq = *(const v4u*)(rowp + A_W), qq = *(const v4u*)rowp; vraw[rr] = *(const v4u*)(rowp + 2 * A_W);
            const unsigned zw[4] = {zq.x, zq.y, zq.z, zq.w}, qw[4] = {qq.x, qq.y, qq.z, qq.w};
#pragma unroll
            for (int j = 0; j < 8; ++j) { const float z = (j & 1) ? bfhi(zw[j >> 1]) : bflo(zw[j >> 1]); q[rr][j] = (j & 1) ? bfhi(qw[j >> 1]) : bflo(qw[j >> 1]);
                const float sg = sigmoidf_(z), omlb = 1.f - lb[j]; kk[rr][j] = omlb * (1.f - sg);
                const float lf = __logf(lb[j] + omlb * sg); cum[rr][j] = rr ? cum[0][j] + lf : lf; } }
        float pre[8];
#pragma unroll
        for (int j = 0; j < 8; ++j) { const float seg = cum[1][j]; float x = seg; const float t1 = __shfl_up(x, 16); if (lane >= 16) x += t1; const float t2 = __shfl_up(x, 32); if (lane >= 32) x += t2;
            pre[j] = x - seg; if (lane >= 48) ((LAS float*)(lds + HG_WT))[wid * 128 + 8 * dg + j] = x; }
        LDS_WAIT(); __syncthreads();
        float total[8];
#pragma unroll
        for (int j = 0; j < 8; ++j) total[j] = 0.f;
#pragma unroll
        for (int w = 0; w < NWAVES; ++w) { const f32x4 a0 = *(const LAS f32x4*)(lds + HG_WT + (w * 128 + 8 * dg) * 4), a1 = *(const LAS f32x4*)(lds + HG_WT + (w * 128 + 8 * dg + 4) * 4);
            const float av[8] = {a0.x, a0.y, a0.z, a0.w, a1.x, a1.y, a1.z, a1.w};
#pragma unroll
            for (int j = 0; j < 8; ++j) { total[j] += av[j]; if (w < wid) pre[j] += av[j]; } }
#pragma unroll
        for (int rr = 0; rr < 2; ++rr) { const int s = 2 * sq + rr; unsigned qt[4], kt[4], kh[4];
#pragma unroll
            for (int j = 0; j < 8; j += 2) { const float b0 = pre[j] + cum[rr][j], b1 = pre[j + 1] + cum[rr][j + 1];
                qt[j >> 1] = pk2(q[rr][j] * __expf(b0), q[rr][j + 1] * __expf(b1));
                kt[j >> 1] = pk2(kk[rr][j] * __expf(-b0), kk[rr][j + 1] * __expf(-b1));
                kh[j >> 1] = pk2(kk[rr][j] * __expf(total[j] - b0), kk[rr][j + 1] * __expf(total[j + 1] - b1)); }
            const v4u qv = {qt[0], qt[1], qt[2], qt[3]};
            *(LAS v4u*)(lds + HG_QT + s * 272 + dg * 16) = qv; *(v4u*)(QTg + (row0 + s) * A_W + h * HD + 8 * dg) = qv;
            *(LAS v4u*)(lds + HG_KT + s * 272 + dg * 16) = (v4u){kt[0], kt[1], kt[2], kt[3]};
            *(LAS v4u*)(lds + HG_KHS + s * 272 + dg * 16) = (v4u){kh[0], kh[1], kh[2], kh[3]};
            *(LAS v4u*)(lds + HG_VS + s * 272 + dg * 16) = vraw[rr]; }
        if (sq == 31) { f32x4 e0, e1; e0.x = __expf(total[0]); e0.y = __expf(total[1]); e0.z = __expf(total[2]); e0.w = __expf(total[3]); e1.x = __expf(total[4]); e1.y = __expf(total[5]); e1.z = __expf(total[6]); e1.w = __expf(total[7]);
            *(f32x4*)(DEC + (size_t)it * HD + 8 * dg) = e0; *(f32x4*)(DEC + (size_t)it * HD + 8 * dg + 4) = e1; }
        LDS_WAIT(); __syncthreads();
        { unsigned kh[8], vt[8];
#pragma unroll
          for (int j = 0; j < 16; j += 2) { const int s = 16 * sq16 + j;
              kh[j >> 1] = (unsigned)*(const LAS unsigned short*)(lds + HG_KHS + s * 272 + d * 2) | ((unsigned)*(const LAS unsigned short*)(lds + HG_KHS + (s + 1) * 272 + d * 2) << 16);
              vt[j >> 1] = (unsigned)*(const LAS unsigned short*)(lds + HG_VS + s * 272 + d * 2) | ((unsigned)*(const LAS unsigned short*)(lds + HG_VS + (s + 1) * 272 + d * 2) << 16); }
          LAS v4u* pk = (LAS v4u*)(lds + HG_KH + d * 144 + sq16 * 32); pk[0] = (v4u){kh[0], kh[1], kh[2], kh[3]}; pk[1] = (v4u){kh[4], kh[5], kh[6], kh[7]};
          LAS v4u* pv = (LAS v4u*)(lds + HG_VT + d * 144 + sq16 * 32); pv[0] = (v4u){vt[0], vt[1], vt[2], vt[3]}; pv[1] = (v4u){vt[4], vt[5], vt[6], vt[7]}; }
        LDS_WAIT(); __syncthreads();
#pragma unroll
        for (int k = 0; k < 2; ++k) { const int tau = 2 * wid + k, ti = tau >> 2, si = tau & 3;
            f32x4 acc = {0.f, 0.f, 0.f, 0.f};
            if (si <= ti) acc = mma_tile<128>(lds + HG_QT + ti * 16 * 272, 272, lds + HG_KT + si * 16 * 272, 272, fr, fq);
#pragma unroll
            for (int i = 0; i < 4; ++i) { const int t = 16 * ti + 4 * fq + i, s = 16 * si + fr; const float v = (s <= t) ? acc[i] : 0.f;
                *(LAS unsigned short*)(lds + HG_PT + t * 144 + s * 2) = (unsigned short)f2bf(v); } }
        LDS_WAIT(); __syncthreads();
#pragma unroll
        for (int k = 0; k < 4; ++k) { const int tau = wid + 8 * k, ti = tau >> 3, vi = tau & 7;
            const f32x4 acc = mma_tile<64>(lds + HG_VT + vi * 16 * 144, 144, lds + HG_PT + ti * 16 * 144, 144, fr, fq);
            v2u w; w.x = pk2(acc[0], acc[1]); w.y = pk2(acc[2], acc[3]);
            *(v2u*)(OINTRA + (row0 + 16 * ti + fr) * A_W + h * HD + 16 * vi + 4 * fq) = w; }
#pragma unroll
        for (int k = 0; k < 8; ++k) { const int tau = wid + 8 * k, vi = tau >> 3, ki = tau & 7;
            const f32x4 acc = mma_tile<64>(lds + HG_KH + ki * 16 * 144, 144, lds + HG_VT + vi * 16 * 144, 144, fr, fq);
            v2u w; w.x = pk2(acc[0], acc[1]); w.y = pk2(acc[2], acc[3]);
            *(v2u*)(DS + ((size_t)it * HD + 16 * vi + fr) * HD + 16 * ki + 4 * fq) = w; }
        LDS_WAIT(); __syncthreads();
    }
}
__device__ __forceinline__ void hgrn_phase_b(Frame& F, const bf16* DS, const float* DEC, bf16* SPREV) {
    const int tid = F.tid, dvl = tid >> 5, dk4 = (tid & 31) * 4;
    for (int item = F.bid; item < BATCH * A_HEADS * 8; item += F.G) {
        const int sl = item & 7, bh = item >> 3, dv = sl * 16 + dvl;
        f32x4 S = {0.f, 0.f, 0.f, 0.f};
        for (int c0 = 0; c0 < HG_NC; c0 += 8) {
            f32x4 ds[8], dc[8];
#pragma unroll
            for (int k = 0; k < 8; ++k) { const size_t it = (size_t)bh * HG_NC + c0 + k; const v2u x = *(const v2u*)(DS + (it * HD + dv) * HD + dk4);
                ds[k] = (f32x4){bflo(x.x), bfhi(x.x), bflo(x.y), bfhi(x.y)}; dc[k] = *(const f32x4*)(DEC + it * HD + dk4); }
#pragma unroll
            for (int k = 0; k < 8; ++k) { const size_t it = (size_t)bh * HG_NC + c0 + k;
                v2u w; w.x = pk2(S.x, S.y); w.y = pk2(S.z, S.w); *(v2u*)(SPREV + (it * HD + dv) * HD + dk4) = w;
                S = S * dc[k] + ds[k]; }
        }
    }
}
__device__ __forceinline__ void hgrn_phase_c(Frame& F, const bf16* P0, const bf16* QTg, const bf16* OINTRA, const bf16* SPREV, const float* nw, bf16* Ob) {
    LAS char* lds = (LAS char*)F.lds;
    const int tid = F.tid, wid = F.wave, lane = F.lane, fr = lane & 15, fq = lane >> 4;
    for (int it = F.bid; it < HG_ITEMS; it += F.G) {
        const int c = it % HG_NC, bh = it / HG_NC, h = bh % A_HEADS, b = bh / A_HEADS;
        const size_t row0 = (size_t)b * SEQ + (size_t)c * HG_CH;
        { const int s = tid >> 3, ch = (tid & 7) * 16; const bf16* src = QTg + (row0 + s) * A_W + h * HD + ch;
          const v4u x0 = *(const v4u*)src, x1 = *(const v4u*)(src + 8); LAS v4u* dst = (LAS v4u*)(lds + HG_QT + s * 272 + ch * 2); dst[0] = x0; dst[1] = x1; }
        { const int dv = tid >> 2, ch = (tid & 3) * 32; const bf16* src = SPREV + ((size_t)it * HD + dv) * HD + ch;
          const v4u x0 = *(const v4u*)src, x1 = *(const v4u*)(src + 8), x2 = *(const v4u*)(src + 16), x3 = *(const v4u*)(src + 24);
          LAS v4u* dst = (LAS v4u*)(lds + HG_SP + dv * 272 + ch * 2); dst[0] = x0; dst[1] = x1; dst[2] = x2; dst[3] = x3; }
        LDS_WAIT(); __syncthreads();
#pragma unroll
        for (int k = 0; k < 4; ++k) { const int tau = wid + 8 * k, ti = tau >> 3, vi = tau & 7;
            const f32x4 acc = mma_tile<128>(lds + HG_SP + vi * 16 * 272, 272, lds + HG_QT + ti * 16 * 272, 272, fr, fq);
            const int t = 16 * ti + fr, dv = 16 * vi + 4 * fq; const v2u oi = *(const v2u*)(OINTRA + (row0 + t) * A_W + h * HD + dv);
            *(LAS f32x4*)(lds + HG_OT + (t * 132 + dv) * 4) = (f32x4){acc[0] + bflo(oi.x), acc[1] + bfhi(oi.x), acc[2] + bflo(oi.y), acc[3] + bfhi(oi.y)}; }
        LDS_WAIT(); __syncthreads();
        { const int t = tid >> 3, dv0 = (tid & 7) * 16;
          float v[16]; float ss = 0.f;
#pragma unroll
          for (int q4 = 0; q4 < 4; ++q4) { const f32x4 x = *(const LAS f32x4*)(lds + HG_OT + (t * 132 + dv0 + 4 * q4) * 4); v[4 * q4] = x.x; v[4 * q4 + 1] = x.y; v[4 * q4 + 2] = x.z; v[4 * q4 + 3] = x.w;
              ss += (x.x * x.x + x.y * x.y) + (x.z * x.z + x.w * x.w); }
          ss += __shfl_xor(ss, 1); ss += __shfl_xor(ss, 2); ss += __shfl_xor(ss, 4);
          const float r = 1.f / sqrtf(ss * (1.f / HD) + RMS_EPS);
          const bf16* gp = P0 + (row0 + t) * AB_IN + 3 * A_W + h * HD + dv0; const v4u g0 = *(const v4u*)gp, g1 = *(const v4u*)(gp + 8);
          const unsigned gw[8] = {g0.x, g0.y, g0.z, g0.w, g1.x, g1.y, g1.z, g1.w}; unsigned o[8];
#pragma unroll
          for (int j = 0; j < 8; ++j) { const float ga = bflo(gw[j]), gb = bfhi(gw[j]);
              o[j] = pk2(v[2 * j] * r * nw[dv0 + 2 * j] * ga * sigmoidf_(ga), v[2 * j + 1] * r * nw[dv0 + 2 * j + 1] * gb * sigmoidf_(gb)); }
          bf16* op = Ob + (row0 + t) * DM + h * HD + dv0; *(v4u*)op = (v4u){o[0], o[1], o[2], o[3]}; *(v4u*)(op + 8) = (v4u){o[4], o[5], o[6], o[7]}; }
        LDS_WAIT(); __syncthreads();
    }
}

constexpr float SB_CUT = -160.f;
__device__ __forceinline__ void sb_phase(Frame& F, const bf16* P0, bf16* Ob) {
    const int tid = F.tid, wid = F.wave, lane = F.lane, r32 = lane & 31, hi = lane >> 5;
    LAS char* lds = (LAS char*)F.lds;
    const int vb0 = (int)(uintptr_t)(lds + ATT_V_OFF) + v_rd_base(lane);
    KVDma dm; kv_dma_init(dm, AB_IN, AB_IN, wid, lane);
    constexpr int NQB = SEQ / 256, NU = BATCH * B_HEADS * NQB;
    for (int rd = 0; ; ++rd) {
        const int idx = (rd & 1) ? rd * F.G + (F.G - 1 - F.bid) : rd * F.G + F.bid;
        if (rd * F.G >= NU) break;
        if (idx >= NU) continue;
        const int qb = NQB - 1 - idx / (BATCH * B_HEADS), bh = idx % (BATCH * B_HEADS), head = bh % B_HEADS, b = bh / B_HEADS;
        const size_t rowb = (size_t)b * SEQ; const int q0 = qb * 256;
        const bf16* Kh = P0 + rowb * AB_IN + 4 * A_W + B_W + head * HD; const bf16* Vh = Kh + B_W;
        const int tw0 = q0 + wid * 32, t = tw0 + r32;
        bf16x8 qr[8]; load_q(qr, P0 + (rowb + t) * AB_IN + 4 * A_W + head * HD + hi * 8);
        float R = 0.f; f32x16 o[4] = {};
        const int jtop = (q0 + 254) >> 6;
        LAS unsigned* dflag = (LAS unsigned*)(lds + ATT_X_OFF);
        if (lane == 0) { dflag[wid] = 0u; dflag[8 + wid] = 0u; }
        LDS_WAIT(); __syncthreads();
        kv_dma(dm, Kh + (size_t)jtop * KVBLK * AB_IN, Vh + (size_t)jtop * KVBLK * AB_IN, lds, 0, wid);
        int buf = 0;
        for (int j = jtop; j >= 0; --j, buf = ATT_BUF - buf) {
            VM_WAIT(); __syncthreads();
            { unsigned alld = 1u;
#pragma unroll
              for (int w = 0; w < NWAVES; ++w) alld &= dflag[((j + 1) & 1) * 8 + w];
              if (__builtin_amdgcn_readfirstlane(alld)) break; }
            if (j > 0) kv_dma(dm, Kh + (size_t)(j - 1) * KVBLK * AB_IN, Vh + (size_t)(j - 1) * KVBLK * AB_IN, lds, ATT_BUF - buf, wid);
            const int k0 = j * KVBLK;
            if (k0 < tw0 + 31) {
                f32x16 p0, p1; qkt(p0, p1, lds + buf + ATT_K_OFF, qr, r32, hi);
                const bool need_mask = (k0 + 63 >= tw0);
                float L0[16], L1[16];
#pragma unroll
                for (int r = 0; r < 16; ++r) {
                    const float z0 = p0[r] * ATT_C, z1 = p1[r] * ATT_C;
                    float l0 = -(fmaxf(z0, 0.f) + __builtin_amdgcn_logf(1.f + __builtin_amdgcn_exp2f(-fabsf(z0))));
                    float l1 = -(fmaxf(z1, 0.f) + __builtin_amdgcn_logf(1.f + __builtin_amdgcn_exp2f(-fabsf(z1))));
                    if (need_mask) { if (k0 + crow(r, hi) >= t) l0 = 0.f; if (k0 + 32 + crow(r, hi) >= t) l1 = 0.f; }
                    L0[r] = l0; L1[r] = l1; p0[r] = z0 + l0; p1[r] = z1 + l1;
                }
                SBAR();
                float Sg[16];
#pragma unroll
                for (int gi = 0; gi < 4; ++gi) {
                    const float a = (L0[4 * gi] + L0[4 * gi + 1]) + (L0[4 * gi + 2] + L0[4 * gi + 3]), c = (L1[4 * gi] + L1[4 * gi + 1]) + (L1[4 * gi + 2] + L1[4 * gi + 3]);
                    auto ra = __builtin_amdgcn_permlane32_swap(__float_as_uint(a), __float_as_uint(a), false, false);
                    auto rc = __builtin_amdgcn_permlane32_swap(__float_as_uint(c), __float_as_uint(c), false, false);
                    Sg[2 * gi] = __uint_as_float(ra[0]); Sg[2 * gi + 1] = __uint_as_float(ra[1]); Sg[8 + 2 * gi] = __uint_as_float(rc[0]); Sg[8 + 2 * gi + 1] = __uint_as_float(rc[1]);
                }
                float run = R;
#pragma unroll
                for (int s = 15; s >= 0; --s) { const float tt = run; run += Sg[s]; Sg[s] = tt; }
                const float Rn = run;
                SBAR();
#pragma unroll
                for (int gi = 0; gi < 4; ++gi) {
                    float base0 = hi ? Sg[2 * gi + 1] : Sg[2 * gi], base1 = hi ? Sg[8 + 2 * gi + 1] : Sg[8 + 2 * gi];
                    float r3 = base0, r2 = r3 + L0[4 * gi + 3], r1 = r2 + L0[4 * gi + 2], r0 = r1 + L0[4 * gi + 1];
                    p0[4 * gi + 3] = __builtin_amdgcn_exp2f(p0[4 * gi + 3] + r3); p0[4 * gi + 2] = __builtin_amdgcn_exp2f(p0[4 * gi + 2] + r2);
                    p0[4 * gi + 1] = __builtin_amdgcn_exp2f(p0[4 * gi + 1] + r1); p0[4 * gi + 0] = __builtin_amdgcn_exp2f(p0[4 * gi + 0] + r0);
                    r3 = base1; r2 = r3 + L1[4 * gi + 3]; r1 = r2 + L1[4 * gi + 2]; r0 = r1 + L1[4 * gi + 1];
                    p1[4 * gi + 3] = __builtin_amdgcn_exp2f(p1[4 * gi + 3] + r3); p1[4 * gi + 2] = __builtin_amdgcn_exp2f(p1[4 * gi + 2] + r2);
                    p1[4 * gi + 1] = __builtin_amdgcn_exp2f(p1[4 * gi + 1] + r1); p1[4 * gi + 0] = __builtin_amdgcn_exp2f(p1[4 * gi + 0] + r0);
                }
                R = Rn;
                { const unsigned dn = __all(R < SB_CUT) ? 1u : 0u; if (lane == 0) dflag[(j & 1) * 8 + wid] = dn; }
                if (need_mask) {
#pragma unroll
                    for (int r = 0; r < 16; ++r) { if (k0 + crow(r, hi) >= t) p0[r] = 0.f; if (k0 + 32 + crow(r, hi) >= t) p1[r] = 0.f; }
                }
                bf16x8 pa0, pa1, pa2, pa3; pack_p(p0, p1, pa0, pa1, pa2, pa3);
                pv_d0(o, vb0 + buf, pa0, pa1, pa2, pa3);
            }
        }
        bf16* Ow = Ob + (rowb + tw0) * DM + A_W + head * HD;
#pragma unroll
        for (int r = 0; r < 16; ++r) { const int orow = crow(r, hi);
#pragma unroll
            for (int d0 = 0; d0 < 4; ++d0) Ow[(size_t)orow * DM + d0 * 32 + r32] = (bf16)f2bf(o[d0][r]); }
    }
}

constexpr int P1_KC = 4096, P1_VC = 4608, P1_KS = 5120, P1_VS = 5632, P1_KW = 6144, P1_VW = 6656, P1_GL = 7168;
__device__ __forceinline__ void nsa_rope_phase(Frame& F, const bf16* P1, const float* TAB, bf16* QROT, bf16* KSROT, bf16* KWROT, bf16* OVL) {
    const int gw = F.bid * NWAVES + F.wave, NGW = F.G * NWAVES, lane = F.lane, hsub = lane >> 3, d0 = (lane & 7) * 8;
    for (int m = gw; m < MTOK; m += NGW) {
        const int t = m & (SEQ - 1);
        const f32x4 c0 = *(const f32x4*)(TAB + (size_t)t * 128 + d0), c1 = *(const f32x4*)(TAB + (size_t)t * 128 + d0 + 4);
        const f32x4 s0 = *(const f32x4*)(TAB + (size_t)t * 128 + 64 + d0), s1 = *(const f32x4*)(TAB + (size_t)t * 128 + 64 + d0 + 4);
        const float cs[8] = {c0.x, c0.y, c0.z, c0.w, c1.x, c1.y, c1.z, c1.w}, sn[8] = {s0.x, s0.y, s0.z, s0.w, s1.x, s1.y, s1.z, s1.w};
        const bf16* row = P1 + (size_t)m * NSA_INP;
#pragma unroll
        for (int hb = 0; hb < 5; ++hb) {
            const int hh = hb * 8 + hsub;
            const bf16* src; bf16* dst;
            if (hh < 32) { src = row + hh * HD; dst = QROT + (size_t)m * DM + hh * HD; }
            else if (hh < 36) { src = row + P1_KS + (hh - 32) * HD; dst = KSROT + (size_t)m * KVW + (hh - 32) * HD; }
            else { src = row + P1_KW + (hh - 36) * HD; dst = KWROT + (size_t)m * KVW + (hh - 36) * HD; }
            const v4u a = *(const v4u*)(src + d0), bq = *(const v4u*)(src + 64 + d0);
            const unsigned aw[4] = {a.x, a.y, a.z, a.w}, bw[4] = {bq.x, bq.y, bq.z, bq.w}; unsigned o1[4], o2[4];
#pragma unroll
            for (int q = 0; q < 4; ++q) { const float x1l = bflo(aw[q]), x1h = bfhi(aw[q]), x2l = bflo(bw[q]), x2h = bfhi(bw[q]);
                o1[q] = pk2(x1l * cs[2 * q] - x2l * sn[2 * q], x1h * cs[2 * q + 1] - x2h * sn[2 * q + 1]);
                o2[q] = pk2(x2l * cs[2 * q] + x1l * sn[2 * q], x2h * cs[2 * q + 1] + x1h * sn[2 * q + 1]); }
            *(v4u*)(dst + d0) = (v4u){o1[0], o1[1], o1[2], o1[3]}; *(v4u*)(dst + 64 + d0) = (v4u){o2[0], o2[1], o2[2], o2[3]};
        }
    }
    for (int i = F.bid * NTHR + F.tid; i < NCMPP * NSLC; i += F.G * NTHR) { const int n = i / NSLC, j = i % NSLC;
        OVL[i] = (n < NCMP && n >= 4 * j - 1 && n <= 4 * j + 3) ? (bf16)0x3f80u : (bf16)0u; }
}
constexpr int CM_A = 0, CM_B = 17408, CM_H = 17408 + 34816;
__device__ __forceinline__ void nsa_compress_phase(Frame& F, const bf16* P1, const float* pos, const bf16* W1t, const bf16* W2t, bf16* KCMP, bf16* VCMP) {
    LAS char* lds = (LAS char*)F.lds;
    const int tid = F.tid, wid = F.wave, lane = F.lane, fr = lane & 15, fq = lane >> 4;
    for (int item = F.bid; item < 128; item += F.G) {
        const int nt = item & 7, g = (item >> 3) & 3, b = (item >> 5) & 1, which = item >> 6;
        const bf16* w1 = W1t + (size_t)which * HD * 32 * HD; const bf16* w2 = W2t + (size_t)which * HD * HD;
        const float* posw = pos + (size_t)which * 32 * HD;
        f32x4 acc[4];
#pragma unroll
        for (int k = 0; k < 4; ++k) acc[k] = (f32x4){0.f, 0.f, 0.f, 0.f};
        for (int l = 0; l < 32; ++l) {
            { const int r = tid >> 3, ch = (tid & 7) * 16, n = nt * 64 + r; unsigned w[8];
              if (n < NCMP) { const bf16* src = P1 + ((size_t)b * SEQ + 16 * n + l) * NSA_INP + P1_KC + which * KVW + g * HD + ch;
                  const v4u x0 = *(const v4u*)src, x1 = *(const v4u*)(src + 8); const unsigned xs[8] = {x0.x, x0.y, x0.z, x0.w, x1.x, x1.y, x1.z, x1.w};
#pragma unroll
                  for (int q = 0; q < 8; ++q) w[q] = pk2(bflo(xs[q]) + posw[l * HD + ch + 2 * q], bfhi(xs[q]) + posw[l * HD + ch + 2 * q + 1]);
              } else {
#pragma unroll
                  for (int q = 0; q < 8; ++q) w[q] = 0u; }
              LAS v4u* dst = (LAS v4u*)(lds + CM_A + r * 272 + ch * 2); dst[0] = (v4u){w[0], w[1], w[2], w[3]}; dst[1] = (v4u){w[4], w[5], w[6], w[7]}; }
            { const int e = tid >> 2, ch = (tid & 3) * 32; const bf16* src = w1 + (size_t)e * 32 * HD + l * HD + ch;
              const v4u x0 = *(const v4u*)src, x1 = *(const v4u*)(src + 8), x2 = *(const v4u*)(src + 16), x3 = *(const v4u*)(src + 24);
              LAS v4u* dst = (LAS v4u*)(lds + CM_B + e * 272 + ch * 2); dst[0] = x0; dst[1] = x1; dst[2] = x2; dst[3] = x3; }
            LDS_WAIT(); __syncthreads();
#pragma unroll
            for (int k = 0; k < 4; ++k) { const int tau = wid + 8 * k, ni = tau >> 3, ei = tau & 7;
                acc[k] += mma_tile<128>(lds + CM_A + ni * 16 * 272, 272, lds + CM_B + ei * 16 * 272, 272, fr, fq); }
            LDS_WAIT(); __syncthreads();
        }
#pragma unroll
        for (int k = 0; k < 4; ++k) { const int tau = wid + 8 * k, ni = tau >> 3, ei = tau & 7;
#pragma unroll
            for (int i = 0; i < 4; ++i) *(LAS unsigned short*)(lds + CM_H + (16 * ni + 4 * fq + i) * 272 + (16 * ei + fr) * 2) = (unsigned short)f2bf(gelu1(acc[k][i])); }
        { const int f = tid >> 2, ch = (tid & 3) * 32; const bf16* src = w2 + (size_t)f * HD + ch;
          const v4u x0 = *(const v4u*)src, x1 = *(const v4u*)(src + 8), x2 = *(const v4u*)(src + 16), x3 = *(const v4u*)(src + 24);
          LAS v4u* dst = (LAS v4u*)(lds + CM_B + f * 272 + ch * 2); dst[0] = x0; dst[1] = x1; dst[2] = x2; dst[3] = x3; }
        LDS_WAIT(); __syncthreads();
        bf16* outp = which ? VCMP : KCMP;
#pragma unroll
        for (int k = 0; k < 4; ++k) { const int tau = wid + 8 * k, ni = tau >> 3, fi = tau & 7;
            const f32x4 a2 = mma_tile<128>(lds + CM_H + ni * 16 * 272, 272, lds + CM_B + fi * 16 * 272, 272, fr, fq);
#pragma unroll
            for (int i = 0; i < 4; ++i) { const int n = nt * 64 + 16 * ni + 4 * fq + i;
                outp[(((size_t)b * NCMPP + n) * NSA_G + g) * HD + 16 * fi + fr] = (n < NCMP) ? (bf16)f2bf(a2[i]) : (bf16)0u; } }
        LDS_WAIT(); __syncthreads();
    }
}
__device__ __forceinline__ unsigned pick4(const unsigned (&a)[4], int i) { return i == 0 ? a[0] : (i == 1 ? a[1] : (i == 2 ? a[2] : a[3])); }
template <int MODE>
__device__ __forceinline__ void nsa_attn_phase(Frame& F, const bf16* P1, const bf16* Qsrc, const bf16* Ksrc, const bf16* Vsrc, const unsigned* SEL, float* O32, float* IMP, bf16* Ob, bool probe_nostore = false) {
    const int tid = F.tid, wid = F.wave, lane = F.lane, r32 = lane & 31, hi = lane >> 5;
    LAS char* lds = (LAS char*)F.lds;
    LAS float* wsc = (LAS float*)(lds + ATT_WS_OFF + wid * 256);
    const int vb0 = (int)(uintptr_t)(lds + ATT_V_OFF) + v_rd_base(lane);
    KVDma dm; kv_dma_init(dm, MODE <= 1 ? NSA_G * HD : KVW, MODE == 0 ? NSA_G * HD : (MODE == 1 ? NSLC : NSA_INP), wid, lane);
    constexpr int NTB = SEQ / 32, NU = BATCH * NSA_G * NTB;
    for (int rd = 0; ; ++rd) {
        int idx;
        { idx = (rd & 1) ? rd * F.G + (F.G - 1 - F.bid) : rd * F.G + F.bid; if (rd * F.G >= NU) break; if (idx >= NU) continue; }
        const int tb = NTB - 1 - idx / (BATCH * NSA_G), bg = idx % (BATCH * NSA_G), g = bg % NSA_G, b = bg / NSA_G;
        const size_t rowb = (size_t)b * SEQ; const int t0 = tb * 32;
        const int t = (MODE == 2) ? t0 + 4 * wid + (r32 >> 3) : t0 + r32, head = (MODE == 2) ? g * NSA_R + (r32 & 7) : g * NSA_R + wid;
        const bf16* Kh; const bf16* Vh; long ldk, ldv; int jlo, jhi;
        if (MODE <= 1) { Kh = Ksrc + ((size_t)b * NCMPP * NSA_G + g) * HD; ldk = NSA_G * HD; jlo = 0; jhi = (t0 >> 4) >> 6;
            if (MODE == 0) { Vh = Vsrc + ((size_t)b * NCMPP * NSA_G + g) * HD; ldv = NSA_G * HD; } else { Vh = Vsrc; ldv = NSLC; } }
        else { Kh = Ksrc + rowb * KVW + g * HD; ldk = KVW; Vh = P1 + rowb * NSA_INP + (MODE == 2 ? P1_VS : P1_VW) + g * HD; ldv = NSA_INP;
            jhi = (t0 + 31) >> 6; jlo = (MODE == 2) ? 0 : ((t0 - (WINDOW - 1) > 0 ? t0 - (WINDOW - 1) : 0) >> 6); }
        unsigned wn[4] = {~0u, ~0u, ~0u, ~0u};
        if (MODE == 2) { const v4u sv = *(const v4u*)(SEL + ((rowb + t) * NSA_G + g) * 4); unsigned selw[4]; selw[0] = sv.x; selw[1] = sv.y; selw[2] = sv.z; selw[3] = sv.w;
            *(LAS v4u*)(lds + ATT_X_OFF + 2048 + (wid * 64 + lane) * 16) = sv;
            LAS unsigned* un = (LAS unsigned*)(lds + ATT_X_OFF);
#pragma unroll
            for (int q = 0; q < 4; ++q) { unsigned x = selw[q]; x |= __shfl_xor(x, 8); x |= __shfl_xor(x, 16); wn[q] = __builtin_amdgcn_readfirstlane(x); if (lane == 0) un[wid * 4 + q] = wn[q]; }
            LDS_WAIT(); __syncthreads();
            LAS int* plist = (LAS int*)(lds + ATT_X_OFF + 128);
            if (wid == 0) {
                unsigned m0 = 0u, m1 = 0u;
                int lane_l = lane; asm volatile("" : "+v"(lane_l));
                const LAS unsigned* ub = un + (lane_l >> 5);
#pragma unroll
                for (int w = 0; w < NWAVES; ++w) { m0 |= ((ub[w * 4] >> (lane & 31)) & 1u) << w; m1 |= ((ub[w * 4 + 2] >> (lane & 31)) & 1u) << w; }
                bool v0 = m0 != 0u && lane <= jhi, v1 = m1 != 0u && lane + 64 <= jhi; int np = 0;
                for (;;) {
                    const unsigned long long a0 = __ballot(v0), a1 = __ballot(v1);
                    if (!(a0 | a1)) break;
                    const int ja_ = a0 ? __builtin_ctzll(a0) : 64 + __builtin_ctzll(a1);
                    const unsigned ma = (ja_ < 64) ? (unsigned)__shfl((int)m0, ja_) : (unsigned)__shfl((int)m1, ja_ - 64);
                    if (lane == (ja_ & 63)) { if (ja_ < 64) v0 = false; else v1 = false; }
                    unsigned long long c0 = __ballot(v0 && !(m0 & ma)), c1 = __ballot(v1 && !(m1 & ma));
                    if (!(c0 | c1)) { c0 = __ballot(v0 && m0 == 0xffu); c1 = __ballot(v1 && m1 == 0xffu); }
                    if (!(c0 | c1)) { c0 = __ballot(v0); c1 = __ballot(v1); }
                    int jb_ = -1;
                    if (c0 | c1) { jb_ = c0 ? __builtin_ctzll(c0) : 64 + __builtin_ctzll(c1); if (lane == (jb_ & 63)) { if (jb_ < 64) v0 = false; else v1 = false; } }
                    if (lane == 0) { plist[2 * np] = ja_; plist[2 * np + 1] = jb_; }
                    ++np;
                }
                if (lane == 0) { int neg1 = -1; asm volatile("" : "+v"(neg1)); plist[2 * np] = neg1; plist[2 * np + 1] = neg1; }
            }
            LDS_WAIT(); }
        bf16x8 qr[8]; load_q(qr, Qsrc + (rowb + t) * (MODE <= 1 ? NSA_INP : DM) + head * HD + hi * 8);
        float m_reg = -1e30f, l_reg = 0.f; f32x16 o[4] = {};
        const int cur = t >> 6;
#define NSA_NEED(jj) (MODE != 2 || ((pick4(wn, (jj) >> 5) >> ((jj) & 31)) & 1u))
#define NSA_MASK(P0, P1, JJ) do { const int k0 = (JJ) * KVBLK; constexpr float NINF = -__builtin_inff(); \
            if (MODE <= 1) { if (!(16 * (k0 + 63) + 31 <= t0)) { \
                    _Pragma("unroll") for (int r = 0; r < 16; ++r) { if (!(16 * (k0 + crow(r, hi)) + 31 <= t)) P0[r] = NINF; if (!(16 * (k0 + 32 + crow(r, hi)) + 31 <= t)) P1[r] = NINF; } } } \
            else if (MODE == 2) { const bool mine = (*(const LAS unsigned*)(lds + ATT_X_OFF + 2048 + (wid * 64 + lane) * 16 + ((JJ) >> 5) * 4) >> ((JJ) & 31)) & 1u; const int lim = mine ? ((JJ) < cur ? 0x7fffffff : t) : -1; \
                _Pragma("unroll") for (int r = 0; r < 16; ++r) { if (k0 + crow(r, hi) > lim) P0[r] = NINF; if (k0 + 32 + crow(r, hi) > lim) P1[r] = NINF; } } \
            else { if (!((k0 > t0 + 31 - WINDOW) && (k0 + 63 <= t0))) { \
                    _Pragma("unroll") for (int r = 0; r < 16; ++r) { const int ka = k0 + crow(r, hi), kb = ka + 32; \
                        if (!(ka <= t && ka > t - WINDOW)) P0[r] = NINF; if (!(kb <= t && kb > t - WINDOW)) P1[r] = NINF; } } } } while (0)
        const int pbase = __builtin_amdgcn_readfirstlane((int)(uintptr_t)(lds + ATT_X_OFF + 128)); int pp = 0;
#define PLIST(i) (*(const LAS int*)(uintptr_t)(unsigned)(pbase + 4 * (i)))
        int ja, jb;
        __syncthreads();
        if (MODE == 2) { ja = PLIST(0); jb = PLIST(1); ja = __builtin_amdgcn_readfirstlane(ja); jb = __builtin_amdgcn_readfirstlane(jb); if (ja < 0) ja = jhi + 1; }
        else { ja = jlo; jb = ja + 1; if (jb > jhi) jb = -1; }
        if (ja <= jhi) kv_dma(dm, Kh + (size_t)ja * KVBLK * ldk, Vh + (size_t)ja * KVBLK * ldv, lds, 0, wid);
        if (jb >= 0) kv_dma(dm, Kh + (size_t)jb * KVBLK * ldk, Vh + (size_t)jb * KVBLK * ldv, lds, ATT_BUF, wid);
        int set = 0;
#pragma nounroll
        while (ja <= jhi) {
            int jc, jd;
            if (MODE == 2) { ++pp; jc = PLIST(2 * pp); jd = PLIST(2 * pp + 1); jc = __builtin_amdgcn_readfirstlane(jc); jd = __builtin_amdgcn_readfirstlane(jd); if (jc < 0) jc = jhi + 1; }
            else { jc = (jb >= 0 ? jb : ja) + 1; jd = jc + 1; if (jd > jhi) jd = -1; }
            VM_WAIT(); __syncthreads();
            if (jc <= jhi) kv_dma(dm, Kh + (size_t)jc * KVBLK * ldk, Vh + (size_t)jc * KVBLK * ldv, lds, ATT_SET - set, wid);
            if (jc <= jhi && jd >= 0) kv_dma(dm, Kh + (size_t)jd * KVBLK * ldk, Vh + (size_t)jd * KVBLK * ldv, lds, ATT_SET - set + ATT_BUF, wid);
            const bool nA = NSA_NEED(ja), nB = (jb >= 0) && NSA_NEED(jb);
            f32x16 a0, a1, b0, b1;
            if (nA) qkt(a0, a1, lds + set + ATT_K_OFF, qr, r32, hi);
            if (nB) qkt(b0, b1, lds + set + ATT_BUF + ATT_K_OFF, qr, r32, hi);
            if (nA) { NSA_MASK(a0, a1, ja); attn_finish(a0, a1, o, m_reg, l_reg, wsc, vb0 + set, r32, hi); }
            if (nB) { NSA_MASK(b0, b1, jb); attn_finish(b0, b1, o, m_reg, l_reg, wsc, vb0 + set + ATT_BUF, r32, hi); }
            ja = jc; jb = (jc <= jhi) ? jd : -1; set = ATT_SET - set;
        }
#undef PLIST
#undef NSA_MASK
#undef NSA_NEED
        { float fac = l_reg > 0.f ? __builtin_amdgcn_rcpf(l_reg) : 0.f;
          if (MODE != 1) { const int br = MODE == 0 ? 0 : (MODE == 2 ? 1 : 2); fac *= sigmoidf_(bf2f(P1[(rowb + t) * NSA_INP + P1_GL + head * 3 + br])); }
          if (hi == 0) wsc[32 + r32] = fac; LDS_WAIT(); }
        if (MODE == 1) {
            float fc[16];
#pragma unroll
            for (int r = 0; r < 16; ++r) fc[r] = wsc[32 + crow(r, hi)];
            LDS_WAIT(); __syncthreads();
#pragma unroll
            for (int r = 0; r < 16; ++r) { const int orow = crow(r, hi);
#pragma unroll
                for (int d0 = 0; d0 < 4; ++d0) *(LAS float*)(lds + ((wid * 32 + orow) * 128 + d0 * 32 + r32) * 4) = o[d0][r] * fc[r]; }
            LDS_WAIT(); __syncthreads();
            { const int tok = tid >> 4, j8 = (tid & 15) * 8; f32x4 s0 = {0.f, 0.f, 0.f, 0.f}, s1 = {0.f, 0.f, 0.f, 0.f};
#pragma unroll
              for (int w = 0; w < 8; ++w) { const LAS f32x4* pp = (const LAS f32x4*)(lds + ((w * 32 + tok) * 128 + j8) * 4); s0 += pp[0]; s1 += pp[1]; }
              f32x4* dst = (f32x4*)(IMP + ((rowb + t0 + tok) * NSA_G + g) * NSLC + j8); dst[0] = s0; dst[1] = s1; }
            LDS_WAIT(); __syncthreads();
        } else {
#pragma unroll
            for (int r = 0; r < 16; ++r) { const int orow = crow(r, hi); const float fc = wsc[32 + orow];
                const size_t off = (MODE == 2) ? (rowb + t0 + 4 * wid + (orow >> 3)) * DM + (g * NSA_R + (orow & 7)) * HD + r32 : (rowb + t0 + orow) * DM + head * HD + r32;
#pragma unroll
                for (int d0 = 0; d0 < 4; ++d0) {
                    if (MODE == 0) O32[off + d0 * 32] = o[d0][r] * fc;
                    else if (MODE == 3) { if (!probe_nostore) O32[off + d0 * 32] += o[d0][r] * fc; }
                    else Ob[off + d0 * 32] = (bf16)f2bf(O32[off + d0 * 32] + o[d0][r] * fc); } }
            LDS_WAIT();
        }
    }
}
__device__ __forceinline__ void nsa_topk_phase(Frame& F, const float* IMP, unsigned* SEL) {
    LAS float* sc = (LAS float*)(F.lds + F.wave * 1024);
    const int gw = F.bid * NWAVES + F.wave, NGW = F.G * NWAVES, lane = F.lane;
    for (int it = gw; it < MTOK * NSA_G; it += NGW) {
        const int m = it / NSA_G, t = m & (SEQ - 1), cur = t >> 6;
        const float* ip = IMP + (size_t)it * NSLC;
        const float a0 = ip[lane], a1 = ip[64 + lane];
        sc[lane] = a0; sc[64 + lane] = a1; LDS_WAIT();
        const int j0 = lane, j1 = lane + 64;
        const bool f0 = (j0 == 0) || (j0 == cur) || (j0 == cur - 1), f1 = (j1 == cur) || (j1 == cur - 1);
        const bool c0 = !f0 && j0 <= cur, c1 = !f1 && j1 <= cur;
        const int nforced = cur >= 2 ? 3 : cur + 1, slots = NTOP - nforced;
        int rk0 = 0, rk1 = 0;
        const int ncand_hi = cur < NSLC ? cur : NSLC - 1;
        for (int i = 1; i <= ncand_hi; ++i) {
            const bool fi = (i == cur) || (i == cur - 1); if (fi) continue;
            const float v = sc[i];
            rk0 += (v > a0 || (v == a0 && i < j0)) ? 1 : 0; rk1 += (v > a1 || (v == a1 && i < j1)) ? 1 : 0;
        }
        const bool s0 = (f0 && j0 <= cur) || (c0 && rk0 < slots), s1 = (f1 && j1 <= cur) || (c1 && rk1 < slots);
        const unsigned long long m0 = __ballot(s0), m1 = __ballot(s1);
        if (lane == 0) { v4u w = {(unsigned)m0, (unsigned)(m0 >> 32), (unsigned)m1, (unsigned)(m1 >> 32)}; *(v4u*)(SEL + (size_t)it * 4) = w; }
        LDS_WAIT();
    }
}

#ifndef STAGE
#define STAGE 3
#endif
#define ZERO_OB_PHASE PH_BEGIN { v4u z = {0u, 0u, 0u, 0u}; v4u* p = (v4u*)Ob; const long n = (long)MTOK * DM / 8; \
            for (long i = (long)F.bid * NTHR + F.tid; i < n; i += (long)F.G * NTHR) p[i] = z; } PH_END
#define MIXER0_PHASES \
    PH_BEGIN { fold_finalize(F, FO_XQ, XW); fold_finalize(F, FO_UP, DFF2); } \
             REP(10) hgrn_phase_a(F, BIG, (const float*)(ws + WS_LB), (bf16*)(ws + WS_QT), (bf16*)(ws + WS_OINTRA), (bf16*)(ws + WS_DS), (float*)(ws + WS_DEC)); \
             REP(11) sb_phase(F, BIG, Ob); PH_END \
    PH_BEGIN REP(12) hgrn_phase_b(F, (const bf16*)(ws + WS_DS), (const float*)(ws + WS_DEC), (bf16*)(ws + WS_SPREV)); PH_END \
    PH_BEGIN REP(13) hgrn_phase_c(F, BIG, (const bf16*)(ws + WS_QT), (const bf16*)(ws + WS_OINTRA), (const bf16*)(ws + WS_SPREV), KIN(IN_HGRN_NW), Ob); PH_END
#if STAGE <= 2
#define MIXER1_PHASES ZERO_OB_PHASE
#else
#define MIXER1_PHASES \
    PH_BEGIN { fold_finalize(F, FO_XQ + XW, XW); } REP(14) { nsa_rope_phase(F, BIG, (const float*)(ws + WS_ROPE), (bf16*)(ws + WS_QROT), (bf16*)(ws + WS_KSROT), (bf16*)(ws + WS_KWROT), (bf16*)(ws + WS_OVL)); \
             nsa_compress_phase(F, BIG, KIN(IN_NSA_CMP_POS), (const bf16*)(ws + WS_W_C1), (const bf16*)(ws + WS_W_C2), (bf16*)(ws + WS_KCMP), (bf16*)(ws + WS_VCMP)); } PH_END \
    PH_BEGIN { REP(15) nsa_attn_phase<0>(F, BIG, BIG, (const bf16*)(ws + WS_KCMP), (const bf16*)(ws + WS_VCMP), nullptr, (float*)(ws + WS_O32), nullptr, nullptr); \
             F.fresh(); REP(15) nsa_attn_phase<1>(F, BIG, BIG, (const bf16*)(ws + WS_KCMP), (const bf16*)(ws + WS_OVL), nullptr, nullptr, (float*)(ws + WS_IMP), nullptr); \
             F.fresh(); REP(17) nsa_attn_phase<3>(F, BIG, (const bf16*)(ws + WS_QROT), (const bf16*)(ws + WS_KWROT), nullptr, nullptr, (float*)(ws + WS_O32), nullptr, nullptr, r_ > 0); } PH_END \
    PH_BEGIN REP(16) nsa_topk_phase(F, (const float*)(ws + WS_IMP), (unsigned*)(ws + WS_SEL)); PH_END \
    PH_BEGIN REP(18) nsa_attn_phase<2>(F, BIG, (const bf16*)(ws + WS_QROT), (const bf16*)(ws + WS_KSROT), nullptr, (const unsigned*)(ws + WS_SEL), (float*)(ws + WS_O32), nullptr, Ob); PH_END
#endif
#ifndef REPMASK
#define REPMASK 0u
#endif
#define REP(gid) for (int r_ = 0; r_ <= (int)((REPMASK >> (gid)) & 1u); ++r_)
#define PH_BEGIN if (pc >= lo && pc < hi) { F.fresh();
#if (REPMASK >> 23) & 1
#define PH_END   if (pc + 1 < hi) { const unsigned long long tb0_ = __builtin_amdgcn_s_memrealtime(); XcdBarrier bb_ = bar; asm volatile("" : "+s"(bb_.bar), "+s"(bb_.x)); xcd_barrier(bb_); \
        const unsigned w_ = (unsigned)(__builtin_amdgcn_s_memrealtime() - tb0_); tbar_acc += w_; if (threadIdx.x == 0) { atomicMax((unsigned*)(args.ws + 3 * MiB) + pc, 0x7fffffffu - w_); atomicMax((unsigned*)(args.ws + 3 * MiB) + 256 + pc, w_); } } } ++pc;
#else
#define PH_END   if (pc + 1 < hi) { XcdBarrier bb_ = bar; asm volatile("" : "+s"(bb_.bar), "+s"(bb_.x)); xcd_barrier(bb_); } } ++pc;
#endif
template <int l>
__device__ __forceinline__ void layer_body(Frame& F, const Args& args, const XcdBarrier& bar, int& pc, const int lo, const int hi, unsigned long long& tbar_acc) {
    unsigned char* ws = F.ws;
    bf16* HB = (bf16*)(ws + WS_HB); bf16* Y = (bf16*)(ws + WS_Y); float* H32 = (float*)karg()->out;
    bf16* BIG = (bf16*)(ws + WS_BIG); bf16* Gm = (bf16*)(ws + WS_G); bf16* Ob = (bf16*)(ws + WS_O);
    bf16* XQ = (bf16*)(ws + WS_XQ); bf16* XO = (bf16*)(ws + WS_XO);
#define RS(k) ((long long*)(ws + WS_RSUM) + (size_t)(k) * MTOK * 2)
#define LNG(k) (KIN(IN_LN_G) + (size_t)(k) * DM)
#define LNB(k) (KIN(IN_LN_B) + (size_t)(k) * DM)
    const float* cs = (const float*)(ws + WS_FOLDF); const float* b2 = cs + FO_N;
        PH_BEGIN REP(1) {
            const int N = l == 0 ? AB_IN : NSA_INP;
            pg8::StaticOrder S; S.init(MTOK, N, F.G, F.bid);
            if (l == 0) { pg8::Gemm g{HB, (const bf16*)(ws + WS_W_ABIN), MTOK, N, DM}; pg8::EpiBf16<0> E{BIG, N, nullptr, 0, 0, 1.f};
                pg8::gemm_phase<pg8::EpiBf16<0>, pg8::StaticOrder, PG8_ALIGN, PG8_SP2>(F.lds + RING_OFF, g, S, E); }
            else { pg8::Gemm g{Y, (const bf16*)(ws + WS_W_NSAIN), MTOK, N, DM}; pg8::EpiBf16Ln E{BIG, N, RS(2), cs + FO_NSA, b2 + FO_NSA};
                pg8::gemm_phase<pg8::EpiBf16Ln, pg8::StaticOrder, PG8_ALIGN, PG8_SP2>(F.lds + RING_OFF, g, S, E);
                if (r_ == 0) convert_job<CJ_L1A>(F, args, 64, 192); }
        } PH_END
#if STAGE <= 1
        ZERO_OB_PHASE
#else
        if (l == 0) {
            MIXER0_PHASES
        } else {
            MIXER1_PHASES
        }
#endif
        PH_BEGIN REP(2) {
            pg8::Gemm g{Ob, l == 0 ? (const bf16*)(ws + WS_W_ABOUT) : (const bf16*)(ws + WS_W_NSAOUT), MTOK, DM, DM};
            pg8::StaticOrder S; S.init(MTOK, DM, F.G, F.bid);
            if (l == 0) { pg8::EpiRes0 E{Y, HB, DM, DN_ALPHA, RS(0)};
                pg8::gemm_phase<pg8::EpiRes0, pg8::StaticOrder, PG8_ALIGN, PG8_SP2>(F.lds + RING_OFF, g, S, E); }
            else { pg8::EpiResLn2 E{Y, RS(2), LNG(2), LNB(2), DM, DN_ALPHA, RS(3)};
                pg8::gemm_phase<pg8::EpiResLn2, pg8::StaticOrder, PG8_ALIGN, PG8_SP2>(F.lds + RING_OFF, g, S, E); }
        } PH_END
        PH_BEGIN REP(3) {
            {   pg8::Gemm g{Y, (const bf16*)(ws + WS_W_XQ) + (size_t)l * XW * DM, MTOK, XW, DM};
                pg8::RangeOrder S; S.init(MTOK, XW, 0, 128, F.bid);
                pg8::EpiBf16Ln E{XQ, XW, RS(3 * l), cs + FO_XQ + l * XW, b2 + FO_XQ + l * XW};
                pg8::gemm_phase<pg8::EpiBf16Ln, pg8::RangeOrder, PG8_ALIGN, PG8_SP2>(F.lds + RING_OFF, g, S, E); }
            {   pg8::Gemm g{(const bf16*)(ws + WS_MEMB), (const bf16*)(ws + WS_W_XKV) + (size_t)l * 2 * XW * DM, BATCH * NMEM, 2 * XW, DM};
                pg8::RangeOrder S; S.init(BATCH * NMEM, 2 * XW, 128, 8, F.bid);
                pg8::EpiBf16<0> E{(bf16*)(ws + WS_XKV) + (size_t)l * BATCH * NMEM * 2 * XW, 2 * XW, nullptr, 0, 0, 1.f};
                pg8::gemm_phase<pg8::EpiBf16<0>, pg8::RangeOrder, PG8_ALIGN, PG8_SP2>(F.lds + RING_OFF, g, S, E); }
            if (r_ == 0) { if (l == 0) convert_job<CJ_DOWN0>(F, args, 136, 120); else convert_job<CJ_L1B>(F, args, 136, 120); }
        } PH_END
        PH_BEGIN { if (l == 1) fold_finalize(F, FO_UP + DFF2, DFF2); } REP(9) xattn_phase(F, XQ, (const bf16*)(ws + WS_XKV) + (size_t)l * BATCH * NMEM * 2 * XW, XO); PH_END
        PH_BEGIN REP(4) {
            pg8::Gemm g{XO, (const bf16*)(ws + WS_W_XO) + (size_t)l * DM * XW, MTOK, DM, XW};
            pg8::StaticOrder S; S.init(MTOK, DM, F.G, F.bid);
            pg8::EpiResLn2 E{Y, RS(3 * l), LNG(3 * l), LNB(3 * l), DM, DN_ALPHA, RS(3 * l + 1)};
            pg8::gemm_phase<pg8::EpiResLn2, pg8::StaticOrder, PG8_ALIGN, PG8_SP2>(F.lds + RING_OFF, g, S, E);
        } PH_END
        PH_BEGIN REP(5) {
#if (REPMASK >> 22) & 1
            if (r_ > 0) { XcdBarrier bb_ = bar; asm volatile("" : "+s"(bb_.bar), "+s"(bb_.x)); xcd_barrier(bb_); }
#endif
            pg8::Gemm g{Y, (const bf16*)(ws + WS_W_UP) + (size_t)l * DFF2 * DM, MTOK, DFF2, DM};
            pg8::StaticOrder S; S.init(MTOK, DFF2, F.G, F.bid);
            pg8::EpiConvGlu E{Gm, (bf16*)(ws + WS_SIDE), RS(3 * l + 1), cs + FO_UP + l * DFF2, b2 + FO_UP + l * DFF2, KIN(IN_FFN_CONV) + (size_t)l * 3 * DFF, DFF};
            pg8::gemm_phase<pg8::EpiConvGlu, pg8::StaticOrder, PG8_ALIGN, PG8_SP2>(F.lds + RING_OFF, g, S, E);
            if (r_ == 0) { if (l == 0) convert_job<CJ_NSA>(F, args, 128, 128); else convert_job<CJ_DOWN1>(F, args, 128, 128); }
        } PH_END
#if (REPMASK >> 20) & 1
        PH_BEGIN {
            pg8::Gemm g{HB, (const bf16*)(ws + WS_W_UP) + (size_t)l * DFF2 * DM, MTOK, DFF2, DM};
            pg8::ZeroOrder S; S.init(MTOK, DFF2, F.G, F.bid);
            pg8::EpiBf16<0> E{Gm, DFF2, nullptr, 0, 0, 1.f};
            pg8::gemm_phase<pg8::EpiBf16<0>, pg8::ZeroOrder, PG8_ALIGN, PG8_SP2>(F.lds + RING_OFF, g, S, E);
        } PH_END
#endif
        PH_BEGIN { if (l == 0) fold_finalize(F, FO_NSA, NSA_INP); } REP(8) convglu_fixup_phase(F, (const bf16*)(ws + WS_SIDE), KIN(IN_FFN_CONV) + (size_t)l * 3 * DFF, Gm); PH_END
        PH_BEGIN REP(6) {
            pg8::Gemm g{Gm, (const bf16*)(ws + WS_W_DOWN) + (size_t)l * DM * DFF, MTOK, DM, DFF};
            pg8::StaticOrder S; S.init(MTOK, DM, F.G, F.bid);
            pg8::EpiResLn2 E{Y, RS(3 * l + 1), LNG(3 * l + 1), LNB(3 * l + 1), DM, DN_ALPHA, RS(3 * l + 2)};
            pg8::gemm_phase<pg8::EpiResLn2, pg8::StaticOrder, PG8_ALIGN, PG8_SP2>(F.lds + RING_OFF, g, S, E);
        } PH_END
        if (l == 1) { PH_BEGIN REP(7) ln_phase(F, Y, LNG(5), LNB(5), H32); PH_END }
#undef RS
#undef LNG
#undef LNB
}
__global__ void __launch_bounds__(NTHR, 2) mega_fwd(Args args) {
    extern __shared__ __attribute__((aligned(16))) unsigned char lds_raw[];
    Frame F;
    F.lds = (LAS unsigned char*)lds_raw; F.ws = args.ws;
    F.tid = threadIdx.x; F.lane = F.tid & 63; F.wave = __builtin_amdgcn_readfirstlane(F.tid >> 6); F.G = gridDim.x;
    unsigned char* ws = args.ws;
    gu32* ctl = (gu32*)(ws + WS_CTL);
    for (int u = F.tid; u < (LDS_BYTES - LDSCTL_OFF) / 4; u += NTHR) ((LAS unsigned*)(F.lds + LDSCTL_OFF))[u] = 0u;
    __syncthreads();
    volatile LAS unsigned* MISC = (volatile LAS unsigned*)(F.lds + MISC_OFF);
    XcdBarrier bar = xcd_barrier_post((unsigned*)(ctl + CW_BAR), MISC + 8);
    const int lo = args.ph_lo, hi = args.ph_hi; int pc = 0; unsigned long long tbar_acc = 0ull;
    bf16* HB = (bf16*)(ws + WS_HB); bf16* Y = (bf16*)(ws + WS_Y); float* H32 = (float*)karg()->out;
    bf16* BIG = (bf16*)(ws + WS_BIG); bf16* Gm = (bf16*)(ws + WS_G); bf16* Ob = (bf16*)(ws + WS_O);
    bf16* XQ = (bf16*)(ws + WS_XQ); bf16* XO = (bf16*)(ws + WS_XO);

    PH_BEGIN REP(0) p0_prologue(F, args); PH_END

#if (REPMASK >> 21) & 1
    for (int e_ = 0; e_ < 40; ++e_) { PH_BEGIN PH_END }
#endif
    layer_body<0>(F, args, bar, pc, lo, hi, tbar_acc);
    layer_body<1>(F, args, bar, pc, lo, hi, tbar_acc);
#if (REPMASK >> 23) & 1
#ifndef PROBE_BID
#define PROBE_BID 0
#endif
#if (REPMASK >> 24) & 1
    if (blockIdx.x == 0) { unsigned long long tot_ = 0ull; for (int k_ = 0; k_ < pc; ++k_) { const unsigned v_ = __hip_atomic_load((unsigned*)(args.ws + 3 * MiB) + k_, __ATOMIC_RELAXED, __HIP_MEMORY_SCOPE_AGENT); const unsigned x_ = __hip_atomic_load((unsigned*)(args.ws + 3 * MiB) + 256 + k_, __ATOMIC_RELAXED, __HIP_MEMORY_SCOPE_AGENT);
#ifdef PROBE_SPREAD_MASK
            if (v_ && ((PROBE_SPREAD_MASK >> k_) & 1ull)) tot_ += x_ - (0x7fffffffu - v_);
#else
            if (v_) tot_ += 0x7fffffffu - v_;
#endif
        }
        const unsigned long long t0_ = __builtin_amdgcn_s_memrealtime(); while (__builtin_amdgcn_s_memrealtime() - t0_ < tot_) __builtin_amdgcn_s_sleep(8); }
#else
    if (blockIdx.x == PROBE_BID) { const unsigned long long t0_ = __builtin_amdgcn_s_memrealtime(); while (__builtin_amdgcn_s_memrealtime() - t0_ < tbar_acc) __builtin_amdgcn_s_sleep(8); }
#endif
#endif
}

extern "C" void kernel_launch(void* const* d_in, const int* in_sizes, int n_in, void* d_out, int out_size, void* d_ws, size_t ws_size, hipStream_t stream) {
    static int grid = 0;
    if (grid == 0) {
        if (n_in != 19 || in_sizes[0] != MTOK * DM || out_size != MTOK * DM || ws_size < WS_END) {
            fprintf(stderr, "kernel_launch: shape mismatch n_in %d in0 %d out %d ws %zu (need %zu)\n", n_in, n_in > 0 ? in_sizes[0] : -1, out_size, ws_size, (size_t)WS_END); grid = -1; return; }
        int dev = 0, cus = 0, per_cu = 0;
        if (hipGetDevice(&dev) != hipSuccess || hipDeviceGetAttribute(&cus, hipDeviceAttributeMultiprocessorCount, dev) != hipSuccess) { grid = -1; return; }
        if (hipFuncSetAttribute((const void*)mega_fwd, hipFuncAttributeMaxDynamicSharedMemorySize, LDS_BYTES) != hipSuccess) { fprintf(stderr, "kernel_launch: hipFuncSetAttribute failed\n"); grid = -1; return; }
        if (hipOccupancyMaxActiveBlocksPerMultiprocessor(&per_cu, (const void*)mega_fwd, NTHR, LDS_BYTES) != hipSuccess || per_cu < 1)
            fprintf(stderr, "kernel_launch: note: occupancy query reports %d workgroups per CU\n", per_cu);
        (void)hipGetLastError();
        grid = cus;
        if (grid != 256) { fprintf(stderr, "kernel_launch: built for a 256-CU device (workgroup ranges of the cross-attention and conversion phases); this device reports %d; nothing launched\n", cus); grid = -1; return; }
    }
    if (grid < 0) return;
    if (hipMemsetAsync((char*)d_ws + WS_CTL, 0, CTL_ZERO_BYTES, stream) != hipSuccess) { fprintf(stderr, "kernel_launch: memset failed\n"); return; }
    Args a{};
    for (int i = 0; i < 19; ++i) a.in[i] = (const float*)d_in[i];
    a.out = (float*)d_out; a.ws = (unsigned char*)d_ws; a.ph_lo = 0; a.ph_hi = 1 << 20;
    hipLaunchKernelGGL(mega_fwd, dim3(grid), dim3(NTHR), LDS_BYTES, stream, a);
    const hipError_t le = hipPeekAtLastError();
    if (le != hipSuccess) fprintf(stderr, "kernel_launch: launch failed: %s\n", hipGetErrorName(le));
}
```

```cpp
#include <hip/hip_runtime.h>
#include <cstdio>
#include <cstdint>
namespace pg8 {
#define PG8_LAS __attribute__((address_space(3)))
typedef unsigned short bf16_t;
typedef short bf16x8 __attribute__((ext_vector_type(8)));
typedef float f32x4 __attribute__((ext_vector_type(4)));
typedef unsigned u32x4 __attribute__((ext_vector_type(4)));
constexpr int BM = 256, BK = 64, HALF = 128, HTB = HALF * BK * 2  , STAGE_BYTES = 8 * HTB, NXCD = 8, WGM = 8;

__host__ __device__ __forceinline__ int lds_byte(int r, int c) { const int st = (r >> 4) * 2 + (c >> 5), rr = r & 15, cc = c & 31, ob = rr * 64 + cc * 2; return st * 1024 + (ob ^ (((ob >> 9) & 1) << 5)); }
__host__ __device__ __forceinline__ void stage_rc(int b, int& R, int& C) { const int st = b / 1024, sb = b % 1024, swz = sb ^ (((sb >> 9) & 1) << 5); R = (st >> 1) * 16 + swz / 64; C = (st & 1) * 32 + (swz % 64) / 2; }
__host__ __device__ __forceinline__ int perm32(int rho) { const int n = rho >> 4, i = rho & 15; return 8 * (i >> 2) + 4 * n + (i & 3); }

struct Unit { int pm, pn; };
struct Gemm { const bf16_t* A; const bf16_t* Bt; int M, N, K; };

struct StaticOrder {
    int nM, nN, nwg, G, c;
    __host__ __device__ void init(int M, int N, int G_, int c_) { nM = M / BM; nN = N / BM; nwg = nM * nN; G = G_; c = c_; }
    __host__ __device__ bool next(int i, Unit& u) const {
        const long L = (long)i * G + c; if (L >= nwg) return false;
        int wgid = (int)L; { const int q = nwg / NXCD, r = nwg % NXCD, xcd = wgid % NXCD, off = wgid / NXCD; wgid = (xcd < r ? xcd * (q + 1) : r * (q + 1) + (xcd - r) * q) + off; }
        const int nig = WGM * nN, gid = wgid / nig, fm = gid * WGM, gsz = (nM - fm) < WGM ? (nM - fm) : WGM;
        u.pm = fm + ((wgid % nig) % gsz); u.pn = (wgid % nig) / gsz; return true;
    }
    __device__ __forceinline__ void a_ready(const Unit&) const {}
    __device__ __forceinline__ void done(const Unit&) const {}
};

__device__ __forceinline__ unsigned cvt_pk_bf16(float lo, float hi) { unsigned r; asm volatile("v_cvt_pk_bf16_f32 %0, %1, %2" : "=v"(r) : "v"(lo), "v"(hi)); return r; }
typedef float f32x2 __attribute__((ext_vector_type(2)));
__device__ __forceinline__ f32x2 gelu_pk(f32x2 v) {
    const f32x2 av = __builtin_elementwise_abs(v), d = av * 0.2316418882f + 1.0f;
    f32x2 t; t.x = __builtin_amdgcn_rcpf(d.x); t.y = __builtin_amdgcn_rcpf(d.y);
    f32x2 q = t * 0.5307027145f + (-0.7265760135f); q = q * t + 0.7107068705f; q = q * t + (-0.142248368f); q = q * t + 0.127414796f; q = q * t;
    const f32x2 s = (v * v) * (-0.72134752044f);
    f32x2 e; e.x = __builtin_amdgcn_exp2f(s.x); e.y = __builtin_amdgcn_exp2f(s.y);
    const f32x2 m = v * (q * e), r = v - m;
    f32x2 o; o.x = v.x < 0.f ? m.x : r.x; o.y = v.y < 0.f ? m.y : r.y; return o;
}

template <int ACT  > struct EpiBf16 {
    static constexpr bool PERM = true, AFTER_DRAIN = false; static_assert(ACT == 0 || ACT == 1, "EpiBf16: ACT is 0 (none) or 1 (gelu_pk)");
    bf16_t* O; int ldc; const float* bias; int split_cols; size_t split_stride; float scale0;
    __device__ __forceinline__ void operator()(const f32x4 (&acc)[2][2][4][2], const Unit& u, int wr, int wc, int fr, int fq) const {
        const int row0 = u.pm * BM + wr * 64 + fr; int colt = u.pn * BM; bf16_t* base = O;
        float sc = 1.f; if (split_cols) { const int t = colt / split_cols; base += (size_t)t * split_stride; colt -= t * split_cols; if (t == 0) sc = scale0; }
        const int col0 = colt + wc * 32 + 8 * fq, bcol0 = u.pn * BM + wc * 32 + 8 * fq;
        f32x4 bv[2][2];
#pragma unroll
        for (int bj = 0; bj < 2; ++bj)
#pragma unroll
            for (int n = 0; n < 2; ++n) bv[bj][n] = bias ? *(const f32x4*)(bias + bcol0 + bj * HALF + 4 * n) : (f32x4){0.f, 0.f, 0.f, 0.f};
#pragma unroll
        for (int ai = 0; ai < 2; ++ai)
#pragma unroll
            for (int m = 0; m < 4; ++m) { bf16_t* rowp = base + (size_t)(row0 + ai * HALF + m * 16) * ldc + col0;
#pragma unroll
                for (int bj = 0; bj < 2; ++bj) { f32x4 v0 = acc[ai][bj][m][0] + bv[bj][0], v1 = acc[ai][bj][m][1] + bv[bj][1];
                    if (ACT == 1) { f32x2 a = gelu_pk((f32x2){v0[0], v0[1]}), b = gelu_pk((f32x2){v0[2], v0[3]}), c = gelu_pk((f32x2){v1[0], v1[1]}), d = gelu_pk((f32x2){v1[2], v1[3]});
                        v0 = (f32x4){a.x, a.y, b.x, b.y}; v1 = (f32x4){c.x, c.y, d.x, d.y}; }
                    v0 = v0 * sc; v1 = v1 * sc; u32x4 w; w.x = cvt_pk_bf16(v0[0], v0[1]); w.y = cvt_pk_bf16(v0[2], v0[3]); w.z = cvt_pk_bf16(v1[0], v1[1]); w.w = cvt_pk_bf16(v1[2], v1[3]);
                    *(u32x4*)(rowp + bj * HALF) = w; } }
    }
};


struct EpiRes {
    static constexpr bool PERM = false, AFTER_DRAIN = false;
    float* Y; const float* res; int ldc; float alpha;
    __device__ __forceinline__ void operator()(const f32x4 (&acc)[2][2][4][2], const Unit& u, int wr, int wc, int fr, int fq) const {
        const int row0 = u.pm * BM + wr * 64 + fr, col0 = u.pn * BM + wc * 32 + 4 * fq;
#pragma unroll
        for (int ai = 0; ai < 2; ++ai)
#pragma unroll
            for (int m = 0; m < 4; ++m) { const size_t off = (size_t)(row0 + ai * HALF + m * 16) * ldc + col0;
#pragma unroll
                for (int bj = 0; bj < 2; ++bj)
#pragma unroll
                    for (int n = 0; n < 2; ++n) { const f32x4 r = *(const f32x4*)(res + off + bj * HALF + n * 16);
                        *(f32x4*)(Y + off + bj * HALF + n * 16) = r * alpha + acc[ai][bj][m][n]; } }
    }
};
struct RangeOrder {
    int nM, nN, ntot, c0, nw, c;
    __host__ __device__ void init(int M, int N, int c0_, int nw_, int c_) { nM = M / BM; nN = N / BM; ntot = nM * nN; c0 = c0_; nw = nw_; c = c_; }
    __host__ __device__ bool next(int i, Unit& u) const {
        if (c < c0 || c >= c0 + nw) return false;
        const int L = i * nw + (c - c0); if (L >= ntot) return false;
        u.pm = L / nN; u.pn = L % nN; return true;
    }
    __device__ __forceinline__ void a_ready(const Unit&) const {}
    __device__ __forceinline__ void done(const Unit&) const {}
};

struct ZeroOrder : StaticOrder {
    __host__ __device__ bool next(int i, Unit& u) const { const bool r = StaticOrder::next(i, u); u.pm = 0; u.pn = 0; return r; }
};

struct EpiResBf {
    static constexpr bool PERM = true, AFTER_DRAIN = false;
    bf16_t* Y; const bf16_t* res; int ldc; float alpha;
    __device__ __forceinline__ void operator()(const f32x4 (&acc)[2][2][4][2], const Unit& u, int wr, int wc, int fr, int fq) const {
        const int row0 = u.pm * BM + wr * 64 + fr, col0 = u.pn * BM + wc * 32 + 8 * fq;
#pragma unroll
        for (int ai = 0; ai < 2; ++ai)
#pragma unroll
            for (int m = 0; m < 4; ++m) { const size_t off = (size_t)(row0 + ai * HALF + m * 16) * ldc + col0;
#pragma unroll
                for (int bj = 0; bj < 2; ++bj) { const u32x4 r = *(const u32x4*)(res + off + bj * HALF);
                    const f32x4 v0 = acc[ai][bj][m][0], v1 = acc[ai][bj][m][1];
                    u32x4 w;
                    w.x = cvt_pk_bf16(__builtin_bit_cast(float, r.x << 16) * alpha + v0[0], __builtin_bit_cast(float, r.x & 0xffff0000u) * alpha + v0[1]);
                    w.y = cvt_pk_bf16(__builtin_bit_cast(float, r.y << 16) * alpha + v0[2], __builtin_bit_cast(float, r.y & 0xffff0000u) * alpha + v0[3]);
                    w.z = cvt_pk_bf16(__builtin_bit_cast(float, r.z << 16) * alpha + v1[0], __builtin_bit_cast(float, r.z & 0xffff0000u) * alpha + v1[1]);
                    w.w = cvt_pk_bf16(__builtin_bit_cast(float, r.w << 16) * alpha + v1[2], __builtin_bit_cast(float, r.w & 0xffff0000u) * alpha + v1[3]);
                    *(u32x4*)(Y + off + bj * HALF) = w; } }
    }
};

struct EpiResF {
    static constexpr bool PERM = true, AFTER_DRAIN = false;
    float* Y; const bf16_t* res; int ldc; float alpha;
    __device__ __forceinline__ void operator()(const f32x4 (&acc)[2][2][4][2], const Unit& u, int wr, int wc, int fr, int fq) const {
        const int row0 = u.pm * BM + wr * 64 + fr, col0 = u.pn * BM + wc * 32 + 8 * fq;
#pragma unroll
        for (int ai = 0; ai < 2; ++ai)
#pragma unroll
            for (int m = 0; m < 4; ++m) { const size_t off = (size_t)(row0 + ai * HALF + m * 16) * ldc + col0;
#pragma unroll
                for (int bj = 0; bj < 2; ++bj) { const u32x4 r = *(const u32x4*)(res + off + bj * HALF);
                    f32x4 o0, o1;
                    o0[0] = __builtin_bit_cast(float, r.x << 16); o0[1] = __builtin_bit_cast(float, r.x & 0xffff0000u); o0[2] = __builtin_bit_cast(float, r.y << 16); o0[3] = __builtin_bit_cast(float, r.y & 0xffff0000u);
                    o1[0] = __builtin_bit_cast(float, r.z << 16); o1[1] = __builtin_bit_cast(float, r.z & 0xffff0000u); o1[2] = __builtin_bit_cast(float, r.w << 16); o1[3] = __builtin_bit_cast(float, r.w & 0xffff0000u);
                    *(f32x4*)(Y + off + bj * HALF) = o0 * alpha + acc[ai][bj][m][0]; *(f32x4*)(Y + off + bj * HALF + 4) = o1 * alpha + acc[ai][bj][m][1]; } }
    }
};

struct EpiResLn {
    static constexpr bool PERM = true, AFTER_DRAIN = false;
    bf16_t* Y; const float* stats; const float* g; const float* b; int ldc; float alpha;
    __device__ __forceinline__ void operator()(const f32x4 (&acc)[2][2][4][2], const Unit& u, int wr, int wc, int fr, int fq) const {
        const int row0 = u.pm * BM + wr * 64 + fr, col0 = u.pn * BM + wc * 32 + 8 * fq;
        f32x4 gv[2][2], bv[2][2];
#pragma unroll
        for (int bj = 0; bj < 2; ++bj)
#pragma unroll
            for (int n = 0; n < 2; ++n) { gv[bj][n] = *(const f32x4*)(g + col0 + bj * HALF + 4 * n) * alpha; bv[bj][n] = *(const f32x4*)(b + col0 + bj * HALF + 4 * n) * alpha; }
#pragma unroll
        for (int ai = 0; ai < 2; ++ai)
#pragma unroll
            for (int m = 0; m < 4; ++m) { const int row = row0 + ai * HALF + m * 16; const size_t off = (size_t)row * ldc + col0;
                const float mean = stats[2 * row], rstd = stats[2 * row + 1];
#pragma unroll
                for (int bj = 0; bj < 2; ++bj) { const u32x4 r = *(const u32x4*)(Y + off + bj * HALF);
                    f32x4 y0, y1;
                    y0[0] = __builtin_bit_cast(float, r.x << 16); y0[1] = __builtin_bit_cast(float, r.x & 0xffff0000u); y0[2] = __builtin_bit_cast(float, r.y << 16); y0[3] = __builtin_bit_cast(float, r.y & 0xffff0000u);
                    y1[0] = __builtin_bit_cast(float, r.z << 16); y1[1] = __builtin_bit_cast(float, r.z & 0xffff0000u); y1[2] = __builtin_bit_cast(float, r.w << 16); y1[3] = __builtin_bit_cast(float, r.w & 0xffff0000u);
                    const f32x4 o0 = (y0 - mean) * rstd * gv[bj][0] + bv[bj][0] + acc[ai][bj][m][0], o1 = (y1 - mean) * rstd * gv[bj][1] + bv[bj][1] + acc[ai][bj][m][1];
                    u32x4 w; w.x = cvt_pk_bf16(o0[0], o0[1]); w.y = cvt_pk_bf16(o0[2], o0[3]); w.z = cvt_pk_bf16(o1[0], o1[1]); w.w = cvt_pk_bf16(o1[2], o1[3]);
                    *(u32x4*)(Y + off + bj * HALF) = w; } }
    }
};

constexpr float RS_SCALE = 1048576.0f, RS_INV = 1.0f / 1048576.0f;
__device__ __forceinline__ float fx20_to_f(long long v) { return (float)(int)(v >> 20) + (float)((unsigned)v & 0xFFFFFu) * RS_INV; }
__device__ __forceinline__ long long f_to_fx20(float s) { const float fl = floorf(s); return ((long long)(int)fl << 20) + (long long)(unsigned)((s - fl) * RS_SCALE + 0.5f); }
__device__ __forceinline__ void row_stats(const long long* rs, int row, float& mean, float& rstd) {
    const long long a = rs[2 * (size_t)row], b = rs[2 * (size_t)row + 1];
    mean = fx20_to_f(a) * (1.0f / 4096.0f); const float var = fx20_to_f(b) * (1.0f / 4096.0f) - mean * mean; rstd = 1.0f / sqrtf(var + 1e-5f);
}
constexpr float FOLD_SCALE = 4294967296.0f, FOLD_INV = 1.0f / 4294967296.0f;
struct EpiBf16Ln {
    static constexpr bool PERM = true, AFTER_DRAIN = false;
    bf16_t* O; int ldc; const long long* rs; const float* cs; const float* b2;
    __device__ __forceinline__ void operator()(const f32x4 (&acc)[2][2][4][2], const Unit& u, int wr, int wc, int fr, int fq) const {
        const int row0 = u.pm * BM + wr * 64 + fr, col0 = u.pn * BM + wc * 32 + 8 * fq;
        f32x4 cv[2][2], bv[2][2];
#pragma unroll
        for (int bj = 0; bj < 2; ++bj)
#pragma unroll
            for (int n = 0; n < 2; ++n) { cv[bj][n] = *(const f32x4*)(cs + col0 + bj * HALF + 4 * n); bv[bj][n] = *(const f32x4*)(b2 + col0 + bj * HALF + 4 * n); }
#pragma unroll
        for (int ai = 0; ai < 2; ++ai)
#pragma unroll
            for (int m = 0; m < 4; ++m) { const int row = row0 + ai * HALF + m * 16; float mean, rstd; row_stats(rs, row, mean, rstd);
                bf16_t* rowp = O + (size_t)row * ldc + col0;
#pragma unroll
                for (int bj = 0; bj < 2; ++bj) { const f32x4 v0 = (acc[ai][bj][m][0] - cv[bj][0] * mean) * rstd + bv[bj][0], v1 = (acc[ai][bj][m][1] - cv[bj][1] * mean) * rstd + bv[bj][1];
                    u32x4 w; w.x = cvt_pk_bf16(v0[0], v0[1]); w.y = cvt_pk_bf16(v0[2], v0[3]); w.z = cvt_pk_bf16(v1[0], v1[1]); w.w = cvt_pk_bf16(v1[2], v1[3]);
                    *(u32x4*)(rowp + bj * HALF) = w; } }
    }
};
__device__ __forceinline__ void row_sums_add(long long* rso, int row, const f32x4& a, const f32x4& b, const f32x4& c, const f32x4& d, int fq) {
    float s1 = ((a[0] + a[1]) + (a[2] + a[3])) + ((b[0] + b[1]) + (b[2] + b[3])) + ((c[0] + c[1]) + (c[2] + c[3])) + ((d[0] + d[1]) + (d[2] + d[3]));
    float s2 = ((a[0] * a[0] + a[1] * a[1]) + (a[2] * a[2] + a[3] * a[3])) + ((b[0] * b[0] + b[1] * b[1]) + (b[2] * b[2] + b[3] * b[3]))
             + ((c[0] * c[0] + c[1] * c[1]) + (c[2] * c[2] + c[3] * c[3])) + ((d[0] * d[0] + d[1] * d[1]) + (d[2] * d[2] + d[3] * d[3]));
    s1 += __shfl_xor(s1, 16); s1 += __shfl_xor(s1, 32); s2 += __shfl_xor(s2, 16); s2 += __shfl_xor(s2, 32);
    if (fq == 0) { atomicAdd((unsigned long long*)(rso + 2 * (size_t)row), (unsigned long long)f_to_fx20(s1)); atomicAdd((unsigned long long*)(rso + 2 * (size_t)row + 1), (unsigned long long)f_to_fx20(s2)); }
}
struct EpiRes0 {
    static constexpr bool PERM = true, AFTER_DRAIN = false;
    bf16_t* Y; const bf16_t* res; int ldc; float alpha; long long* rso;
    __device__ __forceinline__ void operator()(const f32x4 (&acc)[2][2][4][2], const Unit& u, int wr, int wc, int fr, int fq) const {
        const int row0 = u.pm * BM + wr * 64 + fr, col0 = u.pn * BM + wc * 32 + 8 * fq;
#pragma unroll
        for (int ai = 0; ai < 2; ++ai)
#pragma unroll
            for (int m = 0; m < 4; ++m) { const int row = row0 + ai * HALF + m * 16; const size_t off = (size_t)row * ldc + col0; f32x4 o[2][2];
#pragma unroll
                for (int bj = 0; bj < 2; ++bj) { const u32x4 r = *(const u32x4*)(res + off + bj * HALF);
                    f32x4 y0, y1;
                    y0[0] = __builtin_bit_cast(float, r.x << 16); y0[1] = __builtin_bit_cast(float, r.x & 0xffff0000u); y0[2] = __builtin_bit_cast(float, r.y << 16); y0[3] = __builtin_bit_cast(float, r.y & 0xffff0000u);
                    y1[0] = __builtin_bit_cast(float, r.z << 16); y1[1] = __builtin_bit_cast(float, r.z & 0xffff0000u); y1[2] = __builtin_bit_cast(float, r.w << 16); y1[3] = __builtin_bit_cast(float, r.w & 0xffff0000u);
                    o[bj][0] = y0 * alpha + acc[ai][bj][m][0]; o[bj][1] = y1 * alpha + acc[ai][bj][m][1];
                    u32x4 w; w.x = cvt_pk_bf16(o[bj][0][0], o[bj][0][1]); w.y = cvt_pk_bf16(o[bj][0][2], o[bj][0][3]); w.z = cvt_pk_bf16(o[bj][1][0], o[bj][1][1]); w.w = cvt_pk_bf16(o[bj][1][2], o[bj][1][3]);
                    *(u32x4*)(Y + off + bj * HALF) = w; }
                row_sums_add(rso, row, o[0][0], o[0][1], o[1][0], o[1][1], fq); }
    }
};
struct EpiResLn2 {
    static constexpr bool PERM = true, AFTER_DRAIN = false;
    bf16_t* Y; const long long* rsi; const float* g; const float* b; int ldc; float alpha; long long* rso;
    __device__ __forceinline__ void operator()(const f32x4 (&acc)[2][2][4][2], const Unit& u, int wr, int wc, int fr, int fq) const {
        const int row0 = u.pm * BM + wr * 64 + fr, col0 = u.pn * BM + wc * 32 + 8 * fq;
        f32x4 gv[2][2], bv[2][2];
#pragma unroll
        for (int bj = 0; bj < 2; ++bj)
#pragma unroll
            for (int n = 0; n < 2; ++n) { gv[bj][n] = *(const f32x4*)(g + col0 + bj * HALF + 4 * n) * alpha; bv[bj][n] = *(const f32x4*)(b + col0 + bj * HALF + 4 * n) * alpha; }
#pragma unroll
        for (int ai = 0; ai < 2; ++ai)
#pragma unroll
            for (int m = 0; m < 4; ++m) { const int row = row0 + ai * HALF + m * 16; const size_t off = (size_t)row * ldc + col0; float mean, rstd; row_stats(rsi, row, mean, rstd); f32x4 o[2][2];
#pragma unroll
                for (int bj = 0; bj < 2; ++bj) { const u32x4 r = *(const u32x4*)(Y + off + bj * HALF);
                    f32x4 y0, y1;
                    y0[0] = __builtin_bit_cast(float, r.x << 16); y0[1] = __builtin_bit_cast(float, r.x & 0xffff0000u); y0[2] = __builtin_bit_cast(float, r.y << 16); y0[3] = __builtin_bit_cast(float, r.y & 0xffff0000u);
                    y1[0] = __builtin_bit_cast(float, r.z << 16); y1[1] = __builtin_bit_cast(float, r.z & 0xffff0000u); y1[2] = __builtin_bit_cast(float, r.w << 16); y1[3] = __builtin_bit_cast(float, r.w & 0xffff0000u);
                    o[bj][0] = (y0 - mean) * rstd * gv[bj][0] + bv[bj][0] + acc[ai][bj][m][0]; o[bj][1] = (y1 - mean) * rstd * gv[bj][1] + bv[bj][1] + acc[ai][bj][m][1];
                    u32x4 w; w.x = cvt_pk_bf16(o[bj][0][0], o[bj][0][1]); w.y = cvt_pk_bf16(o[bj][0][2], o[bj][0][3]); w.z = cvt_pk_bf16(o[bj][1][0], o[bj][1][1]); w.w = cvt_pk_bf16(o[bj][1][2], o[bj][1][3]);
                    *(u32x4*)(Y + off + bj * HALF) = w; }
                row_sums_add(rso, row, o[0][0], o[0][1], o[1][0], o[1][1], fq); }
    }
};

struct EpiBf16LnTok {
    static constexpr bool PERM = true, AFTER_DRAIN = false, AROWPERM = true;
    bf16_t* O; int ldc; const long long* rs; const float* cs; const float* b2;
    __device__ __forceinline__ void operator()(const f32x4 (&acc)[2][2][4][2], const Unit& u, int wr, int wc, int fr, int fq) const {
        const int row0 = u.pm * BM + 128 * wr + 8 * fr, col0 = u.pn * BM + wc * 32 + 8 * fq;
        f32x4 cv[2][2], bv[2][2];
#pragma unroll
        for (int bj = 0; bj < 2; ++bj)
#pragma unroll
            for (int n = 0; n < 2; ++n) { cv[bj][n] = *(const f32x4*)(cs + col0 + bj * HALF + 4 * n); bv[bj][n] = *(const f32x4*)(b2 + col0 + bj * HALF + 4 * n); }
#pragma unroll
        for (int ai = 0; ai < 2; ++ai)
#pragma unroll
            for (int m = 0; m < 4; ++m) { const int row = row0 + 4 * ai + m; float mean, rstd; row_stats(rs, row, mean, rstd);
                bf16_t* rowp = O + (size_t)row * ldc + col0;
#pragma unroll
                for (int bj = 0; bj < 2; ++bj) { const f32x4 v0 = (acc[ai][bj][m][0] - cv[bj][0] * mean) * rstd + bv[bj][0], v1 = (acc[ai][bj][m][1] - cv[bj][1] * mean) * rstd + bv[bj][1];
                    u32x4 w; w.x = cvt_pk_bf16(v0[0], v0[1]); w.y = cvt_pk_bf16(v0[2], v0[3]); w.z = cvt_pk_bf16(v1[0], v1[1]); w.w = cvt_pk_bf16(v1[2], v1[3]);
                    *(u32x4*)(rowp + bj * HALF) = w; } }
    }
};

__device__ __forceinline__ float dpp_shr1(float x) { return __builtin_bit_cast(float, __builtin_amdgcn_update_dpp(0, __builtin_bit_cast(int, x), 0x111, 0xf, 0xf, true)); }
struct EpiConvGlu {
    static constexpr bool PERM = true, AFTER_DRAIN = false, AROWPERM = true;
    bf16_t* G; bf16_t* side; const long long* rs; const float* cs; const float* b2; const float* cw; int dff;
    __device__ __forceinline__ void operator()(const f32x4 (&acc)[2][2][4][2], const Unit& u, int wr, int wc, int fr, int fq) const {
        const int row0 = u.pm * BM + 128 * wr + 8 * fr, colg = u.pn * BM + wc * 32 + 8 * fq, ch0 = u.pn * HALF + wc * 32 + 8 * fq;
        float mean_[8], rstd_[8];
#pragma unroll
        for (int j = 0; j < 8; ++j) row_stats(rs, row0 + j, mean_[j], rstd_[j]);
        unsigned gout[8][4];
        const int bnd = row0 >> 7;
#pragma unroll
        for (int n = 0; n < 2; ++n) {
            const f32x4 ca = *(const f32x4*)(cs + colg + 4 * n), ba = *(const f32x4*)(b2 + colg + 4 * n), cu = *(const f32x4*)(cs + colg + HALF + 4 * n), bu = *(const f32x4*)(b2 + colg + HALF + 4 * n);
            const f32x4 w0 = *(const f32x4*)(cw + ch0 + 4 * n), w1 = *(const f32x4*)(cw + dff + ch0 + 4 * n), w2 = *(const f32x4*)(cw + 2 * dff + ch0 + 4 * n);
            f32x4 a[8], uu[8];
#pragma unroll
            for (int j = 0; j < 8; ++j) { a[j] = (acc[j >> 2][0][j & 3][n] - ca * mean_[j]) * rstd_[j] + ba; uu[j] = (acc[j >> 2][1][j & 3][n] - cu * mean_[j]) * rstd_[j] + bu; }
            f32x4 p6, p7;
#pragma unroll
            for (int q = 0; q < 4; ++q) { p6[q] = dpp_shr1(a[6][q]); p7[q] = dpp_shr1(a[7][q]); }
            if (fr == 15 && bnd + 1 < 128) { bf16_t* sp = side + ((size_t)(bnd + 1) * 6) * dff + ch0 + 4 * n;
                *(unsigned long long*)(sp) = (unsigned long long)cvt_pk_bf16(a[6][0], a[6][1]) | ((unsigned long long)cvt_pk_bf16(a[6][2], a[6][3]) << 32);
                *(unsigned long long*)(sp + dff) = (unsigned long long)cvt_pk_bf16(a[7][0], a[7][1]) | ((unsigned long long)cvt_pk_bf16(a[7][2], a[7][3]) << 32); }
            if (fr == 0) { bf16_t* sp = side + ((size_t)bnd * 6 + 2) * dff + ch0 + 4 * n;
                *(unsigned long long*)(sp) = (unsigned long long)cvt_pk_bf16(a[0][0], a[0][1]) | ((unsigned long long)cvt_pk_bf16(a[0][2], a[0][3]) << 32);
                *(unsigned long long*)(sp + dff) = (unsigned long long)cvt_pk_bf16(a[1][0], a[1][1]) | ((unsigned long long)cvt_pk_bf16(a[1][2], a[1][3]) << 32);
                *(unsigned long long*)(sp + 2 * dff) = (unsigned long long)cvt_pk_bf16(uu[0][0], uu[0][1]) | ((unsigned long long)cvt_pk_bf16(uu[0][2], uu[0][3]) << 32);
                *(unsigned long long*)(sp + 3 * dff) = (unsigned long long)cvt_pk_bf16(uu[1][0], uu[1][1]) | ((unsigned long long)cvt_pk_bf16(uu[1][2], uu[1][3]) << 32); }
#pragma unroll
            for (int j = 0; j < 8; ++j) { const f32x4 am1 = (j == 0) ? p7 : a[j ? j - 1 : 0], am2 = (j == 0) ? p6 : (j == 1 ? p7 : a[j > 1 ? j - 2 : 0]);
                const f32x4 c = w2 * a[j] + w1 * am1 + w0 * am2;
                const f32x2 g01 = gelu_pk((f32x2){c[0], c[1]}), g23 = gelu_pk((f32x2){c[2], c[3]});
                gout[j][2 * n] = cvt_pk_bf16(g01.x * uu[j][0], g01.y * uu[j][1]); gout[j][2 * n + 1] = cvt_pk_bf16(g23.x * uu[j][2], g23.y * uu[j][3]); }
        }
#pragma unroll
        for (int j = 0; j < 8; ++j) if (!(fr == 0 && j < 2)) { u32x4 w; w.x = gout[j][0]; w.y = gout[j][1]; w.z = gout[j][2]; w.w = gout[j][3]; *(u32x4*)(G + (size_t)(row0 + j) * dff + ch0) = w; }
    }
};
template <class E, class = void> struct arowperm_v { static constexpr bool value = false; };
template <class E> struct arowperm_v<E, decltype((void)E::AROWPERM)> { static constexpr bool value = E::AROWPERM; };
template <class Epi, class Sched, bool ALIGN_EPI = false, bool SP2 = false>
__device__ __forceinline__ void gemm_phase(PG8_LAS unsigned char* lds, const Gemm g, const Sched& S, const Epi& E) {
    int tid_l = threadIdx.x; asm volatile("" : "+v"(tid_l)); const int tid = tid_l, wid = __builtin_amdgcn_readfirstlane(tid >> 6), lane = tid & 63, wr = wid >> 2, wc = wid & 3, fr = lane & 15, fq = lane >> 4;
    const int K = g.K, nt = K / BK;
    unsigned voffA[2], voffB[2];
#pragma unroll
    for (int i = 0; i < 2; ++i) { int R, C; stage_rc(tid * 16 + i * 8192, R, C); const int Rb = Epi::PERM ? ((R & ~31) + perm32(R & 31)) : R;
        const int Ra = arowperm_v<Epi>::value ? (128 * (R >> 6) + 8 * (R & 15) + ((R >> 4) & 3)) : R;
        voffA[i] = (unsigned)(Ra * K + C) * 2u; voffB[i] = (unsigned)(Rb * K + C) * 2u; }
    const size_t hstepA = arowperm_v<Epi>::value ? (size_t)4 * K * 2 : (size_t)HALF * K * 2;
    const size_t kstep = (size_t)(BK * 2);
    const size_t hstep = (size_t)HALF * K * 2;
    const size_t tstep = 2 * hstep;
    const unsigned ldsw = (unsigned)wid * 1024u;
    const int aoff = lds_byte(wr * 64 + fr, fq * 8), boff = lds_byte(wc * 32 + fr, fq * 8);
#define PG8_SA(b, h) (((b) * 2 + (h)) * HTB)
#define PG8_SB(b, h) ((4 + (b) * 2 + (h)) * HTB)
#define PG8_STAGE(bufoff, gbase, voff) do { _Pragma("unroll") for (int _i = 0; _i < 2; ++_i) \
        __builtin_amdgcn_global_load_lds((const unsigned*)((const char*)(gbase) + (voff)[_i]), (PG8_LAS unsigned*)(lds + (bufoff) + ldsw + _i * 8192), 16, 0, 0); } while (0)
#define PG8_LDA(dst, b, h) do { _Pragma("unroll") for (int m = 0; m < 4; ++m) _Pragma("unroll") for (int k = 0; k < 2; ++k) dst[m][k] = *(const PG8_LAS bf16x8*)(lds + PG8_SA(b, h) + aoff + m * 2048 + k * 1024); } while (0)
#define PG8_LDB(dst, b, h) do { _Pragma("unroll") for (int n = 0; n < 2; ++n) _Pragma("unroll") for (int k = 0; k < 2; ++k) dst[n][k] = *(const PG8_LAS bf16x8*)(lds + PG8_SB(b, h) + boff + n * 2048 + k * 1024); } while (0)
#define PG8_MMA(ai, bj, At, Bt) do { __builtin_amdgcn_s_setprio(1); _Pragma("unroll") for (int m = 0; m < 4; ++m) _Pragma("unroll") for (int n = 0; n < 2; ++n) _Pragma("unroll") for (int k = 0; k < 2; ++k) \
        acc[ai][bj][m][n] = __builtin_amdgcn_mfma_f32_16x16x32_bf16(Bt[n][k], At[m][k], acc[ai][bj][m][n], 0, 0, 0); __builtin_amdgcn_s_setprio(0); } while (0)
#define PG8_WAIT_V(n) asm volatile("s_waitcnt vmcnt(" #n ")" ::: "memory")
#define PG8_WAIT_L(n) asm volatile("s_waitcnt lgkmcnt(" #n ")" ::: "memory")
#define PG8_BAR __builtin_amdgcn_s_barrier()
#define PG8_SCHED __builtin_amdgcn_sched_barrier(0)
    Unit cur, nxt; int ui = 0;
    if (!S.next(0, cur)) return;
    f32x4 acc[2][2][4][2];
#pragma unroll
    for (int a = 0; a < 2; ++a)
#pragma unroll
        for (int b = 0; b < 2; ++b)
#pragma unroll
            for (int m = 0; m < 4; ++m)
#pragma unroll
                for (int n = 0; n < 2; ++n) acc[a][b][m][n] = (f32x4){0.f, 0.f, 0.f, 0.f};
    bf16x8 At[4][2], B0[2][2], B1[2][2];
    const char* cA = (const char*)g.A + (size_t)cur.pm * tstep; const char* cB = (const char*)g.Bt + (size_t)cur.pn * tstep;
    S.a_ready(cur);
    if constexpr (SP2) {
        PG8_STAGE(PG8_SB(0, 0), cB, voffB); PG8_STAGE(PG8_SB(0, 1), cB + hstep, voffB); PG8_STAGE(PG8_SA(0, 0), cA, voffA); PG8_STAGE(PG8_SA(0, 1), cA + hstepA, voffA);
        if (wr == 1) PG8_BAR;
        PG8_WAIT_V(2); PG8_BAR;
        PG8_STAGE(PG8_SB(1, 0), cB + kstep, voffB); PG8_STAGE(PG8_SA(1, 0), cA + kstep, voffA); PG8_STAGE(PG8_SB(1, 1), cB + hstep + kstep, voffB);
        PG8_WAIT_V(6); PG8_BAR;
    } else {
        PG8_STAGE(PG8_SB(0, 0), cB, voffB); PG8_STAGE(PG8_SA(0, 0), cA, voffA); PG8_STAGE(PG8_SB(0, 1), cB + hstep, voffB); PG8_STAGE(PG8_SA(0, 1), cA + hstepA, voffA);
        if (wr == 1) PG8_BAR;
        PG8_WAIT_V(4); PG8_BAR;
        PG8_STAGE(PG8_SB(1, 0), cB + kstep, voffB); PG8_STAGE(PG8_SA(1, 0), cA + kstep, voffA); PG8_STAGE(PG8_SB(1, 1), cB + hstep + kstep, voffB);
        PG8_WAIT_V(6); PG8_BAR;
    }
    for (;;) {
        const bool has_next = S.next(ui + 1, nxt);
        const char* nA = has_next ? (const char*)g.A + (size_t)nxt.pm * tstep : cA; const char* nB = has_next ? (const char*)g.Bt + (size_t)nxt.pn * tstep : cB;
        for (int t = 0; t < nt; t += 2) {
            const bool last = (t == nt - 2);
            const char* a1 = cA + (size_t)(t + 1) * kstep;
            const char* a2 = last ? nA : cA + (size_t)(t + 2) * kstep; const char* b2 = last ? nB : cB + (size_t)(t + 2) * kstep;
            const char* a3 = a2 + kstep; const char* b3 = b2 + kstep;
            if (last && has_next) S.a_ready(nxt);
            if constexpr (SP2) {
            PG8_LDB(B0, 0, 0); PG8_LDB(B1, 0, 1); PG8_SCHED; PG8_LDA(At, 0, 0); PG8_STAGE(PG8_SA(1, 1), a1 + hstepA, voffA);
            PG8_WAIT_V(8); PG8_WAIT_L(0); PG8_BAR; PG8_MMA(0, 0, At, B0); PG8_MMA(0, 1, At, B1); PG8_BAR; PG8_SCHED;
            PG8_LDA(At, 0, 1); PG8_STAGE(PG8_SB(0, 0), b2, voffB); PG8_STAGE(PG8_SB(0, 1), b2 + hstep, voffB); PG8_STAGE(PG8_SA(0, 0), a2, voffA);
            PG8_WAIT_V(8); PG8_WAIT_L(0); PG8_BAR; PG8_MMA(1, 0, At, B0); PG8_MMA(1, 1, At, B1); PG8_BAR; PG8_SCHED;
            PG8_LDB(B0, 1, 0); PG8_LDB(B1, 1, 1); PG8_SCHED; PG8_LDA(At, 1, 0); PG8_STAGE(PG8_SA(0, 1), a2 + hstepA, voffA);
            PG8_WAIT_V(8); PG8_WAIT_L(0); PG8_BAR; PG8_MMA(0, 0, At, B0); PG8_MMA(0, 1, At, B1); PG8_BAR; PG8_SCHED;
            PG8_LDA(At, 1, 1); PG8_STAGE(PG8_SB(1, 0), b3, voffB); PG8_STAGE(PG8_SB(1, 1), b3 + hstep, voffB); PG8_STAGE(PG8_SA(1, 0), a3, voffA);
            PG8_WAIT_V(8); PG8_WAIT_L(0); PG8_BAR; PG8_MMA(1, 0, At, B0); PG8_MMA(1, 1, At, B1); PG8_BAR; PG8_SCHED;
            } else {
            PG8_LDB(B0, 0, 0); PG8_SCHED; PG8_LDA(At, 0, 0); PG8_STAGE(PG8_SA(1, 1), a1 + hstepA, voffA);
            PG8_WAIT_L(8); PG8_BAR; PG8_WAIT_L(0); PG8_MMA(0, 0, At, B0); PG8_BAR; PG8_SCHED;
            PG8_LDB(B1, 0, 1); PG8_STAGE(PG8_SB(0, 0), b2, voffB);
            PG8_BAR; PG8_WAIT_L(0); PG8_MMA(0, 1, At, B1); PG8_BAR;
            PG8_LDA(At, 0, 1); PG8_STAGE(PG8_SA(0, 0), a2, voffA);
            PG8_BAR; PG8_WAIT_L(0); PG8_MMA(1, 0, At, B0); PG8_BAR; PG8_SCHED;
            PG8_STAGE(PG8_SB(0, 1), b2 + hstep, voffB);
            PG8_WAIT_V(6); PG8_BAR; PG8_MMA(1, 1, At, B1); PG8_BAR;
            PG8_LDB(B0, 1, 0); PG8_SCHED; PG8_LDA(At, 1, 0); PG8_STAGE(PG8_SA(0, 1), a2 + hstepA, voffA);
            PG8_WAIT_L(8); PG8_BAR; PG8_WAIT_L(0); PG8_MMA(0, 0, At, B0); PG8_BAR; PG8_SCHED;
            PG8_LDB(B1, 1, 1); PG8_STAGE(PG8_SB(1, 0), b3, voffB);
            PG8_BAR; PG8_WAIT_L(0); PG8_MMA(0, 1, At, B1); PG8_BAR;
            PG8_LDA(At, 1, 1); PG8_STAGE(PG8_SA(1, 0), a3, voffA);
            PG8_BAR; PG8_WAIT_L(0); PG8_MMA(1, 0, At, B0); PG8_BAR; PG8_SCHED;
            PG8_STAGE(PG8_SB(1, 1), b3 + hstep, voffB);
            PG8_WAIT_V(6); PG8_BAR; PG8_MMA(1, 1, At, B1); PG8_BAR;
            }
        }
        if constexpr (ALIGN_EPI) { if (wr == 0) PG8_BAR; }
        if constexpr (!Epi::AFTER_DRAIN) { E(acc, cur, wr, wc, fr, fq); S.done(cur); }
        if (!has_next) break;
#pragma unroll
        for (int a = 0; a < 2; ++a)
#pragma unroll
            for (int b = 0; b < 2; ++b)
#pragma unroll
                for (int m = 0; m < 4; ++m)
#pragma unroll
                    for (int n = 0; n < 2; ++n) acc[a][b][m][n] = (f32x4){0.f, 0.f, 0.f, 0.f};
        cur = nxt; cA = nA; cB = nB; ++ui;
        if constexpr (ALIGN_EPI) { if (wr == 1) PG8_BAR; }
    }
    PG8_WAIT_V(0);
    if constexpr (!ALIGN_EPI) { if (wr == 0) PG8_BAR; }
    PG8_BAR;
    if constexpr (Epi::AFTER_DRAIN) { E.fused(acc, cur, wr, wc, fr, fq, lds, wid, lane); S.done(cur); }
#undef PG8_SA
#undef PG8_SB
#undef PG8_STAGE
#undef PG8_LDA
#undef PG8_LDB
#undef PG8_MMA
#undef PG8_WAIT_V
#undef PG8_WAIT_L
#undef PG8_BAR
#undef PG8_SCHED
}
}

#ifndef PG8_SP2
#define PG8_SP2 true
#endif
#ifndef PG8_ALIGN
#define PG8_ALIGN true
#endif
constexpr int NWAVES = 8, NTHR = 512;
constexpr int BATCH = 2, SEQ = 8192, DM = 4096, MTOK = BATCH * SEQ;
constexpr int HD = 128;
constexpr int A_HEADS = 16, B_HEADS = 16, A_W = 2048, B_W = 2048, AB_IN = 4 * A_W + 3 * B_W;
constexpr int NSA_H = 32, NSA_G = 4, NSA_R = 8, KVW = 512, NSA_IN = 4096 + 6 * KVW + 96, NSA_INP = 7424;
constexpr int NCMP = 511, NCMPP = 512, NSLC = 128, NTOP = 16, WINDOW = 512;
constexpr int NMEM = 256, XH = 4, XW = 512;
constexpr int DFF = 11008, DFF2 = 22016;
constexpr float LN_EPS = 1e-5f, RMS_EPS = 1e-6f;
constexpr float DN_ALPHA = 1.41421356237309515f;
constexpr size_t MiB = (size_t)1 << 20;
constexpr size_t WS_CTL = 0, CTL_ZERO_BYTES = 4 * MiB;
constexpr size_t WS_FOLD = 64 * 1024;
constexpr int FO_XQ = 0, FO_UP = 2 * 512, FO_NSA = FO_UP + 2 * 22016, FO_N = FO_NSA + 7424;
constexpr size_t WS_RSUM = 1 * MiB;
static_assert(WS_FOLD + (size_t)2 * FO_N * 8 <= WS_RSUM && WS_RSUM + (size_t)6 * 16384 * 2 * 8 <= CTL_ZERO_BYTES, "CTL map");
constexpr size_t WS_W_ABIN = 4 * MiB;
constexpr size_t WS_W_ABOUT = WS_W_ABIN + 112 * MiB;
constexpr size_t WS_W_NSAIN = WS_W_ABOUT + 32 * MiB;
constexpr size_t WS_W_NSAOUT = WS_W_NSAIN + 58 * MiB;
constexpr size_t WS_W_XQ = WS_W_NSAOUT + 32 * MiB;
constexpr size_t WS_W_XKV = WS_W_XQ + 8 * MiB;
constexpr size_t WS_W_XO = WS_W_XKV + 16 * MiB;
constexpr size_t WS_W_UP = WS_W_XO + 8 * MiB;
constexpr size_t WS_W_DOWN = WS_W_UP + 344 * MiB;
constexpr size_t WS_W_C1 = WS_W_DOWN + 172 * MiB;
constexpr size_t WS_W_C2 = WS_W_C1 + 2 * MiB;
constexpr size_t WS_MEMB = WS_W_C2 + 1 * MiB;
constexpr size_t WS_HB = WS_MEMB + 4 * MiB;
constexpr size_t WS_Y = WS_HB + 128 * MiB;
constexpr size_t WS_BIG = WS_Y + 256 * MiB;
constexpr size_t WS_G = WS_BIG + 688 * MiB;
constexpr size_t WS_O = WS_G + 344 * MiB;
constexpr size_t WS_MISC = WS_O + 128 * MiB;
constexpr size_t WS_END = WS_MISC + 64 * MiB;
constexpr size_t WS_XQ = WS_MISC;
constexpr size_t WS_XO = WS_MISC + 16 * MiB;
constexpr size_t WS_XKV = WS_MISC + 32 * MiB;
constexpr size_t WS_LB = WS_MISC + 34 * MiB;
constexpr size_t WS_SIDE = WS_MISC + 42 * MiB;
constexpr size_t WS_FOLDF = WS_MISC + 40 * MiB;
constexpr size_t WS_ROPE = WS_MISC + 36 * MiB;
constexpr size_t WS_STATS = WS_MISC + 35 * MiB;
constexpr size_t WS_PROJ0 = WS_BIG;
constexpr size_t WS_SPREV = WS_BIG + 448 * MiB;
constexpr size_t WS_QT = WS_G;
constexpr size_t WS_OINTRA = WS_G + 64 * MiB;
constexpr size_t WS_DEC = WS_G + 192 * MiB;
constexpr size_t WS_DS = WS_Y;
constexpr size_t WS_PROJ1 = WS_BIG;
constexpr size_t WS_QROT = WS_BIG + 232 * MiB;
constexpr size_t WS_KSROT = WS_BIG + 360 * MiB;
constexpr size_t WS_KWROT = WS_BIG + 376 * MiB;
constexpr size_t WS_KCMP = WS_BIG + 392 * MiB;
constexpr size_t WS_VCMP = WS_BIG + 393 * MiB;
constexpr size_t WS_OVL = WS_BIG + 394 * MiB;
constexpr size_t WS_SEL = WS_BIG + 395 * MiB;
constexpr size_t WS_IMP = WS_G + 256 * MiB;
constexpr size_t WS_O32 = WS_G;
static_assert(WS_SPREV + 128 * MiB <= WS_G && WS_DEC + 2 * MiB <= WS_O && WS_SEL + MiB <= WS_G, "ws map");
constexpr int CW_TMO = 0, CW_CODE = 1;
constexpr int CW_BAR = 4096;
constexpr int RING_OFF = 0, RING_BYTES = 131072;
constexpr int LDSCTL_OFF = RING_BYTES, MISC_OFF = LDSCTL_OFF + 320;
constexpr int LDS_BYTES = 147456;
static_assert(MISC_OFF + 128 <= LDS_BYTES, "LDS map");

#define GAS __attribute__((address_space(1)))
#define LAS __attribute__((address_space(3)))
typedef unsigned short bf16;
typedef unsigned v4u __attribute__((ext_vector_type(4)));
typedef unsigned v2u __attribute__((ext_vector_type(2)));
typedef float f32x4 __attribute__((ext_vector_type(4)));
typedef float f32x2 __attribute__((ext_vector_type(2)));
typedef float f32x16 __attribute__((ext_vector_type(16)));
typedef short bf16x8 __attribute__((ext_vector_type(8)));
typedef short s16x4 __attribute__((ext_vector_type(4)));
typedef GAS unsigned gu32;
#define RLX_AGENT __ATOMIC_RELAXED, __HIP_MEMORY_SCOPE_AGENT
#define LDS_WAIT() asm volatile("s_waitcnt lgkmcnt(0)" ::: "memory")
#define VM_WAIT() asm volatile("s_waitcnt vmcnt(0)" ::: "memory")
#define SBAR() __builtin_amdgcn_sched_barrier(0)
__device__ __forceinline__ unsigned f2bf(float f) { unsigned u = __builtin_bit_cast(unsigned, f); return (u + 0x7fffu + ((u >> 16) & 1u)) >> 16; }
__device__ __forceinline__ unsigned pk2(float lo, float hi) { return f2bf(lo) | (f2bf(hi) << 16); }
__device__ __forceinline__ float bf2f(unsigned short b) { return __builtin_bit_cast(float, (unsigned)b << 16); }
__device__ __forceinline__ float bflo(unsigned w) { return __builtin_bit_cast(float, w << 16); }
__device__ __forceinline__ float bfhi(unsigned w) { return __builtin_bit_cast(float, w & 0xffff0000u); }
__device__ __forceinline__ unsigned cvtpk(float lo, float hi) { unsigned r; asm volatile("v_cvt_pk_bf16_f32 %0, %1, %2" : "=v"(r) : "v"(lo), "v"(hi)); return r; }
__device__ __forceinline__ float wave_sum(float v) {
#pragma unroll
    for (int o = 1; o < 64; o <<= 1) v += __shfl_xor(v, o);
    return v;
}
__device__ __forceinline__ float sigmoidf_(float x) { return __builtin_amdgcn_rcpf(1.f + __builtin_amdgcn_exp2f(-1.4426950408889634f * x)); }
__device__ __forceinline__ float gelu1(float v) { pg8::f32x2 r = pg8::gelu_pk((pg8::f32x2){v, 0.f}); return r.x; }
#define XB_TMO      128
#define XB_XCNT(j)  (256  + 64 * (j))
#define XB_XSUB(j)  (1280 + 64 * (j))
#define XB_XGEN(j)  (2304 + 64 * (j))
#define XB_TOP      3328
#define XB_TOPGEN   3392
#define XCD_BAR_WORDS 3456
#define XB_SPIN_CAP (1u << 18)
#define LAS __attribute__((address_space(3)))

__device__ __forceinline__ unsigned xb_ld(unsigned* p)              { return __hip_atomic_load(p, __ATOMIC_RELAXED, __HIP_MEMORY_SCOPE_AGENT); }
__device__ __forceinline__ unsigned xb_add(unsigned* p, unsigned v) { return __hip_atomic_fetch_add(p, v, __ATOMIC_RELAXED, __HIP_MEMORY_SCOPE_AGENT); }
__device__ __forceinline__ unsigned xb_xcc_id() { return (unsigned)__builtin_amdgcn_s_getreg((3 << 11) | 20) & 0xFu; }
#define XB_SPIN(cond, bar) do { unsigned _sp = 0; while (cond) { __builtin_amdgcn_s_sleep(1); \
    if ((++_sp & 255u) == 0u) { if (xb_ld(&(bar)[XB_TMO])) break; if (_sp > XB_SPIN_CAP) { atomicAdd(&(bar)[XB_TMO], 1u); break; } } } } while (0)

struct XcdBarrier {
    unsigned* bar; unsigned x;
    volatile LAS unsigned* st;
};

__device__ __forceinline__ XcdBarrier xcd_barrier_post(unsigned* bar, volatile LAS unsigned* st) {
    XcdBarrier b; b.bar = bar; b.x = xb_xcc_id(); b.st = st;
    if (threadIdx.x == 0) (void)xb_add(&bar[XB_XCNT(b.x)], 1u);
    return b;
}
__device__ __forceinline__ void xcd_barrier_complete(unsigned* bar, unsigned x, unsigned& nloc, unsigned& nx) {
    const unsigned G = gridDim.x * gridDim.y * gridDim.z;
    unsigned sum, cnt, mine, sp = 0u;
    for (;;) {
        sum = 0u; cnt = 0u; mine = 0u;
#pragma unroll
        for (unsigned j = 0; j < 16; ++j) { const unsigned c = xb_ld(&bar[XB_XCNT(j)]); sum += c; cnt += (c > 0u) ? 1u : 0u; mine = (j == x) ? c : mine; }
        if (sum == G) break;
        __builtin_amdgcn_s_sleep(1);
        if ((++sp & 255u) == 0u) { if (xb_ld(&bar[XB_TMO])) break; if (sp > XB_SPIN_CAP) { atomicAdd(&bar[XB_TMO], 1u); break; } }
    }
    nloc = mine > 0u ? mine : 1u; nx = cnt > 0u ? cnt : 1u;
}

__device__ __forceinline__ void xcd_barrier(const XcdBarrier& b) {
    asm volatile("s_waitcnt vmcnt(0)" ::: "memory");
    __syncthreads();
    if (threadIdx.x == 0) {
        unsigned* bar = b.bar;
        __builtin_amdgcn_s_waitcnt(0);
        unsigned nloc = b.st[0], nx = b.st[1];
        if (nloc == 0u) { xcd_barrier_complete(bar, b.x, nloc, nx); b.st[0] = nloc; b.st[1] = nx; }
        const unsigned old = xb_add(&bar[XB_XSUB(b.x)], 1u);
        const unsigned gen = old / nloc;
        if (old + 1u == (gen + 1u) * nloc) {
            __builtin_amdgcn_fence(__ATOMIC_RELEASE, "agent");
            asm volatile("s_waitcnt vmcnt(0)" ::: "memory");
            const unsigned og = xb_add(&bar[XB_TOP], 1u);
            const unsigned tg = og / nx;
            if (og + 1u == (tg + 1u) * nx) xb_add(&bar[XB_TOPGEN], 1u);
            else XB_SPIN(xb_ld(&bar[XB_TOPGEN]) == tg, bar);
            __builtin_amdgcn_fence(__ATOMIC_ACQUIRE, "agent");
            xb_add(&bar[XB_XGEN(b.x)], 1u);
            asm volatile("s_waitcnt vmcnt(0)" ::: "memory");
        } else {
            XB_SPIN(xb_ld(&bar[XB_XGEN(b.x)]) == gen, bar);
            __builtin_amdgcn_fence(__ATOMIC_ACQUIRE, "agent");
            asm volatile("s_waitcnt vmcnt(0)" ::: "memory");
        }
    }
    __syncthreads();
}


constexpr int ATT_D = 128, KVBLK = 64;
constexpr int SHM_V = KVBLK * ATT_D * 2, SHM_K = KVBLK * ATT_D * 2;
constexpr int ATT_K_OFF = 0, ATT_V_OFF = SHM_K, ATT_BUF = SHM_K + SHM_V, ATT_SET = 2 * ATT_BUF;
constexpr int ATT_WS_OFF = RING_BYTES + 512;
constexpr int ATT_X_OFF = ATT_WS_OFF + NWAVES * 256;
static_assert(2 * ATT_SET <= RING_BYTES && ATT_X_OFF + 2048 + NTHR * 16 <= LDS_BYTES, "attention LDS map");
#define KSWZ(row, colB) ((row) * 256 + ((colB) ^ (((row) & 7) << 4)))
__device__ __forceinline__ int crow(int r, int hi) { return (r & 3) + 8 * (r >> 2) + 4 * hi; }
__device__ __forceinline__ int v_st(int k, int c) { const int kk = (k & ~0xC) | ((k & 4) << 1) | ((k & 8) >> 1); return ((kk >> 3) * 4 + (c >> 5)) * 512 + ((kk & 7) * 32 + (c & 31)) * 2; }
__device__ __forceinline__ int v_rd_base(int lane) { return ((lane & 3) << 3) | (((lane >> 2) & 3) << 6) | (((lane >> 4) & 1) << 5) | (((lane >> 5) & 1) << 8); }
constexpr int v_rd_off(int d0, int ks, int half) { return d0 * 512 + ks * 4096 + half * 2048; }
template <int OFF> __device__ __forceinline__ s16x4 tr_read(int vb) {
  s16x4 r; asm volatile("ds_read_b64_tr_b16 %0, %1 offset:%2" : "=&v"(r) : "v"(vb), "i"(OFF) : "memory"); return r;
}
__device__ __forceinline__ void qkt(f32x16& p0, f32x16& p1, const LAS char* Ks, const bf16x8* qr, int r32, int hi) {
  p0 = f32x16{}; p1 = f32x16{};
#pragma unroll
  for (int d0 = 0; d0 < 8; ++d0) { const int cb = (d0 * 16 + hi * 8) * 2;
    const bf16x8 b0 = *(const LAS bf16x8*)(Ks + KSWZ(r32, cb));
    const bf16x8 b1 = *(const LAS bf16x8*)(Ks + KSWZ(32 + r32, cb));
    p0 = __builtin_amdgcn_mfma_f32_32x32x16_bf16(b0, qr[d0], p0, 0, 0, 0);
    p1 = __builtin_amdgcn_mfma_f32_32x32x16_bf16(b1, qr[d0], p1, 0, 0, 0); }
}
__device__ __forceinline__ void pack_p(const f32x16& p0, const f32x16& p1, bf16x8& pa0, bf16x8& pa1, bf16x8& pa2, bf16x8& pa3) {
#define PK4(P, BASE, OUT) do { unsigned a0 = cvtpk(P[BASE + 0], P[BASE + 1]), a1 = cvtpk(P[BASE + 2], P[BASE + 3]);   \
    unsigned b0 = cvtpk(P[BASE + 4], P[BASE + 5]), b1 = cvtpk(P[BASE + 6], P[BASE + 7]);                              \
    auto r0 = __builtin_amdgcn_permlane32_swap(a0, b0, false, false); auto r1 = __builtin_amdgcn_permlane32_swap(a1, b1, false, false); \
    v4u w = {r0[0], r1[0], r0[1], r1[1]}; OUT = __builtin_bit_cast(bf16x8, w); } while (0)
  PK4(p0, 0, pa0); PK4(p0, 8, pa1); PK4(p1, 0, pa2); PK4(p1, 8, pa3);
#undef PK4
}
template <int D0> __device__ __forceinline__ void pv_one(f32x16& od, int vb, bf16x8 pa0, bf16x8 pa1, bf16x8 pa2, bf16x8 pa3) {
  const s16x4 l0 = tr_read<v_rd_off(D0, 0, 0)>(vb), h0 = tr_read<v_rd_off(D0, 0, 1)>(vb), l1 = tr_read<v_rd_off(D0, 1, 0)>(vb), h1 = tr_read<v_rd_off(D0, 1, 1)>(vb);
  const s16x4 l2 = tr_read<v_rd_off(D0, 2, 0)>(vb), h2 = tr_read<v_rd_off(D0, 2, 1)>(vb), l3 = tr_read<v_rd_off(D0, 3, 0)>(vb), h3 = tr_read<v_rd_off(D0, 3, 1)>(vb);
  asm volatile("s_waitcnt lgkmcnt(0)" ::: "memory"); SBAR();
#define PKV(L, H) (bf16x8){L[0], L[1], L[2], L[3], H[0], H[1], H[2], H[3]}
  od = __builtin_amdgcn_mfma_f32_32x32x16_bf16(pa0, PKV(l0, h0), od, 0, 0, 0);
  od = __builtin_amdgcn_mfma_f32_32x32x16_bf16(pa1, PKV(l1, h1), od, 0, 0, 0);
  od = __builtin_amdgcn_mfma_f32_32x32x16_bf16(pa2, PKV(l2, h2), od, 0, 0, 0);
  od = __builtin_amdgcn_mfma_f32_32x32x16_bf16(pa3, PKV(l3, h3), od, 0, 0, 0);
#undef PKV
}
__device__ __forceinline__ void pv_d0(f32x16* o, int vb, bf16x8 pa0, bf16x8 pa1, bf16x8 pa2, bf16x8 pa3) {
  pv_one<0>(o[0], vb, pa0, pa1, pa2, pa3); pv_one<1>(o[1], vb, pa0, pa1, pa2, pa3); pv_one<2>(o[2], vb, pa0, pa1, pa2, pa3); pv_one<3>(o[3], vb, pa0, pa1, pa2, pa3);
}
struct KVStage { bf16x8 ks0, ks1, vs0, vs1; };
__device__ __forceinline__ void kv_load(KVStage& s, const bf16* Kh, const bf16* Vh, long ldk, long ldv, int k0, int sr, int sc) {
  s.ks0 = *(const bf16x8*)(Kh + (long)(k0 + sr) * ldk + sc); s.ks1 = *(const bf16x8*)(Kh + (long)(k0 + 32 + sr) * ldk + sc);
  s.vs0 = *(const bf16x8*)(Vh + (long)(k0 + sr) * ldv + sc); s.vs1 = *(const bf16x8*)(Vh + (long)(k0 + 32 + sr) * ldv + sc);
}
__device__ __forceinline__ void kv_write(const KVStage& s, LAS char* lds, int sr, int sc) {
  *(LAS bf16x8*)(lds + ATT_V_OFF + v_st(sr, sc)) = s.vs0; *(LAS bf16x8*)(lds + ATT_V_OFF + v_st(32 + sr, sc)) = s.vs1;
  *(LAS bf16x8*)(lds + ATT_K_OFF + KSWZ(sr, sc * 2)) = s.ks0; *(LAS bf16x8*)(lds + ATT_K_OFF + KSWZ(32 + sr, sc * 2)) = s.ks1;
}
struct KVDma { int ko[2], vo[2]; };
__device__ __forceinline__ void kv_dma_init(KVDma& d, int ldk, int ldv, int wid, int lane) {
#pragma unroll
  for (int i = 0; i < 2; ++i) { const int p = wid * 2 + i;
    const int row = p * 4 + (lane >> 4), cp = lane & 15; d.ko[i] = row * ldk + ((cp ^ (row & 7)) << 3);
    const int sub = p * 2 + (lane >> 5), kk = (sub >> 2) * 8 + ((lane & 31) >> 2), k = (kk & ~0xC) | ((kk & 4) << 1) | ((kk & 8) >> 1), c = (sub & 3) * 32 + (lane & 3) * 8;
    d.vo[i] = k * ldv + c; }
}
__device__ __forceinline__ void kv_dma(const KVDma& d, const bf16* Kt, const bf16* Vt, LAS char* lds, int buf, int wid) {
#pragma unroll
  for (int i = 0; i < 2; ++i) {
    __builtin_amdgcn_global_load_lds((const unsigned*)(Kt + d.ko[i]), (LAS unsigned*)(lds + buf + ATT_K_OFF + (wid * 2 + i) * 1024), 16, 0, 0);
    __builtin_amdgcn_global_load_lds((const unsigned*)(Vt + d.vo[i]), (LAS unsigned*)(lds + buf + ATT_V_OFF + (wid * 2 + i) * 1024), 16, 0, 0); }
}
__device__ __forceinline__ void rescale_o(f32x16* o, float a, LAS float* al_l, int r32, int hi) {
  if (__any(a < 1.f)) { if (hi == 0) al_l[r32] = a; LDS_WAIT();
#pragma unroll
    for (int r = 0; r < 16; ++r) { const float f = al_l[crow(r, hi)];
#pragma unroll
      for (int d = 0; d < 4; ++d) o[d][r] *= f; }
    LDS_WAIT(); }
}
constexpr float ATT_SCALE = 0.088388347648318440f, ATT_C = ATT_SCALE * 1.4426950408889634f, ATT_THR = 8.f;
__device__ __forceinline__ void softmax_tile(f32x16& p0, f32x16& p1, float& m_reg, float& l_reg, float& alpha, bool rowvalid = true) {
  float pmax = p0[0];
#pragma unroll
  for (int r = 1; r < 16; ++r) pmax = fmaxf(pmax, p0[r]);
#pragma unroll
  for (int r = 0; r < 16; ++r) pmax = fmaxf(pmax, p1[r]);
  { auto rr = __builtin_amdgcn_permlane32_swap(__float_as_uint(pmax), __float_as_uint(pmax), false, false);
    pmax = fmaxf(__uint_as_float(rr[0]), __uint_as_float(rr[1])); }
  if (!rowvalid) pmax = -__builtin_inff();
  float mn;
  if (__all(pmax - m_reg <= ATT_THR / ATT_SCALE)) { mn = m_reg; alpha = 1.f; }
  else { mn = fmaxf(m_reg, pmax); alpha = __builtin_amdgcn_exp2f((m_reg - mn) * ATT_C); m_reg = mn; }
  const float mnC = rowvalid ? -mn * ATT_C : -__builtin_inff();
#pragma unroll
  for (int r = 0; r < 16; ++r) { p0[r] = __builtin_amdgcn_exp2f(fmaf(p0[r], ATT_C, mnC)); p1[r] = __builtin_amdgcn_exp2f(fmaf(p1[r], ATT_C, mnC)); }
  float ps = 0.f;
#pragma unroll
  for (int r = 0; r < 16; ++r) ps += p0[r] + p1[r];
  { auto rr = __builtin_amdgcn_permlane32_swap(__float_as_uint(ps), __float_as_uint(ps), false, false);
    ps = __uint_as_float(rr[0]) + __uint_as_float(rr[1]); }
  l_reg = l_reg * alpha + ps;
}
__device__ __forceinline__ void attn_finish(f32x16& p0, f32x16& p1, f32x16* o, float& m_reg, float& l_reg, LAS float* wsc, int vb, int r32, int hi, bool rowvalid = true) {
  float alpha; softmax_tile(p0, p1, m_reg, l_reg, alpha, rowvalid);
  rescale_o(o, alpha, wsc, r32, hi);
  bf16x8 pa0, pa1, pa2, pa3; pack_p(p0, p1, pa0, pa1, pa2, pa3);
  pv_d0(o, vb, pa0, pa1, pa2, pa3);
}
__device__ __forceinline__ void load_q(bf16x8* qr, const bf16* Qw) {
#pragma unroll
  for (int d0 = 0; d0 < 8; ++d0) qr[d0] = *(const bf16x8*)(Qw + d0 * 16);
}

struct Frame {
    LAS unsigned char* lds;
    unsigned char* ws;
    int tid, lane, wave, G, bid;
    __device__ __forceinline__ void fresh() { int t = threadIdx.x; asm volatile("" : "+v"(t)); tid = t; lane = t & 63; wave = __builtin_amdgcn_readfirstlane(t >> 6);
        int g_ = gridDim.x, b_ = blockIdx.x; asm volatile("" : "+s"(g_), "+s"(b_)); G = g_; bid = b_; }
};
struct Args { const float* in[19]; float* out; unsigned char* ws; int ph_lo, ph_hi; };
typedef const Args __attribute__((address_space(4))) KArgs;
__device__ __forceinline__ KArgs* karg() { KArgs* p = (KArgs*)__builtin_amdgcn_kernarg_segment_ptr(); asm volatile("" : "+s"(p)); return p; }
#define KIN(i) ((const float*)karg()->in[i])
enum { IN_X = 0, IN_MEM, IN_AB_W_IN, IN_HGRN_LB, IN_HGRN_NW, IN_AB_W_OUT, IN_NSA_W_IN, IN_NSA_CMP_POS, IN_NSA_CMP_W1, IN_NSA_CMP_W2, IN_NSA_W_OUT,
       IN_XA_WQ, IN_XA_WKV, IN_XA_WO, IN_FFN_UP, IN_FFN_CONV, IN_FFN_DOWN, IN_LN_G, IN_LN_B };

__device__ __forceinline__ void p0_transpose_item(const float* W, int K, int N, bf16* WT, LAS float* scr, int item, int lane) {
    const int nblk = N / 32, kb = item / nblk, nb = item % nblk, k0 = 64 * kb, n0 = 32 * nb;
#pragma unroll 8
    for (int i = 0; i < 32; ++i) { const int kk = 2 * i + (lane >> 5); scr[kk * 33 + (lane & 31)] = W[(size_t)(k0 + kk) * N + n0 + (lane & 31)]; }
    LDS_WAIT(); asm volatile("" ::: "memory");
    const int c = lane & 7;
#pragma unroll
    for (int j = 0; j < 4; ++j) { const int n = (lane >> 3) + 8 * j; const LAS float* s = scr + (8 * c) * 33 + n;
        v4u o; o.x = pk2(s[0 * 33], s[1 * 33]); o.y = pk2(s[2 * 33], s[3 * 33]); o.z = pk2(s[4 * 33], s[5 * 33]); o.w = pk2(s[6 * 33], s[7 * 33]);
        *(GAS v4u*)(WT + (size_t)(n0 + n) * K + k0 + 8 * c) = o; }
    LDS_WAIT(); asm volatile("" ::: "memory");
}
__device__ __forceinline__ int up_col(int n) { const int isu = n >= DFF, ch = isu ? n - DFF : n; return (ch >> 7) * 256 + isu * 128 + (ch & 127); }
__device__ __forceinline__ void p0_transpose_item_fold(const float* W, int K, int N, bf16* WT, LAS float* scr, int item, int lane, const float* g, const float* b, long long* cs, long long* b2, bool upmap = false) {
    const int nblk = N / 32, kb = item / nblk, nb = item % nblk, k0 = 64 * kb, n0 = 32 * nb, n0m = upmap ? up_col(n0) : n0;
#pragma unroll 8
    for (int i = 0; i < 32; ++i) { const int kk = 2 * i + (lane >> 5); scr[kk * 33 + (lane & 31)] = W[(size_t)(k0 + kk) * N + n0 + (lane & 31)]; }
    LDS_WAIT(); asm volatile("" ::: "memory");
    const int c = lane & 7;
    const f32x4 g0 = *(const f32x4*)(g + k0 + 8 * c), g1 = *(const f32x4*)(g + k0 + 8 * c + 4), b0 = *(const f32x4*)(b + k0 + 8 * c), b1 = *(const f32x4*)(b + k0 + 8 * c + 4);
    const float gg[8] = {g0.x, g0.y, g0.z, g0.w, g1.x, g1.y, g1.z, g1.w}, bb[8] = {b0.x, b0.y, b0.z, b0.w, b1.x, b1.y, b1.z, b1.w};
#pragma unroll
    for (int j = 0; j < 4; ++j) { const int n = (lane >> 3) + 8 * j; const LAS float* s = scr + (8 * c) * 33 + n;
        float sc = 0.f, sb = 0.f; unsigned w[4];
#pragma unroll
        for (int q = 0; q < 4; ++q) { const float x0 = s[(2 * q) * 33], x1 = s[(2 * q + 1) * 33]; const unsigned r0 = f2bf(x0 * gg[2 * q]), r1 = f2bf(x1 * gg[2 * q + 1]);
            w[q] = r0 | (r1 << 16); sc += bf2f((unsigned short)r0) + bf2f((unsigned short)r1); sb += x0 * bb[2 * q] + x1 * bb[2 * q + 1]; }
        *(GAS v4u*)(WT + (size_t)(n0m + n) * K + k0 + 8 * c) = (v4u){w[0], w[1], w[2], w[3]};
        sc += __shfl_xor(sc, 1); sc += __shfl_xor(sc, 2); sc += __shfl_xor(sc, 4); sb += __shfl_xor(sb, 1); sb += __shfl_xor(sb, 2); sb += __shfl_xor(sb, 4);
        if (c == 0) { atomicAdd((unsigned long long*)(cs + n0m + n), (unsigned long long)(long long)rintf(sc * pg8::FOLD_SCALE)); atomicAdd((unsigned long long*)(b2 + n0m + n), (unsigned long long)(long long)rintf(sb * pg8::FOLD_SCALE)); } }
    LDS_WAIT(); asm volatile("" ::: "memory");
}
__device__ __forceinline__ void transpose_mat_fold(Frame& F, const float* W, int K, int N, bf16* WT, const float* g, const float* b, long long* cs, long long* b2, int c0 = 0, int nw = 1 << 30, int part = 0, int nparts = 1, bool upmap = false) {
    if (F.bid < c0 || F.bid >= c0 + nw) return;
    LAS float* scr = (LAS float*)(F.lds + RING_OFF + F.wave * 16384);
    const int nwg = nw < F.G ? nw : F.G, gw = (F.bid - c0) * NWAVES + F.wave, NGW = nwg * NWAVES;
    const int nitems = (K / 64) * (N / 32), ilo = (int)((long)nitems * part / nparts), ihi = (int)((long)nitems * (part + 1) / nparts);
    for (int it = ilo + gw; it < ihi; it += NGW) p0_transpose_item_fold(W, K, N, WT, scr, it, F.lane, g, b, cs, b2, upmap);
}
__device__ __forceinline__ void transpose_mat(Frame& F, const float* W, int K, int N, bf16* WT, int c0 = 0, int nw = 1 << 30) {
    if (F.bid < c0 || F.bid >= c0 + nw) return;
    LAS float* scr = (LAS float*)(F.lds + RING_OFF + F.wave * 16384);
    const int nwg = nw < F.G ? nw : F.G, gw = (F.bid - c0) * NWAVES + F.wave, NGW = nwg * NWAVES;
    const int nitems = (K / 64) * (N / 32);
    for (int it = gw; it < nitems; it += NGW) p0_transpose_item(W, K, N, WT, scr, it, F.lane);
}
__device__ __forceinline__ void fold_finalize(Frame& F, int lo, int n) {
    const long long* fs = (const long long*)(F.ws + WS_FOLD); float* fd = (float*)(F.ws + WS_FOLDF);
    for (int i = F.bid * NTHR + F.tid; i < 2 * n; i += F.G * NTHR) { const int j = (i < n) ? lo + i : FO_N + lo + (i - n); const long long v = fs[j]; fd[j] = (float)(int)(v >> 32) + (float)(unsigned)v * pg8::FOLD_INV; }
}
enum { CJ_DOWN0, CJ_NSA, CJ_L1A, CJ_L1B, CJ_DOWN1 };
template <int JOB>
__device__ __forceinline__ void convert_job(Frame& F, const Args& A, int c0, int nw) {
    unsigned char* ws = F.ws; long long* cs = (long long*)(ws + WS_FOLD); long long* b2 = cs + FO_N;
    if (JOB == CJ_DOWN0 || JOB == CJ_DOWN1) { const int l = JOB == CJ_DOWN1; transpose_mat(F, KIN(IN_FFN_DOWN) + (size_t)l * DFF * DM, DFF, DM, (bf16*)(ws + WS_W_DOWN) + (size_t)l * DM * DFF, c0, nw); }
    if (JOB == CJ_NSA) {
        transpose_mat_fold(F, KIN(IN_NSA_W_IN), DM, NSA_IN, (bf16*)(ws + WS_W_NSAIN), KIN(IN_LN_G) + 2 * DM, KIN(IN_LN_B) + 2 * DM, cs + FO_NSA, b2 + FO_NSA, c0, nw);
        transpose_mat(F, KIN(IN_NSA_W_OUT), DM, DM, (bf16*)(ws + WS_W_NSAOUT), c0, nw); }
    if (JOB == CJ_L1A || JOB == CJ_L1B) { const int l = 1;
        if (JOB == CJ_L1A) {
            transpose_mat_fold(F, KIN(IN_XA_WQ) + (size_t)l * DM * XW, DM, XW, (bf16*)(ws + WS_W_XQ) + (size_t)l * XW * DM, KIN(IN_LN_G) + (size_t)(3 * l) * DM, KIN(IN_LN_B) + (size_t)(3 * l) * DM, cs + FO_XQ + l * XW, b2 + FO_XQ + l * XW, c0, nw);
            transpose_mat(F, KIN(IN_XA_WKV) + (size_t)l * DM * 2 * XW, DM, 2 * XW, (bf16*)(ws + WS_W_XKV) + (size_t)l * 2 * XW * DM, c0, nw);
            transpose_mat(F, KIN(IN_XA_WO) + (size_t)l * XW * DM, XW, DM, (bf16*)(ws + WS_W_XO) + (size_t)l * DM * XW, c0, nw); }
        transpose_mat_fold(F, KIN(IN_FFN_UP) + (size_t)l * DM * DFF2, DM, DFF2, (bf16*)(ws + WS_W_UP) + (size_t)l * DFF2 * DM, KIN(IN_LN_G) + (size_t)(3 * l + 1) * DM, KIN(IN_LN_B) + (size_t)(3 * l + 1) * DM,
                           cs + FO_UP + l * DFF2, b2 + FO_UP + l * DFF2, c0, nw, JOB == CJ_L1A ? 0 : 1, 2, true); }
}
__device__ __forceinline__ void cvt_flat(Frame& F, const float* src, bf16* dst, long n8) {
    for (long i = (long)F.bid * NTHR + F.tid; i < n8; i += (long)F.G * NTHR) {
        const f32x4 a = *(const f32x4*)(src + i * 8), b = *(const f32x4*)(src + i * 8 + 4);
        v4u o; o.x = pk2(a.x, a.y); o.y = pk2(a.z, a.w); o.z = pk2(b.x, b.y); o.w = pk2(b.z, b.w);
        *(v4u*)(dst + i * 8) = o; }
}
__device__ __forceinline__ void p0_prologue(Frame& F, const Args& A) {
    unsigned char* ws = F.ws;
    long long* cs = (long long*)(ws + WS_FOLD); long long* b2 = cs + FO_N;
    transpose_mat(F, KIN(IN_AB_W_IN), DM, AB_IN, (bf16*)(ws + WS_W_ABIN));
    transpose_mat(F, KIN(IN_AB_W_OUT), DM, DM, (bf16*)(ws + WS_W_ABOUT));
    { const int l = 0;
        transpose_mat_fold(F, KIN(IN_XA_WQ) + (size_t)l * DM * XW, DM, XW, (bf16*)(ws + WS_W_XQ) + (size_t)l * XW * DM, KIN(IN_LN_G) + (size_t)(3 * l) * DM, KIN(IN_LN_B) + (size_t)(3 * l) * DM, cs + FO_XQ + l * XW, b2 + FO_XQ + l * XW);
        transpose_mat(F, KIN(IN_XA_WKV) + (size_t)l * DM * 2 * XW, DM, 2 * XW, (bf16*)(ws + WS_W_XKV) + (size_t)l * 2 * XW * DM);
        transpose_mat(F, KIN(IN_XA_WO) + (size_t)l * XW * DM, XW, DM, (bf16*)(ws + WS_W_XO) + (size_t)l * DM * XW);
        transpose_mat_fold(F, KIN(IN_FFN_UP) + (size_t)l * DM * DFF2, DM, DFF2, (bf16*)(ws + WS_W_UP) + (size_t)l * DFF2 * DM, KIN(IN_LN_G) + (size_t)(3 * l + 1) * DM, KIN(IN_LN_B) + (size_t)(3 * l + 1) * DM, cs + FO_UP + l * DFF2, b2 + FO_UP + l * DFF2, 0, 1 << 30, 0, 1, true); }
    for (int l = 0; l < 2; ++l) {
        transpose_mat(F, KIN(IN_NSA_CMP_W1) + (size_t)l * 32 * HD * HD, 32 * HD, HD, (bf16*)(ws + WS_W_C1) + (size_t)l * HD * 32 * HD);
        transpose_mat(F, KIN(IN_NSA_CMP_W2) + (size_t)l * HD * HD, HD, HD, (bf16*)(ws + WS_W_C2) + (size_t)l * HD * HD);
    }
    cvt_flat(F, KIN(IN_X), (bf16*)(ws + WS_HB), (long)MTOK * DM / 8);
    cvt_flat(F, KIN(IN_MEM), (bf16*)(ws + WS_MEMB), (long)BATCH * NMEM * DM / 8);
    { v4u z = {0u, 0u, 0u, 0u}; v4u* p = (v4u*)((bf16*)(ws + WS_W_NSAIN) + (size_t)NSA_IN * DM); const long n = (long)(NSA_INP - NSA_IN) * DM / 8;
      for (long i = (long)F.bid * NTHR + F.tid; i < n; i += (long)F.G * NTHR) p[i] = z; }
    { float* tab = (float*)(ws + WS_ROPE);
      for (int i = F.bid * NTHR + F.tid; i < SEQ * 64; i += F.G * NTHR) { const int t = i >> 6, d = i & 63;
          float sn, cs; sincosf((float)t * powf(10000.0f, -(float)d * (1.0f / 64.0f)), &sn, &cs); tab[(size_t)t * 128 + d] = cs; tab[(size_t)t * 128 + 64 + d] = sn; } }
    { const float* lbp = KIN(IN_HGRN_LB); float* lbo = (float*)(ws + WS_LB);
      for (int i = F.bid * NTHR + F.tid; i < A_W; i += F.G * NTHR) { const float a = lbp[i], b = lbp[A_W + i], m = fmaxf(a, b), ea = __expf(a - m), eb = __expf(b - m); lbo[i] = ea / (ea + eb); } }
}

__device__ __forceinline__ void ln_phase(Frame& F, const bf16* Y, const float* g, const float* b, float* h32) {
    const int gw = F.bid * NWAVES + F.wave, NGW = F.G * NWAVES;
    for (int m = gw; m < MTOK; m += NGW) {
        const v4u* yr = (const v4u*)(Y + (size_t)m * DM) + F.lane;
        float v[8][8]; float s = 0.f;
#pragma unroll
        for (int j = 0; j < 8; ++j) { const v4u x = yr[64 * j];
            v[j][0] = bflo(x.x); v[j][1] = bfhi(x.x); v[j][2] = bflo(x.y); v[j][3] = bfhi(x.y); v[j][4] = bflo(x.z); v[j][5] = bfhi(x.z); v[j][6] = bflo(x.w); v[j][7] = bfhi(x.w);
#pragma unroll
            for (int q = 0; q < 8; ++q) s += v[j][q]; }
        const float mean = wave_sum(s) * (1.f / DM); float s2 = 0.f;
#pragma unroll
        for (int j = 0; j < 8; ++j)
#pragma unroll
            for (int q = 0; q < 8; ++q) { v[j][q] -= mean; s2 += v[j][q] * v[j][q]; }
        const float rstd = 1.f / sqrtf(wave_sum(s2) * (1.f / DM) + LN_EPS);
#pragma unroll
        for (int j = 0; j < 8; ++j) { const int c0 = 8 * F.lane + 512 * j;
            const f32x4 g0 = *(const f32x4*)(g + c0), g1 = *(const f32x4*)(g + c0 + 4), b0 = *(const f32x4*)(b + c0), b1 = *(const f32x4*)(b + c0 + 4);
            f32x4 r0, r1;
            r0.x = v[j][0] * rstd * g0.x + b0.x; r0.y = v[j][1] * rstd * g0.y + b0.y; r0.z = v[j][2] * rstd * g0.z + b0.z; r0.w = v[j][3] * rstd * g0.w + b0.w;
            r1.x = v[j][4] * rstd * g1.x + b1.x; r1.y = v[j][5] * rstd * g1.y + b1.y; r1.z = v[j][6] * rstd * g1.z + b1.z; r1.w = v[j][7] * rstd * g1.w + b1.w;
            *(f32x4*)(h32 + (size_t)m * DM + c0) = r0; *(f32x4*)(h32 + (size_t)m * DM + c0 + 4) = r1; }
    }
}

__device__ __forceinline__ void cg_unpack(const v4u x, float* o) { o[0] = bflo(x.x); o[1] = bfhi(x.x); o[2] = bflo(x.y); o[3] = bfhi(x.y); o[4] = bflo(x.z); o[5] = bfhi(x.z); o[6] = bflo(x.w); o[7] = bfhi(x.w); }
__device__ __forceinline__ void convglu_fixup_phase(Frame& F, const bf16* SIDE, const float* cw, bf16* Gm) {
    constexpr int NCG = DFF / 8, NRUN = MTOK / 128;
    for (int it = F.bid * NTHR + F.tid; it < NCG * NRUN; it += F.G * NTHR) {
        const int cg = it % NCG, run = it / NCG, c0 = cg * 8, t0 = run * 128;
        float w0[8], w1[8], w2[8], am2[8], am1[8], a0[8], a1[8], u0[8], u1[8];
#pragma unroll
        for (int j = 0; j < 8; ++j) { w0[j] = cw[c0 + j]; w1[j] = cw[DFF + c0 + j]; w2[j] = cw[2 * DFF + c0 + j]; }
        const bf16* sp = SIDE + (size_t)run * 6 * DFF + c0;
        if ((t0 & (SEQ - 1)) == 0) {
#pragma unroll
            for (int j = 0; j < 8; ++j) { am2[j] = 0.f; am1[j] = 0.f; }
        } else { cg_unpack(*(const v4u*)sp, am2); cg_unpack(*(const v4u*)(sp + DFF), am1); }
        cg_unpack(*(const v4u*)(sp + 2 * DFF), a0); cg_unpack(*(const v4u*)(sp + 3 * DFF), a1); cg_unpack(*(const v4u*)(sp + 4 * DFF), u0); cg_unpack(*(const v4u*)(sp + 5 * DFF), u1);
        unsigned o0[4], o1[4];
#pragma unroll
        for (int j = 0; j < 8; j += 2) {
            const pg8::f32x2 g0 = pg8::gelu_pk((pg8::f32x2){w2[j] * a0[j] + w1[j] * am1[j] + w0[j] * am2[j], w2[j + 1] * a0[j + 1] + w1[j + 1] * am1[j + 1] + w0[j + 1] * am2[j + 1]});
            const pg8::f32x2 g1 = pg8::gelu_pk((pg8::f32x2){w2[j] * a1[j] + w1[j] * a0[j] + w0[j] * am1[j], w2[j + 1] * a1[j + 1] + w1[j + 1] * a0[j + 1] + w0[j + 1] * am1[j + 1]});
            o0[j >> 1] = pk2(g0.x * u0[j], g0.y * u0[j + 1]); o1[j >> 1] = pk2(g1.x * u1[j], g1.y * u1[j + 1]); }
        *(v4u*)(Gm + (size_t)t0 * DFF + c0) = (v4u){o0[0], o0[1], o0[2], o0[3]}; *(v4u*)(Gm + (size_t)(t0 + 1) * DFF + c0) = (v4u){o1[0], o1[1], o1[2], o1[3]};
    }
}

__device__ __forceinline__ void xattn_phase(Frame& F, const bf16* XQ, const bf16* XKV, bf16* XO) {
    const int tid = F.tid, wid = F.wave, lane = F.lane, r32 = lane & 31, hi = lane >> 5;
    LAS char* lds = (LAS char*)F.lds;
    LAS float* wsc = (LAS float*)(lds + ATT_WS_OFF + wid * 256);
    const int vb0 = (int)(uintptr_t)(lds + ATT_V_OFF) + v_rd_base(lane);
    KVDma dm; kv_dma_init(dm, 2 * XW, 2 * XW, wid, lane);
    constexpr int NU = (MTOK / 256) * XH;
    for (int u = F.bid; u < NU; u += F.G) {
        const int head = u % XH, rbk = u / XH, row0 = rbk * 256, b = row0 / SEQ;
        const bf16* Kh = XKV + (size_t)b * NMEM * 2 * XW + head * HD; const bf16* Vh = Kh + XW;
        bf16x8 qr[8]; load_q(qr, XQ + (size_t)(row0 + wid * 32 + r32) * XW + head * HD + hi * 8);
        float m_reg = -1e30f, l_reg = 0.f; f32x16 o[4] = {};
        __syncthreads();
        kv_dma(dm, Kh, Vh, lds, 0, wid);
        for (int j = 0; j < NMEM / KVBLK; ++j) {
            const int buf = (j & 1) * ATT_BUF;
            VM_WAIT(); __syncthreads();
            if (j + 1 < NMEM / KVBLK) kv_dma(dm, Kh + (size_t)(j + 1) * KVBLK * 2 * XW, Vh + (size_t)(j + 1) * KVBLK * 2 * XW, lds, ATT_BUF - buf, wid);
            f32x16 p0, p1; qkt(p0, p1, lds + buf + ATT_K_OFF, qr, r32, hi);
            float alpha; softmax_tile(p0, p1, m_reg, l_reg, alpha);
            rescale_o(o, alpha, wsc, r32, hi);
            bf16x8 pa0, pa1, pa2, pa3; pack_p(p0, p1, pa0, pa1, pa2, pa3);
            pv_d0(o, vb0 + buf, pa0, pa1, pa2, pa3);
        }
        if (hi == 0) wsc[32 + r32] = l_reg; LDS_WAIT();
        bf16* Ow = XO + (size_t)(row0 + wid * 32) * XW + head * HD;
#pragma unroll
        for (int r = 0; r < 16; ++r) { const int orow = crow(r, hi); const float rl = __builtin_amdgcn_rcpf(wsc[32 + orow]);
#pragma unroll
            for (int d0 = 0; d0 < 4; ++d0) Ow[(size_t)orow * XW + d0 * 32 + r32] = (bf16)f2bf(o[d0][r] * rl); }
        LDS_WAIT();
    }
}

template <int K>
__device__ __forceinline__ f32x4 mma_tile(const LAS char* A, int lda, const LAS char* B, int ldb, int fr, int fq) {
    f32x4 acc = {0.f, 0.f, 0.f, 0.f};
#pragma unroll
    for (int k0 = 0; k0 < K; k0 += 32) {
        const bf16x8 a = *(const LAS bf16x8*)(A + fr * lda + (k0 + 8 * fq) * 2);
        const bf16x8 b = *(const LAS bf16x8*)(B + fr * ldb + (k0 + 8 * fq) * 2);
        acc = __builtin_amdgcn_mfma_f32_16x16x32_bf16(a, b, acc, 0, 0, 0);
    }
    return acc;
}
constexpr int HG_CH = 64, HG_NC = SEQ / HG_CH, HG_ITEMS = BATCH * A_HEADS * HG_NC;
constexpr int HG_QT = 0, HG_KT = 17408, HG_KH = 34816, HG_VT = 53248, HG_PT = 71680, HG_SEG = 80896;
constexpr int HG_SP = 17408, HG_OT = 52224;
constexpr int HG_WT = 80896, HG_KHS = 86016, HG_VS = 103424;
__device__ __forceinline__ void hgrn_phase_a(Frame& F, const bf16* P0, const float* lbv, bf16* QTg, bf16* OINTRA, bf16* DS, float* DEC) {
    LAS char* lds = (LAS char*)F.lds;
    const int tid = F.tid, wid = F.wave, lane = F.lane, fr = lane & 15, fq = lane >> 4;
    const int dg = tid & 15, sq = tid >> 4;
    const int d = tid & 127, sq16 = tid >> 7;
    for (int it = F.bid; it < HG_ITEMS; it += F.G) {
        const int c = it % HG_NC, bh = it / HG_NC, h = bh % A_HEADS, b = bh / A_HEADS;
        const size_t row0 = (size_t)b * SEQ + (size_t)c * HG_CH;
        float lb[8], q[2][8], kk[2][8], cum[2][8]; v4u vraw[2];
        { const f32x4 l0 = *(const f32x4*)(lbv + h * HD + 8 * dg), l1 = *(const f32x4*)(lbv + h * HD + 8 * dg + 4);
          lb[0] = l0.x; lb[1] = l0.y; lb[2] = l0.z; lb[3] = l0.w; lb[4] = l1.x; lb[5] = l1.y; lb[6] = l1.z; lb[7] = l1.w; }
#pragma unroll
        for (int rr = 0; rr < 2; ++rr) { const bf16* rowp = P0 + (row0 + 2 * sq + rr) * AB_IN + h * HD + 8 * dg;
            const v4u zq = *(const v4u*)(rowp + A_W), qq = *(const v4u*)rowp; vraw[rr] = *(const v4u*)(rowp + 2 * A_W);
            const unsigned zw[4] = {zq.x, zq.y, zq.z, zq.w}, qw[4] = {qq.x, qq.y, qq.z, qq.w};
#pragma unroll
            for (int j = 0; j < 8; ++j) { const float z = (j & 1) ? bfhi(zw[j >> 1]) : bflo(zw[j >> 1]); q[rr][j] = (j & 1) ? bfhi(qw[j >> 1]) : bflo(qw[j >> 1]);
                const float sg = sigmoidf_(z), omlb = 1.f - lb[j]; kk[rr][j] = omlb * (1.f - sg);
                const float lf = __logf(lb[j] + omlb * sg); cum[rr][j] = rr ? cum[0][j] + lf : lf; } }
        float pre[8];
#pragma unroll
        for (int j = 0; j < 8; ++j) { const float seg = cum[1][j]; float x = seg; const float t1 = __shfl_up(x, 16); if (lane >= 16) x += t1; const float t2 = __shfl_up(x, 32); if (lane >= 32) x += t2;
            pre[j] = x - seg; if (lane >= 48) ((LAS float*)(lds + HG_WT))[wid * 128 + 8 * dg + j] = x; }
        LDS_WAIT(); __syncthreads();
        float total[8];
#pragma unroll
        for (int j = 0; j < 8; ++j) total[j] = 0.f;
#pragma unroll
        for (int w = 0; w < NWAVES; ++w) { const f32x4 a0 = *(const LAS f32x4*)(lds + HG_WT + (w * 128 + 8 * dg) * 4), a1 = *(const LAS f32x4*)(lds + HG_WT + (w * 128 + 8 * dg + 4) * 4);
            const float av[8] = {a0.x, a0.y, a0.z, a0.w, a1.x, a1.y, a1.z, a1.w};
#pragma unroll
            for (int j = 0; j < 8; ++j) { total[j] += av[j]; if (w < wid) pre[j] += av[j]; } }
#pragma unroll
        for (int rr = 0; rr < 2; ++rr) { const int s = 2 * sq + rr; unsigned qt[4], kt[4], kh[4];
#pragma unroll
            for (int j = 0; j < 8; j += 2) { const float b0 = pre[j] + cum[rr][j], b1 = pre[j + 1] + cum[rr][j + 1];
                qt[j >> 1] = pk2(q[rr][j] * __expf(b0), q[rr][j + 1] * __expf(b1));
                kt[j >> 1] = pk2(kk[rr][j] * __expf(-b0), kk[rr][j + 1] * __expf(-b1));
                kh[j >> 1] = pk2(kk[rr][j] * __expf(total[j] - b0), kk[rr][j + 1] * __expf(total[j + 1] - b1)); }
            const v4u qv = {qt[0], qt[1], qt[2], qt[3]};
            *(LAS v4u*)(lds + HG_QT + s * 272 + dg * 16) = qv; *(v4u*)(QTg + (row0 + s) * A_W + h * HD + 8 * dg) = qv;
            *(LAS v4u*)(lds + HG_KT + s * 272 + dg * 16) = (v4u){kt[0], kt[1], kt[2], kt[3]};
            *(LAS v4u*)(lds + HG_KHS + s * 272 + dg * 16) = (v4u){kh[0], kh[1], kh[2], kh[3]};
            *(LAS v4u*)(lds + HG_VS + s * 272 + dg * 16) = vraw[rr]; }
        if (sq == 31) { f32x4 e0, e1; e0.x = __expf(total[0]); e0.y = __expf(total[1]); e0.z = __expf(total[2]); e0.w = __expf(total[3]); e1.x = __expf(total[4]); e1.y = __expf(total[5]); e1.z = __expf(total[6]); e1.w = __expf(total[7]);
            *(f32x4*)(DEC + (size_t)it * HD + 8 * dg) = e0; *(f32x4*)(DEC + (size_t)it * HD + 8 * dg + 4) = e1; }
        LDS_WAIT(); __syncthreads();
        { unsigned kh[8], vt[8];
#pragma unroll
          for (int j = 0; j < 16; j += 2) { const int s = 16 * sq16 + j;
              kh[j >> 1] = (unsigned)*(const LAS unsigned short*)(lds + HG_KHS + s * 272 + d * 2) | ((unsigned)*(const LAS unsigned short*)(lds + HG_KHS + (s + 1) * 272 + d * 2) << 16);
              vt[j >> 1] = (unsigned)*(const LAS unsigned short*)(lds + HG_VS + s * 272 + d * 2) | ((unsigned)*(const LAS unsigned short*)(lds + HG_VS + (s + 1) * 272 + d * 2) << 16); }
          LAS v4u* pk = (LAS v4u*)(lds + HG_KH + d * 144 + sq16 * 32); pk[0] = (v4u){kh[0], kh[1], kh[2], kh[3]}; pk[1] = (v4u){kh[4], kh[5], kh[6], kh[7]};
          LAS v4u* pv = (LAS v4u*)(lds + HG_VT + d * 144 + sq16 * 32); pv[0] = (v4u){vt[0], vt[1], vt[2], vt[3]}; pv[1] = (v4u){vt[4], vt[5], vt[6], vt[7]}; }
        LDS_WAIT(); __syncthreads();
#pragma unroll
        for (int k = 0; k < 2; ++k) { const int tau = 2 * wid + k, ti = tau >> 2, si = tau & 3;
            f32x4 acc = {0.f, 0.f, 0.f, 0.f};
            if (si <= ti) acc = mma_tile<128>(lds + HG_QT + ti * 16 * 272, 272, lds + HG_KT + si * 16 * 272, 272, fr, fq);
#pragma unroll
            for (int i = 0; i < 4; ++i) { const int t = 16 * ti + 4 * fq + i, s = 16 * si + fr; const float v = (s <= t) ? acc[i] : 0.f;
                *(LAS unsigned short*)(lds + HG_PT + t * 144 + s * 2) = (unsigned short)f2bf(v); } }
        LDS_WAIT(); __syncthreads();
#pragma unroll
        for (int k = 0; k < 4; ++k) { const int tau = wid + 8 * k, ti = tau >> 3, vi = tau & 7;
            const f32x4 acc = mma_tile<64>(lds + HG_VT + vi * 16 * 144, 144, lds + HG_PT + ti * 16 * 144, 144, fr, fq);
            v2u w; w.x = pk2(acc[0], acc[1]); w.y = pk2(acc[2], acc[3]);
            *(v2u*)(OINTRA + (row0 + 16 * ti + fr) * A_W + h * HD + 16 * vi + 4 * fq) = w; }
#pragma unroll
        for (int k = 0; k < 8; ++k) { const int tau = wid + 8 * k, vi = tau >> 3, ki = tau & 7;
            const f32x4 acc = mma_tile<64>(lds + HG_KH + ki * 16 * 144, 144, lds + HG_VT + vi * 16 * 144, 144, fr, fq);
            v2u w; w.x = pk2(acc[0], acc[1]); w.y = pk2(acc[2], acc[3]);
            *(v2u*)(DS + ((size_t)it * HD + 16 * vi + fr) * HD + 16 * ki + 4 * fq) = w; }
        LDS_WAIT(); __syncthreads();
    }
}
__device__ __forceinline__ void hgrn_phase_b(Frame& F, const bf16* DS, const float* DEC, bf16* SPREV) {
    const int tid = F.tid, dvl = tid >> 5, dk4 = (tid & 31) * 4;
    for (int item = F.bid; item < BATCH * A_HEADS * 8; item += F.G) {
        const int sl = item & 7, bh = item >> 3, dv = sl * 16 + dvl;
        f32x4 S = {0.f, 0.f, 0.f, 0.f};
        for (int c0 = 0; c0 < HG_NC; c0 += 8) {
            f32x4 ds[8], dc[8];
#pragma unroll
            for (int k = 0; k < 8; ++k) { const size_t it = (size_t)bh * HG_NC + c0 + k; const v2u x = *(const v2u*)(DS + (it * HD + dv) * HD + dk4);
                ds[k] = (f32x4){bflo(x.x), bfhi(x.x), bflo(x.y), bfhi(x.y)}; dc[k] = *(const f32x4*)(DEC + it * HD + dk4); }
#pragma unroll
            for (int k = 0; k < 8; ++k) { const size_t it = (size_t)bh * HG_NC + c0 + k;
                v2u w; w.x = pk2(S.x, S.y); w.y = pk2(S.z, S.w); *(v2u*)(SPREV + (it * HD + dv) * HD + dk4) = w;
                S = S * dc[k] + ds[k]; }
        }
    }
}
__device__ __forceinline__ void hgrn_phase_c(Frame& F, const bf16* P0, const bf16* QTg, const bf16* OINTRA, const bf16* SPREV, const float* nw, bf16* Ob) {
    LAS char* lds = (LAS char*)F.lds;
    const int tid = F.tid, wid = F.wave, lane = F.lane, fr = lane & 15, fq = lane >> 4;
    for (int it = F.bid; it < HG_ITEMS; it += F.G) {
        const int c = it % HG_NC, bh = it / HG_NC, h = bh % A_HEADS, b = bh / A_HEADS;
        const size_t row0 = (size_t)b * SEQ + (size_t)c * HG_CH;
        { const int s = tid >> 3, ch = (tid & 7) * 16; const bf16* src = QTg + (row0 + s) * A_W + h * HD + ch;
          const v4u x0 = *(const v4u*)src, x1 = *(const v4u*)(src + 8); LAS v4u* dst = (LAS v4u*)(lds + HG_QT + s * 272 + ch * 2); dst[0] = x0; dst[1] = x1; }
        { const int dv = tid >> 2, ch = (tid & 3) * 32; const bf16* src = SPREV + ((size_t)it * HD + dv) * HD + ch;
          const v4u x0 = *(const v4u*)src, x1 = *(const v4u*)(src + 8), x2 = *(const v4u*)(src + 16), x3 = *(const v4u*)(src + 24);
          LAS v4u* dst = (LAS v4u*)(lds + HG_SP + dv * 272 + ch * 2); dst[0] = x0; dst[1] = x1; dst[2] = x2; dst[3] = x3; }
        LDS_WAIT(); __syncthreads();
#pragma unroll
        for (int k = 0; k < 4; ++k) { const int tau = wid + 8 * k, ti = tau >> 3, vi = tau & 7;
            const f32x4 acc = mma_tile<128>(lds + HG_SP + vi * 16 * 272, 272, lds + HG_QT + ti * 16 * 272, 272, fr, fq);
            const int t = 16 * ti + fr, dv = 16 * vi + 4 * fq; const v2u oi = *(const v2u*)(OINTRA + (row0 + t) * A_W + h * HD + dv);
            *(LAS f32x4*)(lds + HG_OT + (t * 132 + dv) * 4) = (f32x4){acc[0] + bflo(oi.x), acc[1] + bfhi(oi.x), acc[2] + bflo(oi.y), acc[3] + bfhi(oi.y)}; }
        LDS_WAIT(); __syncthreads();
        { const int t = tid >> 3, dv0 = (tid & 7) * 16;
          float v[16]; float ss = 0.f;
#pragma unroll
          for (int q4 = 0; q4 < 4; ++q4) { const f32x4 x = *(const LAS f32x4*)(lds + HG_OT + (t * 132 + dv0 + 4 * q4) * 4); v[4 * q4] = x.x; v[4 * q4 + 1] = x.y; v[4 * q4 + 2] = x.z; v[4 * q4 + 3] = x.w;
              ss += (x.x * x.x + x.y * x.y) + (x.z * x.z + x.w * x.w); }
          ss += __shfl_xor(ss, 1); ss += __shfl_xor(ss, 2); ss += __shfl_xor(ss, 4);
          const float r = 1.f / sqrtf(ss * (1.f / HD) + RMS_EPS);
          const bf16* gp = P0 + (row0 + t) * AB_IN + 3 * A_W + h * HD + dv0; const v4u g0 = *(const v4u*)gp, g1 = *(const v4u*)(gp + 8);
          const unsigned gw[8] = {g0.x, g0.y, g0.z, g0.w, g1.x, g1.y, g1.z, g1.w}; unsigned o[8];
#pragma unroll
          for (int j = 0; j < 8; ++j) { const float ga = bflo(gw[j]), gb = bfhi(gw[j]);
              o[j] = pk2(v[2 * j] * r * nw[dv0 + 2 * j] * ga * sigmoidf_(ga), v[2 * j + 1] * r * nw[dv0 + 2 * j + 1] * gb * sigmoidf_(gb)); }
          bf16* op = Ob + (row0 + t) * DM + h * HD + dv0; *(v4u*)op = (v4u){o[0], o[1], o[2], o[3]}; *(v4u*)(op + 8) = (v4u){o[4], o[5], o[6], o[7]}; }
        LDS_WAIT(); __syncthreads();
    }
}

constexpr float SB_CUT = -160.f;
__device__ __forceinline__ void sb_phase(Frame& F, const bf16* P0, bf16* Ob) {
    const int tid = F.tid, wid = F.wave, lane = F.lane, r32 = lane & 31, hi = lane >> 5;
    LAS char* lds = (LAS char*)F.lds;
    const int vb0 = (int)(uintptr_t)(lds + ATT_V_OFF) + v_rd_base(lane);
    KVDma dm; kv_dma_init(dm, AB_IN, AB_IN, wid, lane);
    constexpr int NQB = SEQ / 256, NU = BATCH * B_HEADS * NQB;
    for (int rd = 0; ; ++rd) {
        const int idx = (rd & 1) ? rd * F.G + (F.G - 1 - F.bid) : rd * F.G + F.bid;
        if (rd * F.G >= NU) break;
        if (idx >= NU) continue;
        const int qb = NQB - 1 - idx / (BATCH * B_HEADS), bh = idx % (BATCH * B_HEADS), head = bh % B_HEADS, b = bh / B_HEADS;
        const size_t rowb = (size_t)b * SEQ; const int q0 = qb * 256;
        const bf16* Kh = P0 + rowb * AB_IN + 4 * A_W + B_W + head * HD; const bf16* Vh = Kh + B_W;
        const int tw0 = q0 + wid * 32, t = tw0 + r32;
        bf16x8 qr[8]; load_q(qr, P0 + (rowb + t) * AB_IN + 4 * A_W + head * HD + hi * 8);
        float R = 0.f; f32x16 o[4] = {};
        const int jtop = (q0 + 254) >> 6;
        LAS unsigned* dflag = (LAS unsigned*)(lds + ATT_X_OFF);
        if (lane == 0) { dflag[wid] = 0u; dflag[8 + wid] = 0u; }
        LDS_WAIT(); __syncthreads();
        kv_dma(dm, Kh + (size_t)jtop * KVBLK * AB_IN, Vh + (size_t)jtop * KVBLK * AB_IN, lds, 0, wid);
        int buf = 0;
        for (int j = jtop; j >= 0; --j, buf = ATT_BUF - buf) {
            VM_WAIT(); __syncthreads();
            { unsigned alld = 1u;
#pragma unroll
              for (int w = 0; w < NWAVES; ++w) alld &= dflag[((j + 1) & 1) * 8 + w];
              if (__builtin_amdgcn_readfirstlane(alld)) break; }
            if (j > 0) kv_dma(dm, Kh + (size_t)(j - 1) * KVBLK * AB_IN, Vh + (size_t)(j - 1) * KVBLK * AB_IN, lds, ATT_BUF - buf, wid);
            const int k0 = j * KVBLK;
            if (k0 < tw0 + 31) {
                f32x16 p0, p1; qkt(p0, p1, lds + buf + ATT_K_OFF, qr, r32, hi);
                const bool need_mask = (k0 + 63 >= tw0);
                float L0[16], L1[16];
#pragma unroll
                for (int r = 0; r < 16; ++r) {
                    const float z0 = p0[r] * ATT_C, z1 = p1[r] * ATT_C;
                    float l0 = -(fmaxf(z0, 0.f) + __builtin_amdgcn_logf(1.f + __builtin_amdgcn_exp2f(-fabsf(z0))));
                    float l1 = -(fmaxf(z1, 0.f) + __builtin_amdgcn_logf(1.f + __builtin_amdgcn_exp2f(-fabsf(z1))));
                    if (need_mask) { if (k0 + crow(r, hi) >= t) l0 = 0.f; if (k0 + 32 + crow(r, hi) >= t) l1 = 0.f; }
                    L0[r] = l0; L1[r] = l1; p0[r] = z0 + l0; p1[r] = z1 + l1;
                }
                SBAR();
                float Sg[16];
#pragma unroll
                for (int gi = 0; gi < 4; ++gi) {
                    const float a = (L0[4 * gi] + L0[4 * gi + 1]) + (L0[4 * gi + 2] + L0[4 * gi + 3]), c = (L1[4 * gi] + L1[4 * gi + 1]) + (L1[4 * gi + 2] + L1[4 * gi + 3]);
                    auto ra = __builtin_amdgcn_permlane32_swap(__float_as_uint(a), __float_as_uint(a), false, false);
                    auto rc = __builtin_amdgcn_permlane32_swap(__float_as_uint(c), __float_as_uint(c), false, false);
                    Sg[2 * gi] = __uint_as_float(ra[0]); Sg[2 * gi + 1] = __uint_as_float(ra[1]); Sg[8 + 2 * gi] = __uint_as_float(rc[0]); Sg[8 + 2 * gi + 1] = __uint_as_float(rc[1]);
                }
                float run = R;
#pragma unroll
                for (int s = 15; s >= 0; --s) { const float tt = run; run += Sg[s]; Sg[s] = tt; }
                const float Rn = run;
                SBAR();
#pragma unroll
                for (int gi = 0; gi < 4; ++gi) {
                    float base0 = hi ? Sg[2 * gi + 1] : Sg[2 * gi], base1 = hi ? Sg[8 + 2 * gi + 1] : Sg[8 + 2 * gi];
                    float r3 = base0, r2 = r3 + L0[4 * gi + 3], r1 = r2 + L0[4 * gi + 2], r0 = r1 + L0[4 * gi + 1];
                    p0[4 * gi + 3] = __builtin_amdgcn_exp2f(p0[4 * gi + 3] + r3); p0[4 * gi + 2] = __builtin_amdgcn_exp2f(p0[4 * gi + 2] + r2);
                    p0[4 * gi + 1] = __builtin_amdgcn_exp2f(p0[4 * gi + 1] + r1); p0[4 * gi + 0] = __builtin_amdgcn_exp2f(p0[4 * gi + 0] + r0);
                    r3 = base1; r2 = r3 + L1[4 * gi + 3]; r1 = r2 + L1[4 * gi + 2]; r0 = r1 + L1[4 * gi + 1];
                    p1[4 * gi + 3] = __builtin_amdgcn_exp2f(p1[4 * gi + 3] + r3); p1[4 * gi + 2] = __builtin_amdgcn_exp2f(p1[4 * gi + 2] + r2);
                    p1[4 * gi + 1] = __builtin_amdgcn_exp2f(p1[4 * gi + 1] + r1); p1[4 * gi + 0] = __builtin_amdgcn_exp2f(p1[4 * gi + 0] + r0);
                }
                R = Rn;
                { const unsigned dn = __all(R < SB_CUT) ? 1u : 0u; if (lane == 0) dflag[(j & 1) * 8 + wid] = dn; }
                if (need_mask) {
#pragma unroll
                    for (int r = 0; r < 16; ++r) { if (k0 + crow(r, hi) >= t) p0[r] = 0.f; if (k0 + 32 + crow(r, hi) >= t) p1[r] = 0.f; }
                }
                bf16x8 pa0, pa1, pa2, pa3; pack_p(p0, p1, pa0, pa1, pa2, pa3);
                pv_d0(o, vb0 + buf, pa0, pa1, pa2, pa3);
            }
        }
        bf16* Ow = Ob + (rowb + tw0) * DM + A_W + head * HD;
#pragma unroll
        for (int r = 0; r < 16; ++r) { const int orow = crow(r, hi);
#pragma unroll
            for (int d0 = 0; d0 < 4; ++d0) Ow[(size_t)orow * DM + d0 * 32 + r32] = (bf16)f2bf(o[d0][r]); }
    }
}

constexpr int P1_KC = 4096, P1_VC = 4608, P1_KS = 5120, P1_VS = 5632, P1_KW = 6144, P1_VW = 6656, P1_GL = 7168;
__device__ __forceinline__ void nsa_rope_phase(Frame& F, const bf16* P1, const float* TAB, bf16* QROT, bf16* KSROT, bf16* KWROT, bf16* OVL) {
    const int gw = F.bid * NWAVES + F.wave, NGW = F.G * NWAVES, lane = F.lane, hsub = lane >> 3, d0 = (lane & 7) * 8;
    for (int m = gw; m < MTOK; m += NGW) {
        const int t = m & (SEQ - 1);
        const f32x4 c0 = *(const f32x4*)(TAB + (size_t)t * 128 + d0), c1 = *(const f32x4*)(TAB + (size_t)t * 128 + d0 + 4);
        const f32x4 s0 = *(const f32x4*)(TAB + (size_t)t * 128 + 64 + d0), s1 = *(const f32x4*)(TAB + (size_t)t * 128 + 64 + d0 + 4);
        const float cs[8] = {c0.x, c0.y, c0.z, c0.w, c1.x, c1.y, c1.z, c1.w}, sn[8] = {s0.x, s0.y, s0.z, s0.w, s1.x, s1.y, s1.z, s1.w};
        const bf16* row = P1 + (size_t)m * NSA_INP;
#pragma unroll
        for (int hb = 0; hb < 5; ++hb) {
            const int hh = hb * 8 + hsub;
            const bf16* src; bf16* dst;
            if (hh < 32) { src = row + hh * HD; dst = QROT + (size_t)m * DM + hh * HD; }
            else if (hh < 36) { src = row + P1_KS + (hh - 32) * HD; dst = KSROT + (size_t)m * KVW + (hh - 32) * HD; }
            else { src = row + P1_KW + (hh - 36) * HD; dst = KWROT + (size_t)m * KVW + (hh - 36) * HD; }
            const v4u a = *(const v4u*)(src + d0), bq = *(const v4u*)(src + 64 + d0);
            const unsigned aw[4] = {a.x, a.y, a.z, a.w}, bw[4] = {bq.x, bq.y, bq.z, bq.w}; unsigned o1[4], o2[4];
#pragma unroll
            for (int q = 0; q < 4; ++q) { const float x1l = bflo(aw[q]), x1h = bfhi(aw[q]), x2l = bflo(bw[q]), x2h = bfhi(bw[q]);
                o1[q] = pk2(x1l * cs[2 * q] - x2l * sn[2 * q], x1h * cs[2 * q + 1] - x2h * sn[2 * q + 1]);
                o2[q] = pk2(x2l * cs[2 * q] + x1l * sn[2 * q], x2h * cs[2 * q + 1] + x1h * sn[2 * q + 1]); }
            *(v4u*)(dst + d0) = (v4u){o1[0], o1[1], o1[2], o1[3]}; *(v4u*)(dst + 64 + d0) = (v4u){o2[0], o2[1], o2[2], o2[3]};
        }
    }
    for (int i = F.bid * NTHR + F.tid; i < NCMPP * NSLC; i += F.G * NTHR) { const int n = i / NSLC, j = i % NSLC;
        OVL[i] = (n < NCMP && n >= 4 * j - 1 && n <= 4 * j + 3) ? (bf16)0x3f80u : (bf16)0u; }
}
constexpr int CM_A = 0, CM_B = 17408, CM_H = 17408 + 34816;
__device__ __forceinline__ void nsa_compress_phase(Frame& F, const bf16* P1, const float* pos, const bf16* W1t, const bf16* W2t, bf16* KCMP, bf16* VCMP) {
    LAS char* lds = (LAS char*)F.lds;
    const int tid = F.tid, wid = F.wave, lane = F.lane, fr = lane & 15, fq = lane >> 4;
    for (int item = F.bid; item < 128; item += F.G) {
        const int nt = item & 7, g = (item >> 3) & 3, b = (item >> 5) & 1, which = item >> 6;
        const bf16* w1 = W1t + (size_t)which * HD * 32 * HD; const bf16* w2 = W2t + (size_t)which * HD * HD;
        const float* posw = pos + (size_t)which * 32 * HD;
        f32x4 acc[4];
#pragma unroll
        for (int k = 0; k < 4; ++k) acc[k] = (f32x4){0.f, 0.f, 0.f, 0.f};
        for (int l = 0; l < 32; ++l) {
            { const int r = tid >> 3, ch = (tid & 7) * 16, n = nt * 64 + r; unsigned w[8];
              if (n < NCMP) { const bf16* src = P1 + ((size_t)b * SEQ + 16 * n + l) * NSA_INP + P1_KC + which * KVW + g * HD + ch;
                  const v4u x0 = *(const v4u*)src, x1 = *(const v4u*)(src + 8); const unsigned xs[8] = {x0.x, x0.y, x0.z, x0.w, x1.x, x1.y, x1.z, x1.w};
#pragma unroll
                  for (int q = 0; q < 8; ++q) w[q] = pk2(bflo(xs[q]) + posw[l * HD + ch + 2 * q], bfhi(xs[q]) + posw[l * HD + ch + 2 * q + 1]);
              } else {
#pragma unroll
                  for (int q = 0; q < 8; ++q) w[q] = 0u; }
              LAS v4u* dst = (LAS v4u*)(lds + CM_A + r * 272 + ch * 2); dst[0] = (v4u){w[0], w[1], w[2], w[3]}; dst[1] = (v4u){w[4], w[5], w[6], w[7]}; }
            { const int e = tid >> 2, ch = (tid & 3) * 32; const bf16* src = w1 + (size_t)e * 32 * HD + l * HD + ch;
              const v4u x0 = *(const v4u*)src, x1 = *(const v4u*)(src + 8), x2 = *(const v4u*)(src + 16), x3 = *(const v4u*)(src + 24);
              LAS v4u* dst = (LAS v4u*)(lds + CM_B + e * 272 + ch * 2); dst[0] = x0; dst[1] = x1; dst[2] = x2; dst[3] = x3; }
            LDS_WAIT(); __syncthreads();
#pragma unroll
            for (int k = 0; k < 4; ++k) { const int tau = wid + 8 * k, ni = tau >> 3, ei = tau & 7;
                acc[k] += mma_tile<128>(lds + CM_A + ni * 16 * 272, 272, lds + CM_B + ei * 16 * 272, 272, fr, fq); }
            LDS_WAIT(); __syncthreads();
        }
#pragma unroll
        for (int k = 0; k < 4; ++k) { const int tau = wid + 8 * k, ni = tau >> 3, ei = tau & 7;
#pragma unroll
            for (int i = 0; i < 4; ++i) *(LAS unsigned short*)(lds + CM_H + (16 * ni + 4 * fq + i) * 272 + (16 * ei + fr) * 2) = (unsigned short)f2bf(gelu1(acc[k][i])); }
        { const int f = tid >> 2, ch = (tid & 3) * 32; const bf16* src = w2 + (size_t)f * HD + ch;
          const v4u x0 = *(const v4u*)src, x1 = *(const v4u*)(src + 8), x2 = *(const v4u*)(src + 16), x3 = *(const v4u*)(src + 24);
          LAS v4u* dst = (LAS v4u*)(lds + CM_B + f * 272 + ch * 2); dst[0] = x0; dst[1] = x1; dst[2] = x2; dst[3] = x3; }
        LDS_WAIT(); __syncthreads();
        bf16* outp = which ? VCMP : KCMP;
#pragma unroll
        for (int k = 0; k < 4; ++k) { const int tau = wid + 8 * k, ni = tau >> 3, fi = tau & 7;
            const f32x4 a2 = mma_tile<128>(lds + CM_H + ni * 16 * 272, 272, lds + CM_B + fi * 16 * 272, 272, fr, fq);
#pragma unroll
            for (int i = 0; i < 4; ++i) { const int n = nt * 64 + 16 * ni + 4 * fq + i;
                outp[(((size_t)b * NCMPP + n) * NSA_G + g) * HD + 16 * fi + fr] = (n < NCMP) ? (bf16)f2bf(a2[i]) : (bf16)0u; } }
        LDS_WAIT(); __syncthreads();
    }
}
__device__ __forceinline__ unsigned pick4(const unsigned (&a)[4], int i) { return i == 0 ? a[0] : (i == 1 ? a[1] : (i == 2 ? a[2] : a[3])); }
template <int MODE>
__device__ __forceinline__ void nsa_attn_phase(Frame& F, const bf16* P1, const bf16* Qsrc, const bf16* Ksrc, const bf16* Vsrc, const unsigned* SEL, float* O32, float* IMP, bf16* Ob, bool probe_nostore = false) {
    const int tid = F.tid, wid = F.wave, lane = F.lane, r32 = lane & 31, hi = lane >> 5;
    LAS char* lds = (LAS char*)F.lds;
    LAS float* wsc = (LAS float*)(lds + ATT_WS_OFF + wid * 256);
    const int vb0 = (int)(uintptr_t)(lds + ATT_V_OFF) + v_rd_base(lane);
    KVDma dm; kv_dma_init(dm, MODE <= 1 ? NSA_G * HD : KVW, MODE == 0 ? NSA_G * HD : (MODE == 1 ? NSLC : NSA_INP), wid, lane);
    constexpr int NTB = SEQ / 32, NU = BATCH * NSA_G * NTB;
    for (int rd = 0; ; ++rd) {
        int idx;
        { idx = (rd & 1) ? rd * F.G + (F.G - 1 - F.bid) : rd * F.G + F.bid; if (rd * F.G >= NU) break; if (idx >= NU) continue; }
        const int tb = NTB - 1 - idx / (BATCH * NSA_G), bg = idx % (BATCH * NSA_G), g = bg % NSA_G, b = bg / NSA_G;
        const size_t rowb = (size_t)b * SEQ; const int t0 = tb * 32;
        const int t = (MODE == 2) ? t0 + 4 * wid + (r32 >> 3) : t0 + r32, head = (MODE == 2) ? g * NSA_R + (r32 & 7) : g * NSA_R + wid;
        const bf16* Kh; const bf16* Vh; long ldk, ldv; int jlo, jhi;
        if (MODE <= 1) { Kh = Ksrc + ((size_t)b * NCMPP * NSA_G + g) * HD; ldk = NSA_G * HD; jlo = 0; jhi = (t0 >> 4) >> 6;
            if (MODE == 0) { Vh = Vsrc + ((size_t)b * NCMPP * NSA_G + g) * HD; ldv = NSA_G * HD; } else { Vh = Vsrc; ldv = NSLC; } }
        else { Kh = Ksrc + rowb * KVW + g * HD; ldk = KVW; Vh = P1 + rowb * NSA_INP + (MODE == 2 ? P1_VS : P1_VW) + g * HD; ldv = NSA_INP;
            jhi = (t0 + 31) >> 6; jlo = (MODE == 2) ? 0 : ((t0 - (WINDOW - 1) > 0 ? t0 - (WINDOW - 1) : 0) >> 6); }
        unsigned wn[4] = {~0u, ~0u, ~0u, ~0u};
        if (MODE == 2) { const v4u sv = *(const v4u*)(SEL + ((rowb + t) * NSA_G + g) * 4); unsigned selw[4]; selw[0] = sv.x; selw[1] = sv.y; selw[2] = sv.z; selw[3] = sv.w;
            *(LAS v4u*)(lds + ATT_X_OFF + 2048 + (wid * 64 + lane) * 16) = sv;
            LAS unsigned* un = (LAS unsigned*)(lds + ATT_X_OFF);
#pragma unroll
            for (int q = 0; q < 4; ++q) { unsigned x = selw[q]; x |= __shfl_xor(x, 8); x |= __shfl_xor(x, 16); wn[q] = __builtin_amdgcn_readfirstlane(x); if (lane == 0) un[wid * 4 + q] = wn[q]; }
            LDS_WAIT(); __syncthreads();
            LAS int* plist = (LAS int*)(lds + ATT_X_OFF + 128);
            if (wid == 0) {
                unsigned m0 = 0u, m1 = 0u;
                int lane_l = lane; asm volatile("" : "+v"(lane_l));
                const LAS unsigned* ub = un + (lane_l >> 5);
#pragma unroll
                for (int w = 0; w < NWAVES; ++w) { m0 |= ((ub[w * 4] >> (lane & 31)) & 1u) << w; m1 |= ((ub[w * 4 + 2] >> (lane & 31)) & 1u) << w; }
                bool v0 = m0 != 0u && lane <= jhi, v1 = m1 != 0u && lane + 64 <= jhi; int np = 0;
                for (;;) {
                    const unsigned long long a0 = __ballot(v0), a1 = __ballot(v1);
                    if (!(a0 | a1)) break;
                    const int ja_ = a0 ? __builtin_ctzll(a0) : 64 + __builtin_ctzll(a1);
                    const unsigned ma = (ja_ < 64) ? (unsigned)__shfl((int)m0, ja_) : (unsigned)__shfl((int)m1, ja_ - 64);
                    if (lane == (ja_ & 63)) { if (ja_ < 64) v0 = false; else v1 = false; }
                    unsigned long long c0 = __ballot(v0 && !(m0 & ma)), c1 = __ballot(v1 && !(m1 & ma));
                    if (!(c0 | c1)) { c0 = __ballot(v0 && m0 == 0xffu); c1 = __ballot(v1 && m1 == 0xffu); }
                    if (!(c0 | c1)) { c0 = __ballot(v0); c1 = __ballot(v1); }
                    int jb_ = -1;
                    if (c0 | c1) { jb_ = c0 ? __builtin_ctzll(c0) : 64 + __builtin_ctzll(c1); if (lane == (jb_ & 63)) { if (jb_ < 64) v0 = false; else v1 = false; } }
                    if (lane == 0) { plist[2 * np] = ja_; plist[2 * np + 1] = jb_; }
                    ++np;
                }
                if (lane == 0) { int neg1 = -1; asm volatile("" : "+v"(neg1)); plist[2 * np] = neg1; plist[2 * np + 1] = neg1; }
            }
            LDS_WAIT(); }
        bf16x8 qr[8]; load_q(qr, Qsrc + (rowb + t) * (MODE <= 1 ? NSA_INP : DM) + head * HD + hi * 8);
        float m_reg = -1e30f, l_reg = 0.f; f32x16 o[4] = {};
        const int cur = t >> 6;
#define NSA_NEED(jj) (MODE != 2 || ((pick4(wn, (jj) >> 5) >> ((jj) & 31)) & 1u))
#define NSA_MASK(P0, P1, JJ) do { const int k0 = (JJ) * KVBLK; constexpr float NINF = -__builtin_inff(); \
            if (MODE <= 1) { if (!(16 * (k0 + 63) + 31 <= t0)) { \
                    _Pragma("unroll") for (int r = 0; r < 16; ++r) { if (!(16 * (k0 + crow(r, hi)) + 31 <= t)) P0[r] = NINF; if (!(16 * (k0 + 32 + crow(r, hi)) + 31 <= t)) P1[r] = NINF; } } } \
            else if (MODE == 2) { rv_ = (*(const LAS unsigned*)(lds + ATT_X_OFF + 2048 + (wid * 64 + lane) * 16 + ((JJ) >> 5) * 4) >> ((JJ) & 31)) & 1u;     \
                if ((JJ) >= cur) { const int lim = t - k0 - 4 * hi;                          \
                    _Pragma("unroll") for (int r = 0; r < 16; ++r) { if ((r & 3) + 8 * (r >> 2) > lim) P0[r] = NINF; if (32 + (r & 3) + 8 * (r >> 2) > lim) P1[r] = NINF; } } } \
            else { if (!((k0 > t0 + 31 - WINDOW) && (k0 + 63 <= t0))) { \
                    _Pragma("unroll") for (int r = 0; r < 16; ++r) { const int ka = k0 + crow(r, hi), kb = ka + 32; \
                        if (!(ka <= t && ka > t - WINDOW)) P0[r] = NINF; if (!(kb <= t && kb > t - WINDOW)) P1[r] = NINF; } } } } while (0)
        const int pbase = __builtin_amdgcn_readfirstlane((int)(uintptr_t)(lds + ATT_X_OFF + 128)); int pp = 0;
#define PLIST(i) (*(const LAS int*)(uintptr_t)(unsigned)(pbase + 4 * (i)))
        int ja, jb;
        __syncthreads();
        if (MODE == 2) { ja = PLIST(0); jb = PLIST(1); ja = __builtin_amdgcn_readfirstlane(ja); jb = __builtin_amdgcn_readfirstlane(jb); if (ja < 0) ja = jhi + 1; }
        else { ja = jlo; jb = ja + 1; if (jb > jhi) jb = -1; }
        if (ja <= jhi) kv_dma(dm, Kh + (size_t)ja * KVBLK * ldk, Vh + (size_t)ja * KVBLK * ldv, lds, 0, wid);
        if (jb >= 0) kv_dma(dm, Kh + (size_t)jb * KVBLK * ldk, Vh + (size_t)jb * KVBLK * ldv, lds, ATT_BUF, wid);
        int set = 0;
#pragma nounroll
        while (ja <= jhi) {
            int jc, jd;
            if (MODE == 2) { ++pp; jc = PLIST(2 * pp); jd = PLIST(2 * pp + 1); jc = __builtin_amdgcn_readfirstlane(jc); jd = __builtin_amdgcn_readfirstlane(jd); if (jc < 0) jc = jhi + 1; }
            else { jc = (jb >= 0 ? jb : ja) + 1; jd = jc + 1; if (jd > jhi) jd = -1; }
            VM_WAIT(); __syncthreads();
            if (jc <= jhi) kv_dma(dm, Kh + (size_t)jc * KVBLK * ldk, Vh + (size_t)jc * KVBLK * ldv, lds, ATT_SET - set, wid);
            if (jc <= jhi && jd >= 0) kv_dma(dm, Kh + (size_t)jd * KVBLK * ldk, Vh + (size_t)jd * KVBLK * ldv, lds, ATT_SET - set + ATT_BUF, wid);
            const bool nA = NSA_NEED(ja), nB = (jb >= 0) && NSA_NEED(jb);
            f32x16 a0, a1, b0, b1;
            if (nA) qkt(a0, a1, lds + set + ATT_K_OFF, qr, r32, hi);
            if (nB) qkt(b0, b1, lds + set + ATT_BUF + ATT_K_OFF, qr, r32, hi);
            bool rv_ = true;
            if (nA) { NSA_MASK(a0, a1, ja); attn_finish(a0, a1, o, m_reg, l_reg, wsc, vb0 + set, r32, hi, rv_); }
            if (nB) { NSA_MASK(b0, b1, jb); attn_finish(b0, b1, o, m_reg, l_reg, wsc, vb0 + set + ATT_BUF, r32, hi, rv_); }
            ja = jc; jb = (jc <= jhi) ? jd : -1; set = ATT_SET - set;
        }
#undef PLIST
#undef NSA_MASK
#undef NSA_NEED
        { float fac = l_reg > 0.f ? __builtin_amdgcn_rcpf(l_reg) : 0.f;
          if (MODE != 1) { const int br = MODE == 0 ? 0 : (MODE == 2 ? 1 : 2); fac *= sigmoidf_(bf2f(P1[(rowb + t) * NSA_INP + P1_GL + head * 3 + br])); }
          if (hi == 0) wsc[32 + r32] = fac; LDS_WAIT(); }
        if (MODE == 1) {
            float fc[16];
#pragma unroll
            for (int r = 0; r < 16; ++r) fc[r] = wsc[32 + crow(r, hi)];
            LDS_WAIT(); __syncthreads();
#pragma unroll
            for (int r = 0; r < 16; ++r) { const int orow = crow(r, hi);
#pragma unroll
                for (int d0 = 0; d0 < 4; ++d0) *(LAS float*)(lds + ((wid * 32 + orow) * 128 + d0 * 32 + r32) * 4) = o[d0][r] * fc[r]; }
            LDS_WAIT(); __syncthreads();
            { const int tok = tid >> 4, j8 = (tid & 15) * 8; f32x4 s0 = {0.f, 0.f, 0.f, 0.f}, s1 = {0.f, 0.f, 0.f, 0.f};
#pragma unroll
              for (int w = 0; w < 8; ++w) { const LAS f32x4* pp = (const LAS f32x4*)(lds + ((w * 32 + tok) * 128 + j8) * 4); s0 += pp[0]; s1 += pp[1]; }
              f32x4* dst = (f32x4*)(IMP + ((rowb + t0 + tok) * NSA_G + g) * NSLC + j8); dst[0] = s0; dst[1] = s1; }
            LDS_WAIT(); __syncthreads();
        } else {
#pragma unroll
            for (int r = 0; r < 16; ++r) { const int orow = crow(r, hi); const float fc = wsc[32 + orow];
                const size_t off = (MODE == 2) ? (rowb + t0 + 4 * wid + (orow >> 3)) * DM + (g * NSA_R + (orow & 7)) * HD + r32 : (rowb + t0 + orow) * DM + head * HD + r32;
#pragma unroll
                for (int d0 = 0; d0 < 4; ++d0) {
                    if (MODE == 0) O32[off + d0 * 32] = o[d0][r] * fc;
                    else if (MODE == 3) { if (!probe_nostore) O32[off + d0 * 32] += o[d0][r] * fc; }
                    else Ob[off + d0 * 32] = (bf16)f2bf(O32[off + d0 * 32] + o[d0][r] * fc); } }
            LDS_WAIT();
        }
    }
}
__device__ __forceinline__ void nsa_topk_phase(Frame& F, const float* IMP, unsigned* SEL) {
    LAS float* sc = (LAS float*)(F.lds + F.wave * 1024);
    const int gw = F.bid * NWAVES + F.wave, NGW = F.G * NWAVES, lane = F.lane;
    for (int it = gw; it < MTOK * NSA_G; it += NGW) {
        const int m = it / NSA_G, t = m & (SEQ - 1), cur = t >> 6;
        const float* ip = IMP + (size_t)it * NSLC;
        const float a0 = ip[lane], a1 = ip[64 + lane];
        sc[lane] = a0; sc[64 + lane] = a1; LDS_WAIT();
        const int j0 = lane, j1 = lane + 64;
        const bool f0 = (j0 == 0) || (j0 == cur) || (j0 == cur - 1), f1 = (j1 == cur) || (j1 == cur - 1);
        const bool c0 = !f0 && j0 <= cur, c1 = !f1 && j1 <= cur;
        const int nforced = cur >= 2 ? 3 : cur + 1, slots = NTOP - nforced;
        int rk0 = 0, rk1 = 0;
        const int ncand_hi = cur < NSLC ? cur : NSLC - 1;
        for (int i = 1; i <= ncand_hi; ++i) {
            const bool fi = (i == cur) || (i == cur - 1); if (fi) continue;
            const float v = sc[i];
            rk0 += (v > a0 || (v == a0 && i < j0)) ? 1 : 0; rk1 += (v > a1 || (v == a1 && i < j1)) ? 1 : 0;
        }
        const bool s0 = (f0 && j0 <= cur) || (c0 && rk0 < slots), s1 = (f1 && j1 <= cur) || (c1 && rk1 < slots);
        const unsigned long long m0 = __ballot(s0), m1 = __ballot(s1);
        if (lane == 0) { v4u w = {(unsigned)m0, (unsigned)(m0 >> 32), (unsigned)m1, (unsigned)(m1 >> 32)}; *(v4u*)(SEL + (size_t)it * 4) = w; }
        LDS_WAIT();
    }
}

#ifndef STAGE
#define STAGE 3
#endif
#define ZERO_OB_PHASE PH_BEGIN { v4u z = {0u, 0u, 0u, 0u}; v4u* p = (v4u*)Ob; const long n = (long)MTOK * DM / 8; \
            for (long i = (long)F.bid * NTHR + F.tid; i < n; i += (long)F.G * NTHR) p[i] = z; } PH_END
#define MIXER0_PHASES \
    PH_BEGIN { fold_finalize(F, FO_XQ, XW); fold_finalize(F, FO_UP, DFF2); } \
             REP(10) hgrn_phase_a(F, BIG, (const float*)(ws + WS_LB), (bf16*)(ws + WS_QT), (bf16*)(ws + WS_OINTRA), (bf16*)(ws + WS_DS), (float*)(ws + WS_DEC)); \
             REP(11) sb_phase(F, BIG, Ob); PH_END \
    PH_BEGIN REP(12) hgrn_phase_b(F, (const bf16*)(ws + WS_DS), (const float*)(ws + WS_DEC), (bf16*)(ws + WS_SPREV)); PH_END \
    PH_BEGIN REP(13) hgrn_phase_c(F, BIG, (const bf16*)(ws + WS_QT), (const bf16*)(ws + WS_OINTRA), (const bf16*)(ws + WS_SPREV), KIN(IN_HGRN_NW), Ob); PH_END
#if STAGE <= 2
#define MIXER1_PHASES ZERO_OB_PHASE
#else
#define MIXER1_PHASES \
    PH_BEGIN { fold_finalize(F, FO_XQ + XW, XW); } REP(14) { nsa_rope_phase(F, BIG, (const float*)(ws + WS_ROPE), (bf16*)(ws + WS_QROT), (bf16*)(ws + WS_KSROT), (bf16*)(ws + WS_KWROT), (bf16*)(ws + WS_OVL)); \
             nsa_compress_phase(F, BIG, KIN(IN_NSA_CMP_POS), (const bf16*)(ws + WS_W_C1), (const bf16*)(ws + WS_W_C2), (bf16*)(ws + WS_KCMP), (bf16*)(ws + WS_VCMP)); } PH_END \
    PH_BEGIN { REP(15) nsa_attn_phase<0>(F, BIG, BIG, (const bf16*)(ws + WS_KCMP), (const bf16*)(ws + WS_VCMP), nullptr, (float*)(ws + WS_O32), nullptr, nullptr); \
             F.fresh(); REP(15) nsa_attn_phase<1>(F, BIG, BIG, (const bf16*)(ws + WS_KCMP), (const bf16*)(ws + WS_OVL), nullptr, nullptr, (float*)(ws + WS_IMP), nullptr); \
             F.fresh(); REP(17) nsa_attn_phase<3>(F, BIG, (const bf16*)(ws + WS_QROT), (const bf16*)(ws + WS_KWROT), nullptr, nullptr, (float*)(ws + WS_O32), nullptr, nullptr, r_ > 0); } PH_END \
    PH_BEGIN REP(16) nsa_topk_phase(F, (const float*)(ws + WS_IMP), (unsigned*)(ws + WS_SEL)); PH_END \
    PH_BEGIN REP(18) nsa_attn_phase<2>(F, BIG, (const bf16*)(ws + WS_QROT), (const bf16*)(ws + WS_KSROT), nullptr, (const unsigned*)(ws + WS_SEL), (float*)(ws + WS_O32), nullptr, Ob); PH_END
#endif
#ifndef REPMASK
#define REPMASK 0u
#endif
#define REP(gid) for (int r_ = 0; r_ <= (int)((REPMASK >> (gid)) & 1u); ++r_)
#define PH_BEGIN if (pc >= lo && pc < hi) { F.fresh();
#if (REPMASK >> 23) & 1
#define PH_END   if (pc + 1 < hi) { const unsigned long long tb0_ = __builtin_amdgcn_s_memrealtime(); XcdBarrier bb_ = bar; asm volatile("" : "+s"(bb_.bar), "+s"(bb_.x)); xcd_barrier(bb_); \
        const unsigned w_ = (unsigned)(__builtin_amdgcn_s_memrealtime() - tb0_); tbar_acc += w_; if (threadIdx.x == 0) { atomicMax((unsigned*)(args.ws + 3 * MiB) + pc, 0x7fffffffu - w_); atomicMax((unsigned*)(args.ws + 3 * MiB) + 256 + pc, w_); } } } ++pc;
#else
#define PH_END   if (pc + 1 < hi) { XcdBarrier bb_ = bar; asm volatile("" : "+s"(bb_.bar), "+s"(bb_.x)); xcd_barrier(bb_); } } ++pc;
#endif
template <int l>
__device__ __forceinline__ void layer_body(Frame& F, const Args& args, const XcdBarrier& bar, int& pc, const int lo, const int hi, unsigned long long& tbar_acc) {
    unsigned char* ws = F.ws;
    bf16* HB = (bf16*)(ws + WS_HB); bf16* Y = (bf16*)(ws + WS_Y); float* H32 = (float*)karg()->out;
    bf16* BIG = (bf16*)(ws + WS_BIG); bf16* Gm = (bf16*)(ws + WS_G); bf16* Ob = (bf16*)(ws + WS_O);
    bf16* XQ = (bf16*)(ws + WS_XQ); bf16* XO = (bf16*)(ws + WS_XO);
#define RS(k) ((long long*)(ws + WS_RSUM) + (size_t)(k) * MTOK * 2)
#define LNG(k) (KIN(IN_LN_G) + (size_t)(k) * DM)
#define LNB(k) (KIN(IN_LN_B) + (size_t)(k) * DM)
    const float* cs = (const float*)(ws + WS_FOLDF); const float* b2 = cs + FO_N;
        PH_BEGIN REP(1) {
            const int N = l == 0 ? AB_IN : NSA_INP;
            pg8::StaticOrder S; S.init(MTOK, N, F.G, F.bid);
            if (l == 0) { pg8::Gemm g{HB, (const bf16*)(ws + WS_W_ABIN), MTOK, N, DM}; pg8::EpiBf16<0> E{BIG, N, nullptr, 0, 0, 1.f};
                pg8::gemm_phase<pg8::EpiBf16<0>, pg8::StaticOrder, PG8_ALIGN, PG8_SP2>(F.lds + RING_OFF, g, S, E); }
            else { pg8::Gemm g{Y, (const bf16*)(ws + WS_W_NSAIN), MTOK, N, DM}; pg8::EpiBf16Ln E{BIG, N, RS(2), cs + FO_NSA, b2 + FO_NSA};
                pg8::gemm_phase<pg8::EpiBf16Ln, pg8::StaticOrder, PG8_ALIGN, PG8_SP2>(F.lds + RING_OFF, g, S, E);
                if (r_ == 0) convert_job<CJ_L1A>(F, args, 64, 192); }
        } PH_END
#if STAGE <= 1
        ZERO_OB_PHASE
#else
        if (l == 0) {
            MIXER0_PHASES
        } else {
            MIXER1_PHASES
        }
#endif
        PH_BEGIN REP(2) {
            pg8::Gemm g{Ob, l == 0 ? (const bf16*)(ws + WS_W_ABOUT) : (const bf16*)(ws + WS_W_NSAOUT), MTOK, DM, DM};
            pg8::StaticOrder S; S.init(MTOK, DM, F.G, F.bid);
            if (l == 0) { pg8::EpiRes0 E{Y, HB, DM, DN_ALPHA, RS(0)};
                pg8::gemm_phase<pg8::EpiRes0, pg8::StaticOrder, PG8_ALIGN, PG8_SP2>(F.lds + RING_OFF, g, S, E); }
            else { pg8::EpiResLn2 E{Y, RS(2), LNG(2), LNB(2), DM, DN_ALPHA, RS(3)};
                pg8::gemm_phase<pg8::EpiResLn2, pg8::StaticOrder, PG8_ALIGN, PG8_SP2>(F.lds + RING_OFF, g, S, E); }
        } PH_END
        PH_BEGIN REP(3) {
            {   pg8::Gemm g{Y, (const bf16*)(ws + WS_W_XQ) + (size_t)l * XW * DM, MTOK, XW, DM};
                pg8::RangeOrder S; S.init(MTOK, XW, 0, 128, F.bid);
                pg8::EpiBf16Ln E{XQ, XW, RS(3 * l), cs + FO_XQ + l * XW, b2 + FO_XQ + l * XW};
                pg8::gemm_phase<pg8::EpiBf16Ln, pg8::RangeOrder, PG8_ALIGN, PG8_SP2>(F.lds + RING_OFF, g, S, E); }
            {   pg8::Gemm g{(const bf16*)(ws + WS_MEMB), (const bf16*)(ws + WS_W_XKV) + (size_t)l * 2 * XW * DM, BATCH * NMEM, 2 * XW, DM};
                pg8::RangeOrder S; S.init(BATCH * NMEM, 2 * XW, 128, 8, F.bid);
                pg8::EpiBf16<0> E{(bf16*)(ws + WS_XKV) + (size_t)l * BATCH * NMEM * 2 * XW, 2 * XW, nullptr, 0, 0, 1.f};
                pg8::gemm_phase<pg8::EpiBf16<0>, pg8::RangeOrder, PG8_ALIGN, PG8_SP2>(F.lds + RING_OFF, g, S, E); }
            if (r_ == 0) { if (l == 0) convert_job<CJ_DOWN0>(F, args, 136, 120); else convert_job<CJ_L1B>(F, args, 136, 120); }
        } PH_END
        PH_BEGIN { if (l == 1) fold_finalize(F, FO_UP + DFF2, DFF2); } REP(9) xattn_phase(F, XQ, (const bf16*)(ws + WS_XKV) + (size_t)l * BATCH * NMEM * 2 * XW, XO); PH_END
        PH_BEGIN REP(4) {
            pg8::Gemm g{XO, (const bf16*)(ws + WS_W_XO) + (size_t)l * DM * XW, MTOK, DM, XW};
            pg8::StaticOrder S; S.init(MTOK, DM, F.G, F.bid);
            pg8::EpiResLn2 E{Y, RS(3 * l), LNG(3 * l), LNB(3 * l), DM, DN_ALPHA, RS(3 * l + 1)};
            pg8::gemm_phase<pg8::EpiResLn2, pg8::StaticOrder, PG8_ALIGN, PG8_SP2>(F.lds + RING_OFF, g, S, E);
        } PH_END
        PH_BEGIN REP(5) {
#if (REPMASK >> 22) & 1
            if (r_ > 0) { XcdBarrier bb_ = bar; asm volatile("" : "+s"(bb_.bar), "+s"(bb_.x)); xcd_barrier(bb_); }
#endif
            pg8::Gemm g{Y, (const bf16*)(ws + WS_W_UP) + (size_t)l * DFF2 * DM, MTOK, DFF2, DM};
            pg8::StaticOrder S; S.init(MTOK, DFF2, F.G, F.bid);
            pg8::EpiConvGlu E{Gm, (bf16*)(ws + WS_SIDE), RS(3 * l + 1), cs + FO_UP + l * DFF2, b2 + FO_UP + l * DFF2, KIN(IN_FFN_CONV) + (size_t)l * 3 * DFF, DFF};
            pg8::gemm_phase<pg8::EpiConvGlu, pg8::StaticOrder, PG8_ALIGN, PG8_SP2>(F.lds + RING_OFF, g, S, E);
            if (r_ == 0) { if (l == 0) convert_job<CJ_NSA>(F, args, 128, 128); else convert_job<CJ_DOWN1>(F, args, 128, 128); }
        } PH_END
#if (REPMASK >> 20) & 1
        PH_BEGIN {
            pg8::Gemm g{HB, (const bf16*)(ws + WS_W_UP) + (size_t)l * DFF2 * DM, MTOK, DFF2, DM};
            pg8::ZeroOrder S; S.init(MTOK, DFF2, F.G, F.bid);
            pg8::EpiBf16<0> E{Gm, DFF2, nullptr, 0, 0, 1.f};
            pg8::gemm_phase<pg8::EpiBf16<0>, pg8::ZeroOrder, PG8_ALIGN, PG8_SP2>(F.lds + RING_OFF, g, S, E);
        } PH_END
#endif
        PH_BEGIN { if (l == 0) fold_finalize(F, FO_NSA, NSA_INP); } REP(8) convglu_fixup_phase(F, (const bf16*)(ws + WS_SIDE), KIN(IN_FFN_CONV) + (size_t)l * 3 * DFF, Gm); PH_END
        PH_BEGIN REP(6) {
            pg8::Gemm g{Gm, (const bf16*)(ws + WS_W_DOWN) + (size_t)l * DM * DFF, MTOK, DM, DFF};
            pg8::StaticOrder S; S.init(MTOK, DM, F.G, F.bid);
            pg8::EpiResLn2 E{Y, RS(3 * l + 1), LNG(3 * l + 1), LNB(3 * l + 1), DM, DN_ALPHA, RS(3 * l + 2)};
            pg8::gemm_phase<pg8::EpiResLn2, pg8::StaticOrder, PG8_ALIGN, PG8_SP2>(F.lds + RING_OFF, g, S, E);
        } PH_END
        if (l == 1) { PH_BEGIN REP(7) ln_phase(F, Y, LNG(5), LNB(5), H32); PH_END }
#undef RS
#undef LNG
#undef LNB
}
__global__ void __launch_bounds__(NTHR, 2) mega_fwd(Args args) {
    extern __shared__ __attribute__((aligned(16))) unsigned char lds_raw[];
    Frame F;
    F.lds = (LAS unsigned char*)lds_raw; F.ws = args.ws;
    F.tid = threadIdx.x; F.lane = F.tid & 63; F.wave = __builtin_amdgcn_readfirstlane(F.tid >> 6); F.G = gridDim.x;
    unsigned char* ws = args.ws;
    gu32* ctl = (gu32*)(ws + WS_CTL);
    for (int u = F.tid; u < (LDS_BYTES - LDSCTL_OFF) / 4; u += NTHR) ((LAS unsigned*)(F.lds + LDSCTL_OFF))[u] = 0u;
    __syncthreads();
    volatile LAS unsigned* MISC = (volatile LAS unsigned*)(F.lds + MISC_OFF);
    XcdBarrier bar = xcd_barrier_post((unsigned*)(ctl + CW_BAR), MISC + 8);
    const int lo = args.ph_lo, hi = args.ph_hi; int pc = 0; unsigned long long tbar_acc = 0ull;
    bf16* HB = (bf16*)(ws + WS_HB); bf16* Y = (bf16*)(ws + WS_Y); float* H32 = (float*)karg()->out;
    bf16* BIG = (bf16*)(ws + WS_BIG); bf16* Gm = (bf16*)(ws + WS_G); bf16* Ob = (bf16*)(ws + WS_O);
    bf16* XQ = (bf16*)(ws + WS_XQ); bf16* XO = (bf16*)(ws + WS_XO);

    PH_BEGIN REP(0) p0_prologue(F, args); PH_END

#if (REPMASK >> 21) & 1
    for (int e_ = 0; e_ < 40; ++e_) { PH_BEGIN PH_END }
#endif
    layer_body<0>(F, args, bar, pc, lo, hi, tbar_acc);
    layer_body<1>(F, args, bar, pc, lo, hi, tbar_acc);
#if (REPMASK >> 23) & 1
#ifndef PROBE_BID
#define PROBE_BID 0
#endif
#if (REPMASK >> 24) & 1
    if (blockIdx.x == 0) { unsigned long long tot_ = 0ull; for (int k_ = 0; k_ < pc; ++k_) { const unsigned v_ = __hip_atomic_load((unsigned*)(args.ws + 3 * MiB) + k_, __ATOMIC_RELAXED, __HIP_MEMORY_SCOPE_AGENT); const unsigned x_ = __hip_atomic_load((unsigned*)(args.ws + 3 * MiB) + 256 + k_, __ATOMIC_RELAXED, __HIP_MEMORY_SCOPE_AGENT);
#ifdef PROBE_SPREAD_MASK
            if (v_ && ((PROBE_SPREAD_MASK >> k_) & 1ull)) tot_ += x_ - (0x7fffffffu - v_);
#else
            if (v_) tot_ += 0x7fffffffu - v_;
#endif
        }
        const unsigned long long t0_ = __builtin_amdgcn_s_memrealtime(); while (__builtin_amdgcn_s_memrealtime() - t0_ < tot_) __builtin_amdgcn_s_sleep(8); }
#else
    if (blockIdx.x == PROBE_BID) { const unsigned long long t0_ = __builtin_amdgcn_s_memrealtime(); while (__builtin_amdgcn_s_memrealtime() - t0_ < tbar_acc) __builtin_amdgcn_s_sleep(8); }
#endif
#endif
}

extern "C" void kernel_launch(void* const* d_in, const int* in_sizes, int n_in, void* d_out, int out_size, void* d_ws, size_t ws_size, hipStream_t stream) {
    static int grid = 0;
    if (grid == 0) {
        if (n_in != 19 || in_sizes[0] != MTOK * DM || out_size != MTOK * DM || ws_size < WS_END) {
            fprintf(stderr, "kernel_launch: shape mismatch n_in %d in0 %d out %d ws %zu (need %zu)\n", n_in, n_in > 0 ? in_sizes[0] : -1, out_size, ws_size, (size_t)WS_END); grid = -1; return; }
        int dev = 0, cus = 0, per_cu = 0;
        if (hipGetDevice(&dev) != hipSuccess || hipDeviceGetAttribute(&cus, hipDeviceAttributeMultiprocessorCount, dev) != hipSuccess) { grid = -1; return; }
        if (hipFuncSetAttribute((const void*)mega_fwd, hipFuncAttributeMaxDynamicSharedMemorySize, LDS_BYTES) != hipSuccess) { fprintf(stderr, "kernel_launch: hipFuncSetAttribute failed\n"); grid = -1; return; }
        if (hipOccupancyMaxActiveBlocksPerMultiprocessor(&per_cu, (const void*)mega_fwd, NTHR, LDS_BYTES) != hipSuccess || per_cu < 1)
            fprintf(stderr, "kernel_launch: note: occupancy query reports %d workgroups per CU\n", per_cu);
        (void)hipGetLastError();
        grid = cus;
        if (grid != 256) { fprintf(stderr, "kernel_launch: built for a 256-CU device (workgroup ranges of the cross-attention and conversion phases); this device reports %d; nothing launched\n", cus); grid = -1; return; }
    }
    if (grid < 0) return;
    if (hipMemsetAsync((char*)d_ws + WS_CTL, 0, CTL_ZERO_BYTES, stream) != hipSuccess) { fprintf(stderr, "kernel_launch: memset failed\n"); return; }
    Args a{};
    for (int i = 0; i < 19; ++i) a.in[i] = (const float*)d_in[i];
    a.out = (float*)d_out; a.ws = (unsigned char*)d_ws; a.ph_lo = 0; a.ph_hi = 1 << 20;
    hipLaunchKernelGGL(mega_fwd, dim3(grid), dim3(NTHR), LDS_BYTES, stream, a);
    const hipError_t le = hipPeekAtLastError();
    if (le != hipSuccess) fprintf(stderr, "kernel_launch: launch failed: %s\n", hipGetErrorName(le));
}
```

```cpp
#include <hip/hip_runtime.h>
#include <cstdio>
#include <cstdint>
namespace pg8 {
#define PG8_LAS __attribute__((address_space(3)))
typedef unsigned short bf16_t;
typedef short bf16x8 __attribute__((ext_vector_type(8)));
typedef float f32x4 __attribute__((ext_vector_type(4)));
typedef unsigned u32x4 __attribute__((ext_vector_type(4)));
constexpr int BM = 256, BK = 64, HALF = 128, HTB = HALF * BK * 2  , STAGE_BYTES = 8 * HTB, NXCD = 8, WGM = 8;

__host__ __device__ __forceinline__ int lds_byte(int r, int c) { const int st = (r >> 4) * 2 + (c >> 5), rr = r & 15, cc = c & 31, ob = rr * 64 + cc * 2; return st * 1024 + (ob ^ (((ob >> 9) & 1) << 5)); }
__host__ __device__ __forceinline__ void stage_rc(int b, int& R, int& C) { const int st = b / 1024, sb = b % 1024, swz = sb ^ (((sb >> 9) & 1) << 5); R = (st >> 1) * 16 + swz / 64; C = (st & 1) * 32 + (swz % 64) / 2; }
__host__ __device__ __forceinline__ int perm32(int rho) { const int n = rho >> 4, i = rho & 15; return 8 * (i >> 2) + 4 * n + (i & 3); }

struct Unit { int pm, pn; };
struct Gemm { const bf16_t* A; const bf16_t* Bt; int M, N, K; };

struct StaticOrder {
    int nM, nN, nwg, G, c;
    __host__ __device__ void init(int M, int N, int G_, int c_) { nM = M / BM; nN = N / BM; nwg = nM * nN; G = G_; c = c_; }
    __host__ __device__ bool next(int i, Unit& u) const {
        const long L = (long)i * G + c; if (L >= nwg) return false;
        int wgid = (int)L; { const int q = nwg / NXCD, r = nwg % NXCD, xcd = wgid % NXCD, off = wgid / NXCD; wgid = (xcd < r ? xcd * (q + 1) : r * (q + 1) + (xcd - r) * q) + off; }
        const int nig = WGM * nN, gid = wgid / nig, fm = gid * WGM, gsz = (nM - fm) < WGM ? (nM - fm) : WGM;
        u.pm = fm + ((wgid % nig) % gsz); u.pn = (wgid % nig) / gsz; return true;
    }
    __device__ __forceinline__ void a_ready(const Unit&) const {}
    __device__ __forceinline__ void done(const Unit&) const {}
};

__device__ __forceinline__ unsigned cvt_pk_bf16(float lo, float hi) { unsigned r; asm volatile("v_cvt_pk_bf16_f32 %0, %1, %2" : "=v"(r) : "v"(lo), "v"(hi)); return r; }
typedef float f32x2 __attribute__((ext_vector_type(2)));
__device__ __forceinline__ f32x2 gelu_pk(f32x2 v) {
    const f32x2 av = __builtin_elementwise_abs(v), d = av * 0.2316418882f + 1.0f;
    f32x2 t; t.x = __builtin_amdgcn_rcpf(d.x); t.y = __builtin_amdgcn_rcpf(d.y);
    f32x2 q = t * 0.5307027145f + (-0.7265760135f); q = q * t + 0.7107068705f; q = q * t + (-0.142248368f); q = q * t + 0.127414796f; q = q * t;
    const f32x2 s = (v * v) * (-0.72134752044f);
    f32x2 e; e.x = __builtin_amdgcn_exp2f(s.x); e.y = __builtin_amdgcn_exp2f(s.y);
    const f32x2 m = v * (q * e), r = v - m;
    f32x2 o; o.x = v.x < 0.f ? m.x : r.x; o.y = v.y < 0.f ? m.y : r.y; return o;
}

template <int ACT  > struct EpiBf16 {
    static constexpr bool PERM = true, AFTER_DRAIN = false; static_assert(ACT == 0 || ACT == 1, "EpiBf16: ACT is 0 (none) or 1 (gelu_pk)");
    bf16_t* O; int ldc; const float* bias; int split_cols; size_t split_stride; float scale0;
    __device__ __forceinline__ void operator()(const f32x4 (&acc)[2][2][4][2], const Unit& u, int wr, int wc, int fr, int fq) const {
        const int row0 = u.pm * BM + wr * 64 + fr; int colt = u.pn * BM; bf16_t* base = O;
        float sc = 1.f; if (split_cols) { const int t = colt / split_cols; base += (size_t)t * split_stride; colt -= t * split_cols; if (t == 0) sc = scale0; }
        const int col0 = colt + wc * 32 + 8 * fq, bcol0 = u.pn * BM + wc * 32 + 8 * fq;
        f32x4 bv[2][2];
#pragma unroll
        for (int bj = 0; bj < 2; ++bj)
#pragma unroll
            for (int n = 0; n < 2; ++n) bv[bj][n] = bias ? *(const f32x4*)(bias + bcol0 + bj * HALF + 4 * n) : (f32x4){0.f, 0.f, 0.f, 0.f};
#pragma unroll
        for (int ai = 0; ai < 2; ++ai)
#pragma unroll
            for (int m = 0; m < 4; ++m) { bf16_t* rowp = base + (size_t)(row0 + ai * HALF + m * 16) * ldc + col0;
#pragma unroll
                for (int bj = 0; bj < 2; ++bj) { f32x4 v0 = acc[ai][bj][m][0] + bv[bj][0], v1 = acc[ai][bj][m][1] + bv[bj][1];
                    if (ACT == 1) { f32x2 a = gelu_pk((f32x2){v0[0], v0[1]}), b = gelu_pk((f32x2){v0[2], v0[3]}), c = gelu_pk((f32x2){v1[0], v1[1]}), d = gelu_pk((f32x2){v1[2], v1[3]});
                        v0 = (f32x4){a.x, a.y, b.x, b.y}; v1 = (f32x4){c.x, c.y, d.x, d.y}; }
                    v0 = v0 * sc; v1 = v1 * sc; u32x4 w; w.x = cvt_pk_bf16(v0[0], v0[1]); w.y = cvt_pk_bf16(v0[2], v0[3]); w.z = cvt_pk_bf16(v1[0], v1[1]); w.w = cvt_pk_bf16(v1[2], v1[3]);
                    *(u32x4*)(rowp + bj * HALF) = w; } }
    }
};


struct EpiRes {
    static constexpr bool PERM = false, AFTER_DRAIN = false;
    float* Y; const float* res; int ldc; float alpha;
    __device__ __forceinline__ void operator()(const f32x4 (&acc)[2][2][4][2], const Unit& u, int wr, int wc, int fr, int fq) const {
        const int row0 = u.pm * BM + wr * 64 + fr, col0 = u.pn * BM + wc * 32 + 4 * fq;
#pragma unroll
        for (int ai = 0; ai < 2; ++ai)
#pragma unroll
            for (int m = 0; m < 4; ++m) { const size_t off = (size_t)(row0 + ai * HALF + m * 16) * ldc + col0;
#pragma unroll
                for (int bj = 0; bj < 2; ++bj)
#pragma unroll
                    for (int n = 0; n < 2; ++n) { const f32x4 r = *(const f32x4*)(res + off + bj * HALF + n * 16);
                        *(f32x4*)(Y + off + bj * HALF + n * 16) = r * alpha + acc[ai][bj][m][n]; } }
    }
};
struct RangeOrder {
    int nM, nN, ntot, c0, nw, c;
    __host__ __device__ void init(int M, int N, int c0_, int nw_, int c_) { nM = M / BM; nN = N / BM; ntot = nM * nN; c0 = c0_; nw = nw_; c = c_; }
    __host__ __device__ bool next(int i, Unit& u) const {
        if (c < c0 || c >= c0 + nw) return false;
        const int L = i * nw + (c - c0); if (L >= ntot) return false;
        u.pm = L / nN; u.pn = L % nN; return true;
    }
    __device__ __forceinline__ void a_ready(const Unit&) const {}
    __device__ __forceinline__ void done(const Unit&) const {}
};

struct ZeroOrder : StaticOrder {
    __host__ __device__ bool next(int i, Unit& u) const { const bool r = StaticOrder::next(i, u); u.pm = 0; u.pn = 0; return r; }
};

struct EpiResBf {
    static constexpr bool PERM = true, AFTER_DRAIN = false;
    bf16_t* Y; const bf16_t* res; int ldc; float alpha;
    __device__ __forceinline__ void operator()(const f32x4 (&acc)[2][2][4][2], const Unit& u, int wr, int wc, int fr, int fq) const {
        const int row0 = u.pm * BM + wr * 64 + fr, col0 = u.pn * BM + wc * 32 + 8 * fq;
#pragma unroll
        for (int ai = 0; ai < 2; ++ai)
#pragma unroll
            for (int m = 0; m < 4; ++m) { const size_t off = (size_t)(row0 + ai * HALF + m * 16) * ldc + col0;
#pragma unroll
                for (int bj = 0; bj < 2; ++bj) { const u32x4 r = *(const u32x4*)(res + off + bj * HALF);
                    const f32x4 v0 = acc[ai][bj][m][0], v1 = acc[ai][bj][m][1];
                    u32x4 w;
                    w.x = cvt_pk_bf16(__builtin_bit_cast(float, r.x << 16) * alpha + v0[0], __builtin_bit_cast(float, r.x & 0xffff0000u) * alpha + v0[1]);
                    w.y = cvt_pk_bf16(__builtin_bit_cast(float, r.y << 16) * alpha + v0[2], __builtin_bit_cast(float, r.y & 0xffff0000u) * alpha + v0[3]);
                    w.z = cvt_pk_bf16(__builtin_bit_cast(float, r.z << 16) * alpha + v1[0], __builtin_bit_cast(float, r.z & 0xffff0000u) * alpha + v1[1]);
                    w.w = cvt_pk_bf16(__builtin_bit_cast(float, r.w << 16) * alpha + v1[2], __builtin_bit_cast(float, r.w & 0xffff0000u) * alpha + v1[3]);
                    *(u32x4*)(Y + off + bj * HALF) = w; } }
    }
};

struct EpiResF {
    static constexpr bool PERM = true, AFTER_DRAIN = false;
    float* Y; const bf16_t* res; int ldc; float alpha;
    __device__ __forceinline__ void operator()(const f32x4 (&acc)[2][2][4][2], const Unit& u, int wr, int wc, int fr, int fq) const {
        const int row0 = u.pm * BM + wr * 64 + fr, col0 = u.pn * BM + wc * 32 + 8 * fq;
#pragma unroll
        for (int ai = 0; ai < 2; ++ai)
#pragma unroll
            for (int m = 0; m < 4; ++m) { const size_t off = (size_t)(row0 + ai * HALF + m * 16) * ldc + col0;
#pragma unroll
                for (int bj = 0; bj < 2; ++bj) { const u32x4 r = *(const u32x4*)(res + off + bj * HALF);
                    f32x4 o0, o1;
                    o0[0] = __builtin_bit_cast(float, r.x << 16); o0[1] = __builtin_bit_cast(float, r.x & 0xffff0000u); o0[2] = __builtin_bit_cast(float, r.y << 16); o0[3] = __builtin_bit_cast(float, r.y & 0xffff0000u);
                    o1[0] = __builtin_bit_cast(float, r.z << 16); o1[1] = __builtin_bit_cast(float, r.z & 0xffff0000u); o1[2] = __builtin_bit_cast(float, r.w << 16); o1[3] = __builtin_bit_cast(float, r.w & 0xffff0000u);
                    *(f32x4*)(Y + off + bj * HALF) = o0 * alpha + acc[ai][bj][m][0]; *(f32x4*)(Y + off + bj * HALF + 4) = o1 * alpha + acc[ai][bj][m][1]; } }
    }
};

struct EpiResLn {
    static constexpr bool PERM = true, AFTER_DRAIN = false;
    bf16_t* Y; const float* stats; const float* g; const float* b; int ldc; float alpha;
    __device__ __forceinline__ void operator()(const f32x4 (&acc)[2][2][4][2], const Unit& u, int wr, int wc, int fr, int fq) const {
        const int row0 = u.pm * BM + wr * 64 + fr, col0 = u.pn * BM + wc * 32 + 8 * fq;
        f32x4 gv[2][2], bv[2][2];
#pragma unroll
        for (int bj = 0; bj < 2; ++bj)
#pragma unroll
            for (int n = 0; n < 2; ++n) { gv[bj][n] = *(const f32x4*)(g + col0 + bj * HALF + 4 * n) * alpha; bv[bj][n] = *(const f32x4*)(b + col0 + bj * HALF + 4 * n) * alpha; }
#pragma unroll
        for (int ai = 0; ai < 2; ++ai)
#pragma unroll
            for (int m = 0; m < 4; ++m) { const int row = row0 + ai * HALF + m * 16; const size_t off = (size_t)row * ldc + col0;
                const float mean = stats[2 * row], rstd = stats[2 * row + 1];
#pragma unroll
                for (int bj = 0; bj < 2; ++bj) { const u32x4 r = *(const u32x4*)(Y + off + bj * HALF);
                    f32x4 y0, y1;
                    y0[0] = __builtin_bit_cast(float, r.x << 16); y0[1] = __builtin_bit_cast(float, r.x & 0xffff0000u); y0[2] = __builtin_bit_cast(float, r.y << 16); y0[3] = __builtin_bit_cast(float, r.y & 0xffff0000u);
                    y1[0] = __builtin_bit_cast(float, r.z << 16); y1[1] = __builtin_bit_cast(float, r.z & 0xffff0000u); y1[2] = __builtin_bit_cast(float, r.w << 16); y1[3] = __builtin_bit_cast(float, r.w & 0xffff0000u);
                    const f32x4 o0 = (y0 - mean) * rstd * gv[bj][0] + bv[bj][0] + acc[ai][bj][m][0], o1 = (y1 - mean) * rstd * gv[bj][1] + bv[bj][1] + acc[ai][bj][m][1];
                    u32x4 w; w.x = cvt_pk_bf16(o0[0], o0[1]); w.y = cvt_pk_bf16(o0[2], o0[3]); w.z = cvt_pk_bf16(o1[0], o1[1]); w.w = cvt_pk_bf16(o1[2], o1[3]);
                    *(u32x4*)(Y + off + bj * HALF) = w; } }
    }
};

constexpr float RS_SCALE = 1048576.0f, RS_INV = 1.0f / 1048576.0f;
__device__ __forceinline__ float fx20_to_f(long long v) { return (float)(int)(v >> 20) + (float)((unsigned)v & 0xFFFFFu) * RS_INV; }
__device__ __forceinline__ long long f_to_fx20(float s) { const float fl = floorf(s); return ((long long)(int)fl << 20) + (long long)(unsigned)((s - fl) * RS_SCALE + 0.5f); }
__device__ __forceinline__ void row_stats(const long long* rs, int row, float& mean, float& rstd) {
    const long long a = rs[2 * (size_t)row], b = rs[2 * (size_t)row + 1];
    mean = fx20_to_f(a) * (1.0f / 4096.0f); const float var = fx20_to_f(b) * (1.0f / 4096.0f) - mean * mean; rstd = 1.0f / sqrtf(var + 1e-5f);
}
constexpr float FOLD_SCALE = 4294967296.0f, FOLD_INV = 1.0f / 4294967296.0f;
struct EpiBf16Ln {
    static constexpr bool PERM = true, AFTER_DRAIN = false;
    bf16_t* O; int ldc; const long long* rs; const float* cs; const float* b2;
    __device__ __forceinline__ void operator()(const f32x4 (&acc)[2][2][4][2], const Unit& u, int wr, int wc, int fr, int fq) const {
        const int row0 = u.pm * BM + wr * 64 + fr, col0 = u.pn * BM + wc * 32 + 8 * fq;
        f32x4 cv[2][2], bv[2][2];
#pragma unroll
        for (int bj = 0; bj < 2; ++bj)
#pragma unroll
            for (int n = 0; n < 2; ++n) { cv[bj][n] = *(const f32x4*)(cs + col0 + bj * HALF + 4 * n); bv[bj][n] = *(const f32x4*)(b2 + col0 + bj * HALF + 4 * n); }
#pragma unroll
        for (int ai = 0; ai < 2; ++ai)
#pragma unroll
            for (int m = 0; m < 4; ++m) { const int row = row0 + ai * HALF + m * 16; float mean, rstd; row_stats(rs, row, mean, rstd);
                bf16_t* rowp = O + (size_t)row * ldc + col0;
#pragma unroll
                for (int bj = 0; bj < 2; ++bj) { const f32x4 v0 = (acc[ai][bj][m][0] - cv[bj][0] * mean) * rstd + bv[bj][0], v1 = (acc[ai][bj][m][1] - cv[bj][1] * mean) * rstd + bv[bj][1];
                    u32x4 w; w.x = cvt_pk_bf16(v0[0], v0[1]); w.y = cvt_pk_bf16(v0[2], v0[3]); w.z = cvt_pk_bf16(v1[0], v1[1]); w.w = cvt_pk_bf16(v1[2], v1[3]);
                    *(u32x4*)(rowp + bj * HALF) = w; } }
    }
};
__device__ __forceinline__ void row_sums_add(long long* rso, int row, const f32x4& a, const f32x4& b, const f32x4& c, const f32x4& d, int fq) {
    float s1 = ((a[0] + a[1]) + (a[2] + a[3])) + ((b[0] + b[1]) + (b[2] + b[3])) + ((c[0] + c[1]) + (c[2] + c[3])) + ((d[0] + d[1]) + (d[2] + d[3]));
    float s2 = ((a[0] * a[0] + a[1] * a[1]) + (a[2] * a[2] + a[3] * a[3])) + ((b[0] * b[0] + b[1] * b[1]) + (b[2] * b[2] + b[3] * b[3]))
             + ((c[0] * c[0] + c[1] * c[1]) + (c[2] * c[2] + c[3] * c[3])) + ((d[0] * d[0] + d[1] * d[1]) + (d[2] * d[2] + d[3] * d[3]));
    s1 += __shfl_xor(s1, 16); s1 += __shfl_xor(s1, 32); s2 += __shfl_xor(s2, 16); s2 += __shfl_xor(s2, 32);
    if (fq == 0) { atomicAdd((unsigned long long*)(rso + 2 * (size_t)row), (unsigned long long)f_to_fx20(s1)); atomicAdd((unsigned long long*)(rso + 2 * (size_t)row + 1), (unsigned long long)f_to_fx20(s2)); }
}
struct EpiRes0 {
    static constexpr bool PERM = true, AFTER_DRAIN = false;
    bf16_t* Y; const bf16_t* res; int ldc; float alpha; long long* rso;
    __device__ __forceinline__ void operator()(const f32x4 (&acc)[2][2][4][2], const Unit& u, int wr, int wc, int fr, int fq) const {
        const int row0 = u.pm * BM + wr * 64 + fr, col0 = u.pn * BM + wc * 32 + 8 * fq;
#pragma unroll
        for (int ai = 0; ai < 2; ++ai)
#pragma unroll
            for (int m = 0; m < 4; ++m) { const int row = row0 + ai * HALF + m * 16; const size_t off = (size_t)row * ldc + col0; f32x4 o[2][2];
#pragma unroll
                for (int bj = 0; bj < 2; ++bj) { const u32x4 r = *(const u32x4*)(res + off + bj * HALF);
                    f32x4 y0, y1;
                    y0[0] = __builtin_bit_cast(float, r.x << 16); y0[1] = __builtin_bit_cast(float, r.x & 0xffff0000u); y0[2] = __builtin_bit_cast(float, r.y << 16); y0[3] = __builtin_bit_cast(float, r.y & 0xffff0000u);
                    y1[0] = __builtin_bit_cast(float, r.z << 16); y1[1] = __builtin_bit_cast(float, r.z & 0xffff0000u); y1[2] = __builtin_bit_cast(float, r.w << 16); y1[3] = __builtin_bit_cast(float, r.w & 0xffff0000u);
                    o[bj][0] = y0 * alpha + acc[ai][bj][m][0]; o[bj][1] = y1 * alpha + acc[ai][bj][m][1];
                    u32x4 w; w.x = cvt_pk_bf16(o[bj][0][0], o[bj][0][1]); w.y = cvt_pk_bf16(o[bj][0][2], o[bj][0][3]); w.z = cvt_pk_bf16(o[bj][1][0], o[bj][1][1]); w.w = cvt_pk_bf16(o[bj][1][2], o[bj][1][3]);
                    *(u32x4*)(Y + off + bj * HALF) = w; }
                row_sums_add(rso, row, o[0][0], o[0][1], o[1][0], o[1][1], fq); }
    }
};
struct EpiResLn2 {
    static constexpr bool PERM = true, AFTER_DRAIN = false;
    bf16_t* Y; const long long* rsi; const float* g; const float* b; int ldc; float alpha; long long* rso;
    __device__ __forceinline__ void operator()(const f32x4 (&acc)[2][2][4][2], const Unit& u, int wr, int wc, int fr, int fq) const {
        const int row0 = u.pm * BM + wr * 64 + fr, col0 = u.pn * BM + wc * 32 + 8 * fq;
        f32x4 gv[2][2], bv[2][2];
#pragma unroll
        for (int bj = 0; bj < 2; ++bj)
#pragma unroll
            for (int n = 0; n < 2; ++n) { gv[bj][n] = *(const f32x4*)(g + col0 + bj * HALF + 4 * n) * alpha; bv[bj][n] = *(const f32x4*)(b + col0 + bj * HALF + 4 * n) * alpha; }
#pragma unroll
        for (int ai = 0; ai < 2; ++ai)
#pragma unroll
            for (int m = 0; m < 4; ++m) { const int row = row0 + ai * HALF + m * 16; const size_t off = (size_t)row * ldc + col0; float mean, rstd; row_stats(rsi, row, mean, rstd); f32x4 o[2][2];
#pragma unroll
                for (int bj = 0; bj < 2; ++bj) { const u32x4 r = *(const u32x4*)(Y + off + bj * HALF);
                    f32x4 y0, y1;
                    y0[0] = __builtin_bit_cast(float, r.x << 16); y0[1] = __builtin_bit_cast(float, r.x & 0xffff0000u); y0[2] = __builtin_bit_cast(float, r.y << 16); y0[3] = __builtin_bit_cast(float, r.y & 0xffff0000u);
                    y1[0] = __builtin_bit_cast(float, r.z << 16); y1[1] = __builtin_bit_cast(float, r.z & 0xffff0000u); y1[2] = __builtin_bit_cast(float, r.w << 16); y1[3] = __builtin_bit_cast(float, r.w & 0xffff0000u);
                    o[bj][0] = (y0 - mean) * rstd * gv[bj][0] + bv[bj][0] + acc[ai][bj][m][0]; o[bj][1] = (y1 - mean) * rstd * gv[bj][1] + bv[bj][1] + acc[ai][bj][m][1];
                    u32x4 w; w.x = cvt_pk_bf16(o[bj][0][0], o[bj][0][1]); w.y = cvt_pk_bf16(o[bj][0][2], o[bj][0][3]); w.z = cvt_pk_bf16(o[bj][1][0], o[bj][1][1]); w.w = cvt_pk_bf16(o[bj][1][2], o[bj][1][3]);
                    *(u32x4*)(Y + off + bj * HALF) = w; }
                row_sums_add(rso, row, o[0][0], o[0][1], o[1][0], o[1][1], fq); }
    }
};

struct EpiBf16LnTok {
    static constexpr bool PERM = true, AFTER_DRAIN = false, AROWPERM = true;
    bf16_t* O; int ldc; const long long* rs; const float* cs; const float* b2;
    __device__ __forceinline__ void operator()(const f32x4 (&acc)[2][2][4][2], const Unit& u, int wr, int wc, int fr, int fq) const {
        const int row0 = u.pm * BM + 128 * wr + 8 * fr, col0 = u.pn * BM + wc * 32 + 8 * fq;
        f32x4 cv[2][2], bv[2][2];
#pragma unroll
        for (int bj = 0; bj < 2; ++bj)
#pragma unroll
            for (int n = 0; n < 2; ++n) { cv[bj][n] = *(const f32x4*)(cs + col0 + bj * HALF + 4 * n); bv[bj][n] = *(const f32x4*)(b2 + col0 + bj * HALF + 4 * n); }
#pragma unroll
        for (int ai = 0; ai < 2; ++ai)
#pragma unroll
            for (int m = 0; m < 4; ++m) { const int row = row0 + 4 * ai + m; float mean, rstd; row_stats(rs, row, mean, rstd);
                bf16_t* rowp = O + (size_t)row * ldc + col0;
#pragma unroll
                for (int bj = 0; bj < 2; ++bj) { const f32x4 v0 = (acc[ai][bj][m][0] - cv[bj][0] * mean) * rstd + bv[bj][0], v1 = (acc[ai][bj][m][1] - cv[bj][1] * mean) * rstd + bv[bj][1];
                    u32x4 w; w.x = cvt_pk_bf16(v0[0], v0[1]); w.y = cvt_pk_bf16(v0[2], v0[3]); w.z = cvt_pk_bf16(v1[0], v1[1]); w.w = cvt_pk_bf16(v1[2], v1[3]);
                    *(u32x4*)(rowp + bj * HALF) = w; } }
    }
};

__device__ __forceinline__ float dpp_shr1(float x) { return __builtin_bit_cast(float, __builtin_amdgcn_update_dpp(0, __builtin_bit_cast(int, x), 0x111, 0xf, 0xf, true)); }
struct EpiConvGlu {
    static constexpr bool PERM = true, AFTER_DRAIN = false, AROWPERM = true;
    bf16_t* G; bf16_t* side; const long long* rs; const float* cs; const float* b2; const float* cw; int dff;
    __device__ __forceinline__ void operator()(const f32x4 (&acc)[2][2][4][2], const Unit& u, int wr, int wc, int fr, int fq) const {
        const int row0 = u.pm * BM + 128 * wr + 8 * fr, colg = u.pn * BM + wc * 32 + 8 * fq, ch0 = u.pn * HALF + wc * 32 + 8 * fq;
        float mean_[8], rstd_[8];
#pragma unroll
        for (int j = 0; j < 8; ++j) row_stats(rs, row0 + j, mean_[j], rstd_[j]);
        unsigned gout[8][4];
        const int bnd = row0 >> 7;
#pragma unroll
        for (int n = 0; n < 2; ++n) {
            const f32x4 ca = *(const f32x4*)(cs + colg + 4 * n), ba = *(const f32x4*)(b2 + colg + 4 * n), cu = *(const f32x4*)(cs + colg + HALF + 4 * n), bu = *(const f32x4*)(b2 + colg + HALF + 4 * n);
            const f32x4 w0 = *(const f32x4*)(cw + ch0 + 4 * n), w1 = *(const f32x4*)(cw + dff + ch0 + 4 * n), w2 = *(const f32x4*)(cw + 2 * dff + ch0 + 4 * n);
            f32x4 a[8], uu[8];
#pragma unroll
            for (int j = 0; j < 8; ++j) { a[j] = (acc[j >> 2][0][j & 3][n] - ca * mean_[j]) * rstd_[j] + ba; uu[j] = (acc[j >> 2][1][j & 3][n] - cu * mean_[j]) * rstd_[j] + bu; }
            f32x4 p6, p7;
#pragma unroll
            for (int q = 0; q < 4; ++q) { p6[q] = dpp_shr1(a[6][q]); p7[q] = dpp_shr1(a[7][q]); }
            if (fr == 15 && bnd + 1 < 128) { bf16_t* sp = side + ((size_t)(bnd + 1) * 6) * dff + ch0 + 4 * n;
                *(unsigned long long*)(sp) = (unsigned long long)cvt_pk_bf16(a[6][0], a[6][1]) | ((unsigned long long)cvt_pk_bf16(a[6][2], a[6][3]) << 32);
                *(unsigned long long*)(sp + dff) = (unsigned long long)cvt_pk_bf16(a[7][0], a[7][1]) | ((unsigned long long)cvt_pk_bf16(a[7][2], a[7][3]) << 32); }
            if (fr == 0) { bf16_t* sp = side + ((size_t)bnd * 6 + 2) * dff + ch0 + 4 * n;
                *(unsigned long long*)(sp) = (unsigned long long)cvt_pk_bf16(a[0][0], a[0][1]) | ((unsigned long long)cvt_pk_bf16(a[0][2], a[0][3]) << 32);
                *(unsigned long long*)(sp + dff) = (unsigned long long)cvt_pk_bf16(a[1][0], a[1][1]) | ((unsigned long long)cvt_pk_bf16(a[1][2], a[1][3]) << 32);
                *(unsigned long long*)(sp + 2 * dff) = (unsigned long long)cvt_pk_bf16(uu[0][0], uu[0][1]) | ((unsigned long long)cvt_pk_bf16(uu[0][2], uu[0][3]) << 32);
                *(unsigned long long*)(sp + 3 * dff) = (unsigned long long)cvt_pk_bf16(uu[1][0], uu[1][1]) | ((unsigned long long)cvt_pk_bf16(uu[1][2], uu[1][3]) << 32); }
#pragma unroll
            for (int j = 0; j < 8; ++j) { const f32x4 am1 = (j == 0) ? p7 : a[j ? j - 1 : 0], am2 = (j == 0) ? p6 : (j == 1 ? p7 : a[j > 1 ? j - 2 : 0]);
                const f32x4 c = w2 * a[j] + w1 * am1 + w0 * am2;
                const f32x2 g01 = gelu_pk((f32x2){c[0], c[1]}), g23 = gelu_pk((f32x2){c[2], c[3]});
                gout[j][2 * n] = cvt_pk_bf16(g01.x * uu[j][0], g01.y * uu[j][1]); gout[j][2 * n + 1] = cvt_pk_bf16(g23.x * uu[j][2], g23.y * uu[j][3]); }
        }
#pragma unroll
        for (int j = 0; j < 8; ++j) if (!(fr == 0 && j < 2)) { u32x4 w; w.x = gout[j][0]; w.y = gout[j][1]; w.z = gout[j][2]; w.w = gout[j][3]; *(u32x4*)(G + (size_t)(row0 + j) * dff + ch0) = w; }
    }
};
template <class E, class = void> struct arowperm_v { static constexpr bool value = false; };
template <class E> struct arowperm_v<E, decltype((void)E::AROWPERM)> { static constexpr bool value = E::AROWPERM; };
template <class Epi, class Sched, bool ALIGN_EPI = false, bool SP2 = false>
__device__ __forceinline__ void gemm_phase(PG8_LAS unsigned char* lds, const Gemm g, const Sched& S, const Epi& E) {
    int tid_l = threadIdx.x; asm volatile("" : "+v"(tid_l)); const int tid = tid_l, wid = __builtin_amdgcn_readfirstlane(tid >> 6), lane = tid & 63, wr = wid >> 2, wc = wid & 3, fr = lane & 15, fq = lane >> 4;
    const int K = g.K, nt = K / BK;
    unsigned voffA[2], voffB[2];
#pragma unroll
    for (int i = 0; i < 2; ++i) { int R, C; stage_rc(tid * 16 + i * 8192, R, C); const int Rb = Epi::PERM ? ((R & ~31) + perm32(R & 31)) : R;
        const int Ra = arowperm_v<Epi>::value ? (128 * (R >> 6) + 8 * (R & 15) + ((R >> 4) & 3)) : R;
        voffA[i] = (unsigned)(Ra * K + C) * 2u; voffB[i] = (unsigned)(Rb * K + C) * 2u; }
    const size_t hstepA = arowperm_v<Epi>::value ? (size_t)4 * K * 2 : (size_t)HALF * K * 2;
    const size_t kstep = (size_t)(BK * 2);
    const size_t hstep = (size_t)HALF * K * 2;
    const size_t tstep = 2 * hstep;
    const unsigned ldsw = (unsigned)wid * 1024u;
    const int aoff = lds_byte(wr * 64 + fr, fq * 8), boff = lds_byte(wc * 32 + fr, fq * 8);
#define PG8_SA(b, h) (((b) * 2 + (h)) * HTB)
#define PG8_SB(b, h) ((4 + (b) * 2 + (h)) * HTB)
#define PG8_STAGE(bufoff, gbase, voff) do { _Pragma("unroll") for (int _i = 0; _i < 2; ++_i) \
        __builtin_amdgcn_global_load_lds((const unsigned*)((const char*)(gbase) + (voff)[_i]), (PG8_LAS unsigned*)(lds + (bufoff) + ldsw + _i * 8192), 16, 0, 0); } while (0)
#define PG8_LDA(dst, b, h) do { _Pragma("unroll") for (int m = 0; m < 4; ++m) _Pragma("unroll") for (int k = 0; k < 2; ++k) dst[m][k] = *(const PG8_LAS bf16x8*)(lds + PG8_SA(b, h) + aoff + m * 2048 + k * 1024); } while (0)
#define PG8_LDB(dst, b, h) do { _Pragma("unroll") for (int n = 0; n < 2; ++n) _Pragma("unroll") for (int k = 0; k < 2; ++k) dst[n][k] = *(const PG8_LAS bf16x8*)(lds + PG8_SB(b, h) + boff + n * 2048 + k * 1024); } while (0)
#define PG8_MMA(ai, bj, At, Bt) do { __builtin_amdgcn_s_setprio(1); _Pragma("unroll") for (int m = 0; m < 4; ++m) _Pragma("unroll") for (int n = 0; n < 2; ++n) _Pragma("unroll") for (int k = 0; k < 2; ++k) \
        acc[ai][bj][m][n] = __builtin_amdgcn_mfma_f32_16x16x32_bf16(Bt[n][k], At[m][k], acc[ai][bj][m][n], 0, 0, 0); __builtin_amdgcn_s_setprio(0); } while (0)
#define PG8_WAIT_V(n) asm volatile("s_waitcnt vmcnt(" #n ")" ::: "memory")
#define PG8_WAIT_L(n) asm volatile("s_waitcnt lgkmcnt(" #n ")" ::: "memory")
#define PG8_BAR __builtin_amdgcn_s_barrier()
#define PG8_SCHED __builtin_amdgcn_sched_barrier(0)
    Unit cur, nxt; int ui = 0;
    if (!S.next(0, cur)) return;
    f32x4 acc[2][2][4][2];
#pragma unroll
    for (int a = 0; a < 2; ++a)
#pragma unroll
        for (int b = 0; b < 2; ++b)
#pragma unroll
            for (int m = 0; m < 4; ++m)
#pragma unroll
                for (int n = 0; n < 2; ++n) acc[a][b][m][n] = (f32x4){0.f, 0.f, 0.f, 0.f};
    bf16x8 At[4][2], B0[2][2], B1[2][2];
    const char* cA = (const char*)g.A + (size_t)cur.pm * tstep; const char* cB = (const char*)g.Bt + (size_t)cur.pn * tstep;
    S.a_ready(cur);
    if constexpr (SP2) {
        PG8_STAGE(PG8_SB(0, 0), cB, voffB); PG8_STAGE(PG8_SB(0, 1), cB + hstep, voffB); PG8_STAGE(PG8_SA(0, 0), cA, voffA); PG8_STAGE(PG8_SA(0, 1), cA + hstepA, voffA);
        if (wr == 1) PG8_BAR;
        PG8_WAIT_V(2); PG8_BAR;
        PG8_STAGE(PG8_SB(1, 0), cB + kstep, voffB); PG8_STAGE(PG8_SA(1, 0), cA + kstep, voffA); PG8_STAGE(PG8_SB(1, 1), cB + hstep + kstep, voffB);
        PG8_WAIT_V(6); PG8_BAR;
    } else {
        PG8_STAGE(PG8_SB(0, 0), cB, voffB); PG8_STAGE(PG8_SA(0, 0), cA, voffA); PG8_STAGE(PG8_SB(0, 1), cB + hstep, voffB); PG8_STAGE(PG8_SA(0, 1), cA + hstepA, voffA);
        if (wr == 1) PG8_BAR;
        PG8_WAIT_V(4); PG8_BAR;
        PG8_STAGE(PG8_SB(1, 0), cB + kstep, voffB); PG8_STAGE(PG8_SA(1, 0), cA + kstep, voffA); PG8_STAGE(PG8_SB(1, 1), cB + hstep + kstep, voffB);
        PG8_WAIT_V(6); PG8_BAR;
    }
    for (;;) {
        const bool has_next = S.next(ui + 1, nxt);
        const char* nA = has_next ? (const char*)g.A + (size_t)nxt.pm * tstep : cA; const char* nB = has_next ? (const char*)g.Bt + (size_t)nxt.pn * tstep : cB;
        for (int t = 0; t < nt; t += 2) {
            const bool last = (t == nt - 2);
            const char* a1 = cA + (size_t)(t + 1) * kstep;
            const char* a2 = last ? nA : cA + (size_t)(t + 2) * kstep; const char* b2 = last ? nB : cB + (size_t)(t + 2) * kstep;
            const char* a3 = a2 + kstep; const char* b3 = b2 + kstep;
            if (last && has_next) S.a_ready(nxt);
            if constexpr (SP2) {
            PG8_LDB(B0, 0, 0); PG8_LDB(B1, 0, 1); PG8_SCHED; PG8_LDA(At, 0, 0); PG8_STAGE(PG8_SA(1, 1), a1 + hstepA, voffA);
            PG8_WAIT_V(8); PG8_WAIT_L(0); PG8_BAR; PG8_MMA(0, 0, At, B0); PG8_MMA(0, 1, At, B1); PG8_BAR; PG8_SCHED;
            PG8_LDA(At, 0, 1); PG8_STAGE(PG8_SB(0, 0), b2, voffB); PG8_STAGE(PG8_SB(0, 1), b2 + hstep, voffB); PG8_STAGE(PG8_SA(0, 0), a2, voffA);
            PG8_WAIT_V(8); PG8_WAIT_L(0); PG8_BAR; PG8_MMA(1, 0, At, B0); PG8_MMA(1, 1, At, B1); PG8_BAR; PG8_SCHED;
            PG8_LDB(B0, 1, 0); PG8_LDB(B1, 1, 1); PG8_SCHED; PG8_LDA(At, 1, 0); PG8_STAGE(PG8_SA(0, 1), a2 + hstepA, voffA);
            PG8_WAIT_V(8); PG8_WAIT_L(0); PG8_BAR; PG8_MMA(0, 0, At, B0); PG8_MMA(0, 1, At, B1); PG8_BAR; PG8_SCHED;
            PG8_LDA(At, 1, 1); PG8_STAGE(PG8_SB(1, 0), b3, voffB); PG8_STAGE(PG8_SB(1, 1), b3 + hstep, voffB); PG8_STAGE(PG8_SA(1, 0), a3, voffA);
            PG8_WAIT_V(8); PG8_WAIT_L(0); PG8_BAR; PG8_MMA(1, 0, At, B0); PG8_MMA(1, 1, At, B1); PG8_BAR; PG8_SCHED;
            } else {
            PG8_LDB(B0, 0, 0); PG8_SCHED; PG8_LDA(At, 0, 0); PG8_STAGE(PG8_SA(1, 1), a1 + hstepA, voffA);
            PG8_WAIT_L(8); PG8_BAR; PG8_WAIT_L(0); PG8_MMA(0, 0, At, B0); PG8_BAR; PG8_SCHED;
            PG8_LDB(B1, 0, 1); PG8_STAGE(PG8_SB(0, 0), b2, voffB);
            PG8_BAR; PG8_WAIT_L(0); PG8_MMA(0, 1, At, B1); PG8_BAR;
            PG8_LDA(At, 0, 1); PG8_STAGE(PG8_SA(0, 0), a2, voffA);
            PG8_BAR; PG8_WAIT_L(0); PG8_MMA(1, 0, At, B0); PG8_BAR; PG8_SCHED;
            PG8_STAGE(PG8_SB(0, 1), b2 + hstep, voffB);
            PG8_WAIT_V(6); PG8_BAR; PG8_MMA(1, 1, At, B1); PG8_BAR;
            PG8_LDB(B0, 1, 0); PG8_SCHED; PG8_LDA(At, 1, 0); PG8_STAGE(PG8_SA(0, 1), a2 + hstepA, voffA);
            PG8_WAIT_L(8); PG8_BAR; PG8_WAIT_L(0); PG8_MMA(0, 0, At, B0); PG8_BAR; PG8_SCHED;
            PG8_LDB(B1, 1, 1); PG8_STAGE(PG8_SB(1, 0), b3, voffB);
            PG8_BAR; PG8_WAIT_L(0); PG8_MMA(0, 1, At, B1); PG8_BAR;
            PG8_LDA(At, 1, 1); PG8_STAGE(PG8_SA(1, 0), a3, voffA);
            PG8_BAR; PG8_WAIT_L(0); PG8_MMA(1, 0, At, B0); PG8_BAR; PG8_SCHED;
            PG8_STAGE(PG8_SB(1, 1), b3 + hstep, voffB);
            PG8_WAIT_V(6); PG8_BAR; PG8_MMA(1, 1, At, B1); PG8_BAR;
            }
        }
        if constexpr (ALIGN_EPI) { if (wr == 0) PG8_BAR; }
        if constexpr (!Epi::AFTER_DRAIN) { E(acc, cur, wr, wc, fr, fq); S.done(cur); }
        if (!has_next) break;
#pragma unroll
        for (int a = 0; a < 2; ++a)
#pragma unroll
            for (int b = 0; b < 2; ++b)
#pragma unroll
                for (int m = 0; m < 4; ++m)
#pragma unroll
                    for (int n = 0; n < 2; ++n) acc[a][b][m][n] = (f32x4){0.f, 0.f, 0.f, 0.f};
        cur = nxt; cA = nA; cB = nB; ++ui;
        if constexpr (ALIGN_EPI) { if (wr == 1) PG8_BAR; }
    }
    PG8_WAIT_V(0);
    if constexpr (!ALIGN_EPI) { if (wr == 0) PG8_BAR; }
    PG8_BAR;
    if constexpr (Epi::AFTER_DRAIN) { E.fused(acc, cur, wr, wc, fr, fq, lds, wid, lane); S.done(cur); }
#undef PG8_SA
#undef PG8_SB
#undef PG8_STAGE
#undef PG8_LDA
#undef PG8_LDB
#undef PG8_MMA
#undef PG8_WAIT_V
#undef PG8_WAIT_L
#undef PG8_BAR
#undef PG8_SCHED
}
}

#ifndef PG8_SP2
#define PG8_SP2 true
#endif
#ifndef PG8_ALIGN
#define PG8_ALIGN true
#endif
constexpr int NWAVES = 8, NTHR = 512;
constexpr int BATCH = 2, SEQ = 8192, DM = 4096, MTOK = BATCH * SEQ;
constexpr int HD = 128;
constexpr int A_HEADS = 16, B_HEADS = 16, A_W = 2048, B_W = 2048, AB_IN = 4 * A_W + 3 * B_W;
constexpr int NSA_H = 32, NSA_G = 4, NSA_R = 8, KVW = 512, NSA_IN = 4096 + 6 * KVW + 96, NSA_INP = 7424;
constexpr int NCMP = 511, NCMPP = 512, NSLC = 128, NTOP = 16, WINDOW = 512;
constexpr int NMEM = 256, XH = 4, XW = 512;
constexpr int DFF = 11008, DFF2 = 22016;
constexpr float LN_EPS = 1e-5f, RMS_EPS = 1e-6f;
constexpr float DN_ALPHA = 1.41421356237309515f;
constexpr size_t MiB = (size_t)1 << 20;
constexpr size_t WS_CTL = 0, CTL_ZERO_BYTES = 4 * MiB;
constexpr size_t WS_FOLD = 64 * 1024;
constexpr int FO_XQ = 0, FO_UP = 2 * 512, FO_NSA = FO_UP + 2 * 22016, FO_N = FO_NSA + 7424;
constexpr size_t WS_RSUM = 1 * MiB;
static_assert(WS_FOLD + (size_t)2 * FO_N * 8 <= WS_RSUM && WS_RSUM + (size_t)6 * 16384 * 2 * 8 <= CTL_ZERO_BYTES, "CTL map");
constexpr size_t WS_W_ABIN = 4 * MiB;
constexpr size_t WS_W_ABOUT = WS_W_ABIN + 112 * MiB;
constexpr size_t WS_W_NSAIN = WS_W_ABOUT + 32 * MiB;
constexpr size_t WS_W_NSAOUT = WS_W_NSAIN + 58 * MiB;
constexpr size_t WS_W_XQ = WS_W_NSAOUT + 32 * MiB;
constexpr size_t WS_W_XKV = WS_W_XQ + 8 * MiB;
constexpr size_t WS_W_XO = WS_W_XKV + 16 * MiB;
constexpr size_t WS_W_UP = WS_W_XO + 8 * MiB;
constexpr size_t WS_W_DOWN = WS_W_UP + 344 * MiB;
constexpr size_t WS_W_C1 = WS_W_DOWN + 172 * MiB;
constexpr size_t WS_W_C2 = WS_W_C1 + 2 * MiB;
constexpr size_t WS_MEMB = WS_W_C2 + 1 * MiB;
constexpr size_t WS_HB = WS_MEMB + 4 * MiB;
constexpr size_t WS_Y = WS_HB + 128 * MiB;
constexpr size_t WS_BIG = WS_Y + 256 * MiB;
constexpr size_t WS_G = WS_BIG + 688 * MiB;
constexpr size_t WS_O = WS_G + 344 * MiB;
constexpr size_t WS_MISC = WS_O + 128 * MiB;
constexpr size_t WS_END = WS_MISC + 64 * MiB;
constexpr size_t WS_XQ = WS_MISC;
constexpr size_t WS_XO = WS_MISC + 16 * MiB;
constexpr size_t WS_XKV = WS_MISC + 32 * MiB;
constexpr size_t WS_LB = WS_MISC + 34 * MiB;
constexpr size_t WS_SIDE = WS_MISC + 42 * MiB;
constexpr size_t WS_FOLDF = WS_MISC + 40 * MiB;
constexpr size_t WS_ROPE = WS_MISC + 36 * MiB;
constexpr size_t WS_STATS = WS_MISC + 35 * MiB;
constexpr size_t WS_PROJ0 = WS_BIG;
constexpr size_t WS_SPREV = WS_BIG + 448 * MiB;
constexpr size_t WS_QT = WS_G;
constexpr size_t WS_OINTRA = WS_G + 64 * MiB;
constexpr size_t WS_DEC = WS_G + 192 * MiB;
constexpr size_t WS_DS = WS_Y;
constexpr size_t WS_PROJ1 = WS_BIG;
constexpr size_t WS_QROT = WS_BIG + 232 * MiB;
constexpr size_t WS_KSROT = WS_BIG + 360 * MiB;
constexpr size_t WS_KWROT = WS_BIG + 376 * MiB;
constexpr size_t WS_KCMP = WS_BIG + 392 * MiB;
constexpr size_t WS_VCMP = WS_BIG + 393 * MiB;
constexpr size_t WS_OVL = WS_BIG + 394 * MiB;
constexpr size_t WS_SEL = WS_BIG + 395 * MiB;
constexpr size_t WS_IMP = WS_G + 256 * MiB;
constexpr size_t WS_O32 = WS_G;
static_assert(WS_SPREV + 128 * MiB <= WS_G && WS_DEC + 2 * MiB <= WS_O && WS_SEL + MiB <= WS_G, "ws map");
constexpr int CW_TMO = 0, CW_CODE = 1;
constexpr int CW_BAR = 4096;
constexpr int RING_OFF = 0, RING_BYTES = 131072;
constexpr int LDSCTL_OFF = RING_BYTES, MISC_OFF = LDSCTL_OFF + 320;
constexpr int LDS_BYTES = 147456;
static_assert(MISC_OFF + 128 <= LDS_BYTES, "LDS map");

#define GAS __attribute__((address_space(1)))
#define LAS __attribute__((address_space(3)))
typedef unsigned short bf16;
typedef unsigned v4u __attribute__((ext_vector_type(4)));
typedef unsigned v2u __attribute__((ext_vector_type(2)));
typedef float f32x4 __attribute__((ext_vector_type(4)));
typedef float f32x2 __attribute__((ext_vector_type(2)));
typedef float f32x16 __attribute__((ext_vector_type(16)));
typedef short bf16x8 __attribute__((ext_vector_type(8)));
typedef short s16x4 __attribute__((ext_vector_type(4)));
typedef GAS unsigned gu32;
#define RLX_AGENT __ATOMIC_RELAXED, __HIP_MEMORY_SCOPE_AGENT
#define LDS_WAIT() asm volatile("s_waitcnt lgkmcnt(0)" ::: "memory")
#define VM_WAIT() asm volatile("s_waitcnt vmcnt(0)" ::: "memory")
#define SBAR() __builtin_amdgcn_sched_barrier(0)
__device__ __forceinline__ unsigned f2bf(float f) { unsigned u = __builtin_bit_cast(unsigned, f); return (u + 0x7fffu + ((u >> 16) & 1u)) >> 16; }
__device__ __forceinline__ unsigned pk2(float lo, float hi) { return f2bf(lo) | (f2bf(hi) << 16); }
__device__ __forceinline__ float bf2f(unsigned short b) { return __builtin_bit_cast(float, (unsigned)b << 16); }
__device__ __forceinline__ float bflo(unsigned w) { return __builtin_bit_cast(float, w << 16); }
__device__ __forceinline__ float bfhi(unsigned w) { return __builtin_bit_cast(float, w & 0xffff0000u); }
__device__ __forceinline__ unsigned cvtpk(float lo, float hi) { unsigned r; asm volatile("v_cvt_pk_bf16_f32 %0, %1, %2" : "=v"(r) : "v"(lo), "v"(hi)); return r; }
__device__ __forceinline__ float wave_sum(float v) {
#pragma unroll
    for (int o = 1; o < 64; o <<= 1) v += __shfl_xor(v, o);
    return v;
}
__device__ __forceinline__ float sigmoidf_(float x) { return __builtin_amdgcn_rcpf(1.f + __builtin_amdgcn_exp2f(-1.4426950408889634f * x)); }
__device__ __forceinline__ float gelu1(float v) { pg8::f32x2 r = pg8::gelu_pk((pg8::f32x2){v, 0.f}); return r.x; }
#define XB_TMO      128
#define XB_XCNT(j)  (256  + 64 * (j))
#define XB_XSUB(j)  (1280 + 64 * (j))
#define XB_XGEN(j)  (2304 + 64 * (j))
#define XB_TOP      3328
#define XB_TOPGEN   3392
#define XCD_BAR_WORDS 3456
#define XB_SPIN_CAP (1u << 18)
#define LAS __attribute__((address_space(3)))

__device__ __forceinline__ unsigned xb_ld(unsigned* p)              { return __hip_atomic_load(p, __ATOMIC_RELAXED, __HIP_MEMORY_SCOPE_AGENT); }
__device__ __forceinline__ unsigned xb_add(unsigned* p, unsigned v) { return __hip_atomic_fetch_add(p, v, __ATOMIC_RELAXED, __HIP_MEMORY_SCOPE_AGENT); }
__device__ __forceinline__ unsigned xb_xcc_id() { return (unsigned)__builtin_amdgcn_s_getreg((3 << 11) | 20) & 0xFu; }
#define XB_SPIN(cond, bar) do { unsigned _sp = 0; while (cond) { __builtin_amdgcn_s_sleep(1); \
    if ((++_sp & 255u) == 0u) { if (xb_ld(&(bar)[XB_TMO])) break; if (_sp > XB_SPIN_CAP) { atomicAdd(&(bar)[XB_TMO], 1u); break; } } } } while (0)

struct XcdBarrier {
    unsigned* bar; unsigned x;
    volatile LAS unsigned* st;
};

__device__ __forceinline__ XcdBarrier xcd_barrier_post(unsigned* bar, volatile LAS unsigned* st) {
    XcdBarrier b; b.bar = bar; b.x = xb_xcc_id(); b.st = st;
    if (threadIdx.x == 0) (void)xb_add(&bar[XB_XCNT(b.x)], 1u);
    return b;
}
__device__ __forceinline__ void xcd_barrier_complete(unsigned* bar, unsigned x, unsigned& nloc, unsigned& nx) {
    const unsigned G = gridDim.x * gridDim.y * gridDim.z;
    unsigned sum, cnt, mine, sp = 0u;
    for (;;) {
        sum = 0u; cnt = 0u; mine = 0u;
#pragma unroll
        for (unsigned j = 0; j < 16; ++j) { const unsigned c = xb_ld(&bar[XB_XCNT(j)]); sum += c; cnt += (c > 0u) ? 1u : 0u; mine = (j == x) ? c : mine; }
        if (sum == G) break;
        __builtin_amdgcn_s_sleep(1);
        if ((++sp & 255u) == 0u) { if (xb_ld(&bar[XB_TMO])) break; if (sp > XB_SPIN_CAP) { atomicAdd(&bar[XB_TMO], 1u); break; } }
    }
    nloc = mine > 0u ? mine : 1u; nx = cnt > 0u ? cnt : 1u;
}

__device__ __forceinline__ void xcd_barrier(const XcdBarrier& b) {
    asm volatile("s_waitcnt vmcnt(0)" ::: "memory");
    __syncthreads();
    if (threadIdx.x == 0) {
        unsigned* bar = b.bar;
        __builtin_amdgcn_s_waitcnt(0);
        unsigned nloc = b.st[0], nx = b.st[1];
        if (nloc == 0u) { xcd_barrier_complete(bar, b.x, nloc, nx); b.st[0] = nloc; b.st[1] = nx; }
        const unsigned old = xb_add(&bar[XB_XSUB(b.x)], 1u);
        const unsigned gen = old / nloc;
        if (old + 1u == (gen + 1u) * nloc) {
            __builtin_amdgcn_fence(__ATOMIC_RELEASE, "agent");
            asm volatile("s_waitcnt vmcnt(0)" ::: "memory");
            const unsigned og = xb_add(&bar[XB_TOP], 1u);
            const unsigned tg = og / nx;
            if (og + 1u == (tg + 1u) * nx) xb_add(&bar[XB_TOPGEN], 1u);
            else XB_SPIN(xb_ld(&bar[XB_TOPGEN]) == tg, bar);
            __builtin_amdgcn_fence(__ATOMIC_ACQUIRE, "agent");
            xb_add(&bar[XB_XGEN(b.x)], 1u);
            asm volatile("s_waitcnt vmcnt(0)" ::: "memory");
        } else {
            XB_SPIN(xb_ld(&bar[XB_XGEN(b.x)]) == gen, bar);
            __builtin_amdgcn_fence(__ATOMIC_ACQUIRE, "agent");
            asm volatile("s_waitcnt vmcnt(0)" ::: "memory");
        }
    }
    __syncthreads();
}


constexpr int ATT_D = 128, KVBLK = 64;
constexpr int SHM_V = KVBLK * ATT_D * 2, SHM_K = KVBLK * ATT_D * 2;
constexpr int ATT_K_OFF = 0, ATT_V_OFF = SHM_K, ATT_BUF = SHM_K + SHM_V, ATT_SET = 2 * ATT_BUF;
constexpr int ATT_WS_OFF = RING_BYTES + 512;
constexpr int ATT_X_OFF = ATT_WS_OFF + NWAVES * 256;
static_assert(2 * ATT_SET <= RING_BYTES && ATT_X_OFF + 2048 + NTHR * 16 <= LDS_BYTES, "attention LDS map");
#define KSWZ(row, colB) ((row) * 256 + ((colB) ^ (((row) & 7) << 4)))
__device__ __forceinline__ int crow(int r, int hi) { return (r & 3) + 8 * (r >> 2) + 4 * hi; }
__device__ __forceinline__ int v_st(int k, int c) { const int kk = (k & ~0xC) | ((k & 4) << 1) | ((k & 8) >> 1); return ((kk >> 3) * 4 + (c >> 5)) * 512 + ((kk & 7) * 32 + (c & 31)) * 2; }
__device__ __forceinline__ int v_rd_base(int lane) { return ((lane & 3) << 3) | (((lane >> 2) & 3) << 6) | (((lane >> 4) & 1) << 5) | (((lane >> 5) & 1) << 8); }
constexpr int v_rd_off(int d0, int ks, int half) { return d0 * 512 + ks * 4096 + half * 2048; }
template <int OFF> __device__ __forceinline__ s16x4 tr_read(int vb) {
  s16x4 r; asm volatile("ds_read_b64_tr_b16 %0, %1 offset:%2" : "=&v"(r) : "v"(vb), "i"(OFF) : "memory"); return r;
}
__device__ __forceinline__ void qkt(f32x16& p0, f32x16& p1, const LAS char* Ks, const bf16x8* qr, int r32, int hi) {
  p0 = f32x16{}; p1 = f32x16{};
#pragma unroll
  for (int d0 = 0; d0 < 8; ++d0) { const int cb = (d0 * 16 + hi * 8) * 2;
    const bf16x8 b0 = *(const LAS bf16x8*)(Ks + KSWZ(r32, cb));
    const bf16x8 b1 = *(const LAS bf16x8*)(Ks + KSWZ(32 + r32, cb));
    p0 = __builtin_amdgcn_mfma_f32_32x32x16_bf16(b0, qr[d0], p0, 0, 0, 0);
    p1 = __builtin_amdgcn_mfma_f32_32x32x16_bf16(b1, qr[d0], p1, 0, 0, 0); }
}
__device__ __forceinline__ void pack_p(const f32x16& p0, const f32x16& p1, bf16x8& pa0, bf16x8& pa1, bf16x8& pa2, bf16x8& pa3) {
#define PK4(P, BASE, OUT) do { unsigned a0 = cvtpk(P[BASE + 0], P[BASE + 1]), a1 = cvtpk(P[BASE + 2], P[BASE + 3]);   \
    unsigned b0 = cvtpk(P[BASE + 4], P[BASE + 5]), b1 = cvtpk(P[BASE + 6], P[BASE + 7]);                              \
    auto r0 = __builtin_amdgcn_permlane32_swap(a0, b0, false, false); auto r1 = __builtin_amdgcn_permlane32_swap(a1, b1, false, false); \
    v4u w = {r0[0], r1[0], r0[1], r1[1]}; OUT = __builtin_bit_cast(bf16x8, w); } while (0)
  PK4(p0, 0, pa0); PK4(p0, 8, pa1); PK4(p1, 0, pa2); PK4(p1, 8, pa3);
#undef PK4
}
template <int D0> __device__ __forceinline__ void pv_one(f32x16& od, int vb, bf16x8 pa0, bf16x8 pa1, bf16x8 pa2, bf16x8 pa3) {
  const s16x4 l0 = tr_read<v_rd_off(D0, 0, 0)>(vb), h0 = tr_read<v_rd_off(D0, 0, 1)>(vb), l1 = tr_read<v_rd_off(D0, 1, 0)>(vb), h1 = tr_read<v_rd_off(D0, 1, 1)>(vb);
  const s16x4 l2 = tr_read<v_rd_off(D0, 2, 0)>(vb), h2 = tr_read<v_rd_off(D0, 2, 1)>(vb), l3 = tr_read<v_rd_off(D0, 3, 0)>(vb), h3 = tr_read<v_rd_off(D0, 3, 1)>(vb);
  asm volatile("s_waitcnt lgkmcnt(0)" ::: "memory"); SBAR();
#define PKV(L, H) (bf16x8){L[0], L[1], L[2], L[3], H[0], H[1], H[2], H[3]}
  od = __builtin_amdgcn_mfma_f32_32x32x16_bf16(pa0, PKV(l0, h0), od, 0, 0, 0);
  od = __builtin_amdgcn_mfma_f32_32x32x16_bf16(pa1, PKV(l1, h1), od, 0, 0, 0);
  od = __builtin_amdgcn_mfma_f32_32x32x16_bf16(pa2, PKV(l2, h2), od, 0, 0, 0);
  od = __builtin_amdgcn_mfma_f32_32x32x16_bf16(pa3, PKV(l3, h3), od, 0, 0, 0);
#undef PKV
}
__device__ __forceinline__ void pv_d0(f32x16* o, int vb, bf16x8 pa0, bf16x8 pa1, bf16x8 pa2, bf16x8 pa3) {
  pv_one<0>(o[0], vb, pa0, pa1, pa2, pa3); pv_one<1>(o[1], vb, pa0, pa1, pa2, pa3); pv_one<2>(o[2], vb, pa0, pa1, pa2, pa3); pv_one<3>(o[3], vb, pa0, pa1, pa2, pa3);
}
struct KVStage { bf16x8 ks0, ks1, vs0, vs1; };
__device__ __forceinline__ void kv_load(KVStage& s, const bf16* Kh, const bf16* Vh, long ldk, long ldv, int k0, int sr, int sc) {
  s.ks0 = *(const bf16x8*)(Kh + (long)(k0 + sr) * ldk + sc); s.ks1 = *(const bf16x8*)(Kh + (long)(k0 + 32 + sr) * ldk + sc);
  s.vs0 = *(const bf16x8*)(Vh + (long)(k0 + sr) * ldv + sc); s.vs1 = *(const bf16x8*)(Vh + (long)(k0 + 32 + sr) * ldv + sc);
}
__device__ __forceinline__ void kv_write(const KVStage& s, LAS char* lds, int sr, int sc) {
  *(LAS bf16x8*)(lds + ATT_V_OFF + v_st(sr, sc)) = s.vs0; *(LAS bf16x8*)(lds + ATT_V_OFF + v_st(32 + sr, sc)) = s.vs1;
  *(LAS bf16x8*)(lds + ATT_K_OFF + KSWZ(sr, sc * 2)) = s.ks0; *(LAS bf16x8*)(lds + ATT_K_OFF + KSWZ(32 + sr, sc * 2)) = s.ks1;
}
struct KVDma { int ko[2], vo[2]; };
__device__ __forceinline__ void kv_dma_init(KVDma& d, int ldk, int ldv, int wid, int lane) {
#pragma unroll
  for (int i = 0; i < 2; ++i) { const int p = wid * 2 + i;
    const int row = p * 4 + (lane >> 4), cp = lane & 15; d.ko[i] = row * ldk + ((cp ^ (row & 7)) << 3);
    const int sub = p * 2 + (lane >> 5), kk = (sub >> 2) * 8 + ((lane & 31) >> 2), k = (kk & ~0xC) | ((kk & 4) << 1) | ((kk & 8) >> 1), c = (sub & 3) * 32 + (lane & 3) * 8;
    d.vo[i] = k * ldv + c; }
}
__device__ __forceinline__ void kv_dma(const KVDma& d, const bf16* Kt, const bf16* Vt, LAS char* lds, int buf, int wid) {
#pragma unroll
  for (int i = 0; i < 2; ++i) {
    __builtin_amdgcn_global_load_lds((const unsigned*)(Kt + d.ko[i]), (LAS unsigned*)(lds + buf + ATT_K_OFF + (wid * 2 + i) * 1024), 16, 0, 0);
    __builtin_amdgcn_global_load_lds((const unsigned*)(Vt + d.vo[i]), (LAS unsigned*)(lds + buf + ATT_V_OFF + (wid * 2 + i) * 1024), 16, 0, 0); }
}
__device__ __forceinline__ void rescale_o(f32x16* o, float a, LAS float* al_l, int r32, int hi) {
  if (__any(a < 1.f)) { if (hi == 0) al_l[r32] = a; LDS_WAIT();
#pragma unroll
    for (int r = 0; r < 16; ++r) { const float f = al_l[crow(r, hi)];
#pragma unroll
      for (int d = 0; d < 4; ++d) o[d][r] *= f; }
    LDS_WAIT(); }
}
constexpr float ATT_SCALE = 0.088388347648318440f, ATT_C = ATT_SCALE * 1.4426950408889634f, ATT_THR = 8.f;
__device__ __forceinline__ void softmax_tile(f32x16& p0, f32x16& p1, float& m_reg, float& l_reg, float& alpha, bool rowvalid = true) {
  float pmax = p0[0];
#pragma unroll
  for (int r = 1; r < 16; ++r) pmax = fmaxf(pmax, p0[r]);
#pragma unroll
  for (int r = 0; r < 16; ++r) pmax = fmaxf(pmax, p1[r]);
  { auto rr = __builtin_amdgcn_permlane32_swap(__float_as_uint(pmax), __float_as_uint(pmax), false, false);
    pmax = fmaxf(__uint_as_float(rr[0]), __uint_as_float(rr[1])); }
  if (!rowvalid) pmax = -__builtin_inff();
  float mn;
  if (__all(pmax - m_reg <= ATT_THR / ATT_SCALE)) { mn = m_reg; alpha = 1.f; }
  else { mn = fmaxf(m_reg, pmax); alpha = __builtin_amdgcn_exp2f((m_reg - mn) * ATT_C); m_reg = mn; }
  const float mnC = rowvalid ? -mn * ATT_C : -__builtin_inff();
#pragma unroll
  for (int r = 0; r < 16; ++r) { p0[r] = __builtin_amdgcn_exp2f(fmaf(p0[r], ATT_C, mnC)); p1[r] = __builtin_amdgcn_exp2f(fmaf(p1[r], ATT_C, mnC)); }
  float ps = 0.f;
#pragma unroll
  for (int r = 0; r < 16; ++r) ps += p0[r] + p1[r];
  { auto rr = __builtin_amdgcn_permlane32_swap(__float_as_uint(ps), __float_as_uint(ps), false, false);
    ps = __uint_as_float(rr[0]) + __uint_as_float(rr[1]); }
  l_reg = l_reg * alpha + ps;
}
__device__ __forceinline__ void attn_finish(f32x16& p0, f32x16& p1, f32x16* o, float& m_reg, float& l_reg, LAS float* wsc, int vb, int r32, int hi, bool rowvalid = true) {
  float alpha; softmax_tile(p0, p1, m_reg, l_reg, alpha, rowvalid);
  rescale_o(o, alpha, wsc, r32, hi);
  bf16x8 pa0, pa1, pa2, pa3; pack_p(p0, p1, pa0, pa1, pa2, pa3);
  pv_d0(o, vb, pa0, pa1, pa2, pa3);
}
__device__ __forceinline__ void load_q(bf16x8* qr, const bf16* Qw) {
#pragma unroll
  for (int d0 = 0; d0 < 8; ++d0) qr[d0] = *(const bf16x8*)(Qw + d0 * 16);
}

struct Frame {
    LAS unsigned char* lds;
    unsigned char* ws;
    int tid, lane, wave, G, bid;
    __device__ __forceinline__ void fresh() { int t = threadIdx.x; asm volatile("" : "+v"(t)); tid = t; lane = t & 63; wave = __builtin_amdgcn_readfirstlane(t >> 6);
        int g_ = gridDim.x, b_ = blockIdx.x; asm volatile("" : "+s"(g_), "+s"(b_)); G = g_; bid = b_; }
};
struct Args { const float* in[19]; float* out; unsigned char* ws; int ph_lo, ph_hi; };
typedef const Args __attribute__((address_space(4))) KArgs;
__device__ __forceinline__ KArgs* karg() { KArgs* p = (KArgs*)__builtin_amdgcn_kernarg_segment_ptr(); asm volatile("" : "+s"(p)); return p; }
#define KIN(i) ((const float*)karg()->in[i])
enum { IN_X = 0, IN_MEM, IN_AB_W_IN, IN_HGRN_LB, IN_HGRN_NW, IN_AB_W_OUT, IN_NSA_W_IN, IN_NSA_CMP_POS, IN_NSA_CMP_W1, IN_NSA_CMP_W2, IN_NSA_W_OUT,
       IN_XA_WQ, IN_XA_WKV, IN_XA_WO, IN_FFN_UP, IN_FFN_CONV, IN_FFN_DOWN, IN_LN_G, IN_LN_B };

__device__ __forceinline__ void p0_transpose_item(const float* W, int K, int N, bf16* WT, LAS float* scr, int item, int lane) {
    const int nblk = N / 32, kb = item / nblk, nb = item % nblk, k0 = 64 * kb, n0 = 32 * nb;
#pragma unroll 8
    for (int i = 0; i < 32; ++i) { const int kk = 2 * i + (lane >> 5); scr[kk * 33 + (lane & 31)] = W[(size_t)(k0 + kk) * N + n0 + (lane & 31)]; }
    LDS_WAIT(); asm volatile("" ::: "memory");
    const int c = lane & 7;
#pragma unroll
    for (int j = 0; j < 4; ++j) { const int n = (lane >> 3) + 8 * j; const LAS float* s = scr + (8 * c) * 33 + n;
        v4u o; o.x = pk2(s[0 * 33], s[1 * 33]); o.y = pk2(s[2 * 33], s[3 * 33]); o.z = pk2(s[4 * 33], s[5 * 33]); o.w = pk2(s[6 * 33], s[7 * 33]);
        *(GAS v4u*)(WT + (size_t)(n0 + n) * K + k0 + 8 * c) = o; }
    LDS_WAIT(); asm volatile("" ::: "memory");
}
__device__ __forceinline__ int up_col(int n) { const int isu = n >= DFF, ch = isu ? n - DFF : n; return (ch >> 7) * 256 + isu * 128 + (ch & 127); }
__device__ __forceinline__ void p0_transpose_item_fold(const float* W, int K, int N, bf16* WT, LAS float* scr, int item, int lane, const float* g, const float* b, long long* cs, long long* b2, bool upmap = false) {
    const int nblk = N / 32, kb = item / nblk, nb = item % nblk, k0 = 64 * kb, n0 = 32 * nb, n0m = upmap ? up_col(n0) : n0;
#pragma unroll 8
    for (int i = 0; i < 32; ++i) { const int kk = 2 * i + (lane >> 5); scr[kk * 33 + (lane & 31)] = W[(size_t)(k0 + kk) * N + n0 + (lane & 31)]; }
    LDS_WAIT(); asm volatile("" ::: "memory");
    const int c = lane & 7;
    const f32x4 g0 = *(const f32x4*)(g + k0 + 8 * c), g1 = *(const f32x4*)(g + k0 + 8 * c + 4), b0 = *(const f32x4*)(b + k0 + 8 * c), b1 = *(const f32x4*)(b + k0 + 8 * c + 4);
    const float gg[8] = {g0.x, g0.y, g0.z, g0.w, g1.x, g1.y, g1.z, g1.w}, bb[8] = {b0.x, b0.y, b0.z, b0.w, b1.x, b1.y, b1.z, b1.w};
#pragma unroll
    for (int j = 0; j < 4; ++j) { const int n = (lane >> 3) + 8 * j; const LAS float* s = scr + (8 * c) * 33 + n;
        float sc = 0.f, sb = 0.f; unsigned w[4];
#pragma unroll
        for (int q = 0; q < 4; ++q) { const float x0 = s[(2 * q) * 33], x1 = s[(2 * q + 1) * 33]; const unsigned r0 = f2bf(x0 * gg[2 * q]), r1 = f2bf(x1 * gg[2 * q + 1]);
            w[q] = r0 | (r1 << 16); sc += bf2f((unsigned short)r0) + bf2f((unsigned short)r1); sb += x0 * bb[2 * q] + x1 * bb[2 * q + 1]; }
        *(GAS v4u*)(WT + (size_t)(n0m + n) * K + k0 + 8 * c) = (v4u){w[0], w[1], w[2], w[3]};
        sc += __shfl_xor(sc, 1); sc += __shfl_xor(sc, 2); sc += __shfl_xor(sc, 4); sb += __shfl_xor(sb, 1); sb += __shfl_xor(sb, 2); sb += __shfl_xor(sb, 4);
        if (c == 0) { atomicAdd((unsigned long long*)(cs + n0m + n), (unsigned long long)(long long)rintf(sc * pg8::FOLD_SCALE)); atomicAdd((unsigned long long*)(b2 + n0m + n), (unsigned long long)(long long)rintf(sb * pg8::FOLD_SCALE)); } }
    LDS_WAIT(); asm volatile("" ::: "memory");
}
__device__ __forceinline__ void transpose_mat_fold(Frame& F, const float* W, int K, int N, bf16* WT, const float* g, const float* b, long long* cs, long long* b2, int c0 = 0, int nw = 1 << 30, int part = 0, int nparts = 1, bool upmap = false) {
    if (F.bid < c0 || F.bid >= c0 + nw) return;
    LAS float* scr = (LAS float*)(F.lds + RING_OFF + F.wave * 16384);
    const int nwg = nw < F.G ? nw : F.G, gw = (F.bid - c0) * NWAVES + F.wave, NGW = nwg * NWAVES;
    const int nitems = (K / 64) * (N / 32), ilo = (int)((long)nitems * part / nparts), ihi = (int)((long)nitems * (part + 1) / nparts);
    for (int it = ilo + gw; it < ihi; it += NGW) p0_transpose_item_fold(W, K, N, WT, scr, it, F.lane, g, b, cs, b2, upmap);
}
__device__ __forceinline__ void transpose_mat(Frame& F, const float* W, int K, int N, bf16* WT, int c0 = 0, int nw = 1 << 30) {
    if (F.bid < c0 || F.bid >= c0 + nw) return;
    LAS float* scr = (LAS float*)(F.lds + RING_OFF + F.wave * 16384);
    const int nwg = nw < F.G ? nw : F.G, gw = (F.bid - c0) * NWAVES + F.wave, NGW = nwg * NWAVES;
    const int nitems = (K / 64) * (N / 32);
    for (int it = gw; it < nitems; it += NGW) p0_transpose_item(W, K, N, WT, scr, it, F.lane);
}
__device__ __forceinline__ void fold_finalize(Frame& F, int lo, int n) {
    const long long* fs = (const long long*)(F.ws + WS_FOLD); float* fd = (float*)(F.ws + WS_FOLDF);
    for (int i = F.bid * NTHR + F.tid; i < 2 * n; i += F.G * NTHR) { const int j = (i < n) ? lo + i : FO_N + lo + (i - n); const long long v = fs[j]; fd[j] = (float)(int)(v >> 32) + (float)(unsigned)v * pg8::FOLD_INV; }
}
enum { CJ_DOWN0, CJ_NSA, CJ_L1A, CJ_L1B, CJ_DOWN1 };
template <int JOB>
__device__ __forceinline__ void convert_job(Frame& F, const Args& A, int c0, int nw) {
    unsigned char* ws = F.ws; long long* cs = (long long*)(ws + WS_FOLD); long long* b2 = cs + FO_N;
    if (JOB == CJ_DOWN0 || JOB == CJ_DOWN1) { const int l = JOB == CJ_DOWN1; transpose_mat(F, KIN(IN_FFN_DOWN) + (size_t)l * DFF * DM, DFF, DM, (bf16*)(ws + WS_W_DOWN) + (size_t)l * DM * DFF, c0, nw); }
    if (JOB == CJ_NSA) {
        transpose_mat_fold(F, KIN(IN_NSA_W_IN), DM, NSA_IN, (bf16*)(ws + WS_W_NSAIN), KIN(IN_LN_G) + 2 * DM, KIN(IN_LN_B) + 2 * DM, cs + FO_NSA, b2 + FO_NSA, c0, nw);
        transpose_mat(F, KIN(IN_NSA_W_OUT), DM, DM, (bf16*)(ws + WS_W_NSAOUT), c0, nw); }
    if (JOB == CJ_L1A || JOB == CJ_L1B) { const int l = 1;
        if (JOB == CJ_L1A) {
            transpose_mat_fold(F, KIN(IN_XA_WQ) + (size_t)l * DM * XW, DM, XW, (bf16*)(ws + WS_W_XQ) + (size_t)l * XW * DM, KIN(IN_LN_G) + (size_t)(3 * l) * DM, KIN(IN_LN_B) + (size_t)(3 * l) * DM, cs + FO_XQ + l * XW, b2 + FO_XQ + l * XW, c0, nw);
            transpose_mat(F, KIN(IN_XA_WKV) + (size_t)l * DM * 2 * XW, DM, 2 * XW, (bf16*)(ws + WS_W_XKV) + (size_t)l * 2 * XW * DM, c0, nw);
            transpose_mat(F, KIN(IN_XA_WO) + (size_t)l * XW * DM, XW, DM, (bf16*)(ws + WS_W_XO) + (size_t)l * DM * XW, c0, nw); }
        transpose_mat_fold(F, KIN(IN_FFN_UP) + (size_t)l * DM * DFF2, DM, DFF2, (bf16*)(ws + WS_W_UP) + (size_t)l * DFF2 * DM, KIN(IN_LN_G) + (size_t)(3 * l + 1) * DM, KIN(IN_LN_B) + (size_t)(3 * l + 1) * DM,
                           cs + FO_UP + l * DFF2, b2 + FO_UP + l * DFF2, c0, nw, JOB == CJ_L1A ? 0 : 1, 2, true); }
}
__device__ __forceinline__ void cvt_flat(Frame& F, const float* src, bf16* dst, long n8) {
    for (long i = (long)F.bid * NTHR + F.tid; i < n8; i += (long)F.G * NTHR) {
        const f32x4 a = *(const f32x4*)(src + i * 8), b = *(const f32x4*)(src + i * 8 + 4);
        v4u o; o.x = pk2(a.x, a.y); o.y = pk2(a.z, a.w); o.z = pk2(b.x, b.y); o.w = pk2(b.z, b.w);
        *(v4u*)(dst + i * 8) = o; }
}
__device__ __forceinline__ void p0_prologue(Frame& F, const Args& A) {
    unsigned char* ws = F.ws;
    long long* cs = (long long*)(ws + WS_FOLD); long long* b2 = cs + FO_N;
    transpose_mat(F, KIN(IN_AB_W_IN), DM, AB_IN, (bf16*)(ws + WS_W_ABIN));
    transpose_mat(F, KIN(IN_AB_W_OUT), DM, DM, (bf16*)(ws + WS_W_ABOUT));
    { const int l = 0;
        transpose_mat_fold(F, KIN(IN_XA_WQ) + (size_t)l * DM * XW, DM, XW, (bf16*)(ws + WS_W_XQ) + (size_t)l * XW * DM, KIN(IN_LN_G) + (size_t)(3 * l) * DM, KIN(IN_LN_B) + (size_t)(3 * l) * DM, cs + FO_XQ + l * XW, b2 + FO_XQ + l * XW);
        transpose_mat(F, KIN(IN_XA_WKV) + (size_t)l * DM * 2 * XW, DM, 2 * XW, (bf16*)(ws + WS_W_XKV) + (size_t)l * 2 * XW * DM);
        transpose_mat(F, KIN(IN_XA_WO) + (size_t)l * XW * DM, XW, DM, (bf16*)(ws + WS_W_XO) + (size_t)l * DM * XW);
        transpose_mat_fold(F, KIN(IN_FFN_UP) + (size_t)l * DM * DFF2, DM, DFF2, (bf16*)(ws + WS_W_UP) + (size_t)l * DFF2 * DM, KIN(IN_LN_G) + (size_t)(3 * l + 1) * DM, KIN(IN_LN_B) + (size_t)(3 * l + 1) * DM, cs + FO_UP + l * DFF2, b2 + FO_UP + l * DFF2, 0, 1 << 30, 0, 1, true); }
    for (int l = 0; l < 2; ++l) {
        transpose_mat(F, KIN(IN_NSA_CMP_W1) + (size_t)l * 32 * HD * HD, 32 * HD, HD, (bf16*)(ws + WS_W_C1) + (size_t)l * HD * 32 * HD);
        transpose_mat(F, KIN(IN_NSA_CMP_W2) + (size_t)l * HD * HD, HD, HD, (bf16*)(ws + WS_W_C2) + (size_t)l * HD * HD);
    }
    cvt_flat(F, KIN(IN_X), (bf16*)(ws + WS_HB), (long)MTOK * DM / 8);
    cvt_flat(F, KIN(IN_MEM), (bf16*)(ws + WS_MEMB), (long)BATCH * NMEM * DM / 8);
    { v4u z = {0u, 0u, 0u, 0u}; v4u* p = (v4u*)((bf16*)(ws + WS_W_NSAIN) + (size_t)NSA_IN * DM); const long n = (long)(NSA_INP - NSA_IN) * DM / 8;
      for (long i = (long)F.bid * NTHR + F.tid; i < n; i += (long)F.G * NTHR) p[i] = z; }
    { float* tab = (float*)(ws + WS_ROPE);
      for (int i = F.bid * NTHR + F.tid; i < SEQ * 64; i += F.G * NTHR) { const int t = i >> 6, d = i & 63;
          float sn, cs; sincosf((float)t * powf(10000.0f, -(float)d * (1.0f / 64.0f)), &sn, &cs); tab[(size_t)t * 128 + d] = cs; tab[(size_t)t * 128 + 64 + d] = sn; } }
    { const float* lbp = KIN(IN_HGRN_LB); float* lbo = (float*)(ws + WS_LB);
      for (int i = F.bid * NTHR + F.tid; i < A_W; i += F.G * NTHR) { const float a = lbp[i], b = lbp[A_W + i], m = fmaxf(a, b), ea = __expf(a - m), eb = __expf(b - m); lbo[i] = ea / (ea + eb); } }
}

__device__ __forceinline__ void ln_phase(Frame& F, const bf16* Y, const float* g, const float* b, float* h32) {
    const int gw = F.bid * NWAVES + F.wave, NGW = F.G * NWAVES;
    for (int m = gw; m < MTOK; m += NGW) {
        const v4u* yr = (const v4u*)(Y + (size_t)m * DM) + F.lane;
        float v[8][8]; float s = 0.f;
#pragma unroll
        for (int j = 0; j < 8; ++j) { const v4u x = yr[64 * j];
            v[j][0] = bflo(x.x); v[j][1] = bfhi(x.x); v[j][2] = bflo(x.y); v[j][3] = bfhi(x.y); v[j][4] = bflo(x.z); v[j][5] = bfhi(x.z); v[j][6] = bflo(x.w); v[j][7] = bfhi(x.w);
#pragma unroll
            for (int q = 0; q < 8; ++q) s += v[j][q]; }
        const float mean = wave_sum(s) * (1.f / DM); float s2 = 0.f;
#pragma unroll
        for (int j = 0; j < 8; ++j)
#pragma unroll
            for (int q = 0; q < 8; ++q) { v[j][q] -= mean; s2 += v[j][q] * v[j][q]; }
        const float rstd = 1.f / sqrtf(wave_sum(s2) * (1.f / DM) + LN_EPS);
#pragma unroll
        for (int j = 0; j < 8; ++j) { const int c0 = 8 * F.lane + 512 * j;
            const f32x4 g0 = *(const f32x4*)(g + c0), g1 = *(const f32x4*)(g + c0 + 4), b0 = *(const f32x4*)(b + c0), b1 = *(const f32x4*)(b + c0 + 4);
            f32x4 r0, r1;
            r0.x = v[j][0] * rstd * g0.x + b0.x; r0.y = v[j][1] * rstd * g0.y + b0.y; r0.z = v[j][2] * rstd * g0.z + b0.z; r0.w = v[j][3] * rstd * g0.w + b0.w;
            r1.x = v[j][4] * rstd * g1.x + b1.x; r1.y = v[j][5] * rstd * g1.y + b1.y; r1.z = v[j][6] * rstd * g1.z + b1.z; r1.w = v[j][7] * rstd * g1.w + b1.w;
            *(f32x4*)(h32 + (size_t)m * DM + c0) = r0; *(f32x4*)(h32 + (size_t)m * DM + c0 + 4) = r1; }
    }
}

__device__ __forceinline__ void cg_unpack(const v4u x, float* o) { o[0] = bflo(x.x); o[1] = bfhi(x.x); o[2] = bflo(x.y); o[3] = bfhi(x.y); o[4] = bflo(x.z); o[5] = bfhi(x.z); o[6] = bflo(x.w); o[7] = bfhi(x.w); }
__device__ __forceinline__ void convglu_fixup_phase(Frame& F, const bf16* SIDE, const float* cw, bf16* Gm) {
    constexpr int NCG = DFF / 8, NRUN = MTOK / 128;
    for (int it = F.bid * NTHR + F.tid; it < NCG * NRUN; it += F.G * NTHR) {
        const int cg = it % NCG, run = it / NCG, c0 = cg * 8, t0 = run * 128;
        float w0[8], w1[8], w2[8], am2[8], am1[8], a0[8], a1[8], u0[8], u1[8];
#pragma unroll
        for (int j = 0; j < 8; ++j) { w0[j] = cw[c0 + j]; w1[j] = cw[DFF + c0 + j]; w2[j] = cw[2 * DFF + c0 + j]; }
        const bf16* sp = SIDE + (size_t)run * 6 * DFF + c0;
        if ((t0 & (SEQ - 1)) == 0) {
#pragma unroll
            for (int j = 0; j < 8; ++j) { am2[j] = 0.f; am1[j] = 0.f; }
        } else { cg_unpack(*(const v4u*)sp, am2); cg_unpack(*(const v4u*)(sp + DFF), am1); }
        cg_unpack(*(const v4u*)(sp + 2 * DFF), a0); cg_unpack(*(const v4u*)(sp + 3 * DFF), a1); cg_unpack(*(const v4u*)(sp + 4 * DFF), u0); cg_unpack(*(const v4u*)(sp + 5 * DFF), u1);
        unsigned o0[4], o1[4];
#pragma unroll
        for (int j = 0; j < 8; j += 2) {
            const pg8::f32x2 g0 = pg8::gelu_pk((pg8::f32x2){w2[j] * a0[j] + w1[j] * am1[j] + w0[j] * am2[j], w2[j + 1] * a0[j + 1] + w1[j + 1] * am1[j + 1] + w0[j + 1] * am2[j + 1]});
            const pg8::f32x2 g1 = pg8::gelu_pk((pg8::f32x2){w2[j] * a1[j] + w1[j] * a0[j] + w0[j] * am1[j], w2[j + 1] * a1[j + 1] + w1[j + 1] * a0[j + 1] + w0[j + 1] * am1[j + 1]});
            o0[j >> 1] = pk2(g0.x * u0[j], g0.y * u0[j + 1]); o1[j >> 1] = pk2(g1.x * u1[j], g1.y * u1[j + 1]); }
        *(v4u*)(Gm + (size_t)t0 * DFF + c0) = (v4u){o0[0], o0[1], o0[2], o0[3]}; *(v4u*)(Gm + (size_t)(t0 + 1) * DFF + c0) = (v4u){o1[0], o1[1], o1[2], o1[3]};
    }
}

__device__ __forceinline__ void xattn_phase(Frame& F, const bf16* XQ, const bf16* XKV, bf16* XO) {
    const int tid = F.tid, wid = F.wave, lane = F.lane, r32 = lane & 31, hi = lane >> 5;
    LAS char* lds = (LAS char*)F.lds;
    LAS float* wsc = (LAS float*)(lds + ATT_WS_OFF + wid * 256);
    const int vb0 = (int)(uintptr_t)(lds + ATT_V_OFF) + v_rd_base(lane);
    KVDma dm; kv_dma_init(dm, 2 * XW, 2 * XW, wid, lane);
    constexpr int NU = (MTOK / 256) * XH;
    for (int u = F.bid; u < NU; u += F.G) {
        const int head = u % XH, rbk = u / XH, row0 = rbk * 256, b = row0 / SEQ;
        const bf16* Kh = XKV + (size_t)b * NMEM * 2 * XW + head * HD; const bf16* Vh = Kh + XW;
        bf16x8 qr[8]; load_q(qr, XQ + (size_t)(row0 + wid * 32 + r32) * XW + head * HD + hi * 8);
        float m_reg = -1e30f, l_reg = 0.f; f32x16 o[4] = {};
        __syncthreads();
        kv_dma(dm, Kh, Vh, lds, 0, wid);
        for (int j = 0; j < NMEM / KVBLK; ++j) {
            const int buf = (j & 1) * ATT_BUF;
            VM_WAIT(); __syncthreads();
            if (j + 1 < NMEM / KVBLK) kv_dma(dm, Kh + (size_t)(j + 1) * KVBLK * 2 * XW, Vh + (size_t)(j + 1) * KVBLK * 2 * XW, lds, ATT_BUF - buf, wid);
            f32x16 p0, p1; qkt(p0, p1, lds + buf + ATT_K_OFF, qr, r32, hi);
            float alpha; softmax_tile(p0, p1, m_reg, l_reg, alpha);
            rescale_o(o, alpha, wsc, r32, hi);
            bf16x8 pa0, pa1, pa2, pa3; pack_p(p0, p1, pa0, pa1, pa2, pa3);
            pv_d0(o, vb0 + buf, pa0, pa1, pa2, pa3);
        }
        if (hi == 0) wsc[32 + r32] = l_reg; LDS_WAIT();
        bf16* Ow = XO + (size_t)(row0 + wid * 32) * XW + head * HD;
#pragma unroll
        for (int r = 0; r < 16; ++r) { const int orow = crow(r, hi); const float rl = __builtin_amdgcn_rcpf(wsc[32 + orow]);
#pragma unroll
            for (int d0 = 0; d0 < 4; ++d0) Ow[(size_t)orow * XW + d0 * 32 + r32] = (bf16)f2bf(o[d0][r] * rl); }
        LDS_WAIT();
    }
}

template <int K>
__device__ __forceinline__ f32x4 mma_tile(const LAS char* A, int lda, const LAS char* B, int ldb, int fr, int fq) {
    f32x4 acc = {0.f, 0.f, 0.f, 0.f};
#pragma unroll
    for (int k0 = 0; k0 < K; k0 += 32) {
        const bf16x8 a = *(const LAS bf16x8*)(A + fr * lda + (k0 + 8 * fq) * 2);
        const bf16x8 b = *(const LAS bf16x8*)(B + fr * ldb + (k0 + 8 * fq) * 2);
        acc = __builtin_amdgcn_mfma_f32_16x16x32_bf16(a, b, acc, 0, 0, 0);
    }
    return acc;
}
constexpr int HG_CH = 64, HG_NC = SEQ / HG_CH, HG_ITEMS = BATCH * A_HEADS * HG_NC;
constexpr int HG_QT = 0, HG_KT = 17408, HG_KH = 34816, HG_VT = 53248, HG_PT = 71680, HG_SEG = 80896;
constexpr int HG_SP = 17408, HG_OT = 52224;
constexpr int HG_WT = 80896, HG_KHS = 86016, HG_VS = 103424;
__device__ __forceinline__ void hgrn_phase_a(Frame& F, const bf16* P0, const float* lbv, bf16* QTg, bf16* OINTRA, bf16* DS, float* DEC) {
    LAS char* lds = (LAS char*)F.lds;
    const int tid = F.tid, wid = F.wave, lane = F.lane, fr = lane & 15, fq = lane >> 4;
    const int dg = tid & 15, sq = tid >> 4;
    const int d = tid & 127, sq16 = tid >> 7;
    for (int it = F.bid; it < HG_ITEMS; it += F.G) {
        const int c = it % HG_NC, bh = it / HG_NC, h = bh % A_HEADS, b = bh / A_HEADS;
        const size_t row0 = (size_t)b * SEQ + (size_t)c * HG_CH;
        float lb[8], q[2][8], kk[2][8], cum[2][8]; v4u vraw[2];
        { const f32x4 l0 = *(const f32x4*)(lbv + h * HD + 8 * dg), l1 = *(const f32x4*)(lbv + h * HD + 8 * dg + 4);
          lb[0] = l0.x; lb[1] = l0.y; lb[2] = l0.z; lb[3] = l0.w; lb[4] = l1.x; lb[5] = l1.y; lb[6] = l1.z; lb[7] = l1.w; }
#pragma unroll
        for (int rr = 0; rr < 2; ++rr) { const bf16* rowp = P0 + (row0 + 2 * sq + rr) * AB_IN + h * HD + 8 * dg;
            const v4u zq = *(const v4u*)(rowp + A_W), qq = *(const v4u*)rowp; vraw[rr] = *(const v4u*)(rowp + 2 * A_W);
            const unsigned zw[4] = {zq.x, zq.y, zq.z, zq.w}, qw[4] = {qq.x, qq.y, qq.z, qq.w};
#pragma unroll
            for (int j = 0; j < 8; ++j) { const float z = (j & 1) ? bfhi(zw[j >> 1]) : bflo(zw[j >> 1]); q[rr][j] = (j & 1) ? bfhi(qw[j >> 1]) : bflo(qw[j >> 1]);
                const float sg = sigmoidf_(z), omlb = 1.f - lb[j]; kk[rr][j] = omlb * (1.f - sg);
                const float lf = __logf(lb[j] + omlb * sg); cum[rr][j] = rr ? cum[0][j] + lf : lf; } }
        float pre[8];
#pragma unroll
        for (int j = 0; j < 8; ++j) { const float seg = cum[1][j]; float x = seg; const float t1 = __shfl_up(x, 16); if (lane >= 16) x += t1; const float t2 = __shfl_up(x, 32); if (lane >= 32) x += t2;
            pre[j] = x - seg; if (lane >= 48) ((LAS float*)(lds + HG_WT))[wid * 128 + 8 * dg + j] = x; }
        LDS_WAIT(); __syncthreads();
        float total[8];
#pragma unroll
        for (int j = 0; j < 8; ++j) total[j] = 0.f;
#pragma unroll
        for (int w = 0; w < NWAVES; ++w) { const f32x4 a0 = *(const LAS f32x4*)(lds + HG_WT + (w * 128 + 8 * dg) * 4), a1 = *(const LAS f32x4*)(lds + HG_WT + (w * 128 + 8 * dg + 4) * 4);
            const float av[8] = {a0.x, a0.y, a0.z, a0.w, a1.x, a1.y, a1.z, a1.w};
#pragma unroll
            for (int j = 0; j < 8; ++j) { total[j] += av[j]; if (w < wid) pre[j] += av[j]; } }
#pragma unroll
        for (int rr = 0; rr < 2; ++rr) { const int s = 2 * sq + rr; unsigned qt[4], kt[4], kh[4];
#pragma unroll
            for (int j = 0; j < 8; j += 2) { const float b0 = pre[j] + cum[rr][j], b1 = pre[j + 1] + cum[rr][j + 1];
                qt[j >> 1] = pk2(q[rr][j] * __expf(b0), q[rr][j + 1] * __expf(b1));
                kt[j >> 1] = pk2(kk[rr][j] * __expf(-b0), kk[rr][j + 1] * __expf(-b1));
                kh[j >> 1] = pk2(kk[rr][j] * __expf(total[j] - b0), kk[rr][j + 1] * __expf(total[j + 1] - b1)); }
            const v4u qv = {qt[0], qt[1], qt[2], qt[3]};
            *(LAS v4u*)(lds + HG_QT + s * 272 + dg * 16) = qv; *(v4u*)(QTg + (row0 + s) * A_W + h * HD + 8 * dg) = qv;
            *(LAS v4u*)(lds + HG_KT + s * 272 + dg * 16) = (v4u){kt[0], kt[1], kt[2], kt[3]};
            *(LAS v4u*)(lds + HG_KHS + s * 272 + dg * 16) = (v4u){kh[0], kh[1], kh[2], kh[3]};
            *(LAS v4u*)(lds + HG_VS + s * 272 + dg * 16) = vraw[rr]; }
        if (sq == 31) { f32x4 e0, e1; e0.x = __expf(total[0]); e0.y = __expf(total[1]); e0.z = __expf(total[2]); e0.w = __expf(total[3]); e1.x = __expf(total[4]); e1.y = __expf(total[5]); e1.z = __expf(total[6]); e1.w = __expf(total[7]);
            *(f32x4*)(DEC + (size_t)it * HD + 8 * dg) = e0; *(f32x4*)(DEC + (size_t)it * HD + 8 * dg + 4) = e1; }
        LDS_WAIT(); __syncthreads();
        { unsigned kh[8], vt[8];
#pragma unroll
          for (int j = 0; j < 16; j += 2) { const int s = 16 * sq16 + j;
              kh[j >> 1] = (unsigned)*(const LAS unsigned short*)(lds + HG_KHS + s * 272 + d * 2) | ((unsigned)*(const LAS unsigned short*)(lds + HG_KHS + (s + 1) * 272 + d * 2) << 16);
              vt[j >> 1] = (unsigned)*(const LAS unsigned short*)(lds + HG_VS + s * 272 + d * 2) | ((unsigned)*(const LAS unsigned short*)(lds + HG_VS + (s + 1) * 272 + d * 2) << 16); }
          LAS v4u* pk = (LAS v4u*)(lds + HG_KH + d * 144 + sq16 * 32); pk[0] = (v4u){kh[0], kh[1], kh[2], kh[3]}; pk[1] = (v4u){kh[4], kh[5], kh[6], kh[7]};
          LAS v4u* pv = (LAS v4u*)(lds + HG_VT + d * 144 + sq16 * 32); pv[0] = (v4u){vt[0], vt[1], vt[2], vt[3]}; pv[1] = (v4u){vt[4], vt[5], vt[6], vt[7]}; }
        LDS_WAIT(); __syncthreads();
#pragma unroll
        for (int k = 0; k < 2; ++k) { const int tau = 2 * wid + k, ti = tau >> 2, si = tau & 3;
            f32x4 acc = {0.f, 0.f, 0.f, 0.f};
            if (si <= ti) acc = mma_tile<128>(lds + HG_QT + ti * 16 * 272, 272, lds + HG_KT + si * 16 * 272, 272, fr, fq);
#pragma unroll
            for (int i = 0; i < 4; ++i) { const int t = 16 * ti + 4 * fq + i, s = 16 * si + fr; const float v = (s <= t) ? acc[i] : 0.f;
                *(LAS unsigned short*)(lds + HG_PT + t * 144 + s * 2) = (unsigned short)f2bf(v); } }
        LDS_WAIT(); __syncthreads();
#pragma unroll
        for (int k = 0; k < 4; ++k) { const int tau = wid + 8 * k, ti = tau >> 3, vi = tau & 7;
            const f32x4 acc = mma_tile<64>(lds + HG_VT + vi * 16 * 144, 144, lds + HG_PT + ti * 16 * 144, 144, fr, fq);
            v2u w; w.x = pk2(acc[0], acc[1]); w.y = pk2(acc[2], acc[3]);
            *(v2u*)(OINTRA + (row0 + 16 * ti + fr) * A_W + h * HD + 16 * vi + 4 * fq) = w; }
#pragma unroll
        for (int k = 0; k < 8; ++k) { const int tau = wid + 8 * k, vi = tau >> 3, ki = tau & 7;
            const f32x4 acc = mma_tile<64>(lds + HG_KH + ki * 16 * 144, 144, lds + HG_VT + vi * 16 * 144, 144, fr, fq);
            v2u w; w.x = pk2(acc[0], acc[1]); w.y = pk2(acc[2], acc[3]);
            *(v2u*)(DS + ((size_t)it * HD + 16 * vi + fr) * HD + 16 * ki + 4 * fq) = w; }
        LDS_WAIT(); __syncthreads();
    }
}
__device__ __forceinline__ void hgrn_phase_b(Frame& F, const bf16* DS, const float* DEC, bf16* SPREV) {
    const int tid = F.tid, dvl = tid >> 5, dk4 = (tid & 31) * 4;
    for (int item = F.bid; item < BATCH * A_HEADS * 8; item += F.G) {
        const int sl = item & 7, bh = item >> 3, dv = sl * 16 + dvl;
        f32x4 S = {0.f, 0.f, 0.f, 0.f};
        for (int c0 = 0; c0 < HG_NC; c0 += 8) {
            f32x4 ds[8], dc[8];
#pragma unroll
            for (int k = 0; k < 8; ++k) { const size_t it = (size_t)bh * HG_NC + c0 + k; const v2u x = *(const v2u*)(DS + (it * HD + dv) * HD + dk4);
                ds[k] = (f32x4){bflo(x.x), bfhi(x.x), bflo(x.y), bfhi(x.y)}; dc[k] = *(const f32x4*)(DEC + it * HD + dk4); }
#pragma unroll
            for (int k = 0; k < 8; ++k) { const size_t it = (size_t)bh * HG_NC + c0 + k;
                v2u w; w.x = pk2(S.x, S.y); w.y = pk2(S.z, S.w); *(v2u*)(SPREV + (it * HD + dv) * HD + dk4) = w;
                S = S * dc[k] + ds[k]; }
        }
    }
}
__device__ __forceinline__ void hgrn_phase_c(Frame& F, const bf16* P0, const bf16* QTg, const bf16* OINTRA, const bf16* SPREV, const float* nw, bf16* Ob) {
    LAS char* lds = (LAS char*)F.lds;
    const int tid = F.tid, wid = F.wave, lane = F.lane, fr = lane & 15, fq = lane >> 4;
    for (int it = F.bid; it < HG_ITEMS; it += F.G) {
        const int c = it % HG_NC, bh = it / HG_NC, h = bh % A_HEADS, b = bh / A_HEADS;
        const size_t row0 = (size_t)b * SEQ + (size_t)c * HG_CH;
        { const int s = tid >> 3, ch = (tid & 7) * 16; const bf16* src = QTg + (row0 + s) * A_W + h * HD + ch;
          const v4u x0 = *(const v4u*)src, x1 = *(const v4u*)(src + 8); LAS v4u* dst = (LAS v4u*)(lds + HG_QT + s * 272 + ch * 2); dst[0] = x0; dst[1] = x1; }
        { const int dv = tid >> 2, ch = (tid & 3) * 32; const bf16* src = SPREV + ((size_t)it * HD + dv) * HD + ch;
          const v4u x0 = *(const v4u*)src, x1 = *(const v4u*)(src + 8), x2 = *(const v4u*)(src + 16), x3 = *(const v4u*)(src + 24);
          LAS v4u* dst = (LAS v4u*)(lds + HG_SP + dv * 272 + ch * 2); dst[0] = x0; dst[1] = x1; dst[2] = x2; dst[3] = x3; }
        LDS_WAIT(); __syncthreads();
#pragma unroll
        for (int k = 0; k < 4; ++k) { const int tau = wid + 8 * k, ti = tau >> 3, vi = tau & 7;
            const f32x4 acc = mma_tile<128>(lds + HG_SP + vi * 16 * 272, 272, lds + HG_QT + ti * 16 * 272, 272, fr, fq);
            const int t = 16 * ti + fr, dv = 16 * vi + 4 * fq; const v2u oi = *(const v2u*)(OINTRA + (row0 + t) * A_W + h * HD + dv);
            *(LAS f32x4*)(lds + HG_OT + (t * 132 + dv) * 4) = (f32x4){acc[0] + bflo(oi.x), acc[1] + bfhi(oi.x), acc[2] + bflo(oi.y), acc[3] + bfhi(oi.y)}; }
        LDS_WAIT(); __syncthreads();
        { const int t = tid >> 3, dv0 = (tid & 7) * 16;
          float v[16]; float ss = 0.f;
#pragma unroll
          for (int q4 = 0; q4 < 4; ++q4) { const f32x4 x = *(const LAS f32x4*)(lds + HG_OT + (t * 132 + dv0 + 4 * q4) * 4); v[4 * q4] = x.x; v[4 * q4 + 1] = x.y; v[4 * q4 + 2] = x.z; v[4 * q4 + 3] = x.w;
              ss += (x.x * x.x + x.y * x.y) + (x.z * x.z + x.w * x.w); }
          ss += __shfl_xor(ss, 1); ss += __shfl_xor(ss, 2); ss += __shfl_xor(ss, 4);
          const float r = 1.f / sqrtf(ss * (1.f / HD) + RMS_EPS);
          const bf16* gp = P0 + (row0 + t) * AB_IN + 3 * A_W + h * HD + dv0; const v4u g0 = *(const v4u*)gp, g1 = *(const v4u*)(gp + 8);
          const unsigned gw[8] = {g0.x, g0.y, g0.z, g0.w, g1.x, g1.y, g1.z, g1.w}; unsigned o[8];
#pragma unroll
          for (int j = 0; j < 8; ++j) { const float ga = bflo(gw[j]), gb = bfhi(gw[j]);
              o[j] = pk2(v[2 * j] * r * nw[dv0 + 2 * j] * ga * sigmoidf_(ga), v[2 * j + 1] * r * nw[dv0 + 2 * j + 1] * gb * sigmoidf_(gb)); }
          bf16* op = Ob + (row0 + t) * DM + h * HD + dv0; *(v4u*)op = (v4u){o[0], o[1], o[2], o[3]}; *(v4u*)(op + 8) = (v4u){o[4], o[5], o[6], o[7]}; }
        LDS_WAIT(); __syncthreads();
    }
}

constexpr float SB_CUT = -160.f;
__device__ __forceinline__ void sb_phase(Frame& F, const bf16* P0, bf16* Ob) {
    const int tid = F.tid, wid = F.wave, lane = F.lane, r32 = lane & 31, hi = lane >> 5;
    LAS char* lds = (LAS char*)F.lds;
    const int vb0 = (int)(uintptr_t)(lds + ATT_V_OFF) + v_rd_base(lane);
    KVDma dm; kv_dma_init(dm, AB_IN, AB_IN, wid, lane);
    constexpr int NQB = SEQ / 256, NU = BATCH * B_HEADS * NQB;
    for (int rd = 0; ; ++rd) {
        const int idx = (rd & 1) ? rd * F.G + (F.G - 1 - F.bid) : rd * F.G + F.bid;
        if (rd * F.G >= NU) break;
        if (idx >= NU) continue;
        const int qb = NQB - 1 - idx / (BATCH * B_HEADS), bh = idx % (BATCH * B_HEADS), head = bh % B_HEADS, b = bh / B_HEADS;
        const size_t rowb = (size_t)b * SEQ; const int q0 = qb * 256;
        const bf16* Kh = P0 + rowb * AB_IN + 4 * A_W + B_W + head * HD; const bf16* Vh = Kh + B_W;
        const int tw0 = q0 + wid * 32, t = tw0 + r32;
        bf16x8 qr[8]; load_q(qr, P0 + (rowb + t) * AB_IN + 4 * A_W + head * HD + hi * 8);
        float R = 0.f; f32x16 o[4] = {};
        const int jtop = (q0 + 254) >> 6;
        LAS unsigned* dflag = (LAS unsigned*)(lds + ATT_X_OFF);
        if (lane == 0) { dflag[wid] = 0u; dflag[8 + wid] = 0u; }
        LDS_WAIT(); __syncthreads();
        kv_dma(dm, Kh + (size_t)jtop * KVBLK * AB_IN, Vh + (size_t)jtop * KVBLK * AB_IN, lds, 0, wid);
        int buf = 0;
        for (int j = jtop; j >= 0; --j, buf = ATT_BUF - buf) {
            VM_WAIT(); __syncthreads();
            { unsigned alld = 1u;
#pragma unroll
              for (int w = 0; w < NWAVES; ++w) alld &= dflag[((j + 1) & 1) * 8 + w];
              if (__builtin_amdgcn_readfirstlane(alld)) break; }
            if (j > 0) kv_dma(dm, Kh + (size_t)(j - 1) * KVBLK * AB_IN, Vh + (size_t)(j - 1) * KVBLK * AB_IN, lds, ATT_BUF - buf, wid);
            const int k0 = j * KVBLK;
            if (k0 < tw0 + 31) {
                f32x16 p0, p1; qkt(p0, p1, lds + buf + ATT_K_OFF, qr, r32, hi);
                const bool need_mask = (k0 + 63 >= tw0);
                float L0[16], L1[16];
#pragma unroll
                for (int r = 0; r < 16; ++r) {
                    const float z0 = p0[r] * ATT_C, z1 = p1[r] * ATT_C;
                    float l0 = -(fmaxf(z0, 0.f) + __builtin_amdgcn_logf(1.f + __builtin_amdgcn_exp2f(-fabsf(z0))));
                    float l1 = -(fmaxf(z1, 0.f) + __builtin_amdgcn_logf(1.f + __builtin_amdgcn_exp2f(-fabsf(z1))));
                    if (need_mask) { if (k0 + crow(r, hi) >= t) l0 = 0.f; if (k0 + 32 + crow(r, hi) >= t) l1 = 0.f; }
                    L0[r] = l0; L1[r] = l1; p0[r] = z0 + l0; p1[r] = z1 + l1;
                }
                SBAR();
                float Sg[16];
#pragma unroll
                for (int gi = 0; gi < 4; ++gi) {
                    const float a = (L0[4 * gi] + L0[4 * gi + 1]) + (L0[4 * gi + 2] + L0[4 * gi + 3]), c = (L1[4 * gi] + L1[4 * gi + 1]) + (L1[4 * gi + 2] + L1[4 * gi + 3]);
                    auto ra = __builtin_amdgcn_permlane32_swap(__float_as_uint(a), __float_as_uint(a), false, false);
                    auto rc = __builtin_amdgcn_permlane32_swap(__float_as_uint(c), __float_as_uint(c), false, false);
                    Sg[2 * gi] = __uint_as_float(ra[0]); Sg[2 * gi + 1] = __uint_as_float(ra[1]); Sg[8 + 2 * gi] = __uint_as_float(rc[0]); Sg[8 + 2 * gi + 1] = __uint_as_float(rc[1]);
                }
                float run = R;
#pragma unroll
                for (int s = 15; s >= 0; --s) { const float tt = run; run += Sg[s]; Sg[s] = tt; }
                const float Rn = run;
                SBAR();
#pragma unroll
                for (int gi = 0; gi < 4; ++gi) {
                    float base0 = hi ? Sg[2 * gi + 1] : Sg[2 * gi], base1 = hi ? Sg[8 + 2 * gi + 1] : Sg[8 + 2 * gi];
                    float r3 = base0, r2 = r3 + L0[4 * gi + 3], r1 = r2 + L0[4 * gi + 2], r0 = r1 + L0[4 * gi + 1];
                    p0[4 * gi + 3] = __builtin_amdgcn_exp2f(p0[4 * gi + 3] + r3); p0[4 * gi + 2] = __builtin_amdgcn_exp2f(p0[4 * gi + 2] + r2);
                    p0[4 * gi + 1] = __builtin_amdgcn_exp2f(p0[4 * gi + 1] + r1); p0[4 * gi + 0] = __builtin_amdgcn_exp2f(p0[4 * gi + 0] + r0);
                    r3 = base1; r2 = r3 + L1[4 * gi + 3]; r1 = r2 + L1[4 * gi + 2]; r0 = r1 + L1[4 * gi + 1];
                    p1[4 * gi + 3] = __builtin_amdgcn_exp2f(p1[4 * gi + 3] + r3); p1[4 * gi + 2] = __builtin_amdgcn_exp2f(p1[4 * gi + 2] + r2);
                    p1[4 * gi + 1] = __builtin_amdgcn_exp2f(p1[4 * gi + 1] + r1); p1[4 * gi + 0] = __builtin_amdgcn_exp2f(p1[4 * gi + 0] + r0);
                }
                R = Rn;
                { const unsigned dn = __all(R < SB_CUT) ? 1u : 0u; if (lane == 0) dflag[(j & 1) * 8 + wid] = dn; }
                if (need_mask) {
#pragma unroll
                    for (int r = 0; r < 16; ++r) { if (k0 + crow(r, hi) >= t) p0[r] = 0.f; if (k0 + 32 + crow(r, hi) >= t) p1[r] = 0.f; }
                }
                bf16x8 pa0, pa1, pa2, pa3; pack_p(p0, p1, pa0, pa1, pa2, pa3);
                pv_d0(o, vb0 + buf, pa0, pa1, pa2, pa3);
            }
        }
        bf16* Ow = Ob + (rowb + tw0) * DM + A_W + head * HD;
#pragma unroll
        for (int r = 0; r < 16; ++r) { const int orow = crow(r, hi);
#pragma unroll
            for (int d0 = 0; d0 < 4; ++d0) Ow[(size_t)orow * DM + d0 * 32 + r32] = (bf16)f2bf(o[d0][r]); }
    }
}

constexpr int P1_KC = 4096, P1_VC = 4608, P1_KS = 5120, P1_VS = 5632, P1_KW = 6144, P1_VW = 6656, P1_GL = 7168;
__device__ __forceinline__ void nsa_rope_phase(Frame& F, const bf16* P1, const float* TAB, bf16* QROT, bf16* KSROT, bf16* KWROT, bf16* OVL) {
    const int gw = F.bid * NWAVES + F.wave, NGW = F.G * NWAVES, lane = F.lane, hsub = lane >> 3, d0 = (lane & 7) * 8;
    for (int m = gw; m < MTOK; m += NGW) {
        const int t = m & (SEQ - 1);
        const f32x4 c0 = *(const f32x4*)(TAB + (size_t)t * 128 + d0), c1 = *(const f32x4*)(TAB + (size_t)t * 128 + d0 + 4);
        const f32x4 s0 = *(const f32x4*)(TAB + (size_t)t * 128 + 64 + d0), s1 = *(const f32x4*)(TAB + (size_t)t * 128 + 64 + d0 + 4);
        const float cs[8] = {c0.x, c0.y, c0.z, c0.w, c1.x, c1.y, c1.z, c1.w}, sn[8] = {s0.x, s0.y, s0.z, s0.w, s1.x, s1.y, s1.z, s1.w};
        const bf16* row = P1 + (size_t)m * NSA_INP;
#pragma unroll
        for (int hb = 0; hb < 5; ++hb) {
            const int hh = hb * 8 + hsub;
            const bf16* src; bf16* dst;
            if (hh < 32) { src = row + hh * HD; dst = QROT + (size_t)m * DM + hh * HD; }
            else if (hh < 36) { src = row + P1_KS + (hh - 32) * HD; dst = KSROT + (size_t)m * KVW + (hh - 32) * HD; }
            else { src = row + P1_KW + (hh - 36) * HD; dst = KWROT + (size_t)m * KVW + (hh - 36) * HD; }
            const v4u a = *(const v4u*)(src + d0), bq = *(const v4u*)(src + 64 + d0);
            const unsigned aw[4] = {a.x, a.y, a.z, a.w}, bw[4] = {bq.x, bq.y, bq.z, bq.w}; unsigned o1[4], o2[4];
#pragma unroll
            for (int q = 0; q < 4; ++q) { const float x1l = bflo(aw[q]), x1h = bfhi(aw[q]), x2l = bflo(bw[q]), x2h = bfhi(bw[q]);
                o1[q] = pk2(x1l * cs[2 * q] - x2l * sn[2 * q], x1h * cs[2 * q + 1] - x2h * sn[2 * q + 1]);
                o2[q] = pk2(x2l * cs[2 * q] + x1l * sn[2 * q], x2h * cs[2 * q + 1] + x1h * sn[2 * q + 1]); }
            *(v4u*)(dst + d0) = (v4u){o1[0], o1[1], o1[2], o1[3]}; *(v4u*)(dst + 64 + d0) = (v4u){o2[0], o2[1], o2[2], o2[3]};
        }
    }
    for (int i = F.bid * NTHR + F.tid; i < NCMPP * NSLC; i += F.G * NTHR) { const int n = i / NSLC, j = i % NSLC;
        OVL[i] = (n < NCMP && n >= 4 * j - 1 && n <= 4 * j + 3) ? (bf16)0x3f80u : (bf16)0u; }
}
constexpr int CM_A = 0, CM_B = 17408, CM_H = 17408 + 34816;
__device__ __forceinline__ void nsa_compress_phase(Frame& F, const bf16* P1, const float* pos, const bf16* W1t, const bf16* W2t, bf16* KCMP, bf16* VCMP) {
    LAS char* lds = (LAS char*)F.lds;
    const int tid = F.tid, wid = F.wave, lane = F.lane, fr = lane & 15, fq = lane >> 4;
    for (int item = F.bid; item < 128; item += F.G) {
        const int nt = item & 7, g = (item >> 3) & 3, b = (item >> 5) & 1, which = item >> 6;
        const bf16* w1 = W1t + (size_t)which * HD * 32 * HD; const bf16* w2 = W2t + (size_t)which * HD * HD;
        const float* posw = pos + (size_t)which * 32 * HD;
        f32x4 acc[4];
#pragma unroll
        for (int k = 0; k < 4; ++k) acc[k] = (f32x4){0.f, 0.f, 0.f, 0.f};
        for (int l = 0; l < 32; ++l) {
            { const int r = tid >> 3, ch = (tid & 7) * 16, n = nt * 64 + r; unsigned w[8];
              if (n < NCMP) { const bf16* src = P1 + ((size_t)b * SEQ + 16 * n + l) * NSA_INP + P1_KC + which * KVW + g * HD + ch;
                  const v4u x0 = *(const v4u*)src, x1 = *(const v4u*)(src + 8); const unsigned xs[8] = {x0.x, x0.y, x0.z, x0.w, x1.x, x1.y, x1.z, x1.w};
#pragma unroll
                  for (int q = 0; q < 8; ++q) w[q] = pk2(bflo(xs[q]) + posw[l * HD + ch + 2 * q], bfhi(xs[q]) + posw[l * HD + ch + 2 * q + 1]);
              } else {
#pragma unroll
                  for (int q = 0; q < 8; ++q) w[q] = 0u; }
              LAS v4u* dst = (LAS v4u*)(lds + CM_A + r * 272 + ch * 2); dst[0] = (v4u){w[0], w[1], w[2], w[3]}; dst[1] = (v4u){w[4], w[5], w[6], w[7]}; }
            { const int e = tid >> 2, ch = (tid & 3) * 32; const bf16* src = w1 + (size_t)e * 32 * HD + l * HD + ch;
              const v4u x0 = *(const v4u*)src, x1 = *(const v4u*)(src + 8), x2 = *(const v4u*)(src + 16), x3 = *(const v4u*)(src + 24);
              LAS v4u* dst = (LAS v4u*)(lds + CM_B + e * 272 + ch * 2); dst[0] = x0; dst[1] = x1; dst[2] = x2; dst[3] = x3; }
            LDS_WAIT(); __syncthreads();
#pragma unroll
            for (int k = 0; k < 4; ++k) { const int tau = wid + 8 * k, ni = tau >> 3, ei = tau & 7;
                acc[k] += mma_tile<128>(lds + CM_A + ni * 16 * 272, 272, lds + CM_B + ei * 16 * 272, 272, fr, fq); }
            LDS_WAIT(); __syncthreads();
        }
#pragma unroll
        for (int k = 0; k < 4; ++k) { const int tau = wid + 8 * k, ni = tau >> 3, ei = tau & 7;
#pragma unroll
            for (int i = 0; i < 4; ++i) *(LAS unsigned short*)(lds + CM_H + (16 * ni + 4 * fq + i) * 272 + (16 * ei + fr) * 2) = (unsigned short)f2bf(gelu1(acc[k][i])); }
        { const int f = tid >> 2, ch = (tid & 3) * 32; const bf16* src = w2 + (size_t)f * HD + ch;
          const v4u x0 = *(const v4u*)src, x1 = *(const v4u*)(src + 8), x2 = *(const v4u*)(src + 16), x3 = *(const v4u*)(src + 24);
          LAS v4u* dst = (LAS v4u*)(lds + CM_B + f * 272 + ch * 2); dst[0] = x0; dst[1] = x1; dst[2] = x2; dst[3] = x3; }
        LDS_WAIT(); __syncthreads();
        bf16* outp = which ? VCMP : KCMP;
#pragma unroll
        for (int k = 0; k < 4; ++k) { const int tau = wid + 8 * k, ni = tau >> 3, fi = tau & 7;
            const f32x4 a2 = mma_tile<128>(lds + CM_H + ni * 16 * 272, 272, lds + CM_B + fi * 16 * 272, 272, fr, fq);
#pragma unroll
            for (int i = 0; i < 4; ++i) { const int n = nt * 64 + 16 * ni + 4 * fq + i;
                outp[(((size_t)b * NCMPP + n) * NSA_G + g) * HD + 16 * fi + fr] = (n < NCMP) ? (bf16)f2bf(a2[i]) : (bf16)0u; } }
        LDS_WAIT(); __syncthreads();
    }
}
__device__ __forceinline__ unsigned pick4(const unsigned (&a)[4], int i) { return i == 0 ? a[0] : (i == 1 ? a[1] : (i == 2 ? a[2] : a[3])); }
template <int MODE>
__device__ __forceinline__ void nsa_attn_phase(Frame& F, const bf16* P1, const bf16* Qsrc, const bf16* Ksrc, const bf16* Vsrc, const unsigned* SEL, float* O32, float* IMP, bf16* Ob, bool probe_nostore = false) {
    const int tid = F.tid, wid = F.wave, lane = F.lane, r32 = lane & 31, hi = lane >> 5;
    LAS char* lds = (LAS char*)F.lds;
    LAS float* wsc = (LAS float*)(lds + ATT_WS_OFF + wid * 256);
    const int vb0 = (int)(uintptr_t)(lds + ATT_V_OFF) + v_rd_base(lane);
    KVDma dm; kv_dma_init(dm, MODE <= 1 ? NSA_G * HD : KVW, MODE == 0 ? NSA_G * HD : (MODE == 1 ? NSLC : NSA_INP), wid, lane);
    constexpr int NTB = SEQ / 32, NU = BATCH * NSA_G * NTB;
    for (int rd = 0; ; ++rd) {
        int idx;
        { idx = (rd & 1) ? rd * F.G + (F.G - 1 - F.bid) : rd * F.G + F.bid; if (rd * F.G >= NU) break; if (idx >= NU) continue; }
        const int tb = NTB - 1 - idx / (BATCH * NSA_G), bg = idx % (BATCH * NSA_G), g = bg % NSA_G, b = bg / NSA_G;
        const size_t rowb = (size_t)b * SEQ; const int t0 = tb * 32;
        const int t = (MODE == 2) ? t0 + 4 * wid + (r32 >> 3) : t0 + r32, head = (MODE == 2) ? g * NSA_R + (r32 & 7) : g * NSA_R + wid;
        const bf16* Kh; const bf16* Vh; long ldk, ldv; int jlo, jhi;
        if (MODE <= 1) { Kh = Ksrc + ((size_t)b * NCMPP * NSA_G + g) * HD; ldk = NSA_G * HD; jlo = 0; jhi = (t0 >> 4) >> 6;
            if (MODE == 0) { Vh = Vsrc + ((size_t)b * NCMPP * NSA_G + g) * HD; ldv = NSA_G * HD; } else { Vh = Vsrc; ldv = NSLC; } }
        else { Kh = Ksrc + rowb * KVW + g * HD; ldk = KVW; Vh = P1 + rowb * NSA_INP + (MODE == 2 ? P1_VS : P1_VW) + g * HD; ldv = NSA_INP;
            jhi = (t0 + 31) >> 6; jlo = (MODE == 2) ? 0 : ((t0 - (WINDOW - 1) > 0 ? t0 - (WINDOW - 1) : 0) >> 6); }
        unsigned wn[4] = {~0u, ~0u, ~0u, ~0u};
        if (MODE == 2) { const v4u sv = *(const v4u*)(SEL + ((rowb + t) * NSA_G + g) * 4); unsigned selw[4]; selw[0] = sv.x; selw[1] = sv.y; selw[2] = sv.z; selw[3] = sv.w;
            *(LAS v4u*)(lds + ATT_X_OFF + 2048 + (wid * 64 + lane) * 16) = sv;
            LAS unsigned* un = (LAS unsigned*)(lds + ATT_X_OFF);
#pragma unroll
            for (int q = 0; q < 4; ++q) { unsigned x = selw[q]; x |= __shfl_xor(x, 8); x |= __shfl_xor(x, 16); wn[q] = __builtin_amdgcn_readfirstlane(x); if (lane == 0) un[wid * 4 + q] = wn[q]; }
            LDS_WAIT(); __syncthreads();
            LAS int* plist = (LAS int*)(lds + ATT_X_OFF + 128);
            if (wid == 0) {
                unsigned m0 = 0u, m1 = 0u;
                int lane_l = lane; asm volatile("" : "+v"(lane_l));
                const LAS unsigned* ub = un + (lane_l >> 5);
#pragma unroll
                for (int w = 0; w < NWAVES; ++w) { m0 |= ((ub[w * 4] >> (lane & 31)) & 1u) << w; m1 |= ((ub[w * 4 + 2] >> (lane & 31)) & 1u) << w; }
                bool v0 = m0 != 0u && lane <= jhi, v1 = m1 != 0u && lane + 64 <= jhi; int np = 0;
                for (;;) {
                    const unsigned long long a0 = __ballot(v0), a1 = __ballot(v1);
                    if (!(a0 | a1)) break;
                    const int ja_ = a0 ? __builtin_ctzll(a0) : 64 + __builtin_ctzll(a1);
                    const unsigned ma = (ja_ < 64) ? (unsigned)__shfl((int)m0, ja_) : (unsigned)__shfl((int)m1, ja_ - 64);
                    if (lane == (ja_ & 63)) { if (ja_ < 64) v0 = false; else v1 = false; }
                    unsigned long long c0 = __ballot(v0 && !(m0 & ma)), c1 = __ballot(v1 && !(m1 & ma));
                    if (!(c0 | c1)) { c0 = __ballot(v0 && m0 == 0xffu); c1 = __ballot(v1 && m1 == 0xffu); }
                    if (!(c0 | c1)) { c0 = __ballot(v0); c1 = __ballot(v1); }
                    int jb_ = -1;
                    if (c0 | c1) { jb_ = c0 ? __builtin_ctzll(c0) : 64 + __builtin_ctzll(c1); if (lane == (jb_ & 63)) { if (jb_ < 64) v0 = false; else v1 = false; } }
                    if (lane == 0) { plist[2 * np] = ja_; plist[2 * np + 1] = jb_; }
                    ++np;
                }
                if (lane == 0) { int neg1 = -1; asm volatile("" : "+v"(neg1)); plist[2 * np] = neg1; plist[2 * np + 1] = neg1; }
            }
            LDS_WAIT(); }
        bf16x8 qr[8]; load_q(qr, Qsrc + (rowb + t) * (MODE <= 1 ? NSA_INP : DM) + head * HD + hi * 8);
        float m_reg = -1e30f, l_reg = 0.f; f32x16 o[4] = {};
        const int cur = t >> 6;
#define NSA_NEED(jj) (MODE != 2 || ((pick4(wn, (jj) >> 5) >> ((jj) & 31)) & 1u))
#define NSA_MASK(P0, P1, JJ) do { const int k0 = (JJ) * KVBLK; constexpr float NINF = -__builtin_inff(); \
            if (MODE <= 1) { if (!(16 * (k0 + 63) + 31 <= t0)) { \
                    _Pragma("unroll") for (int r = 0; r < 16; ++r) { if (!(16 * (k0 + crow(r, hi)) + 31 <= t)) P0[r] = NINF; if (!(16 * (k0 + 32 + crow(r, hi)) + 31 <= t)) P1[r] = NINF; } } } \
            else if (MODE == 2) { rv_ = (*(const LAS unsigned*)(lds + ATT_X_OFF + 2048 + (wid * 64 + lane) * 16 + ((JJ) >> 5) * 4) >> ((JJ) & 31)) & 1u;     \
                if ((JJ) >= cur) { const int lim = t - k0 - 4 * hi;                          \
                    _Pragma("unroll") for (int r = 0; r < 16; ++r) { if ((r & 3) + 8 * (r >> 2) > lim) P0[r] = NINF; if (32 + (r & 3) + 8 * (r >> 2) > lim) P1[r] = NINF; } } } \
            else { if (!((k0 > t0 + 31 - WINDOW) && (k0 + 63 <= t0))) { \
                    _Pragma("unroll") for (int r = 0; r < 16; ++r) { const int ka = k0 + crow(r, hi), kb = ka + 32; \
                        if (!(ka <= t && ka > t - WINDOW)) P0[r] = NINF; if (!(kb <= t && kb > t - WINDOW)) P1[r] = NINF; } } } } while (0)
        const int pbase = __builtin_amdgcn_readfirstlane((int)(uintptr_t)(lds + ATT_X_OFF + 128)); int pp = 0;
#define PLIST(i) (*(const LAS int*)(uintptr_t)(unsigned)(pbase + 4 * (i)))
        int ja, jb;
        __syncthreads();
        if (MODE == 2) { ja = PLIST(0); jb = PLIST(1); ja = __builtin_amdgcn_readfirstlane(ja); jb = __builtin_amdgcn_readfirstlane(jb); if (ja < 0) ja = jhi + 1; }
        else { ja = jlo; jb = ja + 1; if (jb > jhi) jb = -1; }
        if (ja <= jhi) kv_dma(dm, Kh + (size_t)ja * KVBLK * ldk, Vh + (size_t)ja * KVBLK * ldv, lds, 0, wid);
        if (jb >= 0) kv_dma(dm, Kh + (size_t)jb * KVBLK * ldk, Vh + (size_t)jb * KVBLK * ldv, lds, ATT_BUF, wid);
        int set = 0;
#pragma nounroll
        while (ja <= jhi) {
            int jc, jd;
            if (MODE == 2) { ++pp; jc = PLIST(2 * pp); jd = PLIST(2 * pp + 1); jc = __builtin_amdgcn_readfirstlane(jc); jd = __builtin_amdgcn_readfirstlane(jd); if (jc < 0) jc = jhi + 1; }
            else { jc = (jb >= 0 ? jb : ja) + 1; jd = jc + 1; if (jd > jhi) jd = -1; }
            VM_WAIT(); __syncthreads();
            if (jc <= jhi) kv_dma(dm, Kh + (size_t)jc * KVBLK * ldk, Vh + (size_t)jc * KVBLK * ldv, lds, ATT_SET - set, wid);
            if (jc <= jhi && jd >= 0) kv_dma(dm, Kh + (size_t)jd * KVBLK * ldk, Vh + (size_t)jd * KVBLK * ldv, lds, ATT_SET - set + ATT_BUF, wid);
            const bool nA = NSA_NEED(ja), nB = (jb >= 0) && NSA_NEED(jb);
            f32x16 a0, a1, b0, b1;
            if (nA) qkt(a0, a1, lds + set + ATT_K_OFF, qr, r32, hi);
            if (nB) qkt(b0, b1, lds + set + ATT_BUF + ATT_K_OFF, qr, r32, hi);
            bool rv_ = true;
            if (nA) { NSA_MASK(a0, a1, ja); attn_finish(a0, a1, o, m_reg, l_reg, wsc, vb0 + set, r32, hi, rv_); }
            if (nB) { NSA_MASK(b0, b1, jb); attn_finish(b0, b1, o, m_reg, l_reg, wsc, vb0 + set + ATT_BUF, r32, hi, rv_); }
            ja = jc; jb = (jc <= jhi) ? jd : -1; set = ATT_SET - set;
        }
#undef PLIST
#undef NSA_MASK
#undef NSA_NEED
        { float fac = l_reg > 0.f ? __builtin_amdgcn_rcpf(l_reg) : 0.f;
          if (MODE != 1) { const int br = MODE == 0 ? 0 : (MODE == 2 ? 1 : 2); fac *= sigmoidf_(bf2f(P1[(rowb + t) * NSA_INP + P1_GL + head * 3 + br])); }
          if (hi == 0) wsc[32 + r32] = fac; LDS_WAIT(); }
        if (MODE == 1) {
            float fc[16];
#pragma unroll
            for (int r = 0; r < 16; ++r) fc[r] = wsc[32 + crow(r, hi)];
            LDS_WAIT(); __syncthreads();
#pragma unroll
            for (int r = 0; r < 16; ++r) { const int orow = crow(r, hi);
#pragma unroll
                for (int d0 = 0; d0 < 4; ++d0) *(LAS float*)(lds + ((wid * 32 + orow) * 128 + d0 * 32 + r32) * 4) = o[d0][r] * fc[r]; }
            LDS_WAIT(); __syncthreads();
            { const int tok = tid >> 4, j8 = (tid & 15) * 8; f32x4 s0 = {0.f, 0.f, 0.f, 0.f}, s1 = {0.f, 0.f, 0.f, 0.f};
#pragma unroll
              for (int w = 0; w < 8; ++w) { const LAS f32x4* pp = (const LAS f32x4*)(lds + ((w * 32 + tok) * 128 + j8) * 4); s0 += pp[0]; s1 += pp[1]; }
              f32x4* dst = (f32x4*)(IMP + ((rowb + t0 + tok) * NSA_G + g) * NSLC + j8); dst[0] = s0; dst[1] = s1; }
            LDS_WAIT(); __syncthreads();
        } else {
#pragma unroll
            for (int r = 0; r < 16; ++r) { const int orow = crow(r, hi); const float fc = wsc[32 + orow];
                const size_t off = (MODE == 2) ? (rowb + t0 + 4 * wid + (orow >> 3)) * DM + (g * NSA_R + (orow & 7)) * HD + r32 : (rowb + t0 + orow) * DM + head * HD + r32;
#pragma unroll
                for (int d0 = 0; d0 < 4; ++d0) {
                    if (MODE == 0) Ob[off + d0 * 32] = (bf16)f2bf(o[d0][r] * fc);
                    else if (MODE == 3) { if (!probe_nostore) Ob[off + d0 * 32] = (bf16)f2bf(bf2f(Ob[off + d0 * 32]) + o[d0][r] * fc); }
                    else Ob[off + d0 * 32] = (bf16)f2bf(bf2f(Ob[off + d0 * 32]) + o[d0][r] * fc); } }
            LDS_WAIT();
        }
    }
}
__device__ __forceinline__ void nsa_topk_phase(Frame& F, const float* IMP, unsigned* SEL) {
    LAS float* sc = (LAS float*)(F.lds + F.wave * 1024);
    const int gw = F.bid * NWAVES + F.wave, NGW = F.G * NWAVES, lane = F.lane;
    for (int it = gw; it < MTOK * NSA_G; it += NGW) {
        const int m = it / NSA_G, t = m & (SEQ - 1), cur = t >> 6;
        const float* ip = IMP + (size_t)it * NSLC;
        const float a0 = ip[lane], a1 = ip[64 + lane];
        sc[lane] = a0; sc[64 + lane] = a1; LDS_WAIT();
        const int j0 = lane, j1 = lane + 64;
        const bool f0 = (j0 == 0) || (j0 == cur) || (j0 == cur - 1), f1 = (j1 == cur) || (j1 == cur - 1);
        const bool c0 = !f0 && j0 <= cur, c1 = !f1 && j1 <= cur;
        const int nforced = cur >= 2 ? 3 : cur + 1, slots = NTOP - nforced;
        int rk0 = 0, rk1 = 0;
        const int ncand_hi = cur < NSLC ? cur : NSLC - 1;
        for (int i = 1; i <= ncand_hi; ++i) {
            const bool fi = (i == cur) || (i == cur - 1); if (fi) continue;
            const float v = sc[i];
            rk0 += (v > a0 || (v == a0 && i < j0)) ? 1 : 0; rk1 += (v > a1 || (v == a1 && i < j1)) ? 1 : 0;
        }
        const bool s0 = (f0 && j0 <= cur) || (c0 && rk0 < slots), s1 = (f1 && j1 <= cur) || (c1 && rk1 < slots);
        const unsigned long long m0 = __ballot(s0), m1 = __ballot(s1);
        if (lane == 0) { v4u w = {(unsigned)m0, (unsigned)(m0 >> 32), (unsigned)m1, (unsigned)(m1 >> 32)}; *(v4u*)(SEL + (size_t)it * 4) = w; }
        LDS_WAIT();
    }
}

#ifndef STAGE
#define STAGE 3
#endif
#define ZERO_OB_PHASE PH_BEGIN { v4u z = {0u, 0u, 0u, 0u}; v4u* p = (v4u*)Ob; const long n = (long)MTOK * DM / 8; \
            for (long i = (long)F.bid * NTHR + F.tid; i < n; i += (long)F.G * NTHR) p[i] = z; } PH_END
#define MIXER0_PHASES \
    PH_BEGIN { fold_finalize(F, FO_XQ, XW); fold_finalize(F, FO_UP, DFF2); } \
             REP(10) hgrn_phase_a(F, BIG, (const float*)(ws + WS_LB), (bf16*)(ws + WS_QT), (bf16*)(ws + WS_OINTRA), (bf16*)(ws + WS_DS), (float*)(ws + WS_DEC)); \
             REP(11) sb_phase(F, BIG, Ob); PH_END \
    PH_BEGIN REP(12) hgrn_phase_b(F, (const bf16*)(ws + WS_DS), (const float*)(ws + WS_DEC), (bf16*)(ws + WS_SPREV)); PH_END \
    PH_BEGIN REP(13) hgrn_phase_c(F, BIG, (const bf16*)(ws + WS_QT), (const bf16*)(ws + WS_OINTRA), (const bf16*)(ws + WS_SPREV), KIN(IN_HGRN_NW), Ob); PH_END
#if STAGE <= 2
#define MIXER1_PHASES ZERO_OB_PHASE
#else
#define MIXER1_PHASES \
    PH_BEGIN { fold_finalize(F, FO_XQ + XW, XW); } REP(14) { nsa_rope_phase(F, BIG, (const float*)(ws + WS_ROPE), (bf16*)(ws + WS_QROT), (bf16*)(ws + WS_KSROT), (bf16*)(ws + WS_KWROT), (bf16*)(ws + WS_OVL)); \
             nsa_compress_phase(F, BIG, KIN(IN_NSA_CMP_POS), (const bf16*)(ws + WS_W_C1), (const bf16*)(ws + WS_W_C2), (bf16*)(ws + WS_KCMP), (bf16*)(ws + WS_VCMP)); } PH_END \
    PH_BEGIN { REP(15) nsa_attn_phase<0>(F, BIG, BIG, (const bf16*)(ws + WS_KCMP), (const bf16*)(ws + WS_VCMP), nullptr, nullptr, nullptr, Ob); \
             F.fresh(); REP(15) nsa_attn_phase<1>(F, BIG, BIG, (const bf16*)(ws + WS_KCMP), (const bf16*)(ws + WS_OVL), nullptr, nullptr, (float*)(ws + WS_IMP), nullptr); \
             F.fresh(); REP(17) nsa_attn_phase<3>(F, BIG, (const bf16*)(ws + WS_QROT), (const bf16*)(ws + WS_KWROT), nullptr, nullptr, nullptr, nullptr, Ob, r_ > 0); } PH_END \
    PH_BEGIN REP(16) nsa_topk_phase(F, (const float*)(ws + WS_IMP), (unsigned*)(ws + WS_SEL)); PH_END \
    PH_BEGIN REP(18) nsa_attn_phase<2>(F, BIG, (const bf16*)(ws + WS_QROT), (const bf16*)(ws + WS_KSROT), nullptr, (const unsigned*)(ws + WS_SEL), nullptr, nullptr, Ob); PH_END
#endif
#ifndef REPMASK
#define REPMASK 0u
#endif
#define REP(gid) for (int r_ = 0; r_ <= (int)((REPMASK >> (gid)) & 1u); ++r_)
#define PH_BEGIN if (pc >= lo && pc < hi) { F.fresh();
#if (REPMASK >> 23) & 1
#define PH_END   if (pc + 1 < hi) { const unsigned long long tb0_ = __builtin_amdgcn_s_memrealtime(); XcdBarrier bb_ = bar; asm volatile("" : "+s"(bb_.bar), "+s"(bb_.x)); xcd_barrier(bb_); \
        const unsigned w_ = (unsigned)(__builtin_amdgcn_s_memrealtime() - tb0_); tbar_acc += w_; if (threadIdx.x == 0) { atomicMax((unsigned*)(args.ws + 3 * MiB) + pc, 0x7fffffffu - w_); atomicMax((unsigned*)(args.ws + 3 * MiB) + 256 + pc, w_); } } } ++pc;
#else
#define PH_END   if (pc + 1 < hi) { XcdBarrier bb_ = bar; asm volatile("" : "+s"(bb_.bar), "+s"(bb_.x)); xcd_barrier(bb_); } } ++pc;
#endif
template <int l>
__device__ __forceinline__ void layer_body(Frame& F, const Args& args, const XcdBarrier& bar, int& pc, const int lo, const int hi, unsigned long long& tbar_acc) {
    unsigned char* ws = F.ws;
    bf16* HB = (bf16*)(ws + WS_HB); bf16* Y = (bf16*)(ws + WS_Y); float* H32 = (float*)karg()->out;
    bf16* BIG = (bf16*)(ws + WS_BIG); bf16* Gm = (bf16*)(ws + WS_G); bf16* Ob = (bf16*)(ws + WS_O);
    bf16* XQ = (bf16*)(ws + WS_XQ); bf16* XO = (bf16*)(ws + WS_XO);
#define RS(k) ((long long*)(ws + WS_RSUM) + (size_t)(k) * MTOK * 2)
#define LNG(k) (KIN(IN_LN_G) + (size_t)(k) * DM)
#define LNB(k) (KIN(IN_LN_B) + (size_t)(k) * DM)
    const float* cs = (const float*)(ws + WS_FOLDF); const float* b2 = cs + FO_N;
        PH_BEGIN REP(1) {
            const int N = l == 0 ? AB_IN : NSA_INP;
            pg8::StaticOrder S; S.init(MTOK, N, F.G, F.bid);
            if (l == 0) { pg8::Gemm g{HB, (const bf16*)(ws + WS_W_ABIN), MTOK, N, DM}; pg8::EpiBf16<0> E{BIG, N, nullptr, 0, 0, 1.f};
                pg8::gemm_phase<pg8::EpiBf16<0>, pg8::StaticOrder, PG8_ALIGN, PG8_SP2>(F.lds + RING_OFF, g, S, E); }
            else { pg8::Gemm g{Y, (const bf16*)(ws + WS_W_NSAIN), MTOK, N, DM}; pg8::EpiBf16Ln E{BIG, N, RS(2), cs + FO_NSA, b2 + FO_NSA};
                pg8::gemm_phase<pg8::EpiBf16Ln, pg8::StaticOrder, PG8_ALIGN, PG8_SP2>(F.lds + RING_OFF, g, S, E);
                if (r_ == 0) convert_job<CJ_L1A>(F, args, 64, 192); }
        } PH_END
#if STAGE <= 1
        ZERO_OB_PHASE
#else
        if (l == 0) {
            MIXER0_PHASES
        } else {
            MIXER1_PHASES
        }
#endif
        PH_BEGIN REP(2) {
            pg8::Gemm g{Ob, l == 0 ? (const bf16*)(ws + WS_W_ABOUT) : (const bf16*)(ws + WS_W_NSAOUT), MTOK, DM, DM};
            pg8::StaticOrder S; S.init(MTOK, DM, F.G, F.bid);
            if (l == 0) { pg8::EpiRes0 E{Y, HB, DM, DN_ALPHA, RS(0)};
                pg8::gemm_phase<pg8::EpiRes0, pg8::StaticOrder, PG8_ALIGN, PG8_SP2>(F.lds + RING_OFF, g, S, E); }
            else { pg8::EpiResLn2 E{Y, RS(2), LNG(2), LNB(2), DM, DN_ALPHA, RS(3)};
                pg8::gemm_phase<pg8::EpiResLn2, pg8::StaticOrder, PG8_ALIGN, PG8_SP2>(F.lds + RING_OFF, g, S, E); }
        } PH_END
        PH_BEGIN REP(3) {
            {   pg8::Gemm g{Y, (const bf16*)(ws + WS_W_XQ) + (size_t)l * XW * DM, MTOK, XW, DM};
                pg8::RangeOrder S; S.init(MTOK, XW, 0, 128, F.bid);
                pg8::EpiBf16Ln E{XQ, XW, RS(3 * l), cs + FO_XQ + l * XW, b2 + FO_XQ + l * XW};
                pg8::gemm_phase<pg8::EpiBf16Ln, pg8::RangeOrder, PG8_ALIGN, PG8_SP2>(F.lds + RING_OFF, g, S, E); }
            {   pg8::Gemm g{(const bf16*)(ws + WS_MEMB), (const bf16*)(ws + WS_W_XKV) + (size_t)l * 2 * XW * DM, BATCH * NMEM, 2 * XW, DM};
                pg8::RangeOrder S; S.init(BATCH * NMEM, 2 * XW, 128, 8, F.bid);
                pg8::EpiBf16<0> E{(bf16*)(ws + WS_XKV) + (size_t)l * BATCH * NMEM * 2 * XW, 2 * XW, nullptr, 0, 0, 1.f};
                pg8::gemm_phase<pg8::EpiBf16<0>, pg8::RangeOrder, PG8_ALIGN, PG8_SP2>(F.lds + RING_OFF, g, S, E); }
            if (r_ == 0) { if (l == 0) convert_job<CJ_DOWN0>(F, args, 136, 120); else convert_job<CJ_L1B>(F, args, 136, 120); }
        } PH_END
        PH_BEGIN { if (l == 1) fold_finalize(F, FO_UP + DFF2, DFF2); } REP(9) xattn_phase(F, XQ, (const bf16*)(ws + WS_XKV) + (size_t)l * BATCH * NMEM * 2 * XW, XO); PH_END
        PH_BEGIN REP(4) {
            pg8::Gemm g{XO, (const bf16*)(ws + WS_W_XO) + (size_t)l * DM * XW, MTOK, DM, XW};
            pg8::StaticOrder S; S.init(MTOK, DM, F.G, F.bid);
            pg8::EpiResLn2 E{Y, RS(3 * l), LNG(3 * l), LNB(3 * l), DM, DN_ALPHA, RS(3 * l + 1)};
            pg8::gemm_phase<pg8::EpiResLn2, pg8::StaticOrder, PG8_ALIGN, PG8_SP2>(F.lds + RING_OFF, g, S, E);
        } PH_END
        PH_BEGIN REP(5) {
#if (REPMASK >> 22) & 1
            if (r_ > 0) { XcdBarrier bb_ = bar; asm volatile("" : "+s"(bb_.bar), "+s"(bb_.x)); xcd_barrier(bb_); }
#endif
            pg8::Gemm g{Y, (const bf16*)(ws + WS_W_UP) + (size_t)l * DFF2 * DM, MTOK, DFF2, DM};
            pg8::StaticOrder S; S.init(MTOK, DFF2, F.G, F.bid);
            pg8::EpiConvGlu E{Gm, (bf16*)(ws + WS_SIDE), RS(3 * l + 1), cs + FO_UP + l * DFF2, b2 + FO_UP + l * DFF2, KIN(IN_FFN_CONV) + (size_t)l * 3 * DFF, DFF};
            pg8::gemm_phase<pg8::EpiConvGlu, pg8::StaticOrder, PG8_ALIGN, PG8_SP2>(F.lds + RING_OFF, g, S, E);
            if (r_ == 0) { if (l == 0) convert_job<CJ_NSA>(F, args, 128, 128); else convert_job<CJ_DOWN1>(F, args, 128, 128); }
        } PH_END
#if (REPMASK >> 20) & 1
        PH_BEGIN {
            pg8::Gemm g{HB, (const bf16*)(ws + WS_W_UP) + (size_t)l * DFF2 * DM, MTOK, DFF2, DM};
            pg8::ZeroOrder S; S.init(MTOK, DFF2, F.G, F.bid);
            pg8::EpiBf16<0> E{Gm, DFF2, nullptr, 0, 0, 1.f};
            pg8::gemm_phase<pg8::EpiBf16<0>, pg8::ZeroOrder, PG8_ALIGN, PG8_SP2>(F.lds + RING_OFF, g, S, E);
        } PH_END
#endif
        PH_BEGIN { if (l == 0) fold_finalize(F, FO_NSA, NSA_INP); } REP(8) convglu_fixup_phase(F, (const bf16*)(ws + WS_SIDE), KIN(IN_FFN_CONV) + (size_t)l * 3 * DFF, Gm); PH_END
        PH_BEGIN REP(6) {
            pg8::Gemm g{Gm, (const bf16*)(ws + WS_W_DOWN) + (size_t)l * DM * DFF, MTOK, DM, DFF};
            pg8::StaticOrder S; S.init(MTOK, DM, F.G, F.bid);
            pg8::EpiResLn2 E{Y, RS(3 * l + 1), LNG(3 * l + 1), LNB(3 * l + 1), DM, DN_ALPHA, RS(3 * l + 2)};
            pg8::gemm_phase<pg8::EpiResLn2, pg8::StaticOrder, PG8_ALIGN, PG8_SP2>(F.lds + RING_OFF, g, S, E);
        } PH_END
        if (l == 1) { PH_BEGIN REP(7) ln_phase(F, Y, LNG(5), LNB(5), H32); PH_END }
#undef RS
#undef LNG
#undef LNB
}
__global__ void __launch_bounds__(NTHR, 2) mega_fwd(Args args) {
    extern __shared__ __attribute__((aligned(16))) unsigned char lds_raw[];
    Frame F;
    F.lds = (LAS unsigned char*)lds_raw; F.ws = args.ws;
    F.tid = threadIdx.x; F.lane = F.tid & 63; F.wave = __builtin_amdgcn_readfirstlane(F.tid >> 6); F.G = gridDim.x;
    unsigned char* ws = args.ws;
    gu32* ctl = (gu32*)(ws + WS_CTL);
    for (int u = F.tid; u < (LDS_BYTES - LDSCTL_OFF) / 4; u += NTHR) ((LAS unsigned*)(F.lds + LDSCTL_OFF))[u] = 0u;
    __syncthreads();
    volatile LAS unsigned* MISC = (volatile LAS unsigned*)(F.lds + MISC_OFF);
    XcdBarrier bar = xcd_barrier_post((unsigned*)(ctl + CW_BAR), MISC + 8);
    const int lo = args.ph_lo, hi = args.ph_hi; int pc = 0; unsigned long long tbar_acc = 0ull;
    bf16* HB = (bf16*)(ws + WS_HB); bf16* Y = (bf16*)(ws + WS_Y); float* H32 = (float*)karg()->out;
    bf16* BIG = (bf16*)(ws + WS_BIG); bf16* Gm = (bf16*)(ws + WS_G); bf16* Ob = (bf16*)(ws + WS_O);
    bf16* XQ = (bf16*)(ws + WS_XQ); bf16* XO = (bf16*)(ws + WS_XO);

    PH_BEGIN REP(0) p0_prologue(F, args); PH_END

#if (REPMASK >> 21) & 1
    for (int e_ = 0; e_ < 40; ++e_) { PH_BEGIN PH_END }
#endif
    layer_body<0>(F, args, bar, pc, lo, hi, tbar_acc);
    layer_body<1>(F, args, bar, pc, lo, hi, tbar_acc);
#if (REPMASK >> 23) & 1
#ifndef PROBE_BID
#define PROBE_BID 0
#endif
#if (REPMASK >> 24) & 1
    if (blockIdx.x == 0) { unsigned long long tot_ = 0ull; for (int k_ = 0; k_ < pc; ++k_) { const unsigned v_ = __hip_atomic_load((unsigned*)(args.ws + 3 * MiB) + k_, __ATOMIC_RELAXED, __HIP_MEMORY_SCOPE_AGENT); const unsigned x_ = __hip_atomic_load((unsigned*)(args.ws + 3 * MiB) + 256 + k_, __ATOMIC_RELAXED, __HIP_MEMORY_SCOPE_AGENT);
#ifdef PROBE_SPREAD_MASK
            if (v_ && ((PROBE_SPREAD_MASK >> k_) & 1ull)) tot_ += x_ - (0x7fffffffu - v_);
#else
            if (v_) tot_ += 0x7fffffffu - v_;
#endif
        }
        const unsigned long long t0_ = __builtin_amdgcn_s_memrealtime(); while (__builtin_amdgcn_s_memrealtime() - t0_ < tot_) __builtin_amdgcn_s_sleep(8); }
#else
    if (blockIdx.x == PROBE_BID) { const unsigned long long t0_ = __builtin_amdgcn_s_memrealtime(); while (__builtin_amdgcn_s_memrealtime() - t0_ < tbar_acc) __builtin_amdgcn_s_sleep(8); }
#endif
#endif
}

extern "C" void kernel_launch(void* const* d_in, const int* in_sizes, int n_in, void* d_out, int out_size, void* d_ws, size_t ws_size, hipStream_t stream) {
    static int grid = 0;
    if (grid == 0) {
        if (n_in != 19 || in_sizes[0] != MTOK * DM || out_size != MTOK * DM || ws_size < WS_END) {
            fprintf(stderr, "kernel_launch: shape mismatch n_in %d in0 %d out %d ws %zu (need %zu)\n", n_in, n_in > 0 ? in_sizes[0] : -1, out_size, ws_size, (size_t)WS_END); grid = -1; return; }
        int dev = 0, cus = 0, per_cu = 0;
        if (hipGetDevice(&dev) != hipSuccess || hipDeviceGetAttribute(&cus, hipDeviceAttributeMultiprocessorCount, dev) != hipSuccess) { grid = -1; return; }
        if (hipFuncSetAttribute((const void*)mega_fwd, hipFuncAttributeMaxDynamicSharedMemorySize, LDS_BYTES) != hipSuccess) { fprintf(stderr, "kernel_launch: hipFuncSetAttribute failed\n"); grid = -1; return; }
        if (hipOccupancyMaxActiveBlocksPerMultiprocessor(&per_cu, (const void*)mega_fwd, NTHR, LDS_BYTES) != hipSuccess || per_cu < 1)
            fprintf(stderr, "kernel_launch: note: occupancy query reports %d workgroups per CU\n", per_cu);
        (void)hipGetLastError();
        grid = cus;
        if (grid != 256) { fprintf(stderr, "kernel_launch: built for a 256-CU device (workgroup ranges of the cross-attention and conversion phases); this device reports %d; nothing launched\n", cus); grid = -1; return; }
    }
    if (grid < 0) return;
    if (hipMemsetAsync((char*)d_ws + WS_CTL, 0, CTL_ZERO_BYTES, stream) != hipSuccess) { fprintf(stderr, "kernel_launch: memset failed\n"); return; }
    Args a{};
    for (int i = 0; i < 19; ++i) a.in[i] = (const float*)d_in[i];
    a.out = (float*)d_out; a.ws = (unsigned char*)d_ws; a.ph_lo = 0; a.ph_hi = 1 << 20;
    hipLaunchKernelGGL(mega_fwd, dim3(grid), dim3(NTHR), LDS_BYTES, stream, a);
    const hipError_t le = hipPeekAtLastError();
    if (le != hipSuccess) fprintf(stderr, "kernel_launch: launch failed: %s\n", hipGetErrorName(le));
}
```

```cpp
#include <hip/hip_runtime.h>
#include <cstdio>
#include <cstdint>
namespace pg8 {
#define PG8_LAS __attribute__((address_space(3)))
typedef unsigned short bf16_t;
typedef short bf16x8 __attribute__((ext_vector_type(8)));
typedef float f32x4 __attribute__((ext_vector_type(4)));
typedef unsigned u32x4 __attribute__((ext_vector_type(4)));
constexpr int BM = 256, BK = 64, HALF = 128, HTB = HALF * BK * 2  , STAGE_BYTES = 8 * HTB, NXCD = 8, WGM = 8;

__host__ __device__ __forceinline__ int lds_byte(int r, int c) { const int st = (r >> 4) * 2 + (c >> 5), rr = r & 15, cc = c & 31, ob = rr * 64 + cc * 2; return st * 1024 + (ob ^ (((ob >> 9) & 1) << 5)); }
__host__ __device__ __forceinline__ void stage_rc(int b, int& R, int& C) { const int st = b / 1024, sb = b % 1024, swz = sb ^ (((sb >> 9) & 1) << 5); R = (st >> 1) * 16 + swz / 64; C = (st & 1) * 32 + (swz % 64) / 2; }
__host__ __device__ __forceinline__ int perm32(int rho) { const int n = rho >> 4, i = rho & 15; return 8 * (i >> 2) + 4 * n + (i & 3); }

struct Unit { int pm, pn; };
struct Gemm { const bf16_t* A; const bf16_t* Bt; int M, N, K; };

struct StaticOrder {
    int nM, nN, nwg, G, c;
    __host__ __device__ void init(int M, int N, int G_, int c_) { nM = M / BM; nN = N / BM; nwg = nM * nN; G = G_; c = c_; }
    __host__ __device__ bool next(int i, Unit& u) const {
        const long L = (long)i * G + c; if (L >= nwg) return false;
        int wgid = (int)L; { const int q = nwg / NXCD, r = nwg % NXCD, xcd = wgid % NXCD, off = wgid / NXCD; wgid = (xcd < r ? xcd * (q + 1) : r * (q + 1) + (xcd - r) * q) + off; }
        const int nig = WGM * nN, gid = wgid / nig, fm = gid * WGM, gsz = (nM - fm) < WGM ? (nM - fm) : WGM;
        u.pm = fm + ((wgid % nig) % gsz); u.pn = (wgid % nig) / gsz; return true;
    }
    __device__ __forceinline__ void a_ready(const Unit&) const {}
    __device__ __forceinline__ void done(const Unit&) const {}
};

__device__ __forceinline__ unsigned cvt_pk_bf16(float lo, float hi) { unsigned r; asm volatile("v_cvt_pk_bf16_f32 %0, %1, %2" : "=v"(r) : "v"(lo), "v"(hi)); return r; }
typedef float f32x2 __attribute__((ext_vector_type(2)));
__device__ __forceinline__ f32x2 gelu_pk(f32x2 v) {
    const f32x2 av = __builtin_elementwise_abs(v), d = av * 0.2316418882f + 1.0f;
    f32x2 t; t.x = __builtin_amdgcn_rcpf(d.x); t.y = __builtin_amdgcn_rcpf(d.y);
    f32x2 q = t * 0.5307027145f + (-0.7265760135f); q = q * t + 0.7107068705f; q = q * t + (-0.142248368f); q = q * t + 0.127414796f; q = q * t;
    const f32x2 s = (v * v) * (-0.72134752044f);
    f32x2 e; e.x = __builtin_amdgcn_exp2f(s.x); e.y = __builtin_amdgcn_exp2f(s.y);
    const f32x2 m = v * (q * e), r = v - m;
    f32x2 o; o.x = v.x < 0.f ? m.x : r.x; o.y = v.y < 0.f ? m.y : r.y; return o;
}

template <int ACT  > struct EpiBf16 {
    static constexpr bool PERM = true, AFTER_DRAIN = false; static_assert(ACT == 0 || ACT == 1, "EpiBf16: ACT is 0 (none) or 1 (gelu_pk)");
    bf16_t* O; int ldc; const float* bias; int split_cols; size_t split_stride; float scale0;
    __device__ __forceinline__ void operator()(const f32x4 (&acc)[2][2][4][2], const Unit& u, int wr, int wc, int fr, int fq) const {
        const int row0 = u.pm * BM + wr * 64 + fr; int colt = u.pn * BM; bf16_t* base = O;
        float sc = 1.f; if (split_cols) { const int t = colt / split_cols; base += (size_t)t * split_stride; colt -= t * split_cols; if (t == 0) sc = scale0; }
        const int col0 = colt + wc * 32 + 8 * fq, bcol0 = u.pn * BM + wc * 32 + 8 * fq;
        f32x4 bv[2][2];
#pragma unroll
        for (int bj = 0; bj < 2; ++bj)
#pragma unroll
            for (int n = 0; n < 2; ++n) bv[bj][n] = bias ? *(const f32x4*)(bias + bcol0 + bj * HALF + 4 * n) : (f32x4){0.f, 0.f, 0.f, 0.f};
#pragma unroll
        for (int ai = 0; ai < 2; ++ai)
#pragma unroll
            for (int m = 0; m < 4; ++m) { bf16_t* rowp = base + (size_t)(row0 + ai * HALF + m * 16) * ldc + col0;
#pragma unroll
                for (int bj = 0; bj < 2; ++bj) { f32x4 v0 = acc[ai][bj][m][0] + bv[bj][0], v1 = acc[ai][bj][m][1] + bv[bj][1];
                    if (ACT == 1) { f32x2 a = gelu_pk((f32x2){v0[0], v0[1]}), b = gelu_pk((f32x2){v0[2], v0[3]}), c = gelu_pk((f32x2){v1[0], v1[1]}), d = gelu_pk((f32x2){v1[2], v1[3]});
                        v0 = (f32x4){a.x, a.y, b.x, b.y}; v1 = (f32x4){c.x, c.y, d.x, d.y}; }
                    v0 = v0 * sc; v1 = v1 * sc; u32x4 w; w.x = cvt_pk_bf16(v0[0], v0[1]); w.y = cvt_pk_bf16(v0[2], v0[3]); w.z = cvt_pk_bf16(v1[0], v1[1]); w.w = cvt_pk_bf16(v1[2], v1[3]);
                    *(u32x4*)(rowp + bj * HALF) = w; } }
    }
};


struct EpiRes {
    static constexpr bool PERM = false, AFTER_DRAIN = false;
    float* Y; const float* res; int ldc; float alpha;
    __device__ __forceinline__ void operator()(const f32x4 (&acc)[2][2][4][2], const Unit& u, int wr, int wc, int fr, int fq) const {
        const int row0 = u.pm * BM + wr * 64 + fr, col0 = u.pn * BM + wc * 32 + 4 * fq;
#pragma unroll
        for (int ai = 0; ai < 2; ++ai)
#pragma unroll
            for (int m = 0; m < 4; ++m) { const size_t off = (size_t)(row0 + ai * HALF + m * 16) * ldc + col0;
#pragma unroll
                for (int bj = 0; bj < 2; ++bj)
#pragma unroll
                    for (int n = 0; n < 2; ++n) { const f32x4 r = *(const f32x4*)(res + off + bj * HALF + n * 16);
                        *(f32x4*)(Y + off + bj * HALF + n * 16) = r * alpha + acc[ai][bj][m][n]; } }
    }
};
struct RangeOrder {
    int nM, nN, ntot, c0, nw, c;
    __host__ __device__ void init(int M, int N, int c0_, int nw_, int c_) { nM = M / BM; nN = N / BM; ntot = nM * nN; c0 = c0_; nw = nw_; c = c_; }
    __host__ __device__ bool next(int i, Unit& u) const {
        if (c < c0 || c >= c0 + nw) return false;
        const int L = i * nw + (c - c0); if (L >= ntot) return false;
        u.pm = L / nN; u.pn = L % nN; return true;
    }
    __device__ __forceinline__ void a_ready(const Unit&) const {}
    __device__ __forceinline__ void done(const Unit&) const {}
};

struct ZeroOrder : StaticOrder {
    __host__ __device__ bool next(int i, Unit& u) const { const bool r = StaticOrder::next(i, u); u.pm = 0; u.pn = 0; return r; }
};

struct EpiResBf {
    static constexpr bool PERM = true, AFTER_DRAIN = false;
    bf16_t* Y; const bf16_t* res; int ldc; float alpha;
    __device__ __forceinline__ void operator()(const f32x4 (&acc)[2][2][4][2], const Unit& u, int wr, int wc, int fr, int fq) const {
        const int row0 = u.pm * BM + wr * 64 + fr, col0 = u.pn * BM + wc * 32 + 8 * fq;
#pragma unroll
        for (int ai = 0; ai < 2; ++ai)
#pragma unroll
            for (int m = 0; m < 4; ++m) { const size_t off = (size_t)(row0 + ai * HALF + m * 16) * ldc + col0;
#pragma unroll
                for (int bj = 0; bj < 2; ++bj) { const u32x4 r = *(const u32x4*)(res + off + bj * HALF);
                    const f32x4 v0 = acc[ai][bj][m][0], v1 = acc[ai][bj][m][1];
                    u32x4 w;
                    w.x = cvt_pk_bf16(__builtin_bit_cast(float, r.x << 16) * alpha + v0[0], __builtin_bit_cast(float, r.x & 0xffff0000u) * alpha + v0[1]);
                    w.y = cvt_pk_bf16(__builtin_bit_cast(float, r.y << 16) * alpha + v0[2], __builtin_bit_cast(float, r.y & 0xffff0000u) * alpha + v0[3]);
                    w.z = cvt_pk_bf16(__builtin_bit_cast(float, r.z << 16) * alpha + v1[0], __builtin_bit_cast(float, r.z & 0xffff0000u) * alpha + v1[1]);
                    w.w = cvt_pk_bf16(__builtin_bit_cast(float, r.w << 16) * alpha + v1[2], __builtin_bit_cast(float, r.w & 0xffff0000u) * alpha + v1[3]);
                    *(u32x4*)(Y + off + bj * HALF) = w; } }
    }
};

struct EpiResF {
    static constexpr bool PERM = true, AFTER_DRAIN = false;
    float* Y; const bf16_t* res; int ldc; float alpha;
    __device__ __forceinline__ void operator()(const f32x4 (&acc)[2][2][4][2], const Unit& u, int wr, int wc, int fr, int fq) const {
        const int row0 = u.pm * BM + wr * 64 + fr, col0 = u.pn * BM + wc * 32 + 8 * fq;
#pragma unroll
        for (int ai = 0; ai < 2; ++ai)
#pragma unroll
            for (int m = 0; m < 4; ++m) { const size_t off = (size_t)(row0 + ai * HALF + m * 16) * ldc + col0;
#pragma unroll
                for (int bj = 0; bj < 2; ++bj) { const u32x4 r = *(const u32x4*)(res + off + bj * HALF);
                    f32x4 o0, o1;
                    o0[0] = __builtin_bit_cast(float, r.x << 16); o0[1] = __builtin_bit_cast(float, r.x & 0xffff0000u); o0[2] = __builtin_bit_cast(float, r.y << 16); o0[3] = __builtin_bit_cast(float, r.y & 0xffff0000u);
                    o1[0] = __builtin_bit_cast(float, r.z << 16); o1[1] = __builtin_bit_cast(float, r.z & 0xffff0000u); o1[2] = __builtin_bit_cast(float, r.w << 16); o1[3] = __builtin_bit_cast(float, r.w & 0xffff0000u);
                    *(f32x4*)(Y + off + bj * HALF) = o0 * alpha + acc[ai][bj][m][0]; *(f32x4*)(Y + off + bj * HALF + 4) = o1 * alpha + acc[ai][bj][m][1]; } }
    }
};

struct EpiResLn {
    static constexpr bool PERM = true, AFTER_DRAIN = false;
    bf16_t* Y; const float* stats; const float* g; const float* b; int ldc; float alpha;
    __device__ __forceinline__ void operator()(const f32x4 (&acc)[2][2][4][2], const Unit& u, int wr, int wc, int fr, int fq) const {
        const int row0 = u.pm * BM + wr * 64 + fr, col0 = u.pn * BM + wc * 32 + 8 * fq;
        f32x4 gv[2][2], bv[2][2];
#pragma unroll
        for (int bj = 0; bj < 2; ++bj)
#pragma unroll
            for (int n = 0; n < 2; ++n) { gv[bj][n] = *(const f32x4*)(g + col0 + bj * HALF + 4 * n) * alpha; bv[bj][n] = *(const f32x4*)(b + col0 + bj * HALF + 4 * n) * alpha; }
#pragma unroll
        for (int ai = 0; ai < 2; ++ai)
#pragma unroll
            for (int m = 0; m < 4; ++m) { const int row = row0 + ai * HALF + m * 16; const size_t off = (size_t)row * ldc + col0;
                const float mean = stats[2 * row], rstd = stats[2 * row + 1];
#pragma unroll
                for (int bj = 0; bj < 2; ++bj) { const u32x4 r = *(const u32x4*)(Y + off + bj * HALF);
                    f32x4 y0, y1;
                    y0[0] = __builtin_bit_cast(float, r.x << 16); y0[1] = __builtin_bit_cast(float, r.x & 0xffff0000u); y0[2] = __builtin_bit_cast(float, r.y << 16); y0[3] = __builtin_bit_cast(float, r.y & 0xffff0000u);
                    y1[0] = __builtin_bit_cast(float, r.z << 16); y1[1] = __builtin_bit_cast(float, r.z & 0xffff0000u); y1[2] = __builtin_bit_cast(float, r.w << 16); y1[3] = __builtin_bit_cast(float, r.w & 0xffff0000u);
                    const f32x4 o0 = (y0 - mean) * rstd * gv[bj][0] + bv[bj][0] + acc[ai][bj][m][0], o1 = (y1 - mean) * rstd * gv[bj][1] + bv[bj][1] + acc[ai][bj][m][1];
                    u32x4 w; w.x = cvt_pk_bf16(o0[0], o0[1]); w.y = cvt_pk_bf16(o0[2], o0[3]); w.z = cvt_pk_bf16(o1[0], o1[1]); w.w = cvt_pk_bf16(o1[2], o1[3]);
                    *(u32x4*)(Y + off + bj * HALF) = w; } }
    }
};

constexpr float RS_SCALE = 1048576.0f, RS_INV = 1.0f / 1048576.0f;
__device__ __forceinline__ float fx20_to_f(long long v) { return (float)(int)(v >> 20) + (float)((unsigned)v & 0xFFFFFu) * RS_INV; }
__device__ __forceinline__ long long f_to_fx20(float s) { const float fl = floorf(s); return ((long long)(int)fl << 20) + (long long)(unsigned)((s - fl) * RS_SCALE + 0.5f); }
__device__ __forceinline__ void row_stats(const long long* rs, int row, float& mean, float& rstd) {
    const long long a = rs[2 * (size_t)row], b = rs[2 * (size_t)row + 1];
    mean = fx20_to_f(a) * (1.0f / 4096.0f); const float var = fx20_to_f(b) * (1.0f / 4096.0f) - mean * mean; rstd = 1.0f / sqrtf(var + 1e-5f);
}
constexpr float FOLD_SCALE = 4294967296.0f, FOLD_INV = 1.0f / 4294967296.0f;
struct EpiBf16Ln {
    static constexpr bool PERM = true, AFTER_DRAIN = false;
    bf16_t* O; int ldc; const long long* rs; const float* cs; const float* b2;
    __device__ __forceinline__ void operator()(const f32x4 (&acc)[2][2][4][2], const Unit& u, int wr, int wc, int fr, int fq) const {
        const int row0 = u.pm * BM + wr * 64 + fr, col0 = u.pn * BM + wc * 32 + 8 * fq;
        f32x4 cv[2][2], bv[2][2];
#pragma unroll
        for (int bj = 0; bj < 2; ++bj)
#pragma unroll
            for (int n = 0; n < 2; ++n) { cv[bj][n] = *(const f32x4*)(cs + col0 + bj * HALF + 4 * n); bv[bj][n] = *(const f32x4*)(b2 + col0 + bj * HALF + 4 * n); }
#pragma unroll
        for (int ai = 0; ai < 2; ++ai)
#pragma unroll
            for (int m = 0; m < 4; ++m) { const int row = row0 + ai * HALF + m * 16; float mean, rstd; row_stats(rs, row, mean, rstd);
                bf16_t* rowp = O + (size_t)row * ldc + col0;
#pragma unroll
                for (int bj = 0; bj < 2; ++bj) { const f32x4 v0 = (acc[ai][bj][m][0] - cv[bj][0] * mean) * rstd + bv[bj][0], v1 = (acc[ai][bj][m][1] - cv[bj][1] * mean) * rstd + bv[bj][1];
                    u32x4 w; w.x = cvt_pk_bf16(v0[0], v0[1]); w.y = cvt_pk_bf16(v0[2], v0[3]); w.z = cvt_pk_bf16(v1[0], v1[1]); w.w = cvt_pk_bf16(v1[2], v1[3]);
                    *(u32x4*)(rowp + bj * HALF) = w; } }
    }
};
__device__ __forceinline__ void row_sums_add(long long* rso, int row, const f32x4& a, const f32x4& b, const f32x4& c, const f32x4& d, int fq) {
    float s1 = ((a[0] + a[1]) + (a[2] + a[3])) + ((b[0] + b[1]) + (b[2] + b[3])) + ((c[0] + c[1]) + (c[2] + c[3])) + ((d[0] + d[1]) + (d[2] + d[3]));
    float s2 = ((a[0] * a[0] + a[1] * a[1]) + (a[2] * a[2] + a[3] * a[3])) + ((b[0] * b[0] + b[1] * b[1]) + (b[2] * b[2] + b[3] * b[3]))
             + ((c[0] * c[0] + c[1] * c[1]) + (c[2] * c[2] + c[3] * c[3])) + ((d[0] * d[0] + d[1] * d[1]) + (d[2] * d[2] + d[3] * d[3]));
    s1 += __shfl_xor(s1, 16); s1 += __shfl_xor(s1, 32); s2 += __shfl_xor(s2, 16); s2 += __shfl_xor(s2, 32);
    if (fq == 0) { atomicAdd((unsigned long long*)(rso + 2 * (size_t)row), (unsigned long long)f_to_fx20(s1)); atomicAdd((unsigned long long*)(rso + 2 * (size_t)row + 1), (unsigned long long)f_to_fx20(s2)); }
}
struct EpiRes0 {
    static constexpr bool PERM = true, AFTER_DRAIN = false;
    bf16_t* Y; const bf16_t* res; int ldc; float alpha; long long* rso;
    __device__ __forceinline__ void operator()(const f32x4 (&acc)[2][2][4][2], const Unit& u, int wr, int wc, int fr, int fq) const {
        const int row0 = u.pm * BM + wr * 64 + fr, col0 = u.pn * BM + wc * 32 + 8 * fq;
#pragma unroll
        for (int ai = 0; ai < 2; ++ai)
#pragma unroll
            for (int m = 0; m < 4; ++m) { const int row = row0 + ai * HALF + m * 16; const size_t off = (size_t)row * ldc + col0; f32x4 o[2][2];
#pragma unroll
                for (int bj = 0; bj < 2; ++bj) { const u32x4 r = *(const u32x4*)(res + off + bj * HALF);
                    f32x4 y0, y1;
                    y0[0] = __builtin_bit_cast(float, r.x << 16); y0[1] = __builtin_bit_cast(float, r.x & 0xffff0000u); y0[2] = __builtin_bit_cast(float, r.y << 16); y0[3] = __builtin_bit_cast(float, r.y & 0xffff0000u);
                    y1[0] = __builtin_bit_cast(float, r.z << 16); y1[1] = __builtin_bit_cast(float, r.z & 0xffff0000u); y1[2] = __builtin_bit_cast(float, r.w << 16); y1[3] = __builtin_bit_cast(float, r.w & 0xffff0000u);
                    o[bj][0] = y0 * alpha + acc[ai][bj][m][0]; o[bj][1] = y1 * alpha + acc[ai][bj][m][1];
                    u32x4 w; w.x = cvt_pk_bf16(o[bj][0][0], o[bj][0][1]); w.y = cvt_pk_bf16(o[bj][0][2], o[bj][0][3]); w.z = cvt_pk_bf16(o[bj][1][0], o[bj][1][1]); w.w = cvt_pk_bf16(o[bj][1][2], o[bj][1][3]);
                    *(u32x4*)(Y + off + bj * HALF) = w; }
                row_sums_add(rso, row, o[0][0], o[0][1], o[1][0], o[1][1], fq); }
    }
};
struct EpiResLn2 {
    static constexpr bool PERM = true, AFTER_DRAIN = false;
    bf16_t* Y; const long long* rsi; const float* g; const float* b; int ldc; float alpha; long long* rso;
    __device__ __forceinline__ void operator()(const f32x4 (&acc)[2][2][4][2], const Unit& u, int wr, int wc, int fr, int fq) const {
        const int row0 = u.pm * BM + wr * 64 + fr, col0 = u.pn * BM + wc * 32 + 8 * fq;
        f32x4 gv[2][2], bv[2][2];
#pragma unroll
        for (int bj = 0; bj < 2; ++bj)
#pragma unroll
            for (int n = 0; n < 2; ++n) { gv[bj][n] = *(const f32x4*)(g + col0 + bj * HALF + 4 * n) * alpha; bv[bj][n] = *(const f32x4*)(b + col0 + bj * HALF + 4 * n) * alpha; }
#pragma unroll
        for (int ai = 0; ai < 2; ++ai)
#pragma unroll
            for (int m = 0; m < 4; ++m) { const int row = row0 + ai * HALF + m * 16; const size_t off = (size_t)row * ldc + col0; float mean, rstd; row_stats(rsi, row, mean, rstd); f32x4 o[2][2];
#pragma unroll
                for (int bj = 0; bj < 2; ++bj) { const u32x4 r = *(const u32x4*)(Y + off + bj * HALF);
                    f32x4 y0, y1;
                    y0[0] = __builtin_bit_cast(float, r.x << 16); y0[1] = __builtin_bit_cast(float, r.x & 0xffff0000u); y0[2] = __builtin_bit_cast(float, r.y << 16); y0[3] = __builtin_bit_cast(float, r.y & 0xffff0000u);
                    y1[0] = __builtin_bit_cast(float, r.z << 16); y1[1] = __builtin_bit_cast(float, r.z & 0xffff0000u); y1[2] = __builtin_bit_cast(float, r.w << 16); y1[3] = __builtin_bit_cast(float, r.w & 0xffff0000u);
                    o[bj][0] = (y0 - mean) * rstd * gv[bj][0] + bv[bj][0] + acc[ai][bj][m][0]; o[bj][1] = (y1 - mean) * rstd * gv[bj][1] + bv[bj][1] + acc[ai][bj][m][1];
                    u32x4 w; w.x = cvt_pk_bf16(o[bj][0][0], o[bj][0][1]); w.y = cvt_pk_bf16(o[bj][0][2], o[bj][0][3]); w.z = cvt_pk_bf16(o[bj][1][0], o[bj][1][1]); w.w = cvt_pk_bf16(o[bj][1][2], o[bj][1][3]);
                    *(u32x4*)(Y + off + bj * HALF) = w; }
                row_sums_add(rso, row, o[0][0], o[0][1], o[1][0], o[1][1], fq); }
    }
};

struct EpiBf16LnTok {
    static constexpr bool PERM = true, AFTER_DRAIN = false, AROWPERM = true;
    bf16_t* O; int ldc; const long long* rs; const float* cs; const float* b2;
    __device__ __forceinline__ void operator()(const f32x4 (&acc)[2][2][4][2], const Unit& u, int wr, int wc, int fr, int fq) const {
        const int row0 = u.pm * BM + 128 * wr + 8 * fr, col0 = u.pn * BM + wc * 32 + 8 * fq;
        f32x4 cv[2][2], bv[2][2];
#pragma unroll
        for (int bj = 0; bj < 2; ++bj)
#pragma unroll
            for (int n = 0; n < 2; ++n) { cv[bj][n] = *(const f32x4*)(cs + col0 + bj * HALF + 4 * n); bv[bj][n] = *(const f32x4*)(b2 + col0 + bj * HALF + 4 * n); }
#pragma unroll
        for (int ai = 0; ai < 2; ++ai)
#pragma unroll
            for (int m = 0; m < 4; ++m) { const int row = row0 + 4 * ai + m; float mean, rstd; row_stats(rs, row, mean, rstd);
                bf16_t* rowp = O + (size_t)row * ldc + col0;
#pragma unroll
                for (int bj = 0; bj < 2; ++bj) { const f32x4 v0 = (acc[ai][bj][m][0] - cv[bj][0] * mean) * rstd + bv[bj][0], v1 = (acc[ai][bj][m][1] - cv[bj][1] * mean) * rstd + bv[bj][1];
                    u32x4 w; w.x = cvt_pk_bf16(v0[0], v0[1]); w.y = cvt_pk_bf16(v0[2], v0[3]); w.z = cvt_pk_bf16(v1[0], v1[1]); w.w = cvt_pk_bf16(v1[2], v1[3]);
                    *(u32x4*)(rowp + bj * HALF) = w; } }
    }
};

__device__ __forceinline__ float dpp_shr1(float x) { return __builtin_bit_cast(float, __builtin_amdgcn_update_dpp(0, __builtin_bit_cast(int, x), 0x111, 0xf, 0xf, true)); }
struct EpiConvGlu {
    static constexpr bool PERM = true, AFTER_DRAIN = false, AROWPERM = true;
    bf16_t* G; bf16_t* side; const long long* rs; const float* cs; const float* b2; const float* cw; int dff;
    __device__ __forceinline__ void operator()(const f32x4 (&acc)[2][2][4][2], const Unit& u, int wr, int wc, int fr, int fq) const {
        const int row0 = u.pm * BM + 128 * wr + 8 * fr, colg = u.pn * BM + wc * 32 + 8 * fq, ch0 = u.pn * HALF + wc * 32 + 8 * fq;
        float mean_[8], rstd_[8];
#pragma unroll
        for (int j = 0; j < 8; ++j) row_stats(rs, row0 + j, mean_[j], rstd_[j]);
        unsigned gout[8][4];
        const int bnd = row0 >> 7;
#pragma unroll
        for (int n = 0; n < 2; ++n) {
            const f32x4 ca = *(const f32x4*)(cs + colg + 4 * n), ba = *(const f32x4*)(b2 + colg + 4 * n), cu = *(const f32x4*)(cs + colg + HALF + 4 * n), bu = *(const f32x4*)(b2 + colg + HALF + 4 * n);
            const f32x4 w0 = *(const f32x4*)(cw + ch0 + 4 * n), w1 = *(const f32x4*)(cw + dff + ch0 + 4 * n), w2 = *(const f32x4*)(cw + 2 * dff + ch0 + 4 * n);
            f32x4 a[8], uu[8];
#pragma unroll
            for (int j = 0; j < 8; ++j) { a[j] = (acc[j >> 2][0][j & 3][n] - ca * mean_[j]) * rstd_[j] + ba; uu[j] = (acc[j >> 2][1][j & 3][n] - cu * mean_[j]) * rstd_[j] + bu; }
            f32x4 p6, p7;
#pragma unroll
            for (int q = 0; q < 4; ++q) { p6[q] = dpp_shr1(a[6][q]); p7[q] = dpp_shr1(a[7][q]); }
            if (fr == 15 && bnd + 1 < 128) { bf16_t* sp = side + ((size_t)(bnd + 1) * 6) * dff + ch0 + 4 * n;
                *(unsigned long long*)(sp) = (unsigned long long)cvt_pk_bf16(a[6][0], a[6][1]) | ((unsigned long long)cvt_pk_bf16(a[6][2], a[6][3]) << 32);
                *(unsigned long long*)(sp + dff) = (unsigned long long)cvt_pk_bf16(a[7][0], a[7][1]) | ((unsigned long long)cvt_pk_bf16(a[7][2], a[7][3]) << 32); }
            if (fr == 0) { bf16_t* sp = side + ((size_t)bnd * 6 + 2) * dff + ch0 + 4 * n;
                *(unsigned long long*)(sp) = (unsigned long long)cvt_pk_bf16(a[0][0], a[0][1]) | ((unsigned long long)cvt_pk_bf16(a[0][2], a[0][3]) << 32);
                *(unsigned long long*)(sp + dff) = (unsigned long long)cvt_pk_bf16(a[1][0], a[1][1]) | ((unsigned long long)cvt_pk_bf16(a[1][2], a[1][3]) << 32);
                *(unsigned long long*)(sp + 2 * dff) = (unsigned long long)cvt_pk_bf16(uu[0][0], uu[0][1]) | ((unsigned long long)cvt_pk_bf16(uu[0][2], uu[0][3]) << 32);
                *(unsigned long long*)(sp + 3 * dff) = (unsigned long long)cvt_pk_bf16(uu[1][0], uu[1][1]) | ((unsigned long long)cvt_pk_bf16(uu[1][2], uu[1][3]) << 32); }
#pragma unroll
            for (int j = 0; j < 8; ++j) { const f32x4 am1 = (j == 0) ? p7 : a[j ? j - 1 : 0], am2 = (j == 0) ? p6 : (j == 1 ? p7 : a[j > 1 ? j - 2 : 0]);
                const f32x4 c = w2 * a[j] + w1 * am1 + w0 * am2;
                const f32x2 g01 = gelu_pk((f32x2){c[0], c[1]}), g23 = gelu_pk((f32x2){c[2], c[3]});
                gout[j][2 * n] = cvt_pk_bf16(g01.x * uu[j][0], g01.y * uu[j][1]); gout[j][2 * n + 1] = cvt_pk_bf16(g23.x * uu[j][2], g23.y * uu[j][3]); }
        }
#pragma unroll
        for (int j = 0; j < 8; ++j) if (!(fr == 0 && j < 2)) { u32x4 w; w.x = gout[j][0]; w.y = gout[j][1]; w.z = gout[j][2]; w.w = gout[j][3]; *(u32x4*)(G + (size_t)(row0 + j) * dff + ch0) = w; }
    }
};
template <class E, class = void> struct arowperm_v { static constexpr bool value = false; };
template <class E> struct arowperm_v<E, decltype((void)E::AROWPERM)> { static constexpr bool value = E::AROWPERM; };
template <class Epi, class Sched, bool ALIGN_EPI = false, bool SP2 = false>
__device__ __forceinline__ void gemm_phase(PG8_LAS unsigned char* lds, const Gemm g, const Sched& S, const Epi& E) {
    int tid_l = threadIdx.x; asm volatile("" : "+v"(tid_l)); const int tid = tid_l, wid = __builtin_amdgcn_readfirstlane(tid >> 6), lane = tid & 63, wr = wid >> 2, wc = wid & 3, fr = lane & 15, fq = lane >> 4;
    const int K = g.K, nt = K / BK;
    unsigned voffA[2], voffB[2];
#pragma unroll
    for (int i = 0; i < 2; ++i) { int R, C; stage_rc(tid * 16 + i * 8192, R, C); const int Rb = Epi::PERM ? ((R & ~31) + perm32(R & 31)) : R;
        const int Ra = arowperm_v<Epi>::value ? (128 * (R >> 6) + 8 * (R & 15) + ((R >> 4) & 3)) : R;
        voffA[i] = (unsigned)(Ra * K + C) * 2u; voffB[i] = (unsigned)(Rb * K + C) * 2u; }
    const size_t hstepA = arowperm_v<Epi>::value ? (size_t)4 * K * 2 : (size_t)HALF * K * 2;
    const size_t kstep = (size_t)(BK * 2);
    const size_t hstep = (size_t)HALF * K * 2;
    const size_t tstep = 2 * hstep;
    const unsigned ldsw = (unsigned)wid * 1024u;
    const int aoff = lds_byte(wr * 64 + fr, fq * 8), boff = lds_byte(wc * 32 + fr, fq * 8);
#define PG8_SA(b, h) (((b) * 2 + (h)) * HTB)
#define PG8_SB(b, h) ((4 + (b) * 2 + (h)) * HTB)
#define PG8_STAGE(bufoff, gbase, voff) do { _Pragma("unroll") for (int _i = 0; _i < 2; ++_i) \
        __builtin_amdgcn_global_load_lds((const unsigned*)((const char*)(gbase) + (voff)[_i]), (PG8_LAS unsigned*)(lds + (bufoff) + ldsw + _i * 8192), 16, 0, 0); } while (0)
#define PG8_LDA(dst, b, h) do { _Pragma("unroll") for (int m = 0; m < 4; ++m) _Pragma("unroll") for (int k = 0; k < 2; ++k) dst[m][k] = *(const PG8_LAS bf16x8*)(lds + PG8_SA(b, h) + aoff + m * 2048 + k * 1024); } while (0)
#define PG8_LDB(dst, b, h) do { _Pragma("unroll") for (int n = 0; n < 2; ++n) _Pragma("unroll") for (int k = 0; k < 2; ++k) dst[n][k] = *(const PG8_LAS bf16x8*)(lds + PG8_SB(b, h) + boff + n * 2048 + k * 1024); } while (0)
#define PG8_MMA(ai, bj, At, Bt) do { __builtin_amdgcn_s_setprio(1); _Pragma("unroll") for (int m = 0; m < 4; ++m) _Pragma("unroll") for (int n = 0; n < 2; ++n) _Pragma("unroll") for (int k = 0; k < 2; ++k) \
        acc[ai][bj][m][n] = __builtin_amdgcn_mfma_f32_16x16x32_bf16(Bt[n][k], At[m][k], acc[ai][bj][m][n], 0, 0, 0); __builtin_amdgcn_s_setprio(0); } while (0)
#define PG8_WAIT_V(n) asm volatile("s_waitcnt vmcnt(" #n ")" ::: "memory")
#define PG8_WAIT_L(n) asm volatile("s_waitcnt lgkmcnt(" #n ")" ::: "memory")
#define PG8_BAR __builtin_amdgcn_s_barrier()
#define PG8_SCHED __builtin_amdgcn_sched_barrier(0)
    Unit cur, nxt; int ui = 0;
    if (!S.next(0, cur)) return;
    f32x4 acc[2][2][4][2];
#pragma unroll
    for (int a = 0; a < 2; ++a)
#pragma unroll
        for (int b = 0; b < 2; ++b)
#pragma unroll
            for (int m = 0; m < 4; ++m)
#pragma unroll
                for (int n = 0; n < 2; ++n) acc[a][b][m][n] = (f32x4){0.f, 0.f, 0.f, 0.f};
    bf16x8 At[4][2], B0[2][2], B1[2][2];
    const char* cA = (const char*)g.A + (size_t)cur.pm * tstep; const char* cB = (const char*)g.Bt + (size_t)cur.pn * tstep;
    S.a_ready(cur);
    if constexpr (SP2) {
        PG8_STAGE(PG8_SB(0, 0), cB, voffB); PG8_STAGE(PG8_SB(0, 1), cB + hstep, voffB); PG8_STAGE(PG8_SA(0, 0), cA, voffA); PG8_STAGE(PG8_SA(0, 1), cA + hstepA, voffA);
        if (wr == 1) PG8_BAR;
        PG8_WAIT_V(2); PG8_BAR;
        PG8_STAGE(PG8_SB(1, 0), cB + kstep, voffB); PG8_STAGE(PG8_SA(1, 0), cA + kstep, voffA); PG8_STAGE(PG8_SB(1, 1), cB + hstep + kstep, voffB);
        PG8_WAIT_V(6); PG8_BAR;
    } else {
        PG8_STAGE(PG8_SB(0, 0), cB, voffB); PG8_STAGE(PG8_SA(0, 0), cA, voffA); PG8_STAGE(PG8_SB(0, 1), cB + hstep, voffB); PG8_STAGE(PG8_SA(0, 1), cA + hstepA, voffA);
        if (wr == 1) PG8_BAR;
        PG8_WAIT_V(4); PG8_BAR;
        PG8_STAGE(PG8_SB(1, 0), cB + kstep, voffB); PG8_STAGE(PG8_SA(1, 0), cA + kstep, voffA); PG8_STAGE(PG8_SB(1, 1), cB + hstep + kstep, voffB);
        PG8_WAIT_V(6); PG8_BAR;
    }
    for (;;) {
        const bool has_next = S.next(ui + 1, nxt);
        const char* nA = has_next ? (const char*)g.A + (size_t)nxt.pm * tstep : cA; const char* nB = has_next ? (const char*)g.Bt + (size_t)nxt.pn * tstep : cB;
        for (int t = 0; t < nt; t += 2) {
            const bool last = (t == nt - 2);
            const char* a1 = cA + (size_t)(t + 1) * kstep;
            const char* a2 = last ? nA : cA + (size_t)(t + 2) * kstep; const char* b2 = last ? nB : cB + (size_t)(t + 2) * kstep;
            const char* a3 = a2 + kstep; const char* b3 = b2 + kstep;
            if (last && has_next) S.a_ready(nxt);
            if constexpr (SP2) {
            PG8_LDB(B0, 0, 0); PG8_LDB(B1, 0, 1); PG8_SCHED; PG8_LDA(At, 0, 0); PG8_STAGE(PG8_SA(1, 1), a1 + hstepA, voffA);
            PG8_WAIT_V(8); PG8_WAIT_L(0); PG8_BAR; PG8_MMA(0, 0, At, B0); PG8_MMA(0, 1, At, B1); PG8_BAR; PG8_SCHED;
            PG8_LDA(At, 0, 1); PG8_STAGE(PG8_SB(0, 0), b2, voffB); PG8_STAGE(PG8_SB(0, 1), b2 + hstep, voffB); PG8_STAGE(PG8_SA(0, 0), a2, voffA);
            PG8_WAIT_V(8); PG8_WAIT_L(0); PG8_BAR; PG8_MMA(1, 0, At, B0); PG8_MMA(1, 1, At, B1); PG8_BAR; PG8_SCHED;
            PG8_LDB(B0, 1, 0); PG8_LDB(B1, 1, 1); PG8_SCHED; PG8_LDA(At, 1, 0); PG8_STAGE(PG8_SA(0, 1), a2 + hstepA, voffA);
            PG8_WAIT_V(8); PG8_WAIT_L(0); PG8_BAR; PG8_MMA(0, 0, At, B0); PG8_MMA(0, 1, At, B1); PG8_BAR; PG8_SCHED;
            PG8_LDA(At, 1, 1); PG8_STAGE(PG8_SB(1, 0), b3, voffB); PG8_STAGE(PG8_SB(1, 1), b3 + hstep, voffB); PG8_STAGE(PG8_SA(1, 0), a3, voffA);
            PG8_WAIT_V(8); PG8_WAIT_L(0); PG8_BAR; PG8_MMA(1, 0, At, B0); PG8_MMA(1, 1, At, B1); PG8_BAR; PG8_SCHED;
            } else {
            PG8_LDB(B0, 0, 0); PG8_SCHED; PG8_LDA(At, 0, 0); PG8_STAGE(PG8_SA(1, 1), a1 + hstepA, voffA);
            PG8_WAIT_L(8); PG8_BAR; PG8_WAIT_L(0); PG8_MMA(0, 0, At, B0); PG8_BAR; PG8_SCHED;
            PG8_LDB(B1, 0, 1); PG8_STAGE(PG8_SB(0, 0), b2, voffB);
            PG8_BAR; PG8_WAIT_L(0); PG8_MMA(0, 1, At, B1); PG8_BAR;
            PG8_LDA(At, 0, 1); PG8_STAGE(PG8_SA(0, 0), a2, voffA);
            PG8_BAR; PG8_WAIT_L(0); PG8_MMA(1, 0, At, B0); PG8_BAR; PG8_SCHED;
            PG8_STAGE(PG8_SB(0, 1), b2 + hstep, voffB);
            PG8_WAIT_V(6); PG8_BAR; PG8_MMA(1, 1, At, B1); PG8_BAR;
            PG8_LDB(B0, 1, 0); PG8_SCHED; PG8_LDA(At, 1, 0); PG8_STAGE(PG8_SA(0, 1), a2 + hstepA, voffA);
            PG8_WAIT_L(8); PG8_BAR; PG8_WAIT_L(0); PG8_MMA(0, 0, At, B0); PG8_BAR; PG8_SCHED;
            PG8_LDB(B1, 1, 1); PG8_STAGE(PG8_SB(1, 0), b3, voffB);
            PG8_BAR; PG8_WAIT_L(0); PG8_MMA(0, 1, At, B1); PG8_BAR;
            PG8_LDA(At, 1, 1); PG8_STAGE(PG8_SA(1, 0), a3, voffA);
            PG8_BAR; PG8_WAIT_L(0); PG8_MMA(1, 0, At, B0); PG8_BAR; PG8_SCHED;
            PG8_STAGE(PG8_SB(1, 1), b3 + hstep, voffB);
            PG8_WAIT_V(6); PG8_BAR; PG8_MMA(1, 1, At, B1); PG8_BAR;
            }
        }
        if constexpr (ALIGN_EPI) { if (wr == 0) PG8_BAR; }
        if constexpr (!Epi::AFTER_DRAIN) { E(acc, cur, wr, wc, fr, fq); S.done(cur); }
        if (!has_next) break;
#pragma unroll
        for (int a = 0; a < 2; ++a)
#pragma unroll
            for (int b = 0; b < 2; ++b)
#pragma unroll
                for (int m = 0; m < 4; ++m)
#pragma unroll
                    for (int n = 0; n < 2; ++n) acc[a][b][m][n] = (f32x4){0.f, 0.f, 0.f, 0.f};
        cur = nxt; cA = nA; cB = nB; ++ui;
        if constexpr (ALIGN_EPI) { if (wr == 1) PG8_BAR; }
    }
    PG8_WAIT_V(0);
    if constexpr (!ALIGN_EPI) { if (wr == 0) PG8_BAR; }
    PG8_BAR;
    if constexpr (Epi::AFTER_DRAIN) { E.fused(acc, cur, wr, wc, fr, fq, lds, wid, lane); S.done(cur); }
#undef PG8_SA
#undef PG8_SB
#undef PG8_STAGE
#undef PG8_LDA
#undef PG8_LDB
#undef PG8_MMA
#undef PG8_WAIT_V
#undef PG8_WAIT_L
#undef PG8_BAR
#undef PG8_SCHED
}
}

#ifndef PG8_SP2
#define PG8_SP2 true
#endif
#ifndef PG8_ALIGN
#define PG8_ALIGN true
#endif
constexpr int NWAVES = 8, NTHR = 512;
constexpr int BATCH = 2, SEQ = 8192, DM = 4096, MTOK = BATCH * SEQ;
constexpr int HD = 128;
constexpr int A_HEADS = 16, B_HEADS = 16, A_W = 2048, B_W = 2048, AB_IN = 4 * A_W + 3 * B_W;
constexpr int NSA_H = 32, NSA_G = 4, NSA_R = 8, KVW = 512, NSA_IN = 4096 + 6 * KVW + 96, NSA_INP = 7424;
constexpr int NCMP = 511, NCMPP = 512, NSLC = 128, NTOP = 16, WINDOW = 512;
constexpr int NMEM = 256, XH = 4, XW = 512;
constexpr int DFF = 11008, DFF2 = 22016;
constexpr float LN_EPS = 1e-5f, RMS_EPS = 1e-6f;
constexpr float DN_ALPHA = 1.41421356237309515f;
constexpr size_t MiB = (size_t)1 << 20;
constexpr size_t WS_CTL = 0, CTL_ZERO_BYTES = 4 * MiB;
constexpr size_t WS_FOLD = 64 * 1024;
constexpr int FO_XQ = 0, FO_UP = 2 * 512, FO_NSA = FO_UP + 2 * 22016, FO_N = FO_NSA + 7424;
constexpr size_t WS_RSUM = 1 * MiB;
static_assert(WS_FOLD + (size_t)2 * FO_N * 8 <= WS_RSUM && WS_RSUM + (size_t)6 * 16384 * 2 * 8 <= CTL_ZERO_BYTES, "CTL map");
constexpr size_t WS_W_ABIN = 4 * MiB;
constexpr size_t WS_W_ABOUT = WS_W_ABIN + 112 * MiB;
constexpr size_t WS_W_NSAIN = WS_W_ABOUT + 32 * MiB;
constexpr size_t WS_W_NSAOUT = WS_W_NSAIN + 58 * MiB;
constexpr size_t WS_W_XQ = WS_W_NSAOUT + 32 * MiB;
constexpr size_t WS_W_XKV = WS_W_XQ + 8 * MiB;
constexpr size_t WS_W_XO = WS_W_XKV + 16 * MiB;
constexpr size_t WS_W_UP = WS_W_XO + 8 * MiB;
constexpr size_t WS_W_DOWN = WS_W_UP + 344 * MiB;
constexpr size_t WS_W_C1 = WS_W_DOWN + 172 * MiB;
constexpr size_t WS_W_C2 = WS_W_C1 + 2 * MiB;
constexpr size_t WS_MEMB = WS_W_C2 + 1 * MiB;
constexpr size_t WS_HB = WS_MEMB + 4 * MiB;
constexpr size_t WS_Y = WS_HB + 128 * MiB;
constexpr size_t WS_BIG = WS_Y + 256 * MiB;
constexpr size_t WS_G = WS_BIG + 688 * MiB;
constexpr size_t WS_O = WS_G + 344 * MiB;
constexpr size_t WS_MISC = WS_O + 128 * MiB;
constexpr size_t WS_END = WS_MISC + 64 * MiB;
constexpr size_t WS_XQ = WS_MISC;
constexpr size_t WS_XO = WS_MISC + 16 * MiB;
constexpr size_t WS_XKV = WS_MISC + 32 * MiB;
constexpr size_t WS_LB = WS_MISC + 34 * MiB;
constexpr size_t WS_SIDE = WS_MISC + 42 * MiB;
constexpr size_t WS_FOLDF = WS_MISC + 40 * MiB;
constexpr size_t WS_ROPE = WS_MISC + 36 * MiB;
constexpr size_t WS_STATS = WS_MISC + 35 * MiB;
constexpr size_t WS_PROJ0 = WS_BIG;
constexpr size_t WS_SPREV = WS_BIG + 448 * MiB;
constexpr size_t WS_QT = WS_G;
constexpr size_t WS_OINTRA = WS_G + 64 * MiB;
constexpr size_t WS_DEC = WS_G + 192 * MiB;
constexpr size_t WS_DS = WS_Y;
constexpr size_t WS_PROJ1 = WS_BIG;
constexpr size_t WS_QROT = WS_BIG + 232 * MiB;
constexpr size_t WS_KSROT = WS_BIG + 360 * MiB;
constexpr size_t WS_KWROT = WS_BIG + 376 * MiB;
constexpr size_t WS_KCMP = WS_BIG + 392 * MiB;
constexpr size_t WS_VCMP = WS_BIG + 393 * MiB;
constexpr size_t WS_OVL = WS_BIG + 394 * MiB;
constexpr size_t WS_SEL = WS_BIG + 395 * MiB;
constexpr size_t WS_IMP = WS_G + 256 * MiB;
constexpr size_t WS_O32 = WS_G;
static_assert(WS_SPREV + 128 * MiB <= WS_G && WS_DEC + 2 * MiB <= WS_O && WS_SEL + MiB <= WS_G, "ws map");
constexpr int CW_TMO = 0, CW_CODE = 1;
constexpr int CW_BAR = 4096;
constexpr int RING_OFF = 0, RING_BYTES = 131072;
constexpr int LDSCTL_OFF = RING_BYTES, MISC_OFF = LDSCTL_OFF + 320;
constexpr int LDS_BYTES = 147456;
static_assert(MISC_OFF + 128 <= LDS_BYTES, "LDS map");

#define GAS __attribute__((address_space(1)))
#define LAS __attribute__((address_space(3)))
typedef unsigned short bf16;
typedef unsigned v4u __attribute__((ext_vector_type(4)));
typedef unsigned v2u __attribute__((ext_vector_type(2)));
typedef float f32x4 __attribute__((ext_vector_type(4)));
typedef float f32x2 __attribute__((ext_vector_type(2)));
typedef float f32x16 __attribute__((ext_vector_type(16)));
typedef short bf16x8 __attribute__((ext_vector_type(8)));
typedef short s16x4 __attribute__((ext_vector_type(4)));
typedef GAS unsigned gu32;
#define RLX_AGENT __ATOMIC_RELAXED, __HIP_MEMORY_SCOPE_AGENT
#define LDS_WAIT() asm volatile("s_waitcnt lgkmcnt(0)" ::: "memory")
#define VM_WAIT() asm volatile("s_waitcnt vmcnt(0)" ::: "memory")
#define SBAR() __builtin_amdgcn_sched_barrier(0)
__device__ __forceinline__ unsigned f2bf(float f) { unsigned u = __builtin_bit_cast(unsigned, f); return (u + 0x7fffu + ((u >> 16) & 1u)) >> 16; }
__device__ __forceinline__ unsigned pk2(float lo, float hi) { return f2bf(lo) | (f2bf(hi) << 16); }
__device__ __forceinline__ float bf2f(unsigned short b) { return __builtin_bit_cast(float, (unsigned)b << 16); }
__device__ __forceinline__ float bflo(unsigned w) { return __builtin_bit_cast(float, w << 16); }
__device__ __forceinline__ float bfhi(unsigned w) { return __builtin_bit_cast(float, w & 0xffff0000u); }
__device__ __forceinline__ unsigned cvtpk(float lo, float hi) { unsigned r; asm volatile("v_cvt_pk_bf16_f32 %0, %1, %2" : "=v"(r) : "v"(lo), "v"(hi)); return r; }
__device__ __forceinline__ float wave_sum(float v) {
#pragma unroll
    for (int o = 1; o < 64; o <<= 1) v += __shfl_xor(v, o);
    return v;
}
__device__ __forceinline__ float sigmoidf_(float x) { return __builtin_amdgcn_rcpf(1.f + __builtin_amdgcn_exp2f(-1.4426950408889634f * x)); }
__device__ __forceinline__ float gelu1(float v) { pg8::f32x2 r = pg8::gelu_pk((pg8::f32x2){v, 0.f}); return r.x; }
#define XB_TMO      128
#define XB_XCNT(j)  (256  + 64 * (j))
#define XB_XSUB(j)  (1280 + 64 * (j))
#define XB_XGEN(j)  (2304 + 64 * (j))
#define XB_TOP      3328
#define XB_TOPGEN   3392
#define XCD_BAR_WORDS 3456
#define XB_SPIN_CAP (1u << 18)
#define LAS __attribute__((address_space(3)))

__device__ __forceinline__ unsigned xb_ld(unsigned* p)              { return __hip_atomic_load(p, __ATOMIC_RELAXED, __HIP_MEMORY_SCOPE_AGENT); }
__device__ __forceinline__ unsigned xb_add(unsigned* p, unsigned v) { return __hip_atomic_fetch_add(p, v, __ATOMIC_RELAXED, __HIP_MEMORY_SCOPE_AGENT); }
__device__ __forceinline__ unsigned xb_xcc_id() { return (unsigned)__builtin_amdgcn_s_getreg((3 << 11) | 20) & 0xFu; }
#define XB_SPIN(cond, bar) do { unsigned _sp = 0; while (cond) { __builtin_amdgcn_s_sleep(1); \
    if ((++_sp & 255u) == 0u) { if (xb_ld(&(bar)[XB_TMO])) break; if (_sp > XB_SPIN_CAP) { atomicAdd(&(bar)[XB_TMO], 1u); break; } } } } while (0)

struct XcdBarrier {
    unsigned* bar; unsigned x;
    volatile LAS unsigned* st;
};

__device__ __forceinline__ XcdBarrier xcd_barrier_post(unsigned* bar, volatile LAS unsigned* st) {
    XcdBarrier b; b.bar = bar; b.x = xb_xcc_id(); b.st = st;
    if (threadIdx.x == 0) (void)xb_add(&bar[XB_XCNT(b.x)], 1u);
    return b;
}
__device__ __forceinline__ void xcd_barrier_complete(unsigned* bar, unsigned x, unsigned& nloc, unsigned& nx) {
    const unsigned G = gridDim.x * gridDim.y * gridDim.z;
    unsigned sum, cnt, mine, sp = 0u;
    for (;;) {
        sum = 0u; cnt = 0u; mine = 0u;
#pragma unroll
        for (unsigned j = 0; j < 16; ++j) { const unsigned c = xb_ld(&bar[XB_XCNT(j)]); sum += c; cnt += (c > 0u) ? 1u : 0u; mine = (j == x) ? c : mine; }
        if (sum == G) break;
        __builtin_amdgcn_s_sleep(1);
        if ((++sp & 255u) == 0u) { if (xb_ld(&bar[XB_TMO])) break; if (sp > XB_SPIN_CAP) { atomicAdd(&bar[XB_TMO], 1u); break; } }
    }
    nloc = mine > 0u ? mine : 1u; nx = cnt > 0u ? cnt : 1u;
}

__device__ __forceinline__ void xcd_barrier(const XcdBarrier& b) {
    asm volatile("s_waitcnt vmcnt(0)" ::: "memory");
    __syncthreads();
    if (threadIdx.x == 0) {
        unsigned* bar = b.bar;
        __builtin_amdgcn_s_waitcnt(0);
        unsigned nloc = b.st[0], nx = b.st[1];
        if (nloc == 0u) { xcd_barrier_complete(bar, b.x, nloc, nx); b.st[0] = nloc; b.st[1] = nx; }
        const unsigned old = xb_add(&bar[XB_XSUB(b.x)], 1u);
        const unsigned gen = old / nloc;
        if (old + 1u == (gen + 1u) * nloc) {
            __builtin_amdgcn_fence(__ATOMIC_RELEASE, "agent");
            asm volatile("s_waitcnt vmcnt(0)" ::: "memory");
            const unsigned og = xb_add(&bar[XB_TOP], 1u);
            const unsigned tg = og / nx;
            if (og + 1u == (tg + 1u) * nx) xb_add(&bar[XB_TOPGEN], 1u);
            else XB_SPIN(xb_ld(&bar[XB_TOPGEN]) == tg, bar);
            __builtin_amdgcn_fence(__ATOMIC_ACQUIRE, "agent");
            xb_add(&bar[XB_XGEN(b.x)], 1u);
            asm volatile("s_waitcnt vmcnt(0)" ::: "memory");
        } else {
            XB_SPIN(xb_ld(&bar[XB_XGEN(b.x)]) == gen, bar);
            __builtin_amdgcn_fence(__ATOMIC_ACQUIRE, "agent");
            asm volatile("s_waitcnt vmcnt(0)" ::: "memory");
        }
    }
    __syncthreads();
}


constexpr int ATT_D = 128, KVBLK = 64;
constexpr int SHM_V = KVBLK * ATT_D * 2, SHM_K = KVBLK * ATT_D * 2;
constexpr int ATT_K_OFF = 0, ATT_V_OFF = SHM_K, ATT_BUF = SHM_K + SHM_V, ATT_SET = 2 * ATT_BUF;
constexpr int ATT_WS_OFF = RING_BYTES + 512;
constexpr int ATT_X_OFF = ATT_WS_OFF + NWAVES * 256;
static_assert(2 * ATT_SET <= RING_BYTES && ATT_X_OFF + 2048 + NTHR * 16 <= LDS_BYTES, "attention LDS map");
#define KSWZ(row, colB) ((row) * 256 + ((colB) ^ (((row) & 7) << 4)))
__device__ __forceinline__ int crow(int r, int hi) { return (r & 3) + 8 * (r >> 2) + 4 * hi; }
__device__ __forceinline__ int v_st(int k, int c) { const int kk = (k & ~0xC) | ((k & 4) << 1) | ((k & 8) >> 1); return ((kk >> 3) * 4 + (c >> 5)) * 512 + ((kk & 7) * 32 + (c & 31)) * 2; }
__device__ __forceinline__ int v_rd_base(int lane) { return ((lane & 3) << 3) | (((lane >> 2) & 3) << 6) | (((lane >> 4) & 1) << 5) | (((lane >> 5) & 1) << 8); }
constexpr int v_rd_off(int d0, int ks, int half) { return d0 * 512 + ks * 4096 + half * 2048; }
template <int OFF> __device__ __forceinline__ s16x4 tr_read(int vb) {
  s16x4 r; asm volatile("ds_read_b64_tr_b16 %0, %1 offset:%2" : "=&v"(r) : "v"(vb), "i"(OFF) : "memory"); return r;
}
__device__ __forceinline__ void qkt(f32x16& p0, f32x16& p1, const LAS char* Ks, const bf16x8* qr, int r32, int hi) {
  p0 = f32x16{}; p1 = f32x16{};
#pragma unroll
  for (int d0 = 0; d0 < 8; ++d0) { const int cb = (d0 * 16 + hi * 8) * 2;
    const bf16x8 b0 = *(const LAS bf16x8*)(Ks + KSWZ(r32, cb));
    const bf16x8 b1 = *(const LAS bf16x8*)(Ks + KSWZ(32 + r32, cb));
    p0 = __builtin_amdgcn_mfma_f32_32x32x16_bf16(b0, qr[d0], p0, 0, 0, 0);
    p1 = __builtin_amdgcn_mfma_f32_32x32x16_bf16(b1, qr[d0], p1, 0, 0, 0); }
}
__device__ __forceinline__ void pack_p(const f32x16& p0, const f32x16& p1, bf16x8& pa0, bf16x8& pa1, bf16x8& pa2, bf16x8& pa3) {
#define PK4(P, BASE, OUT) do { unsigned a0 = cvtpk(P[BASE + 0], P[BASE + 1]), a1 = cvtpk(P[BASE + 2], P[BASE + 3]);   \
    unsigned b0 = cvtpk(P[BASE + 4], P[BASE + 5]), b1 = cvtpk(P[BASE + 6], P[BASE + 7]);                              \
    auto r0 = __builtin_amdgcn_permlane32_swap(a0, b0, false, false); auto r1 = __builtin_amdgcn_permlane32_swap(a1, b1, false, false); \
    v4u w = {r0[0], r1[0], r0[1], r1[1]}; OUT = __builtin_bit_cast(bf16x8, w); } while (0)
  PK4(p0, 0, pa0); PK4(p0, 8, pa1); PK4(p1, 0, pa2); PK4(p1, 8, pa3);
#undef PK4
}
template <int D0> __device__ __forceinline__ void pv_one(f32x16& od, int vb, bf16x8 pa0, bf16x8 pa1, bf16x8 pa2, bf16x8 pa3) {
  const s16x4 l0 = tr_read<v_rd_off(D0, 0, 0)>(vb), h0 = tr_read<v_rd_off(D0, 0, 1)>(vb), l1 = tr_read<v_rd_off(D0, 1, 0)>(vb), h1 = tr_read<v_rd_off(D0, 1, 1)>(vb);
  const s16x4 l2 = tr_read<v_rd_off(D0, 2, 0)>(vb), h2 = tr_read<v_rd_off(D0, 2, 1)>(vb), l3 = tr_read<v_rd_off(D0, 3, 0)>(vb), h3 = tr_read<v_rd_off(D0, 3, 1)>(vb);
  asm volatile("s_waitcnt lgkmcnt(0)" ::: "memory"); SBAR();
#define PKV(L, H) (bf16x8){L[0], L[1], L[2], L[3], H[0], H[1], H[2], H[3]}
  od = __builtin_amdgcn_mfma_f32_32x32x16_bf16(pa0, PKV(l0, h0), od, 0, 0, 0);
  od = __builtin_amdgcn_mfma_f32_32x32x16_bf16(pa1, PKV(l1, h1), od, 0, 0, 0);
  od = __builtin_amdgcn_mfma_f32_32x32x16_bf16(pa2, PKV(l2, h2), od, 0, 0, 0);
  od = __builtin_amdgcn_mfma_f32_32x32x16_bf16(pa3, PKV(l3, h3), od, 0, 0, 0);
#undef PKV
}
__device__ __forceinline__ void pv_d0(f32x16* o, int vb, bf16x8 pa0, bf16x8 pa1, bf16x8 pa2, bf16x8 pa3) {
  pv_one<0>(o[0], vb, pa0, pa1, pa2, pa3); pv_one<1>(o[1], vb, pa0, pa1, pa2, pa3); pv_one<2>(o[2], vb, pa0, pa1, pa2, pa3); pv_one<3>(o[3], vb, pa0, pa1, pa2, pa3);
}
struct KVStage { bf16x8 ks0, ks1, vs0, vs1; };
__device__ __forceinline__ void kv_load(KVStage& s, const bf16* Kh, const bf16* Vh, long ldk, long ldv, int k0, int sr, int sc) {
  s.ks0 = *(const bf16x8*)(Kh + (long)(k0 + sr) * ldk + sc); s.ks1 = *(const bf16x8*)(Kh + (long)(k0 + 32 + sr) * ldk + sc);
  s.vs0 = *(const bf16x8*)(Vh + (long)(k0 + sr) * ldv + sc); s.vs1 = *(const bf16x8*)(Vh + (long)(k0 + 32 + sr) * ldv + sc);
}
__device__ __forceinline__ void kv_write(const KVStage& s, LAS char* lds, int sr, int sc) {
  *(LAS bf16x8*)(lds + ATT_V_OFF + v_st(sr, sc)) = s.vs0; *(LAS bf16x8*)(lds + ATT_V_OFF + v_st(32 + sr, sc)) = s.vs1;
  *(LAS bf16x8*)(lds + ATT_K_OFF + KSWZ(sr, sc * 2)) = s.ks0; *(LAS bf16x8*)(lds + ATT_K_OFF + KSWZ(32 + sr, sc * 2)) = s.ks1;
}
struct KVDma { int ko[2], vo[2]; };
__device__ __forceinline__ void kv_dma_init(KVDma& d, int ldk, int ldv, int wid, int lane) {
#pragma unroll
  for (int i = 0; i < 2; ++i) { const int p = wid * 2 + i;
    const int row = p * 4 + (lane >> 4), cp = lane & 15; d.ko[i] = row * ldk + ((cp ^ (row & 7)) << 3);
    const int sub = p * 2 + (lane >> 5), kk = (sub >> 2) * 8 + ((lane & 31) >> 2), k = (kk & ~0xC) | ((kk & 4) << 1) | ((kk & 8) >> 1), c = (sub & 3) * 32 + (lane & 3) * 8;
    d.vo[i] = k * ldv + c; }
}
__device__ __forceinline__ void kv_dma(const KVDma& d, const bf16* Kt, const bf16* Vt, LAS char* lds, int buf, int wid) {
#pragma unroll
  for (int i = 0; i < 2; ++i) {
    __builtin_amdgcn_global_load_lds((const unsigned*)(Kt + d.ko[i]), (LAS unsigned*)(lds + buf + ATT_K_OFF + (wid * 2 + i) * 1024), 16, 0, 0);
    __builtin_amdgcn_global_load_lds((const unsigned*)(Vt + d.vo[i]), (LAS unsigned*)(lds + buf + ATT_V_OFF + (wid * 2 + i) * 1024), 16, 0, 0); }
}
__device__ __forceinline__ void rescale_o(f32x16* o, float a, LAS float* al_l, int r32, int hi) {
  if (__any(a < 1.f)) { if (hi == 0) al_l[r32] = a; LDS_WAIT();
#pragma unroll
    for (int r = 0; r < 16; ++r) { const float f = al_l[crow(r, hi)];
#pragma unroll
      for (int d = 0; d < 4; ++d) o[d][r] *= f; }
    LDS_WAIT(); }
}
constexpr float ATT_SCALE = 0.088388347648318440f, ATT_C = ATT_SCALE * 1.4426950408889634f, ATT_THR = 8.f;
__device__ __forceinline__ void softmax_tile(f32x16& p0, f32x16& p1, float& m_reg, float& l_reg, float& alpha, bool rowvalid = true) {
  float pmax = p0[0];
#pragma unroll
  for (int r = 1; r < 16; ++r) pmax = fmaxf(pmax, p0[r]);
#pragma unroll
  for (int r = 0; r < 16; ++r) pmax = fmaxf(pmax, p1[r]);
  { auto rr = __builtin_amdgcn_permlane32_swap(__float_as_uint(pmax), __float_as_uint(pmax), false, false);
    pmax = fmaxf(__uint_as_float(rr[0]), __uint_as_float(rr[1])); }
  if (!rowvalid) pmax = -__builtin_inff();
  float mn;
  if (__all(pmax - m_reg <= ATT_THR / ATT_SCALE)) { mn = m_reg; alpha = 1.f; }
  else { mn = fmaxf(m_reg, pmax); alpha = __builtin_amdgcn_exp2f((m_reg - mn) * ATT_C); m_reg = mn; }
  const float mnC = rowvalid ? -mn * ATT_C : -__builtin_inff();
#pragma unroll
  for (int r = 0; r < 16; ++r) { p0[r] = __builtin_amdgcn_exp2f(fmaf(p0[r], ATT_C, mnC)); p1[r] = __builtin_amdgcn_exp2f(fmaf(p1[r], ATT_C, mnC)); }
  float ps = 0.f;
#pragma unroll
  for (int r = 0; r < 16; ++r) ps += p0[r] + p1[r];
  { auto rr = __builtin_amdgcn_permlane32_swap(__float_as_uint(ps), __float_as_uint(ps), false, false);
    ps = __uint_as_float(rr[0]) + __uint_as_float(rr[1]); }
  l_reg = l_reg * alpha + ps;
}
__device__ __forceinline__ void attn_finish(f32x16& p0, f32x16& p1, f32x16* o, float& m_reg, float& l_reg, LAS float* wsc, int vb, int r32, int hi, bool rowvalid = true) {
  float alpha; softmax_tile(p0, p1, m_reg, l_reg, alpha, rowvalid);
  rescale_o(o, alpha, wsc, r32, hi);
  bf16x8 pa0, pa1, pa2, pa3; pack_p(p0, p1, pa0, pa1, pa2, pa3);
  pv_d0(o, vb, pa0, pa1, pa2, pa3);
}
__device__ __forceinline__ void load_q(bf16x8* qr, const bf16* Qw) {
#pragma unroll
  for (int d0 = 0; d0 < 8; ++d0) qr[d0] = *(const bf16x8*)(Qw + d0 * 16);
}

struct Frame {
    LAS unsigned char* lds;
    unsigned char* ws;
    int tid, lane, wave, G, bid;
    __device__ __forceinline__ void fresh() { int t = threadIdx.x; asm volatile("" : "+v"(t)); tid = t; lane = t & 63; wave = __builtin_amdgcn_readfirstlane(t >> 6);
        int g_ = gridDim.x, b_ = blockIdx.x; asm volatile("" : "+s"(g_), "+s"(b_)); G = g_; bid = b_; }
};
struct Args { const float* in[19]; float* out; unsigned char* ws; int ph_lo, ph_hi; };
typedef const Args __attribute__((address_space(4))) KArgs;
__device__ __forceinline__ KArgs* karg() { KArgs* p = (KArgs*)__builtin_amdgcn_kernarg_segment_ptr(); asm volatile("" : "+s"(p)); return p; }
#define KIN(i) ((const float*)karg()->in[i])
enum { IN_X = 0, IN_MEM, IN_AB_W_IN, IN_HGRN_LB, IN_HGRN_NW, IN_AB_W_OUT, IN_NSA_W_IN, IN_NSA_CMP_POS, IN_NSA_CMP_W1, IN_NSA_CMP_W2, IN_NSA_W_OUT,
       IN_XA_WQ, IN_XA_WKV, IN_XA_WO, IN_FFN_UP, IN_FFN_CONV, IN_FFN_DOWN, IN_LN_G, IN_LN_B };

__device__ __forceinline__ void p0_transpose_item(const float* W, int K, int N, bf16* WT, LAS float* scr, int item, int lane) {
    const int nblk = N / 32, kb = item / nblk, nb = item % nblk, k0 = 64 * kb, n0 = 32 * nb;
#pragma unroll 8
    for (int i = 0; i < 32; ++i) { const int kk = 2 * i + (lane >> 5); scr[kk * 33 + (lane & 31)] = W[(size_t)(k0 + kk) * N + n0 + (lane & 31)]; }
    LDS_WAIT(); asm volatile("" ::: "memory");
    const int c = lane & 7;
#pragma unroll
    for (int j = 0; j < 4; ++j) { const int n = (lane >> 3) + 8 * j; const LAS float* s = scr + (8 * c) * 33 + n;
        v4u o; o.x = pk2(s[0 * 33], s[1 * 33]); o.y = pk2(s[2 * 33], s[3 * 33]); o.z = pk2(s[4 * 33], s[5 * 33]); o.w = pk2(s[6 * 33], s[7 * 33]);
        *(GAS v4u*)(WT + (size_t)(n0 + n) * K + k0 + 8 * c) = o; }
    LDS_WAIT(); asm volatile("" ::: "memory");
}
__device__ __forceinline__ int up_col(int n) { const int isu = n >= DFF, ch = isu ? n - DFF : n; return (ch >> 7) * 256 + isu * 128 + (ch & 127); }
__device__ __forceinline__ void p0_transpose_item_fold(const float* W, int K, int N, bf16* WT, LAS float* scr, int item, int lane, const float* g, const float* b, long long* cs, long long* b2, bool upmap = false) {
    const int nblk = N / 32, kb = item / nblk, nb = item % nblk, k0 = 64 * kb, n0 = 32 * nb, n0m = upmap ? up_col(n0) : n0;
#pragma unroll 8
    for (int i = 0; i < 32; ++i) { const int kk = 2 * i + (lane >> 5); scr[kk * 33 + (lane & 31)] = W[(size_t)(k0 + kk) * N + n0 + (lane & 31)]; }
    LDS_WAIT(); asm volatile("" ::: "memory");
    const int c = lane & 7;
    const f32x4 g0 = *(const f32x4*)(g + k0 + 8 * c), g1 = *(const f32x4*)(g + k0 + 8 * c + 4), b0 = *(const f32x4*)(b + k0 + 8 * c), b1 = *(const f32x4*)(b + k0 + 8 * c + 4);
    const float gg[8] = {g0.x, g0.y, g0.z, g0.w, g1.x, g1.y, g1.z, g1.w}, bb[8] = {b0.x, b0.y, b0.z, b0.w, b1.x, b1.y, b1.z, b1.w};
#pragma unroll
    for (int j = 0; j < 4; ++j) { const int n = (lane >> 3) + 8 * j; const LAS float* s = scr + (8 * c) * 33 + n;
        float sc = 0.f, sb = 0.f; unsigned w[4];
#pragma unroll
        for (int q = 0; q < 4; ++q) { const float x0 = s[(2 * q) * 33], x1 = s[(2 * q + 1) * 33]; const unsigned r0 = f2bf(x0 * gg[2 * q]), r1 = f2bf(x1 * gg[2 * q + 1]);
            w[q] = r0 | (r1 << 16); sc += bf2f((unsigned short)r0) + bf2f((unsigned short)r1); sb += x0 * bb[2 * q] + x1 * bb[2 * q + 1]; }
        *(GAS v4u*)(WT + (size_t)(n0m + n) * K + k0 + 8 * c) = (v4u){w[0], w[1], w[2], w[3]};
        sc += __shfl_xor(sc, 1); sc += __shfl_xor(sc, 2); sc += __shfl_xor(sc, 4); sb += __shfl_xor(sb, 1); sb += __shfl_xor(sb, 2); sb += __shfl_xor(sb, 4);
        if (c == 0) { atomicAdd((unsigned long long*)(cs + n0m + n), (unsigned long long)(long long)rintf(sc * pg8::FOLD_SCALE)); atomicAdd((unsigned long long*)(b2 + n0m + n), (unsigned long long)(long long)rintf(sb * pg8::FOLD_SCALE)); } }
    LDS_WAIT(); asm volatile("" ::: "memory");
}
__device__ __forceinline__ void transpose_mat_fold(Frame& F, const float* W, int K, int N, bf16* WT, const float* g, const float* b, long long* cs, long long* b2, int c0 = 0, int nw = 1 << 30, int part = 0, int nparts = 1, bool upmap = false) {
    if (F.bid < c0 || F.bid >= c0 + nw) return;
    LAS float* scr = (LAS float*)(F.lds + RING_OFF + F.wave * 16384);
    const int nwg = nw < F.G ? nw : F.G, gw = (F.bid - c0) * NWAVES + F.wave, NGW = nwg * NWAVES;
    const int nitems = (K / 64) * (N / 32), ilo = (int)((long)nitems * part / nparts), ihi = (int)((long)nitems * (part + 1) / nparts);
    for (int it = ilo + gw; it < ihi; it += NGW) p0_transpose_item_fold(W, K, N, WT, scr, it, F.lane, g, b, cs, b2, upmap);
}
__device__ __forceinline__ void transpose_mat(Frame& F, const float* W, int K, int N, bf16* WT, int c0 = 0, int nw = 1 << 30) {
    if (F.bid < c0 || F.bid >= c0 + nw) return;
    LAS float* scr = (LAS float*)(F.lds + RING_OFF + F.wave * 16384);
    const int nwg = nw < F.G ? nw : F.G, gw = (F.bid - c0) * NWAVES + F.wave, NGW = nwg * NWAVES;
    const int nitems = (K / 64) * (N / 32);
    for (int it = gw; it < nitems; it += NGW) p0_transpose_item(W, K, N, WT, scr, it, F.lane);
}
__device__ __forceinline__ void fold_finalize(Frame& F, int lo, int n) {
    const long long* fs = (const long long*)(F.ws + WS_FOLD); float* fd = (float*)(F.ws + WS_FOLDF);
    for (int i = F.bid * NTHR + F.tid; i < 2 * n; i += F.G * NTHR) { const int j = (i < n) ? lo + i : FO_N + lo + (i - n); const long long v = fs[j]; fd[j] = (float)(int)(v >> 32) + (float)(unsigned)v * pg8::FOLD_INV; }
}
enum { CJ_DOWN0, CJ_NSA, CJ_L1A, CJ_L1B, CJ_DOWN1 };
template <int JOB>
__device__ __forceinline__ void convert_job(Frame& F, const Args& A, int c0, int nw) {
    unsigned char* ws = F.ws; long long* cs = (long long*)(ws + WS_FOLD); long long* b2 = cs + FO_N;
    if (JOB == CJ_DOWN0 || JOB == CJ_DOWN1) { const int l = JOB == CJ_DOWN1; transpose_mat(F, KIN(IN_FFN_DOWN) + (size_t)l * DFF * DM, DFF, DM, (bf16*)(ws + WS_W_DOWN) + (size_t)l * DM * DFF, c0, nw); }
    if (JOB == CJ_NSA) {
        transpose_mat_fold(F, KIN(IN_NSA_W_IN), DM, NSA_IN, (bf16*)(ws + WS_W_NSAIN), KIN(IN_LN_G) + 2 * DM, KIN(IN_LN_B) + 2 * DM, cs + FO_NSA, b2 + FO_NSA, c0, nw);
        transpose_mat(F, KIN(IN_NSA_W_OUT), DM, DM, (bf16*)(ws + WS_W_NSAOUT), c0, nw); }
    if (JOB == CJ_L1A || JOB == CJ_L1B) { const int l = 1;
        if (JOB == CJ_L1A) {
            transpose_mat_fold(F, KIN(IN_XA_WQ) + (size_t)l * DM * XW, DM, XW, (bf16*)(ws + WS_W_XQ) + (size_t)l * XW * DM, KIN(IN_LN_G) + (size_t)(3 * l) * DM, KIN(IN_LN_B) + (size_t)(3 * l) * DM, cs + FO_XQ + l * XW, b2 + FO_XQ + l * XW, c0, nw);
            transpose_mat(F, KIN(IN_XA_WKV) + (size_t)l * DM * 2 * XW, DM, 2 * XW, (bf16*)(ws + WS_W_XKV) + (size_t)l * 2 * XW * DM, c0, nw);
            transpose_mat(F, KIN(IN_XA_WO) + (size_t)l * XW * DM, XW, DM, (bf16*)(ws + WS_W_XO) + (size_t)l * DM * XW, c0, nw); }
        transpose_mat_fold(F, KIN(IN_FFN_UP) + (size_t)l * DM * DFF2, DM, DFF2, (bf16*)(ws + WS_W_UP) + (size_t)l * DFF2 * DM, KIN(IN_LN_G) + (size_t)(3 * l + 1) * DM, KIN(IN_LN_B) + (size_t)(3 * l + 1) * DM,
                           cs + FO_UP + l * DFF2, b2 + FO_UP + l * DFF2, c0, nw, JOB == CJ_L1A ? 0 : 1, 2, true); }
}
__device__ __forceinline__ void cvt_flat(Frame& F, const float* src, bf16* dst, long n8) {
    for (long i = (long)F.bid * NTHR + F.tid; i < n8; i += (long)F.G * NTHR) {
        const f32x4 a = *(const f32x4*)(src + i * 8), b = *(const f32x4*)(src + i * 8 + 4);
        v4u o; o.x = pk2(a.x, a.y); o.y = pk2(a.z, a.w); o.z = pk2(b.x, b.y); o.w = pk2(b.z, b.w);
        *(v4u*)(dst + i * 8) = o; }
}
__device__ __forceinline__ void p0_prologue(Frame& F, const Args& A) {
    unsigned char* ws = F.ws;
    long long* cs = (long long*)(ws + WS_FOLD); long long* b2 = cs + FO_N;
    transpose_mat(F, KIN(IN_AB_W_IN), DM, AB_IN, (bf16*)(ws + WS_W_ABIN));
    transpose_mat(F, KIN(IN_AB_W_OUT), DM, DM, (bf16*)(ws + WS_W_ABOUT));
    { const int l = 0;
        transpose_mat_fold(F, KIN(IN_XA_WQ) + (size_t)l * DM * XW, DM, XW, (bf16*)(ws + WS_W_XQ) + (size_t)l * XW * DM, KIN(IN_LN_G) + (size_t)(3 * l) * DM, KIN(IN_LN_B) + (size_t)(3 * l) * DM, cs + FO_XQ + l * XW, b2 + FO_XQ + l * XW);
        transpose_mat(F, KIN(IN_XA_WKV) + (size_t)l * DM * 2 * XW, DM, 2 * XW, (bf16*)(ws + WS_W_XKV) + (size_t)l * 2 * XW * DM);
        transpose_mat(F, KIN(IN_XA_WO) + (size_t)l * XW * DM, XW, DM, (bf16*)(ws + WS_W_XO) + (size_t)l * DM * XW);
        transpose_mat_fold(F, KIN(IN_FFN_UP) + (size_t)l * DM * DFF2, DM, DFF2, (bf16*)(ws + WS_W_UP) + (size_t)l * DFF2 * DM, KIN(IN_LN_G) + (size_t)(3 * l + 1) * DM, KIN(IN_LN_B) + (size_t)(3 * l + 1) * DM, cs + FO_UP + l * DFF2, b2 + FO_UP + l * DFF2, 0, 1 << 30, 0, 1, true); }
    for (int l = 0; l < 2; ++l) {
        transpose_mat(F, KIN(IN_NSA_CMP_W1) + (size_t)l * 32 * HD * HD, 32 * HD, HD, (bf16*)(ws + WS_W_C1) + (size_t)l * HD * 32 * HD);
        transpose_mat(F, KIN(IN_NSA_CMP_W2) + (size_t)l * HD * HD, HD, HD, (bf16*)(ws + WS_W_C2) + (size_t)l * HD * HD);
    }
    cvt_flat(F, KIN(IN_X), (bf16*)(ws + WS_HB), (long)MTOK * DM / 8);
    cvt_flat(F, KIN(IN_MEM), (bf16*)(ws + WS_MEMB), (long)BATCH * NMEM * DM / 8);
    { v4u z = {0u, 0u, 0u, 0u}; v4u* p = (v4u*)((bf16*)(ws + WS_W_NSAIN) + (size_t)NSA_IN * DM); const long n = (long)(NSA_INP - NSA_IN) * DM / 8;
      for (long i = (long)F.bid * NTHR + F.tid; i < n; i += (long)F.G * NTHR) p[i] = z; }
    { float* tab = (float*)(ws + WS_ROPE);
      for (int i = F.bid * NTHR + F.tid; i < SEQ * 64; i += F.G * NTHR) { const int t = i >> 6, d = i & 63;
          float sn, cs; sincosf((float)t * powf(10000.0f, -(float)d * (1.0f / 64.0f)), &sn, &cs); tab[(size_t)t * 128 + d] = cs; tab[(size_t)t * 128 + 64 + d] = sn; } }
    { const float* lbp = KIN(IN_HGRN_LB); float* lbo = (float*)(ws + WS_LB);
      for (int i = F.bid * NTHR + F.tid; i < A_W; i += F.G * NTHR) { const float a = lbp[i], b = lbp[A_W + i], m = fmaxf(a, b), ea = __expf(a - m), eb = __expf(b - m); lbo[i] = ea / (ea + eb); } }
}

__device__ __forceinline__ void ln_phase(Frame& F, const bf16* Y, const float* g, const float* b, float* h32) {
    const int gw = F.bid * NWAVES + F.wave, NGW = F.G * NWAVES;
    for (int m = gw; m < MTOK; m += NGW) {
        const v4u* yr = (const v4u*)(Y + (size_t)m * DM) + F.lane;
        float v[8][8]; float s = 0.f;
#pragma unroll
        for (int j = 0; j < 8; ++j) { const v4u x = yr[64 * j];
            v[j][0] = bflo(x.x); v[j][1] = bfhi(x.x); v[j][2] = bflo(x.y); v[j][3] = bfhi(x.y); v[j][4] = bflo(x.z); v[j][5] = bfhi(x.z); v[j][6] = bflo(x.w); v[j][7] = bfhi(x.w);
#pragma unroll
            for (int q = 0; q < 8; ++q) s += v[j][q]; }
        const float mean = wave_sum(s) * (1.f / DM); float s2 = 0.f;
#pragma unroll
        for (int j = 0; j < 8; ++j)
#pragma unroll
            for (int q = 0; q < 8; ++q) { v[j][q] -= mean; s2 += v[j][q] * v[j][q]; }
        const float rstd = 1.f / sqrtf(wave_sum(s2) * (1.f / DM) + LN_EPS);
#pragma unroll
        for (int j = 0; j < 8; ++j) { const int c0 = 8 * F.lane + 512 * j;
            const f32x4 g0 = *(const f32x4*)(g + c0), g1 = *(const f32x4*)(g + c0 + 4), b0 = *(const f32x4*)(b + c0), b1 = *(const f32x4*)(b + c0 + 4);
            f32x4 r0, r1;
            r0.x = v[j][0] * rstd * g0.x + b0.x; r0.y = v[j][1] * rstd * g0.y + b0.y; r0.z = v[j][2] * rstd * g0.z + b0.z; r0.w = v[j][3] * rstd * g0.w + b0.w;
            r1.x = v[j][4] * rstd * g1.x + b1.x; r1.y = v[j][5] * rstd * g1.y + b1.y; r1.z = v[j][6] * rstd * g1.z + b1.z; r1.w = v[j][7] * rstd * g1.w + b1.w;
            *(f32x4*)(h32 + (size_t)m * DM + c0) = r0; *(f32x4*)(h32 + (size_t)m * DM + c0 + 4) = r1; }
    }
}

__device__ __forceinline__ void cg_unpack(const v4u x, float* o) { o[0] = bflo(x.x); o[1] = bfhi(x.x); o[2] = bflo(x.y); o[3] = bfhi(x.y); o[4] = bflo(x.z); o[5] = bfhi(x.z); o[6] = bflo(x.w); o[7] = bfhi(x.w); }
__device__ __forceinline__ void convglu_fixup_phase(Frame& F, const bf16* SIDE, const float* cw, bf16* Gm) {
    constexpr int NCG = DFF / 8, NRUN = MTOK / 128;
    for (int it = F.bid * NTHR + F.tid; it < NCG * NRUN; it += F.G * NTHR) {
        const int cg = it % NCG, run = it / NCG, c0 = cg * 8, t0 = run * 128;
        float w0[8], w1[8], w2[8], am2[8], am1[8], a0[8], a1[8], u0[8], u1[8];
#pragma unroll
        for (int j = 0; j < 8; ++j) { w0[j] = cw[c0 + j]; w1[j] = cw[DFF + c0 + j]; w2[j] = cw[2 * DFF + c0 + j]; }
        const bf16* sp = SIDE + (size_t)run * 6 * DFF + c0;
        if ((t0 & (SEQ - 1)) == 0) {
#pragma unroll
            for (int j = 0; j < 8; ++j) { am2[j] = 0.f; am1[j] = 0.f; }
        } else { cg_unpack(*(const v4u*)sp, am2); cg_unpack(*(const v4u*)(sp + DFF), am1); }
        cg_unpack(*(const v4u*)(sp + 2 * DFF), a0); cg_unpack(*(const v4u*)(sp + 3 * DFF), a1); cg_unpack(*(const v4u*)(sp + 4 * DFF), u0); cg_unpack(*(const v4u*)(sp + 5 * DFF), u1);
        unsigned o0[4], o1[4];
#pragma unroll
        for (int j = 0; j < 8; j += 2) {
            const pg8::f32x2 g0 = pg8::gelu_pk((pg8::f32x2){w2[j] * a0[j] + w1[j] * am1[j] + w0[j] * am2[j], w2[j + 1] * a0[j + 1] + w1[j + 1] * am1[j + 1] + w0[j + 1] * am2[j + 1]});
            const pg8::f32x2 g1 = pg8::gelu_pk((pg8::f32x2){w2[j] * a1[j] + w1[j] * a0[j] + w0[j] * am1[j], w2[j + 1] * a1[j + 1] + w1[j + 1] * a0[j + 1] + w0[j + 1] * am1[j + 1]});
            o0[j >> 1] = pk2(g0.x * u0[j], g0.y * u0[j + 1]); o1[j >> 1] = pk2(g1.x * u1[j], g1.y * u1[j + 1]); }
        *(v4u*)(Gm + (size_t)t0 * DFF + c0) = (v4u){o0[0], o0[1], o0[2], o0[3]}; *(v4u*)(Gm + (size_t)(t0 + 1) * DFF + c0) = (v4u){o1[0], o1[1], o1[2], o1[3]};
    }
}

__device__ __forceinline__ void xattn_phase(Frame& F, const bf16* XQ, const bf16* XKV, bf16* XO) {
    const int tid = F.tid, wid = F.wave, lane = F.lane, r32 = lane & 31, hi = lane >> 5;
    LAS char* lds = (LAS char*)F.lds;
    LAS float* wsc = (LAS float*)(lds + ATT_WS_OFF + wid * 256);
    const int vb0 = (int)(uintptr_t)(lds + ATT_V_OFF) + v_rd_base(lane);
    KVDma dm; kv_dma_init(dm, 2 * XW, 2 * XW, wid, lane);
    constexpr int NU = (MTOK / 256) * XH;
    for (int u = F.bid; u < NU; u += F.G) {
        const int head = u % XH, rbk = u / XH, row0 = rbk * 256, b = row0 / SEQ;
        const bf16* Kh = XKV + (size_t)b * NMEM * 2 * XW + head * HD; const bf16* Vh = Kh + XW;
        bf16x8 qr[8]; load_q(qr, XQ + (size_t)(row0 + wid * 32 + r32) * XW + head * HD + hi * 8);
        float m_reg = -1e30f, l_reg = 0.f; f32x16 o[4] = {};
        __syncthreads();
        kv_dma(dm, Kh, Vh, lds, 0, wid);
        for (int j = 0; j < NMEM / KVBLK; ++j) {
            const int buf = (j & 1) * ATT_BUF;
            VM_WAIT(); __syncthreads();
            if (j + 1 < NMEM / KVBLK) kv_dma(dm, Kh + (size_t)(j + 1) * KVBLK * 2 * XW, Vh + (size_t)(j + 1) * KVBLK * 2 * XW, lds, ATT_BUF - buf, wid);
            f32x16 p0, p1; qkt(p0, p1, lds + buf + ATT_K_OFF, qr, r32, hi);
            float alpha; softmax_tile(p0, p1, m_reg, l_reg, alpha);
            rescale_o(o, alpha, wsc, r32, hi);
            bf16x8 pa0, pa1, pa2, pa3; pack_p(p0, p1, pa0, pa1, pa2, pa3);
            pv_d0(o, vb0 + buf, pa0, pa1, pa2, pa3);
        }
        if (hi == 0) wsc[32 + r32] = l_reg; LDS_WAIT();
        bf16* Ow = XO + (size_t)(row0 + wid * 32) * XW + head * HD;
#pragma unroll
        for (int r = 0; r < 16; ++r) { const int orow = crow(r, hi); const float rl = __builtin_amdgcn_rcpf(wsc[32 + orow]);
#pragma unroll
            for (int d0 = 0; d0 < 4; ++d0) Ow[(size_t)orow * XW + d0 * 32 + r32] = (bf16)f2bf(o[d0][r] * rl); }
        LDS_WAIT();
    }
}

template <int K>
__device__ __forceinline__ f32x4 mma_tile(const LAS char* A, int lda, const LAS char* B, int ldb, int fr, int fq) {
    f32x4 acc = {0.f, 0.f, 0.f, 0.f};
#pragma unroll
    for (int k0 = 0; k0 < K; k0 += 32) {
        const bf16x8 a = *(const LAS bf16x8*)(A + fr * lda + (k0 + 8 * fq) * 2);
        const bf16x8 b = *(const LAS bf16x8*)(B + fr * ldb + (k0 + 8 * fq) * 2);
        acc = __builtin_amdgcn_mfma_f32_16x16x32_bf16(a, b, acc, 0, 0, 0);
    }
    return acc;
}
constexpr int HG_CH = 64, HG_NC = SEQ / HG_CH, HG_ITEMS = BATCH * A_HEADS * HG_NC;
constexpr int HG_QT = 0, HG_KT = 17408, HG_KH = 34816, HG_VT = 53248, HG_PT = 71680, HG_SEG = 80896;
constexpr int HG_SP = 17408, HG_OT = 52224;
constexpr int HG_WT = 80896, HG_KHS = 86016, HG_VS = 103424;
__device__ __forceinline__ void hgrn_phase_a(Frame& F, const bf16* P0, const float* lbv, bf16* QTg, bf16* OINTRA, bf16* DS, float* DEC) {
    LAS char* lds = (LAS char*)F.lds;
    const int tid = F.tid, wid = F.wave, lane = F.lane, fr = lane & 15, fq = lane >> 4;
    const int dg = tid & 15, sq = tid >> 4;
    const int d = tid & 127, sq16 = tid >> 7;
    for (int it = F.bid; it < HG_ITEMS; it += F.G) {
        const int c = it % HG_NC, bh = it / HG_NC, h = bh % A_HEADS, b = bh / A_HEADS;
        const size_t row0 = (size_t)b * SEQ + (size_t)c * HG_CH;
        float lb[8], q[2][8], kk[2][8], cum[2][8]; v4u vraw[2];
        { const f32x4 l0 = *(const f32x4*)(lbv + h * HD + 8 * dg), l1 = *(const f32x4*)(lbv + h * HD + 8 * dg + 4);
          lb[0] = l0.x; lb[1] = l0.y; lb[2] = l0.z; lb[3] = l0.w; lb[4] = l1.x; lb[5] = l1.y; lb[6] = l1.z; lb[7] = l1.w; }
#pragma unroll
        for (int rr = 0; rr < 2; ++rr) { const bf16* rowp = P0 + (row0 + 2 * sq + rr) * AB_IN + h * HD + 8 * dg;
            const v4u zq = *(const v4u*)(rowp + A_W), qq = *(const v4u*)rowp; vraw[rr] = *(const v4u*)(rowp + 2 * A_W);
            const unsigned zw[4] = {zq.x, zq.y, zq.z, zq.w}, qw[4] = {qq.x, qq.y, qq.z, qq.w};
#pragma unroll
            for (int j = 0; j < 8; ++j) { const float z = (j & 1) ? bfhi(zw[j >> 1]) : bflo(zw[j >> 1]); q[rr][j] = (j & 1) ? bfhi(qw[j >> 1]) : bflo(qw[j >> 1]);
                const float sg = sigmoidf_(z), omlb = 1.f - lb[j]; kk[rr][j] = omlb * (1.f - sg);
                const float lf = __logf(lb[j] + omlb * sg); cum[rr][j] = rr ? cum[0][j] + lf : lf; } }
        float pre[8];
#pragma unroll
        for (int j = 0; j < 8; ++j) { const float seg = cum[1][j]; float x = seg; const float t1 = __shfl_up(x, 16); if (lane >= 16) x += t1; const float t2 = __shfl_up(x, 32); if (lane >= 32) x += t2;
            pre[j] = x - seg; if (lane >= 48) ((LAS float*)(lds + HG_WT))[wid * 128 + 8 * dg + j] = x; }
        LDS_WAIT(); __syncthreads();
        float total[8];
#pragma unroll
        for (int j = 0; j < 8; ++j) total[j] = 0.f;
#pragma unroll
        for (int w = 0; w < NWAVES; ++w) { const f32x4 a0 = *(const LAS f32x4*)(lds + HG_WT + (w * 128 + 8 * dg) * 4), a1 = *(const LAS f32x4*)(lds + HG_WT + (w * 128 + 8 * dg + 4) * 4);
            const float av[8] = {a0.x, a0.y, a0.z, a0.w, a1.x, a1.y, a1.z, a1.w};
#pragma unroll
            for (int j = 0; j < 8; ++j) { total[j] += av[j]; if (w < wid) pre[j] += av[j]; } }
#pragma unroll
        for (int rr = 0; rr < 2; ++rr) { const int s = 2 * sq + rr; unsigned qt[4], kt[4], kh[4];
#pragma unroll
            for (int j = 0; j < 8; j += 2) { const float b0 = pre[j] + cum[rr][j], b1 = pre[j + 1] + cum[rr][j + 1];
                qt[j >> 1] = pk2(q[rr][j] * __expf(b0), q[rr][j + 1] * __expf(b1));
                kt[j >> 1] = pk2(kk[rr][j] * __expf(-b0), kk[rr][j + 1] * __expf(-b1));
                kh[j >> 1] = pk2(kk[rr][j] * __expf(total[j] - b0), kk[rr][j + 1] * __expf(total[j + 1] - b1)); }
            const v4u qv = {qt[0], qt[1], qt[2], qt[3]};
            *(LAS v4u*)(lds + HG_QT + s * 272 + dg * 16) = qv; *(v4u*)(QTg + (row0 + s) * A_W + h * HD + 8 * dg) = qv;
            *(LAS v4u*)(lds + HG_KT + s * 272 + dg * 16) = (v4u){kt[0], kt[1], kt[2], kt[3]};
            *(LAS v4u*)(lds + HG_KHS + s * 272 + dg * 16) = (v4u){kh[0], kh[1], kh[2], kh[3]};
            *(LAS v4u*)(lds + HG_VS + s * 272 + dg * 16) = vraw[rr]; }
        if (sq == 31) { f32x4 e0, e1; e0.x = __expf(total[0]); e0.y = __expf(total[1]); e0.z = __expf(total[2]); e0.w = __expf(total[3]); e1.x = __expf(total[4]); e1.y = __expf(total[5]); e1.z = __expf(total[6]); e1.w = __expf(total[7]);
            *(f32x4*)(DEC + (size_t)it * HD + 8 * dg) = e0; *(f32x4*)(DEC + (size_t)it * HD + 8 * dg + 4) = e1; }
        LDS_WAIT(); __syncthreads();
        { unsigned kh[8], vt[8];
#pragma unroll
          for (int j = 0; j < 16; j += 2) { const int s = 16 * sq16 + j;
              kh[j >> 1] = (unsigned)*(const LAS unsigned short*)(lds + HG_KHS + s * 272 + d * 2) | ((unsigned)*(const LAS unsigned short*)(lds + HG_KHS + (s + 1) * 272 + d * 2) << 16);
              vt[j >> 1] = (unsigned)*(const LAS unsigned short*)(lds + HG_VS + s * 272 + d * 2) | ((unsigned)*(const LAS unsigned short*)(lds + HG_VS + (s + 1) * 272 + d * 2) << 16); }
          LAS v4u* pk = (LAS v4u*)(lds + HG_KH + d * 144 + sq16 * 32); pk[0] = (v4u){kh[0], kh[1], kh[2], kh[3]}; pk[1] = (v4u){kh[4], kh[5], kh[6], kh[7]};
          LAS v4u* pv = (LAS v4u*)(lds + HG_VT + d * 144 + sq16 * 32); pv[0] = (v4u){vt[0], vt[1], vt[2], vt[3]}; pv[1] = (v4u){vt[4], vt[5], vt[6], vt[7]}; }
        LDS_WAIT(); __syncthreads();
#pragma unroll
        for (int k = 0; k < 2; ++k) { const int tau = 2 * wid + k, ti = tau >> 2, si = tau & 3;
            f32x4 acc = {0.f, 0.f, 0.f, 0.f};
            if (si <= ti) acc = mma_tile<128>(lds + HG_QT + ti * 16 * 272, 272, lds + HG_KT + si * 16 * 272, 272, fr, fq);
#pragma unroll
            for (int i = 0; i < 4; ++i) { const int t = 16 * ti + 4 * fq + i, s = 16 * si + fr; const float v = (s <= t) ? acc[i] : 0.f;
                *(LAS unsigned short*)(lds + HG_PT + t * 144 + s * 2) = (unsigned short)f2bf(v); } }
        LDS_WAIT(); __syncthreads();
#pragma unroll
        for (int k = 0; k < 4; ++k) { const int tau = wid + 8 * k, ti = tau >> 3, vi = tau & 7;
            const f32x4 acc = mma_tile<64>(lds + HG_VT + vi * 16 * 144, 144, lds + HG_PT + ti * 16 * 144, 144, fr, fq);
            v2u w; w.x = pk2(acc[0], acc[1]); w.y = pk2(acc[2], acc[3]);
            *(v2u*)(OINTRA + (row0 + 16 * ti + fr) * A_W + h * HD + 16 * vi + 4 * fq) = w; }
#pragma unroll
        for (int k = 0; k < 8; ++k) { const int tau = wid + 8 * k, vi = tau >> 3, ki = tau & 7;
            const f32x4 acc = mma_tile<64>(lds + HG_KH + ki * 16 * 144, 144, lds + HG_VT + vi * 16 * 144, 144, fr, fq);
            v2u w; w.x = pk2(acc[0], acc[1]); w.y = pk2(acc[2], acc[3]);
            *(v2u*)(DS + ((size_t)it * HD + 16 * vi + fr) * HD + 16 * ki + 4 * fq) = w; }
        LDS_WAIT(); __syncthreads();
    }
}
__device__ __forceinline__ void hgrn_phase_b(Frame& F, const bf16* DS, const float* DEC, bf16* SPREV) {
    const int tid = F.tid, dvl = tid >> 5, dk4 = (tid & 31) * 4;
    for (int item = F.bid; item < BATCH * A_HEADS * 8; item += F.G) {
        const int sl = item & 7, bh = item >> 3, dv = sl * 16 + dvl;
        f32x4 S = {0.f, 0.f, 0.f, 0.f};
        for (int c0 = 0; c0 < HG_NC; c0 += 8) {
            f32x4 ds[8], dc[8];
#pragma unroll
            for (int k = 0; k < 8; ++k) { const size_t it = (size_t)bh * HG_NC + c0 + k; const v2u x = *(const v2u*)(DS + (it * HD + dv) * HD + dk4);
                ds[k] = (f32x4){bflo(x.x), bfhi(x.x), bflo(x.y), bfhi(x.y)}; dc[k] = *(const f32x4*)(DEC + it * HD + dk4); }
#pragma unroll
            for (int k = 0; k < 8; ++k) { const size_t it = (size_t)bh * HG_NC + c0 + k;
                v2u w; w.x = pk2(S.x, S.y); w.y = pk2(S.z, S.w); *(v2u*)(SPREV + (it * HD + dv) * HD + dk4) = w;
                S = S * dc[k] + ds[k]; }
        }
    }
}
__device__ __forceinline__ void hgrn_phase_c(Frame& F, const bf16* P0, const bf16* QTg, const bf16* OINTRA, const bf16* SPREV, const float* nw, bf16* Ob) {
    LAS char* lds = (LAS char*)F.lds;
    const int tid = F.tid, wid = F.wave, lane = F.lane, fr = lane & 15, fq = lane >> 4;
    for (int it = F.bid; it < HG_ITEMS; it += F.G) {
        const int c = it % HG_NC, bh = it / HG_NC, h = bh % A_HEADS, b = bh / A_HEADS;
        const size_t row0 = (size_t)b * SEQ + (size_t)c * HG_CH;
        { const int s = tid >> 3, ch = (tid & 7) * 16; const bf16* src = QTg + (row0 + s) * A_W + h * HD + ch;
          const v4u x0 = *(const v4u*)src, x1 = *(const v4u*)(src + 8); LAS v4u* dst = (LAS v4u*)(lds + HG_QT + s * 272 + ch * 2); dst[0] = x0; dst[1] = x1; }
        { const int dv = tid >> 2, ch = (tid & 3) * 32; const bf16* src = SPREV + ((size_t)it * HD + dv) * HD + ch;
          const v4u x0 = *(const v4u*)src, x1 = *(const v4u*)(src + 8), x2 = *(const v4u*)(src + 16), x3 = *(const v4u*)(src + 24);
          LAS v4u* dst = (LAS v4u*)(lds + HG_SP + dv * 272 + ch * 2); dst[0] = x0; dst[1] = x1; dst[2] = x2; dst[3] = x3; }
        LDS_WAIT(); __syncthreads();
#pragma unroll
        for (int k = 0; k < 4; ++k) { const int tau = wid + 8 * k, ti = tau >> 3, vi = tau & 7;
            const f32x4 acc = mma_tile<128>(lds + HG_SP + vi * 16 * 272, 272, lds + HG_QT + ti * 16 * 272, 272, fr, fq);
            const int t = 16 * ti + fr, dv = 16 * vi + 4 * fq; const v2u oi = *(const v2u*)(OINTRA + (row0 + t) * A_W + h * HD + dv);
            *(LAS f32x4*)(lds + HG_OT + (t * 132 + dv) * 4) = (f32x4){acc[0] + bflo(oi.x), acc[1] + bfhi(oi.x), acc[2] + bflo(oi.y), acc[3] + bfhi(oi.y)}; }
        LDS_WAIT(); __syncthreads();
        { const int t = tid >> 3, dv0 = (tid & 7) * 16;
          float v[16]; float ss = 0.f;
#pragma unroll
          for (int q4 = 0; q4 < 4; ++q4) { const f32x4 x = *(const LAS f32x4*)(lds + HG_OT + (t * 132 + dv0 + 4 * q4) * 4); v[4 * q4] = x.x; v[4 * q4 + 1] = x.y; v[4 * q4 + 2] = x.z; v[4 * q4 + 3] = x.w;
              ss += (x.x * x.x + x.y * x.y) + (x.z * x.z + x.w * x.w); }
          ss += __shfl_xor(ss, 1); ss += __shfl_xor(ss, 2); ss += __shfl_xor(ss, 4);
          const float r = 1.f / sqrtf(ss * (1.f / HD) + RMS_EPS);
          const bf16* gp = P0 + (row0 + t) * AB_IN + 3 * A_W + h * HD + dv0; const v4u g0 = *(const v4u*)gp, g1 = *(const v4u*)(gp + 8);
          const unsigned gw[8] = {g0.x, g0.y, g0.z, g0.w, g1.x, g1.y, g1.z, g1.w}; unsigned o[8];
#pragma unroll
          for (int j = 0; j < 8; ++j) { const float ga = bflo(gw[j]), gb = bfhi(gw[j]);
              o[j] = pk2(v[2 * j] * r * nw[dv0 + 2 * j] * ga * sigmoidf_(ga), v[2 * j + 1] * r * nw[dv0 + 2 * j + 1] * gb * sigmoidf_(gb)); }
          bf16* op = Ob + (row0 + t) * DM + h * HD + dv0; *(v4u*)op = (v4u){o[0], o[1], o[2], o[3]}; *(v4u*)(op + 8) = (v4u){o[4], o[5], o[6], o[7]}; }
        LDS_WAIT(); __syncthreads();
    }
}

constexpr float SB_CUT = -160.f;
__device__ __forceinline__ void sb_phase(Frame& F, const bf16* P0, bf16* Ob) {
    const int tid = F.tid, wid = F.wave, lane = F.lane, r32 = lane & 31, hi = lane >> 5;
    LAS char* lds = (LAS char*)F.lds;
    const int vb0 = (int)(uintptr_t)(lds + ATT_V_OFF) + v_rd_base(lane);
    KVDma dm; kv_dma_init(dm, AB_IN, AB_IN, wid, lane);
    constexpr int NQB = SEQ / 256, NU = BATCH * B_HEADS * NQB;
    for (int rd = 0; ; ++rd) {
        const int idx = (rd & 1) ? rd * F.G + (F.G - 1 - F.bid) : rd * F.G + F.bid;
        if (rd * F.G >= NU) break;
        if (idx >= NU) continue;
        const int qb = NQB - 1 - idx / (BATCH * B_HEADS), bh = idx % (BATCH * B_HEADS), head = bh % B_HEADS, b = bh / B_HEADS;
        const size_t rowb = (size_t)b * SEQ; const int q0 = qb * 256;
        const bf16* Kh = P0 + rowb * AB_IN + 4 * A_W + B_W + head * HD; const bf16* Vh = Kh + B_W;
        const int tw0 = q0 + wid * 32, t = tw0 + r32;
        bf16x8 qr[8]; load_q(qr, P0 + (rowb + t) * AB_IN + 4 * A_W + head * HD + hi * 8);
        float R = 0.f; f32x16 o[4] = {};
        const int jtop = (q0 + 254) >> 6;
        LAS unsigned* dflag = (LAS unsigned*)(lds + ATT_X_OFF);
        if (lane == 0) { dflag[wid] = 0u; dflag[8 + wid] = 0u; }
        LDS_WAIT(); __syncthreads();
        kv_dma(dm, Kh + (size_t)jtop * KVBLK * AB_IN, Vh + (size_t)jtop * KVBLK * AB_IN, lds, 0, wid);
        int buf = 0;
        for (int j = jtop; j >= 0; --j, buf = ATT_BUF - buf) {
            VM_WAIT(); __syncthreads();
            { unsigned alld = 1u;
#pragma unroll
              for (int w = 0; w < NWAVES; ++w) alld &= dflag[((j + 1) & 1) * 8 + w];
              if (__builtin_amdgcn_readfirstlane(alld)) break; }
            if (j > 0) kv_dma(dm, Kh + (size_t)(j - 1) * KVBLK * AB_IN, Vh + (size_t)(j - 1) * KVBLK * AB_IN, lds, ATT_BUF - buf, wid);
            const int k0 = j * KVBLK;
            if (k0 < tw0 + 31) {
                f32x16 p0, p1; qkt(p0, p1, lds + buf + ATT_K_OFF, qr, r32, hi);
                const bool need_mask = (k0 + 63 >= tw0);
                float L0[16], L1[16];
#pragma unroll
                for (int r = 0; r < 16; ++r) {
                    const float z0 = p0[r] * ATT_C, z1 = p1[r] * ATT_C;
                    float l0 = -(fmaxf(z0, 0.f) + __builtin_amdgcn_logf(1.f + __builtin_amdgcn_exp2f(-fabsf(z0))));
                    float l1 = -(fmaxf(z1, 0.f) + __builtin_amdgcn_logf(1.f + __builtin_amdgcn_exp2f(-fabsf(z1))));
                    if (need_mask) { if (k0 + crow(r, hi) >= t) l0 = 0.f; if (k0 + 32 + crow(r, hi) >= t) l1 = 0.f; }
                    L0[r] = l0; L1[r] = l1; p0[r] = z0 + l0; p1[r] = z1 + l1;
                }
                SBAR();
                float Sg[16];
#pragma unroll
                for (int gi = 0; gi < 4; ++gi) {
                    const float a = (L0[4 * gi] + L0[4 * gi + 1]) + (L0[4 * gi + 2] + L0[4 * gi + 3]), c = (L1[4 * gi] + L1[4 * gi + 1]) + (L1[4 * gi + 2] + L1[4 * gi + 3]);
                    auto ra = __builtin_amdgcn_permlane32_swap(__float_as_uint(a), __float_as_uint(a), false, false);
                    auto rc = __builtin_amdgcn_permlane32_swap(__float_as_uint(c), __float_as_uint(c), false, false);
                    Sg[2 * gi] = __uint_as_float(ra[0]); Sg[2 * gi + 1] = __uint_as_float(ra[1]); Sg[8 + 2 * gi] = __uint_as_float(rc[0]); Sg[8 + 2 * gi + 1] = __uint_as_float(rc[1]);
                }
                float run = R;
#pragma unroll
                for (int s = 15; s >= 0; --s) { const float tt = run; run += Sg[s]; Sg[s] = tt; }
                const float Rn = run;
                SBAR();
#pragma unroll
                for (int gi = 0; gi < 4; ++gi) {
                    float base0 = hi ? Sg[2 * gi + 1] : Sg[2 * gi], base1 = hi ? Sg[8 + 2 * gi + 1] : Sg[8 + 2 * gi];
                    float r3 = base0, r2 = r3 + L0[4 * gi + 3], r1 = r2 + L0[4 * gi + 2], r0 = r1 + L0[4 * gi + 1];
                    p0[4 * gi + 3] = __builtin_amdgcn_exp2f(p0[4 * gi + 3] + r3); p0[4 * gi + 2] = __builtin_amdgcn_exp2f(p0[4 * gi + 2] + r2);
                    p0[4 * gi + 1] = __builtin_amdgcn_exp2f(p0[4 * gi + 1] + r1); p0[4 * gi + 0] = __builtin_amdgcn_exp2f(p0[4 * gi + 0] + r0);
                    r3 = base1; r2 = r3 + L1[4 * gi + 3]; r1 = r2 + L1[4 * gi + 2]; r0 = r1 + L1[4 * gi + 1];
                    p1[4 * gi + 3] = __builtin_amdgcn_exp2f(p1[4 * gi + 3] + r3); p1[4 * gi + 2] = __builtin_amdgcn_exp2f(p1[4 * gi + 2] + r2);
                    p1[4 * gi + 1] = __builtin_amdgcn_exp2f(p1[4 * gi + 1] + r1); p1[4 * gi + 0] = __builtin_amdgcn_exp2f(p1[4 * gi + 0] + r0);
                }
                R = Rn;
                { const unsigned dn = __all(R < SB_CUT) ? 1u : 0u; if (lane == 0) dflag[(j & 1) * 8 + wid] = dn; }
                if (need_mask) {
#pragma unroll
                    for (int r = 0; r < 16; ++r) { if (k0 + crow(r, hi) >= t) p0[r] = 0.f; if (k0 + 32 + crow(r, hi) >= t) p1[r] = 0.f; }
                }
                bf16x8 pa0, pa1, pa2, pa3; pack_p(p0, p1, pa0, pa1, pa2, pa3);
                pv_d0(o, vb0 + buf, pa0, pa1, pa2, pa3);
            }
        }
        bf16* Ow = Ob + (rowb + tw0) * DM + A_W + head * HD;
#pragma unroll
        for (int r = 0; r < 16; ++r) { const int orow = crow(r, hi);
#pragma unroll
            for (int d0 = 0; d0 < 4; ++d0) Ow[(size_t)orow * DM + d0 * 32 + r32] = (bf16)f2bf(o[d0][r]); }
    }
}

constexpr int P1_KC = 4096, P1_VC = 4608, P1_KS = 5120, P1_VS = 5632, P1_KW = 6144, P1_VW = 6656, P1_GL = 7168;
__device__ __forceinline__ void nsa_rope_phase(Frame& F, const bf16* P1, const float* TAB, bf16* QROT, bf16* KSROT, bf16* KWROT, bf16* OVL) {
    const int gw = F.bid * NWAVES + F.wave, NGW = F.G * NWAVES, lane = F.lane, hsub = lane >> 3, d0 = (lane & 7) * 8;
    for (int m = gw; m < MTOK; m += NGW) {
        const int t = m & (SEQ - 1);
        const f32x4 c0 = *(const f32x4*)(TAB + (size_t)t * 128 + d0), c1 = *(const f32x4*)(TAB + (size_t)t * 128 + d0 + 4);
        const f32x4 s0 = *(const f32x4*)(TAB + (size_t)t * 128 + 64 + d0), s1 = *(const f32x4*)(TAB + (size_t)t * 128 + 64 + d0 + 4);
        const float cs[8] = {c0.x, c0.y, c0.z, c0.w, c1.x, c1.y, c1.z, c1.w}, sn[8] = {s0.x, s0.y, s0.z, s0.w, s1.x, s1.y, s1.z, s1.w};
        const bf16* row = P1 + (size_t)m * NSA_INP;
#pragma unroll
        for (int hb = 0; hb < 5; ++hb) {
            const int hh = hb * 8 + hsub;
            const bf16* src; bf16* dst;
            if (hh < 32) { src = row + hh * HD; dst = QROT + (size_t)m * DM + hh * HD; }
            else if (hh < 36) { src = row + P1_KS + (hh - 32) * HD; dst = KSROT + (size_t)m * KVW + (hh - 32) * HD; }
            else { src = row + P1_KW + (hh - 36) * HD; dst = KWROT + (size_t)m * KVW + (hh - 36) * HD; }
            const v4u a = *(const v4u*)(src + d0), bq = *(const v4u*)(src + 64 + d0);
            const unsigned aw[4] = {a.x, a.y, a.z, a.w}, bw[4] = {bq.x, bq.y, bq.z, bq.w}; unsigned o1[4], o2[4];
#pragma unroll
            for (int q = 0; q < 4; ++q) { const float x1l = bflo(aw[q]), x1h = bfhi(aw[q]), x2l = bflo(bw[q]), x2h = bfhi(bw[q]);
                o1[q] = pk2(x1l * cs[2 * q] - x2l * sn[2 * q], x1h * cs[2 * q + 1] - x2h * sn[2 * q + 1]);
                o2[q] = pk2(x2l * cs[2 * q] + x1l * sn[2 * q], x2h * cs[2 * q + 1] + x1h * sn[2 * q + 1]); }
            *(v4u*)(dst + d0) = (v4u){o1[0], o1[1], o1[2], o1[3]}; *(v4u*)(dst + 64 + d0) = (v4u){o2[0], o2[1], o2[2], o2[3]};
        }
    }
    for (int i = F.bid * NTHR + F.tid; i < NCMPP * NSLC; i += F.G * NTHR) { const int n = i / NSLC, j = i % NSLC;
        OVL[i] = (n < NCMP && n >= 4 * j - 1 && n <= 4 * j + 3) ? (bf16)0x3f80u : (bf16)0u; }
}
constexpr int CM_A = 0, CM_B = 17408, CM_H = 17408 + 34816;
__device__ __forceinline__ void nsa_compress_phase(Frame& F, const bf16* P1, const float* pos, const bf16* W1t, const bf16* W2t, bf16* KCMP, bf16* VCMP) {
    LAS char* lds = (LAS char*)F.lds;
    const int tid = F.tid, wid = F.wave, lane = F.lane, fr = lane & 15, fq = lane >> 4;
    for (int item = F.bid; item < 128; item += F.G) {
        const int nt = item & 7, g = (item >> 3) & 3, b = (item >> 5) & 1, which = item >> 6;
        const bf16* w1 = W1t + (size_t)which * HD * 32 * HD; const bf16* w2 = W2t + (size_t)which * HD * HD;
        const float* posw = pos + (size_t)which * 32 * HD;
        f32x4 acc[4];
#pragma unroll
        for (int k = 0; k < 4; ++k) acc[k] = (f32x4){0.f, 0.f, 0.f, 0.f};
        for (int l = 0; l < 32; ++l) {
            { const int r = tid >> 3, ch = (tid & 7) * 16, n = nt * 64 + r; unsigned w[8];
              if (n < NCMP) { const bf16* src = P1 + ((size_t)b * SEQ + 16 * n + l) * NSA_INP + P1_KC + which * KVW + g * HD + ch;
                  const v4u x0 = *(const v4u*)src, x1 = *(const v4u*)(src + 8); const unsigned xs[8] = {x0.x, x0.y, x0.z, x0.w, x1.x, x1.y, x1.z, x1.w};
#pragma unroll
                  for (int q = 0; q < 8; ++q) w[q] = pk2(bflo(xs[q]) + posw[l * HD + ch + 2 * q], bfhi(xs[q]) + posw[l * HD + ch + 2 * q + 1]);
              } else {
#pragma unroll
                  for (int q = 0; q < 8; ++q) w[q] = 0u; }
              LAS v4u* dst = (LAS v4u*)(lds + CM_A + r * 272 + ch * 2); dst[0] = (v4u){w[0], w[1], w[2], w[3]}; dst[1] = (v4u){w[4], w[5], w[6], w[7]}; }
            { const int e = tid >> 2, ch = (tid & 3) * 32; const bf16* src = w1 + (size_t)e * 32 * HD + l * HD + ch;
              const v4u x0 = *(const v4u*)src, x1 = *(const v4u*)(src + 8), x2 = *(const v4u*)(src + 16), x3 = *(const v4u*)(src + 24);
              LAS v4u* dst = (LAS v4u*)(lds + CM_B + e * 272 + ch * 2); dst[0] = x0; dst[1] = x1; dst[2] = x2; dst[3] = x3; }
            LDS_WAIT(); __syncthreads();
#pragma unroll
            for (int k = 0; k < 4; ++k) { const int tau = wid + 8 * k, ni = tau >> 3, ei = tau & 7;
                acc[k] += mma_tile<128>(lds + CM_A + ni * 16 * 272, 272, lds + CM_B + ei * 16 * 272, 272, fr, fq); }
            LDS_WAIT(); __syncthreads();
        }
#pragma unroll
        for (int k = 0; k < 4; ++k) { const int tau = wid + 8 * k, ni = tau >> 3, ei = tau & 7;
#pragma unroll
            for (int i = 0; i < 4; ++i) *(LAS unsigned short*)(lds + CM_H + (16 * ni + 4 * fq + i) * 272 + (16 * ei + fr) * 2) = (unsigned short)f2bf(gelu1(acc[k][i])); }
        { const int f = tid >> 2, ch = (tid & 3) * 32; const bf16* src = w2 + (size_t)f * HD + ch;
          const v4u x0 = *(const v4u*)src, x1 = *(const v4u*)(src + 8), x2 = *(const v4u*)(src + 16), x3 = *(const v4u*)(src + 24);
          LAS v4u* dst = (LAS v4u*)(lds + CM_B + f * 272 + ch * 2); dst[0] = x0; dst[1] = x1; dst[2] = x2; dst[3] = x3; }
        LDS_WAIT(); __syncthreads();
        bf16* outp = which ? VCMP : KCMP;
#pragma unroll
        for (int k = 0; k < 4; ++k) { const int tau = wid + 8 * k, ni = tau >> 3, fi = tau & 7;
            const f32x4 a2 = mma_tile<128>(lds + CM_H + ni * 16 * 272, 272, lds + CM_B + fi * 16 * 272, 272, fr, fq);
#pragma unroll
            for (int i = 0; i < 4; ++i) { const int n = nt * 64 + 16 * ni + 4 * fq + i;
                outp[(((size_t)b * NCMPP + n) * NSA_G + g) * HD + 16 * fi + fr] = (n < NCMP) ? (bf16)f2bf(a2[i]) : (bf16)0u; } }
        LDS_WAIT(); __syncthreads();
    }
}
__device__ __forceinline__ unsigned pick4(const unsigned (&a)[4], int i) { return i == 0 ? a[0] : (i == 1 ? a[1] : (i == 2 ? a[2] : a[3])); }
template <int MODE>
__device__ __forceinline__ void nsa_attn_phase(Frame& F, const bf16* P1, const bf16* Qsrc, const bf16* Ksrc, const bf16* Vsrc, const unsigned* SEL, float* O32, float* IMP, bf16* Ob, bool probe_nostore = false) {
    const int tid = F.tid, wid = F.wave, lane = F.lane, r32 = lane & 31, hi = lane >> 5;
    LAS char* lds = (LAS char*)F.lds;
    LAS float* wsc = (LAS float*)(lds + ATT_WS_OFF + wid * 256);
    const int vb0 = (int)(uintptr_t)(lds + ATT_V_OFF) + v_rd_base(lane);
    KVDma dm; kv_dma_init(dm, MODE <= 1 ? NSA_G * HD : KVW, MODE == 0 ? NSA_G * HD : (MODE == 1 ? NSLC : NSA_INP), wid, lane);
    constexpr int NTB = SEQ / 32, NU = BATCH * NSA_G * NTB;
    for (int rd = 0; ; ++rd) {
        int idx;
        { idx = (rd & 1) ? rd * F.G + (F.G - 1 - F.bid) : rd * F.G + F.bid; if (rd * F.G >= NU) break; if (idx >= NU) continue; }
        const int tb = NTB - 1 - idx / (BATCH * NSA_G), bg = idx % (BATCH * NSA_G), g = bg % NSA_G, b = bg / NSA_G;
        const size_t rowb = (size_t)b * SEQ; const int t0 = tb * 32;
        const int t = (MODE == 2) ? t0 + 4 * wid + (r32 >> 3) : t0 + r32, head = (MODE == 2) ? g * NSA_R + (r32 & 7) : g * NSA_R + wid;
        const bf16* Kh; const bf16* Vh; long ldk, ldv; int jlo, jhi;
        if (MODE <= 1) { Kh = Ksrc + ((size_t)b * NCMPP * NSA_G + g) * HD; ldk = NSA_G * HD; jlo = 0; jhi = (t0 >> 4) >> 6;
            if (MODE == 0) { Vh = Vsrc + ((size_t)b * NCMPP * NSA_G + g) * HD; ldv = NSA_G * HD; } else { Vh = Vsrc; ldv = NSLC; } }
        else { Kh = Ksrc + rowb * KVW + g * HD; ldk = KVW; Vh = P1 + rowb * NSA_INP + (MODE == 2 ? P1_VS : P1_VW) + g * HD; ldv = NSA_INP;
            jhi = (t0 + 31) >> 6; jlo = (MODE == 2) ? 0 : ((t0 - (WINDOW - 1) > 0 ? t0 - (WINDOW - 1) : 0) >> 6); }
        unsigned wn[4] = {~0u, ~0u, ~0u, ~0u};
        if (MODE == 2) { const v4u sv = *(const v4u*)(SEL + ((rowb + t) * NSA_G + g) * 4); unsigned selw[4]; selw[0] = sv.x; selw[1] = sv.y; selw[2] = sv.z; selw[3] = sv.w;
            *(LAS v4u*)(lds + ATT_X_OFF + 2048 + (wid * 64 + lane) * 16) = sv;
            LAS unsigned* un = (LAS unsigned*)(lds + ATT_X_OFF);
#pragma unroll
            for (int q = 0; q < 4; ++q) { unsigned x = selw[q]; x |= __shfl_xor(x, 8); x |= __shfl_xor(x, 16); wn[q] = __builtin_amdgcn_readfirstlane(x); if (lane == 0) un[wid * 4 + q] = wn[q]; }
            LDS_WAIT(); __syncthreads();
            LAS int* plist = (LAS int*)(lds + ATT_X_OFF + 128);
            if (wid == 0) {
                unsigned m0 = 0u, m1 = 0u;
                int lane_l = lane; asm volatile("" : "+v"(lane_l));
                const LAS unsigned* ub = un + (lane_l >> 5);
#pragma unroll
                for (int w = 0; w < NWAVES; ++w) { m0 |= ((ub[w * 4] >> (lane & 31)) & 1u) << w; m1 |= ((ub[w * 4 + 2] >> (lane & 31)) & 1u) << w; }
                bool v0 = m0 != 0u && lane <= jhi, v1 = m1 != 0u && lane + 64 <= jhi; int np = 0;
                for (;;) {
                    const unsigned long long a0 = __ballot(v0), a1 = __ballot(v1);
                    if (!(a0 | a1)) break;
                    const int ja_ = a0 ? __builtin_ctzll(a0) : 64 + __builtin_ctzll(a1);
                    const unsigned ma = (ja_ < 64) ? (unsigned)__shfl((int)m0, ja_) : (unsigned)__shfl((int)m1, ja_ - 64);
                    if (lane == (ja_ & 63)) { if (ja_ < 64) v0 = false; else v1 = false; }
                    unsigned long long c0 = __ballot(v0 && !(m0 & ma)), c1 = __ballot(v1 && !(m1 & ma));
                    if (!(c0 | c1)) { c0 = __ballot(v0 && m0 == 0xffu); c1 = __ballot(v1 && m1 == 0xffu); }
                    if (!(c0 | c1)) { c0 = __ballot(v0); c1 = __ballot(v1); }
                    int jb_ = -1;
                    if (c0 | c1) { jb_ = c0 ? __builtin_ctzll(c0) : 64 + __builtin_ctzll(c1); if (lane == (jb_ & 63)) { if (jb_ < 64) v0 = false; else v1 = false; } }
                    if (lane == 0) { plist[2 * np] = ja_; plist[2 * np + 1] = jb_; }
                    ++np;
                }
                if (lane == 0) { int neg1 = -1; asm volatile("" : "+v"(neg1)); plist[2 * np] = neg1; plist[2 * np + 1] = neg1; }
            }
            LDS_WAIT(); }
        bf16x8 qr[8]; load_q(qr, Qsrc + (rowb + t) * (MODE <= 1 ? NSA_INP : DM) + head * HD + hi * 8);
        float m_reg = -1e30f, l_reg = 0.f; f32x16 o[4] = {};
        const int cur = t >> 6;
#define NSA_NEED(jj) (MODE != 2 || ((pick4(wn, (jj) >> 5) >> ((jj) & 31)) & 1u))
#define NSA_MASK(P0, P1, JJ) do { const int k0 = (JJ) * KVBLK; constexpr float NINF = -__builtin_inff(); \
            if (MODE <= 1) { if (!(16 * (k0 + 63) + 31 <= t0)) { \
                    _Pragma("unroll") for (int r = 0; r < 16; ++r) { if (!(16 * (k0 + crow(r, hi)) + 31 <= t)) P0[r] = NINF; if (!(16 * (k0 + 32 + crow(r, hi)) + 31 <= t)) P1[r] = NINF; } } } \
            else if (MODE == 2) { rv_ = (*(const LAS unsigned*)(lds + ATT_X_OFF + 2048 + (wid * 64 + lane) * 16 + ((JJ) >> 5) * 4) >> ((JJ) & 31)) & 1u;     \
                if ((JJ) >= cur) { const int lim = t - k0 - 4 * hi;                          \
                    _Pragma("unroll") for (int r = 0; r < 16; ++r) { if ((r & 3) + 8 * (r >> 2) > lim) P0[r] = NINF; if (32 + (r & 3) + 8 * (r >> 2) > lim) P1[r] = NINF; } } } \
            else { if (!((k0 > t0 + 31 - WINDOW) && (k0 + 63 <= t0))) { \
                    _Pragma("unroll") for (int r = 0; r < 16; ++r) { const int ka = k0 + crow(r, hi), kb = ka + 32; \
                        if (!(ka <= t && ka > t - WINDOW)) P0[r] = NINF; if (!(kb <= t && kb > t - WINDOW)) P1[r] = NINF; } } } } while (0)
        const int pbase = __builtin_amdgcn_readfirstlane((int)(uintptr_t)(lds + ATT_X_OFF + 128)); int pp = 0;
#define PLIST(i) (*(const LAS int*)(uintptr_t)(unsigned)(pbase + 4 * (i)))
        int ja, jb;
        __syncthreads();
        if (MODE == 2) { ja = PLIST(0); jb = PLIST(1); ja = __builtin_amdgcn_readfirstlane(ja); jb = __builtin_amdgcn_readfirstlane(jb); if (ja < 0) ja = jhi + 1; }
        else { ja = jlo; jb = ja + 1; if (jb > jhi) jb = -1; }
        if (ja <= jhi) kv_dma(dm, Kh + (size_t)ja * KVBLK * ldk, Vh + (size_t)ja * KVBLK * ldv, lds, 0, wid);
        if (jb >= 0) kv_dma(dm, Kh + (size_t)jb * KVBLK * ldk, Vh + (size_t)jb * KVBLK * ldv, lds, ATT_BUF, wid);
        int set = 0;
#pragma nounroll
        while (ja <= jhi) {
            int jc, jd;
            if (MODE == 2) { ++pp; jc = PLIST(2 * pp); jd = PLIST(2 * pp + 1); jc = __builtin_amdgcn_readfirstlane(jc); jd = __builtin_amdgcn_readfirstlane(jd); if (jc < 0) jc = jhi + 1; }
            else { jc = (jb >= 0 ? jb : ja) + 1; jd = jc + 1; if (jd > jhi) jd = -1; }
            VM_WAIT(); __syncthreads();
            if (jc <= jhi) kv_dma(dm, Kh + (size_t)jc * KVBLK * ldk, Vh + (size_t)jc * KVBLK * ldv, lds, ATT_SET - set, wid);
            if (jc <= jhi && jd >= 0) kv_dma(dm, Kh + (size_t)jd * KVBLK * ldk, Vh + (size_t)jd * KVBLK * ldv, lds, ATT_SET - set + ATT_BUF, wid);
            const bool nA = NSA_NEED(ja), nB = (jb >= 0) && NSA_NEED(jb);
            f32x16 a0, a1, b0, b1;
            if (nA) qkt(a0, a1, lds + set + ATT_K_OFF, qr, r32, hi);
            if (nB) qkt(b0, b1, lds + set + ATT_BUF + ATT_K_OFF, qr, r32, hi);
            bool rv_ = true;
            if (nA) { NSA_MASK(a0, a1, ja); attn_finish(a0, a1, o, m_reg, l_reg, wsc, vb0 + set, r32, hi, rv_); }
            if (nB) { NSA_MASK(b0, b1, jb); attn_finish(b0, b1, o, m_reg, l_reg, wsc, vb0 + set + ATT_BUF, r32, hi, rv_); }
            ja = jc; jb = (jc <= jhi) ? jd : -1; set = ATT_SET - set;
        }
#undef PLIST
#undef NSA_MASK
#undef NSA_NEED
        { float fac = l_reg > 0.f ? __builtin_amdgcn_rcpf(l_reg) : 0.f;
          if (MODE != 1) { const int br = MODE == 0 ? 0 : (MODE == 2 ? 1 : 2); fac *= sigmoidf_(bf2f(P1[(rowb + t) * NSA_INP + P1_GL + head * 3 + br])); }
          if (hi == 0) wsc[32 + r32] = fac; LDS_WAIT(); }
        if (MODE == 1) {
            float fc[16];
#pragma unroll
            for (int r = 0; r < 16; ++r) fc[r] = wsc[32 + crow(r, hi)];
            LDS_WAIT(); __syncthreads();
#pragma unroll
            for (int r = 0; r < 16; ++r) { const int orow = crow(r, hi);
#pragma unroll
                for (int d0 = 0; d0 < 4; ++d0) *(LAS float*)(lds + ((wid * 32 + orow) * 128 + d0 * 32 + r32) * 4) = o[d0][r] * fc[r]; }
            LDS_WAIT(); __syncthreads();
            { const int tok = tid >> 4, j8 = (tid & 15) * 8; f32x4 s0 = {0.f, 0.f, 0.f, 0.f}, s1 = {0.f, 0.f, 0.f, 0.f};
#pragma unroll
              for (int w = 0; w < 8; ++w) { const LAS f32x4* pp = (const LAS f32x4*)(lds + ((w * 32 + tok) * 128 + j8) * 4); s0 += pp[0]; s1 += pp[1]; }
              f32x4* dst = (f32x4*)(IMP + ((rowb + t0 + tok) * NSA_G + g) * NSLC + j8); dst[0] = s0; dst[1] = s1; }
            LDS_WAIT(); __syncthreads();
        } else {
#pragma unroll
            for (int r = 0; r < 16; ++r) { const int orow = crow(r, hi); const float fc = wsc[32 + orow];
                const size_t off = (MODE == 2) ? (rowb + t0 + 4 * wid + (orow >> 3)) * DM + (g * NSA_R + (orow & 7)) * HD + r32 : (rowb + t0 + orow) * DM + head * HD + r32;
#pragma unroll
                for (int d0 = 0; d0 < 4; ++d0) {
                    if (MODE == 0) Ob[off + d0 * 32] = (bf16)f2bf(o[d0][r] * fc);
                    else if (MODE == 3) { if (!probe_nostore) Ob[off + d0 * 32] = (bf16)f2bf(bf2f(Ob[off + d0 * 32]) + o[d0][r] * fc); }
                    else Ob[off + d0 * 32] = (bf16)f2bf(bf2f(Ob[off + d0 * 32]) + o[d0][r] * fc); } }
            LDS_WAIT();
        }
    }
}
__device__ __forceinline__ unsigned topk_key(float v) { const unsigned u = (v == 0.f) ? 0u : __builtin_bit_cast(unsigned, v); return u ^ ((u >> 31) ? 0xffffffffu : 0x80000000u); }
__device__ __forceinline__ void nsa_topk_phase(Frame& F, const float* IMP, unsigned* SEL) {
    const int gw = F.bid * NWAVES + F.wave, NGW = F.G * NWAVES, lane = F.lane;
    for (int it = gw; it < MTOK * NSA_G; it += NGW) {
        const int m = it / NSA_G, t = m & (SEQ - 1), cur = t >> 6;
        const float* ip = IMP + (size_t)it * NSLC;
        const unsigned k0 = topk_key(ip[lane]), k1 = topk_key(ip[64 + lane]);
        const int j0 = lane, j1 = lane + 64;
        const bool f0 = (j0 == 0) || (j0 == cur) || (j0 == cur - 1), f1 = (j1 == cur) || (j1 == cur - 1);
        const unsigned long long c0m = __ballot(!f0 && j0 <= cur), c1m = __ballot(!f1 && j1 <= cur);
        const int nforced = cur >= 2 ? 3 : cur + 1, slots = NTOP - nforced;
        unsigned long long s0m = c0m, s1m = c1m;
        if (__builtin_popcountll(c0m) + __builtin_popcountll(c1m) > slots) {
            unsigned T = 0u;
#pragma nounroll
            for (int bit = 31; bit >= 0; --bit) { const unsigned trial = T | (1u << bit);
                const int cnt = __builtin_popcountll(__ballot(k0 >= trial) & c0m) + __builtin_popcountll(__ballot(k1 >= trial) & c1m);
                if (cnt >= slots) T = trial; }
            unsigned long long e0 = __ballot(k0 == T) & c0m, e1 = __ballot(k1 == T) & c1m;
            s0m = __ballot(k0 > T) & c0m; s1m = __ballot(k1 > T) & c1m;
            int need = slots - __builtin_popcountll(s0m) - __builtin_popcountll(s1m);
            while (need > 0 && e0) { const unsigned long long b = e0 & (~e0 + 1ull); s0m |= b; e0 ^= b; --need; }
            while (need > 0 && e1) { const unsigned long long b = e1 & (~e1 + 1ull); s1m |= b; e1 ^= b; --need; }
        }
        const unsigned long long m0 = s0m | __ballot(f0 && j0 <= cur), m1 = s1m | __ballot(f1 && j1 <= cur);
        if (lane == 0) { v4u w = {(unsigned)m0, (unsigned)(m0 >> 32), (unsigned)m1, (unsigned)(m1 >> 32)}; *(v4u*)(SEL + (size_t)it * 4) = w; }
    }
}

#ifndef STAGE
#define STAGE 3
#endif
#define ZERO_OB_PHASE PH_BEGIN { v4u z = {0u, 0u, 0u, 0u}; v4u* p = (v4u*)Ob; const long n = (long)MTOK * DM / 8; \
            for (long i = (long)F.bid * NTHR + F.tid; i < n; i += (long)F.G * NTHR) p[i] = z; } PH_END
#define MIXER0_PHASES \
    PH_BEGIN { fold_finalize(F, FO_XQ, XW); fold_finalize(F, FO_UP, DFF2); } \
             REP(10) hgrn_phase_a(F, BIG, (const float*)(ws + WS_LB), (bf16*)(ws + WS_QT), (bf16*)(ws + WS_OINTRA), (bf16*)(ws + WS_DS), (float*)(ws + WS_DEC)); \
             REP(11) sb_phase(F, BIG, Ob); PH_END \
    PH_BEGIN REP(12) hgrn_phase_b(F, (const bf16*)(ws + WS_DS), (const float*)(ws + WS_DEC), (bf16*)(ws + WS_SPREV)); PH_END \
    PH_BEGIN REP(13) hgrn_phase_c(F, BIG, (const bf16*)(ws + WS_QT), (const bf16*)(ws + WS_OINTRA), (const bf16*)(ws + WS_SPREV), KIN(IN_HGRN_NW), Ob); PH_END
#if STAGE <= 2
#define MIXER1_PHASES ZERO_OB_PHASE
#else
#define MIXER1_PHASES \
    PH_BEGIN { fold_finalize(F, FO_XQ + XW, XW); } REP(14) { nsa_rope_phase(F, BIG, (const float*)(ws + WS_ROPE), (bf16*)(ws + WS_QROT), (bf16*)(ws + WS_KSROT), (bf16*)(ws + WS_KWROT), (bf16*)(ws + WS_OVL)); \
             nsa_compress_phase(F, BIG, KIN(IN_NSA_CMP_POS), (const bf16*)(ws + WS_W_C1), (const bf16*)(ws + WS_W_C2), (bf16*)(ws + WS_KCMP), (bf16*)(ws + WS_VCMP)); } PH_END \
    PH_BEGIN { REP(15) nsa_attn_phase<0>(F, BIG, BIG, (const bf16*)(ws + WS_KCMP), (const bf16*)(ws + WS_VCMP), nullptr, nullptr, nullptr, Ob); \
             F.fresh(); REP(15) nsa_attn_phase<1>(F, BIG, BIG, (const bf16*)(ws + WS_KCMP), (const bf16*)(ws + WS_OVL), nullptr, nullptr, (float*)(ws + WS_IMP), nullptr); \
             F.fresh(); REP(17) nsa_attn_phase<3>(F, BIG, (const bf16*)(ws + WS_QROT), (const bf16*)(ws + WS_KWROT), nullptr, nullptr, nullptr, nullptr, Ob, r_ > 0); } PH_END \
    PH_BEGIN REP(16) nsa_topk_phase(F, (const float*)(ws + WS_IMP), (unsigned*)(ws + WS_SEL)); PH_END \
    PH_BEGIN REP(18) nsa_attn_phase<2>(F, BIG, (const bf16*)(ws + WS_QROT), (const bf16*)(ws + WS_KSROT), nullptr, (const unsigned*)(ws + WS_SEL), nullptr, nullptr, Ob); PH_END
#endif
#ifndef REPMASK
#define REPMASK 0u
#endif
#define REP(gid) for (int r_ = 0; r_ <= (int)((REPMASK >> (gid)) & 1u); ++r_)
#define PH_BEGIN if (pc >= lo && pc < hi) { F.fresh();
#if (REPMASK >> 23) & 1
#define PH_END   if (pc + 1 < hi) { const unsigned long long tb0_ = __builtin_amdgcn_s_memrealtime(); XcdBarrier bb_ = bar; asm volatile("" : "+s"(bb_.bar), "+s"(bb_.x)); xcd_barrier(bb_); \
        const unsigned w_ = (unsigned)(__builtin_amdgcn_s_memrealtime() - tb0_); tbar_acc += w_; if (threadIdx.x == 0) { atomicMax((unsigned*)(args.ws + 3 * MiB) + pc, 0x7fffffffu - w_); atomicMax((unsigned*)(args.ws + 3 * MiB) + 256 + pc, w_); } } } ++pc;
#else
#define PH_END   if (pc + 1 < hi) { XcdBarrier bb_ = bar; asm volatile("" : "+s"(bb_.bar), "+s"(bb_.x)); xcd_barrier(bb_); } } ++pc;
#endif
template <int l>
__device__ __forceinline__ void layer_body(Frame& F, const Args& args, const XcdBarrier& bar, int& pc, const int lo, const int hi, unsigned long long& tbar_acc) {
    unsigned char* ws = F.ws;
    bf16* HB = (bf16*)(ws + WS_HB); bf16* Y = (bf16*)(ws + WS_Y); float* H32 = (float*)karg()->out;
    bf16* BIG = (bf16*)(ws + WS_BIG); bf16* Gm = (bf16*)(ws + WS_G); bf16* Ob = (bf16*)(ws + WS_O);
    bf16* XQ = (bf16*)(ws + WS_XQ); bf16* XO = (bf16*)(ws + WS_XO);
#define RS(k) ((long long*)(ws + WS_RSUM) + (size_t)(k) * MTOK * 2)
#define LNG(k) (KIN(IN_LN_G) + (size_t)(k) * DM)
#define LNB(k) (KIN(IN_LN_B) + (size_t)(k) * DM)
    const float* cs = (const float*)(ws + WS_FOLDF); const float* b2 = cs + FO_N;
        PH_BEGIN REP(1) {
            const int N = l == 0 ? AB_IN : NSA_INP;
            pg8::StaticOrder S; S.init(MTOK, N, F.G, F.bid);
            if (l == 0) { pg8::Gemm g{HB, (const bf16*)(ws + WS_W_ABIN), MTOK, N, DM}; pg8::EpiBf16<0> E{BIG, N, nullptr, 0, 0, 1.f};
                pg8::gemm_phase<pg8::EpiBf16<0>, pg8::StaticOrder, PG8_ALIGN, PG8_SP2>(F.lds + RING_OFF, g, S, E); }
            else { pg8::Gemm g{Y, (const bf16*)(ws + WS_W_NSAIN), MTOK, N, DM}; pg8::EpiBf16Ln E{BIG, N, RS(2), cs + FO_NSA, b2 + FO_NSA};
                pg8::gemm_phase<pg8::EpiBf16Ln, pg8::StaticOrder, PG8_ALIGN, PG8_SP2>(F.lds + RING_OFF, g, S, E);
                if (r_ == 0) convert_job<CJ_L1A>(F, args, 64, 192); }
        } PH_END
#if STAGE <= 1
        ZERO_OB_PHASE
#else
        if (l == 0) {
            MIXER0_PHASES
        } else {
            MIXER1_PHASES
        }
#endif
        PH_BEGIN REP(2) {
            pg8::Gemm g{Ob, l == 0 ? (const bf16*)(ws + WS_W_ABOUT) : (const bf16*)(ws + WS_W_NSAOUT), MTOK, DM, DM};
            pg8::StaticOrder S; S.init(MTOK, DM, F.G, F.bid);
            if (l == 0) { pg8::EpiRes0 E{Y, HB, DM, DN_ALPHA, RS(0)};
                pg8::gemm_phase<pg8::EpiRes0, pg8::StaticOrder, PG8_ALIGN, PG8_SP2>(F.lds + RING_OFF, g, S, E); }
            else { pg8::EpiResLn2 E{Y, RS(2), LNG(2), LNB(2), DM, DN_ALPHA, RS(3)};
                pg8::gemm_phase<pg8::EpiResLn2, pg8::StaticOrder, PG8_ALIGN, PG8_SP2>(F.lds + RING_OFF, g, S, E); }
        } PH_END
        PH_BEGIN REP(3) {
            {   pg8::Gemm g{Y, (const bf16*)(ws + WS_W_XQ) + (size_t)l * XW * DM, MTOK, XW, DM};
                pg8::RangeOrder S; S.init(MTOK, XW, 0, 128, F.bid);
                pg8::EpiBf16Ln E{XQ, XW, RS(3 * l), cs + FO_XQ + l * XW, b2 + FO_XQ + l * XW};
                pg8::gemm_phase<pg8::EpiBf16Ln, pg8::RangeOrder, PG8_ALIGN, PG8_SP2>(F.lds + RING_OFF, g, S, E); }
            {   pg8::Gemm g{(const bf16*)(ws + WS_MEMB), (const bf16*)(ws + WS_W_XKV) + (size_t)l * 2 * XW * DM, BATCH * NMEM, 2 * XW, DM};
                pg8::RangeOrder S; S.init(BATCH * NMEM, 2 * XW, 128, 8, F.bid);
                pg8::EpiBf16<0> E{(bf16*)(ws + WS_XKV) + (size_t)l * BATCH * NMEM * 2 * XW, 2 * XW, nullptr, 0, 0, 1.f};
                pg8::gemm_phase<pg8::EpiBf16<0>, pg8::RangeOrder, PG8_ALIGN, PG8_SP2>(F.lds + RING_OFF, g, S, E); }
            if (r_ == 0) { if (l == 0) convert_job<CJ_DOWN0>(F, args, 136, 120); else convert_job<CJ_L1B>(F, args, 136, 120); }
        } PH_END
        PH_BEGIN { if (l == 1) fold_finalize(F, FO_UP + DFF2, DFF2); } REP(9) xattn_phase(F, XQ, (const bf16*)(ws + WS_XKV) + (size_t)l * BATCH * NMEM * 2 * XW, XO); PH_END
        PH_BEGIN REP(4) {
            pg8::Gemm g{XO, (const bf16*)(ws + WS_W_XO) + (size_t)l * DM * XW, MTOK, DM, XW};
            pg8::StaticOrder S; S.init(MTOK, DM, F.G, F.bid);
            pg8::EpiResLn2 E{Y, RS(3 * l), LNG(3 * l), LNB(3 * l), DM, DN_ALPHA, RS(3 * l + 1)};
            pg8::gemm_phase<pg8::EpiResLn2, pg8::StaticOrder, PG8_ALIGN, PG8_SP2>(F.lds + RING_OFF, g, S, E);
        } PH_END
        PH_BEGIN REP(5) {
#if (REPMASK >> 22) & 1
            if (r_ > 0) { XcdBarrier bb_ = bar; asm volatile("" : "+s"(bb_.bar), "+s"(bb_.x)); xcd_barrier(bb_); }
#endif
            pg8::Gemm g{Y, (const bf16*)(ws + WS_W_UP) + (size_t)l * DFF2 * DM, MTOK, DFF2, DM};
            pg8::StaticOrder S; S.init(MTOK, DFF2, F.G, F.bid);
            pg8::EpiConvGlu E{Gm, (bf16*)(ws + WS_SIDE), RS(3 * l + 1), cs + FO_UP + l * DFF2, b2 + FO_UP + l * DFF2, KIN(IN_FFN_CONV) + (size_t)l * 3 * DFF, DFF};
            pg8::gemm_phase<pg8::EpiConvGlu, pg8::StaticOrder, PG8_ALIGN, PG8_SP2>(F.lds + RING_OFF, g, S, E);
            if (r_ == 0) { if (l == 0) convert_job<CJ_NSA>(F, args, 128, 128); else convert_job<CJ_DOWN1>(F, args, 128, 128); }
        } PH_END
#if (REPMASK >> 20) & 1
        PH_BEGIN {
            pg8::Gemm g{HB, (const bf16*)(ws + WS_W_UP) + (size_t)l * DFF2 * DM, MTOK, DFF2, DM};
            pg8::ZeroOrder S; S.init(MTOK, DFF2, F.G, F.bid);
            pg8::EpiBf16<0> E{Gm, DFF2, nullptr, 0, 0, 1.f};
            pg8::gemm_phase<pg8::EpiBf16<0>, pg8::ZeroOrder, PG8_ALIGN, PG8_SP2>(F.lds + RING_OFF, g, S, E);
        } PH_END
#endif
        PH_BEGIN { if (l == 0) fold_finalize(F, FO_NSA, NSA_INP); } REP(8) convglu_fixup_phase(F, (const bf16*)(ws + WS_SIDE), KIN(IN_FFN_CONV) + (size_t)l * 3 * DFF, Gm); PH_END
        PH_BEGIN REP(6) {
            pg8::Gemm g{Gm, (const bf16*)(ws + WS_W_DOWN) + (size_t)l * DM * DFF, MTOK, DM, DFF};
            pg8::StaticOrder S; S.init(MTOK, DM, F.G, F.bid);
            pg8::EpiResLn2 E{Y, RS(3 * l + 1), LNG(3 * l + 1), LNB(3 * l + 1), DM, DN_ALPHA, RS(3 * l + 2)};
            pg8::gemm_phase<pg8::EpiResLn2, pg8::StaticOrder, PG8_ALIGN, PG8_SP2>(F.lds + RING_OFF, g, S, E);
        } PH_END
        if (l == 1) { PH_BEGIN REP(7) ln_phase(F, Y, LNG(5), LNB(5), H32); PH_END }
#undef RS
#undef LNG
#undef LNB
}
__global__ void __launch_bounds__(NTHR, 2) mega_fwd(Args args) {
    extern __shared__ __attribute__((aligned(16))) unsigned char lds_raw[];
    Frame F;
    F.lds = (LAS unsigned char*)lds_raw; F.ws = args.ws;
    F.tid = threadIdx.x; F.lane = F.tid & 63; F.wave = __builtin_amdgcn_readfirstlane(F.tid >> 6); F.G = gridDim.x;
    unsigned char* ws = args.ws;
    gu32* ctl = (gu32*)(ws + WS_CTL);
    for (int u = F.tid; u < (LDS_BYTES - LDSCTL_OFF) / 4; u += NTHR) ((LAS unsigned*)(F.lds + LDSCTL_OFF))[u] = 0u;
    __syncthreads();
    volatile LAS unsigned* MISC = (volatile LAS unsigned*)(F.lds + MISC_OFF);
    XcdBarrier bar = xcd_barrier_post((unsigned*)(ctl + CW_BAR), MISC + 8);
    const int lo = args.ph_lo, hi = args.ph_hi; int pc = 0; unsigned long long tbar_acc = 0ull;
    bf16* HB = (bf16*)(ws + WS_HB); bf16* Y = (bf16*)(ws + WS_Y); float* H32 = (float*)karg()->out;
    bf16* BIG = (bf16*)(ws + WS_BIG); bf16* Gm = (bf16*)(ws + WS_G); bf16* Ob = (bf16*)(ws + WS_O);
    bf16* XQ = (bf16*)(ws + WS_XQ); bf16* XO = (bf16*)(ws + WS_XO);

    PH_BEGIN REP(0) p0_prologue(F, args); PH_END

#if (REPMASK >> 21) & 1
    for (int e_ = 0; e_ < 40; ++e_) { PH_BEGIN PH_END }
#endif
    layer_body<0>(F, args, bar, pc, lo, hi, tbar_acc);
    layer_body<1>(F, args, bar, pc, lo, hi, tbar_acc);
#if (REPMASK >> 23) & 1
#ifndef PROBE_BID
#define PROBE_BID 0
#endif
#if (REPMASK >> 24) & 1
    if (blockIdx.x == 0) { unsigned long long tot_ = 0ull; for (int k_ = 0; k_ < pc; ++k_) { const unsigned v_ = __hip_atomic_load((unsigned*)(args.ws + 3 * MiB) + k_, __ATOMIC_RELAXED, __HIP_MEMORY_SCOPE_AGENT); const unsigned x_ = __hip_atomic_load((unsigned*)(args.ws + 3 * MiB) + 256 + k_, __ATOMIC_RELAXED, __HIP_MEMORY_SCOPE_AGENT);
#ifdef PROBE_SPREAD_MASK
            if (v_ && ((PROBE_SPREAD_MASK >> k_) & 1ull)) tot_ += x_ - (0x7fffffffu - v_);
#else
            if (v_) tot_ += 0x7fffffffu - v_;
#endif
        }
        const unsigned long long t0_ = __builtin_amdgcn_s_memrealtime(); while (__builtin_amdgcn_s_memrealtime() - t0_ < tot_) __builtin_amdgcn_s_sleep(8); }
#else
    if (blockIdx.x == PROBE_BID) { const unsigned long long t0_ = __builtin_amdgcn_s_memrealtime(); while (__builtin_amdgcn_s_memrealtime() - t0_ < tbar_acc) __builtin_amdgcn_s_sleep(8); }
#endif
#endif
}

extern "C" void kernel_launch(void* const* d_in, const int* in_sizes, int n_in, void* d_out, int out_size, void* d_ws, size_t ws_size, hipStream_t stream) {
    static int grid = 0;
    if (grid == 0) {
        if (n_in != 19 || in_sizes[0] != MTOK * DM || out_size != MTOK * DM || ws_size < WS_END) {
            fprintf(stderr, "kernel_launch: shape mismatch n_in %d in0 %d out %d ws %zu (need %zu)\n", n_in, n_in > 0 ? in_sizes[0] : -1, out_size, ws_size, (size_t)WS_END); grid = -1; return; }
        int dev = 0, cus = 0, per_cu = 0;
        if (hipGetDevice(&dev) != hipSuccess || hipDeviceGetAttribute(&cus, hipDeviceAttributeMultiprocessorCount, dev) != hipSuccess) { grid = -1; return; }
        if (hipFuncSetAttribute((const void*)mega_fwd, hipFuncAttributeMaxDynamicSharedMemorySize, LDS_BYTES) != hipSuccess) { fprintf(stderr, "kernel_launch: hipFuncSetAttribute failed\n"); grid = -1; return; }
        if (hipOccupancyMaxActiveBlocksPerMultiprocessor(&per_cu, (const void*)mega_fwd, NTHR, LDS_BYTES) != hipSuccess || per_cu < 1)
            fprintf(stderr, "kernel_launch: note: occupancy query reports %d workgroups per CU\n", per_cu);
        (void)hipGetLastError();
        grid = cus;
        if (grid != 256) { fprintf(stderr, "kernel_launch: built for a 256-CU device (workgroup ranges of the cross-attention and conversion phases); this device reports %d; nothing launched\n", cus); grid = -1; return; }
    }
    if (grid < 0) return;
    if (hipMemsetAsync((char*)d_ws + WS_CTL, 0, CTL_ZERO_BYTES, stream) != hipSuccess) { fprintf(stderr, "kernel_launch: memset failed\n"); return; }
    Args a{};
    for (int i = 0; i < 19; ++i) a.in[i] = (const float*)d_in[i];
    a.out = (float*)d_out; a.ws = (unsigned char*)d_ws; a.ph_lo = 0; a.ph_hi = 1 << 20;
    hipLaunchKernelGGL(mega_fwd, dim3(grid), dim3(NTHR), LDS_BYTES, stream, a);
    const hipError_t le = hipPeekAtLastError();
    if (le != hipSuccess) fprintf(stderr, "kernel_launch: launch failed: %s\n", hipGetErrorName(le));
}
```

```cpp
#include <hip/hip_runtime.h>
#include <cstdio>
#include <cstdint>
namespace pg8 {
#define PG8_LAS __attribute__((address_space(3)))
typedef unsigned short bf16_t;
typedef short bf16x8 __attribute__((ext_vector_type(8)));
typedef float f32x4 __attribute__((ext_vector_type(4)));
typedef unsigned u32x4 __attribute__((ext_vector_type(4)));
constexpr int BM = 256, BK = 64, HALF = 128, HTB = HALF * BK * 2  , STAGE_BYTES = 8 * HTB, NXCD = 8, WGM = 8;

__host__ __device__ __forceinline__ int lds_byte(int r, int c) { const int st = (r >> 4) * 2 + (c >> 5), rr = r & 15, cc = c & 31, ob = rr * 64 + cc * 2; return st * 1024 + (ob ^ (((ob >> 9) & 1) << 5)); }
__host__ __device__ __forceinline__ void stage_rc(int b, int& R, int& C) { const int st = b / 1024, sb = b % 1024, swz = sb ^ (((sb >> 9) & 1) << 5); R = (st >> 1) * 16 + swz / 64; C = (st & 1) * 32 + (swz % 64) / 2; }
__host__ __device__ __forceinline__ int perm32(int rho) { const int n = rho >> 4, i = rho & 15; return 8 * (i >> 2) + 4 * n + (i & 3); }

struct Unit { int pm, pn; };
struct Gemm { const bf16_t* A; const bf16_t* Bt; int M, N, K; };

struct StaticOrder {
    int nM, nN, nwg, G, c;
    __host__ __device__ void init(int M, int N, int G_, int c_) { nM = M / BM; nN = N / BM; nwg = nM * nN; G = G_; c = c_; }
    __host__ __device__ bool next(int i, Unit& u) const {
        const long L = (long)i * G + c; if (L >= nwg) return false;
        int wgid = (int)L; { const int q = nwg / NXCD, r = nwg % NXCD, xcd = wgid % NXCD, off = wgid / NXCD; wgid = (xcd < r ? xcd * (q + 1) : r * (q + 1) + (xcd - r) * q) + off; }
        const int nig = WGM * nN, gid = wgid / nig, fm = gid * WGM, gsz = (nM - fm) < WGM ? (nM - fm) : WGM;
        u.pm = fm + ((wgid % nig) % gsz); u.pn = (wgid % nig) / gsz; return true;
    }
    __device__ __forceinline__ void a_ready(const Unit&) const {}
    __device__ __forceinline__ void done(const Unit&) const {}
};

__device__ __forceinline__ unsigned cvt_pk_bf16(float lo, float hi) { unsigned r; asm volatile("v_cvt_pk_bf16_f32 %0, %1, %2" : "=v"(r) : "v"(lo), "v"(hi)); return r; }
typedef float f32x2 __attribute__((ext_vector_type(2)));
__device__ __forceinline__ f32x2 gelu_pk(f32x2 v) {
    const f32x2 av = __builtin_elementwise_abs(v), d = av * 0.2316418882f + 1.0f;
    f32x2 t; t.x = __builtin_amdgcn_rcpf(d.x); t.y = __builtin_amdgcn_rcpf(d.y);
    f32x2 q = t * 0.5307027145f + (-0.7265760135f); q = q * t + 0.7107068705f; q = q * t + (-0.142248368f); q = q * t + 0.127414796f; q = q * t;
    const f32x2 s = (v * v) * (-0.72134752044f);
    f32x2 e; e.x = __builtin_amdgcn_exp2f(s.x); e.y = __builtin_amdgcn_exp2f(s.y);
    const f32x2 m = v * (q * e), r = v - m;
    f32x2 o; o.x = v.x < 0.f ? m.x : r.x; o.y = v.y < 0.f ? m.y : r.y; return o;
}

template <int ACT  > struct EpiBf16 {
    static constexpr bool PERM = true, AFTER_DRAIN = false; static_assert(ACT == 0 || ACT == 1, "EpiBf16: ACT is 0 (none) or 1 (gelu_pk)");
    bf16_t* O; int ldc; const float* bias; int split_cols; size_t split_stride; float scale0;
    __device__ __forceinline__ void operator()(const f32x4 (&acc)[2][2][4][2], const Unit& u, int wr, int wc, int fr, int fq) const {
        const int row0 = u.pm * BM + wr * 64 + fr; int colt = u.pn * BM; bf16_t* base = O;
        float sc = 1.f; if (split_cols) { const int t = colt / split_cols; base += (size_t)t * split_stride; colt -= t * split_cols; if (t == 0) sc = scale0; }
        const int col0 = colt + wc * 32 + 8 * fq, bcol0 = u.pn * BM + wc * 32 + 8 * fq;
        f32x4 bv[2][2];
#pragma unroll
        for (int bj = 0; bj < 2; ++bj)
#pragma unroll
            for (int n = 0; n < 2; ++n) bv[bj][n] = bias ? *(const f32x4*)(bias + bcol0 + bj * HALF + 4 * n) : (f32x4){0.f, 0.f, 0.f, 0.f};
#pragma unroll
        for (int ai = 0; ai < 2; ++ai)
#pragma unroll
            for (int m = 0; m < 4; ++m) { bf16_t* rowp = base + (size_t)(row0 + ai * HALF + m * 16) * ldc + col0;
#pragma unroll
                for (int bj = 0; bj < 2; ++bj) { f32x4 v0 = acc[ai][bj][m][0] + bv[bj][0], v1 = acc[ai][bj][m][1] + bv[bj][1];
                    if (ACT == 1) { f32x2 a = gelu_pk((f32x2){v0[0], v0[1]}), b = gelu_pk((f32x2){v0[2], v0[3]}), c = gelu_pk((f32x2){v1[0], v1[1]}), d = gelu_pk((f32x2){v1[2], v1[3]});
                        v0 = (f32x4){a.x, a.y, b.x, b.y}; v1 = (f32x4){c.x, c.y, d.x, d.y}; }
                    v0 = v0 * sc; v1 = v1 * sc; u32x4 w; w.x = cvt_pk_bf16(v0[0], v0[1]); w.y = cvt_pk_bf16(v0[2], v0[3]); w.z = cvt_pk_bf16(v1[0], v1[1]); w.w = cvt_pk_bf16(v1[2], v1[3]);
                    *(u32x4*)(rowp + bj * HALF) = w; } }
    }
};


struct EpiRes {
    static constexpr bool PERM = false, AFTER_DRAIN = false;
    float* Y; const float* res; int ldc; float alpha;
    __device__ __forceinline__ void operator()(const f32x4 (&acc)[2][2][4][2], const Unit& u, int wr, int wc, int fr, int fq) const {
        const int row0 = u.pm * BM + wr * 64 + fr, col0 = u.pn * BM + wc * 32 + 4 * fq;
#pragma unroll
        for (int ai = 0; ai < 2; ++ai)
#pragma unroll
            for (int m = 0; m < 4; ++m) { const size_t off = (size_t)(row0 + ai * HALF + m * 16) * ldc + col0;
#pragma unroll
                for (int bj = 0; bj < 2; ++bj)
#pragma unroll
                    for (int n = 0; n < 2; ++n) { const f32x4 r = *(const f32x4*)(res + off + bj * HALF + n * 16);
                        *(f32x4*)(Y + off + bj * HALF + n * 16) = r * alpha + acc[ai][bj][m][n]; } }
    }
};
struct RangeOrder {
    int nM, nN, ntot, c0, nw, c;
    __host__ __device__ void init(int M, int N, int c0_, int nw_, int c_) { nM = M / BM; nN = N / BM; ntot = nM * nN; c0 = c0_; nw = nw_; c = c_; }
    __host__ __device__ bool next(int i, Unit& u) const {
        if (c < c0 || c >= c0 + nw) return false;
        const int L = i * nw + (c - c0); if (L >= ntot) return false;
        u.pm = L / nN; u.pn = L % nN; return true;
    }
    __device__ __forceinline__ void a_ready(const Unit&) const {}
    __device__ __forceinline__ void done(const Unit&) const {}
};

struct ZeroOrder : StaticOrder {
    __host__ __device__ bool next(int i, Unit& u) const { const bool r = StaticOrder::next(i, u); u.pm = 0; u.pn = 0; return r; }
};

struct EpiResBf {
    static constexpr bool PERM = true, AFTER_DRAIN = false;
    bf16_t* Y; const bf16_t* res; int ldc; float alpha;
    __device__ __forceinline__ void operator()(const f32x4 (&acc)[2][2][4][2], const Unit& u, int wr, int wc, int fr, int fq) const {
        const int row0 = u.pm * BM + wr * 64 + fr, col0 = u.pn * BM + wc * 32 + 8 * fq;
#pragma unroll
        for (int ai = 0; ai < 2; ++ai)
#pragma unroll
            for (int m = 0; m < 4; ++m) { const size_t off = (size_t)(row0 + ai * HALF + m * 16) * ldc + col0;
#pragma unroll
                for (int bj = 0; bj < 2; ++bj) { const u32x4 r = *(const u32x4*)(res + off + bj * HALF);
                    const f32x4 v0 = acc[ai][bj][m][0], v1 = acc[ai][bj][m][1];
                    u32x4 w;
                    w.x = cvt_pk_bf16(__builtin_bit_cast(float, r.x << 16) * alpha + v0[0], __builtin_bit_cast(float, r.x & 0xffff0000u) * alpha + v0[1]);
                    w.y = cvt_pk_bf16(__builtin_bit_cast(float, r.y << 16) * alpha + v0[2], __builtin_bit_cast(float, r.y & 0xffff0000u) * alpha + v0[3]);
                    w.z = cvt_pk_bf16(__builtin_bit_cast(float, r.z << 16) * alpha + v1[0], __builtin_bit_cast(float, r.z & 0xffff0000u) * alpha + v1[1]);
                    w.w = cvt_pk_bf16(__builtin_bit_cast(float, r.w << 16) * alpha + v1[2], __builtin_bit_cast(float, r.w & 0xffff0000u) * alpha + v1[3]);
                    *(u32x4*)(Y + off + bj * HALF) = w; } }
    }
};

struct EpiResF {
    static constexpr bool PERM = true, AFTER_DRAIN = false;
    float* Y; const bf16_t* res; int ldc; float alpha;
    __device__ __forceinline__ void operator()(const f32x4 (&acc)[2][2][4][2], const Unit& u, int wr, int wc, int fr, int fq) const {
        const int row0 = u.pm * BM + wr * 64 + fr, col0 = u.pn * BM + wc * 32 + 8 * fq;
#pragma unroll
        for (int ai = 0; ai < 2; ++ai)
#pragma unroll
            for (int m = 0; m < 4; ++m) { const size_t off = (size_t)(row0 + ai * HALF + m * 16) * ldc + col0;
#pragma unroll
                for (int bj = 0; bj < 2; ++bj) { const u32x4 r = *(const u32x4*)(res + off + bj * HALF);
                    f32x4 o0, o1;
                    o0[0] = __builtin_bit_cast(float, r.x << 16); o0[1] = __builtin_bit_cast(float, r.x & 0xffff0000u); o0[2] = __builtin_bit_cast(float, r.y << 16); o0[3] = __builtin_bit_cast(float, r.y & 0xffff0000u);
                    o1[0] = __builtin_bit_cast(float, r.z << 16); o1[1] = __builtin_bit_cast(float, r.z & 0xffff0000u); o1[2] = __builtin_bit_cast(float, r.w << 16); o1[3] = __builtin_bit_cast(float, r.w & 0xffff0000u);
                    *(f32x4*)(Y + off + bj * HALF) = o0 * alpha + acc[ai][bj][m][0]; *(f32x4*)(Y + off + bj * HALF + 4) = o1 * alpha + acc[ai][bj][m][1]; } }
    }
};

struct EpiResLn {
    static constexpr bool PERM = true, AFTER_DRAIN = false;
    bf16_t* Y; const float* stats; const float* g; const float* b; int ldc; float alpha;
    __device__ __forceinline__ void operator()(const f32x4 (&acc)[2][2][4][2], const Unit& u, int wr, int wc, int fr, int fq) const {
        const int row0 = u.pm * BM + wr * 64 + fr, col0 = u.pn * BM + wc * 32 + 8 * fq;
        f32x4 gv[2][2], bv[2][2];
#pragma unroll
        for (int bj = 0; bj < 2; ++bj)
#pragma unroll
            for (int n = 0; n < 2; ++n) { gv[bj][n] = *(const f32x4*)(g + col0 + bj * HALF + 4 * n) * alpha; bv[bj][n] = *(const f32x4*)(b + col0 + bj * HALF + 4 * n) * alpha; }
#pragma unroll
        for (int ai = 0; ai < 2; ++ai)
#pragma unroll
            for (int m = 0; m < 4; ++m) { const int row = row0 + ai * HALF + m * 16; const size_t off = (size_t)row * ldc + col0;
                const float mean = stats[2 * row], rstd = stats[2 * row + 1];
#pragma unroll
                for (int bj = 0; bj < 2; ++bj) { const u32x4 r = *(const u32x4*)(Y + off + bj * HALF);
                    f32x4 y0, y1;
                    y0[0] = __builtin_bit_cast(float, r.x << 16); y0[1] = __builtin_bit_cast(float, r.x & 0xffff0000u); y0[2] = __builtin_bit_cast(float, r.y << 16); y0[3] = __builtin_bit_cast(float, r.y & 0xffff0000u);
                    y1[0] = __builtin_bit_cast(float, r.z << 16); y1[1] = __builtin_bit_cast(float, r.z & 0xffff0000u); y1[2] = __builtin_bit_cast(float, r.w << 16); y1[3] = __builtin_bit_cast(float, r.w & 0xffff0000u);
                    const f32x4 o0 = (y0 - mean) * rstd * gv[bj][0] + bv[bj][0] + acc[ai][bj][m][0], o1 = (y1 - mean) * rstd * gv[bj][1] + bv[bj][1] + acc[ai][bj][m][1];
                    u32x4 w; w.x = cvt_pk_bf16(o0[0], o0[1]); w.y = cvt_pk_bf16(o0[2], o0[3]); w.z = cvt_pk_bf16(o1[0], o1[1]); w.w = cvt_pk_bf16(o1[2], o1[3]);
                    *(u32x4*)(Y + off + bj * HALF) = w; } }
    }
};

constexpr float RS_SCALE = 1048576.0f, RS_INV = 1.0f / 1048576.0f;
__device__ __forceinline__ float fx20_to_f(long long v) { return (float)(int)(v >> 20) + (float)((unsigned)v & 0xFFFFFu) * RS_INV; }
__device__ __forceinline__ long long f_to_fx20(float s) { const float fl = floorf(s); return ((long long)(int)fl << 20) + (long long)(unsigned)((s - fl) * RS_SCALE + 0.5f); }
__device__ __forceinline__ void row_stats(const long long* rs, int row, float& mean, float& rstd) {
    const long long a = rs[2 * (size_t)row], b = rs[2 * (size_t)row + 1];
    mean = fx20_to_f(a) * (1.0f / 4096.0f); const float var = fx20_to_f(b) * (1.0f / 4096.0f) - mean * mean; rstd = 1.0f / sqrtf(var + 1e-5f);
}
constexpr float FOLD_SCALE = 4294967296.0f, FOLD_INV = 1.0f / 4294967296.0f;
struct EpiBf16Ln {
    static constexpr bool PERM = true, AFTER_DRAIN = false;
    bf16_t* O; int ldc; const long long* rs; const float* cs; const float* b2;
    __device__ __forceinline__ void operator()(const f32x4 (&acc)[2][2][4][2], const Unit& u, int wr, int wc, int fr, int fq) const {
        const int row0 = u.pm * BM + wr * 64 + fr, col0 = u.pn * BM + wc * 32 + 8 * fq;
        f32x4 cv[2][2], bv[2][2];
#pragma unroll
        for (int bj = 0; bj < 2; ++bj)
#pragma unroll
            for (int n = 0; n < 2; ++n) { cv[bj][n] = *(const f32x4*)(cs + col0 + bj * HALF + 4 * n); bv[bj][n] = *(const f32x4*)(b2 + col0 + bj * HALF + 4 * n); }
#pragma unroll
        for (int ai = 0; ai < 2; ++ai)
#pragma unroll
            for (int m = 0; m < 4; ++m) { const int row = row0 + ai * HALF + m * 16; float mean, rstd; row_stats(rs, row, mean, rstd);
                bf16_t* rowp = O + (size_t)row * ldc + col0;
#pragma unroll
                for (int bj = 0; bj < 2; ++bj) { const f32x4 v0 = (acc[ai][bj][m][0] - cv[bj][0] * mean) * rstd + bv[bj][0], v1 = (acc[ai][bj][m][1] - cv[bj][1] * mean) * rstd + bv[bj][1];
                    u32x4 w; w.x = cvt_pk_bf16(v0[0], v0[1]); w.y = cvt_pk_bf16(v0[2], v0[3]); w.z = cvt_pk_bf16(v1[0], v1[1]); w.w = cvt_pk_bf16(v1[2], v1[3]);
                    *(u32x4*)(rowp + bj * HALF) = w; } }
    }
};
__device__ __forceinline__ void row_sums_add(long long* rso, int row, const f32x4& a, const f32x4& b, const f32x4& c, const f32x4& d, int fq) {
    float s1 = ((a[0] + a[1]) + (a[2] + a[3])) + ((b[0] + b[1]) + (b[2] + b[3])) + ((c[0] + c[1]) + (c[2] + c[3])) + ((d[0] + d[1]) + (d[2] + d[3]));
    float s2 = ((a[0] * a[0] + a[1] * a[1]) + (a[2] * a[2] + a[3] * a[3])) + ((b[0] * b[0] + b[1] * b[1]) + (b[2] * b[2] + b[3] * b[3]))
             + ((c[0] * c[0] + c[1] * c[1]) + (c[2] * c[2] + c[3] * c[3])) + ((d[0] * d[0] + d[1] * d[1]) + (d[2] * d[2] + d[3] * d[3]));
    s1 += __shfl_xor(s1, 16); s1 += __shfl_xor(s1, 32); s2 += __shfl_xor(s2, 16); s2 += __shfl_xor(s2, 32);
    if (fq == 0) { atomicAdd((unsigned long long*)(rso + 2 * (size_t)row), (unsigned long long)f_to_fx20(s1)); atomicAdd((unsigned long long*)(rso + 2 * (size_t)row + 1), (unsigned long long)f_to_fx20(s2)); }
}
struct EpiRes0 {
    static constexpr bool PERM = true, AFTER_DRAIN = false;
    bf16_t* Y; const bf16_t* res; int ldc; float alpha; long long* rso;
    __device__ __forceinline__ void operator()(const f32x4 (&acc)[2][2][4][2], const Unit& u, int wr, int wc, int fr, int fq) const {
        const int row0 = u.pm * BM + wr * 64 + fr, col0 = u.pn * BM + wc * 32 + 8 * fq;
#pragma unroll
        for (int ai = 0; ai < 2; ++ai)
#pragma unroll
            for (int m = 0; m < 4; ++m) { const int row = row0 + ai * HALF + m * 16; const size_t off = (size_t)row * ldc + col0; f32x4 o[2][2];
#pragma unroll
                for (int bj = 0; bj < 2; ++bj) { const u32x4 r = *(const u32x4*)(res + off + bj * HALF);
                    f32x4 y0, y1;
                    y0[0] = __builtin_bit_cast(float, r.x << 16); y0[1] = __builtin_bit_cast(float, r.x & 0xffff0000u); y0[2] = __builtin_bit_cast(float, r.y << 16); y0[3] = __builtin_bit_cast(float, r.y & 0xffff0000u);
                    y1[0] = __builtin_bit_cast(float, r.z << 16); y1[1] = __builtin_bit_cast(float, r.z & 0xffff0000u); y1[2] = __builtin_bit_cast(float, r.w << 16); y1[3] = __builtin_bit_cast(float, r.w & 0xffff0000u);
                    o[bj][0] = y0 * alpha + acc[ai][bj][m][0]; o[bj][1] = y1 * alpha + acc[ai][bj][m][1];
                    u32x4 w; w.x = cvt_pk_bf16(o[bj][0][0], o[bj][0][1]); w.y = cvt_pk_bf16(o[bj][0][2], o[bj][0][3]); w.z = cvt_pk_bf16(o[bj][1][0], o[bj][1][1]); w.w = cvt_pk_bf16(o[bj][1][2], o[bj][1][3]);
                    *(u32x4*)(Y + off + bj * HALF) = w; }
                row_sums_add(rso, row, o[0][0], o[0][1], o[1][0], o[1][1], fq); }
    }
};
struct EpiResLn2 {
    static constexpr bool PERM = true, AFTER_DRAIN = false;
    bf16_t* Y; const long long* rsi; const float* g; const float* b; int ldc; float alpha; long long* rso;
    __device__ __forceinline__ void operator()(const f32x4 (&acc)[2][2][4][2], const Unit& u, int wr, int wc, int fr, int fq) const {
        const int row0 = u.pm * BM + wr * 64 + fr, col0 = u.pn * BM + wc * 32 + 8 * fq;
        f32x4 gv[2][2], bv[2][2];
#pragma unroll
        for (int bj = 0; bj < 2; ++bj)
#pragma unroll
            for (int n = 0; n < 2; ++n) { gv[bj][n] = *(const f32x4*)(g + col0 + bj * HALF + 4 * n) * alpha; bv[bj][n] = *(const f32x4*)(b + col0 + bj * HALF + 4 * n) * alpha; }
#pragma unroll
        for (int ai = 0; ai < 2; ++ai)
#pragma unroll
            for (int m = 0; m < 4; ++m) { const int row = row0 + ai * HALF + m * 16; const size_t off = (size_t)row * ldc + col0; float mean, rstd; row_stats(rsi, row, mean, rstd); f32x4 o[2][2];
#pragma unroll
                for (int bj = 0; bj < 2; ++bj) { const u32x4 r = *(const u32x4*)(Y + off + bj * HALF);
                    f32x4 y0, y1;
                    y0[0] = __builtin_bit_cast(float, r.x << 16); y0[1] = __builtin_bit_cast(float, r.x & 0xffff0000u); y0[2] = __builtin_bit_cast(float, r.y << 16); y0[3] = __builtin_bit_cast(float, r.y & 0xffff0000u);
                    y1[0] = __builtin_bit_cast(float, r.z << 16); y1[1] = __builtin_bit_cast(float, r.z & 0xffff0000u); y1[2] = __builtin_bit_cast(float, r.w << 16); y1[3] = __builtin_bit_cast(float, r.w & 0xffff0000u);
                    o[bj][0] = (y0 - mean) * rstd * gv[bj][0] + bv[bj][0] + acc[ai][bj][m][0]; o[bj][1] = (y1 - mean) * rstd * gv[bj][1] + bv[bj][1] + acc[ai][bj][m][1];
                    u32x4 w; w.x = cvt_pk_bf16(o[bj][0][0], o[bj][0][1]); w.y = cvt_pk_bf16(o[bj][0][2], o[bj][0][3]); w.z = cvt_pk_bf16(o[bj][1][0], o[bj][1][1]); w.w = cvt_pk_bf16(o[bj][1][2], o[bj][1][3]);
                    *(u32x4*)(Y + off + bj * HALF) = w; }
                row_sums_add(rso, row, o[0][0], o[0][1], o[1][0], o[1][1], fq); }
    }
};

struct EpiBf16LnTok {
    static constexpr bool PERM = true, AFTER_DRAIN = false, AROWPERM = true;
    bf16_t* O; int ldc; const long long* rs; const float* cs; const float* b2;
    __device__ __forceinline__ void operator()(const f32x4 (&acc)[2][2][4][2], const Unit& u, int wr, int wc, int fr, int fq) const {
        const int row0 = u.pm * BM + 128 * wr + 8 * fr, col0 = u.pn * BM + wc * 32 + 8 * fq;
        f32x4 cv[2][2], bv[2][2];
#pragma unroll
        for (int bj = 0; bj < 2; ++bj)
#pragma unroll
            for (int n = 0; n < 2; ++n) { cv[bj][n] = *(const f32x4*)(cs + col0 + bj * HALF + 4 * n); bv[bj][n] = *(const f32x4*)(b2 + col0 + bj * HALF + 4 * n); }
#pragma unroll
        for (int ai = 0; ai < 2; ++ai)
#pragma unroll
            for (int m = 0; m < 4; ++m) { const int row = row0 + 4 * ai + m; float mean, rstd; row_stats(rs, row, mean, rstd);
                bf16_t* rowp = O + (size_t)row * ldc + col0;
#pragma unroll
                for (int bj = 0; bj < 2; ++bj) { const f32x4 v0 = (acc[ai][bj][m][0] - cv[bj][0] * mean) * rstd + bv[bj][0], v1 = (acc[ai][bj][m][1] - cv[bj][1] * mean) * rstd + bv[bj][1];
                    u32x4 w; w.x = cvt_pk_bf16(v0[0], v0[1]); w.y = cvt_pk_bf16(v0[2], v0[3]); w.z = cvt_pk_bf16(v1[0], v1[1]); w.w = cvt_pk_bf16(v1[2], v1[3]);
                    *(u32x4*)(rowp + bj * HALF) = w; } }
    }
};

__device__ __forceinline__ float dpp_shr1(float x) { return __builtin_bit_cast(float, __builtin_amdgcn_update_dpp(0, __builtin_bit_cast(int, x), 0x111, 0xf, 0xf, true)); }
struct EpiConvGlu {
    static constexpr bool PERM = true, AFTER_DRAIN = false, AROWPERM = true;
    bf16_t* G; bf16_t* side; const long long* rs; const float* cs; const float* b2; const float* cw; int dff;
    __device__ __forceinline__ void operator()(const f32x4 (&acc)[2][2][4][2], const Unit& u, int wr, int wc, int fr, int fq) const {
        const int row0 = u.pm * BM + 128 * wr + 8 * fr, colg = u.pn * BM + wc * 32 + 8 * fq, ch0 = u.pn * HALF + wc * 32 + 8 * fq;
        float mean_[8], rstd_[8];
#pragma unroll
        for (int j = 0; j < 8; ++j) row_stats(rs, row0 + j, mean_[j], rstd_[j]);
        unsigned gout[8][4];
        const int bnd = row0 >> 7;
#pragma unroll
        for (int n = 0; n < 2; ++n) {
            const f32x4 ca = *(const f32x4*)(cs + colg + 4 * n), ba = *(const f32x4*)(b2 + colg + 4 * n), cu = *(const f32x4*)(cs + colg + HALF + 4 * n), bu = *(const f32x4*)(b2 + colg + HALF + 4 * n);
            const f32x4 w0 = *(const f32x4*)(cw + ch0 + 4 * n), w1 = *(const f32x4*)(cw + dff + ch0 + 4 * n), w2 = *(const f32x4*)(cw + 2 * dff + ch0 + 4 * n);
            f32x4 a[8], uu[8];
#pragma unroll
            for (int j = 0; j < 8; ++j) { a[j] = (acc[j >> 2][0][j & 3][n] - ca * mean_[j]) * rstd_[j] + ba; uu[j] = (acc[j >> 2][1][j & 3][n] - cu * mean_[j]) * rstd_[j] + bu; }
            f32x4 p6, p7;
#pragma unroll
            for (int q = 0; q < 4; ++q) { p6[q] = dpp_shr1(a[6][q]); p7[q] = dpp_shr1(a[7][q]); }
            if (fr == 15 && bnd + 1 < 128) { bf16_t* sp = side + ((size_t)(bnd + 1) * 6) * dff + ch0 + 4 * n;
                *(unsigned long long*)(sp) = (unsigned long long)cvt_pk_bf16(a[6][0], a[6][1]) | ((unsigned long long)cvt_pk_bf16(a[6][2], a[6][3]) << 32);
                *(unsigned long long*)(sp + dff) = (unsigned long long)cvt_pk_bf16(a[7][0], a[7][1]) | ((unsigned long long)cvt_pk_bf16(a[7][2], a[7][3]) << 32); }
            if (fr == 0) { bf16_t* sp = side + ((size_t)bnd * 6 + 2) * dff + ch0 + 4 * n;
                *(unsigned long long*)(sp) = (unsigned long long)cvt_pk_bf16(a[0][0], a[0][1]) | ((unsigned long long)cvt_pk_bf16(a[0][2], a[0][3]) << 32);
                *(unsigned long long*)(sp + dff) = (unsigned long long)cvt_pk_bf16(a[1][0], a[1][1]) | ((unsigned long long)cvt_pk_bf16(a[1][2], a[1][3]) << 32);
                *(unsigned long long*)(sp + 2 * dff) = (unsigned long long)cvt_pk_bf16(uu[0][0], uu[0][1]) | ((unsigned long long)cvt_pk_bf16(uu[0][2], uu[0][3]) << 32);
                *(unsigned long long*)(sp + 3 * dff) = (unsigned long long)cvt_pk_bf16(uu[1][0], uu[1][1]) | ((unsigned long long)cvt_pk_bf16(uu[1][2], uu[1][3]) << 32); }
#pragma unroll
            for (int j = 0; j < 8; ++j) { const f32x4 am1 = (j == 0) ? p7 : a[j ? j - 1 : 0], am2 = (j == 0) ? p6 : (j == 1 ? p7 : a[j > 1 ? j - 2 : 0]);
                const f32x4 c = w2 * a[j] + w1 * am1 + w0 * am2;
                const f32x2 g01 = gelu_pk((f32x2){c[0], c[1]}), g23 = gelu_pk((f32x2){c[2], c[3]});
                gout[j][2 * n] = cvt_pk_bf16(g01.x * uu[j][0], g01.y * uu[j][1]); gout[j][2 * n + 1] = cvt_pk_bf16(g23.x * uu[j][2], g23.y * uu[j][3]); }
        }
#pragma unroll
        for (int j = 0; j < 8; ++j) if (!(fr == 0 && j < 2)) { u32x4 w; w.x = gout[j][0]; w.y = gout[j][1]; w.z = gout[j][2]; w.w = gout[j][3]; *(u32x4*)(G + (size_t)(row0 + j) * dff + ch0) = w; }
    }
};
template <class E, class = void> struct arowperm_v { static constexpr bool value = false; };
template <class E> struct arowperm_v<E, decltype((void)E::AROWPERM)> { static constexpr bool value = E::AROWPERM; };
template <class Epi, class Sched, bool ALIGN_EPI = false, bool SP2 = false>
__device__ __forceinline__ void gemm_phase(PG8_LAS unsigned char* lds, const Gemm g, const Sched& S, const Epi& E) {
    int tid_l = threadIdx.x; asm volatile("" : "+v"(tid_l)); const int tid = tid_l, wid = __builtin_amdgcn_readfirstlane(tid >> 6), lane = tid & 63, wr = wid >> 2, wc = wid & 3, fr = lane & 15, fq = lane >> 4;
    const int K = g.K, nt = K / BK;
    unsigned voffA[2], voffB[2];
#pragma unroll
    for (int i = 0; i < 2; ++i) { int R, C; stage_rc(tid * 16 + i * 8192, R, C); const int Rb = Epi::PERM ? ((R & ~31) + perm32(R & 31)) : R;
        const int Ra = arowperm_v<Epi>::value ? (128 * (R >> 6) + 8 * (R & 15) + ((R >> 4) & 3)) : R;
        voffA[i] = (unsigned)(Ra * K + C) * 2u; voffB[i] = (unsigned)(Rb * K + C) * 2u; }
    const size_t hstepA = arowperm_v<Epi>::value ? (size_t)4 * K * 2 : (size_t)HALF * K * 2;
    const size_t kstep = (size_t)(BK * 2);
    const size_t hstep = (size_t)HALF * K * 2;
    const size_t tstep = 2 * hstep;
    const unsigned ldsw = (unsigned)wid * 1024u;
    const int aoff = lds_byte(wr * 64 + fr, fq * 8), boff = lds_byte(wc * 32 + fr, fq * 8);
#define PG8_SA(b, h) (((b) * 2 + (h)) * HTB)
#define PG8_SB(b, h) ((4 + (b) * 2 + (h)) * HTB)
#define PG8_STAGE(bufoff, gbase, voff) do { _Pragma("unroll") for (int _i = 0; _i < 2; ++_i) \
        __builtin_amdgcn_global_load_lds((const unsigned*)((const char*)(gbase) + (voff)[_i]), (PG8_LAS unsigned*)(lds + (bufoff) + ldsw + _i * 8192), 16, 0, 0); } while (0)
#define PG8_LDA(dst, b, h) do { _Pragma("unroll") for (int m = 0; m < 4; ++m) _Pragma("unroll") for (int k = 0; k < 2; ++k) dst[m][k] = *(const PG8_LAS bf16x8*)(lds + PG8_SA(b, h) + aoff + m * 2048 + k * 1024); } while (0)
#define PG8_LDB(dst, b, h) do { _Pragma("unroll") for (int n = 0; n < 2; ++n) _Pragma("unroll") for (int k = 0; k < 2; ++k) dst[n][k] = *(const PG8_LAS bf16x8*)(lds + PG8_SB(b, h) + boff + n * 2048 + k * 1024); } while (0)
#define PG8_MMA(ai, bj, At, Bt) do { __builtin_amdgcn_s_setprio(1); _Pragma("unroll") for (int m = 0; m < 4; ++m) _Pragma("unroll") for (int n = 0; n < 2; ++n) _Pragma("unroll") for (int k = 0; k < 2; ++k) \
        acc[ai][bj][m][n] = __builtin_amdgcn_mfma_f32_16x16x32_bf16(Bt[n][k], At[m][k], acc[ai][bj][m][n], 0, 0, 0); __builtin_amdgcn_s_setprio(0); } while (0)
#define PG8_WAIT_V(n) asm volatile("s_waitcnt vmcnt(" #n ")" ::: "memory")
#define PG8_WAIT_L(n) asm volatile("s_waitcnt lgkmcnt(" #n ")" ::: "memory")
#define PG8_BAR __builtin_amdgcn_s_barrier()
#define PG8_SCHED __builtin_amdgcn_sched_barrier(0)
    Unit cur, nxt; int ui = 0;
    if (!S.next(0, cur)) return;
    f32x4 acc[2][2][4][2];
#pragma unroll
    for (int a = 0; a < 2; ++a)
#pragma unroll
        for (int b = 0; b < 2; ++b)
#pragma unroll
            for (int m = 0; m < 4; ++m)
#pragma unroll
                for (int n = 0; n < 2; ++n) acc[a][b][m][n] = (f32x4){0.f, 0.f, 0.f, 0.f};
    bf16x8 At[4][2], B0[2][2], B1[2][2];
    const char* cA = (const char*)g.A + (size_t)cur.pm * tstep; const char* cB = (const char*)g.Bt + (size_t)cur.pn * tstep;
    S.a_ready(cur);
    if constexpr (SP2) {
        PG8_STAGE(PG8_SB(0, 0), cB, voffB); PG8_STAGE(PG8_SB(0, 1), cB + hstep, voffB); PG8_STAGE(PG8_SA(0, 0), cA, voffA); PG8_STAGE(PG8_SA(0, 1), cA + hstepA, voffA);
        if (wr == 1) PG8_BAR;
        PG8_WAIT_V(2); PG8_BAR;
        PG8_STAGE(PG8_SB(1, 0), cB + kstep, voffB); PG8_STAGE(PG8_SA(1, 0), cA + kstep, voffA); PG8_STAGE(PG8_SB(1, 1), cB + hstep + kstep, voffB);
        PG8_WAIT_V(6); PG8_BAR;
    } else {
        PG8_STAGE(PG8_SB(0, 0), cB, voffB); PG8_STAGE(PG8_SA(0, 0), cA, voffA); PG8_STAGE(PG8_SB(0, 1), cB + hstep, voffB); PG8_STAGE(PG8_SA(0, 1), cA + hstepA, voffA);
        if (wr == 1) PG8_BAR;
        PG8_WAIT_V(4); PG8_BAR;
        PG8_STAGE(PG8_SB(1, 0), cB + kstep, voffB); PG8_STAGE(PG8_SA(1, 0), cA + kstep, voffA); PG8_STAGE(PG8_SB(1, 1), cB + hstep + kstep, voffB);
        PG8_WAIT_V(6); PG8_BAR;
    }
    for (;;) {
        const bool has_next = S.next(ui + 1, nxt);
        const char* nA = has_next ? (const char*)g.A + (size_t)nxt.pm * tstep : cA; const char* nB = has_next ? (const char*)g.Bt + (size_t)nxt.pn * tstep : cB;
        for (int t = 0; t < nt; t += 2) {
            const bool last = (t == nt - 2);
            const char* a1 = cA + (size_t)(t + 1) * kstep;
            const char* a2 = last ? nA : cA + (size_t)(t + 2) * kstep; const char* b2 = last ? nB : cB + (size_t)(t + 2) * kstep;
            const char* a3 = a2 + kstep; const char* b3 = b2 + kstep;
            if (last && has_next) S.a_ready(nxt);
            if constexpr (SP2) {
            PG8_LDB(B0, 0, 0); PG8_LDB(B1, 0, 1); PG8_SCHED; PG8_LDA(At, 0, 0); PG8_STAGE(PG8_SA(1, 1), a1 + hstepA, voffA);
            PG8_WAIT_V(8); PG8_WAIT_L(0); PG8_BAR; PG8_MMA(0, 0, At, B0); PG8_MMA(0, 1, At, B1); PG8_BAR; PG8_SCHED;
            PG8_LDA(At, 0, 1); PG8_STAGE(PG8_SB(0, 0), b2, voffB); PG8_STAGE(PG8_SB(0, 1), b2 + hstep, voffB); PG8_STAGE(PG8_SA(0, 0), a2, voffA);
            PG8_WAIT_V(8); PG8_WAIT_L(0); PG8_BAR; PG8_MMA(1, 0, At, B0); PG8_MMA(1, 1, At, B1); PG8_BAR; PG8_SCHED;
            PG8_LDB(B0, 1, 0); PG8_LDB(B1, 1, 1); PG8_SCHED; PG8_LDA(At, 1, 0); PG8_STAGE(PG8_SA(0, 1), a2 + hstepA, voffA);
            PG8_WAIT_V(8); PG8_WAIT_L(0); PG8_BAR; PG8_MMA(0, 0, At, B0); PG8_MMA(0, 1, At, B1); PG8_BAR; PG8_SCHED;
            PG8_LDA(At, 1, 1); PG8_STAGE(PG8_SB(1, 0), b3, voffB); PG8_STAGE(PG8_SB(1, 1), b3 + hstep, voffB); PG8_STAGE(PG8_SA(1, 0), a3, voffA);
            PG8_WAIT_V(8); PG8_WAIT_L(0); PG8_BAR; PG8_MMA(1, 0, At, B0); PG8_MMA(1, 1, At, B1); PG8_BAR; PG8_SCHED;
            } else {
            PG8_LDB(B0, 0, 0); PG8_SCHED; PG8_LDA(At, 0, 0); PG8_STAGE(PG8_SA(1, 1), a1 + hstepA, voffA);
            PG8_WAIT_L(8); PG8_BAR; PG8_WAIT_L(0); PG8_MMA(0, 0, At, B0); PG8_BAR; PG8_SCHED;
            PG8_LDB(B1, 0, 1); PG8_STAGE(PG8_SB(0, 0), b2, voffB);
            PG8_BAR; PG8_WAIT_L(0); PG8_MMA(0, 1, At, B1); PG8_BAR;
            PG8_LDA(At, 0, 1); PG8_STAGE(PG8_SA(0, 0), a2, voffA);
            PG8_BAR; PG8_WAIT_L(0); PG8_MMA(1, 0, At, B0); PG8_BAR; PG8_SCHED;
            PG8_STAGE(PG8_SB(0, 1), b2 + hstep, voffB);
            PG8_WAIT_V(6); PG8_BAR; PG8_MMA(1, 1, At, B1); PG8_BAR;
            PG8_LDB(B0, 1, 0); PG8_SCHED; PG8_LDA(At, 1, 0); PG8_STAGE(PG8_SA(0, 1), a2 + hstepA, voffA);
            PG8_WAIT_L(8); PG8_BAR; PG8_WAIT_L(0); PG8_MMA(0, 0, At, B0); PG8_BAR; PG8_SCHED;
            PG8_LDB(B1, 1, 1); PG8_STAGE(PG8_SB(1, 0), b3, voffB);
            PG8_BAR; PG8_WAIT_L(0); PG8_MMA(0, 1, At, B1); PG8_BAR;
            PG8_LDA(At, 1, 1); PG8_STAGE(PG8_SA(1, 0), a3, voffA);
            PG8_BAR; PG8_WAIT_L(0); PG8_MMA(1, 0, At, B0); PG8_BAR; PG8_SCHED;
            PG8_STAGE(PG8_SB(1, 1), b3 + hstep, voffB);
            PG8_WAIT_V(6); PG8_BAR; PG8_MMA(1, 1, At, B1); PG8_BAR;
            }
        }
        if constexpr (ALIGN_EPI) { if (wr == 0) PG8_BAR; }
        if constexpr (!Epi::AFTER_DRAIN) { E(acc, cur, wr, wc, fr, fq); S.done(cur); }
        if (!has_next) break;
#pragma unroll
        for (int a = 0; a < 2; ++a)
#pragma unroll
            for (int b = 0; b < 2; ++b)
#pragma unroll
                for (int m = 0; m < 4; ++m)
#pragma unroll
                    for (int n = 0; n < 2; ++n) acc[a][b][m][n] = (f32x4){0.f, 0.f, 0.f, 0.f};
        cur = nxt; cA = nA; cB = nB; ++ui;
        if constexpr (ALIGN_EPI) { if (wr == 1) PG8_BAR; }
    }
    PG8_WAIT_V(0);
    if constexpr (!ALIGN_EPI) { if (wr == 0) PG8_BAR; }
    PG8_BAR;
    if constexpr (Epi::AFTER_DRAIN) { E.fused(acc, cur, wr, wc, fr, fq, lds, wid, lane); S.done(cur); }
#undef PG8_SA
#undef PG8_SB
#undef PG8_STAGE
#undef PG8_LDA
#undef PG8_LDB
#undef PG8_MMA
#undef PG8_WAIT_V
#undef PG8_WAIT_L
#undef PG8_BAR
#undef PG8_SCHED
}
}

#ifndef PG8_SP2
#define PG8_SP2 true
#endif
#ifndef PG8_ALIGN
#define PG8_ALIGN true
#endif
constexpr int NWAVES = 8, NTHR = 512;
constexpr int BATCH = 2, SEQ = 8192, DM = 4096, MTOK = BATCH * SEQ;
constexpr int HD = 128;
constexpr int A_HEADS = 16, B_HEADS = 16, A_W = 2048, B_W = 2048, AB_IN = 4 * A_W + 3 * B_W;
constexpr int NSA_H = 32, NSA_G = 4, NSA_R = 8, KVW = 512, NSA_IN = 4096 + 6 * KVW + 96, NSA_INP = 7424;
constexpr int NCMP = 511, NCMPP = 512, NSLC = 128, NTOP = 16, WINDOW = 512;
constexpr int NMEM = 256, XH = 4, XW = 512;
constexpr int DFF = 11008, DFF2 = 22016;
constexpr float LN_EPS = 1e-5f, RMS_EPS = 1e-6f;
constexpr float DN_ALPHA = 1.41421356237309515f;
constexpr size_t MiB = (size_t)1 << 20;
constexpr size_t WS_CTL = 0, CTL_ZERO_BYTES = 4 * MiB;
constexpr size_t WS_FOLD = 64 * 1024;
constexpr int FO_XQ = 0, FO_UP = 2 * 512, FO_NSA = FO_UP + 2 * 22016, FO_N = FO_NSA + 7424;
constexpr size_t WS_RSUM = 1 * MiB;
static_assert(WS_FOLD + (size_t)2 * FO_N * 8 <= WS_RSUM && WS_RSUM + (size_t)6 * 16384 * 2 * 8 <= CTL_ZERO_BYTES, "CTL map");
constexpr size_t WS_W_ABIN = 4 * MiB;
constexpr size_t WS_W_ABOUT = WS_W_ABIN + 112 * MiB;
constexpr size_t WS_W_NSAIN = WS_W_ABOUT + 32 * MiB;
constexpr size_t WS_W_NSAOUT = WS_W_NSAIN + 58 * MiB;
constexpr size_t WS_W_XQ = WS_W_NSAOUT + 32 * MiB;
constexpr size_t WS_W_XKV = WS_W_XQ + 8 * MiB;
constexpr size_t WS_W_XO = WS_W_XKV + 16 * MiB;
constexpr size_t WS_W_UP = WS_W_XO + 8 * MiB;
constexpr size_t WS_W_DOWN = WS_W_UP + 344 * MiB;
constexpr size_t WS_W_C1 = WS_W_DOWN + 172 * MiB;
constexpr size_t WS_W_C2 = WS_W_C1 + 2 * MiB;
constexpr size_t WS_MEMB = WS_W_C2 + 1 * MiB;
constexpr size_t WS_HB = WS_MEMB + 4 * MiB;
constexpr size_t WS_Y = WS_HB + 128 * MiB;
constexpr size_t WS_BIG = WS_Y + 256 * MiB;
constexpr size_t WS_G = WS_BIG + 688 * MiB;
constexpr size_t WS_O = WS_G + 344 * MiB;
constexpr size_t WS_MISC = WS_O + 128 * MiB;
constexpr size_t WS_END = WS_MISC + 64 * MiB;
constexpr size_t WS_XQ = WS_MISC;
constexpr size_t WS_XO = WS_MISC + 16 * MiB;
constexpr size_t WS_XKV = WS_MISC + 32 * MiB;
constexpr size_t WS_LB = WS_MISC + 34 * MiB;
constexpr size_t WS_SIDE = WS_MISC + 42 * MiB;
constexpr size_t WS_FOLDF = WS_MISC + 40 * MiB;
constexpr size_t WS_ROPE = WS_MISC + 36 * MiB;
constexpr size_t WS_STATS = WS_MISC + 35 * MiB;
constexpr size_t WS_PROJ0 = WS_BIG;
constexpr size_t WS_SPREV = WS_BIG + 448 * MiB;
constexpr size_t WS_QT = WS_G;
constexpr size_t WS_OINTRA = WS_G + 64 * MiB;
constexpr size_t WS_DEC = WS_G + 192 * MiB;
constexpr size_t WS_DS = WS_Y;
constexpr size_t WS_PROJ1 = WS_BIG;
constexpr size_t WS_QROT = WS_BIG + 232 * MiB;
constexpr size_t WS_KSROT = WS_BIG + 360 * MiB;
constexpr size_t WS_KWROT = WS_BIG + 376 * MiB;
constexpr size_t WS_KCMP = WS_BIG + 392 * MiB;
constexpr size_t WS_VCMP = WS_BIG + 393 * MiB;
constexpr size_t WS_OVL = WS_BIG + 394 * MiB;
constexpr size_t WS_SEL = WS_BIG + 395 * MiB;
constexpr size_t WS_IMP = WS_G + 256 * MiB;
constexpr size_t WS_O32 = WS_G;
static_assert(WS_SPREV + 128 * MiB <= WS_G && WS_DEC + 2 * MiB <= WS_O && WS_SEL + MiB <= WS_G, "ws map");
constexpr int CW_TMO = 0, CW_CODE = 1;
constexpr int CW_BAR = 4096;
constexpr int RING_OFF = 0, RING_BYTES = 131072;
constexpr int LDSCTL_OFF = RING_BYTES, MISC_OFF = LDSCTL_OFF + 320;
constexpr int LDS_BYTES = 147456;
static_assert(MISC_OFF + 128 <= LDS_BYTES, "LDS map");

#define GAS __attribute__((address_space(1)))
#define LAS __attribute__((address_space(3)))
typedef unsigned short bf16;
typedef unsigned v4u __attribute__((ext_vector_type(4)));
typedef unsigned v2u __attribute__((ext_vector_type(2)));
typedef float f32x4 __attribute__((ext_vector_type(4)));
typedef float f32x2 __attribute__((ext_vector_type(2)));
typedef float f32x16 __attribute__((ext_vector_type(16)));
typedef short bf16x8 __attribute__((ext_vector_type(8)));
typedef short s16x4 __attribute__((ext_vector_type(4)));
typedef GAS unsigned gu32;
#define RLX_AGENT __ATOMIC_RELAXED, __HIP_MEMORY_SCOPE_AGENT
#define LDS_WAIT() asm volatile("s_waitcnt lgkmcnt(0)" ::: "memory")
#define VM_WAIT() asm volatile("s_waitcnt vmcnt(0)" ::: "memory")
#define SBAR() __builtin_amdgcn_sched_barrier(0)
__device__ __forceinline__ unsigned f2bf(float f) { unsigned u = __builtin_bit_cast(unsigned, f); return (u + 0x7fffu + ((u >> 16) & 1u)) >> 16; }
__device__ __forceinline__ unsigned pk2(float lo, float hi) { return f2bf(lo) | (f2bf(hi) << 16); }
__device__ __forceinline__ float bf2f(unsigned short b) { return __builtin_bit_cast(float, (unsigned)b << 16); }
__device__ __forceinline__ float bflo(unsigned w) { return __builtin_bit_cast(float, w << 16); }
__device__ __forceinline__ float bfhi(unsigned w) { return __builtin_bit_cast(float, w & 0xffff0000u); }
__device__ __forceinline__ unsigned cvtpk(float lo, float hi) { unsigned r; asm volatile("v_cvt_pk_bf16_f32 %0, %1, %2" : "=v"(r) : "v"(lo), "v"(hi)); return r; }
__device__ __forceinline__ float wave_sum(float v) {
#pragma unroll
    for (int o = 1; o < 64; o <<= 1) v += __shfl_xor(v, o);
    return v;
}
__device__ __forceinline__ float sigmoidf_(float x) { return __builtin_amdgcn_rcpf(1.f + __builtin_amdgcn_exp2f(-1.4426950408889634f * x)); }
__device__ __forceinline__ float gelu1(float v) { pg8::f32x2 r = pg8::gelu_pk((pg8::f32x2){v, 0.f}); return r.x; }
#define XB_TMO      128
#define XB_XCNT(j)  (256  + 64 * (j))
#define XB_XSUB(j)  (1280 + 64 * (j))
#define XB_XGEN(j)  (2304 + 64 * (j))
#define XB_TOP      3328
#define XB_TOPGEN   3392
#define XCD_BAR_WORDS 3456
#define XB_SPIN_CAP (1u << 18)
#define LAS __attribute__((address_space(3)))

__device__ __forceinline__ unsigned xb_ld(unsigned* p)              { return __hip_atomic_load(p, __ATOMIC_RELAXED, __HIP_MEMORY_SCOPE_AGENT); }
__device__ __forceinline__ unsigned xb_add(unsigned* p, unsigned v) { return __hip_atomic_fetch_add(p, v, __ATOMIC_RELAXED, __HIP_MEMORY_SCOPE_AGENT); }
__device__ __forceinline__ unsigned xb_xcc_id() { return (unsigned)__builtin_amdgcn_s_getreg((3 << 11) | 20) & 0xFu; }
#define XB_SPIN(cond, bar) do { unsigned _sp = 0; while (cond) { __builtin_amdgcn_s_sleep(1); \
    if ((++_sp & 255u) == 0u) { if (xb_ld(&(bar)[XB_TMO])) break; if (_sp > XB_SPIN_CAP) { atomicAdd(&(bar)[XB_TMO], 1u); break; } } } } while (0)

struct XcdBarrier {
    unsigned* bar; unsigned x;
    volatile LAS unsigned* st;
};

__device__ __forceinline__ XcdBarrier xcd_barrier_post(unsigned* bar, volatile LAS unsigned* st) {
    XcdBarrier b; b.bar = bar; b.x = xb_xcc_id(); b.st = st;
    if (threadIdx.x == 0) (void)xb_add(&bar[XB_XCNT(b.x)], 1u);
    return b;
}
__device__ __forceinline__ void xcd_barrier_complete(unsigned* bar, unsigned x, unsigned& nloc, unsigned& nx) {
    const unsigned G = gridDim.x * gridDim.y * gridDim.z;
    unsigned sum, cnt, mine, sp = 0u;
    for (;;) {
        sum = 0u; cnt = 0u; mine = 0u;
#pragma unroll
        for (unsigned j = 0; j < 16; ++j) { const unsigned c = xb_ld(&bar[XB_XCNT(j)]); sum += c; cnt += (c > 0u) ? 1u : 0u; mine = (j == x) ? c : mine; }
        if (sum == G) break;
        __builtin_amdgcn_s_sleep(1);
        if ((++sp & 255u) == 0u) { if (xb_ld(&bar[XB_TMO])) break; if (sp > XB_SPIN_CAP) { atomicAdd(&bar[XB_TMO], 1u); break; } }
    }
    nloc = mine > 0u ? mine : 1u; nx = cnt > 0u ? cnt : 1u;
}

__device__ __forceinline__ void xcd_barrier(const XcdBarrier& b) {
    asm volatile("s_waitcnt vmcnt(0)" ::: "memory");
    __syncthreads();
    if (threadIdx.x == 0) {
        unsigned* bar = b.bar;
        __builtin_amdgcn_s_waitcnt(0);
        unsigned nloc = b.st[0], nx = b.st[1];
        if (nloc == 0u) { xcd_barrier_complete(bar, b.x, nloc, nx); b.st[0] = nloc; b.st[1] = nx; }
        const unsigned old = xb_add(&bar[XB_XSUB(b.x)], 1u);
        const unsigned gen = old / nloc;
        if (old + 1u == (gen + 1u) * nloc) {
            __builtin_amdgcn_fence(__ATOMIC_RELEASE, "agent");
            asm volatile("s_waitcnt vmcnt(0)" ::: "memory");
            const unsigned og = xb_add(&bar[XB_TOP], 1u);
            const unsigned tg = og / nx;
            if (og + 1u == (tg + 1u) * nx) xb_add(&bar[XB_TOPGEN], 1u);
            else XB_SPIN(xb_ld(&bar[XB_TOPGEN]) == tg, bar);
            __builtin_amdgcn_fence(__ATOMIC_ACQUIRE, "agent");
            xb_add(&bar[XB_XGEN(b.x)], 1u);
            asm volatile("s_waitcnt vmcnt(0)" ::: "memory");
        } else {
            XB_SPIN(xb_ld(&bar[XB_XGEN(b.x)]) == gen, bar);
            __builtin_amdgcn_fence(__ATOMIC_ACQUIRE, "agent");
            asm volatile("s_waitcnt vmcnt(0)" ::: "memory");
        }
    }
    __syncthreads();
}


constexpr int ATT_D = 128, KVBLK = 64;
constexpr int SHM_V = KVBLK * ATT_D * 2, SHM_K = KVBLK * ATT_D * 2;
constexpr int ATT_K_OFF = 0, ATT_V_OFF = SHM_K, ATT_BUF = SHM_K + SHM_V, ATT_SET = 2 * ATT_BUF;
constexpr int ATT_WS_OFF = RING_BYTES + 512;
constexpr int ATT_X_OFF = ATT_WS_OFF + NWAVES * 256;
static_assert(2 * ATT_SET <= RING_BYTES && ATT_X_OFF + 2048 + NTHR * 16 <= LDS_BYTES, "attention LDS map");
#define KSWZ(row, colB) ((row) * 256 + ((colB) ^ (((row) & 7) << 4)))
__device__ __forceinline__ int crow(int r, int hi) { return (r & 3) + 8 * (r >> 2) + 4 * hi; }
__device__ __forceinline__ int v_st(int k, int c) { const int kk = (k & ~0xC) | ((k & 4) << 1) | ((k & 8) >> 1); return ((kk >> 3) * 4 + (c >> 5)) * 512 + ((kk & 7) * 32 + (c & 31)) * 2; }
__device__ __forceinline__ int v_rd_base(int lane) { return ((lane & 3) << 3) | (((lane >> 2) & 3) << 6) | (((lane >> 4) & 1) << 5) | (((lane >> 5) & 1) << 8); }
constexpr int v_rd_off(int d0, int ks, int half) { return d0 * 512 + ks * 4096 + half * 2048; }
template <int OFF> __device__ __forceinline__ s16x4 tr_read(int vb) {
  s16x4 r; asm volatile("ds_read_b64_tr_b16 %0, %1 offset:%2" : "=&v"(r) : "v"(vb), "i"(OFF) : "memory"); return r;
}
__device__ __forceinline__ void qkt(f32x16& p0, f32x16& p1, const LAS char* Ks, const bf16x8* qr, int r32, int hi) {
  p0 = f32x16{}; p1 = f32x16{};
#pragma unroll
  for (int d0 = 0; d0 < 8; ++d0) { const int cb = (d0 * 16 + hi * 8) * 2;
    const bf16x8 b0 = *(const LAS bf16x8*)(Ks + KSWZ(r32, cb));
    const bf16x8 b1 = *(const LAS bf16x8*)(Ks + KSWZ(32 + r32, cb));
    p0 = __builtin_amdgcn_mfma_f32_32x32x16_bf16(b0, qr[d0], p0, 0, 0, 0);
    p1 = __builtin_amdgcn_mfma_f32_32x32x16_bf16(b1, qr[d0], p1, 0, 0, 0); }
}
__device__ __forceinline__ void pack_p(const f32x16& p0, const f32x16& p1, bf16x8& pa0, bf16x8& pa1, bf16x8& pa2, bf16x8& pa3) {
#define PK4(P, BASE, OUT) do { unsigned a0 = cvtpk(P[BASE + 0], P[BASE + 1]), a1 = cvtpk(P[BASE + 2], P[BASE + 3]);   \
    unsigned b0 = cvtpk(P[BASE + 4], P[BASE + 5]), b1 = cvtpk(P[BASE + 6], P[BASE + 7]);                              \
    auto r0 = __builtin_amdgcn_permlane32_swap(a0, b0, false, false); auto r1 = __builtin_amdgcn_permlane32_swap(a1, b1, false, false); \
    v4u w = {r0[0], r1[0], r0[1], r1[1]}; OUT = __builtin_bit_cast(bf16x8, w); } while (0)
  PK4(p0, 0, pa0); PK4(p0, 8, pa1); PK4(p1, 0, pa2); PK4(p1, 8, pa3);
#undef PK4
}
template <int D0> __device__ __forceinline__ void pv_one(f32x16& od, int vb, bf16x8 pa0, bf16x8 pa1, bf16x8 pa2, bf16x8 pa3) {
  const s16x4 l0 = tr_read<v_rd_off(D0, 0, 0)>(vb), h0 = tr_read<v_rd_off(D0, 0, 1)>(vb), l1 = tr_read<v_rd_off(D0, 1, 0)>(vb), h1 = tr_read<v_rd_off(D0, 1, 1)>(vb);
  const s16x4 l2 = tr_read<v_rd_off(D0, 2, 0)>(vb), h2 = tr_read<v_rd_off(D0, 2, 1)>(vb), l3 = tr_read<v_rd_off(D0, 3, 0)>(vb), h3 = tr_read<v_rd_off(D0, 3, 1)>(vb);
  asm volatile("s_waitcnt lgkmcnt(0)" ::: "memory"); SBAR();
#define PKV(L, H) (bf16x8){L[0], L[1], L[2], L[3], H[0], H[1], H[2], H[3]}
  od = __builtin_amdgcn_mfma_f32_32x32x16_bf16(pa0, PKV(l0, h0), od, 0, 0, 0);
  od = __builtin_amdgcn_mfma_f32_32x32x16_bf16(pa1, PKV(l1, h1), od, 0, 0, 0);
  od = __builtin_amdgcn_mfma_f32_32x32x16_bf16(pa2, PKV(l2, h2), od, 0, 0, 0);
  od = __builtin_amdgcn_mfma_f32_32x32x16_bf16(pa3, PKV(l3, h3), od, 0, 0, 0);
#undef PKV
}
__device__ __forceinline__ void pv_d0(f32x16* o, int vb, bf16x8 pa0, bf16x8 pa1, bf16x8 pa2, bf16x8 pa3) {
  pv_one<0>(o[0], vb, pa0, pa1, pa2, pa3); pv_one<1>(o[1], vb, pa0, pa1, pa2, pa3); pv_one<2>(o[2], vb, pa0, pa1, pa2, pa3); pv_one<3>(o[3], vb, pa0, pa1, pa2, pa3);
}
struct KVStage { bf16x8 ks0, ks1, vs0, vs1; };
__device__ __forceinline__ void kv_load(KVStage& s, const bf16* Kh, const bf16* Vh, long ldk, long ldv, int k0, int sr, int sc) {
  s.ks0 = *(const bf16x8*)(Kh + (long)(k0 + sr) * ldk + sc); s.ks1 = *(const bf16x8*)(Kh + (long)(k0 + 32 + sr) * ldk + sc);
  s.vs0 = *(const bf16x8*)(Vh + (long)(k0 + sr) * ldv + sc); s.vs1 = *(const bf16x8*)(Vh + (long)(k0 + 32 + sr) * ldv + sc);
}
__device__ __forceinline__ void kv_write(const KVStage& s, LAS char* lds, int sr, int sc) {
  *(LAS bf16x8*)(lds + ATT_V_OFF + v_st(sr, sc)) = s.vs0; *(LAS bf16x8*)(lds + ATT_V_OFF + v_st(32 + sr, sc)) = s.vs1;
  *(LAS bf16x8*)(lds + ATT_K_OFF + KSWZ(sr, sc * 2)) = s.ks0; *(LAS bf16x8*)(lds + ATT_K_OFF + KSWZ(32 + sr, sc * 2)) = s.ks1;
}
struct KVDma { int ko[2], vo[2]; };
__device__ __forceinline__ void kv_dma_init(KVDma& d, int ldk, int ldv, int wid, int lane) {
#pragma unroll
  for (int i = 0; i < 2; ++i) { const int p = wid * 2 + i;
    const int row = p * 4 + (lane >> 4), cp = lane & 15; d.ko[i] = row * ldk + ((cp ^ (row & 7)) << 3);
    const int sub = p * 2 + (lane >> 5), kk = (sub >> 2) * 8 + ((lane & 31) >> 2), k = (kk & ~0xC) | ((kk & 4) << 1) | ((kk & 8) >> 1), c = (sub & 3) * 32 + (lane & 3) * 8;
    d.vo[i] = k * ldv + c; }
}
__device__ __forceinline__ void kv_dma(const KVDma& d, const bf16* Kt, const bf16* Vt, LAS char* lds, int buf, int wid) {
#pragma unroll
  for (int i = 0; i < 2; ++i) {
    __builtin_amdgcn_global_load_lds((const unsigned*)(Kt + d.ko[i]), (LAS unsigned*)(lds + buf + ATT_K_OFF + (wid * 2 + i) * 1024), 16, 0, 0);
    __builtin_amdgcn_global_load_lds((const unsigned*)(Vt + d.vo[i]), (LAS unsigned*)(lds + buf + ATT_V_OFF + (wid * 2 + i) * 1024), 16, 0, 0); }
}
__device__ __forceinline__ void rescale_o(f32x16* o, float a, LAS float* al_l, int r32, int hi) {
  if (__any(a < 1.f)) { if (hi == 0) al_l[r32] = a; LDS_WAIT();
#pragma unroll
    for (int r = 0; r < 16; ++r) { const float f = al_l[crow(r, hi)];
#pragma unroll
      for (int d = 0; d < 4; ++d) o[d][r] *= f; }
    LDS_WAIT(); }
}
constexpr float ATT_SCALE = 0.088388347648318440f, ATT_C = ATT_SCALE * 1.4426950408889634f, ATT_THR = 8.f;
__device__ __forceinline__ void softmax_tile(f32x16& p0, f32x16& p1, float& m_reg, float& l_reg, float& alpha, bool rowvalid = true) {
  float pmax = p0[0];
#pragma unroll
  for (int r = 1; r < 16; ++r) pmax = fmaxf(pmax, p0[r]);
#pragma unroll
  for (int r = 0; r < 16; ++r) pmax = fmaxf(pmax, p1[r]);
  { auto rr = __builtin_amdgcn_permlane32_swap(__float_as_uint(pmax), __float_as_uint(pmax), false, false);
    pmax = fmaxf(__uint_as_float(rr[0]), __uint_as_float(rr[1])); }
  if (!rowvalid) pmax = -__builtin_inff();
  float mn;
  if (__all(pmax - m_reg <= ATT_THR / ATT_SCALE)) { mn = m_reg; alpha = 1.f; }
  else { mn = fmaxf(m_reg, pmax); alpha = __builtin_amdgcn_exp2f((m_reg - mn) * ATT_C); m_reg = mn; }
  const float mnC = rowvalid ? -mn * ATT_C : -__builtin_inff();
#pragma unroll
  for (int r = 0; r < 16; ++r) { p0[r] = __builtin_amdgcn_exp2f(fmaf(p0[r], ATT_C, mnC)); p1[r] = __builtin_amdgcn_exp2f(fmaf(p1[r], ATT_C, mnC)); }
  float ps = 0.f;
#pragma unroll
  for (int r = 0; r < 16; ++r) ps += p0[r] + p1[r];
  { auto rr = __builtin_amdgcn_permlane32_swap(__float_as_uint(ps), __float_as_uint(ps), false, false);
    ps = __uint_as_float(rr[0]) + __uint_as_float(rr[1]); }
  l_reg = l_reg * alpha + ps;
}
__device__ __forceinline__ void attn_finish(f32x16& p0, f32x16& p1, f32x16* o, float& m_reg, float& l_reg, LAS float* wsc, int vb, int r32, int hi, bool rowvalid = true) {
  float alpha; softmax_tile(p0, p1, m_reg, l_reg, alpha, rowvalid);
  rescale_o(o, alpha, wsc, r32, hi);
  bf16x8 pa0, pa1, pa2, pa3; pack_p(p0, p1, pa0, pa1, pa2, pa3);
  pv_d0(o, vb, pa0, pa1, pa2, pa3);
}
__device__ __forceinline__ void load_q(bf16x8* qr, const bf16* Qw) {
#pragma unroll
  for (int d0 = 0; d0 < 8; ++d0) qr[d0] = *(const bf16x8*)(Qw + d0 * 16);
}

struct Frame {
    LAS unsigned char* lds;
    unsigned char* ws;
    int tid, lane, wave, G, bid;
    __device__ __forceinline__ void fresh() { int t = threadIdx.x; asm volatile("" : "+v"(t)); tid = t; lane = t & 63; wave = __builtin_amdgcn_readfirstlane(t >> 6);
        int g_ = gridDim.x, b_ = blockIdx.x; asm volatile("" : "+s"(g_), "+s"(b_)); G = g_; bid = b_; }
};
struct Args { const float* in[19]; float* out; unsigned char* ws; int ph_lo, ph_hi; };
typedef const Args __attribute__((address_space(4))) KArgs;
__device__ __forceinline__ KArgs* karg() { KArgs* p = (KArgs*)__builtin_amdgcn_kernarg_segment_ptr(); asm volatile("" : "+s"(p)); return p; }
#define KIN(i) ((const float*)karg()->in[i])
enum { IN_X = 0, IN_MEM, IN_AB_W_IN, IN_HGRN_LB, IN_HGRN_NW, IN_AB_W_OUT, IN_NSA_W_IN, IN_NSA_CMP_POS, IN_NSA_CMP_W1, IN_NSA_CMP_W2, IN_NSA_W_OUT,
       IN_XA_WQ, IN_XA_WKV, IN_XA_WO, IN_FFN_UP, IN_FFN_CONV, IN_FFN_DOWN, IN_LN_G, IN_LN_B };

__device__ __forceinline__ void p0_transpose_item(const float* W, int K, int N, bf16* WT, LAS float* scr, int item, int lane) {
    const int nblk = N / 32, kb = item / nblk, nb = item % nblk, k0 = 64 * kb, n0 = 32 * nb;
#pragma unroll 8
    for (int i = 0; i < 32; ++i) { const int kk = 2 * i + (lane >> 5); scr[kk * 33 + (lane & 31)] = W[(size_t)(k0 + kk) * N + n0 + (lane & 31)]; }
    LDS_WAIT(); asm volatile("" ::: "memory");
    const int c = lane & 7;
#pragma unroll
    for (int j = 0; j < 4; ++j) { const int n = (lane >> 3) + 8 * j; const LAS float* s = scr + (8 * c) * 33 + n;
        v4u o; o.x = pk2(s[0 * 33], s[1 * 33]); o.y = pk2(s[2 * 33], s[3 * 33]); o.z = pk2(s[4 * 33], s[5 * 33]); o.w = pk2(s[6 * 33], s[7 * 33]);
        *(GAS v4u*)(WT + (size_t)(n0 + n) * K + k0 + 8 * c) = o; }
    LDS_WAIT(); asm volatile("" ::: "memory");
}
__device__ __forceinline__ int up_col(int n) { const int isu = n >= DFF, ch = isu ? n - DFF : n; return (ch >> 7) * 256 + isu * 128 + (ch & 127); }
__device__ __forceinline__ void p0_transpose_item_fold(const float* W, int K, int N, bf16* WT, LAS float* scr, int item, int lane, const float* g, const float* b, long long* cs, long long* b2, bool upmap = false) {
    const int nblk = N / 32, kb = item / nblk, nb = item % nblk, k0 = 64 * kb, n0 = 32 * nb, n0m = upmap ? up_col(n0) : n0;
#pragma unroll 8
    for (int i = 0; i < 32; ++i) { const int kk = 2 * i + (lane >> 5); scr[kk * 33 + (lane & 31)] = W[(size_t)(k0 + kk) * N + n0 + (lane & 31)]; }
    LDS_WAIT(); asm volatile("" ::: "memory");
    const int c = lane & 7;
    const f32x4 g0 = *(const f32x4*)(g + k0 + 8 * c), g1 = *(const f32x4*)(g + k0 + 8 * c + 4), b0 = *(const f32x4*)(b + k0 + 8 * c), b1 = *(const f32x4*)(b + k0 + 8 * c + 4);
    const float gg[8] = {g0.x, g0.y, g0.z, g0.w, g1.x, g1.y, g1.z, g1.w}, bb[8] = {b0.x, b0.y, b0.z, b0.w, b1.x, b1.y, b1.z, b1.w};
#pragma unroll
    for (int j = 0; j < 4; ++j) { const int n = (lane >> 3) + 8 * j; const LAS float* s = scr + (8 * c) * 33 + n;
        float sc = 0.f, sb = 0.f; unsigned w[4];
#pragma unroll
        for (int q = 0; q < 4; ++q) { const float x0 = s[(2 * q) * 33], x1 = s[(2 * q + 1) * 33]; const unsigned r0 = f2bf(x0 * gg[2 * q]), r1 = f2bf(x1 * gg[2 * q + 1]);
            w[q] = r0 | (r1 << 16); sc += bf2f((unsigned short)r0) + bf2f((unsigned short)r1); sb += x0 * bb[2 * q] + x1 * bb[2 * q + 1]; }
        *(GAS v4u*)(WT + (size_t)(n0m + n) * K + k0 + 8 * c) = (v4u){w[0], w[1], w[2], w[3]};
        sc += __shfl_xor(sc, 1); sc += __shfl_xor(sc, 2); sc += __shfl_xor(sc, 4); sb += __shfl_xor(sb, 1); sb += __shfl_xor(sb, 2); sb += __shfl_xor(sb, 4);
        if (c == 0) { atomicAdd((unsigned long long*)(cs + n0m + n), (unsigned long long)(long long)rintf(sc * pg8::FOLD_SCALE)); atomicAdd((unsigned long long*)(b2 + n0m + n), (unsigned long long)(long long)rintf(sb * pg8::FOLD_SCALE)); } }
    LDS_WAIT(); asm volatile("" ::: "memory");
}
__device__ __forceinline__ void transpose_mat_fold(Frame& F, const float* W, int K, int N, bf16* WT, const float* g, const float* b, long long* cs, long long* b2, int c0 = 0, int nw = 1 << 30, int part = 0, int nparts = 1, bool upmap = false) {
    if (F.bid < c0 || F.bid >= c0 + nw) return;
    LAS float* scr = (LAS float*)(F.lds + RING_OFF + F.wave * 16384);
    const int nwg = nw < F.G ? nw : F.G, gw = (F.bid - c0) * NWAVES + F.wave, NGW = nwg * NWAVES;
    const int nitems = (K / 64) * (N / 32), ilo = (int)((long)nitems * part / nparts), ihi = (int)((long)nitems * (part + 1) / nparts);
    for (int it = ilo + gw; it < ihi; it += NGW) p0_transpose_item_fold(W, K, N, WT, scr, it, F.lane, g, b, cs, b2, upmap);
}
__device__ __forceinline__ void transpose_mat(Frame& F, const float* W, int K, int N, bf16* WT, int c0 = 0, int nw = 1 << 30) {
    if (F.bid < c0 || F.bid >= c0 + nw) return;
    LAS float* scr = (LAS float*)(F.lds + RING_OFF + F.wave * 16384);
    const int nwg = nw < F.G ? nw : F.G, gw = (F.bid - c0) * NWAVES + F.wave, NGW = nwg * NWAVES;
    const int nitems = (K / 64) * (N / 32);
    for (int it = gw; it < nitems; it += NGW) p0_transpose_item(W, K, N, WT, scr, it, F.lane);
}
__device__ __forceinline__ void fold_finalize(Frame& F, int lo, int n) {
    const long long* fs = (const long long*)(F.ws + WS_FOLD); float* fd = (float*)(F.ws + WS_FOLDF);
    for (int i = F.bid * NTHR + F.tid; i < 2 * n; i += F.G * NTHR) { const int j = (i < n) ? lo + i : FO_N + lo + (i - n); const long long v = fs[j]; fd[j] = (float)(int)(v >> 32) + (float)(unsigned)v * pg8::FOLD_INV; }
}
enum { CJ_DOWN0, CJ_NSA, CJ_L1A, CJ_L1B, CJ_DOWN1 };
template <int JOB>
__device__ __forceinline__ void convert_job(Frame& F, const Args& A, int c0, int nw) {
    unsigned char* ws = F.ws; long long* cs = (long long*)(ws + WS_FOLD); long long* b2 = cs + FO_N;
    if (JOB == CJ_DOWN0 || JOB == CJ_DOWN1) { const int l = JOB == CJ_DOWN1; transpose_mat(F, KIN(IN_FFN_DOWN) + (size_t)l * DFF * DM, DFF, DM, (bf16*)(ws + WS_W_DOWN) + (size_t)l * DM * DFF, c0, nw); }
    if (JOB == CJ_NSA) {
        transpose_mat_fold(F, KIN(IN_NSA_W_IN), DM, NSA_IN, (bf16*)(ws + WS_W_NSAIN), KIN(IN_LN_G) + 2 * DM, KIN(IN_LN_B) + 2 * DM, cs + FO_NSA, b2 + FO_NSA, c0, nw);
        transpose_mat(F, KIN(IN_NSA_W_OUT), DM, DM, (bf16*)(ws + WS_W_NSAOUT), c0, nw); }
    if (JOB == CJ_L1A || JOB == CJ_L1B) { const int l = 1;
        if (JOB == CJ_L1A) {
            transpose_mat_fold(F, KIN(IN_XA_WQ) + (size_t)l * DM * XW, DM, XW, (bf16*)(ws + WS_W_XQ) + (size_t)l * XW * DM, KIN(IN_LN_G) + (size_t)(3 * l) * DM, KIN(IN_LN_B) + (size_t)(3 * l) * DM, cs + FO_XQ + l * XW, b2 + FO_XQ + l * XW, c0, nw);
            transpose_mat(F, KIN(IN_XA_WKV) + (size_t)l * DM * 2 * XW, DM, 2 * XW, (bf16*)(ws + WS_W_XKV) + (size_t)l * 2 * XW * DM, c0, nw);
            transpose_mat(F, KIN(IN_XA_WO) + (size_t)l * XW * DM, XW, DM, (bf16*)(ws + WS_W_XO) + (size_t)l * DM * XW, c0, nw); }
        transpose_mat_fold(F, KIN(IN_FFN_UP) + (size_t)l * DM * DFF2, DM, DFF2, (bf16*)(ws + WS_W_UP) + (size_t)l * DFF2 * DM, KIN(IN_LN_G) + (size_t)(3 * l + 1) * DM, KIN(IN_LN_B) + (size_t)(3 * l + 1) * DM,
                           cs + FO_UP + l * DFF2, b2 + FO_UP + l * DFF2, c0, nw, JOB == CJ_L1A ? 0 : 1, 2, true); }
}
__device__ __forceinline__ void cvt_flat(Frame& F, const float* src, bf16* dst, long n8) {
    for (long i = (long)F.bid * NTHR + F.tid; i < n8; i += (long)F.G * NTHR) {
        const f32x4 a = *(const f32x4*)(src + i * 8), b = *(const f32x4*)(src + i * 8 + 4);
        v4u o; o.x = pk2(a.x, a.y); o.y = pk2(a.z, a.w); o.z = pk2(b.x, b.y); o.w = pk2(b.z, b.w);
        *(v4u*)(dst + i * 8) = o; }
}
__device__ __forceinline__ void p0_prologue(Frame& F, const Args& A) {
    unsigned char* ws = F.ws;
    long long* cs = (long long*)(ws + WS_FOLD); long long* b2 = cs + FO_N;
    transpose_mat(F, KIN(IN_AB_W_IN), DM, AB_IN, (bf16*)(ws + WS_W_ABIN));
    transpose_mat(F, KIN(IN_AB_W_OUT), DM, DM, (bf16*)(ws + WS_W_ABOUT));
    { const int l = 0;
        transpose_mat_fold(F, KIN(IN_XA_WQ) + (size_t)l * DM * XW, DM, XW, (bf16*)(ws + WS_W_XQ) + (size_t)l * XW * DM, KIN(IN_LN_G) + (size_t)(3 * l) * DM, KIN(IN_LN_B) + (size_t)(3 * l) * DM, cs + FO_XQ + l * XW, b2 + FO_XQ + l * XW);
        transpose_mat(F, KIN(IN_XA_WKV) + (size_t)l * DM * 2 * XW, DM, 2 * XW, (bf16*)(ws + WS_W_XKV) + (size_t)l * 2 * XW * DM);
        transpose_mat(F, KIN(IN_XA_WO) + (size_t)l * XW * DM, XW, DM, (bf16*)(ws + WS_W_XO) + (size_t)l * DM * XW);
        transpose_mat_fold(F, KIN(IN_FFN_UP) + (size_t)l * DM * DFF2, DM, DFF2, (bf16*)(ws + WS_W_UP) + (size_t)l * DFF2 * DM, KIN(IN_LN_G) + (size_t)(3 * l + 1) * DM, KIN(IN_LN_B) + (size_t)(3 * l + 1) * DM, cs + FO_UP + l * DFF2, b2 + FO_UP + l * DFF2, 0, 1 << 30, 0, 1, true); }
    for (int l = 0; l < 2; ++l) {
        transpose_mat(F, KIN(IN_NSA_CMP_W1) + (size_t)l * 32 * HD * HD, 32 * HD, HD, (bf16*)(ws + WS_W_C1) + (size_t)l * HD * 32 * HD);
        transpose_mat(F, KIN(IN_NSA_CMP_W2) + (size_t)l * HD * HD, HD, HD, (bf16*)(ws + WS_W_C2) + (size_t)l * HD * HD);
    }
    cvt_flat(F, KIN(IN_X), (bf16*)(ws + WS_HB), (long)MTOK * DM / 8);
    cvt_flat(F, KIN(IN_MEM), (bf16*)(ws + WS_MEMB), (long)BATCH * NMEM * DM / 8);
    { v4u z = {0u, 0u, 0u, 0u}; v4u* p = (v4u*)((bf16*)(ws + WS_W_NSAIN) + (size_t)NSA_IN * DM); const long n = (long)(NSA_INP - NSA_IN) * DM / 8;
      for (long i = (long)F.bid * NTHR + F.tid; i < n; i += (long)F.G * NTHR) p[i] = z; }
    { float* tab = (float*)(ws + WS_ROPE);
      for (int i = F.bid * NTHR + F.tid; i < SEQ * 64; i += F.G * NTHR) { const int t = i >> 6, d = i & 63;
          float sn, cs; sincosf((float)t * powf(10000.0f, -(float)d * (1.0f / 64.0f)), &sn, &cs); tab[(size_t)t * 128 + d] = cs; tab[(size_t)t * 128 + 64 + d] = sn; } }
    { const float* lbp = KIN(IN_HGRN_LB); float* lbo = (float*)(ws + WS_LB);
      for (int i = F.bid * NTHR + F.tid; i < A_W; i += F.G * NTHR) { const float a = lbp[i], b = lbp[A_W + i], m = fmaxf(a, b), ea = __expf(a - m), eb = __expf(b - m); lbo[i] = ea / (ea + eb); } }
}

__device__ __forceinline__ void ln_phase(Frame& F, const bf16* Y, const float* g, const float* b, float* h32) {
    const int gw = F.bid * NWAVES + F.wave, NGW = F.G * NWAVES;
    for (int m = gw; m < MTOK; m += NGW) {
        const v4u* yr = (const v4u*)(Y + (size_t)m * DM) + F.lane;
        float v[8][8]; float s = 0.f;
#pragma unroll
        for (int j = 0; j < 8; ++j) { const v4u x = yr[64 * j];
            v[j][0] = bflo(x.x); v[j][1] = bfhi(x.x); v[j][2] = bflo(x.y); v[j][3] = bfhi(x.y); v[j][4] = bflo(x.z); v[j][5] = bfhi(x.z); v[j][6] = bflo(x.w); v[j][7] = bfhi(x.w);
#pragma unroll
            for (int q = 0; q < 8; ++q) s += v[j][q]; }
        const float mean = wave_sum(s) * (1.f / DM); float s2 = 0.f;
#pragma unroll
        for (int j = 0; j < 8; ++j)
#pragma unroll
            for (int q = 0; q < 8; ++q) { v[j][q] -= mean; s2 += v[j][q] * v[j][q]; }
        const float rstd = 1.f / sqrtf(wave_sum(s2) * (1.f / DM) + LN_EPS);
#pragma unroll
        for (int j = 0; j < 8; ++j) { const int c0 = 8 * F.lane + 512 * j;
            const f32x4 g0 = *(const f32x4*)(g + c0), g1 = *(const f32x4*)(g + c0 + 4), b0 = *(const f32x4*)(b + c0), b1 = *(const f32x4*)(b + c0 + 4);
            f32x4 r0, r1;
            r0.x = v[j][0] * rstd * g0.x + b0.x; r0.y = v[j][1] * rstd * g0.y + b0.y; r0.z = v[j][2] * rstd * g0.z + b0.z; r0.w = v[j][3] * rstd * g0.w + b0.w;
            r1.x = v[j][4] * rstd * g1.x + b1.x; r1.y = v[j][5] * rstd * g1.y + b1.y; r1.z = v[j][6] * rstd * g1.z + b1.z; r1.w = v[j][7] * rstd * g1.w + b1.w;
            *(f32x4*)(h32 + (size_t)m * DM + c0) = r0; *(f32x4*)(h32 + (size_t)m * DM + c0 + 4) = r1; }
    }
}

__device__ __forceinline__ void cg_unpack(const v4u x, float* o) { o[0] = bflo(x.x); o[1] = bfhi(x.x); o[2] = bflo(x.y); o[3] = bfhi(x.y); o[4] = bflo(x.z); o[5] = bfhi(x.z); o[6] = bflo(x.w); o[7] = bfhi(x.w); }
__device__ __forceinline__ void convglu_fixup_phase(Frame& F, const bf16* SIDE, const float* cw, bf16* Gm) {
    constexpr int NCG = DFF / 8, NRUN = MTOK / 128;
    for (int it = F.bid * NTHR + F.tid; it < NCG * NRUN; it += F.G * NTHR) {
        const int cg = it % NCG, run = it / NCG, c0 = cg * 8, t0 = run * 128;
        float w0[8], w1[8], w2[8], am2[8], am1[8], a0[8], a1[8], u0[8], u1[8];
#pragma unroll
        for (int j = 0; j < 8; ++j) { w0[j] = cw[c0 + j]; w1[j] = cw[DFF + c0 + j]; w2[j] = cw[2 * DFF + c0 + j]; }
        const bf16* sp = SIDE + (size_t)run * 6 * DFF + c0;
        if ((t0 & (SEQ - 1)) == 0) {
#pragma unroll
            for (int j = 0; j < 8; ++j) { am2[j] = 0.f; am1[j] = 0.f; }
        } else { cg_unpack(*(const v4u*)sp, am2); cg_unpack(*(const v4u*)(sp + DFF), am1); }
        cg_unpack(*(const v4u*)(sp + 2 * DFF), a0); cg_unpack(*(const v4u*)(sp + 3 * DFF), a1); cg_unpack(*(const v4u*)(sp + 4 * DFF), u0); cg_unpack(*(const v4u*)(sp + 5 * DFF), u1);
        unsigned o0[4], o1[4];
#pragma unroll
        for (int j = 0; j < 8; j += 2) {
            const pg8::f32x2 g0 = pg8::gelu_pk((pg8::f32x2){w2[j] * a0[j] + w1[j] * am1[j] + w0[j] * am2[j], w2[j + 1] * a0[j + 1] + w1[j + 1] * am1[j + 1] + w0[j + 1] * am2[j + 1]});
            const pg8::f32x2 g1 = pg8::gelu_pk((pg8::f32x2){w2[j] * a1[j] + w1[j] * a0[j] + w0[j] * am1[j], w2[j + 1] * a1[j + 1] + w1[j + 1] * a0[j + 1] + w0[j + 1] * am1[j + 1]});
            o0[j >> 1] = pk2(g0.x * u0[j], g0.y * u0[j + 1]); o1[j >> 1] = pk2(g1.x * u1[j], g1.y * u1[j + 1]); }
        *(v4u*)(Gm + (size_t)t0 * DFF + c0) = (v4u){o0[0], o0[1], o0[2], o0[3]}; *(v4u*)(Gm + (size_t)(t0 + 1) * DFF + c0) = (v4u){o1[0], o1[1], o1[2], o1[3]};
    }
}

__device__ __forceinline__ void xattn_phase(Frame& F, const bf16* XQ, const bf16* XKV, bf16* XO) {
    const int tid = F.tid, wid = F.wave, lane = F.lane, r32 = lane & 31, hi = lane >> 5;
    LAS char* lds = (LAS char*)F.lds;
    LAS float* wsc = (LAS float*)(lds + ATT_WS_OFF + wid * 256);
    const int vb0 = (int)(uintptr_t)(lds + ATT_V_OFF) + v_rd_base(lane);
    KVDma dm; kv_dma_init(dm, 2 * XW, 2 * XW, wid, lane);
    constexpr int NU = (MTOK / 256) * XH;
    for (int u = F.bid; u < NU; u += F.G) {
        const int head = u % XH, rbk = u / XH, row0 = rbk * 256, b = row0 / SEQ;
        const bf16* Kh = XKV + (size_t)b * NMEM * 2 * XW + head * HD; const bf16* Vh = Kh + XW;
        bf16x8 qr[8]; load_q(qr, XQ + (size_t)(row0 + wid * 32 + r32) * XW + head * HD + hi * 8);
        float m_reg = -1e30f, l_reg = 0.f; f32x16 o[4] = {};
        __syncthreads();
        kv_dma(dm, Kh, Vh, lds, 0, wid);
        for (int j = 0; j < NMEM / KVBLK; ++j) {
            const int buf = (j & 1) * ATT_BUF;
            VM_WAIT(); __syncthreads();
            if (j + 1 < NMEM / KVBLK) kv_dma(dm, Kh + (size_t)(j + 1) * KVBLK * 2 * XW, Vh + (size_t)(j + 1) * KVBLK * 2 * XW, lds, ATT_BUF - buf, wid);
            f32x16 p0, p1; qkt(p0, p1, lds + buf + ATT_K_OFF, qr, r32, hi);
            float alpha; softmax_tile(p0, p1, m_reg, l_reg, alpha);
            rescale_o(o, alpha, wsc, r32, hi);
            bf16x8 pa0, pa1, pa2, pa3; pack_p(p0, p1, pa0, pa1, pa2, pa3);
            pv_d0(o, vb0 + buf, pa0, pa1, pa2, pa3);
        }
        if (hi == 0) wsc[32 + r32] = l_reg; LDS_WAIT();
        bf16* Ow = XO + (size_t)(row0 + wid * 32) * XW + head * HD;
#pragma unroll
        for (int r = 0; r < 16; ++r) { const int orow = crow(r, hi); const float rl = __builtin_amdgcn_rcpf(wsc[32 + orow]);
#pragma unroll
            for (int d0 = 0; d0 < 4; ++d0) Ow[(size_t)orow * XW + d0 * 32 + r32] = (bf16)f2bf(o[d0][r] * rl); }
        LDS_WAIT();
    }
}

template <int K>
__device__ __forceinline__ f32x4 mma_tile(const LAS char* A, int lda, const LAS char* B, int ldb, int fr, int fq) {
    f32x4 acc = {0.f, 0.f, 0.f, 0.f};
#pragma unroll
    for (int k0 = 0; k0 < K; k0 += 32) {
        const bf16x8 a = *(const LAS bf16x8*)(A + fr * lda + (k0 + 8 * fq) * 2);
        const bf16x8 b = *(const LAS bf16x8*)(B + fr * ldb + (k0 + 8 * fq) * 2);
        acc = __builtin_amdgcn_mfma_f32_16x16x32_bf16(a, b, acc, 0, 0, 0);
    }
    return acc;
}
constexpr int HG_CH = 64, HG_NC = SEQ / HG_CH, HG_ITEMS = BATCH * A_HEADS * HG_NC;
constexpr int HG_QT = 0, HG_KT = 17408, HG_KH = 34816, HG_VT = 53248, HG_PT = 71680, HG_SEG = 80896;
constexpr int HG_SP = 17408, HG_OT = 52224;
constexpr int HG_WT = 80896, HG_KHS = 86016, HG_VS = 103424;
__device__ __forceinline__ void hgrn_phase_a(Frame& F, const bf16* P0, const float* lbv, bf16* QTg, bf16* OINTRA, bf16* DS, float* DEC) {
    LAS char* lds = (LAS char*)F.lds;
    const int tid = F.tid, wid = F.wave, lane = F.lane, fr = lane & 15, fq = lane >> 4;
    const int dg = tid & 15, sq = tid >> 4;
    const int d = tid & 127, sq16 = tid >> 7;
    for (int it = F.bid; it < HG_ITEMS; it += F.G) {
        const int c = it % HG_NC, bh = it / HG_NC, h = bh % A_HEADS, b = bh / A_HEADS;
        const size_t row0 = (size_t)b * SEQ + (size_t)c * HG_CH;
        float lb[8], q[2][8], kk[2][8], cum[2][8]; v4u vraw[2];
        { const f32x4 l0 = *(const f32x4*)(lbv + h * HD + 8 * dg), l1 = *(const f32x4*)(lbv + h * HD + 8 * dg + 4);
          lb[0] = l0.x; lb[1] = l0.y; lb[2] = l0.z; lb[3] = l0.w; lb[4] = l1.x; lb[5] = l1.y; lb[6] = l1.z; lb[7] = l1.w; }
#pragma unroll
        for (int rr = 0; rr < 2; ++rr) { const bf16* rowp = P0 + (row0 + 2 * sq + rr) * AB_IN + h * HD + 8 * dg;
            const v4u zq = *(const v4u*)(rowp + A_W), qq = *(const v4u*)rowp; vraw[rr] = *(const v4u*)(rowp + 2 * A_W);
            const unsigned zw[4] = {zq.x, zq.y, zq.z, zq.w}, qw[4] = {qq.x, qq.y, qq.z, qq.w};
#pragma unroll
            for (int j = 0; j < 8; ++j) { const float z = (j & 1) ? bfhi(zw[j >> 1]) : bflo(zw[j >> 1]); q[rr][j] = (j & 1) ? bfhi(qw[j >> 1]) : bflo(qw[j >> 1]);
                const float sg = sigmoidf_(z), omlb = 1.f - lb[j]; kk[rr][j] = omlb * (1.f - sg);
                const float lf = __logf(lb[j] + omlb * sg); cum[rr][j] = rr ? cum[0][j] + lf : lf; } }
        float pre[8];
#pragma unroll
        for (int j = 0; j < 8; ++j) { const float seg = cum[1][j]; float x = seg; const float t1 = __shfl_up(x, 16); if (lane >= 16) x += t1; const float t2 = __shfl_up(x, 32); if (lane >= 32) x += t2;
            pre[j] = x - seg; if (lane >= 48) ((LAS float*)(lds + HG_WT))[wid * 128 + 8 * dg + j] = x; }
        LDS_WAIT(); __syncthreads();
        float total[8];
#pragma unroll
        for (int j = 0; j < 8; ++j) total[j] = 0.f;
#pragma unroll
        for (int w = 0; w < NWAVES; ++w) { const f32x4 a0 = *(const LAS f32x4*)(lds + HG_WT + (w * 128 + 8 * dg) * 4), a1 = *(const LAS f32x4*)(lds + HG_WT + (w * 128 + 8 * dg + 4) * 4);
            const float av[8] = {a0.x, a0.y, a0.z, a0.w, a1.x, a1.y, a1.z, a1.w};
#pragma unroll
            for (int j = 0; j < 8; ++j) { total[j] += av[j]; if (w < wid) pre[j] += av[j]; } }
#pragma unroll
        for (int rr = 0; rr < 2; ++rr) { const int s = 2 * sq + rr; unsigned qt[4], kt[4], kh[4];
#pragma unroll
            for (int j = 0; j < 8; j += 2) { const float b0 = pre[j] + cum[rr][j], b1 = pre[j + 1] + cum[rr][j + 1];
                qt[j >> 1] = pk2(q[rr][j] * __expf(b0), q[rr][j + 1] * __expf(b1));
                kt[j >> 1] = pk2(kk[rr][j] * __expf(-b0), kk[rr][j + 1] * __expf(-b1));
                kh[j >> 1] = pk2(kk[rr][j] * __expf(total[j] - b0), kk[rr][j + 1] * __expf(total[j + 1] - b1)); }
            const v4u qv = {qt[0], qt[1], qt[2], qt[3]};
            *(LAS v4u*)(lds + HG_QT + s * 272 + dg * 16) = qv; *(v4u*)(QTg + (row0 + s) * A_W + h * HD + 8 * dg) = qv;
            *(LAS v4u*)(lds + HG_KT + s * 272 + dg * 16) = (v4u){kt[0], kt[1], kt[2], kt[3]};
            *(LAS v4u*)(lds + HG_KHS + s * 272 + dg * 16) = (v4u){kh[0], kh[1], kh[2], kh[3]};
            *(LAS v4u*)(lds + HG_VS + s * 272 + dg * 16) = vraw[rr]; }
        if (sq == 31) { f32x4 e0, e1; e0.x = __expf(total[0]); e0.y = __expf(total[1]); e0.z = __expf(total[2]); e0.w = __expf(total[3]); e1.x = __expf(total[4]); e1.y = __expf(total[5]); e1.z = __expf(total[6]); e1.w = __expf(total[7]);
            *(f32x4*)(DEC + (size_t)it * HD + 8 * dg) = e0; *(f32x4*)(DEC + (size_t)it * HD + 8 * dg + 4) = e1; }
        LDS_WAIT(); __syncthreads();
        { unsigned kh[8], vt[8];
#pragma unroll
          for (int j = 0; j < 16; j += 2) { const int s = 16 * sq16 + j;
              kh[j >> 1] = (unsigned)*(const LAS unsigned short*)(lds + HG_KHS + s * 272 + d * 2) | ((unsigned)*(const LAS unsigned short*)(lds + HG_KHS + (s + 1) * 272 + d * 2) << 16);
              vt[j >> 1] = (unsigned)*(const LAS unsigned short*)(lds + HG_VS + s * 272 + d * 2) | ((unsigned)*(const LAS unsigned short*)(lds + HG_VS + (s + 1) * 272 + d * 2) << 16); }
          LAS v4u* pk = (LAS v4u*)(lds + HG_KH + d * 144 + sq16 * 32); pk[0] = (v4u){kh[0], kh[1], kh[2], kh[3]}; pk[1] = (v4u){kh[4], kh[5], kh[6], kh[7]};
          LAS v4u* pv = (LAS v4u*)(lds + HG_VT + d * 144 + sq16 * 32); pv[0] = (v4u){vt[0], vt[1], vt[2], vt[3]}; pv[1] = (v4u){vt[4], vt[5], vt[6], vt[7]}; }
        LDS_WAIT(); __syncthreads();
#pragma unroll
        for (int k = 0; k < 2; ++k) { const int tau = 2 * wid + k, ti = tau >> 2, si = tau & 3;
            f32x4 acc = {0.f, 0.f, 0.f, 0.f};
            if (si <= ti) acc = mma_tile<128>(lds + HG_QT + ti * 16 * 272, 272, lds + HG_KT + si * 16 * 272, 272, fr, fq);
#pragma unroll
            for (int i = 0; i < 4; ++i) { const int t = 16 * ti + 4 * fq + i, s = 16 * si + fr; const float v = (s <= t) ? acc[i] : 0.f;
                *(LAS unsigned short*)(lds + HG_PT + t * 144 + s * 2) = (unsigned short)f2bf(v); } }
        LDS_WAIT(); __syncthreads();
#pragma unroll
        for (int k = 0; k < 4; ++k) { const int tau = wid + 8 * k, ti = tau >> 3, vi = tau & 7;
            const f32x4 acc = mma_tile<64>(lds + HG_VT + vi * 16 * 144, 144, lds + HG_PT + ti * 16 * 144, 144, fr, fq);
            v2u w; w.x = pk2(acc[0], acc[1]); w.y = pk2(acc[2], acc[3]);
            *(v2u*)(OINTRA + (row0 + 16 * ti + fr) * A_W + h * HD + 16 * vi + 4 * fq) = w; }
#pragma unroll
        for (int k = 0; k < 8; ++k) { const int tau = wid + 8 * k, vi = tau >> 3, ki = tau & 7;
            const f32x4 acc = mma_tile<64>(lds + HG_KH + ki * 16 * 144, 144, lds + HG_VT + vi * 16 * 144, 144, fr, fq);
            v2u w; w.x = pk2(acc[0], acc[1]); w.y = pk2(acc[2], acc[3]);
            *(v2u*)(DS + ((size_t)it * HD + 16 * vi + fr) * HD + 16 * ki + 4 * fq) = w; }
        LDS_WAIT(); __syncthreads();
    }
}
__device__ __forceinline__ void hgrn_phase_b(Frame& F, const bf16* DS, const float* DEC, bf16* SPREV) {
    const int tid = F.tid, dvl = tid >> 5, dk4 = (tid & 31) * 4;
    for (int item = F.bid; item < BATCH * A_HEADS * 8; item += F.G) {
        const int sl = item & 7, bh = item >> 3, dv = sl * 16 + dvl;
        f32x4 S = {0.f, 0.f, 0.f, 0.f};
        for (int c0 = 0; c0 < HG_NC; c0 += 8) {
            f32x4 ds[8], dc[8];
#pragma unroll
            for (int k = 0; k < 8; ++k) { const size_t it = (size_t)bh * HG_NC + c0 + k; const v2u x = *(const v2u*)(DS + (it * HD + dv) * HD + dk4);
                ds[k] = (f32x4){bflo(x.x), bfhi(x.x), bflo(x.y), bfhi(x.y)}; dc[k] = *(const f32x4*)(DEC + it * HD + dk4); }
#pragma unroll
            for (int k = 0; k < 8; ++k) { const size_t it = (size_t)bh * HG_NC + c0 + k;
                v2u w; w.x = pk2(S.x, S.y); w.y = pk2(S.z, S.w); *(v2u*)(SPREV + (it * HD + dv) * HD + dk4) = w;
                S = S * dc[k] + ds[k]; }
        }
    }
}
__device__ __forceinline__ void hgrn_phase_c(Frame& F, const bf16* P0, const bf16* QTg, const bf16* OINTRA, const bf16* SPREV, const float* nw, bf16* Ob) {
    LAS char* lds = (LAS char*)F.lds;
    const int tid = F.tid, wid = F.wave, lane = F.lane, fr = lane & 15, fq = lane >> 4;
    for (int it = F.bid; it < HG_ITEMS; it += F.G) {
        const int c = it % HG_NC, bh = it / HG_NC, h = bh % A_HEADS, b = bh / A_HEADS;
        const size_t row0 = (size_t)b * SEQ + (size_t)c * HG_CH;
        { const int s = tid >> 3, ch = (tid & 7) * 16; const bf16* src = QTg + (row0 + s) * A_W + h * HD + ch;
          const v4u x0 = *(const v4u*)src, x1 = *(const v4u*)(src + 8); LAS v4u* dst = (LAS v4u*)(lds + HG_QT + s * 272 + ch * 2); dst[0] = x0; dst[1] = x1; }
        { const int dv = tid >> 2, ch = (tid & 3) * 32; const bf16* src = SPREV + ((size_t)it * HD + dv) * HD + ch;
          const v4u x0 = *(const v4u*)src, x1 = *(const v4u*)(src + 8), x2 = *(const v4u*)(src + 16), x3 = *(const v4u*)(src + 24);
          LAS v4u* dst = (LAS v4u*)(lds + HG_SP + dv * 272 + ch * 2); dst[0] = x0; dst[1] = x1; dst[2] = x2; dst[3] = x3; }
        LDS_WAIT(); __syncthreads();
#pragma unroll
        for (int k = 0; k < 4; ++k) { const int tau = wid + 8 * k, ti = tau >> 3, vi = tau & 7;
            const f32x4 acc = mma_tile<128>(lds + HG_SP + vi * 16 * 272, 272, lds + HG_QT + ti * 16 * 272, 272, fr, fq);
            const int t = 16 * ti + fr, dv = 16 * vi + 4 * fq; const v2u oi = *(const v2u*)(OINTRA + (row0 + t) * A_W + h * HD + dv);
            *(LAS f32x4*)(lds + HG_OT + (t * 132 + dv) * 4) = (f32x4){acc[0] + bflo(oi.x), acc[1] + bfhi(oi.x), acc[2] + bflo(oi.y), acc[3] + bfhi(oi.y)}; }
        LDS_WAIT(); __syncthreads();
        { const int t = tid >> 3, dv0 = (tid & 7) * 16;
          float v[16]; float ss = 0.f;
#pragma unroll
          for (int q4 = 0; q4 < 4; ++q4) { const f32x4 x = *(const LAS f32x4*)(lds + HG_OT + (t * 132 + dv0 + 4 * q4) * 4); v[4 * q4] = x.x; v[4 * q4 + 1] = x.y; v[4 * q4 + 2] = x.z; v[4 * q4 + 3] = x.w;
              ss += (x.x * x.x + x.y * x.y) + (x.z * x.z + x.w * x.w); }
          ss += __shfl_xor(ss, 1); ss += __shfl_xor(ss, 2); ss += __shfl_xor(ss, 4);
          const float r = 1.f / sqrtf(ss * (1.f / HD) + RMS_EPS);
          const bf16* gp = P0 + (row0 + t) * AB_IN + 3 * A_W + h * HD + dv0; const v4u g0 = *(const v4u*)gp, g1 = *(const v4u*)(gp + 8);
          const unsigned gw[8] = {g0.x, g0.y, g0.z, g0.w, g1.x, g1.y, g1.z, g1.w}; unsigned o[8];
#pragma unroll
          for (int j = 0; j < 8; ++j) { const float ga = bflo(gw[j]), gb = bfhi(gw[j]);
              o[j] = pk2(v[2 * j] * r * nw[dv0 + 2 * j] * ga * sigmoidf_(ga), v[2 * j + 1] * r * nw[dv0 + 2 * j + 1] * gb * sigmoidf_(gb)); }
          bf16* op = Ob + (row0 + t) * DM + h * HD + dv0; *(v4u*)op = (v4u){o[0], o[1], o[2], o[3]}; *(v4u*)(op + 8) = (v4u){o[4], o[5], o[6], o[7]}; }
        LDS_WAIT(); __syncthreads();
    }
}

constexpr float SB_CUT = -160.f;
__device__ __forceinline__ void sb_phase(Frame& F, const bf16* P0, bf16* Ob) {
    const int tid = F.tid, wid = F.wave, lane = F.lane, r32 = lane & 31, hi = lane >> 5;
    LAS char* lds = (LAS char*)F.lds;
    const int vb0 = (int)(uintptr_t)(lds + ATT_V_OFF) + v_rd_base(lane);
    KVDma dm; kv_dma_init(dm, AB_IN, AB_IN, wid, lane);
    constexpr int NQB = SEQ / 256, NU = BATCH * B_HEADS * NQB;
    for (int rd = 0; ; ++rd) {
        const int idx = (rd & 1) ? rd * F.G + (F.G - 1 - F.bid) : rd * F.G + F.bid;
        if (rd * F.G >= NU) break;
        if (idx >= NU) continue;
        const int qb = NQB - 1 - idx / (BATCH * B_HEADS), bh = idx % (BATCH * B_HEADS), head = bh % B_HEADS, b = bh / B_HEADS;
        const size_t rowb = (size_t)b * SEQ; const int q0 = qb * 256;
        const bf16* Kh = P0 + rowb * AB_IN + 4 * A_W + B_W + head * HD; const bf16* Vh = Kh + B_W;
        const int tw0 = q0 + wid * 32, t = tw0 + r32;
        bf16x8 qr[8]; load_q(qr, P0 + (rowb + t) * AB_IN + 4 * A_W + head * HD + hi * 8);
        float R = 0.f; f32x16 o[4] = {};
        const int jtop = (q0 + 254) >> 6;
        LAS unsigned* dflag = (LAS unsigned*)(lds + ATT_X_OFF);
        if (lane == 0) { dflag[wid] = 0u; dflag[8 + wid] = 0u; }
        LDS_WAIT(); __syncthreads();
        kv_dma(dm, Kh + (size_t)jtop * KVBLK * AB_IN, Vh + (size_t)jtop * KVBLK * AB_IN, lds, 0, wid);
        int buf = 0;
        for (int j = jtop; j >= 0; --j, buf = ATT_BUF - buf) {
            VM_WAIT(); __syncthreads();
            { unsigned alld = 1u;
#pragma unroll
              for (int w = 0; w < NWAVES; ++w) alld &= dflag[((j + 1) & 1) * 8 + w];
              if (__builtin_amdgcn_readfirstlane(alld)) break; }
            if (j > 0) kv_dma(dm, Kh + (size_t)(j - 1) * KVBLK * AB_IN, Vh + (size_t)(j - 1) * KVBLK * AB_IN, lds, ATT_BUF - buf, wid);
            const int k0 = j * KVBLK;
            if (k0 < tw0 + 31) {
                f32x16 p0, p1; qkt(p0, p1, lds + buf + ATT_K_OFF, qr, r32, hi);
                const bool need_mask = (k0 + 63 >= tw0);
                float L0[16], L1[16];
#pragma unroll
                for (int r = 0; r < 16; ++r) {
                    const float z0 = p0[r] * ATT_C, z1 = p1[r] * ATT_C;
                    float l0 = -(fmaxf(z0, 0.f) + __builtin_amdgcn_logf(1.f + __builtin_amdgcn_exp2f(-fabsf(z0))));
                    float l1 = -(fmaxf(z1, 0.f) + __builtin_amdgcn_logf(1.f + __builtin_amdgcn_exp2f(-fabsf(z1))));
                    if (need_mask) { if (k0 + crow(r, hi) >= t) l0 = 0.f; if (k0 + 32 + crow(r, hi) >= t) l1 = 0.f; }
                    L0[r] = l0; L1[r] = l1; p0[r] = z0 + l0; p1[r] = z1 + l1;
                }
                SBAR();
                float Sg[16];
#pragma unroll
                for (int gi = 0; gi < 4; ++gi) {
                    const float a = (L0[4 * gi] + L0[4 * gi + 1]) + (L0[4 * gi + 2] + L0[4 * gi + 3]), c = (L1[4 * gi] + L1[4 * gi + 1]) + (L1[4 * gi + 2] + L1[4 * gi + 3]);
                    auto ra = __builtin_amdgcn_permlane32_swap(__float_as_uint(a), __float_as_uint(a), false, false);
                    auto rc = __builtin_amdgcn_permlane32_swap(__float_as_uint(c), __float_as_uint(c), false, false);
                    Sg[2 * gi] = __uint_as_float(ra[0]); Sg[2 * gi + 1] = __uint_as_float(ra[1]); Sg[8 + 2 * gi] = __uint_as_float(rc[0]); Sg[8 + 2 * gi + 1] = __uint_as_float(rc[1]);
                }
                float run = R;
#pragma unroll
                for (int s = 15; s >= 0; --s) { const float tt = run; run += Sg[s]; Sg[s] = tt; }
                const float Rn = run;
                SBAR();
#pragma unroll
                for (int gi = 0; gi < 4; ++gi) {
                    float base0 = hi ? Sg[2 * gi + 1] : Sg[2 * gi], base1 = hi ? Sg[8 + 2 * gi + 1] : Sg[8 + 2 * gi];
                    float r3 = base0, r2 = r3 + L0[4 * gi + 3], r1 = r2 + L0[4 * gi + 2], r0 = r1 + L0[4 * gi + 1];
                    p0[4 * gi + 3] = __builtin_amdgcn_exp2f(p0[4 * gi + 3] + r3); p0[4 * gi + 2] = __builtin_amdgcn_exp2f(p0[4 * gi + 2] + r2);
                    p0[4 * gi + 1] = __builtin_amdgcn_exp2f(p0[4 * gi + 1] + r1); p0[4 * gi + 0] = __builtin_amdgcn_exp2f(p0[4 * gi + 0] + r0);
                    r3 = base1; r2 = r3 + L1[4 * gi + 3]; r1 = r2 + L1[4 * gi + 2]; r0 = r1 + L1[4 * gi + 1];
                    p1[4 * gi + 3] = __builtin_amdgcn_exp2f(p1[4 * gi + 3] + r3); p1[4 * gi + 2] = __builtin_amdgcn_exp2f(p1[4 * gi + 2] + r2);
                    p1[4 * gi + 1] = __builtin_amdgcn_exp2f(p1[4 * gi + 1] + r1); p1[4 * gi + 0] = __builtin_amdgcn_exp2f(p1[4 * gi + 0] + r0);
                }
                R = Rn;
                { const unsigned dn = __all(R < SB_CUT) ? 1u : 0u; if (lane == 0) dflag[(j & 1) * 8 + wid] = dn; }
                if (need_mask) {
#pragma unroll
                    for (int r = 0; r < 16; ++r) { if (k0 + crow(r, hi) >= t) p0[r] = 0.f; if (k0 + 32 + crow(r, hi) >= t) p1[r] = 0.f; }
                }
                bf16x8 pa0, pa1, pa2, pa3; pack_p(p0, p1, pa0, pa1, pa2, pa3);
                pv_d0(o, vb0 + buf, pa0, pa1, pa2, pa3);
            }
        }
        bf16* Ow = Ob + (rowb + tw0) * DM + A_W + head * HD;
#pragma unroll
        for (int r = 0; r < 16; ++r) { const int orow = crow(r, hi);
#pragma unroll
            for (int d0 = 0; d0 < 4; ++d0) Ow[(size_t)orow * DM + d0 * 32 + r32] = (bf16)f2bf(o[d0][r]); }
    }
}

constexpr int P1_KC = 4096, P1_VC = 4608, P1_KS = 5120, P1_VS = 5632, P1_KW = 6144, P1_VW = 6656, P1_GL = 7168;
__device__ __forceinline__ void nsa_rope_phase(Frame& F, const bf16* P1, const float* TAB, bf16* QROT, bf16* KSROT, bf16* KWROT, bf16* OVL) {
    const int gw = F.bid * NWAVES + F.wave, NGW = F.G * NWAVES, lane = F.lane, hsub = lane >> 3, d0 = (lane & 7) * 8;
    for (int m = gw; m < MTOK; m += NGW) {
        const int t = m & (SEQ - 1);
        const f32x4 c0 = *(const f32x4*)(TAB + (size_t)t * 128 + d0), c1 = *(const f32x4*)(TAB + (size_t)t * 128 + d0 + 4);
        const f32x4 s0 = *(const f32x4*)(TAB + (size_t)t * 128 + 64 + d0), s1 = *(const f32x4*)(TAB + (size_t)t * 128 + 64 + d0 + 4);
        const float cs[8] = {c0.x, c0.y, c0.z, c0.w, c1.x, c1.y, c1.z, c1.w}, sn[8] = {s0.x, s0.y, s0.z, s0.w, s1.x, s1.y, s1.z, s1.w};
        const bf16* row = P1 + (size_t)m * NSA_INP;
#pragma unroll
        for (int hb = 0; hb < 5; ++hb) {
            const int hh = hb * 8 + hsub;
            const bf16* src; bf16* dst;
            if (hh < 32) { src = row + hh * HD; dst = QROT + (size_t)m * DM + hh * HD; }
            else if (hh < 36) { src = row + P1_KS + (hh - 32) * HD; dst = KSROT + (size_t)m * KVW + (hh - 32) * HD; }
            else { src = row + P1_KW + (hh - 36) * HD; dst = KWROT + (size_t)m * KVW + (hh - 36) * HD; }
            const v4u a = *(const v4u*)(src + d0), bq = *(const v4u*)(src + 64 + d0);
            const unsigned aw[4] = {a.x, a.y, a.z, a.w}, bw[4] = {bq.x, bq.y, bq.z, bq.w}; unsigned o1[4], o2[4];
#pragma unroll
            for (int q = 0; q < 4; ++q) { const float x1l = bflo(aw[q]), x1h = bfhi(aw[q]), x2l = bflo(bw[q]), x2h = bfhi(bw[q]);
                o1[q] = pk2(x1l * cs[2 * q] - x2l * sn[2 * q], x1h * cs[2 * q + 1] - x2h * sn[2 * q + 1]);
                o2[q] = pk2(x2l * cs[2 * q] + x1l * sn[2 * q], x2h * cs[2 * q + 1] + x1h * sn[2 * q + 1]); }
            *(v4u*)(dst + d0) = (v4u){o1[0], o1[1], o1[2], o1[3]}; *(v4u*)(dst + 64 + d0) = (v4u){o2[0], o2[1], o2[2], o2[3]};
        }
    }
    for (int i = F.bid * NTHR + F.tid; i < NCMPP * NSLC; i += F.G * NTHR) { const int n = i / NSLC, j = i % NSLC;
        OVL[i] = (n < NCMP && n >= 4 * j - 1 && n <= 4 * j + 3) ? (bf16)0x3f80u : (bf16)0u; }
}
constexpr int CM_A = 0, CM_B = 17408, CM_H = 17408 + 34816;
__device__ __forceinline__ void nsa_compress_phase(Frame& F, const bf16* P1, const float* pos, const bf16* W1t, const bf16* W2t, bf16* KCMP, bf16* VCMP) {
    LAS char* lds = (LAS char*)F.lds;
    const int tid = F.tid, wid = F.wave, lane = F.lane, fr = lane & 15, fq = lane >> 4;
    for (int item = F.bid; item < 128; item += F.G) {
        const int nt = item & 7, g = (item >> 3) & 3, b = (item >> 5) & 1, which = item >> 6;
        const bf16* w1 = W1t + (size_t)which * HD * 32 * HD; const bf16* w2 = W2t + (size_t)which * HD * HD;
        const float* posw = pos + (size_t)which * 32 * HD;
        f32x4 acc[4];
#pragma unroll
        for (int k = 0; k < 4; ++k) acc[k] = (f32x4){0.f, 0.f, 0.f, 0.f};
        for (int l = 0; l < 32; ++l) {
            { const int r = tid >> 3, ch = (tid & 7) * 16, n = nt * 64 + r; unsigned w[8];
              if (n < NCMP) { const bf16* src = P1 + ((size_t)b * SEQ + 16 * n + l) * NSA_INP + P1_KC + which * KVW + g * HD + ch;
                  const v4u x0 = *(const v4u*)src, x1 = *(const v4u*)(src + 8); const unsigned xs[8] = {x0.x, x0.y, x0.z, x0.w, x1.x, x1.y, x1.z, x1.w};
#pragma unroll
                  for (int q = 0; q < 8; ++q) w[q] = pk2(bflo(xs[q]) + posw[l * HD + ch + 2 * q], bfhi(xs[q]) + posw[l * HD + ch + 2 * q + 1]);
              } else {
#pragma unroll
                  for (int q = 0; q < 8; ++q) w[q] = 0u; }
              LAS v4u* dst = (LAS v4u*)(lds + CM_A + r * 272 + ch * 2); dst[0] = (v4u){w[0], w[1], w[2], w[3]}; dst[1] = (v4u){w[4], w[5], w[6], w[7]}; }
            { const int e = tid >> 2, ch = (tid & 3) * 32; const bf16* src = w1 + (size_t)e * 32 * HD + l * HD + ch;
              const v4u x0 = *(const v4u*)src, x1 = *(const v4u*)(src + 8), x2 = *(const v4u*)(src + 16), x3 = *(const v4u*)(src + 24);
              LAS v4u* dst = (LAS v4u*)(lds + CM_B + e * 272 + ch * 2); dst[0] = x0; dst[1] = x1; dst[2] = x2; dst[3] = x3; }
            LDS_WAIT(); __syncthreads();
#pragma unroll
            for (int k = 0; k < 4; ++k) { const int tau = wid + 8 * k, ni = tau >> 3, ei = tau & 7;
                acc[k] += mma_tile<128>(lds + CM_A + ni * 16 * 272, 272, lds + CM_B + ei * 16 * 272, 272, fr, fq); }
            LDS_WAIT(); __syncthreads();
        }
#pragma unroll
        for (int k = 0; k < 4; ++k) { const int tau = wid + 8 * k, ni = tau >> 3, ei = tau & 7;
#pragma unroll
            for (int i = 0; i < 4; ++i) *(LAS unsigned short*)(lds + CM_H + (16 * ni + 4 * fq + i) * 272 + (16 * ei + fr) * 2) = (unsigned short)f2bf(gelu1(acc[k][i])); }
        { const int f = tid >> 2, ch = (tid & 3) * 32; const bf16* src = w2 + (size_t)f * HD + ch;
          const v4u x0 = *(const v4u*)src, x1 = *(const v4u*)(src + 8), x2 = *(const v4u*)(src + 16), x3 = *(const v4u*)(src + 24);
          LAS v4u* dst = (LAS v4u*)(lds + CM_B + f * 272 + ch * 2); dst[0] = x0; dst[1] = x1; dst[2] = x2; dst[3] = x3; }
        LDS_WAIT(); __syncthreads();
        bf16* outp = which ? VCMP : KCMP;
#pragma unroll
        for (int k = 0; k < 4; ++k) { const int tau = wid + 8 * k, ni = tau >> 3, fi = tau & 7;
            const f32x4 a2 = mma_tile<128>(lds + CM_H + ni * 16 * 272, 272, lds + CM_B + fi * 16 * 272, 272, fr, fq);
#pragma unroll
            for (int i = 0; i < 4; ++i) { const int n = nt * 64 + 16 * ni + 4 * fq + i;
                outp[(((size_t)b * NCMPP + n) * NSA_G + g) * HD + 16 * fi + fr] = (n < NCMP) ? (bf16)f2bf(a2[i]) : (bf16)0u; } }
        LDS_WAIT(); __syncthreads();
    }
}
__device__ __forceinline__ unsigned topk_key(float v) { const unsigned u = (v == 0.f) ? 0u : __builtin_bit_cast(unsigned, v); return u ^ ((u >> 31) ? 0xffffffffu : 0x80000000u); }
__device__ __forceinline__ v4u topk_select(float a0, float a1, int cur, int lane) {
    const unsigned k0 = topk_key(a0), k1 = topk_key(a1);
    const int j0 = lane, j1 = lane + 64;
    const bool f0 = (j0 == 0) || (j0 == cur) || (j0 == cur - 1), f1 = (j1 == cur) || (j1 == cur - 1);
    const unsigned long long c0m = __ballot(!f0 && j0 <= cur), c1m = __ballot(!f1 && j1 <= cur);
    const int nforced = cur >= 2 ? 3 : cur + 1, slots = NTOP - nforced;
    unsigned long long s0m = c0m, s1m = c1m;
    if (__builtin_popcountll(c0m) + __builtin_popcountll(c1m) > slots) {
        unsigned T = 0u;
#pragma nounroll
        for (int bit = 31; bit >= 0; --bit) { const unsigned trial = T | (1u << bit);
            const int cnt = __builtin_popcountll(__ballot(k0 >= trial) & c0m) + __builtin_popcountll(__ballot(k1 >= trial) & c1m);
            if (cnt >= slots) T = trial; }
        unsigned long long e0 = __ballot(k0 == T) & c0m, e1 = __ballot(k1 == T) & c1m;
        s0m = __ballot(k0 > T) & c0m; s1m = __ballot(k1 > T) & c1m;
        int need = slots - __builtin_popcountll(s0m) - __builtin_popcountll(s1m);
        while (need > 0 && e0) { const unsigned long long b = e0 & (~e0 + 1ull); s0m |= b; e0 ^= b; --need; }
        while (need > 0 && e1) { const unsigned long long b = e1 & (~e1 + 1ull); s1m |= b; e1 ^= b; --need; }
    }
    const unsigned long long m0 = s0m | __ballot(f0 && j0 <= cur), m1 = s1m | __ballot(f1 && j1 <= cur);
    return (v4u){(unsigned)m0, (unsigned)(m0 >> 32), (unsigned)m1, (unsigned)(m1 >> 32)};
}
__device__ __forceinline__ unsigned pick4(const unsigned (&a)[4], int i) { return i == 0 ? a[0] : (i == 1 ? a[1] : (i == 2 ? a[2] : a[3])); }
template <int MODE>
__device__ __forceinline__ void nsa_attn_phase(Frame& F, const bf16* P1, const bf16* Qsrc, const bf16* Ksrc, const bf16* Vsrc, const unsigned* SEL, float* O32, unsigned* IMPO, bf16* Ob, bool probe_nostore = false) {
    const int tid = F.tid, wid = F.wave, lane = F.lane, r32 = lane & 31, hi = lane >> 5;
    LAS char* lds = (LAS char*)F.lds;
    LAS float* wsc = (LAS float*)(lds + ATT_WS_OFF + wid * 256);
    const int vb0 = (int)(uintptr_t)(lds + ATT_V_OFF) + v_rd_base(lane);
    KVDma dm; kv_dma_init(dm, MODE <= 1 ? NSA_G * HD : KVW, MODE == 0 ? NSA_G * HD : (MODE == 1 ? NSLC : NSA_INP), wid, lane);
    constexpr int NTB = SEQ / 32, NU = BATCH * NSA_G * NTB;
    for (int rd = 0; ; ++rd) {
        int idx;
        { idx = (rd & 1) ? rd * F.G + (F.G - 1 - F.bid) : rd * F.G + F.bid; if (rd * F.G >= NU) break; if (idx >= NU) continue; }
        const int tb = NTB - 1 - idx / (BATCH * NSA_G), bg = idx % (BATCH * NSA_G), g = bg % NSA_G, b = bg / NSA_G;
        const size_t rowb = (size_t)b * SEQ; const int t0 = tb * 32;
        const int t = (MODE == 2) ? t0 + 4 * wid + (r32 >> 3) : t0 + r32, head = (MODE == 2) ? g * NSA_R + (r32 & 7) : g * NSA_R + wid;
        const bf16* Kh; const bf16* Vh; long ldk, ldv; int jlo, jhi;
        if (MODE <= 1) { Kh = Ksrc + ((size_t)b * NCMPP * NSA_G + g) * HD; ldk = NSA_G * HD; jlo = 0; jhi = (t0 >> 4) >> 6;
            if (MODE == 0) { Vh = Vsrc + ((size_t)b * NCMPP * NSA_G + g) * HD; ldv = NSA_G * HD; } else { Vh = Vsrc; ldv = NSLC; } }
        else { Kh = Ksrc + rowb * KVW + g * HD; ldk = KVW; Vh = P1 + rowb * NSA_INP + (MODE == 2 ? P1_VS : P1_VW) + g * HD; ldv = NSA_INP;
            jhi = (t0 + 31) >> 6; jlo = (MODE == 2) ? 0 : ((t0 - (WINDOW - 1) > 0 ? t0 - (WINDOW - 1) : 0) >> 6); }
        unsigned wn[4] = {~0u, ~0u, ~0u, ~0u};
        if (MODE == 2) { const v4u sv = *(const v4u*)(SEL + ((rowb + t) * NSA_G + g) * 4); unsigned selw[4]; selw[0] = sv.x; selw[1] = sv.y; selw[2] = sv.z; selw[3] = sv.w;
            *(LAS v4u*)(lds + ATT_X_OFF + 2048 + (wid * 64 + lane) * 16) = sv;
            LAS unsigned* un = (LAS unsigned*)(lds + ATT_X_OFF);
#pragma unroll
            for (int q = 0; q < 4; ++q) { unsigned x = selw[q]; x |= __shfl_xor(x, 8); x |= __shfl_xor(x, 16); wn[q] = __builtin_amdgcn_readfirstlane(x); if (lane == 0) un[wid * 4 + q] = wn[q]; }
            LDS_WAIT(); __syncthreads();
            LAS int* plist = (LAS int*)(lds + ATT_X_OFF + 128);
            if (wid == 0) {
                unsigned m0 = 0u, m1 = 0u;
                int lane_l = lane; asm volatile("" : "+v"(lane_l));
                const LAS unsigned* ub = un + (lane_l >> 5);
#pragma unroll
                for (int w = 0; w < NWAVES; ++w) { m0 |= ((ub[w * 4] >> (lane & 31)) & 1u) << w; m1 |= ((ub[w * 4 + 2] >> (lane & 31)) & 1u) << w; }
                bool v0 = m0 != 0u && lane <= jhi, v1 = m1 != 0u && lane + 64 <= jhi; int np = 0;
                for (;;) {
                    const unsigned long long a0 = __ballot(v0), a1 = __ballot(v1);
                    if (!(a0 | a1)) break;
                    const int ja_ = a0 ? __builtin_ctzll(a0) : 64 + __builtin_ctzll(a1);
                    const unsigned ma = (ja_ < 64) ? (unsigned)__shfl((int)m0, ja_) : (unsigned)__shfl((int)m1, ja_ - 64);
                    if (lane == (ja_ & 63)) { if (ja_ < 64) v0 = false; else v1 = false; }
                    unsigned long long c0 = __ballot(v0 && !(m0 & ma)), c1 = __ballot(v1 && !(m1 & ma));
                    if (!(c0 | c1)) { c0 = __ballot(v0 && m0 == 0xffu); c1 = __ballot(v1 && m1 == 0xffu); }
                    if (!(c0 | c1)) { c0 = __ballot(v0); c1 = __ballot(v1); }
                    int jb_ = -1;
                    if (c0 | c1) { jb_ = c0 ? __builtin_ctzll(c0) : 64 + __builtin_ctzll(c1); if (lane == (jb_ & 63)) { if (jb_ < 64) v0 = false; else v1 = false; } }
                    if (lane == 0) { plist[2 * np] = ja_; plist[2 * np + 1] = jb_; }
                    ++np;
                }
                if (lane == 0) { int neg1 = -1; asm volatile("" : "+v"(neg1)); plist[2 * np] = neg1; plist[2 * np + 1] = neg1; }
            }
            LDS_WAIT(); }
        bf16x8 qr[8]; load_q(qr, Qsrc + (rowb + t) * (MODE <= 1 ? NSA_INP : DM) + head * HD + hi * 8);
        float m_reg = -1e30f, l_reg = 0.f; f32x16 o[4] = {};
        const int cur = t >> 6;
#define NSA_NEED(jj) (MODE != 2 || ((pick4(wn, (jj) >> 5) >> ((jj) & 31)) & 1u))
#define NSA_MASK(P0, P1, JJ) do { const int k0 = (JJ) * KVBLK; constexpr float NINF = -__builtin_inff(); \
            if (MODE <= 1) { if (!(16 * (k0 + 63) + 31 <= t0)) { \
                    _Pragma("unroll") for (int r = 0; r < 16; ++r) { if (!(16 * (k0 + crow(r, hi)) + 31 <= t)) P0[r] = NINF; if (!(16 * (k0 + 32 + crow(r, hi)) + 31 <= t)) P1[r] = NINF; } } } \
            else if (MODE == 2) { rv_ = (*(const LAS unsigned*)(lds + ATT_X_OFF + 2048 + (wid * 64 + lane) * 16 + ((JJ) >> 5) * 4) >> ((JJ) & 31)) & 1u;     \
                if ((JJ) >= cur) { const int lim = t - k0 - 4 * hi;                          \
                    _Pragma("unroll") for (int r = 0; r < 16; ++r) { if ((r & 3) + 8 * (r >> 2) > lim) P0[r] = NINF; if (32 + (r & 3) + 8 * (r >> 2) > lim) P1[r] = NINF; } } } \
            else { if (!((k0 > t0 + 31 - WINDOW) && (k0 + 63 <= t0))) { \
                    _Pragma("unroll") for (int r = 0; r < 16; ++r) { const int ka = k0 + crow(r, hi), kb = ka + 32; \
                        if (!(ka <= t && ka > t - WINDOW)) P0[r] = NINF; if (!(kb <= t && kb > t - WINDOW)) P1[r] = NINF; } } } } while (0)
        const int pbase = __builtin_amdgcn_readfirstlane((int)(uintptr_t)(lds + ATT_X_OFF + 128)); int pp = 0;
#define PLIST(i) (*(const LAS int*)(uintptr_t)(unsigned)(pbase + 4 * (i)))
        int ja, jb;
        __syncthreads();
        if (MODE == 2) { ja = PLIST(0); jb = PLIST(1); ja = __builtin_amdgcn_readfirstlane(ja); jb = __builtin_amdgcn_readfirstlane(jb); if (ja < 0) ja = jhi + 1; }
        else { ja = jlo; jb = ja + 1; if (jb > jhi) jb = -1; }
        if (ja <= jhi) kv_dma(dm, Kh + (size_t)ja * KVBLK * ldk, Vh + (size_t)ja * KVBLK * ldv, lds, 0, wid);
        if (jb >= 0) kv_dma(dm, Kh + (size_t)jb * KVBLK * ldk, Vh + (size_t)jb * KVBLK * ldv, lds, ATT_BUF, wid);
        int set = 0;
#pragma nounroll
        while (ja <= jhi) {
            int jc, jd;
            if (MODE == 2) { ++pp; jc = PLIST(2 * pp); jd = PLIST(2 * pp + 1); jc = __builtin_amdgcn_readfirstlane(jc); jd = __builtin_amdgcn_readfirstlane(jd); if (jc < 0) jc = jhi + 1; }
            else { jc = (jb >= 0 ? jb : ja) + 1; jd = jc + 1; if (jd > jhi) jd = -1; }
            VM_WAIT(); __syncthreads();
            if (jc <= jhi) kv_dma(dm, Kh + (size_t)jc * KVBLK * ldk, Vh + (size_t)jc * KVBLK * ldv, lds, ATT_SET - set, wid);
            if (jc <= jhi && jd >= 0) kv_dma(dm, Kh + (size_t)jd * KVBLK * ldk, Vh + (size_t)jd * KVBLK * ldv, lds, ATT_SET - set + ATT_BUF, wid);
            const bool nA = NSA_NEED(ja), nB = (jb >= 0) && NSA_NEED(jb);
            f32x16 a0, a1, b0, b1;
            if (nA) qkt(a0, a1, lds + set + ATT_K_OFF, qr, r32, hi);
            if (nB) qkt(b0, b1, lds + set + ATT_BUF + ATT_K_OFF, qr, r32, hi);
            bool rv_ = true;
            if (nA) { NSA_MASK(a0, a1, ja); attn_finish(a0, a1, o, m_reg, l_reg, wsc, vb0 + set, r32, hi, rv_); }
            if (nB) { NSA_MASK(b0, b1, jb); attn_finish(b0, b1, o, m_reg, l_reg, wsc, vb0 + set + ATT_BUF, r32, hi, rv_); }
            ja = jc; jb = (jc <= jhi) ? jd : -1; set = ATT_SET - set;
        }
#undef PLIST
#undef NSA_MASK
#undef NSA_NEED
        { float fac = l_reg > 0.f ? __builtin_amdgcn_rcpf(l_reg) : 0.f;
          if (MODE != 1) { const int br = MODE == 0 ? 0 : (MODE == 2 ? 1 : 2); fac *= sigmoidf_(bf2f(P1[(rowb + t) * NSA_INP + P1_GL + head * 3 + br])); }
          if (hi == 0) wsc[32 + r32] = fac; LDS_WAIT(); }
        if (MODE == 1) {
            float fc[16];
#pragma unroll
            for (int r = 0; r < 16; ++r) fc[r] = wsc[32 + crow(r, hi)];
            LDS_WAIT(); __syncthreads();
#pragma unroll
            for (int r = 0; r < 16; ++r) { const int orow = crow(r, hi);
#pragma unroll
                for (int d0 = 0; d0 < 4; ++d0) *(LAS float*)(lds + ((wid * 32 + orow) * 128 + d0 * 32 + r32) * 4) = o[d0][r] * fc[r]; }
            LDS_WAIT(); __syncthreads();
            { const int tok = tid >> 4, j8 = (tid & 15) * 8; f32x4 s0 = {0.f, 0.f, 0.f, 0.f}, s1 = {0.f, 0.f, 0.f, 0.f};
#pragma unroll
              for (int w = 0; w < 8; ++w) { const LAS f32x4* pp = (const LAS f32x4*)(lds + ((w * 32 + tok) * 128 + j8) * 4); s0 += pp[0]; s1 += pp[1]; }
              LAS f32x4* dst = (LAS f32x4*)(lds + (tok * 128 + j8) * 4); dst[0] = s0; dst[1] = s1; }
            LDS_WAIT(); __syncthreads();
#pragma nounroll
            for (int q = 0; q < 4; ++q) { const int tok = 4 * wid + q, tt = t0 + tok;
                const float a0 = *(const LAS float*)(lds + (tok * 128 + lane) * 4), a1 = *(const LAS float*)(lds + (tok * 128 + 64 + lane) * 4);
                const v4u w = topk_select(a0, a1, tt >> 6, lane);
                if (lane == 0) *(v4u*)(IMPO + ((rowb + tt) * NSA_G + g) * 4) = w; }
            LDS_WAIT(); __syncthreads();
        } else {
#pragma unroll
            for (int r = 0; r < 16; ++r) { const int orow = crow(r, hi); const float fc = wsc[32 + orow];
                const size_t off = (MODE == 2) ? (rowb + t0 + 4 * wid + (orow >> 3)) * DM + (g * NSA_R + (orow & 7)) * HD + r32 : (rowb + t0 + orow) * DM + head * HD + r32;
#pragma unroll
                for (int d0 = 0; d0 < 4; ++d0) {
                    if (MODE == 0) Ob[off + d0 * 32] = (bf16)f2bf(o[d0][r] * fc);
                    else if (MODE == 3) { if (!probe_nostore) Ob[off + d0 * 32] = (bf16)f2bf(bf2f(Ob[off + d0 * 32]) + o[d0][r] * fc); }
                    else Ob[off + d0 * 32] = (bf16)f2bf(bf2f(Ob[off + d0 * 32]) + o[d0][r] * fc); } }
            LDS_WAIT();
        }
    }
}

#ifndef STAGE
#define STAGE 3
#endif
#define ZERO_OB_PHASE PH_BEGIN { v4u z = {0u, 0u, 0u, 0u}; v4u* p = (v4u*)Ob; const long n = (long)MTOK * DM / 8; \
            for (long i = (long)F.bid * NTHR + F.tid; i < n; i += (long)F.G * NTHR) p[i] = z; } PH_END
#define MIXER0_PHASES \
    PH_BEGIN { fold_finalize(F, FO_XQ, XW); fold_finalize(F, FO_UP, DFF2); } \
             REP(10) hgrn_phase_a(F, BIG, (const float*)(ws + WS_LB), (bf16*)(ws + WS_QT), (bf16*)(ws + WS_OINTRA), (bf16*)(ws + WS_DS), (float*)(ws + WS_DEC)); \
             REP(11) sb_phase(F, BIG, Ob); PH_END \
    PH_BEGIN REP(12) hgrn_phase_b(F, (const bf16*)(ws + WS_DS), (const float*)(ws + WS_DEC), (bf16*)(ws + WS_SPREV)); PH_END \
    PH_BEGIN REP(13) hgrn_phase_c(F, BIG, (const bf16*)(ws + WS_QT), (const bf16*)(ws + WS_OINTRA), (const bf16*)(ws + WS_SPREV), KIN(IN_HGRN_NW), Ob); PH_END
#if STAGE <= 2
#define MIXER1_PHASES ZERO_OB_PHASE
#else
#define MIXER1_PHASES \
    PH_BEGIN { fold_finalize(F, FO_XQ + XW, XW); } REP(14) { nsa_rope_phase(F, BIG, (const float*)(ws + WS_ROPE), (bf16*)(ws + WS_QROT), (bf16*)(ws + WS_KSROT), (bf16*)(ws + WS_KWROT), (bf16*)(ws + WS_OVL)); \
             nsa_compress_phase(F, BIG, KIN(IN_NSA_CMP_POS), (const bf16*)(ws + WS_W_C1), (const bf16*)(ws + WS_W_C2), (bf16*)(ws + WS_KCMP), (bf16*)(ws + WS_VCMP)); } PH_END \
    PH_BEGIN { REP(15) nsa_attn_phase<0>(F, BIG, BIG, (const bf16*)(ws + WS_KCMP), (const bf16*)(ws + WS_VCMP), nullptr, nullptr, nullptr, Ob); \
             F.fresh(); REP(15) nsa_attn_phase<1>(F, BIG, BIG, (const bf16*)(ws + WS_KCMP), (const bf16*)(ws + WS_OVL), nullptr, nullptr, (unsigned*)(ws + WS_SEL), nullptr); \
             F.fresh(); REP(17) nsa_attn_phase<3>(F, BIG, (const bf16*)(ws + WS_QROT), (const bf16*)(ws + WS_KWROT), nullptr, nullptr, nullptr, nullptr, Ob, r_ > 0); } PH_END \
    PH_BEGIN REP(18) nsa_attn_phase<2>(F, BIG, (const bf16*)(ws + WS_QROT), (const bf16*)(ws + WS_KSROT), nullptr, (const unsigned*)(ws + WS_SEL), nullptr, nullptr, Ob); PH_END
#endif
#ifndef REPMASK
#define REPMASK 0u
#endif
#define REP(gid) for (int r_ = 0; r_ <= (int)((REPMASK >> (gid)) & 1u); ++r_)
#define PH_BEGIN if (pc >= lo && pc < hi) { F.fresh();
#if (REPMASK >> 23) & 1
#define PH_END   if (pc + 1 < hi) { const unsigned long long tb0_ = __builtin_amdgcn_s_memrealtime(); XcdBarrier bb_ = bar; asm volatile("" : "+s"(bb_.bar), "+s"(bb_.x)); xcd_barrier(bb_); \
        const unsigned w_ = (unsigned)(__builtin_amdgcn_s_memrealtime() - tb0_); tbar_acc += w_; if (threadIdx.x == 0) { atomicMax((unsigned*)(args.ws + 3 * MiB) + pc, 0x7fffffffu - w_); atomicMax((unsigned*)(args.ws + 3 * MiB) + 256 + pc, w_); } } } ++pc;
#else
#define PH_END   if (pc + 1 < hi) { XcdBarrier bb_ = bar; asm volatile("" : "+s"(bb_.bar), "+s"(bb_.x)); xcd_barrier(bb_); } } ++pc;
#endif
template <int l>
__device__ __forceinline__ void layer_body(Frame& F, const Args& args, const XcdBarrier& bar, int& pc, const int lo, const int hi, unsigned long long& tbar_acc) {
    unsigned char* ws = F.ws;
    bf16* HB = (bf16*)(ws + WS_HB); bf16* Y = (bf16*)(ws + WS_Y); float* H32 = (float*)karg()->out;
    bf16* BIG = (bf16*)(ws + WS_BIG); bf16* Gm = (bf16*)(ws + WS_G); bf16* Ob = (bf16*)(ws + WS_O);
    bf16* XQ = (bf16*)(ws + WS_XQ); bf16* XO = (bf16*)(ws + WS_XO);
#define RS(k) ((long long*)(ws + WS_RSUM) + (size_t)(k) * MTOK * 2)
#define LNG(k) (KIN(IN_LN_G) + (size_t)(k) * DM)
#define LNB(k) (KIN(IN_LN_B) + (size_t)(k) * DM)
    const float* cs = (const float*)(ws + WS_FOLDF); const float* b2 = cs + FO_N;
        PH_BEGIN REP(1) {
            const int N = l == 0 ? AB_IN : NSA_INP;
            pg8::StaticOrder S; S.init(MTOK, N, F.G, F.bid);
            if (l == 0) { pg8::Gemm g{HB, (const bf16*)(ws + WS_W_ABIN), MTOK, N, DM}; pg8::EpiBf16<0> E{BIG, N, nullptr, 0, 0, 1.f};
                pg8::gemm_phase<pg8::EpiBf16<0>, pg8::StaticOrder, PG8_ALIGN, PG8_SP2>(F.lds + RING_OFF, g, S, E); }
            else { pg8::Gemm g{Y, (const bf16*)(ws + WS_W_NSAIN), MTOK, N, DM}; pg8::EpiBf16Ln E{BIG, N, RS(2), cs + FO_NSA, b2 + FO_NSA};
                pg8::gemm_phase<pg8::EpiBf16Ln, pg8::StaticOrder, PG8_ALIGN, PG8_SP2>(F.lds + RING_OFF, g, S, E);
                if (r_ == 0) convert_job<CJ_L1A>(F, args, 64, 192); }
        } PH_END
#if STAGE <= 1
        ZERO_OB_PHASE
#else
        if (l == 0) {
            MIXER0_PHASES
        } else {
            MIXER1_PHASES
        }
#endif
        PH_BEGIN REP(2) {
            pg8::Gemm g{Ob, l == 0 ? (const bf16*)(ws + WS_W_ABOUT) : (const bf16*)(ws + WS_W_NSAOUT), MTOK, DM, DM};
            pg8::StaticOrder S; S.init(MTOK, DM, F.G, F.bid);
            if (l == 0) { pg8::EpiRes0 E{Y, HB, DM, DN_ALPHA, RS(0)};
                pg8::gemm_phase<pg8::EpiRes0, pg8::StaticOrder, PG8_ALIGN, PG8_SP2>(F.lds + RING_OFF, g, S, E); }
            else { pg8::EpiResLn2 E{Y, RS(2), LNG(2), LNB(2), DM, DN_ALPHA, RS(3)};
                pg8::gemm_phase<pg8::EpiResLn2, pg8::StaticOrder, PG8_ALIGN, PG8_SP2>(F.lds + RING_OFF, g, S, E); }
        } PH_END
        PH_BEGIN REP(3) {
            {   pg8::Gemm g{Y, (const bf16*)(ws + WS_W_XQ) + (size_t)l * XW * DM, MTOK, XW, DM};
                pg8::RangeOrder S; S.init(MTOK, XW, 0, 128, F.bid);
                pg8::EpiBf16Ln E{XQ, XW, RS(3 * l), cs + FO_XQ + l * XW, b2 + FO_XQ + l * XW};
                pg8::gemm_phase<pg8::EpiBf16Ln, pg8::RangeOrder, PG8_ALIGN, PG8_SP2>(F.lds + RING_OFF, g, S, E); }
            {   pg8::Gemm g{(const bf16*)(ws + WS_MEMB), (const bf16*)(ws + WS_W_XKV) + (size_t)l * 2 * XW * DM, BATCH * NMEM, 2 * XW, DM};
                pg8::RangeOrder S; S.init(BATCH * NMEM, 2 * XW, 128, 8, F.bid);
                pg8::EpiBf16<0> E{(bf16*)(ws + WS_XKV) + (size_t)l * BATCH * NMEM * 2 * XW, 2 * XW, nullptr, 0, 0, 1.f};
                pg8::gemm_phase<pg8::EpiBf16<0>, pg8::RangeOrder, PG8_ALIGN, PG8_SP2>(F.lds + RING_OFF, g, S, E); }
            if (r_ == 0) { if (l == 0) convert_job<CJ_DOWN0>(F, args, 136, 120); else convert_job<CJ_L1B>(F, args, 136, 120); }
        } PH_END
        PH_BEGIN { if (l == 1) fold_finalize(F, FO_UP + DFF2, DFF2); } REP(9) xattn_phase(F, XQ, (const bf16*)(ws + WS_XKV) + (size_t)l * BATCH * NMEM * 2 * XW, XO); PH_END
        PH_BEGIN REP(4) {
            pg8::Gemm g{XO, (const bf16*)(ws + WS_W_XO) + (size_t)l * DM * XW, MTOK, DM, XW};
            pg8::StaticOrder S; S.init(MTOK, DM, F.G, F.bid);
            pg8::EpiResLn2 E{Y, RS(3 * l), LNG(3 * l), LNB(3 * l), DM, DN_ALPHA, RS(3 * l + 1)};
            pg8::gemm_phase<pg8::EpiResLn2, pg8::StaticOrder, PG8_ALIGN, PG8_SP2>(F.lds + RING_OFF, g, S, E);
        } PH_END
        PH_BEGIN REP(5) {
#if (REPMASK >> 22) & 1
            if (r_ > 0) { XcdBarrier bb_ = bar; asm volatile("" : "+s"(bb_.bar), "+s"(bb_.x)); xcd_barrier(bb_); }
#endif
            pg8::Gemm g{Y, (const bf16*)(ws + WS_W_UP) + (size_t)l * DFF2 * DM, MTOK, DFF2, DM};
            pg8::StaticOrder S; S.init(MTOK, DFF2, F.G, F.bid);
            pg8::EpiConvGlu E{Gm, (bf16*)(ws + WS_SIDE), RS(3 * l + 1), cs + FO_UP + l * DFF2, b2 + FO_UP + l * DFF2, KIN(IN_FFN_CONV) + (size_t)l * 3 * DFF, DFF};
            pg8::gemm_phase<pg8::EpiConvGlu, pg8::StaticOrder, PG8_ALIGN, PG8_SP2>(F.lds + RING_OFF, g, S, E);
            if (r_ == 0) { if (l == 0) convert_job<CJ_NSA>(F, args, 128, 128); else convert_job<CJ_DOWN1>(F, args, 128, 128); }
        } PH_END
#if (REPMASK >> 20) & 1
        PH_BEGIN {
            pg8::Gemm g{HB, (const bf16*)(ws + WS_W_UP) + (size_t)l * DFF2 * DM, MTOK, DFF2, DM};
            pg8::ZeroOrder S; S.init(MTOK, DFF2, F.G, F.bid);
            pg8::EpiBf16<0> E{Gm, DFF2, nullptr, 0, 0, 1.f};
            pg8::gemm_phase<pg8::EpiBf16<0>, pg8::ZeroOrder, PG8_ALIGN, PG8_SP2>(F.lds + RING_OFF, g, S, E);
        } PH_END
#endif
        PH_BEGIN { if (l == 0) fold_finalize(F, FO_NSA, NSA_INP); } REP(8) convglu_fixup_phase(F, (const bf16*)(ws + WS_SIDE), KIN(IN_FFN_CONV) + (size_t)l * 3 * DFF, Gm); PH_END
        PH_BEGIN REP(6) {
            pg8::Gemm g{Gm, (const bf16*)(ws + WS_W_DOWN) + (size_t)l * DM * DFF, MTOK, DM, DFF};
            pg8::StaticOrder S; S.init(MTOK, DM, F.G, F.bid);
            pg8::EpiResLn2 E{Y, RS(3 * l + 1), LNG(3 * l + 1), LNB(3 * l + 1), DM, DN_ALPHA, RS(3 * l + 2)};
            pg8::gemm_phase<pg8::EpiResLn2, pg8::StaticOrder, PG8_ALIGN, PG8_SP2>(F.lds + RING_OFF, g, S, E);
        } PH_END
        if (l == 1) { PH_BEGIN REP(7) ln_phase(F, Y, LNG(5), LNB(5), H32); PH_END }
#undef RS
#undef LNG
#undef LNB
}
__global__ void __launch_bounds__(NTHR, 2) mega_fwd(Args args) {
    extern __shared__ __attribute__((aligned(16))) unsigned char lds_raw[];
    Frame F;
    F.lds = (LAS unsigned char*)lds_raw; F.ws = args.ws;
    F.tid = threadIdx.x; F.lane = F.tid & 63; F.wave = __builtin_amdgcn_readfirstlane(F.tid >> 6); F.G = gridDim.x;
    unsigned char* ws = args.ws;
    gu32* ctl = (gu32*)(ws + WS_CTL);
    for (int u = F.tid; u < (LDS_BYTES - LDSCTL_OFF) / 4; u += NTHR) ((LAS unsigned*)(F.lds + LDSCTL_OFF))[u] = 0u;
    __syncthreads();
    volatile LAS unsigned* MISC = (volatile LAS unsigned*)(F.lds + MISC_OFF);
    XcdBarrier bar = xcd_barrier_post((unsigned*)(ctl + CW_BAR), MISC + 8);
    const int lo = args.ph_lo, hi = args.ph_hi; int pc = 0; unsigned long long tbar_acc = 0ull;
    bf16* HB = (bf16*)(ws + WS_HB); bf16* Y = (bf16*)(ws + WS_Y); float* H32 = (float*)karg()->out;
    bf16* BIG = (bf16*)(ws + WS_BIG); bf16* Gm = (bf16*)(ws + WS_G); bf16* Ob = (bf16*)(ws + WS_O);
    bf16* XQ = (bf16*)(ws + WS_XQ); bf16* XO = (bf16*)(ws + WS_XO);

    PH_BEGIN REP(0) p0_prologue(F, args); PH_END

#if (REPMASK >> 21) & 1
    for (int e_ = 0; e_ < 40; ++e_) { PH_BEGIN PH_END }
#endif
    layer_body<0>(F, args, bar, pc, lo, hi, tbar_acc);
    layer_body<1>(F, args, bar, pc, lo, hi, tbar_acc);
#if (REPMASK >> 23) & 1
#ifndef PROBE_BID
#define PROBE_BID 0
#endif
#if (REPMASK >> 24) & 1
    if (blockIdx.x == 0) { unsigned long long tot_ = 0ull; for (int k_ = 0; k_ < pc; ++k_) { const unsigned v_ = __hip_atomic_load((unsigned*)(args.ws + 3 * MiB) + k_, __ATOMIC_RELAXED, __HIP_MEMORY_SCOPE_AGENT); const unsigned x_ = __hip_atomic_load((unsigned*)(args.ws + 3 * MiB) + 256 + k_, __ATOMIC_RELAXED, __HIP_MEMORY_SCOPE_AGENT);
#ifdef PROBE_SPREAD_MASK
            if (v_ && ((PROBE_SPREAD_MASK >> k_) & 1ull)) tot_ += x_ - (0x7fffffffu - v_);
#else
            if (v_) tot_ += 0x7fffffffu - v_;
#endif
        }
        const unsigned long long t0_ = __builtin_amdgcn_s_memrealtime(); while (__builtin_amdgcn_s_memrealtime() - t0_ < tot_) __builtin_amdgcn_s_sleep(8); }
#else
    if (blockIdx.x == PROBE_BID) { const unsigned long long t0_ = __builtin_amdgcn_s_memrealtime(); while (__builtin_amdgcn_s_memrealtime() - t0_ < tbar_acc) __builtin_amdgcn_s_sleep(8); }
#endif
#endif
}

extern "C" void kernel_launch(void* const* d_in, const int* in_sizes, int n_in, void* d_out, int out_size, void* d_ws, size_t ws_size, hipStream_t stream) {
    static int grid = 0;
    if (grid == 0) {
        if (n_in != 19 || in_sizes[0] != MTOK * DM || out_size != MTOK * DM || ws_size < WS_END) {
            fprintf(stderr, "kernel_launch: shape mismatch n_in %d in0 %d out %d ws %zu (need %zu)\n", n_in, n_in > 0 ? in_sizes[0] : -1, out_size, ws_size, (size_t)WS_END); grid = -1; return; }
        int dev = 0, cus = 0, per_cu = 0;
        if (hipGetDevice(&dev) != hipSuccess || hipDeviceGetAttribute(&cus, hipDeviceAttributeMultiprocessorCount, dev) != hipSuccess) { grid = -1; return; }
        if (hipFuncSetAttribute((const void*)mega_fwd, hipFuncAttributeMaxDynamicSharedMemorySize, LDS_BYTES) != hipSuccess) { fprintf(stderr, "kernel_launch: hipFuncSetAttribute failed\n"); grid = -1; return; }
        if (hipOccupancyMaxActiveBlocksPerMultiprocessor(&per_cu, (const void*)mega_fwd, NTHR, LDS_BYTES) != hipSuccess || per_cu < 1)
            fprintf(stderr, "kernel_launch: note: occupancy query reports %d workgroups per CU\n", per_cu);
        (void)hipGetLastError();
        grid = cus;
        if (grid != 256) { fprintf(stderr, "kernel_launch: built for a 256-CU device (workgroup ranges of the cross-attention and conversion phases); this device reports %d; nothing launched\n", cus); grid = -1; return; }
    }
    if (grid < 0) return;
    if (hipMemsetAsync((char*)d_ws + WS_CTL, 0, CTL_ZERO_BYTES, stream) != hipSuccess) { fprintf(stderr, "kernel_launch: memset failed\n"); return; }
    Args a{};
    for (int i = 0; i < 19; ++i) a.in[i] = (const float*)d_in[i];
    a.out = (float*)d_out; a.ws = (unsigned char*)d_ws; a.ph_lo = 0; a.ph_hi = 1 << 20;
    hipLaunchKernelGGL(mega_fwd, dim3(grid), dim3(NTHR), LDS_BYTES, stream, a);
    const hipError_t le = hipPeekAtLastError();
    if (le != hipSuccess) fprintf(stderr, "kernel_launch: launch failed: %s\n", hipGetErrorName(le));
}
```

```cpp
#include <hip/hip_runtime.h>
#include <cstdio>
#include <cstdint>
namespace pg8 {
#define PG8_LAS __attribute__((address_space(3)))
typedef unsigned short bf16_t;
typedef short bf16x8 __attribute__((ext_vector_type(8)));
typedef float f32x4 __attribute__((ext_vector_type(4)));
typedef unsigned u32x4 __attribute__((ext_vector_type(4)));
constexpr int BM = 256, BK = 64, HALF = 128, HTB = HALF * BK * 2  , STAGE_BYTES = 8 * HTB, NXCD = 8, WGM = 8;

__host__ __device__ __forceinline__ int lds_byte(int r, int c) { const int st = (r >> 4) * 2 + (c >> 5), rr = r & 15, cc = c & 31, ob = rr * 64 + cc * 2; return st * 1024 + (ob ^ (((ob >> 9) & 1) << 5)); }
__host__ __device__ __forceinline__ void stage_rc(int b, int& R, int& C) { const int st = b / 1024, sb = b % 1024, swz = sb ^ (((sb >> 9) & 1) << 5); R = (st >> 1) * 16 + swz / 64; C = (st & 1) * 32 + (swz % 64) / 2; }
__host__ __device__ __forceinline__ int perm32(int rho) { const int n = rho >> 4, i = rho & 15; return 8 * (i >> 2) + 4 * n + (i & 3); }

struct Unit { int pm, pn; };
struct Gemm { const bf16_t* A; const bf16_t* Bt; int M, N, K; };

struct StaticOrder {
    int nM, nN, nwg, G, c;
    __host__ __device__ void init(int M, int N, int G_, int c_) { nM = M / BM; nN = N / BM; nwg = nM * nN; G = G_; c = c_; }
    __host__ __device__ bool next(int i, Unit& u) const {
        const long L = (long)i * G + c; if (L >= nwg) return false;
        int wgid = (int)L; { const int q = nwg / NXCD, r = nwg % NXCD, xcd = wgid % NXCD, off = wgid / NXCD; wgid = (xcd < r ? xcd * (q + 1) : r * (q + 1) + (xcd - r) * q) + off; }
        const int nig = WGM * nN, gid = wgid / nig, fm = gid * WGM, gsz = (nM - fm) < WGM ? (nM - fm) : WGM;
        u.pm = fm + ((wgid % nig) % gsz); u.pn = (wgid % nig) / gsz; return true;
    }
    __device__ __forceinline__ void a_ready(const Unit&) const {}
    __device__ __forceinline__ void done(const Unit&) const {}
};

__device__ __forceinline__ unsigned cvt_pk_bf16(float lo, float hi) { unsigned r; asm volatile("v_cvt_pk_bf16_f32 %0, %1, %2" : "=v"(r) : "v"(lo), "v"(hi)); return r; }
typedef float f32x2 __attribute__((ext_vector_type(2)));
__device__ __forceinline__ f32x2 gelu_pk(f32x2 v) {
    const f32x2 av = __builtin_elementwise_abs(v), d = av * 0.2316418882f + 1.0f;
    f32x2 t; t.x = __builtin_amdgcn_rcpf(d.x); t.y = __builtin_amdgcn_rcpf(d.y);
    f32x2 q = t * 0.5307027145f + (-0.7265760135f); q = q * t + 0.7107068705f; q = q * t + (-0.142248368f); q = q * t + 0.127414796f; q = q * t;
    const f32x2 s = (v * v) * (-0.72134752044f);
    f32x2 e; e.x = __builtin_amdgcn_exp2f(s.x); e.y = __builtin_amdgcn_exp2f(s.y);
    const f32x2 m = v * (q * e), r = v - m;
    f32x2 o; o.x = v.x < 0.f ? m.x : r.x; o.y = v.y < 0.f ? m.y : r.y; return o;
}

template <int ACT  > struct EpiBf16 {
    static constexpr bool PERM = true, AFTER_DRAIN = false; static_assert(ACT == 0 || ACT == 1, "EpiBf16: ACT is 0 (none) or 1 (gelu_pk)");
    bf16_t* O; int ldc; const float* bias; int split_cols; size_t split_stride; float scale0;
    __device__ __forceinline__ void operator()(const f32x4 (&acc)[2][2][4][2], const Unit& u, int wr, int wc, int fr, int fq) const {
        const int row0 = u.pm * BM + wr * 64 + fr; int colt = u.pn * BM; bf16_t* base = O;
        float sc = 1.f; if (split_cols) { const int t = colt / split_cols; base += (size_t)t * split_stride; colt -= t * split_cols; if (t == 0) sc = scale0; }
        const int col0 = colt + wc * 32 + 8 * fq, bcol0 = u.pn * BM + wc * 32 + 8 * fq;
        f32x4 bv[2][2];
#pragma unroll
        for (int bj = 0; bj < 2; ++bj)
#pragma unroll
            for (int n = 0; n < 2; ++n) bv[bj][n] = bias ? *(const f32x4*)(bias + bcol0 + bj * HALF + 4 * n) : (f32x4){0.f, 0.f, 0.f, 0.f};
#pragma unroll
        for (int ai = 0; ai < 2; ++ai)
#pragma unroll
            for (int m = 0; m < 4; ++m) { bf16_t* rowp = base + (size_t)(row0 + ai * HALF + m * 16) * ldc + col0;
#pragma unroll
                for (int bj = 0; bj < 2; ++bj) { f32x4 v0 = acc[ai][bj][m][0] + bv[bj][0], v1 = acc[ai][bj][m][1] + bv[bj][1];
                    if (ACT == 1) { f32x2 a = gelu_pk((f32x2){v0[0], v0[1]}), b = gelu_pk((f32x2){v0[2], v0[3]}), c = gelu_pk((f32x2){v1[0], v1[1]}), d = gelu_pk((f32x2){v1[2], v1[3]});
                        v0 = (f32x4){a.x, a.y, b.x, b.y}; v1 = (f32x4){c.x, c.y, d.x, d.y}; }
                    v0 = v0 * sc; v1 = v1 * sc; u32x4 w; w.x = cvt_pk_bf16(v0[0], v0[1]); w.y = cvt_pk_bf16(v0[2], v0[3]); w.z = cvt_pk_bf16(v1[0], v1[1]); w.w = cvt_pk_bf16(v1[2], v1[3]);
                    *(u32x4*)(rowp + bj * HALF) = w; } }
    }
};


struct EpiRes {
    static constexpr bool PERM = false, AFTER_DRAIN = false;
    float* Y; const float* res; int ldc; float alpha;
    __device__ __forceinline__ void operator()(const f32x4 (&acc)[2][2][4][2], const Unit& u, int wr, int wc, int fr, int fq) const {
        const int row0 = u.pm * BM + wr * 64 + fr, col0 = u.pn * BM + wc * 32 + 4 * fq;
#pragma unroll
        for (int ai = 0; ai < 2; ++ai)
#pragma unroll
            for (int m = 0; m < 4; ++m) { const size_t off = (size_t)(row0 + ai * HALF + m * 16) * ldc + col0;
#pragma unroll
                for (int bj = 0; bj < 2; ++bj)
#pragma unroll
                    for (int n = 0; n < 2; ++n) { const f32x4 r = *(const f32x4*)(res + off + bj * HALF + n * 16);
                        *(f32x4*)(Y + off + bj * HALF + n * 16) = r * alpha + acc[ai][bj][m][n]; } }
    }
};
struct RangeOrder {
    int nM, nN, ntot, c0, nw, c;
    __host__ __device__ void init(int M, int N, int c0_, int nw_, int c_) { nM = M / BM; nN = N / BM; ntot = nM * nN; c0 = c0_; nw = nw_; c = c_; }
    __host__ __device__ bool next(int i, Unit& u) const {
        if (c < c0 || c >= c0 + nw) return false;
        const int L = i * nw + (c - c0); if (L >= ntot) return false;
        u.pm = L / nN; u.pn = L % nN; return true;
    }
    __device__ __forceinline__ void a_ready(const Unit&) const {}
    __device__ __forceinline__ void done(const Unit&) const {}
};

struct ZeroOrder : StaticOrder {
    __host__ __device__ bool next(int i, Unit& u) const { const bool r = StaticOrder::next(i, u); u.pm = 0; u.pn = 0; return r; }
};

struct EpiResBf {
    static constexpr bool PERM = true, AFTER_DRAIN = false;
    bf16_t* Y; const bf16_t* res; int ldc; float alpha;
    __device__ __forceinline__ void operator()(const f32x4 (&acc)[2][2][4][2], const Unit& u, int wr, int wc, int fr, int fq) const {
        const int row0 = u.pm * BM + wr * 64 + fr, col0 = u.pn * BM + wc * 32 + 8 * fq;
#pragma unroll
        for (int ai = 0; ai < 2; ++ai)
#pragma unroll
            for (int m = 0; m < 4; ++m) { const size_t off = (size_t)(row0 + ai * HALF + m * 16) * ldc + col0;
#pragma unroll
                for (int bj = 0; bj < 2; ++bj) { const u32x4 r = *(const u32x4*)(res + off + bj * HALF);
                    const f32x4 v0 = acc[ai][bj][m][0], v1 = acc[ai][bj][m][1];
                    u32x4 w;
                    w.x = cvt_pk_bf16(__builtin_bit_cast(float, r.x << 16) * alpha + v0[0], __builtin_bit_cast(float, r.x & 0xffff0000u) * alpha + v0[1]);
                    w.y = cvt_pk_bf16(__builtin_bit_cast(float, r.y << 16) * alpha + v0[2], __builtin_bit_cast(float, r.y & 0xffff0000u) * alpha + v0[3]);
                    w.z = cvt_pk_bf16(__builtin_bit_cast(float, r.z << 16) * alpha + v1[0], __builtin_bit_cast(float, r.z & 0xffff0000u) * alpha + v1[1]);
                    w.w = cvt_pk_bf16(__builtin_bit_cast(float, r.w << 16) * alpha + v1[2], __builtin_bit_cast(float, r.w & 0xffff0000u) * alpha + v1[3]);
                    *(u32x4*)(Y + off + bj * HALF) = w; } }
    }
};

struct EpiResF {
    static constexpr bool PERM = true, AFTER_DRAIN = false;
    float* Y; const bf16_t* res; int ldc; float alpha;
    __device__ __forceinline__ void operator()(const f32x4 (&acc)[2][2][4][2], const Unit& u, int wr, int wc, int fr, int fq) const {
        const int row0 = u.pm * BM + wr * 64 + fr, col0 = u.pn * BM + wc * 32 + 8 * fq;
#pragma unroll
        for (int ai = 0; ai < 2; ++ai)
#pragma unroll
            for (int m = 0; m < 4; ++m) { const size_t off = (size_t)(row0 + ai * HALF + m * 16) * ldc + col0;
#pragma unroll
                for (int bj = 0; bj < 2; ++bj) { const u32x4 r = *(const u32x4*)(res + off + bj * HALF);
                    f32x4 o0, o1;
                    o0[0] = __builtin_bit_cast(float, r.x << 16); o0[1] = __builtin_bit_cast(float, r.x & 0xffff0000u); o0[2] = __builtin_bit_cast(float, r.y << 16); o0[3] = __builtin_bit_cast(float, r.y & 0xffff0000u);
                    o1[0] = __builtin_bit_cast(float, r.z << 16); o1[1] = __builtin_bit_cast(float, r.z & 0xffff0000u); o1[2] = __builtin_bit_cast(float, r.w << 16); o1[3] = __builtin_bit_cast(float, r.w & 0xffff0000u);
                    *(f32x4*)(Y + off + bj * HALF) = o0 * alpha + acc[ai][bj][m][0]; *(f32x4*)(Y + off + bj * HALF + 4) = o1 * alpha + acc[ai][bj][m][1]; } }
    }
};

struct EpiResLn {
    static constexpr bool PERM = true, AFTER_DRAIN = false;
    bf16_t* Y; const float* stats; const float* g; const float* b; int ldc; float alpha;
    __device__ __forceinline__ void operator()(const f32x4 (&acc)[2][2][4][2], const Unit& u, int wr, int wc, int fr, int fq) const {
        const int row0 = u.pm * BM + wr * 64 + fr, col0 = u.pn * BM + wc * 32 + 8 * fq;
        f32x4 gv[2][2], bv[2][2];
#pragma unroll
        for (int bj = 0; bj < 2; ++bj)
#pragma unroll
            for (int n = 0; n < 2; ++n) { gv[bj][n] = *(const f32x4*)(g + col0 + bj * HALF + 4 * n) * alpha; bv[bj][n] = *(const f32x4*)(b + col0 + bj * HALF + 4 * n) * alpha; }
#pragma unroll
        for (int ai = 0; ai < 2; ++ai)
#pragma unroll
            for (int m = 0; m < 4; ++m) { const int row = row0 + ai * HALF + m * 16; const size_t off = (size_t)row * ldc + col0;
                const float mean = stats[2 * row], rstd = stats[2 * row + 1];
#pragma unroll
                for (int bj = 0; bj < 2; ++bj) { const u32x4 r = *(const u32x4*)(Y + off + bj * HALF);
                    f32x4 y0, y1;
                    y0[0] = __builtin_bit_cast(float, r.x << 16); y0[1] = __builtin_bit_cast(float, r.x & 0xffff0000u); y0[2] = __builtin_bit_cast(float, r.y << 16); y0[3] = __builtin_bit_cast(float, r.y & 0xffff0000u);
                    y1[0] = __builtin_bit_cast(float, r.z << 16); y1[1] = __builtin_bit_cast(float, r.z & 0xffff0000u); y1[2] = __builtin_bit_cast(float, r.w << 16); y1[3] = __builtin_bit_cast(float, r.w & 0xffff0000u);
                    const f32x4 o0 = (y0 - mean) * rstd * gv[bj][0] + bv[bj][0] + acc[ai][bj][m][0], o1 = (y1 - mean) * rstd * gv[bj][1] + bv[bj][1] + acc[ai][bj][m][1];
                    u32x4 w; w.x = cvt_pk_bf16(o0[0], o0[1]); w.y = cvt_pk_bf16(o0[2], o0[3]); w.z = cvt_pk_bf16(o1[0], o1[1]); w.w = cvt_pk_bf16(o1[2], o1[3]);
                    *(u32x4*)(Y + off + bj * HALF) = w; } }
    }
};

constexpr float RS_SCALE = 1048576.0f, RS_INV = 1.0f / 1048576.0f;
__device__ __forceinline__ float fx20_to_f(long long v) { return (float)(int)(v >> 20) + (float)((unsigned)v & 0xFFFFFu) * RS_INV; }
__device__ __forceinline__ long long f_to_fx20(float s) { const float fl = floorf(s); return ((long long)(int)fl << 20) + (long long)(unsigned)((s - fl) * RS_SCALE + 0.5f); }
__device__ __forceinline__ void row_stats(const long long* rs, int row, float& mean, float& rstd) {
    const long long a = rs[2 * (size_t)row], b = rs[2 * (size_t)row + 1];
    mean = fx20_to_f(a) * (1.0f / 4096.0f); const float var = fx20_to_f(b) * (1.0f / 4096.0f) - mean * mean; rstd = 1.0f / sqrtf(var + 1e-5f);
}
constexpr float FOLD_SCALE = 4294967296.0f, FOLD_INV = 1.0f / 4294967296.0f;
struct EpiBf16Ln {
    static constexpr bool PERM = true, AFTER_DRAIN = false;
    bf16_t* O; int ldc; const long long* rs; const float* cs; const float* b2;
    __device__ __forceinline__ void operator()(const f32x4 (&acc)[2][2][4][2], const Unit& u, int wr, int wc, int fr, int fq) const {
        const int row0 = u.pm * BM + wr * 64 + fr, col0 = u.pn * BM + wc * 32 + 8 * fq;
        f32x4 cv[2][2], bv[2][2];
#pragma unroll
        for (int bj = 0; bj < 2; ++bj)
#pragma unroll
            for (int n = 0; n < 2; ++n) { cv[bj][n] = *(const f32x4*)(cs + col0 + bj * HALF + 4 * n); bv[bj][n] = *(const f32x4*)(b2 + col0 + bj * HALF + 4 * n); }
#pragma unroll
        for (int ai = 0; ai < 2; ++ai)
#pragma unroll
            for (int m = 0; m < 4; ++m) { const int row = row0 + ai * HALF + m * 16; float mean, rstd; row_stats(rs, row, mean, rstd);
                bf16_t* rowp = O + (size_t)row * ldc + col0;
#pragma unroll
                for (int bj = 0; bj < 2; ++bj) { const f32x4 v0 = (acc[ai][bj][m][0] - cv[bj][0] * mean) * rstd + bv[bj][0], v1 = (acc[ai][bj][m][1] - cv[bj][1] * mean) * rstd + bv[bj][1];
                    u32x4 w; w.x = cvt_pk_bf16(v0[0], v0[1]); w.y = cvt_pk_bf16(v0[2], v0[3]); w.z = cvt_pk_bf16(v1[0], v1[1]); w.w = cvt_pk_bf16(v1[2], v1[3]);
                    *(u32x4*)(rowp + bj * HALF) = w; } }
    }
};
__device__ __forceinline__ void row_sums_add(long long* rso, int row, const f32x4& a, const f32x4& b, const f32x4& c, const f32x4& d, int fq) {
    float s1 = ((a[0] + a[1]) + (a[2] + a[3])) + ((b[0] + b[1]) + (b[2] + b[3])) + ((c[0] + c[1]) + (c[2] + c[3])) + ((d[0] + d[1]) + (d[2] + d[3]));
    float s2 = ((a[0] * a[0] + a[1] * a[1]) + (a[2] * a[2] + a[3] * a[3])) + ((b[0] * b[0] + b[1] * b[1]) + (b[2] * b[2] + b[3] * b[3]))
             + ((c[0] * c[0] + c[1] * c[1]) + (c[2] * c[2] + c[3] * c[3])) + ((d[0] * d[0] + d[1] * d[1]) + (d[2] * d[2] + d[3] * d[3]));
    s1 += __shfl_xor(s1, 16); s1 += __shfl_xor(s1, 32); s2 += __shfl_xor(s2, 16); s2 += __shfl_xor(s2, 32);
    if (fq == 0) { atomicAdd((unsigned long long*)(rso + 2 * (size_t)row), (unsigned long long)f_to_fx20(s1)); atomicAdd((unsigned long long*)(rso + 2 * (size_t)row + 1), (unsigned long long)f_to_fx20(s2)); }
}
struct EpiRes0 {
    static constexpr bool PERM = true, AFTER_DRAIN = false;
    bf16_t* Y; const bf16_t* res; int ldc; float alpha; long long* rso;
    __device__ __forceinline__ void operator()(const f32x4 (&acc)[2][2][4][2], const Unit& u, int wr, int wc, int fr, int fq) const {
        const int row0 = u.pm * BM + wr * 64 + fr, col0 = u.pn * BM + wc * 32 + 8 * fq;
#pragma unroll
        for (int ai = 0; ai < 2; ++ai)
#pragma unroll
            for (int m = 0; m < 4; ++m) { const int row = row0 + ai * HALF + m * 16; const size_t off = (size_t)row * ldc + col0; f32x4 o[2][2];
#pragma unroll
                for (int bj = 0; bj < 2; ++bj) { const u32x4 r = *(const u32x4*)(res + off + bj * HALF);
                    f32x4 y0, y1;
                    y0[0] = __builtin_bit_cast(float, r.x << 16); y0[1] = __builtin_bit_cast(float, r.x & 0xffff0000u); y0[2] = __builtin_bit_cast(float, r.y << 16); y0[3] = __builtin_bit_cast(float, r.y & 0xffff0000u);
                    y1[0] = __builtin_bit_cast(float, r.z << 16); y1[1] = __builtin_bit_cast(float, r.z & 0xffff0000u); y1[2] = __builtin_bit_cast(float, r.w << 16); y1[3] = __builtin_bit_cast(float, r.w & 0xffff0000u);
                    o[bj][0] = y0 * alpha + acc[ai][bj][m][0]; o[bj][1] = y1 * alpha + acc[ai][bj][m][1];
                    u32x4 w; w.x = cvt_pk_bf16(o[bj][0][0], o[bj][0][1]); w.y = cvt_pk_bf16(o[bj][0][2], o[bj][0][3]); w.z = cvt_pk_bf16(o[bj][1][0], o[bj][1][1]); w.w = cvt_pk_bf16(o[bj][1][2], o[bj][1][3]);
                    *(u32x4*)(Y + off + bj * HALF) = w; }
                row_sums_add(rso, row, o[0][0], o[0][1], o[1][0], o[1][1], fq); }
    }
};
struct EpiResLn2 {
    static constexpr bool PERM = true, AFTER_DRAIN = false;
    bf16_t* Y; const long long* rsi; const float* g; const float* b; int ldc; float alpha; long long* rso;
    __device__ __forceinline__ void operator()(const f32x4 (&acc)[2][2][4][2], const Unit& u, int wr, int wc, int fr, int fq) const {
        const int row0 = u.pm * BM + wr * 64 + fr, col0 = u.pn * BM + wc * 32 + 8 * fq;
        f32x4 gv[2][2], bv[2][2];
#pragma unroll
        for (int bj = 0; bj < 2; ++bj)
#pragma unroll
            for (int n = 0; n < 2; ++n) { gv[bj][n] = *(const f32x4*)(g + col0 + bj * HALF + 4 * n) * alpha; bv[bj][n] = *(const f32x4*)(b + col0 + bj * HALF + 4 * n) * alpha; }
#pragma unroll
        for (int ai = 0; ai < 2; ++ai)
#pragma unroll
            for (int m = 0; m < 4; ++m) { const int row = row0 + ai * HALF + m * 16; const size_t off = (size_t)row * ldc + col0; float mean, rstd; row_stats(rsi, row, mean, rstd); f32x4 o[2][2];
#pragma unroll
                for (int bj = 0; bj < 2; ++bj) { const u32x4 r = *(const u32x4*)(Y + off + bj * HALF);
                    f32x4 y0, y1;
                    y0[0] = __builtin_bit_cast(float, r.x << 16); y0[1] = __builtin_bit_cast(float, r.x & 0xffff0000u); y0[2] = __builtin_bit_cast(float, r.y << 16); y0[3] = __builtin_bit_cast(float, r.y & 0xffff0000u);
                    y1[0] = __builtin_bit_cast(float, r.z << 16); y1[1] = __builtin_bit_cast(float, r.z & 0xffff0000u); y1[2] = __builtin_bit_cast(float, r.w << 16); y1[3] = __builtin_bit_cast(float, r.w & 0xffff0000u);
                    o[bj][0] = (y0 - mean) * rstd * gv[bj][0] + bv[bj][0] + acc[ai][bj][m][0]; o[bj][1] = (y1 - mean) * rstd * gv[bj][1] + bv[bj][1] + acc[ai][bj][m][1];
                    u32x4 w; w.x = cvt_pk_bf16(o[bj][0][0], o[bj][0][1]); w.y = cvt_pk_bf16(o[bj][0][2], o[bj][0][3]); w.z = cvt_pk_bf16(o[bj][1][0], o[bj][1][1]); w.w = cvt_pk_bf16(o[bj][1][2], o[bj][1][3]);
                    *(u32x4*)(Y + off + bj * HALF) = w; }
                row_sums_add(rso, row, o[0][0], o[0][1], o[1][0], o[1][1], fq); }
    }
};

struct EpiBf16LnTok {
    static constexpr bool PERM = true, AFTER_DRAIN = false, AROWPERM = true;
    bf16_t* O; int ldc; const long long* rs; const float* cs; const float* b2;
    __device__ __forceinline__ void operator()(const f32x4 (&acc)[2][2][4][2], const Unit& u, int wr, int wc, int fr, int fq) const {
        const int row0 = u.pm * BM + 128 * wr + 8 * fr, col0 = u.pn * BM + wc * 32 + 8 * fq;
        f32x4 cv[2][2], bv[2][2];
#pragma unroll
        for (int bj = 0; bj < 2; ++bj)
#pragma unroll
            for (int n = 0; n < 2; ++n) { cv[bj][n] = *(const f32x4*)(cs + col0 + bj * HALF + 4 * n); bv[bj][n] = *(const f32x4*)(b2 + col0 + bj * HALF + 4 * n); }
#pragma unroll
        for (int ai = 0; ai < 2; ++ai)
#pragma unroll
            for (int m = 0; m < 4; ++m) { const int row = row0 + 4 * ai + m; float mean, rstd; row_stats(rs, row, mean, rstd);
                bf16_t* rowp = O + (size_t)row * ldc + col0;
#pragma unroll
                for (int bj = 0; bj < 2; ++bj) { const f32x4 v0 = (acc[ai][bj][m][0] - cv[bj][0] * mean) * rstd + bv[bj][0], v1 = (acc[ai][bj][m][1] - cv[bj][1] * mean) * rstd + bv[bj][1];
                    u32x4 w; w.x = cvt_pk_bf16(v0[0], v0[1]); w.y = cvt_pk_bf16(v0[2], v0[3]); w.z = cvt_pk_bf16(v1[0], v1[1]); w.w = cvt_pk_bf16(v1[2], v1[3]);
                    *(u32x4*)(rowp + bj * HALF) = w; } }
    }
};

__device__ __forceinline__ float dpp_shr1(float x) { return __builtin_bit_cast(float, __builtin_amdgcn_update_dpp(0, __builtin_bit_cast(int, x), 0x111, 0xf, 0xf, true)); }
struct EpiConvGlu {
    static constexpr bool PERM = true, AFTER_DRAIN = false, AROWPERM = true;
    bf16_t* G; bf16_t* side; const long long* rs; const float* cs; const float* b2; const float* cw; int dff;
    __device__ __forceinline__ void operator()(const f32x4 (&acc)[2][2][4][2], const Unit& u, int wr, int wc, int fr, int fq) const {
        const int row0 = u.pm * BM + 128 * wr + 8 * fr, colg = u.pn * BM + wc * 32 + 8 * fq, ch0 = u.pn * HALF + wc * 32 + 8 * fq;
        float mean_[8], rstd_[8];
#pragma unroll
        for (int j = 0; j < 8; ++j) row_stats(rs, row0 + j, mean_[j], rstd_[j]);
        unsigned gout[8][4];
        const int bnd = row0 >> 7;
#pragma unroll
        for (int n = 0; n < 2; ++n) {
            const f32x4 ca = *(const f32x4*)(cs + colg + 4 * n), ba = *(const f32x4*)(b2 + colg + 4 * n), cu = *(const f32x4*)(cs + colg + HALF + 4 * n), bu = *(const f32x4*)(b2 + colg + HALF + 4 * n);
            const f32x4 w0 = *(const f32x4*)(cw + ch0 + 4 * n), w1 = *(const f32x4*)(cw + dff + ch0 + 4 * n), w2 = *(const f32x4*)(cw + 2 * dff + ch0 + 4 * n);
            f32x4 a[8], uu[8];
#pragma unroll
            for (int j = 0; j < 8; ++j) { a[j] = (acc[j >> 2][0][j & 3][n] - ca * mean_[j]) * rstd_[j] + ba; uu[j] = (acc[j >> 2][1][j & 3][n] - cu * mean_[j]) * rstd_[j] + bu; }
            f32x4 p6, p7;
#pragma unroll
            for (int q = 0; q < 4; ++q) { p6[q] = dpp_shr1(a[6][q]); p7[q] = dpp_shr1(a[7][q]); }
            if (fr == 15 && bnd + 1 < 128) { bf16_t* sp = side + ((size_t)(bnd + 1) * 6) * dff + ch0 + 4 * n;
                *(unsigned long long*)(sp) = (unsigned long long)cvt_pk_bf16(a[6][0], a[6][1]) | ((unsigned long long)cvt_pk_bf16(a[6][2], a[6][3]) << 32);
                *(unsigned long long*)(sp + dff) = (unsigned long long)cvt_pk_bf16(a[7][0], a[7][1]) | ((unsigned long long)cvt_pk_bf16(a[7][2], a[7][3]) << 32); }
            if (fr == 0) { bf16_t* sp = side + ((size_t)bnd * 6 + 2) * dff + ch0 + 4 * n;
                *(unsigned long long*)(sp) = (unsigned long long)cvt_pk_bf16(a[0][0], a[0][1]) | ((unsigned long long)cvt_pk_bf16(a[0][2], a[0][3]) << 32);
                *(unsigned long long*)(sp + dff) = (unsigned long long)cvt_pk_bf16(a[1][0], a[1][1]) | ((unsigned long long)cvt_pk_bf16(a[1][2], a[1][3]) << 32);
                *(unsigned long long*)(sp + 2 * dff) = (unsigned long long)cvt_pk_bf16(uu[0][0], uu[0][1]) | ((unsigned long long)cvt_pk_bf16(uu[0][2], uu[0][3]) << 32);
                *(unsigned long long*)(sp + 3 * dff) = (unsigned long long)cvt_pk_bf16(uu[1][0], uu[1][1]) | ((unsigned long long)cvt_pk_bf16(uu[1][2], uu[1][3]) << 32); }
#pragma unroll
            for (int j = 0; j < 8; ++j) { const f32x4 am1 = (j == 0) ? p7 : a[j ? j - 1 : 0], am2 = (j == 0) ? p6 : (j == 1 ? p7 : a[j > 1 ? j - 2 : 0]);
                const f32x4 c = w2 * a[j] + w1 * am1 + w0 * am2;
                const f32x2 g01 = gelu_pk((f32x2){c[0], c[1]}), g23 = gelu_pk((f32x2){c[2], c[3]});
                gout[j][2 * n] = cvt_pk_bf16(g01.x * uu[j][0], g01.y * uu[j][1]); gout[j][2 * n + 1] = cvt_pk_bf16(g23.x * uu[j][2], g23.y * uu[j][3]); }
        }
#pragma unroll
        for (int j = 0; j < 8; ++j) if (!(fr == 0 && j < 2)) { u32x4 w; w.x = gout[j][0]; w.y = gout[j][1]; w.z = gout[j][2]; w.w = gout[j][3]; *(u32x4*)(G + (size_t)(row0 + j) * dff + ch0) = w; }
    }
};
template <class E, class = void> struct arowperm_v { static constexpr bool value = false; };
template <class E> struct arowperm_v<E, decltype((void)E::AROWPERM)> { static constexpr bool value = E::AROWPERM; };
template <class Epi, class Sched, bool ALIGN_EPI = false, bool SP2 = false>
__device__ __forceinline__ void gemm_phase(PG8_LAS unsigned char* lds, const Gemm g, const Sched& S, const Epi& E) {
    int tid_l = threadIdx.x; asm volatile("" : "+v"(tid_l)); const int tid = tid_l, wid = __builtin_amdgcn_readfirstlane(tid >> 6), lane = tid & 63, wr = wid >> 2, wc = wid & 3, fr = lane & 15, fq = lane >> 4;
    const int K = g.K, nt = K / BK;
    unsigned voffA[2], voffB[2];
#pragma unroll
    for (int i = 0; i < 2; ++i) { int R, C; stage_rc(tid * 16 + i * 8192, R, C); const int Rb = Epi::PERM ? ((R & ~31) + perm32(R & 31)) : R;
        const int Ra = arowperm_v<Epi>::value ? (128 * (R >> 6) + 8 * (R & 15) + ((R >> 4) & 3)) : R;
        voffA[i] = (unsigned)(Ra * K + C) * 2u; voffB[i] = (unsigned)(Rb * K + C) * 2u; }
    const size_t hstepA = arowperm_v<Epi>::value ? (size_t)4 * K * 2 : (size_t)HALF * K * 2;
    const size_t kstep = (size_t)(BK * 2);
    const size_t hstep = (size_t)HALF * K * 2;
    const size_t tstep = 2 * hstep;
    const unsigned ldsw = (unsigned)wid * 1024u;
    const int aoff = lds_byte(wr * 64 + fr, fq * 8), boff = lds_byte(wc * 32 + fr, fq * 8);
#define PG8_SA(b, h) (((b) * 2 + (h)) * HTB)
#define PG8_SB(b, h) ((4 + (b) * 2 + (h)) * HTB)
#define PG8_STAGE(bufoff, gbase, voff) do { _Pragma("unroll") for (int _i = 0; _i < 2; ++_i) \
        __builtin_amdgcn_global_load_lds((const unsigned*)((const char*)(gbase) + (voff)[_i]), (PG8_LAS unsigned*)(lds + (bufoff) + ldsw + _i * 8192), 16, 0, 0); } while (0)
#define PG8_LDA(dst, b, h) do { _Pragma("unroll") for (int m = 0; m < 4; ++m) _Pragma("unroll") for (int k = 0; k < 2; ++k) dst[m][k] = *(const PG8_LAS bf16x8*)(lds + PG8_SA(b, h) + aoff + m * 2048 + k * 1024); } while (0)
#define PG8_LDB(dst, b, h) do { _Pragma("unroll") for (int n = 0; n < 2; ++n) _Pragma("unroll") for (int k = 0; k < 2; ++k) dst[n][k] = *(const PG8_LAS bf16x8*)(lds + PG8_SB(b, h) + boff + n * 2048 + k * 1024); } while (0)
#define PG8_MMA(ai, bj, At, Bt) do { __builtin_amdgcn_s_setprio(1); _Pragma("unroll") for (int m = 0; m < 4; ++m) _Pragma("unroll") for (int n = 0; n < 2; ++n) _Pragma("unroll") for (int k = 0; k < 2; ++k) \
        acc[ai][bj][m][n] = __builtin_amdgcn_mfma_f32_16x16x32_bf16(Bt[n][k], At[m][k], acc[ai][bj][m][n], 0, 0, 0); __builtin_amdgcn_s_setprio(0); } while (0)
#define PG8_WAIT_V(n) asm volatile("s_waitcnt vmcnt(" #n ")" ::: "memory")
#define PG8_WAIT_L(n) asm volatile("s_waitcnt lgkmcnt(" #n ")" ::: "memory")
#define PG8_BAR __builtin_amdgcn_s_barrier()
#define PG8_SCHED __builtin_amdgcn_sched_barrier(0)
    Unit cur, nxt; int ui = 0;
    if (!S.next(0, cur)) return;
    f32x4 acc[2][2][4][2];
#pragma unroll
    for (int a = 0; a < 2; ++a)
#pragma unroll
        for (int b = 0; b < 2; ++b)
#pragma unroll
            for (int m = 0; m < 4; ++m)
#pragma unroll
                for (int n = 0; n < 2; ++n) acc[a][b][m][n] = (f32x4){0.f, 0.f, 0.f, 0.f};
    bf16x8 At[4][2], B0[2][2], B1[2][2];
    const char* cA = (const char*)g.A + (size_t)cur.pm * tstep; const char* cB = (const char*)g.Bt + (size_t)cur.pn * tstep;
    S.a_ready(cur);
    if constexpr (SP2) {
        PG8_STAGE(PG8_SB(0, 0), cB, voffB); PG8_STAGE(PG8_SB(0, 1), cB + hstep, voffB); PG8_STAGE(PG8_SA(0, 0), cA, voffA); PG8_STAGE(PG8_SA(0, 1), cA + hstepA, voffA);
        if (wr == 1) PG8_BAR;
        PG8_WAIT_V(2); PG8_BAR;
        PG8_STAGE(PG8_SB(1, 0), cB + kstep, voffB); PG8_STAGE(PG8_SA(1, 0), cA + kstep, voffA); PG8_STAGE(PG8_SB(1, 1), cB + hstep + kstep, voffB);
        PG8_WAIT_V(6); PG8_BAR;
    } else {
        PG8_STAGE(PG8_SB(0, 0), cB, voffB); PG8_STAGE(PG8_SA(0, 0), cA, voffA); PG8_STAGE(PG8_SB(0, 1), cB + hstep, voffB); PG8_STAGE(PG8_SA(0, 1), cA + hstepA, voffA);
        if (wr == 1) PG8_BAR;
        PG8_WAIT_V(4); PG8_BAR;
        PG8_STAGE(PG8_SB(1, 0), cB + kstep, voffB); PG8_STAGE(PG8_SA(1, 0), cA + kstep, voffA); PG8_STAGE(PG8_SB(1, 1), cB + hstep + kstep, voffB);
        PG8_WAIT_V(6); PG8_BAR;
    }
    for (;;) {
        const bool has_next = S.next(ui + 1, nxt);
        const char* nA = has_next ? (const char*)g.A + (size_t)nxt.pm * tstep : cA; const char* nB = has_next ? (const char*)g.Bt + (size_t)nxt.pn * tstep : cB;
        for (int t = 0; t < nt; t += 2) {
            const bool last = (t == nt - 2);
            const char* a1 = cA + (size_t)(t + 1) * kstep;
            const char* a2 = last ? nA : cA + (size_t)(t + 2) * kstep; const char* b2 = last ? nB : cB + (size_t)(t + 2) * kstep;
            const char* a3 = a2 + kstep; const char* b3 = b2 + kstep;
            if (last && has_next) S.a_ready(nxt);
            if constexpr (SP2) {
            PG8_LDB(B0, 0, 0); PG8_LDB(B1, 0, 1); PG8_SCHED; PG8_LDA(At, 0, 0); PG8_STAGE(PG8_SA(1, 1), a1 + hstepA, voffA);
            PG8_WAIT_V(8); PG8_WAIT_L(0); PG8_BAR; PG8_MMA(0, 0, At, B0); PG8_MMA(0, 1, At, B1); PG8_BAR; PG8_SCHED;
            PG8_LDA(At, 0, 1); PG8_STAGE(PG8_SB(0, 0), b2, voffB); PG8_STAGE(PG8_SB(0, 1), b2 + hstep, voffB); PG8_STAGE(PG8_SA(0, 0), a2, voffA);
            PG8_WAIT_V(8); PG8_WAIT_L(0); PG8_BAR; PG8_MMA(1, 0, At, B0); PG8_MMA(1, 1, At, B1); PG8_BAR; PG8_SCHED;
            PG8_LDB(B0, 1, 0); PG8_LDB(B1, 1, 1); PG8_SCHED; PG8_LDA(At, 1, 0); PG8_STAGE(PG8_SA(0, 1), a2 + hstepA, voffA);
            PG8_WAIT_V(8); PG8_WAIT_L(0); PG8_BAR; PG8_MMA(0, 0, At, B0); PG8_MMA(0, 1, At, B1); PG8_BAR; PG8_SCHED;
            PG8_LDA(At, 1, 1); PG8_STAGE(PG8_SB(1, 0), b3, voffB); PG8_STAGE(PG8_SB(1, 1), b3 + hstep, voffB); PG8_STAGE(PG8_SA(1, 0), a3, voffA);
            PG8_WAIT_V(8); PG8_WAIT_L(0); PG8_BAR; PG8_MMA(1, 0, At, B0); PG8_MMA(1, 1, At, B1); PG8_BAR; PG8_SCHED;
            } else {
            PG8_LDB(B0, 0, 0); PG8_SCHED; PG8_LDA(At, 0, 0); PG8_STAGE(PG8_SA(1, 1), a1 + hstepA, voffA);
            PG8_WAIT_L(8); PG8_BAR; PG8_WAIT_L(0); PG8_MMA(0, 0, At, B0); PG8_BAR; PG8_SCHED;
            PG8_LDB(B1, 0, 1); PG8_STAGE(PG8_SB(0, 0), b2, voffB);
            PG8_BAR; PG8_WAIT_L(0); PG8_MMA(0, 1, At, B1); PG8_BAR;
            PG8_LDA(At, 0, 1); PG8_STAGE(PG8_SA(0, 0), a2, voffA);
            PG8_BAR; PG8_WAIT_L(0); PG8_MMA(1, 0, At, B0); PG8_BAR; PG8_SCHED;
            PG8_STAGE(PG8_SB(0, 1), b2 + hstep, voffB);
            PG8_WAIT_V(6); PG8_BAR; PG8_MMA(1, 1, At, B1); PG8_BAR;
            PG8_LDB(B0, 1, 0); PG8_SCHED; PG8_LDA(At, 1, 0); PG8_STAGE(PG8_SA(0, 1), a2 + hstepA, voffA);
            PG8_WAIT_L(8); PG8_BAR; PG8_WAIT_L(0); PG8_MMA(0, 0, At, B0); PG8_BAR; PG8_SCHED;
            PG8_LDB(B1, 1, 1); PG8_STAGE(PG8_SB(1, 0), b3, voffB);
            PG8_BAR; PG8_WAIT_L(0); PG8_MMA(0, 1, At, B1); PG8_BAR;
            PG8_LDA(At, 1, 1); PG8_STAGE(PG8_SA(1, 0), a3, voffA);
            PG8_BAR; PG8_WAIT_L(0); PG8_MMA(1, 0, At, B0); PG8_BAR; PG8_SCHED;
            PG8_STAGE(PG8_SB(1, 1), b3 + hstep, voffB);
            PG8_WAIT_V(6); PG8_BAR; PG8_MMA(1, 1, At, B1); PG8_BAR;
            }
        }
        if constexpr (ALIGN_EPI) { if (wr == 0) PG8_BAR; }
        if constexpr (!Epi::AFTER_DRAIN) { E(acc, cur, wr, wc, fr, fq); S.done(cur); }
        if (!has_next) break;
#pragma unroll
        for (int a = 0; a < 2; ++a)
#pragma unroll
            for (int b = 0; b < 2; ++b)
#pragma unroll
                for (int m = 0; m < 4; ++m)
#pragma unroll
                    for (int n = 0; n < 2; ++n) acc[a][b][m][n] = (f32x4){0.f, 0.f, 0.f, 0.f};
        cur = nxt; cA = nA; cB = nB; ++ui;
        if constexpr (ALIGN_EPI) { if (wr == 1) PG8_BAR; }
    }
    PG8_WAIT_V(0);
    if constexpr (!ALIGN_EPI) { if (wr == 0) PG8_BAR; }
    PG8_BAR;
    if constexpr (Epi::AFTER_DRAIN) { E.fused(acc, cur, wr, wc, fr, fq, lds, wid, lane); S.done(cur); }
#undef PG8_SA
#undef PG8_SB
#undef PG8_STAGE
#undef PG8_LDA
#undef PG8_LDB
#undef PG8_MMA
#undef PG8_WAIT_V
#undef PG8_WAIT_L
#undef PG8_BAR
#undef PG8_SCHED
}
}

#ifndef PG8_SP2
#define PG8_SP2 true
#endif
#ifndef PG8_ALIGN
#define PG8_ALIGN true
#endif
constexpr int NWAVES = 8, NTHR = 512;
constexpr int BATCH = 2, SEQ = 8192, DM = 4096, MTOK = BATCH * SEQ;
constexpr int HD = 128;
constexpr int A_HEADS = 16, B_HEADS = 16, A_W = 2048, B_W = 2048, AB_IN = 4 * A_W + 3 * B_W;
constexpr int NSA_H = 32, NSA_G = 4, NSA_R = 8, KVW = 512, NSA_IN = 4096 + 6 * KVW + 96, NSA_INP = 7424;
constexpr int NCMP = 511, NCMPP = 512, NSLC = 128, NTOP = 16, WINDOW = 512;
constexpr int NMEM = 256, XH = 4, XW = 512;
constexpr int DFF = 11008, DFF2 = 22016;
constexpr float LN_EPS = 1e-5f, RMS_EPS = 1e-6f;
constexpr float DN_ALPHA = 1.41421356237309515f;
constexpr size_t MiB = (size_t)1 << 20;
constexpr size_t WS_CTL = 0, CTL_ZERO_BYTES = 4 * MiB;
constexpr size_t WS_FOLD = 64 * 1024;
constexpr int FO_XQ = 0, FO_UP = 2 * 512, FO_NSA = FO_UP + 2 * 22016, FO_N = FO_NSA + 7424;
constexpr size_t WS_RSUM = 1 * MiB;
static_assert(WS_FOLD + (size_t)2 * FO_N * 8 <= WS_RSUM && WS_RSUM + (size_t)6 * 16384 * 2 * 8 <= CTL_ZERO_BYTES, "CTL map");
constexpr size_t WS_W_ABIN = 4 * MiB;
constexpr size_t WS_W_ABOUT = WS_W_ABIN + 112 * MiB;
constexpr size_t WS_W_NSAIN = WS_W_ABOUT + 32 * MiB;
constexpr size_t WS_W_NSAOUT = WS_W_NSAIN + 58 * MiB;
constexpr size_t WS_W_XQ = WS_W_NSAOUT + 32 * MiB;
constexpr size_t WS_W_XKV = WS_W_XQ + 8 * MiB;
constexpr size_t WS_W_XO = WS_W_XKV + 16 * MiB;
constexpr size_t WS_W_UP = WS_W_XO + 8 * MiB;
constexpr size_t WS_W_DOWN = WS_W_UP + 344 * MiB;
constexpr size_t WS_W_C1 = WS_W_DOWN + 172 * MiB;
constexpr size_t WS_W_C2 = WS_W_C1 + 2 * MiB;
constexpr size_t WS_MEMB = WS_W_C2 + 1 * MiB;
constexpr size_t WS_HB = WS_MEMB + 4 * MiB;
constexpr size_t WS_Y = WS_HB + 128 * MiB;
constexpr size_t WS_BIG = WS_Y + 256 * MiB;
constexpr size_t WS_G = WS_BIG + 688 * MiB;
constexpr size_t WS_O = WS_G + 344 * MiB;
constexpr size_t WS_MISC = WS_O + 128 * MiB;
constexpr size_t WS_END = WS_MISC + 64 * MiB;
constexpr size_t WS_XQ = WS_MISC;
constexpr size_t WS_XO = WS_MISC + 16 * MiB;
constexpr size_t WS_XKV = WS_MISC + 32 * MiB;
constexpr size_t WS_LB = WS_MISC + 34 * MiB;
constexpr size_t WS_SIDE = WS_MISC + 42 * MiB;
constexpr size_t WS_FOLDF = WS_MISC + 40 * MiB;
constexpr size_t WS_ROPE = WS_MISC + 36 * MiB;
constexpr size_t WS_STATS = WS_MISC + 35 * MiB;
constexpr size_t WS_PROJ0 = WS_BIG;
constexpr size_t WS_SPREV = WS_BIG + 448 * MiB;
constexpr size_t WS_QT = WS_G;
constexpr size_t WS_OINTRA = WS_G + 64 * MiB;
constexpr size_t WS_DEC = WS_G + 192 * MiB;
constexpr size_t WS_DS = WS_Y;
constexpr size_t WS_PROJ1 = WS_BIG;
constexpr size_t WS_QROT = WS_BIG + 232 * MiB;
constexpr size_t WS_KSROT = WS_BIG + 360 * MiB;
constexpr size_t WS_KWROT = WS_BIG + 376 * MiB;
constexpr size_t WS_KCMP = WS_BIG + 392 * MiB;
constexpr size_t WS_VCMP = WS_BIG + 393 * MiB;
constexpr size_t WS_OVL = WS_BIG + 394 * MiB;
constexpr size_t WS_SEL = WS_BIG + 395 * MiB;
constexpr size_t WS_IMP = WS_G + 256 * MiB;
constexpr size_t WS_O32 = WS_G;
static_assert(WS_SPREV + 128 * MiB <= WS_G && WS_DEC + 2 * MiB <= WS_O && WS_SEL + MiB <= WS_G, "ws map");
constexpr int CW_TMO = 0, CW_CODE = 1;
constexpr int CW_BAR = 4096;
constexpr int CW_XKV = 64;
constexpr int RING_OFF = 0, RING_BYTES = 131072;
constexpr int LDSCTL_OFF = RING_BYTES, MISC_OFF = LDSCTL_OFF + 320;
constexpr int LDS_BYTES = 147456;
static_assert(MISC_OFF + 128 <= LDS_BYTES, "LDS map");

#define GAS __attribute__((address_space(1)))
#define LAS __attribute__((address_space(3)))
typedef unsigned short bf16;
typedef unsigned v4u __attribute__((ext_vector_type(4)));
typedef unsigned v2u __attribute__((ext_vector_type(2)));
typedef float f32x4 __attribute__((ext_vector_type(4)));
typedef float f32x2 __attribute__((ext_vector_type(2)));
typedef float f32x16 __attribute__((ext_vector_type(16)));
typedef short bf16x8 __attribute__((ext_vector_type(8)));
typedef short s16x4 __attribute__((ext_vector_type(4)));
typedef GAS unsigned gu32;
#define RLX_AGENT __ATOMIC_RELAXED, __HIP_MEMORY_SCOPE_AGENT
#define LDS_WAIT() asm volatile("s_waitcnt lgkmcnt(0)" ::: "memory")
#define VM_WAIT() asm volatile("s_waitcnt vmcnt(0)" ::: "memory")
#define SBAR() __builtin_amdgcn_sched_barrier(0)
__device__ __forceinline__ unsigned f2bf(float f) { unsigned u = __builtin_bit_cast(unsigned, f); return (u + 0x7fffu + ((u >> 16) & 1u)) >> 16; }
__device__ __forceinline__ unsigned pk2(float lo, float hi) { return f2bf(lo) | (f2bf(hi) << 16); }
__device__ __forceinline__ float bf2f(unsigned short b) { return __builtin_bit_cast(float, (unsigned)b << 16); }
__device__ __forceinline__ float bflo(unsigned w) { return __builtin_bit_cast(float, w << 16); }
__device__ __forceinline__ float bfhi(unsigned w) { return __builtin_bit_cast(float, w & 0xffff0000u); }
__device__ __forceinline__ unsigned cvtpk(float lo, float hi) { unsigned r; asm volatile("v_cvt_pk_bf16_f32 %0, %1, %2" : "=v"(r) : "v"(lo), "v"(hi)); return r; }
__device__ __forceinline__ float wave_sum(float v) {
#pragma unroll
    for (int o = 1; o < 64; o <<= 1) v += __shfl_xor(v, o);
    return v;
}
__device__ __forceinline__ float sigmoidf_(float x) { return __builtin_amdgcn_rcpf(1.f + __builtin_amdgcn_exp2f(-1.4426950408889634f * x)); }
__device__ __forceinline__ float gelu1(float v) { pg8::f32x2 r = pg8::gelu_pk((pg8::f32x2){v, 0.f}); return r.x; }
#define XB_TMO      128
#define XB_XCNT(j)  (256  + 64 * (j))
#define XB_XSUB(j)  (1280 + 64 * (j))
#define XB_XGEN(j)  (2304 + 64 * (j))
#define XB_TOP      3328
#define XB_TOPGEN   3392
#define XCD_BAR_WORDS 3456
#define XB_SPIN_CAP (1u << 18)
#define LAS __attribute__((address_space(3)))

__device__ __forceinline__ unsigned xb_ld(unsigned* p)              { return __hip_atomic_load(p, __ATOMIC_RELAXED, __HIP_MEMORY_SCOPE_AGENT); }
__device__ __forceinline__ unsigned xb_add(unsigned* p, unsigned v) { return __hip_atomic_fetch_add(p, v, __ATOMIC_RELAXED, __HIP_MEMORY_SCOPE_AGENT); }
__device__ __forceinline__ unsigned xb_xcc_id() { return (unsigned)__builtin_amdgcn_s_getreg((3 << 11) | 20) & 0xFu; }
#define XB_SPIN(cond, bar) do { unsigned _sp = 0; while (cond) { __builtin_amdgcn_s_sleep(1); \
    if ((++_sp & 255u) == 0u) { if (xb_ld(&(bar)[XB_TMO])) break; if (_sp > XB_SPIN_CAP) { atomicAdd(&(bar)[XB_TMO], 1u); break; } } } } while (0)

struct XcdBarrier {
    unsigned* bar; unsigned x;
    volatile LAS unsigned* st;
};

__device__ __forceinline__ XcdBarrier xcd_barrier_post(unsigned* bar, volatile LAS unsigned* st) {
    XcdBarrier b; b.bar = bar; b.x = xb_xcc_id(); b.st = st;
    if (threadIdx.x == 0) (void)xb_add(&bar[XB_XCNT(b.x)], 1u);
    return b;
}
__device__ __forceinline__ void xcd_barrier_complete(unsigned* bar, unsigned x, unsigned& nloc, unsigned& nx) {
    const unsigned G = gridDim.x * gridDim.y * gridDim.z;
    unsigned sum, cnt, mine, sp = 0u;
    for (;;) {
        sum = 0u; cnt = 0u; mine = 0u;
#pragma unroll
        for (unsigned j = 0; j < 16; ++j) { const unsigned c = xb_ld(&bar[XB_XCNT(j)]); sum += c; cnt += (c > 0u) ? 1u : 0u; mine = (j == x) ? c : mine; }
        if (sum == G) break;
        __builtin_amdgcn_s_sleep(1);
        if ((++sp & 255u) == 0u) { if (xb_ld(&bar[XB_TMO])) break; if (sp > XB_SPIN_CAP) { atomicAdd(&bar[XB_TMO], 1u); break; } }
    }
    nloc = mine > 0u ? mine : 1u; nx = cnt > 0u ? cnt : 1u;
}

__device__ __forceinline__ void xcd_barrier(const XcdBarrier& b) {
    asm volatile("s_waitcnt vmcnt(0)" ::: "memory");
    __syncthreads();
    if (threadIdx.x == 0) {
        unsigned* bar = b.bar;
        __builtin_amdgcn_s_waitcnt(0);
        unsigned nloc = b.st[0], nx = b.st[1];
        if (nloc == 0u) { xcd_barrier_complete(bar, b.x, nloc, nx); b.st[0] = nloc; b.st[1] = nx; }
        const unsigned old = xb_add(&bar[XB_XSUB(b.x)], 1u);
        const unsigned gen = old / nloc;
        if (old + 1u == (gen + 1u) * nloc) {
            __builtin_amdgcn_fence(__ATOMIC_RELEASE, "agent");
            asm volatile("s_waitcnt vmcnt(0)" ::: "memory");
            const unsigned og = xb_add(&bar[XB_TOP], 1u);
            const unsigned tg = og / nx;
            if (og + 1u == (tg + 1u) * nx) xb_add(&bar[XB_TOPGEN], 1u);
            else XB_SPIN(xb_ld(&bar[XB_TOPGEN]) == tg, bar);
            __builtin_amdgcn_fence(__ATOMIC_ACQUIRE, "agent");
            xb_add(&bar[XB_XGEN(b.x)], 1u);
            asm volatile("s_waitcnt vmcnt(0)" ::: "memory");
        } else {
            XB_SPIN(xb_ld(&bar[XB_XGEN(b.x)]) == gen, bar);
            __builtin_amdgcn_fence(__ATOMIC_ACQUIRE, "agent");
            asm volatile("s_waitcnt vmcnt(0)" ::: "memory");
        }
    }
    __syncthreads();
}


constexpr int ATT_D = 128, KVBLK = 64;
constexpr int SHM_V = KVBLK * ATT_D * 2, SHM_K = KVBLK * ATT_D * 2;
constexpr int ATT_K_OFF = 0, ATT_V_OFF = SHM_K, ATT_BUF = SHM_K + SHM_V, ATT_SET = 2 * ATT_BUF;
constexpr int ATT_WS_OFF = RING_BYTES + 512;
constexpr int ATT_X_OFF = ATT_WS_OFF + NWAVES * 256;
static_assert(2 * ATT_SET <= RING_BYTES && ATT_X_OFF + 2048 + NTHR * 16 <= LDS_BYTES, "attention LDS map");
#define KSWZ(row, colB) ((row) * 256 + ((colB) ^ (((row) & 7) << 4)))
__device__ __forceinline__ int crow(int r, int hi) { return (r & 3) + 8 * (r >> 2) + 4 * hi; }
__device__ __forceinline__ int v_st(int k, int c) { const int kk = (k & ~0xC) | ((k & 4) << 1) | ((k & 8) >> 1); return ((kk >> 3) * 4 + (c >> 5)) * 512 + ((kk & 7) * 32 + (c & 31)) * 2; }
__device__ __forceinline__ int v_rd_base(int lane) { return ((lane & 3) << 3) | (((lane >> 2) & 3) << 6) | (((lane >> 4) & 1) << 5) | (((lane >> 5) & 1) << 8); }
constexpr int v_rd_off(int d0, int ks, int half) { return d0 * 512 + ks * 4096 + half * 2048; }
template <int OFF> __device__ __forceinline__ s16x4 tr_read(int vb) {
  s16x4 r; asm volatile("ds_read_b64_tr_b16 %0, %1 offset:%2" : "=&v"(r) : "v"(vb), "i"(OFF) : "memory"); return r;
}
__device__ __forceinline__ void qkt(f32x16& p0, f32x16& p1, const LAS char* Ks, const bf16x8* qr, int r32, int hi) {
  p0 = f32x16{}; p1 = f32x16{};
#pragma unroll
  for (int d0 = 0; d0 < 8; ++d0) { const int cb = (d0 * 16 + hi * 8) * 2;
    const bf16x8 b0 = *(const LAS bf16x8*)(Ks + KSWZ(r32, cb));
    const bf16x8 b1 = *(const LAS bf16x8*)(Ks + KSWZ(32 + r32, cb));
    p0 = __builtin_amdgcn_mfma_f32_32x32x16_bf16(b0, qr[d0], p0, 0, 0, 0);
    p1 = __builtin_amdgcn_mfma_f32_32x32x16_bf16(b1, qr[d0], p1, 0, 0, 0); }
}
__device__ __forceinline__ void pack_p(const f32x16& p0, const f32x16& p1, bf16x8& pa0, bf16x8& pa1, bf16x8& pa2, bf16x8& pa3) {
#define PK4(P, BASE, OUT) do { unsigned a0 = cvtpk(P[BASE + 0], P[BASE + 1]), a1 = cvtpk(P[BASE + 2], P[BASE + 3]);   \
    unsigned b0 = cvtpk(P[BASE + 4], P[BASE + 5]), b1 = cvtpk(P[BASE + 6], P[BASE + 7]);                              \
    auto r0 = __builtin_amdgcn_permlane32_swap(a0, b0, false, false); auto r1 = __builtin_amdgcn_permlane32_swap(a1, b1, false, false); \
    v4u w = {r0[0], r1[0], r0[1], r1[1]}; OUT = __builtin_bit_cast(bf16x8, w); } while (0)
  PK4(p0, 0, pa0); PK4(p0, 8, pa1); PK4(p1, 0, pa2); PK4(p1, 8, pa3);
#undef PK4
}
template <int D0> __device__ __forceinline__ void pv_one(f32x16& od, int vb, bf16x8 pa0, bf16x8 pa1, bf16x8 pa2, bf16x8 pa3) {
  const s16x4 l0 = tr_read<v_rd_off(D0, 0, 0)>(vb), h0 = tr_read<v_rd_off(D0, 0, 1)>(vb), l1 = tr_read<v_rd_off(D0, 1, 0)>(vb), h1 = tr_read<v_rd_off(D0, 1, 1)>(vb);
  const s16x4 l2 = tr_read<v_rd_off(D0, 2, 0)>(vb), h2 = tr_read<v_rd_off(D0, 2, 1)>(vb), l3 = tr_read<v_rd_off(D0, 3, 0)>(vb), h3 = tr_read<v_rd_off(D0, 3, 1)>(vb);
  asm volatile("s_waitcnt lgkmcnt(0)" ::: "memory"); SBAR();
#define PKV(L, H) (bf16x8){L[0], L[1], L[2], L[3], H[0], H[1], H[2], H[3]}
  od = __builtin_amdgcn_mfma_f32_32x32x16_bf16(pa0, PKV(l0, h0), od, 0, 0, 0);
  od = __builtin_amdgcn_mfma_f32_32x32x16_bf16(pa1, PKV(l1, h1), od, 0, 0, 0);
  od = __builtin_amdgcn_mfma_f32_32x32x16_bf16(pa2, PKV(l2, h2), od, 0, 0, 0);
  od = __builtin_amdgcn_mfma_f32_32x32x16_bf16(pa3, PKV(l3, h3), od, 0, 0, 0);
#undef PKV
}
__device__ __forceinline__ void pv_d0(f32x16* o, int vb, bf16x8 pa0, bf16x8 pa1, bf16x8 pa2, bf16x8 pa3) {
  pv_one<0>(o[0], vb, pa0, pa1, pa2, pa3); pv_one<1>(o[1], vb, pa0, pa1, pa2, pa3); pv_one<2>(o[2], vb, pa0, pa1, pa2, pa3); pv_one<3>(o[3], vb, pa0, pa1, pa2, pa3);
}
struct KVStage { bf16x8 ks0, ks1, vs0, vs1; };
__device__ __forceinline__ void kv_load(KVStage& s, const bf16* Kh, const bf16* Vh, long ldk, long ldv, int k0, int sr, int sc) {
  s.ks0 = *(const bf16x8*)(Kh + (long)(k0 + sr) * ldk + sc); s.ks1 = *(const bf16x8*)(Kh + (long)(k0 + 32 + sr) * ldk + sc);
  s.vs0 = *(const bf16x8*)(Vh + (long)(k0 + sr) * ldv + sc); s.vs1 = *(const bf16x8*)(Vh + (long)(k0 + 32 + sr) * ldv + sc);
}
__device__ __forceinline__ void kv_write(const KVStage& s, LAS char* lds, int sr, int sc) {
  *(LAS bf16x8*)(lds + ATT_V_OFF + v_st(sr, sc)) = s.vs0; *(LAS bf16x8*)(lds + ATT_V_OFF + v_st(32 + sr, sc)) = s.vs1;
  *(LAS bf16x8*)(lds + ATT_K_OFF + KSWZ(sr, sc * 2)) = s.ks0; *(LAS bf16x8*)(lds + ATT_K_OFF + KSWZ(32 + sr, sc * 2)) = s.ks1;
}
struct KVDma { int ko[2], vo[2]; };
__device__ __forceinline__ void kv_dma_init(KVDma& d, int ldk, int ldv, int wid, int lane) {
#pragma unroll
  for (int i = 0; i < 2; ++i) { const int p = wid * 2 + i;
    const int row = p * 4 + (lane >> 4), cp = lane & 15; d.ko[i] = row * ldk + ((cp ^ (row & 7)) << 3);
    const int sub = p * 2 + (lane >> 5), kk = (sub >> 2) * 8 + ((lane & 31) >> 2), k = (kk & ~0xC) | ((kk & 4) << 1) | ((kk & 8) >> 1), c = (sub & 3) * 32 + (lane & 3) * 8;
    d.vo[i] = k * ldv + c; }
}
__device__ __forceinline__ void kv_dma(const KVDma& d, const bf16* Kt, const bf16* Vt, LAS char* lds, int buf, int wid) {
#pragma unroll
  for (int i = 0; i < 2; ++i) {
    __builtin_amdgcn_global_load_lds((const unsigned*)(Kt + d.ko[i]), (LAS unsigned*)(lds + buf + ATT_K_OFF + (wid * 2 + i) * 1024), 16, 0, 0);
    __builtin_amdgcn_global_load_lds((const unsigned*)(Vt + d.vo[i]), (LAS unsigned*)(lds + buf + ATT_V_OFF + (wid * 2 + i) * 1024), 16, 0, 0); }
}
__device__ __forceinline__ void rescale_o(f32x16* o, float a, LAS float* al_l, int r32, int hi) {
  if (__any(a < 1.f)) { if (hi == 0) al_l[r32] = a; LDS_WAIT();
#pragma unroll
    for (int r = 0; r < 16; ++r) { const float f = al_l[crow(r, hi)];
#pragma unroll
      for (int d = 0; d < 4; ++d) o[d][r] *= f; }
    LDS_WAIT(); }
}
constexpr float ATT_SCALE = 0.088388347648318440f, ATT_C = ATT_SCALE * 1.4426950408889634f, ATT_THR = 8.f;
__device__ __forceinline__ void softmax_tile(f32x16& p0, f32x16& p1, float& m_reg, float& l_reg, float& alpha, bool rowvalid = true) {
  float pmax = p0[0];
#pragma unroll
  for (int r = 1; r < 16; ++r) pmax = fmaxf(pmax, p0[r]);
#pragma unroll
  for (int r = 0; r < 16; ++r) pmax = fmaxf(pmax, p1[r]);
  { auto rr = __builtin_amdgcn_permlane32_swap(__float_as_uint(pmax), __float_as_uint(pmax), false, false);
    pmax = fmaxf(__uint_as_float(rr[0]), __uint_as_float(rr[1])); }
  if (!rowvalid) pmax = -__builtin_inff();
  float mn;
  if (__all(pmax - m_reg <= ATT_THR / ATT_SCALE)) { mn = m_reg; alpha = 1.f; }
  else { mn = fmaxf(m_reg, pmax); alpha = __builtin_amdgcn_exp2f((m_reg - mn) * ATT_C); m_reg = mn; }
  const float mnC = rowvalid ? -mn * ATT_C : -__builtin_inff();
#pragma unroll
  for (int r = 0; r < 16; ++r) { p0[r] = __builtin_amdgcn_exp2f(fmaf(p0[r], ATT_C, mnC)); p1[r] = __builtin_amdgcn_exp2f(fmaf(p1[r], ATT_C, mnC)); }
  float ps = 0.f;
#pragma unroll
  for (int r = 0; r < 16; ++r) ps += p0[r] + p1[r];
  { auto rr = __builtin_amdgcn_permlane32_swap(__float_as_uint(ps), __float_as_uint(ps), false, false);
    ps = __uint_as_float(rr[0]) + __uint_as_float(rr[1]); }
  l_reg = l_reg * alpha + ps;
}
__device__ __forceinline__ void attn_finish(f32x16& p0, f32x16& p1, f32x16* o, float& m_reg, float& l_reg, LAS float* wsc, int vb, int r32, int hi, bool rowvalid = true) {
  float alpha; softmax_tile(p0, p1, m_reg, l_reg, alpha, rowvalid);
  rescale_o(o, alpha, wsc, r32, hi);
  bf16x8 pa0, pa1, pa2, pa3; pack_p(p0, p1, pa0, pa1, pa2, pa3);
  pv_d0(o, vb, pa0, pa1, pa2, pa3);
}
__device__ __forceinline__ void load_q(bf16x8* qr, const bf16* Qw) {
#pragma unroll
  for (int d0 = 0; d0 < 8; ++d0) qr[d0] = *(const bf16x8*)(Qw + d0 * 16);
}

struct Frame {
    LAS unsigned char* lds;
    unsigned char* ws;
    int tid, lane, wave, G, bid;
    __device__ __forceinline__ void fresh() { int t = threadIdx.x; asm volatile("" : "+v"(t)); tid = t; lane = t & 63; wave = __builtin_amdgcn_readfirstlane(t >> 6);
        int g_ = gridDim.x, b_ = blockIdx.x; asm volatile("" : "+s"(g_), "+s"(b_)); G = g_; bid = b_; }
};
struct Args { const float* in[19]; float* out; unsigned char* ws; int ph_lo, ph_hi; };
typedef const Args __attribute__((address_space(4))) KArgs;
__device__ __forceinline__ KArgs* karg() { KArgs* p = (KArgs*)__builtin_amdgcn_kernarg_segment_ptr(); asm volatile("" : "+s"(p)); return p; }
#define KIN(i) ((const float*)karg()->in[i])
enum { IN_X = 0, IN_MEM, IN_AB_W_IN, IN_HGRN_LB, IN_HGRN_NW, IN_AB_W_OUT, IN_NSA_W_IN, IN_NSA_CMP_POS, IN_NSA_CMP_W1, IN_NSA_CMP_W2, IN_NSA_W_OUT,
       IN_XA_WQ, IN_XA_WKV, IN_XA_WO, IN_FFN_UP, IN_FFN_CONV, IN_FFN_DOWN, IN_LN_G, IN_LN_B };

__device__ __forceinline__ void p0_transpose_item(const float* W, int K, int N, bf16* WT, LAS float* scr, int item, int lane) {
    const int nblk = N / 32, kb = item / nblk, nb = item % nblk, k0 = 64 * kb, n0 = 32 * nb;
#pragma unroll 8
    for (int i = 0; i < 32; ++i) { const int kk = 2 * i + (lane >> 5); scr[kk * 33 + (lane & 31)] = W[(size_t)(k0 + kk) * N + n0 + (lane & 31)]; }
    LDS_WAIT(); asm volatile("" ::: "memory");
    const int c = lane & 7;
#pragma unroll
    for (int j = 0; j < 4; ++j) { const int n = (lane >> 3) + 8 * j; const LAS float* s = scr + (8 * c) * 33 + n;
        v4u o; o.x = pk2(s[0 * 33], s[1 * 33]); o.y = pk2(s[2 * 33], s[3 * 33]); o.z = pk2(s[4 * 33], s[5 * 33]); o.w = pk2(s[6 * 33], s[7 * 33]);
        *(GAS v4u*)(WT + (size_t)(n0 + n) * K + k0 + 8 * c) = o; }
    LDS_WAIT(); asm volatile("" ::: "memory");
}
__device__ __forceinline__ int up_col(int n) { const int isu = n >= DFF, ch = isu ? n - DFF : n; return (ch >> 7) * 256 + isu * 128 + (ch & 127); }
__device__ __forceinline__ void p0_transpose_item_fold(const float* W, int K, int N, bf16* WT, LAS float* scr, int item, int lane, const float* g, const float* b, long long* cs, long long* b2, bool upmap = false) {
    const int nblk = N / 32, kb = item / nblk, nb = item % nblk, k0 = 64 * kb, n0 = 32 * nb, n0m = upmap ? up_col(n0) : n0;
#pragma unroll 8
    for (int i = 0; i < 32; ++i) { const int kk = 2 * i + (lane >> 5); scr[kk * 33 + (lane & 31)] = W[(size_t)(k0 + kk) * N + n0 + (lane & 31)]; }
    LDS_WAIT(); asm volatile("" ::: "memory");
    const int c = lane & 7;
    const f32x4 g0 = *(const f32x4*)(g + k0 + 8 * c), g1 = *(const f32x4*)(g + k0 + 8 * c + 4), b0 = *(const f32x4*)(b + k0 + 8 * c), b1 = *(const f32x4*)(b + k0 + 8 * c + 4);
    const float gg[8] = {g0.x, g0.y, g0.z, g0.w, g1.x, g1.y, g1.z, g1.w}, bb[8] = {b0.x, b0.y, b0.z, b0.w, b1.x, b1.y, b1.z, b1.w};
#pragma unroll
    for (int j = 0; j < 4; ++j) { const int n = (lane >> 3) + 8 * j; const LAS float* s = scr + (8 * c) * 33 + n;
        float sc = 0.f, sb = 0.f; unsigned w[4];
#pragma unroll
        for (int q = 0; q < 4; ++q) { const float x0 = s[(2 * q) * 33], x1 = s[(2 * q + 1) * 33]; const unsigned r0 = f2bf(x0 * gg[2 * q]), r1 = f2bf(x1 * gg[2 * q + 1]);
            w[q] = r0 | (r1 << 16); sc += bf2f((unsigned short)r0) + bf2f((unsigned short)r1); sb += x0 * bb[2 * q] + x1 * bb[2 * q + 1]; }
        *(GAS v4u*)(WT + (size_t)(n0m + n) * K + k0 + 8 * c) = (v4u){w[0], w[1], w[2], w[3]};
        sc += __shfl_xor(sc, 1); sc += __shfl_xor(sc, 2); sc += __shfl_xor(sc, 4); sb += __shfl_xor(sb, 1); sb += __shfl_xor(sb, 2); sb += __shfl_xor(sb, 4);
        if (c == 0) { atomicAdd((unsigned long long*)(cs + n0m + n), (unsigned long long)(long long)rintf(sc * pg8::FOLD_SCALE)); atomicAdd((unsigned long long*)(b2 + n0m + n), (unsigned long long)(long long)rintf(sb * pg8::FOLD_SCALE)); } }
    LDS_WAIT(); asm volatile("" ::: "memory");
}
__device__ __forceinline__ void transpose_mat_fold(Frame& F, const float* W, int K, int N, bf16* WT, const float* g, const float* b, long long* cs, long long* b2, int c0 = 0, int nw = 1 << 30, int part = 0, int nparts = 1, bool upmap = false) {
    if (F.bid < c0 || F.bid >= c0 + nw) return;
    LAS float* scr = (LAS float*)(F.lds + RING_OFF + F.wave * 16384);
    const int nwg = nw < F.G ? nw : F.G, gw = (F.bid - c0) * NWAVES + F.wave, NGW = nwg * NWAVES;
    const int nitems = (K / 64) * (N / 32), ilo = (int)((long)nitems * part / nparts), ihi = (int)((long)nitems * (part + 1) / nparts);
    for (int it = ilo + gw; it < ihi; it += NGW) p0_transpose_item_fold(W, K, N, WT, scr, it, F.lane, g, b, cs, b2, upmap);
}
__device__ __forceinline__ void transpose_mat(Frame& F, const float* W, int K, int N, bf16* WT, int c0 = 0, int nw = 1 << 30) {
    if (F.bid < c0 || F.bid >= c0 + nw) return;
    LAS float* scr = (LAS float*)(F.lds + RING_OFF + F.wave * 16384);
    const int nwg = nw < F.G ? nw : F.G, gw = (F.bid - c0) * NWAVES + F.wave, NGW = nwg * NWAVES;
    const int nitems = (K / 64) * (N / 32);
    for (int it = gw; it < nitems; it += NGW) p0_transpose_item(W, K, N, WT, scr, it, F.lane);
}
__device__ __forceinline__ void fold_finalize(Frame& F, int lo, int n) {
    const long long* fs = (const long long*)(F.ws + WS_FOLD); float* fd = (float*)(F.ws + WS_FOLDF);
    for (int i = F.bid * NTHR + F.tid; i < 2 * n; i += F.G * NTHR) { const int j = (i < n) ? lo + i : FO_N + lo + (i - n); const long long v = fs[j]; fd[j] = (float)(int)(v >> 32) + (float)(unsigned)v * pg8::FOLD_INV; }
}
enum { CJ_DOWN0, CJ_NSA, CJ_L1A, CJ_L1B, CJ_DOWN1 };
template <int JOB>
__device__ __forceinline__ void convert_job(Frame& F, const Args& A, int c0, int nw) {
    unsigned char* ws = F.ws; long long* cs = (long long*)(ws + WS_FOLD); long long* b2 = cs + FO_N;
    if (JOB == CJ_DOWN0 || JOB == CJ_DOWN1) { const int l = JOB == CJ_DOWN1; transpose_mat(F, KIN(IN_FFN_DOWN) + (size_t)l * DFF * DM, DFF, DM, (bf16*)(ws + WS_W_DOWN) + (size_t)l * DM * DFF, c0, nw); }
    if (JOB == CJ_NSA) {
        transpose_mat_fold(F, KIN(IN_NSA_W_IN), DM, NSA_IN, (bf16*)(ws + WS_W_NSAIN), KIN(IN_LN_G) + 2 * DM, KIN(IN_LN_B) + 2 * DM, cs + FO_NSA, b2 + FO_NSA, c0, nw);
        transpose_mat(F, KIN(IN_NSA_W_OUT), DM, DM, (bf16*)(ws + WS_W_NSAOUT), c0, nw); }
    if (JOB == CJ_L1A || JOB == CJ_L1B) { const int l = 1;
        if (JOB == CJ_L1A) {
            transpose_mat_fold(F, KIN(IN_XA_WQ) + (size_t)l * DM * XW, DM, XW, (bf16*)(ws + WS_W_XQ) + (size_t)l * XW * DM, KIN(IN_LN_G) + (size_t)(3 * l) * DM, KIN(IN_LN_B) + (size_t)(3 * l) * DM, cs + FO_XQ + l * XW, b2 + FO_XQ + l * XW, c0, nw);
            transpose_mat(F, KIN(IN_XA_WKV) + (size_t)l * DM * 2 * XW, DM, 2 * XW, (bf16*)(ws + WS_W_XKV) + (size_t)l * 2 * XW * DM, c0, nw);
            transpose_mat(F, KIN(IN_XA_WO) + (size_t)l * XW * DM, XW, DM, (bf16*)(ws + WS_W_XO) + (size_t)l * DM * XW, c0, nw); }
        transpose_mat_fold(F, KIN(IN_FFN_UP) + (size_t)l * DM * DFF2, DM, DFF2, (bf16*)(ws + WS_W_UP) + (size_t)l * DFF2 * DM, KIN(IN_LN_G) + (size_t)(3 * l + 1) * DM, KIN(IN_LN_B) + (size_t)(3 * l + 1) * DM,
                           cs + FO_UP + l * DFF2, b2 + FO_UP + l * DFF2, c0, nw, JOB == CJ_L1A ? 0 : 1, 2, true); }
}
__device__ __forceinline__ void cvt_flat(Frame& F, const float* src, bf16* dst, long n8) {
    for (long i = (long)F.bid * NTHR + F.tid; i < n8; i += (long)F.G * NTHR) {
        const f32x4 a = *(const f32x4*)(src + i * 8), b = *(const f32x4*)(src + i * 8 + 4);
        v4u o; o.x = pk2(a.x, a.y); o.y = pk2(a.z, a.w); o.z = pk2(b.x, b.y); o.w = pk2(b.z, b.w);
        *(v4u*)(dst + i * 8) = o; }
}
__device__ __forceinline__ void p0_prologue(Frame& F, const Args& A) {
    unsigned char* ws = F.ws;
    long long* cs = (long long*)(ws + WS_FOLD); long long* b2 = cs + FO_N;
    transpose_mat(F, KIN(IN_AB_W_IN), DM, AB_IN, (bf16*)(ws + WS_W_ABIN));
    transpose_mat(F, KIN(IN_AB_W_OUT), DM, DM, (bf16*)(ws + WS_W_ABOUT));
    { const int l = 0;
        transpose_mat_fold(F, KIN(IN_XA_WQ) + (size_t)l * DM * XW, DM, XW, (bf16*)(ws + WS_W_XQ) + (size_t)l * XW * DM, KIN(IN_LN_G) + (size_t)(3 * l) * DM, KIN(IN_LN_B) + (size_t)(3 * l) * DM, cs + FO_XQ + l * XW, b2 + FO_XQ + l * XW);
        transpose_mat(F, KIN(IN_XA_WKV) + (size_t)l * DM * 2 * XW, DM, 2 * XW, (bf16*)(ws + WS_W_XKV) + (size_t)l * 2 * XW * DM);
        transpose_mat(F, KIN(IN_XA_WO) + (size_t)l * XW * DM, XW, DM, (bf16*)(ws + WS_W_XO) + (size_t)l * DM * XW);
        transpose_mat_fold(F, KIN(IN_FFN_UP) + (size_t)l * DM * DFF2, DM, DFF2, (bf16*)(ws + WS_W_UP) + (size_t)l * DFF2 * DM, KIN(IN_LN_G) + (size_t)(3 * l + 1) * DM, KIN(IN_LN_B) + (size_t)(3 * l + 1) * DM, cs + FO_UP + l * DFF2, b2 + FO_UP + l * DFF2, 0, 1 << 30, 0, 1, true); }
    for (int l = 0; l < 2; ++l) {
        transpose_mat(F, KIN(IN_NSA_CMP_W1) + (size_t)l * 32 * HD * HD, 32 * HD, HD, (bf16*)(ws + WS_W_C1) + (size_t)l * HD * 32 * HD);
        transpose_mat(F, KIN(IN_NSA_CMP_W2) + (size_t)l * HD * HD, HD, HD, (bf16*)(ws + WS_W_C2) + (size_t)l * HD * HD);
    }
    cvt_flat(F, KIN(IN_X), (bf16*)(ws + WS_HB), (long)MTOK * DM / 8);
    cvt_flat(F, KIN(IN_MEM), (bf16*)(ws + WS_MEMB), (long)BATCH * NMEM * DM / 8);
    { v4u z = {0u, 0u, 0u, 0u}; v4u* p = (v4u*)((bf16*)(ws + WS_W_NSAIN) + (size_t)NSA_IN * DM); const long n = (long)(NSA_INP - NSA_IN) * DM / 8;
      for (long i = (long)F.bid * NTHR + F.tid; i < n; i += (long)F.G * NTHR) p[i] = z; }
    { float* tab = (float*)(ws + WS_ROPE);
      for (int i = F.bid * NTHR + F.tid; i < SEQ * 64; i += F.G * NTHR) { const int t = i >> 6, d = i & 63;
          float sn, cs; sincosf((float)t * powf(10000.0f, -(float)d * (1.0f / 64.0f)), &sn, &cs); tab[(size_t)t * 128 + d] = cs; tab[(size_t)t * 128 + 64 + d] = sn; } }
    { const float* lbp = KIN(IN_HGRN_LB); float* lbo = (float*)(ws + WS_LB);
      for (int i = F.bid * NTHR + F.tid; i < A_W; i += F.G * NTHR) { const float a = lbp[i], b = lbp[A_W + i], m = fmaxf(a, b), ea = __expf(a - m), eb = __expf(b - m); lbo[i] = ea / (ea + eb); } }
}

__device__ __forceinline__ void ln_phase(Frame& F, const bf16* Y, const float* g, const float* b, float* h32) {
    const int gw = F.bid * NWAVES + F.wave, NGW = F.G * NWAVES;
    for (int m = gw; m < MTOK; m += NGW) {
        const v4u* yr = (const v4u*)(Y + (size_t)m * DM) + F.lane;
        float v[8][8]; float s = 0.f;
#pragma unroll
        for (int j = 0; j < 8; ++j) { const v4u x = yr[64 * j];
            v[j][0] = bflo(x.x); v[j][1] = bfhi(x.x); v[j][2] = bflo(x.y); v[j][3] = bfhi(x.y); v[j][4] = bflo(x.z); v[j][5] = bfhi(x.z); v[j][6] = bflo(x.w); v[j][7] = bfhi(x.w);
#pragma unroll
            for (int q = 0; q < 8; ++q) s += v[j][q]; }
        const float mean = wave_sum(s) * (1.f / DM); float s2 = 0.f;
#pragma unroll
        for (int j = 0; j < 8; ++j)
#pragma unroll
            for (int q = 0; q < 8; ++q) { v[j][q] -= mean; s2 += v[j][q] * v[j][q]; }
        const float rstd = 1.f / sqrtf(wave_sum(s2) * (1.f / DM) + LN_EPS);
#pragma unroll
        for (int j = 0; j < 8; ++j) { const int c0 = 8 * F.lane + 512 * j;
            const f32x4 g0 = *(const f32x4*)(g + c0), g1 = *(const f32x4*)(g + c0 + 4), b0 = *(const f32x4*)(b + c0), b1 = *(const f32x4*)(b + c0 + 4);
            f32x4 r0, r1;
            r0.x = v[j][0] * rstd * g0.x + b0.x; r0.y = v[j][1] * rstd * g0.y + b0.y; r0.z = v[j][2] * rstd * g0.z + b0.z; r0.w = v[j][3] * rstd * g0.w + b0.w;
            r1.x = v[j][4] * rstd * g1.x + b1.x; r1.y = v[j][5] * rstd * g1.y + b1.y; r1.z = v[j][6] * rstd * g1.z + b1.z; r1.w = v[j][7] * rstd * g1.w + b1.w;
            *(f32x4*)(h32 + (size_t)m * DM + c0) = r0; *(f32x4*)(h32 + (size_t)m * DM + c0 + 4) = r1; }
    }
}

__device__ __forceinline__ void cg_unpack(const v4u x, float* o) { o[0] = bflo(x.x); o[1] = bfhi(x.x); o[2] = bflo(x.y); o[3] = bfhi(x.y); o[4] = bflo(x.z); o[5] = bfhi(x.z); o[6] = bflo(x.w); o[7] = bfhi(x.w); }
__device__ __forceinline__ void convglu_fixup_phase(Frame& F, const bf16* SIDE, const float* cw, bf16* Gm) {
    constexpr int NCG = DFF / 8, NRUN = MTOK / 128;
    for (int it = F.bid * NTHR + F.tid; it < NCG * NRUN; it += F.G * NTHR) {
        const int cg = it % NCG, run = it / NCG, c0 = cg * 8, t0 = run * 128;
        float w0[8], w1[8], w2[8], am2[8], am1[8], a0[8], a1[8], u0[8], u1[8];
#pragma unroll
        for (int j = 0; j < 8; ++j) { w0[j] = cw[c0 + j]; w1[j] = cw[DFF + c0 + j]; w2[j] = cw[2 * DFF + c0 + j]; }
        const bf16* sp = SIDE + (size_t)run * 6 * DFF + c0;
        if ((t0 & (SEQ - 1)) == 0) {
#pragma unroll
            for (int j = 0; j < 8; ++j) { am2[j] = 0.f; am1[j] = 0.f; }
        } else { cg_unpack(*(const v4u*)sp, am2); cg_unpack(*(const v4u*)(sp + DFF), am1); }
        cg_unpack(*(const v4u*)(sp + 2 * DFF), a0); cg_unpack(*(const v4u*)(sp + 3 * DFF), a1); cg_unpack(*(const v4u*)(sp + 4 * DFF), u0); cg_unpack(*(const v4u*)(sp + 5 * DFF), u1);
        unsigned o0[4], o1[4];
#pragma unroll
        for (int j = 0; j < 8; j += 2) {
            const pg8::f32x2 g0 = pg8::gelu_pk((pg8::f32x2){w2[j] * a0[j] + w1[j] * am1[j] + w0[j] * am2[j], w2[j + 1] * a0[j + 1] + w1[j + 1] * am1[j + 1] + w0[j + 1] * am2[j + 1]});
            const pg8::f32x2 g1 = pg8::gelu_pk((pg8::f32x2){w2[j] * a1[j] + w1[j] * a0[j] + w0[j] * am1[j], w2[j + 1] * a1[j + 1] + w1[j + 1] * a0[j + 1] + w0[j + 1] * am1[j + 1]});
            o0[j >> 1] = pk2(g0.x * u0[j], g0.y * u0[j + 1]); o1[j >> 1] = pk2(g1.x * u1[j], g1.y * u1[j + 1]); }
        *(v4u*)(Gm + (size_t)t0 * DFF + c0) = (v4u){o0[0], o0[1], o0[2], o0[3]}; *(v4u*)(Gm + (size_t)(t0 + 1) * DFF + c0) = (v4u){o1[0], o1[1], o1[2], o1[3]};
    }
}

__device__ __forceinline__ void xattn_phase(Frame& F, const bf16* XQ, const bf16* XKV, bf16* XO, int u0, int nu) {
    const int tid = F.tid, wid = F.wave, lane = F.lane, r32 = lane & 31, hi = lane >> 5;
    LAS char* lds = (LAS char*)F.lds;
    LAS float* wsc = (LAS float*)(lds + ATT_WS_OFF + wid * 256);
    const int vb0 = (int)(uintptr_t)(lds + ATT_V_OFF) + v_rd_base(lane);
    KVDma dm; kv_dma_init(dm, 2 * XW, 2 * XW, wid, lane);
    for (int u = u0; u < u0 + nu; ++u) {
        const int head = u % XH, rbk = u / XH, row0 = rbk * 256, b = row0 / SEQ;
        const bf16* Kh = XKV + (size_t)b * NMEM * 2 * XW + head * HD; const bf16* Vh = Kh + XW;
        bf16x8 qr[8]; load_q(qr, XQ + (size_t)(row0 + wid * 32 + r32) * XW + head * HD + hi * 8);
        float m_reg = -1e30f, l_reg = 0.f; f32x16 o[4] = {};
        __syncthreads();
        kv_dma(dm, Kh, Vh, lds, 0, wid);
        for (int j = 0; j < NMEM / KVBLK; ++j) {
            const int buf = (j & 1) * ATT_BUF;
            VM_WAIT(); __syncthreads();
            if (j + 1 < NMEM / KVBLK) kv_dma(dm, Kh + (size_t)(j + 1) * KVBLK * 2 * XW, Vh + (size_t)(j + 1) * KVBLK * 2 * XW, lds, ATT_BUF - buf, wid);
            f32x16 p0, p1; qkt(p0, p1, lds + buf + ATT_K_OFF, qr, r32, hi);
            float alpha; softmax_tile(p0, p1, m_reg, l_reg, alpha);
            rescale_o(o, alpha, wsc, r32, hi);
            bf16x8 pa0, pa1, pa2, pa3; pack_p(p0, p1, pa0, pa1, pa2, pa3);
            pv_d0(o, vb0 + buf, pa0, pa1, pa2, pa3);
        }
        if (hi == 0) wsc[32 + r32] = l_reg; LDS_WAIT();
        bf16* Ow = XO + (size_t)(row0 + wid * 32) * XW + head * HD;
#pragma unroll
        for (int r = 0; r < 16; ++r) { const int orow = crow(r, hi); const float rl = __builtin_amdgcn_rcpf(wsc[32 + orow]);
#pragma unroll
            for (int d0 = 0; d0 < 4; ++d0) Ow[(size_t)orow * XW + d0 * 32 + r32] = (bf16)f2bf(o[d0][r] * rl); }
        LDS_WAIT();
    }
}

template <int K>
__device__ __forceinline__ f32x4 mma_tile(const LAS char* A, int lda, const LAS char* B, int ldb, int fr, int fq) {
    f32x4 acc = {0.f, 0.f, 0.f, 0.f};
#pragma unroll
    for (int k0 = 0; k0 < K; k0 += 32) {
        const bf16x8 a = *(const LAS bf16x8*)(A + fr * lda + (k0 + 8 * fq) * 2);
        const bf16x8 b = *(const LAS bf16x8*)(B + fr * ldb + (k0 + 8 * fq) * 2);
        acc = __builtin_amdgcn_mfma_f32_16x16x32_bf16(a, b, acc, 0, 0, 0);
    }
    return acc;
}
constexpr int HG_CH = 64, HG_NC = SEQ / HG_CH, HG_ITEMS = BATCH * A_HEADS * HG_NC;
constexpr int HG_QT = 0, HG_KT = 17408, HG_KH = 34816, HG_VT = 53248, HG_PT = 71680, HG_SEG = 80896;
constexpr int HG_SP = 17408, HG_OT = 52224;
constexpr int HG_WT = 80896, HG_KHS = 86016, HG_VS = 103424;
__device__ __forceinline__ void hgrn_phase_a(Frame& F, const bf16* P0, const float* lbv, bf16* QTg, bf16* OINTRA, bf16* DS, float* DEC) {
    LAS char* lds = (LAS char*)F.lds;
    const int tid = F.tid, wid = F.wave, lane = F.lane, fr = lane & 15, fq = lane >> 4;
    const int dg = tid & 15, sq = tid >> 4;
    const int d = tid & 127, sq16 = tid >> 7;
    for (int it = F.bid; it < HG_ITEMS; it += F.G) {
        const int c = it % HG_NC, bh = it / HG_NC, h = bh % A_HEADS, b = bh / A_HEADS;
        const size_t row0 = (size_t)b * SEQ + (size_t)c * HG_CH;
        float lb[8], q[2][8], kk[2][8], cum[2][8]; v4u vraw[2];
        { const f32x4 l0 = *(const f32x4*)(lbv + h * HD + 8 * dg), l1 = *(const f32x4*)(lbv + h * HD + 8 * dg + 4);
          lb[0] = l0.x; lb[1] = l0.y; lb[2] = l0.z; lb[3] = l0.w; lb[4] = l1.x; lb[5] = l1.y; lb[6] = l1.z; lb[7] = l1.w; }
#pragma unroll
        for (int rr = 0; rr < 2; ++rr) { const bf16* rowp = P0 + (row0 + 2 * sq + rr) * AB_IN + h * HD + 8 * dg;
            const v4u zq = *(const v4u*)(rowp + A_W), qq = *(const v4u*)rowp; vraw[rr] = *(const v4u*)(rowp + 2 * A_W);
            const unsigned zw[4] = {zq.x, zq.y, zq.z, zq.w}, qw[4] = {qq.x, qq.y, qq.z, qq.w};
#pragma unroll
            for (int j = 0; j < 8; ++j) { const float z = (j & 1) ? bfhi(zw[j >> 1]) : bflo(zw[j >> 1]); q[rr][j] = (j & 1) ? bfhi(qw[j >> 1]) : bflo(qw[j >> 1]);
                const float sg = sigmoidf_(z), omlb = 1.f - lb[j]; kk[rr][j] = omlb * (1.f - sg);
                const float lf = __logf(lb[j] + omlb * sg); cum[rr][j] = rr ? cum[0][j] + lf : lf; } }
        float pre[8];
#pragma unroll
        for (int j = 0; j < 8; ++j) { const float seg = cum[1][j]; float x = seg; const float t1 = __shfl_up(x, 16); if (lane >= 16) x += t1; const float t2 = __shfl_up(x, 32); if (lane >= 32) x += t2;
            pre[j] = x - seg; if (lane >= 48) ((LAS float*)(lds + HG_WT))[wid * 128 + 8 * dg + j] = x; }
        LDS_WAIT(); __syncthreads();
        float total[8];
#pragma unroll
        for (int j = 0; j < 8; ++j) total[j] = 0.f;
#pragma unroll
        for (int w = 0; w < NWAVES; ++w) { const f32x4 a0 = *(const LAS f32x4*)(lds + HG_WT + (w * 128 + 8 * dg) * 4), a1 = *(const LAS f32x4*)(lds + HG_WT + (w * 128 + 8 * dg + 4) * 4);
            const float av[8] = {a0.x, a0.y, a0.z, a0.w, a1.x, a1.y, a1.z, a1.w};
#pragma unroll
            for (int j = 0; j < 8; ++j) { total[j] += av[j]; if (w < wid) pre[j] += av[j]; } }
#pragma unroll
        for (int rr = 0; rr < 2; ++rr) { const int s = 2 * sq + rr; unsigned qt[4], kt[4], kh[4];
#pragma unroll
            for (int j = 0; j < 8; j += 2) { const float b0 = pre[j] + cum[rr][j], b1 = pre[j + 1] + cum[rr][j + 1];
                qt[j >> 1] = pk2(q[rr][j] * __expf(b0), q[rr][j + 1] * __expf(b1));
                kt[j >> 1] = pk2(kk[rr][j] * __expf(-b0), kk[rr][j + 1] * __expf(-b1));
                kh[j >> 1] = pk2(kk[rr][j] * __expf(total[j] - b0), kk[rr][j + 1] * __expf(total[j + 1] - b1)); }
            const v4u qv = {qt[0], qt[1], qt[2], qt[3]};
            *(LAS v4u*)(lds + HG_QT + s * 272 + dg * 16) = qv; *(v4u*)(QTg + (row0 + s) * A_W + h * HD + 8 * dg) = qv;
            *(LAS v4u*)(lds + HG_KT + s * 272 + dg * 16) = (v4u){kt[0], kt[1], kt[2], kt[3]};
            *(LAS v4u*)(lds + HG_KHS + s * 272 + dg * 16) = (v4u){kh[0], kh[1], kh[2], kh[3]};
            *(LAS v4u*)(lds + HG_VS + s * 272 + dg * 16) = vraw[rr]; }
        if (sq == 31) { f32x4 e0, e1; e0.x = __expf(total[0]); e0.y = __expf(total[1]); e0.z = __expf(total[2]); e0.w = __expf(total[3]); e1.x = __expf(total[4]); e1.y = __expf(total[5]); e1.z = __expf(total[6]); e1.w = __expf(total[7]);
            *(f32x4*)(DEC + (size_t)it * HD + 8 * dg) = e0; *(f32x4*)(DEC + (size_t)it * HD + 8 * dg + 4) = e1; }
        LDS_WAIT(); __syncthreads();
        { unsigned kh[8], vt[8];
#pragma unroll
          for (int j = 0; j < 16; j += 2) { const int s = 16 * sq16 + j;
              kh[j >> 1] = (unsigned)*(const LAS unsigned short*)(lds + HG_KHS + s * 272 + d * 2) | ((unsigned)*(const LAS unsigned short*)(lds + HG_KHS + (s + 1) * 272 + d * 2) << 16);
              vt[j >> 1] = (unsigned)*(const LAS unsigned short*)(lds + HG_VS + s * 272 + d * 2) | ((unsigned)*(const LAS unsigned short*)(lds + HG_VS + (s + 1) * 272 + d * 2) << 16); }
          LAS v4u* pk = (LAS v4u*)(lds + HG_KH + d * 144 + sq16 * 32); pk[0] = (v4u){kh[0], kh[1], kh[2], kh[3]}; pk[1] = (v4u){kh[4], kh[5], kh[6], kh[7]};
          LAS v4u* pv = (LAS v4u*)(lds + HG_VT + d * 144 + sq16 * 32); pv[0] = (v4u){vt[0], vt[1], vt[2], vt[3]}; pv[1] = (v4u){vt[4], vt[5], vt[6], vt[7]}; }
        LDS_WAIT(); __syncthreads();
#pragma unroll
        for (int k = 0; k < 2; ++k) { const int tau = 2 * wid + k, ti = tau >> 2, si = tau & 3;
            f32x4 acc = {0.f, 0.f, 0.f, 0.f};
            if (si <= ti) acc = mma_tile<128>(lds + HG_QT + ti * 16 * 272, 272, lds + HG_KT + si * 16 * 272, 272, fr, fq);
#pragma unroll
            for (int i = 0; i < 4; ++i) { const int t = 16 * ti + 4 * fq + i, s = 16 * si + fr; const float v = (s <= t) ? acc[i] : 0.f;
                *(LAS unsigned short*)(lds + HG_PT + t * 144 + s * 2) = (unsigned short)f2bf(v); } }
        LDS_WAIT(); __syncthreads();
#pragma unroll
        for (int k = 0; k < 4; ++k) { const int tau = wid + 8 * k, ti = tau >> 3, vi = tau & 7;
            const f32x4 acc = mma_tile<64>(lds + HG_VT + vi * 16 * 144, 144, lds + HG_PT + ti * 16 * 144, 144, fr, fq);
            v2u w; w.x = pk2(acc[0], acc[1]); w.y = pk2(acc[2], acc[3]);
            *(v2u*)(OINTRA + (row0 + 16 * ti + fr) * A_W + h * HD + 16 * vi + 4 * fq) = w; }
#pragma unroll
        for (int k = 0; k < 8; ++k) { const int tau = wid + 8 * k, vi = tau >> 3, ki = tau & 7;
            const f32x4 acc = mma_tile<64>(lds + HG_KH + ki * 16 * 144, 144, lds + HG_VT + vi * 16 * 144, 144, fr, fq);
            v2u w; w.x = pk2(acc[0], acc[1]); w.y = pk2(acc[2], acc[3]);
            *(v2u*)(DS + ((size_t)it * HD + 16 * vi + fr) * HD + 16 * ki + 4 * fq) = w; }
        LDS_WAIT(); __syncthreads();
    }
}
__device__ __forceinline__ void hgrn_phase_b(Frame& F, const bf16* DS, const float* DEC, bf16* SPREV) {
    const int tid = F.tid, dvl = tid >> 5, dk4 = (tid & 31) * 4;
    for (int item = F.bid; item < BATCH * A_HEADS * 8; item += F.G) {
        const int sl = item & 7, bh = item >> 3, dv = sl * 16 + dvl;
        f32x4 S = {0.f, 0.f, 0.f, 0.f};
        for (int c0 = 0; c0 < HG_NC; c0 += 8) {
            f32x4 ds[8], dc[8];
#pragma unroll
            for (int k = 0; k < 8; ++k) { const size_t it = (size_t)bh * HG_NC + c0 + k; const v2u x = *(const v2u*)(DS + (it * HD + dv) * HD + dk4);
                ds[k] = (f32x4){bflo(x.x), bfhi(x.x), bflo(x.y), bfhi(x.y)}; dc[k] = *(const f32x4*)(DEC + it * HD + dk4); }
#pragma unroll
            for (int k = 0; k < 8; ++k) { const size_t it = (size_t)bh * HG_NC + c0 + k;
                v2u w; w.x = pk2(S.x, S.y); w.y = pk2(S.z, S.w); *(v2u*)(SPREV + (it * HD + dv) * HD + dk4) = w;
                S = S * dc[k] + ds[k]; }
        }
    }
}
__device__ __forceinline__ void hgrn_phase_c(Frame& F, const bf16* P0, const bf16* QTg, const bf16* OINTRA, const bf16* SPREV, const float* nw, bf16* Ob) {
    LAS char* lds = (LAS char*)F.lds;
    const int tid = F.tid, wid = F.wave, lane = F.lane, fr = lane & 15, fq = lane >> 4;
    for (int it = F.bid; it < HG_ITEMS; it += F.G) {
        const int c = it % HG_NC, bh = it / HG_NC, h = bh % A_HEADS, b = bh / A_HEADS;
        const size_t row0 = (size_t)b * SEQ + (size_t)c * HG_CH;
        { const int s = tid >> 3, ch = (tid & 7) * 16; const bf16* src = QTg + (row0 + s) * A_W + h * HD + ch;
          const v4u x0 = *(const v4u*)src, x1 = *(const v4u*)(src + 8); LAS v4u* dst = (LAS v4u*)(lds + HG_QT + s * 272 + ch * 2); dst[0] = x0; dst[1] = x1; }
        { const int dv = tid >> 2, ch = (tid & 3) * 32; const bf16* src = SPREV + ((size_t)it * HD + dv) * HD + ch;
          const v4u x0 = *(const v4u*)src, x1 = *(const v4u*)(src + 8), x2 = *(const v4u*)(src + 16), x3 = *(const v4u*)(src + 24);
          LAS v4u* dst = (LAS v4u*)(lds + HG_SP + dv * 272 + ch * 2); dst[0] = x0; dst[1] = x1; dst[2] = x2; dst[3] = x3; }
        LDS_WAIT(); __syncthreads();
#pragma unroll
        for (int k = 0; k < 4; ++k) { const int tau = wid + 8 * k, ti = tau >> 3, vi = tau & 7;
            const f32x4 acc = mma_tile<128>(lds + HG_SP + vi * 16 * 272, 272, lds + HG_QT + ti * 16 * 272, 272, fr, fq);
            const int t = 16 * ti + fr, dv = 16 * vi + 4 * fq; const v2u oi = *(const v2u*)(OINTRA + (row0 + t) * A_W + h * HD + dv);
            *(LAS f32x4*)(lds + HG_OT + (t * 132 + dv) * 4) = (f32x4){acc[0] + bflo(oi.x), acc[1] + bfhi(oi.x), acc[2] + bflo(oi.y), acc[3] + bfhi(oi.y)}; }
        LDS_WAIT(); __syncthreads();
        { const int t = tid >> 3, dv0 = (tid & 7) * 16;
          float v[16]; float ss = 0.f;
#pragma unroll
          for (int q4 = 0; q4 < 4; ++q4) { const f32x4 x = *(const LAS f32x4*)(lds + HG_OT + (t * 132 + dv0 + 4 * q4) * 4); v[4 * q4] = x.x; v[4 * q4 + 1] = x.y; v[4 * q4 + 2] = x.z; v[4 * q4 + 3] = x.w;
              ss += (x.x * x.x + x.y * x.y) + (x.z * x.z + x.w * x.w); }
          ss += __shfl_xor(ss, 1); ss += __shfl_xor(ss, 2); ss += __shfl_xor(ss, 4);
          const float r = 1.f / sqrtf(ss * (1.f / HD) + RMS_EPS);
          const bf16* gp = P0 + (row0 + t) * AB_IN + 3 * A_W + h * HD + dv0; const v4u g0 = *(const v4u*)gp, g1 = *(const v4u*)(gp + 8);
          const unsigned gw[8] = {g0.x, g0.y, g0.z, g0.w, g1.x, g1.y, g1.z, g1.w}; unsigned o[8];
#pragma unroll
          for (int j = 0; j < 8; ++j) { const float ga = bflo(gw[j]), gb = bfhi(gw[j]);
              o[j] = pk2(v[2 * j] * r * nw[dv0 + 2 * j] * ga * sigmoidf_(ga), v[2 * j + 1] * r * nw[dv0 + 2 * j + 1] * gb * sigmoidf_(gb)); }
          bf16* op = Ob + (row0 + t) * DM + h * HD + dv0; *(v4u*)op = (v4u){o[0], o[1], o[2], o[3]}; *(v4u*)(op + 8) = (v4u){o[4], o[5], o[6], o[7]}; }
        LDS_WAIT(); __syncthreads();
    }
}

constexpr float SB_CUT = -160.f;
__device__ __forceinline__ void sb_phase(Frame& F, const bf16* P0, bf16* Ob) {
    const int tid = F.tid, wid = F.wave, lane = F.lane, r32 = lane & 31, hi = lane >> 5;
    LAS char* lds = (LAS char*)F.lds;
    const int vb0 = (int)(uintptr_t)(lds + ATT_V_OFF) + v_rd_base(lane);
    KVDma dm; kv_dma_init(dm, AB_IN, AB_IN, wid, lane);
    constexpr int NQB = SEQ / 256, NU = BATCH * B_HEADS * NQB;
    for (int rd = 0; ; ++rd) {
        const int idx = (rd & 1) ? rd * F.G + (F.G - 1 - F.bid) : rd * F.G + F.bid;
        if (rd * F.G >= NU) break;
        if (idx >= NU) continue;
        const int qb = NQB - 1 - idx / (BATCH * B_HEADS), bh = idx % (BATCH * B_HEADS), head = bh % B_HEADS, b = bh / B_HEADS;
        const size_t rowb = (size_t)b * SEQ; const int q0 = qb * 256;
        const bf16* Kh = P0 + rowb * AB_IN + 4 * A_W + B_W + head * HD; const bf16* Vh = Kh + B_W;
        const int tw0 = q0 + wid * 32, t = tw0 + r32;
        bf16x8 qr[8]; load_q(qr, P0 + (rowb + t) * AB_IN + 4 * A_W + head * HD + hi * 8);
        float R = 0.f; f32x16 o[4] = {};
        const int jtop = (q0 + 254) >> 6;
        LAS unsigned* dflag = (LAS unsigned*)(lds + ATT_X_OFF);
        if (lane == 0) { dflag[wid] = 0u; dflag[8 + wid] = 0u; }
        LDS_WAIT(); __syncthreads();
        kv_dma(dm, Kh + (size_t)jtop * KVBLK * AB_IN, Vh + (size_t)jtop * KVBLK * AB_IN, lds, 0, wid);
        int buf = 0;
        for (int j = jtop; j >= 0; --j, buf = ATT_BUF - buf) {
            VM_WAIT(); __syncthreads();
            { unsigned alld = 1u;
#pragma unroll
              for (int w = 0; w < NWAVES; ++w) alld &= dflag[((j + 1) & 1) * 8 + w];
              if (__builtin_amdgcn_readfirstlane(alld)) break; }
            if (j > 0) kv_dma(dm, Kh + (size_t)(j - 1) * KVBLK * AB_IN, Vh + (size_t)(j - 1) * KVBLK * AB_IN, lds, ATT_BUF - buf, wid);
            const int k0 = j * KVBLK;
            if (k0 < tw0 + 31) {
                f32x16 p0, p1; qkt(p0, p1, lds + buf + ATT_K_OFF, qr, r32, hi);
                const bool need_mask = (k0 + 63 >= tw0);
                float L0[16], L1[16];
#pragma unroll
                for (int r = 0; r < 16; ++r) {
                    const float z0 = p0[r] * ATT_C, z1 = p1[r] * ATT_C;
                    float l0 = -(fmaxf(z0, 0.f) + __builtin_amdgcn_logf(1.f + __builtin_amdgcn_exp2f(-fabsf(z0))));
                    float l1 = -(fmaxf(z1, 0.f) + __builtin_amdgcn_logf(1.f + __builtin_amdgcn_exp2f(-fabsf(z1))));
                    if (need_mask) { if (k0 + crow(r, hi) >= t) l0 = 0.f; if (k0 + 32 + crow(r, hi) >= t) l1 = 0.f; }
                    L0[r] = l0; L1[r] = l1; p0[r] = z0 + l0; p1[r] = z1 + l1;
                }
                SBAR();
                float Sg[16];
#pragma unroll
                for (int gi = 0; gi < 4; ++gi) {
                    const float a = (L0[4 * gi] + L0[4 * gi + 1]) + (L0[4 * gi + 2] + L0[4 * gi + 3]), c = (L1[4 * gi] + L1[4 * gi + 1]) + (L1[4 * gi + 2] + L1[4 * gi + 3]);
                    auto ra = __builtin_amdgcn_permlane32_swap(__float_as_uint(a), __float_as_uint(a), false, false);
                    auto rc = __builtin_amdgcn_permlane32_swap(__float_as_uint(c), __float_as_uint(c), false, false);
                    Sg[2 * gi] = __uint_as_float(ra[0]); Sg[2 * gi + 1] = __uint_as_float(ra[1]); Sg[8 + 2 * gi] = __uint_as_float(rc[0]); Sg[8 + 2 * gi + 1] = __uint_as_float(rc[1]);
                }
                float run = R;
#pragma unroll
                for (int s = 15; s >= 0; --s) { const float tt = run; run += Sg[s]; Sg[s] = tt; }
                const float Rn = run;
                SBAR();
#pragma unroll
                for (int gi = 0; gi < 4; ++gi) {
                    float base0 = hi ? Sg[2 * gi + 1] : Sg[2 * gi], base1 = hi ? Sg[8 + 2 * gi + 1] : Sg[8 + 2 * gi];
                    float r3 = base0, r2 = r3 + L0[4 * gi + 3], r1 = r2 + L0[4 * gi + 2], r0 = r1 + L0[4 * gi + 1];
                    p0[4 * gi + 3] = __builtin_amdgcn_exp2f(p0[4 * gi + 3] + r3); p0[4 * gi + 2] = __builtin_amdgcn_exp2f(p0[4 * gi + 2] + r2);
                    p0[4 * gi + 1] = __builtin_amdgcn_exp2f(p0[4 * gi + 1] + r1); p0[4 * gi + 0] = __builtin_amdgcn_exp2f(p0[4 * gi + 0] + r0);
                    r3 = base1; r2 = r3 + L1[4 * gi + 3]; r1 = r2 + L1[4 * gi + 2]; r0 = r1 + L1[4 * gi + 1];
                    p1[4 * gi + 3] = __builtin_amdgcn_exp2f(p1[4 * gi + 3] + r3); p1[4 * gi + 2] = __builtin_amdgcn_exp2f(p1[4 * gi + 2] + r2);
                    p1[4 * gi + 1] = __builtin_amdgcn_exp2f(p1[4 * gi + 1] + r1); p1[4 * gi + 0] = __builtin_amdgcn_exp2f(p1[4 * gi + 0] + r0);
                }
                R = Rn;
                { const unsigned dn = __all(R < SB_CUT) ? 1u : 0u; if (lane == 0) dflag[(j & 1) * 8 + wid] = dn; }
                if (need_mask) {
#pragma unroll
                    for (int r = 0; r < 16; ++r) { if (k0 + crow(r, hi) >= t) p0[r] = 0.f; if (k0 + 32 + crow(r, hi) >= t) p1[r] = 0.f; }
                }
                bf16x8 pa0, pa1, pa2, pa3; pack_p(p0, p1, pa0, pa1, pa2, pa3);
                pv_d0(o, vb0 + buf, pa0, pa1, pa2, pa3);
            }
        }
        bf16* Ow = Ob + (rowb + tw0) * DM + A_W + head * HD;
#pragma unroll
        for (int r = 0; r < 16; ++r) { const int orow = crow(r, hi);
#pragma unroll
            for (int d0 = 0; d0 < 4; ++d0) Ow[(size_t)orow * DM + d0 * 32 + r32] = (bf16)f2bf(o[d0][r]); }
    }
}

constexpr int P1_KC = 4096, P1_VC = 4608, P1_KS = 5120, P1_VS = 5632, P1_KW = 6144, P1_VW = 6656, P1_GL = 7168;
__device__ __forceinline__ void nsa_rope_phase(Frame& F, const bf16* P1, const float* TAB, bf16* QROT, bf16* KSROT, bf16* KWROT, bf16* OVL) {
    const int gw = F.bid * NWAVES + F.wave, NGW = F.G * NWAVES, lane = F.lane, hsub = lane >> 3, d0 = (lane & 7) * 8;
    for (int m = gw; m < MTOK; m += NGW) {
        const int t = m & (SEQ - 1);
        const f32x4 c0 = *(const f32x4*)(TAB + (size_t)t * 128 + d0), c1 = *(const f32x4*)(TAB + (size_t)t * 128 + d0 + 4);
        const f32x4 s0 = *(const f32x4*)(TAB + (size_t)t * 128 + 64 + d0), s1 = *(const f32x4*)(TAB + (size_t)t * 128 + 64 + d0 + 4);
        const float cs[8] = {c0.x, c0.y, c0.z, c0.w, c1.x, c1.y, c1.z, c1.w}, sn[8] = {s0.x, s0.y, s0.z, s0.w, s1.x, s1.y, s1.z, s1.w};
        const bf16* row = P1 + (size_t)m * NSA_INP;
#pragma unroll
        for (int hb = 0; hb < 5; ++hb) {
            const int hh = hb * 8 + hsub;
            const bf16* src; bf16* dst;
            if (hh < 32) { src = row + hh * HD; dst = QROT + (size_t)m * DM + hh * HD; }
            else if (hh < 36) { src = row + P1_KS + (hh - 32) * HD; dst = KSROT + (size_t)m * KVW + (hh - 32) * HD; }
            else { src = row + P1_KW + (hh - 36) * HD; dst = KWROT + (size_t)m * KVW + (hh - 36) * HD; }
            const v4u a = *(const v4u*)(src + d0), bq = *(const v4u*)(src + 64 + d0);
            const unsigned aw[4] = {a.x, a.y, a.z, a.w}, bw[4] = {bq.x, bq.y, bq.z, bq.w}; unsigned o1[4], o2[4];
#pragma unroll
            for (int q = 0; q < 4; ++q) { const float x1l = bflo(aw[q]), x1h = bfhi(aw[q]), x2l = bflo(bw[q]), x2h = bfhi(bw[q]);
                o1[q] = pk2(x1l * cs[2 * q] - x2l * sn[2 * q], x1h * cs[2 * q + 1] - x2h * sn[2 * q + 1]);
                o2[q] = pk2(x2l * cs[2 * q] + x1l * sn[2 * q], x2h * cs[2 * q + 1] + x1h * sn[2 * q + 1]); }
            *(v4u*)(dst + d0) = (v4u){o1[0], o1[1], o1[2], o1[3]}; *(v4u*)(dst + 64 + d0) = (v4u){o2[0], o2[1], o2[2], o2[3]};
        }
    }
    for (int i = F.bid * NTHR + F.tid; i < NCMPP * NSLC; i += F.G * NTHR) { const int n = i / NSLC, j = i % NSLC;
        OVL[i] = (n < NCMP && n >= 4 * j - 1 && n <= 4 * j + 3) ? (bf16)0x3f80u : (bf16)0u; }
}
constexpr int CM_A = 0, CM_B = 17408, CM_H = 17408 + 34816;
__device__ __forceinline__ void nsa_compress_phase(Frame& F, const bf16* P1, const float* pos, const bf16* W1t, const bf16* W2t, bf16* KCMP, bf16* VCMP) {
    LAS char* lds = (LAS char*)F.lds;
    const int tid = F.tid, wid = F.wave, lane = F.lane, fr = lane & 15, fq = lane >> 4;
    for (int item = F.bid; item < 128; item += F.G) {
        const int nt = item & 7, g = (item >> 3) & 3, b = (item >> 5) & 1, which = item >> 6;
        const bf16* w1 = W1t + (size_t)which * HD * 32 * HD; const bf16* w2 = W2t + (size_t)which * HD * HD;
        const float* posw = pos + (size_t)which * 32 * HD;
        f32x4 acc[4];
#pragma unroll
        for (int k = 0; k < 4; ++k) acc[k] = (f32x4){0.f, 0.f, 0.f, 0.f};
        for (int l = 0; l < 32; ++l) {
            { const int r = tid >> 3, ch = (tid & 7) * 16, n = nt * 64 + r; unsigned w[8];
              if (n < NCMP) { const bf16* src = P1 + ((size_t)b * SEQ + 16 * n + l) * NSA_INP + P1_KC + which * KVW + g * HD + ch;
                  const v4u x0 = *(const v4u*)src, x1 = *(const v4u*)(src + 8); const unsigned xs[8] = {x0.x, x0.y, x0.z, x0.w, x1.x, x1.y, x1.z, x1.w};
#pragma unroll
                  for (int q = 0; q < 8; ++q) w[q] = pk2(bflo(xs[q]) + posw[l * HD + ch + 2 * q], bfhi(xs[q]) + posw[l * HD + ch + 2 * q + 1]);
              } else {
#pragma unroll
                  for (int q = 0; q < 8; ++q) w[q] = 0u; }
              LAS v4u* dst = (LAS v4u*)(lds + CM_A + r * 272 + ch * 2); dst[0] = (v4u){w[0], w[1], w[2], w[3]}; dst[1] = (v4u){w[4], w[5], w[6], w[7]}; }
            { const int e = tid >> 2, ch = (tid & 3) * 32; const bf16* src = w1 + (size_t)e * 32 * HD + l * HD + ch;
              const v4u x0 = *(const v4u*)src, x1 = *(const v4u*)(src + 8), x2 = *(const v4u*)(src + 16), x3 = *(const v4u*)(src + 24);
              LAS v4u* dst = (LAS v4u*)(lds + CM_B + e * 272 + ch * 2); dst[0] = x0; dst[1] = x1; dst[2] = x2; dst[3] = x3; }
            LDS_WAIT(); __syncthreads();
#pragma unroll
            for (int k = 0; k < 4; ++k) { const int tau = wid + 8 * k, ni = tau >> 3, ei = tau & 7;
                acc[k] += mma_tile<128>(lds + CM_A + ni * 16 * 272, 272, lds + CM_B + ei * 16 * 272, 272, fr, fq); }
            LDS_WAIT(); __syncthreads();
        }
#pragma unroll
        for (int k = 0; k < 4; ++k) { const int tau = wid + 8 * k, ni = tau >> 3, ei = tau & 7;
#pragma unroll
            for (int i = 0; i < 4; ++i) *(LAS unsigned short*)(lds + CM_H + (16 * ni + 4 * fq + i) * 272 + (16 * ei + fr) * 2) = (unsigned short)f2bf(gelu1(acc[k][i])); }
        { const int f = tid >> 2, ch = (tid & 3) * 32; const bf16* src = w2 + (size_t)f * HD + ch;
          const v4u x0 = *(const v4u*)src, x1 = *(const v4u*)(src + 8), x2 = *(const v4u*)(src + 16), x3 = *(const v4u*)(src + 24);
          LAS v4u* dst = (LAS v4u*)(lds + CM_B + f * 272 + ch * 2); dst[0] = x0; dst[1] = x1; dst[2] = x2; dst[3] = x3; }
        LDS_WAIT(); __syncthreads();
        bf16* outp = which ? VCMP : KCMP;
#pragma unroll
        for (int k = 0; k < 4; ++k) { const int tau = wid + 8 * k, ni = tau >> 3, fi = tau & 7;
            const f32x4 a2 = mma_tile<128>(lds + CM_H + ni * 16 * 272, 272, lds + CM_B + fi * 16 * 272, 272, fr, fq);
#pragma unroll
            for (int i = 0; i < 4; ++i) { const int n = nt * 64 + 16 * ni + 4 * fq + i;
                outp[(((size_t)b * NCMPP + n) * NSA_G + g) * HD + 16 * fi + fr] = (n < NCMP) ? (bf16)f2bf(a2[i]) : (bf16)0u; } }
        LDS_WAIT(); __syncthreads();
    }
}
__device__ __forceinline__ unsigned topk_key(float v) { const unsigned u = (v == 0.f) ? 0u : __builtin_bit_cast(unsigned, v); return u ^ ((u >> 31) ? 0xffffffffu : 0x80000000u); }
__device__ __forceinline__ v4u topk_select(float a0, float a1, int cur, int lane) {
    const unsigned k0 = topk_key(a0), k1 = topk_key(a1);
    const int j0 = lane, j1 = lane + 64;
    const bool f0 = (j0 == 0) || (j0 == cur) || (j0 == cur - 1), f1 = (j1 == cur) || (j1 == cur - 1);
    const unsigned long long c0m = __ballot(!f0 && j0 <= cur), c1m = __ballot(!f1 && j1 <= cur);
    const int nforced = cur >= 2 ? 3 : cur + 1, slots = NTOP - nforced;
    unsigned long long s0m = c0m, s1m = c1m;
    if (__builtin_popcountll(c0m) + __builtin_popcountll(c1m) > slots) {
        unsigned T = 0u;
#pragma nounroll
        for (int bit = 31; bit >= 0; --bit) { const unsigned trial = T | (1u << bit);
            const int cnt = __builtin_popcountll(__ballot(k0 >= trial) & c0m) + __builtin_popcountll(__ballot(k1 >= trial) & c1m);
            if (cnt >= slots) T = trial; }
        unsigned long long e0 = __ballot(k0 == T) & c0m, e1 = __ballot(k1 == T) & c1m;
        s0m = __ballot(k0 > T) & c0m; s1m = __ballot(k1 > T) & c1m;
        int need = slots - __builtin_popcountll(s0m) - __builtin_popcountll(s1m);
        while (need > 0 && e0) { const unsigned long long b = e0 & (~e0 + 1ull); s0m |= b; e0 ^= b; --need; }
        while (need > 0 && e1) { const unsigned long long b = e1 & (~e1 + 1ull); s1m |= b; e1 ^= b; --need; }
    }
    const unsigned long long m0 = s0m | __ballot(f0 && j0 <= cur), m1 = s1m | __ballot(f1 && j1 <= cur);
    return (v4u){(unsigned)m0, (unsigned)(m0 >> 32), (unsigned)m1, (unsigned)(m1 >> 32)};
}
__device__ __forceinline__ unsigned pick4(const unsigned (&a)[4], int i) { return i == 0 ? a[0] : (i == 1 ? a[1] : (i == 2 ? a[2] : a[3])); }
template <int MODE>
__device__ __forceinline__ void nsa_attn_phase(Frame& F, const bf16* P1, const bf16* Qsrc, const bf16* Ksrc, const bf16* Vsrc, const unsigned* SEL, float* O32, unsigned* IMPO, bf16* Ob, bool probe_nostore = false) {
    const int tid = F.tid, wid = F.wave, lane = F.lane, r32 = lane & 31, hi = lane >> 5;
    LAS char* lds = (LAS char*)F.lds;
    LAS float* wsc = (LAS float*)(lds + ATT_WS_OFF + wid * 256);
    const int vb0 = (int)(uintptr_t)(lds + ATT_V_OFF) + v_rd_base(lane);
    KVDma dm; kv_dma_init(dm, MODE <= 1 ? NSA_G * HD : KVW, MODE == 0 ? NSA_G * HD : (MODE == 1 ? NSLC : NSA_INP), wid, lane);
    constexpr int NTB = SEQ / 32, NU = BATCH * NSA_G * NTB;
    for (int rd = 0; ; ++rd) {
        int idx;
        { idx = (rd & 1) ? rd * F.G + (F.G - 1 - F.bid) : rd * F.G + F.bid; if (rd * F.G >= NU) break; if (idx >= NU) continue; }
        const int tb = NTB - 1 - idx / (BATCH * NSA_G), bg = idx % (BATCH * NSA_G), g = bg % NSA_G, b = bg / NSA_G;
        const size_t rowb = (size_t)b * SEQ; const int t0 = tb * 32;
        const int t = (MODE == 2) ? t0 + 4 * wid + (r32 >> 3) : t0 + r32, head = (MODE == 2) ? g * NSA_R + (r32 & 7) : g * NSA_R + wid;
        const bf16* Kh; const bf16* Vh; long ldk, ldv; int jlo, jhi;
        if (MODE <= 1) { Kh = Ksrc + ((size_t)b * NCMPP * NSA_G + g) * HD; ldk = NSA_G * HD; jlo = 0; jhi = (t0 >> 4) >> 6;
            if (MODE == 0) { Vh = Vsrc + ((size_t)b * NCMPP * NSA_G + g) * HD; ldv = NSA_G * HD; } else { Vh = Vsrc; ldv = NSLC; } }
        else { Kh = Ksrc + rowb * KVW + g * HD; ldk = KVW; Vh = P1 + rowb * NSA_INP + (MODE == 2 ? P1_VS : P1_VW) + g * HD; ldv = NSA_INP;
            jhi = (t0 + 31) >> 6; jlo = (MODE == 2) ? 0 : ((t0 - (WINDOW - 1) > 0 ? t0 - (WINDOW - 1) : 0) >> 6); }
        unsigned wn[4] = {~0u, ~0u, ~0u, ~0u};
        if (MODE == 2) { const v4u sv = *(const v4u*)(SEL + ((rowb + t) * NSA_G + g) * 4); unsigned selw[4]; selw[0] = sv.x; selw[1] = sv.y; selw[2] = sv.z; selw[3] = sv.w;
            *(LAS v4u*)(lds + ATT_X_OFF + 2048 + (wid * 64 + lane) * 16) = sv;
            LAS unsigned* un = (LAS unsigned*)(lds + ATT_X_OFF);
#pragma unroll
            for (int q = 0; q < 4; ++q) { unsigned x = selw[q]; x |= __shfl_xor(x, 8); x |= __shfl_xor(x, 16); wn[q] = __builtin_amdgcn_readfirstlane(x); if (lane == 0) un[wid * 4 + q] = wn[q]; }
            LDS_WAIT(); __syncthreads();
            LAS int* plist = (LAS int*)(lds + ATT_X_OFF + 128);
            if (wid == 0) {
                unsigned m0 = 0u, m1 = 0u;
                int lane_l = lane; asm volatile("" : "+v"(lane_l));
                const LAS unsigned* ub = un + (lane_l >> 5);
#pragma unroll
                for (int w = 0; w < NWAVES; ++w) { m0 |= ((ub[w * 4] >> (lane & 31)) & 1u) << w; m1 |= ((ub[w * 4 + 2] >> (lane & 31)) & 1u) << w; }
                bool v0 = m0 != 0u && lane <= jhi, v1 = m1 != 0u && lane + 64 <= jhi; int np = 0;
                for (;;) {
                    const unsigned long long a0 = __ballot(v0), a1 = __ballot(v1);
                    if (!(a0 | a1)) break;
                    const int ja_ = a0 ? __builtin_ctzll(a0) : 64 + __builtin_ctzll(a1);
                    const unsigned ma = (ja_ < 64) ? (unsigned)__shfl((int)m0, ja_) : (unsigned)__shfl((int)m1, ja_ - 64);
                    if (lane == (ja_ & 63)) { if (ja_ < 64) v0 = false; else v1 = false; }
                    unsigned long long c0 = __ballot(v0 && !(m0 & ma)), c1 = __ballot(v1 && !(m1 & ma));
                    if (!(c0 | c1)) { c0 = __ballot(v0 && m0 == 0xffu); c1 = __ballot(v1 && m1 == 0xffu); }
                    if (!(c0 | c1)) { c0 = __ballot(v0); c1 = __ballot(v1); }
                    int jb_ = -1;
                    if (c0 | c1) { jb_ = c0 ? __builtin_ctzll(c0) : 64 + __builtin_ctzll(c1); if (lane == (jb_ & 63)) { if (jb_ < 64) v0 = false; else v1 = false; } }
                    if (lane == 0) { plist[2 * np] = ja_; plist[2 * np + 1] = jb_; }
                    ++np;
                }
                if (lane == 0) { int neg1 = -1; asm volatile("" : "+v"(neg1)); plist[2 * np] = neg1; plist[2 * np + 1] = neg1; }
            }
            LDS_WAIT(); }
        bf16x8 qr[8]; load_q(qr, Qsrc + (rowb + t) * (MODE <= 1 ? NSA_INP : DM) + head * HD + hi * 8);
        float m_reg = -1e30f, l_reg = 0.f; f32x16 o[4] = {};
        const int cur = t >> 6;
#define NSA_NEED(jj) (MODE != 2 || ((pick4(wn, (jj) >> 5) >> ((jj) & 31)) & 1u))
#define NSA_MASK(P0, P1, JJ) do { const int k0 = (JJ) * KVBLK; constexpr float NINF = -__builtin_inff(); \
            if (MODE <= 1) { if (!(16 * (k0 + 63) + 31 <= t0)) { \
                    _Pragma("unroll") for (int r = 0; r < 16; ++r) { if (!(16 * (k0 + crow(r, hi)) + 31 <= t)) P0[r] = NINF; if (!(16 * (k0 + 32 + crow(r, hi)) + 31 <= t)) P1[r] = NINF; } } } \
            else if (MODE == 2) { rv_ = (*(const LAS unsigned*)(lds + ATT_X_OFF + 2048 + (wid * 64 + lane) * 16 + ((JJ) >> 5) * 4) >> ((JJ) & 31)) & 1u;     \
                if ((JJ) >= cur) { const int lim = t - k0 - 4 * hi;                          \
                    _Pragma("unroll") for (int r = 0; r < 16; ++r) { if ((r & 3) + 8 * (r >> 2) > lim) P0[r] = NINF; if (32 + (r & 3) + 8 * (r >> 2) > lim) P1[r] = NINF; } } } \
            else { if (!((k0 > t0 + 31 - WINDOW) && (k0 + 63 <= t0))) { \
                    _Pragma("unroll") for (int r = 0; r < 16; ++r) { const int ka = k0 + crow(r, hi), kb = ka + 32; \
                        if (!(ka <= t && ka > t - WINDOW)) P0[r] = NINF; if (!(kb <= t && kb > t - WINDOW)) P1[r] = NINF; } } } } while (0)
        const int pbase = __builtin_amdgcn_readfirstlane((int)(uintptr_t)(lds + ATT_X_OFF + 128)); int pp = 0;
#define PLIST(i) (*(const LAS int*)(uintptr_t)(unsigned)(pbase + 4 * (i)))
        int ja, jb;
        __syncthreads();
        if (MODE == 2) { ja = PLIST(0); jb = PLIST(1); ja = __builtin_amdgcn_readfirstlane(ja); jb = __builtin_amdgcn_readfirstlane(jb); if (ja < 0) ja = jhi + 1; }
        else { ja = jlo; jb = ja + 1; if (jb > jhi) jb = -1; }
        if (ja <= jhi) kv_dma(dm, Kh + (size_t)ja * KVBLK * ldk, Vh + (size_t)ja * KVBLK * ldv, lds, 0, wid);
        if (jb >= 0) kv_dma(dm, Kh + (size_t)jb * KVBLK * ldk, Vh + (size_t)jb * KVBLK * ldv, lds, ATT_BUF, wid);
        int set = 0;
#pragma nounroll
        while (ja <= jhi) {
            int jc, jd;
            if (MODE == 2) { ++pp; jc = PLIST(2 * pp); jd = PLIST(2 * pp + 1); jc = __builtin_amdgcn_readfirstlane(jc); jd = __builtin_amdgcn_readfirstlane(jd); if (jc < 0) jc = jhi + 1; }
            else { jc = (jb >= 0 ? jb : ja) + 1; jd = jc + 1; if (jd > jhi) jd = -1; }
            VM_WAIT(); __syncthreads();
            if (jc <= jhi) kv_dma(dm, Kh + (size_t)jc * KVBLK * ldk, Vh + (size_t)jc * KVBLK * ldv, lds, ATT_SET - set, wid);
            if (jc <= jhi && jd >= 0) kv_dma(dm, Kh + (size_t)jd * KVBLK * ldk, Vh + (size_t)jd * KVBLK * ldv, lds, ATT_SET - set + ATT_BUF, wid);
            const bool nA = NSA_NEED(ja), nB = (jb >= 0) && NSA_NEED(jb);
            f32x16 a0, a1, b0, b1;
            if (nA) qkt(a0, a1, lds + set + ATT_K_OFF, qr, r32, hi);
            if (nB) qkt(b0, b1, lds + set + ATT_BUF + ATT_K_OFF, qr, r32, hi);
            bool rv_ = true;
            if (nA) { NSA_MASK(a0, a1, ja); attn_finish(a0, a1, o, m_reg, l_reg, wsc, vb0 + set, r32, hi, rv_); }
            if (nB) { NSA_MASK(b0, b1, jb); attn_finish(b0, b1, o, m_reg, l_reg, wsc, vb0 + set + ATT_BUF, r32, hi, rv_); }
            ja = jc; jb = (jc <= jhi) ? jd : -1; set = ATT_SET - set;
        }
#undef PLIST
#undef NSA_MASK
#undef NSA_NEED
        { float fac = l_reg > 0.f ? __builtin_amdgcn_rcpf(l_reg) : 0.f;
          if (MODE != 1) { const int br = MODE == 0 ? 0 : (MODE == 2 ? 1 : 2); fac *= sigmoidf_(bf2f(P1[(rowb + t) * NSA_INP + P1_GL + head * 3 + br])); }
          if (hi == 0) wsc[32 + r32] = fac; LDS_WAIT(); }
        if (MODE == 1) {
            float fc[16];
#pragma unroll
            for (int r = 0; r < 16; ++r) fc[r] = wsc[32 + crow(r, hi)];
            LDS_WAIT(); __syncthreads();
#pragma unroll
            for (int r = 0; r < 16; ++r) { const int orow = crow(r, hi);
#pragma unroll
                for (int d0 = 0; d0 < 4; ++d0) *(LAS float*)(lds + ((wid * 32 + orow) * 128 + d0 * 32 + r32) * 4) = o[d0][r] * fc[r]; }
            LDS_WAIT(); __syncthreads();
            { const int tok = tid >> 4, j8 = (tid & 15) * 8; f32x4 s0 = {0.f, 0.f, 0.f, 0.f}, s1 = {0.f, 0.f, 0.f, 0.f};
#pragma unroll
              for (int w = 0; w < 8; ++w) { const LAS f32x4* pp = (const LAS f32x4*)(lds + ((w * 32 + tok) * 128 + j8) * 4); s0 += pp[0]; s1 += pp[1]; }
              LAS f32x4* dst = (LAS f32x4*)(lds + (tok * 128 + j8) * 4); dst[0] = s0; dst[1] = s1; }
            LDS_WAIT(); __syncthreads();
#pragma nounroll
            for (int q = 0; q < 4; ++q) { const int tok = 4 * wid + q, tt = t0 + tok;
                const float a0 = *(const LAS float*)(lds + (tok * 128 + lane) * 4), a1 = *(const LAS float*)(lds + (tok * 128 + 64 + lane) * 4);
                const v4u w = topk_select(a0, a1, tt >> 6, lane);
                if (lane == 0) *(v4u*)(IMPO + ((rowb + tt) * NSA_G + g) * 4) = w; }
            LDS_WAIT(); __syncthreads();
        } else {
#pragma unroll
            for (int r = 0; r < 16; ++r) { const int orow = crow(r, hi); const float fc = wsc[32 + orow];
                const size_t off = (MODE == 2) ? (rowb + t0 + 4 * wid + (orow >> 3)) * DM + (g * NSA_R + (orow & 7)) * HD + r32 : (rowb + t0 + orow) * DM + head * HD + r32;
#pragma unroll
                for (int d0 = 0; d0 < 4; ++d0) {
                    if (MODE == 0) Ob[off + d0 * 32] = (bf16)f2bf(o[d0][r] * fc);
                    else if (MODE == 3) { if (!probe_nostore) Ob[off + d0 * 32] = (bf16)f2bf(bf2f(Ob[off + d0 * 32]) + o[d0][r] * fc); }
                    else Ob[off + d0 * 32] = (bf16)f2bf(bf2f(Ob[off + d0 * 32]) + o[d0][r] * fc); } }
            LDS_WAIT();
        }
    }
}

#ifndef STAGE
#define STAGE 3
#endif
#define ZERO_OB_PHASE PH_BEGIN { v4u z = {0u, 0u, 0u, 0u}; v4u* p = (v4u*)Ob; const long n = (long)MTOK * DM / 8; \
            for (long i = (long)F.bid * NTHR + F.tid; i < n; i += (long)F.G * NTHR) p[i] = z; } PH_END
#define MIXER0_PHASES \
    PH_BEGIN { fold_finalize(F, FO_XQ, XW); fold_finalize(F, FO_UP, DFF2); } \
             REP(10) hgrn_phase_a(F, BIG, (const float*)(ws + WS_LB), (bf16*)(ws + WS_QT), (bf16*)(ws + WS_OINTRA), (bf16*)(ws + WS_DS), (float*)(ws + WS_DEC)); \
             REP(11) sb_phase(F, BIG, Ob); PH_END \
    PH_BEGIN REP(12) hgrn_phase_b(F, (const bf16*)(ws + WS_DS), (const float*)(ws + WS_DEC), (bf16*)(ws + WS_SPREV)); PH_END \
    PH_BEGIN REP(13) hgrn_phase_c(F, BIG, (const bf16*)(ws + WS_QT), (const bf16*)(ws + WS_OINTRA), (const bf16*)(ws + WS_SPREV), KIN(IN_HGRN_NW), Ob); PH_END
#if STAGE <= 2
#define MIXER1_PHASES ZERO_OB_PHASE
#else
#define MIXER1_PHASES \
    PH_BEGIN { fold_finalize(F, FO_XQ + XW, XW); } REP(14) { nsa_rope_phase(F, BIG, (const float*)(ws + WS_ROPE), (bf16*)(ws + WS_QROT), (bf16*)(ws + WS_KSROT), (bf16*)(ws + WS_KWROT), (bf16*)(ws + WS_OVL)); \
             nsa_compress_phase(F, BIG, KIN(IN_NSA_CMP_POS), (const bf16*)(ws + WS_W_C1), (const bf16*)(ws + WS_W_C2), (bf16*)(ws + WS_KCMP), (bf16*)(ws + WS_VCMP)); } PH_END \
    PH_BEGIN { REP(15) nsa_attn_phase<0>(F, BIG, BIG, (const bf16*)(ws + WS_KCMP), (const bf16*)(ws + WS_VCMP), nullptr, nullptr, nullptr, Ob); \
             F.fresh(); REP(15) nsa_attn_phase<1>(F, BIG, BIG, (const bf16*)(ws + WS_KCMP), (const bf16*)(ws + WS_OVL), nullptr, nullptr, (unsigned*)(ws + WS_SEL), nullptr); \
             F.fresh(); REP(17) nsa_attn_phase<3>(F, BIG, (const bf16*)(ws + WS_QROT), (const bf16*)(ws + WS_KWROT), nullptr, nullptr, nullptr, nullptr, Ob, r_ > 0); } PH_END \
    PH_BEGIN REP(18) nsa_attn_phase<2>(F, BIG, (const bf16*)(ws + WS_QROT), (const bf16*)(ws + WS_KSROT), nullptr, (const unsigned*)(ws + WS_SEL), nullptr, nullptr, Ob); PH_END
#endif
#ifndef REPMASK
#define REPMASK 0u
#endif
#define REP(gid) for (int r_ = 0; r_ <= (int)((REPMASK >> (gid)) & 1u); ++r_)
#define PH_BEGIN if (pc >= lo && pc < hi) { F.fresh();
#if (REPMASK >> 23) & 1
#define PH_END   if (pc + 1 < hi) { const unsigned long long tb0_ = __builtin_amdgcn_s_memrealtime(); XcdBarrier bb_ = bar; asm volatile("" : "+s"(bb_.bar), "+s"(bb_.x)); xcd_barrier(bb_); \
        const unsigned w_ = (unsigned)(__builtin_amdgcn_s_memrealtime() - tb0_); tbar_acc += w_; if (threadIdx.x == 0) { atomicMax((unsigned*)(args.ws + 3 * MiB) + pc, 0x7fffffffu - w_); atomicMax((unsigned*)(args.ws + 3 * MiB) + 256 + pc, w_); } } } ++pc;
#else
#define PH_END   if (pc + 1 < hi) { XcdBarrier bb_ = bar; asm volatile("" : "+s"(bb_.bar), "+s"(bb_.x)); xcd_barrier(bb_); } } ++pc;
#endif
template <int l>
__device__ __forceinline__ void layer_body(Frame& F, const Args& args, const XcdBarrier& bar, int& pc, const int lo, const int hi, unsigned long long& tbar_acc) {
    unsigned char* ws = F.ws;
    bf16* HB = (bf16*)(ws + WS_HB); bf16* Y = (bf16*)(ws + WS_Y); float* H32 = (float*)karg()->out;
    bf16* BIG = (bf16*)(ws + WS_BIG); bf16* Gm = (bf16*)(ws + WS_G); bf16* Ob = (bf16*)(ws + WS_O);
    bf16* XQ = (bf16*)(ws + WS_XQ); bf16* XO = (bf16*)(ws + WS_XO);
#define RS(k) ((long long*)(ws + WS_RSUM) + (size_t)(k) * MTOK * 2)
#define LNG(k) (KIN(IN_LN_G) + (size_t)(k) * DM)
#define LNB(k) (KIN(IN_LN_B) + (size_t)(k) * DM)
    const float* cs = (const float*)(ws + WS_FOLDF); const float* b2 = cs + FO_N;
        PH_BEGIN REP(1) {
            const int N = l == 0 ? AB_IN : NSA_INP;
            pg8::StaticOrder S; S.init(MTOK, N, F.G, F.bid);
            if (l == 0) { pg8::Gemm g{HB, (const bf16*)(ws + WS_W_ABIN), MTOK, N, DM}; pg8::EpiBf16<0> E{BIG, N, nullptr, 0, 0, 1.f};
                pg8::gemm_phase<pg8::EpiBf16<0>, pg8::StaticOrder, PG8_ALIGN, PG8_SP2>(F.lds + RING_OFF, g, S, E); }
            else { pg8::Gemm g{Y, (const bf16*)(ws + WS_W_NSAIN), MTOK, N, DM}; pg8::EpiBf16Ln E{BIG, N, RS(2), cs + FO_NSA, b2 + FO_NSA};
                pg8::gemm_phase<pg8::EpiBf16Ln, pg8::StaticOrder, PG8_ALIGN, PG8_SP2>(F.lds + RING_OFF, g, S, E);
                if (r_ == 0) convert_job<CJ_L1A>(F, args, 64, 192); }
        } PH_END
#if STAGE <= 1
        ZERO_OB_PHASE
#else
        if (l == 0) {
            MIXER0_PHASES
        } else {
            MIXER1_PHASES
        }
#endif
        PH_BEGIN REP(2) {
            pg8::Gemm g{Ob, l == 0 ? (const bf16*)(ws + WS_W_ABOUT) : (const bf16*)(ws + WS_W_NSAOUT), MTOK, DM, DM};
            pg8::StaticOrder S; S.init(MTOK, DM, F.G, F.bid);
            if (l == 0) { pg8::EpiRes0 E{Y, HB, DM, DN_ALPHA, RS(0)};
                pg8::gemm_phase<pg8::EpiRes0, pg8::StaticOrder, PG8_ALIGN, PG8_SP2>(F.lds + RING_OFF, g, S, E); }
            else { pg8::EpiResLn2 E{Y, RS(2), LNG(2), LNB(2), DM, DN_ALPHA, RS(3)};
                pg8::gemm_phase<pg8::EpiResLn2, pg8::StaticOrder, PG8_ALIGN, PG8_SP2>(F.lds + RING_OFF, g, S, E); }
        } PH_END
        PH_BEGIN REP(3) {
            {   pg8::Gemm g{Y, (const bf16*)(ws + WS_W_XQ) + (size_t)l * XW * DM, MTOK, XW, DM};
                pg8::RangeOrder S; S.init(MTOK, XW, 0, 128, F.bid);
                pg8::EpiBf16Ln E{XQ, XW, RS(3 * l), cs + FO_XQ + l * XW, b2 + FO_XQ + l * XW};
                pg8::gemm_phase<pg8::EpiBf16Ln, pg8::RangeOrder, PG8_ALIGN, PG8_SP2>(F.lds + RING_OFF, g, S, E); }
            {   pg8::Gemm g{(const bf16*)(ws + WS_MEMB), (const bf16*)(ws + WS_W_XKV) + (size_t)l * 2 * XW * DM, BATCH * NMEM, 2 * XW, DM};
                pg8::RangeOrder S; S.init(BATCH * NMEM, 2 * XW, 128, 8, F.bid);
                pg8::EpiBf16<0> E{(bf16*)(ws + WS_XKV) + (size_t)l * BATCH * NMEM * 2 * XW, 2 * XW, nullptr, 0, 0, 1.f};
                pg8::gemm_phase<pg8::EpiBf16<0>, pg8::RangeOrder, PG8_ALIGN, PG8_SP2>(F.lds + RING_OFF, g, S, E); }
            if (r_ == 0) {
                unsigned* xkv_cnt = (unsigned*)(ws + WS_CTL) + CW_XKV + 64 * l;
                if (F.bid >= 128 && F.bid < 136) {
                    asm volatile("s_waitcnt vmcnt(0)" ::: "memory"); __syncthreads();
                    if (threadIdx.x == 0) { __builtin_amdgcn_fence(__ATOMIC_RELEASE, "agent"); asm volatile("s_waitcnt vmcnt(0)" ::: "memory"); (void)xb_add(xkv_cnt, 1u); } }
                if (l == 0) convert_job<CJ_DOWN0>(F, args, 136, 120); else convert_job<CJ_L1B>(F, args, 136, 120);
                if (F.bid < 128) {
                    asm volatile("s_waitcnt vmcnt(0)" ::: "memory"); __syncthreads();
                    if (threadIdx.x == 0) { unsigned* bar_ = (unsigned*)(ws + WS_CTL) + CW_BAR; XB_SPIN(xb_ld(xkv_cnt) < 8u, bar_); __builtin_amdgcn_fence(__ATOMIC_ACQUIRE, "agent"); asm volatile("s_waitcnt vmcnt(0)" ::: "memory"); }
                    __syncthreads();
                    F.fresh();
                    xattn_phase(F, XQ, (const bf16*)(ws + WS_XKV) + (size_t)l * BATCH * NMEM * 2 * XW, XO, 2 * F.bid, 2); }
            }
        } PH_END
        PH_BEGIN { if (l == 1) fold_finalize(F, FO_UP + DFF2, DFF2); } REP(4) {
            pg8::Gemm g{XO, (const bf16*)(ws + WS_W_XO) + (size_t)l * DM * XW, MTOK, DM, XW};
            pg8::StaticOrder S; S.init(MTOK, DM, F.G, F.bid);
            pg8::EpiResLn2 E{Y, RS(3 * l), LNG(3 * l), LNB(3 * l), DM, DN_ALPHA, RS(3 * l + 1)};
            pg8::gemm_phase<pg8::EpiResLn2, pg8::StaticOrder, PG8_ALIGN, PG8_SP2>(F.lds + RING_OFF, g, S, E);
        } PH_END
        PH_BEGIN REP(5) {
#if (REPMASK >> 22) & 1
            if (r_ > 0) { XcdBarrier bb_ = bar; asm volatile("" : "+s"(bb_.bar), "+s"(bb_.x)); xcd_barrier(bb_); }
#endif
            pg8::Gemm g{Y, (const bf16*)(ws + WS_W_UP) + (size_t)l * DFF2 * DM, MTOK, DFF2, DM};
            pg8::StaticOrder S; S.init(MTOK, DFF2, F.G, F.bid);
            pg8::EpiConvGlu E{Gm, (bf16*)(ws + WS_SIDE), RS(3 * l + 1), cs + FO_UP + l * DFF2, b2 + FO_UP + l * DFF2, KIN(IN_FFN_CONV) + (size_t)l * 3 * DFF, DFF};
            pg8::gemm_phase<pg8::EpiConvGlu, pg8::StaticOrder, PG8_ALIGN, PG8_SP2>(F.lds + RING_OFF, g, S, E);
            if (r_ == 0) { if (l == 0) convert_job<CJ_NSA>(F, args, 128, 128); else convert_job<CJ_DOWN1>(F, args, 128, 128); }
        } PH_END
#if (REPMASK >> 20) & 1
        PH_BEGIN {
            pg8::Gemm g{HB, (const bf16*)(ws + WS_W_UP) + (size_t)l * DFF2 * DM, MTOK, DFF2, DM};
            pg8::ZeroOrder S; S.init(MTOK, DFF2, F.G, F.bid);
            pg8::EpiBf16<0> E{Gm, DFF2, nullptr, 0, 0, 1.f};
            pg8::gemm_phase<pg8::EpiBf16<0>, pg8::ZeroOrder, PG8_ALIGN, PG8_SP2>(F.lds + RING_OFF, g, S, E);
        } PH_END
#endif
        PH_BEGIN { if (l == 0) fold_finalize(F, FO_NSA, NSA_INP); } REP(8) convglu_fixup_phase(F, (const bf16*)(ws + WS_SIDE), KIN(IN_FFN_CONV) + (size_t)l * 3 * DFF, Gm); PH_END
        PH_BEGIN REP(6) {
            pg8::Gemm g{Gm, (const bf16*)(ws + WS_W_DOWN) + (size_t)l * DM * DFF, MTOK, DM, DFF};
            pg8::StaticOrder S; S.init(MTOK, DM, F.G, F.bid);
            pg8::EpiResLn2 E{Y, RS(3 * l + 1), LNG(3 * l + 1), LNB(3 * l + 1), DM, DN_ALPHA, RS(3 * l + 2)};
            pg8::gemm_phase<pg8::EpiResLn2, pg8::StaticOrder, PG8_ALIGN, PG8_SP2>(F.lds + RING_OFF, g, S, E);
        } PH_END
        if (l == 1) { PH_BEGIN REP(7) ln_phase(F, Y, LNG(5), LNB(5), H32); PH_END }
#undef RS
#undef LNG
#undef LNB
}
__global__ void __launch_bounds__(NTHR, 2) mega_fwd(Args args) {
    extern __shared__ __attribute__((aligned(16))) unsigned char lds_raw[];
    Frame F;
    F.lds = (LAS unsigned char*)lds_raw; F.ws = args.ws;
    F.tid = threadIdx.x; F.lane = F.tid & 63; F.wave = __builtin_amdgcn_readfirstlane(F.tid >> 6); F.G = gridDim.x;
    unsigned char* ws = args.ws;
    gu32* ctl = (gu32*)(ws + WS_CTL);
    for (int u = F.tid; u < (LDS_BYTES - LDSCTL_OFF) / 4; u += NTHR) ((LAS unsigned*)(F.lds + LDSCTL_OFF))[u] = 0u;
    __syncthreads();
    volatile LAS unsigned* MISC = (volatile LAS unsigned*)(F.lds + MISC_OFF);
    XcdBarrier bar = xcd_barrier_post((unsigned*)(ctl + CW_BAR), MISC + 8);
    const int lo = args.ph_lo, hi = args.ph_hi; int pc = 0; unsigned long long tbar_acc = 0ull;
    bf16* HB = (bf16*)(ws + WS_HB); bf16* Y = (bf16*)(ws + WS_Y); float* H32 = (float*)karg()->out;
    bf16* BIG = (bf16*)(ws + WS_BIG); bf16* Gm = (bf16*)(ws + WS_G); bf16* Ob = (bf16*)(ws + WS_O);
    bf16* XQ = (bf16*)(ws + WS_XQ); bf16* XO = (bf16*)(ws + WS_XO);

    PH_BEGIN REP(0) p0_prologue(F, args); PH_END

#if (REPMASK >> 21) & 1
    for (int e_ = 0; e_ < 40; ++e_) { PH_BEGIN PH_END }
#endif
    layer_body<0>(F, args, bar, pc, lo, hi, tbar_acc);
    layer_body<1>(F, args, bar, pc, lo, hi, tbar_acc);
#if (REPMASK >> 23) & 1
#ifndef PROBE_BID
#define PROBE_BID 0
#endif
#if (REPMASK >> 24) & 1
    if (blockIdx.x == 0) { unsigned long long tot_ = 0ull; for (int k_ = 0; k_ < pc; ++k_) { const unsigned v_ = __hip_atomic_load((unsigned*)(args.ws + 3 * MiB) + k_, __ATOMIC_RELAXED, __HIP_MEMORY_SCOPE_AGENT); const unsigned x_ = __hip_atomic_load((unsigned*)(args.ws + 3 * MiB) + 256 + k_, __ATOMIC_RELAXED, __HIP_MEMORY_SCOPE_AGENT);
#ifdef PROBE_SPREAD_MASK
            if (v_ && ((PROBE_SPREAD_MASK >> k_) & 1ull)) tot_ += x_ - (0x7fffffffu - v_);
#else
            if (v_) tot_ += 0x7fffffffu - v_;
#endif
        }
        const unsigned long long t0_ = __builtin_amdgcn_s_memrealtime(); while (__builtin_amdgcn_s_memrealtime() - t0_ < tot_) __builtin_amdgcn_s_sleep(8); }
#else
    if (blockIdx.x == PROBE_BID) { const unsigned long long t0_ = __builtin_amdgcn_s_memrealtime(); while (__builtin_amdgcn_s_memrealtime() - t0_ < tbar_acc) __builtin_amdgcn_s_sleep(8); }
#endif
#endif
}

extern "C" void kernel_launch(void* const* d_in, const int* in_sizes, int n_in, void* d_out, int out_size, void* d_ws, size_t ws_size, hipStream_t stream) {
    static int grid = 0;
    if (grid == 0) {
        if (n_in != 19 || in_sizes[0] != MTOK * DM || out_size != MTOK * DM || ws_size < WS_END) {
            fprintf(stderr, "kernel_launch: shape mismatch n_in %d in0 %d out %d ws %zu (need %zu)\n", n_in, n_in > 0 ? in_sizes[0] : -1, out_size, ws_size, (size_t)WS_END); grid = -1; return; }
        int dev = 0, cus = 0, per_cu = 0;
        if (hipGetDevice(&dev) != hipSuccess || hipDeviceGetAttribute(&cus, hipDeviceAttributeMultiprocessorCount, dev) != hipSuccess) { grid = -1; return; }
        if (hipFuncSetAttribute((const void*)mega_fwd, hipFuncAttributeMaxDynamicSharedMemorySize, LDS_BYTES) != hipSuccess) { fprintf(stderr, "kernel_launch: hipFuncSetAttribute failed\n"); grid = -1; return; }
        if (hipOccupancyMaxActiveBlocksPerMultiprocessor(&per_cu, (const void*)mega_fwd, NTHR, LDS_BYTES) != hipSuccess || per_cu < 1)
            fprintf(stderr, "kernel_launch: note: occupancy query reports %d workgroups per CU\n", per_cu);
        (void)hipGetLastError();
        grid = cus;
        if (grid != 256) { fprintf(stderr, "kernel_launch: built for a 256-CU device (workgroup ranges of the cross-attention and conversion phases); this device reports %d; nothing launched\n", cus); grid = -1; return; }
    }
    if (grid < 0) return;
    if (hipMemsetAsync((char*)d_ws + WS_CTL, 0, CTL_ZERO_BYTES, stream) != hipSuccess) { fprintf(stderr, "kernel_launch: memset failed\n"); return; }
    Args a{};
    for (int i = 0; i < 19; ++i) a.in[i] = (const float*)d_in[i];
    a.out = (float*)d_out; a.ws = (unsigned char*)d_ws; a.ph_lo = 0; a.ph_hi = 1 << 20;
    hipLaunchKernelGGL(mega_fwd, dim3(grid), dim3(NTHR), LDS_BYTES, stream, a);
    const hipError_t le = hipPeekAtLastError();
    if (le != hipSuccess) fprintf(stderr, "kernel_launch: launch failed: %s\n", hipGetErrorName(le));
}
```

```cpp
#include <hip/hip_runtime.h>
#include <cstdio>
#include <cstdint>
namespace pg8 {
#define PG8_LAS __attribute__((address_space(3)))
typedef unsigned short bf16_t;
typedef short bf16x8 __attribute__((ext_vector_type(8)));
typedef float f32x4 __attribute__((ext_vector_type(4)));
typedef unsigned u32x4 __attribute__((ext_vector_type(4)));
constexpr int BM = 256, BK = 64, HALF = 128, HTB = HALF * BK * 2  , STAGE_BYTES = 8 * HTB, NXCD = 8, WGM = 8;

__host__ __device__ __forceinline__ int lds_byte(int r, int c) { const int st = (r >> 4) * 2 + (c >> 5), rr = r & 15, cc = c & 31, ob = rr * 64 + cc * 2; return st * 1024 + (ob ^ (((ob >> 9) & 1) << 5)); }
__host__ __device__ __forceinline__ void stage_rc(int b, int& R, int& C) { const int st = b / 1024, sb = b % 1024, swz = sb ^ (((sb >> 9) & 1) << 5); R = (st >> 1) * 16 + swz / 64; C = (st & 1) * 32 + (swz % 64) / 2; }
__host__ __device__ __forceinline__ int perm32(int rho) { const int n = rho >> 4, i = rho & 15; return 8 * (i >> 2) + 4 * n + (i & 3); }

struct Unit { int pm, pn; };
struct Gemm { const bf16_t* A; const bf16_t* Bt; int M, N, K; };

struct StaticOrder {
    int nM, nN, nwg, G, c;
    __host__ __device__ void init(int M, int N, int G_, int c_) { nM = M / BM; nN = N / BM; nwg = nM * nN; G = G_; c = c_; }
    __host__ __device__ bool next(int i, Unit& u) const {
        const long L = (long)i * G + c; if (L >= nwg) return false;
        int wgid = (int)L; { const int q = nwg / NXCD, r = nwg % NXCD, xcd = wgid % NXCD, off = wgid / NXCD; wgid = (xcd < r ? xcd * (q + 1) : r * (q + 1) + (xcd - r) * q) + off; }
        const int nig = WGM * nN, gid = wgid / nig, fm = gid * WGM, gsz = (nM - fm) < WGM ? (nM - fm) : WGM;
        u.pm = fm + ((wgid % nig) % gsz); u.pn = (wgid % nig) / gsz; return true;
    }
    __device__ __forceinline__ void a_ready(const Unit&) const {}
    __device__ __forceinline__ void done(const Unit&) const {}
};

__device__ __forceinline__ unsigned cvt_pk_bf16(float lo, float hi) { unsigned r; asm volatile("v_cvt_pk_bf16_f32 %0, %1, %2" : "=v"(r) : "v"(lo), "v"(hi)); return r; }
typedef float f32x2 __attribute__((ext_vector_type(2)));
__device__ __forceinline__ f32x2 gelu_pk(f32x2 v) {
    const f32x2 av = __builtin_elementwise_abs(v), d = av * 0.2316418882f + 1.0f;
    f32x2 t; t.x = __builtin_amdgcn_rcpf(d.x); t.y = __builtin_amdgcn_rcpf(d.y);
    f32x2 q = t * 0.5307027145f + (-0.7265760135f); q = q * t + 0.7107068705f; q = q * t + (-0.142248368f); q = q * t + 0.127414796f; q = q * t;
    const f32x2 s = (v * v) * (-0.72134752044f);
    f32x2 e; e.x = __builtin_amdgcn_exp2f(s.x); e.y = __builtin_amdgcn_exp2f(s.y);
    const f32x2 m = av * (q * e);
    return __builtin_elementwise_max(v, (f32x2){0.f, 0.f}) - m;
}

template <int ACT  > struct EpiBf16 {
    static constexpr bool PERM = true, AFTER_DRAIN = false; static_assert(ACT == 0 || ACT == 1, "EpiBf16: ACT is 0 (none) or 1 (gelu_pk)");
    bf16_t* O; int ldc; const float* bias; int split_cols; size_t split_stride; float scale0;
    __device__ __forceinline__ void operator()(const f32x4 (&acc)[2][2][4][2], const Unit& u, int wr, int wc, int fr, int fq) const {
        const int row0 = u.pm * BM + wr * 64 + fr; int colt = u.pn * BM; bf16_t* base = O;
        float sc = 1.f; if (split_cols) { const int t = colt / split_cols; base += (size_t)t * split_stride; colt -= t * split_cols; if (t == 0) sc = scale0; }
        const int col0 = colt + wc * 32 + 8 * fq, bcol0 = u.pn * BM + wc * 32 + 8 * fq;
        f32x4 bv[2][2];
#pragma unroll
        for (int bj = 0; bj < 2; ++bj)
#pragma unroll
            for (int n = 0; n < 2; ++n) bv[bj][n] = bias ? *(const f32x4*)(bias + bcol0 + bj * HALF + 4 * n) : (f32x4){0.f, 0.f, 0.f, 0.f};
#pragma unroll
        for (int ai = 0; ai < 2; ++ai)
#pragma unroll
            for (int m = 0; m < 4; ++m) { bf16_t* rowp = base + (size_t)(row0 + ai * HALF + m * 16) * ldc + col0;
#pragma unroll
                for (int bj = 0; bj < 2; ++bj) { f32x4 v0 = acc[ai][bj][m][0] + bv[bj][0], v1 = acc[ai][bj][m][1] + bv[bj][1];
                    if (ACT == 1) { f32x2 a = gelu_pk((f32x2){v0[0], v0[1]}), b = gelu_pk((f32x2){v0[2], v0[3]}), c = gelu_pk((f32x2){v1[0], v1[1]}), d = gelu_pk((f32x2){v1[2], v1[3]});
                        v0 = (f32x4){a.x, a.y, b.x, b.y}; v1 = (f32x4){c.x, c.y, d.x, d.y}; }
                    v0 = v0 * sc; v1 = v1 * sc; u32x4 w; w.x = cvt_pk_bf16(v0[0], v0[1]); w.y = cvt_pk_bf16(v0[2], v0[3]); w.z = cvt_pk_bf16(v1[0], v1[1]); w.w = cvt_pk_bf16(v1[2], v1[3]);
                    *(u32x4*)(rowp + bj * HALF) = w; } }
    }
};


struct EpiRes {
    static constexpr bool PERM = false, AFTER_DRAIN = false;
    float* Y; const float* res; int ldc; float alpha;
    __device__ __forceinline__ void operator()(const f32x4 (&acc)[2][2][4][2], const Unit& u, int wr, int wc, int fr, int fq) const {
        const int row0 = u.pm * BM + wr * 64 + fr, col0 = u.pn * BM + wc * 32 + 4 * fq;
#pragma unroll
        for (int ai = 0; ai < 2; ++ai)
#pragma unroll
            for (int m = 0; m < 4; ++m) { const size_t off = (size_t)(row0 + ai * HALF + m * 16) * ldc + col0;
#pragma unroll
                for (int bj = 0; bj < 2; ++bj)
#pragma unroll
                    for (int n = 0; n < 2; ++n) { const f32x4 r = *(const f32x4*)(res + off + bj * HALF + n * 16);
                        *(f32x4*)(Y + off + bj * HALF + n * 16) = r * alpha + acc[ai][bj][m][n]; } }
    }
};
struct RangeOrder {
    int nM, nN, ntot, c0, nw, c;
    __host__ __device__ void init(int M, int N, int c0_, int nw_, int c_) { nM = M / BM; nN = N / BM; ntot = nM * nN; c0 = c0_; nw = nw_; c = c_; }
    __host__ __device__ bool next(int i, Unit& u) const {
        if (c < c0 || c >= c0 + nw) return false;
        const int L = i * nw + (c - c0); if (L >= ntot) return false;
        u.pm = L / nN; u.pn = L % nN; return true;
    }
    __device__ __forceinline__ void a_ready(const Unit&) const {}
    __device__ __forceinline__ void done(const Unit&) const {}
};

struct ZeroOrder : StaticOrder {
    __host__ __device__ bool next(int i, Unit& u) const { const bool r = StaticOrder::next(i, u); u.pm = 0; u.pn = 0; return r; }
};

struct EpiResBf {
    static constexpr bool PERM = true, AFTER_DRAIN = false;
    bf16_t* Y; const bf16_t* res; int ldc; float alpha;
    __device__ __forceinline__ void operator()(const f32x4 (&acc)[2][2][4][2], const Unit& u, int wr, int wc, int fr, int fq) const {
        const int row0 = u.pm * BM + wr * 64 + fr, col0 = u.pn * BM + wc * 32 + 8 * fq;
#pragma unroll
        for (int ai = 0; ai < 2; ++ai)
#pragma unroll
            for (int m = 0; m < 4; ++m) { const size_t off = (size_t)(row0 + ai * HALF + m * 16) * ldc + col0;
#pragma unroll
                for (int bj = 0; bj < 2; ++bj) { const u32x4 r = *(const u32x4*)(res + off + bj * HALF);
                    const f32x4 v0 = acc[ai][bj][m][0], v1 = acc[ai][bj][m][1];
                    u32x4 w;
                    w.x = cvt_pk_bf16(__builtin_bit_cast(float, r.x << 16) * alpha + v0[0], __builtin_bit_cast(float, r.x & 0xffff0000u) * alpha + v0[1]);
                    w.y = cvt_pk_bf16(__builtin_bit_cast(float, r.y << 16) * alpha + v0[2], __builtin_bit_cast(float, r.y & 0xffff0000u) * alpha + v0[3]);
                    w.z = cvt_pk_bf16(__builtin_bit_cast(float, r.z << 16) * alpha + v1[0], __builtin_bit_cast(float, r.z & 0xffff0000u) * alpha + v1[1]);
                    w.w = cvt_pk_bf16(__builtin_bit_cast(float, r.w << 16) * alpha + v1[2], __builtin_bit_cast(float, r.w & 0xffff0000u) * alpha + v1[3]);
                    *(u32x4*)(Y + off + bj * HALF) = w; } }
    }
};

struct EpiResF {
    static constexpr bool PERM = true, AFTER_DRAIN = false;
    float* Y; const bf16_t* res; int ldc; float alpha;
    __device__ __forceinline__ void operator()(const f32x4 (&acc)[2][2][4][2], const Unit& u, int wr, int wc, int fr, int fq) const {
        const int row0 = u.pm * BM + wr * 64 + fr, col0 = u.pn * BM + wc * 32 + 8 * fq;
#pragma unroll
        for (int ai = 0; ai < 2; ++ai)
#pragma unroll
            for (int m = 0; m < 4; ++m) { const size_t off = (size_t)(row0 + ai * HALF + m * 16) * ldc + col0;
#pragma unroll
                for (int bj = 0; bj < 2; ++bj) { const u32x4 r = *(const u32x4*)(res + off + bj * HALF);
                    f32x4 o0, o1;
                    o0[0] = __builtin_bit_cast(float, r.x << 16); o0[1] = __builtin_bit_cast(float, r.x & 0xffff0000u); o0[2] = __builtin_bit_cast(float, r.y << 16); o0[3] = __builtin_bit_cast(float, r.y & 0xffff0000u);
                    o1[0] = __builtin_bit_cast(float, r.z << 16); o1[1] = __builtin_bit_cast(float, r.z & 0xffff0000u); o1[2] = __builtin_bit_cast(float, r.w << 16); o1[3] = __builtin_bit_cast(float, r.w & 0xffff0000u);
                    *(f32x4*)(Y + off + bj * HALF) = o0 * alpha + acc[ai][bj][m][0]; *(f32x4*)(Y + off + bj * HALF + 4) = o1 * alpha + acc[ai][bj][m][1]; } }
    }
};

struct EpiResLn {
    static constexpr bool PERM = true, AFTER_DRAIN = false;
    bf16_t* Y; const float* stats; const float* g; const float* b; int ldc; float alpha;
    __device__ __forceinline__ void operator()(const f32x4 (&acc)[2][2][4][2], const Unit& u, int wr, int wc, int fr, int fq) const {
        const int row0 = u.pm * BM + wr * 64 + fr, col0 = u.pn * BM + wc * 32 + 8 * fq;
        f32x4 gv[2][2], bv[2][2];
#pragma unroll
        for (int bj = 0; bj < 2; ++bj)
#pragma unroll
            for (int n = 0; n < 2; ++n) { gv[bj][n] = *(const f32x4*)(g + col0 + bj * HALF + 4 * n) * alpha; bv[bj][n] = *(const f32x4*)(b + col0 + bj * HALF + 4 * n) * alpha; }
#pragma unroll
        for (int ai = 0; ai < 2; ++ai)
#pragma unroll
            for (int m = 0; m < 4; ++m) { const int row = row0 + ai * HALF + m * 16; const size_t off = (size_t)row * ldc + col0;
                const float mean = stats[2 * row], rstd = stats[2 * row + 1];
#pragma unroll
                for (int bj = 0; bj < 2; ++bj) { const u32x4 r = *(const u32x4*)(Y + off + bj * HALF);
                    f32x4 y0, y1;
                    y0[0] = __builtin_bit_cast(float, r.x << 16); y0[1] = __builtin_bit_cast(float, r.x & 0xffff0000u); y0[2] = __builtin_bit_cast(float, r.y << 16); y0[3] = __builtin_bit_cast(float, r.y & 0xffff0000u);
                    y1[0] = __builtin_bit_cast(float, r.z << 16); y1[1] = __builtin_bit_cast(float, r.z & 0xffff0000u); y1[2] = __builtin_bit_cast(float, r.w << 16); y1[3] = __builtin_bit_cast(float, r.w & 0xffff0000u);
                    const f32x4 o0 = (y0 - mean) * rstd * gv[bj][0] + bv[bj][0] + acc[ai][bj][m][0], o1 = (y1 - mean) * rstd * gv[bj][1] + bv[bj][1] + acc[ai][bj][m][1];
                    u32x4 w; w.x = cvt_pk_bf16(o0[0], o0[1]); w.y = cvt_pk_bf16(o0[2], o0[3]); w.z = cvt_pk_bf16(o1[0], o1[1]); w.w = cvt_pk_bf16(o1[2], o1[3]);
                    *(u32x4*)(Y + off + bj * HALF) = w; } }
    }
};

constexpr float RS_SCALE = 1048576.0f, RS_INV = 1.0f / 1048576.0f;
__device__ __forceinline__ float fx20_to_f(long long v) { return (float)(int)(v >> 20) + (float)((unsigned)v & 0xFFFFFu) * RS_INV; }
__device__ __forceinline__ long long f_to_fx20(float s) { const float fl = floorf(s); return ((long long)(int)fl << 20) + (long long)(unsigned)((s - fl) * RS_SCALE + 0.5f); }
__device__ __forceinline__ void row_stats(const long long* rs, int row, float& mean, float& rstd) {
    const long long a = rs[2 * (size_t)row], b = rs[2 * (size_t)row + 1];
    mean = fx20_to_f(a) * (1.0f / 4096.0f); const float var = fx20_to_f(b) * (1.0f / 4096.0f) - mean * mean; rstd = __builtin_amdgcn_rsqf(var + 1e-5f);
}
constexpr float FOLD_SCALE = 4294967296.0f, FOLD_INV = 1.0f / 4294967296.0f;
struct EpiBf16Ln {
    static constexpr bool PERM = true, AFTER_DRAIN = false;
    bf16_t* O; int ldc; const long long* rs; const float* cs; const float* b2;
    __device__ __forceinline__ void operator()(const f32x4 (&acc)[2][2][4][2], const Unit& u, int wr, int wc, int fr, int fq) const {
        const int row0 = u.pm * BM + wr * 64 + fr, col0 = u.pn * BM + wc * 32 + 8 * fq;
        f32x4 cv[2][2], bv[2][2];
#pragma unroll
        for (int bj = 0; bj < 2; ++bj)
#pragma unroll
            for (int n = 0; n < 2; ++n) { cv[bj][n] = *(const f32x4*)(cs + col0 + bj * HALF + 4 * n); bv[bj][n] = *(const f32x4*)(b2 + col0 + bj * HALF + 4 * n); }
#pragma unroll
        for (int ai = 0; ai < 2; ++ai)
#pragma unroll
            for (int m = 0; m < 4; ++m) { const int row = row0 + ai * HALF + m * 16; float mean, rstd; row_stats(rs, row, mean, rstd);
                bf16_t* rowp = O + (size_t)row * ldc + col0;
#pragma unroll
                for (int bj = 0; bj < 2; ++bj) { const f32x4 v0 = (acc[ai][bj][m][0] - cv[bj][0] * mean) * rstd + bv[bj][0], v1 = (acc[ai][bj][m][1] - cv[bj][1] * mean) * rstd + bv[bj][1];
                    u32x4 w; w.x = cvt_pk_bf16(v0[0], v0[1]); w.y = cvt_pk_bf16(v0[2], v0[3]); w.z = cvt_pk_bf16(v1[0], v1[1]); w.w = cvt_pk_bf16(v1[2], v1[3]);
                    *(u32x4*)(rowp + bj * HALF) = w; } }
    }
};
__device__ __forceinline__ void row_sums_add(long long* rso, int row, const f32x4& a, const f32x4& b, const f32x4& c, const f32x4& d, int fq) {
    float s1 = ((a[0] + a[1]) + (a[2] + a[3])) + ((b[0] + b[1]) + (b[2] + b[3])) + ((c[0] + c[1]) + (c[2] + c[3])) + ((d[0] + d[1]) + (d[2] + d[3]));
    float s2 = ((a[0] * a[0] + a[1] * a[1]) + (a[2] * a[2] + a[3] * a[3])) + ((b[0] * b[0] + b[1] * b[1]) + (b[2] * b[2] + b[3] * b[3]))
             + ((c[0] * c[0] + c[1] * c[1]) + (c[2] * c[2] + c[3] * c[3])) + ((d[0] * d[0] + d[1] * d[1]) + (d[2] * d[2] + d[3] * d[3]));
    s1 += __shfl_xor(s1, 16); s1 += __shfl_xor(s1, 32); s2 += __shfl_xor(s2, 16); s2 += __shfl_xor(s2, 32);
    if (fq == 0) { atomicAdd((unsigned long long*)(rso + 2 * (size_t)row), (unsigned long long)f_to_fx20(s1)); atomicAdd((unsigned long long*)(rso + 2 * (size_t)row + 1), (unsigned long long)f_to_fx20(s2)); }
}
struct EpiRes0 {
    static constexpr bool PERM = true, AFTER_DRAIN = false;
    bf16_t* Y; const bf16_t* res; int ldc; float alpha; long long* rso;
    __device__ __forceinline__ void operator()(const f32x4 (&acc)[2][2][4][2], const Unit& u, int wr, int wc, int fr, int fq) const {
        const int row0 = u.pm * BM + wr * 64 + fr, col0 = u.pn * BM + wc * 32 + 8 * fq;
#pragma unroll
        for (int ai = 0; ai < 2; ++ai)
#pragma unroll
            for (int m = 0; m < 4; ++m) { const int row = row0 + ai * HALF + m * 16; const size_t off = (size_t)row * ldc + col0; f32x4 o[2][2];
#pragma unroll
                for (int bj = 0; bj < 2; ++bj) { const u32x4 r = *(const u32x4*)(res + off + bj * HALF);
                    f32x4 y0, y1;
                    y0[0] = __builtin_bit_cast(float, r.x << 16); y0[1] = __builtin_bit_cast(float, r.x & 0xffff0000u); y0[2] = __builtin_bit_cast(float, r.y << 16); y0[3] = __builtin_bit_cast(float, r.y & 0xffff0000u);
                    y1[0] = __builtin_bit_cast(float, r.z << 16); y1[1] = __builtin_bit_cast(float, r.z & 0xffff0000u); y1[2] = __builtin_bit_cast(float, r.w << 16); y1[3] = __builtin_bit_cast(float, r.w & 0xffff0000u);
                    o[bj][0] = y0 * alpha + acc[ai][bj][m][0]; o[bj][1] = y1 * alpha + acc[ai][bj][m][1];
                    u32x4 w; w.x = cvt_pk_bf16(o[bj][0][0], o[bj][0][1]); w.y = cvt_pk_bf16(o[bj][0][2], o[bj][0][3]); w.z = cvt_pk_bf16(o[bj][1][0], o[bj][1][1]); w.w = cvt_pk_bf16(o[bj][1][2], o[bj][1][3]);
                    *(u32x4*)(Y + off + bj * HALF) = w; }
                row_sums_add(rso, row, o[0][0], o[0][1], o[1][0], o[1][1], fq); }
    }
};
struct EpiResLn2 {
    static constexpr bool PERM = true, AFTER_DRAIN = false;
    bf16_t* Y; const long long* rsi; const float* g; const float* b; int ldc; float alpha; long long* rso;
    __device__ __forceinline__ void operator()(const f32x4 (&acc)[2][2][4][2], const Unit& u, int wr, int wc, int fr, int fq) const {
        const int row0 = u.pm * BM + wr * 64 + fr, col0 = u.pn * BM + wc * 32 + 8 * fq;
        f32x4 gv[2][2], bv[2][2];
#pragma unroll
        for (int bj = 0; bj < 2; ++bj)
#pragma unroll
            for (int n = 0; n < 2; ++n) { gv[bj][n] = *(const f32x4*)(g + col0 + bj * HALF + 4 * n) * alpha; bv[bj][n] = *(const f32x4*)(b + col0 + bj * HALF + 4 * n) * alpha; }
#pragma unroll
        for (int ai = 0; ai < 2; ++ai)
#pragma unroll
            for (int m = 0; m < 4; ++m) { const int row = row0 + ai * HALF + m * 16; const size_t off = (size_t)row * ldc + col0; float mean, rstd; row_stats(rsi, row, mean, rstd); f32x4 o[2][2];
#pragma unroll
                for (int bj = 0; bj < 2; ++bj) { const u32x4 r = *(const u32x4*)(Y + off + bj * HALF);
                    f32x4 y0, y1;
                    y0[0] = __builtin_bit_cast(float, r.x << 16); y0[1] = __builtin_bit_cast(float, r.x & 0xffff0000u); y0[2] = __builtin_bit_cast(float, r.y << 16); y0[3] = __builtin_bit_cast(float, r.y & 0xffff0000u);
                    y1[0] = __builtin_bit_cast(float, r.z << 16); y1[1] = __builtin_bit_cast(float, r.z & 0xffff0000u); y1[2] = __builtin_bit_cast(float, r.w << 16); y1[3] = __builtin_bit_cast(float, r.w & 0xffff0000u);
                    o[bj][0] = (y0 - mean) * rstd * gv[bj][0] + bv[bj][0] + acc[ai][bj][m][0]; o[bj][1] = (y1 - mean) * rstd * gv[bj][1] + bv[bj][1] + acc[ai][bj][m][1];
                    u32x4 w; w.x = cvt_pk_bf16(o[bj][0][0], o[bj][0][1]); w.y = cvt_pk_bf16(o[bj][0][2], o[bj][0][3]); w.z = cvt_pk_bf16(o[bj][1][0], o[bj][1][1]); w.w = cvt_pk_bf16(o[bj][1][2], o[bj][1][3]);
                    *(u32x4*)(Y + off + bj * HALF) = w; }
                row_sums_add(rso, row, o[0][0], o[0][1], o[1][0], o[1][1], fq); }
    }
};

struct EpiBf16LnTok {
    static constexpr bool PERM = true, AFTER_DRAIN = false, AROWPERM = true;
    bf16_t* O; int ldc; const long long* rs; const float* cs; const float* b2;
    __device__ __forceinline__ void operator()(const f32x4 (&acc)[2][2][4][2], const Unit& u, int wr, int wc, int fr, int fq) const {
        const int row0 = u.pm * BM + 128 * wr + 8 * fr, col0 = u.pn * BM + wc * 32 + 8 * fq;
        f32x4 cv[2][2], bv[2][2];
#pragma unroll
        for (int bj = 0; bj < 2; ++bj)
#pragma unroll
            for (int n = 0; n < 2; ++n) { cv[bj][n] = *(const f32x4*)(cs + col0 + bj * HALF + 4 * n); bv[bj][n] = *(const f32x4*)(b2 + col0 + bj * HALF + 4 * n); }
#pragma unroll
        for (int ai = 0; ai < 2; ++ai)
#pragma unroll
            for (int m = 0; m < 4; ++m) { const int row = row0 + 4 * ai + m; float mean, rstd; row_stats(rs, row, mean, rstd);
                bf16_t* rowp = O + (size_t)row * ldc + col0;
#pragma unroll
                for (int bj = 0; bj < 2; ++bj) { const f32x4 v0 = (acc[ai][bj][m][0] - cv[bj][0] * mean) * rstd + bv[bj][0], v1 = (acc[ai][bj][m][1] - cv[bj][1] * mean) * rstd + bv[bj][1];
                    u32x4 w; w.x = cvt_pk_bf16(v0[0], v0[1]); w.y = cvt_pk_bf16(v0[2], v0[3]); w.z = cvt_pk_bf16(v1[0], v1[1]); w.w = cvt_pk_bf16(v1[2], v1[3]);
                    *(u32x4*)(rowp + bj * HALF) = w; } }
    }
};

__device__ __forceinline__ float dpp_shr1(float x) { return __builtin_bit_cast(float, __builtin_amdgcn_update_dpp(0, __builtin_bit_cast(int, x), 0x111, 0xf, 0xf, true)); }
struct EpiConvGlu {
    static constexpr bool PERM = true, AFTER_DRAIN = false, AROWPERM = true;
    bf16_t* G; bf16_t* side; const long long* rs; const float* cs; const float* b2; const float* cw; int dff;
    __device__ __forceinline__ void operator()(const f32x4 (&acc)[2][2][4][2], const Unit& u, int wr, int wc, int fr, int fq) const {
        const int row0 = u.pm * BM + 128 * wr + 8 * fr, colg = u.pn * BM + wc * 32 + 8 * fq, ch0 = u.pn * HALF + wc * 32 + 8 * fq;
        float mean_[8], rstd_[8];
#pragma unroll
        for (int j = 0; j < 8; ++j) row_stats(rs, row0 + j, mean_[j], rstd_[j]);
        float mr_[8];
#pragma unroll
        for (int j = 0; j < 8; ++j) mr_[j] = mean_[j] * rstd_[j];
        unsigned gout[8][4];
        const int bnd = row0 >> 7;
#pragma unroll
        for (int n = 0; n < 2; ++n) {
            const f32x4 ca = *(const f32x4*)(cs + colg + 4 * n), ba = *(const f32x4*)(b2 + colg + 4 * n), cu = *(const f32x4*)(cs + colg + HALF + 4 * n), bu = *(const f32x4*)(b2 + colg + HALF + 4 * n);
            const f32x4 w0 = *(const f32x4*)(cw + ch0 + 4 * n), w1 = *(const f32x4*)(cw + dff + ch0 + 4 * n), w2 = *(const f32x4*)(cw + 2 * dff + ch0 + 4 * n);
            f32x4 a[8], uu[8];
#pragma unroll
            for (int j = 0; j < 8; ++j) { a[j] = acc[j >> 2][0][j & 3][n] * rstd_[j] + (ba - ca * mr_[j]); uu[j] = acc[j >> 2][1][j & 3][n] * rstd_[j] + (bu - cu * mr_[j]); }
            f32x4 p6, p7;
#pragma unroll
            for (int q = 0; q < 4; ++q) { p6[q] = dpp_shr1(a[6][q]); p7[q] = dpp_shr1(a[7][q]); }
            if (fr == 15 && bnd + 1 < 128) { bf16_t* sp = side + ((size_t)(bnd + 1) * 6) * dff + ch0 + 4 * n;
                *(unsigned long long*)(sp) = (unsigned long long)cvt_pk_bf16(a[6][0], a[6][1]) | ((unsigned long long)cvt_pk_bf16(a[6][2], a[6][3]) << 32);
                *(unsigned long long*)(sp + dff) = (unsigned long long)cvt_pk_bf16(a[7][0], a[7][1]) | ((unsigned long long)cvt_pk_bf16(a[7][2], a[7][3]) << 32); }
            if (fr == 0) { bf16_t* sp = side + ((size_t)bnd * 6 + 2) * dff + ch0 + 4 * n;
                *(unsigned long long*)(sp) = (unsigned long long)cvt_pk_bf16(a[0][0], a[0][1]) | ((unsigned long long)cvt_pk_bf16(a[0][2], a[0][3]) << 32);
                *(unsigned long long*)(sp + dff) = (unsigned long long)cvt_pk_bf16(a[1][0], a[1][1]) | ((unsigned long long)cvt_pk_bf16(a[1][2], a[1][3]) << 32);
                *(unsigned long long*)(sp + 2 * dff) = (unsigned long long)cvt_pk_bf16(uu[0][0], uu[0][1]) | ((unsigned long long)cvt_pk_bf16(uu[0][2], uu[0][3]) << 32);
                *(unsigned long long*)(sp + 3 * dff) = (unsigned long long)cvt_pk_bf16(uu[1][0], uu[1][1]) | ((unsigned long long)cvt_pk_bf16(uu[1][2], uu[1][3]) << 32); }
#pragma unroll
            for (int j = 0; j < 8; ++j) { const f32x4 am1 = (j == 0) ? p7 : a[j ? j - 1 : 0], am2 = (j == 0) ? p6 : (j == 1 ? p7 : a[j > 1 ? j - 2 : 0]);
                const f32x4 c = w2 * a[j] + w1 * am1 + w0 * am2;
                const f32x2 g01 = gelu_pk((f32x2){c[0], c[1]}), g23 = gelu_pk((f32x2){c[2], c[3]});
                gout[j][2 * n] = cvt_pk_bf16(g01.x * uu[j][0], g01.y * uu[j][1]); gout[j][2 * n + 1] = cvt_pk_bf16(g23.x * uu[j][2], g23.y * uu[j][3]); }
        }
#pragma unroll
        for (int j = 0; j < 8; ++j) if (!(fr == 0 && j < 2)) { u32x4 w; w.x = gout[j][0]; w.y = gout[j][1]; w.z = gout[j][2]; w.w = gout[j][3]; *(u32x4*)(G + (size_t)(row0 + j) * dff + ch0) = w; }
    }
};
template <class E, class = void> struct arowperm_v { static constexpr bool value = false; };
template <class E> struct arowperm_v<E, decltype((void)E::AROWPERM)> { static constexpr bool value = E::AROWPERM; };
template <class Epi, class Sched, bool ALIGN_EPI = false, bool SP2 = false>
__device__ __forceinline__ void gemm_phase(PG8_LAS unsigned char* lds, const Gemm g, const Sched& S, const Epi& E) {
    int tid_l = threadIdx.x; asm volatile("" : "+v"(tid_l)); const int tid = tid_l, wid = __builtin_amdgcn_readfirstlane(tid >> 6), lane = tid & 63, wr = wid >> 2, wc = wid & 3, fr = lane & 15, fq = lane >> 4;
    const int K = g.K, nt = K / BK;
    unsigned voffA[2], voffB[2];
#pragma unroll
    for (int i = 0; i < 2; ++i) { int R, C; stage_rc(tid * 16 + i * 8192, R, C); const int Rb = Epi::PERM ? ((R & ~31) + perm32(R & 31)) : R;
        const int Ra = arowperm_v<Epi>::value ? (128 * (R >> 6) + 8 * (R & 15) + ((R >> 4) & 3)) : R;
        voffA[i] = (unsigned)(Ra * K + C) * 2u; voffB[i] = (unsigned)(Rb * K + C) * 2u; }
    const size_t hstepA = arowperm_v<Epi>::value ? (size_t)4 * K * 2 : (size_t)HALF * K * 2;
    const size_t kstep = (size_t)(BK * 2);
    const size_t hstep = (size_t)HALF * K * 2;
    const size_t tstep = 2 * hstep;
    const unsigned ldsw = (unsigned)wid * 1024u;
    const int aoff = lds_byte(wr * 64 + fr, fq * 8), boff = lds_byte(wc * 32 + fr, fq * 8);
#define PG8_SA(b, h) (((b) * 2 + (h)) * HTB)
#define PG8_SB(b, h) ((4 + (b) * 2 + (h)) * HTB)
#define PG8_STAGE(bufoff, gbase, voff) do { _Pragma("unroll") for (int _i = 0; _i < 2; ++_i) \
        __builtin_amdgcn_global_load_lds((const unsigned*)((const char*)(gbase) + (voff)[_i]), (PG8_LAS unsigned*)(lds + (bufoff) + ldsw + _i * 8192), 16, 0, 0); } while (0)
#define PG8_LDA(dst, b, h) do { _Pragma("unroll") for (int m = 0; m < 4; ++m) _Pragma("unroll") for (int k = 0; k < 2; ++k) dst[m][k] = *(const PG8_LAS bf16x8*)(lds + PG8_SA(b, h) + aoff + m * 2048 + k * 1024); } while (0)
#define PG8_LDB(dst, b, h) do { _Pragma("unroll") for (int n = 0; n < 2; ++n) _Pragma("unroll") for (int k = 0; k < 2; ++k) dst[n][k] = *(const PG8_LAS bf16x8*)(lds + PG8_SB(b, h) + boff + n * 2048 + k * 1024); } while (0)
#define PG8_MMA(ai, bj, At, Bt) do { __builtin_amdgcn_s_setprio(1); _Pragma("unroll") for (int m = 0; m < 4; ++m) _Pragma("unroll") for (int n = 0; n < 2; ++n) _Pragma("unroll") for (int k = 0; k < 2; ++k) \
        acc[ai][bj][m][n] = __builtin_amdgcn_mfma_f32_16x16x32_bf16(Bt[n][k], At[m][k], acc[ai][bj][m][n], 0, 0, 0); __builtin_amdgcn_s_setprio(0); } while (0)
#define PG8_WAIT_V(n) asm volatile("s_waitcnt vmcnt(" #n ")" ::: "memory")
#define PG8_WAIT_L(n) asm volatile("s_waitcnt lgkmcnt(" #n ")" ::: "memory")
#define PG8_BAR __builtin_amdgcn_s_barrier()
#define PG8_SCHED __builtin_amdgcn_sched_barrier(0)
    Unit cur, nxt; int ui = 0;
    if (!S.next(0, cur)) return;
    f32x4 acc[2][2][4][2];
#pragma unroll
    for (int a = 0; a < 2; ++a)
#pragma unroll
        for (int b = 0; b < 2; ++b)
#pragma unroll
            for (int m = 0; m < 4; ++m)
#pragma unroll
                for (int n = 0; n < 2; ++n) acc[a][b][m][n] = (f32x4){0.f, 0.f, 0.f, 0.f};
    bf16x8 At[4][2], B0[2][2], B1[2][2];
    const char* cA = (const char*)g.A + (size_t)cur.pm * tstep; const char* cB = (const char*)g.Bt + (size_t)cur.pn * tstep;
    S.a_ready(cur);
    if constexpr (SP2) {
        PG8_STAGE(PG8_SB(0, 0), cB, voffB); PG8_STAGE(PG8_SB(0, 1), cB + hstep, voffB); PG8_STAGE(PG8_SA(0, 0), cA, voffA); PG8_STAGE(PG8_SA(0, 1), cA + hstepA, voffA);
        if (wr == 1) PG8_BAR;
        PG8_WAIT_V(2); PG8_BAR;
        PG8_STAGE(PG8_SB(1, 0), cB + kstep, voffB); PG8_STAGE(PG8_SA(1, 0), cA + kstep, voffA); PG8_STAGE(PG8_SB(1, 1), cB + hstep + kstep, voffB);
        PG8_WAIT_V(6); PG8_BAR;
    } else {
        PG8_STAGE(PG8_SB(0, 0), cB, voffB); PG8_STAGE(PG8_SA(0, 0), cA, voffA); PG8_STAGE(PG8_SB(0, 1), cB + hstep, voffB); PG8_STAGE(PG8_SA(0, 1), cA + hstepA, voffA);
        if (wr == 1) PG8_BAR;
        PG8_WAIT_V(4); PG8_BAR;
        PG8_STAGE(PG8_SB(1, 0), cB + kstep, voffB); PG8_STAGE(PG8_SA(1, 0), cA + kstep, voffA); PG8_STAGE(PG8_SB(1, 1), cB + hstep + kstep, voffB);
        PG8_WAIT_V(6); PG8_BAR;
    }
    for (;;) {
        const bool has_next = S.next(ui + 1, nxt);
        const char* nA = has_next ? (const char*)g.A + (size_t)nxt.pm * tstep : cA; const char* nB = has_next ? (const char*)g.Bt + (size_t)nxt.pn * tstep : cB;
        for (int t = 0; t < nt; t += 2) {
            const bool last = (t == nt - 2);
            const char* a1 = cA + (size_t)(t + 1) * kstep;
            const char* a2 = last ? nA : cA + (size_t)(t + 2) * kstep; const char* b2 = last ? nB : cB + (size_t)(t + 2) * kstep;
            const char* a3 = a2 + kstep; const char* b3 = b2 + kstep;
            if (last && has_next) S.a_ready(nxt);
            if constexpr (SP2) {
            PG8_LDB(B0, 0, 0); PG8_LDB(B1, 0, 1); PG8_SCHED; PG8_LDA(At, 0, 0); PG8_STAGE(PG8_SA(1, 1), a1 + hstepA, voffA);
            PG8_WAIT_V(8); PG8_WAIT_L(0); PG8_BAR; PG8_MMA(0, 0, At, B0); PG8_MMA(0, 1, At, B1); PG8_BAR; PG8_SCHED;
            PG8_LDA(At, 0, 1); PG8_STAGE(PG8_SB(0, 0), b2, voffB); PG8_STAGE(PG8_SB(0, 1), b2 + hstep, voffB); PG8_STAGE(PG8_SA(0, 0), a2, voffA);
            PG8_WAIT_V(8); PG8_WAIT_L(0); PG8_BAR; PG8_MMA(1, 0, At, B0); PG8_MMA(1, 1, At, B1); PG8_BAR; PG8_SCHED;
            PG8_LDB(B0, 1, 0); PG8_LDB(B1, 1, 1); PG8_SCHED; PG8_LDA(At, 1, 0); PG8_STAGE(PG8_SA(0, 1), a2 + hstepA, voffA);
            PG8_WAIT_V(8); PG8_WAIT_L(0); PG8_BAR; PG8_MMA(0, 0, At, B0); PG8_MMA(0, 1, At, B1); PG8_BAR; PG8_SCHED;
            PG8_LDA(At, 1, 1); PG8_STAGE(PG8_SB(1, 0), b3, voffB); PG8_STAGE(PG8_SB(1, 1), b3 + hstep, voffB); PG8_STAGE(PG8_SA(1, 0), a3, voffA);
            PG8_WAIT_V(8); PG8_WAIT_L(0); PG8_BAR; PG8_MMA(1, 0, At, B0); PG8_MMA(1, 1, At, B1); PG8_BAR; PG8_SCHED;
            } else {
            PG8_LDB(B0, 0, 0); PG8_SCHED; PG8_LDA(At, 0, 0); PG8_STAGE(PG8_SA(1, 1), a1 + hstepA, voffA);
            PG8_WAIT_L(8); PG8_BAR; PG8_WAIT_L(0); PG8_MMA(0, 0, At, B0); PG8_BAR; PG8_SCHED;
            PG8_LDB(B1, 0, 1); PG8_STAGE(PG8_SB(0, 0), b2, voffB);
            PG8_BAR; PG8_WAIT_L(0); PG8_MMA(0, 1, At, B1); PG8_BAR;
            PG8_LDA(At, 0, 1); PG8_STAGE(PG8_SA(0, 0), a2, voffA);
            PG8_BAR; PG8_WAIT_L(0); PG8_MMA(1, 0, At, B0); PG8_BAR; PG8_SCHED;
            PG8_STAGE(PG8_SB(0, 1), b2 + hstep, voffB);
            PG8_WAIT_V(6); PG8_BAR; PG8_MMA(1, 1, At, B1); PG8_BAR;
            PG8_LDB(B0, 1, 0); PG8_SCHED; PG8_LDA(At, 1, 0); PG8_STAGE(PG8_SA(0, 1), a2 + hstepA, voffA);
            PG8_WAIT_L(8); PG8_BAR; PG8_WAIT_L(0); PG8_MMA(0, 0, At, B0); PG8_BAR; PG8_SCHED;
            PG8_LDB(B1, 1, 1); PG8_STAGE(PG8_SB(1, 0), b3, voffB);
            PG8_BAR; PG8_WAIT_L(0); PG8_MMA(0, 1, At, B1); PG8_BAR;
            PG8_LDA(At, 1, 1); PG8_STAGE(PG8_SA(1, 0), a3, voffA);
            PG8_BAR; PG8_WAIT_L(0); PG8_MMA(1, 0, At, B0); PG8_BAR; PG8_SCHED;
            PG8_STAGE(PG8_SB(1, 1), b3 + hstep, voffB);
            PG8_WAIT_V(6); PG8_BAR; PG8_MMA(1, 1, At, B1); PG8_BAR;
            }
        }
        if constexpr (ALIGN_EPI) { if (wr == 0) PG8_BAR; }
        if constexpr (!Epi::AFTER_DRAIN) { E(acc, cur, wr, wc, fr, fq); S.done(cur); }
        if (!has_next) break;
#pragma unroll
        for (int a = 0; a < 2; ++a)
#pragma unroll
            for (int b = 0; b < 2; ++b)
#pragma unroll
                for (int m = 0; m < 4; ++m)
#pragma unroll
                    for (int n = 0; n < 2; ++n) acc[a][b][m][n] = (f32x4){0.f, 0.f, 0.f, 0.f};
        cur = nxt; cA = nA; cB = nB; ++ui;
        if constexpr (ALIGN_EPI) { if (wr == 1) PG8_BAR; }
    }
    PG8_WAIT_V(0);
    if constexpr (!ALIGN_EPI) { if (wr == 0) PG8_BAR; }
    PG8_BAR;
    if constexpr (Epi::AFTER_DRAIN) { E.fused(acc, cur, wr, wc, fr, fq, lds, wid, lane); S.done(cur); }
#undef PG8_SA
#undef PG8_SB
#undef PG8_STAGE
#undef PG8_LDA
#undef PG8_LDB
#undef PG8_MMA
#undef PG8_WAIT_V
#undef PG8_WAIT_L
#undef PG8_BAR
#undef PG8_SCHED
}
}

#ifndef PG8_SP2
#define PG8_SP2 true
#endif
#ifndef PG8_ALIGN
#define PG8_ALIGN true
#endif
constexpr int NWAVES = 8, NTHR = 512;
constexpr int BATCH = 2, SEQ = 8192, DM = 4096, MTOK = BATCH * SEQ;
constexpr int HD = 128;
constexpr int A_HEADS = 16, B_HEADS = 16, A_W = 2048, B_W = 2048, AB_IN = 4 * A_W + 3 * B_W;
constexpr int NSA_H = 32, NSA_G = 4, NSA_R = 8, KVW = 512, NSA_IN = 4096 + 6 * KVW + 96, NSA_INP = 7424;
constexpr int NCMP = 511, NCMPP = 512, NSLC = 128, NTOP = 16, WINDOW = 512;
constexpr int NMEM = 256, XH = 4, XW = 512;
constexpr int DFF = 11008, DFF2 = 22016;
constexpr float LN_EPS = 1e-5f, RMS_EPS = 1e-6f;
constexpr float DN_ALPHA = 1.41421356237309515f;
constexpr size_t MiB = (size_t)1 << 20;
constexpr size_t WS_CTL = 0, CTL_ZERO_BYTES = 4 * MiB;
constexpr size_t WS_FOLD = 64 * 1024;
constexpr int FO_XQ = 0, FO_UP = 2 * 512, FO_NSA = FO_UP + 2 * 22016, FO_N = FO_NSA + 7424;
constexpr size_t WS_RSUM = 1 * MiB;
static_assert(WS_FOLD + (size_t)2 * FO_N * 8 <= WS_RSUM && WS_RSUM + (size_t)6 * 16384 * 2 * 8 <= CTL_ZERO_BYTES, "CTL map");
constexpr size_t WS_W_ABIN = 4 * MiB;
constexpr size_t WS_W_ABOUT = WS_W_ABIN + 112 * MiB;
constexpr size_t WS_W_NSAIN = WS_W_ABOUT + 32 * MiB;
constexpr size_t WS_W_NSAOUT = WS_W_NSAIN + 58 * MiB;
constexpr size_t WS_W_XQ = WS_W_NSAOUT + 32 * MiB;
constexpr size_t WS_W_XKV = WS_W_XQ + 8 * MiB;
constexpr size_t WS_W_XO = WS_W_XKV + 16 * MiB;
constexpr size_t WS_W_UP = WS_W_XO + 8 * MiB;
constexpr size_t WS_W_DOWN = WS_W_UP + 344 * MiB;
constexpr size_t WS_W_C1 = WS_W_DOWN + 172 * MiB;
constexpr size_t WS_W_C2 = WS_W_C1 + 2 * MiB;
constexpr size_t WS_MEMB = WS_W_C2 + 1 * MiB;
constexpr size_t WS_HB = WS_MEMB + 4 * MiB;
constexpr size_t WS_Y = WS_HB + 128 * MiB;
constexpr size_t WS_BIG = WS_Y + 256 * MiB;
constexpr size_t WS_G = WS_BIG + 688 * MiB;
constexpr size_t WS_O = WS_G + 344 * MiB;
constexpr size_t WS_MISC = WS_O + 128 * MiB;
constexpr size_t WS_END = WS_MISC + 64 * MiB;
constexpr size_t WS_XQ = WS_MISC;
constexpr size_t WS_XO = WS_MISC + 16 * MiB;
constexpr size_t WS_XKV = WS_MISC + 32 * MiB;
constexpr size_t WS_LB = WS_MISC + 34 * MiB;
constexpr size_t WS_SIDE = WS_MISC + 42 * MiB;
constexpr size_t WS_FOLDF = WS_MISC + 40 * MiB;
constexpr size_t WS_ROPE = WS_MISC + 36 * MiB;
constexpr size_t WS_STATS = WS_MISC + 35 * MiB;
constexpr size_t WS_PROJ0 = WS_BIG;
constexpr size_t WS_SPREV = WS_BIG + 448 * MiB;
constexpr size_t WS_QT = WS_G;
constexpr size_t WS_OINTRA = WS_G + 64 * MiB;
constexpr size_t WS_DEC = WS_G + 192 * MiB;
constexpr size_t WS_DS = WS_Y;
constexpr size_t WS_PROJ1 = WS_BIG;
constexpr size_t WS_QROT = WS_BIG + 232 * MiB;
constexpr size_t WS_KSROT = WS_BIG + 360 * MiB;
constexpr size_t WS_KWROT = WS_BIG + 376 * MiB;
constexpr size_t WS_KCMP = WS_BIG + 392 * MiB;
constexpr size_t WS_VCMP = WS_BIG + 393 * MiB;
constexpr size_t WS_OVL = WS_BIG + 394 * MiB;
constexpr size_t WS_SEL = WS_BIG + 395 * MiB;
constexpr size_t WS_IMP = WS_G + 256 * MiB;
constexpr size_t WS_O32 = WS_G;
static_assert(WS_SPREV + 128 * MiB <= WS_G && WS_DEC + 2 * MiB <= WS_O && WS_SEL + MiB <= WS_G, "ws map");
constexpr int CW_TMO = 0, CW_CODE = 1;
constexpr int CW_BAR = 4096;
constexpr int RING_OFF = 0, RING_BYTES = 131072;
constexpr int LDSCTL_OFF = RING_BYTES, MISC_OFF = LDSCTL_OFF + 320;
constexpr int LDS_BYTES = 147456;
static_assert(MISC_OFF + 128 <= LDS_BYTES, "LDS map");

#define GAS __attribute__((address_space(1)))
#define LAS __attribute__((address_space(3)))
typedef unsigned short bf16;
typedef unsigned v4u __attribute__((ext_vector_type(4)));
typedef unsigned v2u __attribute__((ext_vector_type(2)));
typedef float f32x4 __attribute__((ext_vector_type(4)));
typedef float f32x2 __attribute__((ext_vector_type(2)));
typedef float f32x16 __attribute__((ext_vector_type(16)));
typedef short bf16x8 __attribute__((ext_vector_type(8)));
typedef short s16x4 __attribute__((ext_vector_type(4)));
typedef GAS unsigned gu32;
#define RLX_AGENT __ATOMIC_RELAXED, __HIP_MEMORY_SCOPE_AGENT
#define LDS_WAIT() asm volatile("s_waitcnt lgkmcnt(0)" ::: "memory")
#define VM_WAIT() asm volatile("s_waitcnt vmcnt(0)" ::: "memory")
#define SBAR() __builtin_amdgcn_sched_barrier(0)
__device__ __forceinline__ unsigned f2bf(float f) { unsigned u = __builtin_bit_cast(unsigned, f); return (u + 0x7fffu + ((u >> 16) & 1u)) >> 16; }
__device__ __forceinline__ unsigned pk2(float lo, float hi) { return f2bf(lo) | (f2bf(hi) << 16); }
__device__ __forceinline__ float bf2f(unsigned short b) { return __builtin_bit_cast(float, (unsigned)b << 16); }
__device__ __forceinline__ float bflo(unsigned w) { return __builtin_bit_cast(float, w << 16); }
__device__ __forceinline__ float bfhi(unsigned w) { return __builtin_bit_cast(float, w & 0xffff0000u); }
__device__ __forceinline__ unsigned cvtpk(float lo, float hi) { unsigned r; asm volatile("v_cvt_pk_bf16_f32 %0, %1, %2" : "=v"(r) : "v"(lo), "v"(hi)); return r; }
__device__ __forceinline__ float wave_sum(float v) {
#pragma unroll
    for (int o = 1; o < 64; o <<= 1) v += __shfl_xor(v, o);
    return v;
}
__device__ __forceinline__ float sigmoidf_(float x) { return __builtin_amdgcn_rcpf(1.f + __builtin_amdgcn_exp2f(-1.4426950408889634f * x)); }
__device__ __forceinline__ float gelu1(float v) { pg8::f32x2 r = pg8::gelu_pk((pg8::f32x2){v, 0.f}); return r.x; }
#define XB_TMO      128
#define XB_XCNT(j)  (256  + 64 * (j))
#define XB_XSUB(j)  (1280 + 64 * (j))
#define XB_XGEN(j)  (2304 + 64 * (j))
#define XB_TOP      3328
#define XB_TOPGEN   3392
#define XCD_BAR_WORDS 3456
#define XB_SPIN_CAP (1u << 18)
#define LAS __attribute__((address_space(3)))

__device__ __forceinline__ unsigned xb_ld(unsigned* p)              { return __hip_atomic_load(p, __ATOMIC_RELAXED, __HIP_MEMORY_SCOPE_AGENT); }
__device__ __forceinline__ unsigned xb_add(unsigned* p, unsigned v) { return __hip_atomic_fetch_add(p, v, __ATOMIC_RELAXED, __HIP_MEMORY_SCOPE_AGENT); }
__device__ __forceinline__ unsigned xb_xcc_id() { return (unsigned)__builtin_amdgcn_s_getreg((3 << 11) | 20) & 0xFu; }
#define XB_SPIN(cond, bar) do { unsigned _sp = 0; while (cond) { __builtin_amdgcn_s_sleep(1); \
    if ((++_sp & 255u) == 0u) { if (xb_ld(&(bar)[XB_TMO])) break; if (_sp > XB_SPIN_CAP) { atomicAdd(&(bar)[XB_TMO], 1u); break; } } } } while (0)

struct XcdBarrier {
    unsigned* bar; unsigned x;
    volatile LAS unsigned* st;
};

__device__ __forceinline__ XcdBarrier xcd_barrier_post(unsigned* bar, volatile LAS unsigned* st) {
    XcdBarrier b; b.bar = bar; b.x = xb_xcc_id(); b.st = st;
    if (threadIdx.x == 0) (void)xb_add(&bar[XB_XCNT(b.x)], 1u);
    return b;
}
__device__ __forceinline__ void xcd_barrier_complete(unsigned* bar, unsigned x, unsigned& nloc, unsigned& nx) {
    const unsigned G = gridDim.x * gridDim.y * gridDim.z;
    unsigned sum, cnt, mine, sp = 0u;
    for (;;) {
        sum = 0u; cnt = 0u; mine = 0u;
#pragma unroll
        for (unsigned j = 0; j < 16; ++j) { const unsigned c = xb_ld(&bar[XB_XCNT(j)]); sum += c; cnt += (c > 0u) ? 1u : 0u; mine = (j == x) ? c : mine; }
        if (sum == G) break;
        __builtin_amdgcn_s_sleep(1);
        if ((++sp & 255u) == 0u) { if (xb_ld(&bar[XB_TMO])) break; if (sp > XB_SPIN_CAP) { atomicAdd(&bar[XB_TMO], 1u); break; } }
    }
    nloc = mine > 0u ? mine : 1u; nx = cnt > 0u ? cnt : 1u;
}

__device__ __forceinline__ void xcd_barrier(const XcdBarrier& b) {
    asm volatile("s_waitcnt vmcnt(0)" ::: "memory");
    __syncthreads();
    if (threadIdx.x == 0) {
        unsigned* bar = b.bar;
        __builtin_amdgcn_s_waitcnt(0);
        unsigned nloc = b.st[0], nx = b.st[1];
        if (nloc == 0u) { xcd_barrier_complete(bar, b.x, nloc, nx); b.st[0] = nloc; b.st[1] = nx; }
        const unsigned old = xb_add(&bar[XB_XSUB(b.x)], 1u);
        const unsigned gen = old / nloc;
        if (old + 1u == (gen + 1u) * nloc) {
            __builtin_amdgcn_fence(__ATOMIC_RELEASE, "agent");
            asm volatile("s_waitcnt vmcnt(0)" ::: "memory");
            const unsigned og = xb_add(&bar[XB_TOP], 1u);
            const unsigned tg = og / nx;
            if (og + 1u == (tg + 1u) * nx) xb_add(&bar[XB_TOPGEN], 1u);
            else XB_SPIN(xb_ld(&bar[XB_TOPGEN]) == tg, bar);
            __builtin_amdgcn_fence(__ATOMIC_ACQUIRE, "agent");
            xb_add(&bar[XB_XGEN(b.x)], 1u);
            asm volatile("s_waitcnt vmcnt(0)" ::: "memory");
        } else {
            XB_SPIN(xb_ld(&bar[XB_XGEN(b.x)]) == gen, bar);
            __builtin_amdgcn_fence(__ATOMIC_ACQUIRE, "agent");
            asm volatile("s_waitcnt vmcnt(0)" ::: "memory");
        }
    }
    __syncthreads();
}


constexpr int ATT_D = 128, KVBLK = 64;
constexpr int SHM_V = KVBLK * ATT_D * 2, SHM_K = KVBLK * ATT_D * 2;
constexpr int ATT_K_OFF = 0, ATT_V_OFF = SHM_K, ATT_BUF = SHM_K + SHM_V, ATT_SET = 2 * ATT_BUF;
constexpr int ATT_WS_OFF = RING_BYTES + 512;
constexpr int ATT_X_OFF = ATT_WS_OFF + NWAVES * 256;
static_assert(2 * ATT_SET <= RING_BYTES && ATT_X_OFF + 2048 + NTHR * 16 <= LDS_BYTES, "attention LDS map");
#define KSWZ(row, colB) ((row) * 256 + ((colB) ^ (((row) & 7) << 4)))
__device__ __forceinline__ int crow(int r, int hi) { return (r & 3) + 8 * (r >> 2) + 4 * hi; }
__device__ __forceinline__ int v_st(int k, int c) { const int kk = (k & ~0xC) | ((k & 4) << 1) | ((k & 8) >> 1); return ((kk >> 3) * 4 + (c >> 5)) * 512 + ((kk & 7) * 32 + (c & 31)) * 2; }
__device__ __forceinline__ int v_rd_base(int lane) { return ((lane & 3) << 3) | (((lane >> 2) & 3) << 6) | (((lane >> 4) & 1) << 5) | (((lane >> 5) & 1) << 8); }
constexpr int v_rd_off(int d0, int ks, int half) { return d0 * 512 + ks * 4096 + half * 2048; }
template <int OFF> __device__ __forceinline__ s16x4 tr_read(int vb) {
  s16x4 r; asm volatile("ds_read_b64_tr_b16 %0, %1 offset:%2" : "=&v"(r) : "v"(vb), "i"(OFF) : "memory"); return r;
}
__device__ __forceinline__ void qkt(f32x16& p0, f32x16& p1, const LAS char* Ks, const bf16x8* qr, int r32, int hi) {
  p0 = f32x16{}; p1 = f32x16{};
#pragma unroll
  for (int d0 = 0; d0 < 8; ++d0) { const int cb = (d0 * 16 + hi * 8) * 2;
    const bf16x8 b0 = *(const LAS bf16x8*)(Ks + KSWZ(r32, cb));
    const bf16x8 b1 = *(const LAS bf16x8*)(Ks + KSWZ(32 + r32, cb));
    p0 = __builtin_amdgcn_mfma_f32_32x32x16_bf16(b0, qr[d0], p0, 0, 0, 0);
    p1 = __builtin_amdgcn_mfma_f32_32x32x16_bf16(b1, qr[d0], p1, 0, 0, 0); }
}
__device__ __forceinline__ void pack_p(const f32x16& p0, const f32x16& p1, bf16x8& pa0, bf16x8& pa1, bf16x8& pa2, bf16x8& pa3) {
#define PK4(P, BASE, OUT) do { unsigned a0 = cvtpk(P[BASE + 0], P[BASE + 1]), a1 = cvtpk(P[BASE + 2], P[BASE + 3]);   \
    unsigned b0 = cvtpk(P[BASE + 4], P[BASE + 5]), b1 = cvtpk(P[BASE + 6], P[BASE + 7]);                              \
    auto r0 = __builtin_amdgcn_permlane32_swap(a0, b0, false, false); auto r1 = __builtin_amdgcn_permlane32_swap(a1, b1, false, false); \
    v4u w = {r0[0], r1[0], r0[1], r1[1]}; OUT = __builtin_bit_cast(bf16x8, w); } while (0)
  PK4(p0, 0, pa0); PK4(p0, 8, pa1); PK4(p1, 0, pa2); PK4(p1, 8, pa3);
#undef PK4
}
template <int D0> __device__ __forceinline__ void pv_one(f32x16& od, int vb, bf16x8 pa0, bf16x8 pa1, bf16x8 pa2, bf16x8 pa3) {
  const s16x4 l0 = tr_read<v_rd_off(D0, 0, 0)>(vb), h0 = tr_read<v_rd_off(D0, 0, 1)>(vb), l1 = tr_read<v_rd_off(D0, 1, 0)>(vb), h1 = tr_read<v_rd_off(D0, 1, 1)>(vb);
  const s16x4 l2 = tr_read<v_rd_off(D0, 2, 0)>(vb), h2 = tr_read<v_rd_off(D0, 2, 1)>(vb), l3 = tr_read<v_rd_off(D0, 3, 0)>(vb), h3 = tr_read<v_rd_off(D0, 3, 1)>(vb);
  asm volatile("s_waitcnt lgkmcnt(0)" ::: "memory"); SBAR();
#define PKV(L, H) (bf16x8){L[0], L[1], L[2], L[3], H[0], H[1], H[2], H[3]}
  od = __builtin_amdgcn_mfma_f32_32x32x16_bf16(pa0, PKV(l0, h0), od, 0, 0, 0);
  od = __builtin_amdgcn_mfma_f32_32x32x16_bf16(pa1, PKV(l1, h1), od, 0, 0, 0);
  od = __builtin_amdgcn_mfma_f32_32x32x16_bf16(pa2, PKV(l2, h2), od, 0, 0, 0);
  od = __builtin_amdgcn_mfma_f32_32x32x16_bf16(pa3, PKV(l3, h3), od, 0, 0, 0);
#undef PKV
}
__device__ __forceinline__ void pv_d0(f32x16* o, int vb, bf16x8 pa0, bf16x8 pa1, bf16x8 pa2, bf16x8 pa3) {
  pv_one<0>(o[0], vb, pa0, pa1, pa2, pa3); pv_one<1>(o[1], vb, pa0, pa1, pa2, pa3); pv_one<2>(o[2], vb, pa0, pa1, pa2, pa3); pv_one<3>(o[3], vb, pa0, pa1, pa2, pa3);
}
struct KVStage { bf16x8 ks0, ks1, vs0, vs1; };
__device__ __forceinline__ void kv_load(KVStage& s, const bf16* Kh, const bf16* Vh, long ldk, long ldv, int k0, int sr, int sc) {
  s.ks0 = *(const bf16x8*)(Kh + (long)(k0 + sr) * ldk + sc); s.ks1 = *(const bf16x8*)(Kh + (long)(k0 + 32 + sr) * ldk + sc);
  s.vs0 = *(const bf16x8*)(Vh + (long)(k0 + sr) * ldv + sc); s.vs1 = *(const bf16x8*)(Vh + (long)(k0 + 32 + sr) * ldv + sc);
}
__device__ __forceinline__ void kv_write(const KVStage& s, LAS char* lds, int sr, int sc) {
  *(LAS bf16x8*)(lds + ATT_V_OFF + v_st(sr, sc)) = s.vs0; *(LAS bf16x8*)(lds + ATT_V_OFF + v_st(32 + sr, sc)) = s.vs1;
  *(LAS bf16x8*)(lds + ATT_K_OFF + KSWZ(sr, sc * 2)) = s.ks0; *(LAS bf16x8*)(lds + ATT_K_OFF + KSWZ(32 + sr, sc * 2)) = s.ks1;
}
struct KVDma { int ko[2], vo[2]; };
__device__ __forceinline__ void kv_dma_init(KVDma& d, int ldk, int ldv, int wid, int lane) {
#pragma unroll
  for (int i = 0; i < 2; ++i) { const int p = wid * 2 + i;
    const int row = p * 4 + (lane >> 4), cp = lane & 15; d.ko[i] = row * ldk + ((cp ^ (row & 7)) << 3);
    const int sub = p * 2 + (lane >> 5), kk = (sub >> 2) * 8 + ((lane & 31) >> 2), k = (kk & ~0xC) | ((kk & 4) << 1) | ((kk & 8) >> 1), c = (sub & 3) * 32 + (lane & 3) * 8;
    d.vo[i] = k * ldv + c; }
}
__device__ __forceinline__ void kv_dma(const KVDma& d, const bf16* Kt, const bf16* Vt, LAS char* lds, int buf, int wid) {
#pragma unroll
  for (int i = 0; i < 2; ++i) {
    __builtin_amdgcn_global_load_lds((const unsigned*)(Kt + d.ko[i]), (LAS unsigned*)(lds + buf + ATT_K_OFF + (wid * 2 + i) * 1024), 16, 0, 0);
    __builtin_amdgcn_global_load_lds((const unsigned*)(Vt + d.vo[i]), (LAS unsigned*)(lds + buf + ATT_V_OFF + (wid * 2 + i) * 1024), 16, 0, 0); }
}
__device__ __forceinline__ void rescale_o(f32x16* o, float a, LAS float* al_l, int r32, int hi) {
  if (__any(a < 1.f)) { if (hi == 0) al_l[r32] = a; LDS_WAIT();
#pragma unroll
    for (int r = 0; r < 16; ++r) { const float f = al_l[crow(r, hi)];
#pragma unroll
      for (int d = 0; d < 4; ++d) o[d][r] *= f; }
    LDS_WAIT(); }
}
constexpr float ATT_SCALE = 0.088388347648318440f, ATT_C = ATT_SCALE * 1.4426950408889634f, ATT_THR = 8.f;
__device__ __forceinline__ void softmax_tile(f32x16& p0, f32x16& p1, float& m_reg, float& l_reg, float& alpha, bool rowvalid = true) {
  float pmax = p0[0];
#pragma unroll
  for (int r = 1; r < 16; ++r) pmax = fmaxf(pmax, p0[r]);
#pragma unroll
  for (int r = 0; r < 16; ++r) pmax = fmaxf(pmax, p1[r]);
  { auto rr = __builtin_amdgcn_permlane32_swap(__float_as_uint(pmax), __float_as_uint(pmax), false, false);
    pmax = fmaxf(__uint_as_float(rr[0]), __uint_as_float(rr[1])); }
  if (!rowvalid) pmax = -__builtin_inff();
  float mn;
  if (__all(pmax - m_reg <= ATT_THR / ATT_SCALE)) { mn = m_reg; alpha = 1.f; }
  else { mn = fmaxf(m_reg, pmax); alpha = __builtin_amdgcn_exp2f((m_reg - mn) * ATT_C); m_reg = mn; }
  const float mnC = rowvalid ? -mn * ATT_C : -__builtin_inff();
#pragma unroll
  for (int r = 0; r < 16; ++r) { p0[r] = __builtin_amdgcn_exp2f(fmaf(p0[r], ATT_C, mnC)); p1[r] = __builtin_amdgcn_exp2f(fmaf(p1[r], ATT_C, mnC)); }
  float ps = 0.f;
#pragma unroll
  for (int r = 0; r < 16; ++r) ps += p0[r] + p1[r];
  { auto rr = __builtin_amdgcn_permlane32_swap(__float_as_uint(ps), __float_as_uint(ps), false, false);
    ps = __uint_as_float(rr[0]) + __uint_as_float(rr[1]); }
  l_reg = l_reg * alpha + ps;
}
__device__ __forceinline__ void attn_finish(f32x16& p0, f32x16& p1, f32x16* o, float& m_reg, float& l_reg, LAS float* wsc, int vb, int r32, int hi, bool rowvalid = true) {
  float alpha; softmax_tile(p0, p1, m_reg, l_reg, alpha, rowvalid);
  rescale_o(o, alpha, wsc, r32, hi);
  bf16x8 pa0, pa1, pa2, pa3; pack_p(p0, p1, pa0, pa1, pa2, pa3);
  pv_d0(o, vb, pa0, pa1, pa2, pa3);
}
__device__ __forceinline__ void load_q(bf16x8* qr, const bf16* Qw) {
#pragma unroll
  for (int d0 = 0; d0 < 8; ++d0) qr[d0] = *(const bf16x8*)(Qw + d0 * 16);
}

struct Frame {
    LAS unsigned char* lds;
    unsigned char* ws;
    int tid, lane, wave, G, bid;
    __device__ __forceinline__ void fresh() { int t = threadIdx.x; asm volatile("" : "+v"(t)); tid = t; lane = t & 63; wave = __builtin_amdgcn_readfirstlane(t >> 6);
        int g_ = gridDim.x, b_ = blockIdx.x; asm volatile("" : "+s"(g_), "+s"(b_)); G = g_; bid = b_; }
};
struct Args { const float* in[19]; float* out; unsigned char* ws; int ph_lo, ph_hi; };
typedef const Args __attribute__((address_space(4))) KArgs;
__device__ __forceinline__ KArgs* karg() { KArgs* p = (KArgs*)__builtin_amdgcn_kernarg_segment_ptr(); asm volatile("" : "+s"(p)); return p; }
#define KIN(i) ((const float*)karg()->in[i])
enum { IN_X = 0, IN_MEM, IN_AB_W_IN, IN_HGRN_LB, IN_HGRN_NW, IN_AB_W_OUT, IN_NSA_W_IN, IN_NSA_CMP_POS, IN_NSA_CMP_W1, IN_NSA_CMP_W2, IN_NSA_W_OUT,
       IN_XA_WQ, IN_XA_WKV, IN_XA_WO, IN_FFN_UP, IN_FFN_CONV, IN_FFN_DOWN, IN_LN_G, IN_LN_B };

__device__ __forceinline__ void p0_transpose_item(const float* W, int K, int N, bf16* WT, LAS float* scr, int item, int lane) {
    const int nblk = N / 32, kb = item / nblk, nb = item % nblk, k0 = 64 * kb, n0 = 32 * nb;
#pragma unroll 8
    for (int i = 0; i < 32; ++i) { const int kk = 2 * i + (lane >> 5); scr[kk * 33 + (lane & 31)] = W[(size_t)(k0 + kk) * N + n0 + (lane & 31)]; }
    LDS_WAIT(); asm volatile("" ::: "memory");
    const int c = lane & 7;
#pragma unroll
    for (int j = 0; j < 4; ++j) { const int n = (lane >> 3) + 8 * j; const LAS float* s = scr + (8 * c) * 33 + n;
        v4u o; o.x = pk2(s[0 * 33], s[1 * 33]); o.y = pk2(s[2 * 33], s[3 * 33]); o.z = pk2(s[4 * 33], s[5 * 33]); o.w = pk2(s[6 * 33], s[7 * 33]);
        *(GAS v4u*)(WT + (size_t)(n0 + n) * K + k0 + 8 * c) = o; }
    LDS_WAIT(); asm volatile("" ::: "memory");
}
__device__ __forceinline__ int up_col(int n) { const int isu = n >= DFF, ch = isu ? n - DFF : n; return (ch >> 7) * 256 + isu * 128 + (ch & 127); }
__device__ __forceinline__ void p0_transpose_item_fold(const float* W, int K, int N, bf16* WT, LAS float* scr, int item, int lane, const float* g, const float* b, long long* cs, long long* b2, bool upmap = false) {
    const int nblk = N / 32, kb = item / nblk, nb = item % nblk, k0 = 64 * kb, n0 = 32 * nb, n0m = upmap ? up_col(n0) : n0;
#pragma unroll 8
    for (int i = 0; i < 32; ++i) { const int kk = 2 * i + (lane >> 5); scr[kk * 33 + (lane & 31)] = W[(size_t)(k0 + kk) * N + n0 + (lane & 31)]; }
    LDS_WAIT(); asm volatile("" ::: "memory");
    const int c = lane & 7;
    const f32x4 g0 = *(const f32x4*)(g + k0 + 8 * c), g1 = *(const f32x4*)(g + k0 + 8 * c + 4), b0 = *(const f32x4*)(b + k0 + 8 * c), b1 = *(const f32x4*)(b + k0 + 8 * c + 4);
    const float gg[8] = {g0.x, g0.y, g0.z, g0.w, g1.x, g1.y, g1.z, g1.w}, bb[8] = {b0.x, b0.y, b0.z, b0.w, b1.x, b1.y, b1.z, b1.w};
#pragma unroll
    for (int j = 0; j < 4; ++j) { const int n = (lane >> 3) + 8 * j; const LAS float* s = scr + (8 * c) * 33 + n;
        float sc = 0.f, sb = 0.f; unsigned w[4];
#pragma unroll
        for (int q = 0; q < 4; ++q) { const float x0 = s[(2 * q) * 33], x1 = s[(2 * q + 1) * 33]; const unsigned r0 = f2bf(x0 * gg[2 * q]), r1 = f2bf(x1 * gg[2 * q + 1]);
            w[q] = r0 | (r1 << 16); sc += bf2f((unsigned short)r0) + bf2f((unsigned short)r1); sb += x0 * bb[2 * q] + x1 * bb[2 * q + 1]; }
        *(GAS v4u*)(WT + (size_t)(n0m + n) * K + k0 + 8 * c) = (v4u){w[0], w[1], w[2], w[3]};
        sc += __shfl_xor(sc, 1); sc += __shfl_xor(sc, 2); sc += __shfl_xor(sc, 4); sb += __shfl_xor(sb, 1); sb += __shfl_xor(sb, 2); sb += __shfl_xor(sb, 4);
        if (c == 0) { atomicAdd((unsigned long long*)(cs + n0m + n), (unsigned long long)(long long)rintf(sc * pg8::FOLD_SCALE)); atomicAdd((unsigned long long*)(b2 + n0m + n), (unsigned long long)(long long)rintf(sb * pg8::FOLD_SCALE)); } }
    LDS_WAIT(); asm volatile("" ::: "memory");
}
__device__ __forceinline__ void transpose_mat_fold(Frame& F, const float* W, int K, int N, bf16* WT, const float* g, const float* b, long long* cs, long long* b2, int c0 = 0, int nw = 1 << 30, int part = 0, int nparts = 1, bool upmap = false) {
    if (F.bid < c0 || F.bid >= c0 + nw) return;
    LAS float* scr = (LAS float*)(F.lds + RING_OFF + F.wave * 16384);
    const int nwg = nw < F.G ? nw : F.G, gw = (F.bid - c0) * NWAVES + F.wave, NGW = nwg * NWAVES;
    const int nitems = (K / 64) * (N / 32), ilo = (int)((long)nitems * part / nparts), ihi = (int)((long)nitems * (part + 1) / nparts);
    for (int it = ilo + gw; it < ihi; it += NGW) p0_transpose_item_fold(W, K, N, WT, scr, it, F.lane, g, b, cs, b2, upmap);
}
__device__ __forceinline__ void transpose_mat(Frame& F, const float* W, int K, int N, bf16* WT, int c0 = 0, int nw = 1 << 30) {
    if (F.bid < c0 || F.bid >= c0 + nw) return;
    LAS float* scr = (LAS float*)(F.lds + RING_OFF + F.wave * 16384);
    const int nwg = nw < F.G ? nw : F.G, gw = (F.bid - c0) * NWAVES + F.wave, NGW = nwg * NWAVES;
    const int nitems = (K / 64) * (N / 32);
    for (int it = gw; it < nitems; it += NGW) p0_transpose_item(W, K, N, WT, scr, it, F.lane);
}
__device__ __forceinline__ void fold_finalize(Frame& F, int lo, int n) {
    const long long* fs = (const long long*)(F.ws + WS_FOLD); float* fd = (float*)(F.ws + WS_FOLDF);
    for (int i = F.bid * NTHR + F.tid; i < 2 * n; i += F.G * NTHR) { const int j = (i < n) ? lo + i : FO_N + lo + (i - n); const long long v = fs[j]; fd[j] = (float)(int)(v >> 32) + (float)(unsigned)v * pg8::FOLD_INV; }
}
enum { CJ_DOWN0, CJ_NSA, CJ_L1A, CJ_L1B, CJ_DOWN1 };
template <int JOB>
__device__ __forceinline__ void convert_job(Frame& F, const Args& A, int c0, int nw) {
    unsigned char* ws = F.ws; long long* cs = (long long*)(ws + WS_FOLD); long long* b2 = cs + FO_N;
    if (JOB == CJ_DOWN0 || JOB == CJ_DOWN1) { const int l = JOB == CJ_DOWN1; transpose_mat(F, KIN(IN_FFN_DOWN) + (size_t)l * DFF * DM, DFF, DM, (bf16*)(ws + WS_W_DOWN) + (size_t)l * DM * DFF, c0, nw); }
    if (JOB == CJ_NSA) {
        transpose_mat_fold(F, KIN(IN_NSA_W_IN), DM, NSA_IN, (bf16*)(ws + WS_W_NSAIN), KIN(IN_LN_G) + 2 * DM, KIN(IN_LN_B) + 2 * DM, cs + FO_NSA, b2 + FO_NSA, c0, nw);
        transpose_mat(F, KIN(IN_NSA_W_OUT), DM, DM, (bf16*)(ws + WS_W_NSAOUT), c0, nw); }
    if (JOB == CJ_L1A || JOB == CJ_L1B) { const int l = 1;
        if (JOB == CJ_L1A) {
            transpose_mat_fold(F, KIN(IN_XA_WQ) + (size_t)l * DM * XW, DM, XW, (bf16*)(ws + WS_W_XQ) + (size_t)l * XW * DM, KIN(IN_LN_G) + (size_t)(3 * l) * DM, KIN(IN_LN_B) + (size_t)(3 * l) * DM, cs + FO_XQ + l * XW, b2 + FO_XQ + l * XW, c0, nw);
            transpose_mat(F, KIN(IN_XA_WKV) + (size_t)l * DM * 2 * XW, DM, 2 * XW, (bf16*)(ws + WS_W_XKV) + (size_t)l * 2 * XW * DM, c0, nw);
            transpose_mat(F, KIN(IN_XA_WO) + (size_t)l * XW * DM, XW, DM, (bf16*)(ws + WS_W_XO) + (size_t)l * DM * XW, c0, nw); }
        transpose_mat_fold(F, KIN(IN_FFN_UP) + (size_t)l * DM * DFF2, DM, DFF2, (bf16*)(ws + WS_W_UP) + (size_t)l * DFF2 * DM, KIN(IN_LN_G) + (size_t)(3 * l + 1) * DM, KIN(IN_LN_B) + (size_t)(3 * l + 1) * DM,
                           cs + FO_UP + l * DFF2, b2 + FO_UP + l * DFF2, c0, nw, JOB == CJ_L1A ? 0 : 1, 2, true); }
}
__device__ __forceinline__ void cvt_flat(Frame& F, const float* src, bf16* dst, long n8) {
    for (long i = (long)F.bid * NTHR + F.tid; i < n8; i += (long)F.G * NTHR) {
        const f32x4 a = *(const f32x4*)(src + i * 8), b = *(const f32x4*)(src + i * 8 + 4);
        v4u o; o.x = pk2(a.x, a.y); o.y = pk2(a.z, a.w); o.z = pk2(b.x, b.y); o.w = pk2(b.z, b.w);
        *(v4u*)(dst + i * 8) = o; }
}
__device__ __forceinline__ void p0_prologue(Frame& F, const Args& A) {
    unsigned char* ws = F.ws;
    long long* cs = (long long*)(ws + WS_FOLD); long long* b2 = cs + FO_N;
    transpose_mat(F, KIN(IN_AB_W_IN), DM, AB_IN, (bf16*)(ws + WS_W_ABIN));
    transpose_mat(F, KIN(IN_AB_W_OUT), DM, DM, (bf16*)(ws + WS_W_ABOUT));
    { const int l = 0;
        transpose_mat_fold(F, KIN(IN_XA_WQ) + (size_t)l * DM * XW, DM, XW, (bf16*)(ws + WS_W_XQ) + (size_t)l * XW * DM, KIN(IN_LN_G) + (size_t)(3 * l) * DM, KIN(IN_LN_B) + (size_t)(3 * l) * DM, cs + FO_XQ + l * XW, b2 + FO_XQ + l * XW);
        transpose_mat(F, KIN(IN_XA_WKV) + (size_t)l * DM * 2 * XW, DM, 2 * XW, (bf16*)(ws + WS_W_XKV) + (size_t)l * 2 * XW * DM);
        transpose_mat(F, KIN(IN_XA_WO) + (size_t)l * XW * DM, XW, DM, (bf16*)(ws + WS_W_XO) + (size_t)l * DM * XW);
        transpose_mat_fold(F, KIN(IN_FFN_UP) + (size_t)l * DM * DFF2, DM, DFF2, (bf16*)(ws + WS_W_UP) + (size_t)l * DFF2 * DM, KIN(IN_LN_G) + (size_t)(3 * l + 1) * DM, KIN(IN_LN_B) + (size_t)(3 * l + 1) * DM, cs + FO_UP + l * DFF2, b2 + FO_UP + l * DFF2, 0, 1 << 30, 0, 1, true); }
    for (int l = 0; l < 2; ++l) {
        transpose_mat(F, KIN(IN_NSA_CMP_W1) + (size_t)l * 32 * HD * HD, 32 * HD, HD, (bf16*)(ws + WS_W_C1) + (size_t)l * HD * 32 * HD);
        transpose_mat(F, KIN(IN_NSA_CMP_W2) + (size_t)l * HD * HD, HD, HD, (bf16*)(ws + WS_W_C2) + (size_t)l * HD * HD);
    }
    cvt_flat(F, KIN(IN_X), (bf16*)(ws + WS_HB), (long)MTOK * DM / 8);
    cvt_flat(F, KIN(IN_MEM), (bf16*)(ws + WS_MEMB), (long)BATCH * NMEM * DM / 8);
    { v4u z = {0u, 0u, 0u, 0u}; v4u* p = (v4u*)((bf16*)(ws + WS_W_NSAIN) + (size_t)NSA_IN * DM); const long n = (long)(NSA_INP - NSA_IN) * DM / 8;
      for (long i = (long)F.bid * NTHR + F.tid; i < n; i += (long)F.G * NTHR) p[i] = z; }
    { float* tab = (float*)(ws + WS_ROPE);
      for (int i = F.bid * NTHR + F.tid; i < SEQ * 64; i += F.G * NTHR) { const int t = i >> 6, d = i & 63;
          float sn, cs; sincosf((float)t * powf(10000.0f, -(float)d * (1.0f / 64.0f)), &sn, &cs); tab[(size_t)t * 128 + d] = cs; tab[(size_t)t * 128 + 64 + d] = sn; } }
    { const float* lbp = KIN(IN_HGRN_LB); float* lbo = (float*)(ws + WS_LB);
      for (int i = F.bid * NTHR + F.tid; i < A_W; i += F.G * NTHR) { const float a = lbp[i], b = lbp[A_W + i], m = fmaxf(a, b), ea = __expf(a - m), eb = __expf(b - m); lbo[i] = ea / (ea + eb); } }
}

__device__ __forceinline__ void ln_phase(Frame& F, const bf16* Y, const float* g, const float* b, float* h32) {
    const int gw = F.bid * NWAVES + F.wave, NGW = F.G * NWAVES;
    for (int m = gw; m < MTOK; m += NGW) {
        const v4u* yr = (const v4u*)(Y + (size_t)m * DM) + F.lane;
        float v[8][8]; float s = 0.f;
#pragma unroll
        for (int j = 0; j < 8; ++j) { const v4u x = yr[64 * j];
            v[j][0] = bflo(x.x); v[j][1] = bfhi(x.x); v[j][2] = bflo(x.y); v[j][3] = bfhi(x.y); v[j][4] = bflo(x.z); v[j][5] = bfhi(x.z); v[j][6] = bflo(x.w); v[j][7] = bfhi(x.w);
#pragma unroll
            for (int q = 0; q < 8; ++q) s += v[j][q]; }
        const float mean = wave_sum(s) * (1.f / DM); float s2 = 0.f;
#pragma unroll
        for (int j = 0; j < 8; ++j)
#pragma unroll
            for (int q = 0; q < 8; ++q) { v[j][q] -= mean; s2 += v[j][q] * v[j][q]; }
        const float rstd = 1.f / sqrtf(wave_sum(s2) * (1.f / DM) + LN_EPS);
#pragma unroll
        for (int j = 0; j < 8; ++j) { const int c0 = 8 * F.lane + 512 * j;
            const f32x4 g0 = *(const f32x4*)(g + c0), g1 = *(const f32x4*)(g + c0 + 4), b0 = *(const f32x4*)(b + c0), b1 = *(const f32x4*)(b + c0 + 4);
            f32x4 r0, r1;
            r0.x = v[j][0] * rstd * g0.x + b0.x; r0.y = v[j][1] * rstd * g0.y + b0.y; r0.z = v[j][2] * rstd * g0.z + b0.z; r0.w = v[j][3] * rstd * g0.w + b0.w;
            r1.x = v[j][4] * rstd * g1.x + b1.x; r1.y = v[j][5] * rstd * g1.y + b1.y; r1.z = v[j][6] * rstd * g1.z + b1.z; r1.w = v[j][7] * rstd * g1.w + b1.w;
            *(f32x4*)(h32 + (size_t)m * DM + c0) = r0; *(f32x4*)(h32 + (size_t)m * DM + c0 + 4) = r1; }
    }
}

__device__ __forceinline__ void cg_unpack(const v4u x, float* o) { o[0] = bflo(x.x); o[1] = bfhi(x.x); o[2] = bflo(x.y); o[3] = bfhi(x.y); o[4] = bflo(x.z); o[5] = bfhi(x.z); o[6] = bflo(x.w); o[7] = bfhi(x.w); }
__device__ __forceinline__ void convglu_fixup_phase(Frame& F, const bf16* SIDE, const float* cw, bf16* Gm) {
    constexpr int NCG = DFF / 8, NRUN = MTOK / 128;
    for (int it = F.bid * NTHR + F.tid; it < NCG * NRUN; it += F.G * NTHR) {
        const int cg = it % NCG, run = it / NCG, c0 = cg * 8, t0 = run * 128;
        float w0[8], w1[8], w2[8], am2[8], am1[8], a0[8], a1[8], u0[8], u1[8];
#pragma unroll
        for (int j = 0; j < 8; ++j) { w0[j] = cw[c0 + j]; w1[j] = cw[DFF + c0 + j]; w2[j] = cw[2 * DFF + c0 + j]; }
        const bf16* sp = SIDE + (size_t)run * 6 * DFF + c0;
        if ((t0 & (SEQ - 1)) == 0) {
#pragma unroll
            for (int j = 0; j < 8; ++j) { am2[j] = 0.f; am1[j] = 0.f; }
        } else { cg_unpack(*(const v4u*)sp, am2); cg_unpack(*(const v4u*)(sp + DFF), am1); }
        cg_unpack(*(const v4u*)(sp + 2 * DFF), a0); cg_unpack(*(const v4u*)(sp + 3 * DFF), a1); cg_unpack(*(const v4u*)(sp + 4 * DFF), u0); cg_unpack(*(const v4u*)(sp + 5 * DFF), u1);
        unsigned o0[4], o1[4];
#pragma unroll
        for (int j = 0; j < 8; j += 2) {
            const pg8::f32x2 g0 = pg8::gelu_pk((pg8::f32x2){w2[j] * a0[j] + w1[j] * am1[j] + w0[j] * am2[j], w2[j + 1] * a0[j + 1] + w1[j + 1] * am1[j + 1] + w0[j + 1] * am2[j + 1]});
            const pg8::f32x2 g1 = pg8::gelu_pk((pg8::f32x2){w2[j] * a1[j] + w1[j] * a0[j] + w0[j] * am1[j], w2[j + 1] * a1[j + 1] + w1[j + 1] * a0[j + 1] + w0[j + 1] * am1[j + 1]});
            o0[j >> 1] = pk2(g0.x * u0[j], g0.y * u0[j + 1]); o1[j >> 1] = pk2(g1.x * u1[j], g1.y * u1[j + 1]); }
        *(v4u*)(Gm + (size_t)t0 * DFF + c0) = (v4u){o0[0], o0[1], o0[2], o0[3]}; *(v4u*)(Gm + (size_t)(t0 + 1) * DFF + c0) = (v4u){o1[0], o1[1], o1[2], o1[3]};
    }
}

__device__ __forceinline__ void xattn_phase(Frame& F, const bf16* XQ, const bf16* XKV, bf16* XO) {
    const int tid = F.tid, wid = F.wave, lane = F.lane, r32 = lane & 31, hi = lane >> 5;
    LAS char* lds = (LAS char*)F.lds;
    LAS float* wsc = (LAS float*)(lds + ATT_WS_OFF + wid * 256);
    const int vb0 = (int)(uintptr_t)(lds + ATT_V_OFF) + v_rd_base(lane);
    KVDma dm; kv_dma_init(dm, 2 * XW, 2 * XW, wid, lane);
    constexpr int NU = (MTOK / 256) * XH;
    for (int u = F.bid; u < NU; u += F.G) {
        const int head = u % XH, rbk = u / XH, row0 = rbk * 256, b = row0 / SEQ;
        const bf16* Kh = XKV + (size_t)b * NMEM * 2 * XW + head * HD; const bf16* Vh = Kh + XW;
        bf16x8 qr[8]; load_q(qr, XQ + (size_t)(row0 + wid * 32 + r32) * XW + head * HD + hi * 8);
        float m_reg = -1e30f, l_reg = 0.f; f32x16 o[4] = {};
        __syncthreads();
        kv_dma(dm, Kh, Vh, lds, 0, wid);
        for (int j = 0; j < NMEM / KVBLK; ++j) {
            const int buf = (j & 1) * ATT_BUF;
            VM_WAIT(); __syncthreads();
            if (j + 1 < NMEM / KVBLK) kv_dma(dm, Kh + (size_t)(j + 1) * KVBLK * 2 * XW, Vh + (size_t)(j + 1) * KVBLK * 2 * XW, lds, ATT_BUF - buf, wid);
            f32x16 p0, p1; qkt(p0, p1, lds + buf + ATT_K_OFF, qr, r32, hi);
            float alpha; softmax_tile(p0, p1, m_reg, l_reg, alpha);
            rescale_o(o, alpha, wsc, r32, hi);
            bf16x8 pa0, pa1, pa2, pa3; pack_p(p0, p1, pa0, pa1, pa2, pa3);
            pv_d0(o, vb0 + buf, pa0, pa1, pa2, pa3);
        }
        if (hi == 0) wsc[32 + r32] = l_reg; LDS_WAIT();
        bf16* Ow = XO + (size_t)(row0 + wid * 32) * XW + head * HD;
#pragma unroll
        for (int r = 0; r < 16; ++r) { const int orow = crow(r, hi); const float rl = __builtin_amdgcn_rcpf(wsc[32 + orow]);
#pragma unroll
            for (int d0 = 0; d0 < 4; ++d0) Ow[(size_t)orow * XW + d0 * 32 + r32] = (bf16)f2bf(o[d0][r] * rl); }
        LDS_WAIT();
    }
}

template <int K>
__device__ __forceinline__ f32x4 mma_tile(const LAS char* A, int lda, const LAS char* B, int ldb, int fr, int fq) {
    f32x4 acc = {0.f, 0.f, 0.f, 0.f};
#pragma unroll
    for (int k0 = 0; k0 < K; k0 += 32) {
        const bf16x8 a = *(const LAS bf16x8*)(A + fr * lda + (k0 + 8 * fq) * 2);
        const bf16x8 b = *(const LAS bf16x8*)(B + fr * ldb + (k0 + 8 * fq) * 2);
        acc = __builtin_amdgcn_mfma_f32_16x16x32_bf16(a, b, acc, 0, 0, 0);
    }
    return acc;
}
constexpr int HG_CH = 64, HG_NC = SEQ / HG_CH, HG_ITEMS = BATCH * A_HEADS * HG_NC;
constexpr int HG_QT = 0, HG_KT = 17408, HG_KH = 34816, HG_VT = 53248, HG_PT = 71680, HG_SEG = 80896;
constexpr int HG_SP = 17408, HG_OT = 52224;
constexpr int HG_WT = 80896, HG_KHS = 86016, HG_VS = 103424;
__device__ __forceinline__ void hgrn_phase_a(Frame& F, const bf16* P0, const float* lbv, bf16* QTg, bf16* OINTRA, bf16* DS, float* DEC) {
    LAS char* lds = (LAS char*)F.lds;
    const int tid = F.tid, wid = F.wave, lane = F.lane, fr = lane & 15, fq = lane >> 4;
    const int dg = tid & 15, sq = tid >> 4;
    const int d = tid & 127, sq16 = tid >> 7;
    for (int it = F.bid; it < HG_ITEMS; it += F.G) {
        const int c = it % HG_NC, bh = it / HG_NC, h = bh % A_HEADS, b = bh / A_HEADS;
        const size_t row0 = (size_t)b * SEQ + (size_t)c * HG_CH;
        float lb[8], q[2][8], kk[2][8], cum[2][8]; v4u vraw[2];
        { const f32x4 l0 = *(const f32x4*)(lbv + h * HD + 8 * dg), l1 = *(const f32x4*)(lbv + h * HD + 8 * dg + 4);
          lb[0] = l0.x; lb[1] = l0.y; lb[2] = l0.z; lb[3] = l0.w; lb[4] = l1.x; lb[5] = l1.y; lb[6] = l1.z; lb[7] = l1.w; }
#pragma unroll
        for (int rr = 0; rr < 2; ++rr) { const bf16* rowp = P0 + (row0 + 2 * sq + rr) * AB_IN + h * HD + 8 * dg;
            const v4u zq = *(const v4u*)(rowp + A_W), qq = *(const v4u*)rowp; vraw[rr] = *(const v4u*)(rowp + 2 * A_W);
            const unsigned zw[4] = {zq.x, zq.y, zq.z, zq.w}, qw[4] = {qq.x, qq.y, qq.z, qq.w};
#pragma unroll
            for (int j = 0; j < 8; ++j) { const float z = (j & 1) ? bfhi(zw[j >> 1]) : bflo(zw[j >> 1]); q[rr][j] = (j & 1) ? bfhi(qw[j >> 1]) : bflo(qw[j >> 1]);
                const float sg = sigmoidf_(z), omlb = 1.f - lb[j]; kk[rr][j] = omlb * (1.f - sg);
                const float lf = __logf(lb[j] + omlb * sg); cum[rr][j] = rr ? cum[0][j] + lf : lf; } }
        float pre[8];
#pragma unroll
        for (int j = 0; j < 8; ++j) { const float seg = cum[1][j]; float x = seg; const float t1 = __shfl_up(x, 16); if (lane >= 16) x += t1; const float t2 = __shfl_up(x, 32); if (lane >= 32) x += t2;
            pre[j] = x - seg; if (lane >= 48) ((LAS float*)(lds + HG_WT))[wid * 128 + 8 * dg + j] = x; }
        LDS_WAIT(); __syncthreads();
        float total[8];
#pragma unroll
        for (int j = 0; j < 8; ++j) total[j] = 0.f;
#pragma unroll
        for (int w = 0; w < NWAVES; ++w) { const f32x4 a0 = *(const LAS f32x4*)(lds + HG_WT + (w * 128 + 8 * dg) * 4), a1 = *(const LAS f32x4*)(lds + HG_WT + (w * 128 + 8 * dg + 4) * 4);
            const float av[8] = {a0.x, a0.y, a0.z, a0.w, a1.x, a1.y, a1.z, a1.w};
#pragma unroll
            for (int j = 0; j < 8; ++j) { total[j] += av[j]; if (w < wid) pre[j] += av[j]; } }
#pragma unroll
        for (int rr = 0; rr < 2; ++rr) { const int s = 2 * sq + rr; unsigned qt[4], kt[4], kh[4];
#pragma unroll
            for (int j = 0; j < 8; j += 2) { const float b0 = pre[j] + cum[rr][j], b1 = pre[j + 1] + cum[rr][j + 1];
                qt[j >> 1] = pk2(q[rr][j] * __expf(b0), q[rr][j + 1] * __expf(b1));
                kt[j >> 1] = pk2(kk[rr][j] * __expf(-b0), kk[rr][j + 1] * __expf(-b1));
                kh[j >> 1] = pk2(kk[rr][j] * __expf(total[j] - b0), kk[rr][j + 1] * __expf(total[j + 1] - b1)); }
            const v4u qv = {qt[0], qt[1], qt[2], qt[3]};
            *(LAS v4u*)(lds + HG_QT + s * 272 + dg * 16) = qv; *(v4u*)(QTg + (row0 + s) * A_W + h * HD + 8 * dg) = qv;
            *(LAS v4u*)(lds + HG_KT + s * 272 + dg * 16) = (v4u){kt[0], kt[1], kt[2], kt[3]};
            *(LAS v4u*)(lds + HG_KHS + s * 272 + dg * 16) = (v4u){kh[0], kh[1], kh[2], kh[3]};
            *(LAS v4u*)(lds + HG_VS + s * 272 + dg * 16) = vraw[rr]; }
        if (sq == 31) { f32x4 e0, e1; e0.x = __expf(total[0]); e0.y = __expf(total[1]); e0.z = __expf(total[2]); e0.w = __expf(total[3]); e1.x = __expf(total[4]); e1.y = __expf(total[5]); e1.z = __expf(total[6]); e1.w = __expf(total[7]);
            *(f32x4*)(DEC + (size_t)it * HD + 8 * dg) = e0; *(f32x4*)(DEC + (size_t)it * HD + 8 * dg + 4) = e1; }
        LDS_WAIT(); __syncthreads();
        { unsigned kh[8], vt[8];
#pragma unroll
          for (int j = 0; j < 16; j += 2) { const int s = 16 * sq16 + j;
              kh[j >> 1] = (unsigned)*(const LAS unsigned short*)(lds + HG_KHS + s * 272 + d * 2) | ((unsigned)*(const LAS unsigned short*)(lds + HG_KHS + (s + 1) * 272 + d * 2) << 16);
              vt[j >> 1] = (unsigned)*(const LAS unsigned short*)(lds + HG_VS + s * 272 + d * 2) | ((unsigned)*(const LAS unsigned short*)(lds + HG_VS + (s + 1) * 272 + d * 2) << 16); }
          LAS v4u* pk = (LAS v4u*)(lds + HG_KH + d * 144 + sq16 * 32); pk[0] = (v4u){kh[0], kh[1], kh[2], kh[3]}; pk[1] = (v4u){kh[4], kh[5], kh[6], kh[7]};
          LAS v4u* pv = (LAS v4u*)(lds + HG_VT + d * 144 + sq16 * 32); pv[0] = (v4u){vt[0], vt[1], vt[2], vt[3]}; pv[1] = (v4u){vt[4], vt[5], vt[6], vt[7]}; }
        LDS_WAIT(); __syncthreads();
#pragma unroll
        for (int k = 0; k < 2; ++k) { const int tau = 2 * wid + k, ti = tau >> 2, si = tau & 3;
            f32x4 acc = {0.f, 0.f, 0.f, 0.f};
            if (si <= ti) acc = mma_tile<128>(lds + HG_QT + ti * 16 * 272, 272, lds + HG_KT + si * 16 * 272, 272, fr, fq);
#pragma unroll
            for (int i = 0; i < 4; ++i) { const int t = 16 * ti + 4 * fq + i, s = 16 * si + fr; const float v = (s <= t) ? acc[i] : 0.f;
                *(LAS unsigned short*)(lds + HG_PT + t * 144 + s * 2) = (unsigned short)f2bf(v); } }
        LDS_WAIT(); __syncthreads();
#pragma unroll
        for (int k = 0; k < 4; ++k) { const int tau = wid + 8 * k, ti = tau >> 3, vi = tau & 7;
            const f32x4 acc = mma_tile<64>(lds + HG_VT + vi * 16 * 144, 144, lds + HG_PT + ti * 16 * 144, 144, fr, fq);
            v2u w; w.x = pk2(acc[0], acc[1]); w.y = pk2(acc[2], acc[3]);
            *(v2u*)(OINTRA + (row0 + 16 * ti + fr) * A_W + h * HD + 16 * vi + 4 * fq) = w; }
#pragma unroll
        for (int k = 0; k < 8; ++k) { const int tau = wid + 8 * k, vi = tau >> 3, ki = tau & 7;
            const f32x4 acc = mma_tile<64>(lds + HG_KH + ki * 16 * 144, 144, lds + HG_VT + vi * 16 * 144, 144, fr, fq);
            v2u w; w.x = pk2(acc[0], acc[1]); w.y = pk2(acc[2], acc[3]);
            *(v2u*)(DS + ((size_t)it * HD + 16 * vi + fr) * HD + 16 * ki + 4 * fq) = w; }
        LDS_WAIT(); __syncthreads();
    }
}
__device__ __forceinline__ void hgrn_phase_b(Frame& F, const bf16* DS, const float* DEC, bf16* SPREV) {
    const int tid = F.tid, dvl = tid >> 5, dk4 = (tid & 31) * 4;
    for (int item = F.bid; item < BATCH * A_HEADS * 8; item += F.G) {
        const int sl = item & 7, bh = item >> 3, dv = sl * 16 + dvl;
        f32x4 S = {0.f, 0.f, 0.f, 0.f};
        for (int c0 = 0; c0 < HG_NC; c0 += 8) {
            f32x4 ds[8], dc[8];
#pragma unroll
            for (int k = 0; k < 8; ++k) { const size_t it = (size_t)bh * HG_NC + c0 + k; const v2u x = *(const v2u*)(DS + (it * HD + dv) * HD + dk4);
                ds[k] = (f32x4){bflo(x.x), bfhi(x.x), bflo(x.y), bfhi(x.y)}; dc[k] = *(const f32x4*)(DEC + it * HD + dk4); }
#pragma unroll
            for (int k = 0; k < 8; ++k) { const size_t it = (size_t)bh * HG_NC + c0 + k;
                v2u w; w.x = pk2(S.x, S.y); w.y = pk2(S.z, S.w); *(v2u*)(SPREV + (it * HD + dv) * HD + dk4) = w;
                S = S * dc[k] + ds[k]; }
        }
    }
}
__device__ __forceinline__ void hgrn_phase_c(Frame& F, const bf16* P0, const bf16* QTg, const bf16* OINTRA, const bf16* SPREV, const float* nw, bf16* Ob) {
    LAS char* lds = (LAS char*)F.lds;
    const int tid = F.tid, wid = F.wave, lane = F.lane, fr = lane & 15, fq = lane >> 4;
    for (int it = F.bid; it < HG_ITEMS; it += F.G) {
        const int c = it % HG_NC, bh = it / HG_NC, h = bh % A_HEADS, b = bh / A_HEADS;
        const size_t row0 = (size_t)b * SEQ + (size_t)c * HG_CH;
        { const int s = tid >> 3, ch = (tid & 7) * 16; const bf16* src = QTg + (row0 + s) * A_W + h * HD + ch;
          const v4u x0 = *(const v4u*)src, x1 = *(const v4u*)(src + 8); LAS v4u* dst = (LAS v4u*)(lds + HG_QT + s * 272 + ch * 2); dst[0] = x0; dst[1] = x1; }
        { const int dv = tid >> 2, ch = (tid & 3) * 32; const bf16* src = SPREV + ((size_t)it * HD + dv) * HD + ch;
          const v4u x0 = *(const v4u*)src, x1 = *(const v4u*)(src + 8), x2 = *(const v4u*)(src + 16), x3 = *(const v4u*)(src + 24);
          LAS v4u* dst = (LAS v4u*)(lds + HG_SP + dv * 272 + ch * 2); dst[0] = x0; dst[1] = x1; dst[2] = x2; dst[3] = x3; }
        LDS_WAIT(); __syncthreads();
#pragma unroll
        for (int k = 0; k < 4; ++k) { const int tau = wid + 8 * k, ti = tau >> 3, vi = tau & 7;
            const f32x4 acc = mma_tile<128>(lds + HG_SP + vi * 16 * 272, 272, lds + HG_QT + ti * 16 * 272, 272, fr, fq);
            const int t = 16 * ti + fr, dv = 16 * vi + 4 * fq; const v2u oi = *(const v2u*)(OINTRA + (row0 + t) * A_W + h * HD + dv);
            *(LAS f32x4*)(lds + HG_OT + (t * 132 + dv) * 4) = (f32x4){acc[0] + bflo(oi.x), acc[1] + bfhi(oi.x), acc[2] + bflo(oi.y), acc[3] + bfhi(oi.y)}; }
        LDS_WAIT(); __syncthreads();
        { const int t = tid >> 3, dv0 = (tid & 7) * 16;
          float v[16]; float ss = 0.f;
#pragma unroll
          for (int q4 = 0; q4 < 4; ++q4) { const f32x4 x = *(const LAS f32x4*)(lds + HG_OT + (t * 132 + dv0 + 4 * q4) * 4); v[4 * q4] = x.x; v[4 * q4 + 1] = x.y; v[4 * q4 + 2] = x.z; v[4 * q4 + 3] = x.w;
              ss += (x.x * x.x + x.y * x.y) + (x.z * x.z + x.w * x.w); }
          ss += __shfl_xor(ss, 1); ss += __shfl_xor(ss, 2); ss += __shfl_xor(ss, 4);
          const float r = 1.f / sqrtf(ss * (1.f / HD) + RMS_EPS);
          const bf16* gp = P0 + (row0 + t) * AB_IN + 3 * A_W + h * HD + dv0; const v4u g0 = *(const v4u*)gp, g1 = *(const v4u*)(gp + 8);
          const unsigned gw[8] = {g0.x, g0.y, g0.z, g0.w, g1.x, g1.y, g1.z, g1.w}; unsigned o[8];
#pragma unroll
          for (int j = 0; j < 8; ++j) { const float ga = bflo(gw[j]), gb = bfhi(gw[j]);
              o[j] = pk2(v[2 * j] * r * nw[dv0 + 2 * j] * ga * sigmoidf_(ga), v[2 * j + 1] * r * nw[dv0 + 2 * j + 1] * gb * sigmoidf_(gb)); }
          bf16* op = Ob + (row0 + t) * DM + h * HD + dv0; *(v4u*)op = (v4u){o[0], o[1], o[2], o[3]}; *(v4u*)(op + 8) = (v4u){o[4], o[5], o[6], o[7]}; }
        LDS_WAIT(); __syncthreads();
    }
}

constexpr float SB_CUT = -160.f;
__device__ __forceinline__ void sb_phase(Frame& F, const bf16* P0, bf16* Ob) {
    const int tid = F.tid, wid = F.wave, lane = F.lane, r32 = lane & 31, hi = lane >> 5;
    LAS char* lds = (LAS char*)F.lds;
    const int vb0 = (int)(uintptr_t)(lds + ATT_V_OFF) + v_rd_base(lane);
    KVDma dm; kv_dma_init(dm, AB_IN, AB_IN, wid, lane);
    constexpr int NQB = SEQ / 256, NU = BATCH * B_HEADS * NQB;
    for (int rd = 0; ; ++rd) {
        const int idx = (rd & 1) ? rd * F.G + (F.G - 1 - F.bid) : rd * F.G + F.bid;
        if (rd * F.G >= NU) break;
        if (idx >= NU) continue;
        const int qb = NQB - 1 - idx / (BATCH * B_HEADS), bh = idx % (BATCH * B_HEADS), head = bh % B_HEADS, b = bh / B_HEADS;
        const size_t rowb = (size_t)b * SEQ; const int q0 = qb * 256;
        const bf16* Kh = P0 + rowb * AB_IN + 4 * A_W + B_W + head * HD; const bf16* Vh = Kh + B_W;
        const int tw0 = q0 + wid * 32, t = tw0 + r32;
        bf16x8 qr[8]; load_q(qr, P0 + (rowb + t) * AB_IN + 4 * A_W + head * HD + hi * 8);
        float R = 0.f; f32x16 o[4] = {};
        const int jtop = (q0 + 254) >> 6;
        LAS unsigned* dflag = (LAS unsigned*)(lds + ATT_X_OFF);
        if (lane == 0) { dflag[wid] = 0u; dflag[8 + wid] = 0u; }
        LDS_WAIT(); __syncthreads();
        kv_dma(dm, Kh + (size_t)jtop * KVBLK * AB_IN, Vh + (size_t)jtop * KVBLK * AB_IN, lds, 0, wid);
        int buf = 0;
        for (int j = jtop; j >= 0; --j, buf = ATT_BUF - buf) {
            VM_WAIT(); __syncthreads();
            { unsigned alld = 1u;
#pragma unroll
              for (int w = 0; w < NWAVES; ++w) alld &= dflag[((j + 1) & 1) * 8 + w];
              if (__builtin_amdgcn_readfirstlane(alld)) break; }
            if (j > 0) kv_dma(dm, Kh + (size_t)(j - 1) * KVBLK * AB_IN, Vh + (size_t)(j - 1) * KVBLK * AB_IN, lds, ATT_BUF - buf, wid);
            const int k0 = j * KVBLK;
            if (k0 < tw0 + 31) {
                f32x16 p0, p1; qkt(p0, p1, lds + buf + ATT_K_OFF, qr, r32, hi);
                const bool need_mask = (k0 + 63 >= tw0);
                float L0[16], L1[16];
#pragma unroll
                for (int r = 0; r < 16; ++r) {
                    const float z0 = p0[r] * ATT_C, z1 = p1[r] * ATT_C;
                    float l0 = -(fmaxf(z0, 0.f) + __builtin_amdgcn_logf(1.f + __builtin_amdgcn_exp2f(-fabsf(z0))));
                    float l1 = -(fmaxf(z1, 0.f) + __builtin_amdgcn_logf(1.f + __builtin_amdgcn_exp2f(-fabsf(z1))));
                    if (need_mask) { if (k0 + crow(r, hi) >= t) l0 = 0.f; if (k0 + 32 + crow(r, hi) >= t) l1 = 0.f; }
                    L0[r] = l0; L1[r] = l1; p0[r] = z0 + l0; p1[r] = z1 + l1;
                }
                SBAR();
                float Sg[16];
#pragma unroll
                for (int gi = 0; gi < 4; ++gi) {
                    const float a = (L0[4 * gi] + L0[4 * gi + 1]) + (L0[4 * gi + 2] + L0[4 * gi + 3]), c = (L1[4 * gi] + L1[4 * gi + 1]) + (L1[4 * gi + 2] + L1[4 * gi + 3]);
                    auto ra = __builtin_amdgcn_permlane32_swap(__float_as_uint(a), __float_as_uint(a), false, false);
                    auto rc = __builtin_amdgcn_permlane32_swap(__float_as_uint(c), __float_as_uint(c), false, false);
                    Sg[2 * gi] = __uint_as_float(ra[0]); Sg[2 * gi + 1] = __uint_as_float(ra[1]); Sg[8 + 2 * gi] = __uint_as_float(rc[0]); Sg[8 + 2 * gi + 1] = __uint_as_float(rc[1]);
                }
                float run = R;
#pragma unroll
                for (int s = 15; s >= 0; --s) { const float tt = run; run += Sg[s]; Sg[s] = tt; }
                const float Rn = run;
                SBAR();
#pragma unroll
                for (int gi = 0; gi < 4; ++gi) {
                    float base0 = hi ? Sg[2 * gi + 1] : Sg[2 * gi], base1 = hi ? Sg[8 + 2 * gi + 1] : Sg[8 + 2 * gi];
                    float r3 = base0, r2 = r3 + L0[4 * gi + 3], r1 = r2 + L0[4 * gi + 2], r0 = r1 + L0[4 * gi + 1];
                    p0[4 * gi + 3] = __builtin_amdgcn_exp2f(p0[4 * gi + 3] + r3); p0[4 * gi + 2] = __builtin_amdgcn_exp2f(p0[4 * gi + 2] + r2);
                    p0[4 * gi + 1] = __builtin_amdgcn_exp2f(p0[4 * gi + 1] + r1); p0[4 * gi + 0] = __builtin_amdgcn_exp2f(p0[4 * gi + 0] + r0);
                    r3 = base1; r2 = r3 + L1[4 * gi + 3]; r1 = r2 + L1[4 * gi + 2]; r0 = r1 + L1[4 * gi + 1];
                    p1[4 * gi + 3] = __builtin_amdgcn_exp2f(p1[4 * gi + 3] + r3); p1[4 * gi + 2] = __builtin_amdgcn_exp2f(p1[4 * gi + 2] + r2);
                    p1[4 * gi + 1] = __builtin_amdgcn_exp2f(p1[4 * gi + 1] + r1); p1[4 * gi + 0] = __builtin_amdgcn_exp2f(p1[4 * gi + 0] + r0);
                }
                R = Rn;
                { const unsigned dn = __all(R < SB_CUT) ? 1u : 0u; if (lane == 0) dflag[(j & 1) * 8 + wid] = dn; }
                if (need_mask) {
#pragma unroll
                    for (int r = 0; r < 16; ++r) { if (k0 + crow(r, hi) >= t) p0[r] = 0.f; if (k0 + 32 + crow(r, hi) >= t) p1[r] = 0.f; }
                }
                bf16x8 pa0, pa1, pa2, pa3; pack_p(p0, p1, pa0, pa1, pa2, pa3);
                pv_d0(o, vb0 + buf, pa0, pa1, pa2, pa3);
            }
        }
        bf16* Ow = Ob + (rowb + tw0) * DM + A_W + head * HD;
#pragma unroll
        for (int r = 0; r < 16; ++r) { const int orow = crow(r, hi);
#pragma unroll
            for (int d0 = 0; d0 < 4; ++d0) Ow[(size_t)orow * DM + d0 * 32 + r32] = (bf16)f2bf(o[d0][r]); }
    }
}

constexpr int P1_KC = 4096, P1_VC = 4608, P1_KS = 5120, P1_VS = 5632, P1_KW = 6144, P1_VW = 6656, P1_GL = 7168;
__device__ __forceinline__ void nsa_rope_phase(Frame& F, const bf16* P1, const float* TAB, bf16* QROT, bf16* KSROT, bf16* KWROT, bf16* OVL) {
    const int gw = F.bid * NWAVES + F.wave, NGW = F.G * NWAVES, lane = F.lane, hsub = lane >> 3, d0 = (lane & 7) * 8;
    for (int m = gw; m < MTOK; m += NGW) {
        const int t = m & (SEQ - 1);
        const f32x4 c0 = *(const f32x4*)(TAB + (size_t)t * 128 + d0), c1 = *(const f32x4*)(TAB + (size_t)t * 128 + d0 + 4);
        const f32x4 s0 = *(const f32x4*)(TAB + (size_t)t * 128 + 64 + d0), s1 = *(const f32x4*)(TAB + (size_t)t * 128 + 64 + d0 + 4);
        const float cs[8] = {c0.x, c0.y, c0.z, c0.w, c1.x, c1.y, c1.z, c1.w}, sn[8] = {s0.x, s0.y, s0.z, s0.w, s1.x, s1.y, s1.z, s1.w};
        const bf16* row = P1 + (size_t)m * NSA_INP;
#pragma unroll
        for (int hb = 0; hb < 5; ++hb) {
            const int hh = hb * 8 + hsub;
            const bf16* src; bf16* dst;
            if (hh < 32) { src = row + hh * HD; dst = QROT + (size_t)m * DM + hh * HD; }
            else if (hh < 36) { src = row + P1_KS + (hh - 32) * HD; dst = KSROT + (size_t)m * KVW + (hh - 32) * HD; }
            else { src = row + P1_KW + (hh - 36) * HD; dst = KWROT + (size_t)m * KVW + (hh - 36) * HD; }
            const v4u a = *(const v4u*)(src + d0), bq = *(const v4u*)(src + 64 + d0);
            const unsigned aw[4] = {a.x, a.y, a.z, a.w}, bw[4] = {bq.x, bq.y, bq.z, bq.w}; unsigned o1[4], o2[4];
#pragma unroll
            for (int q = 0; q < 4; ++q) { const float x1l = bflo(aw[q]), x1h = bfhi(aw[q]), x2l = bflo(bw[q]), x2h = bfhi(bw[q]);
                o1[q] = pk2(x1l * cs[2 * q] - x2l * sn[2 * q], x1h * cs[2 * q + 1] - x2h * sn[2 * q + 1]);
                o2[q] = pk2(x2l * cs[2 * q] + x1l * sn[2 * q], x2h * cs[2 * q + 1] + x1h * sn[2 * q + 1]); }
            *(v4u*)(dst + d0) = (v4u){o1[0], o1[1], o1[2], o1[3]}; *(v4u*)(dst + 64 + d0) = (v4u){o2[0], o2[1], o2[2], o2[3]};
        }
    }
    for (int i = F.bid * NTHR + F.tid; i < NCMPP * NSLC; i += F.G * NTHR) { const int n = i / NSLC, j = i % NSLC;
        OVL[i] = (n < NCMP && n >= 4 * j - 1 && n <= 4 * j + 3) ? (bf16)0x3f80u : (bf16)0u; }
}
constexpr int CM_A = 0, CM_B = 17408, CM_H = 17408 + 34816;
__device__ __forceinline__ void nsa_compress_phase(Frame& F, const bf16* P1, const float* pos, const bf16* W1t, const bf16* W2t, bf16* KCMP, bf16* VCMP) {
    LAS char* lds = (LAS char*)F.lds;
    const int tid = F.tid, wid = F.wave, lane = F.lane, fr = lane & 15, fq = lane >> 4;
    for (int item = F.bid; item < 128; item += F.G) {
        const int nt = item & 7, g = (item >> 3) & 3, b = (item >> 5) & 1, which = item >> 6;
        const bf16* w1 = W1t + (size_t)which * HD * 32 * HD; const bf16* w2 = W2t + (size_t)which * HD * HD;
        const float* posw = pos + (size_t)which * 32 * HD;
        f32x4 acc[4];
#pragma unroll
        for (int k = 0; k < 4; ++k) acc[k] = (f32x4){0.f, 0.f, 0.f, 0.f};
        for (int l = 0; l < 32; ++l) {
            { const int r = tid >> 3, ch = (tid & 7) * 16, n = nt * 64 + r; unsigned w[8];
              if (n < NCMP) { const bf16* src = P1 + ((size_t)b * SEQ + 16 * n + l) * NSA_INP + P1_KC + which * KVW + g * HD + ch;
                  const v4u x0 = *(const v4u*)src, x1 = *(const v4u*)(src + 8); const unsigned xs[8] = {x0.x, x0.y, x0.z, x0.w, x1.x, x1.y, x1.z, x1.w};
#pragma unroll
                  for (int q = 0; q < 8; ++q) w[q] = pk2(bflo(xs[q]) + posw[l * HD + ch + 2 * q], bfhi(xs[q]) + posw[l * HD + ch + 2 * q + 1]);
              } else {
#pragma unroll
                  for (int q = 0; q < 8; ++q) w[q] = 0u; }
              LAS v4u* dst = (LAS v4u*)(lds + CM_A + r * 272 + ch * 2); dst[0] = (v4u){w[0], w[1], w[2], w[3]}; dst[1] = (v4u){w[4], w[5], w[6], w[7]}; }
            { const int e = tid >> 2, ch = (tid & 3) * 32; const bf16* src = w1 + (size_t)e * 32 * HD + l * HD + ch;
              const v4u x0 = *(const v4u*)src, x1 = *(const v4u*)(src + 8), x2 = *(const v4u*)(src + 16), x3 = *(const v4u*)(src + 24);
              LAS v4u* dst = (LAS v4u*)(lds + CM_B + e * 272 + ch * 2); dst[0] = x0; dst[1] = x1; dst[2] = x2; dst[3] = x3; }
            LDS_WAIT(); __syncthreads();
#pragma unroll
            for (int k = 0; k < 4; ++k) { const int tau = wid + 8 * k, ni = tau >> 3, ei = tau & 7;
                acc[k] += mma_tile<128>(lds + CM_A + ni * 16 * 272, 272, lds + CM_B + ei * 16 * 272, 272, fr, fq); }
            LDS_WAIT(); __syncthreads();
        }
#pragma unroll
        for (int k = 0; k < 4; ++k) { const int tau = wid + 8 * k, ni = tau >> 3, ei = tau & 7;
#pragma unroll
            for (int i = 0; i < 4; ++i) *(LAS unsigned short*)(lds + CM_H + (16 * ni + 4 * fq + i) * 272 + (16 * ei + fr) * 2) = (unsigned short)f2bf(gelu1(acc[k][i])); }
        { const int f = tid >> 2, ch = (tid & 3) * 32; const bf16* src = w2 + (size_t)f * HD + ch;
          const v4u x0 = *(const v4u*)src, x1 = *(const v4u*)(src + 8), x2 = *(const v4u*)(src + 16), x3 = *(const v4u*)(src + 24);
          LAS v4u* dst = (LAS v4u*)(lds + CM_B + f * 272 + ch * 2); dst[0] = x0; dst[1] = x1; dst[2] = x2; dst[3] = x3; }
        LDS_WAIT(); __syncthreads();
        bf16* outp = which ? VCMP : KCMP;
#pragma unroll
        for (int k = 0; k < 4; ++k) { const int tau = wid + 8 * k, ni = tau >> 3, fi = tau & 7;
            const f32x4 a2 = mma_tile<128>(lds + CM_H + ni * 16 * 272, 272, lds + CM_B + fi * 16 * 272, 272, fr, fq);
#pragma unroll
            for (int i = 0; i < 4; ++i) { const int n = nt * 64 + 16 * ni + 4 * fq + i;
                outp[(((size_t)b * NCMPP + n) * NSA_G + g) * HD + 16 * fi + fr] = (n < NCMP) ? (bf16)f2bf(a2[i]) : (bf16)0u; } }
        LDS_WAIT(); __syncthreads();
    }
}
__device__ __forceinline__ unsigned topk_key(float v) { const unsigned u = (v == 0.f) ? 0u : __builtin_bit_cast(unsigned, v); return u ^ ((u >> 31) ? 0xffffffffu : 0x80000000u); }
__device__ __forceinline__ v4u topk_select(float a0, float a1, int cur, int lane) {
    const unsigned k0 = topk_key(a0), k1 = topk_key(a1);
    const int j0 = lane, j1 = lane + 64;
    const bool f0 = (j0 == 0) || (j0 == cur) || (j0 == cur - 1), f1 = (j1 == cur) || (j1 == cur - 1);
    const unsigned long long c0m = __ballot(!f0 && j0 <= cur), c1m = __ballot(!f1 && j1 <= cur);
    const int nforced = cur >= 2 ? 3 : cur + 1, slots = NTOP - nforced;
    unsigned long long s0m = c0m, s1m = c1m;
    if (__builtin_popcountll(c0m) + __builtin_popcountll(c1m) > slots) {
        unsigned T = 0u;
#pragma nounroll
        for (int bit = 31; bit >= 0; --bit) { const unsigned trial = T | (1u << bit);
            const int cnt = __builtin_popcountll(__ballot(k0 >= trial) & c0m) + __builtin_popcountll(__ballot(k1 >= trial) & c1m);
            if (cnt >= slots) T = trial; }
        unsigned long long e0 = __ballot(k0 == T) & c0m, e1 = __ballot(k1 == T) & c1m;
        s0m = __ballot(k0 > T) & c0m; s1m = __ballot(k1 > T) & c1m;
        int need = slots - __builtin_popcountll(s0m) - __builtin_popcountll(s1m);
        while (need > 0 && e0) { const unsigned long long b = e0 & (~e0 + 1ull); s0m |= b; e0 ^= b; --need; }
        while (need > 0 && e1) { const unsigned long long b = e1 & (~e1 + 1ull); s1m |= b; e1 ^= b; --need; }
    }
    const unsigned long long m0 = s0m | __ballot(f0 && j0 <= cur), m1 = s1m | __ballot(f1 && j1 <= cur);
    return (v4u){(unsigned)m0, (unsigned)(m0 >> 32), (unsigned)m1, (unsigned)(m1 >> 32)};
}
__device__ __forceinline__ unsigned pick4(const unsigned (&a)[4], int i) { return i == 0 ? a[0] : (i == 1 ? a[1] : (i == 2 ? a[2] : a[3])); }
template <int MODE>
__device__ __forceinline__ void nsa_attn_phase(Frame& F, const bf16* P1, const bf16* Qsrc, const bf16* Ksrc, const bf16* Vsrc, const unsigned* SEL, float* O32, unsigned* IMPO, bf16* Ob, bool probe_nostore = false) {
    const int tid = F.tid, wid = F.wave, lane = F.lane, r32 = lane & 31, hi = lane >> 5;
    LAS char* lds = (LAS char*)F.lds;
    LAS float* wsc = (LAS float*)(lds + ATT_WS_OFF + wid * 256);
    const int vb0 = (int)(uintptr_t)(lds + ATT_V_OFF) + v_rd_base(lane);
    KVDma dm; kv_dma_init(dm, MODE <= 1 ? NSA_G * HD : KVW, MODE == 0 ? NSA_G * HD : (MODE == 1 ? NSLC : NSA_INP), wid, lane);
    constexpr int NTB = SEQ / 32, NU = BATCH * NSA_G * NTB;
    for (int rd = 0; ; ++rd) {
        int idx;
        { idx = (rd & 1) ? rd * F.G + (F.G - 1 - F.bid) : rd * F.G + F.bid; if (rd * F.G >= NU) break; if (idx >= NU) continue; }
        const int tb = NTB - 1 - idx / (BATCH * NSA_G), bg = idx % (BATCH * NSA_G), g = bg % NSA_G, b = bg / NSA_G;
        const size_t rowb = (size_t)b * SEQ; const int t0 = tb * 32;
        const int t = (MODE == 2) ? t0 + 4 * wid + (r32 >> 3) : t0 + r32, head = (MODE == 2) ? g * NSA_R + (r32 & 7) : g * NSA_R + wid;
        const bf16* Kh; const bf16* Vh; long ldk, ldv; int jlo, jhi;
        if (MODE <= 1) { Kh = Ksrc + ((size_t)b * NCMPP * NSA_G + g) * HD; ldk = NSA_G * HD; jlo = 0; jhi = (t0 >> 4) >> 6;
            if (MODE == 0) { Vh = Vsrc + ((size_t)b * NCMPP * NSA_G + g) * HD; ldv = NSA_G * HD; } else { Vh = Vsrc; ldv = NSLC; } }
        else { Kh = Ksrc + rowb * KVW + g * HD; ldk = KVW; Vh = P1 + rowb * NSA_INP + (MODE == 2 ? P1_VS : P1_VW) + g * HD; ldv = NSA_INP;
            jhi = (t0 + 31) >> 6; jlo = (MODE == 2) ? 0 : ((t0 - (WINDOW - 1) > 0 ? t0 - (WINDOW - 1) : 0) >> 6); }
        unsigned wn[4] = {~0u, ~0u, ~0u, ~0u};
        if (MODE == 2) { const v4u sv = *(const v4u*)(SEL + ((rowb + t) * NSA_G + g) * 4); unsigned selw[4]; selw[0] = sv.x; selw[1] = sv.y; selw[2] = sv.z; selw[3] = sv.w;
            *(LAS v4u*)(lds + ATT_X_OFF + 2048 + (wid * 64 + lane) * 16) = sv;
            LAS unsigned* un = (LAS unsigned*)(lds + ATT_X_OFF);
#pragma unroll
            for (int q = 0; q < 4; ++q) { unsigned x = selw[q]; x |= __shfl_xor(x, 8); x |= __shfl_xor(x, 16); wn[q] = __builtin_amdgcn_readfirstlane(x); if (lane == 0) un[wid * 4 + q] = wn[q]; }
            LDS_WAIT(); __syncthreads();
            LAS int* plist = (LAS int*)(lds + ATT_X_OFF + 128);
            if (wid == 0) {
                unsigned m0 = 0u, m1 = 0u;
                int lane_l = lane; asm volatile("" : "+v"(lane_l));
                const LAS unsigned* ub = un + (lane_l >> 5);
#pragma unroll
                for (int w = 0; w < NWAVES; ++w) { m0 |= ((ub[w * 4] >> (lane & 31)) & 1u) << w; m1 |= ((ub[w * 4 + 2] >> (lane & 31)) & 1u) << w; }
                bool v0 = m0 != 0u && lane <= jhi, v1 = m1 != 0u && lane + 64 <= jhi; int np = 0;
                for (;;) {
                    const unsigned long long a0 = __ballot(v0), a1 = __ballot(v1);
                    if (!(a0 | a1)) break;
                    const int ja_ = a0 ? __builtin_ctzll(a0) : 64 + __builtin_ctzll(a1);
                    const unsigned ma = (ja_ < 64) ? (unsigned)__shfl((int)m0, ja_) : (unsigned)__shfl((int)m1, ja_ - 64);
                    if (lane == (ja_ & 63)) { if (ja_ < 64) v0 = false; else v1 = false; }
                    unsigned long long c0 = __ballot(v0 && !(m0 & ma)), c1 = __ballot(v1 && !(m1 & ma));
                    if (!(c0 | c1)) { c0 = __ballot(v0 && m0 == 0xffu); c1 = __ballot(v1 && m1 == 0xffu); }
                    if (!(c0 | c1)) { c0 = __ballot(v0); c1 = __ballot(v1); }
                    int jb_ = -1;
                    if (c0 | c1) { jb_ = c0 ? __builtin_ctzll(c0) : 64 + __builtin_ctzll(c1); if (lane == (jb_ & 63)) { if (jb_ < 64) v0 = false; else v1 = false; } }
                    if (lane == 0) { plist[2 * np] = ja_; plist[2 * np + 1] = jb_; }
                    ++np;
                }
                if (lane == 0) { int neg1 = -1; asm volatile("" : "+v"(neg1)); plist[2 * np] = neg1; plist[2 * np + 1] = neg1; }
            }
            LDS_WAIT(); }
        bf16x8 qr[8]; load_q(qr, Qsrc + (rowb + t) * (MODE <= 1 ? NSA_INP : DM) + head * HD + hi * 8);
        float m_reg = -1e30f, l_reg = 0.f; f32x16 o[4] = {};
        const int cur = t >> 6;
#define NSA_NEED(jj) (MODE != 2 || ((pick4(wn, (jj) >> 5) >> ((jj) & 31)) & 1u))
#define NSA_MASK(P0, P1, JJ) do { const int k0 = (JJ) * KVBLK; constexpr float NINF = -__builtin_inff(); \
            if (MODE <= 1) { if (!(16 * (k0 + 63) + 31 <= t0)) { \
                    _Pragma("unroll") for (int r = 0; r < 16; ++r) { if (!(16 * (k0 + crow(r, hi)) + 31 <= t)) P0[r] = NINF; if (!(16 * (k0 + 32 + crow(r, hi)) + 31 <= t)) P1[r] = NINF; } } } \
            else if (MODE == 2) { rv_ = (*(const LAS unsigned*)(lds + ATT_X_OFF + 2048 + (wid * 64 + lane) * 16 + ((JJ) >> 5) * 4) >> ((JJ) & 31)) & 1u;     \
                if ((JJ) >= cur) { const int lim = t - k0 - 4 * hi;                          \
                    _Pragma("unroll") for (int r = 0; r < 16; ++r) { if ((r & 3) + 8 * (r >> 2) > lim) P0[r] = NINF; if (32 + (r & 3) + 8 * (r >> 2) > lim) P1[r] = NINF; } } } \
            else { if (!((k0 > t0 + 31 - WINDOW) && (k0 + 63 <= t0))) { \
                    _Pragma("unroll") for (int r = 0; r < 16; ++r) { const int ka = k0 + crow(r, hi), kb = ka + 32; \
                        if (!(ka <= t && ka > t - WINDOW)) P0[r] = NINF; if (!(kb <= t && kb > t - WINDOW)) P1[r] = NINF; } } } } while (0)
        const int pbase = __builtin_amdgcn_readfirstlane((int)(uintptr_t)(lds + ATT_X_OFF + 128)); int pp = 0;
#define PLIST(i) (*(const LAS int*)(uintptr_t)(unsigned)(pbase + 4 * (i)))
        int ja, jb;
        __syncthreads();
        if (MODE == 2) { ja = PLIST(0); jb = PLIST(1); ja = __builtin_amdgcn_readfirstlane(ja); jb = __builtin_amdgcn_readfirstlane(jb); if (ja < 0) ja = jhi + 1; }
        else { ja = jlo; jb = ja + 1; if (jb > jhi) jb = -1; }
        if (ja <= jhi) kv_dma(dm, Kh + (size_t)ja * KVBLK * ldk, Vh + (size_t)ja * KVBLK * ldv, lds, 0, wid);
        if (jb >= 0) kv_dma(dm, Kh + (size_t)jb * KVBLK * ldk, Vh + (size_t)jb * KVBLK * ldv, lds, ATT_BUF, wid);
        int set = 0;
#pragma nounroll
        while (ja <= jhi) {
            int jc, jd;
            if (MODE == 2) { ++pp; jc = PLIST(2 * pp); jd = PLIST(2 * pp + 1); jc = __builtin_amdgcn_readfirstlane(jc); jd = __builtin_amdgcn_readfirstlane(jd); if (jc < 0) jc = jhi + 1; }
            else { jc = (jb >= 0 ? jb : ja) + 1; jd = jc + 1; if (jd > jhi) jd = -1; }
            VM_WAIT(); __syncthreads();
            if (jc <= jhi) kv_dma(dm, Kh + (size_t)jc * KVBLK * ldk, Vh + (size_t)jc * KVBLK * ldv, lds, ATT_SET - set, wid);
            if (jc <= jhi && jd >= 0) kv_dma(dm, Kh + (size_t)jd * KVBLK * ldk, Vh + (size_t)jd * KVBLK * ldv, lds, ATT_SET - set + ATT_BUF, wid);
            const bool nA = NSA_NEED(ja), nB = (jb >= 0) && NSA_NEED(jb);
            f32x16 a0, a1, b0, b1;
            if (nA) qkt(a0, a1, lds + set + ATT_K_OFF, qr, r32, hi);
            if (nB) qkt(b0, b1, lds + set + ATT_BUF + ATT_K_OFF, qr, r32, hi);
            bool rv_ = true;
            if (nA) { NSA_MASK(a0, a1, ja); attn_finish(a0, a1, o, m_reg, l_reg, wsc, vb0 + set, r32, hi, rv_); }
            if (nB) { NSA_MASK(b0, b1, jb); attn_finish(b0, b1, o, m_reg, l_reg, wsc, vb0 + set + ATT_BUF, r32, hi, rv_); }
            ja = jc; jb = (jc <= jhi) ? jd : -1; set = ATT_SET - set;
        }
#undef PLIST
#undef NSA_MASK
#undef NSA_NEED
        { float fac = l_reg > 0.f ? __builtin_amdgcn_rcpf(l_reg) : 0.f;
          if (MODE != 1) { const int br = MODE == 0 ? 0 : (MODE == 2 ? 1 : 2); fac *= sigmoidf_(bf2f(P1[(rowb + t) * NSA_INP + P1_GL + head * 3 + br])); }
          if (hi == 0) wsc[32 + r32] = fac; LDS_WAIT(); }
        if (MODE == 1) {
            float fc[16];
#pragma unroll
            for (int r = 0; r < 16; ++r) fc[r] = wsc[32 + crow(r, hi)];
            LDS_WAIT(); __syncthreads();
#pragma unroll
            for (int r = 0; r < 16; ++r) { const int orow = crow(r, hi);
#pragma unroll
                for (int d0 = 0; d0 < 4; ++d0) *(LAS float*)(lds + ((wid * 32 + orow) * 128 + d0 * 32 + r32) * 4) = o[d0][r] * fc[r]; }
            LDS_WAIT(); __syncthreads();
            { const int tok = tid >> 4, j8 = (tid & 15) * 8; f32x4 s0 = {0.f, 0.f, 0.f, 0.f}, s1 = {0.f, 0.f, 0.f, 0.f};
#pragma unroll
              for (int w = 0; w < 8; ++w) { const LAS f32x4* pp = (const LAS f32x4*)(lds + ((w * 32 + tok) * 128 + j8) * 4); s0 += pp[0]; s1 += pp[1]; }
              LAS f32x4* dst = (LAS f32x4*)(lds + (tok * 128 + j8) * 4); dst[0] = s0; dst[1] = s1; }
            LDS_WAIT(); __syncthreads();
#pragma nounroll
            for (int q = 0; q < 4; ++q) { const int tok = 4 * wid + q, tt = t0 + tok;
                const float a0 = *(const LAS float*)(lds + (tok * 128 + lane) * 4), a1 = *(const LAS float*)(lds + (tok * 128 + 64 + lane) * 4);
                const v4u w = topk_select(a0, a1, tt >> 6, lane);
                if (lane == 0) *(v4u*)(IMPO + ((rowb + tt) * NSA_G + g) * 4) = w; }
            LDS_WAIT(); __syncthreads();
        } else {
#pragma unroll
            for (int r = 0; r < 16; ++r) { const int orow = crow(r, hi); const float fc = wsc[32 + orow];
                const size_t off = (MODE == 2) ? (rowb + t0 + 4 * wid + (orow >> 3)) * DM + (g * NSA_R + (orow & 7)) * HD + r32 : (rowb + t0 + orow) * DM + head * HD + r32;
#pragma unroll
                for (int d0 = 0; d0 < 4; ++d0) {
                    if (MODE == 0) Ob[off + d0 * 32] = (bf16)f2bf(o[d0][r] * fc);
                    else if (MODE == 3) { if (!probe_nostore) Ob[off + d0 * 32] = (bf16)f2bf(bf2f(Ob[off + d0 * 32]) + o[d0][r] * fc); }
                    else Ob[off + d0 * 32] = (bf16)f2bf(bf2f(Ob[off + d0 * 32]) + o[d0][r] * fc); } }
            LDS_WAIT();
        }
    }
}

#ifndef STAGE
#define STAGE 3
#endif
#define ZERO_OB_PHASE PH_BEGIN { v4u z = {0u, 0u, 0u, 0u}; v4u* p = (v4u*)Ob; const long n = (long)MTOK * DM / 8; \
            for (long i = (long)F.bid * NTHR + F.tid; i < n; i += (long)F.G * NTHR) p[i] = z; } PH_END
#define MIXER0_PHASES \
    PH_BEGIN { fold_finalize(F, FO_XQ, XW); fold_finalize(F, FO_UP, DFF2); } \
             REP(10) hgrn_phase_a(F, BIG, (const float*)(ws + WS_LB), (bf16*)(ws + WS_QT), (bf16*)(ws + WS_OINTRA), (bf16*)(ws + WS_DS), (float*)(ws + WS_DEC)); \
             REP(11) sb_phase(F, BIG, Ob); PH_END \
    PH_BEGIN REP(12) hgrn_phase_b(F, (const bf16*)(ws + WS_DS), (const float*)(ws + WS_DEC), (bf16*)(ws + WS_SPREV)); PH_END \
    PH_BEGIN REP(13) hgrn_phase_c(F, BIG, (const bf16*)(ws + WS_QT), (const bf16*)(ws + WS_OINTRA), (const bf16*)(ws + WS_SPREV), KIN(IN_HGRN_NW), Ob); PH_END
#if STAGE <= 2
#define MIXER1_PHASES ZERO_OB_PHASE
#else
#define MIXER1_PHASES \
    PH_BEGIN { fold_finalize(F, FO_XQ + XW, XW); } REP(14) { nsa_rope_phase(F, BIG, (const float*)(ws + WS_ROPE), (bf16*)(ws + WS_QROT), (bf16*)(ws + WS_KSROT), (bf16*)(ws + WS_KWROT), (bf16*)(ws + WS_OVL)); \
             nsa_compress_phase(F, BIG, KIN(IN_NSA_CMP_POS), (const bf16*)(ws + WS_W_C1), (const bf16*)(ws + WS_W_C2), (bf16*)(ws + WS_KCMP), (bf16*)(ws + WS_VCMP)); } PH_END \
    PH_BEGIN { REP(15) nsa_attn_phase<0>(F, BIG, BIG, (const bf16*)(ws + WS_KCMP), (const bf16*)(ws + WS_VCMP), nullptr, nullptr, nullptr, Ob); \
             F.fresh(); REP(15) nsa_attn_phase<1>(F, BIG, BIG, (const bf16*)(ws + WS_KCMP), (const bf16*)(ws + WS_OVL), nullptr, nullptr, (unsigned*)(ws + WS_SEL), nullptr); \
             F.fresh(); REP(17) nsa_attn_phase<3>(F, BIG, (const bf16*)(ws + WS_QROT), (const bf16*)(ws + WS_KWROT), nullptr, nullptr, nullptr, nullptr, Ob, r_ > 0); } PH_END \
    PH_BEGIN REP(18) nsa_attn_phase<2>(F, BIG, (const bf16*)(ws + WS_QROT), (const bf16*)(ws + WS_KSROT), nullptr, (const unsigned*)(ws + WS_SEL), nullptr, nullptr, Ob); PH_END
#endif
#ifndef REPMASK
#define REPMASK 0u
#endif
#define REP(gid) for (int r_ = 0; r_ <= (int)((REPMASK >> (gid)) & 1u); ++r_)
#define PH_BEGIN if (pc >= lo && pc < hi) { F.fresh();
#if (REPMASK >> 23) & 1
#define PH_END   if (pc + 1 < hi) { const unsigned long long tb0_ = __builtin_amdgcn_s_memrealtime(); XcdBarrier bb_ = bar; asm volatile("" : "+s"(bb_.bar), "+s"(bb_.x)); xcd_barrier(bb_); \
        const unsigned w_ = (unsigned)(__builtin_amdgcn_s_memrealtime() - tb0_); tbar_acc += w_; if (threadIdx.x == 0) { atomicMax((unsigned*)(args.ws + 3 * MiB) + pc, 0x7fffffffu - w_); atomicMax((unsigned*)(args.ws + 3 * MiB) + 256 + pc, w_); } } } ++pc;
#else
#define PH_END   if (pc + 1 < hi) { XcdBarrier bb_ = bar; asm volatile("" : "+s"(bb_.bar), "+s"(bb_.x)); xcd_barrier(bb_); } } ++pc;
#endif
template <int l>
__device__ __forceinline__ void layer_body(Frame& F, const Args& args, const XcdBarrier& bar, int& pc, const int lo, const int hi, unsigned long long& tbar_acc) {
    unsigned char* ws = F.ws;
    bf16* HB = (bf16*)(ws + WS_HB); bf16* Y = (bf16*)(ws + WS_Y); float* H32 = (float*)karg()->out;
    bf16* BIG = (bf16*)(ws + WS_BIG); bf16* Gm = (bf16*)(ws + WS_G); bf16* Ob = (bf16*)(ws + WS_O);
    bf16* XQ = (bf16*)(ws + WS_XQ); bf16* XO = (bf16*)(ws + WS_XO);
#define RS(k) ((long long*)(ws + WS_RSUM) + (size_t)(k) * MTOK * 2)
#define LNG(k) (KIN(IN_LN_G) + (size_t)(k) * DM)
#define LNB(k) (KIN(IN_LN_B) + (size_t)(k) * DM)
    const float* cs = (const float*)(ws + WS_FOLDF); const float* b2 = cs + FO_N;
        PH_BEGIN REP(1) {
            const int N = l == 0 ? AB_IN : NSA_INP;
            pg8::StaticOrder S; S.init(MTOK, N, F.G, F.bid);
            if (l == 0) { pg8::Gemm g{HB, (const bf16*)(ws + WS_W_ABIN), MTOK, N, DM}; pg8::EpiBf16<0> E{BIG, N, nullptr, 0, 0, 1.f};
                pg8::gemm_phase<pg8::EpiBf16<0>, pg8::StaticOrder, PG8_ALIGN, PG8_SP2>(F.lds + RING_OFF, g, S, E); }
            else { pg8::Gemm g{Y, (const bf16*)(ws + WS_W_NSAIN), MTOK, N, DM}; pg8::EpiBf16Ln E{BIG, N, RS(2), cs + FO_NSA, b2 + FO_NSA};
                pg8::gemm_phase<pg8::EpiBf16Ln, pg8::StaticOrder, PG8_ALIGN, PG8_SP2>(F.lds + RING_OFF, g, S, E);
                if (r_ == 0) convert_job<CJ_L1A>(F, args, 64, 192); }
        } PH_END
#if STAGE <= 1
        ZERO_OB_PHASE
#else
        if (l == 0) {
            MIXER0_PHASES
        } else {
            MIXER1_PHASES
        }
#endif
        PH_BEGIN REP(2) {
            pg8::Gemm g{Ob, l == 0 ? (const bf16*)(ws + WS_W_ABOUT) : (const bf16*)(ws + WS_W_NSAOUT), MTOK, DM, DM};
            pg8::StaticOrder S; S.init(MTOK, DM, F.G, F.bid);
            if (l == 0) { pg8::EpiRes0 E{Y, HB, DM, DN_ALPHA, RS(0)};
                pg8::gemm_phase<pg8::EpiRes0, pg8::StaticOrder, PG8_ALIGN, PG8_SP2>(F.lds + RING_OFF, g, S, E); }
            else { pg8::EpiResLn2 E{Y, RS(2), LNG(2), LNB(2), DM, DN_ALPHA, RS(3)};
                pg8::gemm_phase<pg8::EpiResLn2, pg8::StaticOrder, PG8_ALIGN, PG8_SP2>(F.lds + RING_OFF, g, S, E); }
        } PH_END
        PH_BEGIN REP(3) {
            {   pg8::Gemm g{Y, (const bf16*)(ws + WS_W_XQ) + (size_t)l * XW * DM, MTOK, XW, DM};
                pg8::RangeOrder S; S.init(MTOK, XW, 0, 128, F.bid);
                pg8::EpiBf16Ln E{XQ, XW, RS(3 * l), cs + FO_XQ + l * XW, b2 + FO_XQ + l * XW};
                pg8::gemm_phase<pg8::EpiBf16Ln, pg8::RangeOrder, PG8_ALIGN, PG8_SP2>(F.lds + RING_OFF, g, S, E); }
            {   pg8::Gemm g{(const bf16*)(ws + WS_MEMB), (const bf16*)(ws + WS_W_XKV) + (size_t)l * 2 * XW * DM, BATCH * NMEM, 2 * XW, DM};
                pg8::RangeOrder S; S.init(BATCH * NMEM, 2 * XW, 128, 8, F.bid);
                pg8::EpiBf16<0> E{(bf16*)(ws + WS_XKV) + (size_t)l * BATCH * NMEM * 2 * XW, 2 * XW, nullptr, 0, 0, 1.f};
                pg8::gemm_phase<pg8::EpiBf16<0>, pg8::RangeOrder, PG8_ALIGN, PG8_SP2>(F.lds + RING_OFF, g, S, E); }
            if (r_ == 0) { if (l == 0) convert_job<CJ_DOWN0>(F, args, 136, 120); else convert_job<CJ_L1B>(F, args, 136, 120); }
        } PH_END
        PH_BEGIN { if (l == 1) fold_finalize(F, FO_UP + DFF2, DFF2); } REP(9) xattn_phase(F, XQ, (const bf16*)(ws + WS_XKV) + (size_t)l * BATCH * NMEM * 2 * XW, XO); PH_END
        PH_BEGIN REP(4) {
            pg8::Gemm g{XO, (const bf16*)(ws + WS_W_XO) + (size_t)l * DM * XW, MTOK, DM, XW};
            pg8::StaticOrder S; S.init(MTOK, DM, F.G, F.bid);
            pg8::EpiResLn2 E{Y, RS(3 * l), LNG(3 * l), LNB(3 * l), DM, DN_ALPHA, RS(3 * l + 1)};
            pg8::gemm_phase<pg8::EpiResLn2, pg8::StaticOrder, PG8_ALIGN, PG8_SP2>(F.lds + RING_OFF, g, S, E);
        } PH_END
        PH_BEGIN REP(5) {
#if (REPMASK >> 22) & 1
            if (r_ > 0) { XcdBarrier bb_ = bar; asm volatile("" : "+s"(bb_.bar), "+s"(bb_.x)); xcd_barrier(bb_); }
#endif
            pg8::Gemm g{Y, (const bf16*)(ws + WS_W_UP) + (size_t)l * DFF2 * DM, MTOK, DFF2, DM};
            pg8::StaticOrder S; S.init(MTOK, DFF2, F.G, F.bid);
            pg8::EpiConvGlu E{Gm, (bf16*)(ws + WS_SIDE), RS(3 * l + 1), cs + FO_UP + l * DFF2, b2 + FO_UP + l * DFF2, KIN(IN_FFN_CONV) + (size_t)l * 3 * DFF, DFF};
            pg8::gemm_phase<pg8::EpiConvGlu, pg8::StaticOrder, PG8_ALIGN, PG8_SP2>(F.lds + RING_OFF, g, S, E);
            if (r_ == 0) { if (l == 0) convert_job<CJ_NSA>(F, args, 128, 128); else convert_job<CJ_DOWN1>(F, args, 128, 128); }
        } PH_END
#if (REPMASK >> 20) & 1
        PH_BEGIN {
            pg8::Gemm g{HB, (const bf16*)(ws + WS_W_UP) + (size_t)l * DFF2 * DM, MTOK, DFF2, DM};
            pg8::ZeroOrder S; S.init(MTOK, DFF2, F.G, F.bid);
            pg8::EpiBf16<0> E{Gm, DFF2, nullptr, 0, 0, 1.f};
            pg8::gemm_phase<pg8::EpiBf16<0>, pg8::ZeroOrder, PG8_ALIGN, PG8_SP2>(F.lds + RING_OFF, g, S, E);
        } PH_END
#endif
        PH_BEGIN { if (l == 0) fold_finalize(F, FO_NSA, NSA_INP); } REP(8) convglu_fixup_phase(F, (const bf16*)(ws + WS_SIDE), KIN(IN_FFN_CONV) + (size_t)l * 3 * DFF, Gm); PH_END
        PH_BEGIN REP(6) {
            pg8::Gemm g{Gm, (const bf16*)(ws + WS_W_DOWN) + (size_t)l * DM * DFF, MTOK, DM, DFF};
            pg8::StaticOrder S; S.init(MTOK, DM, F.G, F.bid);
            pg8::EpiResLn2 E{Y, RS(3 * l + 1), LNG(3 * l + 1), LNB(3 * l + 1), DM, DN_ALPHA, RS(3 * l + 2)};
            pg8::gemm_phase<pg8::EpiResLn2, pg8::StaticOrder, PG8_ALIGN, PG8_SP2>(F.lds + RING_OFF, g, S, E);
        } PH_END
        if (l == 1) { PH_BEGIN REP(7) ln_phase(F, Y, LNG(5), LNB(5), H32); PH_END }
#undef RS
#undef LNG
#undef LNB
}
__global__ void __launch_bounds__(NTHR, 2) mega_fwd(Args args) {
    extern __shared__ __attribute__((aligned(16))) unsigned char lds_raw[];
    Frame F;
    F.lds = (LAS unsigned char*)lds_raw; F.ws = args.ws;
    F.tid = threadIdx.x; F.lane = F.tid & 63; F.wave = __builtin_amdgcn_readfirstlane(F.tid >> 6); F.G = gridDim.x;
    unsigned char* ws = args.ws;
    gu32* ctl = (gu32*)(ws + WS_CTL);
    for (int u = F.tid; u < (LDS_BYTES - LDSCTL_OFF) / 4; u += NTHR) ((LAS unsigned*)(F.lds + LDSCTL_OFF))[u] = 0u;
    __syncthreads();
    volatile LAS unsigned* MISC = (volatile LAS unsigned*)(F.lds + MISC_OFF);
    XcdBarrier bar = xcd_barrier_post((unsigned*)(ctl + CW_BAR), MISC + 8);
    const int lo = args.ph_lo, hi = args.ph_hi; int pc = 0; unsigned long long tbar_acc = 0ull;
    bf16* HB = (bf16*)(ws + WS_HB); bf16* Y = (bf16*)(ws + WS_Y); float* H32 = (float*)karg()->out;
    bf16* BIG = (bf16*)(ws + WS_BIG); bf16* Gm = (bf16*)(ws + WS_G); bf16* Ob = (bf16*)(ws + WS_O);
    bf16* XQ = (bf16*)(ws + WS_XQ); bf16* XO = (bf16*)(ws + WS_XO);

    PH_BEGIN REP(0) p0_prologue(F, args); PH_END

#if (REPMASK >> 21) & 1
    for (int e_ = 0; e_ < 40; ++e_) { PH_BEGIN PH_END }
#endif
    layer_body<0>(F, args, bar, pc, lo, hi, tbar_acc);
    layer_body<1>(F, args, bar, pc, lo, hi, tbar_acc);
#if (REPMASK >> 23) & 1
#ifndef PROBE_BID
#define PROBE_BID 0
#endif
#if (REPMASK >> 24) & 1
    if (blockIdx.x == 0) { unsigned long long tot_ = 0ull; for (int k_ = 0; k_ < pc; ++k_) { const unsigned v_ = __hip_atomic_load((unsigned*)(args.ws + 3 * MiB) + k_, __ATOMIC_RELAXED, __HIP_MEMORY_SCOPE_AGENT); const unsigned x_ = __hip_atomic_load((unsigned*)(args.ws + 3 * MiB) + 256 + k_, __ATOMIC_RELAXED, __HIP_MEMORY_SCOPE_AGENT);
#ifdef PROBE_SPREAD_MASK
            if (v_ && ((PROBE_SPREAD_MASK >> k_) & 1ull)) tot_ += x_ - (0x7fffffffu - v_);
#else
            if (v_) tot_ += 0x7fffffffu - v_;
#endif
        }
        const unsigned long long t0_ = __builtin_amdgcn_s_memrealtime(); while (__builtin_amdgcn_s_memrealtime() - t0_ < tot_) __builtin_amdgcn_s_sleep(8); }
#else
    if (blockIdx.x == PROBE_BID) { const unsigned long long t0_ = __builtin_amdgcn_s_memrealtime(); while (__builtin_amdgcn_s_memrealtime() - t0_ < tbar_acc) __builtin_amdgcn_s_sleep(8); }
#endif
#endif
}

extern "C" void kernel_launch(void* const* d_in, const int* in_sizes, int n_in, void* d_out, int out_size, void* d_ws, size_t ws_size, hipStream_t stream) {
    static int grid = 0;
    if (grid == 0) {
        if (n_in != 19 || in_sizes[0] != MTOK * DM || out_size != MTOK * DM || ws_size < WS_END) {
            fprintf(stderr, "kernel_launch: shape mismatch n_in %d in0 %d out %d ws %zu (need %zu)\n", n_in, n_in > 0 ? in_sizes[0] : -1, out_size, ws_size, (size_t)WS_END); grid = -1; return; }
        int dev = 0, cus = 0, per_cu = 0;
        if (hipGetDevice(&dev) != hipSuccess || hipDeviceGetAttribute(&cus, hipDeviceAttributeMultiprocessorCount, dev) != hipSuccess) { grid = -1; return; }
        if (hipFuncSetAttribute((const void*)mega_fwd, hipFuncAttributeMaxDynamicSharedMemorySize, LDS_BYTES) != hipSuccess) { fprintf(stderr, "kernel_launch: hipFuncSetAttribute failed\n"); grid = -1; return; }
        if (hipOccupancyMaxActiveBlocksPerMultiprocessor(&per_cu, (const void*)mega_fwd, NTHR, LDS_BYTES) != hipSuccess || per_cu < 1)
            fprintf(stderr, "kernel_launch: note: occupancy query reports %d workgroups per CU\n", per_cu);
        (void)hipGetLastError();
        grid = cus;
        if (grid != 256) { fprintf(stderr, "kernel_launch: built for a 256-CU device (workgroup ranges of the cross-attention and conversion phases); this device reports %d; nothing launched\n", cus); grid = -1; return; }
    }
    if (grid < 0) return;
    if (hipMemsetAsync((char*)d_ws + WS_CTL, 0, CTL_ZERO_BYTES, stream) != hipSuccess) { fprintf(stderr, "kernel_launch: memset failed\n"); return; }
    Args a{};
    for (int i = 0; i < 19; ++i) a.in[i] = (const float*)d_in[i];
    a.out = (float*)d_out; a.ws = (unsigned char*)d_ws; a.ph_lo = 0; a.ph_hi = 1 << 20;
    hipLaunchKernelGGL(mega_fwd, dim3(grid), dim3(NTHR), LDS_BYTES, stream, a);
    const hipError_t le = hipPeekAtLastError();
    if (le != hipSuccess) fprintf(stderr, "kernel_launch: launch failed: %s\n", hipGetErrorName(le));
}
```

```cpp
#include <hip/hip_runtime.h>
#include <cstdio>
#include <cstdint>
namespace pg8 {
#define PG8_LAS __attribute__((address_space(3)))
typedef unsigned short bf16_t;
typedef short bf16x8 __attribute__((ext_vector_type(8)));
typedef float f32x4 __attribute__((ext_vector_type(4)));
typedef unsigned u32x4 __attribute__((ext_vector_type(4)));
constexpr int BM = 256, BK = 64, HALF = 128, HTB = HALF * BK * 2  , STAGE_BYTES = 8 * HTB, NXCD = 8, WGM = 8;

__host__ __device__ __forceinline__ int lds_byte(int r, int c) { const int st = (r >> 4) * 2 + (c >> 5), rr = r & 15, cc = c & 31, ob = rr * 64 + cc * 2; return st * 1024 + (ob ^ (((ob >> 9) & 1) << 5)); }
__host__ __device__ __forceinline__ void stage_rc(int b, int& R, int& C) { const int st = b / 1024, sb = b % 1024, swz = sb ^ (((sb >> 9) & 1) << 5); R = (st >> 1) * 16 + swz / 64; C = (st & 1) * 32 + (swz % 64) / 2; }
__host__ __device__ __forceinline__ int perm32(int rho) { const int n = rho >> 4, i = rho & 15; return 8 * (i >> 2) + 4 * n + (i & 3); }

struct Unit { int pm, pn; };
struct Gemm { const bf16_t* A; const bf16_t* Bt; int M, N, K; };

struct StaticOrder {
    int nM, nN, nwg, G, c;
    __host__ __device__ void init(int M, int N, int G_, int c_) { nM = M / BM; nN = N / BM; nwg = nM * nN; G = G_; c = c_; }
    __host__ __device__ bool next(int i, Unit& u) const {
        const long L = (long)i * G + c; if (L >= nwg) return false;
        int wgid = (int)L; { const int q = nwg / NXCD, r = nwg % NXCD, xcd = wgid % NXCD, off = wgid / NXCD; wgid = (xcd < r ? xcd * (q + 1) : r * (q + 1) + (xcd - r) * q) + off; }
        const int nig = WGM * nN, gid = wgid / nig, fm = gid * WGM, gsz = (nM - fm) < WGM ? (nM - fm) : WGM;
        u.pm = fm + ((wgid % nig) % gsz); u.pn = (wgid % nig) / gsz; return true;
    }
    __device__ __forceinline__ void a_ready(const Unit&) const {}
    __device__ __forceinline__ void done(const Unit&) const {}
};

__device__ __forceinline__ unsigned cvt_pk_bf16(float lo, float hi) { unsigned r; asm volatile("v_cvt_pk_bf16_f32 %0, %1, %2" : "=v"(r) : "v"(lo), "v"(hi)); return r; }
typedef float f32x2 __attribute__((ext_vector_type(2)));
__device__ __forceinline__ f32x2 gelu_pk(f32x2 v) {
    const f32x2 av = __builtin_elementwise_abs(v), d = av * 0.2316418882f + 1.0f;
    f32x2 t; t.x = __builtin_amdgcn_rcpf(d.x); t.y = __builtin_amdgcn_rcpf(d.y);
    f32x2 q = t * 0.5307027145f + (-0.7265760135f); q = q * t + 0.7107068705f; q = q * t + (-0.142248368f); q = q * t + 0.127414796f; q = q * t;
    const f32x2 s = (v * v) * (-0.72134752044f);
    f32x2 e; e.x = __builtin_amdgcn_exp2f(s.x); e.y = __builtin_amdgcn_exp2f(s.y);
    const f32x2 m = av * (q * e);
    return __builtin_elementwise_max(v, (f32x2){0.f, 0.f}) - m;
}

template <int ACT  > struct EpiBf16 {
    static constexpr bool PERM = true, AFTER_DRAIN = false; static_assert(ACT == 0 || ACT == 1, "EpiBf16: ACT is 0 (none) or 1 (gelu_pk)");
    bf16_t* O; int ldc; const float* bias; int split_cols; size_t split_stride; float scale0;
    __device__ __forceinline__ void operator()(const f32x4 (&acc)[2][2][4][2], const Unit& u, int wr, int wc, int fr, int fq) const {
        const int row0 = u.pm * BM + wr * 64 + fr; int colt = u.pn * BM; bf16_t* base = O;
        float sc = 1.f; if (split_cols) { const int t = colt / split_cols; base += (size_t)t * split_stride; colt -= t * split_cols; if (t == 0) sc = scale0; }
        const int col0 = colt + wc * 32 + 8 * fq, bcol0 = u.pn * BM + wc * 32 + 8 * fq;
        f32x4 bv[2][2];
#pragma unroll
        for (int bj = 0; bj < 2; ++bj)
#pragma unroll
            for (int n = 0; n < 2; ++n) bv[bj][n] = bias ? *(const f32x4*)(bias + bcol0 + bj * HALF + 4 * n) : (f32x4){0.f, 0.f, 0.f, 0.f};
#pragma unroll
        for (int ai = 0; ai < 2; ++ai)
#pragma unroll
            for (int m = 0; m < 4; ++m) { bf16_t* rowp = base + (size_t)(row0 + ai * HALF + m * 16) * ldc + col0;
#pragma unroll
                for (int bj = 0; bj < 2; ++bj) { f32x4 v0 = acc[ai][bj][m][0] + bv[bj][0], v1 = acc[ai][bj][m][1] + bv[bj][1];
                    if (ACT == 1) { f32x2 a = gelu_pk((f32x2){v0[0], v0[1]}), b = gelu_pk((f32x2){v0[2], v0[3]}), c = gelu_pk((f32x2){v1[0], v1[1]}), d = gelu_pk((f32x2){v1[2], v1[3]});
                        v0 = (f32x4){a.x, a.y, b.x, b.y}; v1 = (f32x4){c.x, c.y, d.x, d.y}; }
                    v0 = v0 * sc; v1 = v1 * sc; u32x4 w; w.x = cvt_pk_bf16(v0[0], v0[1]); w.y = cvt_pk_bf16(v0[2], v0[3]); w.z = cvt_pk_bf16(v1[0], v1[1]); w.w = cvt_pk_bf16(v1[2], v1[3]);
                    *(u32x4*)(rowp + bj * HALF) = w; } }
    }
};


struct EpiRes {
    static constexpr bool PERM = false, AFTER_DRAIN = false;
    float* Y; const float* res; int ldc; float alpha;
    __device__ __forceinline__ void operator()(const f32x4 (&acc)[2][2][4][2], const Unit& u, int wr, int wc, int fr, int fq) const {
        const int row0 = u.pm * BM + wr * 64 + fr, col0 = u.pn * BM + wc * 32 + 4 * fq;
#pragma unroll
        for (int ai = 0; ai < 2; ++ai)
#pragma unroll
            for (int m = 0; m < 4; ++m) { const size_t off = (size_t)(row0 + ai * HALF + m * 16) * ldc + col0;
#pragma unroll
                for (int bj = 0; bj < 2; ++bj)
#pragma unroll
                    for (int n = 0; n < 2; ++n) { const f32x4 r = *(const f32x4*)(res + off + bj * HALF + n * 16);
                        *(f32x4*)(Y + off + bj * HALF + n * 16) = r * alpha + acc[ai][bj][m][n]; } }
    }
};
struct RangeOrder {
    int nM, nN, ntot, c0, nw, c;
    __host__ __device__ void init(int M, int N, int c0_, int nw_, int c_) { nM = M / BM; nN = N / BM; ntot = nM * nN; c0 = c0_; nw = nw_; c = c_; }
    __host__ __device__ bool next(int i, Unit& u) const {
        if (c < c0 || c >= c0 + nw) return false;
        const int L = i * nw + (c - c0); if (L >= ntot) return false;
        u.pm = L / nN; u.pn = L % nN; return true;
    }
    __device__ __forceinline__ void a_ready(const Unit&) const {}
    __device__ __forceinline__ void done(const Unit&) const {}
};

struct ZeroOrder : StaticOrder {
    __host__ __device__ bool next(int i, Unit& u) const { const bool r = StaticOrder::next(i, u); u.pm = 0; u.pn = 0; return r; }
};

struct EpiResBf {
    static constexpr bool PERM = true, AFTER_DRAIN = false;
    bf16_t* Y; const bf16_t* res; int ldc; float alpha;
    __device__ __forceinline__ void operator()(const f32x4 (&acc)[2][2][4][2], const Unit& u, int wr, int wc, int fr, int fq) const {
        const int row0 = u.pm * BM + wr * 64 + fr, col0 = u.pn * BM + wc * 32 + 8 * fq;
#pragma unroll
        for (int ai = 0; ai < 2; ++ai)
#pragma unroll
            for (int m = 0; m < 4; ++m) { const size_t off = (size_t)(row0 + ai * HALF + m * 16) * ldc + col0;
#pragma unroll
                for (int bj = 0; bj < 2; ++bj) { const u32x4 r = *(const u32x4*)(res + off + bj * HALF);
                    const f32x4 v0 = acc[ai][bj][m][0], v1 = acc[ai][bj][m][1];
                    u32x4 w;
                    w.x = cvt_pk_bf16(__builtin_bit_cast(float, r.x << 16) * alpha + v0[0], __builtin_bit_cast(float, r.x & 0xffff0000u) * alpha + v0[1]);
                    w.y = cvt_pk_bf16(__builtin_bit_cast(float, r.y << 16) * alpha + v0[2], __builtin_bit_cast(float, r.y & 0xffff0000u) * alpha + v0[3]);
                    w.z = cvt_pk_bf16(__builtin_bit_cast(float, r.z << 16) * alpha + v1[0], __builtin_bit_cast(float, r.z & 0xffff0000u) * alpha + v1[1]);
                    w.w = cvt_pk_bf16(__builtin_bit_cast(float, r.w << 16) * alpha + v1[2], __builtin_bit_cast(float, r.w & 0xffff0000u) * alpha + v1[3]);
                    *(u32x4*)(Y + off + bj * HALF) = w; } }
    }
};

struct EpiResF {
    static constexpr bool PERM = true, AFTER_DRAIN = false;
    float* Y; const bf16_t* res; int ldc; float alpha;
    __device__ __forceinline__ void operator()(const f32x4 (&acc)[2][2][4][2], const Unit& u, int wr, int wc, int fr, int fq) const {
        const int row0 = u.pm * BM + wr * 64 + fr, col0 = u.pn * BM + wc * 32 + 8 * fq;
#pragma unroll
        for (int ai = 0; ai < 2; ++ai)
#pragma unroll
            for (int m = 0; m < 4; ++m) { const size_t off = (size_t)(row0 + ai * HALF + m * 16) * ldc + col0;
#pragma unroll
                for (int bj = 0; bj < 2; ++bj) { const u32x4 r = *(const u32x4*)(res + off + bj * HALF);
                    f32x4 o0, o1;
                    o0[0] = __builtin_bit_cast(float, r.x << 16); o0[1] = __builtin_bit_cast(float, r.x & 0xffff0000u); o0[2] = __builtin_bit_cast(float, r.y << 16); o0[3] = __builtin_bit_cast(float, r.y & 0xffff0000u);
                    o1[0] = __builtin_bit_cast(float, r.z << 16); o1[1] = __builtin_bit_cast(float, r.z & 0xffff0000u); o1[2] = __builtin_bit_cast(float, r.w << 16); o1[3] = __builtin_bit_cast(float, r.w & 0xffff0000u);
                    *(f32x4*)(Y + off + bj * HALF) = o0 * alpha + acc[ai][bj][m][0]; *(f32x4*)(Y + off + bj * HALF + 4) = o1 * alpha + acc[ai][bj][m][1]; } }
    }
};

struct EpiResLn {
    static constexpr bool PERM = true, AFTER_DRAIN = false;
    bf16_t* Y; const float* stats; const float* g; const float* b; int ldc; float alpha;
    __device__ __forceinline__ void operator()(const f32x4 (&acc)[2][2][4][2], const Unit& u, int wr, int wc, int fr, int fq) const {
        const int row0 = u.pm * BM + wr * 64 + fr, col0 = u.pn * BM + wc * 32 + 8 * fq;
        f32x4 gv[2][2], bv[2][2];
#pragma unroll
        for (int bj = 0; bj < 2; ++bj)
#pragma unroll
            for (int n = 0; n < 2; ++n) { gv[bj][n] = *(const f32x4*)(g + col0 + bj * HALF + 4 * n) * alpha; bv[bj][n] = *(const f32x4*)(b + col0 + bj * HALF + 4 * n) * alpha; }
#pragma unroll
        for (int ai = 0; ai < 2; ++ai)
#pragma unroll
            for (int m = 0; m < 4; ++m) { const int row = row0 + ai * HALF + m * 16; const size_t off = (size_t)row * ldc + col0;
                const float mean = stats[2 * row], rstd = stats[2 * row + 1];
#pragma unroll
                for (int bj = 0; bj < 2; ++bj) { const u32x4 r = *(const u32x4*)(Y + off + bj * HALF);
                    f32x4 y0, y1;
                    y0[0] = __builtin_bit_cast(float, r.x << 16); y0[1] = __builtin_bit_cast(float, r.x & 0xffff0000u); y0[2] = __builtin_bit_cast(float, r.y << 16); y0[3] = __builtin_bit_cast(float, r.y & 0xffff0000u);
                    y1[0] = __builtin_bit_cast(float, r.z << 16); y1[1] = __builtin_bit_cast(float, r.z & 0xffff0000u); y1[2] = __builtin_bit_cast(float, r.w << 16); y1[3] = __builtin_bit_cast(float, r.w & 0xffff0000u);
                    const f32x4 o0 = (y0 - mean) * rstd * gv[bj][0] + bv[bj][0] + acc[ai][bj][m][0], o1 = (y1 - mean) * rstd * gv[bj][1] + bv[bj][1] + acc[ai][bj][m][1];
                    u32x4 w; w.x = cvt_pk_bf16(o0[0], o0[1]); w.y = cvt_pk_bf16(o0[2], o0[3]); w.z = cvt_pk_bf16(o1[0], o1[1]); w.w = cvt_pk_bf16(o1[2], o1[3]);
                    *(u32x4*)(Y + off + bj * HALF) = w; } }
    }
};

constexpr float RS_SCALE = 1048576.0f, RS_INV = 1.0f / 1048576.0f;
__device__ __forceinline__ float fx20_to_f(long long v) { return (float)(int)(v >> 20) + (float)((unsigned)v & 0xFFFFFu) * RS_INV; }
__device__ __forceinline__ long long f_to_fx20(float s) { const float fl = floorf(s); return ((long long)(int)fl << 20) + (long long)(unsigned)((s - fl) * RS_SCALE + 0.5f); }
__device__ __forceinline__ void row_stats(const long long* rs, int row, float& mean, float& rstd) {
    const long long a = rs[2 * (size_t)row], b = rs[2 * (size_t)row + 1];
    mean = fx20_to_f(a) * (1.0f / 4096.0f); const float var = fx20_to_f(b) * (1.0f / 4096.0f) - mean * mean; rstd = __builtin_amdgcn_rsqf(var + 1e-5f);
}
constexpr float FOLD_SCALE = 4294967296.0f, FOLD_INV = 1.0f / 4294967296.0f;
struct EpiBf16Ln {
    static constexpr bool PERM = true, AFTER_DRAIN = false;
    bf16_t* O; int ldc; const long long* rs; const float* cs; const float* b2;
    __device__ __forceinline__ void operator()(const f32x4 (&acc)[2][2][4][2], const Unit& u, int wr, int wc, int fr, int fq) const {
        const int row0 = u.pm * BM + wr * 64 + fr, col0 = u.pn * BM + wc * 32 + 8 * fq;
        f32x4 cv[2][2], bv[2][2];
#pragma unroll
        for (int bj = 0; bj < 2; ++bj)
#pragma unroll
            for (int n = 0; n < 2; ++n) { cv[bj][n] = *(const f32x4*)(cs + col0 + bj * HALF + 4 * n); bv[bj][n] = *(const f32x4*)(b2 + col0 + bj * HALF + 4 * n); }
#pragma unroll
        for (int ai = 0; ai < 2; ++ai)
#pragma unroll
            for (int m = 0; m < 4; ++m) { const int row = row0 + ai * HALF + m * 16; float mean, rstd; row_stats(rs, row, mean, rstd);
                bf16_t* rowp = O + (size_t)row * ldc + col0;
#pragma unroll
                for (int bj = 0; bj < 2; ++bj) { const f32x4 v0 = (acc[ai][bj][m][0] - cv[bj][0] * mean) * rstd + bv[bj][0], v1 = (acc[ai][bj][m][1] - cv[bj][1] * mean) * rstd + bv[bj][1];
                    u32x4 w; w.x = cvt_pk_bf16(v0[0], v0[1]); w.y = cvt_pk_bf16(v0[2], v0[3]); w.z = cvt_pk_bf16(v1[0], v1[1]); w.w = cvt_pk_bf16(v1[2], v1[3]);
                    *(u32x4*)(rowp + bj * HALF) = w; } }
    }
};
__device__ __forceinline__ void row_sums_add(long long* rso, int row, const f32x4& a, const f32x4& b, const f32x4& c, const f32x4& d, int fq) {
    float s1 = ((a[0] + a[1]) + (a[2] + a[3])) + ((b[0] + b[1]) + (b[2] + b[3])) + ((c[0] + c[1]) + (c[2] + c[3])) + ((d[0] + d[1]) + (d[2] + d[3]));
    float s2 = ((a[0] * a[0] + a[1] * a[1]) + (a[2] * a[2] + a[3] * a[3])) + ((b[0] * b[0] + b[1] * b[1]) + (b[2] * b[2] + b[3] * b[3]))
             + ((c[0] * c[0] + c[1] * c[1]) + (c[2] * c[2] + c[3] * c[3])) + ((d[0] * d[0] + d[1] * d[1]) + (d[2] * d[2] + d[3] * d[3]));
    s1 += __shfl_xor(s1, 16); s1 += __shfl_xor(s1, 32); s2 += __shfl_xor(s2, 16); s2 += __shfl_xor(s2, 32);
    if (fq == 0) { atomicAdd((unsigned long long*)(rso + 2 * (size_t)row), (unsigned long long)f_to_fx20(s1)); atomicAdd((unsigned long long*)(rso + 2 * (size_t)row + 1), (unsigned long long)f_to_fx20(s2)); }
}
struct EpiRes0 {
    static constexpr bool PERM = true, AFTER_DRAIN = false;
    bf16_t* Y; const bf16_t* res; int ldc; float alpha; long long* rso;
    __device__ __forceinline__ void operator()(const f32x4 (&acc)[2][2][4][2], const Unit& u, int wr, int wc, int fr, int fq) const {
        const int row0 = u.pm * BM + wr * 64 + fr, col0 = u.pn * BM + wc * 32 + 8 * fq;
#pragma unroll
        for (int ai = 0; ai < 2; ++ai)
#pragma unroll
            for (int m = 0; m < 4; ++m) { const int row = row0 + ai * HALF + m * 16; const size_t off = (size_t)row * ldc + col0; f32x4 o[2][2];
#pragma unroll
                for (int bj = 0; bj < 2; ++bj) { const u32x4 r = *(const u32x4*)(res + off + bj * HALF);
                    f32x4 y0, y1;
                    y0[0] = __builtin_bit_cast(float, r.x << 16); y0[1] = __builtin_bit_cast(float, r.x & 0xffff0000u); y0[2] = __builtin_bit_cast(float, r.y << 16); y0[3] = __builtin_bit_cast(float, r.y & 0xffff0000u);
                    y1[0] = __builtin_bit_cast(float, r.z << 16); y1[1] = __builtin_bit_cast(float, r.z & 0xffff0000u); y1[2] = __builtin_bit_cast(float, r.w << 16); y1[3] = __builtin_bit_cast(float, r.w & 0xffff0000u);
                    o[bj][0] = y0 * alpha + acc[ai][bj][m][0]; o[bj][1] = y1 * alpha + acc[ai][bj][m][1];
                    u32x4 w; w.x = cvt_pk_bf16(o[bj][0][0], o[bj][0][1]); w.y = cvt_pk_bf16(o[bj][0][2], o[bj][0][3]); w.z = cvt_pk_bf16(o[bj][1][0], o[bj][1][1]); w.w = cvt_pk_bf16(o[bj][1][2], o[bj][1][3]);
                    *(u32x4*)(Y + off + bj * HALF) = w; }
                row_sums_add(rso, row, o[0][0], o[0][1], o[1][0], o[1][1], fq); }
    }
};
struct EpiResLn2 {
    static constexpr bool PERM = true, AFTER_DRAIN = false;
    bf16_t* Y; const long long* rsi; const float* g; const float* b; int ldc; float alpha; long long* rso;
    __device__ __forceinline__ void operator()(const f32x4 (&acc)[2][2][4][2], const Unit& u, int wr, int wc, int fr, int fq) const {
        const int row0 = u.pm * BM + wr * 64 + fr, col0 = u.pn * BM + wc * 32 + 8 * fq;
        f32x4 gv[2][2], bv[2][2];
#pragma unroll
        for (int bj = 0; bj < 2; ++bj)
#pragma unroll
            for (int n = 0; n < 2; ++n) { gv[bj][n] = *(const f32x4*)(g + col0 + bj * HALF + 4 * n) * alpha; bv[bj][n] = *(const f32x4*)(b + col0 + bj * HALF + 4 * n) * alpha; }
#pragma unroll
        for (int ai = 0; ai < 2; ++ai)
#pragma unroll
            for (int m = 0; m < 4; ++m) { const int row = row0 + ai * HALF + m * 16; const size_t off = (size_t)row * ldc + col0; float mean, rstd; row_stats(rsi, row, mean, rstd); f32x4 o[2][2];
#pragma unroll
                for (int bj = 0; bj < 2; ++bj) { const u32x4 r = *(const u32x4*)(Y + off + bj * HALF);
                    f32x4 y0, y1;
                    y0[0] = __builtin_bit_cast(float, r.x << 16); y0[1] = __builtin_bit_cast(float, r.x & 0xffff0000u); y0[2] = __builtin_bit_cast(float, r.y << 16); y0[3] = __builtin_bit_cast(float, r.y & 0xffff0000u);
                    y1[0] = __builtin_bit_cast(float, r.z << 16); y1[1] = __builtin_bit_cast(float, r.z & 0xffff0000u); y1[2] = __builtin_bit_cast(float, r.w << 16); y1[3] = __builtin_bit_cast(float, r.w & 0xffff0000u);
                    o[bj][0] = (y0 - mean) * rstd * gv[bj][0] + bv[bj][0] + acc[ai][bj][m][0]; o[bj][1] = (y1 - mean) * rstd * gv[bj][1] + bv[bj][1] + acc[ai][bj][m][1];
                    u32x4 w; w.x = cvt_pk_bf16(o[bj][0][0], o[bj][0][1]); w.y = cvt_pk_bf16(o[bj][0][2], o[bj][0][3]); w.z = cvt_pk_bf16(o[bj][1][0], o[bj][1][1]); w.w = cvt_pk_bf16(o[bj][1][2], o[bj][1][3]);
                    *(u32x4*)(Y + off + bj * HALF) = w; }
                row_sums_add(rso, row, o[0][0], o[0][1], o[1][0], o[1][1], fq); }
    }
};

struct EpiBf16LnTok {
    static constexpr bool PERM = true, AFTER_DRAIN = false, AROWPERM = true;
    bf16_t* O; int ldc; const long long* rs; const float* cs; const float* b2;
    __device__ __forceinline__ void operator()(const f32x4 (&acc)[2][2][4][2], const Unit& u, int wr, int wc, int fr, int fq) const {
        const int row0 = u.pm * BM + 128 * wr + 8 * fr, col0 = u.pn * BM + wc * 32 + 8 * fq;
        f32x4 cv[2][2], bv[2][2];
#pragma unroll
        for (int bj = 0; bj < 2; ++bj)
#pragma unroll
            for (int n = 0; n < 2; ++n) { cv[bj][n] = *(const f32x4*)(cs + col0 + bj * HALF + 4 * n); bv[bj][n] = *(const f32x4*)(b2 + col0 + bj * HALF + 4 * n); }
#pragma unroll
        for (int ai = 0; ai < 2; ++ai)
#pragma unroll
            for (int m = 0; m < 4; ++m) { const int row = row0 + 4 * ai + m; float mean, rstd; row_stats(rs, row, mean, rstd);
                bf16_t* rowp = O + (size_t)row * ldc + col0;
#pragma unroll
                for (int bj = 0; bj < 2; ++bj) { const f32x4 v0 = (acc[ai][bj][m][0] - cv[bj][0] * mean) * rstd + bv[bj][0], v1 = (acc[ai][bj][m][1] - cv[bj][1] * mean) * rstd + bv[bj][1];
                    u32x4 w; w.x = cvt_pk_bf16(v0[0], v0[1]); w.y = cvt_pk_bf16(v0[2], v0[3]); w.z = cvt_pk_bf16(v1[0], v1[1]); w.w = cvt_pk_bf16(v1[2], v1[3]);
                    *(u32x4*)(rowp + bj * HALF) = w; } }
    }
};

__device__ __forceinline__ float dpp_shr1(float x) { return __builtin_bit_cast(float, __builtin_amdgcn_update_dpp(0, __builtin_bit_cast(int, x), 0x111, 0xf, 0xf, true)); }
struct EpiConvGlu {
    static constexpr bool PERM = true, AFTER_DRAIN = false, AROWPERM = true;
    bf16_t* G; bf16_t* side; const long long* rs; const float* cs; const float* b2; const float* cw; int dff;
    __device__ __forceinline__ void operator()(const f32x4 (&acc)[2][2][4][2], const Unit& u, int wr, int wc, int fr, int fq) const {
        const int row0 = u.pm * BM + 128 * wr + 8 * fr, colg = u.pn * BM + wc * 32 + 8 * fq, ch0 = u.pn * HALF + wc * 32 + 8 * fq;
        float mean_[8], rstd_[8];
#pragma unroll
        for (int j = 0; j < 8; ++j) row_stats(rs, row0 + j, mean_[j], rstd_[j]);
        float mr_[8];
#pragma unroll
        for (int j = 0; j < 8; ++j) mr_[j] = mean_[j] * rstd_[j];
        unsigned gout[8][4];
        const int bnd = row0 >> 7;
#pragma unroll
        for (int n = 0; n < 2; ++n) {
            const f32x4 ca = *(const f32x4*)(cs + colg + 4 * n), ba = *(const f32x4*)(b2 + colg + 4 * n), cu = *(const f32x4*)(cs + colg + HALF + 4 * n), bu = *(const f32x4*)(b2 + colg + HALF + 4 * n);
            const f32x4 w0 = *(const f32x4*)(cw + ch0 + 4 * n), w1 = *(const f32x4*)(cw + dff + ch0 + 4 * n), w2 = *(const f32x4*)(cw + 2 * dff + ch0 + 4 * n);
            f32x4 a[8], uu[8];
#pragma unroll
            for (int j = 0; j < 8; ++j) { a[j] = acc[j >> 2][0][j & 3][n] * rstd_[j] + (ba - ca * mr_[j]); uu[j] = acc[j >> 2][1][j & 3][n] * rstd_[j] + (bu - cu * mr_[j]); }
            f32x4 p6, p7;
#pragma unroll
            for (int q = 0; q < 4; ++q) { p6[q] = dpp_shr1(a[6][q]); p7[q] = dpp_shr1(a[7][q]); }
            if (fr == 15 && bnd + 1 < 128) { bf16_t* sp = side + ((size_t)(bnd + 1) * 6) * dff + ch0 + 4 * n;
                *(unsigned long long*)(sp) = (unsigned long long)cvt_pk_bf16(a[6][0], a[6][1]) | ((unsigned long long)cvt_pk_bf16(a[6][2], a[6][3]) << 32);
                *(unsigned long long*)(sp + dff) = (unsigned long long)cvt_pk_bf16(a[7][0], a[7][1]) | ((unsigned long long)cvt_pk_bf16(a[7][2], a[7][3]) << 32); }
            if (fr == 0) { bf16_t* sp = side + ((size_t)bnd * 6 + 2) * dff + ch0 + 4 * n;
                *(unsigned long long*)(sp) = (unsigned long long)cvt_pk_bf16(a[0][0], a[0][1]) | ((unsigned long long)cvt_pk_bf16(a[0][2], a[0][3]) << 32);
                *(unsigned long long*)(sp + dff) = (unsigned long long)cvt_pk_bf16(a[1][0], a[1][1]) | ((unsigned long long)cvt_pk_bf16(a[1][2], a[1][3]) << 32);
                *(unsigned long long*)(sp + 2 * dff) = (unsigned long long)cvt_pk_bf16(uu[0][0], uu[0][1]) | ((unsigned long long)cvt_pk_bf16(uu[0][2], uu[0][3]) << 32);
                *(unsigned long long*)(sp + 3 * dff) = (unsigned long long)cvt_pk_bf16(uu[1][0], uu[1][1]) | ((unsigned long long)cvt_pk_bf16(uu[1][2], uu[1][3]) << 32); }
#pragma unroll
            for (int j = 0; j < 8; ++j) { const f32x4 am1 = (j == 0) ? p7 : a[j ? j - 1 : 0], am2 = (j == 0) ? p6 : (j == 1 ? p7 : a[j > 1 ? j - 2 : 0]);
                const f32x4 c = w2 * a[j] + w1 * am1 + w0 * am2;
                const f32x2 g01 = gelu_pk((f32x2){c[0], c[1]}), g23 = gelu_pk((f32x2){c[2], c[3]});
                gout[j][2 * n] = cvt_pk_bf16(g01.x * uu[j][0], g01.y * uu[j][1]); gout[j][2 * n + 1] = cvt_pk_bf16(g23.x * uu[j][2], g23.y * uu[j][3]); }
        }
#pragma unroll
        for (int j = 0; j < 8; ++j) if (!(fr == 0 && j < 2)) { u32x4 w; w.x = gout[j][0]; w.y = gout[j][1]; w.z = gout[j][2]; w.w = gout[j][3]; *(u32x4*)(G + (size_t)(row0 + j) * dff + ch0) = w; }
    }
};
template <class E, class = void> struct arowperm_v { static constexpr bool value = false; };
template <class E> struct arowperm_v<E, decltype((void)E::AROWPERM)> { static constexpr bool value = E::AROWPERM; };
template <class Epi, class Sched, bool ALIGN_EPI = false, bool SP2 = false>
__device__ __forceinline__ void gemm_phase(PG8_LAS unsigned char* lds, const Gemm g, const Sched& S, const Epi& E) {
    int tid_l = threadIdx.x; asm volatile("" : "+v"(tid_l)); const int tid = tid_l, wid = __builtin_amdgcn_readfirstlane(tid >> 6), lane = tid & 63, wr = wid >> 2, wc = wid & 3, fr = lane & 15, fq = lane >> 4;
    const int K = g.K, nt = K / BK;
    unsigned voffA[2], voffB[2];
#pragma unroll
    for (int i = 0; i < 2; ++i) { int R, C; stage_rc(tid * 16 + i * 8192, R, C); const int Rb = Epi::PERM ? ((R & ~31) + perm32(R & 31)) : R;
        const int Ra = arowperm_v<Epi>::value ? (128 * (R >> 6) + 8 * (R & 15) + ((R >> 4) & 3)) : R;
        voffA[i] = (unsigned)(Ra * K + C) * 2u; voffB[i] = (unsigned)(Rb * K + C) * 2u; }
    const size_t hstepA = arowperm_v<Epi>::value ? (size_t)4 * K * 2 : (size_t)HALF * K * 2;
    const size_t kstep = (size_t)(BK * 2);
    const size_t hstep = (size_t)HALF * K * 2;
    const size_t tstep = 2 * hstep;
    const unsigned ldsw = (unsigned)wid * 1024u;
    const int aoff = lds_byte(wr * 64 + fr, fq * 8), boff = lds_byte(wc * 32 + fr, fq * 8);
#define PG8_SA(b, h) (((b) * 2 + (h)) * HTB)
#define PG8_SB(b, h) ((4 + (b) * 2 + (h)) * HTB)
#define PG8_STAGE(bufoff, gbase, voff) do { _Pragma("unroll") for (int _i = 0; _i < 2; ++_i) \
        __builtin_amdgcn_global_load_lds((const unsigned*)((const char*)(gbase) + (voff)[_i]), (PG8_LAS unsigned*)(lds + (bufoff) + ldsw + _i * 8192), 16, 0, 0); } while (0)
#define PG8_LDA(dst, b, h) do { _Pragma("unroll") for (int m = 0; m < 4; ++m) _Pragma("unroll") for (int k = 0; k < 2; ++k) dst[m][k] = *(const PG8_LAS bf16x8*)(lds + PG8_SA(b, h) + aoff + m * 2048 + k * 1024); } while (0)
#define PG8_LDB(dst, b, h) do { _Pragma("unroll") for (int n = 0; n < 2; ++n) _Pragma("unroll") for (int k = 0; k < 2; ++k) dst[n][k] = *(const PG8_LAS bf16x8*)(lds + PG8_SB(b, h) + boff + n * 2048 + k * 1024); } while (0)
#define PG8_MMA(ai, bj, At, Bt) do { __builtin_amdgcn_s_setprio(1); _Pragma("unroll") for (int m = 0; m < 4; ++m) _Pragma("unroll") for (int n = 0; n < 2; ++n) _Pragma("unroll") for (int k = 0; k < 2; ++k) \
        acc[ai][bj][m][n] = __builtin_amdgcn_mfma_f32_16x16x32_bf16(Bt[n][k], At[m][k], acc[ai][bj][m][n], 0, 0, 0); __builtin_amdgcn_s_setprio(0); } while (0)
#define PG8_WAIT_V(n) asm volatile("s_waitcnt vmcnt(" #n ")" ::: "memory")
#define PG8_WAIT_L(n) asm volatile("s_waitcnt lgkmcnt(" #n ")" ::: "memory")
#define PG8_BAR __builtin_amdgcn_s_barrier()
#define PG8_SCHED __builtin_amdgcn_sched_barrier(0)
    Unit cur, nxt; int ui = 0;
    if (!S.next(0, cur)) return;
    f32x4 acc[2][2][4][2];
#pragma unroll
    for (int a = 0; a < 2; ++a)
#pragma unroll
        for (int b = 0; b < 2; ++b)
#pragma unroll
            for (int m = 0; m < 4; ++m)
#pragma unroll
                for (int n = 0; n < 2; ++n) acc[a][b][m][n] = (f32x4){0.f, 0.f, 0.f, 0.f};
    bf16x8 At[4][2], B0[2][2], B1[2][2];
    const char* cA = (const char*)g.A + (size_t)cur.pm * tstep; const char* cB = (const char*)g.Bt + (size_t)cur.pn * tstep;
    S.a_ready(cur);
    if constexpr (SP2) {
        PG8_STAGE(PG8_SB(0, 0), cB, voffB); PG8_STAGE(PG8_SB(0, 1), cB + hstep, voffB); PG8_STAGE(PG8_SA(0, 0), cA, voffA); PG8_STAGE(PG8_SA(0, 1), cA + hstepA, voffA);
        if (wr == 1) PG8_BAR;
        PG8_WAIT_V(2); PG8_BAR;
        PG8_STAGE(PG8_SB(1, 0), cB + kstep, voffB); PG8_STAGE(PG8_SA(1, 0), cA + kstep, voffA); PG8_STAGE(PG8_SB(1, 1), cB + hstep + kstep, voffB);
        PG8_WAIT_V(6); PG8_BAR;
    } else {
        PG8_STAGE(PG8_SB(0, 0), cB, voffB); PG8_STAGE(PG8_SA(0, 0), cA, voffA); PG8_STAGE(PG8_SB(0, 1), cB + hstep, voffB); PG8_STAGE(PG8_SA(0, 1), cA + hstepA, voffA);
        if (wr == 1) PG8_BAR;
        PG8_WAIT_V(4); PG8_BAR;
        PG8_STAGE(PG8_SB(1, 0), cB + kstep, voffB); PG8_STAGE(PG8_SA(1, 0), cA + kstep, voffA); PG8_STAGE(PG8_SB(1, 1), cB + hstep + kstep, voffB);
        PG8_WAIT_V(6); PG8_BAR;
    }
    for (;;) {
        const bool has_next = S.next(ui + 1, nxt);
        const char* nA = has_next ? (const char*)g.A + (size_t)nxt.pm * tstep : cA; const char* nB = has_next ? (const char*)g.Bt + (size_t)nxt.pn * tstep : cB;
        for (int t = 0; t < nt; t += 2) {
            const bool last = (t == nt - 2);
            const char* a1 = cA + (size_t)(t + 1) * kstep;
            const char* a2 = last ? nA : cA + (size_t)(t + 2) * kstep; const char* b2 = last ? nB : cB + (size_t)(t + 2) * kstep;
            const char* a3 = a2 + kstep; const char* b3 = b2 + kstep;
            if (last && has_next) S.a_ready(nxt);
            if constexpr (SP2) {
            PG8_LDB(B0, 0, 0); PG8_LDB(B1, 0, 1); PG8_SCHED; PG8_LDA(At, 0, 0); PG8_STAGE(PG8_SA(1, 1), a1 + hstepA, voffA);
            PG8_WAIT_V(8); PG8_WAIT_L(0); PG8_BAR; PG8_MMA(0, 0, At, B0); PG8_MMA(0, 1, At, B1); PG8_BAR; PG8_SCHED;
            PG8_LDA(At, 0, 1); PG8_STAGE(PG8_SB(0, 0), b2, voffB); PG8_STAGE(PG8_SB(0, 1), b2 + hstep, voffB); PG8_STAGE(PG8_SA(0, 0), a2, voffA);
            PG8_WAIT_V(8); PG8_WAIT_L(0); PG8_BAR; PG8_MMA(1, 0, At, B0); PG8_MMA(1, 1, At, B1); PG8_BAR; PG8_SCHED;
            PG8_LDB(B0, 1, 0); PG8_LDB(B1, 1, 1); PG8_SCHED; PG8_LDA(At, 1, 0); PG8_STAGE(PG8_SA(0, 1), a2 + hstepA, voffA);
            PG8_WAIT_V(8); PG8_WAIT_L(0); PG8_BAR; PG8_MMA(0, 0, At, B0); PG8_MMA(0, 1, At, B1); PG8_BAR; PG8_SCHED;
            PG8_LDA(At, 1, 1); PG8_STAGE(PG8_SB(1, 0), b3, voffB); PG8_STAGE(PG8_SB(1, 1), b3 + hstep, voffB); PG8_STAGE(PG8_SA(1, 0), a3, voffA);
            PG8_WAIT_V(8); PG8_WAIT_L(0); PG8_BAR; PG8_MMA(1, 0, At, B0); PG8_MMA(1, 1, At, B1); PG8_BAR; PG8_SCHED;
            } else {
            PG8_LDB(B0, 0, 0); PG8_SCHED; PG8_LDA(At, 0, 0); PG8_STAGE(PG8_SA(1, 1), a1 + hstepA, voffA);
            PG8_WAIT_L(8); PG8_BAR; PG8_WAIT_L(0); PG8_MMA(0, 0, At, B0); PG8_BAR; PG8_SCHED;
            PG8_LDB(B1, 0, 1); PG8_STAGE(PG8_SB(0, 0), b2, voffB);
            PG8_BAR; PG8_WAIT_L(0); PG8_MMA(0, 1, At, B1); PG8_BAR;
            PG8_LDA(At, 0, 1); PG8_STAGE(PG8_SA(0, 0), a2, voffA);
            PG8_BAR; PG8_WAIT_L(0); PG8_MMA(1, 0, At, B0); PG8_BAR; PG8_SCHED;
            PG8_STAGE(PG8_SB(0, 1), b2 + hstep, voffB);
            PG8_WAIT_V(6); PG8_BAR; PG8_MMA(1, 1, At, B1); PG8_BAR;
            PG8_LDB(B0, 1, 0); PG8_SCHED; PG8_LDA(At, 1, 0); PG8_STAGE(PG8_SA(0, 1), a2 + hstepA, voffA);
            PG8_WAIT_L(8); PG8_BAR; PG8_WAIT_L(0); PG8_MMA(0, 0, At, B0); PG8_BAR; PG8_SCHED;
            PG8_LDB(B1, 1, 1); PG8_STAGE(PG8_SB(1, 0), b3, voffB);
            PG8_BAR; PG8_WAIT_L(0); PG8_MMA(0, 1, At, B1); PG8_BAR;
            PG8_LDA(At, 1, 1); PG8_STAGE(PG8_SA(1, 0), a3, voffA);
            PG8_BAR; PG8_WAIT_L(0); PG8_MMA(1, 0, At, B0); PG8_BAR; PG8_SCHED;
            PG8_STAGE(PG8_SB(1, 1), b3 + hstep, voffB);
            PG8_WAIT_V(6); PG8_BAR; PG8_MMA(1, 1, At, B1); PG8_BAR;
            }
        }
        if constexpr (ALIGN_EPI) { if (wr == 0) PG8_BAR; }
        if constexpr (!Epi::AFTER_DRAIN) { E(acc, cur, wr, wc, fr, fq); S.done(cur); }
        if (!has_next) break;
#pragma unroll
        for (int a = 0; a < 2; ++a)
#pragma unroll
            for (int b = 0; b < 2; ++b)
#pragma unroll
                for (int m = 0; m < 4; ++m)
#pragma unroll
                    for (int n = 0; n < 2; ++n) acc[a][b][m][n] = (f32x4){0.f, 0.f, 0.f, 0.f};
        cur = nxt; cA = nA; cB = nB; ++ui;
        if constexpr (ALIGN_EPI) { if (wr == 1) PG8_BAR; }
    }
    PG8_WAIT_V(0);
    if constexpr (!ALIGN_EPI) { if (wr == 0) PG8_BAR; }
    PG8_BAR;
    if constexpr (Epi::AFTER_DRAIN) { E.fused(acc, cur, wr, wc, fr, fq, lds, wid, lane); S.done(cur); }
#undef PG8_SA
#undef PG8_SB
#undef PG8_STAGE
#undef PG8_LDA
#undef PG8_LDB
#undef PG8_MMA
#undef PG8_WAIT_V
#undef PG8_WAIT_L
#undef PG8_BAR
#undef PG8_SCHED
}
}

#ifndef PG8_SP2
#define PG8_SP2 true
#endif
#ifndef PG8_ALIGN
#define PG8_ALIGN true
#endif
constexpr int NWAVES = 8, NTHR = 512;
constexpr int BATCH = 2, SEQ = 8192, DM = 4096, MTOK = BATCH * SEQ;
constexpr int HD = 128;
constexpr int A_HEADS = 16, B_HEADS = 16, A_W = 2048, B_W = 2048, AB_IN = 4 * A_W + 3 * B_W;
constexpr int NSA_H = 32, NSA_G = 4, NSA_R = 8, KVW = 512, NSA_IN = 4096 + 6 * KVW + 96, NSA_INP = 7424;
constexpr int NCMP = 511, NCMPP = 512, NSLC = 128, NTOP = 16, WINDOW = 512;
constexpr int NMEM = 256, XH = 4, XW = 512;
constexpr int DFF = 11008, DFF2 = 22016;
constexpr float LN_EPS = 1e-5f, RMS_EPS = 1e-6f;
constexpr float DN_ALPHA = 1.41421356237309515f;
constexpr size_t MiB = (size_t)1 << 20;
constexpr size_t WS_CTL = 0, CTL_ZERO_BYTES = 4 * MiB;
constexpr size_t WS_FOLD = 64 * 1024;
constexpr int FO_XQ = 0, FO_UP = 2 * 512, FO_NSA = FO_UP + 2 * 22016, FO_N = FO_NSA + 7424;
constexpr size_t WS_RSUM = 1 * MiB;
static_assert(WS_FOLD + (size_t)2 * FO_N * 8 <= WS_RSUM && WS_RSUM + (size_t)6 * 16384 * 2 * 8 <= CTL_ZERO_BYTES, "CTL map");
constexpr size_t WS_W_ABIN = 4 * MiB;
constexpr size_t WS_W_ABOUT = WS_W_ABIN + 112 * MiB;
constexpr size_t WS_W_NSAIN = WS_W_ABOUT + 32 * MiB;
constexpr size_t WS_W_NSAOUT = WS_W_NSAIN + 58 * MiB;
constexpr size_t WS_W_XQ = WS_W_NSAOUT + 32 * MiB;
constexpr size_t WS_W_XKV = WS_W_XQ + 8 * MiB;
constexpr size_t WS_W_XO = WS_W_XKV + 16 * MiB;
constexpr size_t WS_W_UP = WS_W_XO + 8 * MiB;
constexpr size_t WS_W_DOWN = WS_W_UP + 344 * MiB;
constexpr size_t WS_W_C1 = WS_W_DOWN + 172 * MiB;
constexpr size_t WS_W_C2 = WS_W_C1 + 2 * MiB;
constexpr size_t WS_MEMB = WS_W_C2 + 1 * MiB;
constexpr size_t WS_HB = WS_MEMB + 4 * MiB;
constexpr size_t WS_Y = WS_HB + 128 * MiB;
constexpr size_t WS_BIG = WS_Y + 256 * MiB;
constexpr size_t WS_G = WS_BIG + 688 * MiB;
constexpr size_t WS_O = WS_G + 344 * MiB;
constexpr size_t WS_MISC = WS_O + 128 * MiB;
constexpr size_t WS_END = WS_MISC + 64 * MiB;
constexpr size_t WS_XQ = WS_MISC;
constexpr size_t WS_XO = WS_MISC + 16 * MiB;
constexpr size_t WS_XKV = WS_MISC + 32 * MiB;
constexpr size_t WS_LB = WS_MISC + 34 * MiB;
constexpr size_t WS_SIDE = WS_MISC + 42 * MiB;
constexpr size_t WS_FOLDF = WS_MISC + 40 * MiB;
constexpr size_t WS_ROPE = WS_MISC + 36 * MiB;
constexpr size_t WS_STATS = WS_MISC + 35 * MiB;
constexpr size_t WS_PROJ0 = WS_BIG;
constexpr size_t WS_SPREV = WS_BIG + 448 * MiB;
constexpr size_t WS_QT = WS_G;
constexpr size_t WS_OINTRA = WS_G + 64 * MiB;
constexpr size_t WS_DEC = WS_G + 192 * MiB;
constexpr size_t WS_DS = WS_Y;
constexpr size_t WS_PROJ1 = WS_BIG;
constexpr size_t WS_QROT = WS_BIG + 232 * MiB;
constexpr size_t WS_KSROT = WS_BIG + 360 * MiB;
constexpr size_t WS_KWROT = WS_BIG + 376 * MiB;
constexpr size_t WS_KCMP = WS_BIG + 392 * MiB;
constexpr size_t WS_VCMP = WS_BIG + 393 * MiB;
constexpr size_t WS_OVL = WS_BIG + 394 * MiB;
constexpr size_t WS_SEL = WS_BIG + 395 * MiB;
constexpr size_t WS_IMP = WS_G + 256 * MiB;
constexpr size_t WS_O32 = WS_G;
static_assert(WS_SPREV + 128 * MiB <= WS_G && WS_DEC + 2 * MiB <= WS_O && WS_SEL + MiB <= WS_G, "ws map");
constexpr int CW_TMO = 0, CW_CODE = 1;
constexpr int CW_BAR = 4096;
constexpr int RING_OFF = 0, RING_BYTES = 131072;
constexpr int LDSCTL_OFF = RING_BYTES, MISC_OFF = LDSCTL_OFF + 320;
constexpr int LDS_BYTES = 147456;
static_assert(MISC_OFF + 128 <= LDS_BYTES, "LDS map");

#define GAS __attribute__((address_space(1)))
#define LAS __attribute__((address_space(3)))
typedef unsigned short bf16;
typedef unsigned v4u __attribute__((ext_vector_type(4)));
typedef unsigned v2u __attribute__((ext_vector_type(2)));
typedef float f32x4 __attribute__((ext_vector_type(4)));
typedef float f32x2 __attribute__((ext_vector_type(2)));
typedef float f32x16 __attribute__((ext_vector_type(16)));
typedef short bf16x8 __attribute__((ext_vector_type(8)));
typedef short s16x4 __attribute__((ext_vector_type(4)));
typedef GAS unsigned gu32;
#define RLX_AGENT __ATOMIC_RELAXED, __HIP_MEMORY_SCOPE_AGENT
#define LDS_WAIT() asm volatile("s_waitcnt lgkmcnt(0)" ::: "memory")
#define VM_WAIT() asm volatile("s_waitcnt vmcnt(0)" ::: "memory")
#define SBAR() __builtin_amdgcn_sched_barrier(0)
__device__ __forceinline__ unsigned f2bf(float f) { unsigned u = __builtin_bit_cast(unsigned, f); return (u + 0x7fffu + ((u >> 16) & 1u)) >> 16; }
__device__ __forceinline__ unsigned pk2(float lo, float hi) { return f2bf(lo) | (f2bf(hi) << 16); }
__device__ __forceinline__ float bf2f(unsigned short b) { return __builtin_bit_cast(float, (unsigned)b << 16); }
__device__ __forceinline__ float bflo(unsigned w) { return __builtin_bit_cast(float, w << 16); }
__device__ __forceinline__ float bfhi(unsigned w) { return __builtin_bit_cast(float, w & 0xffff0000u); }
__device__ __forceinline__ unsigned cvtpk(float lo, float hi) { unsigned r; asm volatile("v_cvt_pk_bf16_f32 %0, %1, %2" : "=v"(r) : "v"(lo), "v"(hi)); return r; }
__device__ __forceinline__ float wave_sum(float v) {
#pragma unroll
    for (int o = 1; o < 64; o <<= 1) v += __shfl_xor(v, o);
    return v;
}
__device__ __forceinline__ float sigmoidf_(float x) { return __builtin_amdgcn_rcpf(1.f + __builtin_amdgcn_exp2f(-1.4426950408889634f * x)); }
__device__ __forceinline__ float gelu1(float v) { pg8::f32x2 r = pg8::gelu_pk((pg8::f32x2){v, 0.f}); return r.x; }
#define XB_TMO      128
#define XB_XCNT(j)  (256  + 64 * (j))
#define XB_XSUB(j)  (1280 + 64 * (j))
#define XB_XGEN(j)  (2304 + 64 * (j))
#define XB_TOP      3328
#define XB_TOPGEN   3392
#define XCD_BAR_WORDS 3456
#define XB_SPIN_CAP (1u << 18)
#define LAS __attribute__((address_space(3)))

__device__ __forceinline__ unsigned xb_ld(unsigned* p)              { return __hip_atomic_load(p, __ATOMIC_RELAXED, __HIP_MEMORY_SCOPE_AGENT); }
__device__ __forceinline__ unsigned xb_add(unsigned* p, unsigned v) { return __hip_atomic_fetch_add(p, v, __ATOMIC_RELAXED, __HIP_MEMORY_SCOPE_AGENT); }
__device__ __forceinline__ unsigned xb_xcc_id() { return (unsigned)__builtin_amdgcn_s_getreg((3 << 11) | 20) & 0xFu; }
#define XB_SPIN(cond, bar) do { unsigned _sp = 0; while (cond) { __builtin_amdgcn_s_sleep(1); \
    if ((++_sp & 255u) == 0u) { if (xb_ld(&(bar)[XB_TMO])) break; if (_sp > XB_SPIN_CAP) { atomicAdd(&(bar)[XB_TMO], 1u); break; } } } } while (0)

struct XcdBarrier {
    unsigned* bar; unsigned x;
    volatile LAS unsigned* st;
};

__device__ __forceinline__ XcdBarrier xcd_barrier_post(unsigned* bar, volatile LAS unsigned* st) {
    XcdBarrier b; b.bar = bar; b.x = xb_xcc_id(); b.st = st;
    if (threadIdx.x == 0) (void)xb_add(&bar[XB_XCNT(b.x)], 1u);
    return b;
}
__device__ __forceinline__ void xcd_barrier_complete(unsigned* bar, unsigned x, unsigned& nloc, unsigned& nx) {
    const unsigned G = gridDim.x * gridDim.y * gridDim.z;
    unsigned sum, cnt, mine, sp = 0u;
    for (;;) {
        sum = 0u; cnt = 0u; mine = 0u;
#pragma unroll
        for (unsigned j = 0; j < 16; ++j) { const unsigned c = xb_ld(&bar[XB_XCNT(j)]); sum += c; cnt += (c > 0u) ? 1u : 0u; mine = (j == x) ? c : mine; }
        if (sum == G) break;
        __builtin_amdgcn_s_sleep(1);
        if ((++sp & 255u) == 0u) { if (xb_ld(&bar[XB_TMO])) break; if (sp > XB_SPIN_CAP) { atomicAdd(&bar[XB_TMO], 1u); break; } }
    }
    nloc = mine > 0u ? mine : 1u; nx = cnt > 0u ? cnt : 1u;
}

__device__ __forceinline__ void xcd_barrier(const XcdBarrier& b) {
    asm volatile("s_waitcnt vmcnt(0)" ::: "memory");
    __syncthreads();
    if (threadIdx.x == 0) {
        unsigned* bar = b.bar;
        __builtin_amdgcn_s_waitcnt(0);
        unsigned nloc = b.st[0], nx = b.st[1];
        if (nloc == 0u) { xcd_barrier_complete(bar, b.x, nloc, nx); b.st[0] = nloc; b.st[1] = nx; }
        const unsigned old = xb_add(&bar[XB_XSUB(b.x)], 1u);
        const unsigned gen = old / nloc;
        if (old + 1u == (gen + 1u) * nloc) {
            __builtin_amdgcn_fence(__ATOMIC_RELEASE, "agent");
            asm volatile("s_waitcnt vmcnt(0)" ::: "memory");
            const unsigned og = xb_add(&bar[XB_TOP], 1u);
            const unsigned tg = og / nx;
            if (og + 1u == (tg + 1u) * nx) xb_add(&bar[XB_TOPGEN], 1u);
            else XB_SPIN(xb_ld(&bar[XB_TOPGEN]) == tg, bar);
            __builtin_amdgcn_fence(__ATOMIC_ACQUIRE, "agent");
            xb_add(&bar[XB_XGEN(b.x)], 1u);
            asm volatile("s_waitcnt vmcnt(0)" ::: "memory");
        } else {
            XB_SPIN(xb_ld(&bar[XB_XGEN(b.x)]) == gen, bar);
            __builtin_amdgcn_fence(__ATOMIC_ACQUIRE, "agent");
            asm volatile("s_waitcnt vmcnt(0)" ::: "memory");
        }
    }
    __syncthreads();
}


constexpr int ATT_D = 128, KVBLK = 64;
constexpr int SHM_V = KVBLK * ATT_D * 2, SHM_K = KVBLK * ATT_D * 2;
constexpr int ATT_K_OFF = 0, ATT_V_OFF = SHM_K, ATT_BUF = SHM_K + SHM_V, ATT_SET = 2 * ATT_BUF;
constexpr int ATT_WS_OFF = RING_BYTES + 512;
constexpr int ATT_X_OFF = ATT_WS_OFF + NWAVES * 256;
static_assert(2 * ATT_SET <= RING_BYTES && ATT_X_OFF + 2048 + NTHR * 16 <= LDS_BYTES, "attention LDS map");
#define KSWZ(row, colB) ((row) * 256 + ((colB) ^ (((row) & 7) << 4)))
__device__ __forceinline__ int crow(int r, int hi) { return (r & 3) + 8 * (r >> 2) + 4 * hi; }
__device__ __forceinline__ int v_st(int k, int c) { const int kk = (k & ~0xC) | ((k & 4) << 1) | ((k & 8) >> 1); return ((kk >> 3) * 4 + (c >> 5)) * 512 + ((kk & 7) * 32 + (c & 31)) * 2; }
__device__ __forceinline__ int v_rd_base(int lane) { return ((lane & 3) << 3) | (((lane >> 2) & 3) << 6) | (((lane >> 4) & 1) << 5) | (((lane >> 5) & 1) << 8); }
constexpr int v_rd_off(int d0, int ks, int half) { return d0 * 512 + ks * 4096 + half * 2048; }
template <int OFF> __device__ __forceinline__ s16x4 tr_read(int vb) {
  s16x4 r; asm volatile("ds_read_b64_tr_b16 %0, %1 offset:%2" : "=&v"(r) : "v"(vb), "i"(OFF) : "memory"); return r;
}
__device__ __forceinline__ void qkt(f32x16& p0, f32x16& p1, const LAS char* Ks, const bf16x8* qr, int r32, int hi) {
  p0 = f32x16{}; p1 = f32x16{};
#pragma unroll
  for (int d0 = 0; d0 < 8; ++d0) { const int cb = (d0 * 16 + hi * 8) * 2;
    const bf16x8 b0 = *(const LAS bf16x8*)(Ks + KSWZ(r32, cb));
    const bf16x8 b1 = *(const LAS bf16x8*)(Ks + KSWZ(32 + r32, cb));
    p0 = __builtin_amdgcn_mfma_f32_32x32x16_bf16(b0, qr[d0], p0, 0, 0, 0);
    p1 = __builtin_amdgcn_mfma_f32_32x32x16_bf16(b1, qr[d0], p1, 0, 0, 0); }
}
__device__ __forceinline__ void pack_p(const f32x16& p0, const f32x16& p1, bf16x8& pa0, bf16x8& pa1, bf16x8& pa2, bf16x8& pa3) {
#define PK4(P, BASE, OUT) do { unsigned a0 = cvtpk(P[BASE + 0], P[BASE + 1]), a1 = cvtpk(P[BASE + 2], P[BASE + 3]);   \
    unsigned b0 = cvtpk(P[BASE + 4], P[BASE + 5]), b1 = cvtpk(P[BASE + 6], P[BASE + 7]);                              \
    auto r0 = __builtin_amdgcn_permlane32_swap(a0, b0, false, false); auto r1 = __builtin_amdgcn_permlane32_swap(a1, b1, false, false); \
    v4u w = {r0[0], r1[0], r0[1], r1[1]}; OUT = __builtin_bit_cast(bf16x8, w); } while (0)
  PK4(p0, 0, pa0); PK4(p0, 8, pa1); PK4(p1, 0, pa2); PK4(p1, 8, pa3);
#undef PK4
}
template <int D0> __device__ __forceinline__ void pv_one(f32x16& od, int vb, bf16x8 pa0, bf16x8 pa1, bf16x8 pa2, bf16x8 pa3) {
  const s16x4 l0 = tr_read<v_rd_off(D0, 0, 0)>(vb), h0 = tr_read<v_rd_off(D0, 0, 1)>(vb), l1 = tr_read<v_rd_off(D0, 1, 0)>(vb), h1 = tr_read<v_rd_off(D0, 1, 1)>(vb);
  const s16x4 l2 = tr_read<v_rd_off(D0, 2, 0)>(vb), h2 = tr_read<v_rd_off(D0, 2, 1)>(vb), l3 = tr_read<v_rd_off(D0, 3, 0)>(vb), h3 = tr_read<v_rd_off(D0, 3, 1)>(vb);
  asm volatile("s_waitcnt lgkmcnt(0)" ::: "memory"); SBAR();
#define PKV(L, H) (bf16x8){L[0], L[1], L[2], L[3], H[0], H[1], H[2], H[3]}
  od = __builtin_amdgcn_mfma_f32_32x32x16_bf16(pa0, PKV(l0, h0), od, 0, 0, 0);
  od = __builtin_amdgcn_mfma_f32_32x32x16_bf16(pa1, PKV(l1, h1), od, 0, 0, 0);
  od = __builtin_amdgcn_mfma_f32_32x32x16_bf16(pa2, PKV(l2, h2), od, 0, 0, 0);
  od = __builtin_amdgcn_mfma_f32_32x32x16_bf16(pa3, PKV(l3, h3), od, 0, 0, 0);
#undef PKV
}
__device__ __forceinline__ void pv_d0(f32x16* o, int vb, bf16x8 pa0, bf16x8 pa1, bf16x8 pa2, bf16x8 pa3) {
  pv_one<0>(o[0], vb, pa0, pa1, pa2, pa3); pv_one<1>(o[1], vb, pa0, pa1, pa2, pa3); pv_one<2>(o[2], vb, pa0, pa1, pa2, pa3); pv_one<3>(o[3], vb, pa0, pa1, pa2, pa3);
}
struct KVStage { bf16x8 ks0, ks1, vs0, vs1; };
__device__ __forceinline__ void kv_load(KVStage& s, const bf16* Kh, const bf16* Vh, long ldk, long ldv, int k0, int sr, int sc) {
  s.ks0 = *(const bf16x8*)(Kh + (long)(k0 + sr) * ldk + sc); s.ks1 = *(const bf16x8*)(Kh + (long)(k0 + 32 + sr) * ldk + sc);
  s.vs0 = *(const bf16x8*)(Vh + (long)(k0 + sr) * ldv + sc); s.vs1 = *(const bf16x8*)(Vh + (long)(k0 + 32 + sr) * ldv + sc);
}
__device__ __forceinline__ void kv_write(const KVStage& s, LAS char* lds, int sr, int sc) {
  *(LAS bf16x8*)(lds + ATT_V_OFF + v_st(sr, sc)) = s.vs0; *(LAS bf16x8*)(lds + ATT_V_OFF + v_st(32 + sr, sc)) = s.vs1;
  *(LAS bf16x8*)(lds + ATT_K_OFF + KSWZ(sr, sc * 2)) = s.ks0; *(LAS bf16x8*)(lds + ATT_K_OFF + KSWZ(32 + sr, sc * 2)) = s.ks1;
}
struct KVDma { int ko[2], vo[2]; };
__device__ __forceinline__ void kv_dma_init(KVDma& d, int ldk, int ldv, int wid, int lane) {
#pragma unroll
  for (int i = 0; i < 2; ++i) { const int p = wid * 2 + i;
    const int row = p * 4 + (lane >> 4), cp = lane & 15; d.ko[i] = row * ldk + ((cp ^ (row & 7)) << 3);
    const int sub = p * 2 + (lane >> 5), kk = (sub >> 2) * 8 + ((lane & 31) >> 2), k = (kk & ~0xC) | ((kk & 4) << 1) | ((kk & 8) >> 1), c = (sub & 3) * 32 + (lane & 3) * 8;
    d.vo[i] = k * ldv + c; }
}
__device__ __forceinline__ void kv_dma(const KVDma& d, const bf16* Kt, const bf16* Vt, LAS char* lds, int buf, int wid) {
#pragma unroll
  for (int i = 0; i < 2; ++i) {
    __builtin_amdgcn_global_load_lds((const unsigned*)(Kt + d.ko[i]), (LAS unsigned*)(lds + buf + ATT_K_OFF + (wid * 2 + i) * 1024), 16, 0, 0);
    __builtin_amdgcn_global_load_lds((const unsigned*)(Vt + d.vo[i]), (LAS unsigned*)(lds + buf + ATT_V_OFF + (wid * 2 + i) * 1024), 16, 0, 0); }
}
__device__ __forceinline__ void rescale_o(f32x16* o, float a, LAS float* al_l, int r32, int hi) {
  if (__any(a < 1.f)) { if (hi == 0) al_l[r32] = a; LDS_WAIT();
#pragma unroll
    for (int r = 0; r < 16; ++r) { const float f = al_l[crow(r, hi)];
#pragma unroll
      for (int d = 0; d < 4; ++d) o[d][r] *= f; }
    LDS_WAIT(); }
}
constexpr float ATT_SCALE = 0.088388347648318440f, ATT_C = ATT_SCALE * 1.4426950408889634f, ATT_THR = 8.f;
__device__ __forceinline__ void softmax_tile(f32x16& p0, f32x16& p1, float& m_reg, float& l_reg, float& alpha, bool rowvalid = true) {
  float pmax = p0[0];
#pragma unroll
  for (int r = 1; r < 16; ++r) pmax = fmaxf(pmax, p0[r]);
#pragma unroll
  for (int r = 0; r < 16; ++r) pmax = fmaxf(pmax, p1[r]);
  { auto rr = __builtin_amdgcn_permlane32_swap(__float_as_uint(pmax), __float_as_uint(pmax), false, false);
    pmax = fmaxf(__uint_as_float(rr[0]), __uint_as_float(rr[1])); }
  if (!rowvalid) pmax = -__builtin_inff();
  float mn;
  if (__all(pmax - m_reg <= ATT_THR / ATT_SCALE)) { mn = m_reg; alpha = 1.f; }
  else { mn = fmaxf(m_reg, pmax); alpha = __builtin_amdgcn_exp2f((m_reg - mn) * ATT_C); m_reg = mn; }
  const float mnC = rowvalid ? -mn * ATT_C : -__builtin_inff();
#pragma unroll
  for (int r = 0; r < 16; ++r) { p0[r] = __builtin_amdgcn_exp2f(fmaf(p0[r], ATT_C, mnC)); p1[r] = __builtin_amdgcn_exp2f(fmaf(p1[r], ATT_C, mnC)); }
  float ps = 0.f;
#pragma unroll
  for (int r = 0; r < 16; ++r) ps += p0[r] + p1[r];
  { auto rr = __builtin_amdgcn_permlane32_swap(__float_as_uint(ps), __float_as_uint(ps), false, false);
    ps = __uint_as_float(rr[0]) + __uint_as_float(rr[1]); }
  l_reg = l_reg * alpha + ps;
}
__device__ __forceinline__ void attn_finish(f32x16& p0, f32x16& p1, f32x16* o, float& m_reg, float& l_reg, LAS float* wsc, int vb, int r32, int hi, bool rowvalid = true) {
  float alpha; softmax_tile(p0, p1, m_reg, l_reg, alpha, rowvalid);
  rescale_o(o, alpha, wsc, r32, hi);
  bf16x8 pa0, pa1, pa2, pa3; pack_p(p0, p1, pa0, pa1, pa2, pa3);
  pv_d0(o, vb, pa0, pa1, pa2, pa3);
}
__device__ __forceinline__ void load_q(bf16x8* qr, const bf16* Qw) {
#pragma unroll
  for (int d0 = 0; d0 < 8; ++d0) qr[d0] = *(const bf16x8*)(Qw + d0 * 16);
}

struct Frame {
    LAS unsigned char* lds;
    unsigned char* ws;
    int tid, lane, wave, G, bid;
    __device__ __forceinline__ void fresh() { int t = threadIdx.x; asm volatile("" : "+v"(t)); tid = t; lane = t & 63; wave = __builtin_amdgcn_readfirstlane(t >> 6);
        int g_ = gridDim.x, b_ = blockIdx.x; asm volatile("" : "+s"(g_), "+s"(b_)); G = g_; bid = b_; }
};
struct Args { const float* in[19]; float* out; unsigned char* ws; int ph_lo, ph_hi; };
typedef const Args __attribute__((address_space(4))) KArgs;
__device__ __forceinline__ KArgs* karg() { KArgs* p = (KArgs*)__builtin_amdgcn_kernarg_segment_ptr(); asm volatile("" : "+s"(p)); return p; }
#define KIN(i) ((const float*)karg()->in[i])
enum { IN_X = 0, IN_MEM, IN_AB_W_IN, IN_HGRN_LB, IN_HGRN_NW, IN_AB_W_OUT, IN_NSA_W_IN, IN_NSA_CMP_POS, IN_NSA_CMP_W1, IN_NSA_CMP_W2, IN_NSA_W_OUT,
       IN_XA_WQ, IN_XA_WKV, IN_XA_WO, IN_FFN_UP, IN_FFN_CONV, IN_FFN_DOWN, IN_LN_G, IN_LN_B };

__device__ __forceinline__ void p0_transpose_item(const float* W, int K, int N, bf16* WT, LAS float* scr, int item, int lane) {
    const int nblk = N / 32, kb = item / nblk, nb = item % nblk, k0 = 64 * kb, n0 = 32 * nb;
#pragma unroll 8
    for (int i = 0; i < 32; ++i) { const int kk = 2 * i + (lane >> 5); scr[kk * 33 + (lane & 31)] = W[(size_t)(k0 + kk) * N + n0 + (lane & 31)]; }
    LDS_WAIT(); asm volatile("" ::: "memory");
    const int c = lane & 7;
#pragma unroll
    for (int j = 0; j < 4; ++j) { const int n = (lane >> 3) + 8 * j; const LAS float* s = scr + (8 * c) * 33 + n;
        v4u o; o.x = pk2(s[0 * 33], s[1 * 33]); o.y = pk2(s[2 * 33], s[3 * 33]); o.z = pk2(s[4 * 33], s[5 * 33]); o.w = pk2(s[6 * 33], s[7 * 33]);
        *(GAS v4u*)(WT + (size_t)(n0 + n) * K + k0 + 8 * c) = o; }
    LDS_WAIT(); asm volatile("" ::: "memory");
}
__device__ __forceinline__ int up_col(int n) { const int isu = n >= DFF, ch = isu ? n - DFF : n; return (ch >> 7) * 256 + isu * 128 + (ch & 127); }
__device__ __forceinline__ void p0_transpose_item_fold(const float* W, int K, int N, bf16* WT, LAS float* scr, int item, int lane, const float* g, const float* b, long long* cs, long long* b2, bool upmap = false) {
    const int nblk = N / 32, kb = item / nblk, nb = item % nblk, k0 = 64 * kb, n0 = 32 * nb, n0m = upmap ? up_col(n0) : n0;
#pragma unroll 8
    for (int i = 0; i < 32; ++i) { const int kk = 2 * i + (lane >> 5); scr[kk * 33 + (lane & 31)] = W[(size_t)(k0 + kk) * N + n0 + (lane & 31)]; }
    LDS_WAIT(); asm volatile("" ::: "memory");
    const int c = lane & 7;
    const f32x4 g0 = *(const f32x4*)(g + k0 + 8 * c), g1 = *(const f32x4*)(g + k0 + 8 * c + 4), b0 = *(const f32x4*)(b + k0 + 8 * c), b1 = *(const f32x4*)(b + k0 + 8 * c + 4);
    const float gg[8] = {g0.x, g0.y, g0.z, g0.w, g1.x, g1.y, g1.z, g1.w}, bb[8] = {b0.x, b0.y, b0.z, b0.w, b1.x, b1.y, b1.z, b1.w};
#pragma unroll
    for (int j = 0; j < 4; ++j) { const int n = (lane >> 3) + 8 * j; const LAS float* s = scr + (8 * c) * 33 + n;
        float sc = 0.f, sb = 0.f; unsigned w[4];
#pragma unroll
        for (int q = 0; q < 4; ++q) { const float x0 = s[(2 * q) * 33], x1 = s[(2 * q + 1) * 33]; const unsigned r0 = f2bf(x0 * gg[2 * q]), r1 = f2bf(x1 * gg[2 * q + 1]);
            w[q] = r0 | (r1 << 16); sc += bf2f((unsigned short)r0) + bf2f((unsigned short)r1); sb += x0 * bb[2 * q] + x1 * bb[2 * q + 1]; }
        *(GAS v4u*)(WT + (size_t)(n0m + n) * K + k0 + 8 * c) = (v4u){w[0], w[1], w[2], w[3]};
        sc += __shfl_xor(sc, 1); sc += __shfl_xor(sc, 2); sc += __shfl_xor(sc, 4); sb += __shfl_xor(sb, 1); sb += __shfl_xor(sb, 2); sb += __shfl_xor(sb, 4);
        if (c == 0) { atomicAdd((unsigned long long*)(cs + n0m + n), (unsigned long long)(long long)rintf(sc * pg8::FOLD_SCALE)); atomicAdd((unsigned long long*)(b2 + n0m + n), (unsigned long long)(long long)rintf(sb * pg8::FOLD_SCALE)); } }
    LDS_WAIT(); asm volatile("" ::: "memory");
}
__device__ __forceinline__ void transpose_mat_fold(Frame& F, const float* W, int K, int N, bf16* WT, const float* g, const float* b, long long* cs, long long* b2, int c0 = 0, int nw = 1 << 30, int part = 0, int nparts = 1, bool upmap = false) {
    if (F.bid < c0 || F.bid >= c0 + nw) return;
    LAS float* scr = (LAS float*)(F.lds + RING_OFF + F.wave * 16384);
    const int nwg = nw < F.G ? nw : F.G, gw = (F.bid - c0) * NWAVES + F.wave, NGW = nwg * NWAVES;
    const int nitems = (K / 64) * (N / 32), ilo = (int)((long)nitems * part / nparts), ihi = (int)((long)nitems * (part + 1) / nparts);
    for (int it = ilo + gw; it < ihi; it += NGW) p0_transpose_item_fold(W, K, N, WT, scr, it, F.lane, g, b, cs, b2, upmap);
}
__device__ __forceinline__ void transpose_mat(Frame& F, const float* W, int K, int N, bf16* WT, int c0 = 0, int nw = 1 << 30) {
    if (F.bid < c0 || F.bid >= c0 + nw) return;
    LAS float* scr = (LAS float*)(F.lds + RING_OFF + F.wave * 16384);
    const int nwg = nw < F.G ? nw : F.G, gw = (F.bid - c0) * NWAVES + F.wave, NGW = nwg * NWAVES;
    const int nitems = (K / 64) * (N / 32);
    for (int it = gw; it < nitems; it += NGW) p0_transpose_item(W, K, N, WT, scr, it, F.lane);
}
__device__ __forceinline__ void fold_finalize(Frame& F, int lo, int n) {
    const long long* fs = (const long long*)(F.ws + WS_FOLD); float* fd = (float*)(F.ws + WS_FOLDF);
    for (int i = F.bid * NTHR + F.tid; i < 2 * n; i += F.G * NTHR) { const int j = (i < n) ? lo + i : FO_N + lo + (i - n); const long long v = fs[j]; fd[j] = (float)(int)(v >> 32) + (float)(unsigned)v * pg8::FOLD_INV; }
}
enum { CJ_DOWN0, CJ_NSA, CJ_L1A, CJ_L1B, CJ_DOWN1 };
template <int JOB>
__device__ __forceinline__ void convert_job(Frame& F, const Args& A, int c0, int nw) {
    unsigned char* ws = F.ws; long long* cs = (long long*)(ws + WS_FOLD); long long* b2 = cs + FO_N;
    if (JOB == CJ_DOWN0 || JOB == CJ_DOWN1) { const int l = JOB == CJ_DOWN1; transpose_mat(F, KIN(IN_FFN_DOWN) + (size_t)l * DFF * DM, DFF, DM, (bf16*)(ws + WS_W_DOWN) + (size_t)l * DM * DFF, c0, nw); }
    if (JOB == CJ_NSA) {
        transpose_mat_fold(F, KIN(IN_NSA_W_IN), DM, NSA_IN, (bf16*)(ws + WS_W_NSAIN), KIN(IN_LN_G) + 2 * DM, KIN(IN_LN_B) + 2 * DM, cs + FO_NSA, b2 + FO_NSA, c0, nw);
        transpose_mat(F, KIN(IN_NSA_W_OUT), DM, DM, (bf16*)(ws + WS_W_NSAOUT), c0, nw); }
    if (JOB == CJ_L1A || JOB == CJ_L1B) { const int l = 1;
        if (JOB == CJ_L1A) {
            transpose_mat_fold(F, KIN(IN_XA_WQ) + (size_t)l * DM * XW, DM, XW, (bf16*)(ws + WS_W_XQ) + (size_t)l * XW * DM, KIN(IN_LN_G) + (size_t)(3 * l) * DM, KIN(IN_LN_B) + (size_t)(3 * l) * DM, cs + FO_XQ + l * XW, b2 + FO_XQ + l * XW, c0, nw);
            transpose_mat(F, KIN(IN_XA_WKV) + (size_t)l * DM * 2 * XW, DM, 2 * XW, (bf16*)(ws + WS_W_XKV) + (size_t)l * 2 * XW * DM, c0, nw);
            transpose_mat(F, KIN(IN_XA_WO) + (size_t)l * XW * DM, XW, DM, (bf16*)(ws + WS_W_XO) + (size_t)l * DM * XW, c0, nw); }
        transpose_mat_fold(F, KIN(IN_FFN_UP) + (size_t)l * DM * DFF2, DM, DFF2, (bf16*)(ws + WS_W_UP) + (size_t)l * DFF2 * DM, KIN(IN_LN_G) + (size_t)(3 * l + 1) * DM, KIN(IN_LN_B) + (size_t)(3 * l + 1) * DM,
                           cs + FO_UP + l * DFF2, b2 + FO_UP + l * DFF2, c0, nw, JOB == CJ_L1A ? 0 : 1, 2, true); }
}
__device__ __forceinline__ void cvt_flat(Frame& F, const float* src, bf16* dst, long n8) {
    for (long i = (long)F.bid * NTHR + F.tid; i < n8; i += (long)F.G * NTHR) {
        const f32x4 a = *(const f32x4*)(src + i * 8), b = *(const f32x4*)(src + i * 8 + 4);
        v4u o; o.x = pk2(a.x, a.y); o.y = pk2(a.z, a.w); o.z = pk2(b.x, b.y); o.w = pk2(b.z, b.w);
        *(v4u*)(dst + i * 8) = o; }
}
__device__ __forceinline__ void p0_prologue(Frame& F, const Args& A) {
    unsigned char* ws = F.ws;
    long long* cs = (long long*)(ws + WS_FOLD); long long* b2 = cs + FO_N;
    transpose_mat(F, KIN(IN_AB_W_IN), DM, AB_IN, (bf16*)(ws + WS_W_ABIN));
    transpose_mat(F, KIN(IN_AB_W_OUT), DM, DM, (bf16*)(ws + WS_W_ABOUT));
    { const int l = 0;
        transpose_mat_fold(F, KIN(IN_XA_WQ) + (size_t)l * DM * XW, DM, XW, (bf16*)(ws + WS_W_XQ) + (size_t)l * XW * DM, KIN(IN_LN_G) + (size_t)(3 * l) * DM, KIN(IN_LN_B) + (size_t)(3 * l) * DM, cs + FO_XQ + l * XW, b2 + FO_XQ + l * XW);
        transpose_mat(F, KIN(IN_XA_WKV) + (size_t)l * DM * 2 * XW, DM, 2 * XW, (bf16*)(ws + WS_W_XKV) + (size_t)l * 2 * XW * DM);
        transpose_mat(F, KIN(IN_XA_WO) + (size_t)l * XW * DM, XW, DM, (bf16*)(ws + WS_W_XO) + (size_t)l * DM * XW);
        transpose_mat_fold(F, KIN(IN_FFN_UP) + (size_t)l * DM * DFF2, DM, DFF2, (bf16*)(ws + WS_W_UP) + (size_t)l * DFF2 * DM, KIN(IN_LN_G) + (size_t)(3 * l + 1) * DM, KIN(IN_LN_B) + (size_t)(3 * l + 1) * DM, cs + FO_UP + l * DFF2, b2 + FO_UP + l * DFF2, 0, 1 << 30, 0, 1, true); }
    for (int l = 0; l < 2; ++l) {
        transpose_mat(F, KIN(IN_NSA_CMP_W1) + (size_t)l * 32 * HD * HD, 32 * HD, HD, (bf16*)(ws + WS_W_C1) + (size_t)l * HD * 32 * HD);
        transpose_mat(F, KIN(IN_NSA_CMP_W2) + (size_t)l * HD * HD, HD, HD, (bf16*)(ws + WS_W_C2) + (size_t)l * HD * HD);
    }
    cvt_flat(F, KIN(IN_X), (bf16*)(ws + WS_HB), (long)MTOK * DM / 8);
    cvt_flat(F, KIN(IN_MEM), (bf16*)(ws + WS_MEMB), (long)BATCH * NMEM * DM / 8);
    { v4u z = {0u, 0u, 0u, 0u}; v4u* p = (v4u*)((bf16*)(ws + WS_W_NSAIN) + (size_t)NSA_IN * DM); const long n = (long)(NSA_INP - NSA_IN) * DM / 8;
      for (long i = (long)F.bid * NTHR + F.tid; i < n; i += (long)F.G * NTHR) p[i] = z; }
    { float* tab = (float*)(ws + WS_ROPE);
      for (int i = F.bid * NTHR + F.tid; i < SEQ * 64; i += F.G * NTHR) { const int t = i >> 6, d = i & 63;
          float sn, cs; sincosf((float)t * powf(10000.0f, -(float)d * (1.0f / 64.0f)), &sn, &cs); tab[(size_t)t * 128 + d] = cs; tab[(size_t)t * 128 + 64 + d] = sn; } }
    { const float* lbp = KIN(IN_HGRN_LB); float* lbo = (float*)(ws + WS_LB);
      for (int i = F.bid * NTHR + F.tid; i < A_W; i += F.G * NTHR) { const float a = lbp[i], b = lbp[A_W + i], m = fmaxf(a, b), ea = __expf(a - m), eb = __expf(b - m); lbo[i] = ea / (ea + eb); } }
}

__device__ __forceinline__ void ln_phase(Frame& F, const bf16* Y, const float* g, const float* b, float* h32) {
    const int gw = F.bid * NWAVES + F.wave, NGW = F.G * NWAVES;
    for (int m = gw; m < MTOK; m += NGW) {
        const v4u* yr = (const v4u*)(Y + (size_t)m * DM) + F.lane;
        float v[8][8]; float s = 0.f;
#pragma unroll
        for (int j = 0; j < 8; ++j) { const v4u x = yr[64 * j];
            v[j][0] = bflo(x.x); v[j][1] = bfhi(x.x); v[j][2] = bflo(x.y); v[j][3] = bfhi(x.y); v[j][4] = bflo(x.z); v[j][5] = bfhi(x.z); v[j][6] = bflo(x.w); v[j][7] = bfhi(x.w);
#pragma unroll
            for (int q = 0; q < 8; ++q) s += v[j][q]; }
        const float mean = wave_sum(s) * (1.f / DM); float s2 = 0.f;
#pragma unroll
        for (int j = 0; j < 8; ++j)
#pragma unroll
            for (int q = 0; q < 8; ++q) { v[j][q] -= mean; s2 += v[j][q] * v[j][q]; }
        const float rstd = 1.f / sqrtf(wave_sum(s2) * (1.f / DM) + LN_EPS);
#pragma unroll
        for (int j = 0; j < 8; ++j) { const int c0 = 8 * F.lane + 512 * j;
            const f32x4 g0 = *(const f32x4*)(g + c0), g1 = *(const f32x4*)(g + c0 + 4), b0 = *(const f32x4*)(b + c0), b1 = *(const f32x4*)(b + c0 + 4);
            f32x4 r0, r1;
            r0.x = v[j][0] * rstd * g0.x + b0.x; r0.y = v[j][1] * rstd * g0.y + b0.y; r0.z = v[j][2] * rstd * g0.z + b0.z; r0.w = v[j][3] * rstd * g0.w + b0.w;
            r1.x = v[j][4] * rstd * g1.x + b1.x; r1.y = v[j][5] * rstd * g1.y + b1.y; r1.z = v[j][6] * rstd * g1.z + b1.z; r1.w = v[j][7] * rstd * g1.w + b1.w;
            *(f32x4*)(h32 + (size_t)m * DM + c0) = r0; *(f32x4*)(h32 + (size_t)m * DM + c0 + 4) = r1; }
    }
}

__device__ __forceinline__ void cg_unpack(const v4u x, float* o) { o[0] = bflo(x.x); o[1] = bfhi(x.x); o[2] = bflo(x.y); o[3] = bfhi(x.y); o[4] = bflo(x.z); o[5] = bfhi(x.z); o[6] = bflo(x.w); o[7] = bfhi(x.w); }
__device__ __forceinline__ void convglu_fixup_phase(Frame& F, const bf16* SIDE, const float* cw, bf16* Gm) {
    constexpr int NCG = DFF / 8, NRUN = MTOK / 128;
    for (int it = F.bid * NTHR + F.tid; it < NCG * NRUN; it += F.G * NTHR) {
        const int cg = it % NCG, run = it / NCG, c0 = cg * 8, t0 = run * 128;
        float w0[8], w1[8], w2[8], am2[8], am1[8], a0[8], a1[8], u0[8], u1[8];
#pragma unroll
        for (int j = 0; j < 8; ++j) { w0[j] = cw[c0 + j]; w1[j] = cw[DFF + c0 + j]; w2[j] = cw[2 * DFF + c0 + j]; }
        const bf16* sp = SIDE + (size_t)run * 6 * DFF + c0;
        if ((t0 & (SEQ - 1)) == 0) {
#pragma unroll
            for (int j = 0; j < 8; ++j) { am2[j] = 0.f; am1[j] = 0.f; }
        } else { cg_unpack(*(const v4u*)sp, am2); cg_unpack(*(const v4u*)(sp + DFF), am1); }
        cg_unpack(*(const v4u*)(sp + 2 * DFF), a0); cg_unpack(*(const v4u*)(sp + 3 * DFF), a1); cg_unpack(*(const v4u*)(sp + 4 * DFF), u0); cg_unpack(*(const v4u*)(sp + 5 * DFF), u1);
        unsigned o0[4], o1[4];
#pragma unroll
        for (int j = 0; j < 8; j += 2) {
            const pg8::f32x2 g0 = pg8::gelu_pk((pg8::f32x2){w2[j] * a0[j] + w1[j] * am1[j] + w0[j] * am2[j], w2[j + 1] * a0[j + 1] + w1[j + 1] * am1[j + 1] + w0[j + 1] * am2[j + 1]});
            const pg8::f32x2 g1 = pg8::gelu_pk((pg8::f32x2){w2[j] * a1[j] + w1[j] * a0[j] + w0[j] * am1[j], w2[j + 1] * a1[j + 1] + w1[j + 1] * a0[j + 1] + w0[j + 1] * am1[j + 1]});
            o0[j >> 1] = pk2(g0.x * u0[j], g0.y * u0[j + 1]); o1[j >> 1] = pk2(g1.x * u1[j], g1.y * u1[j + 1]); }
        *(v4u*)(Gm + (size_t)t0 * DFF + c0) = (v4u){o0[0], o0[1], o0[2], o0[3]}; *(v4u*)(Gm + (size_t)(t0 + 1) * DFF + c0) = (v4u){o1[0], o1[1], o1[2], o1[3]};
    }
}

__device__ __forceinline__ void xattn_phase(Frame& F, const bf16* XQ, const bf16* XKV, bf16* XO) {
    const int tid = F.tid, wid = F.wave, lane = F.lane, r32 = lane & 31, hi = lane >> 5;
    LAS char* lds = (LAS char*)F.lds;
    LAS float* wsc = (LAS float*)(lds + ATT_WS_OFF + wid * 256);
    const int vb0 = (int)(uintptr_t)(lds + ATT_V_OFF) + v_rd_base(lane);
    KVDma dm; kv_dma_init(dm, 2 * XW, 2 * XW, wid, lane);
    constexpr int NU = (MTOK / 256) * XH;
    for (int u = F.bid; u < NU; u += F.G) {
        const int head = u % XH, rbk = u / XH, row0 = rbk * 256, b = row0 / SEQ;
        const bf16* Kh = XKV + (size_t)b * NMEM * 2 * XW + head * HD; const bf16* Vh = Kh + XW;
        bf16x8 qr[8]; load_q(qr, XQ + (size_t)(row0 + wid * 32 + r32) * XW + head * HD + hi * 8);
        float m_reg = -1e30f, l_reg = 0.f; f32x16 o[4] = {};
        __syncthreads();
        kv_dma(dm, Kh, Vh, lds, 0, wid);
        for (int j = 0; j < NMEM / KVBLK; ++j) {
            const int buf = (j & 1) * ATT_BUF;
            VM_WAIT(); __syncthreads();
            if (j + 1 < NMEM / KVBLK) kv_dma(dm, Kh + (size_t)(j + 1) * KVBLK * 2 * XW, Vh + (size_t)(j + 1) * KVBLK * 2 * XW, lds, ATT_BUF - buf, wid);
            f32x16 p0, p1; qkt(p0, p1, lds + buf + ATT_K_OFF, qr, r32, hi);
            float alpha; softmax_tile(p0, p1, m_reg, l_reg, alpha);
            rescale_o(o, alpha, wsc, r32, hi);
            bf16x8 pa0, pa1, pa2, pa3; pack_p(p0, p1, pa0, pa1, pa2, pa3);
            pv_d0(o, vb0 + buf, pa0, pa1, pa2, pa3);
        }
        if (hi == 0) wsc[32 + r32] = l_reg; LDS_WAIT();
        bf16* Ow = XO + (size_t)(row0 + wid * 32) * XW + head * HD;
#pragma unroll
        for (int r = 0; r < 16; ++r) { const int orow = crow(r, hi); const float rl = __builtin_amdgcn_rcpf(wsc[32 + orow]);
#pragma unroll
            for (int d0 = 0; d0 < 4; ++d0) Ow[(size_t)orow * XW + d0 * 32 + r32] = (bf16)f2bf(o[d0][r] * rl); }
        LDS_WAIT();
    }
}

template <int K>
__device__ __forceinline__ f32x4 mma_tile(const LAS char* A, int lda, const LAS char* B, int ldb, int fr, int fq) {
    f32x4 acc = {0.f, 0.f, 0.f, 0.f};
#pragma unroll
    for (int k0 = 0; k0 < K; k0 += 32) {
        const bf16x8 a = *(const LAS bf16x8*)(A + fr * lda + (k0 + 8 * fq) * 2);
        const bf16x8 b = *(const LAS bf16x8*)(B + fr * ldb + (k0 + 8 * fq) * 2);
        acc = __builtin_amdgcn_mfma_f32_16x16x32_bf16(a, b, acc, 0, 0, 0);
    }
    return acc;
}
constexpr int HG_CH = 64, HG_NC = SEQ / HG_CH, HG_ITEMS = BATCH * A_HEADS * HG_NC;
constexpr int HG_QT = 0, HG_KT = 17408, HG_KH = 34816, HG_VT = 53248, HG_PT = 71680, HG_SEG = 80896;
constexpr int HG_SP = 17408, HG_OT = 52224;
constexpr int HG_WT = 80896, HG_KHS = 86016, HG_VS = 103424;
__device__ __forceinline__ void hgrn_phase_a(Frame& F, const bf16* P0, const float* lbv, bf16* QTg, bf16* OINTRA, bf16* DS, float* DEC) {
    LAS char* lds = (LAS char*)F.lds;
    const int tid = F.tid, wid = F.wave, lane = F.lane, fr = lane & 15, fq = lane >> 4;
    const int dg = tid & 15, sq = tid >> 4;
    const int d = tid & 127, sq16 = tid >> 7;
    for (int it = F.bid; it < HG_ITEMS; it += F.G) {
        const int c = it % HG_NC, bh = it / HG_NC, h = bh % A_HEADS, b = bh / A_HEADS;
        const size_t row0 = (size_t)b * SEQ + (size_t)c * HG_CH;
        float lb[8], q[2][8], kk[2][8], cum[2][8]; v4u vraw[2];
        { const f32x4 l0 = *(const f32x4*)(lbv + h * HD + 8 * dg), l1 = *(const f32x4*)(lbv + h * HD + 8 * dg + 4);
          lb[0] = l0.x; lb[1] = l0.y; lb[2] = l0.z; lb[3] = l0.w; lb[4] = l1.x; lb[5] = l1.y; lb[6] = l1.z; lb[7] = l1.w; }
#pragma unroll
        for (int rr = 0; rr < 2; ++rr) { const bf16* rowp = P0 + (row0 + 2 * sq + rr) * AB_IN + h * HD + 8 * dg;
            const v4u zq = *(const v4u*)(rowp + A_W), qq = *(const v4u*)rowp; vraw[rr] = *(const v4u*)(rowp + 2 * A_W);
            const unsigned zw[4] = {zq.x, zq.y, zq.z, zq.w}, qw[4] = {qq.x, qq.y, qq.z, qq.w};
#pragma unroll
            for (int j = 0; j < 8; ++j) { const float z = (j & 1) ? bfhi(zw[j >> 1]) : bflo(zw[j >> 1]); q[rr][j] = (j & 1) ? bfhi(qw[j >> 1]) : bflo(qw[j >> 1]);
                const float sg = sigmoidf_(z), omlb = 1.f - lb[j]; kk[rr][j] = omlb * (1.f - sg);
                const float lf = __logf(lb[j] + omlb * sg); cum[rr][j] = rr ? cum[0][j] + lf : lf; } }
        float pre[8];
#pragma unroll
        for (int j = 0; j < 8; ++j) { const float seg = cum[1][j]; float x = seg; const float t1 = __shfl_up(x, 16); if (lane >= 16) x += t1; const float t2 = __shfl_up(x, 32); if (lane >= 32) x += t2;
            pre[j] = x - seg; if (lane >= 48) ((LAS float*)(lds + HG_WT))[wid * 128 + 8 * dg + j] = x; }
        LDS_WAIT(); __syncthreads();
        float total[8];
#pragma unroll
        for (int j = 0; j < 8; ++j) total[j] = 0.f;
#pragma unroll
        for (int w = 0; w < NWAVES; ++w) { const f32x4 a0 = *(const LAS f32x4*)(lds + HG_WT + (w * 128 + 8 * dg) * 4), a1 = *(const LAS f32x4*)(lds + HG_WT + (w * 128 + 8 * dg + 4) * 4);
            const float av[8] = {a0.x, a0.y, a0.z, a0.w, a1.x, a1.y, a1.z, a1.w};
#pragma unroll
            for (int j = 0; j < 8; ++j) { total[j] += av[j]; if (w < wid) pre[j] += av[j]; } }
#pragma unroll
        for (int rr = 0; rr < 2; ++rr) { const int s = 2 * sq + rr; unsigned qt[4], kt[4], kh[4];
#pragma unroll
            for (int j = 0; j < 8; j += 2) { const float b0 = pre[j] + cum[rr][j], b1 = pre[j + 1] + cum[rr][j + 1];
                qt[j >> 1] = pk2(q[rr][j] * __expf(b0), q[rr][j + 1] * __expf(b1));
                kt[j >> 1] = pk2(kk[rr][j] * __expf(-b0), kk[rr][j + 1] * __expf(-b1));
                kh[j >> 1] = pk2(kk[rr][j] * __expf(total[j] - b0), kk[rr][j + 1] * __expf(total[j + 1] - b1)); }
            const v4u qv = {qt[0], qt[1], qt[2], qt[3]};
            *(LAS v4u*)(lds + HG_QT + s * 272 + dg * 16) = qv; *(v4u*)(QTg + (row0 + s) * A_W + h * HD + 8 * dg) = qv;
            *(LAS v4u*)(lds + HG_KT + s * 272 + dg * 16) = (v4u){kt[0], kt[1], kt[2], kt[3]};
            *(LAS v4u*)(lds + HG_KHS + s * 272 + dg * 16) = (v4u){kh[0], kh[1], kh[2], kh[3]};
            *(LAS v4u*)(lds + HG_VS + s * 272 + dg * 16) = vraw[rr]; }
        if (sq == 31) { f32x4 e0, e1; e0.x = __expf(total[0]); e0.y = __expf(total[1]); e0.z = __expf(total[2]); e0.w = __expf(total[3]); e1.x = __expf(total[4]); e1.y = __expf(total[5]); e1.z = __expf(total[6]); e1.w = __expf(total[7]);
            *(f32x4*)(DEC + (size_t)it * HD + 8 * dg) = e0; *(f32x4*)(DEC + (size_t)it * HD + 8 * dg + 4) = e1; }
        LDS_WAIT(); __syncthreads();
        { unsigned kh[8], vt[8];
#pragma unroll
          for (int j = 0; j < 16; j += 2) { const int s = 16 * sq16 + j;
              kh[j >> 1] = (unsigned)*(const LAS unsigned short*)(lds + HG_KHS + s * 272 + d * 2) | ((unsigned)*(const LAS unsigned short*)(lds + HG_KHS + (s + 1) * 272 + d * 2) << 16);
              vt[j >> 1] = (unsigned)*(const LAS unsigned short*)(lds + HG_VS + s * 272 + d * 2) | ((unsigned)*(const LAS unsigned short*)(lds + HG_VS + (s + 1) * 272 + d * 2) << 16); }
          LAS v4u* pk = (LAS v4u*)(lds + HG_KH + d * 144 + sq16 * 32); pk[0] = (v4u){kh[0], kh[1], kh[2], kh[3]}; pk[1] = (v4u){kh[4], kh[5], kh[6], kh[7]};
          LAS v4u* pv = (LAS v4u*)(lds + HG_VT + d * 144 + sq16 * 32); pv[0] = (v4u){vt[0], vt[1], vt[2], vt[3]}; pv[1] = (v4u){vt[4], vt[5], vt[6], vt[7]}; }
        LDS_WAIT(); __syncthreads();
#pragma unroll
        for (int k = 0; k < 2; ++k) { const int tau = 2 * wid + k, ti = tau >> 2, si = tau & 3;
            f32x4 acc = {0.f, 0.f, 0.f, 0.f};
            if (si <= ti) acc = mma_tile<128>(lds + HG_QT + ti * 16 * 272, 272, lds + HG_KT + si * 16 * 272, 272, fr, fq);
#pragma unroll
            for (int i = 0; i < 4; ++i) { const int t = 16 * ti + 4 * fq + i, s = 16 * si + fr; const float v = (s <= t) ? acc[i] : 0.f;
                *(LAS unsigned short*)(lds + HG_PT + t * 144 + s * 2) = (unsigned short)f2bf(v); } }
        LDS_WAIT(); __syncthreads();
#pragma unroll
        for (int k = 0; k < 4; ++k) { const int tau = wid + 8 * k, ti = tau >> 3, vi = tau & 7;
            const f32x4 acc = mma_tile<64>(lds + HG_VT + vi * 16 * 144, 144, lds + HG_PT + ti * 16 * 144, 144, fr, fq);
            v2u w; w.x = pk2(acc[0], acc[1]); w.y = pk2(acc[2], acc[3]);
            *(v2u*)(OINTRA + (row0 + 16 * ti + fr) * A_W + h * HD + 16 * vi + 4 * fq) = w; }
#pragma unroll
        for (int k = 0; k < 8; ++k) { const int tau = wid + 8 * k, vi = tau >> 3, ki = tau & 7;
            const f32x4 acc = mma_tile<64>(lds + HG_KH + ki * 16 * 144, 144, lds + HG_VT + vi * 16 * 144, 144, fr, fq);
            v2u w; w.x = pk2(acc[0], acc[1]); w.y = pk2(acc[2], acc[3]);
            *(v2u*)(DS + ((size_t)it * HD + 16 * vi + fr) * HD + 16 * ki + 4 * fq) = w; }
        LDS_WAIT(); __syncthreads();
    }
}
__device__ __forceinline__ void hgrn_phase_b(Frame& F, const bf16* DS, const float* DEC, bf16* SPREV) {
    const int tid = F.tid, dvl = tid >> 5, dk4 = (tid & 31) * 4;
    for (int item = F.bid; item < BATCH * A_HEADS * 8; item += F.G) {
        const int sl = item & 7, bh = item >> 3, dv = sl * 16 + dvl;
        f32x4 S = {0.f, 0.f, 0.f, 0.f};
        for (int c0 = 0; c0 < HG_NC; c0 += 8) {
            f32x4 ds[8], dc[8];
#pragma unroll
            for (int k = 0; k < 8; ++k) { const size_t it = (size_t)bh * HG_NC + c0 + k; const v2u x = *(const v2u*)(DS + (it * HD + dv) * HD + dk4);
                ds[k] = (f32x4){bflo(x.x), bfhi(x.x), bflo(x.y), bfhi(x.y)}; dc[k] = *(const f32x4*)(DEC + it * HD + dk4); }
#pragma unroll
            for (int k = 0; k < 8; ++k) { const size_t it = (size_t)bh * HG_NC + c0 + k;
                v2u w; w.x = pk2(S.x, S.y); w.y = pk2(S.z, S.w); *(v2u*)(SPREV + (it * HD + dv) * HD + dk4) = w;
                S = S * dc[k] + ds[k]; }
        }
    }
}
__device__ __forceinline__ void hgrn_phase_c(Frame& F, const bf16* P0, const bf16* QTg, const bf16* OINTRA, const bf16* SPREV, const float* nw, bf16* Ob) {
    LAS char* lds = (LAS char*)F.lds;
    const int tid = F.tid, wid = F.wave, lane = F.lane, fr = lane & 15, fq = lane >> 4;
    for (int it = F.bid; it < HG_ITEMS; it += F.G) {
        const int c = it % HG_NC, bh = it / HG_NC, h = bh % A_HEADS, b = bh / A_HEADS;
        const size_t row0 = (size_t)b * SEQ + (size_t)c * HG_CH;
        { const int s = tid >> 3, ch = (tid & 7) * 16; const bf16* src = QTg + (row0 + s) * A_W + h * HD + ch;
          const v4u x0 = *(const v4u*)src, x1 = *(const v4u*)(src + 8); LAS v4u* dst = (LAS v4u*)(lds + HG_QT + s * 272 + ch * 2); dst[0] = x0; dst[1] = x1; }
        { const int dv = tid >> 2, ch = (tid & 3) * 32; const bf16* src = SPREV + ((size_t)it * HD + dv) * HD + ch;
          const v4u x0 = *(const v4u*)src, x1 = *(const v4u*)(src + 8), x2 = *(const v4u*)(src + 16), x3 = *(const v4u*)(src + 24);
          LAS v4u* dst = (LAS v4u*)(lds + HG_SP + dv * 272 + ch * 2); dst[0] = x0; dst[1] = x1; dst[2] = x2; dst[3] = x3; }
        LDS_WAIT(); __syncthreads();
#pragma unroll
        for (int k = 0; k < 4; ++k) { const int tau = wid + 8 * k, ti = tau >> 3, vi = tau & 7;
            const f32x4 acc = mma_tile<128>(lds + HG_SP + vi * 16 * 272, 272, lds + HG_QT + ti * 16 * 272, 272, fr, fq);
            const int t = 16 * ti + fr, dv = 16 * vi + 4 * fq; const v2u oi = *(const v2u*)(OINTRA + (row0 + t) * A_W + h * HD + dv);
            *(LAS f32x4*)(lds + HG_OT + (t * 132 + dv) * 4) = (f32x4){acc[0] + bflo(oi.x), acc[1] + bfhi(oi.x), acc[2] + bflo(oi.y), acc[3] + bfhi(oi.y)}; }
        LDS_WAIT(); __syncthreads();
        { const int t = tid >> 3, dv0 = (tid & 7) * 16;
          float v[16]; float ss = 0.f;
#pragma unroll
          for (int q4 = 0; q4 < 4; ++q4) { const f32x4 x = *(const LAS f32x4*)(lds + HG_OT + (t * 132 + dv0 + 4 * q4) * 4); v[4 * q4] = x.x; v[4 * q4 + 1] = x.y; v[4 * q4 + 2] = x.z; v[4 * q4 + 3] = x.w;
              ss += (x.x * x.x + x.y * x.y) + (x.z * x.z + x.w * x.w); }
          ss += __shfl_xor(ss, 1); ss += __shfl_xor(ss, 2); ss += __shfl_xor(ss, 4);
          const float r = 1.f / sqrtf(ss * (1.f / HD) + RMS_EPS);
          const bf16* gp = P0 + (row0 + t) * AB_IN + 3 * A_W + h * HD + dv0; const v4u g0 = *(const v4u*)gp, g1 = *(const v4u*)(gp + 8);
          const unsigned gw[8] = {g0.x, g0.y, g0.z, g0.w, g1.x, g1.y, g1.z, g1.w}; unsigned o[8];
#pragma unroll
          for (int j = 0; j < 8; ++j) { const float ga = bflo(gw[j]), gb = bfhi(gw[j]);
              o[j] = pk2(v[2 * j] * r * nw[dv0 + 2 * j] * ga * sigmoidf_(ga), v[2 * j + 1] * r * nw[dv0 + 2 * j + 1] * gb * sigmoidf_(gb)); }
          bf16* op = Ob + (row0 + t) * DM + h * HD + dv0; *(v4u*)op = (v4u){o[0], o[1], o[2], o[3]}; *(v4u*)(op + 8) = (v4u){o[4], o[5], o[6], o[7]}; }
        LDS_WAIT(); __syncthreads();
    }
}

constexpr float SB_CUT = -160.f;
__device__ __forceinline__ void sb_phase(Frame& F, const bf16* P0, bf16* Ob) {
    const int tid = F.tid, wid = F.wave, lane = F.lane, r32 = lane & 31, hi = lane >> 5;
    LAS char* lds = (LAS char*)F.lds;
    const int vb0 = (int)(uintptr_t)(lds + ATT_V_OFF) + v_rd_base(lane);
    KVDma dm; kv_dma_init(dm, AB_IN, AB_IN, wid, lane);
    constexpr int NQB = SEQ / 256, NU = BATCH * B_HEADS * NQB;
    for (int rd = 0; ; ++rd) {
        const int idx = (rd & 1) ? rd * F.G + (F.G - 1 - F.bid) : rd * F.G + F.bid;
        if (rd * F.G >= NU) break;
        if (idx >= NU) continue;
        const int qb = NQB - 1 - idx / (BATCH * B_HEADS), bh = idx % (BATCH * B_HEADS), head = bh % B_HEADS, b = bh / B_HEADS;
        const size_t rowb = (size_t)b * SEQ; const int q0 = qb * 256;
        const bf16* Kh = P0 + rowb * AB_IN + 4 * A_W + B_W + head * HD; const bf16* Vh = Kh + B_W;
        const int tw0 = q0 + wid * 32, t = tw0 + r32;
        bf16x8 qr[8]; load_q(qr, P0 + (rowb + t) * AB_IN + 4 * A_W + head * HD + hi * 8);
        float R = 0.f; f32x16 o[4] = {};
        const int jtop = (q0 + 254) >> 6;
        LAS unsigned* dflag = (LAS unsigned*)(lds + ATT_X_OFF);
        if (lane == 0) { dflag[wid] = 0u; dflag[8 + wid] = 0u; }
        LDS_WAIT(); __syncthreads();
        kv_dma(dm, Kh + (size_t)jtop * KVBLK * AB_IN, Vh + (size_t)jtop * KVBLK * AB_IN, lds, 0, wid);
        int buf = 0;
        for (int j = jtop; j >= 0; --j, buf = ATT_BUF - buf) {
            VM_WAIT(); __syncthreads();
            { unsigned alld = 1u;
#pragma unroll
              for (int w = 0; w < NWAVES; ++w) alld &= dflag[((j + 1) & 1) * 8 + w];
              if (__builtin_amdgcn_readfirstlane(alld)) break; }
            if (j > 0) kv_dma(dm, Kh + (size_t)(j - 1) * KVBLK * AB_IN, Vh + (size_t)(j - 1) * KVBLK * AB_IN, lds, ATT_BUF - buf, wid);
            const int k0 = j * KVBLK;
            if (k0 < tw0 + 31) {
                f32x16 p0, p1; qkt(p0, p1, lds + buf + ATT_K_OFF, qr, r32, hi);
                const bool need_mask = (k0 + 63 >= tw0);
                float L0[16], L1[16];
#pragma unroll
                for (int r = 0; r < 16; ++r) {
                    const float z0 = p0[r] * ATT_C, z1 = p1[r] * ATT_C;
                    float l0 = -(fmaxf(z0, 0.f) + __builtin_amdgcn_logf(1.f + __builtin_amdgcn_exp2f(-fabsf(z0))));
                    float l1 = -(fmaxf(z1, 0.f) + __builtin_amdgcn_logf(1.f + __builtin_amdgcn_exp2f(-fabsf(z1))));
                    if (need_mask) { if (k0 + crow(r, hi) >= t) l0 = 0.f; if (k0 + 32 + crow(r, hi) >= t) l1 = 0.f; }
                    L0[r] = l0; L1[r] = l1; p0[r] = z0 + l0; p1[r] = z1 + l1;
                }
                SBAR();
                float Sg[16];
#pragma unroll
                for (int gi = 0; gi < 4; ++gi) {
                    const float a = (L0[4 * gi] + L0[4 * gi + 1]) + (L0[4 * gi + 2] + L0[4 * gi + 3]), c = (L1[4 * gi] + L1[4 * gi + 1]) + (L1[4 * gi + 2] + L1[4 * gi + 3]);
                    auto ra = __builtin_amdgcn_permlane32_swap(__float_as_uint(a), __float_as_uint(a), false, false);
                    auto rc = __builtin_amdgcn_permlane32_swap(__float_as_uint(c), __float_as_uint(c), false, false);
                    Sg[2 * gi] = __uint_as_float(ra[0]); Sg[2 * gi + 1] = __uint_as_float(ra[1]); Sg[8 + 2 * gi] = __uint_as_float(rc[0]); Sg[8 + 2 * gi + 1] = __uint_as_float(rc[1]);
                }
                float run = R;
#pragma unroll
                for (int s = 15; s >= 0; --s) { const float tt = run; run += Sg[s]; Sg[s] = tt; }
                const float Rn = run;
                SBAR();
#pragma unroll
                for (int gi = 0; gi < 4; ++gi) {
                    float base0 = hi ? Sg[2 * gi + 1] : Sg[2 * gi], base1 = hi ? Sg[8 + 2 * gi + 1] : Sg[8 + 2 * gi];
                    float r3 = base0, r2 = r3 + L0[4 * gi + 3], r1 = r2 + L0[4 * gi + 2], r0 = r1 + L0[4 * gi + 1];
                    p0[4 * gi + 3] = __builtin_amdgcn_exp2f(p0[4 * gi + 3] + r3); p0[4 * gi + 2] = __builtin_amdgcn_exp2f(p0[4 * gi + 2] + r2);
                    p0[4 * gi + 1] = __builtin_amdgcn_exp2f(p0[4 * gi + 1] + r1); p0[4 * gi + 0] = __builtin_amdgcn_exp2f(p0[4 * gi + 0] + r0);
                    r3 = base1; r2 = r3 + L1[4 * gi + 3]; r1 = r2 + L1[4 * gi + 2]; r0 = r1 + L1[4 * gi + 1];
                    p1[4 * gi + 3] = __builtin_amdgcn_exp2f(p1[4 * gi + 3] + r3); p1[4 * gi + 2] = __builtin_amdgcn_exp2f(p1[4 * gi + 2] + r2);
                    p1[4 * gi + 1] = __builtin_amdgcn_exp2f(p1[4 * gi + 1] + r1); p1[4 * gi + 0] = __builtin_amdgcn_exp2f(p1[4 * gi + 0] + r0);
                }
                R = Rn;
                { const unsigned dn = __all(R < SB_CUT) ? 1u : 0u; if (lane == 0) dflag[(j & 1) * 8 + wid] = dn; }
                if (need_mask) {
#pragma unroll
                    for (int r = 0; r < 16; ++r) { if (k0 + crow(r, hi) >= t) p0[r] = 0.f; if (k0 + 32 + crow(r, hi) >= t) p1[r] = 0.f; }
                }
                bf16x8 pa0, pa1, pa2, pa3; pack_p(p0, p1, pa0, pa1, pa2, pa3);
                pv_d0(o, vb0 + buf, pa0, pa1, pa2, pa3);
            }
        }
        bf16* Ow = Ob + (rowb + tw0) * DM + A_W + head * HD;
#pragma unroll
        for (int r = 0; r < 16; ++r) { const int orow = crow(r, hi);
#pragma unroll
            for (int d0 = 0; d0 < 4; ++d0) Ow[(size_t)orow * DM + d0 * 32 + r32] = (bf16)f2bf(o[d0][r]); }
    }
}

constexpr int P1_KC = 4096, P1_VC = 4608, P1_KS = 5120, P1_VS = 5632, P1_KW = 6144, P1_VW = 6656, P1_GL = 7168;
__device__ __forceinline__ void nsa_rope_phase(Frame& F, const bf16* P1, const float* TAB, bf16* QROT, bf16* KSROT, bf16* KWROT, bf16* OVL) {
    const int gw = F.bid * NWAVES + F.wave, NGW = F.G * NWAVES, lane = F.lane, hsub = lane >> 3, d0 = (lane & 7) * 8;
    for (int m = gw; m < MTOK; m += NGW) {
        const int t = m & (SEQ - 1);
        const f32x4 c0 = *(const f32x4*)(TAB + (size_t)t * 128 + d0), c1 = *(const f32x4*)(TAB + (size_t)t * 128 + d0 + 4);
        const f32x4 s0 = *(const f32x4*)(TAB + (size_t)t * 128 + 64 + d0), s1 = *(const f32x4*)(TAB + (size_t)t * 128 + 64 + d0 + 4);
        const float cs[8] = {c0.x, c0.y, c0.z, c0.w, c1.x, c1.y, c1.z, c1.w}, sn[8] = {s0.x, s0.y, s0.z, s0.w, s1.x, s1.y, s1.z, s1.w};
        const bf16* row = P1 + (size_t)m * NSA_INP;
#pragma unroll
        for (int hb = 0; hb < 5; ++hb) {
            const int hh = hb * 8 + hsub;
            const bf16* src; bf16* dst;
            if (hh < 32) { src = row + hh * HD; dst = QROT + (size_t)m * DM + hh * HD; }
            else if (hh < 36) { src = row + P1_KS + (hh - 32) * HD; dst = KSROT + (size_t)m * KVW + (hh - 32) * HD; }
            else { src = row + P1_KW + (hh - 36) * HD; dst = KWROT + (size_t)m * KVW + (hh - 36) * HD; }
            const v4u a = *(const v4u*)(src + d0), bq = *(const v4u*)(src + 64 + d0);
            const unsigned aw[4] = {a.x, a.y, a.z, a.w}, bw[4] = {bq.x, bq.y, bq.z, bq.w}; unsigned o1[4], o2[4];
#pragma unroll
            for (int q = 0; q < 4; ++q) { const float x1l = bflo(aw[q]), x1h = bfhi(aw[q]), x2l = bflo(bw[q]), x2h = bfhi(bw[q]);
                o1[q] = pk2(x1l * cs[2 * q] - x2l * sn[2 * q], x1h * cs[2 * q + 1] - x2h * sn[2 * q + 1]);
                o2[q] = pk2(x2l * cs[2 * q] + x1l * sn[2 * q], x2h * cs[2 * q + 1] + x1h * sn[2 * q + 1]); }
            *(v4u*)(dst + d0) = (v4u){o1[0], o1[1], o1[2], o1[3]}; *(v4u*)(dst + 64 + d0) = (v4u){o2[0], o2[1], o2[2], o2[3]};
        }
    }
    for (int i = F.bid * NTHR + F.tid; i < NCMPP * NSLC; i += F.G * NTHR) { const int n = i / NSLC, j = i % NSLC;
        OVL[i] = (n < NCMP && n >= 4 * j - 1 && n <= 4 * j + 3) ? (bf16)0x3f80u : (bf16)0u; }
}
constexpr int CM_A = 0, CM_B = 17408, CM_H = 17408 + 34816;
__device__ __forceinline__ void nsa_compress_phase(Frame& F, const bf16* P1, const float* pos, const bf16* W1t, const bf16* W2t, bf16* KCMP, bf16* VCMP) {
    LAS char* lds = (LAS char*)F.lds;
    const int tid = F.tid, wid = F.wave, lane = F.lane, fr = lane & 15, fq = lane >> 4;
    for (int item = F.bid; item < 128; item += F.G) {
        const int nt = item & 7, g = (item >> 3) & 3, b = (item >> 5) & 1, which = item >> 6;
        const bf16* w1 = W1t + (size_t)which * HD * 32 * HD; const bf16* w2 = W2t + (size_t)which * HD * HD;
        const float* posw = pos + (size_t)which * 32 * HD;
        f32x4 acc[4];
#pragma unroll
        for (int k = 0; k < 4; ++k) acc[k] = (f32x4){0.f, 0.f, 0.f, 0.f};
        for (int l = 0; l < 32; ++l) {
            { const int r = tid >> 3, ch = (tid & 7) * 16, n = nt * 64 + r; unsigned w[8];
              if (n < NCMP) { const bf16* src = P1 + ((size_t)b * SEQ + 16 * n + l) * NSA_INP + P1_KC + which * KVW + g * HD + ch;
                  const v4u x0 = *(const v4u*)src, x1 = *(const v4u*)(src + 8); const unsigned xs[8] = {x0.x, x0.y, x0.z, x0.w, x1.x, x1.y, x1.z, x1.w};
#pragma unroll
                  for (int q = 0; q < 8; ++q) w[q] = pk2(bflo(xs[q]) + posw[l * HD + ch + 2 * q], bfhi(xs[q]) + posw[l * HD + ch + 2 * q + 1]);
              } else {
#pragma unroll
                  for (int q = 0; q < 8; ++q) w[q] = 0u; }
              LAS v4u* dst = (LAS v4u*)(lds + CM_A + r * 272 + ch * 2); dst[0] = (v4u){w[0], w[1], w[2], w[3]}; dst[1] = (v4u){w[4], w[5], w[6], w[7]}; }
            { const int e = tid >> 2, ch = (tid & 3) * 32; const bf16* src = w1 + (size_t)e * 32 * HD + l * HD + ch;
              const v4u x0 = *(const v4u*)src, x1 = *(const v4u*)(src + 8), x2 = *(const v4u*)(src + 16), x3 = *(const v4u*)(src + 24);
              LAS v4u* dst = (LAS v4u*)(lds + CM_B + e * 272 + ch * 2); dst[0] = x0; dst[1] = x1; dst[2] = x2; dst[3] = x3; }
            LDS_WAIT(); __syncthreads();
#pragma unroll
            for (int k = 0; k < 4; ++k) { const int tau = wid + 8 * k, ni = tau >> 3, ei = tau & 7;
                acc[k] += mma_tile<128>(lds + CM_A + ni * 16 * 272, 272, lds + CM_B + ei * 16 * 272, 272, fr, fq); }
            LDS_WAIT(); __syncthreads();
        }
#pragma unroll
        for (int k = 0; k < 4; ++k) { const int tau = wid + 8 * k, ni = tau >> 3, ei = tau & 7;
#pragma unroll
            for (int i = 0; i < 4; ++i) *(LAS unsigned short*)(lds + CM_H + (16 * ni + 4 * fq + i) * 272 + (16 * ei + fr) * 2) = (unsigned short)f2bf(gelu1(acc[k][i])); }
        { const int f = tid >> 2, ch = (tid & 3) * 32; const bf16* src = w2 + (size_t)f * HD + ch;
          const v4u x0 = *(const v4u*)src, x1 = *(const v4u*)(src + 8), x2 = *(const v4u*)(src + 16), x3 = *(const v4u*)(src + 24);
          LAS v4u* dst = (LAS v4u*)(lds + CM_B + f * 272 + ch * 2); dst[0] = x0; dst[1] = x1; dst[2] = x2; dst[3] = x3; }
        LDS_WAIT(); __syncthreads();
        bf16* outp = which ? VCMP : KCMP;
#pragma unroll
        for (int k = 0; k < 4; ++k) { const int tau = wid + 8 * k, ni = tau >> 3, fi = tau & 7;
            const f32x4 a2 = mma_tile<128>(lds + CM_H + ni * 16 * 272, 272, lds + CM_B + fi * 16 * 272, 272, fr, fq);
#pragma unroll
            for (int i = 0; i < 4; ++i) { const int n = nt * 64 + 16 * ni + 4 * fq + i;
                outp[(((size_t)b * NCMPP + n) * NSA_G + g) * HD + 16 * fi + fr] = (n < NCMP) ? (bf16)f2bf(a2[i]) : (bf16)0u; } }
        LDS_WAIT(); __syncthreads();
    }
}
__device__ __forceinline__ unsigned topk_key(float v) { const unsigned u = (v == 0.f) ? 0u : __builtin_bit_cast(unsigned, v); return u ^ ((u >> 31) ? 0xffffffffu : 0x80000000u); }
__device__ __forceinline__ v4u topk_select(float a0, float a1, int cur, int lane) {
    const unsigned k0 = topk_key(a0), k1 = topk_key(a1);
    const int j0 = lane, j1 = lane + 64;
    const bool f0 = (j0 == 0) || (j0 == cur) || (j0 == cur - 1), f1 = (j1 == cur) || (j1 == cur - 1);
    const unsigned long long c0m = __ballot(!f0 && j0 <= cur), c1m = __ballot(!f1 && j1 <= cur);
    const int nforced = cur >= 2 ? 3 : cur + 1, slots = NTOP - nforced;
    unsigned long long s0m = c0m, s1m = c1m;
    if (__builtin_popcountll(c0m) + __builtin_popcountll(c1m) > slots) {
        unsigned T = 0u;
#pragma nounroll
        for (int bit = 31; bit >= 0; --bit) { const unsigned trial = T | (1u << bit);
            const int cnt = __builtin_popcountll(__ballot(k0 >= trial) & c0m) + __builtin_popcountll(__ballot(k1 >= trial) & c1m);
            if (cnt >= slots) T = trial; }
        unsigned long long e0 = __ballot(k0 == T) & c0m, e1 = __ballot(k1 == T) & c1m;
        s0m = __ballot(k0 > T) & c0m; s1m = __ballot(k1 > T) & c1m;
        int need = slots - __builtin_popcountll(s0m) - __builtin_popcountll(s1m);
        while (need > 0 && e0) { const unsigned long long b = e0 & (~e0 + 1ull); s0m |= b; e0 ^= b; --need; }
        while (need > 0 && e1) { const unsigned long long b = e1 & (~e1 + 1ull); s1m |= b; e1 ^= b; --need; }
    }
    const unsigned long long m0 = s0m | __ballot(f0 && j0 <= cur), m1 = s1m | __ballot(f1 && j1 <= cur);
    return (v4u){(unsigned)m0, (unsigned)(m0 >> 32), (unsigned)m1, (unsigned)(m1 >> 32)};
}
__device__ __forceinline__ unsigned pick4(const unsigned (&a)[4], int i) { return i == 0 ? a[0] : (i == 1 ? a[1] : (i == 2 ? a[2] : a[3])); }
template <int MODE>
__device__ __forceinline__ void nsa_attn_phase(Frame& F, const bf16* P1, const bf16* Qsrc, const bf16* Ksrc, const bf16* Vsrc, const unsigned* SEL, float* O32, unsigned* IMPO, bf16* Ob, bool probe_nostore = false) {
    const int tid = F.tid, wid = F.wave, lane = F.lane, r32 = lane & 31, hi = lane >> 5;
    LAS char* lds = (LAS char*)F.lds;
    LAS float* wsc = (LAS float*)(lds + ATT_WS_OFF + wid * 256);
    const int vb0 = (int)(uintptr_t)(lds + ATT_V_OFF) + v_rd_base(lane);
    KVDma dm; kv_dma_init(dm, MODE <= 1 ? NSA_G * HD : KVW, MODE == 0 ? NSA_G * HD : (MODE == 1 ? NSLC : NSA_INP), wid, lane);
    constexpr int NTB = SEQ / 32, NU = BATCH * NSA_G * NTB;
    for (int rd = 0; ; ++rd) {
        int idx;
        { idx = (rd & 1) ? rd * F.G + (F.G - 1 - F.bid) : rd * F.G + F.bid; if (rd * F.G >= NU) break; if (idx >= NU) continue; }
        const int tb = NTB - 1 - idx / (BATCH * NSA_G), bg = idx % (BATCH * NSA_G), g = bg % NSA_G, b = bg / NSA_G;
        const size_t rowb = (size_t)b * SEQ; const int t0 = tb * 32;
        const int t = (MODE == 2) ? t0 + 4 * wid + (r32 >> 3) : t0 + r32, head = (MODE == 2) ? g * NSA_R + (r32 & 7) : g * NSA_R + wid;
        const bf16* Kh; const bf16* Vh; long ldk, ldv; int jlo, jhi;
        if (MODE <= 1) { Kh = Ksrc + ((size_t)b * NCMPP * NSA_G + g) * HD; ldk = NSA_G * HD; jlo = 0; jhi = (t0 >> 4) >> 6;
            if (MODE == 0) { Vh = Vsrc + ((size_t)b * NCMPP * NSA_G + g) * HD; ldv = NSA_G * HD; } else { Vh = Vsrc; ldv = NSLC; } }
        else { Kh = Ksrc + rowb * KVW + g * HD; ldk = KVW; Vh = P1 + rowb * NSA_INP + (MODE == 2 ? P1_VS : P1_VW) + g * HD; ldv = NSA_INP;
            jhi = (t0 + 31) >> 6; jlo = (MODE == 2) ? 0 : ((t0 - (WINDOW - 1) > 0 ? t0 - (WINDOW - 1) : 0) >> 6); }
        unsigned wn[4] = {~0u, ~0u, ~0u, ~0u};
        if (MODE == 2) { const v4u sv = *(const v4u*)(SEL + ((rowb + t) * NSA_G + g) * 4); unsigned selw[4]; selw[0] = sv.x; selw[1] = sv.y; selw[2] = sv.z; selw[3] = sv.w;
            *(LAS v4u*)(lds + ATT_X_OFF + 2048 + (wid * 64 + lane) * 16) = sv;
            LAS unsigned* un = (LAS unsigned*)(lds + ATT_X_OFF);
#pragma unroll
            for (int q = 0; q < 4; ++q) { unsigned x = selw[q]; x |= __shfl_xor(x, 8); x |= __shfl_xor(x, 16); wn[q] = __builtin_amdgcn_readfirstlane(x); if (lane == 0) un[wid * 4 + q] = wn[q]; }
            LDS_WAIT(); __syncthreads();
            LAS int* plist = (LAS int*)(lds + ATT_X_OFF + 128);
            if (wid == 0) {
                unsigned m0 = 0u, m1 = 0u;
                int lane_l = lane; asm volatile("" : "+v"(lane_l));
                const LAS unsigned* ub = un + (lane_l >> 5);
#pragma unroll
                for (int w = 0; w < NWAVES; ++w) { m0 |= ((ub[w * 4] >> (lane & 31)) & 1u) << w; m1 |= ((ub[w * 4 + 2] >> (lane & 31)) & 1u) << w; }
                bool v0 = m0 != 0u && lane <= jhi, v1 = m1 != 0u && lane + 64 <= jhi; int np = 0;
                for (;;) {
                    const unsigned long long a0 = __ballot(v0), a1 = __ballot(v1);
                    if (!(a0 | a1)) break;
                    const int ja_ = a0 ? __builtin_ctzll(a0) : 64 + __builtin_ctzll(a1);
                    const unsigned ma = (ja_ < 64) ? (unsigned)__shfl((int)m0, ja_) : (unsigned)__shfl((int)m1, ja_ - 64);
                    if (lane == (ja_ & 63)) { if (ja_ < 64) v0 = false; else v1 = false; }
                    unsigned long long c0 = __ballot(v0 && !(m0 & ma)), c1 = __ballot(v1 && !(m1 & ma));
                    if (!(c0 | c1)) { c0 = __ballot(v0 && m0 == 0xffu); c1 = __ballot(v1 && m1 == 0xffu); }
                    if (!(c0 | c1)) { c0 = __ballot(v0); c1 = __ballot(v1); }
                    int jb_ = -1;
                    if (c0 | c1) { jb_ = c0 ? __builtin_ctzll(c0) : 64 + __builtin_ctzll(c1); if (lane == (jb_ & 63)) { if (jb_ < 64) v0 = false; else v1 = false; } }
                    if (lane == 0) { plist[2 * np] = ja_; plist[2 * np + 1] = jb_; }
                    ++np;
                }
                if (lane == 0) { int neg1 = -1; asm volatile("" : "+v"(neg1)); plist[2 * np] = neg1; plist[2 * np + 1] = neg1; }
            }
            LDS_WAIT(); }
        bf16x8 qr[8]; load_q(qr, Qsrc + (rowb + t) * (MODE <= 1 ? NSA_INP : DM) + head * HD + hi * 8);
        float m_reg = -1e30f, l_reg = 0.f; f32x16 o[4] = {};
        const int cur = t >> 6;
#define NSA_NEED(jj) (MODE != 2 || ((pick4(wn, (jj) >> 5) >> ((jj) & 31)) & 1u))
#define NSA_MASK(P0, P1, JJ) do { const int k0 = (JJ) * KVBLK; constexpr float NINF = -__builtin_inff(); \
            if (MODE <= 1) { if (!(16 * (k0 + 63) + 31 <= t0)) { \
                    _Pragma("unroll") for (int r = 0; r < 16; ++r) { if (!(16 * (k0 + crow(r, hi)) + 31 <= t)) P0[r] = NINF; if (!(16 * (k0 + 32 + crow(r, hi)) + 31 <= t)) P1[r] = NINF; } } } \
            else if (MODE == 2) { rv_ = (*(const LAS unsigned*)(lds + ATT_X_OFF + 2048 + (wid * 64 + lane) * 16 + ((JJ) >> 5) * 4) >> ((JJ) & 31)) & 1u;     \
                if ((JJ) >= cur) { const int lim = t - k0 - 4 * hi;                          \
                    _Pragma("unroll") for (int r = 0; r < 16; ++r) { if ((r & 3) + 8 * (r >> 2) > lim) P0[r] = NINF; if (32 + (r & 3) + 8 * (r >> 2) > lim) P1[r] = NINF; } } } \
            else { if (!((k0 > t0 + 31 - WINDOW) && (k0 + 63 <= t0))) { \
                    _Pragma("unroll") for (int r = 0; r < 16; ++r) { const int ka = k0 + crow(r, hi), kb = ka + 32; \
                        if (!(ka <= t && ka > t - WINDOW)) P0[r] = NINF; if (!(kb <= t && kb > t - WINDOW)) P1[r] = NINF; } } } } while (0)
        const int pbase = __builtin_amdgcn_readfirstlane((int)(uintptr_t)(lds + ATT_X_OFF + 128)); int pp = 0;
#define PLIST(i) (*(const LAS int*)(uintptr_t)(unsigned)(pbase + 4 * (i)))
        int ja, jb;
        __syncthreads();
        if (MODE == 2) { ja = PLIST(0); jb = PLIST(1); ja = __builtin_amdgcn_readfirstlane(ja); jb = __builtin_amdgcn_readfirstlane(jb); if (ja < 0) ja = jhi + 1; }
        else { ja = jlo; jb = ja + 1; if (jb > jhi) jb = -1; }
        if (ja <= jhi) kv_dma(dm, Kh + (size_t)ja * KVBLK * ldk, Vh + (size_t)ja * KVBLK * ldv, lds, 0, wid);
        if (jb >= 0) kv_dma(dm, Kh + (size_t)jb * KVBLK * ldk, Vh + (size_t)jb * KVBLK * ldv, lds, ATT_BUF, wid);
        int set = 0;
#pragma nounroll
        while (ja <= jhi) {
            int jc, jd;
            if (MODE == 2) { ++pp; jc = PLIST(2 * pp); jd = PLIST(2 * pp + 1); jc = __builtin_amdgcn_readfirstlane(jc); jd = __builtin_amdgcn_readfirstlane(jd); if (jc < 0) jc = jhi + 1; }
            else { jc = (jb >= 0 ? jb : ja) + 1; jd = jc + 1; if (jd > jhi) jd = -1; }
            VM_WAIT(); __syncthreads();
            if (jc <= jhi) kv_dma(dm, Kh + (size_t)jc * KVBLK * ldk, Vh + (size_t)jc * KVBLK * ldv, lds, ATT_SET - set, wid);
            if (jc <= jhi && jd >= 0) kv_dma(dm, Kh + (size_t)jd * KVBLK * ldk, Vh + (size_t)jd * KVBLK * ldv, lds, ATT_SET - set + ATT_BUF, wid);
            const bool nA = NSA_NEED(ja), nB = (jb >= 0) && NSA_NEED(jb);
            f32x16 a0, a1, b0, b1;
            if (nA) qkt(a0, a1, lds + set + ATT_K_OFF, qr, r32, hi);
            if (nB) qkt(b0, b1, lds + set + ATT_BUF + ATT_K_OFF, qr, r32, hi);
            bool rv_ = true;
            if (nA) { NSA_MASK(a0, a1, ja); attn_finish(a0, a1, o, m_reg, l_reg, wsc, vb0 + set, r32, hi, rv_); }
            if (nB) { NSA_MASK(b0, b1, jb); attn_finish(b0, b1, o, m_reg, l_reg, wsc, vb0 + set + ATT_BUF, r32, hi, rv_); }
            ja = jc; jb = (jc <= jhi) ? jd : -1; set = ATT_SET - set;
        }
#undef PLIST
#undef NSA_MASK
#undef NSA_NEED
        { float fac = l_reg > 0.f ? __builtin_amdgcn_rcpf(l_reg) : 0.f;
          if (MODE != 1) { const int br = MODE == 0 ? 0 : (MODE == 2 ? 1 : 2); fac *= sigmoidf_(bf2f(P1[(rowb + t) * NSA_INP + P1_GL + head * 3 + br])); }
          if (hi == 0) wsc[32 + r32] = fac; LDS_WAIT(); }
        if (MODE == 1) {
            float fc[16];
#pragma unroll
            for (int r = 0; r < 16; ++r) fc[r] = wsc[32 + crow(r, hi)];
            LDS_WAIT(); __syncthreads();
#pragma unroll
            for (int r = 0; r < 16; ++r) { const int orow = crow(r, hi);
#pragma unroll
                for (int d0 = 0; d0 < 4; ++d0) *(LAS float*)(lds + ((wid * 32 + orow) * 128 + d0 * 32 + r32) * 4) = o[d0][r] * fc[r]; }
            LDS_WAIT(); __syncthreads();
            { const int tok = tid >> 4, j8 = (tid & 15) * 8; f32x4 s0 = {0.f, 0.f, 0.f, 0.f}, s1 = {0.f, 0.f, 0.f, 0.f};
#pragma unroll
              for (int w = 0; w < 8; ++w) { const LAS f32x4* pp = (const LAS f32x4*)(lds + ((w * 32 + tok) * 128 + j8) * 4); s0 += pp[0]; s1 += pp[1]; }
              LAS f32x4* dst = (LAS f32x4*)(lds + (tok * 128 + j8) * 4); dst[0] = s0; dst[1] = s1; }
            LDS_WAIT(); __syncthreads();
#pragma nounroll
            for (int q = 0; q < 4; ++q) { const int tok = 4 * wid + q, tt = t0 + tok;
                const float a0 = *(const LAS float*)(lds + (tok * 128 + lane) * 4), a1 = *(const LAS float*)(lds + (tok * 128 + 64 + lane) * 4);
                const v4u w = topk_select(a0, a1, tt >> 6, lane);
                if (lane == 0) *(v4u*)(IMPO + ((rowb + tt) * NSA_G + g) * 4) = w; }
            LDS_WAIT(); __syncthreads();
        } else {
            bf16* gp0 = (MODE == 2) ? Ob + (rowb + t0 + 4 * wid) * DM + g * NSA_R * HD : Ob + (rowb + t0) * DM + (g * NSA_R + wid) * HD;
            int lane_e = lane; asm volatile("" : "+v"(lane_e));
            const unsigned lo = (MODE == 2) ? (unsigned)lane_e * 8u : (unsigned)(lane_e >> 4) * DM + (unsigned)(lane_e & 15) * 8u;
#define NSA_PIECE(i) (gp0 + ((MODE == 2) ? (size_t)((i) >> 1) * DM + ((i) & 1) * 512 : (size_t)(4 * (i)) * DM) + lo)
            v4u old[8];
            if (MODE != 0 && !probe_nostore) {
#pragma unroll
                for (int i = 0; i < 8; ++i) old[i] = *(const v4u*)NSA_PIECE(i); }
            LDS_WAIT(); __syncthreads();
            LAS float* stg = (LAS float*)(lds + wid * 16384);
#pragma unroll
            for (int r = 0; r < 16; ++r) { const int orow = crow(r, hi); const float fc = wsc[32 + orow];
#pragma unroll
                for (int d0 = 0; d0 < 4; ++d0) stg[orow * 128 + d0 * 32 + r32] = o[d0][r] * fc; }
            LDS_WAIT();
            if (!probe_nostore) {
#pragma unroll
                for (int i = 0; i < 8; ++i) { const int c = 64 * i + lane_e; f32x4 x0 = *(const LAS f32x4*)(stg + c * 8), x1 = *(const LAS f32x4*)(stg + c * 8 + 4);
                    if (MODE != 0) { x0[0] += bflo(old[i].x); x0[1] += bfhi(old[i].x); x0[2] += bflo(old[i].y); x0[3] += bfhi(old[i].y); x1[0] += bflo(old[i].z); x1[1] += bfhi(old[i].z); x1[2] += bflo(old[i].w); x1[3] += bfhi(old[i].w); }
                    const v4u w = {cvtpk(x0[0], x0[1]), cvtpk(x0[2], x0[3]), cvtpk(x1[0], x1[1]), cvtpk(x1[2], x1[3])};
                    *(v4u*)NSA_PIECE(i) = w; } }
#undef NSA_PIECE
            LDS_WAIT();
        }
    }
}

#ifndef STAGE
#define STAGE 3
#endif
#define ZERO_OB_PHASE PH_BEGIN { v4u z = {0u, 0u, 0u, 0u}; v4u* p = (v4u*)Ob; const long n = (long)MTOK * DM / 8; \
            for (long i = (long)F.bid * NTHR + F.tid; i < n; i += (long)F.G * NTHR) p[i] = z; } PH_END
#define MIXER0_PHASES \
    PH_BEGIN { fold_finalize(F, FO_XQ, XW); fold_finalize(F, FO_UP, DFF2); } \
             REP(10) hgrn_phase_a(F, BIG, (const float*)(ws + WS_LB), (bf16*)(ws + WS_QT), (bf16*)(ws + WS_OINTRA), (bf16*)(ws + WS_DS), (float*)(ws + WS_DEC)); \
             REP(11) sb_phase(F, BIG, Ob); PH_END \
    PH_BEGIN REP(12) hgrn_phase_b(F, (const bf16*)(ws + WS_DS), (const float*)(ws + WS_DEC), (bf16*)(ws + WS_SPREV)); PH_END \
    PH_BEGIN REP(13) hgrn_phase_c(F, BIG, (const bf16*)(ws + WS_QT), (const bf16*)(ws + WS_OINTRA), (const bf16*)(ws + WS_SPREV), KIN(IN_HGRN_NW), Ob); PH_END
#if STAGE <= 2
#define MIXER1_PHASES ZERO_OB_PHASE
#else
#define MIXER1_PHASES \
    PH_BEGIN { fold_finalize(F, FO_XQ + XW, XW); } REP(14) { nsa_rope_phase(F, BIG, (const float*)(ws + WS_ROPE), (bf16*)(ws + WS_QROT), (bf16*)(ws + WS_KSROT), (bf16*)(ws + WS_KWROT), (bf16*)(ws + WS_OVL)); \
             nsa_compress_phase(F, BIG, KIN(IN_NSA_CMP_POS), (const bf16*)(ws + WS_W_C1), (const bf16*)(ws + WS_W_C2), (bf16*)(ws + WS_KCMP), (bf16*)(ws + WS_VCMP)); } PH_END \
    PH_BEGIN { REP(15) nsa_attn_phase<0>(F, BIG, BIG, (const bf16*)(ws + WS_KCMP), (const bf16*)(ws + WS_VCMP), nullptr, nullptr, nullptr, Ob); \
             F.fresh(); REP(15) nsa_attn_phase<1>(F, BIG, BIG, (const bf16*)(ws + WS_KCMP), (const bf16*)(ws + WS_OVL), nullptr, nullptr, (unsigned*)(ws + WS_SEL), nullptr); \
             F.fresh(); REP(17) nsa_attn_phase<3>(F, BIG, (const bf16*)(ws + WS_QROT), (const bf16*)(ws + WS_KWROT), nullptr, nullptr, nullptr, nullptr, Ob, r_ > 0); } PH_END \
    PH_BEGIN REP(18) nsa_attn_phase<2>(F, BIG, (const bf16*)(ws + WS_QROT), (const bf16*)(ws + WS_KSROT), nullptr, (const unsigned*)(ws + WS_SEL), nullptr, nullptr, Ob); PH_END
#endif
#ifndef REPMASK
#define REPMASK 0u
#endif
#define REP(gid) for (int r_ = 0; r_ <= (int)((REPMASK >> (gid)) & 1u); ++r_)
#define PH_BEGIN if (pc >= lo && pc < hi) { F.fresh();
#if (REPMASK >> 23) & 1
#define PH_END   if (pc + 1 < hi) { const unsigned long long tb0_ = __builtin_amdgcn_s_memrealtime(); XcdBarrier bb_ = bar; asm volatile("" : "+s"(bb_.bar), "+s"(bb_.x)); xcd_barrier(bb_); \
        const unsigned w_ = (unsigned)(__builtin_amdgcn_s_memrealtime() - tb0_); tbar_acc += w_; if (threadIdx.x == 0) { atomicMax((unsigned*)(args.ws + 3 * MiB) + pc, 0x7fffffffu - w_); atomicMax((unsigned*)(args.ws + 3 * MiB) + 256 + pc, w_); } } } ++pc;
#else
#define PH_END   if (pc + 1 < hi) { XcdBarrier bb_ = bar; asm volatile("" : "+s"(bb_.bar), "+s"(bb_.x)); xcd_barrier(bb_); } } ++pc;
#endif
template <int l>
__device__ __forceinline__ void layer_body(Frame& F, const Args& args, const XcdBarrier& bar, int& pc, const int lo, const int hi, unsigned long long& tbar_acc) {
    unsigned char* ws = F.ws;
    bf16* HB = (bf16*)(ws + WS_HB); bf16* Y = (bf16*)(ws + WS_Y); float* H32 = (float*)karg()->out;
    bf16* BIG = (bf16*)(ws + WS_BIG); bf16* Gm = (bf16*)(ws + WS_G); bf16* Ob = (bf16*)(ws + WS_O);
    bf16* XQ = (bf16*)(ws + WS_XQ); bf16* XO = (bf16*)(ws + WS_XO);
#define RS(k) ((long long*)(ws + WS_RSUM) + (size_t)(k) * MTOK * 2)
#define LNG(k) (KIN(IN_LN_G) + (size_t)(k) * DM)
#define LNB(k) (KIN(IN_LN_B) + (size_t)(k) * DM)
    const float* cs = (const float*)(ws + WS_FOLDF); const float* b2 = cs + FO_N;
        PH_BEGIN REP(1) {
            const int N = l == 0 ? AB_IN : NSA_INP;
            pg8::StaticOrder S; S.init(MTOK, N, F.G, F.bid);
            if (l == 0) { pg8::Gemm g{HB, (const bf16*)(ws + WS_W_ABIN), MTOK, N, DM}; pg8::EpiBf16<0> E{BIG, N, nullptr, 0, 0, 1.f};
                pg8::gemm_phase<pg8::EpiBf16<0>, pg8::StaticOrder, PG8_ALIGN, PG8_SP2>(F.lds + RING_OFF, g, S, E); }
            else { pg8::Gemm g{Y, (const bf16*)(ws + WS_W_NSAIN), MTOK, N, DM}; pg8::EpiBf16Ln E{BIG, N, RS(2), cs + FO_NSA, b2 + FO_NSA};
                pg8::gemm_phase<pg8::EpiBf16Ln, pg8::StaticOrder, PG8_ALIGN, PG8_SP2>(F.lds + RING_OFF, g, S, E);
                if (r_ == 0) convert_job<CJ_L1A>(F, args, 64, 192); }
        } PH_END
#if STAGE <= 1
        ZERO_OB_PHASE
#else
        if (l == 0) {
            MIXER0_PHASES
        } else {
            MIXER1_PHASES
        }
#endif
        PH_BEGIN REP(2) {
            pg8::Gemm g{Ob, l == 0 ? (const bf16*)(ws + WS_W_ABOUT) : (const bf16*)(ws + WS_W_NSAOUT), MTOK, DM, DM};
            pg8::StaticOrder S; S.init(MTOK, DM, F.G, F.bid);
            if (l == 0) { pg8::EpiRes0 E{Y, HB, DM, DN_ALPHA, RS(0)};
                pg8::gemm_phase<pg8::EpiRes0, pg8::StaticOrder, PG8_ALIGN, PG8_SP2>(F.lds + RING_OFF, g, S, E); }
            else { pg8::EpiResLn2 E{Y, RS(2), LNG(2), LNB(2), DM, DN_ALPHA, RS(3)};
                pg8::gemm_phase<pg8::EpiResLn2, pg8::StaticOrder, PG8_ALIGN, PG8_SP2>(F.lds + RING_OFF, g, S, E); }
        } PH_END
        PH_BEGIN REP(3) {
            {   pg8::Gemm g{Y, (const bf16*)(ws + WS_W_XQ) + (size_t)l * XW * DM, MTOK, XW, DM};
                pg8::RangeOrder S; S.init(MTOK, XW, 0, 128, F.bid);
                pg8::EpiBf16Ln E{XQ, XW, RS(3 * l), cs + FO_XQ + l * XW, b2 + FO_XQ + l * XW};
                pg8::gemm_phase<pg8::EpiBf16Ln, pg8::RangeOrder, PG8_ALIGN, PG8_SP2>(F.lds + RING_OFF, g, S, E); }
            {   pg8::Gemm g{(const bf16*)(ws + WS_MEMB), (const bf16*)(ws + WS_W_XKV) + (size_t)l * 2 * XW * DM, BATCH * NMEM, 2 * XW, DM};
                pg8::RangeOrder S; S.init(BATCH * NMEM, 2 * XW, 128, 8, F.bid);
                pg8::EpiBf16<0> E{(bf16*)(ws + WS_XKV) + (size_t)l * BATCH * NMEM * 2 * XW, 2 * XW, nullptr, 0, 0, 1.f};
                pg8::gemm_phase<pg8::EpiBf16<0>, pg8::RangeOrder, PG8_ALIGN, PG8_SP2>(F.lds + RING_OFF, g, S, E); }
            if (r_ == 0) { if (l == 0) convert_job<CJ_DOWN0>(F, args, 136, 120); else convert_job<CJ_L1B>(F, args, 136, 120); }
        } PH_END
        PH_BEGIN { if (l == 1) fold_finalize(F, FO_UP + DFF2, DFF2); } REP(9) xattn_phase(F, XQ, (const bf16*)(ws + WS_XKV) + (size_t)l * BATCH * NMEM * 2 * XW, XO); PH_END
        PH_BEGIN REP(4) {
            pg8::Gemm g{XO, (const bf16*)(ws + WS_W_XO) + (size_t)l * DM * XW, MTOK, DM, XW};
            pg8::StaticOrder S; S.init(MTOK, DM, F.G, F.bid);
            pg8::EpiResLn2 E{Y, RS(3 * l), LNG(3 * l), LNB(3 * l), DM, DN_ALPHA, RS(3 * l + 1)};
            pg8::gemm_phase<pg8::EpiResLn2, pg8::StaticOrder, PG8_ALIGN, PG8_SP2>(F.lds + RING_OFF, g, S, E);
        } PH_END
        PH_BEGIN REP(5) {
#if (REPMASK >> 22) & 1
            if (r_ > 0) { XcdBarrier bb_ = bar; asm volatile("" : "+s"(bb_.bar), "+s"(bb_.x)); xcd_barrier(bb_); }
#endif
            pg8::Gemm g{Y, (const bf16*)(ws + WS_W_UP) + (size_t)l * DFF2 * DM, MTOK, DFF2, DM};
            pg8::StaticOrder S; S.init(MTOK, DFF2, F.G, F.bid);
            pg8::EpiConvGlu E{Gm, (bf16*)(ws + WS_SIDE), RS(3 * l + 1), cs + FO_UP + l * DFF2, b2 + FO_UP + l * DFF2, KIN(IN_FFN_CONV) + (size_t)l * 3 * DFF, DFF};
            pg8::gemm_phase<pg8::EpiConvGlu, pg8::StaticOrder, PG8_ALIGN, PG8_SP2>(F.lds + RING_OFF, g, S, E);
            if (r_ == 0) { if (l == 0) convert_job<CJ_NSA>(F, args, 128, 128); else convert_job<CJ_DOWN1>(F, args, 128, 128); }
        } PH_END
#if (REPMASK >> 20) & 1
        PH_BEGIN {
            pg8::Gemm g{HB, (const bf16*)(ws + WS_W_UP) + (size_t)l * DFF2 * DM, MTOK, DFF2, DM};
            pg8::ZeroOrder S; S.init(MTOK, DFF2, F.G, F.bid);
            pg8::EpiBf16<0> E{Gm, DFF2, nullptr, 0, 0, 1.f};
            pg8::gemm_phase<pg8::EpiBf16<0>, pg8::ZeroOrder, PG8_ALIGN, PG8_SP2>(F.lds + RING_OFF, g, S, E);
        } PH_END
#endif
        PH_BEGIN { if (l == 0) fold_finalize(F, FO_NSA, NSA_INP); } REP(8) convglu_fixup_phase(F, (const bf16*)(ws + WS_SIDE), KIN(IN_FFN_CONV) + (size_t)l * 3 * DFF, Gm); PH_END
        PH_BEGIN REP(6) {
            pg8::Gemm g{Gm, (const bf16*)(ws + WS_W_DOWN) + (size_t)l * DM * DFF, MTOK, DM, DFF};
            pg8::StaticOrder S; S.init(MTOK, DM, F.G, F.bid);
            pg8::EpiResLn2 E{Y, RS(3 * l + 1), LNG(3 * l + 1), LNB(3 * l + 1), DM, DN_ALPHA, RS(3 * l + 2)};
            pg8::gemm_phase<pg8::EpiResLn2, pg8::StaticOrder, PG8_ALIGN, PG8_SP2>(F.lds + RING_OFF, g, S, E);
        } PH_END
        if (l == 1) { PH_BEGIN REP(7) ln_phase(F, Y, LNG(5), LNB(5), H32); PH_END }
#undef RS
#undef LNG
#undef LNB
}
__global__ void __launch_bounds__(NTHR, 2) mega_fwd(Args args) {
    extern __shared__ __attribute__((aligned(16))) unsigned char lds_raw[];
    Frame F;
    F.lds = (LAS unsigned char*)lds_raw; F.ws = args.ws;
    F.tid = threadIdx.x; F.lane = F.tid & 63; F.wave = __builtin_amdgcn_readfirstlane(F.tid >> 6); F.G = gridDim.x;
    unsigned char* ws = args.ws;
    gu32* ctl = (gu32*)(ws + WS_CTL);
    for (int u = F.tid; u < (LDS_BYTES - LDSCTL_OFF) / 4; u += NTHR) ((LAS unsigned*)(F.lds + LDSCTL_OFF))[u] = 0u;
    __syncthreads();
    volatile LAS unsigned* MISC = (volatile LAS unsigned*)(F.lds + MISC_OFF);
    XcdBarrier bar = xcd_barrier_post((unsigned*)(ctl + CW_BAR), MISC + 8);
    const int lo = args.ph_lo, hi = args.ph_hi; int pc = 0; unsigned long long tbar_acc = 0ull;
    bf16* HB = (bf16*)(ws + WS_HB); bf16* Y = (bf16*)(ws + WS_Y); float* H32 = (float*)karg()->out;
    bf16* BIG = (bf16*)(ws + WS_BIG); bf16* Gm = (bf16*)(ws + WS_G); bf16* Ob = (bf16*)(ws + WS_O);
    bf16* XQ = (bf16*)(ws + WS_XQ); bf16* XO = (bf16*)(ws + WS_XO);

    PH_BEGIN REP(0) p0_prologue(F, args); PH_END

#if (REPMASK >> 21) & 1
    for (int e_ = 0; e_ < 40; ++e_) { PH_BEGIN PH_END }
#endif
    layer_body<0>(F, args, bar, pc, lo, hi, tbar_acc);
    layer_body<1>(F, args, bar, pc, lo, hi, tbar_acc);
#if (REPMASK >> 23) & 1
#ifndef PROBE_BID
#define PROBE_BID 0
#endif
#if (REPMASK >> 24) & 1
    if (blockIdx.x == 0) { unsigned long long tot_ = 0ull; for (int k_ = 0; k_ < pc; ++k_) { const unsigned v_ = __hip_atomic_load((unsigned*)(args.ws + 3 * MiB) + k_, __ATOMIC_RELAXED, __HIP_MEMORY_SCOPE_AGENT); const unsigned x_ = __hip_atomic_load((unsigned*)(args.ws + 3 * MiB) + 256 + k_, __ATOMIC_RELAXED, __HIP_MEMORY_SCOPE_AGENT);
#ifdef PROBE_SPREAD_MASK
            if (v_ && ((PROBE_SPREAD_MASK >> k_) & 1ull)) tot_ += x_ - (0x7fffffffu - v_);
#else
            if (v_) tot_ += 0x7fffffffu - v_;
#endif
        }
        const unsigned long long t0_ = __builtin_amdgcn_s_memrealtime(); while (__builtin_amdgcn_s_memrealtime() - t0_ < tot_) __builtin_amdgcn_s_sleep(8); }
#else
    if (blockIdx.x == PROBE_BID) { const unsigned long long t0_ = __builtin_amdgcn_s_memrealtime(); while (__builtin_amdgcn_s_memrealtime() - t0_ < tbar_acc) __builtin_amdgcn_s_sleep(8); }
#endif
#endif
}

extern "C" void kernel_launch(void* const* d_in, const int* in_sizes, int n_in, void* d_out, int out_size, void* d_ws, size_t ws_size, hipStream_t stream) {
    static int grid = 0;
    if (grid == 0) {
        if (n_in != 19 || in_sizes[0] != MTOK * DM || out_size != MTOK * DM || ws_size < WS_END) {
            fprintf(stderr, "kernel_launch: shape mismatch n_in %d in0 %d out %d ws %zu (need %zu)\n", n_in, n_in > 0 ? in_sizes[0] : -1, out_size, ws_size, (size_t)WS_END); grid = -1; return; }
        int dev = 0, cus = 0, per_cu = 0;
        if (hipGetDevice(&dev) != hipSuccess || hipDeviceGetAttribute(&cus, hipDeviceAttributeMultiprocessorCount, dev) != hipSuccess) { grid = -1; return; }
        if (hipFuncSetAttribute((const void*)mega_fwd, hipFuncAttributeMaxDynamicSharedMemorySize, LDS_BYTES) != hipSuccess) { fprintf(stderr, "kernel_launch: hipFuncSetAttribute failed\n"); grid = -1; return; }
        if (hipOccupancyMaxActiveBlocksPerMultiprocessor(&per_cu, (const void*)mega_fwd, NTHR, LDS_BYTES) != hipSuccess || per_cu < 1)
            fprintf(stderr, "kernel_launch: note: occupancy query reports %d workgroups per CU\n", per_cu);
        (void)hipGetLastError();
        grid = cus;
        if (grid != 256) { fprintf(stderr, "kernel_launch: built for a 256-CU device (workgroup ranges of the cross-attention and conversion phases); this device reports %d; nothing launched\n", cus); grid = -1; return; }
    }
    if (grid < 0) return;
    if (hipMemsetAsync((char*)d_ws + WS_CTL, 0, CTL_ZERO_BYTES, stream) != hipSuccess) { fprintf(stderr, "kernel_launch: memset failed\n"); return; }
    Args a{};
    for (int i = 0; i < 19; ++i) a.in[i] = (const float*)d_in[i];
    a.out = (float*)d_out; a.ws = (unsigned char*)d_ws; a.ph_lo = 0; a.ph_hi = 1 << 20;
    hipLaunchKernelGGL(mega_fwd, dim3(grid), dim3(NTHR), LDS_BYTES, stream, a);
    const hipError_t le = hipPeekAtLastError();
    if (le != hipSuccess) fprintf(stderr, "kernel_launch: launch failed: %s\n", hipGetErrorName(le));
}
```

```cpp
#include <hip/hip_runtime.h>
#include <cstdio>
#include <cstdint>
namespace pg8 {
#define PG8_LAS __attribute__((address_space(3)))
typedef unsigned short bf16_t;
typedef short bf16x8 __attribute__((ext_vector_type(8)));
typedef float f32x4 __attribute__((ext_vector_type(4)));
typedef unsigned u32x4 __attribute__((ext_vector_type(4)));
constexpr int BM = 256, BK = 64, HALF = 128, HTB = HALF * BK * 2  , STAGE_BYTES = 8 * HTB, NXCD = 8, WGM = 8;

__host__ __device__ __forceinline__ int lds_byte(int r, int c) { const int st = (r >> 4) * 2 + (c >> 5), rr = r & 15, cc = c & 31, ob = rr * 64 + cc * 2; return st * 1024 + (ob ^ (((ob >> 9) & 1) << 5)); }
__host__ __device__ __forceinline__ void stage_rc(int b, int& R, int& C) { const int st = b / 1024, sb = b % 1024, swz = sb ^ (((sb >> 9) & 1) << 5); R = (st >> 1) * 16 + swz / 64; C = (st & 1) * 32 + (swz % 64) / 2; }
__host__ __device__ __forceinline__ int perm32(int rho) { const int n = rho >> 4, i = rho & 15; return 8 * (i >> 2) + 4 * n + (i & 3); }

struct Unit { int pm, pn; };
struct Gemm { const bf16_t* A; const bf16_t* Bt; int M, N, K; };

struct StaticOrder {
    int nM, nN, nwg, G, c;
    __host__ __device__ void init(int M, int N, int G_, int c_) { nM = M / BM; nN = N / BM; nwg = nM * nN; G = G_; c = c_; }
    __host__ __device__ bool next(int i, Unit& u) const {
        const long L = (long)i * G + c; if (L >= nwg) return false;
        int wgid = (int)L; { const int q = nwg / NXCD, r = nwg % NXCD, xcd = wgid % NXCD, off = wgid / NXCD; wgid = (xcd < r ? xcd * (q + 1) : r * (q + 1) + (xcd - r) * q) + off; }
        const int nig = WGM * nN, gid = wgid / nig, fm = gid * WGM, gsz = (nM - fm) < WGM ? (nM - fm) : WGM;
        u.pm = fm + ((wgid % nig) % gsz); u.pn = (wgid % nig) / gsz; return true;
    }
    __device__ __forceinline__ void a_ready(const Unit&) const {}
    __device__ __forceinline__ void done(const Unit&) const {}
};

__device__ __forceinline__ unsigned cvt_pk_bf16(float lo, float hi) { unsigned r; asm volatile("v_cvt_pk_bf16_f32 %0, %1, %2" : "=v"(r) : "v"(lo), "v"(hi)); return r; }
typedef float f32x2 __attribute__((ext_vector_type(2)));
__device__ __forceinline__ f32x2 gelu_pk(f32x2 v) {
    const f32x2 av = __builtin_elementwise_abs(v), d = av * 0.2316418882f + 1.0f;
    f32x2 t; t.x = __builtin_amdgcn_rcpf(d.x); t.y = __builtin_amdgcn_rcpf(d.y);
    f32x2 q = t * 0.5307027145f + (-0.7265760135f); q = q * t + 0.7107068705f; q = q * t + (-0.142248368f); q = q * t + 0.127414796f; q = q * t;
    const f32x2 s = (v * v) * (-0.72134752044f);
    f32x2 e; e.x = __builtin_amdgcn_exp2f(s.x); e.y = __builtin_amdgcn_exp2f(s.y);
    const f32x2 m = av * (q * e);
    return __builtin_elementwise_max(v, (f32x2){0.f, 0.f}) - m;
}

template <int ACT  > struct EpiBf16 {
    static constexpr bool PERM = true, AFTER_DRAIN = false; static_assert(ACT == 0 || ACT == 1, "EpiBf16: ACT is 0 (none) or 1 (gelu_pk)");
    bf16_t* O; int ldc; const float* bias; int split_cols; size_t split_stride; float scale0;
    __device__ __forceinline__ void operator()(const f32x4 (&acc)[2][2][4][2], const Unit& u, int wr, int wc, int fr, int fq) const {
        const int row0 = u.pm * BM + wr * 64 + fr; int colt = u.pn * BM; bf16_t* base = O;
        float sc = 1.f; if (split_cols) { const int t = colt / split_cols; base += (size_t)t * split_stride; colt -= t * split_cols; if (t == 0) sc = scale0; }
        const int col0 = colt + wc * 32 + 8 * fq, bcol0 = u.pn * BM + wc * 32 + 8 * fq;
        f32x4 bv[2][2];
#pragma unroll
        for (int bj = 0; bj < 2; ++bj)
#pragma unroll
            for (int n = 0; n < 2; ++n) bv[bj][n] = bias ? *(const f32x4*)(bias + bcol0 + bj * HALF + 4 * n) : (f32x4){0.f, 0.f, 0.f, 0.f};
#pragma unroll
        for (int ai = 0; ai < 2; ++ai)
#pragma unroll
            for (int m = 0; m < 4; ++m) { bf16_t* rowp = base + (size_t)(row0 + ai * HALF + m * 16) * ldc + col0;
#pragma unroll
                for (int bj = 0; bj < 2; ++bj) { f32x4 v0 = acc[ai][bj][m][0] + bv[bj][0], v1 = acc[ai][bj][m][1] + bv[bj][1];
                    if (ACT == 1) { f32x2 a = gelu_pk((f32x2){v0[0], v0[1]}), b = gelu_pk((f32x2){v0[2], v0[3]}), c = gelu_pk((f32x2){v1[0], v1[1]}), d = gelu_pk((f32x2){v1[2], v1[3]});
                        v0 = (f32x4){a.x, a.y, b.x, b.y}; v1 = (f32x4){c.x, c.y, d.x, d.y}; }
                    v0 = v0 * sc; v1 = v1 * sc; u32x4 w; w.x = cvt_pk_bf16(v0[0], v0[1]); w.y = cvt_pk_bf16(v0[2], v0[3]); w.z = cvt_pk_bf16(v1[0], v1[1]); w.w = cvt_pk_bf16(v1[2], v1[3]);
                    *(u32x4*)(rowp + bj * HALF) = w; } }
    }
};


struct EpiRes {
    static constexpr bool PERM = false, AFTER_DRAIN = false;
    float* Y; const float* res; int ldc; float alpha;
    __device__ __forceinline__ void operator()(const f32x4 (&acc)[2][2][4][2], const Unit& u, int wr, int wc, int fr, int fq) const {
        const int row0 = u.pm * BM + wr * 64 + fr, col0 = u.pn * BM + wc * 32 + 4 * fq;
#pragma unroll
        for (int ai = 0; ai < 2; ++ai)
#pragma unroll
            for (int m = 0; m < 4; ++m) { const size_t off = (size_t)(row0 + ai * HALF + m * 16) * ldc + col0;
#pragma unroll
                for (int bj = 0; bj < 2; ++bj)
#pragma unroll
                    for (int n = 0; n < 2; ++n) { const f32x4 r = *(const f32x4*)(res + off + bj * HALF + n * 16);
                        *(f32x4*)(Y + off + bj * HALF + n * 16) = r * alpha + acc[ai][bj][m][n]; } }
    }
};
struct RangeOrder {
    int nM, nN, ntot, c0, nw, c;
    __host__ __device__ void init(int M, int N, int c0_, int nw_, int c_) { nM = M / BM; nN = N / BM; ntot = nM * nN; c0 = c0_; nw = nw_; c = c_; }
    __host__ __device__ bool next(int i, Unit& u) const {
        if (c < c0 || c >= c0 + nw) return false;
        const int L = i * nw + (c - c0); if (L >= ntot) return false;
        u.pm = L / nN; u.pn = L % nN; return true;
    }
    __device__ __forceinline__ void a_ready(const Unit&) const {}
    __device__ __forceinline__ void done(const Unit&) const {}
};

struct ZeroOrder : StaticOrder {
    __host__ __device__ bool next(int i, Unit& u) const { const bool r = StaticOrder::next(i, u); u.pm = 0; u.pn = 0; return r; }
};

struct EpiResBf {
    static constexpr bool PERM = true, AFTER_DRAIN = false;
    bf16_t* Y; const bf16_t* res; int ldc; float alpha;
    __device__ __forceinline__ void operator()(const f32x4 (&acc)[2][2][4][2], const Unit& u, int wr, int wc, int fr, int fq) const {
        const int row0 = u.pm * BM + wr * 64 + fr, col0 = u.pn * BM + wc * 32 + 8 * fq;
#pragma unroll
        for (int ai = 0; ai < 2; ++ai)
#pragma unroll
            for (int m = 0; m < 4; ++m) { const size_t off = (size_t)(row0 + ai * HALF + m * 16) * ldc + col0;
#pragma unroll
                for (int bj = 0; bj < 2; ++bj) { const u32x4 r = *(const u32x4*)(res + off + bj * HALF);
                    const f32x4 v0 = acc[ai][bj][m][0], v1 = acc[ai][bj][m][1];
                    u32x4 w;
                    w.x = cvt_pk_bf16(__builtin_bit_cast(float, r.x << 16) * alpha + v0[0], __builtin_bit_cast(float, r.x & 0xffff0000u) * alpha + v0[1]);
                    w.y = cvt_pk_bf16(__builtin_bit_cast(float, r.y << 16) * alpha + v0[2], __builtin_bit_cast(float, r.y & 0xffff0000u) * alpha + v0[3]);
                    w.z = cvt_pk_bf16(__builtin_bit_cast(float, r.z << 16) * alpha + v1[0], __builtin_bit_cast(float, r.z & 0xffff0000u) * alpha + v1[1]);
                    w.w = cvt_pk_bf16(__builtin_bit_cast(float, r.w << 16) * alpha + v1[2], __builtin_bit_cast(float, r.w & 0xffff0000u) * alpha + v1[3]);
                    *(u32x4*)(Y + off + bj * HALF) = w; } }
    }
};

struct EpiResF {
    static constexpr bool PERM = true, AFTER_DRAIN = false;
    float* Y; const bf16_t* res; int ldc; float alpha;
    __device__ __forceinline__ void operator()(const f32x4 (&acc)[2][2][4][2], const Unit& u, int wr, int wc, int fr, int fq) const {
        const int row0 = u.pm * BM + wr * 64 + fr, col0 = u.pn * BM + wc * 32 + 8 * fq;
#pragma unroll
        for (int ai = 0; ai < 2; ++ai)
#pragma unroll
            for (int m = 0; m < 4; ++m) { const size_t off = (size_t)(row0 + ai * HALF + m * 16) * ldc + col0;
#pragma unroll
                for (int bj = 0; bj < 2; ++bj) { const u32x4 r = *(const u32x4*)(res + off + bj * HALF);
                    f32x4 o0, o1;
                    o0[0] = __builtin_bit_cast(float, r.x << 16); o0[1] = __builtin_bit_cast(float, r.x & 0xffff0000u); o0[2] = __builtin_bit_cast(float, r.y << 16); o0[3] = __builtin_bit_cast(float, r.y & 0xffff0000u);
                    o1[0] = __builtin_bit_cast(float, r.z << 16); o1[1] = __builtin_bit_cast(float, r.z & 0xffff0000u); o1[2] = __builtin_bit_cast(float, r.w << 16); o1[3] = __builtin_bit_cast(float, r.w & 0xffff0000u);
                    *(f32x4*)(Y + off + bj * HALF) = o0 * alpha + acc[ai][bj][m][0]; *(f32x4*)(Y + off + bj * HALF + 4) = o1 * alpha + acc[ai][bj][m][1]; } }
    }
};

struct EpiResLn {
    static constexpr bool PERM = true, AFTER_DRAIN = false;
    bf16_t* Y; const float* stats; const float* g; const float* b; int ldc; float alpha;
    __device__ __forceinline__ void operator()(const f32x4 (&acc)[2][2][4][2], const Unit& u, int wr, int wc, int fr, int fq) const {
        const int row0 = u.pm * BM + wr * 64 + fr, col0 = u.pn * BM + wc * 32 + 8 * fq;
        f32x4 gv[2][2], bv[2][2];
#pragma unroll
        for (int bj = 0; bj < 2; ++bj)
#pragma unroll
            for (int n = 0; n < 2; ++n) { gv[bj][n] = *(const f32x4*)(g + col0 + bj * HALF + 4 * n) * alpha; bv[bj][n] = *(const f32x4*)(b + col0 + bj * HALF + 4 * n) * alpha; }
#pragma unroll
        for (int ai = 0; ai < 2; ++ai)
#pragma unroll
            for (int m = 0; m < 4; ++m) { const int row = row0 + ai * HALF + m * 16; const size_t off = (size_t)row * ldc + col0;
                const float mean = stats[2 * row], rstd = stats[2 * row + 1];
#pragma unroll
                for (int bj = 0; bj < 2; ++bj) { const u32x4 r = *(const u32x4*)(Y + off + bj * HALF);
                    f32x4 y0, y1;
                    y0[0] = __builtin_bit_cast(float, r.x << 16); y0[1] = __builtin_bit_cast(float, r.x & 0xffff0000u); y0[2] = __builtin_bit_cast(float, r.y << 16); y0[3] = __builtin_bit_cast(float, r.y & 0xffff0000u);
                    y1[0] = __builtin_bit_cast(float, r.z << 16); y1[1] = __builtin_bit_cast(float, r.z & 0xffff0000u); y1[2] = __builtin_bit_cast(float, r.w << 16); y1[3] = __builtin_bit_cast(float, r.w & 0xffff0000u);
                    const f32x4 o0 = (y0 - mean) * rstd * gv[bj][0] + bv[bj][0] + acc[ai][bj][m][0], o1 = (y1 - mean) * rstd * gv[bj][1] + bv[bj][1] + acc[ai][bj][m][1];
                    u32x4 w; w.x = cvt_pk_bf16(o0[0], o0[1]); w.y = cvt_pk_bf16(o0[2], o0[3]); w.z = cvt_pk_bf16(o1[0], o1[1]); w.w = cvt_pk_bf16(o1[2], o1[3]);
                    *(u32x4*)(Y + off + bj * HALF) = w; } }
    }
};

constexpr float RS_SCALE = 1048576.0f, RS_INV = 1.0f / 1048576.0f;
__device__ __forceinline__ float fx20_to_f(long long v) { return (float)(int)(v >> 20) + (float)((unsigned)v & 0xFFFFFu) * RS_INV; }
__device__ __forceinline__ long long f_to_fx20(float s) { const float fl = floorf(s); return ((long long)(int)fl << 20) + (long long)(unsigned)((s - fl) * RS_SCALE + 0.5f); }
__device__ __forceinline__ void row_stats(const long long* rs, int row, float& mean, float& rstd) {
    const long long a = rs[2 * (size_t)row], b = rs[2 * (size_t)row + 1];
    mean = fx20_to_f(a) * (1.0f / 4096.0f); const float var = fx20_to_f(b) * (1.0f / 4096.0f) - mean * mean; rstd = __builtin_amdgcn_rsqf(var + 1e-5f);
}
constexpr float FOLD_SCALE = 4294967296.0f, FOLD_INV = 1.0f / 4294967296.0f;
struct EpiBf16Ln {
    static constexpr bool PERM = true, AFTER_DRAIN = false;
    bf16_t* O; int ldc; const long long* rs; const float* cs; const float* b2;
    __device__ __forceinline__ void operator()(const f32x4 (&acc)[2][2][4][2], const Unit& u, int wr, int wc, int fr, int fq) const {
        const int row0 = u.pm * BM + wr * 64 + fr, col0 = u.pn * BM + wc * 32 + 8 * fq;
        f32x4 cv[2][2], bv[2][2];
#pragma unroll
        for (int bj = 0; bj < 2; ++bj)
#pragma unroll
            for (int n = 0; n < 2; ++n) { cv[bj][n] = *(const f32x4*)(cs + col0 + bj * HALF + 4 * n); bv[bj][n] = *(const f32x4*)(b2 + col0 + bj * HALF + 4 * n); }
#pragma unroll
        for (int ai = 0; ai < 2; ++ai)
#pragma unroll
            for (int m = 0; m < 4; ++m) { const int row = row0 + ai * HALF + m * 16; float mean, rstd; row_stats(rs, row, mean, rstd);
                bf16_t* rowp = O + (size_t)row * ldc + col0;
#pragma unroll
                for (int bj = 0; bj < 2; ++bj) { const f32x4 v0 = (acc[ai][bj][m][0] - cv[bj][0] * mean) * rstd + bv[bj][0], v1 = (acc[ai][bj][m][1] - cv[bj][1] * mean) * rstd + bv[bj][1];
                    u32x4 w; w.x = cvt_pk_bf16(v0[0], v0[1]); w.y = cvt_pk_bf16(v0[2], v0[3]); w.z = cvt_pk_bf16(v1[0], v1[1]); w.w = cvt_pk_bf16(v1[2], v1[3]);
                    *(u32x4*)(rowp + bj * HALF) = w; } }
    }
};
__device__ __forceinline__ void row_sums_add(long long* rso, int row, const f32x4& a, const f32x4& b, const f32x4& c, const f32x4& d, int fq) {
    float s1 = ((a[0] + a[1]) + (a[2] + a[3])) + ((b[0] + b[1]) + (b[2] + b[3])) + ((c[0] + c[1]) + (c[2] + c[3])) + ((d[0] + d[1]) + (d[2] + d[3]));
    float s2 = ((a[0] * a[0] + a[1] * a[1]) + (a[2] * a[2] + a[3] * a[3])) + ((b[0] * b[0] + b[1] * b[1]) + (b[2] * b[2] + b[3] * b[3]))
             + ((c[0] * c[0] + c[1] * c[1]) + (c[2] * c[2] + c[3] * c[3])) + ((d[0] * d[0] + d[1] * d[1]) + (d[2] * d[2] + d[3] * d[3]));
    s1 += __shfl_xor(s1, 16); s1 += __shfl_xor(s1, 32); s2 += __shfl_xor(s2, 16); s2 += __shfl_xor(s2, 32);
    if (fq == 0) { atomicAdd((unsigned long long*)(rso + 2 * (size_t)row), (unsigned long long)f_to_fx20(s1)); atomicAdd((unsigned long long*)(rso + 2 * (size_t)row + 1), (unsigned long long)f_to_fx20(s2)); }
}
struct EpiRes0 {
    static constexpr bool PERM = true, AFTER_DRAIN = false;
    bf16_t* Y; const bf16_t* res; int ldc; float alpha; long long* rso;
    __device__ __forceinline__ void operator()(const f32x4 (&acc)[2][2][4][2], const Unit& u, int wr, int wc, int fr, int fq) const {
        const int row0 = u.pm * BM + wr * 64 + fr, col0 = u.pn * BM + wc * 32 + 8 * fq;
#pragma unroll
        for (int ai = 0; ai < 2; ++ai)
#pragma unroll
            for (int m = 0; m < 4; ++m) { const int row = row0 + ai * HALF + m * 16; const size_t off = (size_t)row * ldc + col0; f32x4 o[2][2];
#pragma unroll
                for (int bj = 0; bj < 2; ++bj) { const u32x4 r = *(const u32x4*)(res + off + bj * HALF);
                    f32x4 y0, y1;
                    y0[0] = __builtin_bit_cast(float, r.x << 16); y0[1] = __builtin_bit_cast(float, r.x & 0xffff0000u); y0[2] = __builtin_bit_cast(float, r.y << 16); y0[3] = __builtin_bit_cast(float, r.y & 0xffff0000u);
                    y1[0] = __builtin_bit_cast(float, r.z << 16); y1[1] = __builtin_bit_cast(float, r.z & 0xffff0000u); y1[2] = __builtin_bit_cast(float, r.w << 16); y1[3] = __builtin_bit_cast(float, r.w & 0xffff0000u);
                    o[bj][0] = y0 * alpha + acc[ai][bj][m][0]; o[bj][1] = y1 * alpha + acc[ai][bj][m][1];
                    u32x4 w; w.x = cvt_pk_bf16(o[bj][0][0], o[bj][0][1]); w.y = cvt_pk_bf16(o[bj][0][2], o[bj][0][3]); w.z = cvt_pk_bf16(o[bj][1][0], o[bj][1][1]); w.w = cvt_pk_bf16(o[bj][1][2], o[bj][1][3]);
                    *(u32x4*)(Y + off + bj * HALF) = w; }
                row_sums_add(rso, row, o[0][0], o[0][1], o[1][0], o[1][1], fq); }
    }
};
struct EpiResLn2 {
    static constexpr bool PERM = true, AFTER_DRAIN = false;
    bf16_t* Y; const long long* rsi; const float* g; const float* b; int ldc; float alpha; long long* rso;
    __device__ __forceinline__ void operator()(const f32x4 (&acc)[2][2][4][2], const Unit& u, int wr, int wc, int fr, int fq) const {
        const int row0 = u.pm * BM + wr * 64 + fr, col0 = u.pn * BM + wc * 32 + 8 * fq;
        f32x4 gv[2][2], bv[2][2];
#pragma unroll
        for (int bj = 0; bj < 2; ++bj)
#pragma unroll
            for (int n = 0; n < 2; ++n) { gv[bj][n] = *(const f32x4*)(g + col0 + bj * HALF + 4 * n) * alpha; bv[bj][n] = *(const f32x4*)(b + col0 + bj * HALF + 4 * n) * alpha; }
#pragma unroll
        for (int ai = 0; ai < 2; ++ai)
#pragma unroll
            for (int m = 0; m < 4; ++m) { const int row = row0 + ai * HALF + m * 16; const size_t off = (size_t)row * ldc + col0; float mean, rstd; row_stats(rsi, row, mean, rstd); f32x4 o[2][2];
#pragma unroll
                for (int bj = 0; bj < 2; ++bj) { const u32x4 r = *(const u32x4*)(Y + off + bj * HALF);
                    f32x4 y0, y1;
                    y0[0] = __builtin_bit_cast(float, r.x << 16); y0[1] = __builtin_bit_cast(float, r.x & 0xffff0000u); y0[2] = __builtin_bit_cast(float, r.y << 16); y0[3] = __builtin_bit_cast(float, r.y & 0xffff0000u);
                    y1[0] = __builtin_bit_cast(float, r.z << 16); y1[1] = __builtin_bit_cast(float, r.z & 0xffff0000u); y1[2] = __builtin_bit_cast(float, r.w << 16); y1[3] = __builtin_bit_cast(float, r.w & 0xffff0000u);
                    o[bj][0] = (y0 - mean) * rstd * gv[bj][0] + bv[bj][0] + acc[ai][bj][m][0]; o[bj][1] = (y1 - mean) * rstd * gv[bj][1] + bv[bj][1] + acc[ai][bj][m][1];
                    u32x4 w; w.x = cvt_pk_bf16(o[bj][0][0], o[bj][0][1]); w.y = cvt_pk_bf16(o[bj][0][2], o[bj][0][3]); w.z = cvt_pk_bf16(o[bj][1][0], o[bj][1][1]); w.w = cvt_pk_bf16(o[bj][1][2], o[bj][1][3]);
                    *(u32x4*)(Y + off + bj * HALF) = w; }
                row_sums_add(rso, row, o[0][0], o[0][1], o[1][0], o[1][1], fq); }
    }
};

struct EpiBf16LnTok {
    static constexpr bool PERM = true, AFTER_DRAIN = false, AROWPERM = true;
    bf16_t* O; int ldc; const long long* rs; const float* cs; const float* b2;
    __device__ __forceinline__ void operator()(const f32x4 (&acc)[2][2][4][2], const Unit& u, int wr, int wc, int fr, int fq) const {
        const int row0 = u.pm * BM + 128 * wr + 8 * fr, col0 = u.pn * BM + wc * 32 + 8 * fq;
        f32x4 cv[2][2], bv[2][2];
#pragma unroll
        for (int bj = 0; bj < 2; ++bj)
#pragma unroll
            for (int n = 0; n < 2; ++n) { cv[bj][n] = *(const f32x4*)(cs + col0 + bj * HALF + 4 * n); bv[bj][n] = *(const f32x4*)(b2 + col0 + bj * HALF + 4 * n); }
#pragma unroll
        for (int ai = 0; ai < 2; ++ai)
#pragma unroll
            for (int m = 0; m < 4; ++m) { const int row = row0 + 4 * ai + m; float mean, rstd; row_stats(rs, row, mean, rstd);
                bf16_t* rowp = O + (size_t)row * ldc + col0;
#pragma unroll
                for (int bj = 0; bj < 2; ++bj) { const f32x4 v0 = (acc[ai][bj][m][0] - cv[bj][0] * mean) * rstd + bv[bj][0], v1 = (acc[ai][bj][m][1] - cv[bj][1] * mean) * rstd + bv[bj][1];
                    u32x4 w; w.x = cvt_pk_bf16(v0[0], v0[1]); w.y = cvt_pk_bf16(v0[2], v0[3]); w.z = cvt_pk_bf16(v1[0], v1[1]); w.w = cvt_pk_bf16(v1[2], v1[3]);
                    *(u32x4*)(rowp + bj * HALF) = w; } }
    }
};

__device__ __forceinline__ float dpp_shr1(float x) { return __builtin_bit_cast(float, __builtin_amdgcn_update_dpp(0, __builtin_bit_cast(int, x), 0x111, 0xf, 0xf, true)); }
struct EpiConvGlu {
    static constexpr bool PERM = true, AFTER_DRAIN = false, AROWPERM = true;
    bf16_t* G; bf16_t* side; const long long* rs; const float* cs; const float* b2; const float* cw; int dff;
    __device__ __forceinline__ void operator()(const f32x4 (&acc)[2][2][4][2], const Unit& u, int wr, int wc, int fr, int fq) const {
        const int row0 = u.pm * BM + 128 * wr + 8 * fr, colg = u.pn * BM + wc * 32 + 8 * fq, ch0 = u.pn * HALF + wc * 32 + 8 * fq;
        float mean_[8], rstd_[8];
#pragma unroll
        for (int j = 0; j < 8; ++j) row_stats(rs, row0 + j, mean_[j], rstd_[j]);
        float mr_[8];
#pragma unroll
        for (int j = 0; j < 8; ++j) mr_[j] = mean_[j] * rstd_[j];
        unsigned gout[8][4];
        const int bnd = row0 >> 7;
#pragma unroll
        for (int n = 0; n < 2; ++n) {
            const f32x4 ca = *(const f32x4*)(cs + colg + 4 * n), ba = *(const f32x4*)(b2 + colg + 4 * n), cu = *(const f32x4*)(cs + colg + HALF + 4 * n), bu = *(const f32x4*)(b2 + colg + HALF + 4 * n);
            const f32x4 w0 = *(const f32x4*)(cw + ch0 + 4 * n), w1 = *(const f32x4*)(cw + dff + ch0 + 4 * n), w2 = *(const f32x4*)(cw + 2 * dff + ch0 + 4 * n);
            f32x4 a[8], uu[8];
#pragma unroll
            for (int j = 0; j < 8; ++j) { a[j] = acc[j >> 2][0][j & 3][n] * rstd_[j] + (ba - ca * mr_[j]); uu[j] = acc[j >> 2][1][j & 3][n] * rstd_[j] + (bu - cu * mr_[j]); }
            f32x4 p6, p7;
#pragma unroll
            for (int q = 0; q < 4; ++q) { p6[q] = dpp_shr1(a[6][q]); p7[q] = dpp_shr1(a[7][q]); }
            if (fr == 15 && bnd + 1 < 128) { bf16_t* sp = side + ((size_t)(bnd + 1) * 6) * dff + ch0 + 4 * n;
                *(unsigned long long*)(sp) = (unsigned long long)cvt_pk_bf16(a[6][0], a[6][1]) | ((unsigned long long)cvt_pk_bf16(a[6][2], a[6][3]) << 32);
                *(unsigned long long*)(sp + dff) = (unsigned long long)cvt_pk_bf16(a[7][0], a[7][1]) | ((unsigned long long)cvt_pk_bf16(a[7][2], a[7][3]) << 32); }
            if (fr == 0) { bf16_t* sp = side + ((size_t)bnd * 6 + 2) * dff + ch0 + 4 * n;
                *(unsigned long long*)(sp) = (unsigned long long)cvt_pk_bf16(a[0][0], a[0][1]) | ((unsigned long long)cvt_pk_bf16(a[0][2], a[0][3]) << 32);
                *(unsigned long long*)(sp + dff) = (unsigned long long)cvt_pk_bf16(a[1][0], a[1][1]) | ((unsigned long long)cvt_pk_bf16(a[1][2], a[1][3]) << 32);
                *(unsigned long long*)(sp + 2 * dff) = (unsigned long long)cvt_pk_bf16(uu[0][0], uu[0][1]) | ((unsigned long long)cvt_pk_bf16(uu[0][2], uu[0][3]) << 32);
                *(unsigned long long*)(sp + 3 * dff) = (unsigned long long)cvt_pk_bf16(uu[1][0], uu[1][1]) | ((unsigned long long)cvt_pk_bf16(uu[1][2], uu[1][3]) << 32); }
#pragma unroll
            for (int j = 0; j < 8; ++j) { const f32x4 am1 = (j == 0) ? p7 : a[j ? j - 1 : 0], am2 = (j == 0) ? p6 : (j == 1 ? p7 : a[j > 1 ? j - 2 : 0]);
                const f32x4 c = w2 * a[j] + w1 * am1 + w0 * am2;
                const f32x2 g01 = gelu_pk((f32x2){c[0], c[1]}), g23 = gelu_pk((f32x2){c[2], c[3]});
                gout[j][2 * n] = cvt_pk_bf16(g01.x * uu[j][0], g01.y * uu[j][1]); gout[j][2 * n + 1] = cvt_pk_bf16(g23.x * uu[j][2], g23.y * uu[j][3]); }
        }
#pragma unroll
        for (int j = 0; j < 8; ++j) if (!(fr == 0 && j < 2)) { u32x4 w; w.x = gout[j][0]; w.y = gout[j][1]; w.z = gout[j][2]; w.w = gout[j][3]; *(u32x4*)(G + (size_t)(row0 + j) * dff + ch0) = w; }
    }
};
template <class E, class = void> struct arowperm_v { static constexpr bool value = false; };
template <class E> struct arowperm_v<E, decltype((void)E::AROWPERM)> { static constexpr bool value = E::AROWPERM; };
template <class Epi, class Sched, bool ALIGN_EPI = false, bool SP2 = false>
__device__ __forceinline__ void gemm_phase(PG8_LAS unsigned char* lds, const Gemm g, const Sched& S, const Epi& E) {
    int tid_l = threadIdx.x; asm volatile("" : "+v"(tid_l)); const int tid = tid_l, wid = __builtin_amdgcn_readfirstlane(tid >> 6), lane = tid & 63, wr = wid >> 2, wc = wid & 3, fr = lane & 15, fq = lane >> 4;
    const int K = g.K, nt = K / BK;
    unsigned voffA[2], voffB[2];
#pragma unroll
    for (int i = 0; i < 2; ++i) { int R, C; stage_rc(tid * 16 + i * 8192, R, C); const int Rb = Epi::PERM ? ((R & ~31) + perm32(R & 31)) : R;
        const int Ra = arowperm_v<Epi>::value ? (128 * (R >> 6) + 8 * (R & 15) + ((R >> 4) & 3)) : R;
        voffA[i] = (unsigned)(Ra * K + C) * 2u; voffB[i] = (unsigned)(Rb * K + C) * 2u; }
    const size_t hstepA = arowperm_v<Epi>::value ? (size_t)4 * K * 2 : (size_t)HALF * K * 2;
    const size_t kstep = (size_t)(BK * 2);
    const size_t hstep = (size_t)HALF * K * 2;
    const size_t tstep = 2 * hstep;
    const unsigned ldsw = (unsigned)wid * 1024u;
    const int aoff = lds_byte(wr * 64 + fr, fq * 8), boff = lds_byte(wc * 32 + fr, fq * 8);
#define PG8_SA(b, h) (((b) * 2 + (h)) * HTB)
#define PG8_SB(b, h) ((4 + (b) * 2 + (h)) * HTB)
#define PG8_STAGE(bufoff, gbase, voff) do { _Pragma("unroll") for (int _i = 0; _i < 2; ++_i) \
        __builtin_amdgcn_global_load_lds((const unsigned*)((const char*)(gbase) + (voff)[_i]), (PG8_LAS unsigned*)(lds + (bufoff) + ldsw + _i * 8192), 16, 0, 0); } while (0)
#define PG8_LDA(dst, b, h) do { _Pragma("unroll") for (int m = 0; m < 4; ++m) _Pragma("unroll") for (int k = 0; k < 2; ++k) dst[m][k] = *(const PG8_LAS bf16x8*)(lds + PG8_SA(b, h) + aoff + m * 2048 + k * 1024); } while (0)
#define PG8_LDB(dst, b, h) do { _Pragma("unroll") for (int n = 0; n < 2; ++n) _Pragma("unroll") for (int k = 0; k < 2; ++k) dst[n][k] = *(const PG8_LAS bf16x8*)(lds + PG8_SB(b, h) + boff + n * 2048 + k * 1024); } while (0)
#define PG8_MMA(ai, bj, At, Bt) do { __builtin_amdgcn_s_setprio(1); _Pragma("unroll") for (int m = 0; m < 4; ++m) _Pragma("unroll") for (int n = 0; n < 2; ++n) _Pragma("unroll") for (int k = 0; k < 2; ++k) \
        acc[ai][bj][m][n] = __builtin_amdgcn_mfma_f32_16x16x32_bf16(Bt[n][k], At[m][k], acc[ai][bj][m][n], 0, 0, 0); __builtin_amdgcn_s_setprio(0); } while (0)
#define PG8_WAIT_V(n) asm volatile("s_waitcnt vmcnt(" #n ")" ::: "memory")
#define PG8_WAIT_L(n) asm volatile("s_waitcnt lgkmcnt(" #n ")" ::: "memory")
#define PG8_BAR __builtin_amdgcn_s_barrier()
#define PG8_SCHED __builtin_amdgcn_sched_barrier(0)
    Unit cur, nxt; int ui = 0;
    if (!S.next(0, cur)) return;
    f32x4 acc[2][2][4][2];
#pragma unroll
    for (int a = 0; a < 2; ++a)
#pragma unroll
        for (int b = 0; b < 2; ++b)
#pragma unroll
            for (int m = 0; m < 4; ++m)
#pragma unroll
                for (int n = 0; n < 2; ++n) acc[a][b][m][n] = (f32x4){0.f, 0.f, 0.f, 0.f};
    bf16x8 At[4][2], B0[2][2], B1[2][2];
    const char* cA = (const char*)g.A + (size_t)cur.pm * tstep; const char* cB = (const char*)g.Bt + (size_t)cur.pn * tstep;
    S.a_ready(cur);
    if constexpr (SP2) {
        PG8_STAGE(PG8_SB(0, 0), cB, voffB); PG8_STAGE(PG8_SB(0, 1), cB + hstep, voffB); PG8_STAGE(PG8_SA(0, 0), cA, voffA); PG8_STAGE(PG8_SA(0, 1), cA + hstepA, voffA);
        if (wr == 1) PG8_BAR;
        PG8_WAIT_V(2); PG8_BAR;
        PG8_STAGE(PG8_SB(1, 0), cB + kstep, voffB); PG8_STAGE(PG8_SA(1, 0), cA + kstep, voffA); PG8_STAGE(PG8_SB(1, 1), cB + hstep + kstep, voffB);
        PG8_WAIT_V(6); PG8_BAR;
    } else {
        PG8_STAGE(PG8_SB(0, 0), cB, voffB); PG8_STAGE(PG8_SA(0, 0), cA, voffA); PG8_STAGE(PG8_SB(0, 1), cB + hstep, voffB); PG8_STAGE(PG8_SA(0, 1), cA + hstepA, voffA);
        if (wr == 1) PG8_BAR;
        PG8_WAIT_V(4); PG8_BAR;
        PG8_STAGE(PG8_SB(1, 0), cB + kstep, voffB); PG8_STAGE(PG8_SA(1, 0), cA + kstep, voffA); PG8_STAGE(PG8_SB(1, 1), cB + hstep + kstep, voffB);
        PG8_WAIT_V(6); PG8_BAR;
    }
    for (;;) {
        const bool has_next = S.next(ui + 1, nxt);
        const char* nA = has_next ? (const char*)g.A + (size_t)nxt.pm * tstep : cA; const char* nB = has_next ? (const char*)g.Bt + (size_t)nxt.pn * tstep : cB;
        for (int t = 0; t < nt; t += 2) {
            const bool last = (t == nt - 2);
            const char* a1 = cA + (size_t)(t + 1) * kstep;
            const char* a2 = last ? nA : cA + (size_t)(t + 2) * kstep; const char* b2 = last ? nB : cB + (size_t)(t + 2) * kstep;
            const char* a3 = a2 + kstep; const char* b3 = b2 + kstep;
            if (last && has_next) S.a_ready(nxt);
            if constexpr (SP2) {
            PG8_LDB(B0, 0, 0); PG8_LDB(B1, 0, 1); PG8_SCHED; PG8_LDA(At, 0, 0); PG8_STAGE(PG8_SA(1, 1), a1 + hstepA, voffA);
            PG8_WAIT_V(8); PG8_WAIT_L(0); PG8_BAR; PG8_MMA(0, 0, At, B0); PG8_MMA(0, 1, At, B1); PG8_BAR; PG8_SCHED;
            PG8_LDA(At, 0, 1); PG8_STAGE(PG8_SB(0, 0), b2, voffB); PG8_STAGE(PG8_SB(0, 1), b2 + hstep, voffB); PG8_STAGE(PG8_SA(0, 0), a2, voffA);
            PG8_WAIT_V(8); PG8_WAIT_L(0); PG8_BAR; PG8_MMA(1, 0, At, B0); PG8_MMA(1, 1, At, B1); PG8_BAR; PG8_SCHED;
            PG8_LDB(B0, 1, 0); PG8_LDB(B1, 1, 1); PG8_SCHED; PG8_LDA(At, 1, 0); PG8_STAGE(PG8_SA(0, 1), a2 + hstepA, voffA);
            PG8_WAIT_V(8); PG8_WAIT_L(0); PG8_BAR; PG8_MMA(0, 0, At, B0); PG8_MMA(0, 1, At, B1); PG8_BAR; PG8_SCHED;
            PG8_LDA(At, 1, 1); PG8_STAGE(PG8_SB(1, 0), b3, voffB); PG8_STAGE(PG8_SB(1, 1), b3 + hstep, voffB); PG8_STAGE(PG8_SA(1, 0), a3, voffA);
            PG8_WAIT_V(8); PG8_WAIT_L(0); PG8_BAR; PG8_MMA(1, 0, At, B0); PG8_MMA(1, 1, At, B1); PG8_BAR; PG8_SCHED;
            } else {
            PG8_LDB(B0, 0, 0); PG8_SCHED; PG8_LDA(At, 0, 0); PG8_STAGE(PG8_SA(1, 1), a1 + hstepA, voffA);
            PG8_WAIT_L(8); PG8_BAR; PG8_WAIT_L(0); PG8_MMA(0, 0, At, B0); PG8_BAR; PG8_SCHED;
            PG8_LDB(B1, 0, 1); PG8_STAGE(PG8_SB(0, 0), b2, voffB);
            PG8_BAR; PG8_WAIT_L(0); PG8_MMA(0, 1, At, B1); PG8_BAR;
            PG8_LDA(At, 0, 1); PG8_STAGE(PG8_SA(0, 0), a2, voffA);
            PG8_BAR; PG8_WAIT_L(0); PG8_MMA(1, 0, At, B0); PG8_BAR; PG8_SCHED;
            PG8_STAGE(PG8_SB(0, 1), b2 + hstep, voffB);
            PG8_WAIT_V(6); PG8_BAR; PG8_MMA(1, 1, At, B1); PG8_BAR;
            PG8_LDB(B0, 1, 0); PG8_SCHED; PG8_LDA(At, 1, 0); PG8_STAGE(PG8_SA(0, 1), a2 + hstepA, voffA);
            PG8_WAIT_L(8); PG8_BAR; PG8_WAIT_L(0); PG8_MMA(0, 0, At, B0); PG8_BAR; PG8_SCHED;
            PG8_LDB(B1, 1, 1); PG8_STAGE(PG8_SB(1, 0), b3, voffB);
            PG8_BAR; PG8_WAIT_L(0); PG8_MMA(0, 1, At, B1); PG8_BAR;
            PG8_LDA(At, 1, 1); PG8_STAGE(PG8_SA(1, 0), a3, voffA);
            PG8_BAR; PG8_WAIT_L(0); PG8_MMA(1, 0, At, B0); PG8_BAR; PG8_SCHED;
            PG8_STAGE(PG8_SB(1, 1), b3 + hstep, voffB);
            PG8_WAIT_V(6); PG8_BAR; PG8_MMA(1, 1, At, B1); PG8_BAR;
            }
        }
        if constexpr (ALIGN_EPI) { if (wr == 0) PG8_BAR; }
        if constexpr (!Epi::AFTER_DRAIN) { E(acc, cur, wr, wc, fr, fq); S.done(cur); }
        if (!has_next) break;
#pragma unroll
        for (int a = 0; a < 2; ++a)
#pragma unroll
            for (int b = 0; b < 2; ++b)
#pragma unroll
                for (int m = 0; m < 4; ++m)
#pragma unroll
                    for (int n = 0; n < 2; ++n) acc[a][b][m][n] = (f32x4){0.f, 0.f, 0.f, 0.f};
        cur = nxt; cA = nA; cB = nB; ++ui;
        if constexpr (ALIGN_EPI) { if (wr == 1) PG8_BAR; }
    }
    PG8_WAIT_V(0);
    if constexpr (!ALIGN_EPI) { if (wr == 0) PG8_BAR; }
    PG8_BAR;
    if constexpr (Epi::AFTER_DRAIN) { E.fused(acc, cur, wr, wc, fr, fq, lds, wid, lane); S.done(cur); }
#undef PG8_SA
#undef PG8_SB
#undef PG8_STAGE
#undef PG8_LDA
#undef PG8_LDB
#undef PG8_MMA
#undef PG8_WAIT_V
#undef PG8_WAIT_L
#undef PG8_BAR
#undef PG8_SCHED
}
}

#ifndef PG8_SP2
#define PG8_SP2 true
#endif
#ifndef PG8_ALIGN
#define PG8_ALIGN true
#endif
constexpr int NWAVES = 8, NTHR = 512;
constexpr int BATCH = 2, SEQ = 8192, DM = 4096, MTOK = BATCH * SEQ;
constexpr int HD = 128;
constexpr int A_HEADS = 16, B_HEADS = 16, A_W = 2048, B_W = 2048, AB_IN = 4 * A_W + 3 * B_W;
constexpr int NSA_H = 32, NSA_G = 4, NSA_R = 8, KVW = 512, NSA_IN = 4096 + 6 * KVW + 96, NSA_INP = 7424;
constexpr int NCMP = 511, NCMPP = 512, NSLC = 128, NTOP = 16, WINDOW = 512;
constexpr int NMEM = 256, XH = 4, XW = 512;
constexpr int DFF = 11008, DFF2 = 22016;
constexpr float LN_EPS = 1e-5f, RMS_EPS = 1e-6f;
constexpr float DN_ALPHA = 1.41421356237309515f;
constexpr size_t MiB = (size_t)1 << 20;
constexpr size_t WS_CTL = 0, CTL_ZERO_BYTES = 4 * MiB;
constexpr size_t WS_FOLD = 64 * 1024;
constexpr int FO_XQ = 0, FO_UP = 2 * 512, FO_NSA = FO_UP + 2 * 22016, FO_N = FO_NSA + 7424;
constexpr size_t WS_RSUM = 1 * MiB;
static_assert(WS_FOLD + (size_t)2 * FO_N * 8 <= WS_RSUM && WS_RSUM + (size_t)6 * 16384 * 2 * 8 <= CTL_ZERO_BYTES, "CTL map");
constexpr size_t WS_W_ABIN = 4 * MiB;
constexpr size_t WS_W_ABOUT = WS_W_ABIN + 112 * MiB;
constexpr size_t WS_W_NSAIN = WS_W_ABOUT + 32 * MiB;
constexpr size_t WS_W_NSAOUT = WS_W_NSAIN + 58 * MiB;
constexpr size_t WS_W_XQ = WS_W_NSAOUT + 32 * MiB;
constexpr size_t WS_W_XKV = WS_W_XQ + 8 * MiB;
constexpr size_t WS_W_XO = WS_W_XKV + 16 * MiB;
constexpr size_t WS_W_UP = WS_W_XO + 8 * MiB;
constexpr size_t WS_W_DOWN = WS_W_UP + 344 * MiB;
constexpr size_t WS_W_C1 = WS_W_DOWN + 172 * MiB;
constexpr size_t WS_W_C2 = WS_W_C1 + 2 * MiB;
constexpr size_t WS_MEMB = WS_W_C2 + 1 * MiB;
constexpr size_t WS_HB = WS_MEMB + 4 * MiB;
constexpr size_t WS_Y = WS_HB + 128 * MiB;
constexpr size_t WS_BIG = WS_Y + 256 * MiB;
constexpr size_t WS_G = WS_BIG + 688 * MiB;
constexpr size_t WS_O = WS_G + 344 * MiB;
constexpr size_t WS_MISC = WS_O + 128 * MiB;
constexpr size_t WS_END = WS_MISC + 64 * MiB;
constexpr size_t WS_XQ = WS_MISC;
constexpr size_t WS_XO = WS_MISC + 16 * MiB;
constexpr size_t WS_XKV = WS_MISC + 32 * MiB;
constexpr size_t WS_LB = WS_MISC + 34 * MiB;
constexpr size_t WS_SIDE = WS_MISC + 42 * MiB;
constexpr size_t WS_FOLDF = WS_MISC + 40 * MiB;
constexpr size_t WS_ROPE = WS_MISC + 36 * MiB;
constexpr size_t WS_STATS = WS_MISC + 35 * MiB;
constexpr size_t WS_PROJ0 = WS_BIG;
constexpr size_t WS_SPREV = WS_BIG + 448 * MiB;
constexpr size_t WS_QT = WS_G;
constexpr size_t WS_OINTRA = WS_G + 64 * MiB;
constexpr size_t WS_DEC = WS_G + 192 * MiB;
constexpr size_t WS_DS = WS_Y;
constexpr size_t WS_PROJ1 = WS_BIG;
constexpr size_t WS_QROT = WS_BIG + 232 * MiB;
constexpr size_t WS_KSROT = WS_BIG + 360 * MiB;
constexpr size_t WS_KWROT = WS_BIG + 376 * MiB;
constexpr size_t WS_KCMP = WS_BIG + 392 * MiB;
constexpr size_t WS_VCMP = WS_BIG + 393 * MiB;
constexpr size_t WS_OVL = WS_BIG + 394 * MiB;
constexpr size_t WS_SEL = WS_BIG + 395 * MiB;
constexpr size_t WS_IMP = WS_G + 256 * MiB;
constexpr size_t WS_O32 = WS_G;
static_assert(WS_SPREV + 128 * MiB <= WS_G && WS_DEC + 2 * MiB <= WS_O && WS_SEL + MiB <= WS_G, "ws map");
constexpr int CW_TMO = 0, CW_CODE = 1;
constexpr int CW_BAR = 4096;
constexpr int RING_OFF = 0, RING_BYTES = 131072;
constexpr int LDSCTL_OFF = RING_BYTES, MISC_OFF = LDSCTL_OFF + 320;
constexpr int LDS_BYTES = 147456;
static_assert(MISC_OFF + 128 <= LDS_BYTES, "LDS map");

#define GAS __attribute__((address_space(1)))
#define LAS __attribute__((address_space(3)))
typedef unsigned short bf16;
typedef unsigned v4u __attribute__((ext_vector_type(4)));
typedef unsigned v2u __attribute__((ext_vector_type(2)));
typedef float f32x4 __attribute__((ext_vector_type(4)));
typedef float f32x2 __attribute__((ext_vector_type(2)));
typedef float f32x16 __attribute__((ext_vector_type(16)));
typedef short bf16x8 __attribute__((ext_vector_type(8)));
typedef short s16x4 __attribute__((ext_vector_type(4)));
typedef GAS unsigned gu32;
#define RLX_AGENT __ATOMIC_RELAXED, __HIP_MEMORY_SCOPE_AGENT
#define LDS_WAIT() asm volatile("s_waitcnt lgkmcnt(0)" ::: "memory")
#define VM_WAIT() asm volatile("s_waitcnt vmcnt(0)" ::: "memory")
#define SBAR() __builtin_amdgcn_sched_barrier(0)
__device__ __forceinline__ unsigned f2bf(float f) { unsigned u = __builtin_bit_cast(unsigned, f); return (u + 0x7fffu + ((u >> 16) & 1u)) >> 16; }
__device__ __forceinline__ unsigned pk2(float lo, float hi) { return f2bf(lo) | (f2bf(hi) << 16); }
__device__ __forceinline__ float bf2f(unsigned short b) { return __builtin_bit_cast(float, (unsigned)b << 16); }
__device__ __forceinline__ float bflo(unsigned w) { return __builtin_bit_cast(float, w << 16); }
__device__ __forceinline__ float bfhi(unsigned w) { return __builtin_bit_cast(float, w & 0xffff0000u); }
__device__ __forceinline__ unsigned cvtpk(float lo, float hi) { unsigned r; asm volatile("v_cvt_pk_bf16_f32 %0, %1, %2" : "=v"(r) : "v"(lo), "v"(hi)); return r; }
__device__ __forceinline__ float wave_sum(float v) {
#pragma unroll
    for (int o = 1; o < 64; o <<= 1) v += __shfl_xor(v, o);
    return v;
}
__device__ __forceinline__ float sigmoidf_(float x) { return __builtin_amdgcn_rcpf(1.f + __builtin_amdgcn_exp2f(-1.4426950408889634f * x)); }
__device__ __forceinline__ float gelu1(float v) { pg8::f32x2 r = pg8::gelu_pk((pg8::f32x2){v, 0.f}); return r.x; }
#define XB_TMO      128
#define XB_XCNT(j)  (256  + 64 * (j))
#define XB_XSUB(j)  (1280 + 64 * (j))
#define XB_XGEN(j)  (2304 + 64 * (j))
#define XB_TOP      3328
#define XB_TOPGEN   3392
#define XCD_BAR_WORDS 3456
#define XB_SPIN_CAP (1u << 18)
#define LAS __attribute__((address_space(3)))

__device__ __forceinline__ unsigned xb_ld(unsigned* p)              { return __hip_atomic_load(p, __ATOMIC_RELAXED, __HIP_MEMORY_SCOPE_AGENT); }
__device__ __forceinline__ unsigned xb_add(unsigned* p, unsigned v) { return __hip_atomic_fetch_add(p, v, __ATOMIC_RELAXED, __HIP_MEMORY_SCOPE_AGENT); }
__device__ __forceinline__ unsigned xb_xcc_id() { return (unsigned)__builtin_amdgcn_s_getreg((3 << 11) | 20) & 0xFu; }
#define XB_SPIN(cond, bar) do { unsigned _sp = 0; while (cond) { __builtin_amdgcn_s_sleep(1); \
    if ((++_sp & 255u) == 0u) { if (xb_ld(&(bar)[XB_TMO])) break; if (_sp > XB_SPIN_CAP) { atomicAdd(&(bar)[XB_TMO], 1u); break; } } } } while (0)

struct XcdBarrier {
    unsigned* bar; unsigned x;
    volatile LAS unsigned* st;
};

__device__ __forceinline__ XcdBarrier xcd_barrier_post(unsigned* bar, volatile LAS unsigned* st) {
    XcdBarrier b; b.bar = bar; b.x = xb_xcc_id(); b.st = st;
    if (threadIdx.x == 0) (void)xb_add(&bar[XB_XCNT(b.x)], 1u);
    return b;
}
__device__ __forceinline__ void xcd_barrier_complete(unsigned* bar, unsigned x, unsigned& nloc, unsigned& nx) {
    const unsigned G = gridDim.x * gridDim.y * gridDim.z;
    unsigned sum, cnt, mine, sp = 0u;
    for (;;) {
        sum = 0u; cnt = 0u; mine = 0u;
#pragma unroll
        for (unsigned j = 0; j < 16; ++j) { const unsigned c = xb_ld(&bar[XB_XCNT(j)]); sum += c; cnt += (c > 0u) ? 1u : 0u; mine = (j == x) ? c : mine; }
        if (sum == G) break;
        __builtin_amdgcn_s_sleep(1);
        if ((++sp & 255u) == 0u) { if (xb_ld(&bar[XB_TMO])) break; if (sp > XB_SPIN_CAP) { atomicAdd(&bar[XB_TMO], 1u); break; } }
    }
    nloc = mine > 0u ? mine : 1u; nx = cnt > 0u ? cnt : 1u;
}

__device__ __forceinline__ void xcd_barrier(const XcdBarrier& b) {
    asm volatile("s_waitcnt vmcnt(0)" ::: "memory");
    __syncthreads();
    if (threadIdx.x == 0) {
        unsigned* bar = b.bar;
        __builtin_amdgcn_s_waitcnt(0);
        unsigned nloc = b.st[0], nx = b.st[1];
        if (nloc == 0u) { xcd_barrier_complete(bar, b.x, nloc, nx); b.st[0] = nloc; b.st[1] = nx; }
        const unsigned old = xb_add(&bar[XB_XSUB(b.x)], 1u);
        const unsigned gen = old / nloc;
        if (old + 1u == (gen + 1u) * nloc) {
            __builtin_amdgcn_fence(__ATOMIC_RELEASE, "agent");
            asm volatile("s_waitcnt vmcnt(0)" ::: "memory");
            const unsigned og = xb_add(&bar[XB_TOP], 1u);
            const unsigned tg = og / nx;
            if (og + 1u == (tg + 1u) * nx) xb_add(&bar[XB_TOPGEN], 1u);
            else XB_SPIN(xb_ld(&bar[XB_TOPGEN]) == tg, bar);
            __builtin_amdgcn_fence(__ATOMIC_ACQUIRE, "agent");
            xb_add(&bar[XB_XGEN(b.x)], 1u);
            asm volatile("s_waitcnt vmcnt(0)" ::: "memory");
        } else {
            XB_SPIN(xb_ld(&bar[XB_XGEN(b.x)]) == gen, bar);
            __builtin_amdgcn_fence(__ATOMIC_ACQUIRE, "agent");
            asm volatile("s_waitcnt vmcnt(0)" ::: "memory");
        }
    }
    __syncthreads();
}


constexpr int ATT_D = 128, KVBLK = 64;
constexpr int SHM_V = KVBLK * ATT_D * 2, SHM_K = KVBLK * ATT_D * 2;
constexpr int ATT_K_OFF = 0, ATT_V_OFF = SHM_K, ATT_BUF = SHM_K + SHM_V, ATT_SET = 2 * ATT_BUF;
constexpr int ATT_WS_OFF = RING_BYTES + 512;
constexpr int ATT_X_OFF = ATT_WS_OFF + NWAVES * 256;
static_assert(2 * ATT_SET <= RING_BYTES && ATT_X_OFF + 2048 + NTHR * 16 <= LDS_BYTES, "attention LDS map");
#define KSWZ(row, colB) ((row) * 256 + ((colB) ^ (((row) & 7) << 4)))
__device__ __forceinline__ int crow(int r, int hi) { return (r & 3) + 8 * (r >> 2) + 4 * hi; }
__device__ __forceinline__ int v_st(int k, int c) { const int kk = (k & ~0xC) | ((k & 4) << 1) | ((k & 8) >> 1); return ((kk >> 3) * 4 + (c >> 5)) * 512 + ((kk & 7) * 32 + (c & 31)) * 2; }
__device__ __forceinline__ int v_rd_base(int lane) { return ((lane & 3) << 3) | (((lane >> 2) & 3) << 6) | (((lane >> 4) & 1) << 5) | (((lane >> 5) & 1) << 8); }
constexpr int v_rd_off(int d0, int ks, int half) { return d0 * 512 + ks * 4096 + half * 2048; }
template <int OFF> __device__ __forceinline__ s16x4 tr_read(int vb) {
  s16x4 r; asm volatile("ds_read_b64_tr_b16 %0, %1 offset:%2" : "=&v"(r) : "v"(vb), "i"(OFF) : "memory"); return r;
}
__device__ __forceinline__ void qkt(f32x16& p0, f32x16& p1, const LAS char* Ks, const bf16x8* qr, int r32, int hi) {
  p0 = f32x16{}; p1 = f32x16{};
#pragma unroll
  for (int d0 = 0; d0 < 8; ++d0) { const int cb = (d0 * 16 + hi * 8) * 2;
    const bf16x8 b0 = *(const LAS bf16x8*)(Ks + KSWZ(r32, cb));
    const bf16x8 b1 = *(const LAS bf16x8*)(Ks + KSWZ(32 + r32, cb));
    p0 = __builtin_amdgcn_mfma_f32_32x32x16_bf16(b0, qr[d0], p0, 0, 0, 0);
    p1 = __builtin_amdgcn_mfma_f32_32x32x16_bf16(b1, qr[d0], p1, 0, 0, 0); }
}
__device__ __forceinline__ void pack_p(const f32x16& p0, const f32x16& p1, bf16x8& pa0, bf16x8& pa1, bf16x8& pa2, bf16x8& pa3) {
#define PK4(P, BASE, OUT) do { unsigned a0 = cvtpk(P[BASE + 0], P[BASE + 1]), a1 = cvtpk(P[BASE + 2], P[BASE + 3]);   \
    unsigned b0 = cvtpk(P[BASE + 4], P[BASE + 5]), b1 = cvtpk(P[BASE + 6], P[BASE + 7]);                              \
    auto r0 = __builtin_amdgcn_permlane32_swap(a0, b0, false, false); auto r1 = __builtin_amdgcn_permlane32_swap(a1, b1, false, false); \
    v4u w = {r0[0], r1[0], r0[1], r1[1]}; OUT = __builtin_bit_cast(bf16x8, w); } while (0)
  PK4(p0, 0, pa0); PK4(p0, 8, pa1); PK4(p1, 0, pa2); PK4(p1, 8, pa3);
#undef PK4
}
template <int D0> __device__ __forceinline__ void pv_one(f32x16& od, int vb, bf16x8 pa0, bf16x8 pa1, bf16x8 pa2, bf16x8 pa3) {
  const s16x4 l0 = tr_read<v_rd_off(D0, 0, 0)>(vb), h0 = tr_read<v_rd_off(D0, 0, 1)>(vb), l1 = tr_read<v_rd_off(D0, 1, 0)>(vb), h1 = tr_read<v_rd_off(D0, 1, 1)>(vb);
  const s16x4 l2 = tr_read<v_rd_off(D0, 2, 0)>(vb), h2 = tr_read<v_rd_off(D0, 2, 1)>(vb), l3 = tr_read<v_rd_off(D0, 3, 0)>(vb), h3 = tr_read<v_rd_off(D0, 3, 1)>(vb);
  asm volatile("s_waitcnt lgkmcnt(0)" ::: "memory"); SBAR();
#define PKV(L, H) (bf16x8){L[0], L[1], L[2], L[3], H[0], H[1], H[2], H[3]}
  od = __builtin_amdgcn_mfma_f32_32x32x16_bf16(pa0, PKV(l0, h0), od, 0, 0, 0);
  od = __builtin_amdgcn_mfma_f32_32x32x16_bf16(pa1, PKV(l1, h1), od, 0, 0, 0);
  od = __builtin_amdgcn_mfma_f32_32x32x16_bf16(pa2, PKV(l2, h2), od, 0, 0, 0);
  od = __builtin_amdgcn_mfma_f32_32x32x16_bf16(pa3, PKV(l3, h3), od, 0, 0, 0);
#undef PKV
}
__device__ __forceinline__ void pv_d0(f32x16* o, int vb, bf16x8 pa0, bf16x8 pa1, bf16x8 pa2, bf16x8 pa3) {
  pv_one<0>(o[0], vb, pa0, pa1, pa2, pa3); pv_one<1>(o[1], vb, pa0, pa1, pa2, pa3); pv_one<2>(o[2], vb, pa0, pa1, pa2, pa3); pv_one<3>(o[3], vb, pa0, pa1, pa2, pa3);
}
struct KVStage { bf16x8 ks0, ks1, vs0, vs1; };
__device__ __forceinline__ void kv_load(KVStage& s, const bf16* Kh, const bf16* Vh, long ldk, long ldv, int k0, int sr, int sc) {
  s.ks0 = *(const bf16x8*)(Kh + (long)(k0 + sr) * ldk + sc); s.ks1 = *(const bf16x8*)(Kh + (long)(k0 + 32 + sr) * ldk + sc);
  s.vs0 = *(const bf16x8*)(Vh + (long)(k0 + sr) * ldv + sc); s.vs1 = *(const bf16x8*)(Vh + (long)(k0 + 32 + sr) * ldv + sc);
}
__device__ __forceinline__ void kv_write(const KVStage& s, LAS char* lds, int sr, int sc) {
  *(LAS bf16x8*)(lds + ATT_V_OFF + v_st(sr, sc)) = s.vs0; *(LAS bf16x8*)(lds + ATT_V_OFF + v_st(32 + sr, sc)) = s.vs1;
  *(LAS bf16x8*)(lds + ATT_K_OFF + KSWZ(sr, sc * 2)) = s.ks0; *(LAS bf16x8*)(lds + ATT_K_OFF + KSWZ(32 + sr, sc * 2)) = s.ks1;
}
struct KVDma { int ko[2], vo[2]; };
__device__ __forceinline__ void kv_dma_init(KVDma& d, int ldk, int ldv, int wid, int lane) {
#pragma unroll
  for (int i = 0; i < 2; ++i) { const int p = wid * 2 + i;
    const int row = p * 4 + (lane >> 4), cp = lane & 15; d.ko[i] = row * ldk + ((cp ^ (row & 7)) << 3);
    const int sub = p * 2 + (lane >> 5), kk = (sub >> 2) * 8 + ((lane & 31) >> 2), k = (kk & ~0xC) | ((kk & 4) << 1) | ((kk & 8) >> 1), c = (sub & 3) * 32 + (lane & 3) * 8;
    d.vo[i] = k * ldv + c; }
}
__device__ __forceinline__ void kv_dma(const KVDma& d, const bf16* Kt, const bf16* Vt, LAS char* lds, int buf, int wid) {
#pragma unroll
  for (int i = 0; i < 2; ++i) {
    __builtin_amdgcn_global_load_lds((const unsigned*)(Kt + d.ko[i]), (LAS unsigned*)(lds + buf + ATT_K_OFF + (wid * 2 + i) * 1024), 16, 0, 0);
    __builtin_amdgcn_global_load_lds((const unsigned*)(Vt + d.vo[i]), (LAS unsigned*)(lds + buf + ATT_V_OFF + (wid * 2 + i) * 1024), 16, 0, 0); }
}
__device__ __forceinline__ void rescale_o(f32x16* o, float a, LAS float* al_l, int r32, int hi) {
  if (__any(a < 1.f)) { if (hi == 0) al_l[r32] = a; LDS_WAIT();
#pragma unroll
    for (int r = 0; r < 16; ++r) { const float f = al_l[crow(r, hi)];
#pragma unroll
      for (int d = 0; d < 4; ++d) o[d][r] *= f; }
    LDS_WAIT(); }
}
constexpr float ATT_SCALE = 0.088388347648318440f, ATT_C = ATT_SCALE * 1.4426950408889634f, ATT_THR = 8.f;
__device__ __forceinline__ void softmax_tile(f32x16& p0, f32x16& p1, float& m_reg, float& l_reg, float& alpha, bool rowvalid = true) {
  float pmax = p0[0];
#pragma unroll
  for (int r = 1; r < 16; ++r) pmax = fmaxf(pmax, p0[r]);
#pragma unroll
  for (int r = 0; r < 16; ++r) pmax = fmaxf(pmax, p1[r]);
  { auto rr = __builtin_amdgcn_permlane32_swap(__float_as_uint(pmax), __float_as_uint(pmax), false, false);
    pmax = fmaxf(__uint_as_float(rr[0]), __uint_as_float(rr[1])); }
  if (!rowvalid) pmax = -__builtin_inff();
  float mn;
  if (__all(pmax - m_reg <= ATT_THR / ATT_SCALE)) { mn = m_reg; alpha = 1.f; }
  else { mn = fmaxf(m_reg, pmax); alpha = __builtin_amdgcn_exp2f((m_reg - mn) * ATT_C); m_reg = mn; }
  const float mnC = rowvalid ? -mn * ATT_C : -__builtin_inff();
#pragma unroll
  for (int r = 0; r < 16; ++r) { p0[r] = __builtin_amdgcn_exp2f(fmaf(p0[r], ATT_C, mnC)); p1[r] = __builtin_amdgcn_exp2f(fmaf(p1[r], ATT_C, mnC)); }
  float ps = 0.f;
#pragma unroll
  for (int r = 0; r < 16; ++r) ps += p0[r] + p1[r];
  { auto rr = __builtin_amdgcn_permlane32_swap(__float_as_uint(ps), __float_as_uint(ps), false, false);
    ps = __uint_as_float(rr[0]) + __uint_as_float(rr[1]); }
  l_reg = l_reg * alpha + ps;
}
__device__ __forceinline__ void attn_finish(f32x16& p0, f32x16& p1, f32x16* o, float& m_reg, float& l_reg, LAS float* wsc, int vb, int r32, int hi, bool rowvalid = true) {
  float alpha; softmax_tile(p0, p1, m_reg, l_reg, alpha, rowvalid);
  rescale_o(o, alpha, wsc, r32, hi);
  bf16x8 pa0, pa1, pa2, pa3; pack_p(p0, p1, pa0, pa1, pa2, pa3);
  pv_d0(o, vb, pa0, pa1, pa2, pa3);
}
__device__ __forceinline__ void load_q(bf16x8* qr, const bf16* Qw) {
#pragma unroll
  for (int d0 = 0; d0 < 8; ++d0) qr[d0] = *(const bf16x8*)(Qw + d0 * 16);
}

struct Frame {
    LAS unsigned char* lds;
    unsigned char* ws;
    int tid, lane, wave, G, bid;
    __device__ __forceinline__ void fresh() { int t = threadIdx.x; asm volatile("" : "+v"(t)); tid = t; lane = t & 63; wave = __builtin_amdgcn_readfirstlane(t >> 6);
        int g_ = gridDim.x, b_ = blockIdx.x; asm volatile("" : "+s"(g_), "+s"(b_)); G = g_; bid = b_; }
};
struct Args { const float* in[19]; float* out; unsigned char* ws; int ph_lo, ph_hi; };
typedef const Args __attribute__((address_space(4))) KArgs;
__device__ __forceinline__ KArgs* karg() { KArgs* p = (KArgs*)__builtin_amdgcn_kernarg_segment_ptr(); asm volatile("" : "+s"(p)); return p; }
#define KIN(i) ((const float*)karg()->in[i])
enum { IN_X = 0, IN_MEM, IN_AB_W_IN, IN_HGRN_LB, IN_HGRN_NW, IN_AB_W_OUT, IN_NSA_W_IN, IN_NSA_CMP_POS, IN_NSA_CMP_W1, IN_NSA_CMP_W2, IN_NSA_W_OUT,
       IN_XA_WQ, IN_XA_WKV, IN_XA_WO, IN_FFN_UP, IN_FFN_CONV, IN_FFN_DOWN, IN_LN_G, IN_LN_B };

__device__ __forceinline__ void p0_transpose_item(const float* W, int K, int N, bf16* WT, LAS float* scr, int item, int lane) {
    const int nblk = N / 32, kb = item / nblk, nb = item % nblk, k0 = 64 * kb, n0 = 32 * nb;
#pragma unroll 8
    for (int i = 0; i < 32; ++i) { const int kk = 2 * i + (lane >> 5); scr[kk * 33 + (lane & 31)] = W[(size_t)(k0 + kk) * N + n0 + (lane & 31)]; }
    LDS_WAIT(); asm volatile("" ::: "memory");
    const int c = lane & 7;
#pragma unroll
    for (int j = 0; j < 4; ++j) { const int n = (lane >> 3) + 8 * j; const LAS float* s = scr + (8 * c) * 33 + n;
        v4u o; o.x = pk2(s[0 * 33], s[1 * 33]); o.y = pk2(s[2 * 33], s[3 * 33]); o.z = pk2(s[4 * 33], s[5 * 33]); o.w = pk2(s[6 * 33], s[7 * 33]);
        *(GAS v4u*)(WT + (size_t)(n0 + n) * K + k0 + 8 * c) = o; }
    LDS_WAIT(); asm volatile("" ::: "memory");
}
__device__ __forceinline__ int up_col(int n) { const int isu = n >= DFF, ch = isu ? n - DFF : n; return (ch >> 7) * 256 + isu * 128 + (ch & 127); }
__device__ __forceinline__ void p0_transpose_item_fold(const float* W, int K, int N, bf16* WT, LAS float* scr, int item, int lane, const float* g, const float* b, long long* cs, long long* b2, bool upmap = false) {
    const int nblk = N / 32, kb = item / nblk, nb = item % nblk, k0 = 64 * kb, n0 = 32 * nb, n0m = upmap ? up_col(n0) : n0;
#pragma unroll 8
    for (int i = 0; i < 32; ++i) { const int kk = 2 * i + (lane >> 5); scr[kk * 33 + (lane & 31)] = W[(size_t)(k0 + kk) * N + n0 + (lane & 31)]; }
    LDS_WAIT(); asm volatile("" ::: "memory");
    const int c = lane & 7;
    const f32x4 g0 = *(const f32x4*)(g + k0 + 8 * c), g1 = *(const f32x4*)(g + k0 + 8 * c + 4), b0 = *(const f32x4*)(b + k0 + 8 * c), b1 = *(const f32x4*)(b + k0 + 8 * c + 4);
    const float gg[8] = {g0.x, g0.y, g0.z, g0.w, g1.x, g1.y, g1.z, g1.w}, bb[8] = {b0.x, b0.y, b0.z, b0.w, b1.x, b1.y, b1.z, b1.w};
#pragma unroll
    for (int j = 0; j < 4; ++j) { const int n = (lane >> 3) + 8 * j; const LAS float* s = scr + (8 * c) * 33 + n;
        float sc = 0.f, sb = 0.f; unsigned w[4];
#pragma unroll
        for (int q = 0; q < 4; ++q) { const float x0 = s[(2 * q) * 33], x1 = s[(2 * q + 1) * 33]; const unsigned r0 = f2bf(x0 * gg[2 * q]), r1 = f2bf(x1 * gg[2 * q + 1]);
            w[q] = r0 | (r1 << 16); sc += bf2f((unsigned short)r0) + bf2f((unsigned short)r1); sb += x0 * bb[2 * q] + x1 * bb[2 * q + 1]; }
        *(GAS v4u*)(WT + (size_t)(n0m + n) * K + k0 + 8 * c) = (v4u){w[0], w[1], w[2], w[3]};
        sc += __shfl_xor(sc, 1); sc += __shfl_xor(sc, 2); sc += __shfl_xor(sc, 4); sb += __shfl_xor(sb, 1); sb += __shfl_xor(sb, 2); sb += __shfl_xor(sb, 4);
        if (c == 0) { atomicAdd((unsigned long long*)(cs + n0m + n), (unsigned long long)(long long)rintf(sc * pg8::FOLD_SCALE)); atomicAdd((unsigned long long*)(b2 + n0m + n), (unsigned long long)(long long)rintf(sb * pg8::FOLD_SCALE)); } }
    LDS_WAIT(); asm volatile("" ::: "memory");
}
__device__ __forceinline__ void transpose_mat_fold(Frame& F, const float* W, int K, int N, bf16* WT, const float* g, const float* b, long long* cs, long long* b2, int c0 = 0, int nw = 1 << 30, int part = 0, int nparts = 1, bool upmap = false) {
    if (F.bid < c0 || F.bid >= c0 + nw) return;
    LAS float* scr = (LAS float*)(F.lds + RING_OFF + F.wave * 16384);
    const int nwg = nw < F.G ? nw : F.G, gw = (F.bid - c0) * NWAVES + F.wave, NGW = nwg * NWAVES;
    const int nitems = (K / 64) * (N / 32), ilo = (int)((long)nitems * part / nparts), ihi = (int)((long)nitems * (part + 1) / nparts);
    for (int it = ilo + gw; it < ihi; it += NGW) p0_transpose_item_fold(W, K, N, WT, scr, it, F.lane, g, b, cs, b2, upmap);
}
__device__ __forceinline__ void transpose_mat(Frame& F, const float* W, int K, int N, bf16* WT, int c0 = 0, int nw = 1 << 30) {
    if (F.bid < c0 || F.bid >= c0 + nw) return;
    LAS float* scr = (LAS float*)(F.lds + RING_OFF + F.wave * 16384);
    const int nwg = nw < F.G ? nw : F.G, gw = (F.bid - c0) * NWAVES + F.wave, NGW = nwg * NWAVES;
    const int nitems = (K / 64) * (N / 32);
    for (int it = gw; it < nitems; it += NGW) p0_transpose_item(W, K, N, WT, scr, it, F.lane);
}
__device__ __forceinline__ void fold_finalize(Frame& F, int lo, int n) {
    const long long* fs = (const long long*)(F.ws + WS_FOLD); float* fd = (float*)(F.ws + WS_FOLDF);
    for (int i = F.bid * NTHR + F.tid; i < 2 * n; i += F.G * NTHR) { const int j = (i < n) ? lo + i : FO_N + lo + (i - n); const long long v = fs[j]; fd[j] = (float)(int)(v >> 32) + (float)(unsigned)v * pg8::FOLD_INV; }
}
enum { CJ_DOWN0, CJ_NSA, CJ_L1A, CJ_L1B, CJ_DOWN1 };
template <int JOB>
__device__ __forceinline__ void convert_job(Frame& F, const Args& A, int c0, int nw) {
    unsigned char* ws = F.ws; long long* cs = (long long*)(ws + WS_FOLD); long long* b2 = cs + FO_N;
    if (JOB == CJ_DOWN0 || JOB == CJ_DOWN1) { const int l = JOB == CJ_DOWN1; transpose_mat(F, KIN(IN_FFN_DOWN) + (size_t)l * DFF * DM, DFF, DM, (bf16*)(ws + WS_W_DOWN) + (size_t)l * DM * DFF, c0, nw); }
    if (JOB == CJ_NSA) {
        transpose_mat_fold(F, KIN(IN_NSA_W_IN), DM, NSA_IN, (bf16*)(ws + WS_W_NSAIN), KIN(IN_LN_G) + 2 * DM, KIN(IN_LN_B) + 2 * DM, cs + FO_NSA, b2 + FO_NSA, c0, nw);
        transpose_mat(F, KIN(IN_NSA_W_OUT), DM, DM, (bf16*)(ws + WS_W_NSAOUT), c0, nw); }
    if (JOB == CJ_L1A || JOB == CJ_L1B) { const int l = 1;
        if (JOB == CJ_L1A) {
            transpose_mat_fold(F, KIN(IN_XA_WQ) + (size_t)l * DM * XW, DM, XW, (bf16*)(ws + WS_W_XQ) + (size_t)l * XW * DM, KIN(IN_LN_G) + (size_t)(3 * l) * DM, KIN(IN_LN_B) + (size_t)(3 * l) * DM, cs + FO_XQ + l * XW, b2 + FO_XQ + l * XW, c0, nw);
            transpose_mat(F, KIN(IN_XA_WKV) + (size_t)l * DM * 2 * XW, DM, 2 * XW, (bf16*)(ws + WS_W_XKV) + (size_t)l * 2 * XW * DM, c0, nw);
            transpose_mat(F, KIN(IN_XA_WO) + (size_t)l * XW * DM, XW, DM, (bf16*)(ws + WS_W_XO) + (size_t)l * DM * XW, c0, nw); }
        transpose_mat_fold(F, KIN(IN_FFN_UP) + (size_t)l * DM * DFF2, DM, DFF2, (bf16*)(ws + WS_W_UP) + (size_t)l * DFF2 * DM, KIN(IN_LN_G) + (size_t)(3 * l + 1) * DM, KIN(IN_LN_B) + (size_t)(3 * l + 1) * DM,
                           cs + FO_UP + l * DFF2, b2 + FO_UP + l * DFF2, c0, nw, JOB == CJ_L1A ? 0 : 1, 2, true); }
}
__device__ __forceinline__ void cvt_flat(Frame& F, const float* src, bf16* dst, long n8) {
    for (long i = (long)F.bid * NTHR + F.tid; i < n8; i += (long)F.G * NTHR) {
        const f32x4 a = *(const f32x4*)(src + i * 8), b = *(const f32x4*)(src + i * 8 + 4);
        v4u o; o.x = pk2(a.x, a.y); o.y = pk2(a.z, a.w); o.z = pk2(b.x, b.y); o.w = pk2(b.z, b.w);
        *(v4u*)(dst + i * 8) = o; }
}
__device__ __forceinline__ void p0_prologue(Frame& F, const Args& A) {
    unsigned char* ws = F.ws;
    long long* cs = (long long*)(ws + WS_FOLD); long long* b2 = cs + FO_N;
    transpose_mat(F, KIN(IN_AB_W_IN), DM, AB_IN, (bf16*)(ws + WS_W_ABIN));
    transpose_mat(F, KIN(IN_AB_W_OUT), DM, DM, (bf16*)(ws + WS_W_ABOUT));
    { const int l = 0;
        transpose_mat_fold(F, KIN(IN_XA_WQ) + (size_t)l * DM * XW, DM, XW, (bf16*)(ws + WS_W_XQ) + (size_t)l * XW * DM, KIN(IN_LN_G) + (size_t)(3 * l) * DM, KIN(IN_LN_B) + (size_t)(3 * l) * DM, cs + FO_XQ + l * XW, b2 + FO_XQ + l * XW);
        transpose_mat(F, KIN(IN_XA_WKV) + (size_t)l * DM * 2 * XW, DM, 2 * XW, (bf16*)(ws + WS_W_XKV) + (size_t)l * 2 * XW * DM);
        transpose_mat(F, KIN(IN_XA_WO) + (size_t)l * XW * DM, XW, DM, (bf16*)(ws + WS_W_XO) + (size_t)l * DM * XW);
        transpose_mat_fold(F, KIN(IN_FFN_UP) + (size_t)l * DM * DFF2, DM, DFF2, (bf16*)(ws + WS_W_UP) + (size_t)l * DFF2 * DM, KIN(IN_LN_G) + (size_t)(3 * l + 1) * DM, KIN(IN_LN_B) + (size_t)(3 * l + 1) * DM, cs + FO_UP + l * DFF2, b2 + FO_UP + l * DFF2, 0, 1 << 30, 0, 1, true); }
    for (int l = 0; l < 2; ++l) {
        transpose_mat(F, KIN(IN_NSA_CMP_W1) + (size_t)l * 32 * HD * HD, 32 * HD, HD, (bf16*)(ws + WS_W_C1) + (size_t)l * HD * 32 * HD);
        transpose_mat(F, KIN(IN_NSA_CMP_W2) + (size_t)l * HD * HD, HD, HD, (bf16*)(ws + WS_W_C2) + (size_t)l * HD * HD);
    }
    cvt_flat(F, KIN(IN_X), (bf16*)(ws + WS_HB), (long)MTOK * DM / 8);
    cvt_flat(F, KIN(IN_MEM), (bf16*)(ws + WS_MEMB), (long)BATCH * NMEM * DM / 8);
    { v4u z = {0u, 0u, 0u, 0u}; v4u* p = (v4u*)((bf16*)(ws + WS_W_NSAIN) + (size_t)NSA_IN * DM); const long n = (long)(NSA_INP - NSA_IN) * DM / 8;
      for (long i = (long)F.bid * NTHR + F.tid; i < n; i += (long)F.G * NTHR) p[i] = z; }
    { float* tab = (float*)(ws + WS_ROPE);
      for (int i = F.bid * NTHR + F.tid; i < SEQ * 64; i += F.G * NTHR) { const int t = i >> 6, d = i & 63;
          float sn, cs; sincosf((float)t * powf(10000.0f, -(float)d * (1.0f / 64.0f)), &sn, &cs); tab[(size_t)t * 128 + d] = cs; tab[(size_t)t * 128 + 64 + d] = sn; } }
    { const float* lbp = KIN(IN_HGRN_LB); float* lbo = (float*)(ws + WS_LB);
      for (int i = F.bid * NTHR + F.tid; i < A_W; i += F.G * NTHR) { const float a = lbp[i], b = lbp[A_W + i], m = fmaxf(a, b), ea = __expf(a - m), eb = __expf(b - m); lbo[i] = ea / (ea + eb); } }
}

__device__ __forceinline__ void ln_phase(Frame& F, const bf16* Y, const float* g, const float* b, float* h32) {
    const int gw = F.bid * NWAVES + F.wave, NGW = F.G * NWAVES;
    for (int m = gw; m < MTOK; m += NGW) {
        const v4u* yr = (const v4u*)(Y + (size_t)m * DM) + F.lane;
        float v[8][8]; float s = 0.f;
#pragma unroll
        for (int j = 0; j < 8; ++j) { const v4u x = yr[64 * j];
            v[j][0] = bflo(x.x); v[j][1] = bfhi(x.x); v[j][2] = bflo(x.y); v[j][3] = bfhi(x.y); v[j][4] = bflo(x.z); v[j][5] = bfhi(x.z); v[j][6] = bflo(x.w); v[j][7] = bfhi(x.w);
#pragma unroll
            for (int q = 0; q < 8; ++q) s += v[j][q]; }
        const float mean = wave_sum(s) * (1.f / DM); float s2 = 0.f;
#pragma unroll
        for (int j = 0; j < 8; ++j)
#pragma unroll
            for (int q = 0; q < 8; ++q) { v[j][q] -= mean; s2 += v[j][q] * v[j][q]; }
        const float rstd = 1.f / sqrtf(wave_sum(s2) * (1.f / DM) + LN_EPS);
#pragma unroll
        for (int j = 0; j < 8; ++j) { const int c0 = 8 * F.lane + 512 * j;
            const f32x4 g0 = *(const f32x4*)(g + c0), g1 = *(const f32x4*)(g + c0 + 4), b0 = *(const f32x4*)(b + c0), b1 = *(const f32x4*)(b + c0 + 4);
            f32x4 r0, r1;
            r0.x = v[j][0] * rstd * g0.x + b0.x; r0.y = v[j][1] * rstd * g0.y + b0.y; r0.z = v[j][2] * rstd * g0.z + b0.z; r0.w = v[j][3] * rstd * g0.w + b0.w;
            r1.x = v[j][4] * rstd * g1.x + b1.x; r1.y = v[j][5] * rstd * g1.y + b1.y; r1.z = v[j][6] * rstd * g1.z + b1.z; r1.w = v[j][7] * rstd * g1.w + b1.w;
            *(f32x4*)(h32 + (size_t)m * DM + c0) = r0; *(f32x4*)(h32 + (size_t)m * DM + c0 + 4) = r1; }
    }
}

__device__ __forceinline__ void cg_unpack(const v4u x, float* o) { o[0] = bflo(x.x); o[1] = bfhi(x.x); o[2] = bflo(x.y); o[3] = bfhi(x.y); o[4] = bflo(x.z); o[5] = bfhi(x.z); o[6] = bflo(x.w); o[7] = bfhi(x.w); }
__device__ __forceinline__ void convglu_fixup_phase(Frame& F, const bf16* SIDE, const float* cw, bf16* Gm) {
    constexpr int NCG = DFF / 8, NRUN = MTOK / 128;
    for (int it = F.bid * NTHR + F.tid; it < NCG * NRUN; it += F.G * NTHR) {
        const int cg = it % NCG, run = it / NCG, c0 = cg * 8, t0 = run * 128;
        float w0[8], w1[8], w2[8], am2[8], am1[8], a0[8], a1[8], u0[8], u1[8];
#pragma unroll
        for (int j = 0; j < 8; ++j) { w0[j] = cw[c0 + j]; w1[j] = cw[DFF + c0 + j]; w2[j] = cw[2 * DFF + c0 + j]; }
        const bf16* sp = SIDE + (size_t)run * 6 * DFF + c0;
        if ((t0 & (SEQ - 1)) == 0) {
#pragma unroll
            for (int j = 0; j < 8; ++j) { am2[j] = 0.f; am1[j] = 0.f; }
        } else { cg_unpack(*(const v4u*)sp, am2); cg_unpack(*(const v4u*)(sp + DFF), am1); }
        cg_unpack(*(const v4u*)(sp + 2 * DFF), a0); cg_unpack(*(const v4u*)(sp + 3 * DFF), a1); cg_unpack(*(const v4u*)(sp + 4 * DFF), u0); cg_unpack(*(const v4u*)(sp + 5 * DFF), u1);
        unsigned o0[4], o1[4];
#pragma unroll
        for (int j = 0; j < 8; j += 2) {
            const pg8::f32x2 g0 = pg8::gelu_pk((pg8::f32x2){w2[j] * a0[j] + w1[j] * am1[j] + w0[j] * am2[j], w2[j + 1] * a0[j + 1] + w1[j + 1] * am1[j + 1] + w0[j + 1] * am2[j + 1]});
            const pg8::f32x2 g1 = pg8::gelu_pk((pg8::f32x2){w2[j] * a1[j] + w1[j] * a0[j] + w0[j] * am1[j], w2[j + 1] * a1[j + 1] + w1[j + 1] * a0[j + 1] + w0[j + 1] * am1[j + 1]});
            o0[j >> 1] = pk2(g0.x * u0[j], g0.y * u0[j + 1]); o1[j >> 1] = pk2(g1.x * u1[j], g1.y * u1[j + 1]); }
        *(v4u*)(Gm + (size_t)t0 * DFF + c0) = (v4u){o0[0], o0[1], o0[2], o0[3]}; *(v4u*)(Gm + (size_t)(t0 + 1) * DFF + c0) = (v4u){o1[0], o1[1], o1[2], o1[3]};
    }
}

__device__ __forceinline__ void xattn_phase(Frame& F, const bf16* XQ, const bf16* XKV, bf16* XO) {
    const int tid = F.tid, wid = F.wave, lane = F.lane, r32 = lane & 31, hi = lane >> 5;
    LAS char* lds = (LAS char*)F.lds;
    LAS float* wsc = (LAS float*)(lds + ATT_WS_OFF + wid * 256);
    const int vb0 = (int)(uintptr_t)(lds + ATT_V_OFF) + v_rd_base(lane);
    KVDma dm; kv_dma_init(dm, 2 * XW, 2 * XW, wid, lane);
    constexpr int NU = (MTOK / 256) * XH;
    for (int u = F.bid; u < NU; u += F.G) {
        const int head = u % XH, rbk = u / XH, row0 = rbk * 256, b = row0 / SEQ;
        const bf16* Kh = XKV + (size_t)b * NMEM * 2 * XW + head * HD; const bf16* Vh = Kh + XW;
        bf16x8 qr[8]; load_q(qr, XQ + (size_t)(row0 + wid * 32 + r32) * XW + head * HD + hi * 8);
        float m_reg = -1e30f, l_reg = 0.f; f32x16 o[4] = {};
        __syncthreads();
        kv_dma(dm, Kh, Vh, lds, 0, wid);
        for (int j = 0; j < NMEM / KVBLK; ++j) {
            const int buf = (j & 1) * ATT_BUF;
            VM_WAIT(); __syncthreads();
            if (j + 1 < NMEM / KVBLK) kv_dma(dm, Kh + (size_t)(j + 1) * KVBLK * 2 * XW, Vh + (size_t)(j + 1) * KVBLK * 2 * XW, lds, ATT_BUF - buf, wid);
            f32x16 p0, p1; qkt(p0, p1, lds + buf + ATT_K_OFF, qr, r32, hi);
            float alpha; softmax_tile(p0, p1, m_reg, l_reg, alpha);
            rescale_o(o, alpha, wsc, r32, hi);
            bf16x8 pa0, pa1, pa2, pa3; pack_p(p0, p1, pa0, pa1, pa2, pa3);
            pv_d0(o, vb0 + buf, pa0, pa1, pa2, pa3);
        }
        if (hi == 0) wsc[32 + r32] = l_reg; LDS_WAIT();
        bf16* Ow = XO + (size_t)(row0 + wid * 32) * XW + head * HD;
#pragma unroll
        for (int r = 0; r < 16; ++r) { const int orow = crow(r, hi); const float rl = __builtin_amdgcn_rcpf(wsc[32 + orow]);
#pragma unroll
            for (int d0 = 0; d0 < 4; ++d0) Ow[(size_t)orow * XW + d0 * 32 + r32] = (bf16)f2bf(o[d0][r] * rl); }
        LDS_WAIT();
    }
}

template <int K>
__device__ __forceinline__ f32x4 mma_tile(const LAS char* A, int lda, const LAS char* B, int ldb, int fr, int fq) {
    f32x4 acc = {0.f, 0.f, 0.f, 0.f};
#pragma unroll
    for (int k0 = 0; k0 < K; k0 += 32) {
        const bf16x8 a = *(const LAS bf16x8*)(A + fr * lda + (k0 + 8 * fq) * 2);
        const bf16x8 b = *(const LAS bf16x8*)(B + fr * ldb + (k0 + 8 * fq) * 2);
        acc = __builtin_amdgcn_mfma_f32_16x16x32_bf16(a, b, acc, 0, 0, 0);
    }
    return acc;
}
constexpr int HG_CH = 64, HG_NC = SEQ / HG_CH, HG_ITEMS = BATCH * A_HEADS * HG_NC;
constexpr int HG_QT = 0, HG_KT = 17408, HG_KH = 34816, HG_VT = 53248, HG_PT = 71680, HG_SEG = 80896;
constexpr int HG_SP = 17408, HG_OT = 52224;
constexpr int HG_WT = 80896, HG_KHS = 86016, HG_VS = 103424;
__device__ __forceinline__ void hgrn_phase_a(Frame& F, const bf16* P0, const float* lbv, bf16* QTg, bf16* OINTRA, bf16* DS, float* DEC) {
    LAS char* lds = (LAS char*)F.lds;
    const int tid = F.tid, wid = F.wave, lane = F.lane, fr = lane & 15, fq = lane >> 4;
    const int dg = tid & 15, sq = tid >> 4;
    const int d = tid & 127, sq16 = tid >> 7;
    for (int it = F.bid; it < HG_ITEMS; it += F.G) {
        const int c = it % HG_NC, bh = it / HG_NC, h = bh % A_HEADS, b = bh / A_HEADS;
        const size_t row0 = (size_t)b * SEQ + (size_t)c * HG_CH;
        float lb[8], q[2][8], kk[2][8], cum[2][8]; v4u vraw[2];
        { const f32x4 l0 = *(const f32x4*)(lbv + h * HD + 8 * dg), l1 = *(const f32x4*)(lbv + h * HD + 8 * dg + 4);
          lb[0] = l0.x; lb[1] = l0.y; lb[2] = l0.z; lb[3] = l0.w; lb[4] = l1.x; lb[5] = l1.y; lb[6] = l1.z; lb[7] = l1.w; }
#pragma unroll
        for (int rr = 0; rr < 2; ++rr) { const bf16* rowp = P0 + (row0 + 2 * sq + rr) * AB_IN + h * HD + 8 * dg;
            const v4u zq = *(const v4u*)(rowp + A_W), qq = *(const v4u*)rowp; vraw[rr] = *(const v4u*)(rowp + 2 * A_W);
            const unsigned zw[4] = {zq.x, zq.y, zq.z, zq.w}, qw[4] = {qq.x, qq.y, qq.z, qq.w};
#pragma unroll
            for (int j = 0; j < 8; ++j) { const float z = (j & 1) ? bfhi(zw[j >> 1]) : bflo(zw[j >> 1]); q[rr][j] = (j & 1) ? bfhi(qw[j >> 1]) : bflo(qw[j >> 1]);
                const float sg = sigmoidf_(z), omlb = 1.f - lb[j]; kk[rr][j] = omlb * (1.f - sg);
                const float lf = __logf(lb[j] + omlb * sg); cum[rr][j] = rr ? cum[0][j] + lf : lf; } }
        float pre[8];
#pragma unroll
        for (int j = 0; j < 8; ++j) { const float seg = cum[1][j]; float x = seg; const float t1 = __shfl_up(x, 16); if (lane >= 16) x += t1; const float t2 = __shfl_up(x, 32); if (lane >= 32) x += t2;
            pre[j] = x - seg; if (lane >= 48) ((LAS float*)(lds + HG_WT))[wid * 128 + 8 * dg + j] = x; }
        LDS_WAIT(); __syncthreads();
        float total[8];
#pragma unroll
        for (int j = 0; j < 8; ++j) total[j] = 0.f;
#pragma unroll
        for (int w = 0; w < NWAVES; ++w) { const f32x4 a0 = *(const LAS f32x4*)(lds + HG_WT + (w * 128 + 8 * dg) * 4), a1 = *(const LAS f32x4*)(lds + HG_WT + (w * 128 + 8 * dg + 4) * 4);
            const float av[8] = {a0.x, a0.y, a0.z, a0.w, a1.x, a1.y, a1.z, a1.w};
#pragma unroll
            for (int j = 0; j < 8; ++j) { total[j] += av[j]; if (w < wid) pre[j] += av[j]; } }
#pragma unroll
        for (int rr = 0; rr < 2; ++rr) { const int s = 2 * sq + rr; unsigned qt[4], kt[4], kh[4];
#pragma unroll
            for (int j = 0; j < 8; j += 2) { const float b0 = pre[j] + cum[rr][j], b1 = pre[j + 1] + cum[rr][j + 1];
                qt[j >> 1] = pk2(q[rr][j] * __expf(b0), q[rr][j + 1] * __expf(b1));
                kt[j >> 1] = pk2(kk[rr][j] * __expf(-b0), kk[rr][j + 1] * __expf(-b1));
                kh[j >> 1] = pk2(kk[rr][j] * __expf(total[j] - b0), kk[rr][j + 1] * __expf(total[j + 1] - b1)); }
            const v4u qv = {qt[0], qt[1], qt[2], qt[3]};
            *(LAS v4u*)(lds + HG_QT + s * 272 + dg * 16) = qv; *(v4u*)(QTg + (row0 + s) * A_W + h * HD + 8 * dg) = qv;
            *(LAS v4u*)(lds + HG_KT + s * 272 + dg * 16) = (v4u){kt[0], kt[1], kt[2], kt[3]};
            *(LAS v4u*)(lds + HG_KHS + s * 272 + dg * 16) = (v4u){kh[0], kh[1], kh[2], kh[3]};
            *(LAS v4u*)(lds + HG_VS + s * 272 + dg * 16) = vraw[rr]; }
        if (sq == 31) { f32x4 e0, e1; e0.x = __expf(total[0]); e0.y = __expf(total[1]); e0.z = __expf(total[2]); e0.w = __expf(total[3]); e1.x = __expf(total[4]); e1.y = __expf(total[5]); e1.z = __expf(total[6]); e1.w = __expf(total[7]);
            *(f32x4*)(DEC + (size_t)it * HD + 8 * dg) = e0; *(f32x4*)(DEC + (size_t)it * HD + 8 * dg + 4) = e1; }
        LDS_WAIT(); __syncthreads();
        { unsigned kh[8], vt[8];
#pragma unroll
          for (int j = 0; j < 16; j += 2) { const int s = 16 * sq16 + j;
              kh[j >> 1] = (unsigned)*(const LAS unsigned short*)(lds + HG_KHS + s * 272 + d * 2) | ((unsigned)*(const LAS unsigned short*)(lds + HG_KHS + (s + 1) * 272 + d * 2) << 16);
              vt[j >> 1] = (unsigned)*(const LAS unsigned short*)(lds + HG_VS + s * 272 + d * 2) | ((unsigned)*(const LAS unsigned short*)(lds + HG_VS + (s + 1) * 272 + d * 2) << 16); }
          LAS v4u* pk = (LAS v4u*)(lds + HG_KH + d * 144 + sq16 * 32); pk[0] = (v4u){kh[0], kh[1], kh[2], kh[3]}; pk[1] = (v4u){kh[4], kh[5], kh[6], kh[7]};
          LAS v4u* pv = (LAS v4u*)(lds + HG_VT + d * 144 + sq16 * 32); pv[0] = (v4u){vt[0], vt[1], vt[2], vt[3]}; pv[1] = (v4u){vt[4], vt[5], vt[6], vt[7]}; }
        LDS_WAIT(); __syncthreads();
#pragma unroll
        for (int k = 0; k < 2; ++k) { const int tau = 2 * wid + k, ti = tau >> 2, si = tau & 3;
            f32x4 acc = {0.f, 0.f, 0.f, 0.f};
            if (si <= ti) acc = mma_tile<128>(lds + HG_QT + ti * 16 * 272, 272, lds + HG_KT + si * 16 * 272, 272, fr, fq);
#pragma unroll
            for (int i = 0; i < 4; ++i) { const int t = 16 * ti + 4 * fq + i, s = 16 * si + fr; const float v = (s <= t) ? acc[i] : 0.f;
                *(LAS unsigned short*)(lds + HG_PT + t * 144 + s * 2) = (unsigned short)f2bf(v); } }
        LDS_WAIT(); __syncthreads();
#pragma unroll
        for (int k = 0; k < 4; ++k) { const int tau = wid + 8 * k, ti = tau >> 3, vi = tau & 7;
            const f32x4 acc = mma_tile<64>(lds + HG_VT + vi * 16 * 144, 144, lds + HG_PT + ti * 16 * 144, 144, fr, fq);
            v2u w; w.x = pk2(acc[0], acc[1]); w.y = pk2(acc[2], acc[3]);
            *(v2u*)(OINTRA + (row0 + 16 * ti + fr) * A_W + h * HD + 16 * vi + 4 * fq) = w; }
#pragma unroll
        for (int k = 0; k < 8; ++k) { const int tau = wid + 8 * k, vi = tau >> 3, ki = tau & 7;
            const f32x4 acc = mma_tile<64>(lds + HG_KH + ki * 16 * 144, 144, lds + HG_VT + vi * 16 * 144, 144, fr, fq);
            v2u w; w.x = pk2(acc[0], acc[1]); w.y = pk2(acc[2], acc[3]);
            *(v2u*)(DS + ((size_t)it * HD + 16 * vi + fr) * HD + 16 * ki + 4 * fq) = w; }
        LDS_WAIT(); __syncthreads();
    }
}
__device__ __forceinline__ void hgrn_phase_b(Frame& F, const bf16* DS, const float* DEC, bf16* SPREV) {
    const int tid = F.tid, dvl = tid >> 5, dk4 = (tid & 31) * 4;
    for (int item = F.bid; item < BATCH * A_HEADS * 8; item += F.G) {
        const int sl = item & 7, bh = item >> 3, dv = sl * 16 + dvl;
        f32x4 S = {0.f, 0.f, 0.f, 0.f};
        for (int c0 = 0; c0 < HG_NC; c0 += 8) {
            f32x4 ds[8], dc[8];
#pragma unroll
            for (int k = 0; k < 8; ++k) { const size_t it = (size_t)bh * HG_NC + c0 + k; const v2u x = *(const v2u*)(DS + (it * HD + dv) * HD + dk4);
                ds[k] = (f32x4){bflo(x.x), bfhi(x.x), bflo(x.y), bfhi(x.y)}; dc[k] = *(const f32x4*)(DEC + it * HD + dk4); }
#pragma unroll
            for (int k = 0; k < 8; ++k) { const size_t it = (size_t)bh * HG_NC + c0 + k;
                v2u w; w.x = pk2(S.x, S.y); w.y = pk2(S.z, S.w); *(v2u*)(SPREV + (it * HD + dv) * HD + dk4) = w;
                S = S * dc[k] + ds[k]; }
        }
    }
}
__device__ __forceinline__ void hgrn_phase_c(Frame& F, const bf16* P0, const bf16* QTg, const bf16* OINTRA, const bf16* SPREV, const float* nw, bf16* Ob) {
    LAS char* lds = (LAS char*)F.lds;
    const int tid = F.tid, wid = F.wave, lane = F.lane, fr = lane & 15, fq = lane >> 4;
    for (int it = F.bid; it < HG_ITEMS; it += F.G) {
        const int c = it % HG_NC, bh = it / HG_NC, h = bh % A_HEADS, b = bh / A_HEADS;
        const size_t row0 = (size_t)b * SEQ + (size_t)c * HG_CH;
        { const int s = tid >> 3, ch = (tid & 7) * 16; const bf16* src = QTg + (row0 + s) * A_W + h * HD + ch;
          const v4u x0 = *(const v4u*)src, x1 = *(const v4u*)(src + 8); LAS v4u* dst = (LAS v4u*)(lds + HG_QT + s * 272 + ch * 2); dst[0] = x0; dst[1] = x1; }
        { const int dv = tid >> 2, ch = (tid & 3) * 32; const bf16* src = SPREV + ((size_t)it * HD + dv) * HD + ch;
          const v4u x0 = *(const v4u*)src, x1 = *(const v4u*)(src + 8), x2 = *(const v4u*)(src + 16), x3 = *(const v4u*)(src + 24);
          LAS v4u* dst = (LAS v4u*)(lds + HG_SP + dv * 272 + ch * 2); dst[0] = x0; dst[1] = x1; dst[2] = x2; dst[3] = x3; }
        LDS_WAIT(); __syncthreads();
#pragma unroll
        for (int k = 0; k < 4; ++k) { const int tau = wid + 8 * k, ti = tau >> 3, vi = tau & 7;
            const f32x4 acc = mma_tile<128>(lds + HG_SP + vi * 16 * 272, 272, lds + HG_QT + ti * 16 * 272, 272, fr, fq);
            const int t = 16 * ti + fr, dv = 16 * vi + 4 * fq; const v2u oi = *(const v2u*)(OINTRA + (row0 + t) * A_W + h * HD + dv);
            *(LAS f32x4*)(lds + HG_OT + (t * 132 + dv) * 4) = (f32x4){acc[0] + bflo(oi.x), acc[1] + bfhi(oi.x), acc[2] + bflo(oi.y), acc[3] + bfhi(oi.y)}; }
        LDS_WAIT(); __syncthreads();
        { const int t = tid >> 3, dv0 = (tid & 7) * 16;
          float v[16]; float ss = 0.f;
#pragma unroll
          for (int q4 = 0; q4 < 4; ++q4) { const f32x4 x = *(const LAS f32x4*)(lds + HG_OT + (t * 132 + dv0 + 4 * q4) * 4); v[4 * q4] = x.x; v[4 * q4 + 1] = x.y; v[4 * q4 + 2] = x.z; v[4 * q4 + 3] = x.w;
              ss += (x.x * x.x + x.y * x.y) + (x.z * x.z + x.w * x.w); }
          ss += __shfl_xor(ss, 1); ss += __shfl_xor(ss, 2); ss += __shfl_xor(ss, 4);
          const float r = 1.f / sqrtf(ss * (1.f / HD) + RMS_EPS);
          const bf16* gp = P0 + (row0 + t) * AB_IN + 3 * A_W + h * HD + dv0; const v4u g0 = *(const v4u*)gp, g1 = *(const v4u*)(gp + 8);
          const unsigned gw[8] = {g0.x, g0.y, g0.z, g0.w, g1.x, g1.y, g1.z, g1.w}; unsigned o[8];
#pragma unroll
          for (int j = 0; j < 8; ++j) { const float ga = bflo(gw[j]), gb = bfhi(gw[j]);
              o[j] = pk2(v[2 * j] * r * nw[dv0 + 2 * j] * ga * sigmoidf_(ga), v[2 * j + 1] * r * nw[dv0 + 2 * j + 1] * gb * sigmoidf_(gb)); }
          bf16* op = Ob + (row0 + t) * DM + h * HD + dv0; *(v4u*)op = (v4u){o[0], o[1], o[2], o[3]}; *(v4u*)(op + 8) = (v4u){o[4], o[5], o[6], o[7]}; }
        LDS_WAIT(); __syncthreads();
    }
}

constexpr float SB_CUT = -160.f;
__device__ __forceinline__ void sb_phase(Frame& F, const bf16* P0, bf16* Ob) {
    const int tid = F.tid, wid = F.wave, lane = F.lane, r32 = lane & 31, hi = lane >> 5;
    LAS char* lds = (LAS char*)F.lds;
    const int vb0 = (int)(uintptr_t)(lds + ATT_V_OFF) + v_rd_base(lane);
    KVDma dm; kv_dma_init(dm, AB_IN, AB_IN, wid, lane);
    constexpr int NQB = SEQ / 256, NU = BATCH * B_HEADS * NQB;
    for (int rd = 0; ; ++rd) {
        const int idx = (rd & 1) ? rd * F.G + (F.G - 1 - F.bid) : rd * F.G + F.bid;
        if (rd * F.G >= NU) break;
        if (idx >= NU) continue;
        const int qb = NQB - 1 - idx / (BATCH * B_HEADS), bh = idx % (BATCH * B_HEADS), head = bh % B_HEADS, b = bh / B_HEADS;
        const size_t rowb = (size_t)b * SEQ; const int q0 = qb * 256;
        const bf16* Kh = P0 + rowb * AB_IN + 4 * A_W + B_W + head * HD; const bf16* Vh = Kh + B_W;
        const int tw0 = q0 + wid * 32, t = tw0 + r32;
        bf16x8 qr[8]; load_q(qr, P0 + (rowb + t) * AB_IN + 4 * A_W + head * HD + hi * 8);
        float R = 0.f; f32x16 o[4] = {};
        const int jtop = (q0 + 254) >> 6;
        LAS unsigned* dflag = (LAS unsigned*)(lds + ATT_X_OFF);
        if (lane == 0) { dflag[wid] = 0u; dflag[8 + wid] = 0u; }
        LDS_WAIT(); __syncthreads();
        kv_dma(dm, Kh + (size_t)jtop * KVBLK * AB_IN, Vh + (size_t)jtop * KVBLK * AB_IN, lds, 0, wid);
        int buf = 0;
        for (int j = jtop; j >= 0; --j, buf = ATT_BUF - buf) {
            VM_WAIT(); __syncthreads();
            { unsigned alld = 1u;
#pragma unroll
              for (int w = 0; w < NWAVES; ++w) alld &= dflag[((j + 1) & 1) * 8 + w];
              if (__builtin_amdgcn_readfirstlane(alld)) break; }
            if (j > 0) kv_dma(dm, Kh + (size_t)(j - 1) * KVBLK * AB_IN, Vh + (size_t)(j - 1) * KVBLK * AB_IN, lds, ATT_BUF - buf, wid);
            const int k0 = j * KVBLK;
            if (k0 < tw0 + 31) {
                f32x16 p0, p1; qkt(p0, p1, lds + buf + ATT_K_OFF, qr, r32, hi);
                const bool need_mask = (k0 + 63 >= tw0);
                float L0[16], L1[16];
#pragma unroll
                for (int r = 0; r < 16; ++r) {
                    const float z0 = p0[r] * ATT_C, z1 = p1[r] * ATT_C;
                    float l0 = -(fmaxf(z0, 0.f) + __builtin_amdgcn_logf(1.f + __builtin_amdgcn_exp2f(-fabsf(z0))));
                    float l1 = -(fmaxf(z1, 0.f) + __builtin_amdgcn_logf(1.f + __builtin_amdgcn_exp2f(-fabsf(z1))));
                    if (need_mask) { if (k0 + crow(r, hi) >= t) l0 = 0.f; if (k0 + 32 + crow(r, hi) >= t) l1 = 0.f; }
                    L0[r] = l0; L1[r] = l1; p0[r] = z0 + l0; p1[r] = z1 + l1;
                }
                SBAR();
                float Sg[16];
#pragma unroll
                for (int gi = 0; gi < 4; ++gi) {
                    const float a = (L0[4 * gi] + L0[4 * gi + 1]) + (L0[4 * gi + 2] + L0[4 * gi + 3]), c = (L1[4 * gi] + L1[4 * gi + 1]) + (L1[4 * gi + 2] + L1[4 * gi + 3]);
                    auto ra = __builtin_amdgcn_permlane32_swap(__float_as_uint(a), __float_as_uint(a), false, false);
                    auto rc = __builtin_amdgcn_permlane32_swap(__float_as_uint(c), __float_as_uint(c), false, false);
                    Sg[2 * gi] = __uint_as_float(ra[0]); Sg[2 * gi + 1] = __uint_as_float(ra[1]); Sg[8 + 2 * gi] = __uint_as_float(rc[0]); Sg[8 + 2 * gi + 1] = __uint_as_float(rc[1]);
                }
                float run = R;
#pragma unroll
                for (int s = 15; s >= 0; --s) { const float tt = run; run += Sg[s]; Sg[s] = tt; }
                const float Rn = run;
                SBAR();
#pragma unroll
                for (int gi = 0; gi < 4; ++gi) {
                    float base0 = hi ? Sg[2 * gi + 1] : Sg[2 * gi], base1 = hi ? Sg[8 + 2 * gi + 1] : Sg[8 + 2 * gi];
                    float r3 = base0, r2 = r3 + L0[4 * gi + 3], r1 = r2 + L0[4 * gi + 2], r0 = r1 + L0[4 * gi + 1];
                    p0[4 * gi + 3] = __builtin_amdgcn_exp2f(p0[4 * gi + 3] + r3); p0[4 * gi + 2] = __builtin_amdgcn_exp2f(p0[4 * gi + 2] + r2);
                    p0[4 * gi + 1] = __builtin_amdgcn_exp2f(p0[4 * gi + 1] + r1); p0[4 * gi + 0] = __builtin_amdgcn_exp2f(p0[4 * gi + 0] + r0);
                    r3 = base1; r2 = r3 + L1[4 * gi + 3]; r1 = r2 + L1[4 * gi + 2]; r0 = r1 + L1[4 * gi + 1];
                    p1[4 * gi + 3] = __builtin_amdgcn_exp2f(p1[4 * gi + 3] + r3); p1[4 * gi + 2] = __builtin_amdgcn_exp2f(p1[4 * gi + 2] + r2);
                    p1[4 * gi + 1] = __builtin_amdgcn_exp2f(p1[4 * gi + 1] + r1); p1[4 * gi + 0] = __builtin_amdgcn_exp2f(p1[4 * gi + 0] + r0);
                }
                R = Rn;
                { const unsigned dn = __all(R < SB_CUT) ? 1u : 0u; if (lane == 0) dflag[(j & 1) * 8 + wid] = dn; }
                if (need_mask) {
#pragma unroll
                    for (int r = 0; r < 16; ++r) { if (k0 + crow(r, hi) >= t) p0[r] = 0.f; if (k0 + 32 + crow(r, hi) >= t) p1[r] = 0.f; }
                }
                bf16x8 pa0, pa1, pa2, pa3; pack_p(p0, p1, pa0, pa1, pa2, pa3);
                pv_d0(o, vb0 + buf, pa0, pa1, pa2, pa3);
            }
        }
        bf16* Ow = Ob + (rowb + tw0) * DM + A_W + head * HD;
#pragma unroll
        for (int r = 0; r < 16; ++r) { const int orow = crow(r, hi);
#pragma unroll
            for (int d0 = 0; d0 < 4; ++d0) Ow[(size_t)orow * DM + d0 * 32 + r32] = (bf16)f2bf(o[d0][r]); }
    }
}

constexpr int P1_KC = 4096, P1_VC = 4608, P1_KS = 5120, P1_VS = 5632, P1_KW = 6144, P1_VW = 6656, P1_GL = 7168;
__device__ __forceinline__ void nsa_rope_phase(Frame& F, const bf16* P1, const float* TAB, bf16* QROT, bf16* KSROT, bf16* KWROT, bf16* OVL) {
    const int gw = F.bid * NWAVES + F.wave, NGW = F.G * NWAVES, lane = F.lane, hsub = lane >> 3, d0 = (lane & 7) * 8;
    for (int m = gw; m < MTOK; m += NGW) {
        const int t = m & (SEQ - 1);
        const f32x4 c0 = *(const f32x4*)(TAB + (size_t)t * 128 + d0), c1 = *(const f32x4*)(TAB + (size_t)t * 128 + d0 + 4);
        const f32x4 s0 = *(const f32x4*)(TAB + (size_t)t * 128 + 64 + d0), s1 = *(const f32x4*)(TAB + (size_t)t * 128 + 64 + d0 + 4);
        const float cs[8] = {c0.x, c0.y, c0.z, c0.w, c1.x, c1.y, c1.z, c1.w}, sn[8] = {s0.x, s0.y, s0.z, s0.w, s1.x, s1.y, s1.z, s1.w};
        const bf16* row = P1 + (size_t)m * NSA_INP;
#pragma unroll
        for (int hb = 0; hb < 5; ++hb) {
            const int hh = hb * 8 + hsub;
            const bf16* src; bf16* dst;
            if (hh < 32) { src = row + hh * HD; dst = QROT + (size_t)m * DM + hh * HD; }
            else if (hh < 36) { src = row + P1_KS + (hh - 32) * HD; dst = KSROT + (size_t)m * KVW + (hh - 32) * HD; }
            else { src = row + P1_KW + (hh - 36) * HD; dst = KWROT + (size_t)m * KVW + (hh - 36) * HD; }
            const v4u a = *(const v4u*)(src + d0), bq = *(const v4u*)(src + 64 + d0);
            const unsigned aw[4] = {a.x, a.y, a.z, a.w}, bw[4] = {bq.x, bq.y, bq.z, bq.w}; unsigned o1[4], o2[4];
#pragma unroll
            for (int q = 0; q < 4; ++q) { const float x1l = bflo(aw[q]), x1h = bfhi(aw[q]), x2l = bflo(bw[q]), x2h = bfhi(bw[q]);
                o1[q] = pk2(x1l * cs[2 * q] - x2l * sn[2 * q], x1h * cs[2 * q + 1] - x2h * sn[2 * q + 1]);
                o2[q] = pk2(x2l * cs[2 * q] + x1l * sn[2 * q], x2h * cs[2 * q + 1] + x1h * sn[2 * q + 1]); }
            *(v4u*)(dst + d0) = (v4u){o1[0], o1[1], o1[2], o1[3]}; *(v4u*)(dst + 64 + d0) = (v4u){o2[0], o2[1], o2[2], o2[3]};
        }
    }
    for (int i = F.bid * NTHR + F.tid; i < NCMPP * NSLC; i += F.G * NTHR) { const int n = i / NSLC, j = i % NSLC;
        OVL[i] = (n < NCMP && n >= 4 * j - 1 && n <= 4 * j + 3) ? (bf16)0x3f80u : (bf16)0u; }
}
constexpr int CM_A = 0, CM_B = 17408, CM_H = 17408 + 34816;
__device__ __forceinline__ void nsa_compress_phase(Frame& F, const bf16* P1, const float* pos, const bf16* W1t, const bf16* W2t, bf16* KCMP, bf16* VCMP) {
    LAS char* lds = (LAS char*)F.lds;
    const int tid = F.tid, wid = F.wave, lane = F.lane, fr = lane & 15, fq = lane >> 4;
    for (int item = F.bid; item < 128; item += F.G) {
        const int nt = item & 7, g = (item >> 3) & 3, b = (item >> 5) & 1, which = item >> 6;
        const bf16* w1 = W1t + (size_t)which * HD * 32 * HD; const bf16* w2 = W2t + (size_t)which * HD * HD;
        const float* posw = pos + (size_t)which * 32 * HD;
        f32x4 acc[4];
#pragma unroll
        for (int k = 0; k < 4; ++k) acc[k] = (f32x4){0.f, 0.f, 0.f, 0.f};
        for (int l = 0; l < 32; ++l) {
            { const int r = tid >> 3, ch = (tid & 7) * 16, n = nt * 64 + r; unsigned w[8];
              if (n < NCMP) { const bf16* src = P1 + ((size_t)b * SEQ + 16 * n + l) * NSA_INP + P1_KC + which * KVW + g * HD + ch;
                  const v4u x0 = *(const v4u*)src, x1 = *(const v4u*)(src + 8); const unsigned xs[8] = {x0.x, x0.y, x0.z, x0.w, x1.x, x1.y, x1.z, x1.w};
#pragma unroll
                  for (int q = 0; q < 8; ++q) w[q] = pk2(bflo(xs[q]) + posw[l * HD + ch + 2 * q], bfhi(xs[q]) + posw[l * HD + ch + 2 * q + 1]);
              } else {
#pragma unroll
                  for (int q = 0; q < 8; ++q) w[q] = 0u; }
              LAS v4u* dst = (LAS v4u*)(lds + CM_A + r * 272 + ch * 2); dst[0] = (v4u){w[0], w[1], w[2], w[3]}; dst[1] = (v4u){w[4], w[5], w[6], w[7]}; }
            { const int e = tid >> 2, ch = (tid & 3) * 32; const bf16* src = w1 + (size_t)e * 32 * HD + l * HD + ch;
              const v4u x0 = *(const v4u*)src, x1 = *(const v4u*)(src + 8), x2 = *(const v4u*)(src + 16), x3 = *(const v4u*)(src + 24);
              LAS v4u* dst = (LAS v4u*)(lds + CM_B + e * 272 + ch * 2); dst[0] = x0; dst[1] = x1; dst[2] = x2; dst[3] = x3; }
            LDS_WAIT(); __syncthreads();
#pragma unroll
            for (int k = 0; k < 4; ++k) { const int tau = wid + 8 * k, ni = tau >> 3, ei = tau & 7;
                acc[k] += mma_tile<128>(lds + CM_A + ni * 16 * 272, 272, lds + CM_B + ei * 16 * 272, 272, fr, fq); }
            LDS_WAIT(); __syncthreads();
        }
#pragma unroll
        for (int k = 0; k < 4; ++k) { const int tau = wid + 8 * k, ni = tau >> 3, ei = tau & 7;
#pragma unroll
            for (int i = 0; i < 4; ++i) *(LAS unsigned short*)(lds + CM_H + (16 * ni + 4 * fq + i) * 272 + (16 * ei + fr) * 2) = (unsigned short)f2bf(gelu1(acc[k][i])); }
        { const int f = tid >> 2, ch = (tid & 3) * 32; const bf16* src = w2 + (size_t)f * HD + ch;
          const v4u x0 = *(const v4u*)src, x1 = *(const v4u*)(src + 8), x2 = *(const v4u*)(src + 16), x3 = *(const v4u*)(src + 24);
          LAS v4u* dst = (LAS v4u*)(lds + CM_B + f * 272 + ch * 2); dst[0] = x0; dst[1] = x1; dst[2] = x2; dst[3] = x3; }
        LDS_WAIT(); __syncthreads();
        bf16* outp = which ? VCMP : KCMP;
#pragma unroll
        for (int k = 0; k < 4; ++k) { const int tau = wid + 8 * k, ni = tau >> 3, fi = tau & 7;
            const f32x4 a2 = mma_tile<128>(lds + CM_H + ni * 16 * 272, 272, lds + CM_B + fi * 16 * 272, 272, fr, fq);
#pragma unroll
            for (int i = 0; i < 4; ++i) { const int n = nt * 64 + 16 * ni + 4 * fq + i;
                outp[(((size_t)b * NCMPP + n) * NSA_G + g) * HD + 16 * fi + fr] = (n < NCMP) ? (bf16)f2bf(a2[i]) : (bf16)0u; } }
        LDS_WAIT(); __syncthreads();
    }
}
__device__ __forceinline__ unsigned topk_key(float v) { const unsigned u = (v == 0.f) ? 0u : __builtin_bit_cast(unsigned, v); return u ^ ((u >> 31) ? 0xffffffffu : 0x80000000u); }
__device__ __forceinline__ v4u topk_select(float a0, float a1, int cur, int lane) {
    const unsigned k0 = topk_key(a0), k1 = topk_key(a1);
    const int j0 = lane, j1 = lane + 64;
    const bool f0 = (j0 == 0) || (j0 == cur) || (j0 == cur - 1), f1 = (j1 == cur) || (j1 == cur - 1);
    const unsigned long long c0m = __ballot(!f0 && j0 <= cur), c1m = __ballot(!f1 && j1 <= cur);
    const int nforced = cur >= 2 ? 3 : cur + 1, slots = NTOP - nforced;
    unsigned long long s0m = c0m, s1m = c1m;
    if (__builtin_popcountll(c0m) + __builtin_popcountll(c1m) > slots) {
        unsigned T = 0u;
#pragma nounroll
        for (int bit = 31; bit >= 0; --bit) { const unsigned trial = T | (1u << bit);
            const int cnt = __builtin_popcountll(__ballot(k0 >= trial) & c0m) + __builtin_popcountll(__ballot(k1 >= trial) & c1m);
            if (cnt >= slots) T = trial; }
        unsigned long long e0 = __ballot(k0 == T) & c0m, e1 = __ballot(k1 == T) & c1m;
        s0m = __ballot(k0 > T) & c0m; s1m = __ballot(k1 > T) & c1m;
        int need = slots - __builtin_popcountll(s0m) - __builtin_popcountll(s1m);
        while (need > 0 && e0) { const unsigned long long b = e0 & (~e0 + 1ull); s0m |= b; e0 ^= b; --need; }
        while (need > 0 && e1) { const unsigned long long b = e1 & (~e1 + 1ull); s1m |= b; e1 ^= b; --need; }
    }
    const unsigned long long m0 = s0m | __ballot(f0 && j0 <= cur), m1 = s1m | __ballot(f1 && j1 <= cur);
    return (v4u){(unsigned)m0, (unsigned)(m0 >> 32), (unsigned)m1, (unsigned)(m1 >> 32)};
}
__device__ __forceinline__ unsigned pick4(const unsigned (&a)[4], int i) { return i == 0 ? a[0] : (i == 1 ? a[1] : (i == 2 ? a[2] : a[3])); }
template <int MODE>
__device__ __forceinline__ void nsa_attn_phase(Frame& F, const bf16* P1, const bf16* Qsrc, const bf16* Ksrc, const bf16* Vsrc, const unsigned* SEL, float* O32, unsigned* IMPO, bf16* Ob, bool probe_nostore = false) {
    const int tid = F.tid, wid = F.wave, lane = F.lane, r32 = lane & 31, hi = lane >> 5;
    LAS char* lds = (LAS char*)F.lds;
    LAS float* wsc = (LAS float*)(lds + ATT_WS_OFF + wid * 256);
    const int vb0 = (int)(uintptr_t)(lds + ATT_V_OFF) + v_rd_base(lane);
    KVDma dm; kv_dma_init(dm, MODE <= 1 ? NSA_G * HD : KVW, MODE == 0 ? NSA_G * HD : (MODE == 1 ? NSLC : NSA_INP), wid, lane);
    constexpr int NTB = SEQ / 32, NU = BATCH * NSA_G * NTB;
    for (int rd = 0; ; ++rd) {
        int idx;
        { idx = (rd & 1) ? rd * F.G + (F.G - 1 - F.bid) : rd * F.G + F.bid; if (rd * F.G >= NU) break; if (idx >= NU) continue; }
        const int tb = NTB - 1 - idx / (BATCH * NSA_G), bg = idx % (BATCH * NSA_G), g = bg % NSA_G, b = bg / NSA_G;
        const size_t rowb = (size_t)b * SEQ; const int t0 = tb * 32;
        const int t = (MODE == 2) ? t0 + 4 * wid + (r32 >> 3) : t0 + r32, head = (MODE == 2) ? g * NSA_R + (r32 & 7) : g * NSA_R + wid;
        const bf16* Kh; const bf16* Vh; long ldk, ldv; int jlo, jhi;
        if (MODE <= 1) { Kh = Ksrc + ((size_t)b * NCMPP * NSA_G + g) * HD; ldk = NSA_G * HD; jlo = 0; jhi = (t0 >> 4) >> 6;
            if (MODE == 0) { Vh = Vsrc + ((size_t)b * NCMPP * NSA_G + g) * HD; ldv = NSA_G * HD; } else { Vh = Vsrc; ldv = NSLC; } }
        else { Kh = Ksrc + rowb * KVW + g * HD; ldk = KVW; Vh = P1 + rowb * NSA_INP + (MODE == 2 ? P1_VS : P1_VW) + g * HD; ldv = NSA_INP;
            jhi = (t0 + 31) >> 6; jlo = (MODE == 2) ? 0 : ((t0 - (WINDOW - 1) > 0 ? t0 - (WINDOW - 1) : 0) >> 6); }
        unsigned wn[4] = {~0u, ~0u, ~0u, ~0u};
        if (MODE == 2) { const v4u sv = *(const v4u*)(SEL + ((rowb + t) * NSA_G + g) * 4); unsigned selw[4]; selw[0] = sv.x; selw[1] = sv.y; selw[2] = sv.z; selw[3] = sv.w;
            *(LAS v4u*)(lds + ATT_X_OFF + 2048 + (wid * 64 + lane) * 16) = sv;
            LAS unsigned* un = (LAS unsigned*)(lds + ATT_X_OFF);
#pragma unroll
            for (int q = 0; q < 4; ++q) { unsigned x = selw[q]; x |= __shfl_xor(x, 8); x |= __shfl_xor(x, 16); wn[q] = __builtin_amdgcn_readfirstlane(x); if (lane == 0) un[wid * 4 + q] = wn[q]; }
            LDS_WAIT(); __syncthreads();
            LAS int* plist = (LAS int*)(lds + ATT_X_OFF + 128);
            if (wid == 0) {
                unsigned m0 = 0u, m1 = 0u;
                int lane_l = lane; asm volatile("" : "+v"(lane_l));
                const LAS unsigned* ub = un + (lane_l >> 5);
#pragma unroll
                for (int w = 0; w < NWAVES; ++w) { m0 |= ((ub[w * 4] >> (lane & 31)) & 1u) << w; m1 |= ((ub[w * 4 + 2] >> (lane & 31)) & 1u) << w; }
                bool v0 = m0 != 0u && lane <= jhi, v1 = m1 != 0u && lane + 64 <= jhi; int np = 0;
                for (;;) {
                    const unsigned long long a0 = __ballot(v0), a1 = __ballot(v1);
                    if (!(a0 | a1)) break;
                    const int ja_ = a0 ? __builtin_ctzll(a0) : 64 + __builtin_ctzll(a1);
                    const unsigned ma = (ja_ < 64) ? (unsigned)__shfl((int)m0, ja_) : (unsigned)__shfl((int)m1, ja_ - 64);
                    if (lane == (ja_ & 63)) { if (ja_ < 64) v0 = false; else v1 = false; }
                    unsigned long long c0 = __ballot(v0 && !(m0 & ma)), c1 = __ballot(v1 && !(m1 & ma));
                    if (!(c0 | c1)) { c0 = __ballot(v0 && m0 == 0xffu); c1 = __ballot(v1 && m1 == 0xffu); }
                    if (!(c0 | c1)) { c0 = __ballot(v0); c1 = __ballot(v1); }
                    int jb_ = -1;
                    if (c0 | c1) { jb_ = c0 ? __builtin_ctzll(c0) : 64 + __builtin_ctzll(c1); if (lane == (jb_ & 63)) { if (jb_ < 64) v0 = false; else v1 = false; } }
                    if (lane == 0) { plist[2 * np] = ja_; plist[2 * np + 1] = jb_; }
                    ++np;
                }
                if (lane == 0) { int neg1 = -1; asm volatile("" : "+v"(neg1)); plist[2 * np] = neg1; plist[2 * np + 1] = neg1; }
            }
            LDS_WAIT(); }
        bf16x8 qr[8]; load_q(qr, Qsrc + (rowb + t) * (MODE <= 1 ? NSA_INP : DM) + head * HD + hi * 8);
        float m_reg = -1e30f, l_reg = 0.f; f32x16 o[4] = {};
        const int cur = t >> 6;
#define NSA_NEED(jj) (MODE != 2 || ((pick4(wn, (jj) >> 5) >> ((jj) & 31)) & 1u))
#define NSA_MASK(P0, P1, JJ) do { const int k0 = (JJ) * KVBLK; constexpr float NINF = -__builtin_inff(); \
            if (MODE <= 1) { if (!(16 * (k0 + 63) + 31 <= t0)) { \
                    _Pragma("unroll") for (int r = 0; r < 16; ++r) { if (!(16 * (k0 + crow(r, hi)) + 31 <= t)) P0[r] = NINF; if (!(16 * (k0 + 32 + crow(r, hi)) + 31 <= t)) P1[r] = NINF; } } } \
            else if (MODE == 2) { rv_ = (*(const LAS unsigned*)(lds + ATT_X_OFF + 2048 + (wid * 64 + lane) * 16 + ((JJ) >> 5) * 4) >> ((JJ) & 31)) & 1u;     \
                if ((JJ) >= cur) { const int lim = t - k0 - 4 * hi;                          \
                    _Pragma("unroll") for (int r = 0; r < 16; ++r) { if ((r & 3) + 8 * (r >> 2) > lim) P0[r] = NINF; if (32 + (r & 3) + 8 * (r >> 2) > lim) P1[r] = NINF; } } } \
            else { if (!((k0 > t0 + 31 - WINDOW) && (k0 + 63 <= t0))) { \
                    _Pragma("unroll") for (int r = 0; r < 16; ++r) { const int ka = k0 + crow(r, hi), kb = ka + 32; \
                        if (!(ka <= t && ka > t - WINDOW)) P0[r] = NINF; if (!(kb <= t && kb > t - WINDOW)) P1[r] = NINF; } } } } while (0)
        const int pbase = __builtin_amdgcn_readfirstlane((int)(uintptr_t)(lds + ATT_X_OFF + 128)); int pp = 0;
#define PLIST(i) (*(const LAS int*)(uintptr_t)(unsigned)(pbase + 4 * (i)))
        int ja, jb;
        __syncthreads();
        if (MODE == 2) { ja = PLIST(0); jb = PLIST(1); ja = __builtin_amdgcn_readfirstlane(ja); jb = __builtin_amdgcn_readfirstlane(jb); if (ja < 0) ja = jhi + 1; }
        else { ja = jlo; jb = ja + 1; if (jb > jhi) jb = -1; }
        if (ja <= jhi) kv_dma(dm, Kh + (size_t)ja * KVBLK * ldk, Vh + (size_t)ja * KVBLK * ldv, lds, 0, wid);
        if (jb >= 0) kv_dma(dm, Kh + (size_t)jb * KVBLK * ldk, Vh + (size_t)jb * KVBLK * ldv, lds, ATT_BUF, wid);
        int set = 0;
#pragma nounroll
        while (ja <= jhi) {
            int jc, jd;
            if (MODE == 2) { ++pp; jc = PLIST(2 * pp); jd = PLIST(2 * pp + 1); jc = __builtin_amdgcn_readfirstlane(jc); jd = __builtin_amdgcn_readfirstlane(jd); if (jc < 0) jc = jhi + 1; }
            else { jc = (jb >= 0 ? jb : ja) + 1; jd = jc + 1; if (jd > jhi) jd = -1; }
            VM_WAIT(); __syncthreads();
            if (jc <= jhi) kv_dma(dm, Kh + (size_t)jc * KVBLK * ldk, Vh + (size_t)jc * KVBLK * ldv, lds, ATT_SET - set, wid);
            if (jc <= jhi && jd >= 0) kv_dma(dm, Kh + (size_t)jd * KVBLK * ldk, Vh + (size_t)jd * KVBLK * ldv, lds, ATT_SET - set + ATT_BUF, wid);
            const bool nA = NSA_NEED(ja), nB = (jb >= 0) && NSA_NEED(jb);
            f32x16 a0, a1, b0, b1;
            if (nA) qkt(a0, a1, lds + set + ATT_K_OFF, qr, r32, hi);
            if (nB) qkt(b0, b1, lds + set + ATT_BUF + ATT_K_OFF, qr, r32, hi);
            bool rv_ = true;
            if (nA) { NSA_MASK(a0, a1, ja); attn_finish(a0, a1, o, m_reg, l_reg, wsc, vb0 + set, r32, hi, rv_); }
            if (nB) { NSA_MASK(b0, b1, jb); attn_finish(b0, b1, o, m_reg, l_reg, wsc, vb0 + set + ATT_BUF, r32, hi, rv_); }
            ja = jc; jb = (jc <= jhi) ? jd : -1; set = ATT_SET - set;
        }
#undef PLIST
#undef NSA_MASK
#undef NSA_NEED
        { float fac = l_reg > 0.f ? __builtin_amdgcn_rcpf(l_reg) : 0.f;
          if (MODE != 1) { const int br = MODE == 0 ? 0 : (MODE == 2 ? 1 : 2); fac *= sigmoidf_(bf2f(P1[(rowb + t) * NSA_INP + P1_GL + head * 3 + br])); }
          if (hi == 0) wsc[32 + r32] = fac; LDS_WAIT(); }
        if (MODE == 1) {
            float fc[16];
#pragma unroll
            for (int r = 0; r < 16; ++r) fc[r] = wsc[32 + crow(r, hi)];
            LDS_WAIT(); __syncthreads();
#pragma unroll
            for (int r = 0; r < 16; ++r) { const int orow = crow(r, hi);
#pragma unroll
                for (int d0 = 0; d0 < 4; ++d0) *(LAS float*)(lds + ((wid * 32 + orow) * 128 + d0 * 32 + r32) * 4) = o[d0][r] * fc[r]; }
            LDS_WAIT(); __syncthreads();
            { const int tok = tid >> 4, j8 = (tid & 15) * 8; f32x4 s0 = {0.f, 0.f, 0.f, 0.f}, s1 = {0.f, 0.f, 0.f, 0.f};
#pragma unroll
              for (int w = 0; w < 8; ++w) { const LAS f32x4* pp = (const LAS f32x4*)(lds + ((w * 32 + tok) * 128 + j8) * 4); s0 += pp[0]; s1 += pp[1]; }
              LAS f32x4* dst = (LAS f32x4*)(lds + (tok * 128 + j8) * 4); dst[0] = s0; dst[1] = s1; }
            LDS_WAIT(); __syncthreads();
#pragma nounroll
            for (int q = 0; q < 4; ++q) { const int tok = 4 * wid + q, tt = t0 + tok;
                const float a0 = *(const LAS float*)(lds + (tok * 128 + lane) * 4), a1 = *(const LAS float*)(lds + (tok * 128 + 64 + lane) * 4);
                const v4u w = topk_select(a0, a1, tt >> 6, lane);
                if (lane == 0) *(v4u*)(IMPO + ((rowb + tt) * NSA_G + g) * 4) = w; }
            LDS_WAIT(); __syncthreads();
        } else {
            bf16* gp0 = (MODE == 2) ? Ob + (rowb + t0 + 4 * wid) * DM + g * NSA_R * HD : Ob + (rowb + t0) * DM + (g * NSA_R + wid) * HD;
            int lane_e = lane; asm volatile("" : "+v"(lane_e));
            const unsigned lo = (MODE == 2) ? (unsigned)lane_e * 8u : (unsigned)(lane_e >> 4) * DM + (unsigned)(lane_e & 15) * 8u;
#define NSA_PIECE(i) (gp0 + ((MODE == 2) ? (size_t)((i) >> 1) * DM + ((i) & 1) * 512 : (size_t)(4 * (i)) * DM) + lo)
            v4u old[8];
            if (MODE != 0 && !probe_nostore) {
#pragma unroll
                for (int i = 0; i < 8; ++i) old[i] = *(const v4u*)NSA_PIECE(i); }
            LDS_WAIT(); __syncthreads();
            LAS float* stg = (LAS float*)(lds + wid * 16384);
#pragma unroll
            for (int r = 0; r < 16; ++r) { const int orow = crow(r, hi); const float fc = wsc[32 + orow];
#pragma unroll
                for (int d0 = 0; d0 < 4; ++d0) stg[orow * 128 + d0 * 32 + r32] = o[d0][r] * fc; }
            LDS_WAIT();
            if (!probe_nostore) {
#pragma unroll
                for (int i = 0; i < 8; ++i) { const int c = 64 * i + lane_e; f32x4 x0 = *(const LAS f32x4*)(stg + c * 8), x1 = *(const LAS f32x4*)(stg + c * 8 + 4);
                    if (MODE != 0) { x0[0] += bflo(old[i].x); x0[1] += bfhi(old[i].x); x0[2] += bflo(old[i].y); x0[3] += bfhi(old[i].y); x1[0] += bflo(old[i].z); x1[1] += bfhi(old[i].z); x1[2] += bflo(old[i].w); x1[3] += bfhi(old[i].w); }
                    const v4u w = {cvtpk(x0[0], x0[1]), cvtpk(x0[2], x0[3]), cvtpk(x1[0], x1[1]), cvtpk(x1[2], x1[3])};
                    *(v4u*)NSA_PIECE(i) = w; } }
#undef NSA_PIECE
            LDS_WAIT();
        }
    }
}
struct Sub16 { f32x4 o[8]; bf16x8 q[4]; float m, l; };
#define MFMA16(a, b, c) __builtin_amdgcn_mfma_f32_16x16x32_bf16((a), (b), (c), 0, 0, 0)
struct VF16 { s16x4 l0, h0, l1, h1; };
template <int C> __device__ __forceinline__ void pv16_rd(VF16& f, int vaddr) {
    constexpr int CO = (C >> 1) * 512 + (C & 1) * 32;
    f.l0 = tr_read<CO>(vaddr); f.h0 = tr_read<CO + 4096>(vaddr); f.l1 = tr_read<CO + 8192>(vaddr); f.h1 = tr_read<CO + 8192 + 4096>(vaddr);
}
__device__ __forceinline__ void pv16_mma(f32x4& oc, const VF16& f, bf16x8 pa0, bf16x8 pa1) {
    oc = MFMA16(((bf16x8){f.l0[0], f.l0[1], f.l0[2], f.l0[3], f.h0[0], f.h0[1], f.h0[2], f.h0[3]}), pa0, oc);
    oc = MFMA16(((bf16x8){f.l1[0], f.l1[1], f.l1[2], f.l1[3], f.h1[0], f.h1[1], f.h1[2], f.h1[3]}), pa1, oc);
}
__device__ __forceinline__ void slc16_tile(Sub16& S, const LAS char* Kt, int kaddr, int vaddr, bool rowvalid, bool diag, int lim  ) {
    f32x4 a[4];
#pragma unroll
    for (int mb = 0; mb < 4; ++mb) a[mb] = (f32x4){0.f, 0.f, 0.f, 0.f};
#pragma unroll
    for (int ks = 0; ks < 4; ++ks)
#pragma unroll
        for (int mb = 0; mb < 4; ++mb) {
            const bf16x8 kf = *(const LAS bf16x8*)(Kt + ((ks & 1) ? (kaddr ^ 64) : kaddr) + 16 * mb * 256 + 128 * (ks >> 1));
            a[mb] = MFMA16(kf, S.q[ks], a[mb]); }
    constexpr float NINF = -__builtin_inff();
    if (diag) {
#pragma unroll
        for (int mb = 0; mb < 4; ++mb)
#pragma unroll
            for (int i = 0; i < 4; ++i) if (16 * mb + i > lim) a[mb][i] = NINF; }
    float pmax = fmaxf(fmaxf(a[0][0], a[0][1]), fmaxf(a[0][2], a[0][3]));
#pragma unroll
    for (int mb = 1; mb < 4; ++mb) pmax = fmaxf(pmax, fmaxf(fmaxf(a[mb][0], a[mb][1]), fmaxf(a[mb][2], a[mb][3])));
    { auto r16 = __builtin_amdgcn_permlane16_swap(__float_as_uint(pmax), __float_as_uint(pmax), false, false); pmax = fmaxf(__uint_as_float(r16[0]), __uint_as_float(r16[1]));
      auto r32 = __builtin_amdgcn_permlane32_swap(__float_as_uint(pmax), __float_as_uint(pmax), false, false); pmax = fmaxf(__uint_as_float(r32[0]), __uint_as_float(r32[1])); }
    if (!rowvalid) pmax = NINF;
    float alpha = 1.f, mn = S.m;
    if (!__all(pmax - S.m <= ATT_THR / ATT_SCALE)) { mn = fmaxf(S.m, pmax); alpha = __builtin_amdgcn_exp2f((S.m - mn) * ATT_C); S.m = mn; }
    const float mnC = rowvalid ? -mn * ATT_C : NINF;
    float ps = 0.f;
#pragma unroll
    for (int mb = 0; mb < 4; ++mb)
#pragma unroll
        for (int i = 0; i < 4; ++i) { a[mb][i] = __builtin_amdgcn_exp2f(fmaf(a[mb][i], ATT_C, mnC)); ps += a[mb][i]; }
    S.l = S.l * alpha + ps;
    if (__any(alpha < 1.f)) {
#pragma unroll
        for (int c = 0; c < 8; ++c) S.o[c] *= alpha; }
    bf16x8 pa[2];
#pragma unroll
    for (int h = 0; h < 2; ++h) { const v4u w = {cvtpk(a[2 * h][0], a[2 * h][1]), cvtpk(a[2 * h][2], a[2 * h][3]), cvtpk(a[2 * h + 1][0], a[2 * h + 1][1]), cvtpk(a[2 * h + 1][2], a[2 * h + 1][3])};
        pa[h] = __builtin_bit_cast(bf16x8, w); }
    VF16 f0, f1, f2;
#define W8() do { asm volatile("s_waitcnt lgkmcnt(8)" ::: "memory"); SBAR(); } while (0)
    pv16_rd<0>(f0, vaddr); pv16_rd<1>(f1, vaddr); pv16_rd<2>(f2, vaddr);
    W8(); pv16_mma(S.o[0], f0, pa[0], pa[1]); SBAR(); pv16_rd<3>(f0, vaddr);
    W8(); pv16_mma(S.o[1], f1, pa[0], pa[1]); SBAR(); pv16_rd<4>(f1, vaddr);
    W8(); pv16_mma(S.o[2], f2, pa[0], pa[1]); SBAR(); pv16_rd<5>(f2, vaddr);
    W8(); pv16_mma(S.o[3], f0, pa[0], pa[1]); SBAR(); pv16_rd<6>(f0, vaddr);
    W8(); pv16_mma(S.o[4], f1, pa[0], pa[1]); SBAR(); pv16_rd<7>(f1, vaddr);
    W8(); pv16_mma(S.o[5], f2, pa[0], pa[1]); SBAR();
    asm volatile("s_waitcnt lgkmcnt(4)" ::: "memory"); SBAR(); pv16_mma(S.o[6], f0, pa[0], pa[1]); SBAR();
    asm volatile("s_waitcnt lgkmcnt(0)" ::: "memory"); SBAR(); pv16_mma(S.o[7], f1, pa[0], pa[1]);
#undef W8
}
__device__ __forceinline__ void nsa_slc16_phase(Frame& F, const bf16* P1, const bf16* Qsrc, const bf16* Ksrc, const unsigned* SEL, bf16* Ob) {
    const int wid = F.wave, lane = F.lane, fr = lane & 15, fq = lane >> 4;
    LAS char* lds = (LAS char*)F.lds;
    KVDma dm; kv_dma_init(dm, KVW, NSA_INP, wid, lane);
    constexpr int NTB = SEQ / 32, NU = BATCH * NSA_G * NTB;
    const int kaddr = fr * 256 + 16 * (fq ^ (fr & 7));
    const int vlane = (fq & 1) * 2048 + (((lane & 15) >> 2) + 4 * (fq >> 1)) * 64 + 8 * (lane & 3);
    const int vb0 = (int)(uintptr_t)(lds + ATT_V_OFF) + vlane;
    for (int rd = 0; ; ++rd) {
        int idx;
        { idx = (rd & 1) ? rd * F.G + (F.G - 1 - F.bid) : rd * F.G + F.bid; if (rd * F.G >= NU) break; if (idx >= NU) continue; }
        const int tb = NTB - 1 - idx / (BATCH * NSA_G), bg = idx % (BATCH * NSA_G), g = bg % NSA_G, b = bg / NSA_G;
        const size_t rowb = (size_t)b * SEQ; const int t0 = tb * 32;
        const bf16* Kh = Ksrc + rowb * KVW + g * HD; const bf16* Vh = P1 + rowb * NSA_INP + P1_VS + g * HD; const long ldk = KVW, ldv = NSA_INP;
        const int jhi = (t0 + 31) >> 6;
        unsigned wn[4], wa[4], wb[4];
        { const int tsel = t0 + 4 * wid + ((lane >> 3) & 3);
          const v4u sv = *(const v4u*)(SEL + ((rowb + tsel) * NSA_G + g) * 4); unsigned selw[4]; selw[0] = sv.x; selw[1] = sv.y; selw[2] = sv.z; selw[3] = sv.w;
          *(LAS v4u*)(lds + ATT_X_OFF + 2048 + (wid * 64 + lane) * 16) = sv;
          LAS unsigned* un = (LAS unsigned*)(lds + ATT_X_OFF);
#pragma unroll
          for (int q = 0; q < 4; ++q) { unsigned x = selw[q]; x |= __shfl_xor(x, 8);
              wa[q] = (unsigned)__builtin_amdgcn_readlane((int)x, 0); wb[q] = (unsigned)__builtin_amdgcn_readlane((int)x, 16); wn[q] = wa[q] | wb[q]; if (lane == 0) un[wid * 4 + q] = wn[q]; }
          LDS_WAIT(); __syncthreads();
          LAS int* plist = (LAS int*)(lds + ATT_X_OFF + 128);
          if (wid == 0) {
              unsigned m0 = 0u, m1 = 0u;
              int lane_l = lane; asm volatile("" : "+v"(lane_l));
              const LAS unsigned* ub = un + (lane_l >> 5);
#pragma unroll
              for (int w = 0; w < NWAVES; ++w) { m0 |= ((ub[w * 4] >> (lane & 31)) & 1u) << w; m1 |= ((ub[w * 4 + 2] >> (lane & 31)) & 1u) << w; }
              bool v0 = m0 != 0u && lane <= jhi, v1 = m1 != 0u && lane + 64 <= jhi; int np = 0;
              for (;;) {
                  const unsigned long long a0 = __ballot(v0), a1 = __ballot(v1);
                  if (!(a0 | a1)) break;
                  const int ja_ = a0 ? __builtin_ctzll(a0) : 64 + __builtin_ctzll(a1);
                  const unsigned ma = (ja_ < 64) ? (unsigned)__shfl((int)m0, ja_) : (unsigned)__shfl((int)m1, ja_ - 64);
                  if (lane == (ja_ & 63)) { if (ja_ < 64) v0 = false; else v1 = false; }
                  unsigned long long c0 = __ballot(v0 && !(m0 & ma)), c1 = __ballot(v1 && !(m1 & ma));
                  if (!(c0 | c1)) { c0 = __ballot(v0 && m0 == 0xffu); c1 = __ballot(v1 && m1 == 0xffu); }
                  if (!(c0 | c1)) { c0 = __ballot(v0); c1 = __ballot(v1); }
                  int jb_ = -1;
                  if (c0 | c1) { jb_ = c0 ? __builtin_ctzll(c0) : 64 + __builtin_ctzll(c1); if (lane == (jb_ & 63)) { if (jb_ < 64) v0 = false; else v1 = false; } }
                  if (lane == 0) { plist[2 * np] = ja_; plist[2 * np + 1] = jb_; }
                  ++np;
              }
              if (lane == 0) { int neg1 = -1; asm volatile("" : "+v"(neg1)); plist[2 * np] = neg1; plist[2 * np + 1] = neg1; }
          }
          LDS_WAIT(); }
        Sub16 SA, SB;
        const int tokA = t0 + 4 * wid + (fr >> 3), tokB = tokA + 2, head = g * NSA_R + (fr & 7);
        { const bf16* qa = Qsrc + (rowb + tokA) * DM + head * HD + 8 * fq; const bf16* qb = Qsrc + (rowb + tokB) * DM + head * HD + 8 * fq;
#pragma unroll
          for (int ks = 0; ks < 4; ++ks) { SA.q[ks] = *(const bf16x8*)(qa + 32 * ks); SB.q[ks] = *(const bf16x8*)(qb + 32 * ks); } }
#pragma unroll
        for (int c = 0; c < 8; ++c) { SA.o[c] = (f32x4){0.f, 0.f, 0.f, 0.f}; SB.o[c] = (f32x4){0.f, 0.f, 0.f, 0.f}; }
        SA.m = -1e30f; SA.l = 0.f; SB.m = -1e30f; SB.l = 0.f;
        const int selA = (int)(uintptr_t)(lds + ATT_X_OFF + 2048 + (wid * 64 + 8 * (fr >> 3)) * 16), selB = selA + 16 * 16;
        const int pbase = __builtin_amdgcn_readfirstlane((int)(uintptr_t)(lds + ATT_X_OFF + 128)); int pp = 0;
#define PLIST(i) (*(const LAS int*)(uintptr_t)(unsigned)(pbase + 4 * (i)))
#define SLC16_ONE(JJ, BUF) do { const int jj_ = (JJ); const int k0_ = jj_ * KVBLK; const bool dg_ = jj_ >= jhi; \
            if ((pick4(wa, jj_ >> 5) >> (jj_ & 31)) & 1u) { const bool rv_ = (*(const LAS unsigned*)(uintptr_t)(unsigned)(selA + (jj_ >> 5) * 4) >> (jj_ & 31)) & 1u; \
                slc16_tile(SA, lds + (BUF) + ATT_K_OFF, kaddr, vb0 + (BUF), rv_, dg_, tokA - k0_ - 4 * fq); } \
            if ((pick4(wb, jj_ >> 5) >> (jj_ & 31)) & 1u) { const bool rv_ = (*(const LAS unsigned*)(uintptr_t)(unsigned)(selB + (jj_ >> 5) * 4) >> (jj_ & 31)) & 1u; \
                slc16_tile(SB, lds + (BUF) + ATT_K_OFF, kaddr, vb0 + (BUF), rv_, dg_, tokB - k0_ - 4 * fq); } } while (0)
        int ja, jb;
        __syncthreads();
        ja = PLIST(0); jb = PLIST(1); ja = __builtin_amdgcn_readfirstlane(ja); jb = __builtin_amdgcn_readfirstlane(jb); if (ja < 0) ja = jhi + 1;
        if (ja <= jhi) kv_dma(dm, Kh + (size_t)ja * KVBLK * ldk, Vh + (size_t)ja * KVBLK * ldv, lds, 0, wid);
        if (jb >= 0) kv_dma(dm, Kh + (size_t)jb * KVBLK * ldk, Vh + (size_t)jb * KVBLK * ldv, lds, ATT_BUF, wid);
        int set = 0;
#pragma nounroll
        while (ja <= jhi) {
            int jc, jd;
            ++pp; jc = PLIST(2 * pp); jd = PLIST(2 * pp + 1); jc = __builtin_amdgcn_readfirstlane(jc); jd = __builtin_amdgcn_readfirstlane(jd); if (jc < 0) jc = jhi + 1;
            VM_WAIT(); __syncthreads();
            if (jc <= jhi) kv_dma(dm, Kh + (size_t)jc * KVBLK * ldk, Vh + (size_t)jc * KVBLK * ldv, lds, ATT_SET - set, wid);
            if (jc <= jhi && jd >= 0) kv_dma(dm, Kh + (size_t)jd * KVBLK * ldk, Vh + (size_t)jd * KVBLK * ldv, lds, ATT_SET - set + ATT_BUF, wid);
            if ((pick4(wn, ja >> 5) >> (ja & 31)) & 1u) SLC16_ONE(ja, set);
            if (jb >= 0 && ((pick4(wn, jb >> 5) >> (jb & 31)) & 1u)) SLC16_ONE(jb, set + ATT_BUF);
            ja = jc; jb = (jc <= jhi) ? jd : -1; set = ATT_SET - set;
        }
#undef PLIST
#undef SLC16_ONE
        float facA, facB;
        { float la = SA.l; la += __shfl_xor(la, 16); la += __shfl_xor(la, 32); float lb = SB.l; lb += __shfl_xor(lb, 16); lb += __shfl_xor(lb, 32);
          facA = (la > 0.f ? __builtin_amdgcn_rcpf(la) : 0.f) * sigmoidf_(bf2f(P1[(rowb + tokA) * NSA_INP + P1_GL + head * 3 + 1]));
          facB = (lb > 0.f ? __builtin_amdgcn_rcpf(lb) : 0.f) * sigmoidf_(bf2f(P1[(rowb + tokB) * NSA_INP + P1_GL + head * 3 + 1])); }
        bf16* gp0 = Ob + (rowb + t0 + 4 * wid) * DM + g * NSA_R * HD;
        int lane_e = lane; asm volatile("" : "+v"(lane_e));
        const unsigned lo = (unsigned)lane_e * 8u;
#define NSA_PIECE(i) (gp0 + (size_t)((i) >> 1) * DM + ((i) & 1) * 512 + lo)
        v4u old[8];
#pragma unroll
        for (int i = 0; i < 8; ++i) old[i] = *(const v4u*)NSA_PIECE(i);
        LDS_WAIT(); __syncthreads();
        LAS float* stg = (LAS float*)(lds + wid * 16384);
#pragma unroll
        for (int c = 0; c < 8; ++c) {
            *(LAS f32x4*)(stg + fr * 128 + 16 * c + 4 * fq) = SA.o[c] * facA;
            *(LAS f32x4*)(stg + (16 + fr) * 128 + 16 * c + 4 * fq) = SB.o[c] * facB; }
        LDS_WAIT();
#pragma unroll
        for (int i = 0; i < 8; ++i) { const int c = 64 * i + lane_e; f32x4 x0 = *(const LAS f32x4*)(stg + c * 8), x1 = *(const LAS f32x4*)(stg + c * 8 + 4);
            x0[0] += bflo(old[i].x); x0[1] += bfhi(old[i].x); x0[2] += bflo(old[i].y); x0[3] += bfhi(old[i].y); x1[0] += bflo(old[i].z); x1[1] += bfhi(old[i].z); x1[2] += bflo(old[i].w); x1[3] += bfhi(old[i].w);
            const v4u w = {cvtpk(x0[0], x0[1]), cvtpk(x0[2], x0[3]), cvtpk(x1[0], x1[1]), cvtpk(x1[2], x1[3])};
            *(v4u*)NSA_PIECE(i) = w; }
#undef NSA_PIECE
        LDS_WAIT();
    }
}
#undef MFMA16

#ifndef STAGE
#define STAGE 3
#endif
#define ZERO_OB_PHASE PH_BEGIN { v4u z = {0u, 0u, 0u, 0u}; v4u* p = (v4u*)Ob; const long n = (long)MTOK * DM / 8; \
            for (long i = (long)F.bid * NTHR + F.tid; i < n; i += (long)F.G * NTHR) p[i] = z; } PH_END
#define MIXER0_PHASES \
    PH_BEGIN { fold_finalize(F, FO_XQ, XW); fold_finalize(F, FO_UP, DFF2); } \
             REP(10) hgrn_phase_a(F, BIG, (const float*)(ws + WS_LB), (bf16*)(ws + WS_QT), (bf16*)(ws + WS_OINTRA), (bf16*)(ws + WS_DS), (float*)(ws + WS_DEC)); \
             REP(11) sb_phase(F, BIG, Ob); PH_END \
    PH_BEGIN REP(12) hgrn_phase_b(F, (const bf16*)(ws + WS_DS), (const float*)(ws + WS_DEC), (bf16*)(ws + WS_SPREV)); PH_END \
    PH_BEGIN REP(13) hgrn_phase_c(F, BIG, (const bf16*)(ws + WS_QT), (const bf16*)(ws + WS_OINTRA), (const bf16*)(ws + WS_SPREV), KIN(IN_HGRN_NW), Ob); PH_END
#if STAGE <= 2
#define MIXER1_PHASES ZERO_OB_PHASE
#else
#define MIXER1_PHASES \
    PH_BEGIN { fold_finalize(F, FO_XQ + XW, XW); } REP(14) { nsa_rope_phase(F, BIG, (const float*)(ws + WS_ROPE), (bf16*)(ws + WS_QROT), (bf16*)(ws + WS_KSROT), (bf16*)(ws + WS_KWROT), (bf16*)(ws + WS_OVL)); \
             nsa_compress_phase(F, BIG, KIN(IN_NSA_CMP_POS), (const bf16*)(ws + WS_W_C1), (const bf16*)(ws + WS_W_C2), (bf16*)(ws + WS_KCMP), (bf16*)(ws + WS_VCMP)); } PH_END \
    PH_BEGIN { REP(15) nsa_attn_phase<0>(F, BIG, BIG, (const bf16*)(ws + WS_KCMP), (const bf16*)(ws + WS_VCMP), nullptr, nullptr, nullptr, Ob); \
             F.fresh(); REP(15) nsa_attn_phase<1>(F, BIG, BIG, (const bf16*)(ws + WS_KCMP), (const bf16*)(ws + WS_OVL), nullptr, nullptr, (unsigned*)(ws + WS_SEL), nullptr); \
             F.fresh(); REP(17) nsa_attn_phase<3>(F, BIG, (const bf16*)(ws + WS_QROT), (const bf16*)(ws + WS_KWROT), nullptr, nullptr, nullptr, nullptr, Ob, r_ > 0); } PH_END \
    PH_BEGIN REP(18) nsa_slc16_phase(F, BIG, (const bf16*)(ws + WS_QROT), (const bf16*)(ws + WS_KSROT), (const unsigned*)(ws + WS_SEL), Ob); PH_END
#endif
#ifndef REPMASK
#define REPMASK 0u
#endif
#define REP(gid) for (int r_ = 0; r_ <= (int)((REPMASK >> (gid)) & 1u); ++r_)
#define PH_BEGIN if (pc >= lo && pc < hi) { F.fresh();
#if (REPMASK >> 23) & 1
#define PH_END   if (pc + 1 < hi) { const unsigned long long tb0_ = __builtin_amdgcn_s_memrealtime(); XcdBarrier bb_ = bar; asm volatile("" : "+s"(bb_.bar), "+s"(bb_.x)); xcd_barrier(bb_); \
        const unsigned w_ = (unsigned)(__builtin_amdgcn_s_memrealtime() - tb0_); tbar_acc += w_; if (threadIdx.x == 0) { atomicMax((unsigned*)(args.ws + 3 * MiB) + pc, 0x7fffffffu - w_); atomicMax((unsigned*)(args.ws + 3 * MiB) + 256 + pc, w_); } } } ++pc;
#else
#define PH_END   if (pc + 1 < hi) { XcdBarrier bb_ = bar; asm volatile("" : "+s"(bb_.bar), "+s"(bb_.x)); xcd_barrier(bb_); } } ++pc;
#endif
template <int l>
__device__ __forceinline__ void layer_body(Frame& F, const Args& args, const XcdBarrier& bar, int& pc, const int lo, const int hi, unsigned long long& tbar_acc) {
    unsigned char* ws = F.ws;
    bf16* HB = (bf16*)(ws + WS_HB); bf16* Y = (bf16*)(ws + WS_Y); float* H32 = (float*)karg()->out;
    bf16* BIG = (bf16*)(ws + WS_BIG); bf16* Gm = (bf16*)(ws + WS_G); bf16* Ob = (bf16*)(ws + WS_O);
    bf16* XQ = (bf16*)(ws + WS_XQ); bf16* XO = (bf16*)(ws + WS_XO);
#define RS(k) ((long long*)(ws + WS_RSUM) + (size_t)(k) * MTOK * 2)
#define LNG(k) (KIN(IN_LN_G) + (size_t)(k) * DM)
#define LNB(k) (KIN(IN_LN_B) + (size_t)(k) * DM)
    const float* cs = (const float*)(ws + WS_FOLDF); const float* b2 = cs + FO_N;
        PH_BEGIN REP(1) {
            const int N = l == 0 ? AB_IN : NSA_INP;
            pg8::StaticOrder S; S.init(MTOK, N, F.G, F.bid);
            if (l == 0) { pg8::Gemm g{HB, (const bf16*)(ws + WS_W_ABIN), MTOK, N, DM}; pg8::EpiBf16<0> E{BIG, N, nullptr, 0, 0, 1.f};
                pg8::gemm_phase<pg8::EpiBf16<0>, pg8::StaticOrder, PG8_ALIGN, PG8_SP2>(F.lds + RING_OFF, g, S, E); }
            else { pg8::Gemm g{Y, (const bf16*)(ws + WS_W_NSAIN), MTOK, N, DM}; pg8::EpiBf16Ln E{BIG, N, RS(2), cs + FO_NSA, b2 + FO_NSA};
                pg8::gemm_phase<pg8::EpiBf16Ln, pg8::StaticOrder, PG8_ALIGN, PG8_SP2>(F.lds + RING_OFF, g, S, E);
                if (r_ == 0) convert_job<CJ_L1A>(F, args, 64, 192); }
        } PH_END
#if STAGE <= 1
        ZERO_OB_PHASE
#else
        if (l == 0) {
            MIXER0_PHASES
        } else {
            MIXER1_PHASES
        }
#endif
        PH_BEGIN REP(2) {
            pg8::Gemm g{Ob, l == 0 ? (const bf16*)(ws + WS_W_ABOUT) : (const bf16*)(ws + WS_W_NSAOUT), MTOK, DM, DM};
            pg8::StaticOrder S; S.init(MTOK, DM, F.G, F.bid);
            if (l == 0) { pg8::EpiRes0 E{Y, HB, DM, DN_ALPHA, RS(0)};
                pg8::gemm_phase<pg8::EpiRes0, pg8::StaticOrder, PG8_ALIGN, PG8_SP2>(F.lds + RING_OFF, g, S, E); }
            else { pg8::EpiResLn2 E{Y, RS(2), LNG(2), LNB(2), DM, DN_ALPHA, RS(3)};
                pg8::gemm_phase<pg8::EpiResLn2, pg8::StaticOrder, PG8_ALIGN, PG8_SP2>(F.lds + RING_OFF, g, S, E); }
        } PH_END
        PH_BEGIN REP(3) {
            {   pg8::Gemm g{Y, (const bf16*)(ws + WS_W_XQ) + (size_t)l * XW * DM, MTOK, XW, DM};
                pg8::RangeOrder S; S.init(MTOK, XW, 0, 128, F.bid);
                pg8::EpiBf16Ln E{XQ, XW, RS(3 * l), cs + FO_XQ + l * XW, b2 + FO_XQ + l * XW};
                pg8::gemm_phase<pg8::EpiBf16Ln, pg8::RangeOrder, PG8_ALIGN, PG8_SP2>(F.lds + RING_OFF, g, S, E); }
            {   pg8::Gemm g{(const bf16*)(ws + WS_MEMB), (const bf16*)(ws + WS_W_XKV) + (size_t)l * 2 * XW * DM, BATCH * NMEM, 2 * XW, DM};
                pg8::RangeOrder S; S.init(BATCH * NMEM, 2 * XW, 128, 8, F.bid);
                pg8::EpiBf16<0> E{(bf16*)(ws + WS_XKV) + (size_t)l * BATCH * NMEM * 2 * XW, 2 * XW, nullptr, 0, 0, 1.f};
                pg8::gemm_phase<pg8::EpiBf16<0>, pg8::RangeOrder, PG8_ALIGN, PG8_SP2>(F.lds + RING_OFF, g, S, E); }
            if (r_ == 0) { if (l == 0) convert_job<CJ_DOWN0>(F, args, 136, 120); else convert_job<CJ_L1B>(F, args, 136, 120); }
        } PH_END
        PH_BEGIN { if (l == 1) fold_finalize(F, FO_UP + DFF2, DFF2); } REP(9) xattn_phase(F, XQ, (const bf16*)(ws + WS_XKV) + (size_t)l * BATCH * NMEM * 2 * XW, XO); PH_END
        PH_BEGIN REP(4) {
            pg8::Gemm g{XO, (const bf16*)(ws + WS_W_XO) + (size_t)l * DM * XW, MTOK, DM, XW};
            pg8::StaticOrder S; S.init(MTOK, DM, F.G, F.bid);
            pg8::EpiResLn2 E{Y, RS(3 * l), LNG(3 * l), LNB(3 * l), DM, DN_ALPHA, RS(3 * l + 1)};
            pg8::gemm_phase<pg8::EpiResLn2, pg8::StaticOrder, PG8_ALIGN, PG8_SP2>(F.lds + RING_OFF, g, S, E);
        } PH_END
        PH_BEGIN REP(5) {
#if (REPMASK >> 22) & 1
            if (r_ > 0) { XcdBarrier bb_ = bar; asm volatile("" : "+s"(bb_.bar), "+s"(bb_.x)); xcd_barrier(bb_); }
#endif
            pg8::Gemm g{Y, (const bf16*)(ws + WS_W_UP) + (size_t)l * DFF2 * DM, MTOK, DFF2, DM};
            pg8::StaticOrder S; S.init(MTOK, DFF2, F.G, F.bid);
            pg8::EpiConvGlu E{Gm, (bf16*)(ws + WS_SIDE), RS(3 * l + 1), cs + FO_UP + l * DFF2, b2 + FO_UP + l * DFF2, KIN(IN_FFN_CONV) + (size_t)l * 3 * DFF, DFF};
            pg8::gemm_phase<pg8::EpiConvGlu, pg8::StaticOrder, PG8_ALIGN, PG8_SP2>(F.lds + RING_OFF, g, S, E);
            if (r_ == 0) { if (l == 0) convert_job<CJ_NSA>(F, args, 128, 128); else convert_job<CJ_DOWN1>(F, args, 128, 128); }
        } PH_END
#if (REPMASK >> 20) & 1
        PH_BEGIN {
            pg8::Gemm g{HB, (const bf16*)(ws + WS_W_UP) + (size_t)l * DFF2 * DM, MTOK, DFF2, DM};
            pg8::ZeroOrder S; S.init(MTOK, DFF2, F.G, F.bid);
            pg8::EpiBf16<0> E{Gm, DFF2, nullptr, 0, 0, 1.f};
            pg8::gemm_phase<pg8::EpiBf16<0>, pg8::ZeroOrder, PG8_ALIGN, PG8_SP2>(F.lds + RING_OFF, g, S, E);
        } PH_END
#endif
        PH_BEGIN { if (l == 0) fold_finalize(F, FO_NSA, NSA_INP); } REP(8) convglu_fixup_phase(F, (const bf16*)(ws + WS_SIDE), KIN(IN_FFN_CONV) + (size_t)l * 3 * DFF, Gm); PH_END
        PH_BEGIN REP(6) {
            pg8::Gemm g{Gm, (const bf16*)(ws + WS_W_DOWN) + (size_t)l * DM * DFF, MTOK, DM, DFF};
            pg8::StaticOrder S; S.init(MTOK, DM, F.G, F.bid);
            pg8::EpiResLn2 E{Y, RS(3 * l + 1), LNG(3 * l + 1), LNB(3 * l + 1), DM, DN_ALPHA, RS(3 * l + 2)};
            pg8::gemm_phase<pg8::EpiResLn2, pg8::StaticOrder, PG8_ALIGN, PG8_SP2>(F.lds + RING_OFF, g, S, E);
        } PH_END
        if (l == 1) { PH_BEGIN REP(7) ln_phase(F, Y, LNG(5), LNB(5), H32); PH_END }
#undef RS
#undef LNG
#undef LNB
}
__global__ void __launch_bounds__(NTHR, 2) mega_fwd(Args args) {
    extern __shared__ __attribute__((aligned(16))) unsigned char lds_raw[];
    Frame F;
    F.lds = (LAS unsigned char*)lds_raw; F.ws = args.ws;
    F.tid = threadIdx.x; F.lane = F.tid & 63; F.wave = __builtin_amdgcn_readfirstlane(F.tid >> 6); F.G = gridDim.x;
    unsigned char* ws = args.ws;
    gu32* ctl = (gu32*)(ws + WS_CTL);
    for (int u = F.tid; u < (LDS_BYTES - LDSCTL_OFF) / 4; u += NTHR) ((LAS unsigned*)(F.lds + LDSCTL_OFF))[u] = 0u;
    __syncthreads();
    volatile LAS unsigned* MISC = (volatile LAS unsigned*)(F.lds + MISC_OFF);
    XcdBarrier bar = xcd_barrier_post((unsigned*)(ctl + CW_BAR), MISC + 8);
    const int lo = args.ph_lo, hi = args.ph_hi; int pc = 0; unsigned long long tbar_acc = 0ull;
    bf16* HB = (bf16*)(ws + WS_HB); bf16* Y = (bf16*)(ws + WS_Y); float* H32 = (float*)karg()->out;
    bf16* BIG = (bf16*)(ws + WS_BIG); bf16* Gm = (bf16*)(ws + WS_G); bf16* Ob = (bf16*)(ws + WS_O);
    bf16* XQ = (bf16*)(ws + WS_XQ); bf16* XO = (bf16*)(ws + WS_XO);

    PH_BEGIN REP(0) p0_prologue(F, args); PH_END

#if (REPMASK >> 21) & 1
    for (int e_ = 0; e_ < 40; ++e_) { PH_BEGIN PH_END }
#endif
    layer_body<0>(F, args, bar, pc, lo, hi, tbar_acc);
    layer_body<1>(F, args, bar, pc, lo, hi, tbar_acc);
#if (REPMASK >> 23) & 1
#ifndef PROBE_BID
#define PROBE_BID 0
#endif
#if (REPMASK >> 24) & 1
    if (blockIdx.x == 0) { unsigned long long tot_ = 0ull; for (int k_ = 0; k_ < pc; ++k_) { const unsigned v_ = __hip_atomic_load((unsigned*)(args.ws + 3 * MiB) + k_, __ATOMIC_RELAXED, __HIP_MEMORY_SCOPE_AGENT); const unsigned x_ = __hip_atomic_load((unsigned*)(args.ws + 3 * MiB) + 256 + k_, __ATOMIC_RELAXED, __HIP_MEMORY_SCOPE_AGENT);
#ifdef PROBE_SPREAD_MASK
            if (v_ && ((PROBE_SPREAD_MASK >> k_) & 1ull)) tot_ += x_ - (0x7fffffffu - v_);
#else
            if (v_) tot_ += 0x7fffffffu - v_;
#endif
        }
        const unsigned long long t0_ = __builtin_amdgcn_s_memrealtime(); while (__builtin_amdgcn_s_memrealtime() - t0_ < tot_) __builtin_amdgcn_s_sleep(8); }
#else
    if (blockIdx.x == PROBE_BID) { const unsigned long long t0_ = __builtin_amdgcn_s_memrealtime(); while (__builtin_amdgcn_s_memrealtime() - t0_ < tbar_acc) __builtin_amdgcn_s_sleep(8); }
#endif
#endif
}

extern "C" void kernel_launch(void* const* d_in, const int* in_sizes, int n_in, void* d_out, int out_size, void* d_ws, size_t ws_size, hipStream_t stream) {
    static int grid = 0;
    if (grid == 0) {
        if (n_in != 19 || in_sizes[0] != MTOK * DM || out_size != MTOK * DM || ws_size < WS_END) {
            fprintf(stderr, "kernel_launch: shape mismatch n_in %d in0 %d out %d ws %zu (need %zu)\n", n_in, n_in > 0 ? in_sizes[0] : -1, out_size, ws_size, (size_t)WS_END); grid = -1; return; }
        int dev = 0, cus = 0, per_cu = 0;
        if (hipGetDevice(&dev) != hipSuccess || hipDeviceGetAttribute(&cus, hipDeviceAttributeMultiprocessorCount, dev) != hipSuccess) { grid = -1; return; }
        if (hipFuncSetAttribute((const void*)mega_fwd, hipFuncAttributeMaxDynamicSharedMemorySize, LDS_BYTES) != hipSuccess) { fprintf(stderr, "kernel_launch: hipFuncSetAttribute failed\n"); grid = -1; return; }
        if (hipOccupancyMaxActiveBlocksPerMultiprocessor(&per_cu, (const void*)mega_fwd, NTHR, LDS_BYTES) != hipSuccess || per_cu < 1)
            fprintf(stderr, "kernel_launch: note: occupancy query reports %d workgroups per CU\n", per_cu);
        (void)hipGetLastError();
        grid = cus;
        if (grid != 256) { fprintf(stderr, "kernel_launch: built for a 256-CU device (workgroup ranges of the cross-attention and conversion phases); this device reports %d; nothing launched\n", cus); grid = -1; return; }
    }
    if (grid < 0) return;
    if (hipMemsetAsync((char*)d_ws + WS_CTL, 0, CTL_ZERO_BYTES, stream) != hipSuccess) { fprintf(stderr, "kernel_launch: memset failed\n"); return; }
    Args a{};
    for (int i = 0; i < 19; ++i) a.in[i] = (const float*)d_in[i];
    a.out = (float*)d_out; a.ws = (unsigned char*)d_ws; a.ph_lo = 0; a.ph_hi = 1 << 20;
    hipLaunchKernelGGL(mega_fwd, dim3(grid), dim3(NTHR), LDS_BYTES, stream, a);
    const hipError_t le = hipPeekAtLastError();
    if (le != hipSuccess) fprintf(stderr, "kernel_launch: launch failed: %s\n", hipGetErrorName(le));
}
```

```cpp
#include <hip/hip_runtime.h>
#include <cstdio>
#include <cstdint>
namespace pg8 {
#define PG8_LAS __attribute__((address_space(3)))
typedef unsigned short bf16_t;
typedef short bf16x8 __attribute__((ext_vector_type(8)));
typedef float f32x4 __attribute__((ext_vector_type(4)));
typedef unsigned u32x4 __attribute__((ext_vector_type(4)));
constexpr int BM = 256, BK = 64, HALF = 128, HTB = HALF * BK * 2  , STAGE_BYTES = 8 * HTB, NXCD = 8, WGM = 8;

__host__ __device__ __forceinline__ int lds_byte(int r, int c) { const int st = (r >> 4) * 2 + (c >> 5), rr = r & 15, cc = c & 31, ob = rr * 64 + cc * 2; return st * 1024 + (ob ^ (((ob >> 9) & 1) << 5)); }
__host__ __device__ __forceinline__ void stage_rc(int b, int& R, int& C) { const int st = b / 1024, sb = b % 1024, swz = sb ^ (((sb >> 9) & 1) << 5); R = (st >> 1) * 16 + swz / 64; C = (st & 1) * 32 + (swz % 64) / 2; }
__host__ __device__ __forceinline__ int perm32(int rho) { const int n = rho >> 4, i = rho & 15; return 8 * (i >> 2) + 4 * n + (i & 3); }

struct Unit { int pm, pn; };
struct Gemm { const bf16_t* A; const bf16_t* Bt; int M, N, K; };

struct StaticOrder {
    int nM, nN, nwg, G, c;
    __host__ __device__ void init(int M, int N, int G_, int c_) { nM = M / BM; nN = N / BM; nwg = nM * nN; G = G_; c = c_; }
    __host__ __device__ bool next(int i, Unit& u) const {
        const long L = (long)i * G + c; if (L >= nwg) return false;
        int wgid = (int)L; { const int q = nwg / NXCD, r = nwg % NXCD, xcd = wgid % NXCD, off = wgid / NXCD; wgid = (xcd < r ? xcd * (q + 1) : r * (q + 1) + (xcd - r) * q) + off; }
        const int nig = WGM * nN, gid = wgid / nig, fm = gid * WGM, gsz = (nM - fm) < WGM ? (nM - fm) : WGM;
        u.pm = fm + ((wgid % nig) % gsz); u.pn = (wgid % nig) / gsz; return true;
    }
    __device__ __forceinline__ void a_ready(const Unit&) const {}
    __device__ __forceinline__ void done(const Unit&) const {}
};

__device__ __forceinline__ unsigned cvt_pk_bf16(float lo, float hi) { unsigned r; asm volatile("v_cvt_pk_bf16_f32 %0, %1, %2" : "=v"(r) : "v"(lo), "v"(hi)); return r; }
typedef float f32x2 __attribute__((ext_vector_type(2)));
__device__ __forceinline__ f32x2 gelu_pk(f32x2 v) {
    const f32x2 av = __builtin_elementwise_abs(v), d = av * 0.2316418882f + 1.0f;
    f32x2 t; t.x = __builtin_amdgcn_rcpf(d.x); t.y = __builtin_amdgcn_rcpf(d.y);
    f32x2 q = t * 0.5307027145f + (-0.7265760135f); q = q * t + 0.7107068705f; q = q * t + (-0.142248368f); q = q * t + 0.127414796f; q = q * t;
    const f32x2 s = (v * v) * (-0.72134752044f);
    f32x2 e; e.x = __builtin_amdgcn_exp2f(s.x); e.y = __builtin_amdgcn_exp2f(s.y);
    const f32x2 m = av * (q * e);
    return __builtin_elementwise_max(v, (f32x2){0.f, 0.f}) - m;
}

template <int ACT  > struct EpiBf16 {
    static constexpr bool PERM = true, AFTER_DRAIN = false; static_assert(ACT == 0 || ACT == 1, "EpiBf16: ACT is 0 (none) or 1 (gelu_pk)");
    bf16_t* O; int ldc; const float* bias; int split_cols; size_t split_stride; float scale0;
    __device__ __forceinline__ void operator()(const f32x4 (&acc)[2][2][4][2], const Unit& u, int wr, int wc, int fr, int fq) const {
        const int row0 = u.pm * BM + wr * 64 + fr; int colt = u.pn * BM; bf16_t* base = O;
        float sc = 1.f; if (split_cols) { const int t = colt / split_cols; base += (size_t)t * split_stride; colt -= t * split_cols; if (t == 0) sc = scale0; }
        const int col0 = colt + wc * 32 + 8 * fq, bcol0 = u.pn * BM + wc * 32 + 8 * fq;
        f32x4 bv[2][2];
#pragma unroll
        for (int bj = 0; bj < 2; ++bj)
#pragma unroll
            for (int n = 0; n < 2; ++n) bv[bj][n] = bias ? *(const f32x4*)(bias + bcol0 + bj * HALF + 4 * n) : (f32x4){0.f, 0.f, 0.f, 0.f};
#pragma unroll
        for (int ai = 0; ai < 2; ++ai)
#pragma unroll
            for (int m = 0; m < 4; ++m) { bf16_t* rowp = base + (size_t)(row0 + ai * HALF + m * 16) * ldc + col0;
#pragma unroll
                for (int bj = 0; bj < 2; ++bj) { f32x4 v0 = acc[ai][bj][m][0] + bv[bj][0], v1 = acc[ai][bj][m][1] + bv[bj][1];
                    if (ACT == 1) { f32x2 a = gelu_pk((f32x2){v0[0], v0[1]}), b = gelu_pk((f32x2){v0[2], v0[3]}), c = gelu_pk((f32x2){v1[0], v1[1]}), d = gelu_pk((f32x2){v1[2], v1[3]});
                        v0 = (f32x4){a.x, a.y, b.x, b.y}; v1 = (f32x4){c.x, c.y, d.x, d.y}; }
                    v0 = v0 * sc; v1 = v1 * sc; u32x4 w; w.x = cvt_pk_bf16(v0[0], v0[1]); w.y = cvt_pk_bf16(v0[2], v0[3]); w.z = cvt_pk_bf16(v1[0], v1[1]); w.w = cvt_pk_bf16(v1[2], v1[3]);
                    *(u32x4*)(rowp + bj * HALF) = w; } }
    }
};


struct EpiRes {
    static constexpr bool PERM = false, AFTER_DRAIN = false;
    float* Y; const float* res; int ldc; float alpha;
    __device__ __forceinline__ void operator()(const f32x4 (&acc)[2][2][4][2], const Unit& u, int wr, int wc, int fr, int fq) const {
        const int row0 = u.pm * BM + wr * 64 + fr, col0 = u.pn * BM + wc * 32 + 4 * fq;
#pragma unroll
        for (int ai = 0; ai < 2; ++ai)
#pragma unroll
            for (int m = 0; m < 4; ++m) { const size_t off = (size_t)(row0 + ai * HALF + m * 16) * ldc + col0;
#pragma unroll
                for (int bj = 0; bj < 2; ++bj)
#pragma unroll
                    for (int n = 0; n < 2; ++n) { const f32x4 r = *(const f32x4*)(res + off + bj * HALF + n * 16);
                        *(f32x4*)(Y + off + bj * HALF + n * 16) = r * alpha + acc[ai][bj][m][n]; } }
    }
};
struct RangeOrder {
    int nM, nN, ntot, c0, nw, c;
    __host__ __device__ void init(int M, int N, int c0_, int nw_, int c_) { nM = M / BM; nN = N / BM; ntot = nM * nN; c0 = c0_; nw = nw_; c = c_; }
    __host__ __device__ bool next(int i, Unit& u) const {
        if (c < c0 || c >= c0 + nw) return false;
        const int L = i * nw + (c - c0); if (L >= ntot) return false;
        u.pm = L / nN; u.pn = L % nN; return true;
    }
    __device__ __forceinline__ void a_ready(const Unit&) const {}
    __device__ __forceinline__ void done(const Unit&) const {}
};

struct ZeroOrder : StaticOrder {
    __host__ __device__ bool next(int i, Unit& u) const { const bool r = StaticOrder::next(i, u); u.pm = 0; u.pn = 0; return r; }
};

struct EpiResBf {
    static constexpr bool PERM = true, AFTER_DRAIN = false;
    bf16_t* Y; const bf16_t* res; int ldc; float alpha;
    __device__ __forceinline__ void operator()(const f32x4 (&acc)[2][2][4][2], const Unit& u, int wr, int wc, int fr, int fq) const {
        const int row0 = u.pm * BM + wr * 64 + fr, col0 = u.pn * BM + wc * 32 + 8 * fq;
#pragma unroll
        for (int ai = 0; ai < 2; ++ai)
#pragma unroll
            for (int m = 0; m < 4; ++m) { const size_t off = (size_t)(row0 + ai * HALF + m * 16) * ldc + col0;
#pragma unroll
                for (int bj = 0; bj < 2; ++bj) { const u32x4 r = *(const u32x4*)(res + off + bj * HALF);
                    const f32x4 v0 = acc[ai][bj][m][0], v1 = acc[ai][bj][m][1];
                    u32x4 w;
                    w.x = cvt_pk_bf16(__builtin_bit_cast(float, r.x << 16) * alpha + v0[0], __builtin_bit_cast(float, r.x & 0xffff0000u) * alpha + v0[1]);
                    w.y = cvt_pk_bf16(__builtin_bit_cast(float, r.y << 16) * alpha + v0[2], __builtin_bit_cast(float, r.y & 0xffff0000u) * alpha + v0[3]);
                    w.z = cvt_pk_bf16(__builtin_bit_cast(float, r.z << 16) * alpha + v1[0], __builtin_bit_cast(float, r.z & 0xffff0000u) * alpha + v1[1]);
                    w.w = cvt_pk_bf16(__builtin_bit_cast(float, r.w << 16) * alpha + v1[2], __builtin_bit_cast(float, r.w & 0xffff0000u) * alpha + v1[3]);
                    *(u32x4*)(Y + off + bj * HALF) = w; } }
    }
};

struct EpiResF {
    static constexpr bool PERM = true, AFTER_DRAIN = false;
    float* Y; const bf16_t* res; int ldc; float alpha;
    __device__ __forceinline__ void operator()(const f32x4 (&acc)[2][2][4][2], const Unit& u, int wr, int wc, int fr, int fq) const {
        const int row0 = u.pm * BM + wr * 64 + fr, col0 = u.pn * BM + wc * 32 + 8 * fq;
#pragma unroll
        for (int ai = 0; ai < 2; ++ai)
#pragma unroll
            for (int m = 0; m < 4; ++m) { const size_t off = (size_t)(row0 + ai * HALF + m * 16) * ldc + col0;
#pragma unroll
                for (int bj = 0; bj < 2; ++bj) { const u32x4 r = *(const u32x4*)(res + off + bj * HALF);
                    f32x4 o0, o1;
                    o0[0] = __builtin_bit_cast(float, r.x << 16); o0[1] = __builtin_bit_cast(float, r.x & 0xffff0000u); o0[2] = __builtin_bit_cast(float, r.y << 16); o0[3] = __builtin_bit_cast(float, r.y & 0xffff0000u);
                    o1[0] = __builtin_bit_cast(float, r.z << 16); o1[1] = __builtin_bit_cast(float, r.z & 0xffff0000u); o1[2] = __builtin_bit_cast(float, r.w << 16); o1[3] = __builtin_bit_cast(float, r.w & 0xffff0000u);
                    *(f32x4*)(Y + off + bj * HALF) = o0 * alpha + acc[ai][bj][m][0]; *(f32x4*)(Y + off + bj * HALF + 4) = o1 * alpha + acc[ai][bj][m][1]; } }
    }
};

struct EpiResLn {
    static constexpr bool PERM = true, AFTER_DRAIN = false;
    bf16_t* Y; const float* stats; const float* g; const float* b; int ldc; float alpha;
    __device__ __forceinline__ void operator()(const f32x4 (&acc)[2][2][4][2], const Unit& u, int wr, int wc, int fr, int fq) const {
        const int row0 = u.pm * BM + wr * 64 + fr, col0 = u.pn * BM + wc * 32 + 8 * fq;
        f32x4 gv[2][2], bv[2][2];
#pragma unroll
        for (int bj = 0; bj < 2; ++bj)
#pragma unroll
            for (int n = 0; n < 2; ++n) { gv[bj][n] = *(const f32x4*)(g + col0 + bj * HALF + 4 * n) * alpha; bv[bj][n] = *(const f32x4*)(b + col0 + bj * HALF + 4 * n) * alpha; }
#pragma unroll
        for (int ai = 0; ai < 2; ++ai)
#pragma unroll
            for (int m = 0; m < 4; ++m) { const int row = row0 + ai * HALF + m * 16; const size_t off = (size_t)row * ldc + col0;
                const float mean = stats[2 * row], rstd = stats[2 * row + 1];
#pragma unroll
                for (int bj = 0; bj < 2; ++bj) { const u32x4 r = *(const u32x4*)(Y + off + bj * HALF);
                    f32x4 y0, y1;
                    y0[0] = __builtin_bit_cast(float, r.x << 16); y0[1] = __builtin_bit_cast(float, r.x & 0xffff0000u); y0[2] = __builtin_bit_cast(float, r.y << 16); y0[3] = __builtin_bit_cast(float, r.y & 0xffff0000u);
                    y1[0] = __builtin_bit_cast(float, r.z << 16); y1[1] = __builtin_bit_cast(float, r.z & 0xffff0000u); y1[2] = __builtin_bit_cast(float, r.w << 16); y1[3] = __builtin_bit_cast(float, r.w & 0xffff0000u);
                    const f32x4 o0 = (y0 - mean) * rstd * gv[bj][0] + bv[bj][0] + acc[ai][bj][m][0], o1 = (y1 - mean) * rstd * gv[bj][1] + bv[bj][1] + acc[ai][bj][m][1];
                    u32x4 w; w.x = cvt_pk_bf16(o0[0], o0[1]); w.y = cvt_pk_bf16(o0[2], o0[3]); w.z = cvt_pk_bf16(o1[0], o1[1]); w.w = cvt_pk_bf16(o1[2], o1[3]);
                    *(u32x4*)(Y + off + bj * HALF) = w; } }
    }
};

constexpr float RS_SCALE = 1048576.0f, RS_INV = 1.0f / 1048576.0f;
__device__ __forceinline__ float fx20_to_f(long long v) { return (float)(int)(v >> 20) + (float)((unsigned)v & 0xFFFFFu) * RS_INV; }
__device__ __forceinline__ long long f_to_fx20(float s) { const float fl = floorf(s); return ((long long)(int)fl << 20) + (long long)(unsigned)((s - fl) * RS_SCALE + 0.5f); }
__device__ __forceinline__ void row_stats(const long long* rs, int row, float& mean, float& rstd) {
    const long long a = rs[2 * (size_t)row], b = rs[2 * (size_t)row + 1];
    mean = fx20_to_f(a) * (1.0f / 4096.0f); const float var = fx20_to_f(b) * (1.0f / 4096.0f) - mean * mean; rstd = __builtin_amdgcn_rsqf(var + 1e-5f);
}
constexpr float FOLD_SCALE = 4294967296.0f, FOLD_INV = 1.0f / 4294967296.0f;
struct EpiBf16Ln {
    static constexpr bool PERM = true, AFTER_DRAIN = false;
    bf16_t* O; int ldc; const long long* rs; const float* cs; const float* b2;
    __device__ __forceinline__ void operator()(const f32x4 (&acc)[2][2][4][2], const Unit& u, int wr, int wc, int fr, int fq) const {
        const int row0 = u.pm * BM + wr * 64 + fr, col0 = u.pn * BM + wc * 32 + 8 * fq;
        f32x4 cv[2][2], bv[2][2];
#pragma unroll
        for (int bj = 0; bj < 2; ++bj)
#pragma unroll
            for (int n = 0; n < 2; ++n) { cv[bj][n] = *(const f32x4*)(cs + col0 + bj * HALF + 4 * n); bv[bj][n] = *(const f32x4*)(b2 + col0 + bj * HALF + 4 * n); }
#pragma unroll
        for (int ai = 0; ai < 2; ++ai)
#pragma unroll
            for (int m = 0; m < 4; ++m) { const int row = row0 + ai * HALF + m * 16; float mean, rstd; row_stats(rs, row, mean, rstd);
                bf16_t* rowp = O + (size_t)row * ldc + col0;
#pragma unroll
                for (int bj = 0; bj < 2; ++bj) { const f32x4 v0 = (acc[ai][bj][m][0] - cv[bj][0] * mean) * rstd + bv[bj][0], v1 = (acc[ai][bj][m][1] - cv[bj][1] * mean) * rstd + bv[bj][1];
                    u32x4 w; w.x = cvt_pk_bf16(v0[0], v0[1]); w.y = cvt_pk_bf16(v0[2], v0[3]); w.z = cvt_pk_bf16(v1[0], v1[1]); w.w = cvt_pk_bf16(v1[2], v1[3]);
                    *(u32x4*)(rowp + bj * HALF) = w; } }
    }
};
__device__ __forceinline__ void row_sums_add(long long* rso, int row, const f32x4& a, const f32x4& b, const f32x4& c, const f32x4& d, int fq) {
    float s1 = ((a[0] + a[1]) + (a[2] + a[3])) + ((b[0] + b[1]) + (b[2] + b[3])) + ((c[0] + c[1]) + (c[2] + c[3])) + ((d[0] + d[1]) + (d[2] + d[3]));
    float s2 = ((a[0] * a[0] + a[1] * a[1]) + (a[2] * a[2] + a[3] * a[3])) + ((b[0] * b[0] + b[1] * b[1]) + (b[2] * b[2] + b[3] * b[3]))
             + ((c[0] * c[0] + c[1] * c[1]) + (c[2] * c[2] + c[3] * c[3])) + ((d[0] * d[0] + d[1] * d[1]) + (d[2] * d[2] + d[3] * d[3]));
    s1 += __shfl_xor(s1, 16); s1 += __shfl_xor(s1, 32); s2 += __shfl_xor(s2, 16); s2 += __shfl_xor(s2, 32);
    if (fq == 0) { atomicAdd((unsigned long long*)(rso + 2 * (size_t)row), (unsigned long long)f_to_fx20(s1)); atomicAdd((unsigned long long*)(rso + 2 * (size_t)row + 1), (unsigned long long)f_to_fx20(s2)); }
}
struct EpiRes0 {
    static constexpr bool PERM = true, AFTER_DRAIN = false;
    bf16_t* Y; const bf16_t* res; int ldc; float alpha; long long* rso;
    __device__ __forceinline__ void operator()(const f32x4 (&acc)[2][2][4][2], const Unit& u, int wr, int wc, int fr, int fq) const {
        const int row0 = u.pm * BM + wr * 64 + fr, col0 = u.pn * BM + wc * 32 + 8 * fq;
#pragma unroll
        for (int ai = 0; ai < 2; ++ai)
#pragma unroll
            for (int m = 0; m < 4; ++m) { const int row = row0 + ai * HALF + m * 16; const size_t off = (size_t)row * ldc + col0; f32x4 o[2][2];
#pragma unroll
                for (int bj = 0; bj < 2; ++bj) { const u32x4 r = *(const u32x4*)(res + off + bj * HALF);
                    f32x4 y0, y1;
                    y0[0] = __builtin_bit_cast(float, r.x << 16); y0[1] = __builtin_bit_cast(float, r.x & 0xffff0000u); y0[2] = __builtin_bit_cast(float, r.y << 16); y0[3] = __builtin_bit_cast(float, r.y & 0xffff0000u);
                    y1[0] = __builtin_bit_cast(float, r.z << 16); y1[1] = __builtin_bit_cast(float, r.z & 0xffff0000u); y1[2] = __builtin_bit_cast(float, r.w << 16); y1[3] = __builtin_bit_cast(float, r.w & 0xffff0000u);
                    o[bj][0] = y0 * alpha + acc[ai][bj][m][0]; o[bj][1] = y1 * alpha + acc[ai][bj][m][1];
                    u32x4 w; w.x = cvt_pk_bf16(o[bj][0][0], o[bj][0][1]); w.y = cvt_pk_bf16(o[bj][0][2], o[bj][0][3]); w.z = cvt_pk_bf16(o[bj][1][0], o[bj][1][1]); w.w = cvt_pk_bf16(o[bj][1][2], o[bj][1][3]);
                    *(u32x4*)(Y + off + bj * HALF) = w; }
                row_sums_add(rso, row, o[0][0], o[0][1], o[1][0], o[1][1], fq); }
    }
};
struct EpiResLn2 {
    static constexpr bool PERM = true, AFTER_DRAIN = false;
    bf16_t* Y; const long long* rsi; const float* g; const float* b; int ldc; float alpha; long long* rso;
    __device__ __forceinline__ void operator()(const f32x4 (&acc)[2][2][4][2], const Unit& u, int wr, int wc, int fr, int fq) const {
        const int row0 = u.pm * BM + wr * 64 + fr, col0 = u.pn * BM + wc * 32 + 8 * fq;
        f32x4 gv[2][2], bv[2][2];
#pragma unroll
        for (int bj = 0; bj < 2; ++bj)
#pragma unroll
            for (int n = 0; n < 2; ++n) { gv[bj][n] = *(const f32x4*)(g + col0 + bj * HALF + 4 * n) * alpha; bv[bj][n] = *(const f32x4*)(b + col0 + bj * HALF + 4 * n) * alpha; }
#pragma unroll
        for (int ai = 0; ai < 2; ++ai)
#pragma unroll
            for (int m = 0; m < 4; ++m) { const int row = row0 + ai * HALF + m * 16; const size_t off = (size_t)row * ldc + col0; float mean, rstd; row_stats(rsi, row, mean, rstd); f32x4 o[2][2];
#pragma unroll
                for (int bj = 0; bj < 2; ++bj) { const u32x4 r = *(const u32x4*)(Y + off + bj * HALF);
                    f32x4 y0, y1;
                    y0[0] = __builtin_bit_cast(float, r.x << 16); y0[1] = __builtin_bit_cast(float, r.x & 0xffff0000u); y0[2] = __builtin_bit_cast(float, r.y << 16); y0[3] = __builtin_bit_cast(float, r.y & 0xffff0000u);
                    y1[0] = __builtin_bit_cast(float, r.z << 16); y1[1] = __builtin_bit_cast(float, r.z & 0xffff0000u); y1[2] = __builtin_bit_cast(float, r.w << 16); y1[3] = __builtin_bit_cast(float, r.w & 0xffff0000u);
                    o[bj][0] = (y0 - mean) * rstd * gv[bj][0] + bv[bj][0] + acc[ai][bj][m][0]; o[bj][1] = (y1 - mean) * rstd * gv[bj][1] + bv[bj][1] + acc[ai][bj][m][1];
                    u32x4 w; w.x = cvt_pk_bf16(o[bj][0][0], o[bj][0][1]); w.y = cvt_pk_bf16(o[bj][0][2], o[bj][0][3]); w.z = cvt_pk_bf16(o[bj][1][0], o[bj][1][1]); w.w = cvt_pk_bf16(o[bj][1][2], o[bj][1][3]);
                    *(u32x4*)(Y + off + bj * HALF) = w; }
                row_sums_add(rso, row, o[0][0], o[0][1], o[1][0], o[1][1], fq); }
    }
};

struct EpiBf16LnTok {
    static constexpr bool PERM = true, AFTER_DRAIN = false, AROWPERM = true;
    bf16_t* O; int ldc; const long long* rs; const float* cs; const float* b2;
    __device__ __forceinline__ void operator()(const f32x4 (&acc)[2][2][4][2], const Unit& u, int wr, int wc, int fr, int fq) const {
        const int row0 = u.pm * BM + 128 * wr + 8 * fr, col0 = u.pn * BM + wc * 32 + 8 * fq;
        f32x4 cv[2][2], bv[2][2];
#pragma unroll
        for (int bj = 0; bj < 2; ++bj)
#pragma unroll
            for (int n = 0; n < 2; ++n) { cv[bj][n] = *(const f32x4*)(cs + col0 + bj * HALF + 4 * n); bv[bj][n] = *(const f32x4*)(b2 + col0 + bj * HALF + 4 * n); }
#pragma unroll
        for (int ai = 0; ai < 2; ++ai)
#pragma unroll
            for (int m = 0; m < 4; ++m) { const int row = row0 + 4 * ai + m; float mean, rstd; row_stats(rs, row, mean, rstd);
                bf16_t* rowp = O + (size_t)row * ldc + col0;
#pragma unroll
                for (int bj = 0; bj < 2; ++bj) { const f32x4 v0 = (acc[ai][bj][m][0] - cv[bj][0] * mean) * rstd + bv[bj][0], v1 = (acc[ai][bj][m][1] - cv[bj][1] * mean) * rstd + bv[bj][1];
                    u32x4 w; w.x = cvt_pk_bf16(v0[0], v0[1]); w.y = cvt_pk_bf16(v0[2], v0[3]); w.z = cvt_pk_bf16(v1[0], v1[1]); w.w = cvt_pk_bf16(v1[2], v1[3]);
                    *(u32x4*)(rowp + bj * HALF) = w; } }
    }
};

__device__ __forceinline__ float dpp_shr1(float x) { return __builtin_bit_cast(float, __builtin_amdgcn_update_dpp(0, __builtin_bit_cast(int, x), 0x111, 0xf, 0xf, true)); }
struct EpiConvGlu {
    static constexpr bool PERM = true, AFTER_DRAIN = false, AROWPERM = true;
    bf16_t* G; bf16_t* side; const long long* rs; const float* cs; const float* b2; const float* cw; int dff;
    __device__ __forceinline__ void operator()(const f32x4 (&acc)[2][2][4][2], const Unit& u, int wr, int wc, int fr, int fq) const {
        const int row0 = u.pm * BM + 128 * wr + 8 * fr, colg = u.pn * BM + wc * 32 + 8 * fq, ch0 = u.pn * HALF + wc * 32 + 8 * fq;
        float mean_[8], rstd_[8];
#pragma unroll
        for (int j = 0; j < 8; ++j) row_stats(rs, row0 + j, mean_[j], rstd_[j]);
        float mr_[8];
#pragma unroll
        for (int j = 0; j < 8; ++j) mr_[j] = mean_[j] * rstd_[j];
        unsigned gout[8][4];
        const int bnd = row0 >> 7;
#pragma unroll
        for (int n = 0; n < 2; ++n) {
            const f32x4 ca = *(const f32x4*)(cs + colg + 4 * n), ba = *(const f32x4*)(b2 + colg + 4 * n), cu = *(const f32x4*)(cs + colg + HALF + 4 * n), bu = *(const f32x4*)(b2 + colg + HALF + 4 * n);
            const f32x4 w0 = *(const f32x4*)(cw + ch0 + 4 * n), w1 = *(const f32x4*)(cw + dff + ch0 + 4 * n), w2 = *(const f32x4*)(cw + 2 * dff + ch0 + 4 * n);
            f32x4 a[8], uu[8];
#pragma unroll
            for (int j = 0; j < 8; ++j) { a[j] = acc[j >> 2][0][j & 3][n] * rstd_[j] + (ba - ca * mr_[j]); uu[j] = acc[j >> 2][1][j & 3][n] * rstd_[j] + (bu - cu * mr_[j]); }
            f32x4 p6, p7;
#pragma unroll
            for (int q = 0; q < 4; ++q) { p6[q] = dpp_shr1(a[6][q]); p7[q] = dpp_shr1(a[7][q]); }
            if (fr == 15 && bnd + 1 < 128) { bf16_t* sp = side + ((size_t)(bnd + 1) * 6) * dff + ch0 + 4 * n;
                *(unsigned long long*)(sp) = (unsigned long long)cvt_pk_bf16(a[6][0], a[6][1]) | ((unsigned long long)cvt_pk_bf16(a[6][2], a[6][3]) << 32);
                *(unsigned long long*)(sp + dff) = (unsigned long long)cvt_pk_bf16(a[7][0], a[7][1]) | ((unsigned long long)cvt_pk_bf16(a[7][2], a[7][3]) << 32); }
            if (fr == 0) { bf16_t* sp = side + ((size_t)bnd * 6 + 2) * dff + ch0 + 4 * n;
                *(unsigned long long*)(sp) = (unsigned long long)cvt_pk_bf16(a[0][0], a[0][1]) | ((unsigned long long)cvt_pk_bf16(a[0][2], a[0][3]) << 32);
                *(unsigned long long*)(sp + dff) = (unsigned long long)cvt_pk_bf16(a[1][0], a[1][1]) | ((unsigned long long)cvt_pk_bf16(a[1][2], a[1][3]) << 32);
                *(unsigned long long*)(sp + 2 * dff) = (unsigned long long)cvt_pk_bf16(uu[0][0], uu[0][1]) | ((unsigned long long)cvt_pk_bf16(uu[0][2], uu[0][3]) << 32);
                *(unsigned long long*)(sp + 3 * dff) = (unsigned long long)cvt_pk_bf16(uu[1][0], uu[1][1]) | ((unsigned long long)cvt_pk_bf16(uu[1][2], uu[1][3]) << 32); }
#pragma unroll
            for (int j = 0; j < 8; ++j) { const f32x4 am1 = (j == 0) ? p7 : a[j ? j - 1 : 0], am2 = (j == 0) ? p6 : (j == 1 ? p7 : a[j > 1 ? j - 2 : 0]);
                const f32x4 c = w2 * a[j] + w1 * am1 + w0 * am2;
                const f32x2 g01 = gelu_pk((f32x2){c[0], c[1]}), g23 = gelu_pk((f32x2){c[2], c[3]});
                gout[j][2 * n] = cvt_pk_bf16(g01.x * uu[j][0], g01.y * uu[j][1]); gout[j][2 * n + 1] = cvt_pk_bf16(g23.x * uu[j][2], g23.y * uu[j][3]); }
        }
#pragma unroll
        for (int j = 0; j < 8; ++j) if (!(fr == 0 && j < 2)) { u32x4 w; w.x = gout[j][0]; w.y = gout[j][1]; w.z = gout[j][2]; w.w = gout[j][3]; *(u32x4*)(G + (size_t)(row0 + j) * dff + ch0) = w; }
    }
};
template <class E, class = void> struct arowperm_v { static constexpr bool value = false; };
template <class E> struct arowperm_v<E, decltype((void)E::AROWPERM)> { static constexpr bool value = E::AROWPERM; };
template <class Epi, class Sched, bool ALIGN_EPI = false, bool SP2 = false>
__device__ __forceinline__ void gemm_phase(PG8_LAS unsigned char* lds, const Gemm g, const Sched& S, const Epi& E) {
    int tid_l = threadIdx.x; asm volatile("" : "+v"(tid_l)); const int tid = tid_l, wid = __builtin_amdgcn_readfirstlane(tid >> 6), lane = tid & 63, wr = wid >> 2, wc = wid & 3, fr = lane & 15, fq = lane >> 4;
    const int K = g.K, nt = K / BK;
    unsigned voffA[2], voffB[2];
#pragma unroll
    for (int i = 0; i < 2; ++i) { int R, C; stage_rc(tid * 16 + i * 8192, R, C); const int Rb = Epi::PERM ? ((R & ~31) + perm32(R & 31)) : R;
        const int Ra = arowperm_v<Epi>::value ? (128 * (R >> 6) + 8 * (R & 15) + ((R >> 4) & 3)) : R;
        voffA[i] = (unsigned)(Ra * K + C) * 2u; voffB[i] = (unsigned)(Rb * K + C) * 2u; }
    const size_t hstepA = arowperm_v<Epi>::value ? (size_t)4 * K * 2 : (size_t)HALF * K * 2;
    const size_t kstep = (size_t)(BK * 2);
    const size_t hstep = (size_t)HALF * K * 2;
    const size_t tstep = 2 * hstep;
    const unsigned ldsw = (unsigned)wid * 1024u;
    const int aoff = lds_byte(wr * 64 + fr, fq * 8), boff = lds_byte(wc * 32 + fr, fq * 8);
#define PG8_SA(b, h) (((b) * 2 + (h)) * HTB)
#define PG8_SB(b, h) ((4 + (b) * 2 + (h)) * HTB)
#define PG8_STAGE(bufoff, gbase, voff) do { _Pragma("unroll") for (int _i = 0; _i < 2; ++_i) \
        __builtin_amdgcn_global_load_lds((const unsigned*)((const char*)(gbase) + (voff)[_i]), (PG8_LAS unsigned*)(lds + (bufoff) + ldsw + _i * 8192), 16, 0, 0); } while (0)
#define PG8_LDA(dst, b, h) do { _Pragma("unroll") for (int m = 0; m < 4; ++m) _Pragma("unroll") for (int k = 0; k < 2; ++k) dst[m][k] = *(const PG8_LAS bf16x8*)(lds + PG8_SA(b, h) + aoff + m * 2048 + k * 1024); } while (0)
#define PG8_LDB(dst, b, h) do { _Pragma("unroll") for (int n = 0; n < 2; ++n) _Pragma("unroll") for (int k = 0; k < 2; ++k) dst[n][k] = *(const PG8_LAS bf16x8*)(lds + PG8_SB(b, h) + boff + n * 2048 + k * 1024); } while (0)
#define PG8_MMA(ai, bj, At, Bt) do { __builtin_amdgcn_s_setprio(1); _Pragma("unroll") for (int m = 0; m < 4; ++m) _Pragma("unroll") for (int n = 0; n < 2; ++n) _Pragma("unroll") for (int k = 0; k < 2; ++k) \
        acc[ai][bj][m][n] = __builtin_amdgcn_mfma_f32_16x16x32_bf16(Bt[n][k], At[m][k], acc[ai][bj][m][n], 0, 0, 0); __builtin_amdgcn_s_setprio(0); } while (0)
#define PG8_WAIT_V(n) asm volatile("s_waitcnt vmcnt(" #n ")" ::: "memory")
#define PG8_WAIT_L(n) asm volatile("s_waitcnt lgkmcnt(" #n ")" ::: "memory")
#define PG8_BAR __builtin_amdgcn_s_barrier()
#define PG8_SCHED __builtin_amdgcn_sched_barrier(0)
    Unit cur, nxt; int ui = 0;
    if (!S.next(0, cur)) return;
    f32x4 acc[2][2][4][2];
#pragma unroll
    for (int a = 0; a < 2; ++a)
#pragma unroll
        for (int b = 0; b < 2; ++b)
#pragma unroll
            for (int m = 0; m < 4; ++m)
#pragma unroll
                for (int n = 0; n < 2; ++n) acc[a][b][m][n] = (f32x4){0.f, 0.f, 0.f, 0.f};
    bf16x8 At[4][2], B0[2][2], B1[2][2];
    const char* cA = (const char*)g.A + (size_t)cur.pm * tstep; const char* cB = (const char*)g.Bt + (size_t)cur.pn * tstep;
    S.a_ready(cur);
    if constexpr (SP2) {
        PG8_STAGE(PG8_SB(0, 0), cB, voffB); PG8_STAGE(PG8_SB(0, 1), cB + hstep, voffB); PG8_STAGE(PG8_SA(0, 0), cA, voffA); PG8_STAGE(PG8_SA(0, 1), cA + hstepA, voffA);
        if (wr == 1) PG8_BAR;
        PG8_WAIT_V(2); PG8_BAR;
        PG8_STAGE(PG8_SB(1, 0), cB + kstep, voffB); PG8_STAGE(PG8_SA(1, 0), cA + kstep, voffA); PG8_STAGE(PG8_SB(1, 1), cB + hstep + kstep, voffB);
        PG8_WAIT_V(6); PG8_BAR;
    } else {
        PG8_STAGE(PG8_SB(0, 0), cB, voffB); PG8_STAGE(PG8_SA(0, 0), cA, voffA); PG8_STAGE(PG8_SB(0, 1), cB + hstep, voffB); PG8_STAGE(PG8_SA(0, 1), cA + hstepA, voffA);
        if (wr == 1) PG8_BAR;
        PG8_WAIT_V(4); PG8_BAR;
        PG8_STAGE(PG8_SB(1, 0), cB + kstep, voffB); PG8_STAGE(PG8_SA(1, 0), cA + kstep, voffA); PG8_STAGE(PG8_SB(1, 1), cB + hstep + kstep, voffB);
        PG8_WAIT_V(6); PG8_BAR;
    }
    for (;;) {
        const bool has_next = S.next(ui + 1, nxt);
        const char* nA = has_next ? (const char*)g.A + (size_t)nxt.pm * tstep : cA; const char* nB = has_next ? (const char*)g.Bt + (size_t)nxt.pn * tstep : cB;
        for (int t = 0; t < nt; t += 2) {
            const bool last = (t == nt - 2);
            const char* a1 = cA + (size_t)(t + 1) * kstep;
            const char* a2 = last ? nA : cA + (size_t)(t + 2) * kstep; const char* b2 = last ? nB : cB + (size_t)(t + 2) * kstep;
            const char* a3 = a2 + kstep; const char* b3 = b2 + kstep;
            if (last && has_next) S.a_ready(nxt);
            if constexpr (SP2) {
            PG8_LDB(B0, 0, 0); PG8_LDB(B1, 0, 1); PG8_SCHED; PG8_LDA(At, 0, 0); PG8_STAGE(PG8_SA(1, 1), a1 + hstepA, voffA);
            PG8_WAIT_V(8); PG8_WAIT_L(0); PG8_BAR; PG8_MMA(0, 0, At, B0); PG8_MMA(0, 1, At, B1); PG8_BAR; PG8_SCHED;
            PG8_LDA(At, 0, 1); PG8_STAGE(PG8_SB(0, 0), b2, voffB); PG8_STAGE(PG8_SB(0, 1), b2 + hstep, voffB); PG8_STAGE(PG8_SA(0, 0), a2, voffA);
            PG8_WAIT_V(8); PG8_WAIT_L(0); PG8_BAR; PG8_MMA(1, 0, At, B0); PG8_MMA(1, 1, At, B1); PG8_BAR; PG8_SCHED;
            PG8_LDB(B0, 1, 0); PG8_LDB(B1, 1, 1); PG8_SCHED; PG8_LDA(At, 1, 0); PG8_STAGE(PG8_SA(0, 1), a2 + hstepA, voffA);
            PG8_WAIT_V(8); PG8_WAIT_L(0); PG8_BAR; PG8_MMA(0, 0, At, B0); PG8_MMA(0, 1, At, B1); PG8_BAR; PG8_SCHED;
            PG8_LDA(At, 1, 1); PG8_STAGE(PG8_SB(1, 0), b3, voffB); PG8_STAGE(PG8_SB(1, 1), b3 + hstep, voffB); PG8_STAGE(PG8_SA(1, 0), a3, voffA);
            PG8_WAIT_V(8); PG8_WAIT_L(0); PG8_BAR; PG8_MMA(1, 0, At, B0); PG8_MMA(1, 1, At, B1); PG8_BAR; PG8_SCHED;
            } else {
            PG8_LDB(B0, 0, 0); PG8_SCHED; PG8_LDA(At, 0, 0); PG8_STAGE(PG8_SA(1, 1), a1 + hstepA, voffA);
            PG8_WAIT_L(8); PG8_BAR; PG8_WAIT_L(0); PG8_MMA(0, 0, At, B0); PG8_BAR; PG8_SCHED;
            PG8_LDB(B1, 0, 1); PG8_STAGE(PG8_SB(0, 0), b2, voffB);
            PG8_BAR; PG8_WAIT_L(0); PG8_MMA(0, 1, At, B1); PG8_BAR;
            PG8_LDA(At, 0, 1); PG8_STAGE(PG8_SA(0, 0), a2, voffA);
            PG8_BAR; PG8_WAIT_L(0); PG8_MMA(1, 0, At, B0); PG8_BAR; PG8_SCHED;
            PG8_STAGE(PG8_SB(0, 1), b2 + hstep, voffB);
            PG8_WAIT_V(6); PG8_BAR; PG8_MMA(1, 1, At, B1); PG8_BAR;
            PG8_LDB(B0, 1, 0); PG8_SCHED; PG8_LDA(At, 1, 0); PG8_STAGE(PG8_SA(0, 1), a2 + hstepA, voffA);
            PG8_WAIT_L(8); PG8_BAR; PG8_WAIT_L(0); PG8_MMA(0, 0, At, B0); PG8_BAR; PG8_SCHED;
            PG8_LDB(B1, 1, 1); PG8_STAGE(PG8_SB(1, 0), b3, voffB);
            PG8_BAR; PG8_WAIT_L(0); PG8_MMA(0, 1, At, B1); PG8_BAR;
            PG8_LDA(At, 1, 1); PG8_STAGE(PG8_SA(1, 0), a3, voffA);
            PG8_BAR; PG8_WAIT_L(0); PG8_MMA(1, 0, At, B0); PG8_BAR; PG8_SCHED;
            PG8_STAGE(PG8_SB(1, 1), b3 + hstep, voffB);
            PG8_WAIT_V(6); PG8_BAR; PG8_MMA(1, 1, At, B1); PG8_BAR;
            }
        }
        if constexpr (ALIGN_EPI) { if (wr == 0) PG8_BAR; }
        if constexpr (!Epi::AFTER_DRAIN) { E(acc, cur, wr, wc, fr, fq); S.done(cur); }
        if (!has_next) break;
#pragma unroll
        for (int a = 0; a < 2; ++a)
#pragma unroll
            for (int b = 0; b < 2; ++b)
#pragma unroll
                for (int m = 0; m < 4; ++m)
#pragma unroll
                    for (int n = 0; n < 2; ++n) acc[a][b][m][n] = (f32x4){0.f, 0.f, 0.f, 0.f};
        cur = nxt; cA = nA; cB = nB; ++ui;
        if constexpr (ALIGN_EPI) { if (wr == 1) PG8_BAR; }
    }
    PG8_WAIT_V(0);
    if constexpr (!ALIGN_EPI) { if (wr == 0) PG8_BAR; }
    PG8_BAR;
    if constexpr (Epi::AFTER_DRAIN) { E.fused(acc, cur, wr, wc, fr, fq, lds, wid, lane); S.done(cur); }
#undef PG8_SA
#undef PG8_SB
#undef PG8_STAGE
#undef PG8_LDA
#undef PG8_LDB
#undef PG8_MMA
#undef PG8_WAIT_V
#undef PG8_WAIT_L
#undef PG8_BAR
#undef PG8_SCHED
}
}

#ifndef PG8_SP2
#define PG8_SP2 true
#endif
#ifndef PG8_ALIGN
#define PG8_ALIGN true
#endif
constexpr int NWAVES = 8, NTHR = 512;
constexpr int BATCH = 2, SEQ = 8192, DM = 4096, MTOK = BATCH * SEQ;
constexpr int HD = 128;
constexpr int A_HEADS = 16, B_HEADS = 16, A_W = 2048, B_W = 2048, AB_IN = 4 * A_W + 3 * B_W;
constexpr int NSA_H = 32, NSA_G = 4, NSA_R = 8, KVW = 512, NSA_IN = 4096 + 6 * KVW + 96, NSA_INP = 7424;
constexpr int NCMP = 511, NCMPP = 512, NSLC = 128, NTOP = 16, WINDOW = 512;
constexpr int NMEM = 256, XH = 4, XW = 512;
constexpr int DFF = 11008, DFF2 = 22016;
constexpr float LN_EPS = 1e-5f, RMS_EPS = 1e-6f;
constexpr float DN_ALPHA = 1.41421356237309515f;
constexpr size_t MiB = (size_t)1 << 20;
constexpr size_t WS_CTL = 0, CTL_ZERO_BYTES = 4 * MiB;
constexpr size_t WS_FOLD = 64 * 1024;
constexpr int FO_XQ = 0, FO_UP = 2 * 512, FO_NSA = FO_UP + 2 * 22016, FO_N = FO_NSA + 7424;
constexpr size_t WS_RSUM = 1 * MiB;
static_assert(WS_FOLD + (size_t)2 * FO_N * 8 <= WS_RSUM && WS_RSUM + (size_t)6 * 16384 * 2 * 8 <= CTL_ZERO_BYTES, "CTL map");
constexpr size_t WS_W_ABIN = 4 * MiB;
constexpr size_t WS_W_ABOUT = WS_W_ABIN + 112 * MiB;
constexpr size_t WS_W_NSAIN = WS_W_ABOUT + 32 * MiB;
constexpr size_t WS_W_NSAOUT = WS_W_NSAIN + 58 * MiB;
constexpr size_t WS_W_XQ = WS_W_NSAOUT + 32 * MiB;
constexpr size_t WS_W_XKV = WS_W_XQ + 8 * MiB;
constexpr size_t WS_W_XO = WS_W_XKV + 16 * MiB;
constexpr size_t WS_W_UP = WS_W_XO + 8 * MiB;
constexpr size_t WS_W_DOWN = WS_W_UP + 344 * MiB;
constexpr size_t WS_W_C1 = WS_W_DOWN + 172 * MiB;
constexpr size_t WS_W_C2 = WS_W_C1 + 2 * MiB;
constexpr size_t WS_MEMB = WS_W_C2 + 1 * MiB;
constexpr size_t WS_HB = WS_MEMB + 4 * MiB;
constexpr size_t WS_Y = WS_HB + 128 * MiB;
constexpr size_t WS_BIG = WS_Y + 256 * MiB;
constexpr size_t WS_G = WS_BIG + 688 * MiB;
constexpr size_t WS_O = WS_G + 344 * MiB;
constexpr size_t WS_MISC = WS_O + 128 * MiB;
constexpr size_t WS_END = WS_MISC + 64 * MiB;
constexpr size_t WS_XQ = WS_MISC;
constexpr size_t WS_XO = WS_MISC + 16 * MiB;
constexpr size_t WS_XKV = WS_MISC + 32 * MiB;
constexpr size_t WS_LB = WS_MISC + 34 * MiB;
constexpr size_t WS_SIDE = WS_MISC + 42 * MiB;
constexpr size_t WS_FOLDF = WS_MISC + 40 * MiB;
constexpr size_t WS_ROPE = WS_MISC + 36 * MiB;
constexpr size_t WS_STATS = WS_MISC + 35 * MiB;
constexpr size_t WS_PROJ0 = WS_BIG;
constexpr size_t WS_SPREV = WS_BIG + 448 * MiB;
constexpr size_t WS_QT = WS_G;
constexpr size_t WS_OINTRA = WS_G + 64 * MiB;
constexpr size_t WS_DEC = WS_G + 192 * MiB;
constexpr size_t WS_DS = WS_Y;
constexpr size_t WS_PROJ1 = WS_BIG;
constexpr size_t WS_QROT = WS_BIG + 232 * MiB;
constexpr size_t WS_KSROT = WS_BIG + 360 * MiB;
constexpr size_t WS_KWROT = WS_BIG + 376 * MiB;
constexpr size_t WS_KCMP = WS_BIG + 392 * MiB;
constexpr size_t WS_VCMP = WS_BIG + 393 * MiB;
constexpr size_t WS_OVL = WS_BIG + 394 * MiB;
constexpr size_t WS_SEL = WS_BIG + 395 * MiB;
constexpr size_t WS_IMP = WS_G + 256 * MiB;
constexpr size_t WS_O32 = WS_G;
static_assert(WS_SPREV + 128 * MiB <= WS_G && WS_DEC + 2 * MiB <= WS_O && WS_SEL + MiB <= WS_G, "ws map");
constexpr int CW_TMO = 0, CW_CODE = 1;
constexpr int CW_BAR = 4096;
constexpr int RING_OFF = 0, RING_BYTES = 131072;
constexpr int LDSCTL_OFF = RING_BYTES, MISC_OFF = LDSCTL_OFF + 320;
constexpr int LDS_BYTES = 147456;
static_assert(MISC_OFF + 128 <= LDS_BYTES, "LDS map");

#define GAS __attribute__((address_space(1)))
#define LAS __attribute__((address_space(3)))
typedef unsigned short bf16;
typedef unsigned v4u __attribute__((ext_vector_type(4)));
typedef unsigned v2u __attribute__((ext_vector_type(2)));
typedef float f32x4 __attribute__((ext_vector_type(4)));
typedef float f32x2 __attribute__((ext_vector_type(2)));
typedef float f32x16 __attribute__((ext_vector_type(16)));
typedef short bf16x8 __attribute__((ext_vector_type(8)));
typedef short s16x4 __attribute__((ext_vector_type(4)));
typedef GAS unsigned gu32;
#define RLX_AGENT __ATOMIC_RELAXED, __HIP_MEMORY_SCOPE_AGENT
#define LDS_WAIT() asm volatile("s_waitcnt lgkmcnt(0)" ::: "memory")
#define VM_WAIT() asm volatile("s_waitcnt vmcnt(0)" ::: "memory")
#define SBAR() __builtin_amdgcn_sched_barrier(0)
__device__ __forceinline__ unsigned f2bf(float f) { unsigned u = __builtin_bit_cast(unsigned, f); return (u + 0x7fffu + ((u >> 16) & 1u)) >> 16; }
__device__ __forceinline__ unsigned pk2(float lo, float hi) { return f2bf(lo) | (f2bf(hi) << 16); }
__device__ __forceinline__ float bf2f(unsigned short b) { return __builtin_bit_cast(float, (unsigned)b << 16); }
__device__ __forceinline__ float bflo(unsigned w) { return __builtin_bit_cast(float, w << 16); }
__device__ __forceinline__ float bfhi(unsigned w) { return __builtin_bit_cast(float, w & 0xffff0000u); }
__device__ __forceinline__ unsigned cvtpk(float lo, float hi) { unsigned r; asm volatile("v_cvt_pk_bf16_f32 %0, %1, %2" : "=v"(r) : "v"(lo), "v"(hi)); return r; }
__device__ __forceinline__ float wave_sum(float v) {
#pragma unroll
    for (int o = 1; o < 64; o <<= 1) v += __shfl_xor(v, o);
    return v;
}
__device__ __forceinline__ float sigmoidf_(float x) { return __builtin_amdgcn_rcpf(1.f + __builtin_amdgcn_exp2f(-1.4426950408889634f * x)); }
__device__ __forceinline__ float gelu1(float v) { pg8::f32x2 r = pg8::gelu_pk((pg8::f32x2){v, 0.f}); return r.x; }
#define XB_TMO      128
#define XB_XCNT(j)  (256  + 64 * (j))
#define XB_XSUB(j)  (1280 + 64 * (j))
#define XB_XGEN(j)  (2304 + 64 * (j))
#define XB_TOP      3328
#define XB_TOPGEN   3392
#define XCD_BAR_WORDS 3456
#define XB_SPIN_CAP (1u << 18)
#define LAS __attribute__((address_space(3)))

__device__ __forceinline__ unsigned xb_ld(unsigned* p)              { return __hip_atomic_load(p, __ATOMIC_RELAXED, __HIP_MEMORY_SCOPE_AGENT); }
__device__ __forceinline__ unsigned xb_add(unsigned* p, unsigned v) { return __hip_atomic_fetch_add(p, v, __ATOMIC_RELAXED, __HIP_MEMORY_SCOPE_AGENT); }
__device__ __forceinline__ unsigned xb_xcc_id() { return (unsigned)__builtin_amdgcn_s_getreg((3 << 11) | 20) & 0xFu; }
#define XB_SPIN(cond, bar) do { unsigned _sp = 0; while (cond) { __builtin_amdgcn_s_sleep(1); \
    if ((++_sp & 255u) == 0u) { if (xb_ld(&(bar)[XB_TMO])) break; if (_sp > XB_SPIN_CAP) { atomicAdd(&(bar)[XB_TMO], 1u); break; } } } } while (0)

struct XcdBarrier {
    unsigned* bar; unsigned x;
    volatile LAS unsigned* st;
};

__device__ __forceinline__ XcdBarrier xcd_barrier_post(unsigned* bar, volatile LAS unsigned* st) {
    XcdBarrier b; b.bar = bar; b.x = xb_xcc_id(); b.st = st;
    if (threadIdx.x == 0) (void)xb_add(&bar[XB_XCNT(b.x)], 1u);
    return b;
}
__device__ __forceinline__ void xcd_barrier_complete(unsigned* bar, unsigned x, unsigned& nloc, unsigned& nx) {
    const unsigned G = gridDim.x * gridDim.y * gridDim.z;
    unsigned sum, cnt, mine, sp = 0u;
    for (;;) {
        sum = 0u; cnt = 0u; mine = 0u;
#pragma unroll
        for (unsigned j = 0; j < 16; ++j) { const unsigned c = xb_ld(&bar[XB_XCNT(j)]); sum += c; cnt += (c > 0u) ? 1u : 0u; mine = (j == x) ? c : mine; }
        if (sum == G) break;
        __builtin_amdgcn_s_sleep(1);
        if ((++sp & 255u) == 0u) { if (xb_ld(&bar[XB_TMO])) break; if (sp > XB_SPIN_CAP) { atomicAdd(&bar[XB_TMO], 1u); break; } }
    }
    nloc = mine > 0u ? mine : 1u; nx = cnt > 0u ? cnt : 1u;
}

__device__ __forceinline__ void xcd_barrier(const XcdBarrier& b) {
    asm volatile("s_waitcnt vmcnt(0)" ::: "memory");
    __syncthreads();
    if (threadIdx.x == 0) {
        unsigned* bar = b.bar;
        __builtin_amdgcn_s_waitcnt(0);
        unsigned nloc = b.st[0], nx = b.st[1];
        if (nloc == 0u) { xcd_barrier_complete(bar, b.x, nloc, nx); b.st[0] = nloc; b.st[1] = nx; }
        const unsigned old = xb_add(&bar[XB_XSUB(b.x)], 1u);
        const unsigned gen = old / nloc;
        if (old + 1u == (gen + 1u) * nloc) {
            __builtin_amdgcn_fence(__ATOMIC_RELEASE, "agent");
            asm volatile("s_waitcnt vmcnt(0)" ::: "memory");
            const unsigned og = xb_add(&bar[XB_TOP], 1u);
            const unsigned tg = og / nx;
            if (og + 1u == (tg + 1u) * nx) xb_add(&bar[XB_TOPGEN], 1u);
            else XB_SPIN(xb_ld(&bar[XB_TOPGEN]) == tg, bar);
            __builtin_amdgcn_fence(__ATOMIC_ACQUIRE, "agent");
            xb_add(&bar[XB_XGEN(b.x)], 1u);
            asm volatile("s_waitcnt vmcnt(0)" ::: "memory");
        } else {
            XB_SPIN(xb_ld(&bar[XB_XGEN(b.x)]) == gen, bar);
            __builtin_amdgcn_fence(__ATOMIC_ACQUIRE, "agent");
            asm volatile("s_waitcnt vmcnt(0)" ::: "memory");
        }
    }
    __syncthreads();
}


constexpr int ATT_D = 128, KVBLK = 64;
constexpr int SHM_V = KVBLK * ATT_D * 2, SHM_K = KVBLK * ATT_D * 2;
constexpr int ATT_K_OFF = 0, ATT_V_OFF = SHM_K, ATT_BUF = SHM_K + SHM_V, ATT_SET = 2 * ATT_BUF;
constexpr int ATT_WS_OFF = RING_BYTES + 512;
constexpr int ATT_X_OFF = ATT_WS_OFF + NWAVES * 256;
static_assert(2 * ATT_SET <= RING_BYTES && ATT_X_OFF + 2048 + NTHR * 16 <= LDS_BYTES, "attention LDS map");
#define KSWZ(row, colB) ((row) * 256 + ((colB) ^ (((row) & 7) << 4)))
__device__ __forceinline__ int crow(int r, int hi) { return (r & 3) + 8 * (r >> 2) + 4 * hi; }
__device__ __forceinline__ int v_st(int k, int c) { const int kk = (k & ~0xC) | ((k & 4) << 1) | ((k & 8) >> 1); return ((kk >> 3) * 4 + (c >> 5)) * 512 + ((kk & 7) * 32 + (c & 31)) * 2; }
__device__ __forceinline__ int v_rd_base(int lane) { return ((lane & 3) << 3) | (((lane >> 2) & 3) << 6) | (((lane >> 4) & 1) << 5) | (((lane >> 5) & 1) << 8); }
constexpr int v_rd_off(int d0, int ks, int half) { return d0 * 512 + ks * 4096 + half * 2048; }
template <int OFF> __device__ __forceinline__ s16x4 tr_read(int vb) {
  s16x4 r; asm volatile("ds_read_b64_tr_b16 %0, %1 offset:%2" : "=&v"(r) : "v"(vb), "i"(OFF) : "memory"); return r;
}
__device__ __forceinline__ void qkt(f32x16& p0, f32x16& p1, const LAS char* Ks, const bf16x8* qr, int r32, int hi) {
  p0 = f32x16{}; p1 = f32x16{};
#pragma unroll
  for (int d0 = 0; d0 < 8; ++d0) { const int cb = (d0 * 16 + hi * 8) * 2;
    const bf16x8 b0 = *(const LAS bf16x8*)(Ks + KSWZ(r32, cb));
    const bf16x8 b1 = *(const LAS bf16x8*)(Ks + KSWZ(32 + r32, cb));
    p0 = __builtin_amdgcn_mfma_f32_32x32x16_bf16(b0, qr[d0], p0, 0, 0, 0);
    p1 = __builtin_amdgcn_mfma_f32_32x32x16_bf16(b1, qr[d0], p1, 0, 0, 0); }
}
__device__ __forceinline__ void pack_p(const f32x16& p0, const f32x16& p1, bf16x8& pa0, bf16x8& pa1, bf16x8& pa2, bf16x8& pa3) {
#define PK4(P, BASE, OUT) do { unsigned a0 = cvtpk(P[BASE + 0], P[BASE + 1]), a1 = cvtpk(P[BASE + 2], P[BASE + 3]);   \
    unsigned b0 = cvtpk(P[BASE + 4], P[BASE + 5]), b1 = cvtpk(P[BASE + 6], P[BASE + 7]);                              \
    auto r0 = __builtin_amdgcn_permlane32_swap(a0, b0, false, false); auto r1 = __builtin_amdgcn_permlane32_swap(a1, b1, false, false); \
    v4u w = {r0[0], r1[0], r0[1], r1[1]}; OUT = __builtin_bit_cast(bf16x8, w); } while (0)
  PK4(p0, 0, pa0); PK4(p0, 8, pa1); PK4(p1, 0, pa2); PK4(p1, 8, pa3);
#undef PK4
}
template <int D0> __device__ __forceinline__ void pv_one(f32x16& od, int vb, bf16x8 pa0, bf16x8 pa1, bf16x8 pa2, bf16x8 pa3) {
  const s16x4 l0 = tr_read<v_rd_off(D0, 0, 0)>(vb), h0 = tr_read<v_rd_off(D0, 0, 1)>(vb), l1 = tr_read<v_rd_off(D0, 1, 0)>(vb), h1 = tr_read<v_rd_off(D0, 1, 1)>(vb);
  const s16x4 l2 = tr_read<v_rd_off(D0, 2, 0)>(vb), h2 = tr_read<v_rd_off(D0, 2, 1)>(vb), l3 = tr_read<v_rd_off(D0, 3, 0)>(vb), h3 = tr_read<v_rd_off(D0, 3, 1)>(vb);
  asm volatile("s_waitcnt lgkmcnt(0)" ::: "memory"); SBAR();
#define PKV(L, H) (bf16x8){L[0], L[1], L[2], L[3], H[0], H[1], H[2], H[3]}
  od = __builtin_amdgcn_mfma_f32_32x32x16_bf16(pa0, PKV(l0, h0), od, 0, 0, 0);
  od = __builtin_amdgcn_mfma_f32_32x32x16_bf16(pa1, PKV(l1, h1), od, 0, 0, 0);
  od = __builtin_amdgcn_mfma_f32_32x32x16_bf16(pa2, PKV(l2, h2), od, 0, 0, 0);
  od = __builtin_amdgcn_mfma_f32_32x32x16_bf16(pa3, PKV(l3, h3), od, 0, 0, 0);
#undef PKV
}
__device__ __forceinline__ void pv_d0(f32x16* o, int vb, bf16x8 pa0, bf16x8 pa1, bf16x8 pa2, bf16x8 pa3) {
  pv_one<0>(o[0], vb, pa0, pa1, pa2, pa3); pv_one<1>(o[1], vb, pa0, pa1, pa2, pa3); pv_one<2>(o[2], vb, pa0, pa1, pa2, pa3); pv_one<3>(o[3], vb, pa0, pa1, pa2, pa3);
}
struct KVStage { bf16x8 ks0, ks1, vs0, vs1; };
__device__ __forceinline__ void kv_load(KVStage& s, const bf16* Kh, const bf16* Vh, long ldk, long ldv, int k0, int sr, int sc) {
  s.ks0 = *(const bf16x8*)(Kh + (long)(k0 + sr) * ldk + sc); s.ks1 = *(const bf16x8*)(Kh + (long)(k0 + 32 + sr) * ldk + sc);
  s.vs0 = *(const bf16x8*)(Vh + (long)(k0 + sr) * ldv + sc); s.vs1 = *(const bf16x8*)(Vh + (long)(k0 + 32 + sr) * ldv + sc);
}
__device__ __forceinline__ void kv_write(const KVStage& s, LAS char* lds, int sr, int sc) {
  *(LAS bf16x8*)(lds + ATT_V_OFF + v_st(sr, sc)) = s.vs0; *(LAS bf16x8*)(lds + ATT_V_OFF + v_st(32 + sr, sc)) = s.vs1;
  *(LAS bf16x8*)(lds + ATT_K_OFF + KSWZ(sr, sc * 2)) = s.ks0; *(LAS bf16x8*)(lds + ATT_K_OFF + KSWZ(32 + sr, sc * 2)) = s.ks1;
}
struct KVDma { int ko[2], vo[2]; };
__device__ __forceinline__ void kv_dma_init(KVDma& d, int ldk, int ldv, int wid, int lane) {
#pragma unroll
  for (int i = 0; i < 2; ++i) { const int p = wid * 2 + i;
    const int row = p * 4 + (lane >> 4), cp = lane & 15; d.ko[i] = row * ldk + ((cp ^ (row & 7)) << 3);
    const int sub = p * 2 + (lane >> 5), kk = (sub >> 2) * 8 + ((lane & 31) >> 2), k = (kk & ~0xC) | ((kk & 4) << 1) | ((kk & 8) >> 1), c = (sub & 3) * 32 + (lane & 3) * 8;
    d.vo[i] = k * ldv + c; }
}
__device__ __forceinline__ void kv_dma(const KVDma& d, const bf16* Kt, const bf16* Vt, LAS char* lds, int buf, int wid) {
#pragma unroll
  for (int i = 0; i < 2; ++i) {
    __builtin_amdgcn_global_load_lds((const unsigned*)(Kt + d.ko[i]), (LAS unsigned*)(lds + buf + ATT_K_OFF + (wid * 2 + i) * 1024), 16, 0, 0);
    __builtin_amdgcn_global_load_lds((const unsigned*)(Vt + d.vo[i]), (LAS unsigned*)(lds + buf + ATT_V_OFF + (wid * 2 + i) * 1024), 16, 0, 0); }
}
__device__ __forceinline__ void rescale_o(f32x16* o, float a, LAS float* al_l, int r32, int hi) {
  if (__any(a < 1.f)) { if (hi == 0) al_l[r32] = a; LDS_WAIT();
#pragma unroll
    for (int r = 0; r < 16; ++r) { const float f = al_l[crow(r, hi)];
#pragma unroll
      for (int d = 0; d < 4; ++d) o[d][r] *= f; }
    LDS_WAIT(); }
}
constexpr float ATT_SCALE = 0.088388347648318440f, ATT_C = ATT_SCALE * 1.4426950408889634f, ATT_THR = 8.f;
__device__ __forceinline__ void softmax_tile(f32x16& p0, f32x16& p1, float& m_reg, float& l_reg, float& alpha, bool rowvalid = true) {
  float pmax = p0[0];
#pragma unroll
  for (int r = 1; r < 16; ++r) pmax = fmaxf(pmax, p0[r]);
#pragma unroll
  for (int r = 0; r < 16; ++r) pmax = fmaxf(pmax, p1[r]);
  { auto rr = __builtin_amdgcn_permlane32_swap(__float_as_uint(pmax), __float_as_uint(pmax), false, false);
    pmax = fmaxf(__uint_as_float(rr[0]), __uint_as_float(rr[1])); }
  if (!rowvalid) pmax = -__builtin_inff();
  float mn;
  if (__all(pmax - m_reg <= ATT_THR / ATT_SCALE)) { mn = m_reg; alpha = 1.f; }
  else { mn = fmaxf(m_reg, pmax); alpha = __builtin_amdgcn_exp2f((m_reg - mn) * ATT_C); m_reg = mn; }
  const float mnC = rowvalid ? -mn * ATT_C : -__builtin_inff();
#pragma unroll
  for (int r = 0; r < 16; ++r) { p0[r] = __builtin_amdgcn_exp2f(fmaf(p0[r], ATT_C, mnC)); p1[r] = __builtin_amdgcn_exp2f(fmaf(p1[r], ATT_C, mnC)); }
  float ps = 0.f;
#pragma unroll
  for (int r = 0; r < 16; ++r) ps += p0[r] + p1[r];
  { auto rr = __builtin_amdgcn_permlane32_swap(__float_as_uint(ps), __float_as_uint(ps), false, false);
    ps = __uint_as_float(rr[0]) + __uint_as_float(rr[1]); }
  l_reg = l_reg * alpha + ps;
}
__device__ __forceinline__ void attn_finish(f32x16& p0, f32x16& p1, f32x16* o, float& m_reg, float& l_reg, LAS float* wsc, int vb, int r32, int hi, bool rowvalid = true) {
  float alpha; softmax_tile(p0, p1, m_reg, l_reg, alpha, rowvalid);
  rescale_o(o, alpha, wsc, r32, hi);
  bf16x8 pa0, pa1, pa2, pa3; pack_p(p0, p1, pa0, pa1, pa2, pa3);
  pv_d0(o, vb, pa0, pa1, pa2, pa3);
}
__device__ __forceinline__ void load_q(bf16x8* qr, const bf16* Qw) {
#pragma unroll
  for (int d0 = 0; d0 < 8; ++d0) qr[d0] = *(const bf16x8*)(Qw + d0 * 16);
}

struct Frame {
    LAS unsigned char* lds;
    unsigned char* ws;
    int tid, lane, wave, G, bid;
    __device__ __forceinline__ void fresh() { int t = threadIdx.x; asm volatile("" : "+v"(t)); tid = t; lane = t & 63; wave = __builtin_amdgcn_readfirstlane(t >> 6);
        int g_ = gridDim.x, b_ = blockIdx.x; asm volatile("" : "+s"(g_), "+s"(b_)); G = g_; bid = b_; }
};
struct Args { const float* in[19]; float* out; unsigned char* ws; int ph_lo, ph_hi; };
typedef const Args __attribute__((address_space(4))) KArgs;
__device__ __forceinline__ KArgs* karg() { KArgs* p = (KArgs*)__builtin_amdgcn_kernarg_segment_ptr(); asm volatile("" : "+s"(p)); return p; }
#define KIN(i) ((const float*)karg()->in[i])
enum { IN_X = 0, IN_MEM, IN_AB_W_IN, IN_HGRN_LB, IN_HGRN_NW, IN_AB_W_OUT, IN_NSA_W_IN, IN_NSA_CMP_POS, IN_NSA_CMP_W1, IN_NSA_CMP_W2, IN_NSA_W_OUT,
       IN_XA_WQ, IN_XA_WKV, IN_XA_WO, IN_FFN_UP, IN_FFN_CONV, IN_FFN_DOWN, IN_LN_G, IN_LN_B };

__device__ __forceinline__ void p0_transpose_item(const float* W, int K, int N, bf16* WT, LAS float* scr, int item, int lane) {
    const int nblk = N / 32, kb = item / nblk, nb = item % nblk, k0 = 64 * kb, n0 = 32 * nb;
#pragma unroll 8
    for (int i = 0; i < 32; ++i) { const int kk = 2 * i + (lane >> 5); scr[kk * 33 + (lane & 31)] = W[(size_t)(k0 + kk) * N + n0 + (lane & 31)]; }
    LDS_WAIT(); asm volatile("" ::: "memory");
    const int c = lane & 7;
#pragma unroll
    for (int j = 0; j < 4; ++j) { const int n = (lane >> 3) + 8 * j; const LAS float* s = scr + (8 * c) * 33 + n;
        v4u o; o.x = pk2(s[0 * 33], s[1 * 33]); o.y = pk2(s[2 * 33], s[3 * 33]); o.z = pk2(s[4 * 33], s[5 * 33]); o.w = pk2(s[6 * 33], s[7 * 33]);
        *(GAS v4u*)(WT + (size_t)(n0 + n) * K + k0 + 8 * c) = o; }
    LDS_WAIT(); asm volatile("" ::: "memory");
}
__device__ __forceinline__ int up_col(int n) { const int isu = n >= DFF, ch = isu ? n - DFF : n; return (ch >> 7) * 256 + isu * 128 + (ch & 127); }
__device__ __forceinline__ void p0_transpose_item_fold(const float* W, int K, int N, bf16* WT, LAS float* scr, int item, int lane, const float* g, const float* b, long long* cs, long long* b2, bool upmap = false) {
    const int nblk = N / 32, kb = item / nblk, nb = item % nblk, k0 = 64 * kb, n0 = 32 * nb, n0m = upmap ? up_col(n0) : n0;
#pragma unroll 8
    for (int i = 0; i < 32; ++i) { const int kk = 2 * i + (lane >> 5); scr[kk * 33 + (lane & 31)] = W[(size_t)(k0 + kk) * N + n0 + (lane & 31)]; }
    LDS_WAIT(); asm volatile("" ::: "memory");
    const int c = lane & 7;
    const f32x4 g0 = *(const f32x4*)(g + k0 + 8 * c), g1 = *(const f32x4*)(g + k0 + 8 * c + 4), b0 = *(const f32x4*)(b + k0 + 8 * c), b1 = *(const f32x4*)(b + k0 + 8 * c + 4);
    const float gg[8] = {g0.x, g0.y, g0.z, g0.w, g1.x, g1.y, g1.z, g1.w}, bb[8] = {b0.x, b0.y, b0.z, b0.w, b1.x, b1.y, b1.z, b1.w};
#pragma unroll
    for (int j = 0; j < 4; ++j) { const int n = (lane >> 3) + 8 * j; const LAS float* s = scr + (8 * c) * 33 + n;
        float sc = 0.f, sb = 0.f; unsigned w[4];
#pragma unroll
        for (int q = 0; q < 4; ++q) { const float x0 = s[(2 * q) * 33], x1 = s[(2 * q + 1) * 33]; const unsigned r0 = f2bf(x0 * gg[2 * q]), r1 = f2bf(x1 * gg[2 * q + 1]);
            w[q] = r0 | (r1 << 16); sc += bf2f((unsigned short)r0) + bf2f((unsigned short)r1); sb += x0 * bb[2 * q] + x1 * bb[2 * q + 1]; }
        *(GAS v4u*)(WT + (size_t)(n0m + n) * K + k0 + 8 * c) = (v4u){w[0], w[1], w[2], w[3]};
        sc += __shfl_xor(sc, 1); sc += __shfl_xor(sc, 2); sc += __shfl_xor(sc, 4); sb += __shfl_xor(sb, 1); sb += __shfl_xor(sb, 2); sb += __shfl_xor(sb, 4);
        if (c == 0) { atomicAdd((unsigned long long*)(cs + n0m + n), (unsigned long long)(long long)rintf(sc * pg8::FOLD_SCALE)); atomicAdd((unsigned long long*)(b2 + n0m + n), (unsigned long long)(long long)rintf(sb * pg8::FOLD_SCALE)); } }
    LDS_WAIT(); asm volatile("" ::: "memory");
}
__device__ __forceinline__ void transpose_mat_fold(Frame& F, const float* W, int K, int N, bf16* WT, const float* g, const float* b, long long* cs, long long* b2, int c0 = 0, int nw = 1 << 30, int part = 0, int nparts = 1, bool upmap = false) {
    if (F.bid < c0 || F.bid >= c0 + nw) return;
    LAS float* scr = (LAS float*)(F.lds + RING_OFF + F.wave * 16384);
    const int nwg = nw < F.G ? nw : F.G, gw = (F.bid - c0) * NWAVES + F.wave, NGW = nwg * NWAVES;
    const int nitems = (K / 64) * (N / 32), ilo = (int)((long)nitems * part / nparts), ihi = (int)((long)nitems * (part + 1) / nparts);
    for (int it = ilo + gw; it < ihi; it += NGW) p0_transpose_item_fold(W, K, N, WT, scr, it, F.lane, g, b, cs, b2, upmap);
}
__device__ __forceinline__ void transpose_mat(Frame& F, const float* W, int K, int N, bf16* WT, int c0 = 0, int nw = 1 << 30) {
    if (F.bid < c0 || F.bid >= c0 + nw) return;
    LAS float* scr = (LAS float*)(F.lds + RING_OFF + F.wave * 16384);
    const int nwg = nw < F.G ? nw : F.G, gw = (F.bid - c0) * NWAVES + F.wave, NGW = nwg * NWAVES;
    const int nitems = (K / 64) * (N / 32);
    for (int it = gw; it < nitems; it += NGW) p0_transpose_item(W, K, N, WT, scr, it, F.lane);
}
__device__ __forceinline__ void fold_finalize(Frame& F, int lo, int n) {
    const long long* fs = (const long long*)(F.ws + WS_FOLD); float* fd = (float*)(F.ws + WS_FOLDF);
    for (int i = F.bid * NTHR + F.tid; i < 2 * n; i += F.G * NTHR) { const int j = (i < n) ? lo + i : FO_N + lo + (i - n); const long long v = fs[j]; fd[j] = (float)(int)(v >> 32) + (float)(unsigned)v * pg8::FOLD_INV; }
}
enum { CJ_DOWN0, CJ_NSA, CJ_L1A, CJ_L1B, CJ_DOWN1 };
template <int JOB>
__device__ __forceinline__ void convert_job(Frame& F, const Args& A, int c0, int nw) {
    unsigned char* ws = F.ws; long long* cs = (long long*)(ws + WS_FOLD); long long* b2 = cs + FO_N;
    if (JOB == CJ_DOWN0 || JOB == CJ_DOWN1) { const int l = JOB == CJ_DOWN1; transpose_mat(F, KIN(IN_FFN_DOWN) + (size_t)l * DFF * DM, DFF, DM, (bf16*)(ws + WS_W_DOWN) + (size_t)l * DM * DFF, c0, nw); }
    if (JOB == CJ_NSA) {
        transpose_mat_fold(F, KIN(IN_NSA_W_IN), DM, NSA_IN, (bf16*)(ws + WS_W_NSAIN), KIN(IN_LN_G) + 2 * DM, KIN(IN_LN_B) + 2 * DM, cs + FO_NSA, b2 + FO_NSA, c0, nw);
        transpose_mat(F, KIN(IN_NSA_W_OUT), DM, DM, (bf16*)(ws + WS_W_NSAOUT), c0, nw); }
    if (JOB == CJ_L1A || JOB == CJ_L1B) { const int l = 1;
        if (JOB == CJ_L1A) {
            transpose_mat_fold(F, KIN(IN_XA_WQ) + (size_t)l * DM * XW, DM, XW, (bf16*)(ws + WS_W_XQ) + (size_t)l * XW * DM, KIN(IN_LN_G) + (size_t)(3 * l) * DM, KIN(IN_LN_B) + (size_t)(3 * l) * DM, cs + FO_XQ + l * XW, b2 + FO_XQ + l * XW, c0, nw);
            transpose_mat(F, KIN(IN_XA_WKV) + (size_t)l * DM * 2 * XW, DM, 2 * XW, (bf16*)(ws + WS_W_XKV) + (size_t)l * 2 * XW * DM, c0, nw);
            transpose_mat(F, KIN(IN_XA_WO) + (size_t)l * XW * DM, XW, DM, (bf16*)(ws + WS_W_XO) + (size_t)l * DM * XW, c0, nw); }
        transpose_mat_fold(F, KIN(IN_FFN_UP) + (size_t)l * DM * DFF2, DM, DFF2, (bf16*)(ws + WS_W_UP) + (size_t)l * DFF2 * DM, KIN(IN_LN_G) + (size_t)(3 * l + 1) * DM, KIN(IN_LN_B) + (size_t)(3 * l + 1) * DM,
                           cs + FO_UP + l * DFF2, b2 + FO_UP + l * DFF2, c0, nw, JOB == CJ_L1A ? 0 : 1, 2, true); }
}
__device__ __forceinline__ void cvt_flat(Frame& F, const float* src, bf16* dst, long n8) {
    for (long i = (long)F.bid * NTHR + F.tid; i < n8; i += (long)F.G * NTHR) {
        const f32x4 a = *(const f32x4*)(src + i * 8), b = *(const f32x4*)(src + i * 8 + 4);
        v4u o; o.x = pk2(a.x, a.y); o.y = pk2(a.z, a.w); o.z = pk2(b.x, b.y); o.w = pk2(b.z, b.w);
        *(v4u*)(dst + i * 8) = o; }
}
__device__ __forceinline__ void p0_prologue(Frame& F, const Args& A) {
    unsigned char* ws = F.ws;
    long long* cs = (long long*)(ws + WS_FOLD); long long* b2 = cs + FO_N;
    transpose_mat(F, KIN(IN_AB_W_IN), DM, AB_IN, (bf16*)(ws + WS_W_ABIN));
    transpose_mat(F, KIN(IN_AB_W_OUT), DM, DM, (bf16*)(ws + WS_W_ABOUT));
    { const int l = 0;
        transpose_mat_fold(F, KIN(IN_XA_WQ) + (size_t)l * DM * XW, DM, XW, (bf16*)(ws + WS_W_XQ) + (size_t)l * XW * DM, KIN(IN_LN_G) + (size_t)(3 * l) * DM, KIN(IN_LN_B) + (size_t)(3 * l) * DM, cs + FO_XQ + l * XW, b2 + FO_XQ + l * XW);
        transpose_mat(F, KIN(IN_XA_WKV) + (size_t)l * DM * 2 * XW, DM, 2 * XW, (bf16*)(ws + WS_W_XKV) + (size_t)l * 2 * XW * DM);
        transpose_mat(F, KIN(IN_XA_WO) + (size_t)l * XW * DM, XW, DM, (bf16*)(ws + WS_W_XO) + (size_t)l * DM * XW);
        transpose_mat_fold(F, KIN(IN_FFN_UP) + (size_t)l * DM * DFF2, DM, DFF2, (bf16*)(ws + WS_W_UP) + (size_t)l * DFF2 * DM, KIN(IN_LN_G) + (size_t)(3 * l + 1) * DM, KIN(IN_LN_B) + (size_t)(3 * l + 1) * DM, cs + FO_UP + l * DFF2, b2 + FO_UP + l * DFF2, 0, 1 << 30, 0, 1, true); }
    for (int l = 0; l < 2; ++l) {
        transpose_mat(F, KIN(IN_NSA_CMP_W1) + (size_t)l * 32 * HD * HD, 32 * HD, HD, (bf16*)(ws + WS_W_C1) + (size_t)l * HD * 32 * HD);
        transpose_mat(F, KIN(IN_NSA_CMP_W2) + (size_t)l * HD * HD, HD, HD, (bf16*)(ws + WS_W_C2) + (size_t)l * HD * HD);
    }
    cvt_flat(F, KIN(IN_X), (bf16*)(ws + WS_HB), (long)MTOK * DM / 8);
    cvt_flat(F, KIN(IN_MEM), (bf16*)(ws + WS_MEMB), (long)BATCH * NMEM * DM / 8);
    { v4u z = {0u, 0u, 0u, 0u}; v4u* p = (v4u*)((bf16*)(ws + WS_W_NSAIN) + (size_t)NSA_IN * DM); const long n = (long)(NSA_INP - NSA_IN) * DM / 8;
      for (long i = (long)F.bid * NTHR + F.tid; i < n; i += (long)F.G * NTHR) p[i] = z; }
    { float* tab = (float*)(ws + WS_ROPE);
      for (int i = F.bid * NTHR + F.tid; i < SEQ * 64; i += F.G * NTHR) { const int t = i >> 6, d = i & 63;
          float sn, cs; sincosf((float)t * powf(10000.0f, -(float)d * (1.0f / 64.0f)), &sn, &cs); tab[(size_t)t * 128 + d] = cs; tab[(size_t)t * 128 + 64 + d] = sn; } }
    { const float* lbp = KIN(IN_HGRN_LB); float* lbo = (float*)(ws + WS_LB);
      for (int i = F.bid * NTHR + F.tid; i < A_W; i += F.G * NTHR) { const float a = lbp[i], b = lbp[A_W + i], m = fmaxf(a, b), ea = __expf(a - m), eb = __expf(b - m); lbo[i] = ea / (ea + eb); } }
}

__device__ __forceinline__ void ln_phase(Frame& F, const bf16* Y, const float* g, const float* b, float* h32) {
    const int gw = F.bid * NWAVES + F.wave, NGW = F.G * NWAVES;
    for (int m = gw; m < MTOK; m += NGW) {
        const v4u* yr = (const v4u*)(Y + (size_t)m * DM) + F.lane;
        float v[8][8]; float s = 0.f;
#pragma unroll
        for (int j = 0; j < 8; ++j) { const v4u x = yr[64 * j];
            v[j][0] = bflo(x.x); v[j][1] = bfhi(x.x); v[j][2] = bflo(x.y); v[j][3] = bfhi(x.y); v[j][4] = bflo(x.z); v[j][5] = bfhi(x.z); v[j][6] = bflo(x.w); v[j][7] = bfhi(x.w);
#pragma unroll
            for (int q = 0; q < 8; ++q) s += v[j][q]; }
        const float mean = wave_sum(s) * (1.f / DM); float s2 = 0.f;
#pragma unroll
        for (int j = 0; j < 8; ++j)
#pragma unroll
            for (int q = 0; q < 8; ++q) { v[j][q] -= mean; s2 += v[j][q] * v[j][q]; }
        const float rstd = 1.f / sqrtf(wave_sum(s2) * (1.f / DM) + LN_EPS);
#pragma unroll
        for (int j = 0; j < 8; ++j) { const int c0 = 8 * F.lane + 512 * j;
            const f32x4 g0 = *(const f32x4*)(g + c0), g1 = *(const f32x4*)(g + c0 + 4), b0 = *(const f32x4*)(b + c0), b1 = *(const f32x4*)(b + c0 + 4);
            f32x4 r0, r1;
            r0.x = v[j][0] * rstd * g0.x + b0.x; r0.y = v[j][1] * rstd * g0.y + b0.y; r0.z = v[j][2] * rstd * g0.z + b0.z; r0.w = v[j][3] * rstd * g0.w + b0.w;
            r1.x = v[j][4] * rstd * g1.x + b1.x; r1.y = v[j][5] * rstd * g1.y + b1.y; r1.z = v[j][6] * rstd * g1.z + b1.z; r1.w = v[j][7] * rstd * g1.w + b1.w;
            *(f32x4*)(h32 + (size_t)m * DM + c0) = r0; *(f32x4*)(h32 + (size_t)m * DM + c0 + 4) = r1; }
    }
}

__device__ __forceinline__ void cg_unpack(const v4u x, float* o) { o[0] = bflo(x.x); o[1] = bfhi(x.x); o[2] = bflo(x.y); o[3] = bfhi(x.y); o[4] = bflo(x.z); o[5] = bfhi(x.z); o[6] = bflo(x.w); o[7] = bfhi(x.w); }
__device__ __forceinline__ void convglu_fixup_phase(Frame& F, const bf16* SIDE, const float* cw, bf16* Gm) {
    constexpr int NCG = DFF / 8, NRUN = MTOK / 128;
    for (int it = F.bid * NTHR + F.tid; it < NCG * NRUN; it += F.G * NTHR) {
        const int cg = it % NCG, run = it / NCG, c0 = cg * 8, t0 = run * 128;
        float w0[8], w1[8], w2[8], am2[8], am1[8], a0[8], a1[8], u0[8], u1[8];
#pragma unroll
        for (int j = 0; j < 8; ++j) { w0[j] = cw[c0 + j]; w1[j] = cw[DFF + c0 + j]; w2[j] = cw[2 * DFF + c0 + j]; }
        const bf16* sp = SIDE + (size_t)run * 6 * DFF + c0;
        if ((t0 & (SEQ - 1)) == 0) {
#pragma unroll
            for (int j = 0; j < 8; ++j) { am2[j] = 0.f; am1[j] = 0.f; }
        } else { cg_unpack(*(const v4u*)sp, am2); cg_unpack(*(const v4u*)(sp + DFF), am1); }
        cg_unpack(*(const v4u*)(sp + 2 * DFF), a0); cg_unpack(*(const v4u*)(sp + 3 * DFF), a1); cg_unpack(*(const v4u*)(sp + 4 * DFF), u0); cg_unpack(*(const v4u*)(sp + 5 * DFF), u1);
        unsigned o0[4], o1[4];
#pragma unroll
        for (int j = 0; j < 8; j += 2) {
            const pg8::f32x2 g0 = pg8::gelu_pk((pg8::f32x2){w2[j] * a0[j] + w1[j] * am1[j] + w0[j] * am2[j], w2[j + 1] * a0[j + 1] + w1[j + 1] * am1[j + 1] + w0[j + 1] * am2[j + 1]});
            const pg8::f32x2 g1 = pg8::gelu_pk((pg8::f32x2){w2[j] * a1[j] + w1[j] * a0[j] + w0[j] * am1[j], w2[j + 1] * a1[j + 1] + w1[j + 1] * a0[j + 1] + w0[j + 1] * am1[j + 1]});
            o0[j >> 1] = pk2(g0.x * u0[j], g0.y * u0[j + 1]); o1[j >> 1] = pk2(g1.x * u1[j], g1.y * u1[j + 1]); }
        *(v4u*)(Gm + (size_t)t0 * DFF + c0) = (v4u){o0[0], o0[1], o0[2], o0[3]}; *(v4u*)(Gm + (size_t)(t0 + 1) * DFF + c0) = (v4u){o1[0], o1[1], o1[2], o1[3]};
    }
}

__device__ __forceinline__ void xattn_phase(Frame& F, const bf16* XQ, const bf16* XKV, bf16* XO) {
    const int tid = F.tid, wid = F.wave, lane = F.lane, r32 = lane & 31, hi = lane >> 5;
    LAS char* lds = (LAS char*)F.lds;
    LAS float* wsc = (LAS float*)(lds + ATT_WS_OFF + wid * 256);
    const int vb0 = (int)(uintptr_t)(lds + ATT_V_OFF) + v_rd_base(lane);
    KVDma dm; kv_dma_init(dm, 2 * XW, 2 * XW, wid, lane);
    constexpr int NU = (MTOK / 256) * XH;
    for (int u = F.bid; u < NU; u += F.G) {
        const int head = u % XH, rbk = u / XH, row0 = rbk * 256, b = row0 / SEQ;
        const bf16* Kh = XKV + (size_t)b * NMEM * 2 * XW + head * HD; const bf16* Vh = Kh + XW;
        bf16x8 qr[8]; load_q(qr, XQ + (size_t)(row0 + wid * 32 + r32) * XW + head * HD + hi * 8);
        float m_reg = -1e30f, l_reg = 0.f; f32x16 o[4] = {};
        __syncthreads();
        kv_dma(dm, Kh, Vh, lds, 0, wid);
        for (int j = 0; j < NMEM / KVBLK; ++j) {
            const int buf = (j & 1) * ATT_BUF;
            VM_WAIT(); __syncthreads();
            if (j + 1 < NMEM / KVBLK) kv_dma(dm, Kh + (size_t)(j + 1) * KVBLK * 2 * XW, Vh + (size_t)(j + 1) * KVBLK * 2 * XW, lds, ATT_BUF - buf, wid);
            f32x16 p0, p1; qkt(p0, p1, lds + buf + ATT_K_OFF, qr, r32, hi);
            float alpha; softmax_tile(p0, p1, m_reg, l_reg, alpha);
            rescale_o(o, alpha, wsc, r32, hi);
            bf16x8 pa0, pa1, pa2, pa3; pack_p(p0, p1, pa0, pa1, pa2, pa3);
            pv_d0(o, vb0 + buf, pa0, pa1, pa2, pa3);
        }
        if (hi == 0) wsc[32 + r32] = l_reg; LDS_WAIT();
        bf16* Ow = XO + (size_t)(row0 + wid * 32) * XW + head * HD;
#pragma unroll
        for (int r = 0; r < 16; ++r) { const int orow = crow(r, hi); const float rl = __builtin_amdgcn_rcpf(wsc[32 + orow]);
#pragma unroll
            for (int d0 = 0; d0 < 4; ++d0) Ow[(size_t)orow * XW + d0 * 32 + r32] = (bf16)f2bf(o[d0][r] * rl); }
        LDS_WAIT();
    }
}

template <int K>
__device__ __forceinline__ f32x4 mma_tile(const LAS char* A, int lda, const LAS char* B, int ldb, int fr, int fq) {
    f32x4 acc = {0.f, 0.f, 0.f, 0.f};
#pragma unroll
    for (int k0 = 0; k0 < K; k0 += 32) {
        const bf16x8 a = *(const LAS bf16x8*)(A + fr * lda + (k0 + 8 * fq) * 2);
        const bf16x8 b = *(const LAS bf16x8*)(B + fr * ldb + (k0 + 8 * fq) * 2);
        acc = __builtin_amdgcn_mfma_f32_16x16x32_bf16(a, b, acc, 0, 0, 0);
    }
    return acc;
}
constexpr int HG_CH = 64, HG_NC = SEQ / HG_CH, HG_ITEMS = BATCH * A_HEADS * HG_NC;
constexpr int HG_QT = 0, HG_KT = 17408, HG_KH = 34816, HG_VT = 53248, HG_PT = 71680, HG_SEG = 80896;
constexpr int HG_SP = 17408, HG_OT = 52224;
constexpr int HG_WT = 80896, HG_KHS = 86016, HG_VS = 103424;
__device__ __forceinline__ void hgrn_phase_a(Frame& F, const bf16* P0, const float* lbv, bf16* QTg, bf16* OINTRA, bf16* DS, float* DEC) {
    LAS char* lds = (LAS char*)F.lds;
    const int tid = F.tid, wid = F.wave, lane = F.lane, fr = lane & 15, fq = lane >> 4;
    const int dg = tid & 15, sq = tid >> 4;
    const int d = tid & 127, sq16 = tid >> 7;
    for (int it = F.bid; it < HG_ITEMS; it += F.G) {
        const int c = it % HG_NC, bh = it / HG_NC, h = bh % A_HEADS, b = bh / A_HEADS;
        const size_t row0 = (size_t)b * SEQ + (size_t)c * HG_CH;
        float lb[8], q[2][8], kk[2][8], cum[2][8]; v4u vraw[2];
        { const f32x4 l0 = *(const f32x4*)(lbv + h * HD + 8 * dg), l1 = *(const f32x4*)(lbv + h * HD + 8 * dg + 4);
          lb[0] = l0.x; lb[1] = l0.y; lb[2] = l0.z; lb[3] = l0.w; lb[4] = l1.x; lb[5] = l1.y; lb[6] = l1.z; lb[7] = l1.w; }
#pragma unroll
        for (int rr = 0; rr < 2; ++rr) { const bf16* rowp = P0 + (row0 + 2 * sq + rr) * AB_IN + h * HD + 8 * dg;
            const v4u zq = *(const v4u*)(rowp + A_W), qq = *(const v4u*)rowp; vraw[rr] = *(const v4u*)(rowp + 2 * A_W);
            const unsigned zw[4] = {zq.x, zq.y, zq.z, zq.w}, qw[4] = {qq.x, qq.y, qq.z, qq.w};
#pragma unroll
            for (int j = 0; j < 8; ++j) { const float z = (j & 1) ? bfhi(zw[j >> 1]) : bflo(zw[j >> 1]); q[rr][j] = (j & 1) ? bfhi(qw[j >> 1]) : bflo(qw[j >> 1]);
                const float sg = sigmoidf_(z), omlb = 1.f - lb[j]; kk[rr][j] = omlb * (1.f - sg);
                const float lf = __logf(lb[j] + omlb * sg); cum[rr][j] = rr ? cum[0][j] + lf : lf; } }
        float pre[8];
#pragma unroll
        for (int j = 0; j < 8; ++j) { const float seg = cum[1][j]; float x = seg; const float t1 = __shfl_up(x, 16); if (lane >= 16) x += t1; const float t2 = __shfl_up(x, 32); if (lane >= 32) x += t2;
            pre[j] = x - seg; if (lane >= 48) ((LAS float*)(lds + HG_WT))[wid * 128 + 8 * dg + j] = x; }
        LDS_WAIT(); __syncthreads();
        float total[8];
#pragma unroll
        for (int j = 0; j < 8; ++j) total[j] = 0.f;
#pragma unroll
        for (int w = 0; w < NWAVES; ++w) { const f32x4 a0 = *(const LAS f32x4*)(lds + HG_WT + (w * 128 + 8 * dg) * 4), a1 = *(const LAS f32x4*)(lds + HG_WT + (w * 128 + 8 * dg + 4) * 4);
            const float av[8] = {a0.x, a0.y, a0.z, a0.w, a1.x, a1.y, a1.z, a1.w};
#pragma unroll
            for (int j = 0; j < 8; ++j) { total[j] += av[j]; if (w < wid) pre[j] += av[j]; } }
#pragma unroll
        for (int rr = 0; rr < 2; ++rr) { const int s = 2 * sq + rr; unsigned qt[4], kt[4], kh[4];
#pragma unroll
            for (int j = 0; j < 8; j += 2) { const float b0 = pre[j] + cum[rr][j], b1 = pre[j + 1] + cum[rr][j + 1];
                qt[j >> 1] = pk2(q[rr][j] * __expf(b0), q[rr][j + 1] * __expf(b1));
                kt[j >> 1] = pk2(kk[rr][j] * __expf(-b0), kk[rr][j + 1] * __expf(-b1));
                kh[j >> 1] = pk2(kk[rr][j] * __expf(total[j] - b0), kk[rr][j + 1] * __expf(total[j + 1] - b1)); }
            const v4u qv = {qt[0], qt[1], qt[2], qt[3]};
            *(LAS v4u*)(lds + HG_QT + s * 272 + dg * 16) = qv; *(v4u*)(QTg + (row0 + s) * A_W + h * HD + 8 * dg) = qv;
            *(LAS v4u*)(lds + HG_KT + s * 272 + dg * 16) = (v4u){kt[0], kt[1], kt[2], kt[3]};
            *(LAS v4u*)(lds + HG_KHS + s * 272 + dg * 16) = (v4u){kh[0], kh[1], kh[2], kh[3]};
            *(LAS v4u*)(lds + HG_VS + s * 272 + dg * 16) = vraw[rr]; }
        if (sq == 31) { f32x4 e0, e1; e0.x = __expf(total[0]); e0.y = __expf(total[1]); e0.z = __expf(total[2]); e0.w = __expf(total[3]); e1.x = __expf(total[4]); e1.y = __expf(total[5]); e1.z = __expf(total[6]); e1.w = __expf(total[7]);
            *(f32x4*)(DEC + (size_t)it * HD + 8 * dg) = e0; *(f32x4*)(DEC + (size_t)it * HD + 8 * dg + 4) = e1; }
        LDS_WAIT(); __syncthreads();
        { unsigned kh[8], vt[8];
#pragma unroll
          for (int j = 0; j < 16; j += 2) { const int s = 16 * sq16 + j;
              kh[j >> 1] = (unsigned)*(const LAS unsigned short*)(lds + HG_KHS + s * 272 + d * 2) | ((unsigned)*(const LAS unsigned short*)(lds + HG_KHS + (s + 1) * 272 + d * 2) << 16);
              vt[j >> 1] = (unsigned)*(const LAS unsigned short*)(lds + HG_VS + s * 272 + d * 2) | ((unsigned)*(const LAS unsigned short*)(lds + HG_VS + (s + 1) * 272 + d * 2) << 16); }
          LAS v4u* pk = (LAS v4u*)(lds + HG_KH + d * 144 + sq16 * 32); pk[0] = (v4u){kh[0], kh[1], kh[2], kh[3]}; pk[1] = (v4u){kh[4], kh[5], kh[6], kh[7]};
          LAS v4u* pv = (LAS v4u*)(lds + HG_VT + d * 144 + sq16 * 32); pv[0] = (v4u){vt[0], vt[1], vt[2], vt[3]}; pv[1] = (v4u){vt[4], vt[5], vt[6], vt[7]}; }
        LDS_WAIT(); __syncthreads();
#pragma unroll
        for (int k = 0; k < 2; ++k) { const int tau = 2 * wid + k, ti = tau >> 2, si = tau & 3;
            f32x4 acc = {0.f, 0.f, 0.f, 0.f};
            if (si <= ti) acc = mma_tile<128>(lds + HG_QT + ti * 16 * 272, 272, lds + HG_KT + si * 16 * 272, 272, fr, fq);
#pragma unroll
            for (int i = 0; i < 4; ++i) { const int t = 16 * ti + 4 * fq + i, s = 16 * si + fr; const float v = (s <= t) ? acc[i] : 0.f;
                *(LAS unsigned short*)(lds + HG_PT + t * 144 + s * 2) = (unsigned short)f2bf(v); } }
        LDS_WAIT(); __syncthreads();
#pragma unroll
        for (int k = 0; k < 4; ++k) { const int tau = wid + 8 * k, ti = tau >> 3, vi = tau & 7;
            const f32x4 acc = mma_tile<64>(lds + HG_VT + vi * 16 * 144, 144, lds + HG_PT + ti * 16 * 144, 144, fr, fq);
            v2u w; w.x = pk2(acc[0], acc[1]); w.y = pk2(acc[2], acc[3]);
            *(v2u*)(OINTRA + (row0 + 16 * ti + fr) * A_W + h * HD + 16 * vi + 4 * fq) = w; }
#pragma unroll
        for (int k = 0; k < 8; ++k) { const int tau = wid + 8 * k, vi = tau >> 3, ki = tau & 7;
            const f32x4 acc = mma_tile<64>(lds + HG_KH + ki * 16 * 144, 144, lds + HG_VT + vi * 16 * 144, 144, fr, fq);
            v2u w; w.x = pk2(acc[0], acc[1]); w.y = pk2(acc[2], acc[3]);
            *(v2u*)(DS + ((size_t)it * HD + 16 * vi + fr) * HD + 16 * ki + 4 * fq) = w; }
        LDS_WAIT(); __syncthreads();
    }
}
__device__ __forceinline__ void hgrn_phase_b(Frame& F, const bf16* DS, const float* DEC, bf16* SPREV) {
    const int tid = F.tid, dvl = tid >> 5, dk4 = (tid & 31) * 4;
    for (int item = F.bid; item < BATCH * A_HEADS * 8; item += F.G) {
        const int sl = item & 7, bh = item >> 3, dv = sl * 16 + dvl;
        f32x4 S = {0.f, 0.f, 0.f, 0.f};
        for (int c0 = 0; c0 < HG_NC; c0 += 8) {
            f32x4 ds[8], dc[8];
#pragma unroll
            for (int k = 0; k < 8; ++k) { const size_t it = (size_t)bh * HG_NC + c0 + k; const v2u x = *(const v2u*)(DS + (it * HD + dv) * HD + dk4);
                ds[k] = (f32x4){bflo(x.x), bfhi(x.x), bflo(x.y), bfhi(x.y)}; dc[k] = *(const f32x4*)(DEC + it * HD + dk4); }
#pragma unroll
            for (int k = 0; k < 8; ++k) { const size_t it = (size_t)bh * HG_NC + c0 + k;
                v2u w; w.x = pk2(S.x, S.y); w.y = pk2(S.z, S.w); *(v2u*)(SPREV + (it * HD + dv) * HD + dk4) = w;
                S = S * dc[k] + ds[k]; }
        }
    }
}
__device__ __forceinline__ void hgrn_phase_c(Frame& F, const bf16* P0, const bf16* QTg, const bf16* OINTRA, const bf16* SPREV, const float* nw, bf16* Ob) {
    LAS char* lds = (LAS char*)F.lds;
    const int tid = F.tid, wid = F.wave, lane = F.lane, fr = lane & 15, fq = lane >> 4;
    for (int it = F.bid; it < HG_ITEMS; it += F.G) {
        const int c = it % HG_NC, bh = it / HG_NC, h = bh % A_HEADS, b = bh / A_HEADS;
        const size_t row0 = (size_t)b * SEQ + (size_t)c * HG_CH;
        { const int s = tid >> 3, ch = (tid & 7) * 16; const bf16* src = QTg + (row0 + s) * A_W + h * HD + ch;
          const v4u x0 = *(const v4u*)src, x1 = *(const v4u*)(src + 8); LAS v4u* dst = (LAS v4u*)(lds + HG_QT + s * 272 + ch * 2); dst[0] = x0; dst[1] = x1; }
        { const int dv = tid >> 2, ch = (tid & 3) * 32; const bf16* src = SPREV + ((size_t)it * HD + dv) * HD + ch;
          const v4u x0 = *(const v4u*)src, x1 = *(const v4u*)(src + 8), x2 = *(const v4u*)(src + 16), x3 = *(const v4u*)(src + 24);
          LAS v4u* dst = (LAS v4u*)(lds + HG_SP + dv * 272 + ch * 2); dst[0] = x0; dst[1] = x1; dst[2] = x2; dst[3] = x3; }
        LDS_WAIT(); __syncthreads();
#pragma unroll
        for (int k = 0; k < 4; ++k) { const int tau = wid + 8 * k, ti = tau >> 3, vi = tau & 7;
            const f32x4 acc = mma_tile<128>(lds + HG_SP + vi * 16 * 272, 272, lds + HG_QT + ti * 16 * 272, 272, fr, fq);
            const int t = 16 * ti + fr, dv = 16 * vi + 4 * fq; const v2u oi = *(const v2u*)(OINTRA + (row0 + t) * A_W + h * HD + dv);
            *(LAS f32x4*)(lds + HG_OT + (t * 132 + dv) * 4) = (f32x4){acc[0] + bflo(oi.x), acc[1] + bfhi(oi.x), acc[2] + bflo(oi.y), acc[3] + bfhi(oi.y)}; }
        LDS_WAIT(); __syncthreads();
        { const int t = tid >> 3, dv0 = (tid & 7) * 16;
          float v[16]; float ss = 0.f;
#pragma unroll
          for (int q4 = 0; q4 < 4; ++q4) { const f32x4 x = *(const LAS f32x4*)(lds + HG_OT + (t * 132 + dv0 + 4 * q4) * 4); v[4 * q4] = x.x; v[4 * q4 + 1] = x.y; v[4 * q4 + 2] = x.z; v[4 * q4 + 3] = x.w;
              ss += (x.x * x.x + x.y * x.y) + (x.z * x.z + x.w * x.w); }
          ss += __shfl_xor(ss, 1); ss += __shfl_xor(ss, 2); ss += __shfl_xor(ss, 4);
          const float r = 1.f / sqrtf(ss * (1.f / HD) + RMS_EPS);
          const bf16* gp = P0 + (row0 + t) * AB_IN + 3 * A_W + h * HD + dv0; const v4u g0 = *(const v4u*)gp, g1 = *(const v4u*)(gp + 8);
          const unsigned gw[8] = {g0.x, g0.y, g0.z, g0.w, g1.x, g1.y, g1.z, g1.w}; unsigned o[8];
#pragma unroll
          for (int j = 0; j < 8; ++j) { const float ga = bflo(gw[j]), gb = bfhi(gw[j]);
              o[j] = pk2(v[2 * j] * r * nw[dv0 + 2 * j] * ga * sigmoidf_(ga), v[2 * j + 1] * r * nw[dv0 + 2 * j + 1] * gb * sigmoidf_(gb)); }
          bf16* op = Ob + (row0 + t) * DM + h * HD + dv0; *(v4u*)op = (v4u){o[0], o[1], o[2], o[3]}; *(v4u*)(op + 8) = (v4u){o[4], o[5], o[6], o[7]}; }
        LDS_WAIT(); __syncthreads();
    }
}

constexpr float SB_CUT = -160.f;
__device__ __forceinline__ void sb_phase(Frame& F, const bf16* P0, bf16* Ob) {
    const int tid = F.tid, wid = F.wave, lane = F.lane, r32 = lane & 31, hi = lane >> 5;
    LAS char* lds = (LAS char*)F.lds;
    const int vb0 = (int)(uintptr_t)(lds + ATT_V_OFF) + v_rd_base(lane);
    KVDma dm; kv_dma_init(dm, AB_IN, AB_IN, wid, lane);
    constexpr int NQB = SEQ / 256, NU = BATCH * B_HEADS * NQB;
    for (int rd = 0; ; ++rd) {
        const int idx = (rd & 1) ? rd * F.G + (F.G - 1 - F.bid) : rd * F.G + F.bid;
        if (rd * F.G >= NU) break;
        if (idx >= NU) continue;
        const int qb = NQB - 1 - idx / (BATCH * B_HEADS), bh = idx % (BATCH * B_HEADS), head = bh % B_HEADS, b = bh / B_HEADS;
        const size_t rowb = (size_t)b * SEQ; const int q0 = qb * 256;
        const bf16* Kh = P0 + rowb * AB_IN + 4 * A_W + B_W + head * HD; const bf16* Vh = Kh + B_W;
        const int tw0 = q0 + wid * 32, t = tw0 + r32;
        bf16x8 qr[8]; load_q(qr, P0 + (rowb + t) * AB_IN + 4 * A_W + head * HD + hi * 8);
        float R = 0.f; f32x16 o[4] = {};
        const int jtop = (q0 + 254) >> 6;
        LAS unsigned* dflag = (LAS unsigned*)(lds + ATT_X_OFF);
        if (lane == 0) { dflag[wid] = 0u; dflag[8 + wid] = 0u; }
        LDS_WAIT(); __syncthreads();
        kv_dma(dm, Kh + (size_t)jtop * KVBLK * AB_IN, Vh + (size_t)jtop * KVBLK * AB_IN, lds, 0, wid);
        int buf = 0;
        for (int j = jtop; j >= 0; --j, buf = ATT_BUF - buf) {
            VM_WAIT(); __syncthreads();
            { unsigned alld = 1u;
#pragma unroll
              for (int w = 0; w < NWAVES; ++w) alld &= dflag[((j + 1) & 1) * 8 + w];
              if (__builtin_amdgcn_readfirstlane(alld)) break; }
            if (j > 0) kv_dma(dm, Kh + (size_t)(j - 1) * KVBLK * AB_IN, Vh + (size_t)(j - 1) * KVBLK * AB_IN, lds, ATT_BUF - buf, wid);
            const int k0 = j * KVBLK;
            if (k0 < tw0 + 31) {
                f32x16 p0, p1; qkt(p0, p1, lds + buf + ATT_K_OFF, qr, r32, hi);
                const bool need_mask = (k0 + 63 >= tw0);
                float L0[16], L1[16];
#pragma unroll
                for (int r = 0; r < 16; ++r) {
                    const float z0 = p0[r] * ATT_C, z1 = p1[r] * ATT_C;
                    float l0 = -(fmaxf(z0, 0.f) + __builtin_amdgcn_logf(1.f + __builtin_amdgcn_exp2f(-fabsf(z0))));
                    float l1 = -(fmaxf(z1, 0.f) + __builtin_amdgcn_logf(1.f + __builtin_amdgcn_exp2f(-fabsf(z1))));
                    if (need_mask) { if (k0 + crow(r, hi) >= t) l0 = 0.f; if (k0 + 32 + crow(r, hi) >= t) l1 = 0.f; }
                    L0[r] = l0; L1[r] = l1; p0[r] = z0 + l0; p1[r] = z1 + l1;
                }
                SBAR();
                float Sg[16];
#pragma unroll
                for (int gi = 0; gi < 4; ++gi) {
                    const float a = (L0[4 * gi] + L0[4 * gi + 1]) + (L0[4 * gi + 2] + L0[4 * gi + 3]), c = (L1[4 * gi] + L1[4 * gi + 1]) + (L1[4 * gi + 2] + L1[4 * gi + 3]);
                    auto ra = __builtin_amdgcn_permlane32_swap(__float_as_uint(a), __float_as_uint(a), false, false);
                    auto rc = __builtin_amdgcn_permlane32_swap(__float_as_uint(c), __float_as_uint(c), false, false);
                    Sg[2 * gi] = __uint_as_float(ra[0]); Sg[2 * gi + 1] = __uint_as_float(ra[1]); Sg[8 + 2 * gi] = __uint_as_float(rc[0]); Sg[8 + 2 * gi + 1] = __uint_as_float(rc[1]);
                }
                float run = R;
#pragma unroll
                for (int s = 15; s >= 0; --s) { const float tt = run; run += Sg[s]; Sg[s] = tt; }
                const float Rn = run;
                SBAR();
#pragma unroll
                for (int gi = 0; gi < 4; ++gi) {
                    float base0 = hi ? Sg[2 * gi + 1] : Sg[2 * gi], base1 = hi ? Sg[8 + 2 * gi + 1] : Sg[8 + 2 * gi];
                    float r3 = base0, r2 = r3 + L0[4 * gi + 3], r1 = r2 + L0[4 * gi + 2], r0 = r1 + L0[4 * gi + 1];
                    p0[4 * gi + 3] = __builtin_amdgcn_exp2f(p0[4 * gi + 3] + r3); p0[4 * gi + 2] = __builtin_amdgcn_exp2f(p0[4 * gi + 2] + r2);
                    p0[4 * gi + 1] = __builtin_amdgcn_exp2f(p0[4 * gi + 1] + r1); p0[4 * gi + 0] = __builtin_amdgcn_exp2f(p0[4 * gi + 0] + r0);
                    r3 = base1; r2 = r3 + L1[4 * gi + 3]; r1 = r2 + L1[4 * gi + 2]; r0 = r1 + L1[4 * gi + 1];
                    p1[4 * gi + 3] = __builtin_amdgcn_exp2f(p1[4 * gi + 3] + r3); p1[4 * gi + 2] = __builtin_amdgcn_exp2f(p1[4 * gi + 2] + r2);
                    p1[4 * gi + 1] = __builtin_amdgcn_exp2f(p1[4 * gi + 1] + r1); p1[4 * gi + 0] = __builtin_amdgcn_exp2f(p1[4 * gi + 0] + r0);
                }
                R = Rn;
                { const unsigned dn = __all(R < SB_CUT) ? 1u : 0u; if (lane == 0) dflag[(j & 1) * 8 + wid] = dn; }
                if (need_mask) {
#pragma unroll
                    for (int r = 0; r < 16; ++r) { if (k0 + crow(r, hi) >= t) p0[r] = 0.f; if (k0 + 32 + crow(r, hi) >= t) p1[r] = 0.f; }
                }
                bf16x8 pa0, pa1, pa2, pa3; pack_p(p0, p1, pa0, pa1, pa2, pa3);
                pv_d0(o, vb0 + buf, pa0, pa1, pa2, pa3);
            }
        }
        bf16* Ow = Ob + (rowb + tw0) * DM + A_W + head * HD;
#pragma unroll
        for (int r = 0; r < 16; ++r) { const int orow = crow(r, hi);
#pragma unroll
            for (int d0 = 0; d0 < 4; ++d0) Ow[(size_t)orow * DM + d0 * 32 + r32] = (bf16)f2bf(o[d0][r]); }
    }
}

constexpr int P1_KC = 4096, P1_VC = 4608, P1_KS = 5120, P1_VS = 5632, P1_KW = 6144, P1_VW = 6656, P1_GL = 7168;
__device__ __forceinline__ void nsa_rope_phase(Frame& F, const bf16* P1, const float* TAB, bf16* QROT, bf16* KSROT, bf16* KWROT, bf16* OVL) {
    const int gw = F.bid * NWAVES + F.wave, NGW = F.G * NWAVES, lane = F.lane, hsub = lane >> 3, d0 = (lane & 7) * 8;
    for (int m = gw; m < MTOK; m += NGW) {
        const int t = m & (SEQ - 1);
        const f32x4 c0 = *(const f32x4*)(TAB + (size_t)t * 128 + d0), c1 = *(const f32x4*)(TAB + (size_t)t * 128 + d0 + 4);
        const f32x4 s0 = *(const f32x4*)(TAB + (size_t)t * 128 + 64 + d0), s1 = *(const f32x4*)(TAB + (size_t)t * 128 + 64 + d0 + 4);
        const float cs[8] = {c0.x, c0.y, c0.z, c0.w, c1.x, c1.y, c1.z, c1.w}, sn[8] = {s0.x, s0.y, s0.z, s0.w, s1.x, s1.y, s1.z, s1.w};
        const bf16* row = P1 + (size_t)m * NSA_INP;
#pragma unroll
        for (int hb = 0; hb < 5; ++hb) {
            const int hh = hb * 8 + hsub;
            const bf16* src; bf16* dst;
            if (hh < 32) { src = row + hh * HD; dst = QROT + (size_t)m * DM + hh * HD; }
            else if (hh < 36) { src = row + P1_KS + (hh - 32) * HD; dst = KSROT + (size_t)m * KVW + (hh - 32) * HD; }
            else { src = row + P1_KW + (hh - 36) * HD; dst = KWROT + (size_t)m * KVW + (hh - 36) * HD; }
            const v4u a = *(const v4u*)(src + d0), bq = *(const v4u*)(src + 64 + d0);
            const unsigned aw[4] = {a.x, a.y, a.z, a.w}, bw[4] = {bq.x, bq.y, bq.z, bq.w}; unsigned o1[4], o2[4];
#pragma unroll
            for (int q = 0; q < 4; ++q) { const float x1l = bflo(aw[q]), x1h = bfhi(aw[q]), x2l = bflo(bw[q]), x2h = bfhi(bw[q]);
                o1[q] = pk2(x1l * cs[2 * q] - x2l * sn[2 * q], x1h * cs[2 * q + 1] - x2h * sn[2 * q + 1]);
                o2[q] = pk2(x2l * cs[2 * q] + x1l * sn[2 * q], x2h * cs[2 * q + 1] + x1h * sn[2 * q + 1]); }
            *(v4u*)(dst + d0) = (v4u){o1[0], o1[1], o1[2], o1[3]}; *(v4u*)(dst + 64 + d0) = (v4u){o2[0], o2[1], o2[2], o2[3]};
        }
    }
    for (int i = F.bid * NTHR + F.tid; i < NCMPP * NSLC; i += F.G * NTHR) { const int n = i / NSLC, j = i % NSLC;
        OVL[i] = (n < NCMP && n >= 4 * j - 1 && n <= 4 * j + 3) ? (bf16)0x3f80u : (bf16)0u; }
}
constexpr int CM_A = 0, CM_B = 17408, CM_H = 17408 + 34816;
__device__ __forceinline__ void nsa_compress_phase(Frame& F, const bf16* P1, const float* pos, const bf16* W1t, const bf16* W2t, bf16* KCMP, bf16* VCMP) {
    LAS char* lds = (LAS char*)F.lds;
    const int tid = F.tid, wid = F.wave, lane = F.lane, fr = lane & 15, fq = lane >> 4;
    for (int item = F.bid; item < 128; item += F.G) {
        const int nt = item & 7, g = (item >> 3) & 3, b = (item >> 5) & 1, which = item >> 6;
        const bf16* w1 = W1t + (size_t)which * HD * 32 * HD; const bf16* w2 = W2t + (size_t)which * HD * HD;
        const float* posw = pos + (size_t)which * 32 * HD;
        f32x4 acc[4];
#pragma unroll
        for (int k = 0; k < 4; ++k) acc[k] = (f32x4){0.f, 0.f, 0.f, 0.f};
        for (int l = 0; l < 32; ++l) {
            { const int r = tid >> 3, ch = (tid & 7) * 16, n = nt * 64 + r; unsigned w[8];
              if (n < NCMP) { const bf16* src = P1 + ((size_t)b * SEQ + 16 * n + l) * NSA_INP + P1_KC + which * KVW + g * HD + ch;
                  const v4u x0 = *(const v4u*)src, x1 = *(const v4u*)(src + 8); const unsigned xs[8] = {x0.x, x0.y, x0.z, x0.w, x1.x, x1.y, x1.z, x1.w};
#pragma unroll
                  for (int q = 0; q < 8; ++q) w[q] = pk2(bflo(xs[q]) + posw[l * HD + ch + 2 * q], bfhi(xs[q]) + posw[l * HD + ch + 2 * q + 1]);
              } else {
#pragma unroll
                  for (int q = 0; q < 8; ++q) w[q] = 0u; }
              LAS v4u* dst = (LAS v4u*)(lds + CM_A + r * 272 + ch * 2); dst[0] = (v4u){w[0], w[1], w[2], w[3]}; dst[1] = (v4u){w[4], w[5], w[6], w[7]}; }
            { const int e = tid >> 2, ch = (tid & 3) * 32; const bf16* src = w1 + (size_t)e * 32 * HD + l * HD + ch;
              const v4u x0 = *(const v4u*)src, x1 = *(const v4u*)(src + 8), x2 = *(const v4u*)(src + 16), x3 = *(const v4u*)(src + 24);
              LAS v4u* dst = (LAS v4u*)(lds + CM_B + e * 272 + ch * 2); dst[0] = x0; dst[1] = x1; dst[2] = x2; dst[3] = x3; }
            LDS_WAIT(); __syncthreads();
#pragma unroll
            for (int k = 0; k < 4; ++k) { const int tau = wid + 8 * k, ni = tau >> 3, ei = tau & 7;
                acc[k] += mma_tile<128>(lds + CM_A + ni * 16 * 272, 272, lds + CM_B + ei * 16 * 272, 272, fr, fq); }
            LDS_WAIT(); __syncthreads();
        }
#pragma unroll
        for (int k = 0; k < 4; ++k) { const int tau = wid + 8 * k, ni = tau >> 3, ei = tau & 7;
#pragma unroll
            for (int i = 0; i < 4; ++i) *(LAS unsigned short*)(lds + CM_H + (16 * ni + 4 * fq + i) * 272 + (16 * ei + fr) * 2) = (unsigned short)f2bf(gelu1(acc[k][i])); }
        { const int f = tid >> 2, ch = (tid & 3) * 32; const bf16* src = w2 + (size_t)f * HD + ch;
          const v4u x0 = *(const v4u*)src, x1 = *(const v4u*)(src + 8), x2 = *(const v4u*)(src + 16), x3 = *(const v4u*)(src + 24);
          LAS v4u* dst = (LAS v4u*)(lds + CM_B + f * 272 + ch * 2); dst[0] = x0; dst[1] = x1; dst[2] = x2; dst[3] = x3; }
        LDS_WAIT(); __syncthreads();
        bf16* outp = which ? VCMP : KCMP;
#pragma unroll
        for (int k = 0; k < 4; ++k) { const int tau = wid + 8 * k, ni = tau >> 3, fi = tau & 7;
            const f32x4 a2 = mma_tile<128>(lds + CM_H + ni * 16 * 272, 272, lds + CM_B + fi * 16 * 272, 272, fr, fq);
#pragma unroll
            for (int i = 0; i < 4; ++i) { const int n = nt * 64 + 16 * ni + 4 * fq + i;
                outp[(((size_t)b * NCMPP + n) * NSA_G + g) * HD + 16 * fi + fr] = (n < NCMP) ? (bf16)f2bf(a2[i]) : (bf16)0u; } }
        LDS_WAIT(); __syncthreads();
    }
}
__device__ __forceinline__ unsigned topk_key(float v) { const unsigned u = (v == 0.f) ? 0u : __builtin_bit_cast(unsigned, v); return u ^ ((u >> 31) ? 0xffffffffu : 0x80000000u); }
__device__ __forceinline__ v4u topk_select(float a0, float a1, int cur, int lane) {
    const unsigned k0 = topk_key(a0), k1 = topk_key(a1);
    const int j0 = lane, j1 = lane + 64;
    const bool f0 = (j0 == 0) || (j0 == cur) || (j0 == cur - 1), f1 = (j1 == cur) || (j1 == cur - 1);
    const unsigned long long c0m = __ballot(!f0 && j0 <= cur), c1m = __ballot(!f1 && j1 <= cur);
    const int nforced = cur >= 2 ? 3 : cur + 1, slots = NTOP - nforced;
    unsigned long long s0m = c0m, s1m = c1m;
    if (__builtin_popcountll(c0m) + __builtin_popcountll(c1m) > slots) {
        unsigned T = 0u;
#pragma nounroll
        for (int bit = 31; bit >= 0; --bit) { const unsigned trial = T | (1u << bit);
            const int cnt = __builtin_popcountll(__ballot(k0 >= trial) & c0m) + __builtin_popcountll(__ballot(k1 >= trial) & c1m);
            if (cnt >= slots) T = trial; }
        unsigned long long e0 = __ballot(k0 == T) & c0m, e1 = __ballot(k1 == T) & c1m;
        s0m = __ballot(k0 > T) & c0m; s1m = __ballot(k1 > T) & c1m;
        int need = slots - __builtin_popcountll(s0m) - __builtin_popcountll(s1m);
        while (need > 0 && e0) { const unsigned long long b = e0 & (~e0 + 1ull); s0m |= b; e0 ^= b; --need; }
        while (need > 0 && e1) { const unsigned long long b = e1 & (~e1 + 1ull); s1m |= b; e1 ^= b; --need; }
    }
    const unsigned long long m0 = s0m | __ballot(f0 && j0 <= cur), m1 = s1m | __ballot(f1 && j1 <= cur);
    return (v4u){(unsigned)m0, (unsigned)(m0 >> 32), (unsigned)m1, (unsigned)(m1 >> 32)};
}
__device__ __forceinline__ unsigned pick4(const unsigned (&a)[4], int i) { return i == 0 ? a[0] : (i == 1 ? a[1] : (i == 2 ? a[2] : a[3])); }
template <int MODE>
__device__ __forceinline__ void nsa_attn_phase(Frame& F, const bf16* P1, const bf16* Qsrc, const bf16* Ksrc, const bf16* Vsrc, const unsigned* SEL, float* O32, unsigned* IMPO, bf16* Ob, bool probe_nostore = false) {
    const int tid = F.tid, wid = F.wave, lane = F.lane, r32 = lane & 31, hi = lane >> 5;
    LAS char* lds = (LAS char*)F.lds;
    LAS float* wsc = (LAS float*)(lds + ATT_WS_OFF + wid * 256);
    const int vb0 = (int)(uintptr_t)(lds + ATT_V_OFF) + v_rd_base(lane);
    KVDma dm; kv_dma_init(dm, MODE <= 1 ? NSA_G * HD : KVW, MODE == 0 ? NSA_G * HD : (MODE == 1 ? NSLC : NSA_INP), wid, lane);
    constexpr int NTB = SEQ / 32, NU = BATCH * NSA_G * NTB;
    for (int rd = 0; ; ++rd) {
        int idx;
        { idx = (rd & 1) ? rd * F.G + (F.G - 1 - F.bid) : rd * F.G + F.bid; if (rd * F.G >= NU) break; if (idx >= NU) continue; }
        const int tb = NTB - 1 - idx / (BATCH * NSA_G), bg = idx % (BATCH * NSA_G), g = bg % NSA_G, b = bg / NSA_G;
        const size_t rowb = (size_t)b * SEQ; const int t0 = tb * 32;
        const int t = (MODE == 2) ? t0 + 4 * wid + (r32 >> 3) : t0 + r32, head = (MODE == 2) ? g * NSA_R + (r32 & 7) : g * NSA_R + wid;
        const bf16* Kh; const bf16* Vh; long ldk, ldv; int jlo, jhi;
        if (MODE <= 1) { Kh = Ksrc + ((size_t)b * NCMPP * NSA_G + g) * HD; ldk = NSA_G * HD; jlo = 0; jhi = (t0 >> 4) >> 6;
            if (MODE == 0) { Vh = Vsrc + ((size_t)b * NCMPP * NSA_G + g) * HD; ldv = NSA_G * HD; } else { Vh = Vsrc; ldv = NSLC; } }
        else { Kh = Ksrc + rowb * KVW + g * HD; ldk = KVW; Vh = P1 + rowb * NSA_INP + (MODE == 2 ? P1_VS : P1_VW) + g * HD; ldv = NSA_INP;
            jhi = (t0 + 31) >> 6; jlo = (MODE == 2) ? 0 : ((t0 - (WINDOW - 1) > 0 ? t0 - (WINDOW - 1) : 0) >> 6); }
        unsigned wn[4] = {~0u, ~0u, ~0u, ~0u};
        if (MODE == 2) { const v4u sv = *(const v4u*)(SEL + ((rowb + t) * NSA_G + g) * 4); unsigned selw[4]; selw[0] = sv.x; selw[1] = sv.y; selw[2] = sv.z; selw[3] = sv.w;
            *(LAS v4u*)(lds + ATT_X_OFF + 2048 + (wid * 64 + lane) * 16) = sv;
            LAS unsigned* un = (LAS unsigned*)(lds + ATT_X_OFF);
#pragma unroll
            for (int q = 0; q < 4; ++q) { unsigned x = selw[q]; x |= __shfl_xor(x, 8); x |= __shfl_xor(x, 16); wn[q] = __builtin_amdgcn_readfirstlane(x); if (lane == 0) un[wid * 4 + q] = wn[q]; }
            LDS_WAIT(); __syncthreads();
            LAS int* plist = (LAS int*)(lds + ATT_X_OFF + 128);
            if (wid == 0) {
                unsigned m0 = 0u, m1 = 0u;
                int lane_l = lane; asm volatile("" : "+v"(lane_l));
                const LAS unsigned* ub = un + (lane_l >> 5);
#pragma unroll
                for (int w = 0; w < NWAVES; ++w) { m0 |= ((ub[w * 4] >> (lane & 31)) & 1u) << w; m1 |= ((ub[w * 4 + 2] >> (lane & 31)) & 1u) << w; }
                bool v0 = m0 != 0u && lane <= jhi, v1 = m1 != 0u && lane + 64 <= jhi; int np = 0;
                for (;;) {
                    const unsigned long long a0 = __ballot(v0), a1 = __ballot(v1);
                    if (!(a0 | a1)) break;
                    const int ja_ = a0 ? __builtin_ctzll(a0) : 64 + __builtin_ctzll(a1);
                    const unsigned ma = (ja_ < 64) ? (unsigned)__shfl((int)m0, ja_) : (unsigned)__shfl((int)m1, ja_ - 64);
                    if (lane == (ja_ & 63)) { if (ja_ < 64) v0 = false; else v1 = false; }
                    unsigned long long c0 = __ballot(v0 && !(m0 & ma)), c1 = __ballot(v1 && !(m1 & ma));
                    if (!(c0 | c1)) { c0 = __ballot(v0 && m0 == 0xffu); c1 = __ballot(v1 && m1 == 0xffu); }
                    if (!(c0 | c1)) { c0 = __ballot(v0); c1 = __ballot(v1); }
                    int jb_ = -1;
                    if (c0 | c1) { jb_ = c0 ? __builtin_ctzll(c0) : 64 + __builtin_ctzll(c1); if (lane == (jb_ & 63)) { if (jb_ < 64) v0 = false; else v1 = false; } }
                    if (lane == 0) { plist[2 * np] = ja_; plist[2 * np + 1] = jb_; }
                    ++np;
                }
                if (lane == 0) { int neg1 = -1; asm volatile("" : "+v"(neg1)); plist[2 * np] = neg1; plist[2 * np + 1] = neg1; }
            }
            LDS_WAIT(); }
        bf16x8 qr[8]; load_q(qr, Qsrc + (rowb + t) * (MODE <= 1 ? NSA_INP : DM) + head * HD + hi * 8);
        float m_reg = -1e30f, l_reg = 0.f; f32x16 o[4] = {};
        const int cur = t >> 6;
#define NSA_NEED(jj) (MODE != 2 || ((pick4(wn, (jj) >> 5) >> ((jj) & 31)) & 1u))
#define NSA_MASK(P0, P1, JJ) do { const int k0 = (JJ) * KVBLK; constexpr float NINF = -__builtin_inff(); \
            if (MODE <= 1) { if (!(16 * (k0 + 63) + 31 <= t0)) { \
                    _Pragma("unroll") for (int r = 0; r < 16; ++r) { if (!(16 * (k0 + crow(r, hi)) + 31 <= t)) P0[r] = NINF; if (!(16 * (k0 + 32 + crow(r, hi)) + 31 <= t)) P1[r] = NINF; } } } \
            else if (MODE == 2) { rv_ = (*(const LAS unsigned*)(lds + ATT_X_OFF + 2048 + (wid * 64 + lane) * 16 + ((JJ) >> 5) * 4) >> ((JJ) & 31)) & 1u;     \
                if ((JJ) >= cur) { const int lim = t - k0 - 4 * hi;                          \
                    _Pragma("unroll") for (int r = 0; r < 16; ++r) { if ((r & 3) + 8 * (r >> 2) > lim) P0[r] = NINF; if (32 + (r & 3) + 8 * (r >> 2) > lim) P1[r] = NINF; } } } \
            else { if (!((k0 > t0 + 31 - WINDOW) && (k0 + 63 <= t0))) { \
                    _Pragma("unroll") for (int r = 0; r < 16; ++r) { const int ka = k0 + crow(r, hi), kb = ka + 32; \
                        if (!(ka <= t && ka > t - WINDOW)) P0[r] = NINF; if (!(kb <= t && kb > t - WINDOW)) P1[r] = NINF; } } } } while (0)
        const int pbase = __builtin_amdgcn_readfirstlane((int)(uintptr_t)(lds + ATT_X_OFF + 128)); int pp = 0;
#define PLIST(i) (*(const LAS int*)(uintptr_t)(unsigned)(pbase + 4 * (i)))
        int ja, jb;
        __syncthreads();
        if (MODE == 2) { ja = PLIST(0); jb = PLIST(1); ja = __builtin_amdgcn_readfirstlane(ja); jb = __builtin_amdgcn_readfirstlane(jb); if (ja < 0) ja = jhi + 1; }
        else { ja = jlo; jb = ja + 1; if (jb > jhi) jb = -1; }
        if (ja <= jhi) kv_dma(dm, Kh + (size_t)ja * KVBLK * ldk, Vh + (size_t)ja * KVBLK * ldv, lds, 0, wid);
        if (jb >= 0) kv_dma(dm, Kh + (size_t)jb * KVBLK * ldk, Vh + (size_t)jb * KVBLK * ldv, lds, ATT_BUF, wid);
        int set = 0;
#pragma nounroll
        while (ja <= jhi) {
            int jc, jd;
            if (MODE == 2) { ++pp; jc = PLIST(2 * pp); jd = PLIST(2 * pp + 1); jc = __builtin_amdgcn_readfirstlane(jc); jd = __builtin_amdgcn_readfirstlane(jd); if (jc < 0) jc = jhi + 1; }
            else { jc = (jb >= 0 ? jb : ja) + 1; jd = jc + 1; if (jd > jhi) jd = -1; }
            VM_WAIT(); __syncthreads();
            if (jc <= jhi) kv_dma(dm, Kh + (size_t)jc * KVBLK * ldk, Vh + (size_t)jc * KVBLK * ldv, lds, ATT_SET - set, wid);
            if (jc <= jhi && jd >= 0) kv_dma(dm, Kh + (size_t)jd * KVBLK * ldk, Vh + (size_t)jd * KVBLK * ldv, lds, ATT_SET - set + ATT_BUF, wid);
            const bool nA = NSA_NEED(ja), nB = (jb >= 0) && NSA_NEED(jb);
            f32x16 a0, a1, b0, b1;
            if (nA) qkt(a0, a1, lds + set + ATT_K_OFF, qr, r32, hi);
            if (nB) qkt(b0, b1, lds + set + ATT_BUF + ATT_K_OFF, qr, r32, hi);
            bool rv_ = true;
            if (nA) { NSA_MASK(a0, a1, ja); attn_finish(a0, a1, o, m_reg, l_reg, wsc, vb0 + set, r32, hi, rv_); }
            if (nB) { NSA_MASK(b0, b1, jb); attn_finish(b0, b1, o, m_reg, l_reg, wsc, vb0 + set + ATT_BUF, r32, hi, rv_); }
            ja = jc; jb = (jc <= jhi) ? jd : -1; set = ATT_SET - set;
        }
#undef PLIST
#undef NSA_MASK
#undef NSA_NEED
        { float fac = l_reg > 0.f ? __builtin_amdgcn_rcpf(l_reg) : 0.f;
          if (MODE != 1) { const int br = MODE == 0 ? 0 : (MODE == 2 ? 1 : 2); fac *= sigmoidf_(bf2f(P1[(rowb + t) * NSA_INP + P1_GL + head * 3 + br])); }
          if (hi == 0) wsc[32 + r32] = fac; LDS_WAIT(); }
        if (MODE == 1) {
            float fc[16];
#pragma unroll
            for (int r = 0; r < 16; ++r) fc[r] = wsc[32 + crow(r, hi)];
            LDS_WAIT(); __syncthreads();
#pragma unroll
            for (int r = 0; r < 16; ++r) { const int orow = crow(r, hi);
#pragma unroll
                for (int d0 = 0; d0 < 4; ++d0) *(LAS float*)(lds + ((wid * 32 + orow) * 128 + d0 * 32 + r32) * 4) = o[d0][r] * fc[r]; }
            LDS_WAIT(); __syncthreads();
            { const int tok = tid >> 4, j8 = (tid & 15) * 8; f32x4 s0 = {0.f, 0.f, 0.f, 0.f}, s1 = {0.f, 0.f, 0.f, 0.f};
#pragma unroll
              for (int w = 0; w < 8; ++w) { const LAS f32x4* pp = (const LAS f32x4*)(lds + ((w * 32 + tok) * 128 + j8) * 4); s0 += pp[0]; s1 += pp[1]; }
              LAS f32x4* dst = (LAS f32x4*)(lds + (tok * 128 + j8) * 4); dst[0] = s0; dst[1] = s1; }
            LDS_WAIT(); __syncthreads();
#pragma nounroll
            for (int q = 0; q < 4; ++q) { const int tok = 4 * wid + q, tt = t0 + tok;
                const float a0 = *(const LAS float*)(lds + (tok * 128 + lane) * 4), a1 = *(const LAS float*)(lds + (tok * 128 + 64 + lane) * 4);
                const v4u w = topk_select(a0, a1, tt >> 6, lane);
                if (lane == 0) *(v4u*)(IMPO + ((rowb + tt) * NSA_G + g) * 4) = w; }
            LDS_WAIT(); __syncthreads();
        } else {
            bf16* gp0 = (MODE == 2) ? Ob + (rowb + t0 + 4 * wid) * DM + g * NSA_R * HD : Ob + (rowb + t0) * DM + (g * NSA_R + wid) * HD;
            int lane_e = lane; asm volatile("" : "+v"(lane_e));
            const unsigned lo = (MODE == 2) ? (unsigned)lane_e * 8u : (unsigned)(lane_e >> 4) * DM + (unsigned)(lane_e & 15) * 8u;
#define NSA_PIECE(i) (gp0 + ((MODE == 2) ? (size_t)((i) >> 1) * DM + ((i) & 1) * 512 : (size_t)(4 * (i)) * DM) + lo)
            v4u old[8];
            if (MODE != 0 && !probe_nostore) {
#pragma unroll
                for (int i = 0; i < 8; ++i) old[i] = *(const v4u*)NSA_PIECE(i); }
            LDS_WAIT(); __syncthreads();
            LAS float* stg = (LAS float*)(lds + wid * 16384);
#pragma unroll
            for (int r = 0; r < 16; ++r) { const int orow = crow(r, hi); const float fc = wsc[32 + orow];
#pragma unroll
                for (int d0 = 0; d0 < 4; ++d0) stg[orow * 128 + d0 * 32 + r32] = o[d0][r] * fc; }
            LDS_WAIT();
            if (!probe_nostore) {
#pragma unroll
                for (int i = 0; i < 8; ++i) { const int c = 64 * i + lane_e; f32x4 x0 = *(const LAS f32x4*)(stg + c * 8), x1 = *(const LAS f32x4*)(stg + c * 8 + 4);
                    if (MODE != 0) { x0[0] += bflo(old[i].x); x0[1] += bfhi(old[i].x); x0[2] += bflo(old[i].y); x0[3] += bfhi(old[i].y); x1[0] += bflo(old[i].z); x1[1] += bfhi(old[i].z); x1[2] += bflo(old[i].w); x1[3] += bfhi(old[i].w); }
                    const v4u w = {cvtpk(x0[0], x0[1]), cvtpk(x0[2], x0[3]), cvtpk(x1[0], x1[1]), cvtpk(x1[2], x1[3])};
                    *(v4u*)NSA_PIECE(i) = w; } }
#undef NSA_PIECE
            LDS_WAIT();
        }
    }
}
struct Sub16 { f32x4 o[8]; bf16x8 q[4]; float m, l; };
#define MFMA16(a, b, c) __builtin_amdgcn_mfma_f32_16x16x32_bf16((a), (b), (c), 0, 0, 0)
__device__ __forceinline__ void kv_dma_init16(KVDma& d, int ldk, int ldv, int wid, int lane) {
#pragma unroll
  for (int i = 0; i < 2; ++i) { const int p = wid * 2 + i;
    const int row = p * 4 + (lane >> 4), cp = lane & 15; d.ko[i] = row * ldk + ((cp ^ (row & 15)) << 3);
    const int sub = p * 2 + (lane >> 5), kk = (sub >> 2) * 8 + ((lane & 31) >> 2), k = (kk & ~0xC) | ((kk & 4) << 1) | ((kk & 8) >> 1), c = (sub & 3) * 32 + (((lane & 3) ^ (((k >> 2) & 1) << 1)) * 8);
    d.vo[i] = k * ldv + c; }
}
struct VF16 { s16x4 l0, h0, l1, h1; };
template <int C> __device__ __forceinline__ void pv16_rd(VF16& f, int vaddrA, int vaddrB) {
    constexpr int CO = (C >> 1) * 512; const int vaddr = (C & 1) ? vaddrB : vaddrA;
    f.l0 = tr_read<CO>(vaddr); f.h0 = tr_read<CO + 4096>(vaddr); f.l1 = tr_read<CO + 8192>(vaddr); f.h1 = tr_read<CO + 8192 + 4096>(vaddr);
}
__device__ __forceinline__ void pv16_mma(f32x4& oc, const VF16& f, bf16x8 pa0, bf16x8 pa1) {
    oc = MFMA16(((bf16x8){f.l0[0], f.l0[1], f.l0[2], f.l0[3], f.h0[0], f.h0[1], f.h0[2], f.h0[3]}), pa0, oc);
    oc = MFMA16(((bf16x8){f.l1[0], f.l1[1], f.l1[2], f.l1[3], f.h1[0], f.h1[1], f.h1[2], f.h1[3]}), pa1, oc);
}
__device__ __forceinline__ void slc16_tile(Sub16& S, const LAS char* Kt, const int (&kaddr)[4], int vaddrA, int vaddrB, bool rowvalid, bool diag, int lim  ) {
    f32x4 a[4];
#pragma unroll
    for (int mb = 0; mb < 4; ++mb) a[mb] = (f32x4){0.f, 0.f, 0.f, 0.f};
#pragma unroll
    for (int ks = 0; ks < 4; ++ks)
#pragma unroll
        for (int mb = 0; mb < 4; ++mb) {
            const bf16x8 kf = *(const LAS bf16x8*)(Kt + kaddr[ks] + 16 * mb * 256);
            a[mb] = MFMA16(kf, S.q[ks], a[mb]); }
    constexpr float NINF = -__builtin_inff();
    VF16 f0, f1, f2;
    SBAR(); pv16_rd<0>(f0, vaddrA, vaddrB); pv16_rd<1>(f1, vaddrA, vaddrB); pv16_rd<2>(f2, vaddrA, vaddrB); SBAR();
    if (diag) {
#pragma unroll
        for (int mb = 0; mb < 4; ++mb)
#pragma unroll
            for (int i = 0; i < 4; ++i) if (16 * mb + i > lim) a[mb][i] = NINF; }
    float pmax = fmaxf(fmaxf(a[0][0], a[0][1]), fmaxf(a[0][2], a[0][3]));
#pragma unroll
    for (int mb = 1; mb < 4; ++mb) pmax = fmaxf(pmax, fmaxf(fmaxf(a[mb][0], a[mb][1]), fmaxf(a[mb][2], a[mb][3])));
    { auto r16 = __builtin_amdgcn_permlane16_swap(__float_as_uint(pmax), __float_as_uint(pmax), false, false); pmax = fmaxf(__uint_as_float(r16[0]), __uint_as_float(r16[1]));
      auto r32 = __builtin_amdgcn_permlane32_swap(__float_as_uint(pmax), __float_as_uint(pmax), false, false); pmax = fmaxf(__uint_as_float(r32[0]), __uint_as_float(r32[1])); }
    if (!rowvalid) pmax = NINF;
    float alpha = 1.f, mn = S.m;
    if (!__all(pmax - S.m <= ATT_THR / ATT_SCALE)) { mn = fmaxf(S.m, pmax); alpha = __builtin_amdgcn_exp2f((S.m - mn) * ATT_C); S.m = mn; }
    const float mnC = rowvalid ? -mn * ATT_C : NINF;
    float ps = 0.f;
#pragma unroll
    for (int mb = 0; mb < 4; ++mb)
#pragma unroll
        for (int i = 0; i < 4; ++i) { a[mb][i] = __builtin_amdgcn_exp2f(fmaf(a[mb][i], ATT_C, mnC)); ps += a[mb][i]; }
    S.l = S.l * alpha + ps;
    if (__any(alpha < 1.f)) {
#pragma unroll
        for (int c = 0; c < 8; ++c) S.o[c] *= alpha; }
    bf16x8 pa[2];
#pragma unroll
    for (int h = 0; h < 2; ++h) { const v4u w = {cvtpk(a[2 * h][0], a[2 * h][1]), cvtpk(a[2 * h][2], a[2 * h][3]), cvtpk(a[2 * h + 1][0], a[2 * h + 1][1]), cvtpk(a[2 * h + 1][2], a[2 * h + 1][3])};
        pa[h] = __builtin_bit_cast(bf16x8, w); }
#define W8() do { asm volatile("s_waitcnt lgkmcnt(8)" ::: "memory"); SBAR(); } while (0)
    W8(); pv16_mma(S.o[0], f0, pa[0], pa[1]); SBAR(); pv16_rd<3>(f0, vaddrA, vaddrB);
    W8(); pv16_mma(S.o[1], f1, pa[0], pa[1]); SBAR(); pv16_rd<4>(f1, vaddrA, vaddrB);
    W8(); pv16_mma(S.o[2], f2, pa[0], pa[1]); SBAR(); pv16_rd<5>(f2, vaddrA, vaddrB);
    W8(); pv16_mma(S.o[3], f0, pa[0], pa[1]); SBAR(); pv16_rd<6>(f0, vaddrA, vaddrB);
    W8(); pv16_mma(S.o[4], f1, pa[0], pa[1]); SBAR(); pv16_rd<7>(f1, vaddrA, vaddrB);
    W8(); pv16_mma(S.o[5], f2, pa[0], pa[1]); SBAR();
    asm volatile("s_waitcnt lgkmcnt(4)" ::: "memory"); SBAR(); pv16_mma(S.o[6], f0, pa[0], pa[1]); SBAR();
    asm volatile("s_waitcnt lgkmcnt(0)" ::: "memory"); SBAR(); pv16_mma(S.o[7], f1, pa[0], pa[1]);
#undef W8
}
template <int probe = 0>
__device__ __forceinline__ void nsa_slc16_phase(Frame& F, const bf16* P1, const bf16* Qsrc, const bf16* Ksrc, const unsigned* SEL, bf16* Ob) {
    const int wid = F.wave, lane = F.lane, fr = lane & 15, fq = lane >> 4;
    LAS char* lds = (LAS char*)F.lds;
    KVDma dm; kv_dma_init16(dm, KVW, NSA_INP, wid, lane);
    constexpr int NTB = SEQ / 32, NU = BATCH * NSA_G * NTB;
    int kaddr[4];
#pragma unroll
    for (int ks = 0; ks < 4; ++ks) kaddr[ks] = fr * 256 + 16 * (fq ^ (fr & 3)) + 64 * (ks ^ (fr >> 2));
    const int vlane = (fq & 1) * 2048 + (((lane & 15) >> 2) + 4 * (fq >> 1)) * 64 + 8 * (lane & 3);
    const int vb0 = (int)(uintptr_t)(lds + ATT_V_OFF) + vlane + (fq & 1) * 32, vb1 = (int)(uintptr_t)(lds + ATT_V_OFF) + vlane + (1 - (fq & 1)) * 32;
    for (int rd = 0; ; ++rd) {
        int idx;
        { idx = (rd & 1) ? rd * F.G + (F.G - 1 - F.bid) : rd * F.G + F.bid; if (rd * F.G >= NU) break; if (idx >= NU) continue; }
        const int tb = NTB - 1 - idx / (BATCH * NSA_G), bg = idx % (BATCH * NSA_G), g = bg % NSA_G, b = bg / NSA_G;
        const size_t rowb = (size_t)b * SEQ; const int t0 = tb * 32;
        const bf16* Kh = Ksrc + rowb * KVW + g * HD; const bf16* Vh = P1 + rowb * NSA_INP + P1_VS + g * HD; const long ldk = KVW, ldv = NSA_INP;
        const int jhi = (t0 + 31) >> 6;
        unsigned wn[4], wa[4], wb[4];
        { const int tsel = t0 + 4 * wid + ((lane >> 3) & 3);
          const v4u sv = *(const v4u*)(SEL + ((rowb + tsel) * NSA_G + g) * 4); unsigned selw[4]; selw[0] = sv.x; selw[1] = sv.y; selw[2] = sv.z; selw[3] = sv.w;
          *(LAS v4u*)(lds + ATT_X_OFF + 2048 + (wid * 64 + lane) * 16) = sv;
          LAS unsigned* un = (LAS unsigned*)(lds + ATT_X_OFF);
#pragma unroll
          for (int q = 0; q < 4; ++q) { unsigned x = selw[q]; x |= __shfl_xor(x, 8);
              wa[q] = (unsigned)__builtin_amdgcn_readlane((int)x, 0); wb[q] = (unsigned)__builtin_amdgcn_readlane((int)x, 16); wn[q] = wa[q] | wb[q]; if (lane == 0) un[wid * 4 + q] = wn[q]; }
          LDS_WAIT(); __syncthreads();
          LAS int* plist = (LAS int*)(lds + ATT_X_OFF + 128);
          if (wid == 0) {
              unsigned m0 = 0u, m1 = 0u;
              int lane_l = lane; asm volatile("" : "+v"(lane_l));
              const LAS unsigned* ub = un + (lane_l >> 5);
#pragma unroll
              for (int w = 0; w < NWAVES; ++w) { m0 |= ((ub[w * 4] >> (lane & 31)) & 1u) << w; m1 |= ((ub[w * 4 + 2] >> (lane & 31)) & 1u) << w; }
              bool v0 = m0 != 0u && lane <= jhi, v1 = m1 != 0u && lane + 64 <= jhi; int np = 0;
              for (;;) {
                  const unsigned long long a0 = __ballot(v0), a1 = __ballot(v1);
                  if (!(a0 | a1)) break;
                  const int ja_ = a0 ? __builtin_ctzll(a0) : 64 + __builtin_ctzll(a1);
                  const unsigned ma = (ja_ < 64) ? (unsigned)__shfl((int)m0, ja_) : (unsigned)__shfl((int)m1, ja_ - 64);
                  if (lane == (ja_ & 63)) { if (ja_ < 64) v0 = false; else v1 = false; }
                  unsigned long long c0 = __ballot(v0 && !(m0 & ma)), c1 = __ballot(v1 && !(m1 & ma));
                  if (!(c0 | c1)) { c0 = __ballot(v0 && m0 == 0xffu); c1 = __ballot(v1 && m1 == 0xffu); }
                  if (!(c0 | c1)) { c0 = __ballot(v0); c1 = __ballot(v1); }
                  int jb_ = -1;
                  if (c0 | c1) { jb_ = c0 ? __builtin_ctzll(c0) : 64 + __builtin_ctzll(c1); if (lane == (jb_ & 63)) { if (jb_ < 64) v0 = false; else v1 = false; } }
                  if (lane == 0) { plist[2 * np] = ja_; plist[2 * np + 1] = jb_; }
                  ++np;
              }
              if (lane == 0) { int neg1 = -1; asm volatile("" : "+v"(neg1)); plist[2 * np] = neg1; plist[2 * np + 1] = neg1; }
          }
          LDS_WAIT(); }
        Sub16 SA, SB;
        const int tokA = t0 + 4 * wid + (fr >> 3), tokB = tokA + 2, head = g * NSA_R + (fr & 7);
        { const bf16* qa = Qsrc + (rowb + tokA) * DM + head * HD + 8 * fq; const bf16* qb = Qsrc + (rowb + tokB) * DM + head * HD + 8 * fq;
#pragma unroll
          for (int ks = 0; ks < 4; ++ks) { SA.q[ks] = *(const bf16x8*)(qa + 32 * ks); SB.q[ks] = *(const bf16x8*)(qb + 32 * ks); } }
#pragma unroll
        for (int c = 0; c < 8; ++c) { SA.o[c] = (f32x4){0.f, 0.f, 0.f, 0.f}; SB.o[c] = (f32x4){0.f, 0.f, 0.f, 0.f}; }
        SA.m = -1e30f; SA.l = 0.f; SB.m = -1e30f; SB.l = 0.f;
        const int selA = (int)(uintptr_t)(lds + ATT_X_OFF + 2048 + (wid * 64 + 8 * (fr >> 3)) * 16), selB = selA + 16 * 16;
        const int pbase = __builtin_amdgcn_readfirstlane((int)(uintptr_t)(lds + ATT_X_OFF + 128)); int pp = 0;
#define PLIST(i) (*(const LAS int*)(uintptr_t)(unsigned)(pbase + 4 * (i)))
#define SLC16_ONE(JJ, BUF) do { const int jj_ = (JJ); const int k0_ = jj_ * KVBLK; const bool dg_ = jj_ >= jhi; \
            if ((pick4(wa, jj_ >> 5) >> (jj_ & 31)) & 1u) { const bool rv_ = (*(const LAS unsigned*)(uintptr_t)(unsigned)(selA + (jj_ >> 5) * 4) >> (jj_ & 31)) & 1u; \
                slc16_tile(SA, lds + (BUF) + ATT_K_OFF, kaddr, vb0 + (BUF), vb1 + (BUF), rv_, dg_, tokA - k0_ - 4 * fq); } \
            if ((pick4(wb, jj_ >> 5) >> (jj_ & 31)) & 1u) { const bool rv_ = (*(const LAS unsigned*)(uintptr_t)(unsigned)(selB + (jj_ >> 5) * 4) >> (jj_ & 31)) & 1u; \
                slc16_tile(SB, lds + (BUF) + ATT_K_OFF, kaddr, vb0 + (BUF), vb1 + (BUF), rv_, dg_, tokB - k0_ - 4 * fq); } } while (0)
        int ja, jb;
        __syncthreads();
        ja = PLIST(0); jb = PLIST(1); ja = __builtin_amdgcn_readfirstlane(ja); jb = __builtin_amdgcn_readfirstlane(jb); if (ja < 0) ja = jhi + 1;
        if (ja <= jhi && probe != 1) kv_dma(dm, Kh + (size_t)ja * KVBLK * ldk, Vh + (size_t)ja * KVBLK * ldv, lds, 0, wid);
        if (jb >= 0 && probe != 1) kv_dma(dm, Kh + (size_t)jb * KVBLK * ldk, Vh + (size_t)jb * KVBLK * ldv, lds, ATT_BUF, wid);
        int set = 0;
#pragma nounroll
        while (ja <= jhi) {
            int jc, jd;
            ++pp; jc = PLIST(2 * pp); jd = PLIST(2 * pp + 1); jc = __builtin_amdgcn_readfirstlane(jc); jd = __builtin_amdgcn_readfirstlane(jd); if (jc < 0) jc = jhi + 1;
            VM_WAIT(); __syncthreads();
            if (jc <= jhi && probe != 1) kv_dma(dm, Kh + (size_t)jc * KVBLK * ldk, Vh + (size_t)jc * KVBLK * ldv, lds, ATT_SET - set, wid);
            if (jc <= jhi && jd >= 0 && probe != 1) kv_dma(dm, Kh + (size_t)jd * KVBLK * ldk, Vh + (size_t)jd * KVBLK * ldv, lds, ATT_SET - set + ATT_BUF, wid);
            if (probe != 2 && ((pick4(wn, ja >> 5) >> (ja & 31)) & 1u)) SLC16_ONE(ja, set);
            if (probe != 2 && jb >= 0 && ((pick4(wn, jb >> 5) >> (jb & 31)) & 1u)) SLC16_ONE(jb, set + ATT_BUF);
            ja = jc; jb = (jc <= jhi) ? jd : -1; set = ATT_SET - set;
        }
#undef PLIST
#undef SLC16_ONE
        float facA, facB;
        { float la = SA.l; la += __shfl_xor(la, 16); la += __shfl_xor(la, 32); float lb = SB.l; lb += __shfl_xor(lb, 16); lb += __shfl_xor(lb, 32);
          facA = (la > 0.f ? __builtin_amdgcn_rcpf(la) : 0.f) * sigmoidf_(bf2f(P1[(rowb + tokA) * NSA_INP + P1_GL + head * 3 + 1]));
          facB = (lb > 0.f ? __builtin_amdgcn_rcpf(lb) : 0.f) * sigmoidf_(bf2f(P1[(rowb + tokB) * NSA_INP + P1_GL + head * 3 + 1])); }
        bf16* gp0 = Ob + (rowb + t0 + 4 * wid) * DM + g * NSA_R * HD;
        int lane_e = lane; asm volatile("" : "+v"(lane_e));
        const unsigned lo = (unsigned)lane_e * 8u;
#define NSA_PIECE(i) (gp0 + (size_t)((i) >> 1) * DM + ((i) & 1) * 512 + lo)
        v4u old[8];
#pragma unroll
        for (int i = 0; i < 8; ++i) old[i] = probe ? (v4u){0u, 0u, 0u, 0u} : *(const v4u*)NSA_PIECE(i);
        LDS_WAIT(); __syncthreads();
        LAS float* stg = (LAS float*)(lds + wid * 16384);
#pragma unroll
        for (int c = 0; c < 8; ++c) {
            *(LAS f32x4*)(stg + fr * 128 + 16 * c + 4 * fq) = SA.o[c] * facA;
            *(LAS f32x4*)(stg + (16 + fr) * 128 + 16 * c + 4 * fq) = SB.o[c] * facB; }
        LDS_WAIT();
#pragma unroll
        for (int i = 0; i < 8; ++i) { const int c = 64 * i + lane_e; f32x4 x0 = *(const LAS f32x4*)(stg + c * 8), x1 = *(const LAS f32x4*)(stg + c * 8 + 4);
            x0[0] += bflo(old[i].x); x0[1] += bfhi(old[i].x); x0[2] += bflo(old[i].y); x0[3] += bfhi(old[i].y); x1[0] += bflo(old[i].z); x1[1] += bfhi(old[i].z); x1[2] += bflo(old[i].w); x1[3] += bfhi(old[i].w);
            const v4u w = {cvtpk(x0[0], x0[1]), cvtpk(x0[2], x0[3]), cvtpk(x1[0], x1[1]), cvtpk(x1[2], x1[3])};
            if (!probe) *(v4u*)NSA_PIECE(i) = w; }
#undef NSA_PIECE
        LDS_WAIT();
    }
}
#undef MFMA16

#ifndef STAGE
#define STAGE 3
#endif
#define ZERO_OB_PHASE PH_BEGIN { v4u z = {0u, 0u, 0u, 0u}; v4u* p = (v4u*)Ob; const long n = (long)MTOK * DM / 8; \
            for (long i = (long)F.bid * NTHR + F.tid; i < n; i += (long)F.G * NTHR) p[i] = z; } PH_END
#define MIXER0_PHASES \
    PH_BEGIN { fold_finalize(F, FO_XQ, XW); fold_finalize(F, FO_UP, DFF2); } \
             REP(10) hgrn_phase_a(F, BIG, (const float*)(ws + WS_LB), (bf16*)(ws + WS_QT), (bf16*)(ws + WS_OINTRA), (bf16*)(ws + WS_DS), (float*)(ws + WS_DEC)); \
             REP(11) sb_phase(F, BIG, Ob); PH_END \
    PH_BEGIN REP(12) hgrn_phase_b(F, (const bf16*)(ws + WS_DS), (const float*)(ws + WS_DEC), (bf16*)(ws + WS_SPREV)); PH_END \
    PH_BEGIN REP(13) hgrn_phase_c(F, BIG, (const bf16*)(ws + WS_QT), (const bf16*)(ws + WS_OINTRA), (const bf16*)(ws + WS_SPREV), KIN(IN_HGRN_NW), Ob); PH_END
#if STAGE <= 2
#define MIXER1_PHASES ZERO_OB_PHASE
#else
#define MIXER1_PHASES \
    PH_BEGIN { fold_finalize(F, FO_XQ + XW, XW); } REP(14) { nsa_rope_phase(F, BIG, (const float*)(ws + WS_ROPE), (bf16*)(ws + WS_QROT), (bf16*)(ws + WS_KSROT), (bf16*)(ws + WS_KWROT), (bf16*)(ws + WS_OVL)); \
             nsa_compress_phase(F, BIG, KIN(IN_NSA_CMP_POS), (const bf16*)(ws + WS_W_C1), (const bf16*)(ws + WS_W_C2), (bf16*)(ws + WS_KCMP), (bf16*)(ws + WS_VCMP)); } PH_END \
    PH_BEGIN { REP(15) nsa_attn_phase<0>(F, BIG, BIG, (const bf16*)(ws + WS_KCMP), (const bf16*)(ws + WS_VCMP), nullptr, nullptr, nullptr, Ob); \
             F.fresh(); REP(15) nsa_attn_phase<1>(F, BIG, BIG, (const bf16*)(ws + WS_KCMP), (const bf16*)(ws + WS_OVL), nullptr, nullptr, (unsigned*)(ws + WS_SEL), nullptr); \
             F.fresh(); REP(17) nsa_attn_phase<3>(F, BIG, (const bf16*)(ws + WS_QROT), (const bf16*)(ws + WS_KWROT), nullptr, nullptr, nullptr, nullptr, Ob, r_ > 0); } PH_END \
    PH_BEGIN nsa_slc16_phase(F, BIG, (const bf16*)(ws + WS_QROT), (const bf16*)(ws + WS_KSROT), (const unsigned*)(ws + WS_SEL), Ob); SLC_SECOND PH_END
#endif
#ifndef REPMASK
#define REPMASK 0u
#endif
#ifndef SLC_PROBE
#define SLC_PROBE 0
#endif
#if (REPMASK >> 18) & 1
#define SLC_SECOND F.fresh(); nsa_slc16_phase<SLC_PROBE>(F, BIG, (const bf16*)(ws + WS_QROT), (const bf16*)(ws + WS_KSROT), (const unsigned*)(ws + WS_SEL), Ob);
#else
#define SLC_SECOND
#endif
#define REP(gid) for (int r_ = 0; r_ <= (int)((REPMASK >> (gid)) & 1u); ++r_)
#define PH_BEGIN if (pc >= lo && pc < hi) { F.fresh();
#if (REPMASK >> 23) & 1
#define PH_END   if (pc + 1 < hi) { const unsigned long long tb0_ = __builtin_amdgcn_s_memrealtime(); XcdBarrier bb_ = bar; asm volatile("" : "+s"(bb_.bar), "+s"(bb_.x)); xcd_barrier(bb_); \
        const unsigned w_ = (unsigned)(__builtin_amdgcn_s_memrealtime() - tb0_); tbar_acc += w_; if (threadIdx.x == 0) { atomicMax((unsigned*)(args.ws + 3 * MiB) + pc, 0x7fffffffu - w_); atomicMax((unsigned*)(args.ws + 3 * MiB) + 256 + pc, w_); } } } ++pc;
#else
#define PH_END   if (pc + 1 < hi) { XcdBarrier bb_ = bar; asm volatile("" : "+s"(bb_.bar), "+s"(bb_.x)); xcd_barrier(bb_); } } ++pc;
#endif
template <int l>
__device__ __forceinline__ void layer_body(Frame& F, const Args& args, const XcdBarrier& bar, int& pc, const int lo, const int hi, unsigned long long& tbar_acc) {
    unsigned char* ws = F.ws;
    bf16* HB = (bf16*)(ws + WS_HB); bf16* Y = (bf16*)(ws + WS_Y); float* H32 = (float*)karg()->out;
    bf16* BIG = (bf16*)(ws + WS_BIG); bf16* Gm = (bf16*)(ws + WS_G); bf16* Ob = (bf16*)(ws + WS_O);
    bf16* XQ = (bf16*)(ws + WS_XQ); bf16* XO = (bf16*)(ws + WS_XO);
#define RS(k) ((long long*)(ws + WS_RSUM) + (size_t)(k) * MTOK * 2)
#define LNG(k) (KIN(IN_LN_G) + (size_t)(k) * DM)
#define LNB(k) (KIN(IN_LN_B) + (size_t)(k) * DM)
    const float* cs = (const float*)(ws + WS_FOLDF); const float* b2 = cs + FO_N;
        PH_BEGIN REP(1) {
            const int N = l == 0 ? AB_IN : NSA_INP;
            pg8::StaticOrder S; S.init(MTOK, N, F.G, F.bid);
            if (l == 0) { pg8::Gemm g{HB, (const bf16*)(ws + WS_W_ABIN), MTOK, N, DM}; pg8::EpiBf16<0> E{BIG, N, nullptr, 0, 0, 1.f};
                pg8::gemm_phase<pg8::EpiBf16<0>, pg8::StaticOrder, PG8_ALIGN, PG8_SP2>(F.lds + RING_OFF, g, S, E); }
            else { pg8::Gemm g{Y, (const bf16*)(ws + WS_W_NSAIN), MTOK, N, DM}; pg8::EpiBf16Ln E{BIG, N, RS(2), cs + FO_NSA, b2 + FO_NSA};
                pg8::gemm_phase<pg8::EpiBf16Ln, pg8::StaticOrder, PG8_ALIGN, PG8_SP2>(F.lds + RING_OFF, g, S, E);
                if (r_ == 0) convert_job<CJ_L1A>(F, args, 64, 192); }
        } PH_END
#if STAGE <= 1
        ZERO_OB_PHASE
#else
        if (l == 0) {
            MIXER0_PHASES
        } else {
            MIXER1_PHASES
        }
#endif
        PH_BEGIN REP(2) {
            pg8::Gemm g{Ob, l == 0 ? (const bf16*)(ws + WS_W_ABOUT) : (const bf16*)(ws + WS_W_NSAOUT), MTOK, DM, DM};
            pg8::StaticOrder S; S.init(MTOK, DM, F.G, F.bid);
            if (l == 0) { pg8::EpiRes0 E{Y, HB, DM, DN_ALPHA, RS(0)};
                pg8::gemm_phase<pg8::EpiRes0, pg8::StaticOrder, PG8_ALIGN, PG8_SP2>(F.lds + RING_OFF, g, S, E); }
            else { pg8::EpiResLn2 E{Y, RS(2), LNG(2), LNB(2), DM, DN_ALPHA, RS(3)};
                pg8::gemm_phase<pg8::EpiResLn2, pg8::StaticOrder, PG8_ALIGN, PG8_SP2>(F.lds + RING_OFF, g, S, E); }
        } PH_END
        PH_BEGIN REP(3) {
            {   pg8::Gemm g{Y, (const bf16*)(ws + WS_W_XQ) + (size_t)l * XW * DM, MTOK, XW, DM};
                pg8::RangeOrder S; S.init(MTOK, XW, 0, 128, F.bid);
                pg8::EpiBf16Ln E{XQ, XW, RS(3 * l), cs + FO_XQ + l * XW, b2 + FO_XQ + l * XW};
                pg8::gemm_phase<pg8::EpiBf16Ln, pg8::RangeOrder, PG8_ALIGN, PG8_SP2>(F.lds + RING_OFF, g, S, E); }
            {   pg8::Gemm g{(const bf16*)(ws + WS_MEMB), (const bf16*)(ws + WS_W_XKV) + (size_t)l * 2 * XW * DM, BATCH * NMEM, 2 * XW, DM};
                pg8::RangeOrder S; S.init(BATCH * NMEM, 2 * XW, 128, 8, F.bid);
                pg8::EpiBf16<0> E{(bf16*)(ws + WS_XKV) + (size_t)l * BATCH * NMEM * 2 * XW, 2 * XW, nullptr, 0, 0, 1.f};
                pg8::gemm_phase<pg8::EpiBf16<0>, pg8::RangeOrder, PG8_ALIGN, PG8_SP2>(F.lds + RING_OFF, g, S, E); }
            if (r_ == 0) { if (l == 0) convert_job<CJ_DOWN0>(F, args, 136, 120); else convert_job<CJ_L1B>(F, args, 136, 120); }
        } PH_END
        PH_BEGIN { if (l == 1) fold_finalize(F, FO_UP + DFF2, DFF2); } REP(9) xattn_phase(F, XQ, (const bf16*)(ws + WS_XKV) + (size_t)l * BATCH * NMEM * 2 * XW, XO); PH_END
        PH_BEGIN REP(4) {
            pg8::Gemm g{XO, (const bf16*)(ws + WS_W_XO) + (size_t)l * DM * XW, MTOK, DM, XW};
            pg8::StaticOrder S; S.init(MTOK, DM, F.G, F.bid);
            pg8::EpiResLn2 E{Y, RS(3 * l), LNG(3 * l), LNB(3 * l), DM, DN_ALPHA, RS(3 * l + 1)};
            pg8::gemm_phase<pg8::EpiResLn2, pg8::StaticOrder, PG8_ALIGN, PG8_SP2>(F.lds + RING_OFF, g, S, E);
        } PH_END
        PH_BEGIN REP(5) {
#if (REPMASK >> 22) & 1
            if (r_ > 0) { XcdBarrier bb_ = bar; asm volatile("" : "+s"(bb_.bar), "+s"(bb_.x)); xcd_barrier(bb_); }
#endif
            pg8::Gemm g{Y, (const bf16*)(ws + WS_W_UP) + (size_t)l * DFF2 * DM, MTOK, DFF2, DM};
            pg8::StaticOrder S; S.init(MTOK, DFF2, F.G, F.bid);
            pg8::EpiConvGlu E{Gm, (bf16*)(ws + WS_SIDE), RS(3 * l + 1), cs + FO_UP + l * DFF2, b2 + FO_UP + l * DFF2, KIN(IN_FFN_CONV) + (size_t)l * 3 * DFF, DFF};
            pg8::gemm_phase<pg8::EpiConvGlu, pg8::StaticOrder, PG8_ALIGN, PG8_SP2>(F.lds + RING_OFF, g, S, E);
            if (r_ == 0) { if (l == 0) convert_job<CJ_NSA>(F, args, 128, 128); else convert_job<CJ_DOWN1>(F, args, 128, 128); }
        } PH_END
#if (REPMASK >> 20) & 1
        PH_BEGIN {
            pg8::Gemm g{HB, (const bf16*)(ws + WS_W_UP) + (size_t)l * DFF2 * DM, MTOK, DFF2, DM};
            pg8::ZeroOrder S; S.init(MTOK, DFF2, F.G, F.bid);
            pg8::EpiBf16<0> E{Gm, DFF2, nullptr, 0, 0, 1.f};
            pg8::gemm_phase<pg8::EpiBf16<0>, pg8::ZeroOrder, PG8_ALIGN, PG8_SP2>(F.lds + RING_OFF, g, S, E);
        } PH_END
#endif
        PH_BEGIN { if (l == 0) fold_finalize(F, FO_NSA, NSA_INP); } REP(8) convglu_fixup_phase(F, (const bf16*)(ws + WS_SIDE), KIN(IN_FFN_CONV) + (size_t)l * 3 * DFF, Gm); PH_END
        PH_BEGIN REP(6) {
            pg8::Gemm g{Gm, (const bf16*)(ws + WS_W_DOWN) + (size_t)l * DM * DFF, MTOK, DM, DFF};
            pg8::StaticOrder S; S.init(MTOK, DM, F.G, F.bid);
            pg8::EpiResLn2 E{Y, RS(3 * l + 1), LNG(3 * l + 1), LNB(3 * l + 1), DM, DN_ALPHA, RS(3 * l + 2)};
            pg8::gemm_phase<pg8::EpiResLn2, pg8::StaticOrder, PG8_ALIGN, PG8_SP2>(F.lds + RING_OFF, g, S, E);
        } PH_END
        if (l == 1) { PH_BEGIN REP(7) ln_phase(F, Y, LNG(5), LNB(5), H32); PH_END }
#undef RS
#undef LNG
#undef LNB
}
__global__ void __launch_bounds__(NTHR, 2) mega_fwd(Args args) {
    extern __shared__ __attribute__((aligned(16))) unsigned char lds_raw[];
    Frame F;
    F.lds = (LAS unsigned char*)lds_raw; F.ws = args.ws;
    F.tid = threadIdx.x; F.lane = F.tid & 63; F.wave = __builtin_amdgcn_readfirstlane(F.tid >> 6); F.G = gridDim.x;
    unsigned char* ws = args.ws;
    gu32* ctl = (gu32*)(ws + WS_CTL);
    for (int u = F.tid; u < (LDS_BYTES - LDSCTL_OFF) / 4; u += NTHR) ((LAS unsigned*)(F.lds + LDSCTL_OFF))[u] = 0u;
    __syncthreads();
    volatile LAS unsigned* MISC = (volatile LAS unsigned*)(F.lds + MISC_OFF);
    XcdBarrier bar = xcd_barrier_post((unsigned*)(ctl + CW_BAR), MISC + 8);
    const int lo = args.ph_lo, hi = args.ph_hi; int pc = 0; unsigned long long tbar_acc = 0ull;
    bf16* HB = (bf16*)(ws + WS_HB); bf16* Y = (bf16*)(ws + WS_Y); float* H32 = (float*)karg()->out;
    bf16* BIG = (bf16*)(ws + WS_BIG); bf16* Gm = (bf16*)(ws + WS_G); bf16* Ob = (bf16*)(ws + WS_O);
    bf16* XQ = (bf16*)(ws + WS_XQ); bf16* XO = (bf16*)(ws + WS_XO);

    PH_BEGIN REP(0) p0_prologue(F, args); PH_END

#if (REPMASK >> 21) & 1
    for (int e_ = 0; e_ < 40; ++e_) { PH_BEGIN PH_END }
#endif
    layer_body<0>(F, args, bar, pc, lo, hi, tbar_acc);
    layer_body<1>(F, args, bar, pc, lo, hi, tbar_acc);
#if (REPMASK >> 23) & 1
#ifndef PROBE_BID
#define PROBE_BID 0
#endif
#if (REPMASK >> 24) & 1
    if (blockIdx.x == 0) { unsigned long long tot_ = 0ull; for (int k_ = 0; k_ < pc; ++k_) { const unsigned v_ = __hip_atomic_load((unsigned*)(args.ws + 3 * MiB) + k_, __ATOMIC_RELAXED, __HIP_MEMORY_SCOPE_AGENT); const unsigned x_ = __hip_atomic_load((unsigned*)(args.ws + 3 * MiB) + 256 + k_, __ATOMIC_RELAXED, __HIP_MEMORY_SCOPE_AGENT);
#ifdef PROBE_SPREAD_MASK
            if (v_ && ((PROBE_SPREAD_MASK >> k_) & 1ull)) tot_ += x_ - (0x7fffffffu - v_);
#else
            if (v_) tot_ += 0x7fffffffu - v_;
#endif
        }
        const unsigned long long t0_ = __builtin_amdgcn_s_memrealtime(); while (__builtin_amdgcn_s_memrealtime() - t0_ < tot_) __builtin_amdgcn_s_sleep(8); }
#else
    if (blockIdx.x == PROBE_BID) { const unsigned long long t0_ = __builtin_amdgcn_s_memrealtime(); while (__builtin_amdgcn_s_memrealtime() - t0_ < tbar_acc) __builtin_amdgcn_s_sleep(8); }
#endif
#endif
}

extern "C" void kernel_launch(void* const* d_in, const int* in_sizes, int n_in, void* d_out, int out_size, void* d_ws, size_t ws_size, hipStream_t stream) {
    static int grid = 0;
    if (grid == 0) {
        if (n_in != 19 || in_sizes[0] != MTOK * DM || out_size != MTOK * DM || ws_size < WS_END) {
            fprintf(stderr, "kernel_launch: shape mismatch n_in %d in0 %d out %d ws %zu (need %zu)\n", n_in, n_in > 0 ? in_sizes[0] : -1, out_size, ws_size, (size_t)WS_END); grid = -1; return; }
        int dev = 0, cus = 0, per_cu = 0;
        if (hipGetDevice(&dev) != hipSuccess || hipDeviceGetAttribute(&cus, hipDeviceAttributeMultiprocessorCount, dev) != hipSuccess) { grid = -1; return; }
        if (hipFuncSetAttribute((const void*)mega_fwd, hipFuncAttributeMaxDynamicSharedMemorySize, LDS_BYTES) != hipSuccess) { fprintf(stderr, "kernel_launch: hipFuncSetAttribute failed\n"); grid = -1; return; }
        if (hipOccupancyMaxActiveBlocksPerMultiprocessor(&per_cu, (const void*)mega_fwd, NTHR, LDS_BYTES) != hipSuccess || per_cu < 1)
            fprintf(stderr, "kernel_launch: note: occupancy query reports %d workgroups per CU\n", per_cu);
        (void)hipGetLastError();
        grid = cus;
        if (grid != 256) { fprintf(stderr, "kernel_launch: built for a 256-CU device (workgroup ranges of the cross-attention and conversion phases); this device reports %d; nothing launched\n", cus); grid = -1; return; }
    }
    if (grid < 0) return;
    if (hipMemsetAsync((char*)d_ws + WS_CTL, 0, CTL_ZERO_BYTES, stream) != hipSuccess) { fprintf(stderr, "kernel_launch: memset failed\n"); return; }
    Args a{};
    for (int i = 0; i < 19; ++i) a.in[i] = (const float*)d_in[i];
    a.out = (float*)d_out; a.ws = (unsigned char*)d_ws; a.ph_lo = 0; a.ph_hi = 1 << 20;
    hipLaunchKernelGGL(mega_fwd, dim3(grid), dim3(NTHR), LDS_BYTES, stream, a);
    const hipError_t le = hipPeekAtLastError();
    if (le != hipSuccess) fprintf(stderr, "kernel_launch: launch failed: %s\n", hipGetErrorName(le));
}
```

```cpp
#include <hip/hip_runtime.h>
#include <cstdio>
#include <cstdint>
namespace pg8 {
#define PG8_LAS __attribute__((address_space(3)))
typedef unsigned short bf16_t;
typedef short bf16x8 __attribute__((ext_vector_type(8)));
typedef float f32x4 __attribute__((ext_vector_type(4)));
typedef unsigned u32x4 __attribute__((ext_vector_type(4)));
constexpr int BM = 256, BK = 64, HALF = 128, HTB = HALF * BK * 2  , STAGE_BYTES = 8 * HTB, NXCD = 8, WGM = 8;

__host__ __device__ __forceinline__ int lds_byte(int r, int c) { const int st = (r >> 4) * 2 + (c >> 5), rr = r & 15, cc = c & 31, ob = rr * 64 + cc * 2; return st * 1024 + (ob ^ (((ob >> 9) & 1) << 5)); }
__host__ __device__ __forceinline__ void stage_rc(int b, int& R, int& C) { const int st = b / 1024, sb = b % 1024, swz = sb ^ (((sb >> 9) & 1) << 5); R = (st >> 1) * 16 + swz / 64; C = (st & 1) * 32 + (swz % 64) / 2; }
__host__ __device__ __forceinline__ int perm32(int rho) { const int n = rho >> 4, i = rho & 15; return 8 * (i >> 2) + 4 * n + (i & 3); }

struct Unit { int pm, pn; };
struct Gemm { const bf16_t* A; const bf16_t* Bt; int M, N, K; };

struct StaticOrder {
    int nM, nN, nwg, G, c;
    __host__ __device__ void init(int M, int N, int G_, int c_) { nM = M / BM; nN = N / BM; nwg = nM * nN; G = G_; c = c_; }
    __host__ __device__ bool next(int i, Unit& u) const {
        const long L = (long)i * G + c; if (L >= nwg) return false;
        int wgid = (int)L; { const int q = nwg / NXCD, r = nwg % NXCD, xcd = wgid % NXCD, off = wgid / NXCD; wgid = (xcd < r ? xcd * (q + 1) : r * (q + 1) + (xcd - r) * q) + off; }
        const int nig = WGM * nN, gid = wgid / nig, fm = gid * WGM, gsz = (nM - fm) < WGM ? (nM - fm) : WGM;
        u.pm = fm + ((wgid % nig) % gsz); u.pn = (wgid % nig) / gsz; return true;
    }
    __device__ __forceinline__ void a_ready(const Unit&) const {}
    __device__ __forceinline__ void done(const Unit&) const {}
};

__device__ __forceinline__ unsigned cvt_pk_bf16(float lo, float hi) { unsigned r; asm volatile("v_cvt_pk_bf16_f32 %0, %1, %2" : "=v"(r) : "v"(lo), "v"(hi)); return r; }
typedef float f32x2 __attribute__((ext_vector_type(2)));
__device__ __forceinline__ f32x2 gelu_pk(f32x2 v) {
    const f32x2 av = __builtin_elementwise_abs(v), d = av * 0.2316418882f + 1.0f;
    f32x2 t; t.x = __builtin_amdgcn_rcpf(d.x); t.y = __builtin_amdgcn_rcpf(d.y);
    f32x2 q = t * 0.5307027145f + (-0.7265760135f); q = q * t + 0.7107068705f; q = q * t + (-0.142248368f); q = q * t + 0.127414796f; q = q * t;
    const f32x2 s = (v * v) * (-0.72134752044f);
    f32x2 e; e.x = __builtin_amdgcn_exp2f(s.x); e.y = __builtin_amdgcn_exp2f(s.y);
    const f32x2 m = av * (q * e);
    return __builtin_elementwise_max(v, (f32x2){0.f, 0.f}) - m;
}

template <int ACT  > struct EpiBf16 {
    static constexpr bool PERM = true, AFTER_DRAIN = false; static_assert(ACT == 0 || ACT == 1, "EpiBf16: ACT is 0 (none) or 1 (gelu_pk)");
    bf16_t* O; int ldc; const float* bias; int split_cols; size_t split_stride; float scale0;
    __device__ __forceinline__ void operator()(const f32x4 (&acc)[2][2][4][2], const Unit& u, int wr, int wc, int fr, int fq) const {
        const int row0 = u.pm * BM + wr * 64 + fr; int colt = u.pn * BM; bf16_t* base = O;
        float sc = 1.f; if (split_cols) { const int t = colt / split_cols; base += (size_t)t * split_stride; colt -= t * split_cols; if (t == 0) sc = scale0; }
        const int col0 = colt + wc * 32 + 8 * fq, bcol0 = u.pn * BM + wc * 32 + 8 * fq;
        f32x4 bv[2][2];
#pragma unroll
        for (int bj = 0; bj < 2; ++bj)
#pragma unroll
            for (int n = 0; n < 2; ++n) bv[bj][n] = bias ? *(const f32x4*)(bias + bcol0 + bj * HALF + 4 * n) : (f32x4){0.f, 0.f, 0.f, 0.f};
#pragma unroll
        for (int ai = 0; ai < 2; ++ai)
#pragma unroll
            for (int m = 0; m < 4; ++m) { bf16_t* rowp = base + (size_t)(row0 + ai * HALF + m * 16) * ldc + col0;
#pragma unroll
                for (int bj = 0; bj < 2; ++bj) { f32x4 v0 = acc[ai][bj][m][0] + bv[bj][0], v1 = acc[ai][bj][m][1] + bv[bj][1];
                    if (ACT == 1) { f32x2 a = gelu_pk((f32x2){v0[0], v0[1]}), b = gelu_pk((f32x2){v0[2], v0[3]}), c = gelu_pk((f32x2){v1[0], v1[1]}), d = gelu_pk((f32x2){v1[2], v1[3]});
                        v0 = (f32x4){a.x, a.y, b.x, b.y}; v1 = (f32x4){c.x, c.y, d.x, d.y}; }
                    v0 = v0 * sc; v1 = v1 * sc; u32x4 w; w.x = cvt_pk_bf16(v0[0], v0[1]); w.y = cvt_pk_bf16(v0[2], v0[3]); w.z = cvt_pk_bf16(v1[0], v1[1]); w.w = cvt_pk_bf16(v1[2], v1[3]);
                    *(u32x4*)(rowp + bj * HALF) = w; } }
    }
};


struct EpiRes {
    static constexpr bool PERM = false, AFTER_DRAIN = false;
    float* Y; const float* res; int ldc; float alpha;
    __device__ __forceinline__ void operator()(const f32x4 (&acc)[2][2][4][2], const Unit& u, int wr, int wc, int fr, int fq) const {
        const int row0 = u.pm * BM + wr * 64 + fr, col0 = u.pn * BM + wc * 32 + 4 * fq;
#pragma unroll
        for (int ai = 0; ai < 2; ++ai)
#pragma unroll
            for (int m = 0; m < 4; ++m) { const size_t off = (size_t)(row0 + ai * HALF + m * 16) * ldc + col0;
#pragma unroll
                for (int bj = 0; bj < 2; ++bj)
#pragma unroll
                    for (int n = 0; n < 2; ++n) { const f32x4 r = *(const f32x4*)(res + off + bj * HALF + n * 16);
                        *(f32x4*)(Y + off + bj * HALF + n * 16) = r * alpha + acc[ai][bj][m][n]; } }
    }
};
struct RangeOrder {
    int nM, nN, ntot, c0, nw, c;
    __host__ __device__ void init(int M, int N, int c0_, int nw_, int c_) { nM = M / BM; nN = N / BM; ntot = nM * nN; c0 = c0_; nw = nw_; c = c_; }
    __host__ __device__ bool next(int i, Unit& u) const {
        if (c < c0 || c >= c0 + nw) return false;
        const int L = i * nw + (c - c0); if (L >= ntot) return false;
        u.pm = L / nN; u.pn = L % nN; return true;
    }
    __device__ __forceinline__ void a_ready(const Unit&) const {}
    __device__ __forceinline__ void done(const Unit&) const {}
};

struct ZeroOrder : StaticOrder {
    __host__ __device__ bool next(int i, Unit& u) const { const bool r = StaticOrder::next(i, u); u.pm = 0; u.pn = 0; return r; }
};

struct EpiResBf {
    static constexpr bool PERM = true, AFTER_DRAIN = false;
    bf16_t* Y; const bf16_t* res; int ldc; float alpha;
    __device__ __forceinline__ void operator()(const f32x4 (&acc)[2][2][4][2], const Unit& u, int wr, int wc, int fr, int fq) const {
        const int row0 = u.pm * BM + wr * 64 + fr, col0 = u.pn * BM + wc * 32 + 8 * fq;
#pragma unroll
        for (int ai = 0; ai < 2; ++ai)
#pragma unroll
            for (int m = 0; m < 4; ++m) { const size_t off = (size_t)(row0 + ai * HALF + m * 16) * ldc + col0;
#pragma unroll
                for (int bj = 0; bj < 2; ++bj) { const u32x4 r = *(const u32x4*)(res + off + bj * HALF);
                    const f32x4 v0 = acc[ai][bj][m][0], v1 = acc[ai][bj][m][1];
                    u32x4 w;
                    w.x = cvt_pk_bf16(__builtin_bit_cast(float, r.x << 16) * alpha + v0[0], __builtin_bit_cast(float, r.x & 0xffff0000u) * alpha + v0[1]);
                    w.y = cvt_pk_bf16(__builtin_bit_cast(float, r.y << 16) * alpha + v0[2], __builtin_bit_cast(float, r.y & 0xffff0000u) * alpha + v0[3]);
                    w.z = cvt_pk_bf16(__builtin_bit_cast(float, r.z << 16) * alpha + v1[0], __builtin_bit_cast(float, r.z & 0xffff0000u) * alpha + v1[1]);
                    w.w = cvt_pk_bf16(__builtin_bit_cast(float, r.w << 16) * alpha + v1[2], __builtin_bit_cast(float, r.w & 0xffff0000u) * alpha + v1[3]);
                    *(u32x4*)(Y + off + bj * HALF) = w; } }
    }
};

struct EpiResF {
    static constexpr bool PERM = true, AFTER_DRAIN = false;
    float* Y; const bf16_t* res; int ldc; float alpha;
    __device__ __forceinline__ void operator()(const f32x4 (&acc)[2][2][4][2], const Unit& u, int wr, int wc, int fr, int fq) const {
        const int row0 = u.pm * BM + wr * 64 + fr, col0 = u.pn * BM + wc * 32 + 8 * fq;
#pragma unroll
        for (int ai = 0; ai < 2; ++ai)
#pragma unroll
            for (int m = 0; m < 4; ++m) { const size_t off = (size_t)(row0 + ai * HALF + m * 16) * ldc + col0;
#pragma unroll
                for (int bj = 0; bj < 2; ++bj) { const u32x4 r = *(const u32x4*)(res + off + bj * HALF);
                    f32x4 o0, o1;
                    o0[0] = __builtin_bit_cast(float, r.x << 16); o0[1] = __builtin_bit_cast(float, r.x & 0xffff0000u); o0[2] = __builtin_bit_cast(float, r.y << 16); o0[3] = __builtin_bit_cast(float, r.y & 0xffff0000u);
                    o1[0] = __builtin_bit_cast(float, r.z << 16); o1[1] = __builtin_bit_cast(float, r.z & 0xffff0000u); o1[2] = __builtin_bit_cast(float, r.w << 16); o1[3] = __builtin_bit_cast(float, r.w & 0xffff0000u);
                    *(f32x4*)(Y + off + bj * HALF) = o0 * alpha + acc[ai][bj][m][0]; *(f32x4*)(Y + off + bj * HALF + 4) = o1 * alpha + acc[ai][bj][m][1]; } }
    }
};

struct EpiResLn {
    static constexpr bool PERM = true, AFTER_DRAIN = false;
    bf16_t* Y; const float* stats; const float* g; const float* b; int ldc; float alpha;
    __device__ __forceinline__ void operator()(const f32x4 (&acc)[2][2][4][2], const Unit& u, int wr, int wc, int fr, int fq) const {
        const int row0 = u.pm * BM + wr * 64 + fr, col0 = u.pn * BM + wc * 32 + 8 * fq;
        f32x4 gv[2][2], bv[2][2];
#pragma unroll
        for (int bj = 0; bj < 2; ++bj)
#pragma unroll
            for (int n = 0; n < 2; ++n) { gv[bj][n] = *(const f32x4*)(g + col0 + bj * HALF + 4 * n) * alpha; bv[bj][n] = *(const f32x4*)(b + col0 + bj * HALF + 4 * n) * alpha; }
#pragma unroll
        for (int ai = 0; ai < 2; ++ai)
#pragma unroll
            for (int m = 0; m < 4; ++m) { const int row = row0 + ai * HALF + m * 16; const size_t off = (size_t)row * ldc + col0;
                const float mean = stats[2 * row], rstd = stats[2 * row + 1];
#pragma unroll
                for (int bj = 0; bj < 2; ++bj) { const u32x4 r = *(const u32x4*)(Y + off + bj * HALF);
                    f32x4 y0, y1;
                    y0[0] = __builtin_bit_cast(float, r.x << 16); y0[1] = __builtin_bit_cast(float, r.x & 0xffff0000u); y0[2] = __builtin_bit_cast(float, r.y << 16); y0[3] = __builtin_bit_cast(float, r.y & 0xffff0000u);
                    y1[0] = __builtin_bit_cast(float, r.z << 16); y1[1] = __builtin_bit_cast(float, r.z & 0xffff0000u); y1[2] = __builtin_bit_cast(float, r.w << 16); y1[3] = __builtin_bit_cast(float, r.w & 0xffff0000u);
                    const f32x4 o0 = (y0 - mean) * rstd * gv[bj][0] + bv[bj][0] + acc[ai][bj][m][0], o1 = (y1 - mean) * rstd * gv[bj][1] + bv[bj][1] + acc[ai][bj][m][1];
                    u32x4 w; w.x = cvt_pk_bf16(o0[0], o0[1]); w.y = cvt_pk_bf16(o0[2], o0[3]); w.z = cvt_pk_bf16(o1[0], o1[1]); w.w = cvt_pk_bf16(o1[2], o1[3]);
                    *(u32x4*)(Y + off + bj * HALF) = w; } }
    }
};

constexpr float RS_SCALE = 1048576.0f, RS_INV = 1.0f / 1048576.0f;
__device__ __forceinline__ float fx20_to_f(long long v) { return (float)(int)(v >> 20) + (float)((unsigned)v & 0xFFFFFu) * RS_INV; }
__device__ __forceinline__ long long f_to_fx20(float s) { const float fl = floorf(s); return ((long long)(int)fl << 20) + (long long)(unsigned)((s - fl) * RS_SCALE + 0.5f); }
__device__ __forceinline__ void row_stats(const long long* rs, int row, float& mean, float& rstd) {
    const long long a = rs[2 * (size_t)row], b = rs[2 * (size_t)row + 1];
    mean = fx20_to_f(a) * (1.0f / 4096.0f); const float var = fx20_to_f(b) * (1.0f / 4096.0f) - mean * mean; rstd = __builtin_amdgcn_rsqf(var + 1e-5f);
}
constexpr float FOLD_SCALE = 4294967296.0f, FOLD_INV = 1.0f / 4294967296.0f;
struct EpiBf16Ln {
    static constexpr bool PERM = true, AFTER_DRAIN = false;
    bf16_t* O; int ldc; const long long* rs; const float* cs; const float* b2;
    __device__ __forceinline__ void operator()(const f32x4 (&acc)[2][2][4][2], const Unit& u, int wr, int wc, int fr, int fq) const {
        const int row0 = u.pm * BM + wr * 64 + fr, col0 = u.pn * BM + wc * 32 + 8 * fq;
        f32x4 cv[2][2], bv[2][2];
#pragma unroll
        for (int bj = 0; bj < 2; ++bj)
#pragma unroll
            for (int n = 0; n < 2; ++n) { cv[bj][n] = *(const f32x4*)(cs + col0 + bj * HALF + 4 * n); bv[bj][n] = *(const f32x4*)(b2 + col0 + bj * HALF + 4 * n); }
#pragma unroll
        for (int ai = 0; ai < 2; ++ai)
#pragma unroll
            for (int m = 0; m < 4; ++m) { const int row = row0 + ai * HALF + m * 16; float mean, rstd; row_stats(rs, row, mean, rstd);
                bf16_t* rowp = O + (size_t)row * ldc + col0;
#pragma unroll
                for (int bj = 0; bj < 2; ++bj) { const f32x4 v0 = (acc[ai][bj][m][0] - cv[bj][0] * mean) * rstd + bv[bj][0], v1 = (acc[ai][bj][m][1] - cv[bj][1] * mean) * rstd + bv[bj][1];
                    u32x4 w; w.x = cvt_pk_bf16(v0[0], v0[1]); w.y = cvt_pk_bf16(v0[2], v0[3]); w.z = cvt_pk_bf16(v1[0], v1[1]); w.w = cvt_pk_bf16(v1[2], v1[3]);
                    *(u32x4*)(rowp + bj * HALF) = w; } }
    }
};
__device__ __forceinline__ void row_sums_add(long long* rso, int row, const f32x4& a, const f32x4& b, const f32x4& c, const f32x4& d, int fq) {
    float s1 = ((a[0] + a[1]) + (a[2] + a[3])) + ((b[0] + b[1]) + (b[2] + b[3])) + ((c[0] + c[1]) + (c[2] + c[3])) + ((d[0] + d[1]) + (d[2] + d[3]));
    float s2 = ((a[0] * a[0] + a[1] * a[1]) + (a[2] * a[2] + a[3] * a[3])) + ((b[0] * b[0] + b[1] * b[1]) + (b[2] * b[2] + b[3] * b[3]))
             + ((c[0] * c[0] + c[1] * c[1]) + (c[2] * c[2] + c[3] * c[3])) + ((d[0] * d[0] + d[1] * d[1]) + (d[2] * d[2] + d[3] * d[3]));
    s1 += __shfl_xor(s1, 16); s1 += __shfl_xor(s1, 32); s2 += __shfl_xor(s2, 16); s2 += __shfl_xor(s2, 32);
    if (fq == 0) { atomicAdd((unsigned long long*)(rso + 2 * (size_t)row), (unsigned long long)f_to_fx20(s1)); atomicAdd((unsigned long long*)(rso + 2 * (size_t)row + 1), (unsigned long long)f_to_fx20(s2)); }
}
struct EpiRes0 {
    static constexpr bool PERM = true, AFTER_DRAIN = false;
    bf16_t* Y; const bf16_t* res; int ldc; float alpha; long long* rso;
    __device__ __forceinline__ void operator()(const f32x4 (&acc)[2][2][4][2], const Unit& u, int wr, int wc, int fr, int fq) const {
        const int row0 = u.pm * BM + wr * 64 + fr, col0 = u.pn * BM + wc * 32 + 8 * fq;
#pragma unroll
        for (int ai = 0; ai < 2; ++ai)
#pragma unroll
            for (int m = 0; m < 4; ++m) { const int row = row0 + ai * HALF + m * 16; const size_t off = (size_t)row * ldc + col0; f32x4 o[2][2];
#pragma unroll
                for (int bj = 0; bj < 2; ++bj) { const u32x4 r = *(const u32x4*)(res + off + bj * HALF);
                    f32x4 y0, y1;
                    y0[0] = __builtin_bit_cast(float, r.x << 16); y0[1] = __builtin_bit_cast(float, r.x & 0xffff0000u); y0[2] = __builtin_bit_cast(float, r.y << 16); y0[3] = __builtin_bit_cast(float, r.y & 0xffff0000u);
                    y1[0] = __builtin_bit_cast(float, r.z << 16); y1[1] = __builtin_bit_cast(float, r.z & 0xffff0000u); y1[2] = __builtin_bit_cast(float, r.w << 16); y1[3] = __builtin_bit_cast(float, r.w & 0xffff0000u);
                    o[bj][0] = y0 * alpha + acc[ai][bj][m][0]; o[bj][1] = y1 * alpha + acc[ai][bj][m][1];
                    u32x4 w; w.x = cvt_pk_bf16(o[bj][0][0], o[bj][0][1]); w.y = cvt_pk_bf16(o[bj][0][2], o[bj][0][3]); w.z = cvt_pk_bf16(o[bj][1][0], o[bj][1][1]); w.w = cvt_pk_bf16(o[bj][1][2], o[bj][1][3]);
                    *(u32x4*)(Y + off + bj * HALF) = w; }
                row_sums_add(rso, row, o[0][0], o[0][1], o[1][0], o[1][1], fq); }
    }
};
struct EpiResLn2 {
    static constexpr bool PERM = true, AFTER_DRAIN = false;
    bf16_t* Y; const long long* rsi; const float* g; const float* b; int ldc; float alpha; long long* rso;
    __device__ __forceinline__ void operator()(const f32x4 (&acc)[2][2][4][2], const Unit& u, int wr, int wc, int fr, int fq) const {
        const int row0 = u.pm * BM + wr * 64 + fr, col0 = u.pn * BM + wc * 32 + 8 * fq;
        f32x4 gv[2][2], bv[2][2];
#pragma unroll
        for (int bj = 0; bj < 2; ++bj)
#pragma unroll
            for (int n = 0; n < 2; ++n) { gv[bj][n] = *(const f32x4*)(g + col0 + bj * HALF + 4 * n) * alpha; bv[bj][n] = *(const f32x4*)(b + col0 + bj * HALF + 4 * n) * alpha; }
#pragma unroll
        for (int ai = 0; ai < 2; ++ai)
#pragma unroll
            for (int m = 0; m < 4; ++m) { const int row = row0 + ai * HALF + m * 16; const size_t off = (size_t)row * ldc + col0; float mean, rstd; row_stats(rsi, row, mean, rstd); f32x4 o[2][2];
#pragma unroll
                for (int bj = 0; bj < 2; ++bj) { const u32x4 r = *(const u32x4*)(Y + off + bj * HALF);
                    f32x4 y0, y1;
                    y0[0] = __builtin_bit_cast(float, r.x << 16); y0[1] = __builtin_bit_cast(float, r.x & 0xffff0000u); y0[2] = __builtin_bit_cast(float, r.y << 16); y0[3] = __builtin_bit_cast(float, r.y & 0xffff0000u);
                    y1[0] = __builtin_bit_cast(float, r.z << 16); y1[1] = __builtin_bit_cast(float, r.z & 0xffff0000u); y1[2] = __builtin_bit_cast(float, r.w << 16); y1[3] = __builtin_bit_cast(float, r.w & 0xffff0000u);
                    o[bj][0] = (y0 - mean) * rstd * gv[bj][0] + bv[bj][0] + acc[ai][bj][m][0]; o[bj][1] = (y1 - mean) * rstd * gv[bj][1] + bv[bj][1] + acc[ai][bj][m][1];
                    u32x4 w; w.x = cvt_pk_bf16(o[bj][0][0], o[bj][0][1]); w.y = cvt_pk_bf16(o[bj][0][2], o[bj][0][3]); w.z = cvt_pk_bf16(o[bj][1][0], o[bj][1][1]); w.w = cvt_pk_bf16(o[bj][1][2], o[bj][1][3]);
                    *(u32x4*)(Y + off + bj * HALF) = w; }
                row_sums_add(rso, row, o[0][0], o[0][1], o[1][0], o[1][1], fq); }
    }
};

struct EpiBf16LnTok {
    static constexpr bool PERM = true, AFTER_DRAIN = false, AROWPERM = true;
    bf16_t* O; int ldc; const long long* rs; const float* cs; const float* b2;
    __device__ __forceinline__ void operator()(const f32x4 (&acc)[2][2][4][2], const Unit& u, int wr, int wc, int fr, int fq) const {
        const int row0 = u.pm * BM + 128 * wr + 8 * fr, col0 = u.pn * BM + wc * 32 + 8 * fq;
        f32x4 cv[2][2], bv[2][2];
#pragma unroll
        for (int bj = 0; bj < 2; ++bj)
#pragma unroll
            for (int n = 0; n < 2; ++n) { cv[bj][n] = *(const f32x4*)(cs + col0 + bj * HALF + 4 * n); bv[bj][n] = *(const f32x4*)(b2 + col0 + bj * HALF + 4 * n); }
#pragma unroll
        for (int ai = 0; ai < 2; ++ai)
#pragma unroll
            for (int m = 0; m < 4; ++m) { const int row = row0 + 4 * ai + m; float mean, rstd; row_stats(rs, row, mean, rstd);
                bf16_t* rowp = O + (size_t)row * ldc + col0;
#pragma unroll
                for (int bj = 0; bj < 2; ++bj) { const f32x4 v0 = (acc[ai][bj][m][0] - cv[bj][0] * mean) * rstd + bv[bj][0], v1 = (acc[ai][bj][m][1] - cv[bj][1] * mean) * rstd + bv[bj][1];
                    u32x4 w; w.x = cvt_pk_bf16(v0[0], v0[1]); w.y = cvt_pk_bf16(v0[2], v0[3]); w.z = cvt_pk_bf16(v1[0], v1[1]); w.w = cvt_pk_bf16(v1[2], v1[3]);
                    *(u32x4*)(rowp + bj * HALF) = w; } }
    }
};

__device__ __forceinline__ float dpp_shr1(float x) { return __builtin_bit_cast(float, __builtin_amdgcn_update_dpp(0, __builtin_bit_cast(int, x), 0x111, 0xf, 0xf, true)); }
struct EpiConvGlu {
    static constexpr bool PERM = true, AFTER_DRAIN = false, AROWPERM = true;
    bf16_t* G; bf16_t* side; const long long* rs; const float* cs; const float* b2; const float* cw; int dff;
    __device__ __forceinline__ void operator()(const f32x4 (&acc)[2][2][4][2], const Unit& u, int wr, int wc, int fr, int fq) const {
        const int row0 = u.pm * BM + 128 * wr + 8 * fr, colg = u.pn * BM + wc * 32 + 8 * fq, ch0 = u.pn * HALF + wc * 32 + 8 * fq;
        float mean_[8], rstd_[8];
#pragma unroll
        for (int j = 0; j < 8; ++j) row_stats(rs, row0 + j, mean_[j], rstd_[j]);
        float mr_[8];
#pragma unroll
        for (int j = 0; j < 8; ++j) mr_[j] = mean_[j] * rstd_[j];
        unsigned gout[8][4];
        const int bnd = row0 >> 7;
#pragma unroll
        for (int n = 0; n < 2; ++n) {
            const f32x4 ca = *(const f32x4*)(cs + colg + 4 * n), ba = *(const f32x4*)(b2 + colg + 4 * n), cu = *(const f32x4*)(cs + colg + HALF + 4 * n), bu = *(const f32x4*)(b2 + colg + HALF + 4 * n);
            const f32x4 w0 = *(const f32x4*)(cw + ch0 + 4 * n), w1 = *(const f32x4*)(cw + dff + ch0 + 4 * n), w2 = *(const f32x4*)(cw + 2 * dff + ch0 + 4 * n);
            f32x4 a[8], uu[8];
#pragma unroll
            for (int j = 0; j < 8; ++j) { a[j] = acc[j >> 2][0][j & 3][n] * rstd_[j] + (ba - ca * mr_[j]); uu[j] = acc[j >> 2][1][j & 3][n] * rstd_[j] + (bu - cu * mr_[j]); }
            f32x4 p6, p7;
#pragma unroll
            for (int q = 0; q < 4; ++q) { p6[q] = dpp_shr1(a[6][q]); p7[q] = dpp_shr1(a[7][q]); }
            if (fr == 15 && bnd + 1 < 128) { bf16_t* sp = side + ((size_t)(bnd + 1) * 6) * dff + ch0 + 4 * n;
                *(unsigned long long*)(sp) = (unsigned long long)cvt_pk_bf16(a[6][0], a[6][1]) | ((unsigned long long)cvt_pk_bf16(a[6][2], a[6][3]) << 32);
                *(unsigned long long*)(sp + dff) = (unsigned long long)cvt_pk_bf16(a[7][0], a[7][1]) | ((unsigned long long)cvt_pk_bf16(a[7][2], a[7][3]) << 32); }
            if (fr == 0) { bf16_t* sp = side + ((size_t)bnd * 6 + 2) * dff + ch0 + 4 * n;
                *(unsigned long long*)(sp) = (unsigned long long)cvt_pk_bf16(a[0][0], a[0][1]) | ((unsigned long long)cvt_pk_bf16(a[0][2], a[0][3]) << 32);
                *(unsigned long long*)(sp + dff) = (unsigned long long)cvt_pk_bf16(a[1][0], a[1][1]) | ((unsigned long long)cvt_pk_bf16(a[1][2], a[1][3]) << 32);
                *(unsigned long long*)(sp + 2 * dff) = (unsigned long long)cvt_pk_bf16(uu[0][0], uu[0][1]) | ((unsigned long long)cvt_pk_bf16(uu[0][2], uu[0][3]) << 32);
                *(unsigned long long*)(sp + 3 * dff) = (unsigned long long)cvt_pk_bf16(uu[1][0], uu[1][1]) | ((unsigned long long)cvt_pk_bf16(uu[1][2], uu[1][3]) << 32); }
#pragma unroll
            for (int j = 0; j < 8; ++j) { const f32x4 am1 = (j == 0) ? p7 : a[j ? j - 1 : 0], am2 = (j == 0) ? p6 : (j == 1 ? p7 : a[j > 1 ? j - 2 : 0]);
                const f32x4 c = w2 * a[j] + w1 * am1 + w0 * am2;
                const f32x2 g01 = gelu_pk((f32x2){c[0], c[1]}), g23 = gelu_pk((f32x2){c[2], c[3]});
                gout[j][2 * n] = cvt_pk_bf16(g01.x * uu[j][0], g01.y * uu[j][1]); gout[j][2 * n + 1] = cvt_pk_bf16(g23.x * uu[j][2], g23.y * uu[j][3]); }
        }
#pragma unroll
        for (int j = 0; j < 8; ++j) if (!(fr == 0 && j < 2)) { u32x4 w; w.x = gout[j][0]; w.y = gout[j][1]; w.z = gout[j][2]; w.w = gout[j][3]; *(u32x4*)(G + (size_t)(row0 + j) * dff + ch0) = w; }
    }
};
template <class E, class = void> struct arowperm_v { static constexpr bool value = false; };
template <class E> struct arowperm_v<E, decltype((void)E::AROWPERM)> { static constexpr bool value = E::AROWPERM; };
template <class Epi, class Sched, bool ALIGN_EPI = false, bool SP2 = false>
__device__ __forceinline__ void gemm_phase(PG8_LAS unsigned char* lds, const Gemm g, const Sched& S, const Epi& E) {
    int tid_l = threadIdx.x; asm volatile("" : "+v"(tid_l)); const int tid = tid_l, wid = __builtin_amdgcn_readfirstlane(tid >> 6), lane = tid & 63, wr = wid >> 2, wc = wid & 3, fr = lane & 15, fq = lane >> 4;
    const int K = g.K, nt = K / BK;
    unsigned voffA[2], voffB[2];
#pragma unroll
    for (int i = 0; i < 2; ++i) { int R, C; stage_rc(tid * 16 + i * 8192, R, C); const int Rb = Epi::PERM ? ((R & ~31) + perm32(R & 31)) : R;
        const int Ra = arowperm_v<Epi>::value ? (128 * (R >> 6) + 8 * (R & 15) + ((R >> 4) & 3)) : R;
        voffA[i] = (unsigned)(Ra * K + C) * 2u; voffB[i] = (unsigned)(Rb * K + C) * 2u; }
    const size_t hstepA = arowperm_v<Epi>::value ? (size_t)4 * K * 2 : (size_t)HALF * K * 2;
    const size_t kstep = (size_t)(BK * 2);
    const size_t hstep = (size_t)HALF * K * 2;
    const size_t tstep = 2 * hstep;
    const unsigned ldsw = (unsigned)wid * 1024u;
    const int aoff = lds_byte(wr * 64 + fr, fq * 8), boff = lds_byte(wc * 32 + fr, fq * 8);
#define PG8_SA(b, h) (((b) * 2 + (h)) * HTB)
#define PG8_SB(b, h) ((4 + (b) * 2 + (h)) * HTB)
#define PG8_STAGE(bufoff, gbase, voff) do { _Pragma("unroll") for (int _i = 0; _i < 2; ++_i) \
        __builtin_amdgcn_global_load_lds((const unsigned*)((const char*)(gbase) + (voff)[_i]), (PG8_LAS unsigned*)(lds + (bufoff) + ldsw + _i * 8192), 16, 0, 0); } while (0)
#define PG8_LDA(dst, b, h) do { _Pragma("unroll") for (int m = 0; m < 4; ++m) _Pragma("unroll") for (int k = 0; k < 2; ++k) dst[m][k] = *(const PG8_LAS bf16x8*)(lds + PG8_SA(b, h) + aoff + m * 2048 + k * 1024); } while (0)
#define PG8_LDB(dst, b, h) do { _Pragma("unroll") for (int n = 0; n < 2; ++n) _Pragma("unroll") for (int k = 0; k < 2; ++k) dst[n][k] = *(const PG8_LAS bf16x8*)(lds + PG8_SB(b, h) + boff + n * 2048 + k * 1024); } while (0)
#define PG8_MMA(ai, bj, At, Bt) do { __builtin_amdgcn_s_setprio(1); _Pragma("unroll") for (int m = 0; m < 4; ++m) _Pragma("unroll") for (int n = 0; n < 2; ++n) _Pragma("unroll") for (int k = 0; k < 2; ++k) \
        acc[ai][bj][m][n] = __builtin_amdgcn_mfma_f32_16x16x32_bf16(Bt[n][k], At[m][k], acc[ai][bj][m][n], 0, 0, 0); __builtin_amdgcn_s_setprio(0); } while (0)
#define PG8_WAIT_V(n) asm volatile("s_waitcnt vmcnt(" #n ")" ::: "memory")
#define PG8_WAIT_L(n) asm volatile("s_waitcnt lgkmcnt(" #n ")" ::: "memory")
#define PG8_BAR __builtin_amdgcn_s_barrier()
#define PG8_SCHED __builtin_amdgcn_sched_barrier(0)
    Unit cur, nxt; int ui = 0;
    if (!S.next(0, cur)) return;
    f32x4 acc[2][2][4][2];
#pragma unroll
    for (int a = 0; a < 2; ++a)
#pragma unroll
        for (int b = 0; b < 2; ++b)
#pragma unroll
            for (int m = 0; m < 4; ++m)
#pragma unroll
                for (int n = 0; n < 2; ++n) acc[a][b][m][n] = (f32x4){0.f, 0.f, 0.f, 0.f};
    bf16x8 At[4][2], B0[2][2], B1[2][2];
    const char* cA = (const char*)g.A + (size_t)cur.pm * tstep; const char* cB = (const char*)g.Bt + (size_t)cur.pn * tstep;
    S.a_ready(cur);
    if constexpr (SP2) {
        PG8_STAGE(PG8_SB(0, 0), cB, voffB); PG8_STAGE(PG8_SB(0, 1), cB + hstep, voffB); PG8_STAGE(PG8_SA(0, 0), cA, voffA); PG8_STAGE(PG8_SA(0, 1), cA + hstepA, voffA);
        if (wr == 1) PG8_BAR;
        PG8_WAIT_V(2); PG8_BAR;
        PG8_STAGE(PG8_SB(1, 0), cB + kstep, voffB); PG8_STAGE(PG8_SA(1, 0), cA + kstep, voffA); PG8_STAGE(PG8_SB(1, 1), cB + hstep + kstep, voffB);
        PG8_WAIT_V(6); PG8_BAR;
    } else {
        PG8_STAGE(PG8_SB(0, 0), cB, voffB); PG8_STAGE(PG8_SA(0, 0), cA, voffA); PG8_STAGE(PG8_SB(0, 1), cB + hstep, voffB); PG8_STAGE(PG8_SA(0, 1), cA + hstepA, voffA);
        if (wr == 1) PG8_BAR;
        PG8_WAIT_V(4); PG8_BAR;
        PG8_STAGE(PG8_SB(1, 0), cB + kstep, voffB); PG8_STAGE(PG8_SA(1, 0), cA + kstep, voffA); PG8_STAGE(PG8_SB(1, 1), cB + hstep + kstep, voffB);
        PG8_WAIT_V(6); PG8_BAR;
    }
    for (;;) {
        const bool has_next = S.next(ui + 1, nxt);
        const char* nA = has_next ? (const char*)g.A + (size_t)nxt.pm * tstep : cA; const char* nB = has_next ? (const char*)g.Bt + (size_t)nxt.pn * tstep : cB;
        for (int t = 0; t < nt; t += 2) {
            const bool last = (t == nt - 2);
            const char* a1 = cA + (size_t)(t + 1) * kstep;
            const char* a2 = last ? nA : cA + (size_t)(t + 2) * kstep; const char* b2 = last ? nB : cB + (size_t)(t + 2) * kstep;
            const char* a3 = a2 + kstep; const char* b3 = b2 + kstep;
            if (last && has_next) S.a_ready(nxt);
            if constexpr (SP2) {
            PG8_LDB(B0, 0, 0); PG8_LDB(B1, 0, 1); PG8_SCHED; PG8_LDA(At, 0, 0); PG8_STAGE(PG8_SA(1, 1), a1 + hstepA, voffA);
            PG8_WAIT_V(8); PG8_WAIT_L(0); PG8_BAR; PG8_MMA(0, 0, At, B0); PG8_MMA(0, 1, At, B1); PG8_BAR; PG8_SCHED;
            PG8_LDA(At, 0, 1); PG8_STAGE(PG8_SB(0, 0), b2, voffB); PG8_STAGE(PG8_SB(0, 1), b2 + hstep, voffB); PG8_STAGE(PG8_SA(0, 0), a2, voffA);
            PG8_WAIT_V(8); PG8_WAIT_L(0); PG8_BAR; PG8_MMA(1, 0, At, B0); PG8_MMA(1, 1, At, B1); PG8_BAR; PG8_SCHED;
            PG8_LDB(B0, 1, 0); PG8_LDB(B1, 1, 1); PG8_SCHED; PG8_LDA(At, 1, 0); PG8_STAGE(PG8_SA(0, 1), a2 + hstepA, voffA);
            PG8_WAIT_V(8); PG8_WAIT_L(0); PG8_BAR; PG8_MMA(0, 0, At, B0); PG8_MMA(0, 1, At, B1); PG8_BAR; PG8_SCHED;
            PG8_LDA(At, 1, 1); PG8_STAGE(PG8_SB(1, 0), b3, voffB); PG8_STAGE(PG8_SB(1, 1), b3 + hstep, voffB); PG8_STAGE(PG8_SA(1, 0), a3, voffA);
            PG8_WAIT_V(8); PG8_WAIT_L(0); PG8_BAR; PG8_MMA(1, 0, At, B0); PG8_MMA(1, 1, At, B1); PG8_BAR; PG8_SCHED;
            } else {
            PG8_LDB(B0, 0, 0); PG8_SCHED; PG8_LDA(At, 0, 0); PG8_STAGE(PG8_SA(1, 1), a1 + hstepA, voffA);
            PG8_WAIT_L(8); PG8_BAR; PG8_WAIT_L(0); PG8_MMA(0, 0, At, B0); PG8_BAR; PG8_SCHED;
            PG8_LDB(B1, 0, 1); PG8_STAGE(PG8_SB(0, 0), b2, voffB);
            PG8_BAR; PG8_WAIT_L(0); PG8_MMA(0, 1, At, B1); PG8_BAR;
            PG8_LDA(At, 0, 1); PG8_STAGE(PG8_SA(0, 0), a2, voffA);
            PG8_BAR; PG8_WAIT_L(0); PG8_MMA(1, 0, At, B0); PG8_BAR; PG8_SCHED;
            PG8_STAGE(PG8_SB(0, 1), b2 + hstep, voffB);
            PG8_WAIT_V(6); PG8_BAR; PG8_MMA(1, 1, At, B1); PG8_BAR;
            PG8_LDB(B0, 1, 0); PG8_SCHED; PG8_LDA(At, 1, 0); PG8_STAGE(PG8_SA(0, 1), a2 + hstepA, voffA);
            PG8_WAIT_L(8); PG8_BAR; PG8_WAIT_L(0); PG8_MMA(0, 0, At, B0); PG8_BAR; PG8_SCHED;
            PG8_LDB(B1, 1, 1); PG8_STAGE(PG8_SB(1, 0), b3, voffB);
            PG8_BAR; PG8_WAIT_L(0); PG8_MMA(0, 1, At, B1); PG8_BAR;
            PG8_LDA(At, 1, 1); PG8_STAGE(PG8_SA(1, 0), a3, voffA);
            PG8_BAR; PG8_WAIT_L(0); PG8_MMA(1, 0, At, B0); PG8_BAR; PG8_SCHED;
            PG8_STAGE(PG8_SB(1, 1), b3 + hstep, voffB);
            PG8_WAIT_V(6); PG8_BAR; PG8_MMA(1, 1, At, B1); PG8_BAR;
            }
        }
        if constexpr (ALIGN_EPI) { if (wr == 0) PG8_BAR; }
        if constexpr (!Epi::AFTER_DRAIN) { E(acc, cur, wr, wc, fr, fq); S.done(cur); }
        if (!has_next) break;
#pragma unroll
        for (int a = 0; a < 2; ++a)
#pragma unroll
            for (int b = 0; b < 2; ++b)
#pragma unroll
                for (int m = 0; m < 4; ++m)
#pragma unroll
                    for (int n = 0; n < 2; ++n) acc[a][b][m][n] = (f32x4){0.f, 0.f, 0.f, 0.f};
        cur = nxt; cA = nA; cB = nB; ++ui;
        if constexpr (ALIGN_EPI) { if (wr == 1) PG8_BAR; }
    }
    PG8_WAIT_V(0);
    if constexpr (!ALIGN_EPI) { if (wr == 0) PG8_BAR; }
    PG8_BAR;
    if constexpr (Epi::AFTER_DRAIN) { E.fused(acc, cur, wr, wc, fr, fq, lds, wid, lane); S.done(cur); }
#undef PG8_SA
#undef PG8_SB
#undef PG8_STAGE
#undef PG8_LDA
#undef PG8_LDB
#undef PG8_MMA
#undef PG8_WAIT_V
#undef PG8_WAIT_L
#undef PG8_BAR
#undef PG8_SCHED
}
}

#ifndef PG8_SP2
#define PG8_SP2 true
#endif
#ifndef PG8_ALIGN
#define PG8_ALIGN true
#endif
constexpr int NWAVES = 8, NTHR = 512;
constexpr int BATCH = 2, SEQ = 8192, DM = 4096, MTOK = BATCH * SEQ;
constexpr int HD = 128;
constexpr int A_HEADS = 16, B_HEADS = 16, A_W = 2048, B_W = 2048, AB_IN = 4 * A_W + 3 * B_W;
constexpr int NSA_H = 32, NSA_G = 4, NSA_R = 8, KVW = 512, NSA_IN = 4096 + 6 * KVW + 96, NSA_INP = 7424;
constexpr int NCMP = 511, NCMPP = 512, NSLC = 128, NTOP = 16, WINDOW = 512;
constexpr int NMEM = 256, XH = 4, XW = 512;
constexpr int DFF = 11008, DFF2 = 22016;
constexpr float LN_EPS = 1e-5f, RMS_EPS = 1e-6f;
constexpr float DN_ALPHA = 1.41421356237309515f;
constexpr size_t MiB = (size_t)1 << 20;
constexpr size_t WS_CTL = 0, CTL_ZERO_BYTES = 4 * MiB;
constexpr size_t WS_FOLD = 64 * 1024;
constexpr int FO_XQ = 0, FO_UP = 2 * 512, FO_NSA = FO_UP + 2 * 22016, FO_N = FO_NSA + 7424;
constexpr size_t WS_RSUM = 1 * MiB;
static_assert(WS_FOLD + (size_t)2 * FO_N * 8 <= WS_RSUM && WS_RSUM + (size_t)6 * 16384 * 2 * 8 <= CTL_ZERO_BYTES, "CTL map");
constexpr size_t WS_W_ABIN = 4 * MiB;
constexpr size_t WS_W_ABOUT = WS_W_ABIN + 112 * MiB;
constexpr size_t WS_W_NSAIN = WS_W_ABOUT + 32 * MiB;
constexpr size_t WS_W_NSAOUT = WS_W_NSAIN + 58 * MiB;
constexpr size_t WS_W_XQ = WS_W_NSAOUT + 32 * MiB;
constexpr size_t WS_W_XKV = WS_W_XQ + 8 * MiB;
constexpr size_t WS_W_XO = WS_W_XKV + 16 * MiB;
constexpr size_t WS_W_UP = WS_W_XO + 8 * MiB;
constexpr size_t WS_W_DOWN = WS_W_UP + 344 * MiB;
constexpr size_t WS_W_C1 = WS_W_DOWN + 172 * MiB;
constexpr size_t WS_W_C2 = WS_W_C1 + 2 * MiB;
constexpr size_t WS_MEMB = WS_W_C2 + 1 * MiB;
constexpr size_t WS_HB = WS_MEMB + 4 * MiB;
constexpr size_t WS_Y = WS_HB + 128 * MiB;
constexpr size_t WS_BIG = WS_Y + 256 * MiB;
constexpr size_t WS_G = WS_BIG + 688 * MiB;
constexpr size_t WS_O = WS_G + 344 * MiB;
constexpr size_t WS_MISC = WS_O + 128 * MiB;
constexpr size_t WS_END = WS_MISC + 64 * MiB;
constexpr size_t WS_XQ = WS_MISC;
constexpr size_t WS_XO = WS_MISC + 16 * MiB;
constexpr size_t WS_XKV = WS_MISC + 32 * MiB;
constexpr size_t WS_LB = WS_MISC + 34 * MiB;
constexpr size_t WS_SIDE = WS_MISC + 42 * MiB;
constexpr size_t WS_FOLDF = WS_MISC + 40 * MiB;
constexpr size_t WS_ROPE = WS_MISC + 36 * MiB;
constexpr size_t WS_STATS = WS_MISC + 35 * MiB;
constexpr size_t WS_PROJ0 = WS_BIG;
constexpr size_t WS_SPREV = WS_BIG + 448 * MiB;
constexpr size_t WS_QT = WS_G;
constexpr size_t WS_OINTRA = WS_G + 64 * MiB;
constexpr size_t WS_DEC = WS_G + 192 * MiB;
constexpr size_t WS_DS = WS_Y;
constexpr size_t WS_PROJ1 = WS_BIG;
constexpr size_t WS_QROT = WS_BIG + 232 * MiB;
constexpr size_t WS_KSROT = WS_BIG + 360 * MiB;
constexpr size_t WS_KWROT = WS_BIG + 376 * MiB;
constexpr size_t WS_KCMP = WS_BIG + 392 * MiB;
constexpr size_t WS_VCMP = WS_BIG + 393 * MiB;
constexpr size_t WS_OVL = WS_BIG + 394 * MiB;
constexpr size_t WS_SEL = WS_BIG + 395 * MiB;
constexpr size_t WS_IMP = WS_G + 256 * MiB;
constexpr size_t WS_O32 = WS_G;
static_assert(WS_SPREV + 128 * MiB <= WS_G && WS_DEC + 2 * MiB <= WS_O && WS_SEL + MiB <= WS_G, "ws map");
constexpr int CW_TMO = 0, CW_CODE = 1;
constexpr int CW_BAR = 4096;
constexpr int RING_OFF = 0, RING_BYTES = 131072;
constexpr int LDSCTL_OFF = RING_BYTES, MISC_OFF = LDSCTL_OFF + 320;
constexpr int LDS_BYTES = 147456;
static_assert(MISC_OFF + 128 <= LDS_BYTES, "LDS map");

#define GAS __attribute__((address_space(1)))
#define LAS __attribute__((address_space(3)))
typedef unsigned short bf16;
typedef unsigned v4u __attribute__((ext_vector_type(4)));
typedef unsigned v2u __attribute__((ext_vector_type(2)));
typedef float f32x4 __attribute__((ext_vector_type(4)));
typedef float f32x2 __attribute__((ext_vector_type(2)));
typedef float f32x16 __attribute__((ext_vector_type(16)));
typedef short bf16x8 __attribute__((ext_vector_type(8)));
typedef short s16x4 __attribute__((ext_vector_type(4)));
typedef GAS unsigned gu32;
#define RLX_AGENT __ATOMIC_RELAXED, __HIP_MEMORY_SCOPE_AGENT
#define LDS_WAIT() asm volatile("s_waitcnt lgkmcnt(0)" ::: "memory")
#define VM_WAIT() asm volatile("s_waitcnt vmcnt(0)" ::: "memory")
#define SBAR() __builtin_amdgcn_sched_barrier(0)
__device__ __forceinline__ unsigned f2bf(float f) { unsigned u = __builtin_bit_cast(unsigned, f); return (u + 0x7fffu + ((u >> 16) & 1u)) >> 16; }
__device__ __forceinline__ unsigned pk2(float lo, float hi) { return f2bf(lo) | (f2bf(hi) << 16); }
__device__ __forceinline__ float bf2f(unsigned short b) { return __builtin_bit_cast(float, (unsigned)b << 16); }
__device__ __forceinline__ float bflo(unsigned w) { return __builtin_bit_cast(float, w << 16); }
__device__ __forceinline__ float bfhi(unsigned w) { return __builtin_bit_cast(float, w & 0xffff0000u); }
__device__ __forceinline__ unsigned cvtpk(float lo, float hi) { unsigned r; asm volatile("v_cvt_pk_bf16_f32 %0, %1, %2" : "=v"(r) : "v"(lo), "v"(hi)); return r; }
__device__ __forceinline__ float wave_sum(float v) {
#pragma unroll
    for (int o = 1; o < 64; o <<= 1) v += __shfl_xor(v, o);
    return v;
}
__device__ __forceinline__ float sigmoidf_(float x) { return __builtin_amdgcn_rcpf(1.f + __builtin_amdgcn_exp2f(-1.4426950408889634f * x)); }
__device__ __forceinline__ float gelu1(float v) { pg8::f32x2 r = pg8::gelu_pk((pg8::f32x2){v, 0.f}); return r.x; }
#define XB_TMO      128
#define XB_XCNT(j)  (256  + 64 * (j))
#define XB_XSUB(j)  (1280 + 64 * (j))
#define XB_XGEN(j)  (2304 + 64 * (j))
#define XB_TOP      3328
#define XB_TOPGEN   3392
#define XCD_BAR_WORDS 3456
#define XB_SPIN_CAP (1u << 18)
#define LAS __attribute__((address_space(3)))

__device__ __forceinline__ unsigned xb_ld(unsigned* p)              { return __hip_atomic_load(p, __ATOMIC_RELAXED, __HIP_MEMORY_SCOPE_AGENT); }
__device__ __forceinline__ unsigned xb_add(unsigned* p, unsigned v) { return __hip_atomic_fetch_add(p, v, __ATOMIC_RELAXED, __HIP_MEMORY_SCOPE_AGENT); }
__device__ __forceinline__ unsigned xb_xcc_id() { return (unsigned)__builtin_amdgcn_s_getreg((3 << 11) | 20) & 0xFu; }
#define XB_SPIN(cond, bar) do { unsigned _sp = 0; while (cond) { __builtin_amdgcn_s_sleep(1); \
    if ((++_sp & 255u) == 0u) { if (xb_ld(&(bar)[XB_TMO])) break; if (_sp > XB_SPIN_CAP) { atomicAdd(&(bar)[XB_TMO], 1u); break; } } } } while (0)

struct XcdBarrier {
    unsigned* bar; unsigned x;
    volatile LAS unsigned* st;
};

__device__ __forceinline__ XcdBarrier xcd_barrier_post(unsigned* bar, volatile LAS unsigned* st) {
    XcdBarrier b; b.bar = bar; b.x = xb_xcc_id(); b.st = st;
    if (threadIdx.x == 0) (void)xb_add(&bar[XB_XCNT(b.x)], 1u);
    return b;
}
__device__ __forceinline__ void xcd_barrier_complete(unsigned* bar, unsigned x, unsigned& nloc, unsigned& nx) {
    const unsigned G = gridDim.x * gridDim.y * gridDim.z;
    unsigned sum, cnt, mine, sp = 0u;
    for (;;) {
        sum = 0u; cnt = 0u; mine = 0u;
#pragma unroll
        for (unsigned j = 0; j < 16; ++j) { const unsigned c = xb_ld(&bar[XB_XCNT(j)]); sum += c; cnt += (c > 0u) ? 1u : 0u; mine = (j == x) ? c : mine; }
        if (sum == G) break;
        __builtin_amdgcn_s_sleep(1);
        if ((++sp & 255u) == 0u) { if (xb_ld(&bar[XB_TMO])) break; if (sp > XB_SPIN_CAP) { atomicAdd(&bar[XB_TMO], 1u); break; } }
    }
    nloc = mine > 0u ? mine : 1u; nx = cnt > 0u ? cnt : 1u;
}

__device__ __forceinline__ void xcd_barrier(const XcdBarrier& b) {
    asm volatile("s_waitcnt vmcnt(0)" ::: "memory");
    __syncthreads();
    if (threadIdx.x == 0) {
        unsigned* bar = b.bar;
        __builtin_amdgcn_s_waitcnt(0);
        unsigned nloc = b.st[0], nx = b.st[1];
        if (nloc == 0u) { xcd_barrier_complete(bar, b.x, nloc, nx); b.st[0] = nloc; b.st[1] = nx; }
        const unsigned old = xb_add(&bar[XB_XSUB(b.x)], 1u);
        const unsigned gen = old / nloc;
        if (old + 1u == (gen + 1u) * nloc) {
            __builtin_amdgcn_fence(__ATOMIC_RELEASE, "agent");
            asm volatile("s_waitcnt vmcnt(0)" ::: "memory");
            const unsigned og = xb_add(&bar[XB_TOP], 1u);
            const unsigned tg = og / nx;
            if (og + 1u == (tg + 1u) * nx) xb_add(&bar[XB_TOPGEN], 1u);
            else XB_SPIN(xb_ld(&bar[XB_TOPGEN]) == tg, bar);
            __builtin_amdgcn_fence(__ATOMIC_ACQUIRE, "agent");
            xb_add(&bar[XB_XGEN(b.x)], 1u);
            asm volatile("s_waitcnt vmcnt(0)" ::: "memory");
        } else {
            XB_SPIN(xb_ld(&bar[XB_XGEN(b.x)]) == gen, bar);
            __builtin_amdgcn_fence(__ATOMIC_ACQUIRE, "agent");
            asm volatile("s_waitcnt vmcnt(0)" ::: "memory");
        }
    }
    __syncthreads();
}


constexpr int ATT_D = 128, KVBLK = 64;
constexpr int SHM_V = KVBLK * ATT_D * 2, SHM_K = KVBLK * ATT_D * 2;
constexpr int ATT_K_OFF = 0, ATT_V_OFF = SHM_K, ATT_BUF = SHM_K + SHM_V, ATT_SET = 2 * ATT_BUF;
constexpr int ATT_WS_OFF = RING_BYTES + 512;
constexpr int ATT_X_OFF = ATT_WS_OFF + NWAVES * 256;
static_assert(2 * ATT_SET <= RING_BYTES && ATT_X_OFF + 2048 + NTHR * 16 <= LDS_BYTES, "attention LDS map");
#define KSWZ(row, colB) ((row) * 256 + ((colB) ^ (((row) & 15) << 4)))
__device__ __forceinline__ int crow(int r, int hi) { return (r & 3) + 8 * (r >> 2) + 4 * hi; }
__device__ __forceinline__ int v_st(int k, int c) { const int kk = (k & ~0xC) | ((k & 4) << 1) | ((k & 8) >> 1); return ((kk >> 3) * 4 + (c >> 5)) * 512 + ((kk & 7) * 32 + (c & 31)) * 2; }
__device__ __forceinline__ int v_rd_base(int lane) { return ((lane & 3) << 3) | (((lane >> 2) & 3) << 6) | (((lane >> 4) & 1) << 5) | (((lane >> 5) & 1) << 8); }
constexpr int v_rd_off(int d0, int ks, int half) { return d0 * 512 + ks * 4096 + half * 2048; }
template <int OFF> __device__ __forceinline__ s16x4 tr_read(int vb) {
  s16x4 r; asm volatile("ds_read_b64_tr_b16 %0, %1 offset:%2" : "=&v"(r) : "v"(vb), "i"(OFF) : "memory"); return r;
}
__device__ __forceinline__ void qkt(f32x16& p0, f32x16& p1, const LAS char* Ks, const bf16x8* qr, int r32, int hi) {
  p0 = f32x16{}; p1 = f32x16{};
#pragma unroll
  for (int d0 = 0; d0 < 8; ++d0) { const int cb = (d0 * 16 + hi * 8) * 2;
    const bf16x8 b0 = *(const LAS bf16x8*)(Ks + KSWZ(r32, cb));
    const bf16x8 b1 = *(const LAS bf16x8*)(Ks + KSWZ(32 + r32, cb));
    p0 = __builtin_amdgcn_mfma_f32_32x32x16_bf16(b0, qr[d0], p0, 0, 0, 0);
    p1 = __builtin_amdgcn_mfma_f32_32x32x16_bf16(b1, qr[d0], p1, 0, 0, 0); }
}
__device__ __forceinline__ void pack_p(const f32x16& p0, const f32x16& p1, bf16x8& pa0, bf16x8& pa1, bf16x8& pa2, bf16x8& pa3) {
#define PK4(P, BASE, OUT) do { unsigned a0 = cvtpk(P[BASE + 0], P[BASE + 1]), a1 = cvtpk(P[BASE + 2], P[BASE + 3]);   \
    unsigned b0 = cvtpk(P[BASE + 4], P[BASE + 5]), b1 = cvtpk(P[BASE + 6], P[BASE + 7]);                              \
    auto r0 = __builtin_amdgcn_permlane32_swap(a0, b0, false, false); auto r1 = __builtin_amdgcn_permlane32_swap(a1, b1, false, false); \
    v4u w = {r0[0], r1[0], r0[1], r1[1]}; OUT = __builtin_bit_cast(bf16x8, w); } while (0)
  PK4(p0, 0, pa0); PK4(p0, 8, pa1); PK4(p1, 0, pa2); PK4(p1, 8, pa3);
#undef PK4
}
template <int D0> __device__ __forceinline__ void pv_one(f32x16& od, int vb, bf16x8 pa0, bf16x8 pa1, bf16x8 pa2, bf16x8 pa3) {
  const s16x4 l0 = tr_read<v_rd_off(D0, 0, 0)>(vb), h0 = tr_read<v_rd_off(D0, 0, 1)>(vb), l1 = tr_read<v_rd_off(D0, 1, 0)>(vb), h1 = tr_read<v_rd_off(D0, 1, 1)>(vb);
  const s16x4 l2 = tr_read<v_rd_off(D0, 2, 0)>(vb), h2 = tr_read<v_rd_off(D0, 2, 1)>(vb), l3 = tr_read<v_rd_off(D0, 3, 0)>(vb), h3 = tr_read<v_rd_off(D0, 3, 1)>(vb);
  asm volatile("s_waitcnt lgkmcnt(0)" ::: "memory"); SBAR();
#define PKV(L, H) (bf16x8){L[0], L[1], L[2], L[3], H[0], H[1], H[2], H[3]}
  od = __builtin_amdgcn_mfma_f32_32x32x16_bf16(pa0, PKV(l0, h0), od, 0, 0, 0);
  od = __builtin_amdgcn_mfma_f32_32x32x16_bf16(pa1, PKV(l1, h1), od, 0, 0, 0);
  od = __builtin_amdgcn_mfma_f32_32x32x16_bf16(pa2, PKV(l2, h2), od, 0, 0, 0);
  od = __builtin_amdgcn_mfma_f32_32x32x16_bf16(pa3, PKV(l3, h3), od, 0, 0, 0);
#undef PKV
}
__device__ __forceinline__ void pv_d0(f32x16* o, int vb, bf16x8 pa0, bf16x8 pa1, bf16x8 pa2, bf16x8 pa3) {
  pv_one<0>(o[0], vb, pa0, pa1, pa2, pa3); pv_one<1>(o[1], vb, pa0, pa1, pa2, pa3); pv_one<2>(o[2], vb, pa0, pa1, pa2, pa3); pv_one<3>(o[3], vb, pa0, pa1, pa2, pa3);
}
struct KVStage { bf16x8 ks0, ks1, vs0, vs1; };
__device__ __forceinline__ void kv_load(KVStage& s, const bf16* Kh, const bf16* Vh, long ldk, long ldv, int k0, int sr, int sc) {
  s.ks0 = *(const bf16x8*)(Kh + (long)(k0 + sr) * ldk + sc); s.ks1 = *(const bf16x8*)(Kh + (long)(k0 + 32 + sr) * ldk + sc);
  s.vs0 = *(const bf16x8*)(Vh + (long)(k0 + sr) * ldv + sc); s.vs1 = *(const bf16x8*)(Vh + (long)(k0 + 32 + sr) * ldv + sc);
}
__device__ __forceinline__ void kv_write(const KVStage& s, LAS char* lds, int sr, int sc) {
  *(LAS bf16x8*)(lds + ATT_V_OFF + v_st(sr, sc)) = s.vs0; *(LAS bf16x8*)(lds + ATT_V_OFF + v_st(32 + sr, sc)) = s.vs1;
  *(LAS bf16x8*)(lds + ATT_K_OFF + KSWZ(sr, sc * 2)) = s.ks0; *(LAS bf16x8*)(lds + ATT_K_OFF + KSWZ(32 + sr, sc * 2)) = s.ks1;
}
struct KVDma { int ko[2], vo[2]; };
__device__ __forceinline__ void kv_dma_init(KVDma& d, int ldk, int ldv, int wid, int lane) {
#pragma unroll
  for (int i = 0; i < 2; ++i) { const int p = wid * 2 + i;
    const int row = p * 4 + (lane >> 4), cp = lane & 15; d.ko[i] = row * ldk + ((cp ^ (row & 15)) << 3);
    const int sub = p * 2 + (lane >> 5), kk = (sub >> 2) * 8 + ((lane & 31) >> 2), k = (kk & ~0xC) | ((kk & 4) << 1) | ((kk & 8) >> 1), c = (sub & 3) * 32 + (lane & 3) * 8;
    d.vo[i] = k * ldv + c; }
}
__device__ __forceinline__ void kv_dma(const KVDma& d, const bf16* Kt, const bf16* Vt, LAS char* lds, int buf, int wid) {
#pragma unroll
  for (int i = 0; i < 2; ++i) {
    __builtin_amdgcn_global_load_lds((const unsigned*)(Kt + d.ko[i]), (LAS unsigned*)(lds + buf + ATT_K_OFF + (wid * 2 + i) * 1024), 16, 0, 0);
    __builtin_amdgcn_global_load_lds((const unsigned*)(Vt + d.vo[i]), (LAS unsigned*)(lds + buf + ATT_V_OFF + (wid * 2 + i) * 1024), 16, 0, 0); }
}
__device__ __forceinline__ void rescale_o(f32x16* o, float a, LAS float* al_l, int r32, int hi) {
  if (__any(a < 1.f)) { if (hi == 0) al_l[r32] = a; LDS_WAIT();
#pragma unroll
    for (int r = 0; r < 16; ++r) { const float f = al_l[crow(r, hi)];
#pragma unroll
      for (int d = 0; d < 4; ++d) o[d][r] *= f; }
    LDS_WAIT(); }
}
constexpr float ATT_SCALE = 0.088388347648318440f, ATT_C = ATT_SCALE * 1.4426950408889634f, ATT_THR = 8.f;
__device__ __forceinline__ void softmax_tile(f32x16& p0, f32x16& p1, float& m_reg, float& l_reg, float& alpha, bool rowvalid = true) {
  float pmax = p0[0];
#pragma unroll
  for (int r = 1; r < 16; ++r) pmax = fmaxf(pmax, p0[r]);
#pragma unroll
  for (int r = 0; r < 16; ++r) pmax = fmaxf(pmax, p1[r]);
  { auto rr = __builtin_amdgcn_permlane32_swap(__float_as_uint(pmax), __float_as_uint(pmax), false, false);
    pmax = fmaxf(__uint_as_float(rr[0]), __uint_as_float(rr[1])); }
  if (!rowvalid) pmax = -__builtin_inff();
  float mn;
  if (__all(pmax - m_reg <= ATT_THR / ATT_SCALE)) { mn = m_reg; alpha = 1.f; }
  else { mn = fmaxf(m_reg, pmax); alpha = __builtin_amdgcn_exp2f((m_reg - mn) * ATT_C); m_reg = mn; }
  const float mnC = rowvalid ? -mn * ATT_C : -__builtin_inff();
#pragma unroll
  for (int r = 0; r < 16; ++r) { p0[r] = __builtin_amdgcn_exp2f(fmaf(p0[r], ATT_C, mnC)); p1[r] = __builtin_amdgcn_exp2f(fmaf(p1[r], ATT_C, mnC)); }
  float ps = 0.f;
#pragma unroll
  for (int r = 0; r < 16; ++r) ps += p0[r] + p1[r];
  { auto rr = __builtin_amdgcn_permlane32_swap(__float_as_uint(ps), __float_as_uint(ps), false, false);
    ps = __uint_as_float(rr[0]) + __uint_as_float(rr[1]); }
  l_reg = l_reg * alpha + ps;
}
__device__ __forceinline__ void attn_finish(f32x16& p0, f32x16& p1, f32x16* o, float& m_reg, float& l_reg, LAS float* wsc, int vb, int r32, int hi, bool rowvalid = true) {
  float alpha; softmax_tile(p0, p1, m_reg, l_reg, alpha, rowvalid);
  rescale_o(o, alpha, wsc, r32, hi);
  bf16x8 pa0, pa1, pa2, pa3; pack_p(p0, p1, pa0, pa1, pa2, pa3);
  pv_d0(o, vb, pa0, pa1, pa2, pa3);
}
__device__ __forceinline__ void load_q(bf16x8* qr, const bf16* Qw) {
#pragma unroll
  for (int d0 = 0; d0 < 8; ++d0) qr[d0] = *(const bf16x8*)(Qw + d0 * 16);
}

struct Frame {
    LAS unsigned char* lds;
    unsigned char* ws;
    int tid, lane, wave, G, bid;
    __device__ __forceinline__ void fresh() { int t = threadIdx.x; asm volatile("" : "+v"(t)); tid = t; lane = t & 63; wave = __builtin_amdgcn_readfirstlane(t >> 6);
        int g_ = gridDim.x, b_ = blockIdx.x; asm volatile("" : "+s"(g_), "+s"(b_)); G = g_; bid = b_; }
};
struct Args { const float* in[19]; float* out; unsigned char* ws; int ph_lo, ph_hi; };
typedef const Args __attribute__((address_space(4))) KArgs;
__device__ __forceinline__ KArgs* karg() { KArgs* p = (KArgs*)__builtin_amdgcn_kernarg_segment_ptr(); asm volatile("" : "+s"(p)); return p; }
#define KIN(i) ((const float*)karg()->in[i])
enum { IN_X = 0, IN_MEM, IN_AB_W_IN, IN_HGRN_LB, IN_HGRN_NW, IN_AB_W_OUT, IN_NSA_W_IN, IN_NSA_CMP_POS, IN_NSA_CMP_W1, IN_NSA_CMP_W2, IN_NSA_W_OUT,
       IN_XA_WQ, IN_XA_WKV, IN_XA_WO, IN_FFN_UP, IN_FFN_CONV, IN_FFN_DOWN, IN_LN_G, IN_LN_B };

__device__ __forceinline__ void p0_transpose_item(const float* W, int K, int N, bf16* WT, LAS float* scr, int item, int lane) {
    const int nblk = N / 32, kb = item / nblk, nb = item % nblk, k0 = 64 * kb, n0 = 32 * nb;
#pragma unroll 8
    for (int i = 0; i < 32; ++i) { const int kk = 2 * i + (lane >> 5); scr[kk * 33 + (lane & 31)] = W[(size_t)(k0 + kk) * N + n0 + (lane & 31)]; }
    LDS_WAIT(); asm volatile("" ::: "memory");
    const int c = lane & 7;
#pragma unroll
    for (int j = 0; j < 4; ++j) { const int n = (lane >> 3) + 8 * j; const LAS float* s = scr + (8 * c) * 33 + n;
        v4u o; o.x = pk2(s[0 * 33], s[1 * 33]); o.y = pk2(s[2 * 33], s[3 * 33]); o.z = pk2(s[4 * 33], s[5 * 33]); o.w = pk2(s[6 * 33], s[7 * 33]);
        *(GAS v4u*)(WT + (size_t)(n0 + n) * K + k0 + 8 * c) = o; }
    LDS_WAIT(); asm volatile("" ::: "memory");
}
__device__ __forceinline__ int up_col(int n) { const int isu = n >= DFF, ch = isu ? n - DFF : n; return (ch >> 7) * 256 + isu * 128 + (ch & 127); }
__device__ __forceinline__ void p0_transpose_item_fold(const float* W, int K, int N, bf16* WT, LAS float* scr, int item, int lane, const float* g, const float* b, long long* cs, long long* b2, bool upmap = false) {
    const int nblk = N / 32, kb = item / nblk, nb = item % nblk, k0 = 64 * kb, n0 = 32 * nb, n0m = upmap ? up_col(n0) : n0;
#pragma unroll 8
    for (int i = 0; i < 32; ++i) { const int kk = 2 * i + (lane >> 5); scr[kk * 33 + (lane & 31)] = W[(size_t)(k0 + kk) * N + n0 + (lane & 31)]; }
    LDS_WAIT(); asm volatile("" ::: "memory");
    const int c = lane & 7;
    const f32x4 g0 = *(const f32x4*)(g + k0 + 8 * c), g1 = *(const f32x4*)(g + k0 + 8 * c + 4), b0 = *(const f32x4*)(b + k0 + 8 * c), b1 = *(const f32x4*)(b + k0 + 8 * c + 4);
    const float gg[8] = {g0.x, g0.y, g0.z, g0.w, g1.x, g1.y, g1.z, g1.w}, bb[8] = {b0.x, b0.y, b0.z, b0.w, b1.x, b1.y, b1.z, b1.w};
#pragma unroll
    for (int j = 0; j < 4; ++j) { const int n = (lane >> 3) + 8 * j; const LAS float* s = scr + (8 * c) * 33 + n;
        float sc = 0.f, sb = 0.f; unsigned w[4];
#pragma unroll
        for (int q = 0; q < 4; ++q) { const float x0 = s[(2 * q) * 33], x1 = s[(2 * q + 1) * 33]; const unsigned r0 = f2bf(x0 * gg[2 * q]), r1 = f2bf(x1 * gg[2 * q + 1]);
            w[q] = r0 | (r1 << 16); sc += bf2f((unsigned short)r0) + bf2f((unsigned short)r1); sb += x0 * bb[2 * q] + x1 * bb[2 * q + 1]; }
        *(GAS v4u*)(WT + (size_t)(n0m + n) * K + k0 + 8 * c) = (v4u){w[0], w[1], w[2], w[3]};
        sc += __shfl_xor(sc, 1); sc += __shfl_xor(sc, 2); sc += __shfl_xor(sc, 4); sb += __shfl_xor(sb, 1); sb += __shfl_xor(sb, 2); sb += __shfl_xor(sb, 4);
        if (c == 0) { atomicAdd((unsigned long long*)(cs + n0m + n), (unsigned long long)(long long)rintf(sc * pg8::FOLD_SCALE)); atomicAdd((unsigned long long*)(b2 + n0m + n), (unsigned long long)(long long)rintf(sb * pg8::FOLD_SCALE)); } }
    LDS_WAIT(); asm volatile("" ::: "memory");
}
__device__ __forceinline__ void transpose_mat_fold(Frame& F, const float* W, int K, int N, bf16* WT, const float* g, const float* b, long long* cs, long long* b2, int c0 = 0, int nw = 1 << 30, int part = 0, int nparts = 1, bool upmap = false) {
    if (F.bid < c0 || F.bid >= c0 + nw) return;
    LAS float* scr = (LAS float*)(F.lds + RING_OFF + F.wave * 16384);
    const int nwg = nw < F.G ? nw : F.G, gw = (F.bid - c0) * NWAVES + F.wave, NGW = nwg * NWAVES;
    const int nitems = (K / 64) * (N / 32), ilo = (int)((long)nitems * part / nparts), ihi = (int)((long)nitems * (part + 1) / nparts);
    for (int it = ilo + gw; it < ihi; it += NGW) p0_transpose_item_fold(W, K, N, WT, scr, it, F.lane, g, b, cs, b2, upmap);
}
__device__ __forceinline__ void transpose_mat(Frame& F, const float* W, int K, int N, bf16* WT, int c0 = 0, int nw = 1 << 30) {
    if (F.bid < c0 || F.bid >= c0 + nw) return;
    LAS float* scr = (LAS float*)(F.lds + RING_OFF + F.wave * 16384);
    const int nwg = nw < F.G ? nw : F.G, gw = (F.bid - c0) * NWAVES + F.wave, NGW = nwg * NWAVES;
    const int nitems = (K / 64) * (N / 32);
    for (int it = gw; it < nitems; it += NGW) p0_transpose_item(W, K, N, WT, scr, it, F.lane);
}
__device__ __forceinline__ void fold_finalize(Frame& F, int lo, int n) {
    const long long* fs = (const long long*)(F.ws + WS_FOLD); float* fd = (float*)(F.ws + WS_FOLDF);
    for (int i = F.bid * NTHR + F.tid; i < 2 * n; i += F.G * NTHR) { const int j = (i < n) ? lo + i : FO_N + lo + (i - n); const long long v = fs[j]; fd[j] = (float)(int)(v >> 32) + (float)(unsigned)v * pg8::FOLD_INV; }
}
enum { CJ_DOWN0, CJ_NSA, CJ_L1A, CJ_L1B, CJ_DOWN1 };
template <int JOB>
__device__ __forceinline__ void convert_job(Frame& F, const Args& A, int c0, int nw) {
    unsigned char* ws = F.ws; long long* cs = (long long*)(ws + WS_FOLD); long long* b2 = cs + FO_N;
    if (JOB == CJ_DOWN0 || JOB == CJ_DOWN1) { const int l = JOB == CJ_DOWN1; transpose_mat(F, KIN(IN_FFN_DOWN) + (size_t)l * DFF * DM, DFF, DM, (bf16*)(ws + WS_W_DOWN) + (size_t)l * DM * DFF, c0, nw); }
    if (JOB == CJ_NSA) {
        transpose_mat_fold(F, KIN(IN_NSA_W_IN), DM, NSA_IN, (bf16*)(ws + WS_W_NSAIN), KIN(IN_LN_G) + 2 * DM, KIN(IN_LN_B) + 2 * DM, cs + FO_NSA, b2 + FO_NSA, c0, nw);
        transpose_mat(F, KIN(IN_NSA_W_OUT), DM, DM, (bf16*)(ws + WS_W_NSAOUT), c0, nw); }
    if (JOB == CJ_L1A || JOB == CJ_L1B) { const int l = 1;
        if (JOB == CJ_L1A) {
            transpose_mat_fold(F, KIN(IN_XA_WQ) + (size_t)l * DM * XW, DM, XW, (bf16*)(ws + WS_W_XQ) + (size_t)l * XW * DM, KIN(IN_LN_G) + (size_t)(3 * l) * DM, KIN(IN_LN_B) + (size_t)(3 * l) * DM, cs + FO_XQ + l * XW, b2 + FO_XQ + l * XW, c0, nw);
            transpose_mat(F, KIN(IN_XA_WKV) + (size_t)l * DM * 2 * XW, DM, 2 * XW, (bf16*)(ws + WS_W_XKV) + (size_t)l * 2 * XW * DM, c0, nw);
            transpose_mat(F, KIN(IN_XA_WO) + (size_t)l * XW * DM, XW, DM, (bf16*)(ws + WS_W_XO) + (size_t)l * DM * XW, c0, nw); }
        transpose_mat_fold(F, KIN(IN_FFN_UP) + (size_t)l * DM * DFF2, DM, DFF2, (bf16*)(ws + WS_W_UP) + (size_t)l * DFF2 * DM, KIN(IN_LN_G) + (size_t)(3 * l + 1) * DM, KIN(IN_LN_B) + (size_t)(3 * l + 1) * DM,
                           cs + FO_UP + l * DFF2, b2 + FO_UP + l * DFF2, c0, nw, JOB == CJ_L1A ? 0 : 1, 2, true); }
}
__device__ __forceinline__ void cvt_flat(Frame& F, const float* src, bf16* dst, long n8) {
    for (long i = (long)F.bid * NTHR + F.tid; i < n8; i += (long)F.G * NTHR) {
        const f32x4 a = *(const f32x4*)(src + i * 8), b = *(const f32x4*)(src + i * 8 + 4);
        v4u o; o.x = pk2(a.x, a.y); o.y = pk2(a.z, a.w); o.z = pk2(b.x, b.y); o.w = pk2(b.z, b.w);
        *(v4u*)(dst + i * 8) = o; }
}
__device__ __forceinline__ void p0_prologue(Frame& F, const Args& A) {
    unsigned char* ws = F.ws;
    long long* cs = (long long*)(ws + WS_FOLD); long long* b2 = cs + FO_N;
    transpose_mat(F, KIN(IN_AB_W_IN), DM, AB_IN, (bf16*)(ws + WS_W_ABIN));
    transpose_mat(F, KIN(IN_AB_W_OUT), DM, DM, (bf16*)(ws + WS_W_ABOUT));
    { const int l = 0;
        transpose_mat_fold(F, KIN(IN_XA_WQ) + (size_t)l * DM * XW, DM, XW, (bf16*)(ws + WS_W_XQ) + (size_t)l * XW * DM, KIN(IN_LN_G) + (size_t)(3 * l) * DM, KIN(IN_LN_B) + (size_t)(3 * l) * DM, cs + FO_XQ + l * XW, b2 + FO_XQ + l * XW);
        transpose_mat(F, KIN(IN_XA_WKV) + (size_t)l * DM * 2 * XW, DM, 2 * XW, (bf16*)(ws + WS_W_XKV) + (size_t)l * 2 * XW * DM);
        transpose_mat(F, KIN(IN_XA_WO) + (size_t)l * XW * DM, XW, DM, (bf16*)(ws + WS_W_XO) + (size_t)l * DM * XW);
        transpose_mat_fold(F, KIN(IN_FFN_UP) + (size_t)l * DM * DFF2, DM, DFF2, (bf16*)(ws + WS_W_UP) + (size_t)l * DFF2 * DM, KIN(IN_LN_G) + (size_t)(3 * l + 1) * DM, KIN(IN_LN_B) + (size_t)(3 * l + 1) * DM, cs + FO_UP + l * DFF2, b2 + FO_UP + l * DFF2, 0, 1 << 30, 0, 1, true); }
    for (int l = 0; l < 2; ++l) {
        transpose_mat(F, KIN(IN_NSA_CMP_W1) + (size_t)l * 32 * HD * HD, 32 * HD, HD, (bf16*)(ws + WS_W_C1) + (size_t)l * HD * 32 * HD);
        transpose_mat(F, KIN(IN_NSA_CMP_W2) + (size_t)l * HD * HD, HD, HD, (bf16*)(ws + WS_W_C2) + (size_t)l * HD * HD);
    }
    cvt_flat(F, KIN(IN_X), (bf16*)(ws + WS_HB), (long)MTOK * DM / 8);
    cvt_flat(F, KIN(IN_MEM), (bf16*)(ws + WS_MEMB), (long)BATCH * NMEM * DM / 8);
    { v4u z = {0u, 0u, 0u, 0u}; v4u* p = (v4u*)((bf16*)(ws + WS_W_NSAIN) + (size_t)NSA_IN * DM); const long n = (long)(NSA_INP - NSA_IN) * DM / 8;
      for (long i = (long)F.bid * NTHR + F.tid; i < n; i += (long)F.G * NTHR) p[i] = z; }
    { float* tab = (float*)(ws + WS_ROPE);
      for (int i = F.bid * NTHR + F.tid; i < SEQ * 64; i += F.G * NTHR) { const int t = i >> 6, d = i & 63;
          float sn, cs; sincosf((float)t * powf(10000.0f, -(float)d * (1.0f / 64.0f)), &sn, &cs); tab[(size_t)t * 128 + d] = cs; tab[(size_t)t * 128 + 64 + d] = sn; } }
    { const float* lbp = KIN(IN_HGRN_LB); float* lbo = (float*)(ws + WS_LB);
      for (int i = F.bid * NTHR + F.tid; i < A_W; i += F.G * NTHR) { const float a = lbp[i], b = lbp[A_W + i], m = fmaxf(a, b), ea = __expf(a - m), eb = __expf(b - m); lbo[i] = ea / (ea + eb); } }
}

__device__ __forceinline__ void ln_phase(Frame& F, const bf16* Y, const float* g, const float* b, float* h32) {
    const int gw = F.bid * NWAVES + F.wave, NGW = F.G * NWAVES;
    for (int m = gw; m < MTOK; m += NGW) {
        const v4u* yr = (const v4u*)(Y + (size_t)m * DM) + F.lane;
        float v[8][8]; float s = 0.f;
#pragma unroll
        for (int j = 0; j < 8; ++j) { const v4u x = yr[64 * j];
            v[j][0] = bflo(x.x); v[j][1] = bfhi(x.x); v[j][2] = bflo(x.y); v[j][3] = bfhi(x.y); v[j][4] = bflo(x.z); v[j][5] = bfhi(x.z); v[j][6] = bflo(x.w); v[j][7] = bfhi(x.w);
#pragma unroll
            for (int q = 0; q < 8; ++q) s += v[j][q]; }
        const float mean = wave_sum(s) * (1.f / DM); float s2 = 0.f;
#pragma unroll
        for (int j = 0; j < 8; ++j)
#pragma unroll
            for (int q = 0; q < 8; ++q) { v[j][q] -= mean; s2 += v[j][q] * v[j][q]; }
        const float rstd = 1.f / sqrtf(wave_sum(s2) * (1.f / DM) + LN_EPS);
#pragma unroll
        for (int j = 0; j < 8; ++j) { const int c0 = 8 * F.lane + 512 * j;
            const f32x4 g0 = *(const f32x4*)(g + c0), g1 = *(const f32x4*)(g + c0 + 4), b0 = *(const f32x4*)(b + c0), b1 = *(const f32x4*)(b + c0 + 4);
            f32x4 r0, r1;
            r0.x = v[j][0] * rstd * g0.x + b0.x; r0.y = v[j][1] * rstd * g0.y + b0.y; r0.z = v[j][2] * rstd * g0.z + b0.z; r0.w = v[j][3] * rstd * g0.w + b0.w;
            r1.x = v[j][4] * rstd * g1.x + b1.x; r1.y = v[j][5] * rstd * g1.y + b1.y; r1.z = v[j][6] * rstd * g1.z + b1.z; r1.w = v[j][7] * rstd * g1.w + b1.w;
            *(f32x4*)(h32 + (size_t)m * DM + c0) = r0; *(f32x4*)(h32 + (size_t)m * DM + c0 + 4) = r1; }
    }
}

__device__ __forceinline__ void cg_unpack(const v4u x, float* o) { o[0] = bflo(x.x); o[1] = bfhi(x.x); o[2] = bflo(x.y); o[3] = bfhi(x.y); o[4] = bflo(x.z); o[5] = bfhi(x.z); o[6] = bflo(x.w); o[7] = bfhi(x.w); }
__device__ __forceinline__ void convglu_fixup_phase(Frame& F, const bf16* SIDE, const float* cw, bf16* Gm) {
    constexpr int NCG = DFF / 8, NRUN = MTOK / 128;
    for (int it = F.bid * NTHR + F.tid; it < NCG * NRUN; it += F.G * NTHR) {
        const int cg = it % NCG, run = it / NCG, c0 = cg * 8, t0 = run * 128;
        float w0[8], w1[8], w2[8], am2[8], am1[8], a0[8], a1[8], u0[8], u1[8];
#pragma unroll
        for (int j = 0; j < 8; ++j) { w0[j] = cw[c0 + j]; w1[j] = cw[DFF + c0 + j]; w2[j] = cw[2 * DFF + c0 + j]; }
        const bf16* sp = SIDE + (size_t)run * 6 * DFF + c0;
        if ((t0 & (SEQ - 1)) == 0) {
#pragma unroll
            for (int j = 0; j < 8; ++j) { am2[j] = 0.f; am1[j] = 0.f; }
        } else { cg_unpack(*(const v4u*)sp, am2); cg_unpack(*(const v4u*)(sp + DFF), am1); }
        cg_unpack(*(const v4u*)(sp + 2 * DFF), a0); cg_unpack(*(const v4u*)(sp + 3 * DFF), a1); cg_unpack(*(const v4u*)(sp + 4 * DFF), u0); cg_unpack(*(const v4u*)(sp + 5 * DFF), u1);
        unsigned o0[4], o1[4];
#pragma unroll
        for (int j = 0; j < 8; j += 2) {
            const pg8::f32x2 g0 = pg8::gelu_pk((pg8::f32x2){w2[j] * a0[j] + w1[j] * am1[j] + w0[j] * am2[j], w2[j + 1] * a0[j + 1] + w1[j + 1] * am1[j + 1] + w0[j + 1] * am2[j + 1]});
            const pg8::f32x2 g1 = pg8::gelu_pk((pg8::f32x2){w2[j] * a1[j] + w1[j] * a0[j] + w0[j] * am1[j], w2[j + 1] * a1[j + 1] + w1[j + 1] * a0[j + 1] + w0[j + 1] * am1[j + 1]});
            o0[j >> 1] = pk2(g0.x * u0[j], g0.y * u0[j + 1]); o1[j >> 1] = pk2(g1.x * u1[j], g1.y * u1[j + 1]); }
        *(v4u*)(Gm + (size_t)t0 * DFF + c0) = (v4u){o0[0], o0[1], o0[2], o0[3]}; *(v4u*)(Gm + (size_t)(t0 + 1) * DFF + c0) = (v4u){o1[0], o1[1], o1[2], o1[3]};
    }
}

__device__ __forceinline__ void xattn_phase(Frame& F, const bf16* XQ, const bf16* XKV, bf16* XO) {
    const int tid = F.tid, wid = F.wave, lane = F.lane, r32 = lane & 31, hi = lane >> 5;
    LAS char* lds = (LAS char*)F.lds;
    LAS float* wsc = (LAS float*)(lds + ATT_WS_OFF + wid * 256);
    const int vb0 = (int)(uintptr_t)(lds + ATT_V_OFF) + v_rd_base(lane);
    KVDma dm; kv_dma_init(dm, 2 * XW, 2 * XW, wid, lane);
    constexpr int NU = (MTOK / 256) * XH;
    for (int u = F.bid; u < NU; u += F.G) {
        const int head = u % XH, rbk = u / XH, row0 = rbk * 256, b = row0 / SEQ;
        const bf16* Kh = XKV + (size_t)b * NMEM * 2 * XW + head * HD; const bf16* Vh = Kh + XW;
        bf16x8 qr[8]; load_q(qr, XQ + (size_t)(row0 + wid * 32 + r32) * XW + head * HD + hi * 8);
        float m_reg = -1e30f, l_reg = 0.f; f32x16 o[4] = {};
        __syncthreads();
        kv_dma(dm, Kh, Vh, lds, 0, wid);
        for (int j = 0; j < NMEM / KVBLK; ++j) {
            const int buf = (j & 1) * ATT_BUF;
            VM_WAIT(); __syncthreads();
            if (j + 1 < NMEM / KVBLK) kv_dma(dm, Kh + (size_t)(j + 1) * KVBLK * 2 * XW, Vh + (size_t)(j + 1) * KVBLK * 2 * XW, lds, ATT_BUF - buf, wid);
            f32x16 p0, p1; qkt(p0, p1, lds + buf + ATT_K_OFF, qr, r32, hi);
            float alpha; softmax_tile(p0, p1, m_reg, l_reg, alpha);
            rescale_o(o, alpha, wsc, r32, hi);
            bf16x8 pa0, pa1, pa2, pa3; pack_p(p0, p1, pa0, pa1, pa2, pa3);
            pv_d0(o, vb0 + buf, pa0, pa1, pa2, pa3);
        }
        if (hi == 0) wsc[32 + r32] = l_reg; LDS_WAIT();
        bf16* Ow = XO + (size_t)(row0 + wid * 32) * XW + head * HD;
#pragma unroll
        for (int r = 0; r < 16; ++r) { const int orow = crow(r, hi); const float rl = __builtin_amdgcn_rcpf(wsc[32 + orow]);
#pragma unroll
            for (int d0 = 0; d0 < 4; ++d0) Ow[(size_t)orow * XW + d0 * 32 + r32] = (bf16)f2bf(o[d0][r] * rl); }
        LDS_WAIT();
    }
}

template <int K>
__device__ __forceinline__ f32x4 mma_tile(const LAS char* A, int lda, const LAS char* B, int ldb, int fr, int fq) {
    f32x4 acc = {0.f, 0.f, 0.f, 0.f};
#pragma unroll
    for (int k0 = 0; k0 < K; k0 += 32) {
        const bf16x8 a = *(const LAS bf16x8*)(A + fr * lda + (k0 + 8 * fq) * 2);
        const bf16x8 b = *(const LAS bf16x8*)(B + fr * ldb + (k0 + 8 * fq) * 2);
        acc = __builtin_amdgcn_mfma_f32_16x16x32_bf16(a, b, acc, 0, 0, 0);
    }
    return acc;
}
constexpr int HG_CH = 64, HG_NC = SEQ / HG_CH, HG_ITEMS = BATCH * A_HEADS * HG_NC;
constexpr int HG_QT = 0, HG_KT = 17408, HG_KH = 34816, HG_VT = 53248, HG_PT = 71680, HG_SEG = 80896;
constexpr int HG_SP = 17408, HG_OT = 52224;
constexpr int HG_WT = 80896, HG_KHS = 86016, HG_VS = 103424;
__device__ __forceinline__ void hgrn_phase_a(Frame& F, const bf16* P0, const float* lbv, bf16* QTg, bf16* OINTRA, bf16* DS, float* DEC) {
    LAS char* lds = (LAS char*)F.lds;
    const int tid = F.tid, wid = F.wave, lane = F.lane, fr = lane & 15, fq = lane >> 4;
    const int dg = tid & 15, sq = tid >> 4;
    const int d = tid & 127, sq16 = tid >> 7;
    for (int it = F.bid; it < HG_ITEMS; it += F.G) {
        const int c = it % HG_NC, bh = it / HG_NC, h = bh % A_HEADS, b = bh / A_HEADS;
        const size_t row0 = (size_t)b * SEQ + (size_t)c * HG_CH;
        float lb[8], q[2][8], kk[2][8], cum[2][8]; v4u vraw[2];
        { const f32x4 l0 = *(const f32x4*)(lbv + h * HD + 8 * dg), l1 = *(const f32x4*)(lbv + h * HD + 8 * dg + 4);
          lb[0] = l0.x; lb[1] = l0.y; lb[2] = l0.z; lb[3] = l0.w; lb[4] = l1.x; lb[5] = l1.y; lb[6] = l1.z; lb[7] = l1.w; }
#pragma unroll
        for (int rr = 0; rr < 2; ++rr) { const bf16* rowp = P0 + (row0 + 2 * sq + rr) * AB_IN + h * HD + 8 * dg;
            const v4u zq = *(const v4u*)(rowp + A_W), qq = *(const v4u*)rowp; vraw[rr] = *(const v4u*)(rowp + 2 * A_W);
            const unsigned zw[4] = {zq.x, zq.y, zq.z, zq.w}, qw[4] = {qq.x, qq.y, qq.z, qq.w};
#pragma unroll
            for (int j = 0; j < 8; ++j) { const float z = (j & 1) ? bfhi(zw[j >> 1]) : bflo(zw[j >> 1]); q[rr][j] = (j & 1) ? bfhi(qw[j >> 1]) : bflo(qw[j >> 1]);
                const float sg = sigmoidf_(z), omlb = 1.f - lb[j]; kk[rr][j] = omlb * (1.f - sg);
                const float lf = __logf(lb[j] + omlb * sg); cum[rr][j] = rr ? cum[0][j] + lf : lf; } }
        float pre[8];
#pragma unroll
        for (int j = 0; j < 8; ++j) { const float seg = cum[1][j]; float x = seg; const float t1 = __shfl_up(x, 16); if (lane >= 16) x += t1; const float t2 = __shfl_up(x, 32); if (lane >= 32) x += t2;
            pre[j] = x - seg; if (lane >= 48) ((LAS float*)(lds + HG_WT))[wid * 128 + 8 * dg + j] = x; }
        LDS_WAIT(); __syncthreads();
        float total[8];
#pragma unroll
        for (int j = 0; j < 8; ++j) total[j] = 0.f;
#pragma unroll
        for (int w = 0; w < NWAVES; ++w) { const f32x4 a0 = *(const LAS f32x4*)(lds + HG_WT + (w * 128 + 8 * dg) * 4), a1 = *(const LAS f32x4*)(lds + HG_WT + (w * 128 + 8 * dg + 4) * 4);
            const float av[8] = {a0.x, a0.y, a0.z, a0.w, a1.x, a1.y, a1.z, a1.w};
#pragma unroll
            for (int j = 0; j < 8; ++j) { total[j] += av[j]; if (w < wid) pre[j] += av[j]; } }
#pragma unroll
        for (int rr = 0; rr < 2; ++rr) { const int s = 2 * sq + rr; unsigned qt[4], kt[4], kh[4];
#pragma unroll
            for (int j = 0; j < 8; j += 2) { const float b0 = pre[j] + cum[rr][j], b1 = pre[j + 1] + cum[rr][j + 1];
                qt[j >> 1] = pk2(q[rr][j] * __expf(b0), q[rr][j + 1] * __expf(b1));
                kt[j >> 1] = pk2(kk[rr][j] * __expf(-b0), kk[rr][j + 1] * __expf(-b1));
                kh[j >> 1] = pk2(kk[rr][j] * __expf(total[j] - b0), kk[rr][j + 1] * __expf(total[j + 1] - b1)); }
            const v4u qv = {qt[0], qt[1], qt[2], qt[3]};
            *(LAS v4u*)(lds + HG_QT + s * 272 + dg * 16) = qv; *(v4u*)(QTg + (row0 + s) * A_W + h * HD + 8 * dg) = qv;
            *(LAS v4u*)(lds + HG_KT + s * 272 + dg * 16) = (v4u){kt[0], kt[1], kt[2], kt[3]};
            *(LAS v4u*)(lds + HG_KHS + s * 272 + dg * 16) = (v4u){kh[0], kh[1], kh[2], kh[3]};
            *(LAS v4u*)(lds + HG_VS + s * 272 + dg * 16) = vraw[rr]; }
        if (sq == 31) { f32x4 e0, e1; e0.x = __expf(total[0]); e0.y = __expf(total[1]); e0.z = __expf(total[2]); e0.w = __expf(total[3]); e1.x = __expf(total[4]); e1.y = __expf(total[5]); e1.z = __expf(total[6]); e1.w = __expf(total[7]);
            *(f32x4*)(DEC + (size_t)it * HD + 8 * dg) = e0; *(f32x4*)(DEC + (size_t)it * HD + 8 * dg + 4) = e1; }
        LDS_WAIT(); __syncthreads();
        { unsigned kh[8], vt[8];
#pragma unroll
          for (int j = 0; j < 16; j += 2) { const int s = 16 * sq16 + j;
              kh[j >> 1] = (unsigned)*(const LAS unsigned short*)(lds + HG_KHS + s * 272 + d * 2) | ((unsigned)*(const LAS unsigned short*)(lds + HG_KHS + (s + 1) * 272 + d * 2) << 16);
              vt[j >> 1] = (unsigned)*(const LAS unsigned short*)(lds + HG_VS + s * 272 + d * 2) | ((unsigned)*(const LAS unsigned short*)(lds + HG_VS + (s + 1) * 272 + d * 2) << 16); }
          LAS v4u* pk = (LAS v4u*)(lds + HG_KH + d * 144 + sq16 * 32); pk[0] = (v4u){kh[0], kh[1], kh[2], kh[3]}; pk[1] = (v4u){kh[4], kh[5], kh[6], kh[7]};
          LAS v4u* pv = (LAS v4u*)(lds + HG_VT + d * 144 + sq16 * 32); pv[0] = (v4u){vt[0], vt[1], vt[2], vt[3]}; pv[1] = (v4u){vt[4], vt[5], vt[6], vt[7]}; }
        LDS_WAIT(); __syncthreads();
#pragma unroll
        for (int k = 0; k < 2; ++k) { const int tau = 2 * wid + k, ti = tau >> 2, si = tau & 3;
            f32x4 acc = {0.f, 0.f, 0.f, 0.f};
            if (si <= ti) acc = mma_tile<128>(lds + HG_QT + ti * 16 * 272, 272, lds + HG_KT + si * 16 * 272, 272, fr, fq);
#pragma unroll
            for (int i = 0; i < 4; ++i) { const int t = 16 * ti + 4 * fq + i, s = 16 * si + fr; const float v = (s <= t) ? acc[i] : 0.f;
                *(LAS unsigned short*)(lds + HG_PT + t * 144 + s * 2) = (unsigned short)f2bf(v); } }
        LDS_WAIT(); __syncthreads();
#pragma unroll
        for (int k = 0; k < 4; ++k) { const int tau = wid + 8 * k, ti = tau >> 3, vi = tau & 7;
            const f32x4 acc = mma_tile<64>(lds + HG_VT + vi * 16 * 144, 144, lds + HG_PT + ti * 16 * 144, 144, fr, fq);
            v2u w; w.x = pk2(acc[0], acc[1]); w.y = pk2(acc[2], acc[3]);
            *(v2u*)(OINTRA + (row0 + 16 * ti + fr) * A_W + h * HD + 16 * vi + 4 * fq) = w; }
#pragma unroll
        for (int k = 0; k < 8; ++k) { const int tau = wid + 8 * k, vi = tau >> 3, ki = tau & 7;
            const f32x4 acc = mma_tile<64>(lds + HG_KH + ki * 16 * 144, 144, lds + HG_VT + vi * 16 * 144, 144, fr, fq);
            v2u w; w.x = pk2(acc[0], acc[1]); w.y = pk2(acc[2], acc[3]);
            *(v2u*)(DS + ((size_t)it * HD + 16 * vi + fr) * HD + 16 * ki + 4 * fq) = w; }
        LDS_WAIT(); __syncthreads();
    }
}
__device__ __forceinline__ void hgrn_phase_b(Frame& F, const bf16* DS, const float* DEC, bf16* SPREV) {
    const int tid = F.tid, dvl = tid >> 5, dk4 = (tid & 31) * 4;
    for (int item = F.bid; item < BATCH * A_HEADS * 8; item += F.G) {
        const int sl = item & 7, bh = item >> 3, dv = sl * 16 + dvl;
        f32x4 S = {0.f, 0.f, 0.f, 0.f};
        for (int c0 = 0; c0 < HG_NC; c0 += 8) {
            f32x4 ds[8], dc[8];
#pragma unroll
            for (int k = 0; k < 8; ++k) { const size_t it = (size_t)bh * HG_NC + c0 + k; const v2u x = *(const v2u*)(DS + (it * HD + dv) * HD + dk4);
                ds[k] = (f32x4){bflo(x.x), bfhi(x.x), bflo(x.y), bfhi(x.y)}; dc[k] = *(const f32x4*)(DEC + it * HD + dk4); }
#pragma unroll
            for (int k = 0; k < 8; ++k) { const size_t it = (size_t)bh * HG_NC + c0 + k;
                v2u w; w.x = pk2(S.x, S.y); w.y = pk2(S.z, S.w); *(v2u*)(SPREV + (it * HD + dv) * HD + dk4) = w;
                S = S * dc[k] + ds[k]; }
        }
    }
}
__device__ __forceinline__ void hgrn_phase_c(Frame& F, const bf16* P0, const bf16* QTg, const bf16* OINTRA, const bf16* SPREV, const float* nw, bf16* Ob) {
    LAS char* lds = (LAS char*)F.lds;
    const int tid = F.tid, wid = F.wave, lane = F.lane, fr = lane & 15, fq = lane >> 4;
    for (int it = F.bid; it < HG_ITEMS; it += F.G) {
        const int c = it % HG_NC, bh = it / HG_NC, h = bh % A_HEADS, b = bh / A_HEADS;
        const size_t row0 = (size_t)b * SEQ + (size_t)c * HG_CH;
        { const int s = tid >> 3, ch = (tid & 7) * 16; const bf16* src = QTg + (row0 + s) * A_W + h * HD + ch;
          const v4u x0 = *(const v4u*)src, x1 = *(const v4u*)(src + 8); LAS v4u* dst = (LAS v4u*)(lds + HG_QT + s * 272 + ch * 2); dst[0] = x0; dst[1] = x1; }
        { const int dv = tid >> 2, ch = (tid & 3) * 32; const bf16* src = SPREV + ((size_t)it * HD + dv) * HD + ch;
          const v4u x0 = *(const v4u*)src, x1 = *(const v4u*)(src + 8), x2 = *(const v4u*)(src + 16), x3 = *(const v4u*)(src + 24);
          LAS v4u* dst = (LAS v4u*)(lds + HG_SP + dv * 272 + ch * 2); dst[0] = x0; dst[1] = x1; dst[2] = x2; dst[3] = x3; }
        LDS_WAIT(); __syncthreads();
#pragma unroll
        for (int k = 0; k < 4; ++k) { const int tau = wid + 8 * k, ti = tau >> 3, vi = tau & 7;
            const f32x4 acc = mma_tile<128>(lds + HG_SP + vi * 16 * 272, 272, lds + HG_QT + ti * 16 * 272, 272, fr, fq);
            const int t = 16 * ti + fr, dv = 16 * vi + 4 * fq; const v2u oi = *(const v2u*)(OINTRA + (row0 + t) * A_W + h * HD + dv);
            *(LAS f32x4*)(lds + HG_OT + (t * 132 + dv) * 4) = (f32x4){acc[0] + bflo(oi.x), acc[1] + bfhi(oi.x), acc[2] + bflo(oi.y), acc[3] + bfhi(oi.y)}; }
        LDS_WAIT(); __syncthreads();
        { const int t = tid >> 3, dv0 = (tid & 7) * 16;
          float v[16]; float ss = 0.f;
#pragma unroll
          for (int q4 = 0; q4 < 4; ++q4) { const f32x4 x = *(const LAS f32x4*)(lds + HG_OT + (t * 132 + dv0 + 4 * q4) * 4); v[4 * q4] = x.x; v[4 * q4 + 1] = x.y; v[4 * q4 + 2] = x.z; v[4 * q4 + 3] = x.w;
              ss += (x.x * x.x + x.y * x.y) + (x.z * x.z + x.w * x.w); }
          ss += __shfl_xor(ss, 1); ss += __shfl_xor(ss, 2); ss += __shfl_xor(ss, 4);
          const float r = 1.f / sqrtf(ss * (1.f / HD) + RMS_EPS);
          const bf16* gp = P0 + (row0 + t) * AB_IN + 3 * A_W + h * HD + dv0; const v4u g0 = *(const v4u*)gp, g1 = *(const v4u*)(gp + 8);
          const unsigned gw[8] = {g0.x, g0.y, g0.z, g0.w, g1.x, g1.y, g1.z, g1.w}; unsigned o[8];
#pragma unroll
          for (int j = 0; j < 8; ++j) { const float ga = bflo(gw[j]), gb = bfhi(gw[j]);
              o[j] = pk2(v[2 * j] * r * nw[dv0 + 2 * j] * ga * sigmoidf_(ga), v[2 * j + 1] * r * nw[dv0 + 2 * j + 1] * gb * sigmoidf_(gb)); }
          bf16* op = Ob + (row0 + t) * DM + h * HD + dv0; *(v4u*)op = (v4u){o[0], o[1], o[2], o[3]}; *(v4u*)(op + 8) = (v4u){o[4], o[5], o[6], o[7]}; }
        LDS_WAIT(); __syncthreads();
    }
}

constexpr float SB_CUT = -160.f;
__device__ __forceinline__ void sb_phase(Frame& F, const bf16* P0, bf16* Ob) {
    const int tid = F.tid, wid = F.wave, lane = F.lane, r32 = lane & 31, hi = lane >> 5;
    LAS char* lds = (LAS char*)F.lds;
    const int vb0 = (int)(uintptr_t)(lds + ATT_V_OFF) + v_rd_base(lane);
    KVDma dm; kv_dma_init(dm, AB_IN, AB_IN, wid, lane);
    constexpr int NQB = SEQ / 256, NU = BATCH * B_HEADS * NQB;
    for (int rd = 0; ; ++rd) {
        const int idx = (rd & 1) ? rd * F.G + (F.G - 1 - F.bid) : rd * F.G + F.bid;
        if (rd * F.G >= NU) break;
        if (idx >= NU) continue;
        const int qb = NQB - 1 - idx / (BATCH * B_HEADS), bh = idx % (BATCH * B_HEADS), head = bh % B_HEADS, b = bh / B_HEADS;
        const size_t rowb = (size_t)b * SEQ; const int q0 = qb * 256;
        const bf16* Kh = P0 + rowb * AB_IN + 4 * A_W + B_W + head * HD; const bf16* Vh = Kh + B_W;
        const int tw0 = q0 + wid * 32, t = tw0 + r32;
        bf16x8 qr[8]; load_q(qr, P0 + (rowb + t) * AB_IN + 4 * A_W + head * HD + hi * 8);
        float R = 0.f; f32x16 o[4] = {};
        const int jtop = (q0 + 254) >> 6;
        LAS unsigned* dflag = (LAS unsigned*)(lds + ATT_X_OFF);
        if (lane == 0) { dflag[wid] = 0u; dflag[8 + wid] = 0u; }
        LDS_WAIT(); __syncthreads();
        kv_dma(dm, Kh + (size_t)jtop * KVBLK * AB_IN, Vh + (size_t)jtop * KVBLK * AB_IN, lds, 0, wid);
        int buf = 0;
        for (int j = jtop; j >= 0; --j, buf = ATT_BUF - buf) {
            VM_WAIT(); __syncthreads();
            { unsigned alld = 1u;
#pragma unroll
              for (int w = 0; w < NWAVES; ++w) alld &= dflag[((j + 1) & 1) * 8 + w];
              if (__builtin_amdgcn_readfirstlane(alld)) break; }
            if (j > 0) kv_dma(dm, Kh + (size_t)(j - 1) * KVBLK * AB_IN, Vh + (size_t)(j - 1) * KVBLK * AB_IN, lds, ATT_BUF - buf, wid);
            const int k0 = j * KVBLK;
            if (k0 < tw0 + 31) {
                f32x16 p0, p1; qkt(p0, p1, lds + buf + ATT_K_OFF, qr, r32, hi);
                const bool need_mask = (k0 + 63 >= tw0);
                float L0[16], L1[16];
#pragma unroll
                for (int r = 0; r < 16; ++r) {
                    const float z0 = p0[r] * ATT_C, z1 = p1[r] * ATT_C;
                    float l0 = -(fmaxf(z0, 0.f) + __builtin_amdgcn_logf(1.f + __builtin_amdgcn_exp2f(-fabsf(z0))));
                    float l1 = -(fmaxf(z1, 0.f) + __builtin_amdgcn_logf(1.f + __builtin_amdgcn_exp2f(-fabsf(z1))));
                    if (need_mask) { if (k0 + crow(r, hi) >= t) l0 = 0.f; if (k0 + 32 + crow(r, hi) >= t) l1 = 0.f; }
                    L0[r] = l0; L1[r] = l1; p0[r] = z0 + l0; p1[r] = z1 + l1;
                }
                SBAR();
                float Sg[16];
#pragma unroll
                for (int gi = 0; gi < 4; ++gi) {
                    const float a = (L0[4 * gi] + L0[4 * gi + 1]) + (L0[4 * gi + 2] + L0[4 * gi + 3]), c = (L1[4 * gi] + L1[4 * gi + 1]) + (L1[4 * gi + 2] + L1[4 * gi + 3]);
                    auto ra = __builtin_amdgcn_permlane32_swap(__float_as_uint(a), __float_as_uint(a), false, false);
                    auto rc = __builtin_amdgcn_permlane32_swap(__float_as_uint(c), __float_as_uint(c), false, false);
                    Sg[2 * gi] = __uint_as_float(ra[0]); Sg[2 * gi + 1] = __uint_as_float(ra[1]); Sg[8 + 2 * gi] = __uint_as_float(rc[0]); Sg[8 + 2 * gi + 1] = __uint_as_float(rc[1]);
                }
                float run = R;
#pragma unroll
                for (int s = 15; s >= 0; --s) { const float tt = run; run += Sg[s]; Sg[s] = tt; }
                const float Rn = run;
                SBAR();
#pragma unroll
                for (int gi = 0; gi < 4; ++gi) {
                    float base0 = hi ? Sg[2 * gi + 1] : Sg[2 * gi], base1 = hi ? Sg[8 + 2 * gi + 1] : Sg[8 + 2 * gi];
                    float r3 = base0, r2 = r3 + L0[4 * gi + 3], r1 = r2 + L0[4 * gi + 2], r0 = r1 + L0[4 * gi + 1];
                    p0[4 * gi + 3] = __builtin_amdgcn_exp2f(p0[4 * gi + 3] + r3); p0[4 * gi + 2] = __builtin_amdgcn_exp2f(p0[4 * gi + 2] + r2);
                    p0[4 * gi + 1] = __builtin_amdgcn_exp2f(p0[4 * gi + 1] + r1); p0[4 * gi + 0] = __builtin_amdgcn_exp2f(p0[4 * gi + 0] + r0);
                    r3 = base1; r2 = r3 + L1[4 * gi + 3]; r1 = r2 + L1[4 * gi + 2]; r0 = r1 + L1[4 * gi + 1];
                    p1[4 * gi + 3] = __builtin_amdgcn_exp2f(p1[4 * gi + 3] + r3); p1[4 * gi + 2] = __builtin_amdgcn_exp2f(p1[4 * gi + 2] + r2);
                    p1[4 * gi + 1] = __builtin_amdgcn_exp2f(p1[4 * gi + 1] + r1); p1[4 * gi + 0] = __builtin_amdgcn_exp2f(p1[4 * gi + 0] + r0);
                }
                R = Rn;
                { const unsigned dn = __all(R < SB_CUT) ? 1u : 0u; if (lane == 0) dflag[(j & 1) * 8 + wid] = dn; }
                if (need_mask) {
#pragma unroll
                    for (int r = 0; r < 16; ++r) { if (k0 + crow(r, hi) >= t) p0[r] = 0.f; if (k0 + 32 + crow(r, hi) >= t) p1[r] = 0.f; }
                }
                bf16x8 pa0, pa1, pa2, pa3; pack_p(p0, p1, pa0, pa1, pa2, pa3);
                pv_d0(o, vb0 + buf, pa0, pa1, pa2, pa3);
            }
        }
        bf16* Ow = Ob + (rowb + tw0) * DM + A_W + head * HD;
#pragma unroll
        for (int r = 0; r < 16; ++r) { const int orow = crow(r, hi);
#pragma unroll
            for (int d0 = 0; d0 < 4; ++d0) Ow[(size_t)orow * DM + d0 * 32 + r32] = (bf16)f2bf(o[d0][r]); }
    }
}

constexpr int P1_KC = 4096, P1_VC = 4608, P1_KS = 5120, P1_VS = 5632, P1_KW = 6144, P1_VW = 6656, P1_GL = 7168;
__device__ __forceinline__ void nsa_rope_phase(Frame& F, const bf16* P1, const float* TAB, bf16* QROT, bf16* KSROT, bf16* KWROT, bf16* OVL) {
    const int gw = F.bid * NWAVES + F.wave, NGW = F.G * NWAVES, lane = F.lane, hsub = lane >> 3, d0 = (lane & 7) * 8;
    for (int m = gw; m < MTOK; m += NGW) {
        const int t = m & (SEQ - 1);
        const f32x4 c0 = *(const f32x4*)(TAB + (size_t)t * 128 + d0), c1 = *(const f32x4*)(TAB + (size_t)t * 128 + d0 + 4);
        const f32x4 s0 = *(const f32x4*)(TAB + (size_t)t * 128 + 64 + d0), s1 = *(const f32x4*)(TAB + (size_t)t * 128 + 64 + d0 + 4);
        const float cs[8] = {c0.x, c0.y, c0.z, c0.w, c1.x, c1.y, c1.z, c1.w}, sn[8] = {s0.x, s0.y, s0.z, s0.w, s1.x, s1.y, s1.z, s1.w};
        const bf16* row = P1 + (size_t)m * NSA_INP;
#pragma unroll
        for (int hb = 0; hb < 5; ++hb) {
            const int hh = hb * 8 + hsub;
            const bf16* src; bf16* dst;
            if (hh < 32) { src = row + hh * HD; dst = QROT + (size_t)m * DM + hh * HD; }
            else if (hh < 36) { src = row + P1_KS + (hh - 32) * HD; dst = KSROT + (size_t)m * KVW + (hh - 32) * HD; }
            else { src = row + P1_KW + (hh - 36) * HD; dst = KWROT + (size_t)m * KVW + (hh - 36) * HD; }
            const v4u a = *(const v4u*)(src + d0), bq = *(const v4u*)(src + 64 + d0);
            const unsigned aw[4] = {a.x, a.y, a.z, a.w}, bw[4] = {bq.x, bq.y, bq.z, bq.w}; unsigned o1[4], o2[4];
#pragma unroll
            for (int q = 0; q < 4; ++q) { const float x1l = bflo(aw[q]), x1h = bfhi(aw[q]), x2l = bflo(bw[q]), x2h = bfhi(bw[q]);
                o1[q] = pk2(x1l * cs[2 * q] - x2l * sn[2 * q], x1h * cs[2 * q + 1] - x2h * sn[2 * q + 1]);
                o2[q] = pk2(x2l * cs[2 * q] + x1l * sn[2 * q], x2h * cs[2 * q + 1] + x1h * sn[2 * q + 1]); }
            *(v4u*)(dst + d0) = (v4u){o1[0], o1[1], o1[2], o1[3]}; *(v4u*)(dst + 64 + d0) = (v4u){o2[0], o2[1], o2[2], o2[3]};
        }
    }
    for (int i = F.bid * NTHR + F.tid; i < NCMPP * NSLC; i += F.G * NTHR) { const int n = i / NSLC, j = i % NSLC;
        OVL[i] = (n < NCMP && n >= 4 * j - 1 && n <= 4 * j + 3) ? (bf16)0x3f80u : (bf16)0u; }
}
constexpr int CM_A = 0, CM_B = 17408, CM_H = 17408 + 34816;
__device__ __forceinline__ void nsa_compress_phase(Frame& F, const bf16* P1, const float* pos, const bf16* W1t, const bf16* W2t, bf16* KCMP, bf16* VCMP) {
    LAS char* lds = (LAS char*)F.lds;
    const int tid = F.tid, wid = F.wave, lane = F.lane, fr = lane & 15, fq = lane >> 4;
    for (int item = F.bid; item < 128; item += F.G) {
        const int nt = item & 7, g = (item >> 3) & 3, b = (item >> 5) & 1, which = item >> 6;
        const bf16* w1 = W1t + (size_t)which * HD * 32 * HD; const bf16* w2 = W2t + (size_t)which * HD * HD;
        const float* posw = pos + (size_t)which * 32 * HD;
        f32x4 acc[4];
#pragma unroll
        for (int k = 0; k < 4; ++k) acc[k] = (f32x4){0.f, 0.f, 0.f, 0.f};
        for (int l = 0; l < 32; ++l) {
            { const int r = tid >> 3, ch = (tid & 7) * 16, n = nt * 64 + r; unsigned w[8];
              if (n < NCMP) { const bf16* src = P1 + ((size_t)b * SEQ + 16 * n + l) * NSA_INP + P1_KC + which * KVW + g * HD + ch;
                  const v4u x0 = *(const v4u*)src, x1 = *(const v4u*)(src + 8); const unsigned xs[8] = {x0.x, x0.y, x0.z, x0.w, x1.x, x1.y, x1.z, x1.w};
#pragma unroll
                  for (int q = 0; q < 8; ++q) w[q] = pk2(bflo(xs[q]) + posw[l * HD + ch + 2 * q], bfhi(xs[q]) + posw[l * HD + ch + 2 * q + 1]);
              } else {
#pragma unroll
                  for (int q = 0; q < 8; ++q) w[q] = 0u; }
              LAS v4u* dst = (LAS v4u*)(lds + CM_A + r * 272 + ch * 2); dst[0] = (v4u){w[0], w[1], w[2], w[3]}; dst[1] = (v4u){w[4], w[5], w[6], w[7]}; }
            { const int e = tid >> 2, ch = (tid & 3) * 32; const bf16* src = w1 + (size_t)e * 32 * HD + l * HD + ch;
              const v4u x0 = *(const v4u*)src, x1 = *(const v4u*)(src + 8), x2 = *(const v4u*)(src + 16), x3 = *(const v4u*)(src + 24);
              LAS v4u* dst = (LAS v4u*)(lds + CM_B + e * 272 + ch * 2); dst[0] = x0; dst[1] = x1; dst[2] = x2; dst[3] = x3; }
            LDS_WAIT(); __syncthreads();
#pragma unroll
            for (int k = 0; k < 4; ++k) { const int tau = wid + 8 * k, ni = tau >> 3, ei = tau & 7;
                acc[k] += mma_tile<128>(lds + CM_A + ni * 16 * 272, 272, lds + CM_B + ei * 16 * 272, 272, fr, fq); }
            LDS_WAIT(); __syncthreads();
        }
#pragma unroll
        for (int k = 0; k < 4; ++k) { const int tau = wid + 8 * k, ni = tau >> 3, ei = tau & 7;
#pragma unroll
            for (int i = 0; i < 4; ++i) *(LAS unsigned short*)(lds + CM_H + (16 * ni + 4 * fq + i) * 272 + (16 * ei + fr) * 2) = (unsigned short)f2bf(gelu1(acc[k][i])); }
        { const int f = tid >> 2, ch = (tid & 3) * 32; const bf16* src = w2 + (size_t)f * HD + ch;
          const v4u x0 = *(const v4u*)src, x1 = *(const v4u*)(src + 8), x2 = *(const v4u*)(src + 16), x3 = *(const v4u*)(src + 24);
          LAS v4u* dst = (LAS v4u*)(lds + CM_B + f * 272 + ch * 2); dst[0] = x0; dst[1] = x1; dst[2] = x2; dst[3] = x3; }
        LDS_WAIT(); __syncthreads();
        bf16* outp = which ? VCMP : KCMP;
#pragma unroll
        for (int k = 0; k < 4; ++k) { const int tau = wid + 8 * k, ni = tau >> 3, fi = tau & 7;
            const f32x4 a2 = mma_tile<128>(lds + CM_H + ni * 16 * 272, 272, lds + CM_B + fi * 16 * 272, 272, fr, fq);
#pragma unroll
            for (int i = 0; i < 4; ++i) { const int n = nt * 64 + 16 * ni + 4 * fq + i;
                outp[(((size_t)b * NCMPP + n) * NSA_G + g) * HD + 16 * fi + fr] = (n < NCMP) ? (bf16)f2bf(a2[i]) : (bf16)0u; } }
        LDS_WAIT(); __syncthreads();
    }
}
__device__ __forceinline__ unsigned topk_key(float v) { const unsigned u = (v == 0.f) ? 0u : __builtin_bit_cast(unsigned, v); return u ^ ((u >> 31) ? 0xffffffffu : 0x80000000u); }
__device__ __forceinline__ v4u topk_select(float a0, float a1, int cur, int lane) {
    const unsigned k0 = topk_key(a0), k1 = topk_key(a1);
    const int j0 = lane, j1 = lane + 64;
    const bool f0 = (j0 == 0) || (j0 == cur) || (j0 == cur - 1), f1 = (j1 == cur) || (j1 == cur - 1);
    const unsigned long long c0m = __ballot(!f0 && j0 <= cur), c1m = __ballot(!f1 && j1 <= cur);
    const int nforced = cur >= 2 ? 3 : cur + 1, slots = NTOP - nforced;
    unsigned long long s0m = c0m, s1m = c1m;
    if (__builtin_popcountll(c0m) + __builtin_popcountll(c1m) > slots) {
        unsigned T = 0u;
#pragma nounroll
        for (int bit = 31; bit >= 0; --bit) { const unsigned trial = T | (1u << bit);
            const int cnt = __builtin_popcountll(__ballot(k0 >= trial) & c0m) + __builtin_popcountll(__ballot(k1 >= trial) & c1m);
            if (cnt >= slots) T = trial; }
        unsigned long long e0 = __ballot(k0 == T) & c0m, e1 = __ballot(k1 == T) & c1m;
        s0m = __ballot(k0 > T) & c0m; s1m = __ballot(k1 > T) & c1m;
        int need = slots - __builtin_popcountll(s0m) - __builtin_popcountll(s1m);
        while (need > 0 && e0) { const unsigned long long b = e0 & (~e0 + 1ull); s0m |= b; e0 ^= b; --need; }
        while (need > 0 && e1) { const unsigned long long b = e1 & (~e1 + 1ull); s1m |= b; e1 ^= b; --need; }
    }
    const unsigned long long m0 = s0m | __ballot(f0 && j0 <= cur), m1 = s1m | __ballot(f1 && j1 <= cur);
    return (v4u){(unsigned)m0, (unsigned)(m0 >> 32), (unsigned)m1, (unsigned)(m1 >> 32)};
}
__device__ __forceinline__ unsigned pick4(const unsigned (&a)[4], int i) { return i == 0 ? a[0] : (i == 1 ? a[1] : (i == 2 ? a[2] : a[3])); }
template <int MODE>
__device__ __forceinline__ void nsa_attn_phase(Frame& F, const bf16* P1, const bf16* Qsrc, const bf16* Ksrc, const bf16* Vsrc, const unsigned* SEL, float* O32, unsigned* IMPO, bf16* Ob, bool probe_nostore = false) {
    const int tid = F.tid, wid = F.wave, lane = F.lane, r32 = lane & 31, hi = lane >> 5;
    LAS char* lds = (LAS char*)F.lds;
    LAS float* wsc = (LAS float*)(lds + ATT_WS_OFF + wid * 256);
    const int vb0 = (int)(uintptr_t)(lds + ATT_V_OFF) + v_rd_base(lane);
    KVDma dm; kv_dma_init(dm, MODE <= 1 ? NSA_G * HD : KVW, MODE == 0 ? NSA_G * HD : (MODE == 1 ? NSLC : NSA_INP), wid, lane);
    constexpr int NTB = SEQ / 32, NU = BATCH * NSA_G * NTB;
    for (int rd = 0; ; ++rd) {
        int idx;
        { idx = (rd & 1) ? rd * F.G + (F.G - 1 - F.bid) : rd * F.G + F.bid; if (rd * F.G >= NU) break; if (idx >= NU) continue; }
        const int tb = NTB - 1 - idx / (BATCH * NSA_G), bg = idx % (BATCH * NSA_G), g = bg % NSA_G, b = bg / NSA_G;
        const size_t rowb = (size_t)b * SEQ; const int t0 = tb * 32;
        const int t = (MODE == 2) ? t0 + 4 * wid + (r32 >> 3) : t0 + r32, head = (MODE == 2) ? g * NSA_R + (r32 & 7) : g * NSA_R + wid;
        const bf16* Kh; const bf16* Vh; long ldk, ldv; int jlo, jhi;
        if (MODE <= 1) { Kh = Ksrc + ((size_t)b * NCMPP * NSA_G + g) * HD; ldk = NSA_G * HD; jlo = 0; jhi = (t0 >> 4) >> 6;
            if (MODE == 0) { Vh = Vsrc + ((size_t)b * NCMPP * NSA_G + g) * HD; ldv = NSA_G * HD; } else { Vh = Vsrc; ldv = NSLC; } }
        else { Kh = Ksrc + rowb * KVW + g * HD; ldk = KVW; Vh = P1 + rowb * NSA_INP + (MODE == 2 ? P1_VS : P1_VW) + g * HD; ldv = NSA_INP;
            jhi = (t0 + 31) >> 6; jlo = (MODE == 2) ? 0 : ((t0 - (WINDOW - 1) > 0 ? t0 - (WINDOW - 1) : 0) >> 6); }
        unsigned wn[4] = {~0u, ~0u, ~0u, ~0u};
        if (MODE == 2) { const v4u sv = *(const v4u*)(SEL + ((rowb + t) * NSA_G + g) * 4); unsigned selw[4]; selw[0] = sv.x; selw[1] = sv.y; selw[2] = sv.z; selw[3] = sv.w;
            *(LAS v4u*)(lds + ATT_X_OFF + 2048 + (wid * 64 + lane) * 16) = sv;
            LAS unsigned* un = (LAS unsigned*)(lds + ATT_X_OFF);
#pragma unroll
            for (int q = 0; q < 4; ++q) { unsigned x = selw[q]; x |= __shfl_xor(x, 8); x |= __shfl_xor(x, 16); wn[q] = __builtin_amdgcn_readfirstlane(x); if (lane == 0) un[wid * 4 + q] = wn[q]; }
            LDS_WAIT(); __syncthreads();
            LAS int* plist = (LAS int*)(lds + ATT_X_OFF + 128);
            if (wid == 0) {
                unsigned m0 = 0u, m1 = 0u;
                int lane_l = lane; asm volatile("" : "+v"(lane_l));
                const LAS unsigned* ub = un + (lane_l >> 5);
#pragma unroll
                for (int w = 0; w < NWAVES; ++w) { m0 |= ((ub[w * 4] >> (lane & 31)) & 1u) << w; m1 |= ((ub[w * 4 + 2] >> (lane & 31)) & 1u) << w; }
                bool v0 = m0 != 0u && lane <= jhi, v1 = m1 != 0u && lane + 64 <= jhi; int np = 0;
                for (;;) {
                    const unsigned long long a0 = __ballot(v0), a1 = __ballot(v1);
                    if (!(a0 | a1)) break;
                    const int ja_ = a0 ? __builtin_ctzll(a0) : 64 + __builtin_ctzll(a1);
                    const unsigned ma = (ja_ < 64) ? (unsigned)__shfl((int)m0, ja_) : (unsigned)__shfl((int)m1, ja_ - 64);
                    if (lane == (ja_ & 63)) { if (ja_ < 64) v0 = false; else v1 = false; }
                    unsigned long long c0 = __ballot(v0 && !(m0 & ma)), c1 = __ballot(v1 && !(m1 & ma));
                    if (!(c0 | c1)) { c0 = __ballot(v0 && m0 == 0xffu); c1 = __ballot(v1 && m1 == 0xffu); }
                    if (!(c0 | c1)) { c0 = __ballot(v0); c1 = __ballot(v1); }
                    int jb_ = -1;
                    if (c0 | c1) { jb_ = c0 ? __builtin_ctzll(c0) : 64 + __builtin_ctzll(c1); if (lane == (jb_ & 63)) { if (jb_ < 64) v0 = false; else v1 = false; } }
                    if (lane == 0) { plist[2 * np] = ja_; plist[2 * np + 1] = jb_; }
                    ++np;
                }
                if (lane == 0) { int neg1 = -1; asm volatile("" : "+v"(neg1)); plist[2 * np] = neg1; plist[2 * np + 1] = neg1; }
            }
            LDS_WAIT(); }
        bf16x8 qr[8]; load_q(qr, Qsrc + (rowb + t) * (MODE <= 1 ? NSA_INP : DM) + head * HD + hi * 8);
        float m_reg = -1e30f, l_reg = 0.f; f32x16 o[4] = {};
        const int cur = t >> 6;
#define NSA_NEED(jj) (MODE != 2 || ((pick4(wn, (jj) >> 5) >> ((jj) & 31)) & 1u))
#define NSA_MASK(P0, P1, JJ) do { const int k0 = (JJ) * KVBLK; constexpr float NINF = -__builtin_inff(); \
            if (MODE <= 1) { if (!(16 * (k0 + 63) + 31 <= t0)) { \
                    _Pragma("unroll") for (int r = 0; r < 16; ++r) { if (!(16 * (k0 + crow(r, hi)) + 31 <= t)) P0[r] = NINF; if (!(16 * (k0 + 32 + crow(r, hi)) + 31 <= t)) P1[r] = NINF; } } } \
            else if (MODE == 2) { rv_ = (*(const LAS unsigned*)(lds + ATT_X_OFF + 2048 + (wid * 64 + lane) * 16 + ((JJ) >> 5) * 4) >> ((JJ) & 31)) & 1u;     \
                if ((JJ) >= cur) { const int lim = t - k0 - 4 * hi;                          \
                    _Pragma("unroll") for (int r = 0; r < 16; ++r) { if ((r & 3) + 8 * (r >> 2) > lim) P0[r] = NINF; if (32 + (r & 3) + 8 * (r >> 2) > lim) P1[r] = NINF; } } } \
            else { if (!((k0 > t0 + 31 - WINDOW) && (k0 + 63 <= t0))) { \
                    _Pragma("unroll") for (int r = 0; r < 16; ++r) { const int ka = k0 + crow(r, hi), kb = ka + 32; \
                        if (!(ka <= t && ka > t - WINDOW)) P0[r] = NINF; if (!(kb <= t && kb > t - WINDOW)) P1[r] = NINF; } } } } while (0)
        const int pbase = __builtin_amdgcn_readfirstlane((int)(uintptr_t)(lds + ATT_X_OFF + 128)); int pp = 0;
#define PLIST(i) (*(const LAS int*)(uintptr_t)(unsigned)(pbase + 4 * (i)))
        int ja, jb;
        __syncthreads();
        if (MODE == 2) { ja = PLIST(0); jb = PLIST(1); ja = __builtin_amdgcn_readfirstlane(ja); jb = __builtin_amdgcn_readfirstlane(jb); if (ja < 0) ja = jhi + 1; }
        else { ja = jlo; jb = ja + 1; if (jb > jhi) jb = -1; }
        if (ja <= jhi) kv_dma(dm, Kh + (size_t)ja * KVBLK * ldk, Vh + (size_t)ja * KVBLK * ldv, lds, 0, wid);
        if (jb >= 0) kv_dma(dm, Kh + (size_t)jb * KVBLK * ldk, Vh + (size_t)jb * KVBLK * ldv, lds, ATT_BUF, wid);
        int set = 0;
#pragma nounroll
        while (ja <= jhi) {
            int jc, jd;
            if (MODE == 2) { ++pp; jc = PLIST(2 * pp); jd = PLIST(2 * pp + 1); jc = __builtin_amdgcn_readfirstlane(jc); jd = __builtin_amdgcn_readfirstlane(jd); if (jc < 0) jc = jhi + 1; }
            else { jc = (jb >= 0 ? jb : ja) + 1; jd = jc + 1; if (jd > jhi) jd = -1; }
            VM_WAIT(); __syncthreads();
            if (jc <= jhi) kv_dma(dm, Kh + (size_t)jc * KVBLK * ldk, Vh + (size_t)jc * KVBLK * ldv, lds, ATT_SET - set, wid);
            if (jc <= jhi && jd >= 0) kv_dma(dm, Kh + (size_t)jd * KVBLK * ldk, Vh + (size_t)jd * KVBLK * ldv, lds, ATT_SET - set + ATT_BUF, wid);
            const bool nA = NSA_NEED(ja), nB = (jb >= 0) && NSA_NEED(jb);
            f32x16 a0, a1, b0, b1;
            if (nA) qkt(a0, a1, lds + set + ATT_K_OFF, qr, r32, hi);
            if (nB) qkt(b0, b1, lds + set + ATT_BUF + ATT_K_OFF, qr, r32, hi);
            bool rv_ = true;
            if (nA) { NSA_MASK(a0, a1, ja); attn_finish(a0, a1, o, m_reg, l_reg, wsc, vb0 + set, r32, hi, rv_); }
            if (nB) { NSA_MASK(b0, b1, jb); attn_finish(b0, b1, o, m_reg, l_reg, wsc, vb0 + set + ATT_BUF, r32, hi, rv_); }
            ja = jc; jb = (jc <= jhi) ? jd : -1; set = ATT_SET - set;
        }
#undef PLIST
#undef NSA_MASK
#undef NSA_NEED
        { float fac = l_reg > 0.f ? __builtin_amdgcn_rcpf(l_reg) : 0.f;
          if (MODE != 1) { const int br = MODE == 0 ? 0 : (MODE == 2 ? 1 : 2); fac *= sigmoidf_(bf2f(P1[(rowb + t) * NSA_INP + P1_GL + head * 3 + br])); }
          if (hi == 0) wsc[32 + r32] = fac; LDS_WAIT(); }
        if (MODE == 1) {
            float fc[16];
#pragma unroll
            for (int r = 0; r < 16; ++r) fc[r] = wsc[32 + crow(r, hi)];
            LDS_WAIT(); __syncthreads();
#pragma unroll
            for (int r = 0; r < 16; ++r) { const int orow = crow(r, hi);
#pragma unroll
                for (int d0 = 0; d0 < 4; ++d0) *(LAS float*)(lds + ((wid * 32 + orow) * 128 + d0 * 32 + r32) * 4) = o[d0][r] * fc[r]; }
            LDS_WAIT(); __syncthreads();
            { const int tok = tid >> 4, j8 = (tid & 15) * 8; f32x4 s0 = {0.f, 0.f, 0.f, 0.f}, s1 = {0.f, 0.f, 0.f, 0.f};
#pragma unroll
              for (int w = 0; w < 8; ++w) { const LAS f32x4* pp = (const LAS f32x4*)(lds + ((w * 32 + tok) * 128 + j8) * 4); s0 += pp[0]; s1 += pp[1]; }
              LAS f32x4* dst = (LAS f32x4*)(lds + (tok * 128 + j8) * 4); dst[0] = s0; dst[1] = s1; }
            LDS_WAIT(); __syncthreads();
#pragma nounroll
            for (int q = 0; q < 4; ++q) { const int tok = 4 * wid + q, tt = t0 + tok;
                const float a0 = *(const LAS float*)(lds + (tok * 128 + lane) * 4), a1 = *(const LAS float*)(lds + (tok * 128 + 64 + lane) * 4);
                const v4u w = topk_select(a0, a1, tt >> 6, lane);
                if (lane == 0) *(v4u*)(IMPO + ((rowb + tt) * NSA_G + g) * 4) = w; }
            LDS_WAIT(); __syncthreads();
        } else {
            bf16* gp0 = (MODE == 2) ? Ob + (rowb + t0 + 4 * wid) * DM + g * NSA_R * HD : Ob + (rowb + t0) * DM + (g * NSA_R + wid) * HD;
            int lane_e = lane; asm volatile("" : "+v"(lane_e));
            const unsigned lo = (MODE == 2) ? (unsigned)lane_e * 8u : (unsigned)(lane_e >> 4) * DM + (unsigned)(lane_e & 15) * 8u;
#define NSA_PIECE(i) (gp0 + ((MODE == 2) ? (size_t)((i) >> 1) * DM + ((i) & 1) * 512 : (size_t)(4 * (i)) * DM) + lo)
            v4u old[8];
            if (MODE != 0 && !probe_nostore) {
#pragma unroll
                for (int i = 0; i < 8; ++i) old[i] = *(const v4u*)NSA_PIECE(i); }
            LDS_WAIT(); __syncthreads();
            LAS float* stg = (LAS float*)(lds + wid * 16384);
#pragma unroll
            for (int r = 0; r < 16; ++r) { const int orow = crow(r, hi); const float fc = wsc[32 + orow];
#pragma unroll
                for (int d0 = 0; d0 < 4; ++d0) stg[orow * 128 + d0 * 32 + r32] = o[d0][r] * fc; }
            LDS_WAIT();
            if (!probe_nostore) {
#pragma unroll
                for (int i = 0; i < 8; ++i) { const int c = 64 * i + lane_e; f32x4 x0 = *(const LAS f32x4*)(stg + c * 8), x1 = *(const LAS f32x4*)(stg + c * 8 + 4);
                    if (MODE != 0) { x0[0] += bflo(old[i].x); x0[1] += bfhi(old[i].x); x0[2] += bflo(old[i].y); x0[3] += bfhi(old[i].y); x1[0] += bflo(old[i].z); x1[1] += bfhi(old[i].z); x1[2] += bflo(old[i].w); x1[3] += bfhi(old[i].w); }
                    const v4u w = {cvtpk(x0[0], x0[1]), cvtpk(x0[2], x0[3]), cvtpk(x1[0], x1[1]), cvtpk(x1[2], x1[3])};
                    *(v4u*)NSA_PIECE(i) = w; } }
#undef NSA_PIECE
            LDS_WAIT();
        }
    }
}
struct Sub16 { f32x4 o[8]; bf16x8 q[4]; float m, l; };
#define MFMA16(a, b, c) __builtin_amdgcn_mfma_f32_16x16x32_bf16((a), (b), (c), 0, 0, 0)
__device__ __forceinline__ void kv_dma_init16(KVDma& d, int ldk, int ldv, int wid, int lane) {
#pragma unroll
  for (int i = 0; i < 2; ++i) { const int p = wid * 2 + i;
    const int row = p * 4 + (lane >> 4), cp = lane & 15; d.ko[i] = row * ldk + ((cp ^ (row & 15)) << 3);
    const int sub = p * 2 + (lane >> 5), kk = (sub >> 2) * 8 + ((lane & 31) >> 2), k = (kk & ~0xC) | ((kk & 4) << 1) | ((kk & 8) >> 1), c = (sub & 3) * 32 + (((lane & 3) ^ (((k >> 2) & 1) << 1)) * 8);
    d.vo[i] = k * ldv + c; }
}
struct VF16 { s16x4 l0, h0, l1, h1; };
template <int C> __device__ __forceinline__ void pv16_rd(VF16& f, int vaddrA, int vaddrB) {
    constexpr int CO = (C >> 1) * 512; const int vaddr = (C & 1) ? vaddrB : vaddrA;
    f.l0 = tr_read<CO>(vaddr); f.h0 = tr_read<CO + 4096>(vaddr); f.l1 = tr_read<CO + 8192>(vaddr); f.h1 = tr_read<CO + 8192 + 4096>(vaddr);
}
__device__ __forceinline__ void pv16_mma(f32x4& oc, const VF16& f, bf16x8 pa0, bf16x8 pa1) {
    oc = MFMA16(((bf16x8){f.l0[0], f.l0[1], f.l0[2], f.l0[3], f.h0[0], f.h0[1], f.h0[2], f.h0[3]}), pa0, oc);
    oc = MFMA16(((bf16x8){f.l1[0], f.l1[1], f.l1[2], f.l1[3], f.h1[0], f.h1[1], f.h1[2], f.h1[3]}), pa1, oc);
}
__device__ __forceinline__ void slc16_tile(Sub16& S, const LAS char* Kt, const int (&kaddr)[4], int vaddrA, int vaddrB, bool rowvalid, bool diag, int lim  ) {
    f32x4 a[4];
#pragma unroll
    for (int mb = 0; mb < 4; ++mb) a[mb] = (f32x4){0.f, 0.f, 0.f, 0.f};
#pragma unroll
    for (int ks = 0; ks < 4; ++ks)
#pragma unroll
        for (int mb = 0; mb < 4; ++mb) {
            const bf16x8 kf = *(const LAS bf16x8*)(Kt + kaddr[ks] + 16 * mb * 256);
            a[mb] = MFMA16(kf, S.q[ks], a[mb]); }
    constexpr float NINF = -__builtin_inff();
    VF16 f0, f1, f2;
    SBAR(); pv16_rd<0>(f0, vaddrA, vaddrB); pv16_rd<1>(f1, vaddrA, vaddrB); pv16_rd<2>(f2, vaddrA, vaddrB); SBAR();
    if (diag) {
#pragma unroll
        for (int mb = 0; mb < 4; ++mb)
#pragma unroll
            for (int i = 0; i < 4; ++i) if (16 * mb + i > lim) a[mb][i] = NINF; }
    float pmax = fmaxf(fmaxf(a[0][0], a[0][1]), fmaxf(a[0][2], a[0][3]));
#pragma unroll
    for (int mb = 1; mb < 4; ++mb) pmax = fmaxf(pmax, fmaxf(fmaxf(a[mb][0], a[mb][1]), fmaxf(a[mb][2], a[mb][3])));
    { auto r16 = __builtin_amdgcn_permlane16_swap(__float_as_uint(pmax), __float_as_uint(pmax), false, false); pmax = fmaxf(__uint_as_float(r16[0]), __uint_as_float(r16[1]));
      auto r32 = __builtin_amdgcn_permlane32_swap(__float_as_uint(pmax), __float_as_uint(pmax), false, false); pmax = fmaxf(__uint_as_float(r32[0]), __uint_as_float(r32[1])); }
    if (!rowvalid) pmax = NINF;
    float alpha = 1.f, mn = S.m;
    if (!__all(pmax - S.m <= ATT_THR / ATT_SCALE)) { mn = fmaxf(S.m, pmax); alpha = __builtin_amdgcn_exp2f((S.m - mn) * ATT_C); S.m = mn; }
    const float mnC = rowvalid ? -mn * ATT_C : NINF;
    float ps = 0.f;
#pragma unroll
    for (int mb = 0; mb < 4; ++mb)
#pragma unroll
        for (int i = 0; i < 4; ++i) { a[mb][i] = __builtin_amdgcn_exp2f(fmaf(a[mb][i], ATT_C, mnC)); ps += a[mb][i]; }
    S.l = S.l * alpha + ps;
    if (__any(alpha < 1.f)) {
#pragma unroll
        for (int c = 0; c < 8; ++c) S.o[c] *= alpha; }
    bf16x8 pa[2];
#pragma unroll
    for (int h = 0; h < 2; ++h) { const v4u w = {cvtpk(a[2 * h][0], a[2 * h][1]), cvtpk(a[2 * h][2], a[2 * h][3]), cvtpk(a[2 * h + 1][0], a[2 * h + 1][1]), cvtpk(a[2 * h + 1][2], a[2 * h + 1][3])};
        pa[h] = __builtin_bit_cast(bf16x8, w); }
#define W8() do { asm volatile("s_waitcnt lgkmcnt(8)" ::: "memory"); SBAR(); } while (0)
    W8(); pv16_mma(S.o[0], f0, pa[0], pa[1]); SBAR(); pv16_rd<3>(f0, vaddrA, vaddrB);
    W8(); pv16_mma(S.o[1], f1, pa[0], pa[1]); SBAR(); pv16_rd<4>(f1, vaddrA, vaddrB);
    W8(); pv16_mma(S.o[2], f2, pa[0], pa[1]); SBAR(); pv16_rd<5>(f2, vaddrA, vaddrB);
    W8(); pv16_mma(S.o[3], f0, pa[0], pa[1]); SBAR(); pv16_rd<6>(f0, vaddrA, vaddrB);
    W8(); pv16_mma(S.o[4], f1, pa[0], pa[1]); SBAR(); pv16_rd<7>(f1, vaddrA, vaddrB);
    W8(); pv16_mma(S.o[5], f2, pa[0], pa[1]); SBAR();
    asm volatile("s_waitcnt lgkmcnt(4)" ::: "memory"); SBAR(); pv16_mma(S.o[6], f0, pa[0], pa[1]); SBAR();
    asm volatile("s_waitcnt lgkmcnt(0)" ::: "memory"); SBAR(); pv16_mma(S.o[7], f1, pa[0], pa[1]);
#undef W8
}
template <int probe = 0>
__device__ __forceinline__ void nsa_slc16_phase(Frame& F, const bf16* P1, const bf16* Qsrc, const bf16* Ksrc, const unsigned* SEL, bf16* Ob) {
    const int wid = F.wave, lane = F.lane, fr = lane & 15, fq = lane >> 4;
    LAS char* lds = (LAS char*)F.lds;
    KVDma dm; kv_dma_init16(dm, KVW, NSA_INP, wid, lane);
    constexpr int NTB = SEQ / 32, NU = BATCH * NSA_G * NTB;
    int kaddr[4];
#pragma unroll
    for (int ks = 0; ks < 4; ++ks) kaddr[ks] = fr * 256 + 16 * (fq ^ (fr & 3)) + 64 * (ks ^ (fr >> 2));
    const int vlane = (fq & 1) * 2048 + (((lane & 15) >> 2) + 4 * (fq >> 1)) * 64 + 8 * (lane & 3);
    const int vb0 = (int)(uintptr_t)(lds + ATT_V_OFF) + vlane + (fq & 1) * 32, vb1 = (int)(uintptr_t)(lds + ATT_V_OFF) + vlane + (1 - (fq & 1)) * 32;
    for (int rd = 0; ; ++rd) {
        int idx;
        { idx = (rd & 1) ? rd * F.G + (F.G - 1 - F.bid) : rd * F.G + F.bid; if (rd * F.G >= NU) break; if (idx >= NU) continue; }
        const int tb = NTB - 1 - idx / (BATCH * NSA_G), bg = idx % (BATCH * NSA_G), g = bg % NSA_G, b = bg / NSA_G;
        const size_t rowb = (size_t)b * SEQ; const int t0 = tb * 32;
        const bf16* Kh = Ksrc + rowb * KVW + g * HD; const bf16* Vh = P1 + rowb * NSA_INP + P1_VS + g * HD; const long ldk = KVW, ldv = NSA_INP;
        const int jhi = (t0 + 31) >> 6;
        unsigned wn[4], wa[4], wb[4];
        { const int tsel = t0 + 4 * wid + ((lane >> 3) & 3);
          const v4u sv = *(const v4u*)(SEL + ((rowb + tsel) * NSA_G + g) * 4); unsigned selw[4]; selw[0] = sv.x; selw[1] = sv.y; selw[2] = sv.z; selw[3] = sv.w;
          *(LAS v4u*)(lds + ATT_X_OFF + 2048 + (wid * 64 + lane) * 16) = sv;
          LAS unsigned* un = (LAS unsigned*)(lds + ATT_X_OFF);
#pragma unroll
          for (int q = 0; q < 4; ++q) { unsigned x = selw[q]; x |= __shfl_xor(x, 8);
              wa[q] = (unsigned)__builtin_amdgcn_readlane((int)x, 0); wb[q] = (unsigned)__builtin_amdgcn_readlane((int)x, 16); wn[q] = wa[q] | wb[q]; if (lane == 0) un[wid * 4 + q] = wn[q]; }
          LDS_WAIT(); __syncthreads();
          LAS int* plist = (LAS int*)(lds + ATT_X_OFF + 128);
          if (wid == 0) {
              unsigned m0 = 0u, m1 = 0u;
              int lane_l = lane; asm volatile("" : "+v"(lane_l));
              const LAS unsigned* ub = un + (lane_l >> 5);
#pragma unroll
              for (int w = 0; w < NWAVES; ++w) { m0 |= ((ub[w * 4] >> (lane & 31)) & 1u) << w; m1 |= ((ub[w * 4 + 2] >> (lane & 31)) & 1u) << w; }
              bool v0 = m0 != 0u && lane <= jhi, v1 = m1 != 0u && lane + 64 <= jhi; int np = 0;
              for (;;) {
                  const unsigned long long a0 = __ballot(v0), a1 = __ballot(v1);
                  if (!(a0 | a1)) break;
                  const int ja_ = a0 ? __builtin_ctzll(a0) : 64 + __builtin_ctzll(a1);
                  const unsigned ma = (ja_ < 64) ? (unsigned)__shfl((int)m0, ja_) : (unsigned)__shfl((int)m1, ja_ - 64);
                  if (lane == (ja_ & 63)) { if (ja_ < 64) v0 = false; else v1 = false; }
                  unsigned long long c0 = __ballot(v0 && !(m0 & ma)), c1 = __ballot(v1 && !(m1 & ma));
                  if (!(c0 | c1)) { c0 = __ballot(v0 && m0 == 0xffu); c1 = __ballot(v1 && m1 == 0xffu); }
                  if (!(c0 | c1)) { c0 = __ballot(v0); c1 = __ballot(v1); }
                  int jb_ = -1;
                  if (c0 | c1) { jb_ = c0 ? __builtin_ctzll(c0) : 64 + __builtin_ctzll(c1); if (lane == (jb_ & 63)) { if (jb_ < 64) v0 = false; else v1 = false; } }
                  if (lane == 0) { plist[2 * np] = ja_; plist[2 * np + 1] = jb_; }
                  ++np;
              }
              if (lane == 0) { int neg1 = -1; asm volatile("" : "+v"(neg1)); plist[2 * np] = neg1; plist[2 * np + 1] = neg1; }
          }
          LDS_WAIT(); }
        Sub16 SA, SB;
        const int tokA = t0 + 4 * wid + (fr >> 3), tokB = tokA + 2, head = g * NSA_R + (fr & 7);
        { const bf16* qa = Qsrc + (rowb + tokA) * DM + head * HD + 8 * fq; const bf16* qb = Qsrc + (rowb + tokB) * DM + head * HD + 8 * fq;
#pragma unroll
          for (int ks = 0; ks < 4; ++ks) { SA.q[ks] = *(const bf16x8*)(qa + 32 * ks); SB.q[ks] = *(const bf16x8*)(qb + 32 * ks); } }
#pragma unroll
        for (int c = 0; c < 8; ++c) { SA.o[c] = (f32x4){0.f, 0.f, 0.f, 0.f}; SB.o[c] = (f32x4){0.f, 0.f, 0.f, 0.f}; }
        SA.m = -1e30f; SA.l = 0.f; SB.m = -1e30f; SB.l = 0.f;
        const int selA = (int)(uintptr_t)(lds + ATT_X_OFF + 2048 + (wid * 64 + 8 * (fr >> 3)) * 16), selB = selA + 16 * 16;
        const int pbase = __builtin_amdgcn_readfirstlane((int)(uintptr_t)(lds + ATT_X_OFF + 128)); int pp = 0;
#define PLIST(i) (*(const LAS int*)(uintptr_t)(unsigned)(pbase + 4 * (i)))
#define SLC16_ONE(JJ, BUF) do { const int jj_ = (JJ); const int k0_ = jj_ * KVBLK; const bool dg_ = jj_ >= jhi; \
            if ((pick4(wa, jj_ >> 5) >> (jj_ & 31)) & 1u) { const bool rv_ = (*(const LAS unsigned*)(uintptr_t)(unsigned)(selA + (jj_ >> 5) * 4) >> (jj_ & 31)) & 1u; \
                slc16_tile(SA, lds + (BUF) + ATT_K_OFF, kaddr, vb0 + (BUF), vb1 + (BUF), rv_, dg_, tokA - k0_ - 4 * fq); } \
            if ((pick4(wb, jj_ >> 5) >> (jj_ & 31)) & 1u) { const bool rv_ = (*(const LAS unsigned*)(uintptr_t)(unsigned)(selB + (jj_ >> 5) * 4) >> (jj_ & 31)) & 1u; \
                slc16_tile(SB, lds + (BUF) + ATT_K_OFF, kaddr, vb0 + (BUF), vb1 + (BUF), rv_, dg_, tokB - k0_ - 4 * fq); } } while (0)
        int ja, jb;
        __syncthreads();
        ja = PLIST(0); jb = PLIST(1); ja = __builtin_amdgcn_readfirstlane(ja); jb = __builtin_amdgcn_readfirstlane(jb); if (ja < 0) ja = jhi + 1;
        if (ja <= jhi && probe != 1) kv_dma(dm, Kh + (size_t)ja * KVBLK * ldk, Vh + (size_t)ja * KVBLK * ldv, lds, 0, wid);
        if (jb >= 0 && probe != 1) kv_dma(dm, Kh + (size_t)jb * KVBLK * ldk, Vh + (size_t)jb * KVBLK * ldv, lds, ATT_BUF, wid);
        int set = 0;
#pragma nounroll
        while (ja <= jhi) {
            int jc, jd;
            ++pp; jc = PLIST(2 * pp); jd = PLIST(2 * pp + 1); jc = __builtin_amdgcn_readfirstlane(jc); jd = __builtin_amdgcn_readfirstlane(jd); if (jc < 0) jc = jhi + 1;
            VM_WAIT(); __syncthreads();
            if (jc <= jhi && probe != 1) kv_dma(dm, Kh + (size_t)jc * KVBLK * ldk, Vh + (size_t)jc * KVBLK * ldv, lds, ATT_SET - set, wid);
            if (jc <= jhi && jd >= 0 && probe != 1) kv_dma(dm, Kh + (size_t)jd * KVBLK * ldk, Vh + (size_t)jd * KVBLK * ldv, lds, ATT_SET - set + ATT_BUF, wid);
            if (probe != 2 && ((pick4(wn, ja >> 5) >> (ja & 31)) & 1u)) SLC16_ONE(ja, set);
            if (probe != 2 && jb >= 0 && ((pick4(wn, jb >> 5) >> (jb & 31)) & 1u)) SLC16_ONE(jb, set + ATT_BUF);
            ja = jc; jb = (jc <= jhi) ? jd : -1; set = ATT_SET - set;
        }
#undef PLIST
#undef SLC16_ONE
        float facA, facB;
        { float la = SA.l; la += __shfl_xor(la, 16); la += __shfl_xor(la, 32); float lb = SB.l; lb += __shfl_xor(lb, 16); lb += __shfl_xor(lb, 32);
          facA = (la > 0.f ? __builtin_amdgcn_rcpf(la) : 0.f) * sigmoidf_(bf2f(P1[(rowb + tokA) * NSA_INP + P1_GL + head * 3 + 1]));
          facB = (lb > 0.f ? __builtin_amdgcn_rcpf(lb) : 0.f) * sigmoidf_(bf2f(P1[(rowb + tokB) * NSA_INP + P1_GL + head * 3 + 1])); }
        bf16* gp0 = Ob + (rowb + t0 + 4 * wid) * DM + g * NSA_R * HD;
        int lane_e = lane; asm volatile("" : "+v"(lane_e));
        const unsigned lo = (unsigned)lane_e * 8u;
#define NSA_PIECE(i) (gp0 + (size_t)((i) >> 1) * DM + ((i) & 1) * 512 + lo)
        v4u old[8];
#pragma unroll
        for (int i = 0; i < 8; ++i) old[i] = probe ? (v4u){0u, 0u, 0u, 0u} : *(const v4u*)NSA_PIECE(i);
        LDS_WAIT(); __syncthreads();
        LAS float* stg = (LAS float*)(lds + wid * 16384);
#pragma unroll
        for (int c = 0; c < 8; ++c) {
            *(LAS f32x4*)(stg + fr * 128 + 16 * c + 4 * fq) = SA.o[c] * facA;
            *(LAS f32x4*)(stg + (16 + fr) * 128 + 16 * c + 4 * fq) = SB.o[c] * facB; }
        LDS_WAIT();
#pragma unroll
        for (int i = 0; i < 8; ++i) { const int c = 64 * i + lane_e; f32x4 x0 = *(const LAS f32x4*)(stg + c * 8), x1 = *(const LAS f32x4*)(stg + c * 8 + 4);
            x0[0] += bflo(old[i].x); x0[1] += bfhi(old[i].x); x0[2] += bflo(old[i].y); x0[3] += bfhi(old[i].y); x1[0] += bflo(old[i].z); x1[1] += bfhi(old[i].z); x1[2] += bflo(old[i].w); x1[3] += bfhi(old[i].w);
            const v4u w = {cvtpk(x0[0], x0[1]), cvtpk(x0[2], x0[3]), cvtpk(x1[0], x1[1]), cvtpk(x1[2], x1[3])};
            if (!probe) *(v4u*)NSA_PIECE(i) = w; }
#undef NSA_PIECE
        LDS_WAIT();
    }
}
#undef MFMA16

#ifndef STAGE
#define STAGE 3
#endif
#define ZERO_OB_PHASE PH_BEGIN { v4u z = {0u, 0u, 0u, 0u}; v4u* p = (v4u*)Ob; const long n = (long)MTOK * DM / 8; \
            for (long i = (long)F.bid * NTHR + F.tid; i < n; i += (long)F.G * NTHR) p[i] = z; } PH_END
#define MIXER0_PHASES \
    PH_BEGIN { fold_finalize(F, FO_XQ, XW); fold_finalize(F, FO_UP, DFF2); } \
             REP(10) hgrn_phase_a(F, BIG, (const float*)(ws + WS_LB), (bf16*)(ws + WS_QT), (bf16*)(ws + WS_OINTRA), (bf16*)(ws + WS_DS), (float*)(ws + WS_DEC)); \
             REP(11) sb_phase(F, BIG, Ob); PH_END \
    PH_BEGIN REP(12) hgrn_phase_b(F, (const bf16*)(ws + WS_DS), (const float*)(ws + WS_DEC), (bf16*)(ws + WS_SPREV)); PH_END \
    PH_BEGIN REP(13) hgrn_phase_c(F, BIG, (const bf16*)(ws + WS_QT), (const bf16*)(ws + WS_OINTRA), (const bf16*)(ws + WS_SPREV), KIN(IN_HGRN_NW), Ob); PH_END
#if STAGE <= 2
#define MIXER1_PHASES ZERO_OB_PHASE
#else
#define MIXER1_PHASES \
    PH_BEGIN { fold_finalize(F, FO_XQ + XW, XW); } REP(14) { nsa_rope_phase(F, BIG, (const float*)(ws + WS_ROPE), (bf16*)(ws + WS_QROT), (bf16*)(ws + WS_KSROT), (bf16*)(ws + WS_KWROT), (bf16*)(ws + WS_OVL)); \
             nsa_compress_phase(F, BIG, KIN(IN_NSA_CMP_POS), (const bf16*)(ws + WS_W_C1), (const bf16*)(ws + WS_W_C2), (bf16*)(ws + WS_KCMP), (bf16*)(ws + WS_VCMP)); } PH_END \
    PH_BEGIN { REP(15) nsa_attn_phase<0>(F, BIG, BIG, (const bf16*)(ws + WS_KCMP), (const bf16*)(ws + WS_VCMP), nullptr, nullptr, nullptr, Ob); \
             F.fresh(); REP(15) nsa_attn_phase<1>(F, BIG, BIG, (const bf16*)(ws + WS_KCMP), (const bf16*)(ws + WS_OVL), nullptr, nullptr, (unsigned*)(ws + WS_SEL), nullptr); \
             F.fresh(); REP(17) nsa_attn_phase<3>(F, BIG, (const bf16*)(ws + WS_QROT), (const bf16*)(ws + WS_KWROT), nullptr, nullptr, nullptr, nullptr, Ob, r_ > 0); } PH_END \
    PH_BEGIN nsa_slc16_phase(F, BIG, (const bf16*)(ws + WS_QROT), (const bf16*)(ws + WS_KSROT), (const unsigned*)(ws + WS_SEL), Ob); SLC_SECOND PH_END
#endif
#ifndef REPMASK
#define REPMASK 0u
#endif
#ifndef SLC_PROBE
#define SLC_PROBE 0
#endif
#if (REPMASK >> 18) & 1
#define SLC_SECOND F.fresh(); nsa_slc16_phase<SLC_PROBE>(F, BIG, (const bf16*)(ws + WS_QROT), (const bf16*)(ws + WS_KSROT), (const unsigned*)(ws + WS_SEL), Ob);
#else
#define SLC_SECOND
#endif
#define REP(gid) for (int r_ = 0; r_ <= (int)((REPMASK >> (gid)) & 1u); ++r_)
#define PH_BEGIN if (pc >= lo && pc < hi) { F.fresh();
#if (REPMASK >> 23) & 1
#define PH_END   if (pc + 1 < hi) { const unsigned long long tb0_ = __builtin_amdgcn_s_memrealtime(); XcdBarrier bb_ = bar; asm volatile("" : "+s"(bb_.bar), "+s"(bb_.x)); xcd_barrier(bb_); \
        const unsigned w_ = (unsigned)(__builtin_amdgcn_s_memrealtime() - tb0_); tbar_acc += w_; if (threadIdx.x == 0) { atomicMax((unsigned*)(args.ws + 3 * MiB) + pc, 0x7fffffffu - w_); atomicMax((unsigned*)(args.ws + 3 * MiB) + 256 + pc, w_); } } } ++pc;
#else
#define PH_END   if (pc + 1 < hi) { XcdBarrier bb_ = bar; asm volatile("" : "+s"(bb_.bar), "+s"(bb_.x)); xcd_barrier(bb_); } } ++pc;
#endif
template <int l>
__device__ __forceinline__ void layer_body(Frame& F, const Args& args, const XcdBarrier& bar, int& pc, const int lo, const int hi, unsigned long long& tbar_acc) {
    unsigned char* ws = F.ws;
    bf16* HB = (bf16*)(ws + WS_HB); bf16* Y = (bf16*)(ws + WS_Y); float* H32 = (float*)karg()->out;
    bf16* BIG = (bf16*)(ws + WS_BIG); bf16* Gm = (bf16*)(ws + WS_G); bf16* Ob = (bf16*)(ws + WS_O);
    bf16* XQ = (bf16*)(ws + WS_XQ); bf16* XO = (bf16*)(ws + WS_XO);
#define RS(k) ((long long*)(ws + WS_RSUM) + (size_t)(k) * MTOK * 2)
#define LNG(k) (KIN(IN_LN_G) + (size_t)(k) * DM)
#define LNB(k) (KIN(IN_LN_B) + (size_t)(k) * DM)
    const float* cs = (const float*)(ws + WS_FOLDF); const float* b2 = cs + FO_N;
        PH_BEGIN REP(1) {
            const int N = l == 0 ? AB_IN : NSA_INP;
            pg8::StaticOrder S; S.init(MTOK, N, F.G, F.bid);
            if (l == 0) { pg8::Gemm g{HB, (const bf16*)(ws + WS_W_ABIN), MTOK, N, DM}; pg8::EpiBf16<0> E{BIG, N, nullptr, 0, 0, 1.f};
                pg8::gemm_phase<pg8::EpiBf16<0>, pg8::StaticOrder, PG8_ALIGN, PG8_SP2>(F.lds + RING_OFF, g, S, E); }
            else { pg8::Gemm g{Y, (const bf16*)(ws + WS_W_NSAIN), MTOK, N, DM}; pg8::EpiBf16Ln E{BIG, N, RS(2), cs + FO_NSA, b2 + FO_NSA};
                pg8::gemm_phase<pg8::EpiBf16Ln, pg8::StaticOrder, PG8_ALIGN, PG8_SP2>(F.lds + RING_OFF, g, S, E);
                if (r_ == 0) convert_job<CJ_L1A>(F, args, 64, 192); }
        } PH_END
#if STAGE <= 1
        ZERO_OB_PHASE
#else
        if (l == 0) {
            MIXER0_PHASES
        } else {
            MIXER1_PHASES
        }
#endif
        PH_BEGIN REP(2) {
            pg8::Gemm g{Ob, l == 0 ? (const bf16*)(ws + WS_W_ABOUT) : (const bf16*)(ws + WS_W_NSAOUT), MTOK, DM, DM};
            pg8::StaticOrder S; S.init(MTOK, DM, F.G, F.bid);
            if (l == 0) { pg8::EpiRes0 E{Y, HB, DM, DN_ALPHA, RS(0)};
                pg8::gemm_phase<pg8::EpiRes0, pg8::StaticOrder, PG8_ALIGN, PG8_SP2>(F.lds + RING_OFF, g, S, E); }
            else { pg8::EpiResLn2 E{Y, RS(2), LNG(2), LNB(2), DM, DN_ALPHA, RS(3)};
                pg8::gemm_phase<pg8::EpiResLn2, pg8::StaticOrder, PG8_ALIGN, PG8_SP2>(F.lds + RING_OFF, g, S, E); }
        } PH_END
        PH_BEGIN REP(3) {
            {   pg8::Gemm g{Y, (const bf16*)(ws + WS_W_XQ) + (size_t)l * XW * DM, MTOK, XW, DM};
                pg8::RangeOrder S; S.init(MTOK, XW, 0, 128, F.bid);
                pg8::EpiBf16Ln E{XQ, XW, RS(3 * l), cs + FO_XQ + l * XW, b2 + FO_XQ + l * XW};
                pg8::gemm_phase<pg8::EpiBf16Ln, pg8::RangeOrder, PG8_ALIGN, PG8_SP2>(F.lds + RING_OFF, g, S, E); }
            {   pg8::Gemm g{(const bf16*)(ws + WS_MEMB), (const bf16*)(ws + WS_W_XKV) + (size_t)l * 2 * XW * DM, BATCH * NMEM, 2 * XW, DM};
                pg8::RangeOrder S; S.init(BATCH * NMEM, 2 * XW, 128, 8, F.bid);
                pg8::EpiBf16<0> E{(bf16*)(ws + WS_XKV) + (size_t)l * BATCH * NMEM * 2 * XW, 2 * XW, nullptr, 0, 0, 1.f};
                pg8::gemm_phase<pg8::EpiBf16<0>, pg8::RangeOrder, PG8_ALIGN, PG8_SP2>(F.lds + RING_OFF, g, S, E); }
            if (r_ == 0) { if (l == 0) convert_job<CJ_DOWN0>(F, args, 136, 120); else convert_job<CJ_L1B>(F, args, 136, 120); }
        } PH_END
        PH_BEGIN { if (l == 1) fold_finalize(F, FO_UP + DFF2, DFF2); } REP(9) xattn_phase(F, XQ, (const bf16*)(ws + WS_XKV) + (size_t)l * BATCH * NMEM * 2 * XW, XO); PH_END
        PH_BEGIN REP(4) {
            pg8::Gemm g{XO, (const bf16*)(ws + WS_W_XO) + (size_t)l * DM * XW, MTOK, DM, XW};
            pg8::StaticOrder S; S.init(MTOK, DM, F.G, F.bid);
            pg8::EpiResLn2 E{Y, RS(3 * l), LNG(3 * l), LNB(3 * l), DM, DN_ALPHA, RS(3 * l + 1)};
            pg8::gemm_phase<pg8::EpiResLn2, pg8::StaticOrder, PG8_ALIGN, PG8_SP2>(F.lds + RING_OFF, g, S, E);
        } PH_END
        PH_BEGIN REP(5) {
#if (REPMASK >> 22) & 1
            if (r_ > 0) { XcdBarrier bb_ = bar; asm volatile("" : "+s"(bb_.bar), "+s"(bb_.x)); xcd_barrier(bb_); }
#endif
            pg8::Gemm g{Y, (const bf16*)(ws + WS_W_UP) + (size_t)l * DFF2 * DM, MTOK, DFF2, DM};
            pg8::StaticOrder S; S.init(MTOK, DFF2, F.G, F.bid);
            pg8::EpiConvGlu E{Gm, (bf16*)(ws + WS_SIDE), RS(3 * l + 1), cs + FO_UP + l * DFF2, b2 + FO_UP + l * DFF2, KIN(IN_FFN_CONV) + (size_t)l * 3 * DFF, DFF};
            pg8::gemm_phase<pg8::EpiConvGlu, pg8::StaticOrder, PG8_ALIGN, PG8_SP2>(F.lds + RING_OFF, g, S, E);
            if (r_ == 0) { if (l == 0) convert_job<CJ_NSA>(F, args, 128, 128); else convert_job<CJ_DOWN1>(F, args, 128, 128); }
        } PH_END
#if (REPMASK >> 20) & 1
        PH_BEGIN {
            pg8::Gemm g{HB, (const bf16*)(ws + WS_W_UP) + (size_t)l * DFF2 * DM, MTOK, DFF2, DM};
            pg8::ZeroOrder S; S.init(MTOK, DFF2, F.G, F.bid);
            pg8::EpiBf16<0> E{Gm, DFF2, nullptr, 0, 0, 1.f};
            pg8::gemm_phase<pg8::EpiBf16<0>, pg8::ZeroOrder, PG8_ALIGN, PG8_SP2>(F.lds + RING_OFF, g, S, E);
        } PH_END
#endif
        PH_BEGIN { if (l == 0) fold_finalize(F, FO_NSA, NSA_INP); } REP(8) convglu_fixup_phase(F, (const bf16*)(ws + WS_SIDE), KIN(IN_FFN_CONV) + (size_t)l * 3 * DFF, Gm); PH_END
        PH_BEGIN REP(6) {
            pg8::Gemm g{Gm, (const bf16*)(ws + WS_W_DOWN) + (size_t)l * DM * DFF, MTOK, DM, DFF};
            pg8::StaticOrder S; S.init(MTOK, DM, F.G, F.bid);
            pg8::EpiResLn2 E{Y, RS(3 * l + 1), LNG(3 * l + 1), LNB(3 * l + 1), DM, DN_ALPHA, RS(3 * l + 2)};
            pg8::gemm_phase<pg8::EpiResLn2, pg8::StaticOrder, PG8_ALIGN, PG8_SP2>(F.lds + RING_OFF, g, S, E);
        } PH_END
        if (l == 1) { PH_BEGIN REP(7) ln_phase(F, Y, LNG(5), LNB(5), H32); PH_END }
#undef RS
#undef LNG
#undef LNB
}
__global__ void __launch_bounds__(NTHR, 2) mega_fwd(Args args) {
    extern __shared__ __attribute__((aligned(16))) unsigned char lds_raw[];
    Frame F;
    F.lds = (LAS unsigned char*)lds_raw; F.ws = args.ws;
    F.tid = threadIdx.x; F.lane = F.tid & 63; F.wave = __builtin_amdgcn_readfirstlane(F.tid >> 6); F.G = gridDim.x;
    unsigned char* ws = args.ws;
    gu32* ctl = (gu32*)(ws + WS_CTL);
    for (int u = F.tid; u < (LDS_BYTES - LDSCTL_OFF) / 4; u += NTHR) ((LAS unsigned*)(F.lds + LDSCTL_OFF))[u] = 0u;
    __syncthreads();
    volatile LAS unsigned* MISC = (volatile LAS unsigned*)(F.lds + MISC_OFF);
    XcdBarrier bar = xcd_barrier_post((unsigned*)(ctl + CW_BAR), MISC + 8);
    const int lo = args.ph_lo, hi = args.ph_hi; int pc = 0; unsigned long long tbar_acc = 0ull;
    bf16* HB = (bf16*)(ws + WS_HB); bf16* Y = (bf16*)(ws + WS_Y); float* H32 = (float*)karg()->out;
    bf16* BIG = (bf16*)(ws + WS_BIG); bf16* Gm = (bf16*)(ws + WS_G); bf16* Ob = (bf16*)(ws + WS_O);
    bf16* XQ = (bf16*)(ws + WS_XQ); bf16* XO = (bf16*)(ws + WS_XO);

    PH_BEGIN REP(0) p0_prologue(F, args); PH_END

#if (REPMASK >> 21) & 1
    for (int e_ = 0; e_ < 40; ++e_) { PH_BEGIN PH_END }
#endif
    layer_body<0>(F, args, bar, pc, lo, hi, tbar_acc);
    layer_body<1>(F, args, bar, pc, lo, hi, tbar_acc);
#if (REPMASK >> 23) & 1
#ifndef PROBE_BID
#define PROBE_BID 0
#endif
#if (REPMASK >> 24) & 1
    if (blockIdx.x == 0) { unsigned long long tot_ = 0ull; for (int k_ = 0; k_ < pc; ++k_) { const unsigned v_ = __hip_atomic_load((unsigned*)(args.ws + 3 * MiB) + k_, __ATOMIC_RELAXED, __HIP_MEMORY_SCOPE_AGENT); const unsigned x_ = __hip_atomic_load((unsigned*)(args.ws + 3 * MiB) + 256 + k_, __ATOMIC_RELAXED, __HIP_MEMORY_SCOPE_AGENT);
#ifdef PROBE_SPREAD_MASK
            if (v_ && ((PROBE_SPREAD_MASK >> k_) & 1ull)) tot_ += x_ - (0x7fffffffu - v_);
#else
            if (v_) tot_ += 0x7fffffffu - v_;
#endif
        }
        const unsigned long long t0_ = __builtin_amdgcn_s_memrealtime(); while (__builtin_amdgcn_s_memrealtime() - t0_ < tot_) __builtin_amdgcn_s_sleep(8); }
#else
    if (blockIdx.x == PROBE_BID) { const unsigned long long t0_ = __builtin_amdgcn_s_memrealtime(); while (__builtin_amdgcn_s_memrealtime() - t0_ < tbar_acc) __builtin_amdgcn_s_sleep(8); }
#endif
#endif
}

extern "C" void kernel_launch(void* const* d_in, const int* in_sizes, int n_in, void* d_out, int out_size, void* d_ws, size_t ws_size, hipStream_t stream) {
    static int grid = 0;
    if (grid == 0) {
        if (n_in != 19 || in_sizes[0] != MTOK * DM || out_size != MTOK * DM || ws_size < WS_END) {
            fprintf(stderr, "kernel_launch: shape mismatch n_in %d in0 %d out %d ws %zu (need %zu)\n", n_in, n_in > 0 ? in_sizes[0] : -1, out_size, ws_size, (size_t)WS_END); grid = -1; return; }
        int dev = 0, cus = 0, per_cu = 0;
        if (hipGetDevice(&dev) != hipSuccess || hipDeviceGetAttribute(&cus, hipDeviceAttributeMultiprocessorCount, dev) != hipSuccess) { grid = -1; return; }
        if (hipFuncSetAttribute((const void*)mega_fwd, hipFuncAttributeMaxDynamicSharedMemorySize, LDS_BYTES) != hipSuccess) { fprintf(stderr, "kernel_launch: hipFuncSetAttribute failed\n"); grid = -1; return; }
        if (hipOccupancyMaxActiveBlocksPerMultiprocessor(&per_cu, (const void*)mega_fwd, NTHR, LDS_BYTES) != hipSuccess || per_cu < 1)
            fprintf(stderr, "kernel_launch: note: occupancy query reports %d workgroups per CU\n", per_cu);
        (void)hipGetLastError();
        grid = cus;
        if (grid != 256) { fprintf(stderr, "kernel_launch: built for a 256-CU device (workgroup ranges of the cross-attention and conversion phases); this device reports %d; nothing launched\n", cus); grid = -1; return; }
    }
    if (grid < 0) return;
    if (hipMemsetAsync((char*)d_ws + WS_CTL, 0, CTL_ZERO_BYTES, stream) != hipSuccess) { fprintf(stderr, "kernel_launch: memset failed\n"); return; }
    Args a{};
    for (int i = 0; i < 19; ++i) a.in[i] = (const float*)d_in[i];
    a.out = (float*)d_out; a.ws = (unsigned char*)d_ws; a.ph_lo = 0; a.ph_hi = 1 << 20;
    hipLaunchKernelGGL(mega_fwd, dim3(grid), dim3(NTHR), LDS_BYTES, stream, a);
    const hipError_t le = hipPeekAtLastError();
    if (le != hipSuccess) fprintf(stderr, "kernel_launch: launch failed: %s\n", hipGetErrorName(le));
}
```
